# Optimizing an MI355X kernel written in HIP

```python
import jax, jax.numpy as jnp
from jax import lax
import numpy as np

D_MODEL = 1024
BATCH = 8
SEQ = 4096
DEPTH = 4

GRID_W = 64
CTX_LEN = 256
ROPE_BASE = 10000.0
Q_BLOCK = 128
EPS = 1e-6

MLA_HEADS = D_MODEL // 128
MLA_NOPE = 64
MLA_ROPE = 32
MLA_QK = MLA_NOPE + MLA_ROPE
MLA_V = 64
Q_LORA = 3 * D_MODEL // 8
KV_LORA = D_MODEL // 4
MLA_IN = Q_LORA + KV_LORA + MLA_ROPE
CONV_CH = D_MODEL // 2
CONV_K = 31
EVEN_IN = MLA_IN + 2 * CONV_CH
EVEN_OUT = MLA_HEADS * MLA_V + CONV_CH

RW_N = 64
RW_HEADS = D_MODEL // 128
RW_DIM = RW_HEADS * RW_N
DECAY_LORA = 64
ICLR_LORA = 64
GATE_LORA = 128
SHIFT_K = 3
RW_IN = 3 * RW_DIM + 2 * DECAY_LORA + 2 * ICLR_LORA + GATE_LORA
GN_EPS = 64e-5

NA_HEADS = D_MODEL // 128
NA_DIM = 64
WIN_H = 8
WIN_W = 16
NA_IN = 3 * NA_HEADS * NA_DIM
ODD_IN = RW_IN + NA_IN
ODD_OUT = RW_DIM + NA_HEADS * NA_DIM

N_EXPERTS = 16
D_EXPERT = D_MODEL
EC_FACTOR = 2

kernel_name = 'hybrid_mla_conformer_rwkv7_natten_ecmoe_dit'


def rms_norm(x, g):
    xf = x.astype(jnp.float32)
    y = xf * lax.rsqrt(jnp.mean(jnp.square(xf), -1, keepdims=True) + EPS)
    return (y * g.astype(jnp.float32)).astype(x.dtype)


def layer_norm(x, g, b):
    xf = x.astype(jnp.float32)
    mu = jnp.mean(xf, -1, keepdims=True)
    var = jnp.mean(jnp.square(xf - mu), -1, keepdims=True)
    y = (xf - mu) * lax.rsqrt(var + EPS)
    return (y * g.astype(jnp.float32) + b.astype(jnp.float32)).astype(x.dtype)


def head_group_norm(y, g, b):
    B, T, H, N = y.shape
    mu = jnp.mean(y, -1, keepdims=True)
    var = jnp.mean(jnp.square(y - mu), -1, keepdims=True)
    yn = ((y - mu) * lax.rsqrt(var + GN_EPS)).reshape(B, T, H * N)
    return yn * g + b


def depthwise_conv(x, w):
    pad = (w.shape[0] - 1) // 2
    return lax.conv_general_dilated(x, w[:, None, :].astype(x.dtype), (1,), [(pad, pad)],
                                    dimension_numbers=('NWC', 'WIO', 'NWC'),
                                    feature_group_count=x.shape[-1])


def axial_rope_tables(n_tok, rot_dim):
    t = jnp.arange(n_tok, dtype=jnp.int32)
    row = (t // GRID_W).astype(jnp.float32)
    col = (t % GRID_W).astype(jnp.float32)
    half = rot_dim // 2
    inv = ROPE_BASE ** (-jnp.arange(0, half, 2, dtype=jnp.float32) / half)
    ar = row[:, None] * inv
    ac = col[:, None] * inv
    ang = jnp.concatenate([ar, ar, ac, ac], -1)
    return jnp.cos(ang), jnp.sin(ang)


def rotate_half(u):
    u1, u2 = jnp.split(u, 2, -1)
    return jnp.concatenate([-u2, u1], -1)


def apply_axial_rope(x, cos, sin):
    half = x.shape[-1] // 2
    rot = jnp.concatenate([rotate_half(x[..., :half]), rotate_half(x[..., half:])], -1)
    return (x * cos[:, None, :] + rot * sin[:, None, :]).astype(x.dtype)


def dense_attention(q, k, v):
    scale = q.shape[-1] ** -0.5
    s = jnp.einsum('bqhd,bkhd->bhqk', q, k).astype(jnp.float32) * scale
    p = jax.nn.softmax(s, -1).astype(v.dtype)
    return jnp.einsum('bhqk,bkhd->bqhd', p, v)


def blocked_attention(q, k, v):
    B, T, H, D = q.shape
    nb = T // Q_BLOCK
    qb = jnp.moveaxis(q.reshape(B, nb, Q_BLOCK, H, D), 1, 0)
    out = lax.map(lambda qq: dense_attention(qq, k, v), qb)
    return jnp.moveaxis(out, 0, 1).reshape(B, T, H, v.shape[-1])


def mla_qkv(u, q_norm, w_uq, kv_norm, w_ukv, q_g, k_g, rope_cs=None):
    B, T, _ = u.shape
    cq = u[..., :Q_LORA]
    ckv = u[..., Q_LORA:Q_LORA + KV_LORA]
    kr = u[..., Q_LORA + KV_LORA:MLA_IN]
    q = (rms_norm(cq, q_norm) @ w_uq).reshape(B, T, MLA_HEADS, MLA_QK)
    kv = (rms_norm(ckv, kv_norm) @ w_ukv).reshape(B, T, MLA_HEADS, MLA_NOPE + MLA_V)
    k_nope, v = kv[..., :MLA_NOPE], kv[..., MLA_NOPE:]
    k = jnp.concatenate([k_nope, jnp.broadcast_to(kr[:, :, None, :], (B, T, MLA_HEADS, MLA_ROPE))], -1)
    q = rms_norm(q, q_g)
    k = rms_norm(k, k_g)
    if rope_cs is not None:
        cos, sin = rope_cs
        q = jnp.concatenate([q[..., :MLA_NOPE], apply_axial_rope(q[..., MLA_NOPE:], cos, sin)], -1)
        k = jnp.concatenate([k[..., :MLA_NOPE], apply_axial_rope(k[..., MLA_NOPE:], cos, sin)], -1)
    return q, k, v


def conformer_conv(u, dw_w, dw_b, ln_g, ln_b):
    a, gate = jnp.split(u, 2, -1)
    h = a * jax.nn.sigmoid(gate)
    h = depthwise_conv(h, dw_w) + dw_b
    return jax.nn.silu(layer_norm(h, ln_g, ln_b))


def even_mixer(h, hc, rope_cs, w_in, w_out, q_norm, w_uq, kv_norm, w_ukv, q_g, k_g,
               dw_w, dw_b, ln_g, ln_b, with_ctx_out):
    B, T, _ = h.shape
    u = h @ w_in
    uc = hc @ w_in
    mla_p = (q_norm, w_uq, kv_norm, w_ukv, q_g, k_g)
    q, k, v = mla_qkv(u[..., :MLA_IN], *mla_p, rope_cs=rope_cs)
    qc, kc, vc = mla_qkv(uc[..., :MLA_IN], *mla_p)
    o_att = blocked_attention(q, jnp.concatenate([k, kc], 1), jnp.concatenate([v, vc], 1))
    o_conv = conformer_conv(u[..., MLA_IN:], dw_w, dw_b, ln_g, ln_b)
    y = jnp.concatenate([o_att.reshape(B, T, -1), o_conv], -1) @ w_out
    if not with_ctx_out:
        return y, None
    oc_att = dense_attention(qc, kc, vc)
    oc_conv = conformer_conv(uc[..., MLA_IN:], dw_w, dw_b, ln_g, ln_b)
    yc = jnp.concatenate([oc_att.reshape(B, hc.shape[1], -1), oc_conv], -1) @ w_out
    return y, yc


def wkv7_step(S, inp):
    r, w, k, v, a, b = inp
    sa = jnp.einsum('bhvk,bhk->bhv', S, a)
    S = S * w[:, :, None, :] + sa[..., None] * b[:, :, None, :] + v[..., None] * k[:, :, None, :]
    return S, jnp.einsum('bhvk,bhk->bhv', S, r)


def wkv7_scan(S0, r, w, k, v, a, b, reverse):
    xs = tuple(jnp.moveaxis(t.astype(jnp.float32), 1, 0) for t in (r, w, k, v, a, b))
    S, ys = lax.scan(wkv7_step, S0, xs, reverse=reverse)
    return S, jnp.moveaxis(ys, 0, 1)


def rwkv_inputs(u, shift_w, w0, w2, a0, a2, g2, k_k, k_a):
    u = depthwise_conv(u, shift_w)
    B, T, _ = u.shape
    o1 = 3 * RW_DIM
    o2 = o1 + 2 * DECAY_LORA
    o3 = o2 + 2 * ICLR_LORA
    r, k, v = jnp.split(u[..., :o1], 3, axis=-1)
    lw = u[..., o1:o2].reshape(B, T, 2, DECAY_LORA)
    la = u[..., o2:o3].reshape(B, T, 2, ICLR_LORA)
    lg = u[..., o3:]
    logw = (w0 + jnp.einsum('btdr,drc->btdc', jnp.tanh(lw), w2)).astype(jnp.float32)
    w = jnp.exp(-jnp.exp(-jax.nn.softplus(-logw) - 0.5))
    a = jax.nn.sigmoid((a0 + jnp.einsum('btdr,drc->btdc', la, a2)).astype(jnp.float32))
    kk = (k * k_k).reshape(B, T, RW_HEADS, RW_N).astype(jnp.float32)
    kk = kk * lax.rsqrt(jnp.sum(kk * kk, -1, keepdims=True) + 1e-12)
    k_eff = k[:, :, None, :].astype(jnp.float32) * (1.0 + (a - 1.0) * k_a)
    g = jax.nn.sigmoid(lg) @ g2
    hd = lambda t: t.reshape(B, T, RW_HEADS, RW_N).astype(jnp.float32)
    dir_hd = lambda t: t.reshape(B, T, 2, RW_HEADS, RW_N)
    return hd(r), hd(v), kk, dir_hd(w), dir_hd(a), dir_hd(k_eff), g


def rwkv_mixer(u, uc, shift_w, w0, w2, a0, a2, g2, k_k, k_a, r_k, gn_g, gn_b, with_ctx_out):
    p = (shift_w, w0, w2, a0, a2, g2, k_k, k_a)
    lat = rwkv_inputs(u, *p)
    cx = rwkv_inputs(uc, *p)
    rk = r_k.reshape(RW_HEADS, RW_N).astype(jnp.float32)
    B = u.shape[0]

    def direction(inp, d, S0):
        r, v, kk, w, a, k_eff, _ = inp
        a_d, k_d = a[:, :, d], k_eff[:, :, d]
        S, y = wkv7_scan(S0, r, w[:, :, d], k_d, v, -kk, kk * a_d, reverse=(d == 1))
        return S, y + jnp.sum(r * k_d * rk, -1, keepdims=True) * v

    y_lat, y_ctx = [], []
    for d in range(2):
        S0 = jnp.zeros((B, RW_HEADS, RW_N, RW_N), jnp.float32)
        S_c, yc_d = direction(cx, d, S0)
        _, yl_d = direction(lat, d, S_c)
        y_lat.append(yl_d)
        y_ctx.append(yc_d)
    y = head_group_norm(y_lat[0] + y_lat[1], gn_g, gn_b) * lat[6]
    if not with_ctx_out:
        return y, None
    yc = head_group_norm(y_ctx[0] + y_ctx[1], gn_g, gn_b) * cx[6]
    return y, yc


def natten_qkv(u, q_g, k_g):
    B, T, _ = u.shape
    q, k, v = [t.reshape(B, T, NA_HEADS, NA_DIM) for t in jnp.split(u, 3, -1)]
    return rms_norm(q, q_g), rms_norm(k, k_g), v


def neighbourhood_attention(q, k, v, k_ctx, v_ctx, rpb):
    B, T, H, Dh = q.shape
    rows = T // GRID_W
    kh = min(WIN_H, rows)
    kw = min(WIN_W, GRID_W)
    n_loc = kh * kw
    scale = Dh ** -0.5
    qg = q.reshape(B, rows, GRID_W, H, Dh)
    kg = k.reshape(B, rows, GRID_W, H, Dh)
    vg = v.reshape(B, rows, GRID_W, H, Dh)
    cols = jnp.arange(GRID_W, dtype=jnp.int32)
    col_start = jnp.clip(cols - kw // 2, 0, GRID_W - kw)
    col_idx = col_start[:, None] + jnp.arange(kw, dtype=jnp.int32)[None, :]
    dcol = col_idx - cols[:, None] + (WIN_W - 1)

    def one_row(r):
        rs = jnp.clip(r - kh // 2, 0, rows - kh)
        k_band = lax.dynamic_slice_in_dim(kg, rs, kh, axis=1)
        v_band = lax.dynamic_slice_in_dim(vg, rs, kh, axis=1)
        k_win = k_band[:, :, col_idx]
        v_win = v_band[:, :, col_idx]
        q_row = lax.dynamic_index_in_dim(qg, r, axis=1, keepdims=False)
        drow = rs + jnp.arange(kh, dtype=jnp.int32) - r + (WIN_H - 1)
        bias = jnp.transpose(rpb[:, drow][:, :, dcol], (0, 2, 1, 3))
        s_loc = jnp.einsum('bchd,bicjhd->bhcij', q_row, k_win).astype(jnp.float32) * scale + bias.astype(jnp.float32)
        s_ctx = jnp.einsum('bchd,bnhd->bhcn', q_row, k_ctx).astype(jnp.float32) * scale
        s = jnp.concatenate([s_loc.reshape(B, H, GRID_W, n_loc), s_ctx], -1)
        p = jax.nn.softmax(s, -1).astype(v.dtype)
        o = jnp.einsum('bhcij,bicjhd->bchd', p[..., :n_loc].reshape(B, H, GRID_W, kh, kw), v_win)
        return o + jnp.einsum('bhcn,bnhd->bchd', p[..., n_loc:], v_ctx)

    out = lax.map(one_row, jnp.arange(rows, dtype=jnp.int32))
    return jnp.moveaxis(out, 0, 1).reshape(B, T, H, Dh)


def odd_mixer(h, hc, w_in, w_out, shift_w, w0, w2, a0, a2, g2, k_k, k_a, r_k, gn_g, gn_b,
              q_g, k_g, rpb, with_ctx_out):
    B, T, _ = h.shape
    u = h @ w_in
    uc = hc @ w_in
    y_rw, yc_rw = rwkv_mixer(u[..., :RW_IN], uc[..., :RW_IN], shift_w, w0, w2, a0, a2, g2,
                             k_k, k_a, r_k, gn_g, gn_b, with_ctx_out)
    q, k, v = natten_qkv(u[..., RW_IN:], q_g, k_g)
    qc, kc, vc = natten_qkv(uc[..., RW_IN:], q_g, k_g)
    y_na = neighbourhood_attention(q, k, v, kc, vc, rpb)
    y = jnp.concatenate([y_rw, y_na.reshape(B, T, -1)], -1) @ w_out
    if not with_ctx_out:
        return y, None
    yc_na = dense_attention(qc, kc, vc)
    yc = jnp.concatenate([yc_rw, yc_na.reshape(B, hc.shape[1], -1)], -1) @ w_out
    return y, yc


def expert_choice_ffn(h, router, w1, w3, w2):
    B, T, D = h.shape
    cap = max(1, EC_FACTOR * T // N_EXPERTS)
    aff = jax.nn.softmax(jnp.einsum('btd,de->bte', h, router).astype(jnp.float32), -1)
    gate, idx = lax.top_k(jnp.swapaxes(aff, 1, 2), cap)
    xs = jax.vmap(lambda hb, ib: hb[ib])(h, idx)
    hid = jax.nn.silu(jnp.einsum('becd,edf->becf', xs, w1)) * jnp.einsum('becd,edf->becf', xs, w3)
    ys = jnp.einsum('becf,efd->becd', hid, w2) * gate[..., None].astype(h.dtype)
    return jax.vmap(lambda yb, ib: jnp.zeros((T, D), yb.dtype).at[ib.reshape(-1)].add(yb.reshape(-1, D)))(ys, idx)


def setup_inputs(seed: int = 0) -> dict:
    key = jax.random.key(seed)
    keys = iter(jax.random.split(key, 64))

    def nrm(shape, scale):
        return jax.random.normal(next(keys), shape, jnp.float32) * scale

    def gain(shape):
        return 1.0 + nrm(shape, 0.05)

    ne, no = (DEPTH + 1) // 2, DEPTH // 2
    d = D_MODEL
    shift_base = jnp.array([0.25, 0.5, 0.25], jnp.float32)[None, :, None]
    return {
        'x': nrm((BATCH, SEQ, d), 1.0),
        'c': nrm((BATCH, d), 1.0),
        'ctx': nrm((BATCH, CTX_LEN, d), 1.0),
        'c_ctx': nrm((d,), 1.0),
        'ada_w': nrm((DEPTH, d, 6 * d), 0.5 * d ** -0.5),
        'ada_b': nrm((DEPTH, 6 * d), 0.02),
        'norm1_g': gain((DEPTH, d)),
        'norm2_g': gain((DEPTH, d)),
        'ev_w_in': nrm((ne, d, EVEN_IN), d ** -0.5),
        'ev_w_out': nrm((ne, EVEN_OUT, d), EVEN_OUT ** -0.5),
        'mla_q_norm': gain((ne, Q_LORA)),
        'mla_w_uq': nrm((ne, Q_LORA, MLA_HEADS * MLA_QK), Q_LORA ** -0.5),
        'mla_kv_norm': gain((ne, KV_LORA)),
        'mla_w_ukv': nrm((ne, KV_LORA, MLA_HEADS * (MLA_NOPE + MLA_V)), KV_LORA ** -0.5),
        'mla_q_g': gain((ne, MLA_QK)),
        'mla_k_g': gain((ne, MLA_QK)),
        'cv_dw_w': nrm((ne, CONV_K, CONV_CH), CONV_K ** -0.5),
        'cv_dw_b': nrm((ne, CONV_CH), 0.02),
        'cv_ln_g': gain((ne, CONV_CH)),
        'cv_ln_b': nrm((ne, CONV_CH), 0.02),
        'od_w_in': nrm((no, d, ODD_IN), d ** -0.5),
        'od_w_out': nrm((no, ODD_OUT, d), ODD_OUT ** -0.5),
        'rw_shift_w': shift_base + nrm((no, SHIFT_K, RW_IN), 0.1),
        'rw_w0': jax.random.uniform(next(keys), (no, 2, RW_DIM), jnp.float32, -4.0, 1.0),
        'rw_w2': nrm((no, 2, DECAY_LORA, RW_DIM), 0.5 * DECAY_LORA ** -0.5),
        'rw_a0': nrm((no, 2, RW_DIM), 0.5),
        'rw_a2': nrm((no, 2, ICLR_LORA, RW_DIM), 0.5 * ICLR_LORA ** -0.5),
        'rw_g2': nrm((no, GATE_LORA, RW_DIM), GATE_LORA ** -0.5),
        'rw_k_k': 0.85 + nrm((no, RW_DIM), 0.05),
        'rw_k_a': gain((no, RW_DIM)),
        'rw_r_k': nrm((no, RW_DIM), 0.3),
        'rw_gn_g': gain((no, RW_DIM)),
        'rw_gn_b': nrm((no, RW_DIM), 0.02),
        'na_q_g': gain((no, NA_DIM)),
        'na_k_g': gain((no, NA_DIM)),
        'na_rpb': nrm((no, NA_HEADS, 2 * WIN_H - 1, 2 * WIN_W - 1), 0.5),
        'moe_router': nrm((DEPTH, d, N_EXPERTS), d ** -0.5),
        'moe_w1': nrm((DEPTH, N_EXPERTS, d, D_EXPERT), d ** -0.5),
        'moe_w3': nrm((DEPTH, N_EXPERTS, d, D_EXPERT), d ** -0.5),
        'moe_w2': nrm((DEPTH, N_EXPERTS, D_EXPERT, d), D_EXPERT ** -0.5),
    }


def reference(x, c, ctx, c_ctx, ada_w, ada_b, norm1_g, norm2_g,
              ev_w_in, ev_w_out, mla_q_norm, mla_w_uq, mla_kv_norm, mla_w_ukv, mla_q_g, mla_k_g,
              cv_dw_w, cv_dw_b, cv_ln_g, cv_ln_b,
              od_w_in, od_w_out, rw_shift_w, rw_w0, rw_w2, rw_a0, rw_a2, rw_g2, rw_k_k, rw_k_a, rw_r_k,
              rw_gn_g, rw_gn_b, na_q_g, na_k_g, na_rpb,
              moe_router, moe_w1, moe_w3, moe_w2):
    rope_cs = axial_rope_tables(x.shape[1], MLA_ROPE)
    for i in range(DEPTH):
        last = i == DEPTH - 1
        j = i // 2
        mod = jnp.einsum('bd,de->be', jax.nn.silu(c), ada_w[i]) + ada_b[i]
        mod_c = jax.nn.silu(c_ctx) @ ada_w[i] + ada_b[i]
        sh1, sc1, g1, sh2, sc2, g2 = jnp.split(mod[:, None, :], 6, -1)
        csh1, csc1, cg1, csh2, csc2, cg2 = jnp.split(mod_c[None, None, :], 6, -1)
        h = rms_norm(x, norm1_g[i]) * (1.0 + sc1) + sh1
        hc = rms_norm(ctx, norm1_g[i]) * (1.0 + csc1) + csh1
        if i % 2 == 0:
            y, yc = even_mixer(h, hc, rope_cs, ev_w_in[j], ev_w_out[j], mla_q_norm[j], mla_w_uq[j],
                               mla_kv_norm[j], mla_w_ukv[j], mla_q_g[j], mla_k_g[j],
                               cv_dw_w[j], cv_dw_b[j], cv_ln_g[j], cv_ln_b[j], not last)
        else:
            y, yc = odd_mixer(h, hc, od_w_in[j], od_w_out[j], rw_shift_w[j], rw_w0[j], rw_w2[j],
                              rw_a0[j], rw_a2[j], rw_g2[j], rw_k_k[j], rw_k_a[j], rw_r_k[j],
                              rw_gn_g[j], rw_gn_b[j], na_q_g[j], na_k_g[j], na_rpb[j], not last)
        x = x + g1 * y
        h = rms_norm(x, norm2_g[i]) * (1.0 + sc2) + sh2
        x = x + g2 * expert_choice_ffn(h, moe_router[i], moe_w1[i], moe_w3[i], moe_w2[i])
        if not last:
            ctx = ctx + cg1 * yc
            hc = rms_norm(ctx, norm2_g[i]) * (1.0 + csc2) + csh2
            ctx = ctx + cg2 * expert_choice_ffn(hc, moe_router[i], moe_w1[i], moe_w3[i], moe_w2[i])
    return x
```

```cpp
#include <hip/hip_runtime.h>
#include <cstdio>
#include <cstdint>

#ifndef MEGA
#define MEGA 0
#endif

#define LAS __attribute__((address_space(3)))
#define DI __device__ __forceinline__

typedef unsigned short bf16;
typedef short bf16x8 __attribute__((ext_vector_type(8)));
typedef float f32x4 __attribute__((ext_vector_type(4)));
typedef float f32x2 __attribute__((ext_vector_type(2)));
typedef float f32x16 __attribute__((ext_vector_type(16)));
typedef unsigned u32x4 __attribute__((ext_vector_type(4)));
typedef unsigned u32x2 __attribute__((ext_vector_type(2)));
typedef __bf16 bf16x2_t __attribute__((ext_vector_type(2)));

constexpr int DM = 1024, NB = 8, TL = 4096, LCX = 256;
constexpr int NLAT = NB * TL, NCTX = NB * LCX, MT = NLAT + NCTX;
constexpr int KPOS = TL + LCX;
constexpr float EPS = 1e-6f, GN_EPS = 64e-5f;
constexpr int EV_IN = 1696, EV_INP = 1792, OD_IN = 3456, OD_INP = 3584, RW_IN = 1920;
constexpr int NEXP = 16, CAPL = 512, CAPC = 32, ESLOTS = NB * CAPL + NB * CAPC;
constexpr float LOG2E = 1.4426950408889634f;

constexpr size_t MiB = 1ull << 20;
constexpr size_t WS_CTL = 0, CTL_BYTES = 1 * MiB;
constexpr size_t WS_MOD = 1 * MiB, WS_ROPE = 2 * MiB, WS_XC = 4 * MiB;
constexpr size_t WS_ROWS = 12 * MiB, WS_GATE = 12 * MiB + 512 * 1024, WS_SLOT = 13 * MiB, WS_AFFT = 16 * MiB, WS_AFFC = 18 * MiB;
constexpr size_t WS_WEVIN = 20 * MiB, WS_WEVOUT = 27 * MiB, WS_WUQ = 31 * MiB, WS_WUKV = 33 * MiB, WS_WODIN = 34 * MiB, WS_WODOUT = 48 * MiB, WS_WLORA = 52 * MiB;
constexpr size_t WS_W13 = 56 * MiB, WS_W2 = 120 * MiB, WS_HB = 152 * MiB, WS_OCAT = 220 * MiB, WS_ARENA = 288 * MiB;
constexpr size_t A_U = 0, A_QPRE = 119 * MiB, A_KVPRE = 221 * MiB, A_QB = 357 * MiB, A_KB = 408 * MiB, A_VT = 459 * MiB;
constexpr size_t A_W = 0, A_KEFF = 136 * MiB, A_BSC = 204 * MiB, A_R = 272 * MiB, A_V = 306 * MiB, A_KK = 340 * MiB, A_G = 374 * MiB, A_K = 408 * MiB, A_L = 442 * MiB,
                 A_QN = 468 * MiB, A_KN = 502 * MiB, A_VTN = 536 * MiB, A_YS = 408 * MiB;
constexpr size_t A_HID = 0, A_Y2 = 136 * MiB;
constexpr size_t WS_END = WS_ARENA + 570 * MiB;
constexpr int LDS_BYTES = 147456;

DI unsigned pk2(float lo, float hi) { f32x2 v = {lo, hi}; bf16x2_t b = __builtin_convertvector(v, bf16x2_t); return __builtin_bit_cast(unsigned, b); }
DI float bflo(unsigned u) { return __builtin_bit_cast(float, u << 16); }
DI float bfhi(unsigned u) { return __builtin_bit_cast(float, u & 0xffff0000u); }
DI float bf2f(bf16 x) { return __builtin_bit_cast(float, ((unsigned)x) << 16); }
DI bf16 f2bf(float f) { return (bf16)(pk2(f, 0.f) & 0xffffu); }
DI void unpack8(u32x4 v, float (&f)[8]) { f[0] = bflo(v.x); f[1] = bfhi(v.x); f[2] = bflo(v.y); f[3] = bfhi(v.y); f[4] = bflo(v.z); f[5] = bfhi(v.z); f[6] = bflo(v.w); f[7] = bfhi(v.w); }
DI u32x4 pack8(const float (&f)[8]) { u32x4 r; r.x = pk2(f[0], f[1]); r.y = pk2(f[2], f[3]); r.z = pk2(f[4], f[5]); r.w = pk2(f[6], f[7]); return r; }
DI float wave_sum(float v) {
#pragma unroll
    for (int o = 1; o < 64; o <<= 1) v += __shfl_xor(v, o);
    return v;
}
DI float sum8(float v) { v += __shfl_xor(v, 1); v += __shfl_xor(v, 2); v += __shfl_xor(v, 4); return v; }
DI float sigmoidf_(float x) { return 1.f / (1.f + __expf(-x)); }
DI float siluf_(float x) { return x / (1.f + __expf(-x)); }
#define MFMA32(a, b, c) __builtin_amdgcn_mfma_f32_32x32x16_bf16((a), (b), (c), 0, 0, 0)

#define XB_TMO      128
#define XB_XCNT(j)  (256  + 64 * (j))
#define XB_XSUB(j)  (1280 + 64 * (j))
#define XB_XGEN(j)  (2304 + 64 * (j))
#define XB_TOP      3328
#define XB_TOPGEN   3392
#define XCD_BAR_WORDS 3456
#define XB_SPIN_CAP (1u << 22)
__device__ __forceinline__ unsigned xb_ld(unsigned* p)              { return __hip_atomic_load(p, __ATOMIC_RELAXED, __HIP_MEMORY_SCOPE_AGENT); }
__device__ __forceinline__ unsigned xb_add(unsigned* p, unsigned v) { return __hip_atomic_fetch_add(p, v, __ATOMIC_RELAXED, __HIP_MEMORY_SCOPE_AGENT); }
__device__ __forceinline__ unsigned xb_xcc_id() { return (unsigned)__builtin_amdgcn_s_getreg((3 << 11) | 20) & 0xFu; }
#define XB_SPIN(cond, bar) do { unsigned _sp = 0; while (cond) { __builtin_amdgcn_s_sleep(1); \
    if ((++_sp & 255u) == 0u) { if (xb_ld(&(bar)[XB_TMO])) break; if (_sp > XB_SPIN_CAP) { atomicAdd(&(bar)[XB_TMO], 1u); break; } } } } while (0)
struct XcdBarrier { unsigned* bar; unsigned x; volatile LAS unsigned* st; };
__device__ __forceinline__ XcdBarrier xcd_barrier_post(unsigned* bar, volatile LAS unsigned* st) {
    XcdBarrier b; b.bar = bar; b.x = xb_xcc_id(); b.st = st;
    if (threadIdx.x == 0) (void)xb_add(&bar[XB_XCNT(b.x)], 1u);
    return b;
}
__device__ __forceinline__ void xcd_barrier_complete(unsigned* bar, unsigned x, unsigned& nloc, unsigned& nx) {
    const unsigned G = gridDim.x * gridDim.y * gridDim.z;
    unsigned sum, cnt, mine, sp = 0u;
    for (;;) {
        sum = 0u; cnt = 0u; mine = 0u;
#pragma unroll
        for (unsigned j = 0; j < 16; ++j) { const unsigned c = xb_ld(&bar[XB_XCNT(j)]); sum += c; cnt += (c > 0u) ? 1u : 0u; mine = (j == x) ? c : mine; }
        if (sum == G) break;
        __builtin_amdgcn_s_sleep(1);
        if ((++sp & 255u) == 0u) { if (xb_ld(&bar[XB_TMO])) break; if (sp > XB_SPIN_CAP) { atomicAdd(&bar[XB_TMO], 1u); break; } }
    }
    nloc = mine > 0u ? mine : 1u; nx = cnt > 0u ? cnt : 1u;
}
__device__ __forceinline__ void xcd_barrier(const XcdBarrier& b) {
    asm volatile("s_waitcnt vmcnt(0)" ::: "memory");
    __syncthreads();
    if (threadIdx.x == 0) {
        unsigned* bar = b.bar;
        __builtin_amdgcn_s_waitcnt(0);
        unsigned nloc = b.st[0], nx = b.st[1];
        if (nloc == 0u) { xcd_barrier_complete(bar, b.x, nloc, nx); b.st[0] = nloc; b.st[1] = nx; }
        const unsigned old = xb_add(&bar[XB_XSUB(b.x)], 1u);
        const unsigned gen = old / nloc;
        if (old + 1u == (gen + 1u) * nloc) {
            __builtin_amdgcn_fence(__ATOMIC_RELEASE, "agent");
            asm volatile("s_waitcnt vmcnt(0)" ::: "memory");
            const unsigned og = xb_add(&bar[XB_TOP], 1u);
            const unsigned tg = og / nx;
            if (og + 1u == (tg + 1u) * nx) xb_add(&bar[XB_TOPGEN], 1u);
            else XB_SPIN(xb_ld(&bar[XB_TOPGEN]) == tg, bar);
            __builtin_amdgcn_fence(__ATOMIC_ACQUIRE, "agent");
            xb_add(&bar[XB_XGEN(b.x)], 1u);
            asm volatile("s_waitcnt vmcnt(0)" ::: "memory");
        } else {
            XB_SPIN(xb_ld(&bar[XB_XGEN(b.x)]) == gen, bar);
            __builtin_amdgcn_fence(__ATOMIC_ACQUIRE, "agent");
            asm volatile("s_waitcnt vmcnt(0)" ::: "memory");
        }
    }
    __syncthreads();
}

struct Ctx { LAS unsigned char* lds; int tid, lane, wave, bid, nb, vcu; };
struct Args { const float* in[40]; float* out; unsigned char* ws; int ph_lo, ph_hi; };
enum { I_X = 0, I_C, I_CTX, I_CCTX, I_ADAW, I_ADAB, I_N1G, I_N2G, I_EVWIN, I_EVWOUT, I_QNORM, I_WUQ, I_KVNORM, I_WUKV, I_QG, I_KG, I_DWW, I_DWB, I_LNG, I_LNB,
       I_ODWIN, I_ODWOUT, I_SHIFTW, I_W0, I_W2L, I_A0, I_A2, I_G2, I_KKW, I_KA, I_RK, I_GNG, I_GNB, I_NAQG, I_NAKG, I_RPB, I_ROUTER, I_MW1, I_MW3, I_MW2 };

DI void transpose_item(const float* __restrict__ W, int K, int N, bf16* __restrict__ WT, int dst_row0, const float* __restrict__ gain, LAS float* scr, int k0, int n0, int lane) {
#pragma unroll 8
    for (int i = 0; i < 32; ++i) { const int kk = 2 * i + (lane >> 5); float v = W[(size_t)(k0 + kk) * N + n0 + (lane & 31)]; if (gain) v *= gain[k0 + kk]; scr[kk * 33 + (lane & 31)] = v; }
    asm volatile("s_waitcnt lgkmcnt(0)" ::: "memory");
    const int c = lane & 7;
#pragma unroll
    for (int j = 0; j < 4; ++j) { const int n = (lane >> 3) + 8 * j; const LAS float* s = scr + (8 * c) * 33 + n;
        u32x4 o; o.x = pk2(s[0 * 33], s[1 * 33]); o.y = pk2(s[2 * 33], s[3 * 33]); o.z = pk2(s[4 * 33], s[5 * 33]); o.w = pk2(s[6 * 33], s[7 * 33]);
        *(u32x4*)(WT + (size_t)(dst_row0 + n) * K + k0 + 8 * c) = o; }
    asm volatile("s_waitcnt lgkmcnt(0)" ::: "memory");
}
DI void transpose_matrix(const Ctx& C, const float* W, int K, int N, bf16* WT, const float* gain, int mode  ) {
    LAS float* scr = (LAS float*)(C.lds + C.wave * 8704);
    const int nkb = K / 64, nnb = N / 32, nit = nkb * nnb, gw = C.vcu * 8 + C.wave, ngw = C.nb * 8;
    for (int it = gw; it < nit; it += ngw) {
        const int kb = it / nnb, nbk = it % nnb, n0 = nbk * 32;
        int d0 = n0; if (mode) d0 = (n0 >> 7) * 256 + (n0 & 127) + (mode == 2 ? 128 : 0);
        transpose_item(W, K, N, WT, d0, gain, scr, kb * 64, n0, C.lane);
    }
}
DI void moe_weight_prep(const Ctx& C, const float* w1, const float* w3, const float* w2, bf16* W13, bf16* W2) {
    LAS float* scr = (LAS float*)(C.lds + C.wave * 8704);
    const int gw = C.vcu * 8 + C.wave, ngw = C.nb * 8;
    constexpr int PER = 16 * 32;
    for (int it = gw; it < NEXP * 3 * PER; it += ngw) {
        const int e = it / (3 * PER), r = it % (3 * PER), which = r / PER, q = r % PER, kb = q / 32, n0 = (q % 32) * 32;
        if (which == 0)      transpose_item(w1 + (size_t)e * DM * DM, DM, DM, W13 + (size_t)e * 2048 * DM, (n0 >> 7) * 256 + (n0 & 127), nullptr, scr, kb * 64, n0, C.lane);
        else if (which == 1) transpose_item(w3 + (size_t)e * DM * DM, DM, DM, W13 + (size_t)e * 2048 * DM, (n0 >> 7) * 256 + (n0 & 127) + 128, nullptr, scr, kb * 64, n0, C.lane);
        else                 transpose_item(w2 + (size_t)e * DM * DM, DM, DM, W2 + (size_t)e * DM * DM, n0, nullptr, scr, kb * 64, n0, C.lane);
    }
}

DI void ph_prologue(const Ctx& C, const Args& a) {
    unsigned char* ws = a.ws;
    {
        LAS float* sv = (LAS float*)C.lds;
        LAS float* red = sv + 9 * 1024;
        for (int i = C.tid; i < 9 * 1024; i += 512) { const int m = i >> 10, k = i & 1023; const float c = (m < 8) ? a.in[I_C][m * 1024 + k] : a.in[I_CCTX][k]; sv[i] = siluf_(c); }
        __syncthreads();
        float* MOD = (float*)(ws + WS_MOD);
        for (int it = C.bid; it < 4 * 96; it += C.nb) {
            const int layer = it / 96, col = (it % 96) * 64 + C.lane;
            const float* wp = a.in[I_ADAW] + (size_t)layer * 1024 * 6144 + col;
            float acc[9];
#pragma unroll
            for (int m = 0; m < 9; ++m) acc[m] = 0.f;
            const int kb = C.wave * 128;
#pragma unroll 4
            for (int k = 0; k < 128; ++k) { const float w = wp[(size_t)(kb + k) * 6144];
#pragma unroll
                for (int m = 0; m < 9; ++m) acc[m] += sv[m * 1024 + kb + k] * w; }
#pragma unroll
            for (int m = 0; m < 9; ++m) red[(C.wave * 9 + m) * 64 + C.lane] = acc[m];
            __syncthreads();
            for (int i = C.tid; i < 576; i += 512) { const int m = i >> 6, l = i & 63; float s = 0.f;
#pragma unroll
                for (int w = 0; w < 8; ++w) s += red[(w * 9 + m) * 64 + l];
                const int cc = (it % 96) * 64 + l;
                MOD[(size_t)(layer * 9 + m) * 6144 + cc] = s + a.in[I_ADAB][layer * 6144 + cc]; }
            __syncthreads();
        }
    }
    {
        f32x2* CS = (f32x2*)(ws + WS_ROPE);
        for (int i = C.bid * 512 + C.tid; i < 4096 * 16; i += C.nb * 512) {
            const int pos = i >> 4, j = i & 15, f = j & 7;
            const float inv = powf(10000.f, -(float)(2 * f) / 16.f);
            const float ang = (float)((j < 8) ? (pos >> 6) : (pos & 63)) * inv;
            const double tw = 6.283185307179586476925;
            const double x = (double)ang, n = __builtin_rint(x / tw), rr = x - n * tw;
            CS[i] = (f32x2){__cosf((float)rr), __sinf((float)rr)};
        }
    }
    for (int j = 0; j < 2; ++j) {
        transpose_matrix(C, a.in[I_EVWIN] + (size_t)j * DM * EV_IN, DM, EV_IN, (bf16*)(ws + WS_WEVIN) + (size_t)j * EV_INP * DM, nullptr, 0);
        transpose_matrix(C, a.in[I_EVWOUT] + (size_t)j * DM * DM, DM, DM, (bf16*)(ws + WS_WEVOUT) + (size_t)j * DM * DM, nullptr, 0);
        transpose_matrix(C, a.in[I_WUQ] + (size_t)j * 384 * 768, 384, 768, (bf16*)(ws + WS_WUQ) + (size_t)j * 768 * 384, a.in[I_QNORM] + j * 384, 0);
        transpose_matrix(C, a.in[I_WUKV] + (size_t)j * 256 * 1024, 256, 1024, (bf16*)(ws + WS_WUKV) + (size_t)j * 1024 * 256, a.in[I_KVNORM] + j * 256, 0);
        transpose_matrix(C, a.in[I_ODWIN] + (size_t)j * DM * OD_IN, DM, OD_IN, (bf16*)(ws + WS_WODIN) + (size_t)j * OD_INP * DM, nullptr, 0);
        transpose_matrix(C, a.in[I_ODWOUT] + (size_t)j * DM * DM, DM, DM, (bf16*)(ws + WS_WODOUT) + (size_t)j * DM * DM, nullptr, 0);
    }
    {
        const int gt = C.bid * 512 + C.tid, ngt = C.nb * 512;
        for (int j = 0; j < 2; ++j) {
            u32x4* p0 = (u32x4*)((bf16*)(ws + WS_WEVIN) + (size_t)j * EV_INP * DM + (size_t)EV_IN * DM);
            for (int i = gt; i < (EV_INP - EV_IN) * DM / 8; i += ngt) p0[i] = (u32x4){0u, 0u, 0u, 0u};
            u32x4* p1 = (u32x4*)((bf16*)(ws + WS_WODIN) + (size_t)j * OD_INP * DM + (size_t)OD_IN * DM);
            for (int i = gt; i < (OD_INP - OD_IN) * DM / 8; i += ngt) p1[i] = (u32x4){0u, 0u, 0u, 0u};
            bf16* WL = (bf16*)(ws + WS_WLORA) + (size_t)j * 2560 * 384;
            const float* w2 = a.in[I_W2L] + (size_t)j * 2 * 64 * 512; const float* a2 = a.in[I_A2] + (size_t)j * 2 * 64 * 512; const float* g2 = a.in[I_G2] + (size_t)j * 128 * 512;
            for (int i = gt; i < 2560 * 384; i += ngt) {
                const int n = i / 384, k = i % 384; float v = 0.f;
                if (n < 1024) { const int d = n >> 9, c = n & 511; if (k >= d * 64 && k < d * 64 + 64) v = w2[(size_t)(d * 64 + (k - d * 64)) * 512 + c]; }
                else if (n < 2048) { const int d = (n - 1024) >> 9, c = n & 511; if (k >= 128 + d * 64 && k < 128 + d * 64 + 64) v = a2[(size_t)(d * 64 + (k - 128 - d * 64)) * 512 + c]; }
                else { const int c = n - 2048; if (k >= 256) v = g2[(size_t)(k - 256) * 512 + c]; }
                WL[i] = f2bf(v);
            }
        }
    }
}

template <bool ROUTER>
DI void ph_norm(const Ctx& C, const float* xlat, const float* xctx, const float* gain, const float* mod  , int shift_off, int scale_off, bf16* H,
                const float* router  , float* AFFT, float* AFFC, int* SLOT) {
    LAS float* RT = (LAS float*)C.lds;
    if (ROUTER) { for (int i = C.tid; i < 16384; i += 512) { const int c = i >> 4, e = i & 15; RT[e * 1024 + c] = router[i]; } __syncthreads(); }
    const int gw = C.bid * 8 + C.wave, ngw = C.nb * 8, lane = C.lane;
    for (int row = gw; row < MT; row += ngw) {
        const float* xr = row < NLAT ? xlat + (size_t)row * DM : xctx + (size_t)(row - NLAT) * DM;
        const int mi = row < NLAT ? (row >> 12) : 8;
        const float* mp = mod + mi * 6144;
        f32x4 v[4]; float ss = 0.f;
#pragma unroll
        for (int j = 0; j < 4; ++j) { v[j] = *(const f32x4*)(xr + 256 * j + 4 * lane); ss += v[j].x * v[j].x + v[j].y * v[j].y + v[j].z * v[j].z + v[j].w * v[j].w; }
        ss = wave_sum(ss);
        const float rs = 1.0f / sqrtf(ss * (1.f / 1024.f) + EPS);
#pragma unroll
        for (int j = 0; j < 4; ++j) {
            const int c = 256 * j + 4 * lane;
            const f32x4 g = *(const f32x4*)(gain + c), sc = *(const f32x4*)(mp + scale_off + c), sh = *(const f32x4*)(mp + shift_off + c);
            v[j] = (v[j] * rs) * g * (sc + 1.0f) + sh;
            *(u32x2*)(H + (size_t)row * DM + c) = (u32x2){pk2(v[j].x, v[j].y), pk2(v[j].z, v[j].w)};
        }
        if (ROUTER) {
            float mylg = 0.f;
#pragma unroll 1
            for (int e = 0; e < 16; ++e) { float p = 0.f;
#pragma unroll
                for (int j = 0; j < 4; ++j) { const f32x4 w = *(const LAS f32x4*)(RT + e * 1024 + 256 * j + 4 * lane); p += v[j].x * w.x + v[j].y * w.y + v[j].z * w.z + v[j].w * w.w; }
                p = wave_sum(p); mylg = (lane == e) ? p : mylg; }
            float mx = mylg;
#pragma unroll
            for (int o = 1; o < 16; o <<= 1) mx = fmaxf(mx, __shfl_xor(mx, o));
            const float ex = expf(mylg - mx); float sum = ex;
#pragma unroll
            for (int o = 1; o < 16; o <<= 1) sum += __shfl_xor(sum, o);
            const float mine = ex / sum;
            if (lane < 16) {
                if (row < NLAT) AFFT[(size_t)((row >> 12) * 16 + lane) * TL + (row & 4095)] = mine;
                else { const int rc = row - NLAT; AFFC[(size_t)((rc >> 8) * 16 + lane) * LCX + (rc & 255)] = mine; }
                SLOT[(size_t)row * 16 + lane] = -1;
            }
        }
    }
}

template <class Epi>
DI void gemm_unit(const bf16* __restrict__ A, int lda, const int* __restrict__ rows, const bf16* __restrict__ Bt, int K, int pm, int pn, const Epi& E, int wave, int lane) {
    const int wr = wave >> 2, wc = wave & 3, r = lane & 31, h = lane >> 5;
    const bf16* ap[2][2]; const bf16* bp[2];
#pragma unroll
    for (int ai = 0; ai < 2; ++ai)
#pragma unroll
        for (int mm = 0; mm < 2; ++mm) { const int lr = 256 * pm + 128 * ai + 64 * wr + 32 * mm + r; const int gr = rows ? rows[lr] : lr; ap[ai][mm] = A + (size_t)gr * lda + 8 * h; }
#pragma unroll
    for (int bj = 0; bj < 2; ++bj) bp[bj] = Bt + (size_t)(256 * pn + 128 * bj + 32 * wc + r) * K + 8 * h;
    f32x16 acc[2][2][2];
#pragma unroll
    for (int ai = 0; ai < 2; ++ai)
#pragma unroll
        for (int mm = 0; mm < 2; ++mm)
#pragma unroll
            for (int bj = 0; bj < 2; ++bj)
#pragma unroll
                for (int i = 0; i < 16; ++i) acc[ai][mm][bj][i] = 0.f;
#pragma unroll 2
    for (int k0 = 0; k0 < K; k0 += 16) {
        bf16x8 af[2][2], bfr[2];
#pragma unroll
        for (int ai = 0; ai < 2; ++ai)
#pragma unroll
            for (int mm = 0; mm < 2; ++mm) af[ai][mm] = *(const bf16x8*)(ap[ai][mm] + k0);
#pragma unroll
        for (int bj = 0; bj < 2; ++bj) bfr[bj] = *(const bf16x8*)(bp[bj] + k0);
#pragma unroll
        for (int ai = 0; ai < 2; ++ai)
#pragma unroll
            for (int mm = 0; mm < 2; ++mm)
#pragma unroll
                for (int bj = 0; bj < 2; ++bj) acc[ai][mm][bj] = MFMA32(bfr[bj], af[ai][mm], acc[ai][mm][bj]);
    }
#pragma unroll
    for (int ai = 0; ai < 2; ++ai)
#pragma unroll
        for (int mm = 0; mm < 2; ++mm) {
            const int row = 256 * pm + 128 * ai + 64 * wr + 32 * mm + r;
#pragma unroll
            for (int g = 0; g < 4; ++g) {
                const int col = 256 * pn + 32 * wc + 8 * g + 4 * h;
                const f32x4 v0 = {acc[ai][mm][0][4 * g], acc[ai][mm][0][4 * g + 1], acc[ai][mm][0][4 * g + 2], acc[ai][mm][0][4 * g + 3]};
                const f32x4 v1 = {acc[ai][mm][1][4 * g], acc[ai][mm][1][4 * g + 1], acc[ai][mm][1][4 * g + 2], acc[ai][mm][1][4 * g + 3]};
                E(row, col, v0, v1);
            }
        }
}
template <class Epi>
DI void gemm_phase(const Ctx& C, const bf16* A, int lda, const bf16* Bt, int K, int nM, int nN, const Epi& E) {
    for (int u = C.vcu; u < nM * nN; u += C.nb) gemm_unit(A, lda, nullptr, Bt, K, u / nN, u % nN, E, C.wave, C.lane);
}

struct EpiBf16 { bf16* O; int ldo;
    DI void operator()(int row, int col, f32x4 v0, f32x4 v1) const { bf16* p = O + (size_t)row * ldo + col;
        *(u32x2*)p = (u32x2){pk2(v0[0], v0[1]), pk2(v0[2], v0[3])}; *(u32x2*)(p + 128) = (u32x2){pk2(v1[0], v1[1]), pk2(v1[2], v1[3])}; } };
struct EpiF32 { float* O; int ldo;
    DI void operator()(int row, int col, f32x4 v0, f32x4 v1) const { float* p = O + (size_t)row * ldo + col; *(f32x4*)p = v0; *(f32x4*)(p + 128) = v1; } };
struct EpiResid { const float* xin_lat; const float* xin_ctx; float* xout_lat; float* xout_ctx; const float* modg;
    DI void operator()(int row, int col, f32x4 v0, f32x4 v1) const {
        const float* xi; float* xo; int mi;
        if (row < NLAT) { xi = xin_lat + (size_t)row * DM; xo = xout_lat + (size_t)row * DM; mi = row >> 12; }
        else { xi = xin_ctx + (size_t)(row - NLAT) * DM; xo = xout_ctx + (size_t)(row - NLAT) * DM; mi = 8; }
        const float* g = modg + mi * 6144 + col;
        const f32x4 g0 = *(const f32x4*)g, g1 = *(const f32x4*)(g + 128), x0 = *(const f32x4*)(xi + col), x1 = *(const f32x4*)(xi + col + 128);
        *(f32x4*)(xo + col) = x0 + g0 * v0; *(f32x4*)(xo + col + 128) = x1 + g1 * v1; } };
struct EpiGlu { bf16* O;
    DI void operator()(int row, int col, f32x4 v0, f32x4 v1) const { const int f = (col >> 8) * 128 + (col & 255);
        *(u32x2*)(O + (size_t)row * DM + f) = (u32x2){pk2(siluf_(v0[0]) * v1[0], siluf_(v0[1]) * v1[1]), pk2(siluf_(v0[2]) * v1[2], siluf_(v0[3]) * v1[3])}; } };
struct EpiGate { bf16* O; const float* gate;
    DI void operator()(int row, int col, f32x4 v0, f32x4 v1) const { const float g = gate[row]; bf16* p = O + (size_t)row * DM + col;
        *(u32x2*)p = (u32x2){pk2(v0[0] * g, v0[1] * g), pk2(v0[2] * g, v0[3] * g)}; *(u32x2*)(p + 128) = (u32x2){pk2(v1[0] * g, v1[1] * g), pk2(v1[2] * g, v1[3] * g)}; } };
struct EpiLora { float* W; bf16* KEFF; bf16* BSC; bf16* G; const bf16* Kin; const bf16* KKin; const float* w0; const float* a0; const float* ka;
    DI void one(int row, int col, f32x4 v) const {
        if (col < 1024) { const int d = col >> 9, c = col & 511; f32x4 o;
#pragma unroll
            for (int e = 0; e < 4; ++e) { const float lw = w0[d * 512 + c + e] + v[e]; const float z = -lw; const float sp = fmaxf(z, 0.f) + __logf(1.f + __expf(-fabsf(z))); o[e] = expf(-expf(-sp - 0.5f)); }
            *(f32x4*)(W + ((size_t)d * MT + row) * 512 + c) = o; }
        else if (col < 2048) { const int d = (col - 1024) >> 9, c = col & 511;
            const u32x2 kr = *(const u32x2*)(Kin + (size_t)row * 512 + c), kkr = *(const u32x2*)(KKin + (size_t)row * 512 + c);
            const float kf[4] = {bflo(kr.x), bfhi(kr.x), bflo(kr.y), bfhi(kr.y)}, kkf[4] = {bflo(kkr.x), bfhi(kkr.x), bflo(kkr.y), bfhi(kkr.y)};
            float ke[4], bs[4];
#pragma unroll
            for (int e = 0; e < 4; ++e) { const float av = sigmoidf_(a0[d * 512 + c + e] + v[e]); ke[e] = kf[e] * (1.f + (av - 1.f) * ka[c + e]); bs[e] = kkf[e] * av; }
            *(u32x2*)(KEFF + ((size_t)d * MT + row) * 512 + c) = (u32x2){pk2(ke[0], ke[1]), pk2(ke[2], ke[3])};
            *(u32x2*)(BSC + ((size_t)d * MT + row) * 512 + c) = (u32x2){pk2(bs[0], bs[1]), pk2(bs[2], bs[3])}; }
        else { *(u32x2*)(G + (size_t)row * 512 + (col - 2048)) = (u32x2){pk2(v[0], v[1]), pk2(v[2], v[3])}; }
    }
    DI void operator()(int row, int col, f32x4 v0, f32x4 v1) const { one(row, col, v0); one(row, col + 128, v1); } };

DI int swap23(int x) { return (x & ~12) | ((x & 4) << 1) | ((x & 8) >> 1); }
template <int DQK, bool NAT>
DI void flash_range(f32x16 (&o)[2], float& m, float& l, const bf16x8 (&qf)[DQK / 16], const bf16* __restrict__ Kb, const bf16* __restrict__ Vt, int pos0, int nblk, int r, int h,
                    const LAS float* tab, int qc, int cs, int drow0) {
    const int kr = swap23(r);
    for (int blk = 0; blk < nblk; ++blk) {
        const int pos = pos0 + 32 * blk;
        f32x16 s;
#pragma unroll
        for (int i = 0; i < 16; ++i) s[i] = 0.f;
        const bf16* kp = Kb + (size_t)(pos + kr) * DQK + 8 * h;
#pragma unroll
        for (int kk = 0; kk < DQK / 16; ++kk) s = MFMA32(*(const bf16x8*)(kp + 16 * kk), qf[kk], s);
        if (NAT) {
            const int irow = blk >> 1, cc0 = (blk & 1) * 32;
            const LAS float* trow = tab + (drow0 + irow) * 31;
#pragma unroll
            for (int i = 0; i < 16; ++i) {
                const int kib = (i & 3) | (((i >> 2) & 1) << 2) | (h << 3) | ((i >> 3) << 4);
                const int cc = cc0 + kib; const bool ok = (cc >= cs) && (cc < cs + 16);
                int dc = cc - qc + 15; dc = dc < 0 ? 0 : (dc > 30 ? 30 : dc);
                s[i] = ok ? s[i] + trow[dc] : -1e30f;
            }
        }
        float mx = s[0];
#pragma unroll
        for (int i = 1; i < 16; ++i) mx = fmaxf(mx, s[i]);
        mx = fmaxf(mx, __shfl_xor(mx, 32));
        const float mn = fmaxf(m, mx), alpha = __builtin_amdgcn_exp2f(m - mn);
        float rs = 0.f; f32x16 p;
#pragma unroll
        for (int i = 0; i < 16; ++i) { float e = __builtin_amdgcn_exp2f(s[i] - mn); if (NAT) e = (s[i] > -1e29f) ? e : 0.f; p[i] = e; rs += e; }
        rs += __shfl_xor(rs, 32);
        l = l * alpha + rs; m = mn;
#pragma unroll
        for (int i = 0; i < 16; ++i) { o[0][i] *= alpha; o[1][i] *= alpha; }
#pragma unroll
        for (int s2 = 0; s2 < 2; ++s2) {
            u32x4 pw; pw.x = pk2(p[8 * s2], p[8 * s2 + 1]); pw.y = pk2(p[8 * s2 + 2], p[8 * s2 + 3]); pw.z = pk2(p[8 * s2 + 4], p[8 * s2 + 5]); pw.w = pk2(p[8 * s2 + 6], p[8 * s2 + 7]);
            const bf16x8 pb = __builtin_bit_cast(bf16x8, pw);
#pragma unroll
            for (int dt = 0; dt < 2; ++dt) { const bf16x8 va = *(const bf16x8*)(Vt + (size_t)(32 * dt + r) * KPOS + pos + 16 * s2 + 8 * h); o[dt] = MFMA32(va, pb, o[dt]); }
        }
    }
}
DI void flash_store(const f32x16 (&o)[2], float l, bf16* orow  , int h) {
    const float inv = 1.f / l;
#pragma unroll
    for (int dt = 0; dt < 2; ++dt)
#pragma unroll
        for (int g = 0; g < 4; ++g)
            *(u32x2*)(orow + 32 * dt + 8 * g + 4 * h) = (u32x2){pk2(o[dt][4 * g] * inv, o[dt][4 * g + 1] * inv), pk2(o[dt][4 * g + 2] * inv, o[dt][4 * g + 3] * inv)};
}

DI void ph_attn_mla(const Ctx& C, const bf16* QB, const bf16* KB, const bf16* VT, bf16* OCAT, bool last) {
    const int r = C.lane & 31, h = C.lane >> 5;
    for (int u = C.vcu; u < 64 * 17; u += C.nb) {
        const int bh = u / 17, qblk = u % 17, b = bh >> 3, hh = bh & 7;
        if (last && qblk == 16) continue;
        const int qpos = qblk * 256 + 32 * C.wave + r;
        const bf16* qp = QB + ((size_t)bh * KPOS + qpos) * 96 + 8 * h;
        bf16x8 qf[6];
#pragma unroll
        for (int kk = 0; kk < 6; ++kk) qf[kk] = *(const bf16x8*)(qp + 16 * kk);
        f32x16 o[2];
#pragma unroll
        for (int i = 0; i < 16; ++i) { o[0][i] = 0.f; o[1][i] = 0.f; }
        float m = -1e30f, l = 0.f;
        flash_range<96, false>(o, m, l, qf, KB + (size_t)bh * KPOS * 96, VT + (size_t)bh * 64 * KPOS, qblk < 16 ? 0 : TL, qblk < 16 ? KPOS / 32 : LCX / 32, r, h, nullptr, 0, 0, 0);
        const int row = qblk < 16 ? b * TL + qpos : NLAT + b * LCX + (qpos - TL);
        flash_store(o, l, OCAT + (size_t)row * DM + hh * 64, h);
    }
}
DI void ph_natten(const Ctx& C, const bf16* QN, const bf16* KN, const bf16* VTN, bf16* OCAT, const float* rpb  , bool last) {
    const int r = C.lane & 31, h = C.lane >> 5;
    LAS float* tab = (LAS float*)C.lds;
    const int nunits = 1024 + (last ? 0 : 64);
    for (int u = C.vcu; u < nunits; u += C.nb) {
        const bool isctx = u >= 1024;
        const int bh = isctx ? u - 1024 : (u >> 4), b = bh >> 3, hh = bh & 7;
        __syncthreads();
        for (int i = C.tid; i < 465; i += 512) tab[i] = rpb[hh * 465 + i] * LOG2E;
        __syncthreads();
        int qpos, row, grow = 0, qc = 0, rs = 0, cs = 0;
        if (!isctx) { const int rg = u & 15; grow = 4 * rg + (C.wave >> 1); qc = 32 * (C.wave & 1) + r; qpos = grow * 64 + qc; row = b * TL + qpos;
            rs = grow - 4; rs = rs < 0 ? 0 : (rs > 56 ? 56 : rs); cs = qc - 8; cs = cs < 0 ? 0 : (cs > 48 ? 48 : cs); }
        else { qpos = TL + 32 * C.wave + r; row = NLAT + b * LCX + 32 * C.wave + r; }
        const bf16* qp = QN + ((size_t)bh * KPOS + qpos) * 64 + 8 * h;
        bf16x8 qf[4];
#pragma unroll
        for (int kk = 0; kk < 4; ++kk) qf[kk] = *(const bf16x8*)(qp + 16 * kk);
        f32x16 o[2];
#pragma unroll
        for (int i = 0; i < 16; ++i) { o[0][i] = 0.f; o[1][i] = 0.f; }
        float m = -1e30f, l = 0.f;
        const bf16* Kb = KN + (size_t)bh * KPOS * 64; const bf16* Vt = VTN + (size_t)bh * 64 * KPOS;
        if (!isctx) flash_range<64, true>(o, m, l, qf, Kb, Vt, rs * 64, 16, r, h, tab, qc, cs, rs - grow + 7);
        flash_range<64, false>(o, m, l, qf, Kb, Vt, TL, LCX / 32, r, h, nullptr, 0, 0, 0);
        flash_store(o, l, OCAT + (size_t)row * DM + 512 + hh * 64, h);
    }
}

DI void ph_mla_fin(const Ctx& C, const bf16* U, const float* QPRE, const float* KVPRE, const float* qg, const float* kg, const f32x2* CS, bf16* QB, bf16* KB, bf16* VT) {
    LAS bf16* VL = (LAS bf16*)C.lds;
    const int lane = C.lane, hh = lane >> 3, sub = lane & 7;
    const float C2 = 0.10206207261596575f * LOG2E;
    for (int u = C.vcu; u < MT / 64; u += C.nb) {
        const int row0 = 64 * u, b = row0 < NLAT ? (row0 >> 12) : ((row0 - NLAT) >> 8), pos0 = row0 < NLAT ? (row0 & 4095) : TL + ((row0 - NLAT) & 255);
        const bool lat = row0 < NLAT;
        for (int i = 0; i < 8; ++i) {
            const int pl = 8 * C.wave + i, row = row0 + pl, pos = pos0 + pl;
            const bf16* ur = U + (size_t)row * EV_INP;
            float sq = 0.f, skv = 0.f;
#pragma unroll
            for (int mq = 0; mq < 6; ++mq) { const float x = bf2f(ur[lane + 64 * mq]); sq += x * x; }
#pragma unroll
            for (int mq = 0; mq < 4; ++mq) { const float x = bf2f(ur[384 + lane + 64 * mq]); skv += x * x; }
            sq = wave_sum(sq); skv = wave_sum(skv);
            const float rsq = 1.0f / sqrtf(sq * (1.f / 384.f) + EPS), rskv = 1.0f / sqrtf(skv * (1.f / 256.f) + EPS);
            float cr = 1.f, sr = 0.f, cc = 1.f, sc = 0.f;
            if (lat) { const f32x2 a0 = CS[pos * 16 + sub], a1 = CS[pos * 16 + 8 + sub]; cr = a0.x; sr = a0.y; cc = a1.x; sc = a1.y; }
            float qv[12]; float ss = 0.f;
#pragma unroll
            for (int mq = 0; mq < 12; ++mq) { qv[mq] = QPRE[(size_t)row * 768 + hh * 96 + sub + 8 * mq] * rsq; ss += qv[mq] * qv[mq]; }
            ss = sum8(ss);
            float rn = 1.0f / sqrtf(ss * (1.f / 96.f) + EPS);
#pragma unroll
            for (int mq = 0; mq < 12; ++mq) qv[mq] = qv[mq] * rn * qg[sub + 8 * mq];
            { const float x0 = qv[8], x1 = qv[9], y0 = qv[10], y1 = qv[11]; qv[8] = x0 * cr - x1 * sr; qv[9] = x1 * cr + x0 * sr; qv[10] = y0 * cc - y1 * sc; qv[11] = y1 * cc + y0 * sc; }
            bf16* qo = QB + ((size_t)(b * 8 + hh) * KPOS + pos) * 96 + sub;
#pragma unroll
            for (int mq = 0; mq < 12; ++mq) qo[8 * mq] = f2bf(qv[mq] * C2);
            float kv[12]; ss = 0.f;
#pragma unroll
            for (int mq = 0; mq < 8; ++mq) kv[mq] = KVPRE[(size_t)row * 1024 + hh * 128 + sub + 8 * mq] * rskv;
#pragma unroll
            for (int mq = 8; mq < 12; ++mq) kv[mq] = bf2f(ur[640 + sub + 8 * (mq - 8)]);
#pragma unroll
            for (int mq = 0; mq < 12; ++mq) ss += kv[mq] * kv[mq];
            ss = sum8(ss);
            rn = 1.0f / sqrtf(ss * (1.f / 96.f) + EPS);
#pragma unroll
            for (int mq = 0; mq < 12; ++mq) kv[mq] = kv[mq] * rn * kg[sub + 8 * mq];
            { const float x0 = kv[8], x1 = kv[9], y0 = kv[10], y1 = kv[11]; kv[8] = x0 * cr - x1 * sr; kv[9] = x1 * cr + x0 * sr; kv[10] = y0 * cc - y1 * sc; kv[11] = y1 * cc + y0 * sc; }
            bf16* ko = KB + ((size_t)(b * 8 + hh) * KPOS + pos) * 96 + sub;
#pragma unroll
            for (int mq = 0; mq < 12; ++mq) ko[8 * mq] = f2bf(kv[mq]);
#pragma unroll
            for (int mq = 0; mq < 8; ++mq) { const int dv = sub + 8 * mq; VL[(hh * 64 + dv) * 64 + pl] = f2bf(KVPRE[(size_t)row * 1024 + hh * 128 + 64 + dv] * rskv); }
        }
        __syncthreads();
        { const int hd = C.tid;
            bf16* dst = VT + ((size_t)(b * 8 + (hd >> 6)) * 64 + (hd & 63)) * KPOS + pos0;
#pragma unroll
            for (int q = 0; q < 8; ++q) *(u32x4*)(dst + 8 * q) = *(const LAS u32x4*)(VL + hd * 64 + 8 * q); }
        __syncthreads();
    }
}

DI void ph_conv(const Ctx& C, const bf16* U, const float* dww  , const float* dwb, const float* lng, const float* lnb, bf16* OCAT) {
    LAS float* G = (LAS float*)C.lds;
    const int c = C.tid;
    float wk[31];
#pragma unroll
    for (int k = 0; k < 31; ++k) wk[k] = dww[k * 512 + c];
    const float bias = dwb[c];
    for (int u = C.vcu; u < MT / 32; u += C.nb) {
        const int row0 = 32 * u; int base, t0, tseq;
        if (row0 < NLAT) { base = row0 & ~4095; t0 = row0 & 4095; tseq = TL; } else { const int rc = row0 - NLAT; base = NLAT + (rc & ~255); t0 = rc & 255; tseq = LCX; }
        __syncthreads();
        for (int rr = 0; rr < 62; ++rr) { const int tt = t0 - 15 + rr; float g = 0.f;
            if (tt >= 0 && tt < tseq) { const bf16* ur = U + (size_t)(base + tt) * EV_INP; g = bf2f(ur[672 + c]) * sigmoidf_(bf2f(ur[1184 + c])); }
            G[rr * 512 + c] = g; }
        __syncthreads();
        float acc[32];
#pragma unroll
        for (int t = 0; t < 32; ++t) acc[t] = bias;
#pragma unroll
        for (int rr = 0; rr < 62; ++rr) { const float gv = G[rr * 512 + c];
#pragma unroll
            for (int t = 0; t < 32; ++t) { const int k = rr - t; if (k >= 0 && k < 31) acc[t] += gv * wk[k]; } }
        __syncthreads();
#pragma unroll
        for (int t = 0; t < 32; ++t) G[t * 512 + c] = acc[t];
        __syncthreads();
#pragma unroll
        for (int q = 0; q < 4; ++q) {
            const int t = 4 * C.wave + q, row = row0 + t;
            const f32x4 a0 = *(const LAS f32x4*)(G + t * 512 + 8 * C.lane), a1 = *(const LAS f32x4*)(G + t * 512 + 8 * C.lane + 4);
            float x[8] = {a0.x, a0.y, a0.z, a0.w, a1.x, a1.y, a1.z, a1.w}; float s = 0.f;
#pragma unroll
            for (int e = 0; e < 8; ++e) s += x[e];
            const float mu = wave_sum(s) * (1.f / 512.f); float s2 = 0.f;
#pragma unroll
            for (int e = 0; e < 8; ++e) { x[e] -= mu; s2 += x[e] * x[e]; }
            const float rstd = 1.0f / sqrtf(wave_sum(s2) * (1.f / 512.f) + EPS);
            float y[8];
#pragma unroll
            for (int e = 0; e < 8; ++e) { const float z = x[e] * rstd * lng[8 * C.lane + e] + lnb[8 * C.lane + e]; y[e] = siluf_(z); }
            *(u32x4*)(OCAT + (size_t)row * DM + 512 + 8 * C.lane) = pack8(y);
        }
    }
}

DI void shifted8(const bf16* up, const bf16* uc, const bf16* un, bool hp, bool hn, const float* sw, int c0, float (&o)[8]) {
    const u32x4 z = {0u, 0u, 0u, 0u};
    const u32x4 vp = hp ? *(const u32x4*)(up + c0) : z, vc = *(const u32x4*)(uc + c0), vn = hn ? *(const u32x4*)(un + c0) : z;
    float p[8], c[8], n[8]; unpack8(vp, p); unpack8(vc, c); unpack8(vn, n);
#pragma unroll
    for (int e = 0; e < 8; ++e) o[e] = p[e] * sw[c0 + e] + c[e] * sw[RW_IN + c0 + e] + n[e] * sw[2 * RW_IN + c0 + e];
}
DI void ph_prep(const Ctx& C, const bf16* U, const float* sw  , const float* kkw  , const float* naqg, const float* nakg,
                bf16* R, bf16* V, bf16* K, bf16* KK, bf16* L, bf16* QN, bf16* KN, bf16* VTN) {
    LAS bf16* VL = (LAS bf16*)C.lds;
    const int lane = C.lane, hh = lane >> 3, sub = lane & 7;
    const float C2 = 0.125f * LOG2E;
    for (int u = C.vcu; u < MT / 64; u += C.nb) {
        const int row0 = 64 * u; const bool lat = row0 < NLAT;
        const int b = lat ? (row0 >> 12) : ((row0 - NLAT) >> 8), pos0 = lat ? (row0 & 4095) : TL + ((row0 - NLAT) & 255), tseq = lat ? TL : LCX, tb = lat ? (row0 & 4095) : ((row0 - NLAT) & 255);
        for (int i = 0; i < 8; ++i) {
            const int pl = 8 * C.wave + i, row = row0 + pl, pos = pos0 + pl, t = tb + pl;
            const bool hp = t > 0, hn = t < tseq - 1;
            const bf16* uc = U + (size_t)row * OD_INP; const bf16* up = uc - OD_INP; const bf16* un = uc + OD_INP;
            float o[8];
            shifted8(up, uc, un, hp, hn, sw, 8 * lane, o);          *(u32x4*)(R + (size_t)row * 512 + 8 * lane) = pack8(o);
            shifted8(up, uc, un, hp, hn, sw, 1024 + 8 * lane, o);   *(u32x4*)(V + (size_t)row * 512 + 8 * lane) = pack8(o);
            shifted8(up, uc, un, hp, hn, sw, 512 + 8 * lane, o);    *(u32x4*)(K + (size_t)row * 512 + 8 * lane) = pack8(o);
            { float kk[8]; float ss = 0.f;
#pragma unroll
                for (int e = 0; e < 8; ++e) { kk[e] = o[e] * kkw[8 * lane + e]; ss += kk[e] * kk[e]; }
                ss = sum8(ss); const float rn = 1.0f / sqrtf(ss + 1e-12f);
#pragma unroll
                for (int e = 0; e < 8; ++e) kk[e] *= rn;
                *(u32x4*)(KK + (size_t)row * 512 + 8 * lane) = pack8(kk); }
            if (lane < 48) {
                shifted8(up, uc, un, hp, hn, sw, 1536 + 8 * lane, o);
                if (lane < 16) {
#pragma unroll
                    for (int e = 0; e < 8; ++e) { const float ex = __expf(2.f * o[e]); o[e] = 1.f - 2.f / (ex + 1.f); }
                } else if (lane >= 32) {
#pragma unroll
                    for (int e = 0; e < 8; ++e) o[e] = sigmoidf_(o[e]);
                }
                *(u32x4*)(L + (size_t)row * 384 + 8 * lane) = pack8(o);
            }
            { float x[8]; unpack8(*(const u32x4*)(uc + RW_IN + 8 * lane), x); float ss = 0.f;
#pragma unroll
                for (int e = 0; e < 8; ++e) ss += x[e] * x[e];
                ss = sum8(ss); const float rn = 1.0f / sqrtf(ss * (1.f / 64.f) + EPS);
#pragma unroll
                for (int e = 0; e < 8; ++e) x[e] = x[e] * rn * naqg[8 * sub + e] * C2;
                *(u32x4*)(QN + ((size_t)(b * 8 + hh) * KPOS + pos) * 64 + 8 * sub) = pack8(x); }
            { float x[8]; unpack8(*(const u32x4*)(uc + RW_IN + 512 + 8 * lane), x); float ss = 0.f;
#pragma unroll
                for (int e = 0; e < 8; ++e) ss += x[e] * x[e];
                ss = sum8(ss); const float rn = 1.0f / sqrtf(ss * (1.f / 64.f) + EPS);
#pragma unroll
                for (int e = 0; e < 8; ++e) x[e] = x[e] * rn * nakg[8 * sub + e];
                *(u32x4*)(KN + ((size_t)(b * 8 + hh) * KPOS + pos) * 64 + 8 * sub) = pack8(x); }
            { const u32x4 vv = *(const u32x4*)(uc + RW_IN + 1024 + 8 * lane); const unsigned w4[4] = {vv.x, vv.y, vv.z, vv.w};
#pragma unroll
                for (int e = 0; e < 8; ++e) { const int dv = 8 * sub + e; VL[(hh * 64 + dv) * 64 + pl] = (bf16)((e & 1) ? (w4[e >> 1] >> 16) : (w4[e >> 1] & 0xffffu)); } }
        }
        __syncthreads();
        { const int hd = C.tid; bf16* dst = VTN + ((size_t)(b * 8 + (hd >> 6)) * 64 + (hd & 63)) * KPOS + pos0;
#pragma unroll
            for (int q = 0; q < 8; ++q) *(u32x4*)(dst + 8 * q) = *(const LAS u32x4*)(VL + hd * 64 + 8 * q); }
        __syncthreads();
    }
}

#define DPP_ADD(x, ctrl) ((x) + __builtin_bit_cast(float, __builtin_amdgcn_update_dpp(0, __builtin_bit_cast(int, (x)), (ctrl), 0xf, 0xf, false)))
DI float sum16(float x) { x = DPP_ADD(x, 0xB1); x = DPP_ADD(x, 0x4E); x = DPP_ADD(x, 0x141); x = DPP_ADD(x, 0x140); return x; }
DI int scan_row(int s, int d, int b) { if (s < LCX) return NLAT + b * LCX + (d ? (LCX - 1 - s) : s); const int t = s - LCX; return b * TL + (d ? (TL - 1 - t) : t); }
DI void ph_scan(const Ctx& C, const bf16* R, const bf16* V, const bf16* KK, const float* W, const bf16* KEFF, const bf16* BSC, float* YS) {
    constexpr int CH = 32, BUF = 5 * CH * 64 + CH * 32;
    LAS float* lds = (LAS float*)C.lds;
    LAS float* ystage = lds + 2 * BUF;
    const int tid = C.tid, i = tid >> 4, kq = tid & 15;
    for (int cid = C.bid; cid < 256; cid += C.nb) {
        const int b = cid >> 5, hh = (cid >> 2) & 7, d = (cid >> 1) & 1, hf = cid & 1;
        const float* Wd = W + (size_t)d * MT * 512; const bf16* KEd = KEFF + (size_t)d * MT * 512; const bf16* BSd = BSC + (size_t)d * MT * 512; float* Yd = YS + (size_t)d * MT * 512;
        float S[4] = {0.f, 0.f, 0.f, 0.f};
        const int sl = tid >> 4, sub = tid & 15;
        f32x4 lw; u32x4 l1, l2, l3;
        auto issue = [&](int ck) {
            const int row = scan_row(ck * CH + sl, d, b);
            lw = *(const f32x4*)(Wd + (size_t)row * 512 + hh * 64 + 4 * sub);
            if (sub < 8) { l1 = *(const u32x4*)(R + (size_t)row * 512 + hh * 64 + 8 * sub); l2 = *(const u32x4*)(KEd + (size_t)row * 512 + hh * 64 + 8 * sub); }
            else { l1 = *(const u32x4*)(KK + (size_t)row * 512 + hh * 64 + 8 * (sub - 8)); l2 = *(const u32x4*)(BSd + (size_t)row * 512 + hh * 64 + 8 * (sub - 8)); }
            if (sub < 4) l3 = *(const u32x4*)(V + (size_t)row * 512 + hh * 64 + 32 * hf + 8 * sub);
        };
        auto commit = [&](int bufi) {
            LAS float* B = lds + bufi * BUF;
            *(LAS f32x4*)(B + (1 * CH + sl) * 64 + 4 * sub) = lw;
            float f1[8], f2[8]; unpack8(l1, f1); unpack8(l2, f2);
            const int a1 = sub < 8 ? 0 : 3, a2 = sub < 8 ? 2 : 4, off = 8 * (sub & 7);
            *(LAS f32x4*)(B + (a1 * CH + sl) * 64 + off) = (f32x4){f1[0], f1[1], f1[2], f1[3]}; *(LAS f32x4*)(B + (a1 * CH + sl) * 64 + off + 4) = (f32x4){f1[4], f1[5], f1[6], f1[7]};
            *(LAS f32x4*)(B + (a2 * CH + sl) * 64 + off) = (f32x4){f2[0], f2[1], f2[2], f2[3]}; *(LAS f32x4*)(B + (a2 * CH + sl) * 64 + off + 4) = (f32x4){f2[4], f2[5], f2[6], f2[7]};
            if (sub < 4) { float f3[8]; unpack8(l3, f3); LAS float* vp = B + 5 * CH * 64 + sl * 32 + 8 * sub;
                *(LAS f32x4*)vp = (f32x4){f3[0], f3[1], f3[2], f3[3]}; *(LAS f32x4*)(vp + 4) = (f32x4){f3[4], f3[5], f3[6], f3[7]}; }
        };
        __syncthreads();
        issue(0); commit(0);
        __syncthreads();
        constexpr int NCK = KPOS / CH;
        for (int ck = 0; ck < NCK; ++ck) {
            if (ck + 1 < NCK) issue(ck + 1);
            const LAS float* B = lds + (ck & 1) * BUF; LAS float* ys = ystage + (ck & 1) * CH * 32;
#pragma unroll 4
            for (int s = 0; s < CH; ++s) {
                const f32x4 rr = *(const LAS f32x4*)(B + (0 * CH + s) * 64 + 4 * kq), ww = *(const LAS f32x4*)(B + (1 * CH + s) * 64 + 4 * kq), ke = *(const LAS f32x4*)(B + (2 * CH + s) * 64 + 4 * kq),
                            kk = *(const LAS f32x4*)(B + (3 * CH + s) * 64 + 4 * kq), bs = *(const LAS f32x4*)(B + (4 * CH + s) * 64 + 4 * kq);
                const float v = B[5 * CH * 64 + s * 32 + i];
                float sa = -(S[0] * kk.x + S[1] * kk.y + S[2] * kk.z + S[3] * kk.w);
                sa = sum16(sa);
                S[0] = S[0] * ww.x + (sa * bs.x + v * ke.x); S[1] = S[1] * ww.y + (sa * bs.y + v * ke.y); S[2] = S[2] * ww.z + (sa * bs.z + v * ke.z); S[3] = S[3] * ww.w + (sa * bs.w + v * ke.w);
                float y = S[0] * rr.x + S[1] * rr.y + S[2] * rr.z + S[3] * rr.w;
                y = sum16(y);
                if (kq == 0) ys[s * 32 + i] = y;
            }
            if (ck + 1 < NCK) commit((ck + 1) & 1);
            __syncthreads();
            if (tid < 256) { const int s = tid >> 3, q = tid & 7; const int row = scan_row(ck * CH + s, d, b);
                *(f32x4*)(Yd + (size_t)row * 512 + hh * 64 + 32 * hf + 4 * q) = *(const LAS f32x4*)(ys + s * 32 + 4 * q); }
        }
    }
}

DI void ph_post(const Ctx& C, const float* YS, const bf16* R, const bf16* V, const bf16* KEFF, const bf16* G, const float* rk, const float* gng, const float* gnb, bf16* OCAT, bool last) {
    const int gw = C.bid * 8 + C.wave, ngw = C.nb * 8, lane = C.lane, nrows = last ? NLAT : MT;
    for (int row = gw; row < nrows; row += ngw) {
        const size_t o = (size_t)row * 512 + 8 * lane;
        const f32x4 y0a = *(const f32x4*)(YS + o), y0b = *(const f32x4*)(YS + o + 4), y1a = *(const f32x4*)(YS + (size_t)MT * 512 + o), y1b = *(const f32x4*)(YS + (size_t)MT * 512 + o + 4);
        float y[8] = {y0a.x + y1a.x, y0a.y + y1a.y, y0a.z + y1a.z, y0a.w + y1a.w, y0b.x + y1b.x, y0b.y + y1b.y, y0b.z + y1b.z, y0b.w + y1b.w};
        float r[8], v[8], k0[8], k1[8], g[8];
        unpack8(*(const u32x4*)(R + o), r); unpack8(*(const u32x4*)(V + o), v); unpack8(*(const u32x4*)(KEFF + o), k0); unpack8(*(const u32x4*)(KEFF + (size_t)MT * 512 + o), k1); unpack8(*(const u32x4*)(G + o), g);
        float bsum = 0.f;
#pragma unroll
        for (int e = 0; e < 8; ++e) bsum += r[e] * (k0[e] + k1[e]) * rk[8 * lane + e];
        bsum = sum8(bsum);
        float s = 0.f;
#pragma unroll
        for (int e = 0; e < 8; ++e) { y[e] += bsum * v[e]; s += y[e]; }
        const float mu = sum8(s) * (1.f / 64.f); float s2 = 0.f;
#pragma unroll
        for (int e = 0; e < 8; ++e) { y[e] -= mu; s2 += y[e] * y[e]; }
        const float rstd = 1.0f / sqrtf(sum8(s2) * (1.f / 64.f) + GN_EPS);
        float out[8];
#pragma unroll
        for (int e = 0; e < 8; ++e) out[e] = (y[e] * rstd * gng[8 * lane + e] + gnb[8 * lane + e]) * g[e];
        *(u32x4*)(OCAT + (size_t)row * DM + 8 * lane) = pack8(out);
    }
}

DI void ph_topk(const Ctx& C, const float* AFFT, const float* AFFC, int* ROWS, float* GATE, int* SLOT, bool last) {
    LAS unsigned long long* key = (LAS unsigned long long*)C.lds;
    const int nprob = last ? 128 : 256;
    for (int p = C.bid; p < nprob; p += C.nb) {
        const bool isctx = p >= 128; const int be = p & 127, b = be >> 4, e = be & 15;
        const int n = isctx ? LCX : TL, cap = isctx ? CAPC : CAPL;
        const float* src = isctx ? AFFC + (size_t)be * LCX : AFFT + (size_t)be * TL;
        __syncthreads();
        for (int t = C.tid; t < n; t += 512) key[t] = ((unsigned long long)__builtin_bit_cast(unsigned, src[t]) << 32) | (unsigned long long)(0xFFFFFFFFu - (unsigned)t);
        __syncthreads();
        for (int k = 2; k <= n; k <<= 1)
            for (int j = k >> 1; j > 0; j >>= 1) {
                for (int q = C.tid; q < n / 2; q += 512) {
                    const int i = ((q & ~(j - 1)) << 1) | (q & (j - 1)), ix = i | j;
                    const unsigned long long a = key[i], bb = key[ix];
                    const bool desc = ((i & k) == 0);
                    if (desc ? (a < bb) : (a > bb)) { key[i] = bb; key[ix] = a; }
                }
                __syncthreads();
            }
        for (int jx = C.tid; jx < cap; jx += 512) {
            const unsigned long long kv = key[jx]; const int t = (int)(0xFFFFFFFFu - (unsigned)(kv & 0xFFFFFFFFull)); const float g = __builtin_bit_cast(float, (unsigned)(kv >> 32));
            const int slot = isctx ? NB * CAPL + b * CAPC + jx : b * CAPL + jx, row = isctx ? NLAT + b * LCX + t : b * TL + t;
            ROWS[e * ESLOTS + slot] = row; GATE[e * ESLOTS + slot] = g; SLOT[(size_t)row * 16 + e] = slot;
        }
    }
}

DI void ph_combine(const Ctx& C, float* xlat, float* xctx, const float* modg2  , const int* SLOT, const bf16* Y2, bool last) {
    const int gw = C.bid * 8 + C.wave, ngw = C.nb * 8, lane = C.lane, nrows = last ? NLAT : MT;
    for (int row = gw; row < nrows; row += ngw) {
        float* xr = row < NLAT ? xlat + (size_t)row * DM : xctx + (size_t)(row - NLAT) * DM;
        const int mi = row < NLAT ? (row >> 12) : 8;
        const int sv = SLOT[(size_t)row * 16 + (lane & 15)];
        f32x4 acc[4];
#pragma unroll
        for (int j = 0; j < 4; ++j) acc[j] = (f32x4){0.f, 0.f, 0.f, 0.f};
        for (int e = 0; e < 16; ++e) {
            const int s = __shfl(sv, e);
            if (s >= 0) { const bf16* yp = Y2 + ((size_t)e * ESLOTS + s) * DM + 4 * lane;
#pragma unroll
                for (int j = 0; j < 4; ++j) { const u32x2 w = *(const u32x2*)(yp + 256 * j); acc[j] += (f32x4){bflo(w.x), bfhi(w.x), bflo(w.y), bfhi(w.y)}; } }
        }
#pragma unroll
        for (int j = 0; j < 4; ++j) { const int c = 256 * j + 4 * lane; const f32x4 g = *(const f32x4*)(modg2 + mi * 6144 + c); f32x4 x = *(const f32x4*)(xr + c); x += g * acc[j]; *(f32x4*)(xr + c) = x; }
    }
}

constexpr int PH_PER_PAIR = 24, N_PHASES = 1 + 2 * PH_PER_PAIR;
__global__ void __launch_bounds__(512, 2) fwd_kernel(Args a) {
    extern __shared__ __attribute__((aligned(16))) unsigned char smem[];
    Ctx C0; C0.lds = (LAS unsigned char*)smem; C0.tid = threadIdx.x; C0.lane = C0.tid & 63; C0.wave = __builtin_amdgcn_readfirstlane(C0.tid >> 6); C0.bid = blockIdx.x; C0.nb = gridDim.x;
    C0.vcu = (C0.nb % 8 == 0) ? (C0.bid % 8) * (C0.nb / 8) + C0.bid / 8 : C0.bid;
    unsigned char* ws = a.ws;
    volatile LAS unsigned* bst = (volatile LAS unsigned*)(C0.lds + LDS_BYTES - 16);
#if MEGA
    if (C0.tid == 0) { bst[0] = 0u; bst[1] = 0u; }
    __syncthreads();
    XcdBarrier bar = xcd_barrier_post((unsigned*)(ws + WS_CTL) + 4096, bst);
#define SEAM() do { if (ph < hi) xcd_barrier(bar); } while (0)
#else
#define SEAM() do { } while (0)
#endif
    const int lo = a.ph_lo, hi = a.ph_hi;
    int ph = 0;
#ifndef ONLY
#define ONLY -1
#endif
#ifndef SITE_LO
#define SITE_LO 0
#define SITE_HI 99
#endif
#define PHASE(SITE, ...) do { if ((ONLY < 0 || ONLY == (SITE)) && (SITE) >= SITE_LO && (SITE) <= SITE_HI && ph >= lo && ph < hi) { Ctx C; C.lds = C0.lds; { int t_ = threadIdx.x; asm volatile("" : "+v"(t_)); C.tid = t_; C.lane = t_ & 63; C.wave = __builtin_amdgcn_readfirstlane(t_ >> 6); } \
        { int b_ = C0.bid, n_ = C0.nb, v_ = C0.vcu; asm volatile("" : "+s"(b_), "+s"(n_), "+s"(v_)); C.bid = b_; C.nb = n_; C.vcu = v_; } __VA_ARGS__; ++ph; SEAM(); } else ++ph; } while (0)
    float* const XL = a.out; float* const XC = (float*)(ws + WS_XC);
    const float* MOD = (const float*)(ws + WS_MOD);
    bf16* const HB = (bf16*)(ws + WS_HB); bf16* const OCAT = (bf16*)(ws + WS_OCAT);
    unsigned char* const AR = ws + WS_ARENA;
    int* const ROWS = (int*)(ws + WS_ROWS); float* const GATE = (float*)(ws + WS_GATE); int* const SLOT = (int*)(ws + WS_SLOT);
    float* const AFFT = (float*)(ws + WS_AFFT); float* const AFFC = (float*)(ws + WS_AFFC);
    bf16* const W13 = (bf16*)(ws + WS_W13); bf16* const W2 = (bf16*)(ws + WS_W2);

    PHASE(0, ph_prologue(C, a));

    for (int lp = 0; lp < 2; ++lp) {
        {
            const int i = 2 * lp, j = lp; const bool last = false;
            const float* modl = MOD + (size_t)i * 9 * 6144;
            const float* xin_l = (i == 0) ? a.in[I_X] : XL; const float* xin_c = (i == 0) ? a.in[I_CTX] : XC;
            bf16* U = (bf16*)(AR + A_U); float* QPRE = (float*)(AR + A_QPRE); float* KVPRE = (float*)(AR + A_KVPRE);
            bf16* QB = (bf16*)(AR + A_QB); bf16* KB = (bf16*)(AR + A_KB); bf16* VT = (bf16*)(AR + A_VT);
            PHASE(1, { ph_norm<false>(C, xin_l, xin_c, a.in[I_N1G] + i * DM, modl, 0, 1024, HB, nullptr, nullptr, nullptr, nullptr);
                    moe_weight_prep(C, a.in[I_MW1] + (size_t)i * NEXP * DM * DM, a.in[I_MW3] + (size_t)i * NEXP * DM * DM, a.in[I_MW2] + (size_t)i * NEXP * DM * DM, W13, W2); });
            PHASE(2, { EpiBf16 E{U, EV_INP}; gemm_phase(C, HB, DM, (const bf16*)(ws + WS_WEVIN) + (size_t)j * EV_INP * DM, DM, MT / 256, EV_INP / 256, E); });
            PHASE(3, { EpiF32 Eq{QPRE, 768}; gemm_phase(C, U, EV_INP, (const bf16*)(ws + WS_WUQ) + (size_t)j * 768 * 384, 384, MT / 256, 3, Eq);
                    EpiF32 Ek{KVPRE, 1024}; gemm_phase(C, U + 384, EV_INP, (const bf16*)(ws + WS_WUKV) + (size_t)j * 1024 * 256, 256, MT / 256, 4, Ek); });
            PHASE(4, { ph_mla_fin(C, U, QPRE, KVPRE, a.in[I_QG] + j * 96, a.in[I_KG] + j * 96, (const f32x2*)(ws + WS_ROPE), QB, KB, VT);
                    ph_conv(C, U, a.in[I_DWW] + (size_t)j * 31 * 512, a.in[I_DWB] + j * 512, a.in[I_LNG] + j * 512, a.in[I_LNB] + j * 512, OCAT); });
            PHASE(5, ph_attn_mla(C, QB, KB, VT, OCAT, last));
            PHASE(6, { EpiResid E{xin_l, xin_c, XL, XC, modl + 2048}; gemm_phase(C, OCAT, DM, (const bf16*)(ws + WS_WEVOUT) + (size_t)j * DM * DM, DM, MT / 256, 4, E); });
            PHASE(7, ph_norm<true>(C, XL, XC, a.in[I_N2G] + i * DM, modl, 3072, 4096, HB, a.in[I_ROUTER] + (size_t)i * DM * 16, AFFT, AFFC, SLOT));
            PHASE(8, ph_topk(C, AFFT, AFFC, ROWS, GATE, SLOT, last));
            PHASE(9, { for (int u = C.vcu; u < NEXP * 17 * 8; u += C.nb) { const int e = u / 136, q = u % 136, pm = q >> 3, pn = q & 7;
                        EpiGlu E{(bf16*)(AR + A_HID) + (size_t)e * ESLOTS * DM}; gemm_unit(HB, DM, ROWS + e * ESLOTS, W13 + (size_t)e * 2048 * DM, DM, pm, pn, E, C.wave, C.lane); } });
            PHASE(10, { for (int u = C.vcu; u < NEXP * 17 * 4; u += C.nb) { const int e = u / 68, q = u % 68, pm = q >> 2, pn = q & 3;
                        EpiGate E{(bf16*)(AR + A_Y2) + (size_t)e * ESLOTS * DM, GATE + e * ESLOTS};
                        gemm_unit((const bf16*)(AR + A_HID) + (size_t)e * ESLOTS * DM, DM, nullptr, W2 + (size_t)e * DM * DM, DM, pm, pn, E, C.wave, C.lane); } });
            PHASE(11, ph_combine(C, XL, XC, modl + 5120, SLOT, (const bf16*)(AR + A_Y2), last));
        }
        {
            const int i = 2 * lp + 1, j = lp; const bool last = (i == 3);
            const float* modl = MOD + (size_t)i * 9 * 6144;
            bf16* U = (bf16*)(AR + A_U); float* Wd = (float*)(AR + A_W); bf16* KEFF = (bf16*)(AR + A_KEFF); bf16* BSC = (bf16*)(AR + A_BSC);
            bf16* R = (bf16*)(AR + A_R); bf16* V = (bf16*)(AR + A_V); bf16* KK = (bf16*)(AR + A_KK); bf16* G = (bf16*)(AR + A_G); bf16* K = (bf16*)(AR + A_K); bf16* L = (bf16*)(AR + A_L);
            bf16* QN = (bf16*)(AR + A_QN); bf16* KN = (bf16*)(AR + A_KN); bf16* VTN = (bf16*)(AR + A_VTN); float* YS = (float*)(AR + A_YS);
            PHASE(12, { ph_norm<false>(C, XL, XC, a.in[I_N1G] + i * DM, modl, 0, 1024, HB, nullptr, nullptr, nullptr, nullptr);
                    moe_weight_prep(C, a.in[I_MW1] + (size_t)i * NEXP * DM * DM, a.in[I_MW3] + (size_t)i * NEXP * DM * DM, a.in[I_MW2] + (size_t)i * NEXP * DM * DM, W13, W2); });
            PHASE(13, { EpiBf16 E{U, OD_INP}; gemm_phase(C, HB, DM, (const bf16*)(ws + WS_WODIN) + (size_t)j * OD_INP * DM, DM, MT / 256, OD_INP / 256, E); });
            PHASE(14, ph_prep(C, U, a.in[I_SHIFTW] + (size_t)j * 3 * RW_IN, a.in[I_KKW] + j * 512, a.in[I_NAQG] + j * 64, a.in[I_NAKG] + j * 64, R, V, K, KK, L, QN, KN, VTN));
            PHASE(15, { EpiLora E{Wd, KEFF, BSC, G, K, KK, a.in[I_W0] + j * 1024, a.in[I_A0] + j * 1024, a.in[I_KA] + j * 512};
                    gemm_phase(C, L, 384, (const bf16*)(ws + WS_WLORA) + (size_t)j * 2560 * 384, 384, MT / 256, 10, E); });
            PHASE(16, ph_natten(C, QN, KN, VTN, OCAT, a.in[I_RPB] + (size_t)j * 8 * 465, last));
            PHASE(17, ph_scan(C, R, V, KK, Wd, KEFF, BSC, YS));
            PHASE(18, ph_post(C, YS, R, V, KEFF, G, a.in[I_RK] + j * 512, a.in[I_GNG] + j * 512, a.in[I_GNB] + j * 512, OCAT, last));
            PHASE(19, { EpiResid E{XL, XC, XL, XC, modl + 2048}; gemm_phase(C, OCAT, DM, (const bf16*)(ws + WS_WODOUT) + (size_t)j * DM * DM, DM, last ? NLAT / 256 : MT / 256, 4, E); });
            PHASE(20, ph_norm<true>(C, XL, XC, a.in[I_N2G] + i * DM, modl, 3072, 4096, HB, a.in[I_ROUTER] + (size_t)i * DM * 16, AFFT, AFFC, SLOT));
            PHASE(21, ph_topk(C, AFFT, AFFC, ROWS, GATE, SLOT, last));
            PHASE(22, { const int nmt = last ? 16 : 17; for (int u = C.vcu; u < NEXP * nmt * 8; u += C.nb) { const int e = u / (nmt * 8), q = u % (nmt * 8), pm = q >> 3, pn = q & 7;
                        EpiGlu E{(bf16*)(AR + A_HID) + (size_t)e * ESLOTS * DM}; gemm_unit(HB, DM, ROWS + e * ESLOTS, W13 + (size_t)e * 2048 * DM, DM, pm, pn, E, C.wave, C.lane); } });
            PHASE(23, { const int nmt = last ? 16 : 17; for (int u = C.vcu; u < NEXP * nmt * 4; u += C.nb) { const int e = u / (nmt * 4), q = u % (nmt * 4), pm = q >> 2, pn = q & 3;
                        EpiGate E{(bf16*)(AR + A_Y2) + (size_t)e * ESLOTS * DM, GATE + e * ESLOTS};
                        gemm_unit((const bf16*)(AR + A_HID) + (size_t)e * ESLOTS * DM, DM, nullptr, W2 + (size_t)e * DM * DM, DM, pm, pn, E, C.wave, C.lane); } });
            PHASE(24, ph_combine(C, XL, XC, modl + 5120, SLOT, (const bf16*)(AR + A_Y2), last));
        }
    }
}

extern "C" void kernel_launch(void* const* d_in, const int* in_sizes, int n_in, void* d_out, int out_size, void* d_ws, size_t ws_size, hipStream_t stream) {
    static int grid = 0;
    if (grid == 0) {
        if (n_in != 40 || out_size != NLAT * DM || ws_size < WS_END) { fprintf(stderr, "kernel_launch: unexpected shapes (n_in %d out %d ws %zu need %zu)\n", n_in, out_size, ws_size, (size_t)WS_END); grid = -1; return; }
        int dev = 0, cus = 0, per_cu = 0;
        if (hipGetDevice(&dev) != hipSuccess || hipDeviceGetAttribute(&cus, hipDeviceAttributeMultiprocessorCount, dev) != hipSuccess) { grid = -1; return; }
        if (hipFuncSetAttribute((const void*)fwd_kernel, hipFuncAttributeMaxDynamicSharedMemorySize, LDS_BYTES) != hipSuccess) { fprintf(stderr, "kernel_launch: hipFuncSetAttribute failed\n"); grid = -1; return; }
        if (hipOccupancyMaxActiveBlocksPerMultiprocessor(&per_cu, (const void*)fwd_kernel, 512, LDS_BYTES) != hipSuccess || per_cu < 1) { fprintf(stderr, "kernel_launch: occupancy query says %d\n", per_cu); per_cu = 1; }
        (void)hipGetLastError();
        grid = cus;
    }
    if (grid < 0) return;
    (void)hipMemsetAsync((char*)d_ws + WS_CTL, 0, CTL_BYTES, stream);
    Args a{};
    for (int i = 0; i < 40; ++i) a.in[i] = (const float*)d_in[i];
    a.out = (float*)d_out; a.ws = (unsigned char*)d_ws;
#if MEGA
    a.ph_lo = 0; a.ph_hi = N_PHASES;
    hipLaunchKernelGGL(fwd_kernel, dim3(grid), dim3(512), LDS_BYTES, stream, a);
#else
    for (int p = 0; p < N_PHASES; ++p) { a.ph_lo = p; a.ph_hi = p + 1; hipLaunchKernelGGL(fwd_kernel, dim3(grid), dim3(512), LDS_BYTES, stream, a); }
#endif
}
```

```cpp
#include <hip/hip_runtime.h>
#include <cstdio>
#include <cstdint>

#ifndef MEGA
#define MEGA 1
#endif

#define LAS __attribute__((address_space(3)))
#define DI __device__ __forceinline__

typedef unsigned short bf16;
typedef short bf16x8 __attribute__((ext_vector_type(8)));
typedef float f32x4 __attribute__((ext_vector_type(4)));
typedef float f32x2 __attribute__((ext_vector_type(2)));
typedef float f32x16 __attribute__((ext_vector_type(16)));
typedef unsigned u32x4 __attribute__((ext_vector_type(4)));
typedef unsigned u32x2 __attribute__((ext_vector_type(2)));
typedef __bf16 bf16x2_t __attribute__((ext_vector_type(2)));

constexpr int DM = 1024, NB = 8, TL = 4096, LCX = 256;
constexpr int NLAT = NB * TL, NCTX = NB * LCX, MT = NLAT + NCTX;
constexpr int KPOS = TL + LCX;
constexpr float EPS = 1e-6f, GN_EPS = 64e-5f;
constexpr int EV_IN = 1696, EV_INP = 1792, OD_IN = 3456, OD_INP = 3584, RW_IN = 1920;
constexpr int NEXP = 16, CAPL = 512, CAPC = 32, ESLOTS = NB * CAPL + NB * CAPC;
constexpr float LOG2E = 1.4426950408889634f;

constexpr size_t MiB = 1ull << 20;
constexpr size_t WS_CTL = 0, CTL_BYTES = 1 * MiB;
constexpr size_t WS_MOD = 1 * MiB, WS_ROPE = 2 * MiB, WS_XC = 4 * MiB;
constexpr size_t WS_ROWS = 12 * MiB, WS_GATE = 12 * MiB + 512 * 1024, WS_SLOT = 13 * MiB, WS_AFFT = 16 * MiB, WS_AFFC = 18 * MiB;
constexpr size_t WS_WEVIN = 20 * MiB, WS_WEVOUT = 27 * MiB, WS_WUQ = 31 * MiB, WS_WUKV = 33 * MiB, WS_WODIN = 34 * MiB, WS_WODOUT = 48 * MiB, WS_WLORA = 52 * MiB;
constexpr size_t WS_W13 = 56 * MiB, WS_W2 = 120 * MiB, WS_HB = 152 * MiB, WS_OCAT = 220 * MiB, WS_ARENA = 288 * MiB;
constexpr size_t A_U = 0, A_QPRE = 119 * MiB, A_KVPRE = 221 * MiB, A_QB = 357 * MiB, A_KB = 408 * MiB, A_VT = 459 * MiB;
constexpr size_t A_W = 0, A_KEFF = 136 * MiB, A_BSC = 204 * MiB, A_R = 272 * MiB, A_V = 306 * MiB, A_KK = 340 * MiB, A_G = 374 * MiB, A_K = 408 * MiB, A_L = 442 * MiB,
                 A_QN = 468 * MiB, A_KN = 502 * MiB, A_VTN = 536 * MiB, A_YS = 408 * MiB;
constexpr size_t A_HID = 0, A_Y2 = 136 * MiB;
constexpr size_t WS_END = WS_ARENA + 570 * MiB;
constexpr int LDS_BYTES = 147456;

DI unsigned pk2(float lo, float hi) { f32x2 v = {lo, hi}; bf16x2_t b = __builtin_convertvector(v, bf16x2_t); return __builtin_bit_cast(unsigned, b); }
DI float bflo(unsigned u) { return __builtin_bit_cast(float, u << 16); }
DI float bfhi(unsigned u) { return __builtin_bit_cast(float, u & 0xffff0000u); }
DI float bf2f(bf16 x) { return __builtin_bit_cast(float, ((unsigned)x) << 16); }
DI bf16 f2bf(float f) { return (bf16)(pk2(f, 0.f) & 0xffffu); }
DI void unpack8(u32x4 v, float (&f)[8]) { f[0] = bflo(v.x); f[1] = bfhi(v.x); f[2] = bflo(v.y); f[3] = bfhi(v.y); f[4] = bflo(v.z); f[5] = bfhi(v.z); f[6] = bflo(v.w); f[7] = bfhi(v.w); }
DI u32x4 pack8(const float (&f)[8]) { u32x4 r; r.x = pk2(f[0], f[1]); r.y = pk2(f[2], f[3]); r.z = pk2(f[4], f[5]); r.w = pk2(f[6], f[7]); return r; }
DI float wave_sum(float v) {
#pragma unroll
    for (int o = 1; o < 64; o <<= 1) v += __shfl_xor(v, o);
    return v;
}
DI float sum8(float v) { v += __shfl_xor(v, 1); v += __shfl_xor(v, 2); v += __shfl_xor(v, 4); return v; }
DI float sigmoidf_(float x) { return 1.f / (1.f + __expf(-x)); }
DI float siluf_(float x) { return x / (1.f + __expf(-x)); }
#define MFMA32(a, b, c) __builtin_amdgcn_mfma_f32_32x32x16_bf16((a), (b), (c), 0, 0, 0)

#define XB_TMO      128
#define XB_XCNT(j)  (256  + 64 * (j))
#define XB_XSUB(j)  (1280 + 64 * (j))
#define XB_XGEN(j)  (2304 + 64 * (j))
#define XB_TOP      3328
#define XB_TOPGEN   3392
#define XCD_BAR_WORDS 3456
#define XB_SPIN_CAP (1u << 22)
__device__ __forceinline__ unsigned xb_ld(unsigned* p)              { return __hip_atomic_load(p, __ATOMIC_RELAXED, __HIP_MEMORY_SCOPE_AGENT); }
__device__ __forceinline__ unsigned xb_add(unsigned* p, unsigned v) { return __hip_atomic_fetch_add(p, v, __ATOMIC_RELAXED, __HIP_MEMORY_SCOPE_AGENT); }
__device__ __forceinline__ unsigned xb_xcc_id() { return (unsigned)__builtin_amdgcn_s_getreg((3 << 11) | 20) & 0xFu; }
#define XB_SPIN(cond, bar) do { unsigned _sp = 0; while (cond) { __builtin_amdgcn_s_sleep(1); \
    if ((++_sp & 255u) == 0u) { if (xb_ld(&(bar)[XB_TMO])) break; if (_sp > XB_SPIN_CAP) { atomicAdd(&(bar)[XB_TMO], 1u); break; } } } } while (0)
struct XcdBarrier { unsigned* bar; unsigned x; volatile LAS unsigned* st; };
__device__ __forceinline__ XcdBarrier xcd_barrier_post(unsigned* bar, volatile LAS unsigned* st) {
    XcdBarrier b; b.bar = bar; b.x = xb_xcc_id(); b.st = st;
    if (threadIdx.x == 0) (void)xb_add(&bar[XB_XCNT(b.x)], 1u);
    return b;
}
__device__ __forceinline__ void xcd_barrier_complete(unsigned* bar, unsigned x, unsigned& nloc, unsigned& nx) {
    const unsigned G = gridDim.x * gridDim.y * gridDim.z;
    unsigned sum, cnt, mine, sp = 0u;
    for (;;) {
        sum = 0u; cnt = 0u; mine = 0u;
#pragma unroll
        for (unsigned j = 0; j < 16; ++j) { const unsigned c = xb_ld(&bar[XB_XCNT(j)]); sum += c; cnt += (c > 0u) ? 1u : 0u; mine = (j == x) ? c : mine; }
        if (sum == G) break;
        __builtin_amdgcn_s_sleep(1);
        if ((++sp & 255u) == 0u) { if (xb_ld(&bar[XB_TMO])) break; if (sp > XB_SPIN_CAP) { atomicAdd(&bar[XB_TMO], 1u); break; } }
    }
    nloc = mine > 0u ? mine : 1u; nx = cnt > 0u ? cnt : 1u;
}
__device__ __forceinline__ void xcd_barrier(const XcdBarrier& b) {
    asm volatile("s_waitcnt vmcnt(0)" ::: "memory");
    __syncthreads();
    if (threadIdx.x == 0) {
        unsigned* bar = b.bar;
        __builtin_amdgcn_s_waitcnt(0);
        unsigned nloc = b.st[0], nx = b.st[1];
        if (nloc == 0u) { xcd_barrier_complete(bar, b.x, nloc, nx); b.st[0] = nloc; b.st[1] = nx; }
        const unsigned old = xb_add(&bar[XB_XSUB(b.x)], 1u);
        const unsigned gen = old / nloc;
        if (old + 1u == (gen + 1u) * nloc) {
            __builtin_amdgcn_fence(__ATOMIC_RELEASE, "agent");
            asm volatile("s_waitcnt vmcnt(0)" ::: "memory");
            const unsigned og = xb_add(&bar[XB_TOP], 1u);
            const unsigned tg = og / nx;
            if (og + 1u == (tg + 1u) * nx) xb_add(&bar[XB_TOPGEN], 1u);
            else XB_SPIN(xb_ld(&bar[XB_TOPGEN]) == tg, bar);
            __builtin_amdgcn_fence(__ATOMIC_ACQUIRE, "agent");
            xb_add(&bar[XB_XGEN(b.x)], 1u);
            asm volatile("s_waitcnt vmcnt(0)" ::: "memory");
        } else {
            XB_SPIN(xb_ld(&bar[XB_XGEN(b.x)]) == gen, bar);
            __builtin_amdgcn_fence(__ATOMIC_ACQUIRE, "agent");
            asm volatile("s_waitcnt vmcnt(0)" ::: "memory");
        }
    }
    __syncthreads();
}

struct Ctx { LAS unsigned char* lds; int tid, lane, wave, bid, nb, vcu; };
struct Args { const float* in[40]; float* out; unsigned char* ws; int ph_lo, ph_hi; };
enum { I_X = 0, I_C, I_CTX, I_CCTX, I_ADAW, I_ADAB, I_N1G, I_N2G, I_EVWIN, I_EVWOUT, I_QNORM, I_WUQ, I_KVNORM, I_WUKV, I_QG, I_KG, I_DWW, I_DWB, I_LNG, I_LNB,
       I_ODWIN, I_ODWOUT, I_SHIFTW, I_W0, I_W2L, I_A0, I_A2, I_G2, I_KKW, I_KA, I_RK, I_GNG, I_GNB, I_NAQG, I_NAKG, I_RPB, I_ROUTER, I_MW1, I_MW3, I_MW2 };

DI void transpose_item(const float* __restrict__ W, int K, int N, bf16* __restrict__ WT, int dst_row0, const float* __restrict__ gain, LAS float* scr, int k0, int n0, int lane) {
#pragma unroll 8
    for (int i = 0; i < 32; ++i) { const int kk = 2 * i + (lane >> 5); float v = W[(size_t)(k0 + kk) * N + n0 + (lane & 31)]; if (gain) v *= gain[k0 + kk]; scr[kk * 33 + (lane & 31)] = v; }
    asm volatile("s_waitcnt lgkmcnt(0)" ::: "memory");
    const int c = lane & 7;
#pragma unroll
    for (int j = 0; j < 4; ++j) { const int n = (lane >> 3) + 8 * j; const LAS float* s = scr + (8 * c) * 33 + n;
        u32x4 o; o.x = pk2(s[0 * 33], s[1 * 33]); o.y = pk2(s[2 * 33], s[3 * 33]); o.z = pk2(s[4 * 33], s[5 * 33]); o.w = pk2(s[6 * 33], s[7 * 33]);
        *(u32x4*)(WT + (size_t)(dst_row0 + n) * K + k0 + 8 * c) = o; }
    asm volatile("s_waitcnt lgkmcnt(0)" ::: "memory");
}
DI void transpose_matrix(const Ctx& C, const float* W, int K, int N, bf16* WT, const float* gain, int mode  ) {
    LAS float* scr = (LAS float*)(C.lds + C.wave * 8704);
    const int nkb = K / 64, nnb = N / 32, nit = nkb * nnb, gw = C.vcu * 8 + C.wave, ngw = C.nb * 8;
    for (int it = gw; it < nit; it += ngw) {
        const int kb = it / nnb, nbk = it % nnb, n0 = nbk * 32;
        int d0 = n0; if (mode) d0 = (n0 >> 7) * 256 + (n0 & 127) + (mode == 2 ? 128 : 0);
        transpose_item(W, K, N, WT, d0, gain, scr, kb * 64, n0, C.lane);
    }
}
DI void moe_weight_prep(const Ctx& C, const float* w1, const float* w3, const float* w2, bf16* W13, bf16* W2) {
    LAS float* scr = (LAS float*)(C.lds + C.wave * 8704);
    const int gw = C.vcu * 8 + C.wave, ngw = C.nb * 8;
    constexpr int PER = 16 * 32;
    for (int it = gw; it < NEXP * 3 * PER; it += ngw) {
        const int e = it / (3 * PER), r = it % (3 * PER), which = r / PER, q = r % PER, kb = q / 32, n0 = (q % 32) * 32;
        if (which == 0)      transpose_item(w1 + (size_t)e * DM * DM, DM, DM, W13 + (size_t)e * 2048 * DM, (n0 >> 7) * 256 + (n0 & 127), nullptr, scr, kb * 64, n0, C.lane);
        else if (which == 1) transpose_item(w3 + (size_t)e * DM * DM, DM, DM, W13 + (size_t)e * 2048 * DM, (n0 >> 7) * 256 + (n0 & 127) + 128, nullptr, scr, kb * 64, n0, C.lane);
        else                 transpose_item(w2 + (size_t)e * DM * DM, DM, DM, W2 + (size_t)e * DM * DM, n0, nullptr, scr, kb * 64, n0, C.lane);
    }
}

DI void ph_prologue(const Ctx& C, const Args& a) {
    unsigned char* ws = a.ws;
    {
        LAS float* sv = (LAS float*)C.lds;
        LAS float* red = sv + 9 * 1024;
        for (int i = C.tid; i < 9 * 1024; i += 512) { const int m = i >> 10, k = i & 1023; const float c = (m < 8) ? a.in[I_C][m * 1024 + k] : a.in[I_CCTX][k]; sv[i] = siluf_(c); }
        __syncthreads();
        float* MOD = (float*)(ws + WS_MOD);
        for (int it = C.bid; it < 4 * 96; it += C.nb) {
            const int layer = it / 96, col = (it % 96) * 64 + C.lane;
            const float* wp = a.in[I_ADAW] + (size_t)layer * 1024 * 6144 + col;
            float acc[9];
#pragma unroll
            for (int m = 0; m < 9; ++m) acc[m] = 0.f;
            const int kb = C.wave * 128;
#pragma unroll 4
            for (int k = 0; k < 128; ++k) { const float w = wp[(size_t)(kb + k) * 6144];
#pragma unroll
                for (int m = 0; m < 9; ++m) acc[m] += sv[m * 1024 + kb + k] * w; }
#pragma unroll
            for (int m = 0; m < 9; ++m) red[(C.wave * 9 + m) * 64 + C.lane] = acc[m];
            __syncthreads();
            for (int i = C.tid; i < 576; i += 512) { const int m = i >> 6, l = i & 63; float s = 0.f;
#pragma unroll
                for (int w = 0; w < 8; ++w) s += red[(w * 9 + m) * 64 + l];
                const int cc = (it % 96) * 64 + l;
                MOD[(size_t)(layer * 9 + m) * 6144 + cc] = s + a.in[I_ADAB][layer * 6144 + cc]; }
            __syncthreads();
        }
    }
    {
        f32x2* CS = (f32x2*)(ws + WS_ROPE);
        for (int i = C.bid * 512 + C.tid; i < 4096 * 16; i += C.nb * 512) {
            const int pos = i >> 4, j = i & 15, f = j & 7;
            const float inv = powf(10000.f, -(float)(2 * f) / 16.f);
            const float ang = (float)((j < 8) ? (pos >> 6) : (pos & 63)) * inv;
            const double tw = 6.283185307179586476925;
            const double x = (double)ang, n = __builtin_rint(x / tw), rr = x - n * tw;
            CS[i] = (f32x2){__cosf((float)rr), __sinf((float)rr)};
        }
    }
    for (int j = 0; j < 2; ++j) {
        transpose_matrix(C, a.in[I_EVWIN] + (size_t)j * DM * EV_IN, DM, EV_IN, (bf16*)(ws + WS_WEVIN) + (size_t)j * EV_INP * DM, nullptr, 0);
        transpose_matrix(C, a.in[I_EVWOUT] + (size_t)j * DM * DM, DM, DM, (bf16*)(ws + WS_WEVOUT) + (size_t)j * DM * DM, nullptr, 0);
        transpose_matrix(C, a.in[I_WUQ] + (size_t)j * 384 * 768, 384, 768, (bf16*)(ws + WS_WUQ) + (size_t)j * 768 * 384, a.in[I_QNORM] + j * 384, 0);
        transpose_matrix(C, a.in[I_WUKV] + (size_t)j * 256 * 1024, 256, 1024, (bf16*)(ws + WS_WUKV) + (size_t)j * 1024 * 256, a.in[I_KVNORM] + j * 256, 0);
        transpose_matrix(C, a.in[I_ODWIN] + (size_t)j * DM * OD_IN, DM, OD_IN, (bf16*)(ws + WS_WODIN) + (size_t)j * OD_INP * DM, nullptr, 0);
        transpose_matrix(C, a.in[I_ODWOUT] + (size_t)j * DM * DM, DM, DM, (bf16*)(ws + WS_WODOUT) + (size_t)j * DM * DM, nullptr, 0);
    }
    {
        const int gt = C.bid * 512 + C.tid, ngt = C.nb * 512;
        for (int j = 0; j < 2; ++j) {
            u32x4* p0 = (u32x4*)((bf16*)(ws + WS_WEVIN) + (size_t)j * EV_INP * DM + (size_t)EV_IN * DM);
            for (int i = gt; i < (EV_INP - EV_IN) * DM / 8; i += ngt) p0[i] = (u32x4){0u, 0u, 0u, 0u};
            u32x4* p1 = (u32x4*)((bf16*)(ws + WS_WODIN) + (size_t)j * OD_INP * DM + (size_t)OD_IN * DM);
            for (int i = gt; i < (OD_INP - OD_IN) * DM / 8; i += ngt) p1[i] = (u32x4){0u, 0u, 0u, 0u};
            bf16* WL = (bf16*)(ws + WS_WLORA) + (size_t)j * 2560 * 384;
            const float* w2 = a.in[I_W2L] + (size_t)j * 2 * 64 * 512; const float* a2 = a.in[I_A2] + (size_t)j * 2 * 64 * 512; const float* g2 = a.in[I_G2] + (size_t)j * 128 * 512;
            for (int i = gt; i < 2560 * 384; i += ngt) {
                const int n = i / 384, k = i % 384; float v = 0.f;
                if (n < 1024) { const int d = n >> 9, c = n & 511; if (k >= d * 64 && k < d * 64 + 64) v = w2[(size_t)(d * 64 + (k - d * 64)) * 512 + c]; }
                else if (n < 2048) { const int d = (n - 1024) >> 9, c = n & 511; if (k >= 128 + d * 64 && k < 128 + d * 64 + 64) v = a2[(size_t)(d * 64 + (k - 128 - d * 64)) * 512 + c]; }
                else { const int c = n - 2048; if (k >= 256) v = g2[(size_t)(k - 256) * 512 + c]; }
                WL[i] = f2bf(v);
            }
        }
    }
}

template <bool ROUTER>
DI void ph_norm(const Ctx& C, const float* xlat, const float* xctx, const float* gain, const float* mod  , int shift_off, int scale_off, bf16* H,
                const float* router  , float* AFFT, float* AFFC, int* SLOT) {
    LAS float* RT = (LAS float*)C.lds;
    if (ROUTER) { for (int i = C.tid; i < 16384; i += 512) { const int c = i >> 4, e = i & 15; RT[e * 1024 + c] = router[i]; } __syncthreads(); }
    const int gw = C.bid * 8 + C.wave, ngw = C.nb * 8, lane = C.lane;
    for (int row = gw; row < MT; row += ngw) {
        const float* xr = row < NLAT ? xlat + (size_t)row * DM : xctx + (size_t)(row - NLAT) * DM;
        const int mi = row < NLAT ? (row >> 12) : 8;
        const float* mp = mod + mi * 6144;
        f32x4 v[4]; float ss = 0.f;
#pragma unroll
        for (int j = 0; j < 4; ++j) { v[j] = *(const f32x4*)(xr + 256 * j + 4 * lane); ss += v[j].x * v[j].x + v[j].y * v[j].y + v[j].z * v[j].z + v[j].w * v[j].w; }
        ss = wave_sum(ss);
        const float rs = 1.0f / sqrtf(ss * (1.f / 1024.f) + EPS);
#pragma unroll
        for (int j = 0; j < 4; ++j) {
            const int c = 256 * j + 4 * lane;
            const f32x4 g = *(const f32x4*)(gain + c), sc = *(const f32x4*)(mp + scale_off + c), sh = *(const f32x4*)(mp + shift_off + c);
            v[j] = (v[j] * rs) * g * (sc + 1.0f) + sh;
            *(u32x2*)(H + (size_t)row * DM + c) = (u32x2){pk2(v[j].x, v[j].y), pk2(v[j].z, v[j].w)};
        }
        if (ROUTER) {
            float mylg = 0.f;
#pragma unroll 1
            for (int e = 0; e < 16; ++e) { float p = 0.f;
#pragma unroll
                for (int j = 0; j < 4; ++j) { const f32x4 w = *(const LAS f32x4*)(RT + e * 1024 + 256 * j + 4 * lane); p += v[j].x * w.x + v[j].y * w.y + v[j].z * w.z + v[j].w * w.w; }
                p = wave_sum(p); mylg = (lane == e) ? p : mylg; }
            float mx = mylg;
#pragma unroll
            for (int o = 1; o < 16; o <<= 1) mx = fmaxf(mx, __shfl_xor(mx, o));
            const float ex = expf(mylg - mx); float sum = ex;
#pragma unroll
            for (int o = 1; o < 16; o <<= 1) sum += __shfl_xor(sum, o);
            const float mine = ex / sum;
            if (lane < 16) {
                if (row < NLAT) AFFT[(size_t)((row >> 12) * 16 + lane) * TL + (row & 4095)] = mine;
                else { const int rc = row - NLAT; AFFC[(size_t)((rc >> 8) * 16 + lane) * LCX + (rc & 255)] = mine; }
                SLOT[(size_t)row * 16 + lane] = -1;
            }
        }
    }
}

template <class Epi>
DI void gemm_unit(const bf16* __restrict__ A, int lda, const int* __restrict__ rows, const bf16* __restrict__ Bt, int K, int pm, int pn, const Epi& E, int wave, int lane) {
    const int wr = wave >> 2, wc = wave & 3, r = lane & 31, h = lane >> 5;
    const bf16* ap[2][2]; const bf16* bp[2];
#pragma unroll
    for (int ai = 0; ai < 2; ++ai)
#pragma unroll
        for (int mm = 0; mm < 2; ++mm) { const int lr = 256 * pm + 128 * ai + 64 * wr + 32 * mm + r; const int gr = rows ? rows[lr] : lr; ap[ai][mm] = A + (size_t)gr * lda + 8 * h; }
#pragma unroll
    for (int bj = 0; bj < 2; ++bj) bp[bj] = Bt + (size_t)(256 * pn + 128 * bj + 32 * wc + r) * K + 8 * h;
    f32x16 acc[2][2][2];
#pragma unroll
    for (int ai = 0; ai < 2; ++ai)
#pragma unroll
        for (int mm = 0; mm < 2; ++mm)
#pragma unroll
            for (int bj = 0; bj < 2; ++bj)
#pragma unroll
                for (int i = 0; i < 16; ++i) acc[ai][mm][bj][i] = 0.f;
#pragma unroll 2
    for (int k0 = 0; k0 < K; k0 += 16) {
        bf16x8 af[2][2], bfr[2];
#pragma unroll
        for (int ai = 0; ai < 2; ++ai)
#pragma unroll
            for (int mm = 0; mm < 2; ++mm) af[ai][mm] = *(const bf16x8*)(ap[ai][mm] + k0);
#pragma unroll
        for (int bj = 0; bj < 2; ++bj) bfr[bj] = *(const bf16x8*)(bp[bj] + k0);
#pragma unroll
        for (int ai = 0; ai < 2; ++ai)
#pragma unroll
            for (int mm = 0; mm < 2; ++mm)
#pragma unroll
                for (int bj = 0; bj < 2; ++bj) acc[ai][mm][bj] = MFMA32(bfr[bj], af[ai][mm], acc[ai][mm][bj]);
    }
#pragma unroll
    for (int ai = 0; ai < 2; ++ai)
#pragma unroll
        for (int mm = 0; mm < 2; ++mm) {
            const int row = 256 * pm + 128 * ai + 64 * wr + 32 * mm + r;
#pragma unroll
            for (int g = 0; g < 4; ++g) {
                const int col = 256 * pn + 32 * wc + 8 * g + 4 * h;
                const f32x4 v0 = {acc[ai][mm][0][4 * g], acc[ai][mm][0][4 * g + 1], acc[ai][mm][0][4 * g + 2], acc[ai][mm][0][4 * g + 3]};
                const f32x4 v1 = {acc[ai][mm][1][4 * g], acc[ai][mm][1][4 * g + 1], acc[ai][mm][1][4 * g + 2], acc[ai][mm][1][4 * g + 3]};
                E(row, col, v0, v1);
            }
        }
}
template <class Epi>
DI void gemm_phase(const Ctx& C, const bf16* A, int lda, const bf16* Bt, int K, int nM, int nN, const Epi& E) {
    for (int u = C.vcu; u < nM * nN; u += C.nb) gemm_unit(A, lda, nullptr, Bt, K, u / nN, u % nN, E, C.wave, C.lane);
}

struct EpiBf16 { bf16* O; int ldo;
    DI void operator()(int row, int col, f32x4 v0, f32x4 v1) const { bf16* p = O + (size_t)row * ldo + col;
        *(u32x2*)p = (u32x2){pk2(v0[0], v0[1]), pk2(v0[2], v0[3])}; *(u32x2*)(p + 128) = (u32x2){pk2(v1[0], v1[1]), pk2(v1[2], v1[3])}; } };
struct EpiF32 { float* O; int ldo;
    DI void operator()(int row, int col, f32x4 v0, f32x4 v1) const { float* p = O + (size_t)row * ldo + col; *(f32x4*)p = v0; *(f32x4*)(p + 128) = v1; } };
struct EpiResid { const float* xin_lat; const float* xin_ctx; float* xout_lat; float* xout_ctx; const float* modg;
    DI void operator()(int row, int col, f32x4 v0, f32x4 v1) const {
        const float* xi; float* xo; int mi;
        if (row < NLAT) { xi = xin_lat + (size_t)row * DM; xo = xout_lat + (size_t)row * DM; mi = row >> 12; }
        else { xi = xin_ctx + (size_t)(row - NLAT) * DM; xo = xout_ctx + (size_t)(row - NLAT) * DM; mi = 8; }
        const float* g = modg + mi * 6144 + col;
        const f32x4 g0 = *(const f32x4*)g, g1 = *(const f32x4*)(g + 128), x0 = *(const f32x4*)(xi + col), x1 = *(const f32x4*)(xi + col + 128);
        *(f32x4*)(xo + col) = x0 + g0 * v0; *(f32x4*)(xo + col + 128) = x1 + g1 * v1; } };
struct EpiGlu { bf16* O;
    DI void operator()(int row, int col, f32x4 v0, f32x4 v1) const { const int f = (col >> 8) * 128 + (col & 255);
        *(u32x2*)(O + (size_t)row * DM + f) = (u32x2){pk2(siluf_(v0[0]) * v1[0], siluf_(v0[1]) * v1[1]), pk2(siluf_(v0[2]) * v1[2], siluf_(v0[3]) * v1[3])}; } };
struct EpiGate { bf16* O; const float* gate;
    DI void operator()(int row, int col, f32x4 v0, f32x4 v1) const { const float g = gate[row]; bf16* p = O + (size_t)row * DM + col;
        *(u32x2*)p = (u32x2){pk2(v0[0] * g, v0[1] * g), pk2(v0[2] * g, v0[3] * g)}; *(u32x2*)(p + 128) = (u32x2){pk2(v1[0] * g, v1[1] * g), pk2(v1[2] * g, v1[3] * g)}; } };
struct EpiLora { float* W; bf16* KEFF; bf16* BSC; bf16* G; const bf16* Kin; const bf16* KKin; const float* w0; const float* a0; const float* ka;
    DI void one(int row, int col, f32x4 v) const {
        if (col < 1024) { const int d = col >> 9, c = col & 511; f32x4 o;
#pragma unroll
            for (int e = 0; e < 4; ++e) { const float lw = w0[d * 512 + c + e] + v[e]; const float z = -lw; const float sp = fmaxf(z, 0.f) + __logf(1.f + __expf(-fabsf(z))); o[e] = expf(-expf(-sp - 0.5f)); }
            *(f32x4*)(W + ((size_t)d * MT + row) * 512 + c) = o; }
        else if (col < 2048) { const int d = (col - 1024) >> 9, c = col & 511;
            const u32x2 kr = *(const u32x2*)(Kin + (size_t)row * 512 + c), kkr = *(const u32x2*)(KKin + (size_t)row * 512 + c);
            const float kf[4] = {bflo(kr.x), bfhi(kr.x), bflo(kr.y), bfhi(kr.y)}, kkf[4] = {bflo(kkr.x), bfhi(kkr.x), bflo(kkr.y), bfhi(kkr.y)};
            float ke[4], bs[4];
#pragma unroll
            for (int e = 0; e < 4; ++e) { const float av = sigmoidf_(a0[d * 512 + c + e] + v[e]); ke[e] = kf[e] * (1.f + (av - 1.f) * ka[c + e]); bs[e] = kkf[e] * av; }
            *(u32x2*)(KEFF + ((size_t)d * MT + row) * 512 + c) = (u32x2){pk2(ke[0], ke[1]), pk2(ke[2], ke[3])};
            *(u32x2*)(BSC + ((size_t)d * MT + row) * 512 + c) = (u32x2){pk2(bs[0], bs[1]), pk2(bs[2], bs[3])}; }
        else { *(u32x2*)(G + (size_t)row * 512 + (col - 2048)) = (u32x2){pk2(v[0], v[1]), pk2(v[2], v[3])}; }
    }
    DI void operator()(int row, int col, f32x4 v0, f32x4 v1) const { one(row, col, v0); one(row, col + 128, v1); } };

DI int swap23(int x) { return (x & ~12) | ((x & 4) << 1) | ((x & 8) >> 1); }
template <int DQK, bool NAT>
DI void flash_range(f32x16 (&o)[2], float& m, float& l, const bf16x8 (&qf)[DQK / 16], const bf16* __restrict__ Kb, const bf16* __restrict__ Vt, int pos0, int nblk, int r, int h,
                    const LAS float* tab, int qc, int cs, int drow0) {
    const int kr = swap23(r);
    for (int blk = 0; blk < nblk; ++blk) {
        const int pos = pos0 + 32 * blk;
        f32x16 s;
#pragma unroll
        for (int i = 0; i < 16; ++i) s[i] = 0.f;
        const bf16* kp = Kb + (size_t)(pos + kr) * DQK + 8 * h;
#pragma unroll
        for (int kk = 0; kk < DQK / 16; ++kk) s = MFMA32(*(const bf16x8*)(kp + 16 * kk), qf[kk], s);
        if (NAT) {
            const int irow = blk >> 1, cc0 = (blk & 1) * 32;
            const LAS float* trow = tab + (drow0 + irow) * 31;
#pragma unroll
            for (int i = 0; i < 16; ++i) {
                const int kib = (i & 3) | (((i >> 2) & 1) << 2) | (h << 3) | ((i >> 3) << 4);
                const int cc = cc0 + kib; const bool ok = (cc >= cs) && (cc < cs + 16);
                int dc = cc - qc + 15; dc = dc < 0 ? 0 : (dc > 30 ? 30 : dc);
                s[i] = ok ? s[i] + trow[dc] : -1e30f;
            }
        }
        float mx = s[0];
#pragma unroll
        for (int i = 1; i < 16; ++i) mx = fmaxf(mx, s[i]);
        mx = fmaxf(mx, __shfl_xor(mx, 32));
        const float mn = fmaxf(m, mx), alpha = __builtin_amdgcn_exp2f(m - mn);
        float rs = 0.f; f32x16 p;
#pragma unroll
        for (int i = 0; i < 16; ++i) { float e = __builtin_amdgcn_exp2f(s[i] - mn); if (NAT) e = (s[i] > -1e29f) ? e : 0.f; p[i] = e; rs += e; }
        rs += __shfl_xor(rs, 32);
        l = l * alpha + rs; m = mn;
#pragma unroll
        for (int i = 0; i < 16; ++i) { o[0][i] *= alpha; o[1][i] *= alpha; }
#pragma unroll
        for (int s2 = 0; s2 < 2; ++s2) {
            u32x4 pw; pw.x = pk2(p[8 * s2], p[8 * s2 + 1]); pw.y = pk2(p[8 * s2 + 2], p[8 * s2 + 3]); pw.z = pk2(p[8 * s2 + 4], p[8 * s2 + 5]); pw.w = pk2(p[8 * s2 + 6], p[8 * s2 + 7]);
            const bf16x8 pb = __builtin_bit_cast(bf16x8, pw);
#pragma unroll
            for (int dt = 0; dt < 2; ++dt) { const bf16x8 va = *(const bf16x8*)(Vt + (size_t)(32 * dt + r) * KPOS + pos + 16 * s2 + 8 * h); o[dt] = MFMA32(va, pb, o[dt]); }
        }
    }
}
DI void flash_store(const f32x16 (&o)[2], float l, bf16* orow  , int h) {
    const float inv = 1.f / l;
#pragma unroll
    for (int dt = 0; dt < 2; ++dt)
#pragma unroll
        for (int g = 0; g < 4; ++g)
            *(u32x2*)(orow + 32 * dt + 8 * g + 4 * h) = (u32x2){pk2(o[dt][4 * g] * inv, o[dt][4 * g + 1] * inv), pk2(o[dt][4 * g + 2] * inv, o[dt][4 * g + 3] * inv)};
}

DI void ph_attn_mla(const Ctx& C, const bf16* QB, const bf16* KB, const bf16* VT, bf16* OCAT, bool last) {
    const int r = C.lane & 31, h = C.lane >> 5;
    for (int u = C.vcu; u < 64 * 17; u += C.nb) {
        const int bh = u / 17, qblk = u % 17, b = bh >> 3, hh = bh & 7;
        if (last && qblk == 16) continue;
        const int qpos = qblk * 256 + 32 * C.wave + r;
        const bf16* qp = QB + ((size_t)bh * KPOS + qpos) * 96 + 8 * h;
        bf16x8 qf[6];
#pragma unroll
        for (int kk = 0; kk < 6; ++kk) qf[kk] = *(const bf16x8*)(qp + 16 * kk);
        f32x16 o[2];
#pragma unroll
        for (int i = 0; i < 16; ++i) { o[0][i] = 0.f; o[1][i] = 0.f; }
        float m = -1e30f, l = 0.f;
        flash_range<96, false>(o, m, l, qf, KB + (size_t)bh * KPOS * 96, VT + (size_t)bh * 64 * KPOS, qblk < 16 ? 0 : TL, qblk < 16 ? KPOS / 32 : LCX / 32, r, h, nullptr, 0, 0, 0);
        const int row = qblk < 16 ? b * TL + qpos : NLAT + b * LCX + (qpos - TL);
        flash_store(o, l, OCAT + (size_t)row * DM + hh * 64, h);
    }
}
DI void ph_natten(const Ctx& C, const bf16* QN, const bf16* KN, const bf16* VTN, bf16* OCAT, const float* rpb  , bool last) {
    const int r = C.lane & 31, h = C.lane >> 5;
    LAS float* tab = (LAS float*)C.lds;
    const int nunits = 1024 + (last ? 0 : 64);
    for (int u = C.vcu; u < nunits; u += C.nb) {
        const bool isctx = u >= 1024;
        const int bh = isctx ? u - 1024 : (u >> 4), b = bh >> 3, hh = bh & 7;
        __syncthreads();
        for (int i = C.tid; i < 465; i += 512) tab[i] = rpb[hh * 465 + i] * LOG2E;
        __syncthreads();
        int qpos, row, grow = 0, qc = 0, rs = 0, cs = 0;
        if (!isctx) { const int rg = u & 15; grow = 4 * rg + (C.wave >> 1); qc = 32 * (C.wave & 1) + r; qpos = grow * 64 + qc; row = b * TL + qpos;
            rs = grow - 4; rs = rs < 0 ? 0 : (rs > 56 ? 56 : rs); cs = qc - 8; cs = cs < 0 ? 0 : (cs > 48 ? 48 : cs); }
        else { qpos = TL + 32 * C.wave + r; row = NLAT + b * LCX + 32 * C.wave + r; }
        const bf16* qp = QN + ((size_t)bh * KPOS + qpos) * 64 + 8 * h;
        bf16x8 qf[4];
#pragma unroll
        for (int kk = 0; kk < 4; ++kk) qf[kk] = *(const bf16x8*)(qp + 16 * kk);
        f32x16 o[2];
#pragma unroll
        for (int i = 0; i < 16; ++i) { o[0][i] = 0.f; o[1][i] = 0.f; }
        float m = -1e30f, l = 0.f;
        const bf16* Kb = KN + (size_t)bh * KPOS * 64; const bf16* Vt = VTN + (size_t)bh * 64 * KPOS;
        if (!isctx) flash_range<64, true>(o, m, l, qf, Kb, Vt, rs * 64, 16, r, h, tab, qc, cs, rs - grow + 7);
        flash_range<64, false>(o, m, l, qf, Kb, Vt, TL, LCX / 32, r, h, nullptr, 0, 0, 0);
        flash_store(o, l, OCAT + (size_t)row * DM + 512 + hh * 64, h);
    }
}

DI void ph_mla_fin(const Ctx& C, const bf16* U, const float* QPRE, const float* KVPRE, const float* qg, const float* kg, const f32x2* CS, bf16* QB, bf16* KB, bf16* VT) {
    LAS bf16* VL = (LAS bf16*)C.lds;
    const int lane = C.lane, hh = lane >> 3, sub = lane & 7;
    const float C2 = 0.10206207261596575f * LOG2E;
    for (int u = C.vcu; u < MT / 64; u += C.nb) {
        const int row0 = 64 * u, b = row0 < NLAT ? (row0 >> 12) : ((row0 - NLAT) >> 8), pos0 = row0 < NLAT ? (row0 & 4095) : TL + ((row0 - NLAT) & 255);
        const bool lat = row0 < NLAT;
        for (int i = 0; i < 8; ++i) {
            const int pl = 8 * C.wave + i, row = row0 + pl, pos = pos0 + pl;
            const bf16* ur = U + (size_t)row * EV_INP;
            float sq = 0.f, skv = 0.f;
#pragma unroll
            for (int mq = 0; mq < 6; ++mq) { const float x = bf2f(ur[lane + 64 * mq]); sq += x * x; }
#pragma unroll
            for (int mq = 0; mq < 4; ++mq) { const float x = bf2f(ur[384 + lane + 64 * mq]); skv += x * x; }
            sq = wave_sum(sq); skv = wave_sum(skv);
            const float rsq = 1.0f / sqrtf(sq * (1.f / 384.f) + EPS), rskv = 1.0f / sqrtf(skv * (1.f / 256.f) + EPS);
            float cr = 1.f, sr = 0.f, cc = 1.f, sc = 0.f;
            if (lat) { const f32x2 a0 = CS[pos * 16 + sub], a1 = CS[pos * 16 + 8 + sub]; cr = a0.x; sr = a0.y; cc = a1.x; sc = a1.y; }
            float qv[12]; float ss = 0.f;
#pragma unroll
            for (int mq = 0; mq < 12; ++mq) { qv[mq] = QPRE[(size_t)row * 768 + hh * 96 + sub + 8 * mq] * rsq; ss += qv[mq] * qv[mq]; }
            ss = sum8(ss);
            float rn = 1.0f / sqrtf(ss * (1.f / 96.f) + EPS);
#pragma unroll
            for (int mq = 0; mq < 12; ++mq) qv[mq] = qv[mq] * rn * qg[sub + 8 * mq];
            { const float x0 = qv[8], x1 = qv[9], y0 = qv[10], y1 = qv[11]; qv[8] = x0 * cr - x1 * sr; qv[9] = x1 * cr + x0 * sr; qv[10] = y0 * cc - y1 * sc; qv[11] = y1 * cc + y0 * sc; }
            bf16* qo = QB + ((size_t)(b * 8 + hh) * KPOS + pos) * 96 + sub;
#pragma unroll
            for (int mq = 0; mq < 12; ++mq) qo[8 * mq] = f2bf(qv[mq] * C2);
            float kv[12]; ss = 0.f;
#pragma unroll
            for (int mq = 0; mq < 8; ++mq) kv[mq] = KVPRE[(size_t)row * 1024 + hh * 128 + sub + 8 * mq] * rskv;
#pragma unroll
            for (int mq = 8; mq < 12; ++mq) kv[mq] = bf2f(ur[640 + sub + 8 * (mq - 8)]);
#pragma unroll
            for (int mq = 0; mq < 12; ++mq) ss += kv[mq] * kv[mq];
            ss = sum8(ss);
            rn = 1.0f / sqrtf(ss * (1.f / 96.f) + EPS);
#pragma unroll
            for (int mq = 0; mq < 12; ++mq) kv[mq] = kv[mq] * rn * kg[sub + 8 * mq];
            { const float x0 = kv[8], x1 = kv[9], y0 = kv[10], y1 = kv[11]; kv[8] = x0 * cr - x1 * sr; kv[9] = x1 * cr + x0 * sr; kv[10] = y0 * cc - y1 * sc; kv[11] = y1 * cc + y0 * sc; }
            bf16* ko = KB + ((size_t)(b * 8 + hh) * KPOS + pos) * 96 + sub;
#pragma unroll
            for (int mq = 0; mq < 12; ++mq) ko[8 * mq] = f2bf(kv[mq]);
#pragma unroll
            for (int mq = 0; mq < 8; ++mq) { const int dv = sub + 8 * mq; VL[(hh * 64 + dv) * 64 + pl] = f2bf(KVPRE[(size_t)row * 1024 + hh * 128 + 64 + dv] * rskv); }
        }
        __syncthreads();
        { const int hd = C.tid;
            bf16* dst = VT + ((size_t)(b * 8 + (hd >> 6)) * 64 + (hd & 63)) * KPOS + pos0;
#pragma unroll
            for (int q = 0; q < 8; ++q) *(u32x4*)(dst + 8 * q) = *(const LAS u32x4*)(VL + hd * 64 + 8 * q); }
        __syncthreads();
    }
}

DI void ph_conv(const Ctx& C, const bf16* U, const float* dww  , const float* dwb, const float* lng, const float* lnb, bf16* OCAT) {
    LAS float* G = (LAS float*)C.lds;
    const int c = C.tid;
    float wk[31];
#pragma unroll
    for (int k = 0; k < 31; ++k) wk[k] = dww[k * 512 + c];
    const float bias = dwb[c];
    for (int u = C.vcu; u < MT / 32; u += C.nb) {
        const int row0 = 32 * u; int base, t0, tseq;
        if (row0 < NLAT) { base = row0 & ~4095; t0 = row0 & 4095; tseq = TL; } else { const int rc = row0 - NLAT; base = NLAT + (rc & ~255); t0 = rc & 255; tseq = LCX; }
        __syncthreads();
        for (int rr = 0; rr < 62; ++rr) { const int tt = t0 - 15 + rr; float g = 0.f;
            if (tt >= 0 && tt < tseq) { const bf16* ur = U + (size_t)(base + tt) * EV_INP; g = bf2f(ur[672 + c]) * sigmoidf_(bf2f(ur[1184 + c])); }
            G[rr * 512 + c] = g; }
        __syncthreads();
        float acc[32];
#pragma unroll
        for (int t = 0; t < 32; ++t) acc[t] = bias;
#pragma unroll
        for (int rr = 0; rr < 62; ++rr) { const float gv = G[rr * 512 + c];
#pragma unroll
            for (int t = 0; t < 32; ++t) { const int k = rr - t; if (k >= 0 && k < 31) acc[t] += gv * wk[k]; } }
        __syncthreads();
#pragma unroll
        for (int t = 0; t < 32; ++t) G[t * 512 + c] = acc[t];
        __syncthreads();
#pragma unroll
        for (int q = 0; q < 4; ++q) {
            const int t = 4 * C.wave + q, row = row0 + t;
            const f32x4 a0 = *(const LAS f32x4*)(G + t * 512 + 8 * C.lane), a1 = *(const LAS f32x4*)(G + t * 512 + 8 * C.lane + 4);
            float x[8] = {a0.x, a0.y, a0.z, a0.w, a1.x, a1.y, a1.z, a1.w}; float s = 0.f;
#pragma unroll
            for (int e = 0; e < 8; ++e) s += x[e];
            const float mu = wave_sum(s) * (1.f / 512.f); float s2 = 0.f;
#pragma unroll
            for (int e = 0; e < 8; ++e) { x[e] -= mu; s2 += x[e] * x[e]; }
            const float rstd = 1.0f / sqrtf(wave_sum(s2) * (1.f / 512.f) + EPS);
            float y[8];
#pragma unroll
            for (int e = 0; e < 8; ++e) { const float z = x[e] * rstd * lng[8 * C.lane + e] + lnb[8 * C.lane + e]; y[e] = siluf_(z); }
            *(u32x4*)(OCAT + (size_t)row * DM + 512 + 8 * C.lane) = pack8(y);
        }
    }
}

DI void shifted8(const bf16* up, const bf16* uc, const bf16* un, bool hp, bool hn, const float* sw, int c0, float (&o)[8]) {
    const u32x4 z = {0u, 0u, 0u, 0u};
    const u32x4 vp = hp ? *(const u32x4*)(up + c0) : z, vc = *(const u32x4*)(uc + c0), vn = hn ? *(const u32x4*)(un + c0) : z;
    float p[8], c[8], n[8]; unpack8(vp, p); unpack8(vc, c); unpack8(vn, n);
#pragma unroll
    for (int e = 0; e < 8; ++e) o[e] = p[e] * sw[c0 + e] + c[e] * sw[RW_IN + c0 + e] + n[e] * sw[2 * RW_IN + c0 + e];
}
DI void ph_prep(const Ctx& C, const bf16* U, const float* sw  , const float* kkw  , const float* naqg, const float* nakg,
                bf16* R, bf16* V, bf16* K, bf16* KK, bf16* L, bf16* QN, bf16* KN, bf16* VTN) {
    LAS bf16* VL = (LAS bf16*)C.lds;
    const int lane = C.lane, hh = lane >> 3, sub = lane & 7;
    const float C2 = 0.125f * LOG2E;
    for (int u = C.vcu; u < MT / 64; u += C.nb) {
        const int row0 = 64 * u; const bool lat = row0 < NLAT;
        const int b = lat ? (row0 >> 12) : ((row0 - NLAT) >> 8), pos0 = lat ? (row0 & 4095) : TL + ((row0 - NLAT) & 255), tseq = lat ? TL : LCX, tb = lat ? (row0 & 4095) : ((row0 - NLAT) & 255);
        for (int i = 0; i < 8; ++i) {
            const int pl = 8 * C.wave + i, row = row0 + pl, pos = pos0 + pl, t = tb + pl;
            const bool hp = t > 0, hn = t < tseq - 1;
            const bf16* uc = U + (size_t)row * OD_INP; const bf16* up = uc - OD_INP; const bf16* un = uc + OD_INP;
            float o[8];
            shifted8(up, uc, un, hp, hn, sw, 8 * lane, o);          *(u32x4*)(R + (size_t)row * 512 + 8 * lane) = pack8(o);
            shifted8(up, uc, un, hp, hn, sw, 1024 + 8 * lane, o);   *(u32x4*)(V + (size_t)row * 512 + 8 * lane) = pack8(o);
            shifted8(up, uc, un, hp, hn, sw, 512 + 8 * lane, o);    *(u32x4*)(K + (size_t)row * 512 + 8 * lane) = pack8(o);
            { float kk[8]; float ss = 0.f;
#pragma unroll
                for (int e = 0; e < 8; ++e) { kk[e] = o[e] * kkw[8 * lane + e]; ss += kk[e] * kk[e]; }
                ss = sum8(ss); const float rn = 1.0f / sqrtf(ss + 1e-12f);
#pragma unroll
                for (int e = 0; e < 8; ++e) kk[e] *= rn;
                *(u32x4*)(KK + (size_t)row * 512 + 8 * lane) = pack8(kk); }
            if (lane < 48) {
                shifted8(up, uc, un, hp, hn, sw, 1536 + 8 * lane, o);
                if (lane < 16) {
#pragma unroll
                    for (int e = 0; e < 8; ++e) { const float ex = __expf(2.f * o[e]); o[e] = 1.f - 2.f / (ex + 1.f); }
                } else if (lane >= 32) {
#pragma unroll
                    for (int e = 0; e < 8; ++e) o[e] = sigmoidf_(o[e]);
                }
                *(u32x4*)(L + (size_t)row * 384 + 8 * lane) = pack8(o);
            }
            { float x[8]; unpack8(*(const u32x4*)(uc + RW_IN + 8 * lane), x); float ss = 0.f;
#pragma unroll
                for (int e = 0; e < 8; ++e) ss += x[e] * x[e];
                ss = sum8(ss); const float rn = 1.0f / sqrtf(ss * (1.f / 64.f) + EPS);
#pragma unroll
                for (int e = 0; e < 8; ++e) x[e] = x[e] * rn * naqg[8 * sub + e] * C2;
                *(u32x4*)(QN + ((size_t)(b * 8 + hh) * KPOS + pos) * 64 + 8 * sub) = pack8(x); }
            { float x[8]; unpack8(*(const u32x4*)(uc + RW_IN + 512 + 8 * lane), x); float ss = 0.f;
#pragma unroll
                for (int e = 0; e < 8; ++e) ss += x[e] * x[e];
                ss = sum8(ss); const float rn = 1.0f / sqrtf(ss * (1.f / 64.f) + EPS);
#pragma unroll
                for (int e = 0; e < 8; ++e) x[e] = x[e] * rn * nakg[8 * sub + e];
                *(u32x4*)(KN + ((size_t)(b * 8 + hh) * KPOS + pos) * 64 + 8 * sub) = pack8(x); }
            { const u32x4 vv = *(const u32x4*)(uc + RW_IN + 1024 + 8 * lane); const unsigned w4[4] = {vv.x, vv.y, vv.z, vv.w};
#pragma unroll
                for (int e = 0; e < 8; ++e) { const int dv = 8 * sub + e; VL[(hh * 64 + dv) * 64 + pl] = (bf16)((e & 1) ? (w4[e >> 1] >> 16) : (w4[e >> 1] & 0xffffu)); } }
        }
        __syncthreads();
        { const int hd = C.tid; bf16* dst = VTN + ((size_t)(b * 8 + (hd >> 6)) * 64 + (hd & 63)) * KPOS + pos0;
#pragma unroll
            for (int q = 0; q < 8; ++q) *(u32x4*)(dst + 8 * q) = *(const LAS u32x4*)(VL + hd * 64 + 8 * q); }
        __syncthreads();
    }
}

#define DPP_ADD(x, ctrl) ((x) + __builtin_bit_cast(float, __builtin_amdgcn_update_dpp(0, __builtin_bit_cast(int, (x)), (ctrl), 0xf, 0xf, false)))
DI float sum16(float x) { x = DPP_ADD(x, 0xB1); x = DPP_ADD(x, 0x4E); x = DPP_ADD(x, 0x141); x = DPP_ADD(x, 0x140); return x; }
DI int scan_row(int s, int d, int b) { if (s < LCX) return NLAT + b * LCX + (d ? (LCX - 1 - s) : s); const int t = s - LCX; return b * TL + (d ? (TL - 1 - t) : t); }
DI void ph_scan(const Ctx& C, const bf16* R, const bf16* V, const bf16* KK, const float* W, const bf16* KEFF, const bf16* BSC, float* YS) {
    constexpr int CH = 32, BUF = 5 * CH * 64 + CH * 32;
    LAS float* lds = (LAS float*)C.lds;
    LAS float* ystage = lds + 2 * BUF;
    const int tid = C.tid, i = tid >> 4, kq = tid & 15;
    for (int cid = C.bid; cid < 256; cid += C.nb) {
        const int b = cid >> 5, hh = (cid >> 2) & 7, d = (cid >> 1) & 1, hf = cid & 1;
        const float* Wd = W + (size_t)d * MT * 512; const bf16* KEd = KEFF + (size_t)d * MT * 512; const bf16* BSd = BSC + (size_t)d * MT * 512; float* Yd = YS + (size_t)d * MT * 512;
        float S[4] = {0.f, 0.f, 0.f, 0.f};
        const int sl = tid >> 4, sub = tid & 15;
        f32x4 lw; u32x4 l1, l2, l3;
        auto issue = [&](int ck) {
            const int row = scan_row(ck * CH + sl, d, b);
            lw = *(const f32x4*)(Wd + (size_t)row * 512 + hh * 64 + 4 * sub);
            if (sub < 8) { l1 = *(const u32x4*)(R + (size_t)row * 512 + hh * 64 + 8 * sub); l2 = *(const u32x4*)(KEd + (size_t)row * 512 + hh * 64 + 8 * sub); }
            else { l1 = *(const u32x4*)(KK + (size_t)row * 512 + hh * 64 + 8 * (sub - 8)); l2 = *(const u32x4*)(BSd + (size_t)row * 512 + hh * 64 + 8 * (sub - 8)); }
            if (sub < 4) l3 = *(const u32x4*)(V + (size_t)row * 512 + hh * 64 + 32 * hf + 8 * sub);
        };
        auto commit = [&](int bufi) {
            LAS float* B = lds + bufi * BUF;
            *(LAS f32x4*)(B + (1 * CH + sl) * 64 + 4 * sub) = lw;
            float f1[8], f2[8]; unpack8(l1, f1); unpack8(l2, f2);
            const int a1 = sub < 8 ? 0 : 3, a2 = sub < 8 ? 2 : 4, off = 8 * (sub & 7);
            *(LAS f32x4*)(B + (a1 * CH + sl) * 64 + off) = (f32x4){f1[0], f1[1], f1[2], f1[3]}; *(LAS f32x4*)(B + (a1 * CH + sl) * 64 + off + 4) = (f32x4){f1[4], f1[5], f1[6], f1[7]};
            *(LAS f32x4*)(B + (a2 * CH + sl) * 64 + off) = (f32x4){f2[0], f2[1], f2[2], f2[3]}; *(LAS f32x4*)(B + (a2 * CH + sl) * 64 + off + 4) = (f32x4){f2[4], f2[5], f2[6], f2[7]};
            if (sub < 4) { float f3[8]; unpack8(l3, f3); LAS float* vp = B + 5 * CH * 64 + sl * 32 + 8 * sub;
                *(LAS f32x4*)vp = (f32x4){f3[0], f3[1], f3[2], f3[3]}; *(LAS f32x4*)(vp + 4) = (f32x4){f3[4], f3[5], f3[6], f3[7]}; }
        };
        __syncthreads();
        issue(0); commit(0);
        __syncthreads();
        constexpr int NCK = KPOS / CH;
        for (int ck = 0; ck < NCK; ++ck) {
            if (ck + 1 < NCK) issue(ck + 1);
            const LAS float* B = lds + (ck & 1) * BUF; LAS float* ys = ystage + (ck & 1) * CH * 32;
#pragma unroll 4
            for (int s = 0; s < CH; ++s) {
                const f32x4 rr = *(const LAS f32x4*)(B + (0 * CH + s) * 64 + 4 * kq), ww = *(const LAS f32x4*)(B + (1 * CH + s) * 64 + 4 * kq), ke = *(const LAS f32x4*)(B + (2 * CH + s) * 64 + 4 * kq),
                            kk = *(const LAS f32x4*)(B + (3 * CH + s) * 64 + 4 * kq), bs = *(const LAS f32x4*)(B + (4 * CH + s) * 64 + 4 * kq);
                const float v = B[5 * CH * 64 + s * 32 + i];
                float sa = -(S[0] * kk.x + S[1] * kk.y + S[2] * kk.z + S[3] * kk.w);
                sa = sum16(sa);
                S[0] = S[0] * ww.x + (sa * bs.x + v * ke.x); S[1] = S[1] * ww.y + (sa * bs.y + v * ke.y); S[2] = S[2] * ww.z + (sa * bs.z + v * ke.z); S[3] = S[3] * ww.w + (sa * bs.w + v * ke.w);
                float y = S[0] * rr.x + S[1] * rr.y + S[2] * rr.z + S[3] * rr.w;
                y = sum16(y);
                if (kq == 0) ys[s * 32 + i] = y;
            }
            if (ck + 1 < NCK) commit((ck + 1) & 1);
            __syncthreads();
            if (tid < 256) { const int s = tid >> 3, q = tid & 7; const int row = scan_row(ck * CH + s, d, b);
                *(f32x4*)(Yd + (size_t)row * 512 + hh * 64 + 32 * hf + 4 * q) = *(const LAS f32x4*)(ys + s * 32 + 4 * q); }
        }
    }
}

DI void ph_post(const Ctx& C, const float* YS, const bf16* R, const bf16* V, const bf16* KEFF, const bf16* G, const float* rk, const float* gng, const float* gnb, bf16* OCAT, bool last) {
    const int gw = C.bid * 8 + C.wave, ngw = C.nb * 8, lane = C.lane, nrows = last ? NLAT : MT;
    for (int row = gw; row < nrows; row += ngw) {
        const size_t o = (size_t)row * 512 + 8 * lane;
        const f32x4 y0a = *(const f32x4*)(YS + o), y0b = *(const f32x4*)(YS + o + 4), y1a = *(const f32x4*)(YS + (size_t)MT * 512 + o), y1b = *(const f32x4*)(YS + (size_t)MT * 512 + o + 4);
        float y[8] = {y0a.x + y1a.x, y0a.y + y1a.y, y0a.z + y1a.z, y0a.w + y1a.w, y0b.x + y1b.x, y0b.y + y1b.y, y0b.z + y1b.z, y0b.w + y1b.w};
        float r[8], v[8], k0[8], k1[8], g[8];
        unpack8(*(const u32x4*)(R + o), r); unpack8(*(const u32x4*)(V + o), v); unpack8(*(const u32x4*)(KEFF + o), k0); unpack8(*(const u32x4*)(KEFF + (size_t)MT * 512 + o), k1); unpack8(*(const u32x4*)(G + o), g);
        float bsum = 0.f;
#pragma unroll
        for (int e = 0; e < 8; ++e) bsum += r[e] * (k0[e] + k1[e]) * rk[8 * lane + e];
        bsum = sum8(bsum);
        float s = 0.f;
#pragma unroll
        for (int e = 0; e < 8; ++e) { y[e] += bsum * v[e]; s += y[e]; }
        const float mu = sum8(s) * (1.f / 64.f); float s2 = 0.f;
#pragma unroll
        for (int e = 0; e < 8; ++e) { y[e] -= mu; s2 += y[e] * y[e]; }
        const float rstd = 1.0f / sqrtf(sum8(s2) * (1.f / 64.f) + GN_EPS);
        float out[8];
#pragma unroll
        for (int e = 0; e < 8; ++e) out[e] = (y[e] * rstd * gng[8 * lane + e] + gnb[8 * lane + e]) * g[e];
        *(u32x4*)(OCAT + (size_t)row * DM + 8 * lane) = pack8(out);
    }
}

DI void ph_topk(const Ctx& C, const float* AFFT, const float* AFFC, int* ROWS, float* GATE, int* SLOT, bool last) {
    LAS unsigned long long* key = (LAS unsigned long long*)C.lds;
    const int nprob = last ? 128 : 256;
    for (int p = C.bid; p < nprob; p += C.nb) {
        const bool isctx = p >= 128; const int be = p & 127, b = be >> 4, e = be & 15;
        const int n = isctx ? LCX : TL, cap = isctx ? CAPC : CAPL;
        const float* src = isctx ? AFFC + (size_t)be * LCX : AFFT + (size_t)be * TL;
        __syncthreads();
        for (int t = C.tid; t < n; t += 512) key[t] = ((unsigned long long)__builtin_bit_cast(unsigned, src[t]) << 32) | (unsigned long long)(0xFFFFFFFFu - (unsigned)t);
        __syncthreads();
        for (int k = 2; k <= n; k <<= 1)
            for (int j = k >> 1; j > 0; j >>= 1) {
                for (int q = C.tid; q < n / 2; q += 512) {
                    const int i = ((q & ~(j - 1)) << 1) | (q & (j - 1)), ix = i | j;
                    const unsigned long long a = key[i], bb = key[ix];
                    const bool desc = ((i & k) == 0);
                    if (desc ? (a < bb) : (a > bb)) { key[i] = bb; key[ix] = a; }
                }
                __syncthreads();
            }
        for (int jx = C.tid; jx < cap; jx += 512) {
            const unsigned long long kv = key[jx]; const int t = (int)(0xFFFFFFFFu - (unsigned)(kv & 0xFFFFFFFFull)); const float g = __builtin_bit_cast(float, (unsigned)(kv >> 32));
            const int slot = isctx ? NB * CAPL + b * CAPC + jx : b * CAPL + jx, row = isctx ? NLAT + b * LCX + t : b * TL + t;
            ROWS[e * ESLOTS + slot] = row; GATE[e * ESLOTS + slot] = g; SLOT[(size_t)row * 16 + e] = slot;
        }
    }
}

DI void ph_combine(const Ctx& C, float* xlat, float* xctx, const float* modg2  , const int* SLOT, const bf16* Y2, bool last) {
    const int gw = C.bid * 8 + C.wave, ngw = C.nb * 8, lane = C.lane, nrows = last ? NLAT : MT;
    for (int row = gw; row < nrows; row += ngw) {
        float* xr = row < NLAT ? xlat + (size_t)row * DM : xctx + (size_t)(row - NLAT) * DM;
        const int mi = row < NLAT ? (row >> 12) : 8;
        const int sv = SLOT[(size_t)row * 16 + (lane & 15)];
        f32x4 acc[4];
#pragma unroll
        for (int j = 0; j < 4; ++j) acc[j] = (f32x4){0.f, 0.f, 0.f, 0.f};
        for (int e = 0; e < 16; ++e) {
            const int s = __shfl(sv, e);
            if (s >= 0) { const bf16* yp = Y2 + ((size_t)e * ESLOTS + s) * DM + 4 * lane;
#pragma unroll
                for (int j = 0; j < 4; ++j) { const u32x2 w = *(const u32x2*)(yp + 256 * j); acc[j] += (f32x4){bflo(w.x), bfhi(w.x), bflo(w.y), bfhi(w.y)}; } }
        }
#pragma unroll
        for (int j = 0; j < 4; ++j) { const int c = 256 * j + 4 * lane; const f32x4 g = *(const f32x4*)(modg2 + mi * 6144 + c); f32x4 x = *(const f32x4*)(xr + c); x += g * acc[j]; *(f32x4*)(xr + c) = x; }
    }
}

constexpr int PH_PER_PAIR = 24, N_PHASES = 1 + 2 * PH_PER_PAIR;
__global__ void __launch_bounds__(512, 2) fwd_kernel(Args a) {
    extern __shared__ __attribute__((aligned(16))) unsigned char smem[];
    Ctx C0; C0.lds = (LAS unsigned char*)smem; C0.tid = threadIdx.x; C0.lane = C0.tid & 63; C0.wave = __builtin_amdgcn_readfirstlane(C0.tid >> 6); C0.bid = blockIdx.x; C0.nb = gridDim.x;
    C0.vcu = (C0.nb % 8 == 0) ? (C0.bid % 8) * (C0.nb / 8) + C0.bid / 8 : C0.bid;
    unsigned char* ws = a.ws;
    volatile LAS unsigned* bst = (volatile LAS unsigned*)(C0.lds + LDS_BYTES - 16);
#if MEGA
    if (C0.tid == 0) { bst[0] = 0u; bst[1] = 0u; }
    __syncthreads();
    XcdBarrier bar = xcd_barrier_post((unsigned*)(ws + WS_CTL) + 4096, bst);
#define SEAM() do { if (ph < hi) xcd_barrier(bar); } while (0)
#else
#define SEAM() do { } while (0)
#endif
    const int lo = a.ph_lo, hi = a.ph_hi;
    int ph = 0;
#ifndef ONLY
#define ONLY -1
#endif
#ifndef SITE_LO
#define SITE_LO 0
#define SITE_HI 99
#endif
#define PHASE(SITE, ...) do { if ((ONLY < 0 || ONLY == (SITE)) && (SITE) >= SITE_LO && (SITE) <= SITE_HI && ph >= lo && ph < hi) { Ctx C; C.lds = C0.lds; { int t_ = threadIdx.x; asm volatile("" : "+v"(t_)); C.tid = t_; C.lane = t_ & 63; C.wave = __builtin_amdgcn_readfirstlane(t_ >> 6); } \
        { int b_ = C0.bid, n_ = C0.nb, v_ = C0.vcu; asm volatile("" : "+s"(b_), "+s"(n_), "+s"(v_)); C.bid = b_; C.nb = n_; C.vcu = v_; } __VA_ARGS__; ++ph; SEAM(); } else ++ph; } while (0)
    float* const XL = a.out; float* const XC = (float*)(ws + WS_XC);
    const float* MOD = (const float*)(ws + WS_MOD);
    bf16* const HB = (bf16*)(ws + WS_HB); bf16* const OCAT = (bf16*)(ws + WS_OCAT);
    unsigned char* const AR = ws + WS_ARENA;
    int* const ROWS = (int*)(ws + WS_ROWS); float* const GATE = (float*)(ws + WS_GATE); int* const SLOT = (int*)(ws + WS_SLOT);
    float* const AFFT = (float*)(ws + WS_AFFT); float* const AFFC = (float*)(ws + WS_AFFC);
    bf16* const W13 = (bf16*)(ws + WS_W13); bf16* const W2 = (bf16*)(ws + WS_W2);

    PHASE(0, ph_prologue(C, a));

    for (int lp = 0; lp < 2; ++lp) {
        {
            const int i = 2 * lp, j = lp; const bool last = false;
            const float* modl = MOD + (size_t)i * 9 * 6144;
            const float* xin_l = (i == 0) ? a.in[I_X] : XL; const float* xin_c = (i == 0) ? a.in[I_CTX] : XC;
            bf16* U = (bf16*)(AR + A_U); float* QPRE = (float*)(AR + A_QPRE); float* KVPRE = (float*)(AR + A_KVPRE);
            bf16* QB = (bf16*)(AR + A_QB); bf16* KB = (bf16*)(AR + A_KB); bf16* VT = (bf16*)(AR + A_VT);
            PHASE(1, { ph_norm<false>(C, xin_l, xin_c, a.in[I_N1G] + i * DM, modl, 0, 1024, HB, nullptr, nullptr, nullptr, nullptr);
                    moe_weight_prep(C, a.in[I_MW1] + (size_t)i * NEXP * DM * DM, a.in[I_MW3] + (size_t)i * NEXP * DM * DM, a.in[I_MW2] + (size_t)i * NEXP * DM * DM, W13, W2); });
            PHASE(2, { EpiBf16 E{U, EV_INP}; gemm_phase(C, HB, DM, (const bf16*)(ws + WS_WEVIN) + (size_t)j * EV_INP * DM, DM, MT / 256, EV_INP / 256, E); });
            PHASE(3, { EpiF32 Eq{QPRE, 768}; gemm_phase(C, U, EV_INP, (const bf16*)(ws + WS_WUQ) + (size_t)j * 768 * 384, 384, MT / 256, 3, Eq);
                    EpiF32 Ek{KVPRE, 1024}; gemm_phase(C, U + 384, EV_INP, (const bf16*)(ws + WS_WUKV) + (size_t)j * 1024 * 256, 256, MT / 256, 4, Ek); });
            PHASE(4, { ph_mla_fin(C, U, QPRE, KVPRE, a.in[I_QG] + j * 96, a.in[I_KG] + j * 96, (const f32x2*)(ws + WS_ROPE), QB, KB, VT);
                    ph_conv(C, U, a.in[I_DWW] + (size_t)j * 31 * 512, a.in[I_DWB] + j * 512, a.in[I_LNG] + j * 512, a.in[I_LNB] + j * 512, OCAT); });
            PHASE(5, ph_attn_mla(C, QB, KB, VT, OCAT, last));
            PHASE(6, { EpiResid E{xin_l, xin_c, XL, XC, modl + 2048}; gemm_phase(C, OCAT, DM, (const bf16*)(ws + WS_WEVOUT) + (size_t)j * DM * DM, DM, MT / 256, 4, E); });
            PHASE(7, ph_norm<true>(C, XL, XC, a.in[I_N2G] + i * DM, modl, 3072, 4096, HB, a.in[I_ROUTER] + (size_t)i * DM * 16, AFFT, AFFC, SLOT));
            PHASE(8, ph_topk(C, AFFT, AFFC, ROWS, GATE, SLOT, last));
            PHASE(9, { for (int u = C.vcu; u < NEXP * 17 * 8; u += C.nb) { const int e = u / 136, q = u % 136, pm = q >> 3, pn = q & 7;
                        EpiGlu E{(bf16*)(AR + A_HID) + (size_t)e * ESLOTS * DM}; gemm_unit(HB, DM, ROWS + e * ESLOTS, W13 + (size_t)e * 2048 * DM, DM, pm, pn, E, C.wave, C.lane); } });
            PHASE(10, { for (int u = C.vcu; u < NEXP * 17 * 4; u += C.nb) { const int e = u / 68, q = u % 68, pm = q >> 2, pn = q & 3;
                        EpiGate E{(bf16*)(AR + A_Y2) + (size_t)e * ESLOTS * DM, GATE + e * ESLOTS};
                        gemm_unit((const bf16*)(AR + A_HID) + (size_t)e * ESLOTS * DM, DM, nullptr, W2 + (size_t)e * DM * DM, DM, pm, pn, E, C.wave, C.lane); } });
            PHASE(11, ph_combine(C, XL, XC, modl + 5120, SLOT, (const bf16*)(AR + A_Y2), last));
        }
        {
            const int i = 2 * lp + 1, j = lp; const bool last = (i == 3);
            const float* modl = MOD + (size_t)i * 9 * 6144;
            bf16* U = (bf16*)(AR + A_U); float* Wd = (float*)(AR + A_W); bf16* KEFF = (bf16*)(AR + A_KEFF); bf16* BSC = (bf16*)(AR + A_BSC);
            bf16* R = (bf16*)(AR + A_R); bf16* V = (bf16*)(AR + A_V); bf16* KK = (bf16*)(AR + A_KK); bf16* G = (bf16*)(AR + A_G); bf16* K = (bf16*)(AR + A_K); bf16* L = (bf16*)(AR + A_L);
            bf16* QN = (bf16*)(AR + A_QN); bf16* KN = (bf16*)(AR + A_KN); bf16* VTN = (bf16*)(AR + A_VTN); float* YS = (float*)(AR + A_YS);
            PHASE(12, { ph_norm<false>(C, XL, XC, a.in[I_N1G] + i * DM, modl, 0, 1024, HB, nullptr, nullptr, nullptr, nullptr);
                    moe_weight_prep(C, a.in[I_MW1] + (size_t)i * NEXP * DM * DM, a.in[I_MW3] + (size_t)i * NEXP * DM * DM, a.in[I_MW2] + (size_t)i * NEXP * DM * DM, W13, W2); });
            PHASE(13, { EpiBf16 E{U, OD_INP}; gemm_phase(C, HB, DM, (const bf16*)(ws + WS_WODIN) + (size_t)j * OD_INP * DM, DM, MT / 256, OD_INP / 256, E); });
            PHASE(14, ph_prep(C, U, a.in[I_SHIFTW] + (size_t)j * 3 * RW_IN, a.in[I_KKW] + j * 512, a.in[I_NAQG] + j * 64, a.in[I_NAKG] + j * 64, R, V, K, KK, L, QN, KN, VTN));
            PHASE(15, { EpiLora E{Wd, KEFF, BSC, G, K, KK, a.in[I_W0] + j * 1024, a.in[I_A0] + j * 1024, a.in[I_KA] + j * 512};
                    gemm_phase(C, L, 384, (const bf16*)(ws + WS_WLORA) + (size_t)j * 2560 * 384, 384, MT / 256, 10, E); });
            PHASE(16, ph_natten(C, QN, KN, VTN, OCAT, a.in[I_RPB] + (size_t)j * 8 * 465, last));
            PHASE(17, ph_scan(C, R, V, KK, Wd, KEFF, BSC, YS));
            PHASE(18, ph_post(C, YS, R, V, KEFF, G, a.in[I_RK] + j * 512, a.in[I_GNG] + j * 512, a.in[I_GNB] + j * 512, OCAT, last));
            PHASE(19, { EpiResid E{XL, XC, XL, XC, modl + 2048}; gemm_phase(C, OCAT, DM, (const bf16*)(ws + WS_WODOUT) + (size_t)j * DM * DM, DM, last ? NLAT / 256 : MT / 256, 4, E); });
            PHASE(20, ph_norm<true>(C, XL, XC, a.in[I_N2G] + i * DM, modl, 3072, 4096, HB, a.in[I_ROUTER] + (size_t)i * DM * 16, AFFT, AFFC, SLOT));
            PHASE(21, ph_topk(C, AFFT, AFFC, ROWS, GATE, SLOT, last));
            PHASE(22, { const int nmt = last ? 16 : 17; for (int u = C.vcu; u < NEXP * nmt * 8; u += C.nb) { const int e = u / (nmt * 8), q = u % (nmt * 8), pm = q >> 3, pn = q & 7;
                        EpiGlu E{(bf16*)(AR + A_HID) + (size_t)e * ESLOTS * DM}; gemm_unit(HB, DM, ROWS + e * ESLOTS, W13 + (size_t)e * 2048 * DM, DM, pm, pn, E, C.wave, C.lane); } });
            PHASE(23, { const int nmt = last ? 16 : 17; for (int u = C.vcu; u < NEXP * nmt * 4; u += C.nb) { const int e = u / (nmt * 4), q = u % (nmt * 4), pm = q >> 2, pn = q & 3;
                        EpiGate E{(bf16*)(AR + A_Y2) + (size_t)e * ESLOTS * DM, GATE + e * ESLOTS};
                        gemm_unit((const bf16*)(AR + A_HID) + (size_t)e * ESLOTS * DM, DM, nullptr, W2 + (size_t)e * DM * DM, DM, pm, pn, E, C.wave, C.lane); } });
            PHASE(24, ph_combine(C, XL, XC, modl + 5120, SLOT, (const bf16*)(AR + A_Y2), last));
        }
    }
}

extern "C" void kernel_launch(void* const* d_in, const int* in_sizes, int n_in, void* d_out, int out_size, void* d_ws, size_t ws_size, hipStream_t stream) {
    static int grid = 0;
    if (grid == 0) {
        if (n_in != 40 || out_size != NLAT * DM || ws_size < WS_END) { fprintf(stderr, "kernel_launch: unexpected shapes (n_in %d out %d ws %zu need %zu)\n", n_in, out_size, ws_size, (size_t)WS_END); grid = -1; return; }
        int dev = 0, cus = 0, per_cu = 0;
        if (hipGetDevice(&dev) != hipSuccess || hipDeviceGetAttribute(&cus, hipDeviceAttributeMultiprocessorCount, dev) != hipSuccess) { grid = -1; return; }
        if (hipFuncSetAttribute((const void*)fwd_kernel, hipFuncAttributeMaxDynamicSharedMemorySize, LDS_BYTES) != hipSuccess) { fprintf(stderr, "kernel_launch: hipFuncSetAttribute failed\n"); grid = -1; return; }
        if (hipOccupancyMaxActiveBlocksPerMultiprocessor(&per_cu, (const void*)fwd_kernel, 512, LDS_BYTES) != hipSuccess || per_cu < 1) { fprintf(stderr, "kernel_launch: occupancy query says %d\n", per_cu); per_cu = 1; }
        (void)hipGetLastError();
        grid = cus;
    }
    if (grid < 0) return;
    (void)hipMemsetAsync((char*)d_ws + WS_CTL, 0, CTL_BYTES, stream);
    Args a{};
    for (int i = 0; i < 40; ++i) a.in[i] = (const float*)d_in[i];
    a.out = (float*)d_out; a.ws = (unsigned char*)d_ws;
#if MEGA
    a.ph_lo = 0; a.ph_hi = N_PHASES;
    hipLaunchKernelGGL(fwd_kernel, dim3(grid), dim3(512), LDS_BYTES, stream, a);
#else
    for (int p = 0; p < N_PHASES; ++p) { a.ph_lo = p; a.ph_hi = p + 1; hipLaunchKernelGGL(fwd_kernel, dim3(grid), dim3(512), LDS_BYTES, stream, a); }
#endif
}
```

```cpp
#include <hip/hip_runtime.h>
#include <cstdio>
#include <cstdint>

#ifndef MEGA
#define MEGA 1
#endif

#define LAS __attribute__((address_space(3)))
#define DI __device__ __forceinline__

typedef unsigned short bf16;
typedef short bf16x8 __attribute__((ext_vector_type(8)));
typedef float f32x4 __attribute__((ext_vector_type(4)));
typedef float f32x2 __attribute__((ext_vector_type(2)));
typedef float f32x16 __attribute__((ext_vector_type(16)));
typedef unsigned u32x4 __attribute__((ext_vector_type(4)));
typedef unsigned u32x2 __attribute__((ext_vector_type(2)));
typedef __bf16 bf16x2_t __attribute__((ext_vector_type(2)));

constexpr int DM = 1024, NB = 8, TL = 4096, LCX = 256;
constexpr int NLAT = NB * TL, NCTX = NB * LCX, MT = NLAT + NCTX;
constexpr int KPOS = TL + LCX;
constexpr float EPS = 1e-6f, GN_EPS = 64e-5f;
constexpr int EV_IN = 1696, EV_INP = 1792, OD_IN = 3456, OD_INP = 3584, RW_IN = 1920;
constexpr int NEXP = 16, CAPL = 512, CAPC = 32, ESLOTS = NB * CAPL + NB * CAPC;
constexpr float LOG2E = 1.4426950408889634f;

constexpr size_t MiB = 1ull << 20;
constexpr size_t WS_CTL = 0, CTL_BYTES = 1 * MiB;
constexpr size_t WS_MOD = 1 * MiB, WS_ROPE = 2 * MiB, WS_XC = 4 * MiB;
constexpr size_t WS_ROWS = 12 * MiB, WS_GATE = 12 * MiB + 512 * 1024, WS_SLOT = 13 * MiB, WS_AFFT = 16 * MiB, WS_AFFC = 18 * MiB;
constexpr size_t WS_WEVIN = 20 * MiB, WS_WEVOUT = 27 * MiB, WS_WUQ = 31 * MiB, WS_WUKV = 33 * MiB, WS_WODIN = 34 * MiB, WS_WODOUT = 48 * MiB, WS_WLORA = 52 * MiB;
constexpr size_t WS_W13 = 56 * MiB, WS_W2 = 120 * MiB, WS_HB = 152 * MiB, WS_OCAT = 220 * MiB, WS_ARENA = 288 * MiB;
constexpr size_t A_U = 0, A_QPRE = 119 * MiB, A_KVPRE = 221 * MiB, A_QB = 357 * MiB, A_KB = 408 * MiB, A_VT = 459 * MiB;
constexpr size_t A_W = 0, A_KEFF = 136 * MiB, A_BSC = 204 * MiB, A_R = 272 * MiB, A_V = 306 * MiB, A_KK = 340 * MiB, A_G = 374 * MiB, A_K = 408 * MiB, A_L = 442 * MiB,
                 A_QN = 468 * MiB, A_KN = 502 * MiB, A_VTN = 536 * MiB, A_YS = 408 * MiB;
constexpr size_t A_HID = 0, A_Y2 = 136 * MiB;
constexpr size_t WS_END = WS_ARENA + 570 * MiB;
constexpr int LDS_BYTES = 147456;

DI unsigned pk2(float lo, float hi) { f32x2 v = {lo, hi}; bf16x2_t b = __builtin_convertvector(v, bf16x2_t); return __builtin_bit_cast(unsigned, b); }
DI float bflo(unsigned u) { return __builtin_bit_cast(float, u << 16); }
DI float bfhi(unsigned u) { return __builtin_bit_cast(float, u & 0xffff0000u); }
DI float bf2f(bf16 x) { return __builtin_bit_cast(float, ((unsigned)x) << 16); }
DI bf16 f2bf(float f) { return (bf16)(pk2(f, 0.f) & 0xffffu); }
DI void unpack8(u32x4 v, float (&f)[8]) { f[0] = bflo(v.x); f[1] = bfhi(v.x); f[2] = bflo(v.y); f[3] = bfhi(v.y); f[4] = bflo(v.z); f[5] = bfhi(v.z); f[6] = bflo(v.w); f[7] = bfhi(v.w); }
DI u32x4 pack8(const float (&f)[8]) { u32x4 r; r.x = pk2(f[0], f[1]); r.y = pk2(f[2], f[3]); r.z = pk2(f[4], f[5]); r.w = pk2(f[6], f[7]); return r; }
#define DPP_ADD(x, ctrl) ((x) + __builtin_bit_cast(float, __builtin_amdgcn_update_dpp(0, __builtin_bit_cast(int, (x)), (ctrl), 0xf, 0xf, false)))
#define DPP_MAX(x, ctrl) fmaxf((x), __builtin_bit_cast(float, __builtin_amdgcn_update_dpp(0, __builtin_bit_cast(int, (x)), (ctrl), 0xf, 0xf, false)))
DI float sum8(float x) { x = DPP_ADD(x, 0xB1); x = DPP_ADD(x, 0x4E); x = DPP_ADD(x, 0x141); return x; }
DI float sum16(float x) { x = DPP_ADD(x, 0xB1); x = DPP_ADD(x, 0x4E); x = DPP_ADD(x, 0x141); x = DPP_ADD(x, 0x140); return x; }
DI float max16(float x) { x = DPP_MAX(x, 0xB1); x = DPP_MAX(x, 0x4E); x = DPP_MAX(x, 0x141); x = DPP_MAX(x, 0x140); return x; }
DI float rdlane(float x, int l) { return __builtin_bit_cast(float, __builtin_amdgcn_readlane(__builtin_bit_cast(int, x), l)); }
DI float wave_sum(float v) { const float x = sum16(v); return (rdlane(x, 0) + rdlane(x, 16)) + (rdlane(x, 32) + rdlane(x, 48)); }
DI float xor32(float v, int lane) { return __builtin_bit_cast(float, __builtin_amdgcn_ds_bpermute((lane ^ 32) << 2, __builtin_bit_cast(int, v))); }
DI float sigmoidf_(float x) { return 1.f / (1.f + __expf(-x)); }
DI float siluf_(float x) { return x / (1.f + __expf(-x)); }
#define MFMA32(a, b, c) __builtin_amdgcn_mfma_f32_32x32x16_bf16((a), (b), (c), 0, 0, 0)

#define XB_TMO      128
#define XB_XCNT(j)  (256  + 64 * (j))
#define XB_XSUB(j)  (1280 + 64 * (j))
#define XB_XGEN(j)  (2304 + 64 * (j))
#define XB_TOP      3328
#define XB_TOPGEN   3392
#define XCD_BAR_WORDS 3456
#define XB_SPIN_CAP (1u << 22)
__device__ __forceinline__ unsigned xb_ld(unsigned* p)              { return __hip_atomic_load(p, __ATOMIC_RELAXED, __HIP_MEMORY_SCOPE_AGENT); }
__device__ __forceinline__ unsigned xb_add(unsigned* p, unsigned v) { return __hip_atomic_fetch_add(p, v, __ATOMIC_RELAXED, __HIP_MEMORY_SCOPE_AGENT); }
__device__ __forceinline__ unsigned xb_xcc_id() { return (unsigned)__builtin_amdgcn_s_getreg((3 << 11) | 20) & 0xFu; }
#define XB_SPIN(cond, bar) do { unsigned _sp = 0; while (cond) { __builtin_amdgcn_s_sleep(1); \
    if ((++_sp & 255u) == 0u) { if (xb_ld(&(bar)[XB_TMO])) break; if (_sp > XB_SPIN_CAP) { atomicAdd(&(bar)[XB_TMO], 1u); break; } } } } while (0)
struct XcdBarrier { unsigned* bar; unsigned x; volatile LAS unsigned* st; };
__device__ __forceinline__ XcdBarrier xcd_barrier_post(unsigned* bar, volatile LAS unsigned* st, bool leader) {
    XcdBarrier b; b.bar = bar; b.x = xb_xcc_id(); b.st = st;
    if (leader) (void)xb_add(&bar[XB_XCNT(b.x)], 1u);
    return b;
}
__device__ __forceinline__ void xcd_barrier_complete(unsigned* bar, unsigned x, unsigned& nloc, unsigned& nx) {
    const unsigned G = gridDim.x * gridDim.y * gridDim.z;
    unsigned sum, cnt, mine, sp = 0u;
    for (;;) {
        sum = 0u; cnt = 0u; mine = 0u;
#pragma unroll
        for (unsigned j = 0; j < 16; ++j) { const unsigned c = xb_ld(&bar[XB_XCNT(j)]); sum += c; cnt += (c > 0u) ? 1u : 0u; mine = (j == x) ? c : mine; }
        if (sum == G) break;
        __builtin_amdgcn_s_sleep(1);
        if ((++sp & 255u) == 0u) { if (xb_ld(&bar[XB_TMO])) break; if (sp > XB_SPIN_CAP) { atomicAdd(&bar[XB_TMO], 1u); break; } }
    }
    nloc = mine > 0u ? mine : 1u; nx = cnt > 0u ? cnt : 1u;
}
__device__ __forceinline__ void xcd_barrier(const XcdBarrier& b, bool leader) {
    asm volatile("s_waitcnt vmcnt(0)" ::: "memory");
    __syncthreads();
    if (leader) {
        unsigned* bar = b.bar;
        __builtin_amdgcn_s_waitcnt(0);
        unsigned nloc = b.st[0], nx = b.st[1];
        if (nloc == 0u) { xcd_barrier_complete(bar, b.x, nloc, nx); b.st[0] = nloc; b.st[1] = nx; }
        const unsigned old = xb_add(&bar[XB_XSUB(b.x)], 1u);
        const unsigned gen = old / nloc;
        if (old + 1u == (gen + 1u) * nloc) {
            __builtin_amdgcn_fence(__ATOMIC_RELEASE, "agent");
            asm volatile("s_waitcnt vmcnt(0)" ::: "memory");
            const unsigned og = xb_add(&bar[XB_TOP], 1u);
            const unsigned tg = og / nx;
            if (og + 1u == (tg + 1u) * nx) xb_add(&bar[XB_TOPGEN], 1u);
            else XB_SPIN(xb_ld(&bar[XB_TOPGEN]) == tg, bar);
            __builtin_amdgcn_fence(__ATOMIC_ACQUIRE, "agent");
            xb_add(&bar[XB_XGEN(b.x)], 1u);
            asm volatile("s_waitcnt vmcnt(0)" ::: "memory");
        } else {
            XB_SPIN(xb_ld(&bar[XB_XGEN(b.x)]) == gen, bar);
            __builtin_amdgcn_fence(__ATOMIC_ACQUIRE, "agent");
            asm volatile("s_waitcnt vmcnt(0)" ::: "memory");
        }
    }
    __syncthreads();
}

struct Ctx { LAS unsigned char* lds; int tid, lane, wave, bid, nb, vcu; };
struct Args { const float* in[40]; float* out; unsigned char* ws; int ph_lo, ph_hi; };
enum { I_X = 0, I_C, I_CTX, I_CCTX, I_ADAW, I_ADAB, I_N1G, I_N2G, I_EVWIN, I_EVWOUT, I_QNORM, I_WUQ, I_KVNORM, I_WUKV, I_QG, I_KG, I_DWW, I_DWB, I_LNG, I_LNB,
       I_ODWIN, I_ODWOUT, I_SHIFTW, I_W0, I_W2L, I_A0, I_A2, I_G2, I_KKW, I_KA, I_RK, I_GNG, I_GNB, I_NAQG, I_NAKG, I_RPB, I_ROUTER, I_MW1, I_MW3, I_MW2 };

DI void transpose_item(const float* __restrict__ W, int K, int N, bf16* __restrict__ WT, int dst_row0, const float* __restrict__ gain, LAS float* scr, int k0, int n0, int lane) {
#pragma unroll 8
    for (int i = 0; i < 32; ++i) { const int kk = 2 * i + (lane >> 5); float v = W[(size_t)(k0 + kk) * N + n0 + (lane & 31)]; if (gain) v *= gain[k0 + kk]; scr[kk * 33 + (lane & 31)] = v; }
    asm volatile("s_waitcnt lgkmcnt(0)" ::: "memory");
    const int c = lane & 7;
#pragma unroll
    for (int j = 0; j < 4; ++j) { const int n = (lane >> 3) + 8 * j; const LAS float* s = scr + (8 * c) * 33 + n;
        u32x4 o; o.x = pk2(s[0 * 33], s[1 * 33]); o.y = pk2(s[2 * 33], s[3 * 33]); o.z = pk2(s[4 * 33], s[5 * 33]); o.w = pk2(s[6 * 33], s[7 * 33]);
        *(u32x4*)(WT + (size_t)(dst_row0 + n) * K + k0 + 8 * c) = o; }
    asm volatile("s_waitcnt lgkmcnt(0)" ::: "memory");
}
DI void transpose_matrix(const Ctx& C, const float* W, int K, int N, bf16* WT, const float* gain, int mode  ) {
    LAS float* scr = (LAS float*)(C.lds + C.wave * 8704);
    const int nkb = K / 64, nnb = N / 32, nit = nkb * nnb, gw = C.vcu * 8 + C.wave, ngw = C.nb * 8;
    for (int it = gw; it < nit; it += ngw) {
        const int kb = it / nnb, nbk = it % nnb, n0 = nbk * 32;
        int d0 = n0; if (mode) d0 = (n0 >> 7) * 256 + (n0 & 127) + (mode == 2 ? 128 : 0);
        transpose_item(W, K, N, WT, d0, gain, scr, kb * 64, n0, C.lane);
    }
}
DI void moe_weight_prep(const Ctx& C, const float* w1, const float* w3, const float* w2, bf16* W13, bf16* W2) {
    LAS float* scr = (LAS float*)(C.lds + C.wave * 8704);
    const int gw = C.vcu * 8 + C.wave, ngw = C.nb * 8;
    constexpr int PER = 16 * 32;
    for (int it = gw; it < NEXP * 3 * PER; it += ngw) {
        const int e = it / (3 * PER), r = it % (3 * PER), which = r / PER, q = r % PER, kb = q / 32, n0 = (q % 32) * 32;
        if (which == 0)      transpose_item(w1 + (size_t)e * DM * DM, DM, DM, W13 + (size_t)e * 2048 * DM, (n0 >> 7) * 256 + (n0 & 127), nullptr, scr, kb * 64, n0, C.lane);
        else if (which == 1) transpose_item(w3 + (size_t)e * DM * DM, DM, DM, W13 + (size_t)e * 2048 * DM, (n0 >> 7) * 256 + (n0 & 127) + 128, nullptr, scr, kb * 64, n0, C.lane);
        else                 transpose_item(w2 + (size_t)e * DM * DM, DM, DM, W2 + (size_t)e * DM * DM, n0, nullptr, scr, kb * 64, n0, C.lane);
    }
}

DI void ph_prologue(const Ctx& C, const Args& a) {
    unsigned char* ws = a.ws;
    {
        LAS float* sv = (LAS float*)C.lds;
        LAS float* red = sv + 9 * 1024;
        for (int i = C.tid; i < 9 * 1024; i += 512) { const int m = i >> 10, k = i & 1023; const float c = (m < 8) ? a.in[I_C][m * 1024 + k] : a.in[I_CCTX][k]; sv[i] = siluf_(c); }
        __syncthreads();
        float* MOD = (float*)(ws + WS_MOD);
        for (int it = C.bid; it < 4 * 96; it += C.nb) {
            const int layer = it / 96, col = (it % 96) * 64 + C.lane;
            const float* wp = a.in[I_ADAW] + (size_t)layer * 1024 * 6144 + col;
            float acc[9];
#pragma unroll
            for (int m = 0; m < 9; ++m) acc[m] = 0.f;
            const int kb = C.wave * 128;
#pragma unroll 4
            for (int k = 0; k < 128; ++k) { const float w = wp[(size_t)(kb + k) * 6144];
#pragma unroll
                for (int m = 0; m < 9; ++m) acc[m] += sv[m * 1024 + kb + k] * w; }
#pragma unroll
            for (int m = 0; m < 9; ++m) red[(C.wave * 9 + m) * 64 + C.lane] = acc[m];
            __syncthreads();
            for (int i = C.tid; i < 576; i += 512) { const int m = i >> 6, l = i & 63; float s = 0.f;
#pragma unroll
                for (int w = 0; w < 8; ++w) s += red[(w * 9 + m) * 64 + l];
                const int cc = (it % 96) * 64 + l;
                MOD[(size_t)(layer * 9 + m) * 6144 + cc] = s + a.in[I_ADAB][layer * 6144 + cc]; }
            __syncthreads();
        }
    }
    {
        f32x2* CS = (f32x2*)(ws + WS_ROPE);
        for (int i = C.bid * 512 + C.tid; i < 4096 * 16; i += C.nb * 512) {
            const int pos = i >> 4, j = i & 15, f = j & 7;
            const float inv = powf(10000.f, -(float)(2 * f) / 16.f);
            const float ang = (float)((j < 8) ? (pos >> 6) : (pos & 63)) * inv;
            const double tw = 6.283185307179586476925;
            const double x = (double)ang, n = __builtin_rint(x / tw), rr = x - n * tw;
            CS[i] = (f32x2){__cosf((float)rr), __sinf((float)rr)};
        }
    }
    for (int j = 0; j < 2; ++j) {
        transpose_matrix(C, a.in[I_EVWIN] + (size_t)j * DM * EV_IN, DM, EV_IN, (bf16*)(ws + WS_WEVIN) + (size_t)j * EV_INP * DM, nullptr, 0);
        transpose_matrix(C, a.in[I_EVWOUT] + (size_t)j * DM * DM, DM, DM, (bf16*)(ws + WS_WEVOUT) + (size_t)j * DM * DM, nullptr, 0);
        transpose_matrix(C, a.in[I_WUQ] + (size_t)j * 384 * 768, 384, 768, (bf16*)(ws + WS_WUQ) + (size_t)j * 768 * 384, a.in[I_QNORM] + j * 384, 0);
        transpose_matrix(C, a.in[I_WUKV] + (size_t)j * 256 * 1024, 256, 1024, (bf16*)(ws + WS_WUKV) + (size_t)j * 1024 * 256, a.in[I_KVNORM] + j * 256, 0);
        transpose_matrix(C, a.in[I_ODWIN] + (size_t)j * DM * OD_IN, DM, OD_IN, (bf16*)(ws + WS_WODIN) + (size_t)j * OD_INP * DM, nullptr, 0);
        transpose_matrix(C, a.in[I_ODWOUT] + (size_t)j * DM * DM, DM, DM, (bf16*)(ws + WS_WODOUT) + (size_t)j * DM * DM, nullptr, 0);
    }
    {
        const int gt = C.bid * 512 + C.tid, ngt = C.nb * 512;
        for (int j = 0; j < 2; ++j) {
            u32x4* p0 = (u32x4*)((bf16*)(ws + WS_WEVIN) + (size_t)j * EV_INP * DM + (size_t)EV_IN * DM);
            for (int i = gt; i < (EV_INP - EV_IN) * DM / 8; i += ngt) p0[i] = (u32x4){0u, 0u, 0u, 0u};
            u32x4* p1 = (u32x4*)((bf16*)(ws + WS_WODIN) + (size_t)j * OD_INP * DM + (size_t)OD_IN * DM);
            for (int i = gt; i < (OD_INP - OD_IN) * DM / 8; i += ngt) p1[i] = (u32x4){0u, 0u, 0u, 0u};
            bf16* WL = (bf16*)(ws + WS_WLORA) + (size_t)j * 196608;
            const float* w2 = a.in[I_W2L] + (size_t)j * 2 * 64 * 512; const float* a2 = a.in[I_A2] + (size_t)j * 2 * 64 * 512; const float* g2 = a.in[I_G2] + (size_t)j * 128 * 512;
            for (int i = gt; i < 196608; i += ngt) {
                float v;
                if (i < 65536) { const int d = i >> 15, c = (i >> 6) & 511, r = i & 63; v = w2[(size_t)(d * 64 + r) * 512 + c]; }
                else if (i < 131072) { const int q = i - 65536, d = q >> 15, c = (q >> 6) & 511, r = q & 63; v = a2[(size_t)(d * 64 + r) * 512 + c]; }
                else { const int q = i - 131072, c = q >> 7, r = q & 127; v = g2[(size_t)r * 512 + c]; }
                WL[i] = f2bf(v);
            }
        }
    }
}

template <bool ROUTER>
DI void ph_norm(const Ctx& C, const float* xlat, const float* xctx, const float* gain, const float* mod  , int shift_off, int scale_off, bf16* H,
                const float* router  , float* AFFT, float* AFFC, int* SLOT) {
    LAS float* RT = (LAS float*)C.lds;
    if (ROUTER) { for (int i = C.tid; i < 16384; i += 512) { const int c = i >> 4, e = i & 15; RT[e * 1024 + c] = router[i]; } __syncthreads(); }
    const int gw = C.bid * 8 + C.wave, ngw = C.nb * 8, lane = C.lane;
    for (int row = gw; row < MT; row += ngw) {
        const float* xr = row < NLAT ? xlat + (size_t)row * DM : xctx + (size_t)(row - NLAT) * DM;
        const int mi = row < NLAT ? (row >> 12) : 8;
        const float* mp = mod + mi * 6144;
        f32x4 v[4]; float ss = 0.f;
#pragma unroll
        for (int j = 0; j < 4; ++j) { v[j] = *(const f32x4*)(xr + 256 * j + 4 * lane); ss += v[j].x * v[j].x + v[j].y * v[j].y + v[j].z * v[j].z + v[j].w * v[j].w; }
        ss = wave_sum(ss);
        const float rs = 1.0f / sqrtf(ss * (1.f / 1024.f) + EPS);
#pragma unroll
        for (int j = 0; j < 4; ++j) {
            const int c = 256 * j + 4 * lane;
            const f32x4 g = *(const f32x4*)(gain + c), sc = *(const f32x4*)(mp + scale_off + c), sh = *(const f32x4*)(mp + shift_off + c);
            v[j] = (v[j] * rs) * g * (sc + 1.0f) + sh;
            *(u32x2*)(H + (size_t)row * DM + c) = (u32x2){pk2(v[j].x, v[j].y), pk2(v[j].z, v[j].w)};
        }
        if (ROUTER) {
            float mylg = 0.f;
#pragma unroll 1
            for (int e = 0; e < 16; ++e) { float p = 0.f;
#pragma unroll
                for (int j = 0; j < 4; ++j) { const f32x4 w = *(const LAS f32x4*)(RT + e * 1024 + 256 * j + 4 * lane); p += v[j].x * w.x + v[j].y * w.y + v[j].z * w.z + v[j].w * w.w; }
                p = wave_sum(p); mylg = (lane == e) ? p : mylg; }
            const float mx = max16(mylg);
            const float ex = expf(mylg - mx);
            const float mine = ex / sum16(ex);
            if (lane < 16) {
                if (row < NLAT) AFFT[(size_t)((row >> 12) * 16 + lane) * TL + (row & 4095)] = mine;
                else { const int rc = row - NLAT; AFFC[(size_t)((rc >> 8) * 16 + lane) * LCX + (rc & 255)] = mine; }
                SLOT[(size_t)row * 16 + lane] = -1;
            }
        }
    }
}

template <class Epi>
DI void gemm_unit(const bf16* __restrict__ A, int lda, const int* __restrict__ rows, const bf16* __restrict__ Bt, int K, int pm, int pn, const Epi& E, int wave, int lane) {
    const int wr = wave >> 2, wc = wave & 3, r = lane & 31, h = lane >> 5;
    const bf16* ap[2][2]; const bf16* bp[2];
#pragma unroll
    for (int ai = 0; ai < 2; ++ai)
#pragma unroll
        for (int mm = 0; mm < 2; ++mm) { const int lr = 256 * pm + 128 * ai + 64 * wr + 32 * mm + r; const int gr = rows ? rows[lr] : lr; ap[ai][mm] = A + (size_t)gr * lda + 8 * h; }
#pragma unroll
    for (int bj = 0; bj < 2; ++bj) bp[bj] = Bt + (size_t)(256 * pn + 128 * bj + 32 * wc + r) * K + 8 * h;
    f32x16 acc[2][2][2];
#pragma unroll
    for (int ai = 0; ai < 2; ++ai)
#pragma unroll
        for (int mm = 0; mm < 2; ++mm)
#pragma unroll
            for (int bj = 0; bj < 2; ++bj)
#pragma unroll
                for (int i = 0; i < 16; ++i) acc[ai][mm][bj][i] = 0.f;
#pragma unroll 2
    for (int k0 = 0; k0 < K; k0 += 16) {
        bf16x8 af[2][2], bfr[2];
#pragma unroll
        for (int ai = 0; ai < 2; ++ai)
#pragma unroll
            for (int mm = 0; mm < 2; ++mm) af[ai][mm] = *(const bf16x8*)(ap[ai][mm] + k0);
#pragma unroll
        for (int bj = 0; bj < 2; ++bj) bfr[bj] = *(const bf16x8*)(bp[bj] + k0);
#pragma unroll
        for (int ai = 0; ai < 2; ++ai)
#pragma unroll
            for (int mm = 0; mm < 2; ++mm)
#pragma unroll
                for (int bj = 0; bj < 2; ++bj) acc[ai][mm][bj] = MFMA32(bfr[bj], af[ai][mm], acc[ai][mm][bj]);
    }
#pragma unroll
    for (int ai = 0; ai < 2; ++ai)
#pragma unroll
        for (int mm = 0; mm < 2; ++mm) {
            const int row = 256 * pm + 128 * ai + 64 * wr + 32 * mm + r;
#pragma unroll
            for (int g = 0; g < 4; ++g) {
                const int col = 256 * pn + 32 * wc + 8 * g + 4 * h;
                const f32x4 v0 = {acc[ai][mm][0][4 * g], acc[ai][mm][0][4 * g + 1], acc[ai][mm][0][4 * g + 2], acc[ai][mm][0][4 * g + 3]};
                const f32x4 v1 = {acc[ai][mm][1][4 * g], acc[ai][mm][1][4 * g + 1], acc[ai][mm][1][4 * g + 2], acc[ai][mm][1][4 * g + 3]};
                E(row, col, v0, v1);
            }
        }
}
template <class Epi>
DI void gemm_phase(const Ctx& C, const bf16* A, int lda, const bf16* Bt, int K, int nM, int nN, const Epi& E) {
    for (int u = C.vcu; u < nM * nN; u += C.nb) gemm_unit(A, lda, nullptr, Bt, K, u / nN, u % nN, E, C.wave, C.lane);
}

struct EpiBf16 { bf16* O; int ldo;
    DI void operator()(int row, int col, f32x4 v0, f32x4 v1) const { bf16* p = O + (size_t)row * ldo + col;
        *(u32x2*)p = (u32x2){pk2(v0[0], v0[1]), pk2(v0[2], v0[3])}; *(u32x2*)(p + 128) = (u32x2){pk2(v1[0], v1[1]), pk2(v1[2], v1[3])}; } };
struct EpiF32 { float* O; int ldo;
    DI void operator()(int row, int col, f32x4 v0, f32x4 v1) const { float* p = O + (size_t)row * ldo + col; *(f32x4*)p = v0; *(f32x4*)(p + 128) = v1; } };
struct EpiResid { const float* xin_lat; const float* xin_ctx; float* xout_lat; float* xout_ctx; const float* modg;
    DI void operator()(int row, int col, f32x4 v0, f32x4 v1) const {
        const float* xi; float* xo; int mi;
        if (row < NLAT) { xi = xin_lat + (size_t)row * DM; xo = xout_lat + (size_t)row * DM; mi = row >> 12; }
        else { xi = xin_ctx + (size_t)(row - NLAT) * DM; xo = xout_ctx + (size_t)(row - NLAT) * DM; mi = 8; }
        const float* g = modg + mi * 6144 + col;
        const f32x4 g0 = *(const f32x4*)g, g1 = *(const f32x4*)(g + 128), x0 = *(const f32x4*)(xi + col), x1 = *(const f32x4*)(xi + col + 128);
        *(f32x4*)(xo + col) = x0 + g0 * v0; *(f32x4*)(xo + col + 128) = x1 + g1 * v1; } };
struct EpiGlu { bf16* O;
    DI void operator()(int row, int col, f32x4 v0, f32x4 v1) const { const int f = ((col & 2047) >> 8) * 128 + (col & 255);
        *(u32x2*)(O + (size_t)row * DM + f) = (u32x2){pk2(siluf_(v0[0]) * v1[0], siluf_(v0[1]) * v1[1]), pk2(siluf_(v0[2]) * v1[2], siluf_(v0[3]) * v1[3])}; } };
struct EpiGate { bf16* O; const float* gate;
    DI void operator()(int row, int col, f32x4 v0, f32x4 v1) const { const float g = gate[row]; bf16* p = O + (size_t)row * DM + (col & 1023);
        *(u32x2*)p = (u32x2){pk2(v0[0] * g, v0[1] * g), pk2(v0[2] * g, v0[3] * g)}; *(u32x2*)(p + 128) = (u32x2){pk2(v1[0] * g, v1[1] * g), pk2(v1[2] * g, v1[3] * g)}; } };
struct EpiLoraW { float* W; const float* w0;
    DI void one(int row, int c, f32x4 v) const { f32x4 o;
#pragma unroll
        for (int e = 0; e < 4; ++e) { const float lw = w0[c + e] + v[e]; const float z = -lw; const float sp = fmaxf(z, 0.f) + __logf(1.f + __expf(-fabsf(z))); o[e] = __expf(-__expf(-sp - 0.5f)); }
        *(f32x4*)(W + (size_t)row * 512 + c) = o; }
    DI void operator()(int row, int col, f32x4 v0, f32x4 v1) const { one(row, col, v0); one(row, col + 128, v1); } };
struct EpiLoraA { bf16* KEFF; bf16* BSC; const bf16* Kin; const bf16* KKin; const float* a0; const float* ka;
    DI void one(int row, int c, f32x4 v) const {
        const u32x2 kr = *(const u32x2*)(Kin + (size_t)row * 512 + c), kkr = *(const u32x2*)(KKin + (size_t)row * 512 + c);
        const float kf[4] = {bflo(kr.x), bfhi(kr.x), bflo(kr.y), bfhi(kr.y)}, kkf[4] = {bflo(kkr.x), bfhi(kkr.x), bflo(kkr.y), bfhi(kkr.y)};
        float ke[4], bs[4];
#pragma unroll
        for (int e = 0; e < 4; ++e) { const float av = sigmoidf_(a0[c + e] + v[e]); ke[e] = kf[e] * (1.f + (av - 1.f) * ka[c + e]); bs[e] = kkf[e] * av; }
        *(u32x2*)(KEFF + (size_t)row * 512 + c) = (u32x2){pk2(ke[0], ke[1]), pk2(ke[2], ke[3])};
        *(u32x2*)(BSC + (size_t)row * 512 + c) = (u32x2){pk2(bs[0], bs[1]), pk2(bs[2], bs[3])}; }
    DI void operator()(int row, int col, f32x4 v0, f32x4 v1) const { one(row, col, v0); one(row, col + 128, v1); } };


namespace pg8 {
constexpr int BM = 256, BK = 64, HALF = 128, HTB = HALF * BK * 2, STAGE_BYTES = 8 * HTB;
DI int lds_byte(int r, int c) { const int st = (r >> 4) * 2 + (c >> 5), rr = r & 15, cc = c & 31, ob = rr * 64 + cc * 2; return st * 1024 + (ob ^ (((ob >> 9) & 1) << 5)); }
DI void stage_rc(int b, int& R, int& C) { const int st = b / 1024, sb = b % 1024, swz = sb ^ (((sb >> 9) & 1) << 5); R = (st >> 1) * 16 + swz / 64; C = (st & 1) * 32 + (swz % 64) / 2; }
DI int perm32(int rho) { const int n = rho >> 4, i = rho & 15; return 8 * (i >> 2) + 4 * n + (i & 3); }
struct Unit { int pm, pn; };
struct Gemm { const bf16* A; const bf16* Bt; int lda, K; const int* rows; };
struct OrderMN { int nM, nN, G, c;
    DI bool next(int i, Unit& u) const { const int L = i * G + c; if (L >= nM * nN) return false; u.pm = L / nN; u.pn = L % nN; return true; } };
struct OrderMoE { int nMt, nN, mstride  , G, c;
    DI bool next(int i, Unit& u) const { const int L = i * G + c, per = nMt * nN; if (L >= NEXP * per) return false; const int e = L / per, q = L % per; u.pm = e * mstride + q / nN; u.pn = e * nN + q % nN; return true; } };
template <class E4> struct EpiAdapt { E4 e;
    DI void operator()(const f32x4 (&acc)[2][2][4][2], const Unit& u, int wr, int wc, int fr, int fq) const {
#pragma unroll
        for (int ai = 0; ai < 2; ++ai)
#pragma unroll
            for (int m = 0; m < 4; ++m) { const int row = u.pm * BM + ai * HALF + wr * 64 + m * 16 + fr;
#pragma unroll
                for (int n = 0; n < 2; ++n) e(row, u.pn * BM + wc * 32 + 8 * fq + 4 * n, acc[ai][0][m][n], acc[ai][1][m][n]);
                __builtin_amdgcn_sched_barrier(0); } } };

template <class Epi, class Sched>
DI void gemm_phase(LAS unsigned char* lds, const Gemm g, const Sched& S, const Epi& E, const int tid) {
    const int wid = __builtin_amdgcn_readfirstlane(tid >> 6), lane = tid & 63, wr = wid >> 2, wc = wid & 3, fr = lane & 15, fq = lane >> 4;
    const int K = g.K, nt = K / BK;
    int RA[2], CA[2]; unsigned voffB[2];
#pragma unroll
    for (int i = 0; i < 2; ++i) { int R, C; stage_rc(tid * 16 + i * 8192, R, C); RA[i] = R; CA[i] = C; const int Rb = (R & ~31) + perm32(R & 31); voffB[i] = (unsigned)(Rb * K + C) * 2u; }
    const size_t kstep = (size_t)(BK * 2), hstep = (size_t)HALF * K * 2, tstep = 2 * hstep;
    const unsigned ldsw = (unsigned)wid * 1024u;
    const int aoff = lds_byte(wr * 64 + fr, fq * 8), boff = lds_byte(wc * 32 + fr, fq * 8);
    const char* const gA = (const char*)g.A;
#define PG8_SA(b, h) (((b) * 2 + (h)) * HTB)
#define PG8_SB(b, h) ((4 + (b) * 2 + (h)) * HTB)
#define PG8_STAGE(bufoff, gbase, voff) do { _Pragma("unroll") for (int _i = 0; _i < 2; ++_i) \
        __builtin_amdgcn_global_load_lds((const unsigned*)((const char*)(gbase) + (voff)[_i]), (LAS unsigned*)(lds + (bufoff) + ldsw + _i * 8192), 16, 0, 0); } while (0)
#define PG8_LDA(dst, b, h) do { _Pragma("unroll") for (int m = 0; m < 4; ++m) _Pragma("unroll") for (int k = 0; k < 2; ++k) dst[m][k] = *(const LAS bf16x8*)(lds + PG8_SA(b, h) + aoff + m * 2048 + k * 1024); } while (0)
#define PG8_LDB(dst, b, h) do { _Pragma("unroll") for (int n = 0; n < 2; ++n) _Pragma("unroll") for (int k = 0; k < 2; ++k) dst[n][k] = *(const LAS bf16x8*)(lds + PG8_SB(b, h) + boff + n * 2048 + k * 1024); } while (0)
#define PG8_MMA(ai, bj, At, Bt) do { __builtin_amdgcn_s_setprio(1); _Pragma("unroll") for (int m = 0; m < 4; ++m) _Pragma("unroll") for (int n = 0; n < 2; ++n) _Pragma("unroll") for (int k = 0; k < 2; ++k) \
        acc[ai][bj][m][n] = __builtin_amdgcn_mfma_f32_16x16x32_bf16(Bt[n][k], At[m][k], acc[ai][bj][m][n], 0, 0, 0); __builtin_amdgcn_s_setprio(0); } while (0)
#define PG8_WAIT_V(n) asm volatile("s_waitcnt vmcnt(" #n ")" ::: "memory")
#define PG8_WAIT_L(n) asm volatile("s_waitcnt lgkmcnt(" #n ")" ::: "memory")
#define PG8_BAR __builtin_amdgcn_s_barrier()
#define PG8_SCHED __builtin_amdgcn_sched_barrier(0)
#define PG8_AOFF(vo, u) do { _Pragma("unroll") for (int _h = 0; _h < 2; ++_h) _Pragma("unroll") for (int _i = 0; _i < 2; ++_i) { const int _lr = (u).pm * BM + _h * HALF + RA[_i]; \
        const int _gr = g.rows ? g.rows[_lr] : _lr; vo[_h][_i] = (unsigned)(((size_t)_gr * g.lda + CA[_i]) * 2u); } } while (0)
    Unit cur, nxt; int ui = 0;
    if (!S.next(0, cur)) return;
    f32x4 acc[2][2][4][2];
#pragma unroll
    for (int a = 0; a < 2; ++a)
#pragma unroll
        for (int b = 0; b < 2; ++b)
#pragma unroll
            for (int m = 0; m < 4; ++m)
#pragma unroll
                for (int n = 0; n < 2; ++n) acc[a][b][m][n] = (f32x4){0.f, 0.f, 0.f, 0.f};
    bf16x8 At[4][2], B0[2][2], B1[2][2];
    unsigned cvo[2][2], nvo[2][2];
    PG8_AOFF(cvo, cur);
    const char* cB = (const char*)g.Bt + (size_t)cur.pn * tstep;
    PG8_STAGE(PG8_SB(0, 0), cB, voffB); PG8_STAGE(PG8_SB(0, 1), cB + hstep, voffB); PG8_STAGE(PG8_SA(0, 0), gA, cvo[0]); PG8_STAGE(PG8_SA(0, 1), gA, cvo[1]);
    if (wr == 1) PG8_BAR;
    PG8_WAIT_V(2); PG8_BAR;
    PG8_STAGE(PG8_SB(1, 0), cB + kstep, voffB); PG8_STAGE(PG8_SA(1, 0), gA + kstep, cvo[0]); PG8_STAGE(PG8_SB(1, 1), cB + hstep + kstep, voffB);
    PG8_WAIT_V(6); PG8_BAR;
    for (;;) {
        const bool has_next = S.next(ui + 1, nxt);
        if (has_next) { PG8_AOFF(nvo, nxt); } else {
#pragma unroll
            for (int _h = 0; _h < 2; ++_h)
#pragma unroll
                for (int _i = 0; _i < 2; ++_i) nvo[_h][_i] = cvo[_h][_i]; }
        const char* nB = has_next ? (const char*)g.Bt + (size_t)nxt.pn * tstep : cB;
        for (int t = 0; t < nt; t += 2) {
            const bool last = (t == nt - 2);
            const char* a1 = gA + (size_t)(t + 1) * kstep;
            const char* a2 = last ? gA : gA + (size_t)(t + 2) * kstep; const char* b2 = last ? nB : cB + (size_t)(t + 2) * kstep;
            const char* a3 = a2 + kstep; const char* b3 = b2 + kstep;
            unsigned v20[2], v21[2];
#pragma unroll
            for (int _i = 0; _i < 2; ++_i) { v20[_i] = last ? nvo[0][_i] : cvo[0][_i]; v21[_i] = last ? nvo[1][_i] : cvo[1][_i]; }
            PG8_LDB(B0, 0, 0); PG8_LDB(B1, 0, 1); PG8_SCHED; PG8_LDA(At, 0, 0); PG8_STAGE(PG8_SA(1, 1), a1, cvo[1]);
            PG8_WAIT_V(8); PG8_WAIT_L(0); PG8_BAR; PG8_MMA(0, 0, At, B0); PG8_MMA(0, 1, At, B1); PG8_BAR; PG8_SCHED;
            PG8_LDA(At, 0, 1); PG8_STAGE(PG8_SB(0, 0), b2, voffB); PG8_STAGE(PG8_SB(0, 1), b2 + hstep, voffB); PG8_STAGE(PG8_SA(0, 0), a2, v20);
            PG8_WAIT_V(8); PG8_WAIT_L(0); PG8_BAR; PG8_MMA(1, 0, At, B0); PG8_MMA(1, 1, At, B1); PG8_BAR; PG8_SCHED;
            PG8_LDB(B0, 1, 0); PG8_LDB(B1, 1, 1); PG8_SCHED; PG8_LDA(At, 1, 0); PG8_STAGE(PG8_SA(0, 1), a2, v21);
            PG8_WAIT_V(8); PG8_WAIT_L(0); PG8_BAR; PG8_MMA(0, 0, At, B0); PG8_MMA(0, 1, At, B1); PG8_BAR; PG8_SCHED;
            PG8_LDA(At, 1, 1); PG8_STAGE(PG8_SB(1, 0), b3, voffB); PG8_STAGE(PG8_SB(1, 1), b3 + hstep, voffB); PG8_STAGE(PG8_SA(1, 0), a3, v20);
            PG8_WAIT_V(8); PG8_WAIT_L(0); PG8_BAR; PG8_MMA(1, 0, At, B0); PG8_MMA(1, 1, At, B1); PG8_BAR; PG8_SCHED;
        }
        if (wr == 0) PG8_BAR;
        E(acc, cur, wr, wc, fr, fq);
        if (!has_next) break;
#pragma unroll
        for (int a = 0; a < 2; ++a)
#pragma unroll
            for (int b = 0; b < 2; ++b)
#pragma unroll
                for (int m = 0; m < 4; ++m)
#pragma unroll
                    for (int n = 0; n < 2; ++n) acc[a][b][m][n] = (f32x4){0.f, 0.f, 0.f, 0.f};
        cur = nxt; cB = nB; ++ui;
#pragma unroll
        for (int _h = 0; _h < 2; ++_h)
#pragma unroll
            for (int _i = 0; _i < 2; ++_i) cvo[_h][_i] = nvo[_h][_i];
        if (wr == 1) PG8_BAR;
    }
    PG8_WAIT_V(0);
    PG8_BAR;
#undef PG8_SA
#undef PG8_SB
#undef PG8_STAGE
#undef PG8_LDA
#undef PG8_LDB
#undef PG8_MMA
#undef PG8_WAIT_V
#undef PG8_WAIT_L
#undef PG8_BAR
#undef PG8_SCHED
#undef PG8_AOFF
}
}
template <class E4> DI void fast_gemm(const Ctx& C, const bf16* A, int lda, const bf16* Bt, int K, int nM, int nN, const E4& e) {
    pg8::Gemm g{A, Bt, lda, K, nullptr}; pg8::OrderMN S{nM, nN, C.nb, C.vcu}; pg8::EpiAdapt<E4> E{e};
    pg8::gemm_phase(C.lds, g, S, E, C.tid);
}

DI int swap23(int x) { return (x & ~12) | ((x & 4) << 1) | ((x & 8) >> 1); }
template <int DQK, bool NAT>
DI void flash_range(f32x16 (&o)[2], float& m, float& l, const bf16x8 (&qf)[DQK / 16], const bf16* __restrict__ Kb, const bf16* __restrict__ Vt, int pos0, int nblk, int r, int h,
                    const LAS float* tab, int qc, int cs, int drow0) {
    const int kr = swap23(r);
    for (int blk = 0; blk < nblk; ++blk) {
        const int pos = pos0 + 32 * blk;
        f32x16 s;
#pragma unroll
        for (int i = 0; i < 16; ++i) s[i] = 0.f;
        const bf16* kp = Kb + (size_t)(pos + kr) * DQK + 8 * h;
#pragma unroll
        for (int kk = 0; kk < DQK / 16; ++kk) s = MFMA32(*(const bf16x8*)(kp + 16 * kk), qf[kk], s);
        if (NAT) {
            const int irow = blk >> 1, cc0 = (blk & 1) * 32;
            const LAS float* trow = tab + (drow0 + irow) * 31;
#pragma unroll
            for (int i = 0; i < 16; ++i) {
                const int kib = (i & 3) | (((i >> 2) & 1) << 2) | (h << 3) | ((i >> 3) << 4);
                const int cc = cc0 + kib; const bool ok = (cc >= cs) && (cc < cs + 16);
                int dc = cc - qc + 15; dc = dc < 0 ? 0 : (dc > 30 ? 30 : dc);
                s[i] = ok ? s[i] + trow[dc] : -1e30f;
            }
        }
        float mx = s[0];
#pragma unroll
        for (int i = 1; i < 16; ++i) mx = fmaxf(mx, s[i]);
        mx = fmaxf(mx, xor32(mx, r + 32 * h));
        const float mn = fmaxf(m, mx), alpha = __builtin_amdgcn_exp2f(m - mn);
        float rs = 0.f; f32x16 p;
#pragma unroll
        for (int i = 0; i < 16; ++i) { float e = __builtin_amdgcn_exp2f(s[i] - mn); if (NAT) e = (s[i] > -1e29f) ? e : 0.f; p[i] = e; rs += e; }
        rs += xor32(rs, r + 32 * h);
        l = l * alpha + rs; m = mn;
#pragma unroll
        for (int i = 0; i < 16; ++i) { o[0][i] *= alpha; o[1][i] *= alpha; }
#pragma unroll
        for (int s2 = 0; s2 < 2; ++s2) {
            u32x4 pw; pw.x = pk2(p[8 * s2], p[8 * s2 + 1]); pw.y = pk2(p[8 * s2 + 2], p[8 * s2 + 3]); pw.z = pk2(p[8 * s2 + 4], p[8 * s2 + 5]); pw.w = pk2(p[8 * s2 + 6], p[8 * s2 + 7]);
            const bf16x8 pb = __builtin_bit_cast(bf16x8, pw);
#pragma unroll
            for (int dt = 0; dt < 2; ++dt) { const bf16x8 va = *(const bf16x8*)(Vt + (size_t)(32 * dt + r) * KPOS + pos + 16 * s2 + 8 * h); o[dt] = MFMA32(va, pb, o[dt]); }
        }
    }
}
DI void flash_store(const f32x16 (&o)[2], float l, bf16* orow  , int h) {
    const float inv = 1.f / l;
#pragma unroll
    for (int dt = 0; dt < 2; ++dt)
#pragma unroll
        for (int g = 0; g < 4; ++g)
            *(u32x2*)(orow + 32 * dt + 8 * g + 4 * h) = (u32x2){pk2(o[dt][4 * g] * inv, o[dt][4 * g + 1] * inv), pk2(o[dt][4 * g + 2] * inv, o[dt][4 * g + 3] * inv)};
}

DI void ph_attn_mla(const Ctx& C, const bf16* QB, const bf16* KB, const bf16* VT, bf16* OCAT, bool last) {
    const int r = C.lane & 31, h = C.lane >> 5;
    for (int u = C.vcu; u < 64 * 17; u += C.nb) {
        const int bh = u / 17, qblk = u % 17, b = bh >> 3, hh = bh & 7;
        if (last && qblk == 16) continue;
        const int qpos = qblk * 256 + 32 * C.wave + r;
        const bf16* qp = QB + ((size_t)bh * KPOS + qpos) * 96 + 8 * h;
        bf16x8 qf[6];
#pragma unroll
        for (int kk = 0; kk < 6; ++kk) qf[kk] = *(const bf16x8*)(qp + 16 * kk);
        f32x16 o[2];
#pragma unroll
        for (int i = 0; i < 16; ++i) { o[0][i] = 0.f; o[1][i] = 0.f; }
        float m = -1e30f, l = 0.f;
        flash_range<96, false>(o, m, l, qf, KB + (size_t)bh * KPOS * 96, VT + (size_t)bh * 64 * KPOS, qblk < 16 ? 0 : TL, qblk < 16 ? KPOS / 32 : LCX / 32, r, h, nullptr, 0, 0, 0);
        const int row = qblk < 16 ? b * TL + qpos : NLAT + b * LCX + (qpos - TL);
        flash_store(o, l, OCAT + (size_t)row * DM + hh * 64, h);
    }
}
DI void ph_natten(const Ctx& C, const bf16* QN, const bf16* KN, const bf16* VTN, bf16* OCAT, const float* rpb  , bool last) {
    const int r = C.lane & 31, h = C.lane >> 5;
    LAS float* tab = (LAS float*)C.lds;
    const int nunits = 1024 + (last ? 0 : 64);
    for (int u = C.vcu; u < nunits; u += C.nb) {
        const bool isctx = u >= 1024;
        const int bh = isctx ? u - 1024 : (u >> 4), b = bh >> 3, hh = bh & 7;
        __syncthreads();
        for (int i = C.tid; i < 465; i += 512) tab[i] = rpb[hh * 465 + i] * LOG2E;
        __syncthreads();
        int qpos, row, grow = 0, qc = 0, rs = 0, cs = 0;
        if (!isctx) { const int rg = u & 15; grow = 4 * rg + (C.wave >> 1); qc = 32 * (C.wave & 1) + r; qpos = grow * 64 + qc; row = b * TL + qpos;
            rs = grow - 4; rs = rs < 0 ? 0 : (rs > 56 ? 56 : rs); cs = qc - 8; cs = cs < 0 ? 0 : (cs > 48 ? 48 : cs); }
        else { qpos = TL + 32 * C.wave + r; row = NLAT + b * LCX + 32 * C.wave + r; }
        const bf16* qp = QN + ((size_t)bh * KPOS + qpos) * 64 + 8 * h;
        bf16x8 qf[4];
#pragma unroll
        for (int kk = 0; kk < 4; ++kk) qf[kk] = *(const bf16x8*)(qp + 16 * kk);
        f32x16 o[2];
#pragma unroll
        for (int i = 0; i < 16; ++i) { o[0][i] = 0.f; o[1][i] = 0.f; }
        float m = -1e30f, l = 0.f;
        const bf16* Kb = KN + (size_t)bh * KPOS * 64; const bf16* Vt = VTN + (size_t)bh * 64 * KPOS;
        if (!isctx) flash_range<64, true>(o, m, l, qf, Kb, Vt, rs * 64, 16, r, h, tab, qc, cs, rs - grow + 7);
        flash_range<64, false>(o, m, l, qf, Kb, Vt, TL, LCX / 32, r, h, nullptr, 0, 0, 0);
        flash_store(o, l, OCAT + (size_t)row * DM + 512 + hh * 64, h);
    }
}

DI void ph_mla_fin(const Ctx& C, const bf16* U, const float* QPRE, const float* KVPRE, const float* qg, const float* kg, const f32x2* CS, bf16* QB, bf16* KB, bf16* VT) {
    LAS bf16* VL = (LAS bf16*)C.lds;
    const int lane = C.lane, hh = lane >> 3, sub = lane & 7;
    const float C2 = 0.10206207261596575f * LOG2E;
    for (int u = C.vcu; u < MT / 64; u += C.nb) {
        const int row0 = 64 * u, b = row0 < NLAT ? (row0 >> 12) : ((row0 - NLAT) >> 8), pos0 = row0 < NLAT ? (row0 & 4095) : TL + ((row0 - NLAT) & 255);
        const bool lat = row0 < NLAT;
        for (int i = 0; i < 8; ++i) {
            const int pl = 8 * C.wave + i, row = row0 + pl, pos = pos0 + pl;
            const bf16* ur = U + (size_t)row * EV_INP;
            float sq = 0.f, skv = 0.f;
#pragma unroll
            for (int mq = 0; mq < 6; ++mq) { const float x = bf2f(ur[lane + 64 * mq]); sq += x * x; }
#pragma unroll
            for (int mq = 0; mq < 4; ++mq) { const float x = bf2f(ur[384 + lane + 64 * mq]); skv += x * x; }
            sq = wave_sum(sq); skv = wave_sum(skv);
            const float rsq = 1.0f / sqrtf(sq * (1.f / 384.f) + EPS), rskv = 1.0f / sqrtf(skv * (1.f / 256.f) + EPS);
            float cr = 1.f, sr = 0.f, cc = 1.f, sc = 0.f;
            if (lat) { const f32x2 a0 = CS[pos * 16 + sub], a1 = CS[pos * 16 + 8 + sub]; cr = a0.x; sr = a0.y; cc = a1.x; sc = a1.y; }
            float qv[12]; float ss = 0.f;
#pragma unroll
            for (int mq = 0; mq < 12; ++mq) { qv[mq] = QPRE[(size_t)row * 768 + hh * 96 + sub + 8 * mq] * rsq; ss += qv[mq] * qv[mq]; }
            ss = sum8(ss);
            float rn = 1.0f / sqrtf(ss * (1.f / 96.f) + EPS);
#pragma unroll
            for (int mq = 0; mq < 12; ++mq) qv[mq] = qv[mq] * rn * qg[sub + 8 * mq];
            { const float x0 = qv[8], x1 = qv[9], y0 = qv[10], y1 = qv[11]; qv[8] = x0 * cr - x1 * sr; qv[9] = x1 * cr + x0 * sr; qv[10] = y0 * cc - y1 * sc; qv[11] = y1 * cc + y0 * sc; }
            bf16* qo = QB + ((size_t)(b * 8 + hh) * KPOS + pos) * 96 + sub;
#pragma unroll
            for (int mq = 0; mq < 12; ++mq) qo[8 * mq] = f2bf(qv[mq] * C2);
            float kv[12]; ss = 0.f;
#pragma unroll
            for (int mq = 0; mq < 8; ++mq) kv[mq] = KVPRE[(size_t)row * 1024 + hh * 128 + sub + 8 * mq] * rskv;
#pragma unroll
            for (int mq = 8; mq < 12; ++mq) kv[mq] = bf2f(ur[640 + sub + 8 * (mq - 8)]);
#pragma unroll
            for (int mq = 0; mq < 12; ++mq) ss += kv[mq] * kv[mq];
            ss = sum8(ss);
            rn = 1.0f / sqrtf(ss * (1.f / 96.f) + EPS);
#pragma unroll
            for (int mq = 0; mq < 12; ++mq) kv[mq] = kv[mq] * rn * kg[sub + 8 * mq];
            { const float x0 = kv[8], x1 = kv[9], y0 = kv[10], y1 = kv[11]; kv[8] = x0 * cr - x1 * sr; kv[9] = x1 * cr + x0 * sr; kv[10] = y0 * cc - y1 * sc; kv[11] = y1 * cc + y0 * sc; }
            bf16* ko = KB + ((size_t)(b * 8 + hh) * KPOS + pos) * 96 + sub;
#pragma unroll
            for (int mq = 0; mq < 12; ++mq) ko[8 * mq] = f2bf(kv[mq]);
#pragma unroll
            for (int mq = 0; mq < 8; ++mq) { const int dv = sub + 8 * mq; VL[(hh * 64 + dv) * 64 + pl] = f2bf(KVPRE[(size_t)row * 1024 + hh * 128 + 64 + dv] * rskv); }
        }
        __syncthreads();
        { const int hd = C.tid;
            bf16* dst = VT + ((size_t)(b * 8 + (hd >> 6)) * 64 + (hd & 63)) * KPOS + pos0;
#pragma unroll
            for (int q = 0; q < 8; ++q) *(u32x4*)(dst + 8 * q) = *(const LAS u32x4*)(VL + hd * 64 + 8 * q); }
        __syncthreads();
    }
}

DI void ph_conv(const Ctx& C, const bf16* U, const float* dww  , const float* dwb, const float* lng, const float* lnb, bf16* OCAT) {
    LAS float* G = (LAS float*)C.lds;
    const int c = C.tid;
    float wk[31];
#pragma unroll
    for (int k = 0; k < 31; ++k) wk[k] = dww[k * 512 + c];
    const float bias = dwb[c];
    for (int u = C.vcu; u < MT / 32; u += C.nb) {
        const int row0 = 32 * u; int base, t0, tseq;
        if (row0 < NLAT) { base = row0 & ~4095; t0 = row0 & 4095; tseq = TL; } else { const int rc = row0 - NLAT; base = NLAT + (rc & ~255); t0 = rc & 255; tseq = LCX; }
        __syncthreads();
        for (int rr = 0; rr < 62; ++rr) { const int tt = t0 - 15 + rr; float g = 0.f;
            if (tt >= 0 && tt < tseq) { const bf16* ur = U + (size_t)(base + tt) * EV_INP; g = bf2f(ur[672 + c]) * sigmoidf_(bf2f(ur[1184 + c])); }
            G[rr * 512 + c] = g; }
        __syncthreads();
        float acc[32];
#pragma unroll
        for (int t = 0; t < 32; ++t) acc[t] = bias;
#pragma unroll
        for (int rr = 0; rr < 62; ++rr) { const float gv = G[rr * 512 + c];
#pragma unroll
            for (int t = 0; t < 32; ++t) { const int k = rr - t; if (k >= 0 && k < 31) acc[t] += gv * wk[k]; } }
        __syncthreads();
#pragma unroll
        for (int t = 0; t < 32; ++t) G[t * 512 + c] = acc[t];
        __syncthreads();
#pragma unroll
        for (int q = 0; q < 4; ++q) {
            const int t = 4 * C.wave + q, row = row0 + t;
            const f32x4 a0 = *(const LAS f32x4*)(G + t * 512 + 8 * C.lane), a1 = *(const LAS f32x4*)(G + t * 512 + 8 * C.lane + 4);
            float x[8] = {a0.x, a0.y, a0.z, a0.w, a1.x, a1.y, a1.z, a1.w}; float s = 0.f;
#pragma unroll
            for (int e = 0; e < 8; ++e) s += x[e];
            const float mu = wave_sum(s) * (1.f / 512.f); float s2 = 0.f;
#pragma unroll
            for (int e = 0; e < 8; ++e) { x[e] -= mu; s2 += x[e] * x[e]; }
            const float rstd = 1.0f / sqrtf(wave_sum(s2) * (1.f / 512.f) + EPS);
            float y[8];
#pragma unroll
            for (int e = 0; e < 8; ++e) { const float z = x[e] * rstd * lng[8 * C.lane + e] + lnb[8 * C.lane + e]; y[e] = siluf_(z); }
            *(u32x4*)(OCAT + (size_t)row * DM + 512 + 8 * C.lane) = pack8(y);
        }
    }
}

DI void shifted8(const bf16* up, const bf16* uc, const bf16* un, bool hp, bool hn, const float* sw, int c0, float (&o)[8]) {
    const u32x4 z = {0u, 0u, 0u, 0u};
    const u32x4 vp = hp ? *(const u32x4*)(up + c0) : z, vc = *(const u32x4*)(uc + c0), vn = hn ? *(const u32x4*)(un + c0) : z;
    float p[8], c[8], n[8]; unpack8(vp, p); unpack8(vc, c); unpack8(vn, n);
#pragma unroll
    for (int e = 0; e < 8; ++e) o[e] = p[e] * sw[c0 + e] + c[e] * sw[RW_IN + c0 + e] + n[e] * sw[2 * RW_IN + c0 + e];
}
DI void ph_prep(const Ctx& C, const bf16* U, const float* sw  , const float* kkw  , const float* naqg, const float* nakg,
                bf16* R, bf16* V, bf16* K, bf16* KK, bf16* L, bf16* QN, bf16* KN, bf16* VTN) {
    LAS bf16* VL = (LAS bf16*)C.lds;
    const int lane = C.lane, hh = lane >> 3, sub = lane & 7;
    const float C2 = 0.125f * LOG2E;
    for (int u = C.vcu; u < MT / 64; u += C.nb) {
        const int row0 = 64 * u; const bool lat = row0 < NLAT;
        const int b = lat ? (row0 >> 12) : ((row0 - NLAT) >> 8), pos0 = lat ? (row0 & 4095) : TL + ((row0 - NLAT) & 255), tseq = lat ? TL : LCX, tb = lat ? (row0 & 4095) : ((row0 - NLAT) & 255);
        for (int i = 0; i < 8; ++i) {
            const int pl = 8 * C.wave + i, row = row0 + pl, pos = pos0 + pl, t = tb + pl;
            const bool hp = t > 0, hn = t < tseq - 1;
            const bf16* uc = U + (size_t)row * OD_INP; const bf16* up = uc - OD_INP; const bf16* un = uc + OD_INP;
            float o[8];
            shifted8(up, uc, un, hp, hn, sw, 8 * lane, o);          *(u32x4*)(R + (size_t)row * 512 + 8 * lane) = pack8(o);
            shifted8(up, uc, un, hp, hn, sw, 1024 + 8 * lane, o);   *(u32x4*)(V + (size_t)row * 512 + 8 * lane) = pack8(o);
            shifted8(up, uc, un, hp, hn, sw, 512 + 8 * lane, o);    *(u32x4*)(K + (size_t)row * 512 + 8 * lane) = pack8(o);
            { float kk[8]; float ss = 0.f;
#pragma unroll
                for (int e = 0; e < 8; ++e) { kk[e] = o[e] * kkw[8 * lane + e]; ss += kk[e] * kk[e]; }
                ss = sum8(ss); const float rn = 1.0f / sqrtf(ss + 1e-12f);
#pragma unroll
                for (int e = 0; e < 8; ++e) kk[e] *= rn;
                *(u32x4*)(KK + (size_t)row * 512 + 8 * lane) = pack8(kk); }
            if (lane < 48) {
                shifted8(up, uc, un, hp, hn, sw, 1536 + 8 * lane, o);
                if (lane < 16) {
#pragma unroll
                    for (int e = 0; e < 8; ++e) { const float ex = __expf(2.f * o[e]); o[e] = 1.f - 2.f / (ex + 1.f); }
                } else if (lane >= 32) {
#pragma unroll
                    for (int e = 0; e < 8; ++e) o[e] = sigmoidf_(o[e]);
                }
                *(u32x4*)(L + (size_t)row * 384 + 8 * lane) = pack8(o);
            }
            { float x[8]; unpack8(*(const u32x4*)(uc + RW_IN + 8 * lane), x); float ss = 0.f;
#pragma unroll
                for (int e = 0; e < 8; ++e) ss += x[e] * x[e];
                ss = sum8(ss); const float rn = 1.0f / sqrtf(ss * (1.f / 64.f) + EPS);
#pragma unroll
                for (int e = 0; e < 8; ++e) x[e] = x[e] * rn * naqg[8 * sub + e] * C2;
                *(u32x4*)(QN + ((size_t)(b * 8 + hh) * KPOS + pos) * 64 + 8 * sub) = pack8(x); }
            { float x[8]; unpack8(*(const u32x4*)(uc + RW_IN + 512 + 8 * lane), x); float ss = 0.f;
#pragma unroll
                for (int e = 0; e < 8; ++e) ss += x[e] * x[e];
                ss = sum8(ss); const float rn = 1.0f / sqrtf(ss * (1.f / 64.f) + EPS);
#pragma unroll
                for (int e = 0; e < 8; ++e) x[e] = x[e] * rn * nakg[8 * sub + e];
                *(u32x4*)(KN + ((size_t)(b * 8 + hh) * KPOS + pos) * 64 + 8 * sub) = pack8(x); }
            { const u32x4 vv = *(const u32x4*)(uc + RW_IN + 1024 + 8 * lane); const unsigned w4[4] = {vv.x, vv.y, vv.z, vv.w};
#pragma unroll
                for (int e = 0; e < 8; ++e) { const int dv = 8 * sub + e; VL[(hh * 64 + dv) * 64 + pl] = (bf16)((e & 1) ? (w4[e >> 1] >> 16) : (w4[e >> 1] & 0xffffu)); } }
        }
        __syncthreads();
        { const int hd = C.tid; bf16* dst = VTN + ((size_t)(b * 8 + (hd >> 6)) * 64 + (hd & 63)) * KPOS + pos0;
#pragma unroll
            for (int q = 0; q < 8; ++q) *(u32x4*)(dst + 8 * q) = *(const LAS u32x4*)(VL + hd * 64 + 8 * q); }
        __syncthreads();
    }
}

DI int scan_row(int s, int d, int b) { if (s < LCX) return NLAT + b * LCX + (d ? (LCX - 1 - s) : s); const int t = s - LCX; return b * TL + (d ? (TL - 1 - t) : t); }
DI void ph_scan(const Ctx& C, const bf16* R, const bf16* V, const bf16* KK, const float* W, const bf16* KEFF, const bf16* BSC, float* YS) {
    constexpr int CH = 32, BUF = 5 * CH * 64 + CH * 32;
    LAS float* lds = (LAS float*)C.lds;
    LAS float* ystage = lds + 2 * BUF;
    const int tid = C.tid, i = tid >> 4, kq = tid & 15;
    for (int cid = C.bid; cid < 256; cid += C.nb) {
        const int b = cid >> 5, hh = (cid >> 2) & 7, d = (cid >> 1) & 1, hf = cid & 1;
        const float* Wd = W + (size_t)d * MT * 512; const bf16* KEd = KEFF + (size_t)d * MT * 512; const bf16* BSd = BSC + (size_t)d * MT * 512; float* Yd = YS + (size_t)d * MT * 512;
        float S[4] = {0.f, 0.f, 0.f, 0.f};
        const int sl = tid >> 4, sub = tid & 15;
        f32x4 lw; u32x4 l1, l2, l3;
        auto issue = [&](int ck) {
            const int row = scan_row(ck * CH + sl, d, b);
            lw = *(const f32x4*)(Wd + (size_t)row * 512 + hh * 64 + 4 * sub);
            if (sub < 8) { l1 = *(const u32x4*)(R + (size_t)row * 512 + hh * 64 + 8 * sub); l2 = *(const u32x4*)(KEd + (size_t)row * 512 + hh * 64 + 8 * sub); }
            else { l1 = *(const u32x4*)(KK + (size_t)row * 512 + hh * 64 + 8 * (sub - 8)); l2 = *(const u32x4*)(BSd + (size_t)row * 512 + hh * 64 + 8 * (sub - 8)); }
            if (sub < 4) l3 = *(const u32x4*)(V + (size_t)row * 512 + hh * 64 + 32 * hf + 8 * sub);
        };
        auto commit = [&](int bufi) {
            LAS float* B = lds + bufi * BUF;
            *(LAS f32x4*)(B + (1 * CH + sl) * 64 + 4 * sub) = lw;
            float f1[8], f2[8]; unpack8(l1, f1); unpack8(l2, f2);
            const int a1 = sub < 8 ? 0 : 3, a2 = sub < 8 ? 2 : 4, off = 8 * (sub & 7);
            *(LAS f32x4*)(B + (a1 * CH + sl) * 64 + off) = (f32x4){f1[0], f1[1], f1[2], f1[3]}; *(LAS f32x4*)(B + (a1 * CH + sl) * 64 + off + 4) = (f32x4){f1[4], f1[5], f1[6], f1[7]};
            *(LAS f32x4*)(B + (a2 * CH + sl) * 64 + off) = (f32x4){f2[0], f2[1], f2[2], f2[3]}; *(LAS f32x4*)(B + (a2 * CH + sl) * 64 + off + 4) = (f32x4){f2[4], f2[5], f2[6], f2[7]};
            if (sub < 4) { float f3[8]; unpack8(l3, f3); LAS float* vp = B + 5 * CH * 64 + sl * 32 + 8 * sub;
                *(LAS f32x4*)vp = (f32x4){f3[0], f3[1], f3[2], f3[3]}; *(LAS f32x4*)(vp + 4) = (f32x4){f3[4], f3[5], f3[6], f3[7]}; }
        };
        __syncthreads();
        issue(0); commit(0);
        __syncthreads();
        constexpr int NCK = KPOS / CH;
        for (int ck = 0; ck < NCK; ++ck) {
            if (ck + 1 < NCK) issue(ck + 1);
            const LAS float* B = lds + (ck & 1) * BUF; LAS float* ys = ystage + (ck & 1) * CH * 32;
#pragma unroll 4
            for (int s = 0; s < CH; ++s) {
                const f32x4 rr = *(const LAS f32x4*)(B + (0 * CH + s) * 64 + 4 * kq), ww = *(const LAS f32x4*)(B + (1 * CH + s) * 64 + 4 * kq), ke = *(const LAS f32x4*)(B + (2 * CH + s) * 64 + 4 * kq),
                            kk = *(const LAS f32x4*)(B + (3 * CH + s) * 64 + 4 * kq), bs = *(const LAS f32x4*)(B + (4 * CH + s) * 64 + 4 * kq);
                const float v = B[5 * CH * 64 + s * 32 + i];
                float sa = -(S[0] * kk.x + S[1] * kk.y + S[2] * kk.z + S[3] * kk.w);
                sa = sum16(sa);
                S[0] = S[0] * ww.x + (sa * bs.x + v * ke.x); S[1] = S[1] * ww.y + (sa * bs.y + v * ke.y); S[2] = S[2] * ww.z + (sa * bs.z + v * ke.z); S[3] = S[3] * ww.w + (sa * bs.w + v * ke.w);
                float y = S[0] * rr.x + S[1] * rr.y + S[2] * rr.z + S[3] * rr.w;
                y = sum16(y);
                if (kq == 0) ys[s * 32 + i] = y;
            }
            if (ck + 1 < NCK) commit((ck + 1) & 1);
            __syncthreads();
            if (tid < 256) { const int s = tid >> 3, q = tid & 7; const int row = scan_row(ck * CH + s, d, b);
                *(f32x4*)(Yd + (size_t)row * 512 + hh * 64 + 32 * hf + 4 * q) = *(const LAS f32x4*)(ys + s * 32 + 4 * q); }
        }
    }
}

DI void ph_post(const Ctx& C, const float* YS, const bf16* R, const bf16* V, const bf16* KEFF, const bf16* G, const float* rk, const float* gng, const float* gnb, bf16* OCAT, bool last) {
    const int gw = C.bid * 8 + C.wave, ngw = C.nb * 8, lane = C.lane, nrows = last ? NLAT : MT;
    for (int row = gw; row < nrows; row += ngw) {
        const size_t o = (size_t)row * 512 + 8 * lane;
        const f32x4 y0a = *(const f32x4*)(YS + o), y0b = *(const f32x4*)(YS + o + 4), y1a = *(const f32x4*)(YS + (size_t)MT * 512 + o), y1b = *(const f32x4*)(YS + (size_t)MT * 512 + o + 4);
        float y[8] = {y0a.x + y1a.x, y0a.y + y1a.y, y0a.z + y1a.z, y0a.w + y1a.w, y0b.x + y1b.x, y0b.y + y1b.y, y0b.z + y1b.z, y0b.w + y1b.w};
        float r[8], v[8], k0[8], k1[8], g[8];
        unpack8(*(const u32x4*)(R + o), r); unpack8(*(const u32x4*)(V + o), v); unpack8(*(const u32x4*)(KEFF + o), k0); unpack8(*(const u32x4*)(KEFF + (size_t)MT * 512 + o), k1); unpack8(*(const u32x4*)(G + o), g);
        float bsum = 0.f;
#pragma unroll
        for (int e = 0; e < 8; ++e) bsum += r[e] * (k0[e] + k1[e]) * rk[8 * lane + e];
        bsum = sum8(bsum);
        float s = 0.f;
#pragma unroll
        for (int e = 0; e < 8; ++e) { y[e] += bsum * v[e]; s += y[e]; }
        const float mu = sum8(s) * (1.f / 64.f); float s2 = 0.f;
#pragma unroll
        for (int e = 0; e < 8; ++e) { y[e] -= mu; s2 += y[e] * y[e]; }
        const float rstd = 1.0f / sqrtf(sum8(s2) * (1.f / 64.f) + GN_EPS);
        float out[8];
#pragma unroll
        for (int e = 0; e < 8; ++e) out[e] = (y[e] * rstd * gng[8 * lane + e] + gnb[8 * lane + e]) * g[e];
        *(u32x4*)(OCAT + (size_t)row * DM + 8 * lane) = pack8(out);
    }
}

DI void ph_topk(const Ctx& C, const float* AFFT, const float* AFFC, int* ROWS, float* GATE, int* SLOT, bool last) {
    LAS unsigned long long* key = (LAS unsigned long long*)C.lds;
    const int nprob = last ? 128 : 256;
    for (int p = C.bid; p < nprob; p += C.nb) {
        const bool isctx = p >= 128; const int be = p & 127, b = be >> 4, e = be & 15;
        const int n = isctx ? LCX : TL, cap = isctx ? CAPC : CAPL;
        const float* src = isctx ? AFFC + (size_t)be * LCX : AFFT + (size_t)be * TL;
        __syncthreads();
        for (int t = C.tid; t < n; t += 512) key[t] = ((unsigned long long)__builtin_bit_cast(unsigned, src[t]) << 32) | (unsigned long long)(0xFFFFFFFFu - (unsigned)t);
        __syncthreads();
        for (int k = 2; k <= n; k <<= 1)
            for (int j = k >> 1; j > 0; j >>= 1) {
                for (int q = C.tid; q < n / 2; q += 512) {
                    const int i = ((q & ~(j - 1)) << 1) | (q & (j - 1)), ix = i | j;
                    const unsigned long long a = key[i], bb = key[ix];
                    const bool desc = ((i & k) == 0);
                    if (desc ? (a < bb) : (a > bb)) { key[i] = bb; key[ix] = a; }
                }
                __syncthreads();
            }
        for (int jx = C.tid; jx < cap; jx += 512) {
            const unsigned long long kv = key[jx]; const int t = (int)(0xFFFFFFFFu - (unsigned)(kv & 0xFFFFFFFFull)); const float g = __builtin_bit_cast(float, (unsigned)(kv >> 32));
            const int slot = isctx ? NB * CAPL + b * CAPC + jx : b * CAPL + jx, row = isctx ? NLAT + b * LCX + t : b * TL + t;
            ROWS[e * ESLOTS + slot] = row; GATE[e * ESLOTS + slot] = g; SLOT[(size_t)row * 16 + e] = slot;
        }
    }
}

DI void ph_combine(const Ctx& C, float* xlat, float* xctx, const float* modg2  , const int* SLOT, const bf16* Y2, bool last) {
    const int gw = C.bid * 8 + C.wave, ngw = C.nb * 8, lane = C.lane, nrows = last ? NLAT : MT;
    for (int row = gw; row < nrows; row += ngw) {
        float* xr = row < NLAT ? xlat + (size_t)row * DM : xctx + (size_t)(row - NLAT) * DM;
        const int mi = row < NLAT ? (row >> 12) : 8;
        const int sv = SLOT[(size_t)row * 16 + (lane & 15)];
        f32x4 acc[4];
#pragma unroll
        for (int j = 0; j < 4; ++j) acc[j] = (f32x4){0.f, 0.f, 0.f, 0.f};
#pragma unroll
        for (int e = 0; e < 16; ++e) {
            const int s = __builtin_amdgcn_readlane(sv, e);
            if (s >= 0) { const bf16* yp = Y2 + ((size_t)e * ESLOTS + s) * DM + 4 * lane;
#pragma unroll
                for (int j = 0; j < 4; ++j) { const u32x2 w = *(const u32x2*)(yp + 256 * j); acc[j] += (f32x4){bflo(w.x), bfhi(w.x), bflo(w.y), bfhi(w.y)}; } }
        }
#pragma unroll
        for (int j = 0; j < 4; ++j) { const int c = 256 * j + 4 * lane; const f32x4 g = *(const f32x4*)(modg2 + mi * 6144 + c); f32x4 x = *(const f32x4*)(xr + c); x += g * acc[j]; *(f32x4*)(xr + c) = x; }
    }
}

template <class T> DI T* launder_ptr(T* p) { unsigned long long v = (unsigned long long)p; unsigned lo = (unsigned)v, hi = (unsigned)(v >> 32); asm volatile("" : "+v"(lo), "+v"(hi));
    lo = __builtin_amdgcn_readfirstlane(lo); hi = __builtin_amdgcn_readfirstlane(hi); return (T*)(__attribute__((address_space(1))) T*)(((unsigned long long)hi << 32) | lo); }
constexpr int PH_PER_PAIR = 24, N_PHASES = 1 + 2 * PH_PER_PAIR;
constexpr size_t WS_PTRS = 128 * 1024;
#define P_XC    ((float*)(ws + WS_XC))
#define P_MOD   ((const float*)(ws + WS_MOD))
#define P_HB    ((bf16*)(ws + WS_HB))
#define P_OCAT  ((bf16*)(ws + WS_OCAT))
#define P_AR    (ws + WS_ARENA)
#define P_ROWS  ((int*)(ws + WS_ROWS))
#define P_GATE  ((float*)(ws + WS_GATE))
#define P_SLOT  ((int*)(ws + WS_SLOT))
#define P_AFFT  ((float*)(ws + WS_AFFT))
#define P_AFFC  ((float*)(ws + WS_AFFC))
#define P_W13   ((bf16*)(ws + WS_W13))
#define P_W2    ((bf16*)(ws + WS_W2))
#define P_U     ((bf16*)(P_AR + A_U))
#define P_QPRE  ((float*)(P_AR + A_QPRE))
#define P_KVPRE ((float*)(P_AR + A_KVPRE))
#define P_QB    ((bf16*)(P_AR + A_QB))
#define P_KB    ((bf16*)(P_AR + A_KB))
#define P_VT    ((bf16*)(P_AR + A_VT))
#define P_W     ((float*)(P_AR + A_W))
#define P_KEFF  ((bf16*)(P_AR + A_KEFF))
#define P_BSC   ((bf16*)(P_AR + A_BSC))
#define P_R     ((bf16*)(P_AR + A_R))
#define P_V     ((bf16*)(P_AR + A_V))
#define P_KK    ((bf16*)(P_AR + A_KK))
#define P_G     ((bf16*)(P_AR + A_G))
#define P_K     ((bf16*)(P_AR + A_K))
#define P_L     ((bf16*)(P_AR + A_L))
#define P_QN    ((bf16*)(P_AR + A_QN))
#define P_KN    ((bf16*)(P_AR + A_KN))
#define P_VTN   ((bf16*)(P_AR + A_VTN))
#define P_YS    ((float*)(P_AR + A_YS))
#define P_HID   ((bf16*)(P_AR + A_HID))
#define P_Y2    ((bf16*)(P_AR + A_Y2))
#define MODL(i) (P_MOD + (size_t)(i) * 9 * 6144)
#define RELAUNDER() do { int l_ = C.lane; asm volatile("" : "+v"(l_)); C.lane = l_; C.tid = (C.wave << 6) | l_; } while (0)
__global__ void __launch_bounds__(512, 2) fwd_kernel(Args a) {
    extern __shared__ __attribute__((aligned(16))) unsigned char smem[];
    Ctx C0; C0.lds = (LAS unsigned char*)smem; C0.tid = threadIdx.x; C0.lane = C0.tid & 63; C0.wave = __builtin_amdgcn_readfirstlane(C0.tid >> 6); C0.bid = blockIdx.x; C0.nb = gridDim.x;
    C0.vcu = (C0.nb % 8 == 0) ? (C0.bid % 8) * (C0.nb / 8) + C0.bid / 8 : C0.bid;
    volatile LAS unsigned* bst = (volatile LAS unsigned*)(C0.lds + LDS_BYTES - 16);
#if MEGA
    if (C0.tid == 0) { bst[0] = 0u; bst[1] = 0u; }
    __syncthreads();
    const unsigned bar_x = xcd_barrier_post((unsigned*)(a.ws + WS_CTL) + 4096, bst, C0.tid == 0).x;
#define SEAM() do { if (ph < hi) { XcdBarrier b2_; b2_.bar = launder_ptr((unsigned*)(a.ws + WS_CTL) + 4096); b2_.x = bar_x; b2_.st = bst; xcd_barrier(b2_, C.tid == 0); } } while (0)
#else
#define SEAM() do { } while (0)
#endif
#if MEGA
    constexpr int lo = 0, hi = N_PHASES;
#else
    const int lo = a.ph_lo, hi = a.ph_hi;
#endif
    int ph = 0;
#ifndef ONLY
#define ONLY -1
#endif
#ifndef SITE_LO
#define SITE_LO 0
#define SITE_HI 99
#endif
#define PHASE(SITE, ...) do { if ((ONLY < 0 || ONLY == (SITE)) && (SITE) >= SITE_LO && (SITE) <= SITE_HI && ph >= lo && ph < hi) { Ctx C; C.lds = C0.lds; \
        { int w_ = C0.wave; asm volatile("" : "+s"(w_)); unsigned m_ = ~0u; asm volatile("" : "+s"(m_)); int l_ = (int)__builtin_amdgcn_mbcnt_hi(m_, __builtin_amdgcn_mbcnt_lo(m_, 0u)); C.wave = w_; C.lane = l_; C.tid = (w_ << 6) | l_; } \
        { int b_ = C0.bid, n_ = C0.nb, v_ = C0.vcu; asm volatile("" : "+s"(b_), "+s"(n_), "+s"(v_)); C.bid = b_; C.nb = n_; C.vcu = v_; } \
        unsigned char* ws = launder_ptr(a.ws); float* XL = launder_ptr(a.out); const int lq = __builtin_amdgcn_readfirstlane(lp); typedef const __attribute__((address_space(1))) float* gfp_t; const gfp_t* INT_ = (const gfp_t*)(ws + WS_PTRS); (void)INT_; (void)XL; (void)lq; \
        __VA_ARGS__; ++ph; SEAM(); } else ++ph; } while (0)

    { const int lp = 0;
      PHASE(0, { if (C.bid == 0) { _Pragma("unroll") for (int k = 0; k < 40; ++k) if (C.tid == k) ((const float**)(ws + WS_PTRS))[k] = a.in[k]; }
                 ph_prologue(C, a); }); }

    for (int lp = 0; lp < 2; ++lp) {
        PHASE(1, { const int i = 2 * lq; const float* xl = (i == 0) ? ((const float*)INT_[I_X]) : XL; const float* xc = (i == 0) ? ((const float*)INT_[I_CTX]) : P_XC;
                   ph_norm<false>(C, xl, xc, ((const float*)INT_[I_N1G]) + i * DM, MODL(i), 0, 1024, P_HB, nullptr, nullptr, nullptr, nullptr);
                   moe_weight_prep(C, ((const float*)INT_[I_MW1]) + (size_t)i * NEXP * DM * DM, ((const float*)INT_[I_MW3]) + (size_t)i * NEXP * DM * DM, ((const float*)INT_[I_MW2]) + (size_t)i * NEXP * DM * DM, P_W13, P_W2); });
        PHASE(2, { EpiBf16 E{P_U, EV_INP}; fast_gemm(C, P_HB, DM, (const bf16*)(ws + WS_WEVIN) + (size_t)lq * EV_INP * DM, DM, MT / 256, EV_INP / 256, E); });
        PHASE(3, { EpiF32 Eq{P_QPRE, 768}; fast_gemm(C, P_U, EV_INP, (const bf16*)(ws + WS_WUQ) + (size_t)lq * 768 * 384, 384, MT / 256, 3, Eq); RELAUNDER();
                   EpiF32 Ek{P_KVPRE, 1024}; fast_gemm(C, P_U + 384, EV_INP, (const bf16*)(ws + WS_WUKV) + (size_t)lq * 1024 * 256, 256, MT / 256, 4, Ek); });
        PHASE(4, { ph_mla_fin(C, P_U, P_QPRE, P_KVPRE, ((const float*)INT_[I_QG]) + lq * 96, ((const float*)INT_[I_KG]) + lq * 96, (const f32x2*)(ws + WS_ROPE), P_QB, P_KB, P_VT);
                   ph_conv(C, P_U, ((const float*)INT_[I_DWW]) + (size_t)lq * 31 * 512, ((const float*)INT_[I_DWB]) + lq * 512, ((const float*)INT_[I_LNG]) + lq * 512, ((const float*)INT_[I_LNB]) + lq * 512, P_OCAT); });
        PHASE(5, ph_attn_mla(C, P_QB, P_KB, P_VT, P_OCAT, false));
        PHASE(6, { const int i = 2 * lq; const float* xl = (i == 0) ? ((const float*)INT_[I_X]) : XL; const float* xc = (i == 0) ? ((const float*)INT_[I_CTX]) : P_XC;
                   EpiResid E{xl, xc, XL, P_XC, MODL(i) + 2048}; fast_gemm(C, P_OCAT, DM, (const bf16*)(ws + WS_WEVOUT) + (size_t)lq * DM * DM, DM, MT / 256, 4, E); });
        PHASE(7, { const int i = 2 * lq; ph_norm<true>(C, XL, P_XC, ((const float*)INT_[I_N2G]) + i * DM, MODL(i), 3072, 4096, P_HB, ((const float*)INT_[I_ROUTER]) + (size_t)i * DM * 16, P_AFFT, P_AFFC, P_SLOT); });
        PHASE(8, ph_topk(C, P_AFFT, P_AFFC, P_ROWS, P_GATE, P_SLOT, false));
        PHASE(9, { pg8::Gemm g{P_HB, P_W13, DM, DM, P_ROWS}; pg8::OrderMoE S{17, 8, 17, C.nb, C.vcu}; pg8::EpiAdapt<EpiGlu> E{EpiGlu{P_HID}}; pg8::gemm_phase(C.lds, g, S, E, C.tid); });
        PHASE(10, { pg8::Gemm g{P_HID, P_W2, DM, DM, nullptr}; pg8::OrderMoE S{17, 4, 17, C.nb, C.vcu}; pg8::EpiAdapt<EpiGate> E{EpiGate{P_Y2, P_GATE}}; pg8::gemm_phase(C.lds, g, S, E, C.tid); });
        PHASE(11, { const int i = 2 * lq; ph_combine(C, XL, P_XC, MODL(i) + 5120, P_SLOT, P_Y2, false); });
        PHASE(12, { const int i = 2 * lq + 1; ph_norm<false>(C, XL, P_XC, ((const float*)INT_[I_N1G]) + i * DM, MODL(i), 0, 1024, P_HB, nullptr, nullptr, nullptr, nullptr);
                    moe_weight_prep(C, ((const float*)INT_[I_MW1]) + (size_t)i * NEXP * DM * DM, ((const float*)INT_[I_MW3]) + (size_t)i * NEXP * DM * DM, ((const float*)INT_[I_MW2]) + (size_t)i * NEXP * DM * DM, P_W13, P_W2); });
        PHASE(13, { EpiBf16 E{P_U, OD_INP}; fast_gemm(C, P_HB, DM, (const bf16*)(ws + WS_WODIN) + (size_t)lq * OD_INP * DM, DM, MT / 256, OD_INP / 256, E); });
        PHASE(14, ph_prep(C, P_U, ((const float*)INT_[I_SHIFTW]) + (size_t)lq * 3 * RW_IN, ((const float*)INT_[I_KKW]) + lq * 512, ((const float*)INT_[I_NAQG]) + lq * 64, ((const float*)INT_[I_NAKG]) + lq * 64, P_R, P_V, P_K, P_KK, P_L, P_QN, P_KN, P_VTN));
        PHASE(15, { const bf16* WL = (const bf16*)(ws + WS_WLORA) + (size_t)lq * 196608;
                    for (int u = C.vcu; u < (MT / 256) * 10; u += C.nb) { const int pm = u / 10, q = u % 10;
                        if (q < 4) { const int d = q >> 1, pn = q & 1; EpiLoraW E{P_W + (size_t)d * MT * 512, ((const float*)INT_[I_W0]) + lq * 1024 + d * 512};
                            gemm_unit(P_L + d * 64, 384, nullptr, WL + (size_t)d * 32768, 64, pm, pn, E, C.wave, C.lane); }
                        else if (q < 8) { const int d = (q - 4) >> 1, pn = q & 1; EpiLoraA E{P_KEFF + (size_t)d * MT * 512, P_BSC + (size_t)d * MT * 512, P_K, P_KK, ((const float*)INT_[I_A0]) + lq * 1024 + d * 512, ((const float*)INT_[I_KA]) + lq * 512};
                            gemm_unit(P_L + 128 + d * 64, 384, nullptr, WL + 65536 + (size_t)d * 32768, 64, pm, pn, E, C.wave, C.lane); }
                        else { const int pn = q & 1; EpiBf16 E{P_G, 512}; gemm_unit(P_L + 256, 384, nullptr, WL + 131072, 128, pm, pn, E, C.wave, C.lane); } } });
        PHASE(16, ph_natten(C, P_QN, P_KN, P_VTN, P_OCAT, ((const float*)INT_[I_RPB]) + (size_t)lq * 8 * 465, lq == 1));
        PHASE(17, ph_scan(C, P_R, P_V, P_KK, P_W, P_KEFF, P_BSC, P_YS));
        PHASE(18, ph_post(C, P_YS, P_R, P_V, P_KEFF, P_G, ((const float*)INT_[I_RK]) + lq * 512, ((const float*)INT_[I_GNG]) + lq * 512, ((const float*)INT_[I_GNB]) + lq * 512, P_OCAT, lq == 1));
        PHASE(19, { const int i = 2 * lq + 1; EpiResid E{XL, P_XC, XL, P_XC, MODL(i) + 2048};
                    fast_gemm(C, P_OCAT, DM, (const bf16*)(ws + WS_WODOUT) + (size_t)lq * DM * DM, DM, (lq == 1) ? NLAT / 256 : MT / 256, 4, E); });
        PHASE(20, { const int i = 2 * lq + 1; ph_norm<true>(C, XL, P_XC, ((const float*)INT_[I_N2G]) + i * DM, MODL(i), 3072, 4096, P_HB, ((const float*)INT_[I_ROUTER]) + (size_t)i * DM * 16, P_AFFT, P_AFFC, P_SLOT); });
        PHASE(21, ph_topk(C, P_AFFT, P_AFFC, P_ROWS, P_GATE, P_SLOT, lq == 1));
        PHASE(22, { pg8::Gemm g{P_HB, P_W13, DM, DM, P_ROWS}; pg8::OrderMoE S{(lq == 1) ? 16 : 17, 8, 17, C.nb, C.vcu}; pg8::EpiAdapt<EpiGlu> E{EpiGlu{P_HID}}; pg8::gemm_phase(C.lds, g, S, E, C.tid); });
        PHASE(23, { pg8::Gemm g{P_HID, P_W2, DM, DM, nullptr}; pg8::OrderMoE S{(lq == 1) ? 16 : 17, 4, 17, C.nb, C.vcu}; pg8::EpiAdapt<EpiGate> E{EpiGate{P_Y2, P_GATE}}; pg8::gemm_phase(C.lds, g, S, E, C.tid); });
        PHASE(24, { const int i = 2 * lq + 1; ph_combine(C, XL, P_XC, MODL(i) + 5120, P_SLOT, P_Y2, lq == 1); });
    }
}

extern "C" void kernel_launch(void* const* d_in, const int* in_sizes, int n_in, void* d_out, int out_size, void* d_ws, size_t ws_size, hipStream_t stream) {
    static int grid = 0;
    if (grid == 0) {
        if (n_in != 40 || out_size != NLAT * DM || ws_size < WS_END) { fprintf(stderr, "kernel_launch: unexpected shapes (n_in %d out %d ws %zu need %zu)\n", n_in, out_size, ws_size, (size_t)WS_END); grid = -1; return; }
        int dev = 0, cus = 0, per_cu = 0;
        if (hipGetDevice(&dev) != hipSuccess || hipDeviceGetAttribute(&cus, hipDeviceAttributeMultiprocessorCount, dev) != hipSuccess) { grid = -1; return; }
        if (hipFuncSetAttribute((const void*)fwd_kernel, hipFuncAttributeMaxDynamicSharedMemorySize, LDS_BYTES) != hipSuccess) { fprintf(stderr, "kernel_launch: hipFuncSetAttribute failed\n"); grid = -1; return; }
        if (hipOccupancyMaxActiveBlocksPerMultiprocessor(&per_cu, (const void*)fwd_kernel, 512, LDS_BYTES) != hipSuccess || per_cu < 1) { fprintf(stderr, "kernel_launch: occupancy query says %d\n", per_cu); per_cu = 1; }
        (void)hipGetLastError();
        grid = cus;
    }
    if (grid < 0) return;
    (void)hipMemsetAsync((char*)d_ws + WS_CTL, 0, CTL_BYTES, stream);
    Args a{};
    for (int i = 0; i < 40; ++i) a.in[i] = (const float*)d_in[i];
    a.out = (float*)d_out; a.ws = (unsigned char*)d_ws;
#if MEGA
    a.ph_lo = 0; a.ph_hi = N_PHASES;
    hipLaunchKernelGGL(fwd_kernel, dim3(grid), dim3(512), LDS_BYTES, stream, a);
#else
    for (int p = 0; p < N_PHASES; ++p) { a.ph_lo = p; a.ph_hi = p + 1; hipLaunchKernelGGL(fwd_kernel, dim3(grid), dim3(512), LDS_BYTES, stream, a); }
#endif
}
```

```cpp
#include <hip/hip_runtime.h>
#include <cstdio>
#include <cstdint>

#ifndef MEGA
#define MEGA 1
#endif

#define LAS __attribute__((address_space(3)))
#define DI __device__ __forceinline__

typedef unsigned short bf16;
typedef short bf16x8 __attribute__((ext_vector_type(8)));
typedef float f32x4 __attribute__((ext_vector_type(4)));
typedef float f32x2 __attribute__((ext_vector_type(2)));
typedef float f32x16 __attribute__((ext_vector_type(16)));
typedef unsigned u32x4 __attribute__((ext_vector_type(4)));
typedef unsigned u32x2 __attribute__((ext_vector_type(2)));
typedef __bf16 bf16x2_t __attribute__((ext_vector_type(2)));

constexpr int DM = 1024, NB = 8, TL = 4096, LCX = 256;
constexpr int NLAT = NB * TL, NCTX = NB * LCX, MT = NLAT + NCTX;
constexpr int KPOS = TL + LCX;
constexpr float EPS = 1e-6f, GN_EPS = 64e-5f;
constexpr int EV_IN = 1696, EV_INP = 1792, OD_IN = 3456, OD_INP = 3584, RW_IN = 1920;
constexpr int NEXP = 16, CAPL = 512, CAPC = 32, ESLOTS = NB * CAPL + NB * CAPC;
constexpr float LOG2E = 1.4426950408889634f;

constexpr size_t MiB = 1ull << 20;
constexpr size_t WS_CTL = 0, CTL_BYTES = 1 * MiB;
constexpr size_t WS_MOD = 1 * MiB, WS_ROPE = 2 * MiB, WS_XC = 4 * MiB;
constexpr size_t WS_ROWS = 12 * MiB, WS_GATE = 12 * MiB + 512 * 1024, WS_SLOT = 13 * MiB, WS_AFFT = 16 * MiB, WS_AFFC = 18 * MiB;
constexpr size_t WS_WEVIN = 20 * MiB, WS_WEVOUT = 27 * MiB, WS_WUQ = 31 * MiB, WS_WUKV = 33 * MiB, WS_WODIN = 34 * MiB, WS_WODOUT = 48 * MiB, WS_WLORA = 52 * MiB;
constexpr size_t WS_W13 = 56 * MiB, WS_W2 = 120 * MiB, WS_HB = 152 * MiB, WS_OCAT = 220 * MiB, WS_ARENA = 288 * MiB;
constexpr size_t A_U = 0, A_QPRE = 119 * MiB, A_KVPRE = 221 * MiB, A_QB = 357 * MiB, A_KB = 408 * MiB, A_VT = 459 * MiB;
constexpr size_t A_W = 0, A_KEFF = 136 * MiB, A_BSC = 204 * MiB, A_R = 272 * MiB, A_V = 306 * MiB, A_KK = 340 * MiB, A_G = 374 * MiB, A_K = 408 * MiB, A_L = 442 * MiB,
                 A_QN = 468 * MiB, A_KN = 502 * MiB, A_VTN = 536 * MiB, A_YS = 408 * MiB;
constexpr size_t A_HID = 0, A_Y2 = 136 * MiB;
constexpr size_t WS_END = WS_ARENA + 570 * MiB;
constexpr int LDS_BYTES = 147456;

DI unsigned pk2(float lo, float hi) { f32x2 v = {lo, hi}; bf16x2_t b = __builtin_convertvector(v, bf16x2_t); return __builtin_bit_cast(unsigned, b); }
DI float bflo(unsigned u) { return __builtin_bit_cast(float, u << 16); }
DI float bfhi(unsigned u) { return __builtin_bit_cast(float, u & 0xffff0000u); }
DI float bf2f(bf16 x) { return __builtin_bit_cast(float, ((unsigned)x) << 16); }
DI bf16 f2bf(float f) { return (bf16)(pk2(f, 0.f) & 0xffffu); }
DI void unpack8(u32x4 v, float (&f)[8]) { f[0] = bflo(v.x); f[1] = bfhi(v.x); f[2] = bflo(v.y); f[3] = bfhi(v.y); f[4] = bflo(v.z); f[5] = bfhi(v.z); f[6] = bflo(v.w); f[7] = bfhi(v.w); }
DI u32x4 pack8(const float (&f)[8]) { u32x4 r; r.x = pk2(f[0], f[1]); r.y = pk2(f[2], f[3]); r.z = pk2(f[4], f[5]); r.w = pk2(f[6], f[7]); return r; }
#define DPP_ADD(x, ctrl) ((x) + __builtin_bit_cast(float, __builtin_amdgcn_update_dpp(0, __builtin_bit_cast(int, (x)), (ctrl), 0xf, 0xf, false)))
#define DPP_MAX(x, ctrl) fmaxf((x), __builtin_bit_cast(float, __builtin_amdgcn_update_dpp(0, __builtin_bit_cast(int, (x)), (ctrl), 0xf, 0xf, false)))
DI float sum8(float x) { x = DPP_ADD(x, 0xB1); x = DPP_ADD(x, 0x4E); x = DPP_ADD(x, 0x141); return x; }
DI float sum16(float x) { x = DPP_ADD(x, 0xB1); x = DPP_ADD(x, 0x4E); x = DPP_ADD(x, 0x141); x = DPP_ADD(x, 0x140); return x; }
DI float max16(float x) { x = DPP_MAX(x, 0xB1); x = DPP_MAX(x, 0x4E); x = DPP_MAX(x, 0x141); x = DPP_MAX(x, 0x140); return x; }
DI float rdlane(float x, int l) { return __builtin_bit_cast(float, __builtin_amdgcn_readlane(__builtin_bit_cast(int, x), l)); }
DI float wave_sum(float v) { const float x = sum16(v); return (rdlane(x, 0) + rdlane(x, 16)) + (rdlane(x, 32) + rdlane(x, 48)); }
DI float xor32(float v, int lane) { return __builtin_bit_cast(float, __builtin_amdgcn_ds_bpermute((lane ^ 32) << 2, __builtin_bit_cast(int, v))); }
DI float sigmoidf_(float x) { return 1.f / (1.f + __expf(-x)); }
DI float siluf_(float x) { return x / (1.f + __expf(-x)); }
#define MFMA32(a, b, c) __builtin_amdgcn_mfma_f32_32x32x16_bf16((a), (b), (c), 0, 0, 0)

#define XB_TMO      128
#define XB_XCNT(j)  (256  + 64 * (j))
#define XB_XSUB(j)  (1280 + 64 * (j))
#define XB_XGEN(j)  (2304 + 64 * (j))
#define XB_TOP      3328
#define XB_TOPGEN   3392
#define XCD_BAR_WORDS 3456
#define XB_SPIN_CAP (1u << 22)
__device__ __forceinline__ unsigned xb_ld(unsigned* p)              { return __hip_atomic_load(p, __ATOMIC_RELAXED, __HIP_MEMORY_SCOPE_AGENT); }
__device__ __forceinline__ unsigned xb_add(unsigned* p, unsigned v) { return __hip_atomic_fetch_add(p, v, __ATOMIC_RELAXED, __HIP_MEMORY_SCOPE_AGENT); }
__device__ __forceinline__ unsigned xb_xcc_id() { return (unsigned)__builtin_amdgcn_s_getreg((3 << 11) | 20) & 0xFu; }
#define XB_SPIN(cond, bar) do { unsigned _sp = 0; while (cond) { __builtin_amdgcn_s_sleep(1); \
    if ((++_sp & 255u) == 0u) { if (xb_ld(&(bar)[XB_TMO])) break; if (_sp > XB_SPIN_CAP) { atomicAdd(&(bar)[XB_TMO], 1u); break; } } } } while (0)
struct XcdBarrier { unsigned* bar; unsigned x; volatile LAS unsigned* st; };
__device__ __forceinline__ XcdBarrier xcd_barrier_post(unsigned* bar, volatile LAS unsigned* st, bool leader) {
    XcdBarrier b; b.bar = bar; b.x = xb_xcc_id(); b.st = st;
    if (leader) (void)xb_add(&bar[XB_XCNT(b.x)], 1u);
    return b;
}
__device__ __forceinline__ void xcd_barrier_complete(unsigned* bar, unsigned x, unsigned& nloc, unsigned& nx) {
    const unsigned G = gridDim.x * gridDim.y * gridDim.z;
    unsigned sum, cnt, mine, sp = 0u;
    for (;;) {
        sum = 0u; cnt = 0u; mine = 0u;
#pragma unroll
        for (unsigned j = 0; j < 16; ++j) { const unsigned c = xb_ld(&bar[XB_XCNT(j)]); sum += c; cnt += (c > 0u) ? 1u : 0u; mine = (j == x) ? c : mine; }
        if (sum == G) break;
        __builtin_amdgcn_s_sleep(1);
        if ((++sp & 255u) == 0u) { if (xb_ld(&bar[XB_TMO])) break; if (sp > XB_SPIN_CAP) { atomicAdd(&bar[XB_TMO], 1u); break; } }
    }
    nloc = mine > 0u ? mine : 1u; nx = cnt > 0u ? cnt : 1u;
}
__device__ __forceinline__ void xcd_barrier(const XcdBarrier& b, bool leader) {
    asm volatile("s_waitcnt vmcnt(0)" ::: "memory");
    __syncthreads();
    if (leader) {
        unsigned* bar = b.bar;
        __builtin_amdgcn_s_waitcnt(0);
        unsigned nloc = b.st[0], nx = b.st[1];
        if (nloc == 0u) { xcd_barrier_complete(bar, b.x, nloc, nx); b.st[0] = nloc; b.st[1] = nx; }
        const unsigned old = xb_add(&bar[XB_XSUB(b.x)], 1u);
        const unsigned gen = old / nloc;
        if (old + 1u == (gen + 1u) * nloc) {
            __builtin_amdgcn_fence(__ATOMIC_RELEASE, "agent");
            asm volatile("s_waitcnt vmcnt(0)" ::: "memory");
            const unsigned og = xb_add(&bar[XB_TOP], 1u);
            const unsigned tg = og / nx;
            if (og + 1u == (tg + 1u) * nx) xb_add(&bar[XB_TOPGEN], 1u);
            else XB_SPIN(xb_ld(&bar[XB_TOPGEN]) == tg, bar);
            __builtin_amdgcn_fence(__ATOMIC_ACQUIRE, "agent");
            xb_add(&bar[XB_XGEN(b.x)], 1u);
            asm volatile("s_waitcnt vmcnt(0)" ::: "memory");
        } else {
            XB_SPIN(xb_ld(&bar[XB_XGEN(b.x)]) == gen, bar);
            __builtin_amdgcn_fence(__ATOMIC_ACQUIRE, "agent");
            asm volatile("s_waitcnt vmcnt(0)" ::: "memory");
        }
    }
    __syncthreads();
}

struct Ctx { LAS unsigned char* lds; int tid, lane, wave, bid, nb, vcu; };
struct Args { const float* in[40]; float* out; unsigned char* ws; int ph_lo, ph_hi; };
enum { I_X = 0, I_C, I_CTX, I_CCTX, I_ADAW, I_ADAB, I_N1G, I_N2G, I_EVWIN, I_EVWOUT, I_QNORM, I_WUQ, I_KVNORM, I_WUKV, I_QG, I_KG, I_DWW, I_DWB, I_LNG, I_LNB,
       I_ODWIN, I_ODWOUT, I_SHIFTW, I_W0, I_W2L, I_A0, I_A2, I_G2, I_KKW, I_KA, I_RK, I_GNG, I_GNB, I_NAQG, I_NAKG, I_RPB, I_ROUTER, I_MW1, I_MW3, I_MW2 };

DI void transpose_item(const float* __restrict__ W, int K, int N, bf16* __restrict__ WT, int dst_row0, const float* __restrict__ gain, LAS float* scr, int k0, int n0, int lane) {
#pragma unroll 8
    for (int i = 0; i < 32; ++i) { const int kk = 2 * i + (lane >> 5); float v = W[(size_t)(k0 + kk) * N + n0 + (lane & 31)]; if (gain) v *= gain[k0 + kk]; scr[kk * 33 + (lane & 31)] = v; }
    asm volatile("s_waitcnt lgkmcnt(0)" ::: "memory");
    const int c = lane & 7;
#pragma unroll
    for (int j = 0; j < 4; ++j) { const int n = (lane >> 3) + 8 * j; const LAS float* s = scr + (8 * c) * 33 + n;
        u32x4 o; o.x = pk2(s[0 * 33], s[1 * 33]); o.y = pk2(s[2 * 33], s[3 * 33]); o.z = pk2(s[4 * 33], s[5 * 33]); o.w = pk2(s[6 * 33], s[7 * 33]);
        *(u32x4*)(WT + (size_t)(dst_row0 + n) * K + k0 + 8 * c) = o; }
    asm volatile("s_waitcnt lgkmcnt(0)" ::: "memory");
}
DI void transpose_item64(const float* __restrict__ W, int K, int N, bf16* __restrict__ WT, int dst_row0, LAS float* scr, int k0, int n0, int lane) {
    f32x4 v[16];
#pragma unroll
    for (int i = 0; i < 16; ++i) v[i] = *(const f32x4*)(W + (size_t)(k0 + 4 * i + (lane >> 4)) * N + n0 + 4 * (lane & 15));
#pragma unroll
    for (int i = 0; i < 16; ++i) { LAS float* d = scr + (4 * i + (lane >> 4)) * 65 + 4 * (lane & 15); d[0] = v[i].x; d[1] = v[i].y; d[2] = v[i].z; d[3] = v[i].w; }
    asm volatile("s_waitcnt lgkmcnt(0)" ::: "memory");
    const int c = lane & 7;
#pragma unroll
    for (int j = 0; j < 8; ++j) { const int n = (lane >> 3) + 8 * j; const LAS float* s = scr + (8 * c) * 65 + n;
        u32x4 o; o.x = pk2(s[0 * 65], s[1 * 65]); o.y = pk2(s[2 * 65], s[3 * 65]); o.z = pk2(s[4 * 65], s[5 * 65]); o.w = pk2(s[6 * 65], s[7 * 65]);
        *(u32x4*)(WT + (size_t)(dst_row0 + n) * K + k0 + 8 * c) = o; }
    asm volatile("s_waitcnt lgkmcnt(0)" ::: "memory");
}
DI void transpose_matrix(const Ctx& C, const float* W, int K, int N, bf16* WT, const float* gain, int mode  ) {
    LAS float* scr = (LAS float*)(C.lds + C.wave * 8704);
    const int nkb = K / 64, nnb = N / 32, nit = nkb * nnb, gw = C.vcu * 8 + C.wave, ngw = C.nb * 8;
    for (int it = gw; it < nit; it += ngw) {
        const int kb = it / nnb, nbk = it % nnb, n0 = nbk * 32;
        int d0 = n0; if (mode) d0 = (n0 >> 7) * 256 + (n0 & 127) + (mode == 2 ? 128 : 0);
        transpose_item(W, K, N, WT, d0, gain, scr, kb * 64, n0, C.lane);
    }
}
DI void moe_weight_prep(const Ctx& C, const float* w1, const float* w3, const float* w2, bf16* W13, bf16* W2) {
    LAS float* scr = (LAS float*)(C.lds + C.wave * 16640);
    const int gw = C.vcu * 8 + C.wave, ngw = C.nb * 8;
    constexpr int PER = 16 * 16;
    for (int it = gw; it < NEXP * 3 * PER; it += ngw) {
        const int e = it / (3 * PER), r = it % (3 * PER), which = r / PER, q = r % PER, kb = q / 16, n0 = (q % 16) * 64;
        if (which == 0)      transpose_item64(w1 + (size_t)e * DM * DM, DM, DM, W13 + (size_t)e * 2048 * DM, (n0 >> 7) * 256 + (n0 & 127), scr, kb * 64, n0, C.lane);
        else if (which == 1) transpose_item64(w3 + (size_t)e * DM * DM, DM, DM, W13 + (size_t)e * 2048 * DM, (n0 >> 7) * 256 + (n0 & 127) + 128, scr, kb * 64, n0, C.lane);
        else                 transpose_item64(w2 + (size_t)e * DM * DM, DM, DM, W2 + (size_t)e * DM * DM, n0, scr, kb * 64, n0, C.lane);
    }
}

DI void ph_prologue(const Ctx& C, const Args& a) {
    unsigned char* ws = a.ws;
    {
        LAS float* sv = (LAS float*)C.lds;
        LAS float* red = sv + 9 * 1024;
        for (int i = C.tid; i < 9 * 1024; i += 512) { const int m = i >> 10, k = i & 1023; const float c = (m < 8) ? a.in[I_C][m * 1024 + k] : a.in[I_CCTX][k]; sv[i] = siluf_(c); }
        __syncthreads();
        float* MOD = (float*)(ws + WS_MOD);
        for (int it = C.bid; it < 4 * 96; it += C.nb) {
            const int layer = it / 96, col = (it % 96) * 64 + C.lane;
            const float* wp = a.in[I_ADAW] + (size_t)layer * 1024 * 6144 + col;
            float acc[9];
#pragma unroll
            for (int m = 0; m < 9; ++m) acc[m] = 0.f;
            const int kb = C.wave * 128;
#pragma unroll 4
            for (int k = 0; k < 128; ++k) { const float w = wp[(size_t)(kb + k) * 6144];
#pragma unroll
                for (int m = 0; m < 9; ++m) acc[m] += sv[m * 1024 + kb + k] * w; }
#pragma unroll
            for (int m = 0; m < 9; ++m) red[(C.wave * 9 + m) * 64 + C.lane] = acc[m];
            __syncthreads();
            for (int i = C.tid; i < 576; i += 512) { const int m = i >> 6, l = i & 63; float s = 0.f;
#pragma unroll
                for (int w = 0; w < 8; ++w) s += red[(w * 9 + m) * 64 + l];
                const int cc = (it % 96) * 64 + l;
                MOD[(size_t)(layer * 9 + m) * 6144 + cc] = s + a.in[I_ADAB][layer * 6144 + cc]; }
            __syncthreads();
        }
    }
    {
        f32x2* CS = (f32x2*)(ws + WS_ROPE);
        for (int i = C.bid * 512 + C.tid; i < 4096 * 16; i += C.nb * 512) {
            const int pos = i >> 4, j = i & 15, f = j & 7;
            const float inv = powf(10000.f, -(float)(2 * f) / 16.f);
            const float ang = (float)((j < 8) ? (pos >> 6) : (pos & 63)) * inv;
            const double tw = 6.283185307179586476925;
            const double x = (double)ang, n = __builtin_rint(x / tw), rr = x - n * tw;
            CS[i] = (f32x2){__cosf((float)rr), __sinf((float)rr)};
        }
    }
    for (int j = 0; j < 2; ++j) {
        transpose_matrix(C, a.in[I_EVWIN] + (size_t)j * DM * EV_IN, DM, EV_IN, (bf16*)(ws + WS_WEVIN) + (size_t)j * EV_INP * DM, nullptr, 0);
        transpose_matrix(C, a.in[I_EVWOUT] + (size_t)j * DM * DM, DM, DM, (bf16*)(ws + WS_WEVOUT) + (size_t)j * DM * DM, nullptr, 0);
        transpose_matrix(C, a.in[I_WUQ] + (size_t)j * 384 * 768, 384, 768, (bf16*)(ws + WS_WUQ) + (size_t)j * 768 * 384, a.in[I_QNORM] + j * 384, 0);
        transpose_matrix(C, a.in[I_WUKV] + (size_t)j * 256 * 1024, 256, 1024, (bf16*)(ws + WS_WUKV) + (size_t)j * 1024 * 256, a.in[I_KVNORM] + j * 256, 0);
        transpose_matrix(C, a.in[I_ODWIN] + (size_t)j * DM * OD_IN, DM, OD_IN, (bf16*)(ws + WS_WODIN) + (size_t)j * OD_INP * DM, nullptr, 0);
        transpose_matrix(C, a.in[I_ODWOUT] + (size_t)j * DM * DM, DM, DM, (bf16*)(ws + WS_WODOUT) + (size_t)j * DM * DM, nullptr, 0);
    }
    {
        const int gt = C.bid * 512 + C.tid, ngt = C.nb * 512;
        for (int j = 0; j < 2; ++j) {
            u32x4* p0 = (u32x4*)((bf16*)(ws + WS_WEVIN) + (size_t)j * EV_INP * DM + (size_t)EV_IN * DM);
            for (int i = gt; i < (EV_INP - EV_IN) * DM / 8; i += ngt) p0[i] = (u32x4){0u, 0u, 0u, 0u};
            u32x4* p1 = (u32x4*)((bf16*)(ws + WS_WODIN) + (size_t)j * OD_INP * DM + (size_t)OD_IN * DM);
            for (int i = gt; i < (OD_INP - OD_IN) * DM / 8; i += ngt) p1[i] = (u32x4){0u, 0u, 0u, 0u};
            bf16* WL = (bf16*)(ws + WS_WLORA) + (size_t)j * 196608;
            const float* w2 = a.in[I_W2L] + (size_t)j * 2 * 64 * 512; const float* a2 = a.in[I_A2] + (size_t)j * 2 * 64 * 512; const float* g2 = a.in[I_G2] + (size_t)j * 128 * 512;
            for (int i = gt; i < 196608; i += ngt) {
                float v;
                if (i < 65536) { const int d = i >> 15, c = (i >> 6) & 511, r = i & 63; v = w2[(size_t)(d * 64 + r) * 512 + c]; }
                else if (i < 131072) { const int q = i - 65536, d = q >> 15, c = (q >> 6) & 511, r = q & 63; v = a2[(size_t)(d * 64 + r) * 512 + c]; }
                else { const int q = i - 131072, c = q >> 7, r = q & 127; v = g2[(size_t)r * 512 + c]; }
                WL[i] = f2bf(v);
            }
        }
    }
}

template <bool ROUTER>
DI void ph_norm(const Ctx& C, const float* xlat, const float* xctx, const float* gain, const float* mod  , int shift_off, int scale_off, bf16* H,
                const float* router  , float* AFFT, float* AFFC, int* SLOT) {
    LAS float* RT = (LAS float*)C.lds;
    if (ROUTER) { for (int i = C.tid; i < 16384; i += 512) { const int c = i >> 4, e = i & 15; RT[e * 1024 + c] = router[i]; } __syncthreads(); }
    const int gw = C.bid * 8 + C.wave, ngw = C.nb * 8, lane = C.lane;
    for (int row = gw; row < MT; row += ngw) {
        const float* xr = row < NLAT ? xlat + (size_t)row * DM : xctx + (size_t)(row - NLAT) * DM;
        const int mi = row < NLAT ? (row >> 12) : 8;
        const float* mp = mod + mi * 6144;
        f32x4 v[4]; float ss = 0.f;
#pragma unroll
        for (int j = 0; j < 4; ++j) { v[j] = *(const f32x4*)(xr + 256 * j + 4 * lane); ss += v[j].x * v[j].x + v[j].y * v[j].y + v[j].z * v[j].z + v[j].w * v[j].w; }
        ss = wave_sum(ss);
        const float rs = 1.0f / sqrtf(ss * (1.f / 1024.f) + EPS);
#pragma unroll
        for (int j = 0; j < 4; ++j) {
            const int c = 256 * j + 4 * lane;
            const f32x4 g = *(const f32x4*)(gain + c), sc = *(const f32x4*)(mp + scale_off + c), sh = *(const f32x4*)(mp + shift_off + c);
            v[j] = (v[j] * rs) * g * (sc + 1.0f) + sh;
            *(u32x2*)(H + (size_t)row * DM + c) = (u32x2){pk2(v[j].x, v[j].y), pk2(v[j].z, v[j].w)};
        }
        if (ROUTER) {
            float mylg = 0.f;
#pragma unroll 1
            for (int e = 0; e < 16; ++e) { float p = 0.f;
#pragma unroll
                for (int j = 0; j < 4; ++j) { const f32x4 w = *(const LAS f32x4*)(RT + e * 1024 + 256 * j + 4 * lane); p += v[j].x * w.x + v[j].y * w.y + v[j].z * w.z + v[j].w * w.w; }
                p = wave_sum(p); mylg = (lane == e) ? p : mylg; }
            const float mx = max16(mylg);
            const float ex = expf(mylg - mx);
            const float mine = ex / sum16(ex);
            if (lane < 16) {
                if (row < NLAT) AFFT[(size_t)((row >> 12) * 16 + lane) * TL + (row & 4095)] = mine;
                else { const int rc = row - NLAT; AFFC[(size_t)((rc >> 8) * 16 + lane) * LCX + (rc & 255)] = mine; }
                SLOT[(size_t)row * 16 + lane] = -1;
            }
        }
    }
}

template <class Epi>
DI void gemm_unit(const bf16* __restrict__ A, int lda, const int* __restrict__ rows, const bf16* __restrict__ Bt, int K, int pm, int pn, const Epi& E, int wave, int lane) {
    const int wr = wave >> 2, wc = wave & 3, r = lane & 31, h = lane >> 5;
    const bf16* ap[2][2]; const bf16* bp[2];
#pragma unroll
    for (int ai = 0; ai < 2; ++ai)
#pragma unroll
        for (int mm = 0; mm < 2; ++mm) { const int lr = 256 * pm + 128 * ai + 64 * wr + 32 * mm + r; const int gr = rows ? rows[lr] : lr; ap[ai][mm] = A + (size_t)gr * lda + 8 * h; }
#pragma unroll
    for (int bj = 0; bj < 2; ++bj) bp[bj] = Bt + (size_t)(256 * pn + 128 * bj + 32 * wc + r) * K + 8 * h;
    f32x16 acc[2][2][2];
#pragma unroll
    for (int ai = 0; ai < 2; ++ai)
#pragma unroll
        for (int mm = 0; mm < 2; ++mm)
#pragma unroll
            for (int bj = 0; bj < 2; ++bj)
#pragma unroll
                for (int i = 0; i < 16; ++i) acc[ai][mm][bj][i] = 0.f;
#pragma unroll 2
    for (int k0 = 0; k0 < K; k0 += 16) {
        bf16x8 af[2][2], bfr[2];
#pragma unroll
        for (int ai = 0; ai < 2; ++ai)
#pragma unroll
            for (int mm = 0; mm < 2; ++mm) af[ai][mm] = *(const bf16x8*)(ap[ai][mm] + k0);
#pragma unroll
        for (int bj = 0; bj < 2; ++bj) bfr[bj] = *(const bf16x8*)(bp[bj] + k0);
#pragma unroll
        for (int ai = 0; ai < 2; ++ai)
#pragma unroll
            for (int mm = 0; mm < 2; ++mm)
#pragma unroll
                for (int bj = 0; bj < 2; ++bj) acc[ai][mm][bj] = MFMA32(bfr[bj], af[ai][mm], acc[ai][mm][bj]);
    }
#pragma unroll
    for (int ai = 0; ai < 2; ++ai)
#pragma unroll
        for (int mm = 0; mm < 2; ++mm) {
            const int row = 256 * pm + 128 * ai + 64 * wr + 32 * mm + r;
#pragma unroll
            for (int g = 0; g < 4; ++g) {
                const int col = 256 * pn + 32 * wc + 8 * g + 4 * h;
                const f32x4 v0 = {acc[ai][mm][0][4 * g], acc[ai][mm][0][4 * g + 1], acc[ai][mm][0][4 * g + 2], acc[ai][mm][0][4 * g + 3]};
                const f32x4 v1 = {acc[ai][mm][1][4 * g], acc[ai][mm][1][4 * g + 1], acc[ai][mm][1][4 * g + 2], acc[ai][mm][1][4 * g + 3]};
                E(row, col, v0, v1);
            }
        }
}
template <class Epi>
DI void gemm_phase(const Ctx& C, const bf16* A, int lda, const bf16* Bt, int K, int nM, int nN, const Epi& E) {
    for (int u = C.vcu; u < nM * nN; u += C.nb) gemm_unit(A, lda, nullptr, Bt, K, u / nN, u % nN, E, C.wave, C.lane);
}

struct EpiBf16 { bf16* O; int ldo;
    DI void operator()(int row, int col, f32x4 v0, f32x4 v1) const { bf16* p = O + (size_t)row * ldo + col;
        *(u32x2*)p = (u32x2){pk2(v0[0], v0[1]), pk2(v0[2], v0[3])}; *(u32x2*)(p + 128) = (u32x2){pk2(v1[0], v1[1]), pk2(v1[2], v1[3])}; } };
struct EpiF32 { float* O; int ldo;
    DI void operator()(int row, int col, f32x4 v0, f32x4 v1) const { float* p = O + (size_t)row * ldo + col; *(f32x4*)p = v0; *(f32x4*)(p + 128) = v1; } };
struct EpiResid { const float* xin_lat; const float* xin_ctx; float* xout_lat; float* xout_ctx; const float* modg;
    DI void operator()(int row, int col, f32x4 v0, f32x4 v1) const {
        const float* xi; float* xo; int mi;
        if (row < NLAT) { xi = xin_lat + (size_t)row * DM; xo = xout_lat + (size_t)row * DM; mi = row >> 12; }
        else { xi = xin_ctx + (size_t)(row - NLAT) * DM; xo = xout_ctx + (size_t)(row - NLAT) * DM; mi = 8; }
        const float* g = modg + mi * 6144 + col;
        const f32x4 g0 = *(const f32x4*)g, g1 = *(const f32x4*)(g + 128), x0 = *(const f32x4*)(xi + col), x1 = *(const f32x4*)(xi + col + 128);
        *(f32x4*)(xo + col) = x0 + g0 * v0; *(f32x4*)(xo + col + 128) = x1 + g1 * v1; } };
struct EpiGlu { bf16* O;
    DI void operator()(int row, int col, f32x4 v0, f32x4 v1) const { const int f = ((col & 2047) >> 8) * 128 + (col & 255);
        *(u32x2*)(O + (size_t)row * DM + f) = (u32x2){pk2(siluf_(v0[0]) * v1[0], siluf_(v0[1]) * v1[1]), pk2(siluf_(v0[2]) * v1[2], siluf_(v0[3]) * v1[3])}; } };
struct EpiGate { bf16* O; const float* gate;
    DI void operator()(int row, int col, f32x4 v0, f32x4 v1) const { const float g = gate[row]; bf16* p = O + (size_t)row * DM + (col & 1023);
        *(u32x2*)p = (u32x2){pk2(v0[0] * g, v0[1] * g), pk2(v0[2] * g, v0[3] * g)}; *(u32x2*)(p + 128) = (u32x2){pk2(v1[0] * g, v1[1] * g), pk2(v1[2] * g, v1[3] * g)}; } };
struct EpiLoraW { float* W; const float* w0;
    DI void one(int row, int c, f32x4 v) const { f32x4 o;
#pragma unroll
        for (int e = 0; e < 4; ++e) { const float lw = w0[c + e] + v[e]; const float z = -lw; const float sp = fmaxf(z, 0.f) + __logf(1.f + __expf(-fabsf(z))); o[e] = __expf(-__expf(-sp - 0.5f)); }
        *(f32x4*)(W + (size_t)row * 512 + c) = o; }
    DI void operator()(int row, int col, f32x4 v0, f32x4 v1) const { one(row, col, v0); one(row, col + 128, v1); } };
struct EpiLoraA { bf16* KEFF; bf16* BSC; const bf16* Kin; const bf16* KKin; const float* a0; const float* ka;
    DI void one(int row, int c, f32x4 v) const {
        const u32x2 kr = *(const u32x2*)(Kin + (size_t)row * 512 + c), kkr = *(const u32x2*)(KKin + (size_t)row * 512 + c);
        const float kf[4] = {bflo(kr.x), bfhi(kr.x), bflo(kr.y), bfhi(kr.y)}, kkf[4] = {bflo(kkr.x), bfhi(kkr.x), bflo(kkr.y), bfhi(kkr.y)};
        float ke[4], bs[4];
#pragma unroll
        for (int e = 0; e < 4; ++e) { const float av = sigmoidf_(a0[c + e] + v[e]); ke[e] = kf[e] * (1.f + (av - 1.f) * ka[c + e]); bs[e] = kkf[e] * av; }
        *(u32x2*)(KEFF + (size_t)row * 512 + c) = (u32x2){pk2(ke[0], ke[1]), pk2(ke[2], ke[3])};
        *(u32x2*)(BSC + (size_t)row * 512 + c) = (u32x2){pk2(bs[0], bs[1]), pk2(bs[2], bs[3])}; }
    DI void operator()(int row, int col, f32x4 v0, f32x4 v1) const { one(row, col, v0); one(row, col + 128, v1); } };


namespace pg8 {
constexpr int BM = 256, BK = 64, HALF = 128, HTB = HALF * BK * 2, STAGE_BYTES = 8 * HTB;
DI int lds_byte(int r, int c) { const int st = (r >> 4) * 2 + (c >> 5), rr = r & 15, cc = c & 31, ob = rr * 64 + cc * 2; return st * 1024 + (ob ^ (((ob >> 9) & 1) << 5)); }
DI void stage_rc(int b, int& R, int& C) { const int st = b / 1024, sb = b % 1024, swz = sb ^ (((sb >> 9) & 1) << 5); R = (st >> 1) * 16 + swz / 64; C = (st & 1) * 32 + (swz % 64) / 2; }
DI int perm32(int rho) { const int n = rho >> 4, i = rho & 15; return 8 * (i >> 2) + 4 * n + (i & 3); }
struct Unit { int pm, pn; };
struct Gemm { const bf16* A; const bf16* Bt; int lda, K; const int* rows; };
struct OrderMN { int nM, nN, G, c;
    DI bool next(int i, Unit& u) const { const int L = i * G + c; if (L >= nM * nN) return false; u.pm = L / nN; u.pn = L % nN; return true; } };
struct OrderMoE { int nMt, nN, mstride  , G, c;
    DI bool next(int i, Unit& u) const { const int L = i * G + c, per = nMt * nN; if (L >= NEXP * per) return false; const int e = L / per, q = L % per; u.pm = e * mstride + q / nN; u.pn = e * nN + q % nN; return true; } };
template <class E4> struct EpiAdapt { E4 e;
    DI void operator()(const f32x4 (&acc)[2][2][4][2], const Unit& u, int wr, int wc, int fr, int fq) const {
#pragma unroll
        for (int ai = 0; ai < 2; ++ai)
#pragma unroll
            for (int m = 0; m < 4; ++m) { const int row = u.pm * BM + ai * HALF + wr * 64 + m * 16 + fr;
#pragma unroll
                for (int n = 0; n < 2; ++n) e(row, u.pn * BM + wc * 32 + 8 * fq + 4 * n, acc[ai][0][m][n], acc[ai][1][m][n]);
                __builtin_amdgcn_sched_barrier(0); } } };

template <class Epi, class Sched>
DI void gemm_phase(LAS unsigned char* lds, const Gemm g, const Sched& S, const Epi& E, const int tid) {
    const int wid = __builtin_amdgcn_readfirstlane(tid >> 6), lane = tid & 63, wr = wid >> 2, wc = wid & 3, fr = lane & 15, fq = lane >> 4;
    const int K = g.K, nt = K / BK;
    int RA[2], CA[2]; unsigned voffB[2];
#pragma unroll
    for (int i = 0; i < 2; ++i) { int R, C; stage_rc(tid * 16 + i * 8192, R, C); RA[i] = R; CA[i] = C; const int Rb = (R & ~31) + perm32(R & 31); voffB[i] = (unsigned)(Rb * K + C) * 2u; }
    const size_t kstep = (size_t)(BK * 2), hstep = (size_t)HALF * K * 2, tstep = 2 * hstep;
    const unsigned ldsw = (unsigned)wid * 1024u;
    const int aoff = lds_byte(wr * 64 + fr, fq * 8), boff = lds_byte(wc * 32 + fr, fq * 8);
    const char* const gA = (const char*)g.A;
#define PG8_SA(b, h) (((b) * 2 + (h)) * HTB)
#define PG8_SB(b, h) ((4 + (b) * 2 + (h)) * HTB)
#define PG8_STAGE(bufoff, gbase, voff) do { _Pragma("unroll") for (int _i = 0; _i < 2; ++_i) \
        __builtin_amdgcn_global_load_lds((const unsigned*)((const char*)(gbase) + (voff)[_i]), (LAS unsigned*)(lds + (bufoff) + ldsw + _i * 8192), 16, 0, 0); } while (0)
#define PG8_LDA(dst, b, h) do { _Pragma("unroll") for (int m = 0; m < 4; ++m) _Pragma("unroll") for (int k = 0; k < 2; ++k) dst[m][k] = *(const LAS bf16x8*)(lds + PG8_SA(b, h) + aoff + m * 2048 + k * 1024); } while (0)
#define PG8_LDB(dst, b, h) do { _Pragma("unroll") for (int n = 0; n < 2; ++n) _Pragma("unroll") for (int k = 0; k < 2; ++k) dst[n][k] = *(const LAS bf16x8*)(lds + PG8_SB(b, h) + boff + n * 2048 + k * 1024); } while (0)
#define PG8_MMA(ai, bj, At, Bt) do { __builtin_amdgcn_s_setprio(1); _Pragma("unroll") for (int m = 0; m < 4; ++m) _Pragma("unroll") for (int n = 0; n < 2; ++n) _Pragma("unroll") for (int k = 0; k < 2; ++k) \
        acc[ai][bj][m][n] = __builtin_amdgcn_mfma_f32_16x16x32_bf16(Bt[n][k], At[m][k], acc[ai][bj][m][n], 0, 0, 0); __builtin_amdgcn_s_setprio(0); } while (0)
#define PG8_WAIT_V(n) asm volatile("s_waitcnt vmcnt(" #n ")" ::: "memory")
#define PG8_WAIT_L(n) asm volatile("s_waitcnt lgkmcnt(" #n ")" ::: "memory")
#define PG8_BAR __builtin_amdgcn_s_barrier()
#define PG8_SCHED __builtin_amdgcn_sched_barrier(0)
#define PG8_AOFF(vo, u) do { _Pragma("unroll") for (int _h = 0; _h < 2; ++_h) _Pragma("unroll") for (int _i = 0; _i < 2; ++_i) { const int _lr = (u).pm * BM + _h * HALF + RA[_i]; \
        const int _gr = g.rows ? g.rows[_lr] : _lr; vo[_h][_i] = (unsigned)(((size_t)_gr * g.lda + CA[_i]) * 2u); } } while (0)
    Unit cur, nxt; int ui = 0;
    if (!S.next(0, cur)) return;
    f32x4 acc[2][2][4][2];
#pragma unroll
    for (int a = 0; a < 2; ++a)
#pragma unroll
        for (int b = 0; b < 2; ++b)
#pragma unroll
            for (int m = 0; m < 4; ++m)
#pragma unroll
                for (int n = 0; n < 2; ++n) acc[a][b][m][n] = (f32x4){0.f, 0.f, 0.f, 0.f};
    bf16x8 At[4][2], B0[2][2], B1[2][2];
    unsigned cvo[2][2], nvo[2][2];
    PG8_AOFF(cvo, cur);
    const char* cB = (const char*)g.Bt + (size_t)cur.pn * tstep;
    PG8_STAGE(PG8_SB(0, 0), cB, voffB); PG8_STAGE(PG8_SB(0, 1), cB + hstep, voffB); PG8_STAGE(PG8_SA(0, 0), gA, cvo[0]); PG8_STAGE(PG8_SA(0, 1), gA, cvo[1]);
    if (wr == 1) PG8_BAR;
    PG8_WAIT_V(2); PG8_BAR;
    PG8_STAGE(PG8_SB(1, 0), cB + kstep, voffB); PG8_STAGE(PG8_SA(1, 0), gA + kstep, cvo[0]); PG8_STAGE(PG8_SB(1, 1), cB + hstep + kstep, voffB);
    PG8_WAIT_V(6); PG8_BAR;
    for (;;) {
        const bool has_next = S.next(ui + 1, nxt);
        if (has_next) { PG8_AOFF(nvo, nxt); } else {
#pragma unroll
            for (int _h = 0; _h < 2; ++_h)
#pragma unroll
                for (int _i = 0; _i < 2; ++_i) nvo[_h][_i] = cvo[_h][_i]; }
        const char* nB = has_next ? (const char*)g.Bt + (size_t)nxt.pn * tstep : cB;
        for (int t = 0; t < nt; t += 2) {
            const bool last = (t == nt - 2);
            const char* a1 = gA + (size_t)(t + 1) * kstep;
            const char* a2 = last ? gA : gA + (size_t)(t + 2) * kstep; const char* b2 = last ? nB : cB + (size_t)(t + 2) * kstep;
            const char* a3 = a2 + kstep; const char* b3 = b2 + kstep;
            unsigned v20[2], v21[2];
#pragma unroll
            for (int _i = 0; _i < 2; ++_i) { v20[_i] = last ? nvo[0][_i] : cvo[0][_i]; v21[_i] = last ? nvo[1][_i] : cvo[1][_i]; }
            PG8_LDB(B0, 0, 0); PG8_LDB(B1, 0, 1); PG8_SCHED; PG8_LDA(At, 0, 0); PG8_STAGE(PG8_SA(1, 1), a1, cvo[1]);
            PG8_WAIT_V(8); PG8_WAIT_L(0); PG8_BAR; PG8_MMA(0, 0, At, B0); PG8_MMA(0, 1, At, B1); PG8_BAR; PG8_SCHED;
            PG8_LDA(At, 0, 1); PG8_STAGE(PG8_SB(0, 0), b2, voffB); PG8_STAGE(PG8_SB(0, 1), b2 + hstep, voffB); PG8_STAGE(PG8_SA(0, 0), a2, v20);
            PG8_WAIT_V(8); PG8_WAIT_L(0); PG8_BAR; PG8_MMA(1, 0, At, B0); PG8_MMA(1, 1, At, B1); PG8_BAR; PG8_SCHED;
            PG8_LDB(B0, 1, 0); PG8_LDB(B1, 1, 1); PG8_SCHED; PG8_LDA(At, 1, 0); PG8_STAGE(PG8_SA(0, 1), a2, v21);
            PG8_WAIT_V(8); PG8_WAIT_L(0); PG8_BAR; PG8_MMA(0, 0, At, B0); PG8_MMA(0, 1, At, B1); PG8_BAR; PG8_SCHED;
            PG8_LDA(At, 1, 1); PG8_STAGE(PG8_SB(1, 0), b3, voffB); PG8_STAGE(PG8_SB(1, 1), b3 + hstep, voffB); PG8_STAGE(PG8_SA(1, 0), a3, v20);
            PG8_WAIT_V(8); PG8_WAIT_L(0); PG8_BAR; PG8_MMA(1, 0, At, B0); PG8_MMA(1, 1, At, B1); PG8_BAR; PG8_SCHED;
        }
        if (wr == 0) PG8_BAR;
        E(acc, cur, wr, wc, fr, fq);
        if (!has_next) break;
#pragma unroll
        for (int a = 0; a < 2; ++a)
#pragma unroll
            for (int b = 0; b < 2; ++b)
#pragma unroll
                for (int m = 0; m < 4; ++m)
#pragma unroll
                    for (int n = 0; n < 2; ++n) acc[a][b][m][n] = (f32x4){0.f, 0.f, 0.f, 0.f};
        cur = nxt; cB = nB; ++ui;
#pragma unroll
        for (int _h = 0; _h < 2; ++_h)
#pragma unroll
            for (int _i = 0; _i < 2; ++_i) cvo[_h][_i] = nvo[_h][_i];
        if (wr == 1) PG8_BAR;
    }
    PG8_WAIT_V(0);
    PG8_BAR;
#undef PG8_SA
#undef PG8_SB
#undef PG8_STAGE
#undef PG8_LDA
#undef PG8_LDB
#undef PG8_MMA
#undef PG8_WAIT_V
#undef PG8_WAIT_L
#undef PG8_BAR
#undef PG8_SCHED
#undef PG8_AOFF
}
}
template <class E4> DI void fast_gemm(const Ctx& C, const bf16* A, int lda, const bf16* Bt, int K, int nM, int nN, const E4& e) {
    pg8::Gemm g{A, Bt, lda, K, nullptr}; pg8::OrderMN S{nM, nN, C.nb, C.vcu}; pg8::EpiAdapt<E4> E{e};
    pg8::gemm_phase(C.lds, g, S, E, C.tid);
}

DI int swap23(int x) { return (x & ~12) | ((x & 4) << 1) | ((x & 8) >> 1); }
template <int DQK, bool NAT>
DI void flash_range(f32x16 (&o)[2], float& m, float& l, const bf16x8 (&qf)[DQK / 16], const bf16* __restrict__ Kb, const bf16* __restrict__ Vt, int pos0, int nblk, int r, int h,
                    const LAS float* tab, int qc, int cs, int drow0) {
    const int kr = swap23(r);
    for (int blk = 0; blk < nblk; ++blk) {
        const int pos = pos0 + 32 * blk;
        f32x16 s;
#pragma unroll
        for (int i = 0; i < 16; ++i) s[i] = 0.f;
        const bf16* kp = Kb + (size_t)(pos + kr) * DQK + 8 * h;
#pragma unroll
        for (int kk = 0; kk < DQK / 16; ++kk) s = MFMA32(*(const bf16x8*)(kp + 16 * kk), qf[kk], s);
        if (NAT) {
            const int irow = blk >> 1, cc0 = (blk & 1) * 32;
            const LAS float* trow = tab + (drow0 + irow) * 31;
#pragma unroll
            for (int i = 0; i < 16; ++i) {
                const int kib = (i & 3) | (((i >> 2) & 1) << 2) | (h << 3) | ((i >> 3) << 4);
                const int cc = cc0 + kib; const bool ok = (cc >= cs) && (cc < cs + 16);
                int dc = cc - qc + 15; dc = dc < 0 ? 0 : (dc > 30 ? 30 : dc);
                s[i] = ok ? s[i] + trow[dc] : -1e30f;
            }
        }
        float mx = s[0];
#pragma unroll
        for (int i = 1; i < 16; ++i) mx = fmaxf(mx, s[i]);
        mx = fmaxf(mx, xor32(mx, r + 32 * h));
        const float mn = fmaxf(m, mx), alpha = __builtin_amdgcn_exp2f(m - mn);
        float rs = 0.f; f32x16 p;
#pragma unroll
        for (int i = 0; i < 16; ++i) { float e = __builtin_amdgcn_exp2f(s[i] - mn); if (NAT) e = (s[i] > -1e29f) ? e : 0.f; p[i] = e; rs += e; }
        rs += xor32(rs, r + 32 * h);
        l = l * alpha + rs; m = mn;
#pragma unroll
        for (int i = 0; i < 16; ++i) { o[0][i] *= alpha; o[1][i] *= alpha; }
#pragma unroll
        for (int s2 = 0; s2 < 2; ++s2) {
            u32x4 pw; pw.x = pk2(p[8 * s2], p[8 * s2 + 1]); pw.y = pk2(p[8 * s2 + 2], p[8 * s2 + 3]); pw.z = pk2(p[8 * s2 + 4], p[8 * s2 + 5]); pw.w = pk2(p[8 * s2 + 6], p[8 * s2 + 7]);
            const bf16x8 pb = __builtin_bit_cast(bf16x8, pw);
#pragma unroll
            for (int dt = 0; dt < 2; ++dt) { const bf16x8 va = *(const bf16x8*)(Vt + (size_t)(32 * dt + r) * KPOS + pos + 16 * s2 + 8 * h); o[dt] = MFMA32(va, pb, o[dt]); }
        }
    }
}
DI void flash_store(const f32x16 (&o)[2], float l, bf16* orow  , int h) {
    const float inv = 1.f / l;
#pragma unroll
    for (int dt = 0; dt < 2; ++dt)
#pragma unroll
        for (int g = 0; g < 4; ++g)
            *(u32x2*)(orow + 32 * dt + 8 * g + 4 * h) = (u32x2){pk2(o[dt][4 * g] * inv, o[dt][4 * g + 1] * inv), pk2(o[dt][4 * g + 2] * inv, o[dt][4 * g + 3] * inv)};
}

DI void ph_attn_mla(const Ctx& C, const bf16* QB, const bf16* KB, const bf16* VT, bf16* OCAT, bool last) {
    const int r = C.lane & 31, h = C.lane >> 5;
    for (int u = C.vcu; u < 64 * 17; u += C.nb) {
        const int bh = u / 17, qblk = u % 17, b = bh >> 3, hh = bh & 7;
        if (last && qblk == 16) continue;
        const int qpos = qblk * 256 + 32 * C.wave + r;
        const bf16* qp = QB + ((size_t)bh * KPOS + qpos) * 96 + 8 * h;
        bf16x8 qf[6];
#pragma unroll
        for (int kk = 0; kk < 6; ++kk) qf[kk] = *(const bf16x8*)(qp + 16 * kk);
        f32x16 o[2];
#pragma unroll
        for (int i = 0; i < 16; ++i) { o[0][i] = 0.f; o[1][i] = 0.f; }
        float m = -1e30f, l = 0.f;
        flash_range<96, false>(o, m, l, qf, KB + (size_t)bh * KPOS * 96, VT + (size_t)bh * 64 * KPOS, qblk < 16 ? 0 : TL, qblk < 16 ? KPOS / 32 : LCX / 32, r, h, nullptr, 0, 0, 0);
        const int row = qblk < 16 ? b * TL + qpos : NLAT + b * LCX + (qpos - TL);
        flash_store(o, l, OCAT + (size_t)row * DM + hh * 64, h);
    }
}

template <int DQK> struct AttnGeo { static constexpr int KSTR = DQK * 2 + 16, KBYTES = 64 * KSTR, VSTR = 144, VBYTES = 64 * VSTR, BUF = KBYTES + VBYTES, KPIECES = 64 * DQK / 8; };
template <int DQK>
DI void attn_tile_loop(const Ctx& C, f32x16 (&o)[2], float& l, const bf16x8 (&qf)[DQK / 16], const bf16* __restrict__ Kb, const bf16* __restrict__ Vt, int pos_base, int ntiles) {
    typedef AttnGeo<DQK> G;
    const int tid = C.tid, r = C.lane & 31, h = C.lane >> 5, kr = swap23(r);
    constexpr bool K2 = G::KPIECES > 512;
    const int kq0 = tid, kq1 = tid + 512;
    const int kl0 = (kq0 / (DQK / 8)) * G::KSTR + (kq0 % (DQK / 8)) * 16, kl1 = (kq1 / (DQK / 8)) * G::KSTR + (kq1 % (DQK / 8)) * 16;
    const int vl = G::KBYTES + (tid >> 3) * G::VSTR + (tid & 7) * 16;
    const bf16* vg = Vt + (size_t)(tid >> 3) * KPOS + 8 * (tid & 7);
    u32x4 rk0, rk1, rv;
    rk1 = (u32x4){0u, 0u, 0u, 0u};
    { const int pos0 = pos_base; rk0 = *(const u32x4*)(Kb + (size_t)pos0 * DQK + 8 * kq0); if (K2 && tid < 256) rk1 = *(const u32x4*)(Kb + (size_t)pos0 * DQK + 8 * kq1); rv = *(const u32x4*)(vg + pos0); }
    __syncthreads();
    *(LAS u32x4*)(C.lds + kl0) = rk0; if (K2 && tid < 256) *(LAS u32x4*)(C.lds + kl1) = rk1; *(LAS u32x4*)(C.lds + vl) = rv;
    __syncthreads();
    float mref = 0.f;
    constexpr float THR = 8.f;
    for (int t = 0; t < ntiles; ++t) {
        const LAS unsigned char* B = C.lds + (t & 1) * G::BUF;
        if (t + 1 < ntiles) { const int pos0 = pos_base + 64 * (t + 1);
            rk0 = *(const u32x4*)(Kb + (size_t)pos0 * DQK + 8 * kq0); if (K2 && tid < 256) rk1 = *(const u32x4*)(Kb + (size_t)pos0 * DQK + 8 * kq1); rv = *(const u32x4*)(vg + pos0); }
        f32x16 sc[2];
#pragma unroll
        for (int j = 0; j < 2; ++j) {
#pragma unroll
            for (int i = 0; i < 16; ++i) sc[j][i] = -mref;
            const LAS unsigned char* kp = B + (32 * j + kr) * G::KSTR + 16 * h;
#pragma unroll
            for (int kk = 0; kk < DQK / 16; ++kk) sc[j] = MFMA32(*(const LAS bf16x8*)(kp + 32 * kk), qf[kk], sc[j]);
        }
        float mx = fmaxf(sc[0][0], sc[1][0]);
#pragma unroll
        for (int i = 1; i < 16; ++i) mx = fmaxf(mx, fmaxf(sc[0][i], sc[1][i]));
        mx = fmaxf(mx, xor32(mx, C.lane));
        if (t == 0 || __builtin_amdgcn_ballot_w64(mx > THR) != 0ull) {
            const float delta = (t == 0) ? mx : fmaxf(mx, 0.f);
#pragma unroll
            for (int i = 0; i < 16; ++i) { sc[0][i] -= delta; sc[1][i] -= delta; }
            if (t > 0) { const float alpha = __builtin_amdgcn_exp2f(-delta); l *= alpha;
#pragma unroll
                for (int i = 0; i < 16; ++i) { o[0][i] *= alpha; o[1][i] *= alpha; } }
            mref += delta;
        }
        f32x2 rs2 = {0.f, 0.f};
#pragma unroll
        for (int j = 0; j < 2; ++j)
#pragma unroll
            for (int i = 0; i < 16; i += 2) { sc[j][i] = __builtin_amdgcn_exp2f(sc[j][i]); sc[j][i + 1] = __builtin_amdgcn_exp2f(sc[j][i + 1]); rs2 += (f32x2){sc[j][i], sc[j][i + 1]}; }
        float rs = rs2.x + rs2.y;
        rs += xor32(rs, C.lane);
        l += rs;
#pragma unroll
        for (int j = 0; j < 2; ++j)
#pragma unroll
            for (int s2 = 0; s2 < 2; ++s2) {
                u32x4 pw; pw.x = pk2(sc[j][8 * s2], sc[j][8 * s2 + 1]); pw.y = pk2(sc[j][8 * s2 + 2], sc[j][8 * s2 + 3]); pw.z = pk2(sc[j][8 * s2 + 4], sc[j][8 * s2 + 5]); pw.w = pk2(sc[j][8 * s2 + 6], sc[j][8 * s2 + 7]);
                const bf16x8 pb = __builtin_bit_cast(bf16x8, pw);
#pragma unroll
                for (int dt = 0; dt < 2; ++dt) o[dt] = MFMA32(*(const LAS bf16x8*)(B + G::KBYTES + (32 * dt + r) * G::VSTR + (32 * j + 16 * s2 + 8 * h) * 2), pb, o[dt]);
            }
        if (t + 1 < ntiles) { LAS unsigned char* Bn = C.lds + ((t + 1) & 1) * G::BUF;
            *(LAS u32x4*)(Bn + kl0) = rk0; if (K2 && tid < 256) *(LAS u32x4*)(Bn + kl1) = rk1; *(LAS u32x4*)(Bn + vl) = rv; }
        __syncthreads();
    }
}
DI void ph_attn_mla2(const Ctx& C, const bf16* QB, const bf16* KB, const bf16* VT, bf16* OCAT, bool last) {
    const int r = C.lane & 31, h = C.lane >> 5;
    for (int u = C.vcu; u < 64 * 17; u += C.nb) {
        const int bh = u / 17, qblk = u % 17, b = bh >> 3, hh = bh & 7;
        if (last && qblk == 16) continue;
        const int qpos = qblk * 256 + 32 * C.wave + r;
        const bf16* qp = QB + ((size_t)bh * KPOS + qpos) * 96 + 8 * h;
        bf16x8 qf[6];
#pragma unroll
        for (int kk = 0; kk < 6; ++kk) qf[kk] = *(const bf16x8*)(qp + 16 * kk);
        f32x16 o[2];
#pragma unroll
        for (int i = 0; i < 16; ++i) { o[0][i] = 0.f; o[1][i] = 0.f; }
        float l = 0.f;
        attn_tile_loop<96>(C, o, l, qf, KB + (size_t)bh * KPOS * 96, VT + (size_t)bh * 64 * KPOS, qblk < 16 ? 0 : TL, qblk < 16 ? KPOS / 64 : LCX / 64);
        const int row = qblk < 16 ? b * TL + qpos : NLAT + b * LCX + (qpos - TL);
        flash_store(o, l, OCAT + (size_t)row * DM + hh * 64, h);
    }
}

DI void ph_natten(const Ctx& C, const bf16* QN, const bf16* KN, const bf16* VTN, bf16* OCAT, const float* rpb  , bool last) {
    const int r = C.lane & 31, h = C.lane >> 5;
    LAS float* tab = (LAS float*)C.lds;
    const int nunits = 1024 + (last ? 0 : 64);
    for (int u = C.vcu; u < nunits; u += C.nb) {
        const bool isctx = u >= 1024;
        const int bh = isctx ? u - 1024 : (u >> 4), b = bh >> 3, hh = bh & 7;
        __syncthreads();
        for (int i = C.tid; i < 465; i += 512) tab[i] = rpb[hh * 465 + i] * LOG2E;
        __syncthreads();
        int qpos, row, grow = 0, qc = 0, rs = 0, cs = 0;
        if (!isctx) { const int rg = u & 15; grow = 4 * rg + (C.wave >> 1); qc = 32 * (C.wave & 1) + r; qpos = grow * 64 + qc; row = b * TL + qpos;
            rs = grow - 4; rs = rs < 0 ? 0 : (rs > 56 ? 56 : rs); cs = qc - 8; cs = cs < 0 ? 0 : (cs > 48 ? 48 : cs); }
        else { qpos = TL + 32 * C.wave + r; row = NLAT + b * LCX + 32 * C.wave + r; }
        const bf16* qp = QN + ((size_t)bh * KPOS + qpos) * 64 + 8 * h;
        bf16x8 qf[4];
#pragma unroll
        for (int kk = 0; kk < 4; ++kk) qf[kk] = *(const bf16x8*)(qp + 16 * kk);
        f32x16 o[2];
#pragma unroll
        for (int i = 0; i < 16; ++i) { o[0][i] = 0.f; o[1][i] = 0.f; }
        float m = -1e30f, l = 0.f;
        const bf16* Kb = KN + (size_t)bh * KPOS * 64; const bf16* Vt = VTN + (size_t)bh * 64 * KPOS;
        if (!isctx) flash_range<64, true>(o, m, l, qf, Kb, Vt, rs * 64, 16, r, h, tab, qc, cs, rs - grow + 7);
        flash_range<64, false>(o, m, l, qf, Kb, Vt, TL, LCX / 32, r, h, nullptr, 0, 0, 0);
        flash_store(o, l, OCAT + (size_t)row * DM + 512 + hh * 64, h);
    }
}

DI void ph_mla_fin(const Ctx& C, const bf16* U, const float* QPRE, const float* KVPRE, const float* qg, const float* kg, const f32x2* CS, bf16* QB, bf16* KB, bf16* VT) {
    LAS bf16* VL = (LAS bf16*)C.lds;
    const int lane = C.lane, hh = lane >> 3, sub = lane & 7;
    const float C2 = 0.10206207261596575f * LOG2E;
    for (int u = C.vcu; u < MT / 64; u += C.nb) {
        const int row0 = 64 * u, b = row0 < NLAT ? (row0 >> 12) : ((row0 - NLAT) >> 8), pos0 = row0 < NLAT ? (row0 & 4095) : TL + ((row0 - NLAT) & 255);
        const bool lat = row0 < NLAT;
        for (int i = 0; i < 8; ++i) {
            const int pl = 8 * C.wave + i, row = row0 + pl, pos = pos0 + pl;
            const bf16* ur = U + (size_t)row * EV_INP;
            float sq = 0.f, skv = 0.f;
#pragma unroll
            for (int mq = 0; mq < 6; ++mq) { const float x = bf2f(ur[lane + 64 * mq]); sq += x * x; }
#pragma unroll
            for (int mq = 0; mq < 4; ++mq) { const float x = bf2f(ur[384 + lane + 64 * mq]); skv += x * x; }
            sq = wave_sum(sq); skv = wave_sum(skv);
            const float rsq = 1.0f / sqrtf(sq * (1.f / 384.f) + EPS), rskv = 1.0f / sqrtf(skv * (1.f / 256.f) + EPS);
            float cr = 1.f, sr = 0.f, cc = 1.f, sc = 0.f;
            if (lat) { const f32x2 a0 = CS[pos * 16 + sub], a1 = CS[pos * 16 + 8 + sub]; cr = a0.x; sr = a0.y; cc = a1.x; sc = a1.y; }
            float qv[12]; float ss = 0.f;
#pragma unroll
            for (int mq = 0; mq < 12; ++mq) { qv[mq] = QPRE[(size_t)row * 768 + hh * 96 + sub + 8 * mq] * rsq; ss += qv[mq] * qv[mq]; }
            ss = sum8(ss);
            float rn = 1.0f / sqrtf(ss * (1.f / 96.f) + EPS);
#pragma unroll
            for (int mq = 0; mq < 12; ++mq) qv[mq] = qv[mq] * rn * qg[sub + 8 * mq];
            { const float x0 = qv[8], x1 = qv[9], y0 = qv[10], y1 = qv[11]; qv[8] = x0 * cr - x1 * sr; qv[9] = x1 * cr + x0 * sr; qv[10] = y0 * cc - y1 * sc; qv[11] = y1 * cc + y0 * sc; }
            bf16* qo = QB + ((size_t)(b * 8 + hh) * KPOS + pos) * 96 + sub;
#pragma unroll
            for (int mq = 0; mq < 12; ++mq) qo[8 * mq] = f2bf(qv[mq] * C2);
            float kv[12]; ss = 0.f;
#pragma unroll
            for (int mq = 0; mq < 8; ++mq) kv[mq] = KVPRE[(size_t)row * 1024 + hh * 128 + sub + 8 * mq] * rskv;
#pragma unroll
            for (int mq = 8; mq < 12; ++mq) kv[mq] = bf2f(ur[640 + sub + 8 * (mq - 8)]);
#pragma unroll
            for (int mq = 0; mq < 12; ++mq) ss += kv[mq] * kv[mq];
            ss = sum8(ss);
            rn = 1.0f / sqrtf(ss * (1.f / 96.f) + EPS);
#pragma unroll
            for (int mq = 0; mq < 12; ++mq) kv[mq] = kv[mq] * rn * kg[sub + 8 * mq];
            { const float x0 = kv[8], x1 = kv[9], y0 = kv[10], y1 = kv[11]; kv[8] = x0 * cr - x1 * sr; kv[9] = x1 * cr + x0 * sr; kv[10] = y0 * cc - y1 * sc; kv[11] = y1 * cc + y0 * sc; }
            bf16* ko = KB + ((size_t)(b * 8 + hh) * KPOS + pos) * 96 + sub;
#pragma unroll
            for (int mq = 0; mq < 12; ++mq) ko[8 * mq] = f2bf(kv[mq]);
#pragma unroll
            for (int mq = 0; mq < 8; ++mq) { const int dv = sub + 8 * mq; VL[(hh * 64 + dv) * 64 + pl] = f2bf(KVPRE[(size_t)row * 1024 + hh * 128 + 64 + dv] * rskv); }
        }
        __syncthreads();
        { const int hd = C.tid;
            bf16* dst = VT + ((size_t)(b * 8 + (hd >> 6)) * 64 + (hd & 63)) * KPOS + pos0;
#pragma unroll
            for (int q = 0; q < 8; ++q) *(u32x4*)(dst + 8 * q) = *(const LAS u32x4*)(VL + hd * 64 + 8 * q); }
        __syncthreads();
    }
}

DI void ph_conv(const Ctx& C, const bf16* U, const float* dww  , const float* dwb, const float* lng, const float* lnb, bf16* OCAT) {
    LAS float* G = (LAS float*)C.lds;
    const int c = C.tid;
    float wk[31];
#pragma unroll
    for (int k = 0; k < 31; ++k) wk[k] = dww[k * 512 + c];
    const float bias = dwb[c];
    for (int u = C.vcu; u < MT / 32; u += C.nb) {
        const int row0 = 32 * u; int base, t0, tseq;
        if (row0 < NLAT) { base = row0 & ~4095; t0 = row0 & 4095; tseq = TL; } else { const int rc = row0 - NLAT; base = NLAT + (rc & ~255); t0 = rc & 255; tseq = LCX; }
        __syncthreads();
        for (int rr = 0; rr < 62; ++rr) { const int tt = t0 - 15 + rr; float g = 0.f;
            if (tt >= 0 && tt < tseq) { const bf16* ur = U + (size_t)(base + tt) * EV_INP; g = bf2f(ur[672 + c]) * sigmoidf_(bf2f(ur[1184 + c])); }
            G[rr * 512 + c] = g; }
        __syncthreads();
        float acc[32];
#pragma unroll
        for (int t = 0; t < 32; ++t) acc[t] = bias;
#pragma unroll
        for (int rr = 0; rr < 62; ++rr) { const float gv = G[rr * 512 + c];
#pragma unroll
            for (int t = 0; t < 32; ++t) { const int k = rr - t; if (k >= 0 && k < 31) acc[t] += gv * wk[k]; } }
        __syncthreads();
#pragma unroll
        for (int t = 0; t < 32; ++t) G[t * 512 + c] = acc[t];
        __syncthreads();
#pragma unroll
        for (int q = 0; q < 4; ++q) {
            const int t = 4 * C.wave + q, row = row0 + t;
            const f32x4 a0 = *(const LAS f32x4*)(G + t * 512 + 8 * C.lane), a1 = *(const LAS f32x4*)(G + t * 512 + 8 * C.lane + 4);
            float x[8] = {a0.x, a0.y, a0.z, a0.w, a1.x, a1.y, a1.z, a1.w}; float s = 0.f;
#pragma unroll
            for (int e = 0; e < 8; ++e) s += x[e];
            const float mu = wave_sum(s) * (1.f / 512.f); float s2 = 0.f;
#pragma unroll
            for (int e = 0; e < 8; ++e) { x[e] -= mu; s2 += x[e] * x[e]; }
            const float rstd = 1.0f / sqrtf(wave_sum(s2) * (1.f / 512.f) + EPS);
            float y[8];
#pragma unroll
            for (int e = 0; e < 8; ++e) { const float z = x[e] * rstd * lng[8 * C.lane + e] + lnb[8 * C.lane + e]; y[e] = siluf_(z); }
            *(u32x4*)(OCAT + (size_t)row * DM + 512 + 8 * C.lane) = pack8(y);
        }
    }
}

DI void shifted8(const bf16* up, const bf16* uc, const bf16* un, bool hp, bool hn, const float* sw, int c0, float (&o)[8]) {
    const u32x4 z = {0u, 0u, 0u, 0u};
    const u32x4 vp = hp ? *(const u32x4*)(up + c0) : z, vc = *(const u32x4*)(uc + c0), vn = hn ? *(const u32x4*)(un + c0) : z;
    float p[8], c[8], n[8]; unpack8(vp, p); unpack8(vc, c); unpack8(vn, n);
#pragma unroll
    for (int e = 0; e < 8; ++e) o[e] = p[e] * sw[c0 + e] + c[e] * sw[RW_IN + c0 + e] + n[e] * sw[2 * RW_IN + c0 + e];
}
DI void ph_prep(const Ctx& C, const bf16* U, const float* sw  , const float* kkw  , const float* naqg, const float* nakg,
                bf16* R, bf16* V, bf16* K, bf16* KK, bf16* L, bf16* QN, bf16* KN, bf16* VTN) {
    LAS bf16* VL = (LAS bf16*)C.lds;
    const int lane = C.lane, hh = lane >> 3, sub = lane & 7;
    const float C2 = 0.125f * LOG2E;
    for (int u = C.vcu; u < MT / 64; u += C.nb) {
        const int row0 = 64 * u; const bool lat = row0 < NLAT;
        const int b = lat ? (row0 >> 12) : ((row0 - NLAT) >> 8), pos0 = lat ? (row0 & 4095) : TL + ((row0 - NLAT) & 255), tseq = lat ? TL : LCX, tb = lat ? (row0 & 4095) : ((row0 - NLAT) & 255);
        for (int i = 0; i < 8; ++i) {
            const int pl = 8 * C.wave + i, row = row0 + pl, pos = pos0 + pl, t = tb + pl;
            const bool hp = t > 0, hn = t < tseq - 1;
            const bf16* uc = U + (size_t)row * OD_INP; const bf16* up = uc - OD_INP; const bf16* un = uc + OD_INP;
            float o[8];
            shifted8(up, uc, un, hp, hn, sw, 8 * lane, o);          *(u32x4*)(R + (size_t)row * 512 + 8 * lane) = pack8(o);
            shifted8(up, uc, un, hp, hn, sw, 1024 + 8 * lane, o);   *(u32x4*)(V + (size_t)row * 512 + 8 * lane) = pack8(o);
            shifted8(up, uc, un, hp, hn, sw, 512 + 8 * lane, o);    *(u32x4*)(K + (size_t)row * 512 + 8 * lane) = pack8(o);
            { float kk[8]; float ss = 0.f;
#pragma unroll
                for (int e = 0; e < 8; ++e) { kk[e] = o[e] * kkw[8 * lane + e]; ss += kk[e] * kk[e]; }
                ss = sum8(ss); const float rn = 1.0f / sqrtf(ss + 1e-12f);
#pragma unroll
                for (int e = 0; e < 8; ++e) kk[e] *= rn;
                *(u32x4*)(KK + (size_t)row * 512 + 8 * lane) = pack8(kk); }
            if (lane < 48) {
                shifted8(up, uc, un, hp, hn, sw, 1536 + 8 * lane, o);
                if (lane < 16) {
#pragma unroll
                    for (int e = 0; e < 8; ++e) { const float ex = __expf(2.f * o[e]); o[e] = 1.f - 2.f / (ex + 1.f); }
                } else if (lane >= 32) {
#pragma unroll
                    for (int e = 0; e < 8; ++e) o[e] = sigmoidf_(o[e]);
                }
                *(u32x4*)(L + (size_t)row * 384 + 8 * lane) = pack8(o);
            }
            { float x[8]; unpack8(*(const u32x4*)(uc + RW_IN + 8 * lane), x); float ss = 0.f;
#pragma unroll
                for (int e = 0; e < 8; ++e) ss += x[e] * x[e];
                ss = sum8(ss); const float rn = 1.0f / sqrtf(ss * (1.f / 64.f) + EPS);
#pragma unroll
                for (int e = 0; e < 8; ++e) x[e] = x[e] * rn * naqg[8 * sub + e] * C2;
                *(u32x4*)(QN + ((size_t)(b * 8 + hh) * KPOS + pos) * 64 + 8 * sub) = pack8(x); }
            { float x[8]; unpack8(*(const u32x4*)(uc + RW_IN + 512 + 8 * lane), x); float ss = 0.f;
#pragma unroll
                for (int e = 0; e < 8; ++e) ss += x[e] * x[e];
                ss = sum8(ss); const float rn = 1.0f / sqrtf(ss * (1.f / 64.f) + EPS);
#pragma unroll
                for (int e = 0; e < 8; ++e) x[e] = x[e] * rn * nakg[8 * sub + e];
                *(u32x4*)(KN + ((size_t)(b * 8 + hh) * KPOS + pos) * 64 + 8 * sub) = pack8(x); }
            { const u32x4 vv = *(const u32x4*)(uc + RW_IN + 1024 + 8 * lane); const unsigned w4[4] = {vv.x, vv.y, vv.z, vv.w};
#pragma unroll
                for (int e = 0; e < 8; ++e) { const int dv = 8 * sub + e; VL[(hh * 64 + dv) * 64 + pl] = (bf16)((e & 1) ? (w4[e >> 1] >> 16) : (w4[e >> 1] & 0xffffu)); } }
        }
        __syncthreads();
        { const int hd = C.tid; bf16* dst = VTN + ((size_t)(b * 8 + (hd >> 6)) * 64 + (hd & 63)) * KPOS + pos0;
#pragma unroll
            for (int q = 0; q < 8; ++q) *(u32x4*)(dst + 8 * q) = *(const LAS u32x4*)(VL + hd * 64 + 8 * q); }
        __syncthreads();
    }
}

DI int scan_row(int s, int d, int b) { if (s < LCX) return NLAT + b * LCX + (d ? (LCX - 1 - s) : s); const int t = s - LCX; return b * TL + (d ? (TL - 1 - t) : t); }
DI void ph_scan(const Ctx& C, const bf16* R, const bf16* V, const bf16* KK, const float* W, const bf16* KEFF, const bf16* BSC, float* YS) {
    constexpr int CH = 32, BUF = 5 * CH * 64 + CH * 32;
    LAS float* lds = (LAS float*)C.lds;
    LAS float* ystage = lds + 2 * BUF;
    const int tid = C.tid, i = tid >> 4, kq = tid & 15;
    for (int cid = C.bid; cid < 256; cid += C.nb) {
        const int b = cid >> 5, hh = (cid >> 2) & 7, d = (cid >> 1) & 1, hf = cid & 1;
        const float* Wd = W + (size_t)d * MT * 512; const bf16* KEd = KEFF + (size_t)d * MT * 512; const bf16* BSd = BSC + (size_t)d * MT * 512; float* Yd = YS + (size_t)d * MT * 512;
        float S[4] = {0.f, 0.f, 0.f, 0.f};
        const int sl = tid >> 4, sub = tid & 15;
        f32x4 lw; u32x4 l1, l2, l3;
        auto issue = [&](int ck) {
            const int row = scan_row(ck * CH + sl, d, b);
            lw = *(const f32x4*)(Wd + (size_t)row * 512 + hh * 64 + 4 * sub);
            if (sub < 8) { l1 = *(const u32x4*)(R + (size_t)row * 512 + hh * 64 + 8 * sub); l2 = *(const u32x4*)(KEd + (size_t)row * 512 + hh * 64 + 8 * sub); }
            else { l1 = *(const u32x4*)(KK + (size_t)row * 512 + hh * 64 + 8 * (sub - 8)); l2 = *(const u32x4*)(BSd + (size_t)row * 512 + hh * 64 + 8 * (sub - 8)); }
            if (sub < 4) l3 = *(const u32x4*)(V + (size_t)row * 512 + hh * 64 + 32 * hf + 8 * sub);
        };
        auto commit = [&](int bufi) {
            LAS float* B = lds + bufi * BUF;
            *(LAS f32x4*)(B + (1 * CH + sl) * 64 + 4 * sub) = lw;
            float f1[8], f2[8]; unpack8(l1, f1); unpack8(l2, f2);
            const int a1 = sub < 8 ? 0 : 3, a2 = sub < 8 ? 2 : 4, off = 8 * (sub & 7);
            *(LAS f32x4*)(B + (a1 * CH + sl) * 64 + off) = (f32x4){f1[0], f1[1], f1[2], f1[3]}; *(LAS f32x4*)(B + (a1 * CH + sl) * 64 + off + 4) = (f32x4){f1[4], f1[5], f1[6], f1[7]};
            *(LAS f32x4*)(B + (a2 * CH + sl) * 64 + off) = (f32x4){f2[0], f2[1], f2[2], f2[3]}; *(LAS f32x4*)(B + (a2 * CH + sl) * 64 + off + 4) = (f32x4){f2[4], f2[5], f2[6], f2[7]};
            if (sub < 4) { float f3[8]; unpack8(l3, f3); LAS float* vp = B + 5 * CH * 64 + sl * 32 + 8 * sub;
                *(LAS f32x4*)vp = (f32x4){f3[0], f3[1], f3[2], f3[3]}; *(LAS f32x4*)(vp + 4) = (f32x4){f3[4], f3[5], f3[6], f3[7]}; }
        };
        __syncthreads();
        issue(0); commit(0);
        __syncthreads();
        constexpr int NCK = KPOS / CH;
        for (int ck = 0; ck < NCK; ++ck) {
            if (ck + 1 < NCK) issue(ck + 1);
            const LAS float* B = lds + (ck & 1) * BUF; LAS float* ys = ystage + (ck & 1) * CH * 32;
#pragma unroll 4
            for (int s = 0; s < CH; ++s) {
                const f32x4 rr = *(const LAS f32x4*)(B + (0 * CH + s) * 64 + 4 * kq), ww = *(const LAS f32x4*)(B + (1 * CH + s) * 64 + 4 * kq), ke = *(const LAS f32x4*)(B + (2 * CH + s) * 64 + 4 * kq),
                            kk = *(const LAS f32x4*)(B + (3 * CH + s) * 64 + 4 * kq), bs = *(const LAS f32x4*)(B + (4 * CH + s) * 64 + 4 * kq);
                const float v = B[5 * CH * 64 + s * 32 + i];
                float sa = -(S[0] * kk.x + S[1] * kk.y + S[2] * kk.z + S[3] * kk.w);
                sa = sum16(sa);
                S[0] = S[0] * ww.x + (sa * bs.x + v * ke.x); S[1] = S[1] * ww.y + (sa * bs.y + v * ke.y); S[2] = S[2] * ww.z + (sa * bs.z + v * ke.z); S[3] = S[3] * ww.w + (sa * bs.w + v * ke.w);
                float y = S[0] * rr.x + S[1] * rr.y + S[2] * rr.z + S[3] * rr.w;
                y = sum16(y);
                if (kq == 0) ys[s * 32 + i] = y;
            }
            if (ck + 1 < NCK) commit((ck + 1) & 1);
            __syncthreads();
            if (tid < 256) { const int s = tid >> 3, q = tid & 7; const int row = scan_row(ck * CH + s, d, b);
                *(f32x4*)(Yd + (size_t)row * 512 + hh * 64 + 32 * hf + 4 * q) = *(const LAS f32x4*)(ys + s * 32 + 4 * q); }
        }
    }
}

DI void ph_post(const Ctx& C, const float* YS, const bf16* R, const bf16* V, const bf16* KEFF, const bf16* G, const float* rk, const float* gng, const float* gnb, bf16* OCAT, bool last) {
    const int gw = C.bid * 8 + C.wave, ngw = C.nb * 8, lane = C.lane, nrows = last ? NLAT : MT;
    for (int row = gw; row < nrows; row += ngw) {
        const size_t o = (size_t)row * 512 + 8 * lane;
        const f32x4 y0a = *(const f32x4*)(YS + o), y0b = *(const f32x4*)(YS + o + 4), y1a = *(const f32x4*)(YS + (size_t)MT * 512 + o), y1b = *(const f32x4*)(YS + (size_t)MT * 512 + o + 4);
        float y[8] = {y0a.x + y1a.x, y0a.y + y1a.y, y0a.z + y1a.z, y0a.w + y1a.w, y0b.x + y1b.x, y0b.y + y1b.y, y0b.z + y1b.z, y0b.w + y1b.w};
        float r[8], v[8], k0[8], k1[8], g[8];
        unpack8(*(const u32x4*)(R + o), r); unpack8(*(const u32x4*)(V + o), v); unpack8(*(const u32x4*)(KEFF + o), k0); unpack8(*(const u32x4*)(KEFF + (size_t)MT * 512 + o), k1); unpack8(*(const u32x4*)(G + o), g);
        float bsum = 0.f;
#pragma unroll
        for (int e = 0; e < 8; ++e) bsum += r[e] * (k0[e] + k1[e]) * rk[8 * lane + e];
        bsum = sum8(bsum);
        float s = 0.f;
#pragma unroll
        for (int e = 0; e < 8; ++e) { y[e] += bsum * v[e]; s += y[e]; }
        const float mu = sum8(s) * (1.f / 64.f); float s2 = 0.f;
#pragma unroll
        for (int e = 0; e < 8; ++e) { y[e] -= mu; s2 += y[e] * y[e]; }
        const float rstd = 1.0f / sqrtf(sum8(s2) * (1.f / 64.f) + GN_EPS);
        float out[8];
#pragma unroll
        for (int e = 0; e < 8; ++e) out[e] = (y[e] * rstd * gng[8 * lane + e] + gnb[8 * lane + e]) * g[e];
        *(u32x4*)(OCAT + (size_t)row * DM + 8 * lane) = pack8(out);
    }
}

DI void ph_topk(const Ctx& C, const float* AFFT, const float* AFFC, int* ROWS, float* GATE, int* SLOT, bool last) {
    LAS unsigned long long* key = (LAS unsigned long long*)C.lds;
    const int nprob = last ? 128 : 256;
    for (int p = C.bid; p < nprob; p += C.nb) {
        const bool isctx = p >= 128; const int be = p & 127, b = be >> 4, e = be & 15;
        const int n = isctx ? LCX : TL, cap = isctx ? CAPC : CAPL;
        const float* src = isctx ? AFFC + (size_t)be * LCX : AFFT + (size_t)be * TL;
        __syncthreads();
        for (int t = C.tid; t < n; t += 512) key[t] = ((unsigned long long)__builtin_bit_cast(unsigned, src[t]) << 32) | (unsigned long long)(0xFFFFFFFFu - (unsigned)t);
        __syncthreads();
        for (int k = 2; k <= n; k <<= 1)
            for (int j = k >> 1; j > 0; j >>= 1) {
                for (int q = C.tid; q < n / 2; q += 512) {
                    const int i = ((q & ~(j - 1)) << 1) | (q & (j - 1)), ix = i | j;
                    const unsigned long long a = key[i], bb = key[ix];
                    const bool desc = ((i & k) == 0);
                    if (desc ? (a < bb) : (a > bb)) { key[i] = bb; key[ix] = a; }
                }
                __syncthreads();
            }
        for (int jx = C.tid; jx < cap; jx += 512) {
            const unsigned long long kv = key[jx]; const int t = (int)(0xFFFFFFFFu - (unsigned)(kv & 0xFFFFFFFFull)); const float g = __builtin_bit_cast(float, (unsigned)(kv >> 32));
            const int slot = isctx ? NB * CAPL + b * CAPC + jx : b * CAPL + jx, row = isctx ? NLAT + b * LCX + t : b * TL + t;
            ROWS[e * ESLOTS + slot] = row; GATE[e * ESLOTS + slot] = g; SLOT[(size_t)row * 16 + e] = slot;
        }
    }
}

DI void ph_combine(const Ctx& C, float* xlat, float* xctx, const float* modg2  , const int* SLOT, const bf16* Y2, bool last) {
    const int gw = C.bid * 8 + C.wave, ngw = C.nb * 8, lane = C.lane, nrows = last ? NLAT : MT;
    for (int row = gw; row < nrows; row += ngw) {
        float* xr = row < NLAT ? xlat + (size_t)row * DM : xctx + (size_t)(row - NLAT) * DM;
        const int mi = row < NLAT ? (row >> 12) : 8;
        const int sv = SLOT[(size_t)row * 16 + (lane & 15)];
        f32x4 acc[4];
#pragma unroll
        for (int j = 0; j < 4; ++j) acc[j] = (f32x4){0.f, 0.f, 0.f, 0.f};
#pragma unroll
        for (int e = 0; e < 16; ++e) {
            const int s = __builtin_amdgcn_readlane(sv, e);
            if (s >= 0) { const bf16* yp = Y2 + ((size_t)e * ESLOTS + s) * DM + 4 * lane;
#pragma unroll
                for (int j = 0; j < 4; ++j) { const u32x2 w = *(const u32x2*)(yp + 256 * j); acc[j] += (f32x4){bflo(w.x), bfhi(w.x), bflo(w.y), bfhi(w.y)}; } }
        }
#pragma unroll
        for (int j = 0; j < 4; ++j) { const int c = 256 * j + 4 * lane; const f32x4 g = *(const f32x4*)(modg2 + mi * 6144 + c); f32x4 x = *(const f32x4*)(xr + c); x += g * acc[j]; *(f32x4*)(xr + c) = x; }
    }
}

template <class T> DI T* launder_ptr(T* p) { unsigned long long v = (unsigned long long)p; unsigned lo = (unsigned)v, hi = (unsigned)(v >> 32); asm volatile("" : "+v"(lo), "+v"(hi));
    lo = __builtin_amdgcn_readfirstlane(lo); hi = __builtin_amdgcn_readfirstlane(hi); return (T*)(__attribute__((address_space(1))) T*)(((unsigned long long)hi << 32) | lo); }
constexpr int PH_PER_PAIR = 24, N_PHASES = 1 + 2 * PH_PER_PAIR;
constexpr size_t WS_PTRS = 128 * 1024;
#define P_XC    ((float*)(ws + WS_XC))
#define P_MOD   ((const float*)(ws + WS_MOD))
#define P_HB    ((bf16*)(ws + WS_HB))
#define P_OCAT  ((bf16*)(ws + WS_OCAT))
#define P_AR    (ws + WS_ARENA)
#define P_ROWS  ((int*)(ws + WS_ROWS))
#define P_GATE  ((float*)(ws + WS_GATE))
#define P_SLOT  ((int*)(ws + WS_SLOT))
#define P_AFFT  ((float*)(ws + WS_AFFT))
#define P_AFFC  ((float*)(ws + WS_AFFC))
#define P_W13   ((bf16*)(ws + WS_W13))
#define P_W2    ((bf16*)(ws + WS_W2))
#define P_U     ((bf16*)(P_AR + A_U))
#define P_QPRE  ((float*)(P_AR + A_QPRE))
#define P_KVPRE ((float*)(P_AR + A_KVPRE))
#define P_QB    ((bf16*)(P_AR + A_QB))
#define P_KB    ((bf16*)(P_AR + A_KB))
#define P_VT    ((bf16*)(P_AR + A_VT))
#define P_W     ((float*)(P_AR + A_W))
#define P_KEFF  ((bf16*)(P_AR + A_KEFF))
#define P_BSC   ((bf16*)(P_AR + A_BSC))
#define P_R     ((bf16*)(P_AR + A_R))
#define P_V     ((bf16*)(P_AR + A_V))
#define P_KK    ((bf16*)(P_AR + A_KK))
#define P_G     ((bf16*)(P_AR + A_G))
#define P_K     ((bf16*)(P_AR + A_K))
#define P_L     ((bf16*)(P_AR + A_L))
#define P_QN    ((bf16*)(P_AR + A_QN))
#define P_KN    ((bf16*)(P_AR + A_KN))
#define P_VTN   ((bf16*)(P_AR + A_VTN))
#define P_YS    ((float*)(P_AR + A_YS))
#define P_HID   ((bf16*)(P_AR + A_HID))
#define P_Y2    ((bf16*)(P_AR + A_Y2))
#define MODL(i) (P_MOD + (size_t)(i) * 9 * 6144)
#define RELAUNDER() do { int l_ = C.lane; asm volatile("" : "+v"(l_)); C.lane = l_; C.tid = (C.wave << 6) | l_; } while (0)
__global__ void __launch_bounds__(512, 2) fwd_kernel(Args a) {
    extern __shared__ __attribute__((aligned(16))) unsigned char smem[];
    Ctx C0; C0.lds = (LAS unsigned char*)smem; C0.tid = threadIdx.x; C0.lane = C0.tid & 63; C0.wave = __builtin_amdgcn_readfirstlane(C0.tid >> 6); C0.bid = blockIdx.x; C0.nb = gridDim.x;
    C0.vcu = (C0.nb % 8 == 0) ? (C0.bid % 8) * (C0.nb / 8) + C0.bid / 8 : C0.bid;
    volatile LAS unsigned* bst = (volatile LAS unsigned*)(C0.lds + LDS_BYTES - 16);
#if MEGA
    if (C0.tid == 0) { bst[0] = 0u; bst[1] = 0u; }
    __syncthreads();
    const unsigned bar_x = xcd_barrier_post((unsigned*)(a.ws + WS_CTL) + 4096, bst, C0.tid == 0).x;
#define SEAM() do { if (ph < hi) { XcdBarrier b2_; unsigned zb_ = 0u; asm volatile("" : "+s"(zb_)); b2_.bar = (unsigned*)(a.ws + WS_CTL) + 4096 + zb_; b2_.x = bar_x; b2_.st = bst; xcd_barrier(b2_, C.tid == 0); } } while (0)
#else
#define SEAM() do { } while (0)
#endif
#if MEGA
    constexpr int lo = 0, hi = N_PHASES;
#else
    const int lo = a.ph_lo, hi = a.ph_hi;
#endif
    int ph = 0;
#ifndef ONLY
#define ONLY -1
#endif
#ifndef REPMASK
#define REPMASK 0
#endif
#ifndef SITE_LO
#define SITE_LO 0
#define SITE_HI 99
#endif
#define PHASE(SITE, ...) do { if ((ONLY < 0 || ONLY == (SITE)) && (SITE) >= SITE_LO && (SITE) <= SITE_HI && ph >= lo && ph < hi) { Ctx C; C.lds = C0.lds; \
        { int w_ = C0.wave; asm volatile("" : "+s"(w_)); unsigned m_ = ~0u; asm volatile("" : "+s"(m_)); int l_ = (int)__builtin_amdgcn_mbcnt_hi(m_, __builtin_amdgcn_mbcnt_lo(m_, 0u)); C.wave = w_; C.lane = l_; C.tid = (w_ << 6) | l_; } \
        { int b_ = C0.bid, n_ = C0.nb, v_ = C0.vcu; asm volatile("" : "+s"(b_), "+s"(n_), "+s"(v_)); C.bid = b_; C.nb = n_; C.vcu = v_; } \
        unsigned z_ = 0u; asm volatile("" : "+s"(z_)); unsigned char* ws = a.ws + z_; float* XL = a.out + z_; const int lq = __builtin_amdgcn_readfirstlane(lp); typedef const __attribute__((address_space(1))) float* gfp_t; const gfp_t* INT_ = (const gfp_t*)(ws + WS_PTRS); (void)INT_; (void)XL; (void)lq; \
        for (int rep_ = 0; rep_ < ((((REPMASK) >> (SITE)) & 1) ? 2 : 1); ++rep_) { __VA_ARGS__; if ((((REPMASK) >> (SITE)) & 1)) __syncthreads(); } ++ph; SEAM(); } else ++ph; } while (0)

    { const int lp = 0;
      PHASE(0, { if (C.bid == 0) { _Pragma("unroll") for (int k = 0; k < 40; ++k) if (C.tid == k) ((const float**)(ws + WS_PTRS))[k] = a.in[k]; }
                 ph_prologue(C, a); }); }

    for (int lp = 0; lp < 2; ++lp) {
        PHASE(1, { const int i = 2 * lq; const float* xl = (i == 0) ? ((const float*)INT_[I_X]) : XL; const float* xc = (i == 0) ? ((const float*)INT_[I_CTX]) : P_XC;
                   ph_norm<false>(C, xl, xc, ((const float*)INT_[I_N1G]) + i * DM, MODL(i), 0, 1024, P_HB, nullptr, nullptr, nullptr, nullptr);
                   moe_weight_prep(C, ((const float*)INT_[I_MW1]) + (size_t)i * NEXP * DM * DM, ((const float*)INT_[I_MW3]) + (size_t)i * NEXP * DM * DM, ((const float*)INT_[I_MW2]) + (size_t)i * NEXP * DM * DM, P_W13, P_W2); });
        PHASE(2, { EpiBf16 E{P_U, EV_INP}; fast_gemm(C, P_HB, DM, (const bf16*)(ws + WS_WEVIN) + (size_t)lq * EV_INP * DM, DM, MT / 256, EV_INP / 256, E); });
        PHASE(3, { EpiF32 Eq{P_QPRE, 768}; fast_gemm(C, P_U, EV_INP, (const bf16*)(ws + WS_WUQ) + (size_t)lq * 768 * 384, 384, MT / 256, 3, Eq); RELAUNDER();
                   EpiF32 Ek{P_KVPRE, 1024}; fast_gemm(C, P_U + 384, EV_INP, (const bf16*)(ws + WS_WUKV) + (size_t)lq * 1024 * 256, 256, MT / 256, 4, Ek); });
        PHASE(4, { ph_mla_fin(C, P_U, P_QPRE, P_KVPRE, ((const float*)INT_[I_QG]) + lq * 96, ((const float*)INT_[I_KG]) + lq * 96, (const f32x2*)(ws + WS_ROPE), P_QB, P_KB, P_VT);
                   ph_conv(C, P_U, ((const float*)INT_[I_DWW]) + (size_t)lq * 31 * 512, ((const float*)INT_[I_DWB]) + lq * 512, ((const float*)INT_[I_LNG]) + lq * 512, ((const float*)INT_[I_LNB]) + lq * 512, P_OCAT); });
        PHASE(5, ph_attn_mla2(C, P_QB, P_KB, P_VT, P_OCAT, false));
        PHASE(6, { const int i = 2 * lq; const float* xl = (i == 0) ? ((const float*)INT_[I_X]) : XL; const float* xc = (i == 0) ? ((const float*)INT_[I_CTX]) : P_XC;
                   EpiResid E{xl, xc, XL, P_XC, MODL(i) + 2048}; fast_gemm(C, P_OCAT, DM, (const bf16*)(ws + WS_WEVOUT) + (size_t)lq * DM * DM, DM, MT / 256, 4, E); });
        PHASE(7, { const int i = 2 * lq; ph_norm<true>(C, XL, P_XC, ((const float*)INT_[I_N2G]) + i * DM, MODL(i), 3072, 4096, P_HB, ((const float*)INT_[I_ROUTER]) + (size_t)i * DM * 16, P_AFFT, P_AFFC, P_SLOT); });
        PHASE(8, ph_topk(C, P_AFFT, P_AFFC, P_ROWS, P_GATE, P_SLOT, false));
        PHASE(9, { pg8::Gemm g{P_HB, P_W13, DM, DM, P_ROWS}; pg8::OrderMoE S{17, 8, 17, C.nb, C.vcu}; pg8::EpiAdapt<EpiGlu> E{EpiGlu{P_HID}}; pg8::gemm_phase(C.lds, g, S, E, C.tid); });
        PHASE(10, { pg8::Gemm g{P_HID, P_W2, DM, DM, nullptr}; pg8::OrderMoE S{17, 4, 17, C.nb, C.vcu}; pg8::EpiAdapt<EpiGate> E{EpiGate{P_Y2, P_GATE}}; pg8::gemm_phase(C.lds, g, S, E, C.tid); });
        PHASE(11, { const int i = 2 * lq; ph_combine(C, XL, P_XC, MODL(i) + 5120, P_SLOT, P_Y2, false); });
        PHASE(12, { const int i = 2 * lq + 1; ph_norm<false>(C, XL, P_XC, ((const float*)INT_[I_N1G]) + i * DM, MODL(i), 0, 1024, P_HB, nullptr, nullptr, nullptr, nullptr);
                    moe_weight_prep(C, ((const float*)INT_[I_MW1]) + (size_t)i * NEXP * DM * DM, ((const float*)INT_[I_MW3]) + (size_t)i * NEXP * DM * DM, ((const float*)INT_[I_MW2]) + (size_t)i * NEXP * DM * DM, P_W13, P_W2); });
        PHASE(13, { EpiBf16 E{P_U, OD_INP}; fast_gemm(C, P_HB, DM, (const bf16*)(ws + WS_WODIN) + (size_t)lq * OD_INP * DM, DM, MT / 256, OD_INP / 256, E); });
        PHASE(14, ph_prep(C, P_U, ((const float*)INT_[I_SHIFTW]) + (size_t)lq * 3 * RW_IN, ((const float*)INT_[I_KKW]) + lq * 512, ((const float*)INT_[I_NAQG]) + lq * 64, ((const float*)INT_[I_NAKG]) + lq * 64, P_R, P_V, P_K, P_KK, P_L, P_QN, P_KN, P_VTN));
        PHASE(15, { const bf16* WL = (const bf16*)(ws + WS_WLORA) + (size_t)lq * 196608;
                    for (int u = C.vcu; u < (MT / 256) * 10; u += C.nb) { const int pm = u / 10, q = u % 10;
                        if (q < 4) { const int d = q >> 1, pn = q & 1; EpiLoraW E{P_W + (size_t)d * MT * 512, ((const float*)INT_[I_W0]) + lq * 1024 + d * 512};
                            gemm_unit(P_L + d * 64, 384, nullptr, WL + (size_t)d * 32768, 64, pm, pn, E, C.wave, C.lane); }
                        else if (q < 8) { const int d = (q - 4) >> 1, pn = q & 1; EpiLoraA E{P_KEFF + (size_t)d * MT * 512, P_BSC + (size_t)d * MT * 512, P_K, P_KK, ((const float*)INT_[I_A0]) + lq * 1024 + d * 512, ((const float*)INT_[I_KA]) + lq * 512};
                            gemm_unit(P_L + 128 + d * 64, 384, nullptr, WL + 65536 + (size_t)d * 32768, 64, pm, pn, E, C.wave, C.lane); }
                        else { const int pn = q & 1; EpiBf16 E{P_G, 512}; gemm_unit(P_L + 256, 384, nullptr, WL + 131072, 128, pm, pn, E, C.wave, C.lane); } } });
        PHASE(16, ph_natten(C, P_QN, P_KN, P_VTN, P_OCAT, ((const float*)INT_[I_RPB]) + (size_t)lq * 8 * 465, lq == 1));
        PHASE(17, ph_scan(C, P_R, P_V, P_KK, P_W, P_KEFF, P_BSC, P_YS));
        PHASE(18, ph_post(C, P_YS, P_R, P_V, P_KEFF, P_G, ((const float*)INT_[I_RK]) + lq * 512, ((const float*)INT_[I_GNG]) + lq * 512, ((const float*)INT_[I_GNB]) + lq * 512, P_OCAT, lq == 1));
        PHASE(19, { const int i = 2 * lq + 1; EpiResid E{XL, P_XC, XL, P_XC, MODL(i) + 2048};
                    fast_gemm(C, P_OCAT, DM, (const bf16*)(ws + WS_WODOUT) + (size_t)lq * DM * DM, DM, (lq == 1) ? NLAT / 256 : MT / 256, 4, E); });
        PHASE(20, { const int i = 2 * lq + 1; ph_norm<true>(C, XL, P_XC, ((const float*)INT_[I_N2G]) + i * DM, MODL(i), 3072, 4096, P_HB, ((const float*)INT_[I_ROUTER]) + (size_t)i * DM * 16, P_AFFT, P_AFFC, P_SLOT); });
        PHASE(21, ph_topk(C, P_AFFT, P_AFFC, P_ROWS, P_GATE, P_SLOT, lq == 1));
        PHASE(22, { pg8::Gemm g{P_HB, P_W13, DM, DM, P_ROWS}; pg8::OrderMoE S{(lq == 1) ? 16 : 17, 8, 17, C.nb, C.vcu}; pg8::EpiAdapt<EpiGlu> E{EpiGlu{P_HID}}; pg8::gemm_phase(C.lds, g, S, E, C.tid); });
        PHASE(23, { pg8::Gemm g{P_HID, P_W2, DM, DM, nullptr}; pg8::OrderMoE S{(lq == 1) ? 16 : 17, 4, 17, C.nb, C.vcu}; pg8::EpiAdapt<EpiGate> E{EpiGate{P_Y2, P_GATE}}; pg8::gemm_phase(C.lds, g, S, E, C.tid); });
        PHASE(24, { const int i = 2 * lq + 1; ph_combine(C, XL, P_XC, MODL(i) + 5120, P_SLOT, P_Y2, lq == 1); });
    }
}

extern "C" void kernel_launch(void* const* d_in, const int* in_sizes, int n_in, void* d_out, int out_size, void* d_ws, size_t ws_size, hipStream_t stream) {
    static int grid = 0;
    if (grid == 0) {
        if (n_in != 40 || out_size != NLAT * DM || ws_size < WS_END) { fprintf(stderr, "kernel_launch: unexpected shapes (n_in %d out %d ws %zu need %zu)\n", n_in, out_size, ws_size, (size_t)WS_END); grid = -1; return; }
        int dev = 0, cus = 0, per_cu = 0;
        if (hipGetDevice(&dev) != hipSuccess || hipDeviceGetAttribute(&cus, hipDeviceAttributeMultiprocessorCount, dev) != hipSuccess) { grid = -1; return; }
        if (hipFuncSetAttribute((const void*)fwd_kernel, hipFuncAttributeMaxDynamicSharedMemorySize, LDS_BYTES) != hipSuccess) { fprintf(stderr, "kernel_launch: hipFuncSetAttribute failed\n"); grid = -1; return; }
        if (hipOccupancyMaxActiveBlocksPerMultiprocessor(&per_cu, (const void*)fwd_kernel, 512, LDS_BYTES) != hipSuccess || per_cu < 1) { fprintf(stderr, "kernel_launch: occupancy query says %d\n", per_cu); per_cu = 1; }
        (void)hipGetLastError();
        grid = cus;
    }
    if (grid < 0) return;
    (void)hipMemsetAsync((char*)d_ws + WS_CTL, 0, CTL_BYTES, stream);
    Args a{};
    for (int i = 0; i < 40; ++i) a.in[i] = (const float*)d_in[i];
    a.out = (float*)d_out; a.ws = (unsigned char*)d_ws;
#if MEGA
    a.ph_lo = 0; a.ph_hi = N_PHASES;
    hipLaunchKernelGGL(fwd_kernel, dim3(grid), dim3(512), LDS_BYTES, stream, a);
#else
    for (int p = 0; p < N_PHASES; ++p) { a.ph_lo = p; a.ph_hi = p + 1; hipLaunchKernelGGL(fwd_kernel, dim3(grid), dim3(512), LDS_BYTES, stream, a); }
#endif
}
```

```cpp
#include <hip/hip_runtime.h>
#include <cstdio>
#include <cstdint>

#ifndef MEGA
#define MEGA 1
#endif

#define LAS __attribute__((address_space(3)))
#define DI __device__ __forceinline__

typedef unsigned short bf16;
typedef short bf16x8 __attribute__((ext_vector_type(8)));
typedef float f32x4 __attribute__((ext_vector_type(4)));
typedef float f32x2 __attribute__((ext_vector_type(2)));
typedef float f32x16 __attribute__((ext_vector_type(16)));
typedef unsigned u32x4 __attribute__((ext_vector_type(4)));
typedef unsigned u32x2 __attribute__((ext_vector_type(2)));
typedef __bf16 bf16x2_t __attribute__((ext_vector_type(2)));

constexpr int DM = 1024, NB = 8, TL = 4096, LCX = 256;
constexpr int NLAT = NB * TL, NCTX = NB * LCX, MT = NLAT + NCTX;
constexpr int KPOS = TL + LCX;
constexpr float EPS = 1e-6f, GN_EPS = 64e-5f;
constexpr int EV_IN = 1696, EV_INP = 1792, OD_IN = 3456, OD_INP = 3584, RW_IN = 1920;
constexpr int NEXP = 16, CAPL = 512, CAPC = 32, ESLOTS = NB * CAPL + NB * CAPC;
constexpr float LOG2E = 1.4426950408889634f;

constexpr size_t MiB = 1ull << 20;
constexpr size_t WS_CTL = 0, CTL_BYTES = 1 * MiB;
constexpr size_t WS_MOD = 1 * MiB, WS_ROPE = 2 * MiB, WS_XC = 4 * MiB;
constexpr size_t WS_ROWS = 12 * MiB, WS_GATE = 12 * MiB + 512 * 1024, WS_SLOT = 13 * MiB, WS_AFFT = 16 * MiB, WS_AFFC = 18 * MiB;
constexpr size_t WS_WEVIN = 20 * MiB, WS_WEVOUT = 27 * MiB, WS_WUQ = 31 * MiB, WS_WUKV = 33 * MiB, WS_WODIN = 34 * MiB, WS_WODOUT = 48 * MiB, WS_WLORA = 52 * MiB;
constexpr size_t WS_W13 = 56 * MiB, WS_W2 = 120 * MiB, WS_HB = 152 * MiB, WS_OCAT = 220 * MiB, WS_ARENA = 288 * MiB;
constexpr size_t A_U = 0, A_QPRE = 119 * MiB, A_KVPRE = 221 * MiB, A_QB = 357 * MiB, A_KB = 408 * MiB, A_VT = 459 * MiB;
constexpr size_t A_W = 0, A_KEFF = 136 * MiB, A_BSC = 204 * MiB, A_R = 272 * MiB, A_V = 306 * MiB, A_KK = 340 * MiB, A_G = 374 * MiB, A_K = 408 * MiB, A_L = 442 * MiB,
                 A_QN = 468 * MiB, A_KN = 502 * MiB, A_VTN = 536 * MiB, A_YS = 408 * MiB;
constexpr size_t A_HID = 0, A_Y2 = 136 * MiB;
constexpr size_t WS_END = WS_ARENA + 570 * MiB;
constexpr int LDS_BYTES = 147456;

DI unsigned pk2(float lo, float hi) { f32x2 v = {lo, hi}; bf16x2_t b = __builtin_convertvector(v, bf16x2_t); return __builtin_bit_cast(unsigned, b); }
DI float bflo(unsigned u) { return __builtin_bit_cast(float, u << 16); }
DI float bfhi(unsigned u) { return __builtin_bit_cast(float, u & 0xffff0000u); }
DI float bf2f(bf16 x) { return __builtin_bit_cast(float, ((unsigned)x) << 16); }
DI bf16 f2bf(float f) { return (bf16)(pk2(f, 0.f) & 0xffffu); }
DI void unpack8(u32x4 v, float (&f)[8]) { f[0] = bflo(v.x); f[1] = bfhi(v.x); f[2] = bflo(v.y); f[3] = bfhi(v.y); f[4] = bflo(v.z); f[5] = bfhi(v.z); f[6] = bflo(v.w); f[7] = bfhi(v.w); }
DI u32x4 pack8(const float (&f)[8]) { u32x4 r; r.x = pk2(f[0], f[1]); r.y = pk2(f[2], f[3]); r.z = pk2(f[4], f[5]); r.w = pk2(f[6], f[7]); return r; }
#define DPP_ADD(x, ctrl) ((x) + __builtin_bit_cast(float, __builtin_amdgcn_update_dpp(0, __builtin_bit_cast(int, (x)), (ctrl), 0xf, 0xf, false)))
#define DPP_MAX(x, ctrl) fmaxf((x), __builtin_bit_cast(float, __builtin_amdgcn_update_dpp(0, __builtin_bit_cast(int, (x)), (ctrl), 0xf, 0xf, false)))
DI float sum8(float x) { x = DPP_ADD(x, 0xB1); x = DPP_ADD(x, 0x4E); x = DPP_ADD(x, 0x141); return x; }
DI float sum16(float x) { x = DPP_ADD(x, 0xB1); x = DPP_ADD(x, 0x4E); x = DPP_ADD(x, 0x141); x = DPP_ADD(x, 0x140); return x; }
DI float max16(float x) { x = DPP_MAX(x, 0xB1); x = DPP_MAX(x, 0x4E); x = DPP_MAX(x, 0x141); x = DPP_MAX(x, 0x140); return x; }
DI float rdlane(float x, int l) { return __builtin_bit_cast(float, __builtin_amdgcn_readlane(__builtin_bit_cast(int, x), l)); }
DI float wave_sum(float v) { const float x = sum16(v); return (rdlane(x, 0) + rdlane(x, 16)) + (rdlane(x, 32) + rdlane(x, 48)); }
DI float xor32(float v, int lane) { return __builtin_bit_cast(float, __builtin_amdgcn_ds_bpermute((lane ^ 32) << 2, __builtin_bit_cast(int, v))); }
DI float sigmoidf_(float x) { return 1.f / (1.f + __expf(-x)); }
DI float siluf_(float x) { return x / (1.f + __expf(-x)); }
#define MFMA32(a, b, c) __builtin_amdgcn_mfma_f32_32x32x16_bf16((a), (b), (c), 0, 0, 0)

#define XB_TMO      128
#define XB_XCNT(j)  (256  + 64 * (j))
#define XB_XSUB(j)  (1280 + 64 * (j))
#define XB_XGEN(j)  (2304 + 64 * (j))
#define XB_TOP      3328
#define XB_TOPGEN   3392
#define XCD_BAR_WORDS 3456
#define XB_SPIN_CAP (1u << 22)
__device__ __forceinline__ unsigned xb_ld(unsigned* p)              { return __hip_atomic_load(p, __ATOMIC_RELAXED, __HIP_MEMORY_SCOPE_AGENT); }
__device__ __forceinline__ unsigned xb_add(unsigned* p, unsigned v) { return __hip_atomic_fetch_add(p, v, __ATOMIC_RELAXED, __HIP_MEMORY_SCOPE_AGENT); }
__device__ __forceinline__ unsigned xb_xcc_id() { return (unsigned)__builtin_amdgcn_s_getreg((3 << 11) | 20) & 0xFu; }
#define XB_SPIN(cond, bar) do { unsigned _sp = 0; while (cond) { __builtin_amdgcn_s_sleep(1); \
    if ((++_sp & 255u) == 0u) { if (xb_ld(&(bar)[XB_TMO])) break; if (_sp > XB_SPIN_CAP) { atomicAdd(&(bar)[XB_TMO], 1u); break; } } } } while (0)
struct XcdBarrier { unsigned* bar; unsigned x; volatile LAS unsigned* st; };
__device__ __forceinline__ XcdBarrier xcd_barrier_post(unsigned* bar, volatile LAS unsigned* st, bool leader) {
    XcdBarrier b; b.bar = bar; b.x = xb_xcc_id(); b.st = st;
    if (leader) (void)xb_add(&bar[XB_XCNT(b.x)], 1u);
    return b;
}
__device__ __forceinline__ void xcd_barrier_complete(unsigned* bar, unsigned x, unsigned& nloc, unsigned& nx) {
    const unsigned G = gridDim.x * gridDim.y * gridDim.z;
    unsigned sum, cnt, mine, sp = 0u;
    for (;;) {
        sum = 0u; cnt = 0u; mine = 0u;
#pragma unroll
        for (unsigned j = 0; j < 16; ++j) { const unsigned c = xb_ld(&bar[XB_XCNT(j)]); sum += c; cnt += (c > 0u) ? 1u : 0u; mine = (j == x) ? c : mine; }
        if (sum == G) break;
        __builtin_amdgcn_s_sleep(1);
        if ((++sp & 255u) == 0u) { if (xb_ld(&bar[XB_TMO])) break; if (sp > XB_SPIN_CAP) { atomicAdd(&bar[XB_TMO], 1u); break; } }
    }
    nloc = mine > 0u ? mine : 1u; nx = cnt > 0u ? cnt : 1u;
}
__device__ __forceinline__ void xcd_barrier(const XcdBarrier& b, bool leader) {
    asm volatile("s_waitcnt vmcnt(0)" ::: "memory");
    __syncthreads();
    if (leader) {
        unsigned* bar = b.bar;
        __builtin_amdgcn_s_waitcnt(0);
        unsigned nloc = b.st[0], nx = b.st[1];
        if (nloc == 0u) { xcd_barrier_complete(bar, b.x, nloc, nx); b.st[0] = nloc; b.st[1] = nx; }
        const unsigned old = xb_add(&bar[XB_XSUB(b.x)], 1u);
        const unsigned gen = old / nloc;
        if (old + 1u == (gen + 1u) * nloc) {
            __builtin_amdgcn_fence(__ATOMIC_RELEASE, "agent");
            asm volatile("s_waitcnt vmcnt(0)" ::: "memory");
            const unsigned og = xb_add(&bar[XB_TOP], 1u);
            const unsigned tg = og / nx;
            if (og + 1u == (tg + 1u) * nx) xb_add(&bar[XB_TOPGEN], 1u);
            else XB_SPIN(xb_ld(&bar[XB_TOPGEN]) == tg, bar);
            __builtin_amdgcn_fence(__ATOMIC_ACQUIRE, "agent");
            xb_add(&bar[XB_XGEN(b.x)], 1u);
            asm volatile("s_waitcnt vmcnt(0)" ::: "memory");
        } else {
            XB_SPIN(xb_ld(&bar[XB_XGEN(b.x)]) == gen, bar);
            __builtin_amdgcn_fence(__ATOMIC_ACQUIRE, "agent");
            asm volatile("s_waitcnt vmcnt(0)" ::: "memory");
        }
    }
    __syncthreads();
}

struct Ctx { LAS unsigned char* lds; int tid, lane, wave, bid, nb, vcu; };
struct Args { const float* in[40]; float* out; unsigned char* ws; int ph_lo, ph_hi; };
enum { I_X = 0, I_C, I_CTX, I_CCTX, I_ADAW, I_ADAB, I_N1G, I_N2G, I_EVWIN, I_EVWOUT, I_QNORM, I_WUQ, I_KVNORM, I_WUKV, I_QG, I_KG, I_DWW, I_DWB, I_LNG, I_LNB,
       I_ODWIN, I_ODWOUT, I_SHIFTW, I_W0, I_W2L, I_A0, I_A2, I_G2, I_KKW, I_KA, I_RK, I_GNG, I_GNB, I_NAQG, I_NAKG, I_RPB, I_ROUTER, I_MW1, I_MW3, I_MW2 };

DI void transpose_item(const float* __restrict__ W, int K, int N, bf16* __restrict__ WT, int dst_row0, const float* __restrict__ gain, LAS float* scr, int k0, int n0, int lane) {
#pragma unroll 8
    for (int i = 0; i < 32; ++i) { const int kk = 2 * i + (lane >> 5); float v = W[(size_t)(k0 + kk) * N + n0 + (lane & 31)]; if (gain) v *= gain[k0 + kk]; scr[kk * 33 + (lane & 31)] = v; }
    asm volatile("s_waitcnt lgkmcnt(0)" ::: "memory");
    const int c = lane & 7;
#pragma unroll
    for (int j = 0; j < 4; ++j) { const int n = (lane >> 3) + 8 * j; const LAS float* s = scr + (8 * c) * 33 + n;
        u32x4 o; o.x = pk2(s[0 * 33], s[1 * 33]); o.y = pk2(s[2 * 33], s[3 * 33]); o.z = pk2(s[4 * 33], s[5 * 33]); o.w = pk2(s[6 * 33], s[7 * 33]);
        *(u32x4*)(WT + (size_t)(dst_row0 + n) * K + k0 + 8 * c) = o; }
    asm volatile("s_waitcnt lgkmcnt(0)" ::: "memory");
}
DI void transpose_item64(const float* __restrict__ W, int K, int N, bf16* __restrict__ WT, int dst_row0, LAS float* scr, int k0, int n0, int lane) {
    f32x4 v[16];
#pragma unroll
    for (int i = 0; i < 16; ++i) v[i] = *(const f32x4*)(W + (size_t)(k0 + 4 * i + (lane >> 4)) * N + n0 + 4 * (lane & 15));
#pragma unroll
    for (int i = 0; i < 16; ++i) { LAS float* d = scr + (4 * i + (lane >> 4)) * 65 + 4 * (lane & 15); d[0] = v[i].x; d[1] = v[i].y; d[2] = v[i].z; d[3] = v[i].w; }
    asm volatile("s_waitcnt lgkmcnt(0)" ::: "memory");
    const int c = lane & 7;
#pragma unroll
    for (int j = 0; j < 8; ++j) { const int n = (lane >> 3) + 8 * j; const LAS float* s = scr + (8 * c) * 65 + n;
        u32x4 o; o.x = pk2(s[0 * 65], s[1 * 65]); o.y = pk2(s[2 * 65], s[3 * 65]); o.z = pk2(s[4 * 65], s[5 * 65]); o.w = pk2(s[6 * 65], s[7 * 65]);
        *(u32x4*)(WT + (size_t)(dst_row0 + n) * K + k0 + 8 * c) = o; }
    asm volatile("s_waitcnt lgkmcnt(0)" ::: "memory");
}
DI void transpose_matrix(const Ctx& C, const float* W, int K, int N, bf16* WT, const float* gain, int mode  ) {
    LAS float* scr = (LAS float*)(C.lds + C.wave * 8704);
    const int nkb = K / 64, nnb = N / 32, nit = nkb * nnb, gw = C.vcu * 8 + C.wave, ngw = C.nb * 8;
    for (int it = gw; it < nit; it += ngw) {
        const int kb = it / nnb, nbk = it % nnb, n0 = nbk * 32;
        int d0 = n0; if (mode) d0 = (n0 >> 7) * 256 + (n0 & 127) + (mode == 2 ? 128 : 0);
        transpose_item(W, K, N, WT, d0, gain, scr, kb * 64, n0, C.lane);
    }
}
DI void moe_weight_prep(const Ctx& C, const float* w1, const float* w3, const float* w2, bf16* W13, bf16* W2) {
    LAS float* scr = (LAS float*)(C.lds + C.wave * 16640);
    const int gw = C.vcu * 8 + C.wave, ngw = C.nb * 8;
    constexpr int PER = 16 * 16;
    for (int it = gw; it < NEXP * 3 * PER; it += ngw) {
        const int e = it / (3 * PER), r = it % (3 * PER), which = r / PER, q = r % PER, kb = q / 16, n0 = (q % 16) * 64;
        if (which == 0)      transpose_item64(w1 + (size_t)e * DM * DM, DM, DM, W13 + (size_t)e * 2048 * DM, (n0 >> 7) * 256 + (n0 & 127), scr, kb * 64, n0, C.lane);
        else if (which == 1) transpose_item64(w3 + (size_t)e * DM * DM, DM, DM, W13 + (size_t)e * 2048 * DM, (n0 >> 7) * 256 + (n0 & 127) + 128, scr, kb * 64, n0, C.lane);
        else                 transpose_item64(w2 + (size_t)e * DM * DM, DM, DM, W2 + (size_t)e * DM * DM, n0, scr, kb * 64, n0, C.lane);
    }
}

DI void ph_prologue(const Ctx& C, const Args& a) {
    unsigned char* ws = a.ws;
    {
        LAS float* sv = (LAS float*)C.lds;
        LAS float* red = sv + 9 * 1024;
        for (int i = C.tid; i < 9 * 1024; i += 512) { const int m = i >> 10, k = i & 1023; const float c = (m < 8) ? a.in[I_C][m * 1024 + k] : a.in[I_CCTX][k]; sv[i] = siluf_(c); }
        __syncthreads();
        float* MOD = (float*)(ws + WS_MOD);
        for (int it = C.bid; it < 4 * 96; it += C.nb) {
            const int layer = it / 96, col = (it % 96) * 64 + C.lane;
            const float* wp = a.in[I_ADAW] + (size_t)layer * 1024 * 6144 + col;
            float acc[9];
#pragma unroll
            for (int m = 0; m < 9; ++m) acc[m] = 0.f;
            const int kb = C.wave * 128;
#pragma unroll 4
            for (int k = 0; k < 128; ++k) { const float w = wp[(size_t)(kb + k) * 6144];
#pragma unroll
                for (int m = 0; m < 9; ++m) acc[m] += sv[m * 1024 + kb + k] * w; }
#pragma unroll
            for (int m = 0; m < 9; ++m) red[(C.wave * 9 + m) * 64 + C.lane] = acc[m];
            __syncthreads();
            for (int i = C.tid; i < 576; i += 512) { const int m = i >> 6, l = i & 63; float s = 0.f;
#pragma unroll
                for (int w = 0; w < 8; ++w) s += red[(w * 9 + m) * 64 + l];
                const int cc = (it % 96) * 64 + l;
                MOD[(size_t)(layer * 9 + m) * 6144 + cc] = s + a.in[I_ADAB][layer * 6144 + cc]; }
            __syncthreads();
        }
    }
    {
        f32x2* CS = (f32x2*)(ws + WS_ROPE);
        for (int i = C.bid * 512 + C.tid; i < 4096 * 16; i += C.nb * 512) {
            const int pos = i >> 4, j = i & 15, f = j & 7;
            const float inv = powf(10000.f, -(float)(2 * f) / 16.f);
            const float ang = (float)((j < 8) ? (pos >> 6) : (pos & 63)) * inv;
            const double tw = 6.283185307179586476925;
            const double x = (double)ang, n = __builtin_rint(x / tw), rr = x - n * tw;
            CS[i] = (f32x2){__cosf((float)rr), __sinf((float)rr)};
        }
    }
    for (int j = 0; j < 2; ++j) {
        transpose_matrix(C, a.in[I_EVWIN] + (size_t)j * DM * EV_IN, DM, EV_IN, (bf16*)(ws + WS_WEVIN) + (size_t)j * EV_INP * DM, nullptr, 0);
        transpose_matrix(C, a.in[I_EVWOUT] + (size_t)j * DM * DM, DM, DM, (bf16*)(ws + WS_WEVOUT) + (size_t)j * DM * DM, nullptr, 0);
        transpose_matrix(C, a.in[I_WUQ] + (size_t)j * 384 * 768, 384, 768, (bf16*)(ws + WS_WUQ) + (size_t)j * 768 * 384, a.in[I_QNORM] + j * 384, 0);
        transpose_matrix(C, a.in[I_WUKV] + (size_t)j * 256 * 1024, 256, 1024, (bf16*)(ws + WS_WUKV) + (size_t)j * 1024 * 256, a.in[I_KVNORM] + j * 256, 0);
        transpose_matrix(C, a.in[I_ODWIN] + (size_t)j * DM * OD_IN, DM, OD_IN, (bf16*)(ws + WS_WODIN) + (size_t)j * OD_INP * DM, nullptr, 0);
        transpose_matrix(C, a.in[I_ODWOUT] + (size_t)j * DM * DM, DM, DM, (bf16*)(ws + WS_WODOUT) + (size_t)j * DM * DM, nullptr, 0);
    }
    {
        const int gt = C.bid * 512 + C.tid, ngt = C.nb * 512;
        for (int j = 0; j < 2; ++j) {
            u32x4* p0 = (u32x4*)((bf16*)(ws + WS_WEVIN) + (size_t)j * EV_INP * DM + (size_t)EV_IN * DM);
            for (int i = gt; i < (EV_INP - EV_IN) * DM / 8; i += ngt) p0[i] = (u32x4){0u, 0u, 0u, 0u};
            u32x4* p1 = (u32x4*)((bf16*)(ws + WS_WODIN) + (size_t)j * OD_INP * DM + (size_t)OD_IN * DM);
            for (int i = gt; i < (OD_INP - OD_IN) * DM / 8; i += ngt) p1[i] = (u32x4){0u, 0u, 0u, 0u};
            bf16* WL = (bf16*)(ws + WS_WLORA) + (size_t)j * 196608;
            const float* w2 = a.in[I_W2L] + (size_t)j * 2 * 64 * 512; const float* a2 = a.in[I_A2] + (size_t)j * 2 * 64 * 512; const float* g2 = a.in[I_G2] + (size_t)j * 128 * 512;
            for (int i = gt; i < 196608; i += ngt) {
                float v;
                if (i < 65536) { const int d = i >> 15, c = (i >> 6) & 511, r = i & 63; v = w2[(size_t)(d * 64 + r) * 512 + c]; }
                else if (i < 131072) { const int q = i - 65536, d = q >> 15, c = (q >> 6) & 511, r = q & 63; v = a2[(size_t)(d * 64 + r) * 512 + c]; }
                else { const int q = i - 131072, c = q >> 7, r = q & 127; v = g2[(size_t)r * 512 + c]; }
                WL[i] = f2bf(v);
            }
        }
    }
}

template <bool ROUTER>
DI void ph_norm(const Ctx& C, const float* xlat, const float* xctx, const float* gain, const float* mod  , int shift_off, int scale_off, bf16* H,
                const float* router  , float* AFFT, float* AFFC, int* SLOT) {
    LAS float* RT = (LAS float*)C.lds;
    if (ROUTER) { for (int i = C.tid; i < 16384; i += 512) { const int c = i >> 4, e = i & 15; RT[e * 1024 + c] = router[i]; } __syncthreads(); }
    const int gw = C.bid * 8 + C.wave, ngw = C.nb * 8, lane = C.lane;
    for (int row = gw; row < MT; row += ngw) {
        const float* xr = row < NLAT ? xlat + (size_t)row * DM : xctx + (size_t)(row - NLAT) * DM;
        const int mi = row < NLAT ? (row >> 12) : 8;
        const float* mp = mod + mi * 6144;
        f32x4 v[4]; float ss = 0.f;
#pragma unroll
        for (int j = 0; j < 4; ++j) { v[j] = *(const f32x4*)(xr + 256 * j + 4 * lane); ss += v[j].x * v[j].x + v[j].y * v[j].y + v[j].z * v[j].z + v[j].w * v[j].w; }
        ss = wave_sum(ss);
        const float rs = 1.0f / sqrtf(ss * (1.f / 1024.f) + EPS);
#pragma unroll
        for (int j = 0; j < 4; ++j) {
            const int c = 256 * j + 4 * lane;
            const f32x4 g = *(const f32x4*)(gain + c), sc = *(const f32x4*)(mp + scale_off + c), sh = *(const f32x4*)(mp + shift_off + c);
            v[j] = (v[j] * rs) * g * (sc + 1.0f) + sh;
            *(u32x2*)(H + (size_t)row * DM + c) = (u32x2){pk2(v[j].x, v[j].y), pk2(v[j].z, v[j].w)};
        }
        if (ROUTER) {
            float mylg = 0.f;
#pragma unroll 1
            for (int e = 0; e < 16; ++e) { float p = 0.f;
#pragma unroll
                for (int j = 0; j < 4; ++j) { const f32x4 w = *(const LAS f32x4*)(RT + e * 1024 + 256 * j + 4 * lane); p += v[j].x * w.x + v[j].y * w.y + v[j].z * w.z + v[j].w * w.w; }
                p = wave_sum(p); mylg = (lane == e) ? p : mylg; }
            const float mx = max16(mylg);
            const float ex = expf(mylg - mx);
            const float mine = ex / sum16(ex);
            if (lane < 16) {
                if (row < NLAT) AFFT[(size_t)((row >> 12) * 16 + lane) * TL + (row & 4095)] = mine;
                else { const int rc = row - NLAT; AFFC[(size_t)((rc >> 8) * 16 + lane) * LCX + (rc & 255)] = mine; }
                SLOT[(size_t)row * 16 + lane] = -1;
            }
        }
    }
}

template <class Epi>
DI void gemm_unit(const bf16* __restrict__ A, int lda, const int* __restrict__ rows, const bf16* __restrict__ Bt, int K, int pm, int pn, const Epi& E, int wave, int lane) {
    const int wr = wave >> 2, wc = wave & 3, r = lane & 31, h = lane >> 5;
    const bf16* ap[2][2]; const bf16* bp[2];
#pragma unroll
    for (int ai = 0; ai < 2; ++ai)
#pragma unroll
        for (int mm = 0; mm < 2; ++mm) { const int lr = 256 * pm + 128 * ai + 64 * wr + 32 * mm + r; const int gr = rows ? rows[lr] : lr; ap[ai][mm] = A + (size_t)gr * lda + 8 * h; }
#pragma unroll
    for (int bj = 0; bj < 2; ++bj) bp[bj] = Bt + (size_t)(256 * pn + 128 * bj + 32 * wc + r) * K + 8 * h;
    f32x16 acc[2][2][2];
#pragma unroll
    for (int ai = 0; ai < 2; ++ai)
#pragma unroll
        for (int mm = 0; mm < 2; ++mm)
#pragma unroll
            for (int bj = 0; bj < 2; ++bj)
#pragma unroll
                for (int i = 0; i < 16; ++i) acc[ai][mm][bj][i] = 0.f;
#pragma unroll 2
    for (int k0 = 0; k0 < K; k0 += 16) {
        bf16x8 af[2][2], bfr[2];
#pragma unroll
        for (int ai = 0; ai < 2; ++ai)
#pragma unroll
            for (int mm = 0; mm < 2; ++mm) af[ai][mm] = *(const bf16x8*)(ap[ai][mm] + k0);
#pragma unroll
        for (int bj = 0; bj < 2; ++bj) bfr[bj] = *(const bf16x8*)(bp[bj] + k0);
#pragma unroll
        for (int ai = 0; ai < 2; ++ai)
#pragma unroll
            for (int mm = 0; mm < 2; ++mm)
#pragma unroll
                for (int bj = 0; bj < 2; ++bj) acc[ai][mm][bj] = MFMA32(bfr[bj], af[ai][mm], acc[ai][mm][bj]);
    }
#pragma unroll
    for (int ai = 0; ai < 2; ++ai)
#pragma unroll
        for (int mm = 0; mm < 2; ++mm) {
            const int row = 256 * pm + 128 * ai + 64 * wr + 32 * mm + r;
#pragma unroll
            for (int g = 0; g < 4; ++g) {
                const int col = 256 * pn + 32 * wc + 8 * g + 4 * h;
                const f32x4 v0 = {acc[ai][mm][0][4 * g], acc[ai][mm][0][4 * g + 1], acc[ai][mm][0][4 * g + 2], acc[ai][mm][0][4 * g + 3]};
                const f32x4 v1 = {acc[ai][mm][1][4 * g], acc[ai][mm][1][4 * g + 1], acc[ai][mm][1][4 * g + 2], acc[ai][mm][1][4 * g + 3]};
                E(row, col, v0, v1);
            }
        }
}
template <class Epi>
DI void gemm_phase(const Ctx& C, const bf16* A, int lda, const bf16* Bt, int K, int nM, int nN, const Epi& E) {
    for (int u = C.vcu; u < nM * nN; u += C.nb) gemm_unit(A, lda, nullptr, Bt, K, u / nN, u % nN, E, C.wave, C.lane);
}

struct EpiBf16 { bf16* O; int ldo;
    DI void operator()(int row, int col, f32x4 v0, f32x4 v1) const { bf16* p = O + (size_t)row * ldo + col;
        *(u32x2*)p = (u32x2){pk2(v0[0], v0[1]), pk2(v0[2], v0[3])}; *(u32x2*)(p + 128) = (u32x2){pk2(v1[0], v1[1]), pk2(v1[2], v1[3])}; } };
struct EpiF32 { float* O; int ldo;
    DI void operator()(int row, int col, f32x4 v0, f32x4 v1) const { float* p = O + (size_t)row * ldo + col; *(f32x4*)p = v0; *(f32x4*)(p + 128) = v1; } };
struct EpiResid { const float* xin_lat; const float* xin_ctx; float* xout_lat; float* xout_ctx; const float* modg;
    DI void operator()(int row, int col, f32x4 v0, f32x4 v1) const {
        const float* xi; float* xo; int mi;
        if (row < NLAT) { xi = xin_lat + (size_t)row * DM; xo = xout_lat + (size_t)row * DM; mi = row >> 12; }
        else { xi = xin_ctx + (size_t)(row - NLAT) * DM; xo = xout_ctx + (size_t)(row - NLAT) * DM; mi = 8; }
        const float* g = modg + mi * 6144 + col;
        const f32x4 g0 = *(const f32x4*)g, g1 = *(const f32x4*)(g + 128), x0 = *(const f32x4*)(xi + col), x1 = *(const f32x4*)(xi + col + 128);
        *(f32x4*)(xo + col) = x0 + g0 * v0; *(f32x4*)(xo + col + 128) = x1 + g1 * v1; } };
struct EpiGlu { bf16* O;
    DI void operator()(int row, int col, f32x4 v0, f32x4 v1) const { const int f = ((col & 2047) >> 8) * 128 + (col & 255);
        *(u32x2*)(O + (size_t)row * DM + f) = (u32x2){pk2(siluf_(v0[0]) * v1[0], siluf_(v0[1]) * v1[1]), pk2(siluf_(v0[2]) * v1[2], siluf_(v0[3]) * v1[3])}; } };
struct EpiGate { bf16* O; const float* gate;
    DI void operator()(int row, int col, f32x4 v0, f32x4 v1) const { const float g = gate[row]; bf16* p = O + (size_t)row * DM + (col & 1023);
        *(u32x2*)p = (u32x2){pk2(v0[0] * g, v0[1] * g), pk2(v0[2] * g, v0[3] * g)}; *(u32x2*)(p + 128) = (u32x2){pk2(v1[0] * g, v1[1] * g), pk2(v1[2] * g, v1[3] * g)}; } };
struct EpiLoraW { float* W; const float* w0;
    DI void one(int row, int c, f32x4 v) const { f32x4 o;
#pragma unroll
        for (int e = 0; e < 4; ++e) { const float lw = w0[c + e] + v[e]; const float z = -lw; const float sp = fmaxf(z, 0.f) + __logf(1.f + __expf(-fabsf(z))); o[e] = __expf(-__expf(-sp - 0.5f)); }
        *(f32x4*)(W + (size_t)row * 512 + c) = o; }
    DI void operator()(int row, int col, f32x4 v0, f32x4 v1) const { one(row, col, v0); one(row, col + 128, v1); } };
struct EpiLoraA { bf16* KEFF; bf16* BSC; const bf16* Kin; const bf16* KKin; const float* a0; const float* ka;
    DI void one(int row, int c, f32x4 v) const {
        const u32x2 kr = *(const u32x2*)(Kin + (size_t)row * 512 + c), kkr = *(const u32x2*)(KKin + (size_t)row * 512 + c);
        const float kf[4] = {bflo(kr.x), bfhi(kr.x), bflo(kr.y), bfhi(kr.y)}, kkf[4] = {bflo(kkr.x), bfhi(kkr.x), bflo(kkr.y), bfhi(kkr.y)};
        float ke[4], bs[4];
#pragma unroll
        for (int e = 0; e < 4; ++e) { const float av = sigmoidf_(a0[c + e] + v[e]); ke[e] = kf[e] * (1.f + (av - 1.f) * ka[c + e]); bs[e] = kkf[e] * av; }
        *(u32x2*)(KEFF + (size_t)row * 512 + c) = (u32x2){pk2(ke[0], ke[1]), pk2(ke[2], ke[3])};
        *(u32x2*)(BSC + (size_t)row * 512 + c) = (u32x2){pk2(bs[0], bs[1]), pk2(bs[2], bs[3])}; }
    DI void operator()(int row, int col, f32x4 v0, f32x4 v1) const { one(row, col, v0); one(row, col + 128, v1); } };


namespace pg8 {
constexpr int BM = 256, BK = 64, HALF = 128, HTB = HALF * BK * 2, STAGE_BYTES = 8 * HTB;
DI int lds_byte(int r, int c) { const int st = (r >> 4) * 2 + (c >> 5), rr = r & 15, cc = c & 31, ob = rr * 64 + cc * 2; return st * 1024 + (ob ^ (((ob >> 9) & 1) << 5)); }
DI void stage_rc(int b, int& R, int& C) { const int st = b / 1024, sb = b % 1024, swz = sb ^ (((sb >> 9) & 1) << 5); R = (st >> 1) * 16 + swz / 64; C = (st & 1) * 32 + (swz % 64) / 2; }
DI int perm32(int rho) { const int n = rho >> 4, i = rho & 15; return 8 * (i >> 2) + 4 * n + (i & 3); }
struct Unit { int pm, pn; };
struct Gemm { const bf16* A; const bf16* Bt; int lda, K; const int* rows; };
struct OrderMN { int nM, nN, G, c;
    DI bool next(int i, Unit& u) const { const int L = i * G + c; if (L >= nM * nN) return false; u.pm = L / nN; u.pn = L % nN; return true; } };
struct OrderMoE { int nMt, nN, mstride  , G, c;
    DI bool next(int i, Unit& u) const { const int L = i * G + c, per = nMt * nN; if (L >= NEXP * per) return false; const int e = L / per, q = L % per; u.pm = e * mstride + q / nN; u.pn = e * nN + q % nN; return true; } };
template <class E4> struct EpiAdapt { E4 e;
    DI void operator()(const f32x4 (&acc)[2][2][4][2], const Unit& u, int wr, int wc, int fr, int fq) const {
#pragma unroll
        for (int ai = 0; ai < 2; ++ai)
#pragma unroll
            for (int m = 0; m < 4; ++m) { const int row = u.pm * BM + ai * HALF + wr * 64 + m * 16 + fr;
#pragma unroll
                for (int n = 0; n < 2; ++n) e(row, u.pn * BM + wc * 32 + 8 * fq + 4 * n, acc[ai][0][m][n], acc[ai][1][m][n]);
                __builtin_amdgcn_sched_barrier(0); } } };

template <class Epi, class Sched>
DI void gemm_phase(LAS unsigned char* lds, const Gemm g, const Sched& S, const Epi& E, const int tid) {
    const int wid = __builtin_amdgcn_readfirstlane(tid >> 6), lane = tid & 63, wr = wid >> 2, wc = wid & 3, fr = lane & 15, fq = lane >> 4;
    const int K = g.K, nt = K / BK;
    int RA[2], CA[2]; unsigned voffB[2];
#pragma unroll
    for (int i = 0; i < 2; ++i) { int R, C; stage_rc(tid * 16 + i * 8192, R, C); RA[i] = R; CA[i] = C; const int Rb = (R & ~31) + perm32(R & 31); voffB[i] = (unsigned)(Rb * K + C) * 2u; }
    const size_t kstep = (size_t)(BK * 2), hstep = (size_t)HALF * K * 2, tstep = 2 * hstep;
    const unsigned ldsw = (unsigned)wid * 1024u;
    const int aoff = lds_byte(wr * 64 + fr, fq * 8), boff = lds_byte(wc * 32 + fr, fq * 8);
    const char* const gA = (const char*)g.A;
#define PG8_SA(b, h) (((b) * 2 + (h)) * HTB)
#define PG8_SB(b, h) ((4 + (b) * 2 + (h)) * HTB)
#define PG8_STAGE(bufoff, gbase, voff) do { _Pragma("unroll") for (int _i = 0; _i < 2; ++_i) \
        __builtin_amdgcn_global_load_lds((const unsigned*)((const char*)(gbase) + (voff)[_i]), (LAS unsigned*)(lds + (bufoff) + ldsw + _i * 8192), 16, 0, 0); } while (0)
#define PG8_LDA(dst, b, h) do { _Pragma("unroll") for (int m = 0; m < 4; ++m) _Pragma("unroll") for (int k = 0; k < 2; ++k) dst[m][k] = *(const LAS bf16x8*)(lds + PG8_SA(b, h) + aoff + m * 2048 + k * 1024); } while (0)
#define PG8_LDB(dst, b, h) do { _Pragma("unroll") for (int n = 0; n < 2; ++n) _Pragma("unroll") for (int k = 0; k < 2; ++k) dst[n][k] = *(const LAS bf16x8*)(lds + PG8_SB(b, h) + boff + n * 2048 + k * 1024); } while (0)
#define PG8_MMA(ai, bj, At, Bt) do { __builtin_amdgcn_s_setprio(1); _Pragma("unroll") for (int m = 0; m < 4; ++m) _Pragma("unroll") for (int n = 0; n < 2; ++n) _Pragma("unroll") for (int k = 0; k < 2; ++k) \
        acc[ai][bj][m][n] = __builtin_amdgcn_mfma_f32_16x16x32_bf16(Bt[n][k], At[m][k], acc[ai][bj][m][n], 0, 0, 0); __builtin_amdgcn_s_setprio(0); } while (0)
#define PG8_WAIT_V(n) asm volatile("s_waitcnt vmcnt(" #n ")" ::: "memory")
#define PG8_WAIT_L(n) asm volatile("s_waitcnt lgkmcnt(" #n ")" ::: "memory")
#define PG8_BAR __builtin_amdgcn_s_barrier()
#define PG8_SCHED __builtin_amdgcn_sched_barrier(0)
#define PG8_AOFF(vo, u) do { _Pragma("unroll") for (int _h = 0; _h < 2; ++_h) _Pragma("unroll") for (int _i = 0; _i < 2; ++_i) { const int _lr = (u).pm * BM + _h * HALF + RA[_i]; \
        const int _gr = g.rows ? g.rows[_lr] : _lr; vo[_h][_i] = (unsigned)(((size_t)_gr * g.lda + CA[_i]) * 2u); } } while (0)
    Unit cur, nxt; int ui = 0;
    if (!S.next(0, cur)) return;
    f32x4 acc[2][2][4][2];
#pragma unroll
    for (int a = 0; a < 2; ++a)
#pragma unroll
        for (int b = 0; b < 2; ++b)
#pragma unroll
            for (int m = 0; m < 4; ++m)
#pragma unroll
                for (int n = 0; n < 2; ++n) acc[a][b][m][n] = (f32x4){0.f, 0.f, 0.f, 0.f};
    bf16x8 At[4][2], B0[2][2], B1[2][2];
    unsigned cvo[2][2], nvo[2][2];
    PG8_AOFF(cvo, cur);
    const char* cB = (const char*)g.Bt + (size_t)cur.pn * tstep;
    PG8_STAGE(PG8_SB(0, 0), cB, voffB); PG8_STAGE(PG8_SB(0, 1), cB + hstep, voffB); PG8_STAGE(PG8_SA(0, 0), gA, cvo[0]); PG8_STAGE(PG8_SA(0, 1), gA, cvo[1]);
    if (wr == 1) PG8_BAR;
    PG8_WAIT_V(2); PG8_BAR;
    PG8_STAGE(PG8_SB(1, 0), cB + kstep, voffB); PG8_STAGE(PG8_SA(1, 0), gA + kstep, cvo[0]); PG8_STAGE(PG8_SB(1, 1), cB + hstep + kstep, voffB);
    PG8_WAIT_V(6); PG8_BAR;
    for (;;) {
        const bool has_next = S.next(ui + 1, nxt);
        if (has_next) { PG8_AOFF(nvo, nxt); } else {
#pragma unroll
            for (int _h = 0; _h < 2; ++_h)
#pragma unroll
                for (int _i = 0; _i < 2; ++_i) nvo[_h][_i] = cvo[_h][_i]; }
        const char* nB = has_next ? (const char*)g.Bt + (size_t)nxt.pn * tstep : cB;
        for (int t = 0; t < nt; t += 2) {
            const bool last = (t == nt - 2);
            const char* a1 = gA + (size_t)(t + 1) * kstep;
            const char* a2 = last ? gA : gA + (size_t)(t + 2) * kstep; const char* b2 = last ? nB : cB + (size_t)(t + 2) * kstep;
            const char* a3 = a2 + kstep; const char* b3 = b2 + kstep;
            unsigned v20[2], v21[2];
#pragma unroll
            for (int _i = 0; _i < 2; ++_i) { v20[_i] = last ? nvo[0][_i] : cvo[0][_i]; v21[_i] = last ? nvo[1][_i] : cvo[1][_i]; }
            PG8_LDB(B0, 0, 0); PG8_LDB(B1, 0, 1); PG8_SCHED; PG8_LDA(At, 0, 0); PG8_STAGE(PG8_SA(1, 1), a1, cvo[1]);
            PG8_WAIT_V(8); PG8_WAIT_L(0); PG8_BAR; PG8_MMA(0, 0, At, B0); PG8_MMA(0, 1, At, B1); PG8_BAR; PG8_SCHED;
            PG8_LDA(At, 0, 1); PG8_STAGE(PG8_SB(0, 0), b2, voffB); PG8_STAGE(PG8_SB(0, 1), b2 + hstep, voffB); PG8_STAGE(PG8_SA(0, 0), a2, v20);
            PG8_WAIT_V(8); PG8_WAIT_L(0); PG8_BAR; PG8_MMA(1, 0, At, B0); PG8_MMA(1, 1, At, B1); PG8_BAR; PG8_SCHED;
            PG8_LDB(B0, 1, 0); PG8_LDB(B1, 1, 1); PG8_SCHED; PG8_LDA(At, 1, 0); PG8_STAGE(PG8_SA(0, 1), a2, v21);
            PG8_WAIT_V(8); PG8_WAIT_L(0); PG8_BAR; PG8_MMA(0, 0, At, B0); PG8_MMA(0, 1, At, B1); PG8_BAR; PG8_SCHED;
            PG8_LDA(At, 1, 1); PG8_STAGE(PG8_SB(1, 0), b3, voffB); PG8_STAGE(PG8_SB(1, 1), b3 + hstep, voffB); PG8_STAGE(PG8_SA(1, 0), a3, v20);
            PG8_WAIT_V(8); PG8_WAIT_L(0); PG8_BAR; PG8_MMA(1, 0, At, B0); PG8_MMA(1, 1, At, B1); PG8_BAR; PG8_SCHED;
        }
        if (wr == 0) PG8_BAR;
        E(acc, cur, wr, wc, fr, fq);
        if (!has_next) break;
#pragma unroll
        for (int a = 0; a < 2; ++a)
#pragma unroll
            for (int b = 0; b < 2; ++b)
#pragma unroll
                for (int m = 0; m < 4; ++m)
#pragma unroll
                    for (int n = 0; n < 2; ++n) acc[a][b][m][n] = (f32x4){0.f, 0.f, 0.f, 0.f};
        cur = nxt; cB = nB; ++ui;
#pragma unroll
        for (int _h = 0; _h < 2; ++_h)
#pragma unroll
            for (int _i = 0; _i < 2; ++_i) cvo[_h][_i] = nvo[_h][_i];
        if (wr == 1) PG8_BAR;
    }
    PG8_WAIT_V(0);
    PG8_BAR;
#undef PG8_SA
#undef PG8_SB
#undef PG8_STAGE
#undef PG8_LDA
#undef PG8_LDB
#undef PG8_MMA
#undef PG8_WAIT_V
#undef PG8_WAIT_L
#undef PG8_BAR
#undef PG8_SCHED
#undef PG8_AOFF
}
}
template <class E4> DI void fast_gemm(const Ctx& C, const bf16* A, int lda, const bf16* Bt, int K, int nM, int nN, const E4& e) {
    pg8::Gemm g{A, Bt, lda, K, nullptr}; pg8::OrderMN S{nM, nN, C.nb, C.vcu}; pg8::EpiAdapt<E4> E{e};
    pg8::gemm_phase(C.lds, g, S, E, C.tid);
}

DI int swap23(int x) { return (x & ~12) | ((x & 4) << 1) | ((x & 8) >> 1); }
template <int DQK, bool NAT>
DI void flash_range(f32x16 (&o)[2], float& m, float& l, const bf16x8 (&qf)[DQK / 16], const bf16* __restrict__ Kb, const bf16* __restrict__ Vt, int pos0, int nblk, int r, int h,
                    const LAS float* tab, int qc, int cs, int drow0) {
    const int kr = swap23(r);
    for (int blk = 0; blk < nblk; ++blk) {
        const int pos = pos0 + 32 * blk;
        f32x16 s;
#pragma unroll
        for (int i = 0; i < 16; ++i) s[i] = 0.f;
        const bf16* kp = Kb + (size_t)(pos + kr) * DQK + 8 * h;
#pragma unroll
        for (int kk = 0; kk < DQK / 16; ++kk) s = MFMA32(*(const bf16x8*)(kp + 16 * kk), qf[kk], s);
        if (NAT) {
            const int irow = blk >> 1, cc0 = (blk & 1) * 32;
            const LAS float* trow = tab + (drow0 + irow) * 31;
#pragma unroll
            for (int i = 0; i < 16; ++i) {
                const int kib = (i & 3) | (((i >> 2) & 1) << 2) | (h << 3) | ((i >> 3) << 4);
                const int cc = cc0 + kib; const bool ok = (cc >= cs) && (cc < cs + 16);
                int dc = cc - qc + 15; dc = dc < 0 ? 0 : (dc > 30 ? 30 : dc);
                s[i] = ok ? s[i] + trow[dc] : -1e30f;
            }
        }
        float mx = s[0];
#pragma unroll
        for (int i = 1; i < 16; ++i) mx = fmaxf(mx, s[i]);
        mx = fmaxf(mx, xor32(mx, r + 32 * h));
        const float mn = fmaxf(m, mx), alpha = __builtin_amdgcn_exp2f(m - mn);
        float rs = 0.f; f32x16 p;
#pragma unroll
        for (int i = 0; i < 16; ++i) { float e = __builtin_amdgcn_exp2f(s[i] - mn); if (NAT) e = (s[i] > -1e29f) ? e : 0.f; p[i] = e; rs += e; }
        rs += xor32(rs, r + 32 * h);
        l = l * alpha + rs; m = mn;
#pragma unroll
        for (int i = 0; i < 16; ++i) { o[0][i] *= alpha; o[1][i] *= alpha; }
#pragma unroll
        for (int s2 = 0; s2 < 2; ++s2) {
            u32x4 pw; pw.x = pk2(p[8 * s2], p[8 * s2 + 1]); pw.y = pk2(p[8 * s2 + 2], p[8 * s2 + 3]); pw.z = pk2(p[8 * s2 + 4], p[8 * s2 + 5]); pw.w = pk2(p[8 * s2 + 6], p[8 * s2 + 7]);
            const bf16x8 pb = __builtin_bit_cast(bf16x8, pw);
#pragma unroll
            for (int dt = 0; dt < 2; ++dt) { const bf16x8 va = *(const bf16x8*)(Vt + (size_t)(32 * dt + r) * KPOS + pos + 16 * s2 + 8 * h); o[dt] = MFMA32(va, pb, o[dt]); }
        }
    }
}
DI void flash_store(const f32x16 (&o)[2], float l, bf16* orow  , int h) {
    const float inv = 1.f / l;
#pragma unroll
    for (int dt = 0; dt < 2; ++dt)
#pragma unroll
        for (int g = 0; g < 4; ++g)
            *(u32x2*)(orow + 32 * dt + 8 * g + 4 * h) = (u32x2){pk2(o[dt][4 * g] * inv, o[dt][4 * g + 1] * inv), pk2(o[dt][4 * g + 2] * inv, o[dt][4 * g + 3] * inv)};
}

DI void ph_attn_mla(const Ctx& C, const bf16* QB, const bf16* KB, const bf16* VT, bf16* OCAT, bool last) {
    const int r = C.lane & 31, h = C.lane >> 5;
    for (int u = C.vcu; u < 64 * 17; u += C.nb) {
        const int bh = u / 17, qblk = u % 17, b = bh >> 3, hh = bh & 7;
        if (last && qblk == 16) continue;
        const int qpos = qblk * 256 + 32 * C.wave + r;
        const bf16* qp = QB + ((size_t)bh * KPOS + qpos) * 96 + 8 * h;
        bf16x8 qf[6];
#pragma unroll
        for (int kk = 0; kk < 6; ++kk) qf[kk] = *(const bf16x8*)(qp + 16 * kk);
        f32x16 o[2];
#pragma unroll
        for (int i = 0; i < 16; ++i) { o[0][i] = 0.f; o[1][i] = 0.f; }
        float m = -1e30f, l = 0.f;
        flash_range<96, false>(o, m, l, qf, KB + (size_t)bh * KPOS * 96, VT + (size_t)bh * 64 * KPOS, qblk < 16 ? 0 : TL, qblk < 16 ? KPOS / 32 : LCX / 32, r, h, nullptr, 0, 0, 0);
        const int row = qblk < 16 ? b * TL + qpos : NLAT + b * LCX + (qpos - TL);
        flash_store(o, l, OCAT + (size_t)row * DM + hh * 64, h);
    }
}

template <int DQK> struct AttnGeo { static constexpr int KSTR = DQK * 2 + 16, KBYTES = 64 * KSTR, VSTR = 144, VBYTES = 64 * VSTR, BUF = KBYTES + VBYTES, KPIECES = 64 * DQK / 8; };
template <int DQK>
DI void attn_tile_loop(const Ctx& C, f32x16 (&o)[2], float& l, const bf16x8 (&qf)[DQK / 16], const bf16* __restrict__ Kb, const bf16* __restrict__ Vt, int pos_base, int ntiles) {
    typedef AttnGeo<DQK> G;
    const int tid = C.tid, r = C.lane & 31, h = C.lane >> 5, kr = swap23(r);
    constexpr bool K2 = G::KPIECES > 512;
    const int kq0 = tid, kq1 = tid + 512;
    const int kl0 = (kq0 / (DQK / 8)) * G::KSTR + (kq0 % (DQK / 8)) * 16, kl1 = (kq1 / (DQK / 8)) * G::KSTR + (kq1 % (DQK / 8)) * 16;
    const int vl = G::KBYTES + (tid >> 3) * G::VSTR + (tid & 7) * 16;
    const bf16* vg = Vt + (size_t)(tid >> 3) * KPOS + 8 * (tid & 7);
    u32x4 rk0, rk1, rv;
    rk1 = (u32x4){0u, 0u, 0u, 0u};
    { const int pos0 = pos_base; rk0 = *(const u32x4*)(Kb + (size_t)pos0 * DQK + 8 * kq0); if (K2 && tid < 256) rk1 = *(const u32x4*)(Kb + (size_t)pos0 * DQK + 8 * kq1); rv = *(const u32x4*)(vg + pos0); }
    __syncthreads();
    *(LAS u32x4*)(C.lds + kl0) = rk0; if (K2 && tid < 256) *(LAS u32x4*)(C.lds + kl1) = rk1; *(LAS u32x4*)(C.lds + vl) = rv;
    __syncthreads();
    float mref = 0.f;
    constexpr float THR = 8.f;
    for (int t = 0; t < ntiles; ++t) {
        const LAS unsigned char* B = C.lds + (t & 1) * G::BUF;
        if (t + 1 < ntiles) { const int pos0 = pos_base + 64 * (t + 1);
            rk0 = *(const u32x4*)(Kb + (size_t)pos0 * DQK + 8 * kq0); if (K2 && tid < 256) rk1 = *(const u32x4*)(Kb + (size_t)pos0 * DQK + 8 * kq1); rv = *(const u32x4*)(vg + pos0); }
        f32x16 sc[2];
#pragma unroll
        for (int j = 0; j < 2; ++j) {
#pragma unroll
            for (int i = 0; i < 16; ++i) sc[j][i] = -mref;
            const LAS unsigned char* kp = B + (32 * j + kr) * G::KSTR + 16 * h;
#pragma unroll
            for (int kk = 0; kk < DQK / 16; ++kk) sc[j] = MFMA32(*(const LAS bf16x8*)(kp + 32 * kk), qf[kk], sc[j]);
        }
        float mx = fmaxf(sc[0][0], sc[1][0]);
#pragma unroll
        for (int i = 1; i < 16; ++i) mx = fmaxf(mx, fmaxf(sc[0][i], sc[1][i]));
        mx = fmaxf(mx, xor32(mx, C.lane));
        if (t == 0 || __builtin_amdgcn_ballot_w64(mx > THR) != 0ull) {
            const float delta = (t == 0) ? mx : fmaxf(mx, 0.f);
#pragma unroll
            for (int i = 0; i < 16; ++i) { sc[0][i] -= delta; sc[1][i] -= delta; }
            if (t > 0) { const float alpha = __builtin_amdgcn_exp2f(-delta); l *= alpha;
#pragma unroll
                for (int i = 0; i < 16; ++i) { o[0][i] *= alpha; o[1][i] *= alpha; } }
            mref += delta;
        }
        f32x2 rs2 = {0.f, 0.f};
#pragma unroll
        for (int j = 0; j < 2; ++j)
#pragma unroll
            for (int i = 0; i < 16; i += 2) { sc[j][i] = __builtin_amdgcn_exp2f(sc[j][i]); sc[j][i + 1] = __builtin_amdgcn_exp2f(sc[j][i + 1]); rs2 += (f32x2){sc[j][i], sc[j][i + 1]}; }
        float rs = rs2.x + rs2.y;
        rs += xor32(rs, C.lane);
        l += rs;
#pragma unroll
        for (int j = 0; j < 2; ++j)
#pragma unroll
            for (int s2 = 0; s2 < 2; ++s2) {
                u32x4 pw; pw.x = pk2(sc[j][8 * s2], sc[j][8 * s2 + 1]); pw.y = pk2(sc[j][8 * s2 + 2], sc[j][8 * s2 + 3]); pw.z = pk2(sc[j][8 * s2 + 4], sc[j][8 * s2 + 5]); pw.w = pk2(sc[j][8 * s2 + 6], sc[j][8 * s2 + 7]);
                const bf16x8 pb = __builtin_bit_cast(bf16x8, pw);
#pragma unroll
                for (int dt = 0; dt < 2; ++dt) o[dt] = MFMA32(*(const LAS bf16x8*)(B + G::KBYTES + (32 * dt + r) * G::VSTR + (32 * j + 16 * s2 + 8 * h) * 2), pb, o[dt]);
            }
        if (t + 1 < ntiles) { LAS unsigned char* Bn = C.lds + ((t + 1) & 1) * G::BUF;
            *(LAS u32x4*)(Bn + kl0) = rk0; if (K2 && tid < 256) *(LAS u32x4*)(Bn + kl1) = rk1; *(LAS u32x4*)(Bn + vl) = rv; }
        __syncthreads();
    }
}
DI void ph_attn_mla2(const Ctx& C, const bf16* QB, const bf16* KB, const bf16* VT, bf16* OCAT, bool last) {
    const int r = C.lane & 31, h = C.lane >> 5;
    for (int u = C.vcu; u < 64 * 17; u += C.nb) {
        const int bh = u / 17, qblk = u % 17, b = bh >> 3, hh = bh & 7;
        if (last && qblk == 16) continue;
        const int qpos = qblk * 256 + 32 * C.wave + r;
        const bf16* qp = QB + ((size_t)bh * KPOS + qpos) * 96 + 8 * h;
        bf16x8 qf[6];
#pragma unroll
        for (int kk = 0; kk < 6; ++kk) qf[kk] = *(const bf16x8*)(qp + 16 * kk);
        f32x16 o[2];
#pragma unroll
        for (int i = 0; i < 16; ++i) { o[0][i] = 0.f; o[1][i] = 0.f; }
        float l = 0.f;
        attn_tile_loop<96>(C, o, l, qf, KB + (size_t)bh * KPOS * 96, VT + (size_t)bh * 64 * KPOS, qblk < 16 ? 0 : TL, qblk < 16 ? KPOS / 64 : LCX / 64);
        const int row = qblk < 16 ? b * TL + qpos : NLAT + b * LCX + (qpos - TL);
        flash_store(o, l, OCAT + (size_t)row * DM + hh * 64, h);
    }
}

DI void ph_natten(const Ctx& C, const bf16* QN, const bf16* KN, const bf16* VTN, bf16* OCAT, const float* rpb  , bool last) {
    const int r = C.lane & 31, h = C.lane >> 5;
    LAS float* tab = (LAS float*)C.lds;
    const int nunits = 1024 + (last ? 0 : 64);
    for (int u = C.vcu; u < nunits; u += C.nb) {
        const bool isctx = u >= 1024;
        const int bh = isctx ? u - 1024 : (u >> 4), b = bh >> 3, hh = bh & 7;
        __syncthreads();
        for (int i = C.tid; i < 465; i += 512) tab[i] = rpb[hh * 465 + i] * LOG2E;
        __syncthreads();
        int qpos, row, grow = 0, qc = 0, rs = 0, cs = 0;
        if (!isctx) { const int rg = u & 15; grow = 4 * rg + (C.wave >> 1); qc = 32 * (C.wave & 1) + r; qpos = grow * 64 + qc; row = b * TL + qpos;
            rs = grow - 4; rs = rs < 0 ? 0 : (rs > 56 ? 56 : rs); cs = qc - 8; cs = cs < 0 ? 0 : (cs > 48 ? 48 : cs); }
        else { qpos = TL + 32 * C.wave + r; row = NLAT + b * LCX + 32 * C.wave + r; }
        const bf16* qp = QN + ((size_t)bh * KPOS + qpos) * 64 + 8 * h;
        bf16x8 qf[4];
#pragma unroll
        for (int kk = 0; kk < 4; ++kk) qf[kk] = *(const bf16x8*)(qp + 16 * kk);
        f32x16 o[2];
#pragma unroll
        for (int i = 0; i < 16; ++i) { o[0][i] = 0.f; o[1][i] = 0.f; }
        float m = -1e30f, l = 0.f;
        const bf16* Kb = KN + (size_t)bh * KPOS * 64; const bf16* Vt = VTN + (size_t)bh * 64 * KPOS;
        if (!isctx) flash_range<64, true>(o, m, l, qf, Kb, Vt, rs * 64, 16, r, h, tab, qc, cs, rs - grow + 7);
        flash_range<64, false>(o, m, l, qf, Kb, Vt, TL, LCX / 32, r, h, nullptr, 0, 0, 0);
        flash_store(o, l, OCAT + (size_t)row * DM + 512 + hh * 64, h);
    }
}

DI void ph_mla_fin(const Ctx& C, const bf16* U, const float* QPRE, const float* KVPRE, const float* qg, const float* kg, const f32x2* CS, bf16* QB, bf16* KB, bf16* VT) {
    LAS bf16* VL = (LAS bf16*)C.lds;
    const int lane = C.lane, hh = lane >> 3, sub = lane & 7;
    const float C2 = 0.10206207261596575f * LOG2E;
    for (int u = C.vcu; u < MT / 64; u += C.nb) {
        const int row0 = 64 * u, b = row0 < NLAT ? (row0 >> 12) : ((row0 - NLAT) >> 8), pos0 = row0 < NLAT ? (row0 & 4095) : TL + ((row0 - NLAT) & 255);
        const bool lat = row0 < NLAT;
        for (int i = 0; i < 8; ++i) {
            const int pl = 8 * C.wave + i, row = row0 + pl, pos = pos0 + pl;
            const bf16* ur = U + (size_t)row * EV_INP;
            float sq = 0.f, skv = 0.f;
#pragma unroll
            for (int mq = 0; mq < 6; ++mq) { const float x = bf2f(ur[lane + 64 * mq]); sq += x * x; }
#pragma unroll
            for (int mq = 0; mq < 4; ++mq) { const float x = bf2f(ur[384 + lane + 64 * mq]); skv += x * x; }
            sq = wave_sum(sq); skv = wave_sum(skv);
            const float rsq = 1.0f / sqrtf(sq * (1.f / 384.f) + EPS), rskv = 1.0f / sqrtf(skv * (1.f / 256.f) + EPS);
            float cr = 1.f, sr = 0.f, cc = 1.f, sc = 0.f;
            if (lat) { const f32x2 a0 = CS[pos * 16 + sub], a1 = CS[pos * 16 + 8 + sub]; cr = a0.x; sr = a0.y; cc = a1.x; sc = a1.y; }
            float qv[12]; float ss = 0.f;
#pragma unroll
            for (int mq = 0; mq < 12; ++mq) { qv[mq] = QPRE[(size_t)row * 768 + hh * 96 + sub + 8 * mq] * rsq; ss += qv[mq] * qv[mq]; }
            ss = sum8(ss);
            float rn = 1.0f / sqrtf(ss * (1.f / 96.f) + EPS);
#pragma unroll
            for (int mq = 0; mq < 12; ++mq) qv[mq] = qv[mq] * rn * qg[sub + 8 * mq];
            { const float x0 = qv[8], x1 = qv[9], y0 = qv[10], y1 = qv[11]; qv[8] = x0 * cr - x1 * sr; qv[9] = x1 * cr + x0 * sr; qv[10] = y0 * cc - y1 * sc; qv[11] = y1 * cc + y0 * sc; }
            bf16* qo = QB + ((size_t)(b * 8 + hh) * KPOS + pos) * 96 + sub;
#pragma unroll
            for (int mq = 0; mq < 12; ++mq) qo[8 * mq] = f2bf(qv[mq] * C2);
            float kv[12]; ss = 0.f;
#pragma unroll
            for (int mq = 0; mq < 8; ++mq) kv[mq] = KVPRE[(size_t)row * 1024 + hh * 128 + sub + 8 * mq] * rskv;
#pragma unroll
            for (int mq = 8; mq < 12; ++mq) kv[mq] = bf2f(ur[640 + sub + 8 * (mq - 8)]);
#pragma unroll
            for (int mq = 0; mq < 12; ++mq) ss += kv[mq] * kv[mq];
            ss = sum8(ss);
            rn = 1.0f / sqrtf(ss * (1.f / 96.f) + EPS);
#pragma unroll
            for (int mq = 0; mq < 12; ++mq) kv[mq] = kv[mq] * rn * kg[sub + 8 * mq];
            { const float x0 = kv[8], x1 = kv[9], y0 = kv[10], y1 = kv[11]; kv[8] = x0 * cr - x1 * sr; kv[9] = x1 * cr + x0 * sr; kv[10] = y0 * cc - y1 * sc; kv[11] = y1 * cc + y0 * sc; }
            bf16* ko = KB + ((size_t)(b * 8 + hh) * KPOS + pos) * 96 + sub;
#pragma unroll
            for (int mq = 0; mq < 12; ++mq) ko[8 * mq] = f2bf(kv[mq]);
#pragma unroll
            for (int mq = 0; mq < 8; ++mq) { const int dv = sub + 8 * mq; VL[(hh * 64 + dv) * 64 + pl] = f2bf(KVPRE[(size_t)row * 1024 + hh * 128 + 64 + dv] * rskv); }
        }
        __syncthreads();
        { const int hd = C.tid;
            bf16* dst = VT + ((size_t)(b * 8 + (hd >> 6)) * 64 + (hd & 63)) * KPOS + pos0;
#pragma unroll
            for (int q = 0; q < 8; ++q) *(u32x4*)(dst + 8 * q) = *(const LAS u32x4*)(VL + hd * 64 + 8 * q); }
        __syncthreads();
    }
}

DI void ph_conv(const Ctx& C, const bf16* U, const float* dww  , const float* dwb, const float* lng, const float* lnb, bf16* OCAT) {
    LAS float* G = (LAS float*)C.lds;
    const int c = C.tid;
    float wk[31];
#pragma unroll
    for (int k = 0; k < 31; ++k) wk[k] = dww[k * 512 + c];
    const float bias = dwb[c];
    for (int u = C.vcu; u < MT / 32; u += C.nb) {
        const int row0 = 32 * u; int base, t0, tseq;
        if (row0 < NLAT) { base = row0 & ~4095; t0 = row0 & 4095; tseq = TL; } else { const int rc = row0 - NLAT; base = NLAT + (rc & ~255); t0 = rc & 255; tseq = LCX; }
        __syncthreads();
        for (int rr = 0; rr < 62; ++rr) { const int tt = t0 - 15 + rr; float g = 0.f;
            if (tt >= 0 && tt < tseq) { const bf16* ur = U + (size_t)(base + tt) * EV_INP; g = bf2f(ur[672 + c]) * sigmoidf_(bf2f(ur[1184 + c])); }
            G[rr * 512 + c] = g; }
        __syncthreads();
        float acc[32];
#pragma unroll
        for (int t = 0; t < 32; ++t) acc[t] = bias;
#pragma unroll
        for (int rr = 0; rr < 62; ++rr) { const float gv = G[rr * 512 + c];
#pragma unroll
            for (int t = 0; t < 32; ++t) { const int k = rr - t; if (k >= 0 && k < 31) acc[t] += gv * wk[k]; } }
        __syncthreads();
#pragma unroll
        for (int t = 0; t < 32; ++t) G[t * 512 + c] = acc[t];
        __syncthreads();
#pragma unroll
        for (int q = 0; q < 4; ++q) {
            const int t = 4 * C.wave + q, row = row0 + t;
            const f32x4 a0 = *(const LAS f32x4*)(G + t * 512 + 8 * C.lane), a1 = *(const LAS f32x4*)(G + t * 512 + 8 * C.lane + 4);
            float x[8] = {a0.x, a0.y, a0.z, a0.w, a1.x, a1.y, a1.z, a1.w}; float s = 0.f;
#pragma unroll
            for (int e = 0; e < 8; ++e) s += x[e];
            const float mu = wave_sum(s) * (1.f / 512.f); float s2 = 0.f;
#pragma unroll
            for (int e = 0; e < 8; ++e) { x[e] -= mu; s2 += x[e] * x[e]; }
            const float rstd = 1.0f / sqrtf(wave_sum(s2) * (1.f / 512.f) + EPS);
            float y[8];
#pragma unroll
            for (int e = 0; e < 8; ++e) { const float z = x[e] * rstd * lng[8 * C.lane + e] + lnb[8 * C.lane + e]; y[e] = siluf_(z); }
            *(u32x4*)(OCAT + (size_t)row * DM + 512 + 8 * C.lane) = pack8(y);
        }
    }
}

DI void shifted8(const bf16* up, const bf16* uc, const bf16* un, bool hp, bool hn, const float* sw, int c0, float (&o)[8]) {
    const u32x4 z = {0u, 0u, 0u, 0u};
    const u32x4 vp = hp ? *(const u32x4*)(up + c0) : z, vc = *(const u32x4*)(uc + c0), vn = hn ? *(const u32x4*)(un + c0) : z;
    float p[8], c[8], n[8]; unpack8(vp, p); unpack8(vc, c); unpack8(vn, n);
#pragma unroll
    for (int e = 0; e < 8; ++e) o[e] = p[e] * sw[c0 + e] + c[e] * sw[RW_IN + c0 + e] + n[e] * sw[2 * RW_IN + c0 + e];
}
DI void ph_prep(const Ctx& C, const bf16* U, const float* sw  , const float* kkw  , const float* naqg, const float* nakg,
                bf16* R, bf16* V, bf16* K, bf16* KK, bf16* L, bf16* QN, bf16* KN, bf16* VTN) {
    LAS bf16* VL = (LAS bf16*)C.lds;
    const int lane = C.lane, hh = lane >> 3, sub = lane & 7;
    const float C2 = 0.125f * LOG2E;
    for (int u = C.vcu; u < MT / 64; u += C.nb) {
        const int row0 = 64 * u; const bool lat = row0 < NLAT;
        const int b = lat ? (row0 >> 12) : ((row0 - NLAT) >> 8), pos0 = lat ? (row0 & 4095) : TL + ((row0 - NLAT) & 255), tseq = lat ? TL : LCX, tb = lat ? (row0 & 4095) : ((row0 - NLAT) & 255);
        for (int i = 0; i < 8; ++i) {
            const int pl = 8 * C.wave + i, row = row0 + pl, pos = pos0 + pl, t = tb + pl;
            const bool hp = t > 0, hn = t < tseq - 1;
            const bf16* uc = U + (size_t)row * OD_INP; const bf16* up = uc - OD_INP; const bf16* un = uc + OD_INP;
            float o[8];
            shifted8(up, uc, un, hp, hn, sw, 8 * lane, o);          *(u32x4*)(R + (size_t)row * 512 + 8 * lane) = pack8(o);
            shifted8(up, uc, un, hp, hn, sw, 1024 + 8 * lane, o);   *(u32x4*)(V + (size_t)row * 512 + 8 * lane) = pack8(o);
            shifted8(up, uc, un, hp, hn, sw, 512 + 8 * lane, o);    *(u32x4*)(K + (size_t)row * 512 + 8 * lane) = pack8(o);
            { float kk[8]; float ss = 0.f;
#pragma unroll
                for (int e = 0; e < 8; ++e) { kk[e] = o[e] * kkw[8 * lane + e]; ss += kk[e] * kk[e]; }
                ss = sum8(ss); const float rn = 1.0f / sqrtf(ss + 1e-12f);
#pragma unroll
                for (int e = 0; e < 8; ++e) kk[e] *= rn;
                *(u32x4*)(KK + (size_t)row * 512 + 8 * lane) = pack8(kk); }
            if (lane < 48) {
                shifted8(up, uc, un, hp, hn, sw, 1536 + 8 * lane, o);
                if (lane < 16) {
#pragma unroll
                    for (int e = 0; e < 8; ++e) { const float ex = __expf(2.f * o[e]); o[e] = 1.f - 2.f / (ex + 1.f); }
                } else if (lane >= 32) {
#pragma unroll
                    for (int e = 0; e < 8; ++e) o[e] = sigmoidf_(o[e]);
                }
                *(u32x4*)(L + (size_t)row * 384 + 8 * lane) = pack8(o);
            }
            { float x[8]; unpack8(*(const u32x4*)(uc + RW_IN + 8 * lane), x); float ss = 0.f;
#pragma unroll
                for (int e = 0; e < 8; ++e) ss += x[e] * x[e];
                ss = sum8(ss); const float rn = 1.0f / sqrtf(ss * (1.f / 64.f) + EPS);
#pragma unroll
                for (int e = 0; e < 8; ++e) x[e] = x[e] * rn * naqg[8 * sub + e] * C2;
                *(u32x4*)(QN + ((size_t)(b * 8 + hh) * KPOS + pos) * 64 + 8 * sub) = pack8(x); }
            { float x[8]; unpack8(*(const u32x4*)(uc + RW_IN + 512 + 8 * lane), x); float ss = 0.f;
#pragma unroll
                for (int e = 0; e < 8; ++e) ss += x[e] * x[e];
                ss = sum8(ss); const float rn = 1.0f / sqrtf(ss * (1.f / 64.f) + EPS);
#pragma unroll
                for (int e = 0; e < 8; ++e) x[e] = x[e] * rn * nakg[8 * sub + e];
                *(u32x4*)(KN + ((size_t)(b * 8 + hh) * KPOS + pos) * 64 + 8 * sub) = pack8(x); }
            { const u32x4 vv = *(const u32x4*)(uc + RW_IN + 1024 + 8 * lane); const unsigned w4[4] = {vv.x, vv.y, vv.z, vv.w};
#pragma unroll
                for (int e = 0; e < 8; ++e) { const int dv = 8 * sub + e; VL[(hh * 64 + dv) * 64 + pl] = (bf16)((e & 1) ? (w4[e >> 1] >> 16) : (w4[e >> 1] & 0xffffu)); } }
        }
        __syncthreads();
        { const int hd = C.tid; bf16* dst = VTN + ((size_t)(b * 8 + (hd >> 6)) * 64 + (hd & 63)) * KPOS + pos0;
#pragma unroll
            for (int q = 0; q < 8; ++q) *(u32x4*)(dst + 8 * q) = *(const LAS u32x4*)(VL + hd * 64 + 8 * q); }
        __syncthreads();
    }
}

DI int scan_row(int s, int d, int b) { if (s < LCX) return NLAT + b * LCX + (d ? (LCX - 1 - s) : s); const int t = s - LCX; return b * TL + (d ? (TL - 1 - t) : t); }
DI void ph_scan(const Ctx& C, const bf16* R, const bf16* V, const bf16* KK, const float* W, const bf16* KEFF, const bf16* BSC, float* YS) {
    constexpr int CH = 32, BUF = 5 * CH * 64 + CH * 32;
    LAS float* lds = (LAS float*)C.lds;
    LAS float* ystage = lds + 2 * BUF;
    const int tid = C.tid, i = tid >> 4, kq = tid & 15;
    for (int cid = C.bid; cid < 256; cid += C.nb) {
        const int b = cid >> 5, hh = (cid >> 2) & 7, d = (cid >> 1) & 1, hf = cid & 1;
        const float* Wd = W + (size_t)d * MT * 512; const bf16* KEd = KEFF + (size_t)d * MT * 512; const bf16* BSd = BSC + (size_t)d * MT * 512; float* Yd = YS + (size_t)d * MT * 512;
        float S[4] = {0.f, 0.f, 0.f, 0.f};
        const int sl = tid >> 4, sub = tid & 15;
        f32x4 lw; u32x4 l1, l2, l3;
        auto issue = [&](int ck) {
            const int row = scan_row(ck * CH + sl, d, b);
            lw = *(const f32x4*)(Wd + (size_t)row * 512 + hh * 64 + 4 * sub);
            if (sub < 8) { l1 = *(const u32x4*)(R + (size_t)row * 512 + hh * 64 + 8 * sub); l2 = *(const u32x4*)(KEd + (size_t)row * 512 + hh * 64 + 8 * sub); }
            else { l1 = *(const u32x4*)(KK + (size_t)row * 512 + hh * 64 + 8 * (sub - 8)); l2 = *(const u32x4*)(BSd + (size_t)row * 512 + hh * 64 + 8 * (sub - 8)); }
            if (sub < 4) l3 = *(const u32x4*)(V + (size_t)row * 512 + hh * 64 + 32 * hf + 8 * sub);
        };
        auto commit = [&](int bufi) {
            LAS float* B = lds + bufi * BUF;
            *(LAS f32x4*)(B + (1 * CH + sl) * 64 + 4 * sub) = lw;
            float f1[8], f2[8]; unpack8(l1, f1); unpack8(l2, f2);
            const int a1 = sub < 8 ? 0 : 3, a2 = sub < 8 ? 2 : 4, off = 8 * (sub & 7);
            *(LAS f32x4*)(B + (a1 * CH + sl) * 64 + off) = (f32x4){f1[0], f1[1], f1[2], f1[3]}; *(LAS f32x4*)(B + (a1 * CH + sl) * 64 + off + 4) = (f32x4){f1[4], f1[5], f1[6], f1[7]};
            *(LAS f32x4*)(B + (a2 * CH + sl) * 64 + off) = (f32x4){f2[0], f2[1], f2[2], f2[3]}; *(LAS f32x4*)(B + (a2 * CH + sl) * 64 + off + 4) = (f32x4){f2[4], f2[5], f2[6], f2[7]};
            if (sub < 4) { float f3[8]; unpack8(l3, f3); LAS float* vp = B + 5 * CH * 64 + sl * 32 + 8 * sub;
                *(LAS f32x4*)vp = (f32x4){f3[0], f3[1], f3[2], f3[3]}; *(LAS f32x4*)(vp + 4) = (f32x4){f3[4], f3[5], f3[6], f3[7]}; }
        };
        __syncthreads();
        issue(0); commit(0);
        __syncthreads();
        constexpr int NCK = KPOS / CH;
        for (int ck = 0; ck < NCK; ++ck) {
            if (ck + 1 < NCK) issue(ck + 1);
            const LAS float* B = lds + (ck & 1) * BUF; LAS float* ys = ystage + (ck & 1) * CH * 32;
#pragma unroll 4
            for (int s = 0; s < CH; ++s) {
                const f32x4 rr = *(const LAS f32x4*)(B + (0 * CH + s) * 64 + 4 * kq), ww = *(const LAS f32x4*)(B + (1 * CH + s) * 64 + 4 * kq), ke = *(const LAS f32x4*)(B + (2 * CH + s) * 64 + 4 * kq),
                            kk = *(const LAS f32x4*)(B + (3 * CH + s) * 64 + 4 * kq), bs = *(const LAS f32x4*)(B + (4 * CH + s) * 64 + 4 * kq);
                const float v = B[5 * CH * 64 + s * 32 + i];
                float sa = -(S[0] * kk.x + S[1] * kk.y + S[2] * kk.z + S[3] * kk.w);
                sa = sum16(sa);
                S[0] = S[0] * ww.x + (sa * bs.x + v * ke.x); S[1] = S[1] * ww.y + (sa * bs.y + v * ke.y); S[2] = S[2] * ww.z + (sa * bs.z + v * ke.z); S[3] = S[3] * ww.w + (sa * bs.w + v * ke.w);
                float y = S[0] * rr.x + S[1] * rr.y + S[2] * rr.z + S[3] * rr.w;
                y = sum16(y);
                if (kq == 0) ys[s * 32 + i] = y;
            }
            if (ck + 1 < NCK) commit((ck + 1) & 1);
            __syncthreads();
            if (tid < 256) { const int s = tid >> 3, q = tid & 7; const int row = scan_row(ck * CH + s, d, b);
                *(f32x4*)(Yd + (size_t)row * 512 + hh * 64 + 32 * hf + 4 * q) = *(const LAS f32x4*)(ys + s * 32 + 4 * q); }
        }
    }
}


DI void ph_scan2(const Ctx& C, const bf16* R, const bf16* V, const bf16* KK, const float* W, const bf16* KEFF, const bf16* BSC, float* YS) {
    constexpr int CH = 16, BUF = 5 * CH * 64 + CH * 32, NCK = KPOS / CH, DEPTH = 4;
    static_assert(NCK % DEPTH == 0, "chunk loop is unrolled by DEPTH");
    LAS float* lds = (LAS float*)C.lds;
    LAS float* ypart = lds + 2 * BUF;
    const bool comp = C.wave < 4;
    const int rowl = 8 * (C.wave & 3) + (C.lane >> 3), ks = C.lane & 7, lt = C.tid - 256;
    for (int cid0 = C.bid; cid0 < 256; cid0 += C.nb) {
        const int hf = (cid0 >> 3) & 1, chain = (cid0 & 7) | ((cid0 >> 4) << 3), b = chain >> 4, hh = (chain >> 1) & 7, d = chain & 1;
        const float* Wd = W + (size_t)d * MT * 512; const bf16* KEd = KEFF + (size_t)d * MT * 512; const bf16* BSd = BSC + (size_t)d * MT * 512; float* Yd = YS + (size_t)d * MT * 512;
        u32x4 reg[DEPTH][4];
        auto issue = [&](int ck, u32x4 (&rg)[4]) {
#pragma unroll
            for (int rnd = 0; rnd < 4; ++rnd) { const int p = lt + 256 * rnd; rg[rnd] = (u32x4){0u, 0u, 0u, 0u};
                if (p < 832) { const int sl = p / 52, q = p % 52; const size_t base = (size_t)scan_row(ck * CH + sl, d, b) * 512 + hh * 64;
                    if (q < 16) rg[rnd] = *(const u32x4*)(Wd + base + 4 * q);
                    else if (q < 48) { const int a = (q - 16) >> 3, pc = (q - 16) & 7; const bf16* src = a == 0 ? R : (a == 1 ? KEd : (a == 2 ? KK : BSd)); rg[rnd] = *(const u32x4*)(src + base + 8 * pc); }
                    else rg[rnd] = *(const u32x4*)(V + base + 32 * hf + 8 * (q - 48)); } }
        };
        auto commit = [&](int bufi, const u32x4 (&rg)[4]) {
            LAS float* B = lds + bufi * BUF;
#pragma unroll
            for (int rnd = 0; rnd < 4; ++rnd) { const int p = lt + 256 * rnd;
                if (p < 832) { const int sl = p / 52, q = p % 52;
                    if (q < 16) *(LAS u32x4*)(B + (1 * CH + sl) * 64 + 4 * q) = rg[rnd];
                    else { float f[8]; unpack8(rg[rnd], f); LAS float* dst;
                        if (q < 48) { const int a = (q - 16) >> 3, pc = (q - 16) & 7; const int arr = a == 0 ? 0 : a + 1; dst = B + (arr * CH + sl) * 64 + 8 * pc; }
                        else dst = B + 5 * CH * 64 + sl * 32 + 8 * (q - 48);
                        *(LAS f32x4*)dst = (f32x4){f[0], f[1], f[2], f[3]}; *(LAS f32x4*)(dst + 4) = (f32x4){f[4], f[5], f[6], f[7]}; } } }
        };
        auto y_reduce = [&](int ck) {
            const LAS float* yp = ypart + (ck & 1) * (CH * 32 * 8) + lt * 16;
            const f32x4 a0 = *(const LAS f32x4*)yp, a1 = *(const LAS f32x4*)(yp + 4), b0 = *(const LAS f32x4*)(yp + 8), b1 = *(const LAS f32x4*)(yp + 12);
            const float y0 = ((a0.x + a0.y) + (a0.z + a0.w)) + ((a1.x + a1.y) + (a1.z + a1.w)), y1 = ((b0.x + b0.y) + (b0.z + b0.w)) + ((b1.x + b1.y) + (b1.z + b1.w));
            const int row = scan_row(ck * CH + (lt >> 4), d, b);
            *(f32x2*)(Yd + (size_t)row * 512 + hh * 64 + 32 * hf + 2 * (lt & 15)) = (f32x2){y0, y1};
        };
        f32x2 S[4];
#pragma unroll
        for (int q = 0; q < 4; ++q) S[q] = (f32x2){0.f, 0.f};
        __syncthreads();
        if (!comp) { issue(0, reg[0]); commit(0, reg[0]);
#pragma unroll
            for (int k = 1; k < DEPTH; ++k) issue(k, reg[k]); }
        __syncthreads();
        for (int ck0 = 0; ck0 < NCK; ck0 += DEPTH) {
#pragma unroll
            for (int kk = 0; kk < DEPTH; ++kk) {
                const int ck = ck0 + kk;
                if (comp) {
                    const LAS float* B = lds + (ck & 1) * BUF + 8 * ks; LAS float* yq = ypart + (ck & 1) * (CH * 32 * 8) + rowl * 8 + ks;
#pragma unroll 4
                    for (int sI = 0; sI < CH; ++sI) {
                        const LAS float* bp = B + sI * 64;
                        const f32x4 r0 = *(const LAS f32x4*)(bp), r1 = *(const LAS f32x4*)(bp + 4), w0 = *(const LAS f32x4*)(bp + CH * 64), w1 = *(const LAS f32x4*)(bp + CH * 64 + 4),
                                    e0 = *(const LAS f32x4*)(bp + 2 * CH * 64), e1 = *(const LAS f32x4*)(bp + 2 * CH * 64 + 4), k0 = *(const LAS f32x4*)(bp + 3 * CH * 64), k1 = *(const LAS f32x4*)(bp + 3 * CH * 64 + 4),
                                    c0 = *(const LAS f32x4*)(bp + 4 * CH * 64), c1 = *(const LAS f32x4*)(bp + 4 * CH * 64 + 4);
                        const float v = lds[(ck & 1) * BUF + 5 * CH * 64 + sI * 32 + rowl];
                        f32x2 acc = S[0] * (f32x2){k0.x, k0.y};
                        acc = __builtin_elementwise_fma(S[1], (f32x2){k0.z, k0.w}, acc); acc = __builtin_elementwise_fma(S[2], (f32x2){k1.x, k1.y}, acc); acc = __builtin_elementwise_fma(S[3], (f32x2){k1.z, k1.w}, acc);
                        const float sa = sum8(-(acc.x + acc.y));
                        const f32x2 sa2 = {sa, sa}, v2 = {v, v};
                        S[0] = __builtin_elementwise_fma(S[0], (f32x2){w0.x, w0.y}, __builtin_elementwise_fma(sa2, (f32x2){c0.x, c0.y}, v2 * (f32x2){e0.x, e0.y}));
                        S[1] = __builtin_elementwise_fma(S[1], (f32x2){w0.z, w0.w}, __builtin_elementwise_fma(sa2, (f32x2){c0.z, c0.w}, v2 * (f32x2){e0.z, e0.w}));
                        S[2] = __builtin_elementwise_fma(S[2], (f32x2){w1.x, w1.y}, __builtin_elementwise_fma(sa2, (f32x2){c1.x, c1.y}, v2 * (f32x2){e1.x, e1.y}));
                        S[3] = __builtin_elementwise_fma(S[3], (f32x2){w1.z, w1.w}, __builtin_elementwise_fma(sa2, (f32x2){c1.z, c1.w}, v2 * (f32x2){e1.z, e1.w}));
                        f32x2 ya = S[0] * (f32x2){r0.x, r0.y};
                        ya = __builtin_elementwise_fma(S[1], (f32x2){r0.z, r0.w}, ya); ya = __builtin_elementwise_fma(S[2], (f32x2){r1.x, r1.y}, ya); ya = __builtin_elementwise_fma(S[3], (f32x2){r1.z, r1.w}, ya);
                        yq[sI * 256] = ya.x + ya.y;
                    }
                } else {
                    if (ck + 1 < NCK) commit((ck + 1) & 1, reg[(kk + 1) % DEPTH]);
                    if (ck + DEPTH < NCK) issue(ck + DEPTH, reg[kk]);
                    if (ck > 0) y_reduce(ck - 1);
                }
                __syncthreads();
            }
        }
        if (!comp) y_reduce(NCK - 1);
    }
}

DI void ph_post(const Ctx& C, const float* YS, const bf16* R, const bf16* V, const bf16* KEFF, const bf16* G, const float* rk, const float* gng, const float* gnb, bf16* OCAT, bool last) {
    const int gw = C.bid * 8 + C.wave, ngw = C.nb * 8, lane = C.lane, nrows = last ? NLAT : MT;
    for (int row = gw; row < nrows; row += ngw) {
        const size_t o = (size_t)row * 512 + 8 * lane;
        const f32x4 y0a = *(const f32x4*)(YS + o), y0b = *(const f32x4*)(YS + o + 4), y1a = *(const f32x4*)(YS + (size_t)MT * 512 + o), y1b = *(const f32x4*)(YS + (size_t)MT * 512 + o + 4);
        float y[8] = {y0a.x + y1a.x, y0a.y + y1a.y, y0a.z + y1a.z, y0a.w + y1a.w, y0b.x + y1b.x, y0b.y + y1b.y, y0b.z + y1b.z, y0b.w + y1b.w};
        float r[8], v[8], k0[8], k1[8], g[8];
        unpack8(*(const u32x4*)(R + o), r); unpack8(*(const u32x4*)(V + o), v); unpack8(*(const u32x4*)(KEFF + o), k0); unpack8(*(const u32x4*)(KEFF + (size_t)MT * 512 + o), k1); unpack8(*(const u32x4*)(G + o), g);
        float bsum = 0.f;
#pragma unroll
        for (int e = 0; e < 8; ++e) bsum += r[e] * (k0[e] + k1[e]) * rk[8 * lane + e];
        bsum = sum8(bsum);
        float s = 0.f;
#pragma unroll
        for (int e = 0; e < 8; ++e) { y[e] += bsum * v[e]; s += y[e]; }
        const float mu = sum8(s) * (1.f / 64.f); float s2 = 0.f;
#pragma unroll
        for (int e = 0; e < 8; ++e) { y[e] -= mu; s2 += y[e] * y[e]; }
        const float rstd = 1.0f / sqrtf(sum8(s2) * (1.f / 64.f) + GN_EPS);
        float out[8];
#pragma unroll
        for (int e = 0; e < 8; ++e) out[e] = (y[e] * rstd * gng[8 * lane + e] + gnb[8 * lane + e]) * g[e];
        *(u32x4*)(OCAT + (size_t)row * DM + 8 * lane) = pack8(out);
    }
}

DI void ph_topk(const Ctx& C, const float* AFFT, const float* AFFC, int* ROWS, float* GATE, int* SLOT, bool last) {
    LAS unsigned long long* key = (LAS unsigned long long*)C.lds;
    const int nprob = last ? 128 : 256;
    for (int p = C.bid; p < nprob; p += C.nb) {
        const bool isctx = p >= 128; const int be = p & 127, b = be >> 4, e = be & 15;
        const int n = isctx ? LCX : TL, cap = isctx ? CAPC : CAPL;
        const float* src = isctx ? AFFC + (size_t)be * LCX : AFFT + (size_t)be * TL;
        __syncthreads();
        for (int t = C.tid; t < n; t += 512) key[t] = ((unsigned long long)__builtin_bit_cast(unsigned, src[t]) << 32) | (unsigned long long)(0xFFFFFFFFu - (unsigned)t);
        __syncthreads();
        for (int k = 2; k <= n; k <<= 1)
            for (int j = k >> 1; j > 0; j >>= 1) {
                for (int q = C.tid; q < n / 2; q += 512) {
                    const int i = ((q & ~(j - 1)) << 1) | (q & (j - 1)), ix = i | j;
                    const unsigned long long a = key[i], bb = key[ix];
                    const bool desc = ((i & k) == 0);
                    if (desc ? (a < bb) : (a > bb)) { key[i] = bb; key[ix] = a; }
                }
                __syncthreads();
            }
        for (int jx = C.tid; jx < cap; jx += 512) {
            const unsigned long long kv = key[jx]; const int t = (int)(0xFFFFFFFFu - (unsigned)(kv & 0xFFFFFFFFull)); const float g = __builtin_bit_cast(float, (unsigned)(kv >> 32));
            const int slot = isctx ? NB * CAPL + b * CAPC + jx : b * CAPL + jx, row = isctx ? NLAT + b * LCX + t : b * TL + t;
            ROWS[e * ESLOTS + slot] = row; GATE[e * ESLOTS + slot] = g; SLOT[(size_t)row * 16 + e] = slot;
        }
    }
}

DI void ph_combine(const Ctx& C, float* xlat, float* xctx, const float* modg2  , const int* SLOT, const bf16* Y2, bool last) {
    const int gw = C.bid * 8 + C.wave, ngw = C.nb * 8, lane = C.lane, nrows = last ? NLAT : MT;
    for (int row = gw; row < nrows; row += ngw) {
        float* xr = row < NLAT ? xlat + (size_t)row * DM : xctx + (size_t)(row - NLAT) * DM;
        const int mi = row < NLAT ? (row >> 12) : 8;
        const int sv = SLOT[(size_t)row * 16 + (lane & 15)];
        f32x4 acc[4];
#pragma unroll
        for (int j = 0; j < 4; ++j) acc[j] = (f32x4){0.f, 0.f, 0.f, 0.f};
#pragma unroll
        for (int e = 0; e < 16; ++e) {
            const int s = __builtin_amdgcn_readlane(sv, e);
            if (s >= 0) { const bf16* yp = Y2 + ((size_t)e * ESLOTS + s) * DM + 4 * lane;
#pragma unroll
                for (int j = 0; j < 4; ++j) { const u32x2 w = *(const u32x2*)(yp + 256 * j); acc[j] += (f32x4){bflo(w.x), bfhi(w.x), bflo(w.y), bfhi(w.y)}; } }
        }
#pragma unroll
        for (int j = 0; j < 4; ++j) { const int c = 256 * j + 4 * lane; const f32x4 g = *(const f32x4*)(modg2 + mi * 6144 + c); f32x4 x = *(const f32x4*)(xr + c); x += g * acc[j]; *(f32x4*)(xr + c) = x; }
    }
}

template <int N> struct IC { static constexpr int value = N; };
template <class T> DI T* launder_ptr(T* p) { unsigned long long v = (unsigned long long)p; unsigned lo = (unsigned)v, hi = (unsigned)(v >> 32); asm volatile("" : "+v"(lo), "+v"(hi));
    lo = __builtin_amdgcn_readfirstlane(lo); hi = __builtin_amdgcn_readfirstlane(hi); return (T*)(__attribute__((address_space(1))) T*)(((unsigned long long)hi << 32) | lo); }
constexpr int PH_PER_PAIR = 24, N_PHASES = 1 + 2 * PH_PER_PAIR;
constexpr size_t WS_PTRS = 128 * 1024;
#define P_XC    ((float*)(ws + WS_XC))
#define P_MOD   ((const float*)(ws + WS_MOD))
#define P_HB    ((bf16*)(ws + WS_HB))
#define P_OCAT  ((bf16*)(ws + WS_OCAT))
#define P_AR    (ws + WS_ARENA)
#define P_ROWS  ((int*)(ws + WS_ROWS))
#define P_GATE  ((float*)(ws + WS_GATE))
#define P_SLOT  ((int*)(ws + WS_SLOT))
#define P_AFFT  ((float*)(ws + WS_AFFT))
#define P_AFFC  ((float*)(ws + WS_AFFC))
#define P_W13   ((bf16*)(ws + WS_W13))
#define P_W2    ((bf16*)(ws + WS_W2))
#define P_U     ((bf16*)(P_AR + A_U))
#define P_QPRE  ((float*)(P_AR + A_QPRE))
#define P_KVPRE ((float*)(P_AR + A_KVPRE))
#define P_QB    ((bf16*)(P_AR + A_QB))
#define P_KB    ((bf16*)(P_AR + A_KB))
#define P_VT    ((bf16*)(P_AR + A_VT))
#define P_W     ((float*)(P_AR + A_W))
#define P_KEFF  ((bf16*)(P_AR + A_KEFF))
#define P_BSC   ((bf16*)(P_AR + A_BSC))
#define P_R     ((bf16*)(P_AR + A_R))
#define P_V     ((bf16*)(P_AR + A_V))
#define P_KK    ((bf16*)(P_AR + A_KK))
#define P_G     ((bf16*)(P_AR + A_G))
#define P_K     ((bf16*)(P_AR + A_K))
#define P_L     ((bf16*)(P_AR + A_L))
#define P_QN    ((bf16*)(P_AR + A_QN))
#define P_KN    ((bf16*)(P_AR + A_KN))
#define P_VTN   ((bf16*)(P_AR + A_VTN))
#define P_YS    ((float*)(P_AR + A_YS))
#define P_HID   ((bf16*)(P_AR + A_HID))
#define P_Y2    ((bf16*)(P_AR + A_Y2))
#define MODL(i) (P_MOD + (size_t)(i) * 9 * 6144)
#define RELAUNDER() do { int l_ = C.lane; asm volatile("" : "+v"(l_)); C.lane = l_; C.tid = (C.wave << 6) | l_; } while (0)
__global__ void __launch_bounds__(512, 2) fwd_kernel(Args a) {
    extern __shared__ __attribute__((aligned(16))) unsigned char smem[];
    Ctx C0; C0.lds = (LAS unsigned char*)smem; C0.tid = threadIdx.x; C0.lane = C0.tid & 63; C0.wave = __builtin_amdgcn_readfirstlane(C0.tid >> 6); C0.bid = blockIdx.x; C0.nb = gridDim.x;
    C0.vcu = (C0.nb % 8 == 0) ? (C0.bid % 8) * (C0.nb / 8) + C0.bid / 8 : C0.bid;
    volatile LAS unsigned* bst = (volatile LAS unsigned*)(C0.lds + LDS_BYTES - 16);
#if MEGA
    if (C0.tid == 0) { bst[0] = 0u; bst[1] = 0u; }
    __syncthreads();
    const unsigned bar_x = xcd_barrier_post((unsigned*)(a.ws + WS_CTL) + 4096, bst, C0.tid == 0).x;
#define SEAM() do { if (ph < hi) { XcdBarrier b2_; b2_.bar = (unsigned*)(ws + WS_CTL) + 4096; b2_.x = bar_x; b2_.st = bst; xcd_barrier(b2_, C.tid == 0); } } while (0)
#else
#define SEAM() do { } while (0)
#endif
#if MEGA
    constexpr int lo = 0, hi = N_PHASES;
#else
    const int lo = a.ph_lo, hi = a.ph_hi;
#endif
    int ph = 0;
#ifndef ONLY
#define ONLY -1
#endif
#ifndef REPMASK
#define REPMASK 0
#endif
#ifndef SITE_LO
#define SITE_LO 0
#define SITE_HI 99
#endif
#define PHASE(SITE, ...) do { if ((ONLY < 0 || ONLY == (SITE)) && (SITE) >= SITE_LO && (SITE) <= SITE_HI && ph >= lo && ph < hi) { Ctx C; C.lds = C0.lds; \
        { int w_ = C0.wave; asm volatile("" : "+s"(w_)); unsigned m_ = ~0u; asm volatile("" : "+s"(m_)); int l_ = (int)__builtin_amdgcn_mbcnt_hi(m_, __builtin_amdgcn_mbcnt_lo(m_, 0u)); C.wave = w_; C.lane = l_; C.tid = (w_ << 6) | l_; } \
        { int b_ = C0.bid, n_ = C0.nb, v_ = C0.vcu; asm volatile("" : "+s"(b_), "+s"(n_), "+s"(v_)); C.bid = b_; C.nb = n_; C.vcu = v_; } \
        unsigned z_ = 0u; asm volatile("" : "+s"(z_)); unsigned char* ws = a.ws + z_; float* XL = a.out + z_; const int lq = __builtin_amdgcn_readfirstlane(lp); typedef const __attribute__((address_space(1))) float* gfp_t; const gfp_t* INT_ = (const gfp_t*)(ws + WS_PTRS); (void)INT_; (void)XL; (void)lq; \
        for (int rep_ = 0; rep_ < ((((REPMASK) >> (SITE)) & 1) ? 2 : 1); ++rep_) { __VA_ARGS__; if ((((REPMASK) >> (SITE)) & 1)) __syncthreads(); } ++ph; SEAM(); } else ++ph; } while (0)

    { const int lp = 0;
      PHASE(0, { if (C.bid == 0) { _Pragma("unroll") for (int k = 0; k < 40; ++k) if (C.tid == k) ((const float**)(ws + WS_PTRS))[k] = a.in[k]; }
                 ph_prologue(C, a); }); }

    auto layer_pair = [&](auto lpc) __attribute__((always_inline)) {
        constexpr int lp = decltype(lpc)::value;
        PHASE(1, { const int i = 2 * lq; const float* xl = (i == 0) ? ((const float*)INT_[I_X]) : XL; const float* xc = (i == 0) ? ((const float*)INT_[I_CTX]) : P_XC;
                   ph_norm<false>(C, xl, xc, ((const float*)INT_[I_N1G]) + i * DM, MODL(i), 0, 1024, P_HB, nullptr, nullptr, nullptr, nullptr);
                   moe_weight_prep(C, ((const float*)INT_[I_MW1]) + (size_t)i * NEXP * DM * DM, ((const float*)INT_[I_MW3]) + (size_t)i * NEXP * DM * DM, ((const float*)INT_[I_MW2]) + (size_t)i * NEXP * DM * DM, P_W13, P_W2); });
        PHASE(2, { EpiBf16 E{P_U, EV_INP}; fast_gemm(C, P_HB, DM, (const bf16*)(ws + WS_WEVIN) + (size_t)lq * EV_INP * DM, DM, MT / 256, EV_INP / 256, E); });
        PHASE(3, { EpiF32 Eq{P_QPRE, 768}; fast_gemm(C, P_U, EV_INP, (const bf16*)(ws + WS_WUQ) + (size_t)lq * 768 * 384, 384, MT / 256, 3, Eq); RELAUNDER();
                   EpiF32 Ek{P_KVPRE, 1024}; fast_gemm(C, P_U + 384, EV_INP, (const bf16*)(ws + WS_WUKV) + (size_t)lq * 1024 * 256, 256, MT / 256, 4, Ek); });
        PHASE(4, { ph_mla_fin(C, P_U, P_QPRE, P_KVPRE, ((const float*)INT_[I_QG]) + lq * 96, ((const float*)INT_[I_KG]) + lq * 96, (const f32x2*)(ws + WS_ROPE), P_QB, P_KB, P_VT);
                   ph_conv(C, P_U, ((const float*)INT_[I_DWW]) + (size_t)lq * 31 * 512, ((const float*)INT_[I_DWB]) + lq * 512, ((const float*)INT_[I_LNG]) + lq * 512, ((const float*)INT_[I_LNB]) + lq * 512, P_OCAT); });
        PHASE(5, ph_attn_mla2(C, P_QB, P_KB, P_VT, P_OCAT, false));
        PHASE(6, { const int i = 2 * lq; const float* xl = (i == 0) ? ((const float*)INT_[I_X]) : XL; const float* xc = (i == 0) ? ((const float*)INT_[I_CTX]) : P_XC;
                   EpiResid E{xl, xc, XL, P_XC, MODL(i) + 2048}; fast_gemm(C, P_OCAT, DM, (const bf16*)(ws + WS_WEVOUT) + (size_t)lq * DM * DM, DM, MT / 256, 4, E); });
        PHASE(7, { const int i = 2 * lq; ph_norm<true>(C, XL, P_XC, ((const float*)INT_[I_N2G]) + i * DM, MODL(i), 3072, 4096, P_HB, ((const float*)INT_[I_ROUTER]) + (size_t)i * DM * 16, P_AFFT, P_AFFC, P_SLOT); });
        PHASE(8, ph_topk(C, P_AFFT, P_AFFC, P_ROWS, P_GATE, P_SLOT, false));
        PHASE(9, { pg8::Gemm g{P_HB, P_W13, DM, DM, P_ROWS}; pg8::OrderMoE S{17, 8, 17, C.nb, C.vcu}; pg8::EpiAdapt<EpiGlu> E{EpiGlu{P_HID}}; pg8::gemm_phase(C.lds, g, S, E, C.tid); });
        PHASE(10, { pg8::Gemm g{P_HID, P_W2, DM, DM, nullptr}; pg8::OrderMoE S{17, 4, 17, C.nb, C.vcu}; pg8::EpiAdapt<EpiGate> E{EpiGate{P_Y2, P_GATE}}; pg8::gemm_phase(C.lds, g, S, E, C.tid); });
        PHASE(11, { const int i = 2 * lq; ph_combine(C, XL, P_XC, MODL(i) + 5120, P_SLOT, P_Y2, false); });
        PHASE(12, { const int i = 2 * lq + 1; ph_norm<false>(C, XL, P_XC, ((const float*)INT_[I_N1G]) + i * DM, MODL(i), 0, 1024, P_HB, nullptr, nullptr, nullptr, nullptr);
                    moe_weight_prep(C, ((const float*)INT_[I_MW1]) + (size_t)i * NEXP * DM * DM, ((const float*)INT_[I_MW3]) + (size_t)i * NEXP * DM * DM, ((const float*)INT_[I_MW2]) + (size_t)i * NEXP * DM * DM, P_W13, P_W2); });
        PHASE(13, { EpiBf16 E{P_U, OD_INP}; fast_gemm(C, P_HB, DM, (const bf16*)(ws + WS_WODIN) + (size_t)lq * OD_INP * DM, DM, MT / 256, OD_INP / 256, E); });
        PHASE(14, ph_prep(C, P_U, ((const float*)INT_[I_SHIFTW]) + (size_t)lq * 3 * RW_IN, ((const float*)INT_[I_KKW]) + lq * 512, ((const float*)INT_[I_NAQG]) + lq * 64, ((const float*)INT_[I_NAKG]) + lq * 64, P_R, P_V, P_K, P_KK, P_L, P_QN, P_KN, P_VTN));
        PHASE(15, { const bf16* WL = (const bf16*)(ws + WS_WLORA) + (size_t)lq * 196608;
                    for (int u = C.vcu; u < (MT / 256) * 10; u += C.nb) { const int pm = u / 10, q = u % 10;
                        if (q < 4) { const int d = q >> 1, pn = q & 1; EpiLoraW E{P_W + (size_t)d * MT * 512, ((const float*)INT_[I_W0]) + lq * 1024 + d * 512};
                            gemm_unit(P_L + d * 64, 384, nullptr, WL + (size_t)d * 32768, 64, pm, pn, E, C.wave, C.lane); }
                        else if (q < 8) { const int d = (q - 4) >> 1, pn = q & 1; EpiLoraA E{P_KEFF + (size_t)d * MT * 512, P_BSC + (size_t)d * MT * 512, P_K, P_KK, ((const float*)INT_[I_A0]) + lq * 1024 + d * 512, ((const float*)INT_[I_KA]) + lq * 512};
                            gemm_unit(P_L + 128 + d * 64, 384, nullptr, WL + 65536 + (size_t)d * 32768, 64, pm, pn, E, C.wave, C.lane); }
                        else { const int pn = q & 1; EpiBf16 E{P_G, 512}; gemm_unit(P_L + 256, 384, nullptr, WL + 131072, 128, pm, pn, E, C.wave, C.lane); } } });
        PHASE(16, ph_natten(C, P_QN, P_KN, P_VTN, P_OCAT, ((const float*)INT_[I_RPB]) + (size_t)lq * 8 * 465, lq == 1));
        PHASE(17, ph_scan2(C, P_R, P_V, P_KK, P_W, P_KEFF, P_BSC, P_YS));
        PHASE(18, ph_post(C, P_YS, P_R, P_V, P_KEFF, P_G, ((const float*)INT_[I_RK]) + lq * 512, ((const float*)INT_[I_GNG]) + lq * 512, ((const float*)INT_[I_GNB]) + lq * 512, P_OCAT, lq == 1));
        PHASE(19, { const int i = 2 * lq + 1; EpiResid E{XL, P_XC, XL, P_XC, MODL(i) + 2048};
                    fast_gemm(C, P_OCAT, DM, (const bf16*)(ws + WS_WODOUT) + (size_t)lq * DM * DM, DM, (lq == 1) ? NLAT / 256 : MT / 256, 4, E); });
        PHASE(20, { const int i = 2 * lq + 1; ph_norm<true>(C, XL, P_XC, ((const float*)INT_[I_N2G]) + i * DM, MODL(i), 3072, 4096, P_HB, ((const float*)INT_[I_ROUTER]) + (size_t)i * DM * 16, P_AFFT, P_AFFC, P_SLOT); });
        PHASE(21, ph_topk(C, P_AFFT, P_AFFC, P_ROWS, P_GATE, P_SLOT, lq == 1));
        PHASE(22, { pg8::Gemm g{P_HB, P_W13, DM, DM, P_ROWS}; pg8::OrderMoE S{(lq == 1) ? 16 : 17, 8, 17, C.nb, C.vcu}; pg8::EpiAdapt<EpiGlu> E{EpiGlu{P_HID}}; pg8::gemm_phase(C.lds, g, S, E, C.tid); });
        PHASE(23, { pg8::Gemm g{P_HID, P_W2, DM, DM, nullptr}; pg8::OrderMoE S{(lq == 1) ? 16 : 17, 4, 17, C.nb, C.vcu}; pg8::EpiAdapt<EpiGate> E{EpiGate{P_Y2, P_GATE}}; pg8::gemm_phase(C.lds, g, S, E, C.tid); });
        PHASE(24, { const int i = 2 * lq + 1; ph_combine(C, XL, P_XC, MODL(i) + 5120, P_SLOT, P_Y2, lq == 1); });
    };
    layer_pair(IC<0>{}); layer_pair(IC<1>{});
}

extern "C" void kernel_launch(void* const* d_in, const int* in_sizes, int n_in, void* d_out, int out_size, void* d_ws, size_t ws_size, hipStream_t stream) {
    static int grid = 0;
    if (grid == 0) {
        if (n_in != 40 || out_size != NLAT * DM || ws_size < WS_END) { fprintf(stderr, "kernel_launch: unexpected shapes (n_in %d out %d ws %zu need %zu)\n", n_in, out_size, ws_size, (size_t)WS_END); grid = -1; return; }
        int dev = 0, cus = 0, per_cu = 0;
        if (hipGetDevice(&dev) != hipSuccess || hipDeviceGetAttribute(&cus, hipDeviceAttributeMultiprocessorCount, dev) != hipSuccess) { grid = -1; return; }
        if (hipFuncSetAttribute((const void*)fwd_kernel, hipFuncAttributeMaxDynamicSharedMemorySize, LDS_BYTES) != hipSuccess) { fprintf(stderr, "kernel_launch: hipFuncSetAttribute failed\n"); grid = -1; return; }
        if (hipOccupancyMaxActiveBlocksPerMultiprocessor(&per_cu, (const void*)fwd_kernel, 512, LDS_BYTES) != hipSuccess || per_cu < 1) { fprintf(stderr, "kernel_launch: occupancy query says %d\n", per_cu); per_cu = 1; }
        (void)hipGetLastError();
        grid = cus;
    }
    if (grid < 0) return;
    (void)hipMemsetAsync((char*)d_ws + WS_CTL, 0, CTL_BYTES, stream);
    Args a{};
    for (int i = 0; i < 40; ++i) a.in[i] = (const float*)d_in[i];
    a.out = (float*)d_out; a.ws = (unsigned char*)d_ws;
#if MEGA
    a.ph_lo = 0; a.ph_hi = N_PHASES;
    hipLaunchKernelGGL(fwd_kernel, dim3(grid), dim3(512), LDS_BYTES, stream, a);
#else
    for (int p = 0; p < N_PHASES; ++p) { a.ph_lo = p; a.ph_hi = p + 1; hipLaunchKernelGGL(fwd_kernel, dim3(grid), dim3(512), LDS_BYTES, stream, a); }
#endif
}
```

```cpp
#include <hip/hip_runtime.h>
#include <cstdio>
#include <cstdint>

#ifndef MEGA
#define MEGA 1
#endif

#define LAS __attribute__((address_space(3)))
#define DI __device__ __forceinline__

typedef unsigned short bf16;
typedef short bf16x8 __attribute__((ext_vector_type(8)));
typedef float f32x4 __attribute__((ext_vector_type(4)));
typedef float f32x2 __attribute__((ext_vector_type(2)));
typedef float f32x16 __attribute__((ext_vector_type(16)));
typedef unsigned u32x4 __attribute__((ext_vector_type(4)));
typedef unsigned u32x2 __attribute__((ext_vector_type(2)));
typedef __bf16 bf16x2_t __attribute__((ext_vector_type(2)));

constexpr int DM = 1024, NB = 8, TL = 4096, LCX = 256;
constexpr int NLAT = NB * TL, NCTX = NB * LCX, MT = NLAT + NCTX;
constexpr int KPOS = TL + LCX;
constexpr float EPS = 1e-6f, GN_EPS = 64e-5f;
constexpr int EV_IN = 1696, EV_INP = 1792, OD_IN = 3456, OD_INP = 3584, RW_IN = 1920;
constexpr int NEXP = 16, CAPL = 512, CAPC = 32, ESLOTS = NB * CAPL + NB * CAPC;
constexpr float LOG2E = 1.4426950408889634f;

constexpr size_t MiB = 1ull << 20;
constexpr size_t WS_CTL = 0, CTL_BYTES = 1 * MiB;
constexpr size_t WS_MOD = 1 * MiB, WS_ROPE = 2 * MiB, WS_XC = 4 * MiB;
constexpr size_t WS_ROWS = 12 * MiB, WS_GATE = 12 * MiB + 512 * 1024, WS_SLOT = 13 * MiB, WS_AFFT = 16 * MiB, WS_AFFC = 18 * MiB;
constexpr size_t WS_WEVIN = 20 * MiB, WS_WEVOUT = 27 * MiB, WS_WUQ = 31 * MiB, WS_WUKV = 33 * MiB, WS_WODIN = 34 * MiB, WS_WODOUT = 48 * MiB, WS_WLORA = 52 * MiB;
constexpr size_t WS_W13 = 56 * MiB, WS_W2 = 120 * MiB, WS_HB = 152 * MiB, WS_OCAT = 220 * MiB, WS_ARENA = 288 * MiB;
constexpr size_t A_U = 0, A_QPRE = 119 * MiB, A_KVPRE = 221 * MiB, A_QB = 357 * MiB, A_KB = 408 * MiB, A_VT = 459 * MiB;
constexpr size_t A_W = 0, A_KEFF = 136 * MiB  , A_G = 204 * MiB, A_R = 238 * MiB, A_V = 272 * MiB, A_KK = 306 * MiB, A_K = 340 * MiB, A_L = 374 * MiB,
                 A_QN = 400 * MiB, A_KN = 434 * MiB, A_VTN = 468 * MiB, A_YS = 374 * MiB  ;
constexpr size_t A_HID = 0, A_Y2 = 136 * MiB;
constexpr size_t WS_END = WS_ARENA + 570 * MiB;
constexpr int LDS_BYTES = 147456;

DI unsigned pk2(float lo, float hi) { f32x2 v = {lo, hi}; bf16x2_t b = __builtin_convertvector(v, bf16x2_t); return __builtin_bit_cast(unsigned, b); }
DI float bflo(unsigned u) { return __builtin_bit_cast(float, u << 16); }
DI float bfhi(unsigned u) { return __builtin_bit_cast(float, u & 0xffff0000u); }
DI float bf2f(bf16 x) { return __builtin_bit_cast(float, ((unsigned)x) << 16); }
DI bf16 f2bf(float f) { return (bf16)(pk2(f, 0.f) & 0xffffu); }
DI void unpack8(u32x4 v, float (&f)[8]) { f[0] = bflo(v.x); f[1] = bfhi(v.x); f[2] = bflo(v.y); f[3] = bfhi(v.y); f[4] = bflo(v.z); f[5] = bfhi(v.z); f[6] = bflo(v.w); f[7] = bfhi(v.w); }
DI u32x4 pack8(const float (&f)[8]) { u32x4 r; r.x = pk2(f[0], f[1]); r.y = pk2(f[2], f[3]); r.z = pk2(f[4], f[5]); r.w = pk2(f[6], f[7]); return r; }
#define DPP_ADD(x, ctrl) ((x) + __builtin_bit_cast(float, __builtin_amdgcn_update_dpp(0, __builtin_bit_cast(int, (x)), (ctrl), 0xf, 0xf, false)))
#define DPP_MAX(x, ctrl) fmaxf((x), __builtin_bit_cast(float, __builtin_amdgcn_update_dpp(0, __builtin_bit_cast(int, (x)), (ctrl), 0xf, 0xf, false)))
DI float sum8(float x) { x = DPP_ADD(x, 0xB1); x = DPP_ADD(x, 0x4E); x = DPP_ADD(x, 0x141); return x; }
DI float sum16(float x) { x = DPP_ADD(x, 0xB1); x = DPP_ADD(x, 0x4E); x = DPP_ADD(x, 0x141); x = DPP_ADD(x, 0x140); return x; }
DI float max16(float x) { x = DPP_MAX(x, 0xB1); x = DPP_MAX(x, 0x4E); x = DPP_MAX(x, 0x141); x = DPP_MAX(x, 0x140); return x; }
DI float rdlane(float x, int l) { return __builtin_bit_cast(float, __builtin_amdgcn_readlane(__builtin_bit_cast(int, x), l)); }
DI float wave_sum(float v) { const float x = sum16(v); return (rdlane(x, 0) + rdlane(x, 16)) + (rdlane(x, 32) + rdlane(x, 48)); }
DI float xor32(float v, int lane) { return __builtin_bit_cast(float, __builtin_amdgcn_ds_bpermute((lane ^ 32) << 2, __builtin_bit_cast(int, v))); }
DI float sigmoidf_(float x) { return __builtin_amdgcn_rcpf(1.f + __expf(-x)); }
DI float siluf_(float x) { return x * __builtin_amdgcn_rcpf(1.f + __expf(-x)); }
#define MFMA32(a, b, c) __builtin_amdgcn_mfma_f32_32x32x16_bf16((a), (b), (c), 0, 0, 0)

#define XB_TMO      128
#define XB_XCNT(j)  (256  + 64 * (j))
#define XB_XSUB(j)  (1280 + 64 * (j))
#define XB_XGEN(j)  (2304 + 64 * (j))
#define XB_TOP      3328
#define XB_TOPGEN   3392
#define XCD_BAR_WORDS 3456
#define XB_SPIN_CAP (1u << 22)
__device__ __forceinline__ unsigned xb_ld(unsigned* p)              { return __hip_atomic_load(p, __ATOMIC_RELAXED, __HIP_MEMORY_SCOPE_AGENT); }
__device__ __forceinline__ unsigned xb_add(unsigned* p, unsigned v) { return __hip_atomic_fetch_add(p, v, __ATOMIC_RELAXED, __HIP_MEMORY_SCOPE_AGENT); }
__device__ __forceinline__ unsigned xb_xcc_id() { return (unsigned)__builtin_amdgcn_s_getreg((3 << 11) | 20) & 0xFu; }
#define XB_SPIN(cond, bar) do { unsigned _sp = 0; while (cond) { __builtin_amdgcn_s_sleep(1); \
    if ((++_sp & 255u) == 0u) { if (xb_ld(&(bar)[XB_TMO])) break; if (_sp > XB_SPIN_CAP) { atomicAdd(&(bar)[XB_TMO], 1u); break; } } } } while (0)
struct XcdBarrier { unsigned* bar; unsigned x; volatile LAS unsigned* st; };
__device__ __forceinline__ XcdBarrier xcd_barrier_post(unsigned* bar, volatile LAS unsigned* st, bool leader) {
    XcdBarrier b; b.bar = bar; b.x = xb_xcc_id(); b.st = st;
    if (leader) (void)xb_add(&bar[XB_XCNT(b.x)], 1u);
    return b;
}
__device__ __forceinline__ void xcd_barrier_complete(unsigned* bar, unsigned x, unsigned& nloc, unsigned& nx) {
    const unsigned G = gridDim.x * gridDim.y * gridDim.z;
    unsigned sum, cnt, mine, sp = 0u;
    for (;;) {
        sum = 0u; cnt = 0u; mine = 0u;
#pragma unroll
        for (unsigned j = 0; j < 16; ++j) { const unsigned c = xb_ld(&bar[XB_XCNT(j)]); sum += c; cnt += (c > 0u) ? 1u : 0u; mine = (j == x) ? c : mine; }
        if (sum == G) break;
        __builtin_amdgcn_s_sleep(1);
        if ((++sp & 255u) == 0u) { if (xb_ld(&bar[XB_TMO])) break; if (sp > XB_SPIN_CAP) { atomicAdd(&bar[XB_TMO], 1u); break; } }
    }
    nloc = mine > 0u ? mine : 1u; nx = cnt > 0u ? cnt : 1u;
}
__device__ __forceinline__ void xcd_barrier(const XcdBarrier& b, bool leader) {
    asm volatile("s_waitcnt vmcnt(0)" ::: "memory");
    __syncthreads();
    if (leader) {
        unsigned* bar = b.bar;
        __builtin_amdgcn_s_waitcnt(0);
        unsigned nloc = b.st[0], nx = b.st[1];
        if (nloc == 0u) { xcd_barrier_complete(bar, b.x, nloc, nx); b.st[0] = nloc; b.st[1] = nx; }
        const unsigned old = xb_add(&bar[XB_XSUB(b.x)], 1u);
        const unsigned gen = old / nloc;
        if (old + 1u == (gen + 1u) * nloc) {
            __builtin_amdgcn_fence(__ATOMIC_RELEASE, "agent");
            asm volatile("s_waitcnt vmcnt(0)" ::: "memory");
            const unsigned og = xb_add(&bar[XB_TOP], 1u);
            const unsigned tg = og / nx;
            if (og + 1u == (tg + 1u) * nx) xb_add(&bar[XB_TOPGEN], 1u);
            else XB_SPIN(xb_ld(&bar[XB_TOPGEN]) == tg, bar);
            __builtin_amdgcn_fence(__ATOMIC_ACQUIRE, "agent");
            xb_add(&bar[XB_XGEN(b.x)], 1u);
            asm volatile("s_waitcnt vmcnt(0)" ::: "memory");
        } else {
            XB_SPIN(xb_ld(&bar[XB_XGEN(b.x)]) == gen, bar);
            __builtin_amdgcn_fence(__ATOMIC_ACQUIRE, "agent");
            asm volatile("s_waitcnt vmcnt(0)" ::: "memory");
        }
    }
    __syncthreads();
}

struct Ctx { LAS unsigned char* lds; int tid, lane, wave, bid, nb, vcu; };
struct Args { const float* in[40]; float* out; unsigned char* ws; int ph_lo, ph_hi; };
enum { I_X = 0, I_C, I_CTX, I_CCTX, I_ADAW, I_ADAB, I_N1G, I_N2G, I_EVWIN, I_EVWOUT, I_QNORM, I_WUQ, I_KVNORM, I_WUKV, I_QG, I_KG, I_DWW, I_DWB, I_LNG, I_LNB,
       I_ODWIN, I_ODWOUT, I_SHIFTW, I_W0, I_W2L, I_A0, I_A2, I_G2, I_KKW, I_KA, I_RK, I_GNG, I_GNB, I_NAQG, I_NAKG, I_RPB, I_ROUTER, I_MW1, I_MW3, I_MW2 };

DI void transpose_item(const float* __restrict__ W, int K, int N, bf16* __restrict__ WT, int dst_row0, const float* __restrict__ gain, LAS float* scr, int k0, int n0, int lane) {
#pragma unroll 8
    for (int i = 0; i < 32; ++i) { const int kk = 2 * i + (lane >> 5); float v = W[(size_t)(k0 + kk) * N + n0 + (lane & 31)]; if (gain) v *= gain[k0 + kk]; scr[kk * 33 + (lane & 31)] = v; }
    asm volatile("s_waitcnt lgkmcnt(0)" ::: "memory");
    const int c = lane & 7;
#pragma unroll
    for (int j = 0; j < 4; ++j) { const int n = (lane >> 3) + 8 * j; const LAS float* s = scr + (8 * c) * 33 + n;
        u32x4 o; o.x = pk2(s[0 * 33], s[1 * 33]); o.y = pk2(s[2 * 33], s[3 * 33]); o.z = pk2(s[4 * 33], s[5 * 33]); o.w = pk2(s[6 * 33], s[7 * 33]);
        *(u32x4*)(WT + (size_t)(dst_row0 + n) * K + k0 + 8 * c) = o; }
    asm volatile("s_waitcnt lgkmcnt(0)" ::: "memory");
}
DI void transpose_item64(const float* __restrict__ W, int K, int N, bf16* __restrict__ WT, int dst_row0, LAS float* scr, int k0, int n0, int lane) {
    f32x4 v[16];
#pragma unroll
    for (int i = 0; i < 16; ++i) v[i] = *(const f32x4*)(W + (size_t)(k0 + 4 * i + (lane >> 4)) * N + n0 + 4 * (lane & 15));
#pragma unroll
    for (int i = 0; i < 16; ++i) { LAS float* d = scr + (4 * i + (lane >> 4)) * 65 + 4 * (lane & 15); d[0] = v[i].x; d[1] = v[i].y; d[2] = v[i].z; d[3] = v[i].w; }
    asm volatile("s_waitcnt lgkmcnt(0)" ::: "memory");
    const int c = lane & 7;
#pragma unroll
    for (int j = 0; j < 8; ++j) { const int n = (lane >> 3) + 8 * j; const LAS float* s = scr + (8 * c) * 65 + n;
        u32x4 o; o.x = pk2(s[0 * 65], s[1 * 65]); o.y = pk2(s[2 * 65], s[3 * 65]); o.z = pk2(s[4 * 65], s[5 * 65]); o.w = pk2(s[6 * 65], s[7 * 65]);
        *(u32x4*)(WT + (size_t)(dst_row0 + n) * K + k0 + 8 * c) = o; }
    asm volatile("s_waitcnt lgkmcnt(0)" ::: "memory");
}
DI void transpose_matrix(const Ctx& C, const float* W, int K, int N, bf16* WT, const float* gain, int mode  ) {
    LAS float* scr = (LAS float*)(C.lds + C.wave * 8704);
    const int nkb = K / 64, nnb = N / 32, nit = nkb * nnb, gw = C.vcu * 8 + C.wave, ngw = C.nb * 8;
    for (int it = gw; it < nit; it += ngw) {
        const int kb = it / nnb, nbk = it % nnb, n0 = nbk * 32;
        int d0 = n0; if (mode) d0 = (n0 >> 7) * 256 + (n0 & 127) + (mode == 2 ? 128 : 0);
        transpose_item(W, K, N, WT, d0, gain, scr, kb * 64, n0, C.lane);
    }
}
DI void moe_weight_prep(const Ctx& C, const float* w1, const float* w3, const float* w2, bf16* W13, bf16* W2) {
    LAS float* scr = (LAS float*)(C.lds + C.wave * 16640);
    const int gw = C.vcu * 8 + C.wave, ngw = C.nb * 8;
    constexpr int PER = 16 * 16;
    for (int it = gw; it < NEXP * 3 * PER; it += ngw) {
        const int e = it / (3 * PER), r = it % (3 * PER), which = r / PER, q = r % PER, kb = q / 16, n0 = (q % 16) * 64;
        if (which == 0)      transpose_item64(w1 + (size_t)e * DM * DM, DM, DM, W13 + (size_t)e * 2048 * DM, (n0 >> 7) * 256 + (n0 & 127), scr, kb * 64, n0, C.lane);
        else if (which == 1) transpose_item64(w3 + (size_t)e * DM * DM, DM, DM, W13 + (size_t)e * 2048 * DM, (n0 >> 7) * 256 + (n0 & 127) + 128, scr, kb * 64, n0, C.lane);
        else                 transpose_item64(w2 + (size_t)e * DM * DM, DM, DM, W2 + (size_t)e * DM * DM, n0, scr, kb * 64, n0, C.lane);
    }
}

DI void ph_prologue(const Ctx& C, const Args& a) {
    unsigned char* ws = a.ws;
    {
        LAS float* sv = (LAS float*)C.lds;
        LAS float* red = sv + 9 * 1024;
        for (int i = C.tid; i < 9 * 1024; i += 512) { const int m = i >> 10, k = i & 1023; const float c = (m < 8) ? a.in[I_C][m * 1024 + k] : a.in[I_CCTX][k]; sv[i] = siluf_(c); }
        __syncthreads();
        float* MOD = (float*)(ws + WS_MOD);
        for (int it = C.bid; it < 4 * 96; it += C.nb) {
            const int layer = it / 96, col = (it % 96) * 64 + C.lane;
            const float* wp = a.in[I_ADAW] + (size_t)layer * 1024 * 6144 + col;
            float acc[9];
#pragma unroll
            for (int m = 0; m < 9; ++m) acc[m] = 0.f;
            const int kb = C.wave * 128;
#pragma unroll 4
            for (int k = 0; k < 128; ++k) { const float w = wp[(size_t)(kb + k) * 6144];
#pragma unroll
                for (int m = 0; m < 9; ++m) acc[m] += sv[m * 1024 + kb + k] * w; }
#pragma unroll
            for (int m = 0; m < 9; ++m) red[(C.wave * 9 + m) * 64 + C.lane] = acc[m];
            __syncthreads();
            for (int i = C.tid; i < 576; i += 512) { const int m = i >> 6, l = i & 63; float s = 0.f;
#pragma unroll
                for (int w = 0; w < 8; ++w) s += red[(w * 9 + m) * 64 + l];
                const int cc = (it % 96) * 64 + l;
                MOD[(size_t)(layer * 9 + m) * 6144 + cc] = s + a.in[I_ADAB][layer * 6144 + cc]; }
            __syncthreads();
        }
    }
    {
        f32x2* CS = (f32x2*)(ws + WS_ROPE);
        for (int i = C.bid * 512 + C.tid; i < 4096 * 16; i += C.nb * 512) {
            const int pos = i >> 4, j = i & 15, f = j & 7;
            const float inv = powf(10000.f, -(float)(2 * f) / 16.f);
            const float ang = (float)((j < 8) ? (pos >> 6) : (pos & 63)) * inv;
            const double tw = 6.283185307179586476925;
            const double x = (double)ang, n = __builtin_rint(x / tw), rr = x - n * tw;
            CS[i] = (f32x2){__cosf((float)rr), __sinf((float)rr)};
        }
    }
    for (int j = 0; j < 2; ++j) {
        transpose_matrix(C, a.in[I_EVWIN] + (size_t)j * DM * EV_IN, DM, EV_IN, (bf16*)(ws + WS_WEVIN) + (size_t)j * EV_INP * DM, nullptr, 0);
        transpose_matrix(C, a.in[I_EVWOUT] + (size_t)j * DM * DM, DM, DM, (bf16*)(ws + WS_WEVOUT) + (size_t)j * DM * DM, nullptr, 0);
        transpose_matrix(C, a.in[I_WUQ] + (size_t)j * 384 * 768, 384, 768, (bf16*)(ws + WS_WUQ) + (size_t)j * 768 * 384, a.in[I_QNORM] + j * 384, 0);
        transpose_matrix(C, a.in[I_WUKV] + (size_t)j * 256 * 1024, 256, 1024, (bf16*)(ws + WS_WUKV) + (size_t)j * 1024 * 256, a.in[I_KVNORM] + j * 256, 0);
        transpose_matrix(C, a.in[I_ODWIN] + (size_t)j * DM * OD_IN, DM, OD_IN, (bf16*)(ws + WS_WODIN) + (size_t)j * OD_INP * DM, nullptr, 0);
        transpose_matrix(C, a.in[I_ODWOUT] + (size_t)j * DM * DM, DM, DM, (bf16*)(ws + WS_WODOUT) + (size_t)j * DM * DM, nullptr, 0);
    }
    {
        const int gt = C.bid * 512 + C.tid, ngt = C.nb * 512;
        for (int j = 0; j < 2; ++j) {
            u32x4* p0 = (u32x4*)((bf16*)(ws + WS_WEVIN) + (size_t)j * EV_INP * DM + (size_t)EV_IN * DM);
            for (int i = gt; i < (EV_INP - EV_IN) * DM / 8; i += ngt) p0[i] = (u32x4){0u, 0u, 0u, 0u};
            u32x4* p1 = (u32x4*)((bf16*)(ws + WS_WODIN) + (size_t)j * OD_INP * DM + (size_t)OD_IN * DM);
            for (int i = gt; i < (OD_INP - OD_IN) * DM / 8; i += ngt) p1[i] = (u32x4){0u, 0u, 0u, 0u};
            bf16* WL = (bf16*)(ws + WS_WLORA) + (size_t)j * 655360;
            const float* w2 = a.in[I_W2L] + (size_t)j * 2 * 64 * 512; const float* a2 = a.in[I_A2] + (size_t)j * 2 * 64 * 512; const float* g2 = a.in[I_G2] + (size_t)j * 128 * 512;
            for (int i = gt; i < 655360; i += ngt) {
                const int n = i >> 8, k = i & 255; float v = 0.f;
                if (n < 1024) { const int d = n >> 9, c = n & 511; if (k >= d * 64 && k < d * 64 + 64) v = w2[(size_t)k * 512 + c]; }
                else if (n < 2048) { const int d = (n - 1024) >> 9, c = n & 511; if (k >= 128 + d * 64 && k < 192 + d * 64) v = a2[(size_t)(k - 128) * 512 + c]; }
                else { const int c = n - 2048; if (k >= 128) v = g2[(size_t)(k - 128) * 512 + c]; }
                WL[i] = f2bf(v);
            }
        }
    }
}

template <bool ROUTER>
DI void ph_norm(const Ctx& C, const float* xlat, const float* xctx, const float* gain, const float* mod  , int shift_off, int scale_off, bf16* H,
                const float* router  , float* AFFT, float* AFFC, int* SLOT) {
    LAS float* RT = (LAS float*)C.lds;
    if (ROUTER) { for (int i = C.tid; i < 16384; i += 512) { const int c = i >> 4, e = i & 15; RT[e * 1024 + c] = router[i]; } __syncthreads(); }
    const int gw = C.bid * 8 + C.wave, ngw = C.nb * 8, lane = C.lane;
    for (int row = gw; row < MT; row += ngw) {
        const float* xr = row < NLAT ? xlat + (size_t)row * DM : xctx + (size_t)(row - NLAT) * DM;
        const int mi = row < NLAT ? (row >> 12) : 8;
        const float* mp = mod + mi * 6144;
        f32x4 v[4]; float ss = 0.f;
#pragma unroll
        for (int j = 0; j < 4; ++j) { v[j] = *(const f32x4*)(xr + 256 * j + 4 * lane); ss += v[j].x * v[j].x + v[j].y * v[j].y + v[j].z * v[j].z + v[j].w * v[j].w; }
        ss = wave_sum(ss);
        const float rs = 1.0f / sqrtf(ss * (1.f / 1024.f) + EPS);
#pragma unroll
        for (int j = 0; j < 4; ++j) {
            const int c = 256 * j + 4 * lane;
            const f32x4 g = *(const f32x4*)(gain + c), sc = *(const f32x4*)(mp + scale_off + c), sh = *(const f32x4*)(mp + shift_off + c);
            v[j] = (v[j] * rs) * g * (sc + 1.0f) + sh;
            *(u32x2*)(H + (size_t)row * DM + c) = (u32x2){pk2(v[j].x, v[j].y), pk2(v[j].z, v[j].w)};
        }
        if (ROUTER) {
            float mylg = 0.f;
#pragma unroll 1
            for (int e = 0; e < 16; ++e) { float p = 0.f;
#pragma unroll
                for (int j = 0; j < 4; ++j) { const f32x4 w = *(const LAS f32x4*)(RT + e * 1024 + 256 * j + 4 * lane); p += v[j].x * w.x + v[j].y * w.y + v[j].z * w.z + v[j].w * w.w; }
                p = wave_sum(p); mylg = (lane == e) ? p : mylg; }
            const float mx = max16(mylg);
            const float ex = expf(mylg - mx);
            const float mine = ex / sum16(ex);
            if (lane < 16) {
                if (row < NLAT) AFFT[(size_t)((row >> 12) * 16 + lane) * TL + (row & 4095)] = mine;
                else { const int rc = row - NLAT; AFFC[(size_t)((rc >> 8) * 16 + lane) * LCX + (rc & 255)] = mine; }
                SLOT[(size_t)row * 16 + lane] = -1;
            }
        }
    }
}

template <class Epi>
DI void gemm_unit(const bf16* __restrict__ A, int lda, const int* __restrict__ rows, const bf16* __restrict__ Bt, int K, int pm, int pn, const Epi& E, int wave, int lane) {
    const int wr = wave >> 2, wc = wave & 3, r = lane & 31, h = lane >> 5;
    const bf16* ap[2][2]; const bf16* bp[2];
#pragma unroll
    for (int ai = 0; ai < 2; ++ai)
#pragma unroll
        for (int mm = 0; mm < 2; ++mm) { const int lr = 256 * pm + 128 * ai + 64 * wr + 32 * mm + r; const int gr = rows ? rows[lr] : lr; ap[ai][mm] = A + (size_t)gr * lda + 8 * h; }
#pragma unroll
    for (int bj = 0; bj < 2; ++bj) bp[bj] = Bt + (size_t)(256 * pn + 128 * bj + 32 * wc + r) * K + 8 * h;
    f32x16 acc[2][2][2];
#pragma unroll
    for (int ai = 0; ai < 2; ++ai)
#pragma unroll
        for (int mm = 0; mm < 2; ++mm)
#pragma unroll
            for (int bj = 0; bj < 2; ++bj)
#pragma unroll
                for (int i = 0; i < 16; ++i) acc[ai][mm][bj][i] = 0.f;
#pragma unroll 2
    for (int k0 = 0; k0 < K; k0 += 16) {
        bf16x8 af[2][2], bfr[2];
#pragma unroll
        for (int ai = 0; ai < 2; ++ai)
#pragma unroll
            for (int mm = 0; mm < 2; ++mm) af[ai][mm] = *(const bf16x8*)(ap[ai][mm] + k0);
#pragma unroll
        for (int bj = 0; bj < 2; ++bj) bfr[bj] = *(const bf16x8*)(bp[bj] + k0);
#pragma unroll
        for (int ai = 0; ai < 2; ++ai)
#pragma unroll
            for (int mm = 0; mm < 2; ++mm)
#pragma unroll
                for (int bj = 0; bj < 2; ++bj) acc[ai][mm][bj] = MFMA32(bfr[bj], af[ai][mm], acc[ai][mm][bj]);
    }
#pragma unroll
    for (int ai = 0; ai < 2; ++ai)
#pragma unroll
        for (int mm = 0; mm < 2; ++mm) {
            const int row = 256 * pm + 128 * ai + 64 * wr + 32 * mm + r;
#pragma unroll
            for (int g = 0; g < 4; ++g) {
                const int col = 256 * pn + 32 * wc + 8 * g + 4 * h;
                const f32x4 v0 = {acc[ai][mm][0][4 * g], acc[ai][mm][0][4 * g + 1], acc[ai][mm][0][4 * g + 2], acc[ai][mm][0][4 * g + 3]};
                const f32x4 v1 = {acc[ai][mm][1][4 * g], acc[ai][mm][1][4 * g + 1], acc[ai][mm][1][4 * g + 2], acc[ai][mm][1][4 * g + 3]};
                E(row, col, v0, v1);
            }
        }
}
template <class Epi>
DI void gemm_phase(const Ctx& C, const bf16* A, int lda, const bf16* Bt, int K, int nM, int nN, const Epi& E) {
    for (int u = C.vcu; u < nM * nN; u += C.nb) gemm_unit(A, lda, nullptr, Bt, K, u / nN, u % nN, E, C.wave, C.lane);
}

struct EpiBf16 { bf16* O; int ldo;
    DI void operator()(int row, int col, f32x4 v0, f32x4 v1) const { bf16* p = O + (size_t)row * ldo + col;
        *(u32x2*)p = (u32x2){pk2(v0[0], v0[1]), pk2(v0[2], v0[3])}; *(u32x2*)(p + 128) = (u32x2){pk2(v1[0], v1[1]), pk2(v1[2], v1[3])}; } };
struct EpiF32 { float* O; int ldo;
    DI void operator()(int row, int col, f32x4 v0, f32x4 v1) const { float* p = O + (size_t)row * ldo + col; *(f32x4*)p = v0; *(f32x4*)(p + 128) = v1; } };
struct EpiResid { const float* xin_lat; const float* xin_ctx; float* xout_lat; float* xout_ctx; const float* modg;
    DI void operator()(int row, int col, f32x4 v0, f32x4 v1) const {
        const float* xi; float* xo; int mi;
        if (row < NLAT) { xi = xin_lat + (size_t)row * DM; xo = xout_lat + (size_t)row * DM; mi = row >> 12; }
        else { xi = xin_ctx + (size_t)(row - NLAT) * DM; xo = xout_ctx + (size_t)(row - NLAT) * DM; mi = 8; }
        const float* g = modg + mi * 6144 + col;
        const f32x4 g0 = *(const f32x4*)g, g1 = *(const f32x4*)(g + 128), x0 = *(const f32x4*)(xi + col), x1 = *(const f32x4*)(xi + col + 128);
        *(f32x4*)(xo + col) = x0 + g0 * v0; *(f32x4*)(xo + col + 128) = x1 + g1 * v1; } };
struct EpiGlu { bf16* O;
    DI void operator()(int row, int col, f32x4 v0, f32x4 v1) const { const int f = ((col & 2047) >> 8) * 128 + (col & 255);
        *(u32x2*)(O + (size_t)row * DM + f) = (u32x2){pk2(siluf_(v0[0]) * v1[0], siluf_(v0[1]) * v1[1]), pk2(siluf_(v0[2]) * v1[2], siluf_(v0[3]) * v1[3])}; } };
struct EpiGate { bf16* O; const float* gate;
    DI void operator()(int row, int col, f32x4 v0, f32x4 v1) const { const float g = gate[row]; bf16* p = O + (size_t)row * DM + (col & 1023);
        *(u32x2*)p = (u32x2){pk2(v0[0] * g, v0[1] * g), pk2(v0[2] * g, v0[3] * g)}; *(u32x2*)(p + 128) = (u32x2){pk2(v1[0] * g, v1[1] * g), pk2(v1[2] * g, v1[3] * g)}; } };
struct EpiLoraW { float* W; const float* w0;
    DI void one(int row, int col, f32x4 v) const { const int d = col >> 9, c = col & 511; f32x4 o;
#pragma unroll
        for (int e = 0; e < 4; ++e) { const float lw = w0[col + e] + v[e]; const float z = -lw; const float sp = fmaxf(z, 0.f) + __logf(1.f + __expf(-fabsf(z))); o[e] = __expf(-__expf(-sp - 0.5f)); }
        *(f32x4*)(W + ((size_t)d * MT + row) * 512 + c) = o; }
    DI void operator()(int row, int col, f32x4 v0, f32x4 v1) const { one(row, col, v0); one(row, col + 128, v1); } };
struct EpiLoraA { bf16* Aout; const float* a0;
    DI void one(int row, int col, f32x4 v) const { const int d = col >> 9, c = col & 511; const f32x4 b = *(const f32x4*)(a0 + col);
        *(u32x2*)(Aout + ((size_t)d * MT + row) * 512 + c) = (u32x2){pk2(sigmoidf_(b[0] + v[0]), sigmoidf_(b[1] + v[1])), pk2(sigmoidf_(b[2] + v[2]), sigmoidf_(b[3] + v[3]))}; }
    DI void operator()(int row, int col, f32x4 v0, f32x4 v1) const { one(row, col, v0); one(row, col + 128, v1); } };

namespace pg8 {
constexpr int BM = 256, BK = 64, HALF = 128, HTB = HALF * BK * 2, STAGE_BYTES = 8 * HTB;
DI int lds_byte(int r, int c) { const int st = (r >> 4) * 2 + (c >> 5), rr = r & 15, cc = c & 31, ob = rr * 64 + cc * 2; return st * 1024 + (ob ^ (((ob >> 9) & 1) << 5)); }
DI void stage_rc(int b, int& R, int& C) { const int st = b / 1024, sb = b % 1024, swz = sb ^ (((sb >> 9) & 1) << 5); R = (st >> 1) * 16 + swz / 64; C = (st & 1) * 32 + (swz % 64) / 2; }
DI int perm32(int rho) { const int n = rho >> 4, i = rho & 15; return 8 * (i >> 2) + 4 * n + (i & 3); }
struct Unit { int pm, pn; };
struct Gemm { const bf16* A; const bf16* Bt; int lda, K; const int* rows; };
struct OrderMN { int nM, nN, G, c;
    DI bool next(int i, Unit& u) const { const int L = i * G + c; if (L >= nM * nN) return false; u.pm = L / nN; u.pn = L % nN; return true; } };
struct OrderMoE { int nMt, nN, mstride  , G, c;
    DI bool next(int i, Unit& u) const { const int L = i * G + c, per = nMt * nN; if (L >= NEXP * per) return false; const int e = L / per, q = L % per; u.pm = e * mstride + q / nN; u.pn = e * nN + q % nN; return true; } };
template <class E4> struct EpiAdapt { E4 e;
    DI void operator()(const f32x4 (&acc)[2][2][4][2], const Unit& u, int wr, int wc, int fr, int fq) const {
#pragma unroll
        for (int ai = 0; ai < 2; ++ai)
#pragma unroll
            for (int m = 0; m < 4; ++m) { const int row = u.pm * BM + ai * HALF + wr * 64 + m * 16 + fr;
#pragma unroll
                for (int n = 0; n < 2; ++n) e(row, u.pn * BM + wc * 32 + 8 * fq + 4 * n, acc[ai][0][m][n], acc[ai][1][m][n]); } } };

template <class Epi, class Sched>
DI void gemm_phase(LAS unsigned char* lds, const Gemm g, const Sched& S, const Epi& E, const int tid) {
    const int wid = __builtin_amdgcn_readfirstlane(tid >> 6), lane = tid & 63, wr = wid >> 2, wc = wid & 3, fr = lane & 15, fq = lane >> 4;
    const int K = g.K, nt = K / BK;
    int RA[2], CA[2]; unsigned voffB[2];
#pragma unroll
    for (int i = 0; i < 2; ++i) { int R, C; stage_rc(tid * 16 + i * 8192, R, C); RA[i] = R; CA[i] = C; const int Rb = (R & ~31) + perm32(R & 31); voffB[i] = (unsigned)(Rb * K + C) * 2u; }
    const size_t kstep = (size_t)(BK * 2), hstep = (size_t)HALF * K * 2, tstep = 2 * hstep;
    const unsigned ldsw = (unsigned)wid * 1024u;
    const int aoff = lds_byte(wr * 64 + fr, fq * 8), boff = lds_byte(wc * 32 + fr, fq * 8);
    const char* const gA = (const char*)g.A;
#define PG8_SA(b, h) (((b) * 2 + (h)) * HTB)
#define PG8_SB(b, h) ((4 + (b) * 2 + (h)) * HTB)
#define PG8_STAGE(bufoff, gbase, voff) do { _Pragma("unroll") for (int _i = 0; _i < 2; ++_i) \
        __builtin_amdgcn_global_load_lds((const unsigned*)((const char*)(gbase) + (voff)[_i]), (LAS unsigned*)(lds + (bufoff) + ldsw + _i * 8192), 16, 0, 0); } while (0)
#define PG8_LDA(dst, b, h) do { _Pragma("unroll") for (int m = 0; m < 4; ++m) _Pragma("unroll") for (int k = 0; k < 2; ++k) dst[m][k] = *(const LAS bf16x8*)(lds + PG8_SA(b, h) + aoff + m * 2048 + k * 1024); } while (0)
#define PG8_LDB(dst, b, h) do { _Pragma("unroll") for (int n = 0; n < 2; ++n) _Pragma("unroll") for (int k = 0; k < 2; ++k) dst[n][k] = *(const LAS bf16x8*)(lds + PG8_SB(b, h) + boff + n * 2048 + k * 1024); } while (0)
#define PG8_MMA(ai, bj, At, Bt) do { __builtin_amdgcn_s_setprio(1); _Pragma("unroll") for (int m = 0; m < 4; ++m) _Pragma("unroll") for (int n = 0; n < 2; ++n) _Pragma("unroll") for (int k = 0; k < 2; ++k) \
        acc[ai][bj][m][n] = __builtin_amdgcn_mfma_f32_16x16x32_bf16(Bt[n][k], At[m][k], acc[ai][bj][m][n], 0, 0, 0); __builtin_amdgcn_s_setprio(0); } while (0)
#define PG8_WAIT_V(n) asm volatile("s_waitcnt vmcnt(" #n ")" ::: "memory")
#define PG8_WAIT_L(n) asm volatile("s_waitcnt lgkmcnt(" #n ")" ::: "memory")
#define PG8_BAR __builtin_amdgcn_s_barrier()
#define PG8_SCHED __builtin_amdgcn_sched_barrier(0)
#define PG8_AOFF(vo, u) do { _Pragma("unroll") for (int _h = 0; _h < 2; ++_h) _Pragma("unroll") for (int _i = 0; _i < 2; ++_i) { const int _lr = (u).pm * BM + _h * HALF + RA[_i]; \
        const int _gr = g.rows ? g.rows[_lr] : _lr; vo[_h][_i] = (unsigned)(((size_t)_gr * g.lda + CA[_i]) * 2u); } } while (0)
    Unit cur, nxt; int ui = 0;
    if (!S.next(0, cur)) return;
    f32x4 acc[2][2][4][2];
#pragma unroll
    for (int a = 0; a < 2; ++a)
#pragma unroll
        for (int b = 0; b < 2; ++b)
#pragma unroll
            for (int m = 0; m < 4; ++m)
#pragma unroll
                for (int n = 0; n < 2; ++n) acc[a][b][m][n] = (f32x4){0.f, 0.f, 0.f, 0.f};
    bf16x8 At[4][2], B0[2][2], B1[2][2];
    unsigned cvo[2][2], nvo[2][2];
    PG8_AOFF(cvo, cur);
    const char* cB = (const char*)g.Bt + (size_t)cur.pn * tstep;
    PG8_STAGE(PG8_SB(0, 0), cB, voffB); PG8_STAGE(PG8_SB(0, 1), cB + hstep, voffB); PG8_STAGE(PG8_SA(0, 0), gA, cvo[0]); PG8_STAGE(PG8_SA(0, 1), gA, cvo[1]);
    if (wr == 1) PG8_BAR;
    PG8_WAIT_V(2); PG8_BAR;
    PG8_STAGE(PG8_SB(1, 0), cB + kstep, voffB); PG8_STAGE(PG8_SA(1, 0), gA + kstep, cvo[0]); PG8_STAGE(PG8_SB(1, 1), cB + hstep + kstep, voffB);
    PG8_WAIT_V(6); PG8_BAR;
    for (;;) {
        const bool has_next = S.next(ui + 1, nxt);
        if (has_next) { PG8_AOFF(nvo, nxt); } else {
#pragma unroll
            for (int _h = 0; _h < 2; ++_h)
#pragma unroll
                for (int _i = 0; _i < 2; ++_i) nvo[_h][_i] = cvo[_h][_i]; }
        const char* nB = has_next ? (const char*)g.Bt + (size_t)nxt.pn * tstep : cB;
        for (int t = 0; t < nt; t += 2) {
            const bool last = (t == nt - 2);
            const char* a1 = gA + (size_t)(t + 1) * kstep;
            const char* a2 = last ? gA : gA + (size_t)(t + 2) * kstep; const char* b2 = last ? nB : cB + (size_t)(t + 2) * kstep;
            const char* a3 = a2 + kstep; const char* b3 = b2 + kstep;
            unsigned v20[2], v21[2];
#pragma unroll
            for (int _i = 0; _i < 2; ++_i) { v20[_i] = last ? nvo[0][_i] : cvo[0][_i]; v21[_i] = last ? nvo[1][_i] : cvo[1][_i]; }
            PG8_LDB(B0, 0, 0); PG8_LDB(B1, 0, 1); PG8_SCHED; PG8_LDA(At, 0, 0); PG8_STAGE(PG8_SA(1, 1), a1, cvo[1]);
            PG8_WAIT_V(8); PG8_WAIT_L(0); PG8_BAR; PG8_MMA(0, 0, At, B0); PG8_MMA(0, 1, At, B1); PG8_BAR; PG8_SCHED;
            PG8_LDA(At, 0, 1); PG8_STAGE(PG8_SB(0, 0), b2, voffB); PG8_STAGE(PG8_SB(0, 1), b2 + hstep, voffB); PG8_STAGE(PG8_SA(0, 0), a2, v20);
            PG8_WAIT_V(8); PG8_WAIT_L(0); PG8_BAR; PG8_MMA(1, 0, At, B0); PG8_MMA(1, 1, At, B1); PG8_BAR; PG8_SCHED;
            PG8_LDB(B0, 1, 0); PG8_LDB(B1, 1, 1); PG8_SCHED; PG8_LDA(At, 1, 0); PG8_STAGE(PG8_SA(0, 1), a2, v21);
            PG8_WAIT_V(8); PG8_WAIT_L(0); PG8_BAR; PG8_MMA(0, 0, At, B0); PG8_MMA(0, 1, At, B1); PG8_BAR; PG8_SCHED;
            PG8_LDA(At, 1, 1); PG8_STAGE(PG8_SB(1, 0), b3, voffB); PG8_STAGE(PG8_SB(1, 1), b3 + hstep, voffB); PG8_STAGE(PG8_SA(1, 0), a3, v20);
            PG8_WAIT_V(8); PG8_WAIT_L(0); PG8_BAR; PG8_MMA(1, 0, At, B0); PG8_MMA(1, 1, At, B1); PG8_BAR; PG8_SCHED;
        }
        if (wr == 0) PG8_BAR;
        E(acc, cur, wr, wc, fr, fq);
        if (!has_next) break;
#pragma unroll
        for (int a = 0; a < 2; ++a)
#pragma unroll
            for (int b = 0; b < 2; ++b)
#pragma unroll
                for (int m = 0; m < 4; ++m)
#pragma unroll
                    for (int n = 0; n < 2; ++n) acc[a][b][m][n] = (f32x4){0.f, 0.f, 0.f, 0.f};
        cur = nxt; cB = nB; ++ui;
#pragma unroll
        for (int _h = 0; _h < 2; ++_h)
#pragma unroll
            for (int _i = 0; _i < 2; ++_i) cvo[_h][_i] = nvo[_h][_i];
        if (wr == 1) PG8_BAR;
    }
    PG8_WAIT_V(0);
    PG8_BAR;
#undef PG8_SA
#undef PG8_SB
#undef PG8_STAGE
#undef PG8_LDA
#undef PG8_LDB
#undef PG8_MMA
#undef PG8_WAIT_V
#undef PG8_WAIT_L
#undef PG8_BAR
#undef PG8_SCHED
#undef PG8_AOFF
}
}
template <class E4> DI void fast_gemm(const Ctx& C, const bf16* A, int lda, const bf16* Bt, int K, int nM, int nN, const E4& e) {
    pg8::Gemm g{A, Bt, lda, K, nullptr}; pg8::OrderMN S{nM, nN, C.nb, C.vcu}; pg8::EpiAdapt<E4> E{e};
    pg8::gemm_phase(C.lds, g, S, E, C.tid);
}

DI int swap23(int x) { return (x & ~12) | ((x & 4) << 1) | ((x & 8) >> 1); }
template <int DQK, bool NAT>
DI void flash_range(f32x16 (&o)[2], float& m, float& l, const bf16x8 (&qf)[DQK / 16], const bf16* __restrict__ Kb, const bf16* __restrict__ Vt, int pos0, int nblk, int r, int h,
                    const LAS float* tab, int qc, int cs, int drow0) {
    const int kr = swap23(r);
    for (int blk = 0; blk < nblk; ++blk) {
        const int pos = pos0 + 32 * blk;
        f32x16 s;
#pragma unroll
        for (int i = 0; i < 16; ++i) s[i] = 0.f;
        const bf16* kp = Kb + (size_t)(pos + kr) * DQK + 8 * h;
#pragma unroll
        for (int kk = 0; kk < DQK / 16; ++kk) s = MFMA32(*(const bf16x8*)(kp + 16 * kk), qf[kk], s);
        if (NAT) {
            const int irow = blk >> 1, cc0 = (blk & 1) * 32;
            const LAS float* trow = tab + (drow0 + irow) * 31;
#pragma unroll
            for (int i = 0; i < 16; ++i) {
                const int kib = (i & 3) | (((i >> 2) & 1) << 2) | (h << 3) | ((i >> 3) << 4);
                const int cc = cc0 + kib; const bool ok = (cc >= cs) && (cc < cs + 16);
                int dc = cc - qc + 15; dc = dc < 0 ? 0 : (dc > 30 ? 30 : dc);
                s[i] = ok ? s[i] + trow[dc] : -1e30f;
            }
        }
        float mx = s[0];
#pragma unroll
        for (int i = 1; i < 16; ++i) mx = fmaxf(mx, s[i]);
        mx = fmaxf(mx, xor32(mx, r + 32 * h));
        const float mn = fmaxf(m, mx), alpha = __builtin_amdgcn_exp2f(m - mn);
        float rs = 0.f; f32x16 p;
#pragma unroll
        for (int i = 0; i < 16; ++i) { float e = __builtin_amdgcn_exp2f(s[i] - mn); if (NAT) e = (s[i] > -1e29f) ? e : 0.f; p[i] = e; rs += e; }
        rs += xor32(rs, r + 32 * h);
        l = l * alpha + rs; m = mn;
#pragma unroll
        for (int i = 0; i < 16; ++i) { o[0][i] *= alpha; o[1][i] *= alpha; }
#pragma unroll
        for (int s2 = 0; s2 < 2; ++s2) {
            u32x4 pw; pw.x = pk2(p[8 * s2], p[8 * s2 + 1]); pw.y = pk2(p[8 * s2 + 2], p[8 * s2 + 3]); pw.z = pk2(p[8 * s2 + 4], p[8 * s2 + 5]); pw.w = pk2(p[8 * s2 + 6], p[8 * s2 + 7]);
            const bf16x8 pb = __builtin_bit_cast(bf16x8, pw);
#pragma unroll
            for (int dt = 0; dt < 2; ++dt) { const bf16x8 va = *(const bf16x8*)(Vt + (size_t)(32 * dt + r) * KPOS + pos + 16 * s2 + 8 * h); o[dt] = MFMA32(va, pb, o[dt]); }
        }
    }
}
DI void flash_store(const f32x16 (&o)[2], float l, bf16* orow  , int h) {
    const float inv = 1.f / l;
#pragma unroll
    for (int dt = 0; dt < 2; ++dt)
#pragma unroll
        for (int g = 0; g < 4; ++g)
            *(u32x2*)(orow + 32 * dt + 8 * g + 4 * h) = (u32x2){pk2(o[dt][4 * g] * inv, o[dt][4 * g + 1] * inv), pk2(o[dt][4 * g + 2] * inv, o[dt][4 * g + 3] * inv)};
}

DI void ph_attn_mla(const Ctx& C, const bf16* QB, const bf16* KB, const bf16* VT, bf16* OCAT, bool last) {
    const int r = C.lane & 31, h = C.lane >> 5;
    for (int u = C.vcu; u < 64 * 17; u += C.nb) {
        const int bh = u / 17, qblk = u % 17, b = bh >> 3, hh = bh & 7;
        if (last && qblk == 16) continue;
        const int qpos = qblk * 256 + 32 * C.wave + r;
        const bf16* qp = QB + ((size_t)bh * KPOS + qpos) * 96 + 8 * h;
        bf16x8 qf[6];
#pragma unroll
        for (int kk = 0; kk < 6; ++kk) qf[kk] = *(const bf16x8*)(qp + 16 * kk);
        f32x16 o[2];
#pragma unroll
        for (int i = 0; i < 16; ++i) { o[0][i] = 0.f; o[1][i] = 0.f; }
        float m = -1e30f, l = 0.f;
        flash_range<96, false>(o, m, l, qf, KB + (size_t)bh * KPOS * 96, VT + (size_t)bh * 64 * KPOS, qblk < 16 ? 0 : TL, qblk < 16 ? KPOS / 32 : LCX / 32, r, h, nullptr, 0, 0, 0);
        const int row = qblk < 16 ? b * TL + qpos : NLAT + b * LCX + (qpos - TL);
        flash_store(o, l, OCAT + (size_t)row * DM + hh * 64, h);
    }
}

template <int DQK> struct AttnGeo { static constexpr int KSTR = DQK * 2 + 16, KBYTES = 64 * KSTR, VSTR = 144, VBYTES = 64 * VSTR, BUF = KBYTES + VBYTES, KPIECES = 64 * DQK / 8; };
template <int DQK>
DI void attn_tile_loop(const Ctx& C, f32x16 (&o)[2], float& l, const bf16x8 (&qf)[DQK / 16], const bf16* __restrict__ Kb, const bf16* __restrict__ Vt, int pos_base, int ntiles) {
    typedef AttnGeo<DQK> G;
    const int tid = C.tid, r = C.lane & 31, h = C.lane >> 5, kr = swap23(r);
    constexpr bool K2 = G::KPIECES > 512;
    const int kq0 = tid, kq1 = tid + 512;
    const int kl0 = (kq0 / (DQK / 8)) * G::KSTR + (kq0 % (DQK / 8)) * 16, kl1 = (kq1 / (DQK / 8)) * G::KSTR + (kq1 % (DQK / 8)) * 16;
    const int vl = G::KBYTES + (tid >> 3) * G::VSTR + (tid & 7) * 16;
    const bf16* vg = Vt + (size_t)(tid >> 3) * KPOS + 8 * (tid & 7);
    u32x4 rk0, rk1, rv;
    rk1 = (u32x4){0u, 0u, 0u, 0u};
    { const int pos0 = pos_base; rk0 = *(const u32x4*)(Kb + (size_t)pos0 * DQK + 8 * kq0); if (K2 && tid < 256) rk1 = *(const u32x4*)(Kb + (size_t)pos0 * DQK + 8 * kq1); rv = *(const u32x4*)(vg + pos0); }
    __syncthreads();
    *(LAS u32x4*)(C.lds + kl0) = rk0; if (K2 && tid < 256) *(LAS u32x4*)(C.lds + kl1) = rk1; *(LAS u32x4*)(C.lds + vl) = rv;
    __syncthreads();
    float mref = 0.f;
    constexpr float THR = 8.f;
    for (int t = 0; t < ntiles; ++t) {
        const LAS unsigned char* B = C.lds + (t & 1) * G::BUF;
        if (t + 1 < ntiles) { const int pos0 = pos_base + 64 * (t + 1);
            rk0 = *(const u32x4*)(Kb + (size_t)pos0 * DQK + 8 * kq0); if (K2 && tid < 256) rk1 = *(const u32x4*)(Kb + (size_t)pos0 * DQK + 8 * kq1); rv = *(const u32x4*)(vg + pos0); }
        f32x16 sc[2];
#pragma unroll
        for (int j = 0; j < 2; ++j) {
#pragma unroll
            for (int i = 0; i < 16; ++i) sc[j][i] = -mref;
            const LAS unsigned char* kp = B + (32 * j + kr) * G::KSTR + 16 * h;
#pragma unroll
            for (int kk = 0; kk < DQK / 16; ++kk) sc[j] = MFMA32(*(const LAS bf16x8*)(kp + 32 * kk), qf[kk], sc[j]);
        }
        float mx = fmaxf(sc[0][0], sc[1][0]);
#pragma unroll
        for (int i = 1; i < 16; ++i) mx = fmaxf(mx, fmaxf(sc[0][i], sc[1][i]));
        mx = fmaxf(mx, xor32(mx, C.lane));
        if (t == 0 || __builtin_amdgcn_ballot_w64(mx > THR) != 0ull) {
            const float delta = (t == 0) ? mx : fmaxf(mx, 0.f);
#pragma unroll
            for (int i = 0; i < 16; ++i) { sc[0][i] -= delta; sc[1][i] -= delta; }
            if (t > 0) { const float alpha = __builtin_amdgcn_exp2f(-delta); l *= alpha;
#pragma unroll
                for (int i = 0; i < 16; ++i) { o[0][i] *= alpha; o[1][i] *= alpha; } }
            mref += delta;
        }
        f32x2 rs2 = {0.f, 0.f};
#pragma unroll
        for (int j = 0; j < 2; ++j)
#pragma unroll
            for (int i = 0; i < 16; i += 2) { sc[j][i] = __builtin_amdgcn_exp2f(sc[j][i]); sc[j][i + 1] = __builtin_amdgcn_exp2f(sc[j][i + 1]); rs2 += (f32x2){sc[j][i], sc[j][i + 1]}; }
        float rs = rs2.x + rs2.y;
        rs += xor32(rs, C.lane);
        l += rs;
#pragma unroll
        for (int j = 0; j < 2; ++j)
#pragma unroll
            for (int s2 = 0; s2 < 2; ++s2) {
                u32x4 pw; pw.x = pk2(sc[j][8 * s2], sc[j][8 * s2 + 1]); pw.y = pk2(sc[j][8 * s2 + 2], sc[j][8 * s2 + 3]); pw.z = pk2(sc[j][8 * s2 + 4], sc[j][8 * s2 + 5]); pw.w = pk2(sc[j][8 * s2 + 6], sc[j][8 * s2 + 7]);
                const bf16x8 pb = __builtin_bit_cast(bf16x8, pw);
#pragma unroll
                for (int dt = 0; dt < 2; ++dt) o[dt] = MFMA32(*(const LAS bf16x8*)(B + G::KBYTES + (32 * dt + r) * G::VSTR + (32 * j + 16 * s2 + 8 * h) * 2), pb, o[dt]);
            }
        if (t + 1 < ntiles) { LAS unsigned char* Bn = C.lds + ((t + 1) & 1) * G::BUF;
            *(LAS u32x4*)(Bn + kl0) = rk0; if (K2 && tid < 256) *(LAS u32x4*)(Bn + kl1) = rk1; *(LAS u32x4*)(Bn + vl) = rv; }
        __syncthreads();
    }
}
DI void ph_attn_mla2(const Ctx& C, const bf16* QB, const bf16* KB, const bf16* VT, bf16* OCAT, bool last) {
    const int r = C.lane & 31, h = C.lane >> 5;
    const int nunits = 1024 + (last ? 0 : 64);
    for (int u = C.vcu; u < nunits; u += C.nb) {
        const int bh = u < 1024 ? (u >> 4) : u - 1024, qblk = u < 1024 ? (u & 15) : 16, b = bh >> 3, hh = bh & 7;
        const int qpos = qblk * 256 + 32 * C.wave + r;
        const bf16* qp = QB + ((size_t)bh * KPOS + qpos) * 96 + 8 * h;
        bf16x8 qf[6];
#pragma unroll
        for (int kk = 0; kk < 6; ++kk) qf[kk] = *(const bf16x8*)(qp + 16 * kk);
        f32x16 o[2];
#pragma unroll
        for (int i = 0; i < 16; ++i) { o[0][i] = 0.f; o[1][i] = 0.f; }
        float l = 0.f;
        attn_tile_loop<96>(C, o, l, qf, KB + (size_t)bh * KPOS * 96, VT + (size_t)bh * 64 * KPOS, qblk < 16 ? 0 : TL, qblk < 16 ? KPOS / 64 : LCX / 64);
        const int row = qblk < 16 ? b * TL + qpos : NLAT + b * LCX + (qpos - TL);
        flash_store(o, l, OCAT + (size_t)row * DM + hh * 64, h);
    }
}

DI void ph_natten(const Ctx& C, const bf16* QN, const bf16* KN, const bf16* VTN, bf16* OCAT, const float* rpb  , bool last) {
    const int r = C.lane & 31, h = C.lane >> 5;
    LAS float* tab = (LAS float*)C.lds;
    const int nunits = 1024 + (last ? 0 : 64);
    for (int u = C.vcu; u < nunits; u += C.nb) {
        const bool isctx = u >= 1024;
        const int bh = isctx ? u - 1024 : (u >> 4), b = bh >> 3, hh = bh & 7;
        __syncthreads();
        for (int i = C.tid; i < 465; i += 512) tab[i] = rpb[hh * 465 + i] * LOG2E;
        __syncthreads();
        int qpos, row, grow = 0, qc = 0, rs = 0, cs = 0;
        if (!isctx) { const int rg = u & 15; grow = 4 * rg + (C.wave >> 1); qc = 32 * (C.wave & 1) + r; qpos = grow * 64 + qc; row = b * TL + qpos;
            rs = grow - 4; rs = rs < 0 ? 0 : (rs > 56 ? 56 : rs); cs = qc - 8; cs = cs < 0 ? 0 : (cs > 48 ? 48 : cs); }
        else { qpos = TL + 32 * C.wave + r; row = NLAT + b * LCX + 32 * C.wave + r; }
        const bf16* qp = QN + ((size_t)bh * KPOS + qpos) * 64 + 8 * h;
        bf16x8 qf[4];
#pragma unroll
        for (int kk = 0; kk < 4; ++kk) qf[kk] = *(const bf16x8*)(qp + 16 * kk);
        f32x16 o[2];
#pragma unroll
        for (int i = 0; i < 16; ++i) { o[0][i] = 0.f; o[1][i] = 0.f; }
        float m = -1e30f, l = 0.f;
        const bf16* Kb = KN + (size_t)bh * KPOS * 64; const bf16* Vt = VTN + (size_t)bh * 64 * KPOS;
        if (!isctx) flash_range<64, true>(o, m, l, qf, Kb, Vt, rs * 64, 16, r, h, tab, qc, cs, rs - grow + 7);
        flash_range<64, false>(o, m, l, qf, Kb, Vt, TL, LCX / 32, r, h, nullptr, 0, 0, 0);
        flash_store(o, l, OCAT + (size_t)row * DM + 512 + hh * 64, h);
    }
}

DI void ph_mla_fin(const Ctx& C, const bf16* U, const float* QPRE, const float* KVPRE, const float* qg, const float* kg, const f32x2* CS, bf16* QB, bf16* KB, bf16* VT) {
    LAS bf16* VL = (LAS bf16*)C.lds;
    const int lane = C.lane, j = lane >> 3, sub = lane & 7;
    const float C2 = 0.10206207261596575f * LOG2E;
    float qgn[8], qgr[4], kgn[8], kgr[4];
#pragma unroll
    for (int e = 0; e < 8; ++e) { qgn[e] = qg[8 * sub + e] * C2; kgn[e] = kg[8 * sub + e]; }
#pragma unroll
    for (int m = 0; m < 4; ++m) { qgr[m] = qg[64 + sub + 8 * m] * C2; kgr[m] = kg[64 + sub + 8 * m]; }
    for (int u = C.vcu; u < MT / 64; u += C.nb) {
        const int row0 = 64 * u, b = row0 < NLAT ? (row0 >> 12) : ((row0 - NLAT) >> 8), pos0 = row0 < NLAT ? (row0 & 4095) : TL + ((row0 - NLAT) & 255);
        const bool lat = row0 < NLAT;
        const int pl = 8 * C.wave + j, row = row0 + pl, pos = pos0 + pl;
        const bf16* ur = U + (size_t)row * EV_INP;
        float sq = 0.f, skv = 0.f;
#pragma unroll
        for (int m = 0; m < 6; ++m) { float x[8]; unpack8(*(const u32x4*)(ur + 8 * (sub + 8 * m)), x);
#pragma unroll
            for (int e = 0; e < 8; ++e) sq += x[e] * x[e]; }
#pragma unroll
        for (int m = 0; m < 4; ++m) { float x[8]; unpack8(*(const u32x4*)(ur + 384 + 8 * (sub + 8 * m)), x);
#pragma unroll
            for (int e = 0; e < 8; ++e) skv += x[e] * x[e]; }
        sq = sum8(sq); skv = sum8(skv);
        const float rsq = 1.0f / sqrtf(sq * (1.f / 384.f) + EPS), rskv = 1.0f / sqrtf(skv * (1.f / 256.f) + EPS);
        float krv[4];
#pragma unroll
        for (int m = 0; m < 4; ++m) krv[m] = bf2f(ur[640 + sub + 8 * m]);
        float cr = 1.f, sr = 0.f, cc = 1.f, sc = 0.f;
        if (lat) { const f32x2 a0 = CS[pos * 16 + sub], a1 = CS[pos * 16 + 8 + sub]; cr = a0.x; sr = a0.y; cc = a1.x; sc = a1.y; }
        const float* qrow = QPRE + (size_t)row * 768; const float* kvrow = KVPRE + (size_t)row * 1024;
#pragma unroll 2
        for (int hh = 0; hh < 8; ++hh) {
            { const f32x4 n0 = *(const f32x4*)(qrow + hh * 96 + 8 * sub), n1 = *(const f32x4*)(qrow + hh * 96 + 8 * sub + 4);
              float qn[8] = {n0.x * rsq, n0.y * rsq, n0.z * rsq, n0.w * rsq, n1.x * rsq, n1.y * rsq, n1.z * rsq, n1.w * rsq}, qr[4]; float ss = 0.f;
#pragma unroll
              for (int m = 0; m < 4; ++m) { qr[m] = qrow[hh * 96 + 64 + sub + 8 * m] * rsq; ss += qr[m] * qr[m]; }
#pragma unroll
              for (int e = 0; e < 8; ++e) ss += qn[e] * qn[e];
              const float rn = 1.0f / sqrtf(sum8(ss) * (1.f / 96.f) + EPS);
#pragma unroll
              for (int e = 0; e < 8; ++e) qn[e] *= rn * qgn[e];
#pragma unroll
              for (int m = 0; m < 4; ++m) qr[m] *= rn * qgr[m];
              { const float x0 = qr[0], x1 = qr[1], y0 = qr[2], y1 = qr[3]; qr[0] = x0 * cr - x1 * sr; qr[1] = x1 * cr + x0 * sr; qr[2] = y0 * cc - y1 * sc; qr[3] = y1 * cc + y0 * sc; }
              bf16* qo = QB + ((size_t)(b * 8 + hh) * KPOS + pos) * 96;
              *(u32x4*)(qo + 8 * sub) = pack8(qn);
#pragma unroll
              for (int m = 0; m < 4; ++m) qo[64 + sub + 8 * m] = f2bf(qr[m]); }
            { const f32x4 n0 = *(const f32x4*)(kvrow + hh * 128 + 8 * sub), n1 = *(const f32x4*)(kvrow + hh * 128 + 8 * sub + 4);
              float kn[8] = {n0.x * rskv, n0.y * rskv, n0.z * rskv, n0.w * rskv, n1.x * rskv, n1.y * rskv, n1.z * rskv, n1.w * rskv}, kr[4]; float ss = 0.f;
#pragma unroll
              for (int m = 0; m < 4; ++m) { kr[m] = krv[m]; ss += kr[m] * kr[m]; }
#pragma unroll
              for (int e = 0; e < 8; ++e) ss += kn[e] * kn[e];
              const float rn = 1.0f / sqrtf(sum8(ss) * (1.f / 96.f) + EPS);
#pragma unroll
              for (int e = 0; e < 8; ++e) kn[e] *= rn * kgn[e];
#pragma unroll
              for (int m = 0; m < 4; ++m) kr[m] *= rn * kgr[m];
              { const float x0 = kr[0], x1 = kr[1], y0 = kr[2], y1 = kr[3]; kr[0] = x0 * cr - x1 * sr; kr[1] = x1 * cr + x0 * sr; kr[2] = y0 * cc - y1 * sc; kr[3] = y1 * cc + y0 * sc; }
              bf16* ko = KB + ((size_t)(b * 8 + hh) * KPOS + pos) * 96;
              *(u32x4*)(ko + 8 * sub) = pack8(kn);
#pragma unroll
              for (int m = 0; m < 4; ++m) ko[64 + sub + 8 * m] = f2bf(kr[m]); }
            { const f32x4 v0 = *(const f32x4*)(kvrow + hh * 128 + 64 + 8 * sub), v1 = *(const f32x4*)(kvrow + hh * 128 + 64 + 8 * sub + 4);
              const float vv[8] = {v0.x, v0.y, v0.z, v0.w, v1.x, v1.y, v1.z, v1.w};
#pragma unroll
              for (int e = 0; e < 8; ++e) VL[(hh * 64 + 8 * sub + e) * 64 + pl] = f2bf(vv[e] * rskv); }
        }
        __syncthreads();
        { const int hd = C.tid;
            bf16* dst = VT + ((size_t)(b * 8 + (hd >> 6)) * 64 + (hd & 63)) * KPOS + pos0;
#pragma unroll
            for (int q = 0; q < 8; ++q) *(u32x4*)(dst + 8 * q) = *(const LAS u32x4*)(VL + hd * 64 + 8 * q); }
        __syncthreads();
    }
}

DI void ph_conv(const Ctx& C, const bf16* U, const float* dww  , const float* dwb, const float* lng, const float* lnb, bf16* OCAT) {
    LAS float* G = (LAS float*)C.lds;
    const int c = C.tid;
    float wk[31];
#pragma unroll
    for (int k = 0; k < 31; ++k) wk[k] = dww[k * 512 + c];
    const float bias = dwb[c];
    for (int u = C.vcu; u < MT / 32; u += C.nb) {
        const int row0 = 32 * u; int base, t0, tseq;
        if (row0 < NLAT) { base = row0 & ~4095; t0 = row0 & 4095; tseq = TL; } else { const int rc = row0 - NLAT; base = NLAT + (rc & ~255); t0 = rc & 255; tseq = LCX; }
        __syncthreads();
        for (int rr = C.wave; rr < 62; rr += 8) { const int tt = t0 - 15 + rr; float g[8];
#pragma unroll
            for (int e = 0; e < 8; ++e) g[e] = 0.f;
            if (tt >= 0 && tt < tseq) { const bf16* ur = U + (size_t)(base + tt) * EV_INP; float av[8], gv[8]; unpack8(*(const u32x4*)(ur + 672 + 8 * C.lane), av); unpack8(*(const u32x4*)(ur + 1184 + 8 * C.lane), gv);
#pragma unroll
                for (int e = 0; e < 8; ++e) g[e] = av[e] * sigmoidf_(gv[e]); }
            *(LAS f32x4*)(G + rr * 512 + 8 * C.lane) = (f32x4){g[0], g[1], g[2], g[3]}; *(LAS f32x4*)(G + rr * 512 + 8 * C.lane + 4) = (f32x4){g[4], g[5], g[6], g[7]}; }
        __syncthreads();
        float acc[32];
#pragma unroll
        for (int t = 0; t < 32; ++t) acc[t] = bias;
#pragma unroll
        for (int rr = 0; rr < 62; ++rr) { const float gv = G[rr * 512 + c];
#pragma unroll
            for (int t = 0; t < 32; ++t) { const int k = rr - t; if (k >= 0 && k < 31) acc[t] += gv * wk[k]; } }
        __syncthreads();
#pragma unroll
        for (int t = 0; t < 32; ++t) G[t * 512 + c] = acc[t];
        __syncthreads();
#pragma unroll
        for (int q = 0; q < 4; ++q) {
            const int t = 4 * C.wave + q, row = row0 + t;
            const f32x4 a0 = *(const LAS f32x4*)(G + t * 512 + 8 * C.lane), a1 = *(const LAS f32x4*)(G + t * 512 + 8 * C.lane + 4);
            float x[8] = {a0.x, a0.y, a0.z, a0.w, a1.x, a1.y, a1.z, a1.w}; float s = 0.f;
#pragma unroll
            for (int e = 0; e < 8; ++e) s += x[e];
            const float mu = wave_sum(s) * (1.f / 512.f); float s2 = 0.f;
#pragma unroll
            for (int e = 0; e < 8; ++e) { x[e] -= mu; s2 += x[e] * x[e]; }
            const float rstd = 1.0f / sqrtf(wave_sum(s2) * (1.f / 512.f) + EPS);
            float y[8];
#pragma unroll
            for (int e = 0; e < 8; ++e) { const float z = x[e] * rstd * lng[8 * C.lane + e] + lnb[8 * C.lane + e]; y[e] = siluf_(z); }
            *(u32x4*)(OCAT + (size_t)row * DM + 512 + 8 * C.lane) = pack8(y);
        }
    }
}

DI void shifted8(const bf16* up, const bf16* uc, const bf16* un, bool hp, bool hn, const float* sw, int c0, float (&o)[8]) {
    const u32x4 z = {0u, 0u, 0u, 0u};
    const u32x4 vp = hp ? *(const u32x4*)(up + c0) : z, vc = *(const u32x4*)(uc + c0), vn = hn ? *(const u32x4*)(un + c0) : z;
    float p[8], c[8], n[8]; unpack8(vp, p); unpack8(vc, c); unpack8(vn, n);
#pragma unroll
    for (int e = 0; e < 8; ++e) o[e] = p[e] * sw[c0 + e] + c[e] * sw[RW_IN + c0 + e] + n[e] * sw[2 * RW_IN + c0 + e];
}
DI void ph_prep(const Ctx& C, const bf16* U, const float* sw  , const float* kkw  , const float* naqg, const float* nakg,
                bf16* R, bf16* V, bf16* K, bf16* KK, bf16* L, bf16* QN, bf16* KN, bf16* VTN) {
    LAS bf16* VL = (LAS bf16*)C.lds;
    const int lane = C.lane, hh = lane >> 3, sub = lane & 7;
    const float C2 = 0.125f * LOG2E;
    for (int u = C.vcu; u < MT / 64; u += C.nb) {
        const int row0 = 64 * u; const bool lat = row0 < NLAT;
        const int b = lat ? (row0 >> 12) : ((row0 - NLAT) >> 8), pos0 = lat ? (row0 & 4095) : TL + ((row0 - NLAT) & 255), tseq = lat ? TL : LCX, tb = lat ? (row0 & 4095) : ((row0 - NLAT) & 255);
        for (int i = 0; i < 8; ++i) {
            const int pl = 8 * C.wave + i, row = row0 + pl, pos = pos0 + pl, t = tb + pl;
            const bool hp = t > 0, hn = t < tseq - 1;
            const bf16* uc = U + (size_t)row * OD_INP; const bf16* up = uc - OD_INP; const bf16* un = uc + OD_INP;
            float o[8];
            shifted8(up, uc, un, hp, hn, sw, 8 * lane, o);          *(u32x4*)(R + (size_t)row * 512 + 8 * lane) = pack8(o);
            shifted8(up, uc, un, hp, hn, sw, 1024 + 8 * lane, o);   *(u32x4*)(V + (size_t)row * 512 + 8 * lane) = pack8(o);
            shifted8(up, uc, un, hp, hn, sw, 512 + 8 * lane, o);    *(u32x4*)(K + (size_t)row * 512 + 8 * lane) = pack8(o);
            { float kk[8]; float ss = 0.f;
#pragma unroll
                for (int e = 0; e < 8; ++e) { kk[e] = o[e] * kkw[8 * lane + e]; ss += kk[e] * kk[e]; }
                ss = sum8(ss); const float rn = 1.0f / sqrtf(ss + 1e-12f);
#pragma unroll
                for (int e = 0; e < 8; ++e) kk[e] *= rn;
                *(u32x4*)(KK + (size_t)row * 512 + 8 * lane) = pack8(kk); }
            if (lane < 48) {
                shifted8(up, uc, un, hp, hn, sw, 1536 + 8 * lane, o);
                if (lane < 16) {
#pragma unroll
                    for (int e = 0; e < 8; ++e) { const float ex = __expf(2.f * o[e]); o[e] = 1.f - 2.f / (ex + 1.f); }
                } else if (lane >= 32) {
#pragma unroll
                    for (int e = 0; e < 8; ++e) o[e] = sigmoidf_(o[e]);
                }
                *(u32x4*)(L + (size_t)row * 384 + 8 * lane) = pack8(o);
            }
            { float x[8]; unpack8(*(const u32x4*)(uc + RW_IN + 8 * lane), x); float ss = 0.f;
#pragma unroll
                for (int e = 0; e < 8; ++e) ss += x[e] * x[e];
                ss = sum8(ss); const float rn = 1.0f / sqrtf(ss * (1.f / 64.f) + EPS);
#pragma unroll
                for (int e = 0; e < 8; ++e) x[e] = x[e] * rn * naqg[8 * sub + e] * C2;
                *(u32x4*)(QN + ((size_t)(b * 8 + hh) * KPOS + pos) * 64 + 8 * sub) = pack8(x); }
            { float x[8]; unpack8(*(const u32x4*)(uc + RW_IN + 512 + 8 * lane), x); float ss = 0.f;
#pragma unroll
                for (int e = 0; e < 8; ++e) ss += x[e] * x[e];
                ss = sum8(ss); const float rn = 1.0f / sqrtf(ss * (1.f / 64.f) + EPS);
#pragma unroll
                for (int e = 0; e < 8; ++e) x[e] = x[e] * rn * nakg[8 * sub + e];
                *(u32x4*)(KN + ((size_t)(b * 8 + hh) * KPOS + pos) * 64 + 8 * sub) = pack8(x); }
            { const u32x4 vv = *(const u32x4*)(uc + RW_IN + 1024 + 8 * lane); const unsigned w4[4] = {vv.x, vv.y, vv.z, vv.w};
#pragma unroll
                for (int e = 0; e < 8; ++e) { const int dv = 8 * sub + e; VL[(hh * 64 + dv) * 64 + pl] = (bf16)((e & 1) ? (w4[e >> 1] >> 16) : (w4[e >> 1] & 0xffffu)); } }
        }
        __syncthreads();
        { const int hd = C.tid; bf16* dst = VTN + ((size_t)(b * 8 + (hd >> 6)) * 64 + (hd & 63)) * KPOS + pos0;
#pragma unroll
            for (int q = 0; q < 8; ++q) *(u32x4*)(dst + 8 * q) = *(const LAS u32x4*)(VL + hd * 64 + 8 * q); }
        __syncthreads();
    }
}

DI int scan_row(int s, int d, int b) { if (s < LCX) return NLAT + b * LCX + (d ? (LCX - 1 - s) : s); const int t = s - LCX; return b * TL + (d ? (TL - 1 - t) : t); }
DI void ph_scan(const Ctx& C, const bf16* R, const bf16* V, const bf16* KK, const float* W, const bf16* KEFF, const bf16* BSC, float* YS) {
    constexpr int CH = 32, BUF = 5 * CH * 64 + CH * 32;
    LAS float* lds = (LAS float*)C.lds;
    LAS float* ystage = lds + 2 * BUF;
    const int tid = C.tid, i = tid >> 4, kq = tid & 15;
    for (int cid = C.bid; cid < 256; cid += C.nb) {
        const int b = cid >> 5, hh = (cid >> 2) & 7, d = (cid >> 1) & 1, hf = cid & 1;
        const float* Wd = W + (size_t)d * MT * 512; const bf16* KEd = KEFF + (size_t)d * MT * 512; const bf16* BSd = BSC + (size_t)d * MT * 512; float* Yd = YS + (size_t)d * MT * 512;
        float S[4] = {0.f, 0.f, 0.f, 0.f};
        const int sl = tid >> 4, sub = tid & 15;
        f32x4 lw; u32x4 l1, l2, l3;
        auto issue = [&](int ck) {
            const int row = scan_row(ck * CH + sl, d, b);
            lw = *(const f32x4*)(Wd + (size_t)row * 512 + hh * 64 + 4 * sub);
            if (sub < 8) { l1 = *(const u32x4*)(R + (size_t)row * 512 + hh * 64 + 8 * sub); l2 = *(const u32x4*)(KEd + (size_t)row * 512 + hh * 64 + 8 * sub); }
            else { l1 = *(const u32x4*)(KK + (size_t)row * 512 + hh * 64 + 8 * (sub - 8)); l2 = *(const u32x4*)(BSd + (size_t)row * 512 + hh * 64 + 8 * (sub - 8)); }
            if (sub < 4) l3 = *(const u32x4*)(V + (size_t)row * 512 + hh * 64 + 32 * hf + 8 * sub);
        };
        auto commit = [&](int bufi) {
            LAS float* B = lds + bufi * BUF;
            *(LAS f32x4*)(B + (1 * CH + sl) * 64 + 4 * sub) = lw;
            float f1[8], f2[8]; unpack8(l1, f1); unpack8(l2, f2);
            const int a1 = sub < 8 ? 0 : 3, a2 = sub < 8 ? 2 : 4, off = 8 * (sub & 7);
            *(LAS f32x4*)(B + (a1 * CH + sl) * 64 + off) = (f32x4){f1[0], f1[1], f1[2], f1[3]}; *(LAS f32x4*)(B + (a1 * CH + sl) * 64 + off + 4) = (f32x4){f1[4], f1[5], f1[6], f1[7]};
            *(LAS f32x4*)(B + (a2 * CH + sl) * 64 + off) = (f32x4){f2[0], f2[1], f2[2], f2[3]}; *(LAS f32x4*)(B + (a2 * CH + sl) * 64 + off + 4) = (f32x4){f2[4], f2[5], f2[6], f2[7]};
            if (sub < 4) { float f3[8]; unpack8(l3, f3); LAS float* vp = B + 5 * CH * 64 + sl * 32 + 8 * sub;
                *(LAS f32x4*)vp = (f32x4){f3[0], f3[1], f3[2], f3[3]}; *(LAS f32x4*)(vp + 4) = (f32x4){f3[4], f3[5], f3[6], f3[7]}; }
        };
        __syncthreads();
        issue(0); commit(0);
        __syncthreads();
        constexpr int NCK = KPOS / CH;
        for (int ck = 0; ck < NCK; ++ck) {
            if (ck + 1 < NCK) issue(ck + 1);
            const LAS float* B = lds + (ck & 1) * BUF; LAS float* ys = ystage + (ck & 1) * CH * 32;
#pragma unroll 4
            for (int s = 0; s < CH; ++s) {
                const f32x4 rr = *(const LAS f32x4*)(B + (0 * CH + s) * 64 + 4 * kq), ww = *(const LAS f32x4*)(B + (1 * CH + s) * 64 + 4 * kq), ke = *(const LAS f32x4*)(B + (2 * CH + s) * 64 + 4 * kq),
                            kk = *(const LAS f32x4*)(B + (3 * CH + s) * 64 + 4 * kq), bs = *(const LAS f32x4*)(B + (4 * CH + s) * 64 + 4 * kq);
                const float v = B[5 * CH * 64 + s * 32 + i];
                float sa = -(S[0] * kk.x + S[1] * kk.y + S[2] * kk.z + S[3] * kk.w);
                sa = sum16(sa);
                S[0] = S[0] * ww.x + (sa * bs.x + v * ke.x); S[1] = S[1] * ww.y + (sa * bs.y + v * ke.y); S[2] = S[2] * ww.z + (sa * bs.z + v * ke.z); S[3] = S[3] * ww.w + (sa * bs.w + v * ke.w);
                float y = S[0] * rr.x + S[1] * rr.y + S[2] * rr.z + S[3] * rr.w;
                y = sum16(y);
                if (kq == 0) ys[s * 32 + i] = y;
            }
            if (ck + 1 < NCK) commit((ck + 1) & 1);
            __syncthreads();
            if (tid < 256) { const int s = tid >> 3, q = tid & 7; const int row = scan_row(ck * CH + s, d, b);
                *(f32x4*)(Yd + (size_t)row * 512 + hh * 64 + 32 * hf + 4 * q) = *(const LAS f32x4*)(ys + s * 32 + 4 * q); }
        }
    }
}


DI void ph_scan2(const Ctx& C, const bf16* R, const bf16* V, const bf16* K, const bf16* KK, const float* W, const bf16* AR_  , const float* ka, float* YS) {
    constexpr int CH = 16, BUF = 5 * CH * 64 + CH * 32, NCK = KPOS / CH, DEPTH = 4, YP = CH * 32 * 16;
    static_assert(NCK % DEPTH == 0, "chunk loop is unrolled by DEPTH");
    LAS float* lds = (LAS float*)C.lds;
    LAS float* ypart = lds + 2 * BUF;
    const bool comp = C.wave < 4;
    const int rp = 4 * (C.wave & 3) + (C.lane >> 4), kq = C.lane & 15, lt = C.tid - 256;
    for (int cid0 = C.bid; cid0 < 256; cid0 += C.nb) {
        const int hf = (cid0 >> 3) & 1, chain = (cid0 & 7) | ((cid0 >> 4) << 3), b = chain >> 4, hh = (chain >> 1) & 7, d = chain & 1;
        const float* Wd = W + (size_t)d * MT * 512; const bf16* Ad = AR_ + (size_t)d * MT * 512; float* Yd = YS + (size_t)d * MT * 512;
        u32x4 reg[DEPTH][4];
        float kav[8];
#pragma unroll
        for (int e = 0; e < 8; ++e) kav[e] = ka[hh * 64 + 8 * (lt & 7) + e];
        auto issue = [&](int ck, u32x4 (&rg)[4]) {
            { const size_t base = (size_t)scan_row(ck * CH + (lt >> 4), d, b) * 512 + hh * 64; rg[0] = *(const u32x4*)(Wd + base + 4 * (lt & 15)); }
            rg[1] = (u32x4){0u, 0u, 0u, 0u};
            if (lt < 128) { const size_t base = (size_t)scan_row(ck * CH + (lt >> 3), d, b) * 512 + hh * 64; rg[1] = *(const u32x4*)(R + base + 8 * (lt & 7)); }
            else if (lt < 192) { const int x = lt - 128; const size_t base = (size_t)scan_row(ck * CH + (x >> 2), d, b) * 512 + hh * 64; rg[1] = *(const u32x4*)(V + base + 32 * hf + 8 * (x & 3)); }
            { const size_t base = (size_t)scan_row(ck * CH + ((lt & 127) >> 3), d, b) * 512 + hh * 64 + 8 * (lt & 7); rg[2] = *(const u32x4*)((lt < 128 ? K : KK) + base); rg[3] = *(const u32x4*)(Ad + base); }
        };
        auto commit = [&](int bufi, const u32x4 (&rg)[4]) {
            LAS float* B = lds + bufi * BUF;
            *(LAS u32x4*)(B + (1 * CH + (lt >> 4)) * 64 + 4 * (lt & 15)) = rg[0];
            if (lt < 192) { float f[8]; unpack8(rg[1], f); LAS float* dst = lt < 128 ? B + (0 * CH + (lt >> 3)) * 64 + 8 * (lt & 7) : B + 5 * CH * 64 + ((lt - 128) >> 2) * 32 + 8 * ((lt - 128) & 3);
                *(LAS f32x4*)dst = (f32x4){f[0], f[1], f[2], f[3]}; *(LAS f32x4*)(dst + 4) = (f32x4){f[4], f[5], f[6], f[7]}; }
            { float x[8], av[8]; unpack8(rg[2], x); unpack8(rg[3], av); const int sl = (lt & 127) >> 3, pc = lt & 7;
                if (lt < 128) {
#pragma unroll
                    for (int e = 0; e < 8; ++e) x[e] = x[e] * (1.f + (av[e] - 1.f) * kav[e]);
                    LAS float* dst = B + (2 * CH + sl) * 64 + 8 * pc; *(LAS f32x4*)dst = (f32x4){x[0], x[1], x[2], x[3]}; *(LAS f32x4*)(dst + 4) = (f32x4){x[4], x[5], x[6], x[7]};
                } else {
                    LAS float* dk = B + (3 * CH + sl) * 64 + 8 * pc; *(LAS f32x4*)dk = (f32x4){x[0], x[1], x[2], x[3]}; *(LAS f32x4*)(dk + 4) = (f32x4){x[4], x[5], x[6], x[7]};
#pragma unroll
                    for (int e = 0; e < 8; ++e) x[e] *= av[e];
                    LAS float* db = B + (4 * CH + sl) * 64 + 8 * pc; *(LAS f32x4*)db = (f32x4){x[0], x[1], x[2], x[3]}; *(LAS f32x4*)(db + 4) = (f32x4){x[4], x[5], x[6], x[7]};
                } }
        };
        auto y_reduce = [&](int ck) {
            const LAS float* yp = ypart + (ck & 1) * YP + lt * 32;
            float y[2];
#pragma unroll
            for (int j = 0; j < 2; ++j) { const f32x4 a0 = *(const LAS f32x4*)(yp + 16 * j), a1 = *(const LAS f32x4*)(yp + 16 * j + 4), a2 = *(const LAS f32x4*)(yp + 16 * j + 8), a3 = *(const LAS f32x4*)(yp + 16 * j + 12);
                y[j] = (((a0.x + a0.y) + (a0.z + a0.w)) + ((a1.x + a1.y) + (a1.z + a1.w))) + (((a2.x + a2.y) + (a2.z + a2.w)) + ((a3.x + a3.y) + (a3.z + a3.w))); }
            const int row = scan_row(ck * CH + (lt >> 4), d, b);
            *(f32x2*)(Yd + (size_t)row * 512 + hh * 64 + 32 * hf + 2 * (lt & 15)) = (f32x2){y[0], y[1]};
        };
        f32x2 S[2][2];
#pragma unroll
        for (int j = 0; j < 2; ++j) { S[j][0] = (f32x2){0.f, 0.f}; S[j][1] = (f32x2){0.f, 0.f}; }
        __syncthreads();
        if (!comp) { issue(0, reg[0]); commit(0, reg[0]);
#pragma unroll
            for (int k = 1; k < DEPTH; ++k) issue(k, reg[k]); }
        __syncthreads();
        for (int ck0 = 0; ck0 < NCK; ck0 += DEPTH) {
#pragma unroll
            for (int kk = 0; kk < DEPTH; ++kk) {
                const int ck = ck0 + kk;
                if (comp) {
                    const LAS float* B = lds + (ck & 1) * BUF + 4 * kq; const LAS float* vb = lds + (ck & 1) * BUF + 5 * CH * 64 + 2 * rp; LAS float* yq = ypart + (ck & 1) * YP + (2 * rp) * 16 + kq;
                    f32x4 op[2][5]; f32x2 vv[2];
#define SCAN_LOAD(set, sI) do { const LAS float* bp_ = B + (sI) * 64; _Pragma("unroll") for (int a_ = 0; a_ < 5; ++a_) op[set][a_] = *(const LAS f32x4*)(bp_ + a_ * CH * 64); vv[set] = *(const LAS f32x2*)(vb + (sI) * 32); } while (0)
#define SCAN_ROW(set, sI, j, vj) do { f32x2 acc = S[j][0] * (f32x2){op[set][3].x, op[set][3].y}; acc = __builtin_elementwise_fma(S[j][1], (f32x2){op[set][3].z, op[set][3].w}, acc); \
                        const float sa = sum16(-(acc.x + acc.y)); const f32x2 sa2 = {sa, sa}, v2 = {vj, vj}; \
                        S[j][0] = __builtin_elementwise_fma(S[j][0], (f32x2){op[set][1].x, op[set][1].y}, __builtin_elementwise_fma(sa2, (f32x2){op[set][4].x, op[set][4].y}, v2 * (f32x2){op[set][2].x, op[set][2].y})); \
                        S[j][1] = __builtin_elementwise_fma(S[j][1], (f32x2){op[set][1].z, op[set][1].w}, __builtin_elementwise_fma(sa2, (f32x2){op[set][4].z, op[set][4].w}, v2 * (f32x2){op[set][2].z, op[set][2].w})); \
                        const f32x2 ya = __builtin_elementwise_fma(S[j][1], (f32x2){op[set][0].z, op[set][0].w}, S[j][0] * (f32x2){op[set][0].x, op[set][0].y}); \
                        yq[(sI) * 512 + (j) * 16] = ya.x + ya.y; } while (0)
#define SCAN_STEP(set, sI) do { SCAN_ROW(set, sI, 0, vv[set].x); SCAN_ROW(set, sI, 1, vv[set].y); } while (0)
                    SCAN_LOAD(0, 0);
#pragma unroll
                    for (int sI = 0; sI < CH; sI += 2) {
                        SCAN_LOAD(1, sI + 1);
                        SCAN_STEP(0, sI);
                        if (sI + 2 < CH) SCAN_LOAD(0, sI + 2);
                        SCAN_STEP(1, sI + 1);
                    }
#undef SCAN_LOAD
#undef SCAN_ROW
#undef SCAN_STEP
                } else {
                    if (ck + 1 < NCK) commit((ck + 1) & 1, reg[(kk + 1) % DEPTH]);
                    if (ck + DEPTH < NCK) issue(ck + DEPTH, reg[kk]);
                    if (ck > 0) y_reduce(ck - 1);
                }
                __syncthreads();
            }
        }
        if (!comp) y_reduce(NCK - 1);
    }
}

DI void ph_post(const Ctx& C, const float* YS, const bf16* R, const bf16* V, const bf16* K, const bf16* A2, const float* ka, const bf16* G, const float* rk, const float* gng, const float* gnb, bf16* OCAT, bool last) {
    const int gw = C.bid * 8 + C.wave, ngw = C.nb * 8, lane = C.lane, nrows = last ? NLAT : MT;
    for (int row = gw; row < nrows; row += ngw) {
        const size_t o = (size_t)row * 512 + 8 * lane;
        const f32x4 y0a = *(const f32x4*)(YS + o), y0b = *(const f32x4*)(YS + o + 4), y1a = *(const f32x4*)(YS + (size_t)MT * 512 + o), y1b = *(const f32x4*)(YS + (size_t)MT * 512 + o + 4);
        float y[8] = {y0a.x + y1a.x, y0a.y + y1a.y, y0a.z + y1a.z, y0a.w + y1a.w, y0b.x + y1b.x, y0b.y + y1b.y, y0b.z + y1b.z, y0b.w + y1b.w};
        float r[8], v[8], kx[8], a0[8], a1[8], g[8];
        unpack8(*(const u32x4*)(R + o), r); unpack8(*(const u32x4*)(V + o), v); unpack8(*(const u32x4*)(K + o), kx); unpack8(*(const u32x4*)(A2 + o), a0); unpack8(*(const u32x4*)(A2 + (size_t)MT * 512 + o), a1); unpack8(*(const u32x4*)(G + o), g);
        float bsum = 0.f;
#pragma unroll
        for (int e = 0; e < 8; ++e) { const float kae = ka[8 * lane + e]; bsum += r[e] * (kx[e] * (1.f + (a0[e] - 1.f) * kae) + kx[e] * (1.f + (a1[e] - 1.f) * kae)) * rk[8 * lane + e]; }
        bsum = sum8(bsum);
        float s = 0.f;
#pragma unroll
        for (int e = 0; e < 8; ++e) { y[e] += bsum * v[e]; s += y[e]; }
        const float mu = sum8(s) * (1.f / 64.f); float s2 = 0.f;
#pragma unroll
        for (int e = 0; e < 8; ++e) { y[e] -= mu; s2 += y[e] * y[e]; }
        const float rstd = 1.0f / sqrtf(sum8(s2) * (1.f / 64.f) + GN_EPS);
        float out[8];
#pragma unroll
        for (int e = 0; e < 8; ++e) out[e] = (y[e] * rstd * gng[8 * lane + e] + gnb[8 * lane + e]) * g[e];
        *(u32x4*)(OCAT + (size_t)row * DM + 8 * lane) = pack8(out);
    }
}

DI void ph_topk(const Ctx& C, const float* AFFT, const float* AFFC, int* ROWS, float* GATE, int* SLOT, bool last) {
    LAS unsigned long long* key = (LAS unsigned long long*)C.lds;
    const int nprob = last ? 128 : 256;
    for (int p = C.bid; p < nprob; p += C.nb) {
        const bool isctx = p >= 128; const int be = p & 127, b = be >> 4, e = be & 15;
        const int n = isctx ? LCX : TL, cap = isctx ? CAPC : CAPL;
        const float* src = isctx ? AFFC + (size_t)be * LCX : AFFT + (size_t)be * TL;
        __syncthreads();
        for (int t = C.tid; t < n; t += 512) key[t] = ((unsigned long long)__builtin_bit_cast(unsigned, src[t]) << 32) | (unsigned long long)(0xFFFFFFFFu - (unsigned)t);
        __syncthreads();
        for (int k = 2; k <= n; k <<= 1)
            for (int j = k >> 1; j > 0; j >>= 1) {
                for (int q = C.tid; q < n / 2; q += 512) {
                    const int i = ((q & ~(j - 1)) << 1) | (q & (j - 1)), ix = i | j;
                    const unsigned long long a = key[i], bb = key[ix];
                    const bool desc = ((i & k) == 0);
                    if (desc ? (a < bb) : (a > bb)) { key[i] = bb; key[ix] = a; }
                }
                __syncthreads();
            }
        for (int jx = C.tid; jx < cap; jx += 512) {
            const unsigned long long kv = key[jx]; const int t = (int)(0xFFFFFFFFu - (unsigned)(kv & 0xFFFFFFFFull)); const float g = __builtin_bit_cast(float, (unsigned)(kv >> 32));
            const int slot = isctx ? NB * CAPL + b * CAPC + jx : b * CAPL + jx, row = isctx ? NLAT + b * LCX + t : b * TL + t;
            ROWS[e * ESLOTS + slot] = row; GATE[e * ESLOTS + slot] = g; SLOT[(size_t)row * 16 + e] = slot;
        }
    }
}

DI void ph_combine(const Ctx& C, float* xlat, float* xctx, const float* modg2  , const int* SLOT, const bf16* Y2, bool last) {
    const int gw = C.bid * 8 + C.wave, ngw = C.nb * 8, lane = C.lane, nrows = last ? NLAT : MT;
    for (int row = gw; row < nrows; row += ngw) {
        float* xr = row < NLAT ? xlat + (size_t)row * DM : xctx + (size_t)(row - NLAT) * DM;
        const int mi = row < NLAT ? (row >> 12) : 8;
        const int sv = SLOT[(size_t)row * 16 + (lane & 15)];
        f32x4 acc[4];
#pragma unroll
        for (int j = 0; j < 4; ++j) acc[j] = (f32x4){0.f, 0.f, 0.f, 0.f};
#pragma unroll
        for (int e = 0; e < 16; ++e) {
            const int s = __builtin_amdgcn_readlane(sv, e);
            if (s >= 0) { const bf16* yp = Y2 + ((size_t)e * ESLOTS + s) * DM + 4 * lane;
#pragma unroll
                for (int j = 0; j < 4; ++j) { const u32x2 w = *(const u32x2*)(yp + 256 * j); acc[j] += (f32x4){bflo(w.x), bfhi(w.x), bflo(w.y), bfhi(w.y)}; } }
        }
#pragma unroll
        for (int j = 0; j < 4; ++j) { const int c = 256 * j + 4 * lane; const f32x4 g = *(const f32x4*)(modg2 + mi * 6144 + c); f32x4 x = *(const f32x4*)(xr + c); x += g * acc[j]; *(f32x4*)(xr + c) = x; }
    }
}

template <int N> struct IC { static constexpr int value = N; };
DI const float* in_ptr(const unsigned char* ws, int k) { const unsigned long long v = ((const unsigned long long*)(ws + 128 * 1024))[k];
    const unsigned lo = __builtin_amdgcn_readfirstlane((unsigned)v), hi = __builtin_amdgcn_readfirstlane((unsigned)(v >> 32));
    return (const float*)(__attribute__((address_space(1))) const float*)(((unsigned long long)hi << 32) | lo); }
template <class T> DI T* launder_ptr(T* p) { unsigned long long v = (unsigned long long)p; unsigned lo = (unsigned)v, hi = (unsigned)(v >> 32); asm volatile("" : "+v"(lo), "+v"(hi));
    lo = __builtin_amdgcn_readfirstlane(lo); hi = __builtin_amdgcn_readfirstlane(hi); return (T*)(__attribute__((address_space(1))) T*)(((unsigned long long)hi << 32) | lo); }
constexpr int PH_PER_PAIR = 24, N_PHASES = 1 + 2 * PH_PER_PAIR;
constexpr size_t WS_PTRS = 128 * 1024;
#define P_XC    ((float*)(ws + WS_XC))
#define P_MOD   ((const float*)(ws + WS_MOD))
#define P_HB    ((bf16*)(ws + WS_HB))
#define P_OCAT  ((bf16*)(ws + WS_OCAT))
#define P_AR    (ws + WS_ARENA)
#define P_ROWS  ((int*)(ws + WS_ROWS))
#define P_GATE  ((float*)(ws + WS_GATE))
#define P_SLOT  ((int*)(ws + WS_SLOT))
#define P_AFFT  ((float*)(ws + WS_AFFT))
#define P_AFFC  ((float*)(ws + WS_AFFC))
#define P_W13   ((bf16*)(ws + WS_W13))
#define P_W2    ((bf16*)(ws + WS_W2))
#define P_U     ((bf16*)(P_AR + A_U))
#define P_QPRE  ((float*)(P_AR + A_QPRE))
#define P_KVPRE ((float*)(P_AR + A_KVPRE))
#define P_QB    ((bf16*)(P_AR + A_QB))
#define P_KB    ((bf16*)(P_AR + A_KB))
#define P_VT    ((bf16*)(P_AR + A_VT))
#define P_W     ((float*)(P_AR + A_W))
#define P_KEFF  ((bf16*)(P_AR + A_KEFF))
#define P_R     ((bf16*)(P_AR + A_R))
#define P_V     ((bf16*)(P_AR + A_V))
#define P_KK    ((bf16*)(P_AR + A_KK))
#define P_G     ((bf16*)(P_AR + A_G))
#define P_K     ((bf16*)(P_AR + A_K))
#define P_L     ((bf16*)(P_AR + A_L))
#define P_QN    ((bf16*)(P_AR + A_QN))
#define P_KN    ((bf16*)(P_AR + A_KN))
#define P_VTN   ((bf16*)(P_AR + A_VTN))
#define P_YS    ((float*)(P_AR + A_YS))
#define P_HID   ((bf16*)(P_AR + A_HID))
#define P_Y2    ((bf16*)(P_AR + A_Y2))
#define MODL(i) (P_MOD + (size_t)(i) * 9 * 6144)
#define RELAUNDER() do { int l_ = C.lane; asm volatile("" : "+v"(l_)); C.lane = l_; C.tid = (C.wave << 6) | l_; } while (0)
__global__ void __launch_bounds__(512, 2) fwd_kernel(Args a) {
    extern __shared__ __attribute__((aligned(16))) unsigned char smem[];
    Ctx C0; C0.lds = (LAS unsigned char*)smem; C0.tid = threadIdx.x; C0.lane = C0.tid & 63; C0.wave = __builtin_amdgcn_readfirstlane(C0.tid >> 6); C0.bid = blockIdx.x; C0.nb = gridDim.x;
    C0.vcu = (C0.nb % 8 == 0) ? (C0.bid % 8) * (C0.nb / 8) + C0.bid / 8 : C0.bid;
    volatile LAS unsigned* bst = (volatile LAS unsigned*)(C0.lds + LDS_BYTES - 16);
#if MEGA
    if (C0.tid == 0) { bst[0] = 0u; bst[1] = 0u; }
    __syncthreads();
    const unsigned bar_x = xcd_barrier_post((unsigned*)(a.ws + WS_CTL) + 4096, bst, C0.tid == 0).x;
#define SEAM() do { if (ph < hi) { XcdBarrier b2_; b2_.bar = (unsigned*)(ws + WS_CTL) + 4096; b2_.x = bar_x; b2_.st = bst; xcd_barrier(b2_, C.tid == 0); } } while (0)
#else
#define SEAM() do { } while (0)
#endif
#if MEGA
    constexpr int lo = 0, hi = N_PHASES;
#else
    const int lo = a.ph_lo, hi = a.ph_hi;
#endif
    int ph = 0;
#ifndef ONLY
#define ONLY -1
#endif
#ifndef REPMASK
#define REPMASK 0
#endif
#ifndef SITE_LO
#define SITE_LO 0
#define SITE_HI 99
#endif
#define PHASE(SITE, ...) do { if ((ONLY < 0 || ONLY == (SITE)) && (SITE) >= SITE_LO && (SITE) <= SITE_HI && ph >= lo && ph < hi) { Ctx C; C.lds = C0.lds; \
        { int w_ = C0.wave; asm volatile("" : "+s"(w_)); unsigned m_ = ~0u; asm volatile("" : "+s"(m_)); int l_ = (int)__builtin_amdgcn_mbcnt_hi(m_, __builtin_amdgcn_mbcnt_lo(m_, 0u)); C.wave = w_; C.lane = l_; C.tid = (w_ << 6) | l_; } \
        { int b_ = C0.bid, n_ = C0.nb, v_ = C0.vcu; asm volatile("" : "+s"(b_), "+s"(n_), "+s"(v_)); C.bid = b_; C.nb = n_; C.vcu = v_; } \
        unsigned z_ = 0u; asm volatile("" : "+s"(z_)); unsigned char* ws = a.ws + z_; float* XL = a.out + z_; const int lq = __builtin_amdgcn_readfirstlane(lp); typedef const __attribute__((address_space(1))) float* gfp_t; const gfp_t* INT_ = (const gfp_t*)(ws + WS_PTRS); (void)INT_; (void)XL; (void)lq; \
        for (int rep_ = 0; rep_ < ((((REPMASK) >> (SITE)) & 1) ? 2 : 1); ++rep_) { __VA_ARGS__; if ((((REPMASK) >> (SITE)) & 1)) __syncthreads(); } ++ph; SEAM(); } else ++ph; } while (0)

    { const int lp = 0;
      PHASE(0, { if (C.bid == 0) { _Pragma("unroll") for (int k = 0; k < 40; ++k) if (C.tid == k) ((const float**)(ws + WS_PTRS))[k] = a.in[k]; }
                 ph_prologue(C, a); }); }

    auto layer_pair = [&](auto lpc) __attribute__((always_inline)) {
        constexpr int lp = decltype(lpc)::value;
        PHASE(1, { const int i = 2 * lq; const float* xl = (i == 0) ? in_ptr(ws, I_X) : XL; const float* xc = (i == 0) ? in_ptr(ws, I_CTX) : P_XC;
                   ph_norm<false>(C, xl, xc, in_ptr(ws, I_N1G) + i * DM, MODL(i), 0, 1024, P_HB, nullptr, nullptr, nullptr, nullptr);
                   moe_weight_prep(C, in_ptr(ws, I_MW1) + (size_t)i * NEXP * DM * DM, in_ptr(ws, I_MW3) + (size_t)i * NEXP * DM * DM, in_ptr(ws, I_MW2) + (size_t)i * NEXP * DM * DM, P_W13, P_W2); });
        PHASE(2, { EpiBf16 E{P_U, EV_INP}; fast_gemm(C, P_HB, DM, (const bf16*)(ws + WS_WEVIN) + (size_t)lq * EV_INP * DM, DM, MT / 256, EV_INP / 256, E); });
        PHASE(3, { EpiF32 Eq{P_QPRE, 768}; fast_gemm(C, P_U, EV_INP, (const bf16*)(ws + WS_WUQ) + (size_t)lq * 768 * 384, 384, MT / 256, 3, Eq); RELAUNDER();
                   EpiF32 Ek{P_KVPRE, 1024}; fast_gemm(C, P_U + 384, EV_INP, (const bf16*)(ws + WS_WUKV) + (size_t)lq * 1024 * 256, 256, MT / 256, 4, Ek); });
        PHASE(4, { ph_mla_fin(C, P_U, P_QPRE, P_KVPRE, in_ptr(ws, I_QG) + lq * 96, in_ptr(ws, I_KG) + lq * 96, (const f32x2*)(ws + WS_ROPE), P_QB, P_KB, P_VT);
                   ph_conv(C, P_U, in_ptr(ws, I_DWW) + (size_t)lq * 31 * 512, in_ptr(ws, I_DWB) + lq * 512, in_ptr(ws, I_LNG) + lq * 512, in_ptr(ws, I_LNB) + lq * 512, P_OCAT); });
        PHASE(5, ph_attn_mla2(C, P_QB, P_KB, P_VT, P_OCAT, false));
        PHASE(6, { const int i = 2 * lq; const float* xl = (i == 0) ? in_ptr(ws, I_X) : XL; const float* xc = (i == 0) ? in_ptr(ws, I_CTX) : P_XC;
                   EpiResid E{xl, xc, XL, P_XC, MODL(i) + 2048}; fast_gemm(C, P_OCAT, DM, (const bf16*)(ws + WS_WEVOUT) + (size_t)lq * DM * DM, DM, MT / 256, 4, E); });
        PHASE(7, { const int i = 2 * lq; ph_norm<true>(C, XL, P_XC, in_ptr(ws, I_N2G) + i * DM, MODL(i), 3072, 4096, P_HB, in_ptr(ws, I_ROUTER) + (size_t)i * DM * 16, P_AFFT, P_AFFC, P_SLOT); });
        PHASE(8, ph_topk(C, P_AFFT, P_AFFC, P_ROWS, P_GATE, P_SLOT, false));
        PHASE(9, { pg8::Gemm g{P_HB, P_W13, DM, DM, P_ROWS}; pg8::OrderMoE S{17, 8, 17, C.nb, C.vcu}; pg8::EpiAdapt<EpiGlu> E{EpiGlu{P_HID}}; pg8::gemm_phase(C.lds, g, S, E, C.tid); });
        PHASE(10, { pg8::Gemm g{P_HID, P_W2, DM, DM, nullptr}; pg8::OrderMoE S{17, 4, 17, C.nb, C.vcu}; pg8::EpiAdapt<EpiGate> E{EpiGate{P_Y2, P_GATE}}; pg8::gemm_phase(C.lds, g, S, E, C.tid); });
        PHASE(11, { const int i = 2 * lq; ph_combine(C, XL, P_XC, MODL(i) + 5120, P_SLOT, P_Y2, false); });
        PHASE(12, { const int i = 2 * lq + 1; ph_norm<false>(C, XL, P_XC, in_ptr(ws, I_N1G) + i * DM, MODL(i), 0, 1024, P_HB, nullptr, nullptr, nullptr, nullptr);
                    moe_weight_prep(C, in_ptr(ws, I_MW1) + (size_t)i * NEXP * DM * DM, in_ptr(ws, I_MW3) + (size_t)i * NEXP * DM * DM, in_ptr(ws, I_MW2) + (size_t)i * NEXP * DM * DM, P_W13, P_W2); });
        PHASE(13, { EpiBf16 E{P_U, OD_INP}; fast_gemm(C, P_HB, DM, (const bf16*)(ws + WS_WODIN) + (size_t)lq * OD_INP * DM, DM, MT / 256, OD_INP / 256, E); });
        PHASE(14, ph_prep(C, P_U, in_ptr(ws, I_SHIFTW) + (size_t)lq * 3 * RW_IN, in_ptr(ws, I_KKW) + lq * 512, in_ptr(ws, I_NAQG) + lq * 64, in_ptr(ws, I_NAKG) + lq * 64, P_R, P_V, P_K, P_KK, P_L, P_QN, P_KN, P_VTN));
        PHASE(15, { const bf16* WL = (const bf16*)(ws + WS_WLORA) + (size_t)lq * 655360;
                    { EpiLoraW E{P_W, in_ptr(ws, I_W0) + lq * 1024}; fast_gemm(C, P_L, 384, WL, 256, MT / 256, 4, E); } RELAUNDER();
                    { EpiLoraA E{P_KEFF, in_ptr(ws, I_A0) + lq * 1024}; fast_gemm(C, P_L, 384, WL + (size_t)1024 * 256, 256, MT / 256, 4, E); } RELAUNDER();
                    { EpiBf16 E{P_G, 512}; fast_gemm(C, P_L + 128, 384, WL + (size_t)2048 * 256, 256, MT / 256, 2, E); } });
        PHASE(16, ph_natten(C, P_QN, P_KN, P_VTN, P_OCAT, in_ptr(ws, I_RPB) + (size_t)lq * 8 * 465, lq == 1));
        PHASE(17, ph_scan2(C, P_R, P_V, P_K, P_KK, P_W, P_KEFF, in_ptr(ws, I_KA) + lq * 512, P_YS));
        PHASE(18, ph_post(C, P_YS, P_R, P_V, P_K, P_KEFF, in_ptr(ws, I_KA) + lq * 512, P_G, in_ptr(ws, I_RK) + lq * 512, in_ptr(ws, I_GNG) + lq * 512, in_ptr(ws, I_GNB) + lq * 512, P_OCAT, lq == 1));
        PHASE(19, { const int i = 2 * lq + 1; EpiResid E{XL, P_XC, XL, P_XC, MODL(i) + 2048};
                    fast_gemm(C, P_OCAT, DM, (const bf16*)(ws + WS_WODOUT) + (size_t)lq * DM * DM, DM, (lq == 1) ? NLAT / 256 : MT / 256, 4, E); });
        PHASE(20, { const int i = 2 * lq + 1; ph_norm<true>(C, XL, P_XC, in_ptr(ws, I_N2G) + i * DM, MODL(i), 3072, 4096, P_HB, in_ptr(ws, I_ROUTER) + (size_t)i * DM * 16, P_AFFT, P_AFFC, P_SLOT); });
        PHASE(21, ph_topk(C, P_AFFT, P_AFFC, P_ROWS, P_GATE, P_SLOT, lq == 1));
        PHASE(22, { pg8::Gemm g{P_HB, P_W13, DM, DM, P_ROWS}; pg8::OrderMoE S{(lq == 1) ? 16 : 17, 8, 17, C.nb, C.vcu}; pg8::EpiAdapt<EpiGlu> E{EpiGlu{P_HID}}; pg8::gemm_phase(C.lds, g, S, E, C.tid); });
        PHASE(23, { pg8::Gemm g{P_HID, P_W2, DM, DM, nullptr}; pg8::OrderMoE S{(lq == 1) ? 16 : 17, 4, 17, C.nb, C.vcu}; pg8::EpiAdapt<EpiGate> E{EpiGate{P_Y2, P_GATE}}; pg8::gemm_phase(C.lds, g, S, E, C.tid); });
        PHASE(24, { const int i = 2 * lq + 1; ph_combine(C, XL, P_XC, MODL(i) + 5120, P_SLOT, P_Y2, lq == 1); });
    };
    layer_pair(IC<0>{}); layer_pair(IC<1>{});
}

extern "C" void kernel_launch(void* const* d_in, const int* in_sizes, int n_in, void* d_out, int out_size, void* d_ws, size_t ws_size, hipStream_t stream) {
    static int grid = 0;
    if (grid == 0) {
        if (n_in != 40 || out_size != NLAT * DM || ws_size < WS_END) { fprintf(stderr, "kernel_launch: unexpected shapes (n_in %d out %d ws %zu need %zu)\n", n_in, out_size, ws_size, (size_t)WS_END); grid = -1; return; }
        int dev = 0, cus = 0, per_cu = 0;
        if (hipGetDevice(&dev) != hipSuccess || hipDeviceGetAttribute(&cus, hipDeviceAttributeMultiprocessorCount, dev) != hipSuccess) { grid = -1; return; }
        if (hipFuncSetAttribute((const void*)fwd_kernel, hipFuncAttributeMaxDynamicSharedMemorySize, LDS_BYTES) != hipSuccess) { fprintf(stderr, "kernel_launch: hipFuncSetAttribute failed\n"); grid = -1; return; }
        if (hipOccupancyMaxActiveBlocksPerMultiprocessor(&per_cu, (const void*)fwd_kernel, 512, LDS_BYTES) != hipSuccess || per_cu < 1) { fprintf(stderr, "kernel_launch: occupancy query says %d\n", per_cu); per_cu = 1; }
        (void)hipGetLastError();
        grid = cus;
    }
    if (grid < 0) return;
    (void)hipMemsetAsync((char*)d_ws + WS_CTL, 0, CTL_BYTES, stream);
    Args a{};
    for (int i = 0; i < 40; ++i) a.in[i] = (const float*)d_in[i];
    a.out = (float*)d_out; a.ws = (unsigned char*)d_ws;
#if MEGA
    a.ph_lo = 0; a.ph_hi = N_PHASES;
    hipLaunchKernelGGL(fwd_kernel, dim3(grid), dim3(512), LDS_BYTES, stream, a);
#else
    for (int p = 0; p < N_PHASES; ++p) { a.ph_lo = p; a.ph_hi = p + 1; hipLaunchKernelGGL(fwd_kernel, dim3(grid), dim3(512), LDS_BYTES, stream, a); }
#endif
}
```

```cpp
#include <hip/hip_runtime.h>
#include <cstdio>
#include <cstdint>

#ifndef MEGA
#define MEGA 1
#endif

#define LAS __attribute__((address_space(3)))
#define DI __device__ __forceinline__

typedef unsigned short bf16;
typedef short bf16x8 __attribute__((ext_vector_type(8)));
typedef float f32x4 __attribute__((ext_vector_type(4)));
typedef float f32x2 __attribute__((ext_vector_type(2)));
typedef float f32x16 __attribute__((ext_vector_type(16)));
typedef unsigned u32x4 __attribute__((ext_vector_type(4)));
typedef unsigned u32x2 __attribute__((ext_vector_type(2)));
typedef __bf16 bf16x2_t __attribute__((ext_vector_type(2)));

constexpr int DM = 1024, NB = 8, TL = 4096, LCX = 256;
constexpr int NLAT = NB * TL, NCTX = NB * LCX, MT = NLAT + NCTX;
constexpr int KPOS = TL + LCX;
constexpr float EPS = 1e-6f, GN_EPS = 64e-5f;
constexpr int EV_IN = 1696, EV_INP = 1792, OD_IN = 3456, OD_INP = 3584, RW_IN = 1920;
constexpr int NEXP = 16, CAPL = 512, CAPC = 32, ESLOTS = NB * CAPL + NB * CAPC;
constexpr float LOG2E = 1.4426950408889634f;

constexpr size_t MiB = 1ull << 20;
constexpr size_t WS_CTL = 0, CTL_BYTES = 1 * MiB;
constexpr size_t WS_MOD = 1 * MiB, WS_ROPE = 2 * MiB, WS_XC = 4 * MiB;
constexpr size_t WS_ROWS = 12 * MiB, WS_GATE = 12 * MiB + 512 * 1024, WS_SLOT = 13 * MiB, WS_AFFT = 16 * MiB, WS_AFFC = 18 * MiB;
constexpr size_t WS_WEVIN = 20 * MiB, WS_WEVOUT = 27 * MiB, WS_WUQ = 31 * MiB, WS_WUKV = 33 * MiB, WS_WODIN = 34 * MiB, WS_WODOUT = 48 * MiB, WS_WLORA = 52 * MiB;
constexpr size_t WS_W13 = 56 * MiB, WS_W2 = 120 * MiB, WS_HB = 152 * MiB, WS_OCAT = 220 * MiB, WS_ARENA = 288 * MiB;
constexpr size_t A_U = 0, A_QPRE = 119 * MiB, A_KVPRE = 221 * MiB, A_QB = 357 * MiB, A_KB = 408 * MiB, A_VT = 459 * MiB;
constexpr size_t A_W = 0, A_KEFF = 136 * MiB  , A_G = 204 * MiB, A_R = 238 * MiB, A_V = 272 * MiB, A_KK = 306 * MiB, A_K = 340 * MiB, A_L = 374 * MiB,
                 A_QN = 400 * MiB, A_KN = 434 * MiB, A_VTN = 468 * MiB, A_YS = 374 * MiB  ;
constexpr size_t A_HID = 0, A_Y2 = 136 * MiB;
constexpr size_t WS_END = WS_ARENA + 570 * MiB;
constexpr int LDS_BYTES = 147456;

DI unsigned pk2(float lo, float hi) { f32x2 v = {lo, hi}; bf16x2_t b = __builtin_convertvector(v, bf16x2_t); return __builtin_bit_cast(unsigned, b); }
DI float bflo(unsigned u) { return __builtin_bit_cast(float, u << 16); }
DI float bfhi(unsigned u) { return __builtin_bit_cast(float, u & 0xffff0000u); }
DI float bf2f(bf16 x) { return __builtin_bit_cast(float, ((unsigned)x) << 16); }
DI bf16 f2bf(float f) { return (bf16)(pk2(f, 0.f) & 0xffffu); }
DI void unpack8(u32x4 v, float (&f)[8]) { f[0] = bflo(v.x); f[1] = bfhi(v.x); f[2] = bflo(v.y); f[3] = bfhi(v.y); f[4] = bflo(v.z); f[5] = bfhi(v.z); f[6] = bflo(v.w); f[7] = bfhi(v.w); }
DI u32x4 pack8(const float (&f)[8]) { u32x4 r; r.x = pk2(f[0], f[1]); r.y = pk2(f[2], f[3]); r.z = pk2(f[4], f[5]); r.w = pk2(f[6], f[7]); return r; }
#define DPP_ADD(x, ctrl) ((x) + __builtin_bit_cast(float, __builtin_amdgcn_update_dpp(0, __builtin_bit_cast(int, (x)), (ctrl), 0xf, 0xf, false)))
#define DPP_MAX(x, ctrl) fmaxf((x), __builtin_bit_cast(float, __builtin_amdgcn_update_dpp(0, __builtin_bit_cast(int, (x)), (ctrl), 0xf, 0xf, false)))
DI float sum8(float x) { x = DPP_ADD(x, 0xB1); x = DPP_ADD(x, 0x4E); x = DPP_ADD(x, 0x141); return x; }
DI float sum16(float x) { x = DPP_ADD(x, 0xB1); x = DPP_ADD(x, 0x4E); x = DPP_ADD(x, 0x141); x = DPP_ADD(x, 0x140); return x; }
DI float max16(float x) { x = DPP_MAX(x, 0xB1); x = DPP_MAX(x, 0x4E); x = DPP_MAX(x, 0x141); x = DPP_MAX(x, 0x140); return x; }
DI float rdlane(float x, int l) { return __builtin_bit_cast(float, __builtin_amdgcn_readlane(__builtin_bit_cast(int, x), l)); }
DI float wave_sum(float v) { const float x = sum16(v); return (rdlane(x, 0) + rdlane(x, 16)) + (rdlane(x, 32) + rdlane(x, 48)); }
DI float xor32(float v, int lane) { return __builtin_bit_cast(float, __builtin_amdgcn_ds_bpermute((lane ^ 32) << 2, __builtin_bit_cast(int, v))); }
DI float sigmoidf_(float x) { return __builtin_amdgcn_rcpf(1.f + __expf(-x)); }
DI float siluf_(float x) { return x * __builtin_amdgcn_rcpf(1.f + __expf(-x)); }
#define MFMA32(a, b, c) __builtin_amdgcn_mfma_f32_32x32x16_bf16((a), (b), (c), 0, 0, 0)

#define XB_TMO      128
#define XB_XCNT(j)  (256  + 64 * (j))
#define XB_XSUB(j)  (1280 + 64 * (j))
#define XB_XGEN(j)  (2304 + 64 * (j))
#define XB_TOP      3328
#define XB_TOPGEN   3392
#define XCD_BAR_WORDS 3456
#define XB_SPIN_CAP (1u << 22)
__device__ __forceinline__ unsigned xb_ld(unsigned* p)              { return __hip_atomic_load(p, __ATOMIC_RELAXED, __HIP_MEMORY_SCOPE_AGENT); }
__device__ __forceinline__ unsigned xb_add(unsigned* p, unsigned v) { return __hip_atomic_fetch_add(p, v, __ATOMIC_RELAXED, __HIP_MEMORY_SCOPE_AGENT); }
__device__ __forceinline__ unsigned xb_xcc_id() { return (unsigned)__builtin_amdgcn_s_getreg((3 << 11) | 20) & 0xFu; }
#define XB_SPIN(cond, bar) do { unsigned _sp = 0; while (cond) { __builtin_amdgcn_s_sleep(1); \
    if ((++_sp & 255u) == 0u) { if (xb_ld(&(bar)[XB_TMO])) break; if (_sp > XB_SPIN_CAP) { atomicAdd(&(bar)[XB_TMO], 1u); break; } } } } while (0)
struct XcdBarrier { unsigned* bar; unsigned x; volatile LAS unsigned* st; };
__device__ __forceinline__ XcdBarrier xcd_barrier_post(unsigned* bar, volatile LAS unsigned* st, bool leader) {
    XcdBarrier b; b.bar = bar; b.x = xb_xcc_id(); b.st = st;
    if (leader) (void)xb_add(&bar[XB_XCNT(b.x)], 1u);
    return b;
}
__device__ __forceinline__ void xcd_barrier_complete(unsigned* bar, unsigned x, unsigned& nloc, unsigned& nx) {
    const unsigned G = gridDim.x * gridDim.y * gridDim.z;
    unsigned sum, cnt, mine, sp = 0u;
    for (;;) {
        sum = 0u; cnt = 0u; mine = 0u;
#pragma unroll
        for (unsigned j = 0; j < 16; ++j) { const unsigned c = xb_ld(&bar[XB_XCNT(j)]); sum += c; cnt += (c > 0u) ? 1u : 0u; mine = (j == x) ? c : mine; }
        if (sum == G) break;
        __builtin_amdgcn_s_sleep(1);
        if ((++sp & 255u) == 0u) { if (xb_ld(&bar[XB_TMO])) break; if (sp > XB_SPIN_CAP) { atomicAdd(&bar[XB_TMO], 1u); break; } }
    }
    nloc = mine > 0u ? mine : 1u; nx = cnt > 0u ? cnt : 1u;
}
__device__ __forceinline__ void xcd_barrier(const XcdBarrier& b, bool leader) {
    asm volatile("s_waitcnt vmcnt(0)" ::: "memory");
    __syncthreads();
    if (leader) {
        unsigned* bar = b.bar;
        __builtin_amdgcn_s_waitcnt(0);
        unsigned nloc = b.st[0], nx = b.st[1];
        if (nloc == 0u) { xcd_barrier_complete(bar, b.x, nloc, nx); b.st[0] = nloc; b.st[1] = nx; }
        const unsigned old = xb_add(&bar[XB_XSUB(b.x)], 1u);
        const unsigned gen = old / nloc;
        if (old + 1u == (gen + 1u) * nloc) {
            __builtin_amdgcn_fence(__ATOMIC_RELEASE, "agent");
            asm volatile("s_waitcnt vmcnt(0)" ::: "memory");
            const unsigned og = xb_add(&bar[XB_TOP], 1u);
            const unsigned tg = og / nx;
            if (og + 1u == (tg + 1u) * nx) xb_add(&bar[XB_TOPGEN], 1u);
            else XB_SPIN(xb_ld(&bar[XB_TOPGEN]) == tg, bar);
            __builtin_amdgcn_fence(__ATOMIC_ACQUIRE, "agent");
            xb_add(&bar[XB_XGEN(b.x)], 1u);
            asm volatile("s_waitcnt vmcnt(0)" ::: "memory");
        } else {
            XB_SPIN(xb_ld(&bar[XB_XGEN(b.x)]) == gen, bar);
            __builtin_amdgcn_fence(__ATOMIC_ACQUIRE, "agent");
            asm volatile("s_waitcnt vmcnt(0)" ::: "memory");
        }
    }
    __syncthreads();
}

struct Ctx { LAS unsigned char* lds; int tid, lane, wave, bid, nb, vcu; };
struct Args { const float* in[40]; float* out; unsigned char* ws; int ph_lo, ph_hi; };
enum { I_X = 0, I_C, I_CTX, I_CCTX, I_ADAW, I_ADAB, I_N1G, I_N2G, I_EVWIN, I_EVWOUT, I_QNORM, I_WUQ, I_KVNORM, I_WUKV, I_QG, I_KG, I_DWW, I_DWB, I_LNG, I_LNB,
       I_ODWIN, I_ODWOUT, I_SHIFTW, I_W0, I_W2L, I_A0, I_A2, I_G2, I_KKW, I_KA, I_RK, I_GNG, I_GNB, I_NAQG, I_NAKG, I_RPB, I_ROUTER, I_MW1, I_MW3, I_MW2 };

DI void transpose_item(const float* __restrict__ W, int K, int N, bf16* __restrict__ WT, int dst_row0, const float* __restrict__ gain, LAS float* scr, int k0, int n0, int lane) {
#pragma unroll 8
    for (int i = 0; i < 32; ++i) { const int kk = 2 * i + (lane >> 5); float v = W[(size_t)(k0 + kk) * N + n0 + (lane & 31)]; if (gain) v *= gain[k0 + kk]; scr[kk * 33 + (lane & 31)] = v; }
    asm volatile("s_waitcnt lgkmcnt(0)" ::: "memory");
    const int c = lane & 7;
#pragma unroll
    for (int j = 0; j < 4; ++j) { const int n = (lane >> 3) + 8 * j; const LAS float* s = scr + (8 * c) * 33 + n;
        u32x4 o; o.x = pk2(s[0 * 33], s[1 * 33]); o.y = pk2(s[2 * 33], s[3 * 33]); o.z = pk2(s[4 * 33], s[5 * 33]); o.w = pk2(s[6 * 33], s[7 * 33]);
        *(u32x4*)(WT + (size_t)(dst_row0 + n) * K + k0 + 8 * c) = o; }
    asm volatile("s_waitcnt lgkmcnt(0)" ::: "memory");
}
DI void transpose_item64(const float* __restrict__ W, int K, int N, bf16* __restrict__ WT, int dst_row0, LAS float* scr, int k0, int n0, int lane) {
    f32x4 v[16];
#pragma unroll
    for (int i = 0; i < 16; ++i) v[i] = *(const f32x4*)(W + (size_t)(k0 + 4 * i + (lane >> 4)) * N + n0 + 4 * (lane & 15));
#pragma unroll
    for (int i = 0; i < 16; ++i) { LAS float* d = scr + (4 * i + (lane >> 4)) * 65 + 4 * (lane & 15); d[0] = v[i].x; d[1] = v[i].y; d[2] = v[i].z; d[3] = v[i].w; }
    asm volatile("s_waitcnt lgkmcnt(0)" ::: "memory");
    const int c = lane & 7;
#pragma unroll
    for (int j = 0; j < 8; ++j) { const int n = (lane >> 3) + 8 * j; const LAS float* s = scr + (8 * c) * 65 + n;
        u32x4 o; o.x = pk2(s[0 * 65], s[1 * 65]); o.y = pk2(s[2 * 65], s[3 * 65]); o.z = pk2(s[4 * 65], s[5 * 65]); o.w = pk2(s[6 * 65], s[7 * 65]);
        *(u32x4*)(WT + (size_t)(dst_row0 + n) * K + k0 + 8 * c) = o; }
    asm volatile("s_waitcnt lgkmcnt(0)" ::: "memory");
}
DI void transpose_matrix(const Ctx& C, const float* W, int K, int N, bf16* WT, const float* gain, int mode  ) {
    LAS float* scr = (LAS float*)(C.lds + C.wave * 8704);
    const int nkb = K / 64, nnb = N / 32, nit = nkb * nnb, gw = C.vcu * 8 + C.wave, ngw = C.nb * 8;
    for (int it = gw; it < nit; it += ngw) {
        const int kb = it / nnb, nbk = it % nnb, n0 = nbk * 32;
        int d0 = n0; if (mode) d0 = (n0 >> 7) * 256 + (n0 & 127) + (mode == 2 ? 128 : 0);
        transpose_item(W, K, N, WT, d0, gain, scr, kb * 64, n0, C.lane);
    }
}
DI void moe_weight_prep(const Ctx& C, const float* w1, const float* w3, const float* w2, bf16* W13, bf16* W2) {
    LAS float* scr = (LAS float*)(C.lds + C.wave * 16640);
    const int gw = C.vcu * 8 + C.wave, ngw = C.nb * 8;
    constexpr int PER = 16 * 16;
    for (int it = gw; it < NEXP * 3 * PER; it += ngw) {
        const int e = it / (3 * PER), r = it % (3 * PER), which = r / PER, q = r % PER, kb = q / 16, n0 = (q % 16) * 64;
        if (which == 0)      transpose_item64(w1 + (size_t)e * DM * DM, DM, DM, W13 + (size_t)e * 2048 * DM, (n0 >> 7) * 256 + (n0 & 127), scr, kb * 64, n0, C.lane);
        else if (which == 1) transpose_item64(w3 + (size_t)e * DM * DM, DM, DM, W13 + (size_t)e * 2048 * DM, (n0 >> 7) * 256 + (n0 & 127) + 128, scr, kb * 64, n0, C.lane);
        else                 transpose_item64(w2 + (size_t)e * DM * DM, DM, DM, W2 + (size_t)e * DM * DM, n0, scr, kb * 64, n0, C.lane);
    }
}

DI void ph_prologue(const Ctx& C, const Args& a) {
    unsigned char* ws = a.ws;
    {
        LAS float* sv = (LAS float*)C.lds;
        LAS float* red = sv + 9 * 1024;
        for (int i = C.tid; i < 9 * 1024; i += 512) { const int m = i >> 10, k = i & 1023; const float c = (m < 8) ? a.in[I_C][m * 1024 + k] : a.in[I_CCTX][k]; sv[i] = siluf_(c); }
        __syncthreads();
        float* MOD = (float*)(ws + WS_MOD);
        for (int it = C.bid; it < 4 * 96; it += C.nb) {
            const int layer = it / 96, col = (it % 96) * 64 + C.lane;
            const float* wp = a.in[I_ADAW] + (size_t)layer * 1024 * 6144 + col;
            float acc[9];
#pragma unroll
            for (int m = 0; m < 9; ++m) acc[m] = 0.f;
            const int kb = C.wave * 128;
#pragma unroll 4
            for (int k = 0; k < 128; ++k) { const float w = wp[(size_t)(kb + k) * 6144];
#pragma unroll
                for (int m = 0; m < 9; ++m) acc[m] += sv[m * 1024 + kb + k] * w; }
#pragma unroll
            for (int m = 0; m < 9; ++m) red[(C.wave * 9 + m) * 64 + C.lane] = acc[m];
            __syncthreads();
            for (int i = C.tid; i < 576; i += 512) { const int m = i >> 6, l = i & 63; float s = 0.f;
#pragma unroll
                for (int w = 0; w < 8; ++w) s += red[(w * 9 + m) * 64 + l];
                const int cc = (it % 96) * 64 + l;
                MOD[(size_t)(layer * 9 + m) * 6144 + cc] = s + a.in[I_ADAB][layer * 6144 + cc]; }
            __syncthreads();
        }
    }
    {
        f32x2* CS = (f32x2*)(ws + WS_ROPE);
        for (int i = C.bid * 512 + C.tid; i < 4096 * 16; i += C.nb * 512) {
            const int pos = i >> 4, j = i & 15, f = j & 7;
            const float inv = powf(10000.f, -(float)(2 * f) / 16.f);
            const float ang = (float)((j < 8) ? (pos >> 6) : (pos & 63)) * inv;
            const double tw = 6.283185307179586476925;
            const double x = (double)ang, n = __builtin_rint(x / tw), rr = x - n * tw;
            CS[i] = (f32x2){__cosf((float)rr), __sinf((float)rr)};
        }
    }
    for (int j = 0; j < 2; ++j) {
        transpose_matrix(C, a.in[I_EVWIN] + (size_t)j * DM * EV_IN, DM, EV_IN, (bf16*)(ws + WS_WEVIN) + (size_t)j * EV_INP * DM, nullptr, 0);
        transpose_matrix(C, a.in[I_EVWOUT] + (size_t)j * DM * DM, DM, DM, (bf16*)(ws + WS_WEVOUT) + (size_t)j * DM * DM, nullptr, 0);
        transpose_matrix(C, a.in[I_WUQ] + (size_t)j * 384 * 768, 384, 768, (bf16*)(ws + WS_WUQ) + (size_t)j * 768 * 384, a.in[I_QNORM] + j * 384, 0);
        transpose_matrix(C, a.in[I_WUKV] + (size_t)j * 256 * 1024, 256, 1024, (bf16*)(ws + WS_WUKV) + (size_t)j * 1024 * 256, a.in[I_KVNORM] + j * 256, 0);
        transpose_matrix(C, a.in[I_ODWIN] + (size_t)j * DM * OD_IN, DM, OD_IN, (bf16*)(ws + WS_WODIN) + (size_t)j * OD_INP * DM, nullptr, 0);
        transpose_matrix(C, a.in[I_ODWOUT] + (size_t)j * DM * DM, DM, DM, (bf16*)(ws + WS_WODOUT) + (size_t)j * DM * DM, nullptr, 0);
    }
    {
        const int gt = C.bid * 512 + C.tid, ngt = C.nb * 512;
        for (int j = 0; j < 2; ++j) {
            u32x4* p0 = (u32x4*)((bf16*)(ws + WS_WEVIN) + (size_t)j * EV_INP * DM + (size_t)EV_IN * DM);
            for (int i = gt; i < (EV_INP - EV_IN) * DM / 8; i += ngt) p0[i] = (u32x4){0u, 0u, 0u, 0u};
            u32x4* p1 = (u32x4*)((bf16*)(ws + WS_WODIN) + (size_t)j * OD_INP * DM + (size_t)OD_IN * DM);
            for (int i = gt; i < (OD_INP - OD_IN) * DM / 8; i += ngt) p1[i] = (u32x4){0u, 0u, 0u, 0u};
            bf16* WL = (bf16*)(ws + WS_WLORA) + (size_t)j * 655360;
            const float* w2 = a.in[I_W2L] + (size_t)j * 2 * 64 * 512; const float* a2 = a.in[I_A2] + (size_t)j * 2 * 64 * 512; const float* g2 = a.in[I_G2] + (size_t)j * 128 * 512;
            for (int i = gt; i < 655360; i += ngt) {
                const int n = i >> 8, k = i & 255; float v = 0.f;
                if (n < 1024) { const int d = n >> 9, c = n & 511; if (k >= d * 64 && k < d * 64 + 64) v = w2[(size_t)k * 512 + c]; }
                else if (n < 2048) { const int d = (n - 1024) >> 9, c = n & 511; if (k >= 128 + d * 64 && k < 192 + d * 64) v = a2[(size_t)(k - 128) * 512 + c]; }
                else { const int c = n - 2048; if (k >= 128) v = g2[(size_t)(k - 128) * 512 + c]; }
                WL[i] = f2bf(v);
            }
        }
    }
}

template <bool ROUTER>
DI void ph_norm(const Ctx& C, const float* xlat, const float* xctx, const float* gain, const float* mod  , int shift_off, int scale_off, bf16* H,
                const float* router  , float* AFFT, float* AFFC, int* SLOT) {
    LAS float* RT = (LAS float*)C.lds;
    if (ROUTER) { for (int i = C.tid; i < 16384; i += 512) { const int c = i >> 4, e = i & 15; RT[e * 1024 + c] = router[i]; } __syncthreads(); }
    const int gw = C.bid * 8 + C.wave, ngw = C.nb * 8, lane = C.lane;
    for (int row = gw; row < MT; row += ngw) {
        const float* xr = row < NLAT ? xlat + (size_t)row * DM : xctx + (size_t)(row - NLAT) * DM;
        const int mi = row < NLAT ? (row >> 12) : 8;
        const float* mp = mod + mi * 6144;
        f32x4 v[4]; float ss = 0.f;
#pragma unroll
        for (int j = 0; j < 4; ++j) { v[j] = *(const f32x4*)(xr + 256 * j + 4 * lane); ss += v[j].x * v[j].x + v[j].y * v[j].y + v[j].z * v[j].z + v[j].w * v[j].w; }
        ss = wave_sum(ss);
        const float rs = 1.0f / sqrtf(ss * (1.f / 1024.f) + EPS);
#pragma unroll
        for (int j = 0; j < 4; ++j) {
            const int c = 256 * j + 4 * lane;
            const f32x4 g = *(const f32x4*)(gain + c), sc = *(const f32x4*)(mp + scale_off + c), sh = *(const f32x4*)(mp + shift_off + c);
            v[j] = (v[j] * rs) * g * (sc + 1.0f) + sh;
            *(u32x2*)(H + (size_t)row * DM + c) = (u32x2){pk2(v[j].x, v[j].y), pk2(v[j].z, v[j].w)};
        }
        if (ROUTER) {
            float mylg = 0.f;
#pragma unroll 1
            for (int e = 0; e < 16; ++e) { float p = 0.f;
#pragma unroll
                for (int j = 0; j < 4; ++j) { const f32x4 w = *(const LAS f32x4*)(RT + e * 1024 + 256 * j + 4 * lane); p += v[j].x * w.x + v[j].y * w.y + v[j].z * w.z + v[j].w * w.w; }
                p = wave_sum(p); mylg = (lane == e) ? p : mylg; }
            const float mx = max16(mylg);
            const float ex = expf(mylg - mx);
            const float mine = ex / sum16(ex);
            if (lane < 16) {
                if (row < NLAT) AFFT[(size_t)((row >> 12) * 16 + lane) * TL + (row & 4095)] = mine;
                else { const int rc = row - NLAT; AFFC[(size_t)((rc >> 8) * 16 + lane) * LCX + (rc & 255)] = mine; }
                SLOT[(size_t)row * 16 + lane] = -1;
            }
        }
    }
}

template <class Epi>
DI void gemm_unit(const bf16* __restrict__ A, int lda, const int* __restrict__ rows, const bf16* __restrict__ Bt, int K, int pm, int pn, const Epi& E, int wave, int lane) {
    const int wr = wave >> 2, wc = wave & 3, r = lane & 31, h = lane >> 5;
    const bf16* ap[2][2]; const bf16* bp[2];
#pragma unroll
    for (int ai = 0; ai < 2; ++ai)
#pragma unroll
        for (int mm = 0; mm < 2; ++mm) { const int lr = 256 * pm + 128 * ai + 64 * wr + 32 * mm + r; const int gr = rows ? rows[lr] : lr; ap[ai][mm] = A + (size_t)gr * lda + 8 * h; }
#pragma unroll
    for (int bj = 0; bj < 2; ++bj) bp[bj] = Bt + (size_t)(256 * pn + 128 * bj + 32 * wc + r) * K + 8 * h;
    f32x16 acc[2][2][2];
#pragma unroll
    for (int ai = 0; ai < 2; ++ai)
#pragma unroll
        for (int mm = 0; mm < 2; ++mm)
#pragma unroll
            for (int bj = 0; bj < 2; ++bj)
#pragma unroll
                for (int i = 0; i < 16; ++i) acc[ai][mm][bj][i] = 0.f;
#pragma unroll 2
    for (int k0 = 0; k0 < K; k0 += 16) {
        bf16x8 af[2][2], bfr[2];
#pragma unroll
        for (int ai = 0; ai < 2; ++ai)
#pragma unroll
            for (int mm = 0; mm < 2; ++mm) af[ai][mm] = *(const bf16x8*)(ap[ai][mm] + k0);
#pragma unroll
        for (int bj = 0; bj < 2; ++bj) bfr[bj] = *(const bf16x8*)(bp[bj] + k0);
#pragma unroll
        for (int ai = 0; ai < 2; ++ai)
#pragma unroll
            for (int mm = 0; mm < 2; ++mm)
#pragma unroll
                for (int bj = 0; bj < 2; ++bj) acc[ai][mm][bj] = MFMA32(bfr[bj], af[ai][mm], acc[ai][mm][bj]);
    }
#pragma unroll
    for (int ai = 0; ai < 2; ++ai)
#pragma unroll
        for (int mm = 0; mm < 2; ++mm) {
            const int row = 256 * pm + 128 * ai + 64 * wr + 32 * mm + r;
#pragma unroll
            for (int g = 0; g < 4; ++g) {
                const int col = 256 * pn + 32 * wc + 8 * g + 4 * h;
                const f32x4 v0 = {acc[ai][mm][0][4 * g], acc[ai][mm][0][4 * g + 1], acc[ai][mm][0][4 * g + 2], acc[ai][mm][0][4 * g + 3]};
                const f32x4 v1 = {acc[ai][mm][1][4 * g], acc[ai][mm][1][4 * g + 1], acc[ai][mm][1][4 * g + 2], acc[ai][mm][1][4 * g + 3]};
                E(row, col, v0, v1);
            }
        }
}
template <class Epi>
DI void gemm_phase(const Ctx& C, const bf16* A, int lda, const bf16* Bt, int K, int nM, int nN, const Epi& E) {
    for (int u = C.vcu; u < nM * nN; u += C.nb) gemm_unit(A, lda, nullptr, Bt, K, u / nN, u % nN, E, C.wave, C.lane);
}

struct EpiBf16 { bf16* O; int ldo;
    DI void operator()(int row, int col, f32x4 v0, f32x4 v1) const { bf16* p = O + (size_t)row * ldo + col;
        *(u32x2*)p = (u32x2){pk2(v0[0], v0[1]), pk2(v0[2], v0[3])}; *(u32x2*)(p + 128) = (u32x2){pk2(v1[0], v1[1]), pk2(v1[2], v1[3])}; } };
struct EpiF32 { float* O; int ldo;
    DI void operator()(int row, int col, f32x4 v0, f32x4 v1) const { float* p = O + (size_t)row * ldo + col; *(f32x4*)p = v0; *(f32x4*)(p + 128) = v1; } };
struct EpiResid { const float* xin_lat; const float* xin_ctx; float* xout_lat; float* xout_ctx; const float* modg;
    DI void operator()(int row, int col, f32x4 v0, f32x4 v1) const {
        const float* xi; float* xo; int mi;
        if (row < NLAT) { xi = xin_lat + (size_t)row * DM; xo = xout_lat + (size_t)row * DM; mi = row >> 12; }
        else { xi = xin_ctx + (size_t)(row - NLAT) * DM; xo = xout_ctx + (size_t)(row - NLAT) * DM; mi = 8; }
        const float* g = modg + mi * 6144 + col;
        const f32x4 g0 = *(const f32x4*)g, g1 = *(const f32x4*)(g + 128), x0 = *(const f32x4*)(xi + col), x1 = *(const f32x4*)(xi + col + 128);
        *(f32x4*)(xo + col) = x0 + g0 * v0; *(f32x4*)(xo + col + 128) = x1 + g1 * v1; } };
struct EpiGlu { bf16* O;
    DI void operator()(int row, int col, f32x4 v0, f32x4 v1) const { const int f = ((col & 2047) >> 8) * 128 + (col & 255);
        *(u32x2*)(O + (size_t)row * DM + f) = (u32x2){pk2(siluf_(v0[0]) * v1[0], siluf_(v0[1]) * v1[1]), pk2(siluf_(v0[2]) * v1[2], siluf_(v0[3]) * v1[3])}; } };
struct EpiGate { bf16* O; const float* gate;
    DI void operator()(int row, int col, f32x4 v0, f32x4 v1) const { const float g = gate[row]; bf16* p = O + (size_t)row * DM + (col & 1023);
        *(u32x2*)p = (u32x2){pk2(v0[0] * g, v0[1] * g), pk2(v0[2] * g, v0[3] * g)}; *(u32x2*)(p + 128) = (u32x2){pk2(v1[0] * g, v1[1] * g), pk2(v1[2] * g, v1[3] * g)}; } };
struct EpiLoraW { float* W; const float* w0;
    DI void one(int row, int col, f32x4 v) const { const int d = col >> 9, c = col & 511; f32x4 o;
#pragma unroll
        for (int e = 0; e < 4; ++e) { const float lw = w0[col + e] + v[e]; const float z = -lw; const float sp = fmaxf(z, 0.f) + __logf(1.f + __expf(-fabsf(z))); o[e] = __expf(-__expf(-sp - 0.5f)); }
        *(f32x4*)(W + ((size_t)d * MT + row) * 512 + c) = o; }
    DI void operator()(int row, int col, f32x4 v0, f32x4 v1) const { one(row, col, v0); one(row, col + 128, v1); } };
struct EpiLoraA { bf16* Aout; const float* a0;
    DI void one(int row, int col, f32x4 v) const { const int d = col >> 9, c = col & 511; const f32x4 b = *(const f32x4*)(a0 + col);
        *(u32x2*)(Aout + ((size_t)d * MT + row) * 512 + c) = (u32x2){pk2(sigmoidf_(b[0] + v[0]), sigmoidf_(b[1] + v[1])), pk2(sigmoidf_(b[2] + v[2]), sigmoidf_(b[3] + v[3]))}; }
    DI void operator()(int row, int col, f32x4 v0, f32x4 v1) const { one(row, col, v0); one(row, col + 128, v1); } };

namespace pg8 {
constexpr int BM = 256, BK = 64, HALF = 128, HTB = HALF * BK * 2, STAGE_BYTES = 8 * HTB;
DI int lds_byte(int r, int c) { const int st = (r >> 4) * 2 + (c >> 5), rr = r & 15, cc = c & 31, ob = rr * 64 + cc * 2; return st * 1024 + (ob ^ (((ob >> 9) & 1) << 5)); }
DI void stage_rc(int b, int& R, int& C) { const int st = b / 1024, sb = b % 1024, swz = sb ^ (((sb >> 9) & 1) << 5); R = (st >> 1) * 16 + swz / 64; C = (st & 1) * 32 + (swz % 64) / 2; }
DI int perm32(int rho) { const int n = rho >> 4, i = rho & 15; return 8 * (i >> 2) + 4 * n + (i & 3); }
struct Unit { int pm, pn; };
struct Gemm { const bf16* A; const bf16* Bt; int lda, K; const int* rows; };
struct OrderMN { int nM, nN, G, c;
    DI bool next(int i, Unit& u) const { const int L = i * G + c; if (L >= nM * nN) return false; u.pm = L / nN; u.pn = L % nN; return true; } };
struct OrderMoE { int nMt, nN, mstride  , G, c;
    DI bool next(int i, Unit& u) const { const int L = i * G + c, per = nMt * nN; if (L >= NEXP * per) return false; const int e = L / per, q = L % per; u.pm = e * mstride + q / nN; u.pn = e * nN + q % nN; return true; } };
template <class E4> struct EpiAdapt { E4 e;
    DI void operator()(const f32x4 (&acc)[2][2][4][2], const Unit& u, int wr, int wc, int fr, int fq) const {
#pragma unroll
        for (int ai = 0; ai < 2; ++ai)
#pragma unroll
            for (int m = 0; m < 4; ++m) { const int row = u.pm * BM + ai * HALF + wr * 64 + m * 16 + fr;
#pragma unroll
                for (int n = 0; n < 2; ++n) e(row, u.pn * BM + wc * 32 + 8 * fq + 4 * n, acc[ai][0][m][n], acc[ai][1][m][n]); } } };

template <class Epi, class Sched>
DI void gemm_phase(LAS unsigned char* lds, const Gemm g, const Sched& S, const Epi& E, const int tid) {
    const int wid = __builtin_amdgcn_readfirstlane(tid >> 6), lane = tid & 63, wr = wid >> 2, wc = wid & 3, fr = lane & 15, fq = lane >> 4;
    const int K = g.K, nt = K / BK;
    int RA[2], CA[2]; unsigned voffB[2];
#pragma unroll
    for (int i = 0; i < 2; ++i) { int R, C; stage_rc(tid * 16 + i * 8192, R, C); RA[i] = R; CA[i] = C; const int Rb = (R & ~31) + perm32(R & 31); voffB[i] = (unsigned)(Rb * K + C) * 2u; }
    const size_t kstep = (size_t)(BK * 2), hstep = (size_t)HALF * K * 2, tstep = 2 * hstep;
    const unsigned ldsw = (unsigned)wid * 1024u;
    const int aoff = lds_byte(wr * 64 + fr, fq * 8), boff = lds_byte(wc * 32 + fr, fq * 8);
    const char* const gA = (const char*)g.A;
#define PG8_SA(b, h) (((b) * 2 + (h)) * HTB)
#define PG8_SB(b, h) ((4 + (b) * 2 + (h)) * HTB)
#define PG8_STAGE(bufoff, gbase, voff) do { _Pragma("unroll") for (int _i = 0; _i < 2; ++_i) \
        __builtin_amdgcn_global_load_lds((const unsigned*)((const char*)(gbase) + (voff)[_i]), (LAS unsigned*)(lds + (bufoff) + ldsw + _i * 8192), 16, 0, 0); } while (0)
#define PG8_LDA(dst, b, h) do { _Pragma("unroll") for (int m = 0; m < 4; ++m) _Pragma("unroll") for (int k = 0; k < 2; ++k) dst[m][k] = *(const LAS bf16x8*)(lds + PG8_SA(b, h) + aoff + m * 2048 + k * 1024); } while (0)
#define PG8_LDB(dst, b, h) do { _Pragma("unroll") for (int n = 0; n < 2; ++n) _Pragma("unroll") for (int k = 0; k < 2; ++k) dst[n][k] = *(const LAS bf16x8*)(lds + PG8_SB(b, h) + boff + n * 2048 + k * 1024); } while (0)
#define PG8_MMA(ai, bj, At, Bt) do { __builtin_amdgcn_s_setprio(1); _Pragma("unroll") for (int m = 0; m < 4; ++m) _Pragma("unroll") for (int n = 0; n < 2; ++n) _Pragma("unroll") for (int k = 0; k < 2; ++k) \
        acc[ai][bj][m][n] = __builtin_amdgcn_mfma_f32_16x16x32_bf16(Bt[n][k], At[m][k], acc[ai][bj][m][n], 0, 0, 0); __builtin_amdgcn_s_setprio(0); } while (0)
#define PG8_WAIT_V(n) asm volatile("s_waitcnt vmcnt(" #n ")" ::: "memory")
#define PG8_WAIT_L(n) asm volatile("s_waitcnt lgkmcnt(" #n ")" ::: "memory")
#define PG8_BAR __builtin_amdgcn_s_barrier()
#define PG8_SCHED __builtin_amdgcn_sched_barrier(0)
#define PG8_AOFF(vo, u) do { _Pragma("unroll") for (int _h = 0; _h < 2; ++_h) _Pragma("unroll") for (int _i = 0; _i < 2; ++_i) { const int _lr = (u).pm * BM + _h * HALF + RA[_i]; \
        const int _gr = g.rows ? g.rows[_lr] : _lr; vo[_h][_i] = (unsigned)(((size_t)_gr * g.lda + CA[_i]) * 2u); } } while (0)
    Unit cur, nxt; int ui = 0;
    if (!S.next(0, cur)) return;
    f32x4 acc[2][2][4][2];
#pragma unroll
    for (int a = 0; a < 2; ++a)
#pragma unroll
        for (int b = 0; b < 2; ++b)
#pragma unroll
            for (int m = 0; m < 4; ++m)
#pragma unroll
                for (int n = 0; n < 2; ++n) acc[a][b][m][n] = (f32x4){0.f, 0.f, 0.f, 0.f};
    bf16x8 At[4][2], B0[2][2], B1[2][2];
    unsigned cvo[2][2], nvo[2][2];
    PG8_AOFF(cvo, cur);
    const char* cB = (const char*)g.Bt + (size_t)cur.pn * tstep;
    PG8_STAGE(PG8_SB(0, 0), cB, voffB); PG8_STAGE(PG8_SB(0, 1), cB + hstep, voffB); PG8_STAGE(PG8_SA(0, 0), gA, cvo[0]); PG8_STAGE(PG8_SA(0, 1), gA, cvo[1]);
    if (wr == 1) PG8_BAR;
    PG8_WAIT_V(2); PG8_BAR;
    PG8_STAGE(PG8_SB(1, 0), cB + kstep, voffB); PG8_STAGE(PG8_SA(1, 0), gA + kstep, cvo[0]); PG8_STAGE(PG8_SB(1, 1), cB + hstep + kstep, voffB);
    PG8_WAIT_V(6); PG8_BAR;
    for (;;) {
        const bool has_next = S.next(ui + 1, nxt);
        if (has_next) { PG8_AOFF(nvo, nxt); } else {
#pragma unroll
            for (int _h = 0; _h < 2; ++_h)
#pragma unroll
                for (int _i = 0; _i < 2; ++_i) nvo[_h][_i] = cvo[_h][_i]; }
        const char* nB = has_next ? (const char*)g.Bt + (size_t)nxt.pn * tstep : cB;
        for (int t = 0; t < nt; t += 2) {
            const bool last = (t == nt - 2);
            const char* a1 = gA + (size_t)(t + 1) * kstep;
            const char* a2 = last ? gA : gA + (size_t)(t + 2) * kstep; const char* b2 = last ? nB : cB + (size_t)(t + 2) * kstep;
            const char* a3 = a2 + kstep; const char* b3 = b2 + kstep;
            unsigned v20[2], v21[2];
#pragma unroll
            for (int _i = 0; _i < 2; ++_i) { v20[_i] = last ? nvo[0][_i] : cvo[0][_i]; v21[_i] = last ? nvo[1][_i] : cvo[1][_i]; }
            PG8_LDB(B0, 0, 0); PG8_LDB(B1, 0, 1); PG8_SCHED; PG8_LDA(At, 0, 0); PG8_STAGE(PG8_SA(1, 1), a1, cvo[1]);
            PG8_WAIT_V(8); PG8_WAIT_L(0); PG8_BAR; PG8_MMA(0, 0, At, B0); PG8_MMA(0, 1, At, B1); PG8_BAR; PG8_SCHED;
            PG8_LDA(At, 0, 1); PG8_STAGE(PG8_SB(0, 0), b2, voffB); PG8_STAGE(PG8_SB(0, 1), b2 + hstep, voffB); PG8_STAGE(PG8_SA(0, 0), a2, v20);
            PG8_WAIT_V(8); PG8_WAIT_L(0); PG8_BAR; PG8_MMA(1, 0, At, B0); PG8_MMA(1, 1, At, B1); PG8_BAR; PG8_SCHED;
            PG8_LDB(B0, 1, 0); PG8_LDB(B1, 1, 1); PG8_SCHED; PG8_LDA(At, 1, 0); PG8_STAGE(PG8_SA(0, 1), a2, v21);
            PG8_WAIT_V(8); PG8_WAIT_L(0); PG8_BAR; PG8_MMA(0, 0, At, B0); PG8_MMA(0, 1, At, B1); PG8_BAR; PG8_SCHED;
            PG8_LDA(At, 1, 1); PG8_STAGE(PG8_SB(1, 0), b3, voffB); PG8_STAGE(PG8_SB(1, 1), b3 + hstep, voffB); PG8_STAGE(PG8_SA(1, 0), a3, v20);
            PG8_WAIT_V(8); PG8_WAIT_L(0); PG8_BAR; PG8_MMA(1, 0, At, B0); PG8_MMA(1, 1, At, B1); PG8_BAR; PG8_SCHED;
        }
        if (wr == 0) PG8_BAR;
        E(acc, cur, wr, wc, fr, fq);
        if (!has_next) break;
#pragma unroll
        for (int a = 0; a < 2; ++a)
#pragma unroll
            for (int b = 0; b < 2; ++b)
#pragma unroll
                for (int m = 0; m < 4; ++m)
#pragma unroll
                    for (int n = 0; n < 2; ++n) acc[a][b][m][n] = (f32x4){0.f, 0.f, 0.f, 0.f};
        cur = nxt; cB = nB; ++ui;
#pragma unroll
        for (int _h = 0; _h < 2; ++_h)
#pragma unroll
            for (int _i = 0; _i < 2; ++_i) cvo[_h][_i] = nvo[_h][_i];
        if (wr == 1) PG8_BAR;
    }
    PG8_WAIT_V(0);
    PG8_BAR;
#undef PG8_SA
#undef PG8_SB
#undef PG8_STAGE
#undef PG8_LDA
#undef PG8_LDB
#undef PG8_MMA
#undef PG8_WAIT_V
#undef PG8_WAIT_L
#undef PG8_BAR
#undef PG8_SCHED
#undef PG8_AOFF
}
}
template <class E4> DI void fast_gemm(const Ctx& C, const bf16* A, int lda, const bf16* Bt, int K, int nM, int nN, const E4& e, bool rev = false) {
    pg8::Gemm g{A, Bt, lda, K, nullptr}; pg8::OrderMN S{nM, nN, C.nb, rev ? C.nb - 1 - C.vcu : C.vcu}; pg8::EpiAdapt<E4> E{e};
    pg8::gemm_phase(C.lds, g, S, E, C.tid);
}

DI int swap23(int x) { return (x & ~12) | ((x & 4) << 1) | ((x & 8) >> 1); }
template <int DQK, bool NAT>
DI void flash_range(f32x16 (&o)[2], float& m, float& l, const bf16x8 (&qf)[DQK / 16], const bf16* __restrict__ Kb, const bf16* __restrict__ Vt, int pos0, int nblk, int r, int h,
                    const LAS float* tab, int qc, int cs, int drow0) {
    const int kr = swap23(r);
    for (int blk = 0; blk < nblk; ++blk) {
        const int pos = pos0 + 32 * blk;
        f32x16 s;
#pragma unroll
        for (int i = 0; i < 16; ++i) s[i] = 0.f;
        const bf16* kp = Kb + (size_t)(pos + kr) * DQK + 8 * h;
#pragma unroll
        for (int kk = 0; kk < DQK / 16; ++kk) s = MFMA32(*(const bf16x8*)(kp + 16 * kk), qf[kk], s);
        if (NAT) {
            const int irow = blk >> 1, cc0 = (blk & 1) * 32;
            const LAS float* trow = tab + (drow0 + irow) * 31;
#pragma unroll
            for (int i = 0; i < 16; ++i) {
                const int kib = (i & 3) | (((i >> 2) & 1) << 2) | (h << 3) | ((i >> 3) << 4);
                const int cc = cc0 + kib; const bool ok = (cc >= cs) && (cc < cs + 16);
                int dc = cc - qc + 15; dc = dc < 0 ? 0 : (dc > 30 ? 30 : dc);
                s[i] = ok ? s[i] + trow[dc] : -1e30f;
            }
        }
        float mx = s[0];
#pragma unroll
        for (int i = 1; i < 16; ++i) mx = fmaxf(mx, s[i]);
        mx = fmaxf(mx, xor32(mx, r + 32 * h));
        const float mn = fmaxf(m, mx), alpha = __builtin_amdgcn_exp2f(m - mn);
        float rs = 0.f; f32x16 p;
#pragma unroll
        for (int i = 0; i < 16; ++i) { float e = __builtin_amdgcn_exp2f(s[i] - mn); if (NAT) e = (s[i] > -1e29f) ? e : 0.f; p[i] = e; rs += e; }
        rs += xor32(rs, r + 32 * h);
        l = l * alpha + rs; m = mn;
#pragma unroll
        for (int i = 0; i < 16; ++i) { o[0][i] *= alpha; o[1][i] *= alpha; }
#pragma unroll
        for (int s2 = 0; s2 < 2; ++s2) {
            u32x4 pw; pw.x = pk2(p[8 * s2], p[8 * s2 + 1]); pw.y = pk2(p[8 * s2 + 2], p[8 * s2 + 3]); pw.z = pk2(p[8 * s2 + 4], p[8 * s2 + 5]); pw.w = pk2(p[8 * s2 + 6], p[8 * s2 + 7]);
            const bf16x8 pb = __builtin_bit_cast(bf16x8, pw);
#pragma unroll
            for (int dt = 0; dt < 2; ++dt) { const bf16x8 va = *(const bf16x8*)(Vt + (size_t)(32 * dt + r) * KPOS + pos + 16 * s2 + 8 * h); o[dt] = MFMA32(va, pb, o[dt]); }
        }
    }
}
DI void flash_store(const f32x16 (&o)[2], float l, bf16* orow  , int h) {
    const float inv = 1.f / l;
#pragma unroll
    for (int dt = 0; dt < 2; ++dt)
#pragma unroll
        for (int g = 0; g < 4; ++g)
            *(u32x2*)(orow + 32 * dt + 8 * g + 4 * h) = (u32x2){pk2(o[dt][4 * g] * inv, o[dt][4 * g + 1] * inv), pk2(o[dt][4 * g + 2] * inv, o[dt][4 * g + 3] * inv)};
}

DI void ph_attn_mla(const Ctx& C, const bf16* QB, const bf16* KB, const bf16* VT, bf16* OCAT, bool last) {
    const int r = C.lane & 31, h = C.lane >> 5;
    for (int u = C.vcu; u < 64 * 17; u += C.nb) {
        const int bh = u / 17, qblk = u % 17, b = bh >> 3, hh = bh & 7;
        if (last && qblk == 16) continue;
        const int qpos = qblk * 256 + 32 * C.wave + r;
        const bf16* qp = QB + ((size_t)bh * KPOS + qpos) * 96 + 8 * h;
        bf16x8 qf[6];
#pragma unroll
        for (int kk = 0; kk < 6; ++kk) qf[kk] = *(const bf16x8*)(qp + 16 * kk);
        f32x16 o[2];
#pragma unroll
        for (int i = 0; i < 16; ++i) { o[0][i] = 0.f; o[1][i] = 0.f; }
        float m = -1e30f, l = 0.f;
        flash_range<96, false>(o, m, l, qf, KB + (size_t)bh * KPOS * 96, VT + (size_t)bh * 64 * KPOS, qblk < 16 ? 0 : TL, qblk < 16 ? KPOS / 32 : LCX / 32, r, h, nullptr, 0, 0, 0);
        const int row = qblk < 16 ? b * TL + qpos : NLAT + b * LCX + (qpos - TL);
        flash_store(o, l, OCAT + (size_t)row * DM + hh * 64, h);
    }
}

template <int DQK> struct AttnGeo { static constexpr int KSTR = DQK * 2 + 16, KBYTES = 64 * KSTR, VSTR = 144, VBYTES = 64 * VSTR, BUF = KBYTES + VBYTES, KPIECES = 64 * DQK / 8; };
template <int DQK, bool NAT>
DI void attn_tile_loop(const Ctx& C, f32x16 (&o)[2], float& l, const bf16x8 (&qf)[DQK / 16], const bf16* __restrict__ Kb, const bf16* __restrict__ Vt, int pos1, int n1, int pos2, int n2,
                       const LAS float* tab, int grow, int rs, int qc, int cs) {
    typedef AttnGeo<DQK> G;
    const int tid = C.tid, r = C.lane & 31, h = C.lane >> 5, kr = swap23(r), ntiles = n1 + n2;
    constexpr bool K2 = G::KPIECES > 512;
    const int kq0 = tid, kq1 = tid + 512;
    const int kl0 = (kq0 / (DQK / 8)) * G::KSTR + (kq0 % (DQK / 8)) * 16, kl1 = (kq1 / (DQK / 8)) * G::KSTR + (kq1 % (DQK / 8)) * 16;
    const int vl = G::KBYTES + (tid >> 3) * G::VSTR + (tid & 7) * 16;
    const bf16* vg = Vt + (size_t)(tid >> 3) * KPOS + 8 * (tid & 7);
    u32x4 rk0, rk1, rv;
    rk1 = (u32x4){0u, 0u, 0u, 0u};
#define ATT_POS(t) ((t) < n1 ? pos1 + 64 * (t) : pos2 + 64 * ((t) - n1))
    { const int pos0 = ATT_POS(0); rk0 = *(const u32x4*)(Kb + (size_t)pos0 * DQK + 8 * kq0); if (K2 && tid < 256) rk1 = *(const u32x4*)(Kb + (size_t)pos0 * DQK + 8 * kq1); rv = *(const u32x4*)(vg + pos0); }
    __syncthreads();
    *(LAS u32x4*)(C.lds + kl0) = rk0; if (K2 && tid < 256) *(LAS u32x4*)(C.lds + kl1) = rk1; *(LAS u32x4*)(C.lds + vl) = rv;
    __syncthreads();
    float mref = 0.f; bool first = true;
    constexpr float THR = 8.f;
    for (int t = 0; t < ntiles; ++t) {
        const LAS unsigned char* B = C.lds + (t & 1) * G::BUF;
        if (t + 1 < ntiles) { const int pos0 = ATT_POS(t + 1);
            rk0 = *(const u32x4*)(Kb + (size_t)pos0 * DQK + 8 * kq0); if (K2 && tid < 256) rk1 = *(const u32x4*)(Kb + (size_t)pos0 * DQK + 8 * kq1); rv = *(const u32x4*)(vg + pos0); }
        const int gr = (pos1 >> 6) + t;
        const bool active = !NAT || t >= n1 || (gr >= rs && gr < rs + 8);
        if (active) {
            f32x16 sc[2];
#pragma unroll
            for (int j = 0; j < 2; ++j) {
#pragma unroll
                for (int i = 0; i < 16; ++i) sc[j][i] = -mref;
                const LAS unsigned char* kp = B + (32 * j + kr) * G::KSTR + 16 * h;
#pragma unroll
                for (int kk = 0; kk < DQK / 16; ++kk) sc[j] = MFMA32(*(const LAS bf16x8*)(kp + 32 * kk), qf[kk], sc[j]);
            }
            if (NAT && t < n1) {
                const LAS float* trow = tab + (gr - grow + 7) * 31;
#pragma unroll
                for (int j = 0; j < 2; ++j)
#pragma unroll
                    for (int i = 0; i < 16; ++i) {
                        const int cc = 32 * j + ((i & 3) | (((i >> 2) & 1) << 2) | (h << 3) | ((i >> 3) << 4)); const bool ok = (cc >= cs) && (cc < cs + 16);
                        int dc = cc - qc + 15; dc = dc < 0 ? 0 : (dc > 30 ? 30 : dc);
                        sc[j][i] = ok ? sc[j][i] + trow[dc] : -1e30f;
                    }
            }
            float mx = fmaxf(sc[0][0], sc[1][0]);
#pragma unroll
            for (int i = 1; i < 16; ++i) mx = fmaxf(mx, fmaxf(sc[0][i], sc[1][i]));
            mx = fmaxf(mx, xor32(mx, C.lane));
            if (first || __builtin_amdgcn_ballot_w64(mx > THR) != 0ull) {
                const float delta = first ? mx : fmaxf(mx, 0.f);
#pragma unroll
                for (int i = 0; i < 16; ++i) { sc[0][i] -= delta; sc[1][i] -= delta; }
                if (!first) { const float alpha = __builtin_amdgcn_exp2f(-delta); l *= alpha;
#pragma unroll
                    for (int i = 0; i < 16; ++i) { o[0][i] *= alpha; o[1][i] *= alpha; } }
                mref += delta; first = false;
            }
            f32x2 rs2 = {0.f, 0.f};
#pragma unroll
            for (int j = 0; j < 2; ++j)
#pragma unroll
                for (int i = 0; i < 16; i += 2) { sc[j][i] = __builtin_amdgcn_exp2f(sc[j][i]); sc[j][i + 1] = __builtin_amdgcn_exp2f(sc[j][i + 1]); rs2 += (f32x2){sc[j][i], sc[j][i + 1]}; }
            float rsum = rs2.x + rs2.y;
            rsum += xor32(rsum, C.lane);
            l += rsum;
#pragma unroll
            for (int j = 0; j < 2; ++j)
#pragma unroll
                for (int s2 = 0; s2 < 2; ++s2) {
                    u32x4 pw; pw.x = pk2(sc[j][8 * s2], sc[j][8 * s2 + 1]); pw.y = pk2(sc[j][8 * s2 + 2], sc[j][8 * s2 + 3]); pw.z = pk2(sc[j][8 * s2 + 4], sc[j][8 * s2 + 5]); pw.w = pk2(sc[j][8 * s2 + 6], sc[j][8 * s2 + 7]);
                    const bf16x8 pb = __builtin_bit_cast(bf16x8, pw);
#pragma unroll
                    for (int dt = 0; dt < 2; ++dt) o[dt] = MFMA32(*(const LAS bf16x8*)(B + G::KBYTES + (32 * dt + r) * G::VSTR + (32 * j + 16 * s2 + 8 * h) * 2), pb, o[dt]);
                }
        }
        if (t + 1 < ntiles) { LAS unsigned char* Bn = C.lds + ((t + 1) & 1) * G::BUF;
            *(LAS u32x4*)(Bn + kl0) = rk0; if (K2 && tid < 256) *(LAS u32x4*)(Bn + kl1) = rk1; *(LAS u32x4*)(Bn + vl) = rv; }
        __syncthreads();
    }
#undef ATT_POS
}
DI void ph_attn_mla2(const Ctx& C, const bf16* QB, const bf16* KB, const bf16* VT, bf16* OCAT, bool last) {
    const int r = C.lane & 31, h = C.lane >> 5;
    const int nunits = 1024 + (last ? 0 : 64);
    for (int u = C.vcu; u < nunits; u += C.nb) {
        const int bh = u < 1024 ? (u >> 4) : u - 1024, qblk = u < 1024 ? (u & 15) : 16, b = bh >> 3, hh = bh & 7;
        const int qpos = qblk * 256 + 32 * C.wave + r;
        const bf16* qp = QB + ((size_t)bh * KPOS + qpos) * 96 + 8 * h;
        bf16x8 qf[6];
#pragma unroll
        for (int kk = 0; kk < 6; ++kk) qf[kk] = *(const bf16x8*)(qp + 16 * kk);
        f32x16 o[2];
#pragma unroll
        for (int i = 0; i < 16; ++i) { o[0][i] = 0.f; o[1][i] = 0.f; }
        float l = 0.f;
        attn_tile_loop<96, false>(C, o, l, qf, KB + (size_t)bh * KPOS * 96, VT + (size_t)bh * 64 * KPOS, qblk < 16 ? 0 : TL, qblk < 16 ? KPOS / 64 : LCX / 64, 0, 0, nullptr, 0, 0, 0, 0);
        const int row = qblk < 16 ? b * TL + qpos : NLAT + b * LCX + (qpos - TL);
        flash_store(o, l, OCAT + (size_t)row * DM + hh * 64, h);
    }
}

DI void ph_natten2(const Ctx& C, const bf16* QN, const bf16* KN, const bf16* VTN, bf16* OCAT, const float* rpb  , bool last) {
    const int r = C.lane & 31, h = C.lane >> 5;
    LAS float* tab = (LAS float*)(C.lds + 2 * AttnGeo<64>::BUF);
    const int nunits = 1024 + (last ? 0 : 64);
    for (int u = C.vcu; u < nunits; u += C.nb) {
        const bool isctx = u >= 1024;
        const int bh = isctx ? u - 1024 : (u >> 4), b = bh >> 3, hh = bh & 7;
        __syncthreads();
        for (int i = C.tid; i < 465; i += 512) tab[i] = rpb[hh * 465 + i] * LOG2E;
        int qpos, row, grow = 0, qc = 0, rs = 0, cs = 0, rlo = 0, nband = 0;
        if (!isctx) { const int rg = u & 15; grow = 4 * rg + (C.wave >> 1); qc = 32 * (C.wave & 1) + r; qpos = grow * 64 + qc; row = b * TL + qpos;
            rs = grow - 4; rs = rs < 0 ? 0 : (rs > 56 ? 56 : rs); cs = qc - 8; cs = cs < 0 ? 0 : (cs > 48 ? 48 : cs);
            rlo = 4 * rg - 4; rlo = rlo < 0 ? 0 : (rlo > 56 ? 56 : rlo); int rhi = 4 * rg + 3 - 4; rhi = rhi < 0 ? 0 : (rhi > 56 ? 56 : rhi); nband = rhi + 8 - rlo; }
        else { qpos = TL + 32 * C.wave + r; row = NLAT + b * LCX + 32 * C.wave + r; }
        const bf16* qp = QN + ((size_t)bh * KPOS + qpos) * 64 + 8 * h;
        bf16x8 qf[4];
#pragma unroll
        for (int kk = 0; kk < 4; ++kk) qf[kk] = *(const bf16x8*)(qp + 16 * kk);
        f32x16 o[2];
#pragma unroll
        for (int i = 0; i < 16; ++i) { o[0][i] = 0.f; o[1][i] = 0.f; }
        float l = 0.f;
        attn_tile_loop<64, true>(C, o, l, qf, KN + (size_t)bh * KPOS * 64, VTN + (size_t)bh * 64 * KPOS, rlo * 64, nband, TL, LCX / 64, tab, grow, rs, qc, cs);
        flash_store(o, l, OCAT + (size_t)row * DM + 512 + hh * 64, h);
    }
}

DI void ph_natten(const Ctx& C, const bf16* QN, const bf16* KN, const bf16* VTN, bf16* OCAT, const float* rpb  , bool last) {
    const int r = C.lane & 31, h = C.lane >> 5;
    LAS float* tab = (LAS float*)C.lds;
    const int nunits = 1024 + (last ? 0 : 64);
    for (int u = C.vcu; u < nunits; u += C.nb) {
        const bool isctx = u >= 1024;
        const int bh = isctx ? u - 1024 : (u >> 4), b = bh >> 3, hh = bh & 7;
        __syncthreads();
        for (int i = C.tid; i < 465; i += 512) tab[i] = rpb[hh * 465 + i] * LOG2E;
        __syncthreads();
        int qpos, row, grow = 0, qc = 0, rs = 0, cs = 0;
        if (!isctx) { const int rg = u & 15; grow = 4 * rg + (C.wave >> 1); qc = 32 * (C.wave & 1) + r; qpos = grow * 64 + qc; row = b * TL + qpos;
            rs = grow - 4; rs = rs < 0 ? 0 : (rs > 56 ? 56 : rs); cs = qc - 8; cs = cs < 0 ? 0 : (cs > 48 ? 48 : cs); }
        else { qpos = TL + 32 * C.wave + r; row = NLAT + b * LCX + 32 * C.wave + r; }
        const bf16* qp = QN + ((size_t)bh * KPOS + qpos) * 64 + 8 * h;
        bf16x8 qf[4];
#pragma unroll
        for (int kk = 0; kk < 4; ++kk) qf[kk] = *(const bf16x8*)(qp + 16 * kk);
        f32x16 o[2];
#pragma unroll
        for (int i = 0; i < 16; ++i) { o[0][i] = 0.f; o[1][i] = 0.f; }
        float m = -1e30f, l = 0.f;
        const bf16* Kb = KN + (size_t)bh * KPOS * 64; const bf16* Vt = VTN + (size_t)bh * 64 * KPOS;
        if (!isctx) flash_range<64, true>(o, m, l, qf, Kb, Vt, rs * 64, 16, r, h, tab, qc, cs, rs - grow + 7);
        flash_range<64, false>(o, m, l, qf, Kb, Vt, TL, LCX / 32, r, h, nullptr, 0, 0, 0);
        flash_store(o, l, OCAT + (size_t)row * DM + 512 + hh * 64, h);
    }
}

DI void ph_mla_fin(const Ctx& C, const bf16* U, const float* QPRE, const float* KVPRE, const float* qg, const float* kg, const f32x2* CS, bf16* QB, bf16* KB, bf16* VT) {
    LAS bf16* VL = (LAS bf16*)C.lds;
    const int lane = C.lane, j = lane >> 3, sub = lane & 7;
    const float C2 = 0.10206207261596575f * LOG2E;
    float qgn[8], qgr[4], kgn[8], kgr[4];
#pragma unroll
    for (int e = 0; e < 8; ++e) { qgn[e] = qg[8 * sub + e] * C2; kgn[e] = kg[8 * sub + e]; }
#pragma unroll
    for (int m = 0; m < 4; ++m) { qgr[m] = qg[64 + sub + 8 * m] * C2; kgr[m] = kg[64 + sub + 8 * m]; }
    for (int u = C.vcu; u < MT / 64; u += C.nb) {
        const int row0 = 64 * u, b = row0 < NLAT ? (row0 >> 12) : ((row0 - NLAT) >> 8), pos0 = row0 < NLAT ? (row0 & 4095) : TL + ((row0 - NLAT) & 255);
        const bool lat = row0 < NLAT;
        const int pl = 8 * C.wave + j, row = row0 + pl, pos = pos0 + pl;
        const bf16* ur = U + (size_t)row * EV_INP;
        float sq = 0.f, skv = 0.f;
#pragma unroll
        for (int m = 0; m < 6; ++m) { float x[8]; unpack8(*(const u32x4*)(ur + 8 * (sub + 8 * m)), x);
#pragma unroll
            for (int e = 0; e < 8; ++e) sq += x[e] * x[e]; }
#pragma unroll
        for (int m = 0; m < 4; ++m) { float x[8]; unpack8(*(const u32x4*)(ur + 384 + 8 * (sub + 8 * m)), x);
#pragma unroll
            for (int e = 0; e < 8; ++e) skv += x[e] * x[e]; }
        sq = sum8(sq); skv = sum8(skv);
        const float rsq = 1.0f / sqrtf(sq * (1.f / 384.f) + EPS), rskv = 1.0f / sqrtf(skv * (1.f / 256.f) + EPS);
        float krv[4];
#pragma unroll
        for (int m = 0; m < 4; ++m) krv[m] = bf2f(ur[640 + sub + 8 * m]);
        float cr = 1.f, sr = 0.f, cc = 1.f, sc = 0.f;
        if (lat) { const f32x2 a0 = CS[pos * 16 + sub], a1 = CS[pos * 16 + 8 + sub]; cr = a0.x; sr = a0.y; cc = a1.x; sc = a1.y; }
        const float* qrow = QPRE + (size_t)row * 768; const float* kvrow = KVPRE + (size_t)row * 1024;
#pragma unroll 2
        for (int hh = 0; hh < 8; ++hh) {
            { const f32x4 n0 = *(const f32x4*)(qrow + hh * 96 + 8 * sub), n1 = *(const f32x4*)(qrow + hh * 96 + 8 * sub + 4);
              float qn[8] = {n0.x * rsq, n0.y * rsq, n0.z * rsq, n0.w * rsq, n1.x * rsq, n1.y * rsq, n1.z * rsq, n1.w * rsq}, qr[4]; float ss = 0.f;
#pragma unroll
              for (int m = 0; m < 4; ++m) { qr[m] = qrow[hh * 96 + 64 + sub + 8 * m] * rsq; ss += qr[m] * qr[m]; }
#pragma unroll
              for (int e = 0; e < 8; ++e) ss += qn[e] * qn[e];
              const float rn = 1.0f / sqrtf(sum8(ss) * (1.f / 96.f) + EPS);
#pragma unroll
              for (int e = 0; e < 8; ++e) qn[e] *= rn * qgn[e];
#pragma unroll
              for (int m = 0; m < 4; ++m) qr[m] *= rn * qgr[m];
              { const float x0 = qr[0], x1 = qr[1], y0 = qr[2], y1 = qr[3]; qr[0] = x0 * cr - x1 * sr; qr[1] = x1 * cr + x0 * sr; qr[2] = y0 * cc - y1 * sc; qr[3] = y1 * cc + y0 * sc; }
              bf16* qo = QB + ((size_t)(b * 8 + hh) * KPOS + pos) * 96;
              *(u32x4*)(qo + 8 * sub) = pack8(qn);
#pragma unroll
              for (int m = 0; m < 4; ++m) qo[64 + sub + 8 * m] = f2bf(qr[m]); }
            { const f32x4 n0 = *(const f32x4*)(kvrow + hh * 128 + 8 * sub), n1 = *(const f32x4*)(kvrow + hh * 128 + 8 * sub + 4);
              float kn[8] = {n0.x * rskv, n0.y * rskv, n0.z * rskv, n0.w * rskv, n1.x * rskv, n1.y * rskv, n1.z * rskv, n1.w * rskv}, kr[4]; float ss = 0.f;
#pragma unroll
              for (int m = 0; m < 4; ++m) { kr[m] = krv[m]; ss += kr[m] * kr[m]; }
#pragma unroll
              for (int e = 0; e < 8; ++e) ss += kn[e] * kn[e];
              const float rn = 1.0f / sqrtf(sum8(ss) * (1.f / 96.f) + EPS);
#pragma unroll
              for (int e = 0; e < 8; ++e) kn[e] *= rn * kgn[e];
#pragma unroll
              for (int m = 0; m < 4; ++m) kr[m] *= rn * kgr[m];
              { const float x0 = kr[0], x1 = kr[1], y0 = kr[2], y1 = kr[3]; kr[0] = x0 * cr - x1 * sr; kr[1] = x1 * cr + x0 * sr; kr[2] = y0 * cc - y1 * sc; kr[3] = y1 * cc + y0 * sc; }
              bf16* ko = KB + ((size_t)(b * 8 + hh) * KPOS + pos) * 96;
              *(u32x4*)(ko + 8 * sub) = pack8(kn);
#pragma unroll
              for (int m = 0; m < 4; ++m) ko[64 + sub + 8 * m] = f2bf(kr[m]); }
            { const f32x4 v0 = *(const f32x4*)(kvrow + hh * 128 + 64 + 8 * sub), v1 = *(const f32x4*)(kvrow + hh * 128 + 64 + 8 * sub + 4);
              const float vv[8] = {v0.x, v0.y, v0.z, v0.w, v1.x, v1.y, v1.z, v1.w};
#pragma unroll
              for (int e = 0; e < 8; ++e) VL[(hh * 64 + 8 * sub + e) * 64 + pl] = f2bf(vv[e] * rskv); }
        }
        __syncthreads();
        { const int hd = C.tid;
            bf16* dst = VT + ((size_t)(b * 8 + (hd >> 6)) * 64 + (hd & 63)) * KPOS + pos0;
#pragma unroll
            for (int q = 0; q < 8; ++q) *(u32x4*)(dst + 8 * q) = *(const LAS u32x4*)(VL + hd * 64 + 8 * q); }
        __syncthreads();
    }
}

DI void ph_conv(const Ctx& C, const bf16* U, const float* dww  , const float* dwb, const float* lng, const float* lnb, bf16* OCAT) {
    LAS float* G = (LAS float*)C.lds;
    const int c = C.tid;
    float wk[31];
#pragma unroll
    for (int k = 0; k < 31; ++k) wk[k] = dww[k * 512 + c];
    const float bias = dwb[c];
    for (int u = C.nb - 1 - C.vcu; u < MT / 32; u += C.nb) {
        const int row0 = 32 * u; int base, t0, tseq;
        if (row0 < NLAT) { base = row0 & ~4095; t0 = row0 & 4095; tseq = TL; } else { const int rc = row0 - NLAT; base = NLAT + (rc & ~255); t0 = rc & 255; tseq = LCX; }
        __syncthreads();
        for (int rr = C.wave; rr < 62; rr += 8) { const int tt = t0 - 15 + rr; float g[8];
#pragma unroll
            for (int e = 0; e < 8; ++e) g[e] = 0.f;
            if (tt >= 0 && tt < tseq) { const bf16* ur = U + (size_t)(base + tt) * EV_INP; float av[8], gv[8]; unpack8(*(const u32x4*)(ur + 672 + 8 * C.lane), av); unpack8(*(const u32x4*)(ur + 1184 + 8 * C.lane), gv);
#pragma unroll
                for (int e = 0; e < 8; ++e) g[e] = av[e] * sigmoidf_(gv[e]); }
            *(LAS f32x4*)(G + rr * 512 + 8 * C.lane) = (f32x4){g[0], g[1], g[2], g[3]}; *(LAS f32x4*)(G + rr * 512 + 8 * C.lane + 4) = (f32x4){g[4], g[5], g[6], g[7]}; }
        __syncthreads();
        float acc[32];
#pragma unroll
        for (int t = 0; t < 32; ++t) acc[t] = bias;
#pragma unroll
        for (int rr = 0; rr < 62; ++rr) { const float gv = G[rr * 512 + c];
#pragma unroll
            for (int t = 0; t < 32; ++t) { const int k = rr - t; if (k >= 0 && k < 31) acc[t] += gv * wk[k]; } }
        __syncthreads();
#pragma unroll
        for (int t = 0; t < 32; ++t) G[t * 512 + c] = acc[t];
        __syncthreads();
#pragma unroll
        for (int q = 0; q < 4; ++q) {
            const int t = 4 * C.wave + q, row = row0 + t;
            const f32x4 a0 = *(const LAS f32x4*)(G + t * 512 + 8 * C.lane), a1 = *(const LAS f32x4*)(G + t * 512 + 8 * C.lane + 4);
            float x[8] = {a0.x, a0.y, a0.z, a0.w, a1.x, a1.y, a1.z, a1.w}; float s = 0.f;
#pragma unroll
            for (int e = 0; e < 8; ++e) s += x[e];
            const float mu = wave_sum(s) * (1.f / 512.f); float s2 = 0.f;
#pragma unroll
            for (int e = 0; e < 8; ++e) { x[e] -= mu; s2 += x[e] * x[e]; }
            const float rstd = 1.0f / sqrtf(wave_sum(s2) * (1.f / 512.f) + EPS);
            float y[8];
#pragma unroll
            for (int e = 0; e < 8; ++e) { const float z = x[e] * rstd * lng[8 * C.lane + e] + lnb[8 * C.lane + e]; y[e] = siluf_(z); }
            *(u32x4*)(OCAT + (size_t)row * DM + 512 + 8 * C.lane) = pack8(y);
        }
    }
}

DI void shifted8(const bf16* up, const bf16* uc, const bf16* un, bool hp, bool hn, const float* sw, int c0, float (&o)[8]) {
    const u32x4 z = {0u, 0u, 0u, 0u};
    const u32x4 vp = hp ? *(const u32x4*)(up + c0) : z, vc = *(const u32x4*)(uc + c0), vn = hn ? *(const u32x4*)(un + c0) : z;
    float p[8], c[8], n[8]; unpack8(vp, p); unpack8(vc, c); unpack8(vn, n);
#pragma unroll
    for (int e = 0; e < 8; ++e) o[e] = p[e] * sw[c0 + e] + c[e] * sw[RW_IN + c0 + e] + n[e] * sw[2 * RW_IN + c0 + e];
}
DI void ph_prep(const Ctx& C, const bf16* U, const float* sw  , const float* kkw  , const float* naqg, const float* nakg,
                bf16* R, bf16* V, bf16* K, bf16* KK, bf16* L, bf16* QN, bf16* KN, bf16* VTN) {
    LAS bf16* VL = (LAS bf16*)C.lds;
    const int lane = C.lane, hh = lane >> 3, sub = lane & 7;
    const float C2 = 0.125f * LOG2E;
    for (int u = C.vcu; u < MT / 32; u += C.nb) {
        const int row0 = 32 * u; const bool lat = row0 < NLAT;
        const int b = lat ? (row0 >> 12) : ((row0 - NLAT) >> 8), pos0 = lat ? (row0 & 4095) : TL + ((row0 - NLAT) & 255), tseq = lat ? TL : LCX, tb = lat ? (row0 & 4095) : ((row0 - NLAT) & 255);
        for (int i = 0; i < 4; ++i) {
            const int pl = 4 * C.wave + i, row = row0 + pl, pos = pos0 + pl, t = tb + pl;
            const bool hp = t > 0, hn = t < tseq - 1;
            const bf16* uc = U + (size_t)row * OD_INP; const bf16* up = uc - OD_INP; const bf16* un = uc + OD_INP;
            float o[8];
            shifted8(up, uc, un, hp, hn, sw, 8 * lane, o);          *(u32x4*)(R + (size_t)row * 512 + 8 * lane) = pack8(o);
            shifted8(up, uc, un, hp, hn, sw, 1024 + 8 * lane, o);   *(u32x4*)(V + (size_t)row * 512 + 8 * lane) = pack8(o);
            shifted8(up, uc, un, hp, hn, sw, 512 + 8 * lane, o);    *(u32x4*)(K + (size_t)row * 512 + 8 * lane) = pack8(o);
            { float kk[8]; float ss = 0.f;
#pragma unroll
                for (int e = 0; e < 8; ++e) { kk[e] = o[e] * kkw[8 * lane + e]; ss += kk[e] * kk[e]; }
                ss = sum8(ss); const float rn = 1.0f / sqrtf(ss + 1e-12f);
#pragma unroll
                for (int e = 0; e < 8; ++e) kk[e] *= rn;
                *(u32x4*)(KK + (size_t)row * 512 + 8 * lane) = pack8(kk); }
            if (lane < 48) {
                shifted8(up, uc, un, hp, hn, sw, 1536 + 8 * lane, o);
                if (lane < 16) {
#pragma unroll
                    for (int e = 0; e < 8; ++e) { const float ex = __expf(2.f * o[e]); o[e] = 1.f - 2.f / (ex + 1.f); }
                } else if (lane >= 32) {
#pragma unroll
                    for (int e = 0; e < 8; ++e) o[e] = sigmoidf_(o[e]);
                }
                *(u32x4*)(L + (size_t)row * 384 + 8 * lane) = pack8(o);
            }
            { float x[8]; unpack8(*(const u32x4*)(uc + RW_IN + 8 * lane), x); float ss = 0.f;
#pragma unroll
                for (int e = 0; e < 8; ++e) ss += x[e] * x[e];
                ss = sum8(ss); const float rn = 1.0f / sqrtf(ss * (1.f / 64.f) + EPS);
#pragma unroll
                for (int e = 0; e < 8; ++e) x[e] = x[e] * rn * naqg[8 * sub + e] * C2;
                *(u32x4*)(QN + ((size_t)(b * 8 + hh) * KPOS + pos) * 64 + 8 * sub) = pack8(x); }
            { float x[8]; unpack8(*(const u32x4*)(uc + RW_IN + 512 + 8 * lane), x); float ss = 0.f;
#pragma unroll
                for (int e = 0; e < 8; ++e) ss += x[e] * x[e];
                ss = sum8(ss); const float rn = 1.0f / sqrtf(ss * (1.f / 64.f) + EPS);
#pragma unroll
                for (int e = 0; e < 8; ++e) x[e] = x[e] * rn * nakg[8 * sub + e];
                *(u32x4*)(KN + ((size_t)(b * 8 + hh) * KPOS + pos) * 64 + 8 * sub) = pack8(x); }
            { const u32x4 vv = *(const u32x4*)(uc + RW_IN + 1024 + 8 * lane); const unsigned w4[4] = {vv.x, vv.y, vv.z, vv.w};
#pragma unroll
                for (int e = 0; e < 8; ++e) { const int dv = 8 * sub + e; VL[(hh * 64 + dv) * 32 + pl] = (bf16)((e & 1) ? (w4[e >> 1] >> 16) : (w4[e >> 1] & 0xffffu)); } }
        }
        __syncthreads();
        { const int hd = C.tid; bf16* dst = VTN + ((size_t)(b * 8 + (hd >> 6)) * 64 + (hd & 63)) * KPOS + pos0;
#pragma unroll
            for (int q = 0; q < 4; ++q) *(u32x4*)(dst + 8 * q) = *(const LAS u32x4*)(VL + hd * 32 + 8 * q); }
        __syncthreads();
    }
}

DI int scan_row(int s, int d, int b) { if (s < LCX) return NLAT + b * LCX + (d ? (LCX - 1 - s) : s); const int t = s - LCX; return b * TL + (d ? (TL - 1 - t) : t); }
DI void ph_scan(const Ctx& C, const bf16* R, const bf16* V, const bf16* KK, const float* W, const bf16* KEFF, const bf16* BSC, float* YS) {
    constexpr int CH = 32, BUF = 5 * CH * 64 + CH * 32;
    LAS float* lds = (LAS float*)C.lds;
    LAS float* ystage = lds + 2 * BUF;
    const int tid = C.tid, i = tid >> 4, kq = tid & 15;
    for (int cid = C.bid; cid < 256; cid += C.nb) {
        const int b = cid >> 5, hh = (cid >> 2) & 7, d = (cid >> 1) & 1, hf = cid & 1;
        const float* Wd = W + (size_t)d * MT * 512; const bf16* KEd = KEFF + (size_t)d * MT * 512; const bf16* BSd = BSC + (size_t)d * MT * 512; float* Yd = YS + (size_t)d * MT * 512;
        float S[4] = {0.f, 0.f, 0.f, 0.f};
        const int sl = tid >> 4, sub = tid & 15;
        f32x4 lw; u32x4 l1, l2, l3;
        auto issue = [&](int ck) {
            const int row = scan_row(ck * CH + sl, d, b);
            lw = *(const f32x4*)(Wd + (size_t)row * 512 + hh * 64 + 4 * sub);
            if (sub < 8) { l1 = *(const u32x4*)(R + (size_t)row * 512 + hh * 64 + 8 * sub); l2 = *(const u32x4*)(KEd + (size_t)row * 512 + hh * 64 + 8 * sub); }
            else { l1 = *(const u32x4*)(KK + (size_t)row * 512 + hh * 64 + 8 * (sub - 8)); l2 = *(const u32x4*)(BSd + (size_t)row * 512 + hh * 64 + 8 * (sub - 8)); }
            if (sub < 4) l3 = *(const u32x4*)(V + (size_t)row * 512 + hh * 64 + 32 * hf + 8 * sub);
        };
        auto commit = [&](int bufi) {
            LAS float* B = lds + bufi * BUF;
            *(LAS f32x4*)(B + (1 * CH + sl) * 64 + 4 * sub) = lw;
            float f1[8], f2[8]; unpack8(l1, f1); unpack8(l2, f2);
            const int a1 = sub < 8 ? 0 : 3, a2 = sub < 8 ? 2 : 4, off = 8 * (sub & 7);
            *(LAS f32x4*)(B + (a1 * CH + sl) * 64 + off) = (f32x4){f1[0], f1[1], f1[2], f1[3]}; *(LAS f32x4*)(B + (a1 * CH + sl) * 64 + off + 4) = (f32x4){f1[4], f1[5], f1[6], f1[7]};
            *(LAS f32x4*)(B + (a2 * CH + sl) * 64 + off) = (f32x4){f2[0], f2[1], f2[2], f2[3]}; *(LAS f32x4*)(B + (a2 * CH + sl) * 64 + off + 4) = (f32x4){f2[4], f2[5], f2[6], f2[7]};
            if (sub < 4) { float f3[8]; unpack8(l3, f3); LAS float* vp = B + 5 * CH * 64 + sl * 32 + 8 * sub;
                *(LAS f32x4*)vp = (f32x4){f3[0], f3[1], f3[2], f3[3]}; *(LAS f32x4*)(vp + 4) = (f32x4){f3[4], f3[5], f3[6], f3[7]}; }
        };
        __syncthreads();
        issue(0); commit(0);
        __syncthreads();
        constexpr int NCK = KPOS / CH;
        for (int ck = 0; ck < NCK; ++ck) {
            if (ck + 1 < NCK) issue(ck + 1);
            const LAS float* B = lds + (ck & 1) * BUF; LAS float* ys = ystage + (ck & 1) * CH * 32;
#pragma unroll 4
            for (int s = 0; s < CH; ++s) {
                const f32x4 rr = *(const LAS f32x4*)(B + (0 * CH + s) * 64 + 4 * kq), ww = *(const LAS f32x4*)(B + (1 * CH + s) * 64 + 4 * kq), ke = *(const LAS f32x4*)(B + (2 * CH + s) * 64 + 4 * kq),
                            kk = *(const LAS f32x4*)(B + (3 * CH + s) * 64 + 4 * kq), bs = *(const LAS f32x4*)(B + (4 * CH + s) * 64 + 4 * kq);
                const float v = B[5 * CH * 64 + s * 32 + i];
                float sa = -(S[0] * kk.x + S[1] * kk.y + S[2] * kk.z + S[3] * kk.w);
                sa = sum16(sa);
                S[0] = S[0] * ww.x + (sa * bs.x + v * ke.x); S[1] = S[1] * ww.y + (sa * bs.y + v * ke.y); S[2] = S[2] * ww.z + (sa * bs.z + v * ke.z); S[3] = S[3] * ww.w + (sa * bs.w + v * ke.w);
                float y = S[0] * rr.x + S[1] * rr.y + S[2] * rr.z + S[3] * rr.w;
                y = sum16(y);
                if (kq == 0) ys[s * 32 + i] = y;
            }
            if (ck + 1 < NCK) commit((ck + 1) & 1);
            __syncthreads();
            if (tid < 256) { const int s = tid >> 3, q = tid & 7; const int row = scan_row(ck * CH + s, d, b);
                *(f32x4*)(Yd + (size_t)row * 512 + hh * 64 + 32 * hf + 4 * q) = *(const LAS f32x4*)(ys + s * 32 + 4 * q); }
        }
    }
}


DI void ph_scan2(const Ctx& C, const bf16* R, const bf16* V, const bf16* K, const bf16* KK, const float* W, const bf16* AR_  , const float* ka, float* YS) {
    constexpr int CH = 16, BUF = 5 * CH * 64 + CH * 32, NCK = KPOS / CH, DEPTH = 4, YP = CH * 32 * 16;
    static_assert(NCK % DEPTH == 0, "chunk loop is unrolled by DEPTH");
    LAS float* lds = (LAS float*)C.lds;
    LAS float* ypart = lds + 2 * BUF;
    const bool comp = C.wave < 4;
    const int rp = 4 * (C.wave & 3) + (C.lane >> 4), kq = C.lane & 15, lt = C.tid - 256;
    for (int cid0 = C.bid; cid0 < 256; cid0 += C.nb) {
        const int hf = (cid0 >> 3) & 1, chain = (cid0 & 7) | ((cid0 >> 4) << 3), b = chain >> 4, hh = (chain >> 1) & 7, d = chain & 1;
        const float* Wd = W + (size_t)d * MT * 512; const bf16* Ad = AR_ + (size_t)d * MT * 512; float* Yd = YS + (size_t)d * MT * 512;
        u32x4 reg[DEPTH][4];
        float kav[8];
#pragma unroll
        for (int e = 0; e < 8; ++e) kav[e] = ka[hh * 64 + 8 * (lt & 7) + e];
        auto issue = [&](int ck, u32x4 (&rg)[4]) {
            { const size_t base = (size_t)scan_row(ck * CH + (lt >> 4), d, b) * 512 + hh * 64; rg[0] = *(const u32x4*)(Wd + base + 4 * (lt & 15)); }
            rg[1] = (u32x4){0u, 0u, 0u, 0u};
            if (lt < 128) { const size_t base = (size_t)scan_row(ck * CH + (lt >> 3), d, b) * 512 + hh * 64; rg[1] = *(const u32x4*)(R + base + 8 * (lt & 7)); }
            else if (lt < 192) { const int x = lt - 128; const size_t base = (size_t)scan_row(ck * CH + (x >> 2), d, b) * 512 + hh * 64; rg[1] = *(const u32x4*)(V + base + 32 * hf + 8 * (x & 3)); }
            { const size_t base = (size_t)scan_row(ck * CH + ((lt & 127) >> 3), d, b) * 512 + hh * 64 + 8 * (lt & 7); rg[2] = *(const u32x4*)((lt < 128 ? K : KK) + base); rg[3] = *(const u32x4*)(Ad + base); }
        };
        auto commit = [&](int bufi, const u32x4 (&rg)[4]) {
            LAS float* B = lds + bufi * BUF;
            *(LAS u32x4*)(B + (1 * CH + (lt >> 4)) * 64 + 4 * (lt & 15)) = rg[0];
            if (lt < 192) { float f[8]; unpack8(rg[1], f); LAS float* dst = lt < 128 ? B + (0 * CH + (lt >> 3)) * 64 + 8 * (lt & 7) : B + 5 * CH * 64 + ((lt - 128) >> 2) * 32 + 8 * ((lt - 128) & 3);
                *(LAS f32x4*)dst = (f32x4){f[0], f[1], f[2], f[3]}; *(LAS f32x4*)(dst + 4) = (f32x4){f[4], f[5], f[6], f[7]}; }
            { float x[8], av[8]; unpack8(rg[2], x); unpack8(rg[3], av); const int sl = (lt & 127) >> 3, pc = lt & 7;
                if (lt < 128) {
#pragma unroll
                    for (int e = 0; e < 8; ++e) x[e] = x[e] * (1.f + (av[e] - 1.f) * kav[e]);
                    LAS float* dst = B + (2 * CH + sl) * 64 + 8 * pc; *(LAS f32x4*)dst = (f32x4){x[0], x[1], x[2], x[3]}; *(LAS f32x4*)(dst + 4) = (f32x4){x[4], x[5], x[6], x[7]};
                } else {
                    LAS float* dk = B + (3 * CH + sl) * 64 + 8 * pc; *(LAS f32x4*)dk = (f32x4){x[0], x[1], x[2], x[3]}; *(LAS f32x4*)(dk + 4) = (f32x4){x[4], x[5], x[6], x[7]};
#pragma unroll
                    for (int e = 0; e < 8; ++e) x[e] *= av[e];
                    LAS float* db = B + (4 * CH + sl) * 64 + 8 * pc; *(LAS f32x4*)db = (f32x4){x[0], x[1], x[2], x[3]}; *(LAS f32x4*)(db + 4) = (f32x4){x[4], x[5], x[6], x[7]};
                } }
        };
        auto y_reduce = [&](int ck) {
            const LAS float* yp = ypart + (ck & 1) * YP + lt * 32;
            float y[2];
#pragma unroll
            for (int j = 0; j < 2; ++j) { const f32x4 a0 = *(const LAS f32x4*)(yp + 16 * j), a1 = *(const LAS f32x4*)(yp + 16 * j + 4), a2 = *(const LAS f32x4*)(yp + 16 * j + 8), a3 = *(const LAS f32x4*)(yp + 16 * j + 12);
                y[j] = (((a0.x + a0.y) + (a0.z + a0.w)) + ((a1.x + a1.y) + (a1.z + a1.w))) + (((a2.x + a2.y) + (a2.z + a2.w)) + ((a3.x + a3.y) + (a3.z + a3.w))); }
            const int row = scan_row(ck * CH + (lt >> 4), d, b);
            *(f32x2*)(Yd + (size_t)row * 512 + hh * 64 + 32 * hf + 2 * (lt & 15)) = (f32x2){y[0], y[1]};
        };
        f32x2 S[2][2];
#pragma unroll
        for (int j = 0; j < 2; ++j) { S[j][0] = (f32x2){0.f, 0.f}; S[j][1] = (f32x2){0.f, 0.f}; }
        __syncthreads();
        if (!comp) { issue(0, reg[0]); commit(0, reg[0]);
#pragma unroll
            for (int k = 1; k < DEPTH; ++k) issue(k, reg[k]); }
        __syncthreads();
        for (int ck0 = 0; ck0 < NCK; ck0 += DEPTH) {
#pragma unroll
            for (int kk = 0; kk < DEPTH; ++kk) {
                const int ck = ck0 + kk;
                if (comp) {
                    const LAS float* B = lds + (ck & 1) * BUF + 4 * kq; const LAS float* vb = lds + (ck & 1) * BUF + 5 * CH * 64 + 2 * rp; LAS float* yq = ypart + (ck & 1) * YP + (2 * rp) * 16 + kq;
                    f32x4 op[2][5]; f32x2 vv[2];
#define SCAN_LOAD(set, sI) do { const LAS float* bp_ = B + (sI) * 64; _Pragma("unroll") for (int a_ = 0; a_ < 5; ++a_) op[set][a_] = *(const LAS f32x4*)(bp_ + a_ * CH * 64); vv[set] = *(const LAS f32x2*)(vb + (sI) * 32); } while (0)
#define SCAN_ROW(set, sI, j, vj) do { f32x2 acc = S[j][0] * (f32x2){op[set][3].x, op[set][3].y}; acc = __builtin_elementwise_fma(S[j][1], (f32x2){op[set][3].z, op[set][3].w}, acc); \
                        const float sa = sum16(-(acc.x + acc.y)); const f32x2 sa2 = {sa, sa}, v2 = {vj, vj}; \
                        S[j][0] = __builtin_elementwise_fma(S[j][0], (f32x2){op[set][1].x, op[set][1].y}, __builtin_elementwise_fma(sa2, (f32x2){op[set][4].x, op[set][4].y}, v2 * (f32x2){op[set][2].x, op[set][2].y})); \
                        S[j][1] = __builtin_elementwise_fma(S[j][1], (f32x2){op[set][1].z, op[set][1].w}, __builtin_elementwise_fma(sa2, (f32x2){op[set][4].z, op[set][4].w}, v2 * (f32x2){op[set][2].z, op[set][2].w})); \
                        const f32x2 ya = __builtin_elementwise_fma(S[j][1], (f32x2){op[set][0].z, op[set][0].w}, S[j][0] * (f32x2){op[set][0].x, op[set][0].y}); \
                        yq[(sI) * 512 + (j) * 16] = ya.x + ya.y; } while (0)
#define SCAN_STEP(set, sI) do { SCAN_ROW(set, sI, 0, vv[set].x); SCAN_ROW(set, sI, 1, vv[set].y); } while (0)
                    SCAN_LOAD(0, 0);
#pragma unroll
                    for (int sI = 0; sI < CH; sI += 2) {
                        SCAN_LOAD(1, sI + 1);
                        SCAN_STEP(0, sI);
                        if (sI + 2 < CH) SCAN_LOAD(0, sI + 2);
                        SCAN_STEP(1, sI + 1);
                    }
#undef SCAN_LOAD
#undef SCAN_ROW
#undef SCAN_STEP
                } else {
                    if (ck + 1 < NCK) commit((ck + 1) & 1, reg[(kk + 1) % DEPTH]);
                    if (ck + DEPTH < NCK) issue(ck + DEPTH, reg[kk]);
                    if (ck > 0) y_reduce(ck - 1);
                }
                __syncthreads();
            }
        }
        if (!comp) y_reduce(NCK - 1);
    }
}

DI void ph_post(const Ctx& C, const float* YS, const bf16* R, const bf16* V, const bf16* K, const bf16* A2, const float* ka, const bf16* G, const float* rk, const float* gng, const float* gnb, bf16* OCAT, bool last) {
    const int gw = C.bid * 8 + C.wave, ngw = C.nb * 8, lane = C.lane, nrows = last ? NLAT : MT;
    for (int row = gw; row < nrows; row += ngw) {
        const size_t o = (size_t)row * 512 + 8 * lane;
        const f32x4 y0a = *(const f32x4*)(YS + o), y0b = *(const f32x4*)(YS + o + 4), y1a = *(const f32x4*)(YS + (size_t)MT * 512 + o), y1b = *(const f32x4*)(YS + (size_t)MT * 512 + o + 4);
        float y[8] = {y0a.x + y1a.x, y0a.y + y1a.y, y0a.z + y1a.z, y0a.w + y1a.w, y0b.x + y1b.x, y0b.y + y1b.y, y0b.z + y1b.z, y0b.w + y1b.w};
        float r[8], v[8], kx[8], a0[8], a1[8], g[8];
        unpack8(*(const u32x4*)(R + o), r); unpack8(*(const u32x4*)(V + o), v); unpack8(*(const u32x4*)(K + o), kx); unpack8(*(const u32x4*)(A2 + o), a0); unpack8(*(const u32x4*)(A2 + (size_t)MT * 512 + o), a1); unpack8(*(const u32x4*)(G + o), g);
        float bsum = 0.f;
#pragma unroll
        for (int e = 0; e < 8; ++e) { const float kae = ka[8 * lane + e]; bsum += r[e] * (kx[e] * (1.f + (a0[e] - 1.f) * kae) + kx[e] * (1.f + (a1[e] - 1.f) * kae)) * rk[8 * lane + e]; }
        bsum = sum8(bsum);
        float s = 0.f;
#pragma unroll
        for (int e = 0; e < 8; ++e) { y[e] += bsum * v[e]; s += y[e]; }
        const float mu = sum8(s) * (1.f / 64.f); float s2 = 0.f;
#pragma unroll
        for (int e = 0; e < 8; ++e) { y[e] -= mu; s2 += y[e] * y[e]; }
        const float rstd = 1.0f / sqrtf(sum8(s2) * (1.f / 64.f) + GN_EPS);
        float out[8];
#pragma unroll
        for (int e = 0; e < 8; ++e) out[e] = (y[e] * rstd * gng[8 * lane + e] + gnb[8 * lane + e]) * g[e];
        *(u32x4*)(OCAT + (size_t)row * DM + 8 * lane) = pack8(out);
    }
}

DI void ph_topk(const Ctx& C, const float* AFFT, const float* AFFC, int* ROWS, float* GATE, int* SLOT, bool last) {
    LAS unsigned long long* key = (LAS unsigned long long*)C.lds;
    const int nprob = last ? 128 : 256;
    for (int p = C.bid; p < nprob; p += C.nb) {
        const bool isctx = p >= 128; const int be = p & 127, b = be >> 4, e = be & 15;
        const int n = isctx ? LCX : TL, cap = isctx ? CAPC : CAPL;
        const float* src = isctx ? AFFC + (size_t)be * LCX : AFFT + (size_t)be * TL;
        __syncthreads();
        for (int t = C.tid; t < n; t += 512) key[t] = ((unsigned long long)__builtin_bit_cast(unsigned, src[t]) << 32) | (unsigned long long)(0xFFFFFFFFu - (unsigned)t);
        __syncthreads();
        for (int k = 2; k <= n; k <<= 1)
            for (int j = k >> 1; j > 0; j >>= 1) {
                for (int q = C.tid; q < n / 2; q += 512) {
                    const int i = ((q & ~(j - 1)) << 1) | (q & (j - 1)), ix = i | j;
                    const unsigned long long a = key[i], bb = key[ix];
                    const bool desc = ((i & k) == 0);
                    if (desc ? (a < bb) : (a > bb)) { key[i] = bb; key[ix] = a; }
                }
                __syncthreads();
            }
        for (int jx = C.tid; jx < cap; jx += 512) {
            const unsigned long long kv = key[jx]; const int t = (int)(0xFFFFFFFFu - (unsigned)(kv & 0xFFFFFFFFull)); const float g = __builtin_bit_cast(float, (unsigned)(kv >> 32));
            const int slot = isctx ? NB * CAPL + b * CAPC + jx : b * CAPL + jx, row = isctx ? NLAT + b * LCX + t : b * TL + t;
            ROWS[e * ESLOTS + slot] = row; GATE[e * ESLOTS + slot] = g; SLOT[(size_t)row * 16 + e] = slot;
        }
    }
}

DI void ph_combine(const Ctx& C, float* xlat, float* xctx, const float* modg2  , const int* SLOT, const bf16* Y2, bool last,
                   const float* ngain  , const float* nmod  , bf16* H) {
    const int gw = C.bid * 8 + C.wave, ngw = C.nb * 8, lane = C.lane, nrows = last ? NLAT : MT;
    for (int row = gw; row < nrows; row += ngw) {
        float* xr = row < NLAT ? xlat + (size_t)row * DM : xctx + (size_t)(row - NLAT) * DM;
        const int mi = row < NLAT ? (row >> 12) : 8;
        const int sv = SLOT[(size_t)row * 16 + (lane & 15)];
        f32x4 acc[4];
#pragma unroll
        for (int j = 0; j < 4; ++j) acc[j] = (f32x4){0.f, 0.f, 0.f, 0.f};
#pragma unroll
        for (int e = 0; e < 16; ++e) {
            const int s = __builtin_amdgcn_readlane(sv, e);
            if (s >= 0) { const bf16* yp = Y2 + ((size_t)e * ESLOTS + s) * DM + 4 * lane;
#pragma unroll
                for (int j = 0; j < 4; ++j) { const u32x2 w = *(const u32x2*)(yp + 256 * j); acc[j] += (f32x4){bflo(w.x), bfhi(w.x), bflo(w.y), bfhi(w.y)}; } }
        }
#pragma unroll
        for (int j = 0; j < 4; ++j) { const int c = 256 * j + 4 * lane; const f32x4 g = *(const f32x4*)(modg2 + mi * 6144 + c); f32x4 x = *(const f32x4*)(xr + c); x += g * acc[j]; *(f32x4*)(xr + c) = x; acc[j] = x; }
        if (ngain) {
            float ss = 0.f;
#pragma unroll
            for (int j = 0; j < 4; ++j) ss += acc[j].x * acc[j].x + acc[j].y * acc[j].y + acc[j].z * acc[j].z + acc[j].w * acc[j].w;
            const float rs = 1.0f / sqrtf(wave_sum(ss) * (1.f / 1024.f) + EPS);
            const float* mp = nmod + mi * 6144;
#pragma unroll
            for (int j = 0; j < 4; ++j) { const int c = 256 * j + 4 * lane;
                const f32x4 g = *(const f32x4*)(ngain + c), sc = *(const f32x4*)(mp + 1024 + c), sh = *(const f32x4*)(mp + c);
                const f32x4 hv = (acc[j] * rs) * g * (sc + 1.0f) + sh;
                *(u32x2*)(H + (size_t)row * DM + c) = (u32x2){pk2(hv.x, hv.y), pk2(hv.z, hv.w)}; }
        }
    }
}

template <int N> struct IC { static constexpr int value = N; };
DI const float* in_ptr(const unsigned char* ws, int k) { const unsigned long long v = ((const unsigned long long*)(ws + 128 * 1024))[k];
    const unsigned lo = __builtin_amdgcn_readfirstlane((unsigned)v), hi = __builtin_amdgcn_readfirstlane((unsigned)(v >> 32));
    return (const float*)(__attribute__((address_space(1))) const float*)(((unsigned long long)hi << 32) | lo); }
template <class T> DI T* launder_ptr(T* p) { unsigned long long v = (unsigned long long)p; unsigned lo = (unsigned)v, hi = (unsigned)(v >> 32); asm volatile("" : "+v"(lo), "+v"(hi));
    lo = __builtin_amdgcn_readfirstlane(lo); hi = __builtin_amdgcn_readfirstlane(hi); return (T*)(__attribute__((address_space(1))) T*)(((unsigned long long)hi << 32) | lo); }
constexpr int N_PHASES = 1 + 23 + 22;
constexpr size_t WS_PTRS = 128 * 1024;
#define P_XC    ((float*)(ws + WS_XC))
#define P_MOD   ((const float*)(ws + WS_MOD))
#define P_HB    ((bf16*)(ws + WS_HB))
#define P_OCAT  ((bf16*)(ws + WS_OCAT))
#define P_AR    (ws + WS_ARENA)
#define P_ROWS  ((int*)(ws + WS_ROWS))
#define P_GATE  ((float*)(ws + WS_GATE))
#define P_SLOT  ((int*)(ws + WS_SLOT))
#define P_AFFT  ((float*)(ws + WS_AFFT))
#define P_AFFC  ((float*)(ws + WS_AFFC))
#define P_W13   ((bf16*)(ws + WS_W13))
#define P_W2    ((bf16*)(ws + WS_W2))
#define P_U     ((bf16*)(P_AR + A_U))
#define P_QPRE  ((float*)(P_AR + A_QPRE))
#define P_KVPRE ((float*)(P_AR + A_KVPRE))
#define P_QB    ((bf16*)(P_AR + A_QB))
#define P_KB    ((bf16*)(P_AR + A_KB))
#define P_VT    ((bf16*)(P_AR + A_VT))
#define P_W     ((float*)(P_AR + A_W))
#define P_KEFF  ((bf16*)(P_AR + A_KEFF))
#define P_R     ((bf16*)(P_AR + A_R))
#define P_V     ((bf16*)(P_AR + A_V))
#define P_KK    ((bf16*)(P_AR + A_KK))
#define P_G     ((bf16*)(P_AR + A_G))
#define P_K     ((bf16*)(P_AR + A_K))
#define P_L     ((bf16*)(P_AR + A_L))
#define P_QN    ((bf16*)(P_AR + A_QN))
#define P_KN    ((bf16*)(P_AR + A_KN))
#define P_VTN   ((bf16*)(P_AR + A_VTN))
#define P_YS    ((float*)(P_AR + A_YS))
#define P_HID   ((bf16*)(P_AR + A_HID))
#define P_Y2    ((bf16*)(P_AR + A_Y2))
#define MODL(i) (P_MOD + (size_t)(i) * 9 * 6144)
#define RELAUNDER() do { int l_ = C.lane; asm volatile("" : "+v"(l_)); C.lane = l_; C.tid = (C.wave << 6) | l_; } while (0)
__global__ void __launch_bounds__(512, 2) fwd_kernel(Args a) {
    extern __shared__ __attribute__((aligned(16))) unsigned char smem[];
    Ctx C0; C0.lds = (LAS unsigned char*)smem; C0.tid = threadIdx.x; C0.lane = C0.tid & 63; C0.wave = __builtin_amdgcn_readfirstlane(C0.tid >> 6); C0.bid = blockIdx.x; C0.nb = gridDim.x;
    C0.vcu = (C0.nb % 8 == 0) ? (C0.bid % 8) * (C0.nb / 8) + C0.bid / 8 : C0.bid;
    volatile LAS unsigned* bst = (volatile LAS unsigned*)(C0.lds + LDS_BYTES - 16);
#if MEGA
    if (C0.tid == 0) { bst[0] = 0u; bst[1] = 0u; }
    __syncthreads();
    const unsigned bar_x = xcd_barrier_post((unsigned*)(a.ws + WS_CTL) + 4096, bst, C0.tid == 0).x;
#define SEAM() do { if (ph < hi) { XcdBarrier b2_; b2_.bar = (unsigned*)(ws + WS_CTL) + 4096; b2_.x = bar_x; b2_.st = bst; xcd_barrier(b2_, C.tid == 0); } } while (0)
#else
#define SEAM() do { } while (0)
#endif
#if MEGA
    constexpr int lo = 0, hi = N_PHASES;
#else
    const int lo = a.ph_lo, hi = a.ph_hi;
#endif
    int ph = 0;
#ifndef ONLY
#define ONLY -1
#endif
#ifndef REPMASK
#define REPMASK 0
#endif
#ifndef SITE_LO
#define SITE_LO 0
#define SITE_HI 99
#endif
#define PHASE(SITE, ...) do { if ((ONLY < 0 || ONLY == (SITE)) && (SITE) >= SITE_LO && (SITE) <= SITE_HI && ph >= lo && ph < hi) { Ctx C; C.lds = C0.lds; \
        { int w_ = C0.wave; asm volatile("" : "+s"(w_)); unsigned m_ = ~0u; asm volatile("" : "+s"(m_)); int l_ = (int)__builtin_amdgcn_mbcnt_hi(m_, __builtin_amdgcn_mbcnt_lo(m_, 0u)); C.wave = w_; C.lane = l_; C.tid = (w_ << 6) | l_; } \
        { int b_ = C0.bid, n_ = C0.nb, v_ = C0.vcu; asm volatile("" : "+s"(b_), "+s"(n_), "+s"(v_)); C.bid = b_; C.nb = n_; C.vcu = v_; } \
        unsigned z_ = 0u; asm volatile("" : "+s"(z_)); unsigned char* ws = a.ws + z_; float* XL = a.out + z_; const int lq = __builtin_amdgcn_readfirstlane(lp); typedef const __attribute__((address_space(1))) float* gfp_t; const gfp_t* INT_ = (const gfp_t*)(ws + WS_PTRS); (void)INT_; (void)XL; (void)lq; \
        for (int rep_ = 0; rep_ < ((((REPMASK) >> (SITE)) & 1) ? 2 : 1); ++rep_) { __VA_ARGS__; if ((((REPMASK) >> (SITE)) & 1)) __syncthreads(); } ++ph; SEAM(); } else ++ph; } while (0)

    { const int lp = 0;
      PHASE(0, { if (C.bid == 0) { _Pragma("unroll") for (int k = 0; k < 40; ++k) if (C.tid == k) ((const float**)(ws + WS_PTRS))[k] = a.in[k]; }
                 ph_prologue(C, a); }); }

    auto layer_pair = [&](auto lpc) __attribute__((always_inline)) {
        constexpr int lp = decltype(lpc)::value;
        if constexpr (lp == 0) PHASE(1, { const int i = 2 * lq; const float* xl = (i == 0) ? in_ptr(ws, I_X) : XL; const float* xc = (i == 0) ? in_ptr(ws, I_CTX) : P_XC;
                   ph_norm<false>(C, xl, xc, in_ptr(ws, I_N1G) + i * DM, MODL(i), 0, 1024, P_HB, nullptr, nullptr, nullptr, nullptr);
                   moe_weight_prep(C, in_ptr(ws, I_MW1) + (size_t)i * NEXP * DM * DM, in_ptr(ws, I_MW3) + (size_t)i * NEXP * DM * DM, in_ptr(ws, I_MW2) + (size_t)i * NEXP * DM * DM, P_W13, P_W2); });
        PHASE(2, { EpiBf16 E{P_U, EV_INP}; fast_gemm(C, P_HB, DM, (const bf16*)(ws + WS_WEVIN) + (size_t)lq * EV_INP * DM, DM, MT / 256, EV_INP / 256, E); });
        PHASE(3, { EpiF32 Eq{P_QPRE, 768}; fast_gemm(C, P_U, EV_INP, (const bf16*)(ws + WS_WUQ) + (size_t)lq * 768 * 384, 384, MT / 256, 3, Eq); RELAUNDER();
                   EpiF32 Ek{P_KVPRE, 1024}; fast_gemm(C, P_U + 384, EV_INP, (const bf16*)(ws + WS_WUKV) + (size_t)lq * 1024 * 256, 256, MT / 256, 4, Ek, true); });
        PHASE(4, { ph_mla_fin(C, P_U, P_QPRE, P_KVPRE, in_ptr(ws, I_QG) + lq * 96, in_ptr(ws, I_KG) + lq * 96, (const f32x2*)(ws + WS_ROPE), P_QB, P_KB, P_VT);
                   ph_conv(C, P_U, in_ptr(ws, I_DWW) + (size_t)lq * 31 * 512, in_ptr(ws, I_DWB) + lq * 512, in_ptr(ws, I_LNG) + lq * 512, in_ptr(ws, I_LNB) + lq * 512, P_OCAT); });
        PHASE(5, ph_attn_mla2(C, P_QB, P_KB, P_VT, P_OCAT, false));
        PHASE(6, { const int i = 2 * lq; const float* xl = (i == 0) ? in_ptr(ws, I_X) : XL; const float* xc = (i == 0) ? in_ptr(ws, I_CTX) : P_XC;
                   EpiResid E{xl, xc, XL, P_XC, MODL(i) + 2048}; fast_gemm(C, P_OCAT, DM, (const bf16*)(ws + WS_WEVOUT) + (size_t)lq * DM * DM, DM, MT / 256, 4, E); });
        PHASE(7, { const int i = 2 * lq; ph_norm<true>(C, XL, P_XC, in_ptr(ws, I_N2G) + i * DM, MODL(i), 3072, 4096, P_HB, in_ptr(ws, I_ROUTER) + (size_t)i * DM * 16, P_AFFT, P_AFFC, P_SLOT); });
        PHASE(8, ph_topk(C, P_AFFT, P_AFFC, P_ROWS, P_GATE, P_SLOT, false));
        PHASE(9, { pg8::Gemm g{P_HB, P_W13, DM, DM, P_ROWS}; pg8::OrderMoE S{17, 8, 17, C.nb, C.vcu}; pg8::EpiAdapt<EpiGlu> E{EpiGlu{P_HID}}; pg8::gemm_phase(C.lds, g, S, E, C.tid); });
        PHASE(10, { pg8::Gemm g{P_HID, P_W2, DM, DM, nullptr}; pg8::OrderMoE S{17, 4, 17, C.nb, C.vcu}; pg8::EpiAdapt<EpiGate> E{EpiGate{P_Y2, P_GATE}}; pg8::gemm_phase(C.lds, g, S, E, C.tid); });
        PHASE(11, { const int i = 2 * lq; ph_combine(C, XL, P_XC, MODL(i) + 5120, P_SLOT, P_Y2, false, in_ptr(ws, I_N1G) + (i + 1) * DM, MODL(i + 1), P_HB);
                    moe_weight_prep(C, in_ptr(ws, I_MW1) + (size_t)(i + 1) * NEXP * DM * DM, in_ptr(ws, I_MW3) + (size_t)(i + 1) * NEXP * DM * DM, in_ptr(ws, I_MW2) + (size_t)(i + 1) * NEXP * DM * DM, P_W13, P_W2); });
        PHASE(13, { EpiBf16 E{P_U, OD_INP}; fast_gemm(C, P_HB, DM, (const bf16*)(ws + WS_WODIN) + (size_t)lq * OD_INP * DM, DM, MT / 256, OD_INP / 256, E); });
        PHASE(14, ph_prep(C, P_U, in_ptr(ws, I_SHIFTW) + (size_t)lq * 3 * RW_IN, in_ptr(ws, I_KKW) + lq * 512, in_ptr(ws, I_NAQG) + lq * 64, in_ptr(ws, I_NAKG) + lq * 64, P_R, P_V, P_K, P_KK, P_L, P_QN, P_KN, P_VTN));
        PHASE(15, { const bf16* WL = (const bf16*)(ws + WS_WLORA) + (size_t)lq * 655360;
                    { EpiLoraW E{P_W, in_ptr(ws, I_W0) + lq * 1024}; fast_gemm(C, P_L, 384, WL, 256, MT / 256, 4, E); } RELAUNDER();
                    { EpiLoraA E{P_KEFF, in_ptr(ws, I_A0) + lq * 1024}; fast_gemm(C, P_L, 384, WL + (size_t)1024 * 256, 256, MT / 256, 4, E, true); } RELAUNDER();
                    { EpiBf16 E{P_G, 512}; fast_gemm(C, P_L + 128, 384, WL + (size_t)2048 * 256, 256, MT / 256, 2, E); } });
        PHASE(16, ph_natten2(C, P_QN, P_KN, P_VTN, P_OCAT, in_ptr(ws, I_RPB) + (size_t)lq * 8 * 465, lq == 1));
        PHASE(17, ph_scan2(C, P_R, P_V, P_K, P_KK, P_W, P_KEFF, in_ptr(ws, I_KA) + lq * 512, P_YS));
        PHASE(18, ph_post(C, P_YS, P_R, P_V, P_K, P_KEFF, in_ptr(ws, I_KA) + lq * 512, P_G, in_ptr(ws, I_RK) + lq * 512, in_ptr(ws, I_GNG) + lq * 512, in_ptr(ws, I_GNB) + lq * 512, P_OCAT, lq == 1));
        PHASE(19, { const int i = 2 * lq + 1; EpiResid E{XL, P_XC, XL, P_XC, MODL(i) + 2048};
                    fast_gemm(C, P_OCAT, DM, (const bf16*)(ws + WS_WODOUT) + (size_t)lq * DM * DM, DM, (lq == 1) ? NLAT / 256 : MT / 256, 4, E); });
        PHASE(20, { const int i = 2 * lq + 1; ph_norm<true>(C, XL, P_XC, in_ptr(ws, I_N2G) + i * DM, MODL(i), 3072, 4096, P_HB, in_ptr(ws, I_ROUTER) + (size_t)i * DM * 16, P_AFFT, P_AFFC, P_SLOT); });
        PHASE(21, ph_topk(C, P_AFFT, P_AFFC, P_ROWS, P_GATE, P_SLOT, lq == 1));
        PHASE(22, { pg8::Gemm g{P_HB, P_W13, DM, DM, P_ROWS}; pg8::OrderMoE S{(lq == 1) ? 16 : 17, 8, 17, C.nb, C.vcu}; pg8::EpiAdapt<EpiGlu> E{EpiGlu{P_HID}}; pg8::gemm_phase(C.lds, g, S, E, C.tid); });
        PHASE(23, { pg8::Gemm g{P_HID, P_W2, DM, DM, nullptr}; pg8::OrderMoE S{(lq == 1) ? 16 : 17, 4, 17, C.nb, C.vcu}; pg8::EpiAdapt<EpiGate> E{EpiGate{P_Y2, P_GATE}}; pg8::gemm_phase(C.lds, g, S, E, C.tid); });
        PHASE(24, { const int i = 2 * lq + 1;
                    if (lp == 0) { ph_combine(C, XL, P_XC, MODL(i) + 5120, P_SLOT, P_Y2, false, in_ptr(ws, I_N1G) + (i + 1) * DM, MODL(i + 1), P_HB);
                        moe_weight_prep(C, in_ptr(ws, I_MW1) + (size_t)(i + 1) * NEXP * DM * DM, in_ptr(ws, I_MW3) + (size_t)(i + 1) * NEXP * DM * DM, in_ptr(ws, I_MW2) + (size_t)(i + 1) * NEXP * DM * DM, P_W13, P_W2); }
                    else ph_combine(C, XL, P_XC, MODL(i) + 5120, P_SLOT, P_Y2, true, nullptr, nullptr, nullptr); });
    };
    layer_pair(IC<0>{}); layer_pair(IC<1>{});
}

extern "C" void kernel_launch(void* const* d_in, const int* in_sizes, int n_in, void* d_out, int out_size, void* d_ws, size_t ws_size, hipStream_t stream) {
    static int grid = 0;
    if (grid == 0) {
        if (n_in != 40 || out_size != NLAT * DM || ws_size < WS_END) { fprintf(stderr, "kernel_launch: unexpected shapes (n_in %d out %d ws %zu need %zu)\n", n_in, out_size, ws_size, (size_t)WS_END); grid = -1; return; }
        int dev = 0, cus = 0, per_cu = 0;
        if (hipGetDevice(&dev) != hipSuccess || hipDeviceGetAttribute(&cus, hipDeviceAttributeMultiprocessorCount, dev) != hipSuccess) { grid = -1; return; }
        if (hipFuncSetAttribute((const void*)fwd_kernel, hipFuncAttributeMaxDynamicSharedMemorySize, LDS_BYTES) != hipSuccess) { fprintf(stderr, "kernel_launch: hipFuncSetAttribute failed\n"); grid = -1; return; }
        if (hipOccupancyMaxActiveBlocksPerMultiprocessor(&per_cu, (const void*)fwd_kernel, 512, LDS_BYTES) != hipSuccess || per_cu < 1) { fprintf(stderr, "kernel_launch: occupancy query says %d\n", per_cu); per_cu = 1; }
        (void)hipGetLastError();
        grid = cus;
    }
    if (grid < 0) return;
    (void)hipMemsetAsync((char*)d_ws + WS_CTL, 0, CTL_BYTES, stream);
    Args a{};
    for (int i = 0; i < 40; ++i) a.in[i] = (const float*)d_in[i];
    a.out = (float*)d_out; a.ws = (unsigned char*)d_ws;
#if MEGA
    a.ph_lo = 0; a.ph_hi = N_PHASES;
    hipLaunchKernelGGL(fwd_kernel, dim3(grid), dim3(512), LDS_BYTES, stream, a);
#else
    for (int p = 0; p < N_PHASES; ++p) { a.ph_lo = p; a.ph_hi = p + 1; hipLaunchKernelGGL(fwd_kernel, dim3(grid), dim3(512), LDS_BYTES, stream, a); }
#endif
}
```

```cpp
#include <hip/hip_runtime.h>
#include <cstdio>
#include <cstdint>

#ifndef MEGA
#define MEGA 1
#endif

#define LAS __attribute__((address_space(3)))
#define DI __device__ __forceinline__

typedef unsigned short bf16;
typedef short bf16x8 __attribute__((ext_vector_type(8)));
typedef float f32x4 __attribute__((ext_vector_type(4)));
typedef float f32x2 __attribute__((ext_vector_type(2)));
typedef float f32x16 __attribute__((ext_vector_type(16)));
typedef unsigned u32x4 __attribute__((ext_vector_type(4)));
typedef unsigned u32x2 __attribute__((ext_vector_type(2)));
typedef __bf16 bf16x2_t __attribute__((ext_vector_type(2)));

constexpr int DM = 1024, NB = 8, TL = 4096, LCX = 256;
constexpr int NLAT = NB * TL, NCTX = NB * LCX, MT = NLAT + NCTX;
constexpr int KPOS = TL + LCX;
constexpr float EPS = 1e-6f, GN_EPS = 64e-5f;
constexpr int EV_IN = 1696, EV_INP = 1792, OD_IN = 3456, OD_INP = 3584, RW_IN = 1920;
constexpr int NEXP = 16, CAPL = 512, CAPC = 32, ESLOTS = NB * CAPL + NB * CAPC;
constexpr float LOG2E = 1.4426950408889634f;

constexpr size_t MiB = 1ull << 20;
constexpr size_t WS_CTL = 0, CTL_BYTES = 1 * MiB;
constexpr size_t WS_MOD = 1 * MiB, WS_ROPE = 2 * MiB, WS_XC = 4 * MiB;
constexpr size_t WS_ROWS = 12 * MiB, WS_GATE = 12 * MiB + 512 * 1024, WS_SLOT = 13 * MiB, WS_AFFT = 16 * MiB, WS_AFFC = 18 * MiB;
constexpr size_t WS_WEVIN = 20 * MiB, WS_WEVOUT = 27 * MiB, WS_WUQ = 31 * MiB, WS_WUKV = 33 * MiB, WS_WODIN = 34 * MiB, WS_WODOUT = 48 * MiB, WS_WLORA = 52 * MiB;
constexpr size_t WS_W13 = 56 * MiB, WS_W2 = 120 * MiB, WS_HB = 152 * MiB, WS_OCAT = 220 * MiB, WS_ARENA = 288 * MiB;
constexpr size_t A_U = 0, A_QPRE = 119 * MiB, A_KVPRE = 221 * MiB, A_QB = 357 * MiB, A_KB = 408 * MiB, A_VT = 459 * MiB;
constexpr size_t A_W = 0, A_KEFF = 136 * MiB  , A_G = 204 * MiB, A_R = 238 * MiB, A_V = 272 * MiB, A_KK = 306 * MiB, A_K = 340 * MiB, A_L = 374 * MiB,
                 A_QN = 400 * MiB, A_KN = 434 * MiB, A_VTN = 468 * MiB, A_YS = 374 * MiB  ;
constexpr size_t A_HID = 0, A_Y2 = 136 * MiB;
constexpr size_t A_IMG = 510 * MiB;
constexpr size_t WS_END = WS_ARENA + 612 * MiB;
constexpr int LDS_BYTES = 147456;

DI unsigned pk2(float lo, float hi) { f32x2 v = {lo, hi}; bf16x2_t b = __builtin_convertvector(v, bf16x2_t); return __builtin_bit_cast(unsigned, b); }
DI float bflo(unsigned u) { return __builtin_bit_cast(float, u << 16); }
DI float bfhi(unsigned u) { return __builtin_bit_cast(float, u & 0xffff0000u); }
DI float bf2f(bf16 x) { return __builtin_bit_cast(float, ((unsigned)x) << 16); }
DI bf16 f2bf(float f) { return (bf16)(pk2(f, 0.f) & 0xffffu); }
DI void unpack8(u32x4 v, float (&f)[8]) { f[0] = bflo(v.x); f[1] = bfhi(v.x); f[2] = bflo(v.y); f[3] = bfhi(v.y); f[4] = bflo(v.z); f[5] = bfhi(v.z); f[6] = bflo(v.w); f[7] = bfhi(v.w); }
DI u32x4 pack8(const float (&f)[8]) { u32x4 r; r.x = pk2(f[0], f[1]); r.y = pk2(f[2], f[3]); r.z = pk2(f[4], f[5]); r.w = pk2(f[6], f[7]); return r; }
#define DPP_ADD(x, ctrl) ((x) + __builtin_bit_cast(float, __builtin_amdgcn_update_dpp(0, __builtin_bit_cast(int, (x)), (ctrl), 0xf, 0xf, false)))
#define DPP_MAX(x, ctrl) fmaxf((x), __builtin_bit_cast(float, __builtin_amdgcn_update_dpp(0, __builtin_bit_cast(int, (x)), (ctrl), 0xf, 0xf, false)))
DI float sum8(float x) { x = DPP_ADD(x, 0xB1); x = DPP_ADD(x, 0x4E); x = DPP_ADD(x, 0x141); return x; }
DI float sum16(float x) { x = DPP_ADD(x, 0xB1); x = DPP_ADD(x, 0x4E); x = DPP_ADD(x, 0x141); x = DPP_ADD(x, 0x140); return x; }
DI float max16(float x) { x = DPP_MAX(x, 0xB1); x = DPP_MAX(x, 0x4E); x = DPP_MAX(x, 0x141); x = DPP_MAX(x, 0x140); return x; }
DI float rdlane(float x, int l) { return __builtin_bit_cast(float, __builtin_amdgcn_readlane(__builtin_bit_cast(int, x), l)); }
DI float wave_sum(float v) { const float x = sum16(v); return (rdlane(x, 0) + rdlane(x, 16)) + (rdlane(x, 32) + rdlane(x, 48)); }
DI float xor32(float v, int lane) { return __builtin_bit_cast(float, __builtin_amdgcn_ds_bpermute((lane ^ 32) << 2, __builtin_bit_cast(int, v))); }
DI float sigmoidf_(float x) { return __builtin_amdgcn_rcpf(1.f + __expf(-x)); }
DI float siluf_(float x) { return x * __builtin_amdgcn_rcpf(1.f + __expf(-x)); }
#define MFMA32(a, b, c) __builtin_amdgcn_mfma_f32_32x32x16_bf16((a), (b), (c), 0, 0, 0)

#define XB_TMO      128
#define XB_XCNT(j)  (256  + 64 * (j))
#define XB_XSUB(j)  (1280 + 64 * (j))
#define XB_XGEN(j)  (2304 + 64 * (j))
#define XB_TOP      3328
#define XB_TOPGEN   3392
#define XCD_BAR_WORDS 3456
#define XB_SPIN_CAP (1u << 22)
__device__ __forceinline__ unsigned xb_ld(unsigned* p)              { return __hip_atomic_load(p, __ATOMIC_RELAXED, __HIP_MEMORY_SCOPE_AGENT); }
__device__ __forceinline__ unsigned xb_add(unsigned* p, unsigned v) { return __hip_atomic_fetch_add(p, v, __ATOMIC_RELAXED, __HIP_MEMORY_SCOPE_AGENT); }
__device__ __forceinline__ unsigned xb_xcc_id() { return (unsigned)__builtin_amdgcn_s_getreg((3 << 11) | 20) & 0xFu; }
#define XB_SPIN(cond, bar) do { unsigned _sp = 0; while (cond) { __builtin_amdgcn_s_sleep(1); \
    if ((++_sp & 255u) == 0u) { if (xb_ld(&(bar)[XB_TMO])) break; if (_sp > XB_SPIN_CAP) { atomicAdd(&(bar)[XB_TMO], 1u); break; } } } } while (0)
struct XcdBarrier { unsigned* bar; unsigned x; volatile LAS unsigned* st; };
__device__ __forceinline__ XcdBarrier xcd_barrier_post(unsigned* bar, volatile LAS unsigned* st, bool leader) {
    XcdBarrier b; b.bar = bar; b.x = xb_xcc_id(); b.st = st;
    if (leader) (void)xb_add(&bar[XB_XCNT(b.x)], 1u);
    return b;
}
__device__ __forceinline__ void xcd_barrier_complete(unsigned* bar, unsigned x, unsigned& nloc, unsigned& nx) {
    const unsigned G = gridDim.x * gridDim.y * gridDim.z;
    unsigned sum, cnt, mine, sp = 0u;
    for (;;) {
        sum = 0u; cnt = 0u; mine = 0u;
#pragma unroll
        for (unsigned j = 0; j < 16; ++j) { const unsigned c = xb_ld(&bar[XB_XCNT(j)]); sum += c; cnt += (c > 0u) ? 1u : 0u; mine = (j == x) ? c : mine; }
        if (sum == G) break;
        __builtin_amdgcn_s_sleep(1);
        if ((++sp & 255u) == 0u) { if (xb_ld(&bar[XB_TMO])) break; if (sp > XB_SPIN_CAP) { atomicAdd(&bar[XB_TMO], 1u); break; } }
    }
    nloc = mine > 0u ? mine : 1u; nx = cnt > 0u ? cnt : 1u;
}
__device__ __forceinline__ void xcd_barrier(const XcdBarrier& b, bool leader) {
    asm volatile("s_waitcnt vmcnt(0)" ::: "memory");
    __syncthreads();
    if (leader) {
        unsigned* bar = b.bar;
        __builtin_amdgcn_s_waitcnt(0);
        unsigned nloc = b.st[0], nx = b.st[1];
        if (nloc == 0u) { xcd_barrier_complete(bar, b.x, nloc, nx); b.st[0] = nloc; b.st[1] = nx; }
        const unsigned old = xb_add(&bar[XB_XSUB(b.x)], 1u);
        const unsigned gen = old / nloc;
        if (old + 1u == (gen + 1u) * nloc) {
            __builtin_amdgcn_fence(__ATOMIC_RELEASE, "agent");
            asm volatile("s_waitcnt vmcnt(0)" ::: "memory");
            const unsigned og = xb_add(&bar[XB_TOP], 1u);
            const unsigned tg = og / nx;
            if (og + 1u == (tg + 1u) * nx) xb_add(&bar[XB_TOPGEN], 1u);
            else XB_SPIN(xb_ld(&bar[XB_TOPGEN]) == tg, bar);
            __builtin_amdgcn_fence(__ATOMIC_ACQUIRE, "agent");
            xb_add(&bar[XB_XGEN(b.x)], 1u);
            asm volatile("s_waitcnt vmcnt(0)" ::: "memory");
        } else {
            XB_SPIN(xb_ld(&bar[XB_XGEN(b.x)]) == gen, bar);
            __builtin_amdgcn_fence(__ATOMIC_ACQUIRE, "agent");
            asm volatile("s_waitcnt vmcnt(0)" ::: "memory");
        }
    }
    __syncthreads();
}

struct Ctx { LAS unsigned char* lds; int tid, lane, wave, bid, nb, vcu; };
struct Args { const float* in[40]; float* out; unsigned char* ws; int ph_lo, ph_hi; };
enum { I_X = 0, I_C, I_CTX, I_CCTX, I_ADAW, I_ADAB, I_N1G, I_N2G, I_EVWIN, I_EVWOUT, I_QNORM, I_WUQ, I_KVNORM, I_WUKV, I_QG, I_KG, I_DWW, I_DWB, I_LNG, I_LNB,
       I_ODWIN, I_ODWOUT, I_SHIFTW, I_W0, I_W2L, I_A0, I_A2, I_G2, I_KKW, I_KA, I_RK, I_GNG, I_GNB, I_NAQG, I_NAKG, I_RPB, I_ROUTER, I_MW1, I_MW3, I_MW2 };

DI void transpose_item(const float* __restrict__ W, int K, int N, bf16* __restrict__ WT, int dst_row0, const float* __restrict__ gain, LAS float* scr, int k0, int n0, int lane) {
#pragma unroll 8
    for (int i = 0; i < 32; ++i) { const int kk = 2 * i + (lane >> 5); float v = W[(size_t)(k0 + kk) * N + n0 + (lane & 31)]; if (gain) v *= gain[k0 + kk]; scr[kk * 33 + (lane & 31)] = v; }
    asm volatile("s_waitcnt lgkmcnt(0)" ::: "memory");
    const int c = lane & 7;
#pragma unroll
    for (int j = 0; j < 4; ++j) { const int n = (lane >> 3) + 8 * j; const LAS float* s = scr + (8 * c) * 33 + n;
        u32x4 o; o.x = pk2(s[0 * 33], s[1 * 33]); o.y = pk2(s[2 * 33], s[3 * 33]); o.z = pk2(s[4 * 33], s[5 * 33]); o.w = pk2(s[6 * 33], s[7 * 33]);
        *(u32x4*)(WT + (size_t)(dst_row0 + n) * K + k0 + 8 * c) = o; }
    asm volatile("s_waitcnt lgkmcnt(0)" ::: "memory");
}
DI void transpose_item64(const float* __restrict__ W, int K, int N, bf16* __restrict__ WT, int dst_row0, LAS float* scr, int k0, int n0, int lane) {
    f32x4 v[16];
#pragma unroll
    for (int i = 0; i < 16; ++i) v[i] = *(const f32x4*)(W + (size_t)(k0 + 4 * i + (lane >> 4)) * N + n0 + 4 * (lane & 15));
#pragma unroll
    for (int i = 0; i < 16; ++i) { LAS float* d = scr + (4 * i + (lane >> 4)) * 65 + 4 * (lane & 15); d[0] = v[i].x; d[1] = v[i].y; d[2] = v[i].z; d[3] = v[i].w; }
    asm volatile("s_waitcnt lgkmcnt(0)" ::: "memory");
    const int c = lane & 7;
#pragma unroll
    for (int j = 0; j < 8; ++j) { const int n = (lane >> 3) + 8 * j; const LAS float* s = scr + (8 * c) * 65 + n;
        u32x4 o; o.x = pk2(s[0 * 65], s[1 * 65]); o.y = pk2(s[2 * 65], s[3 * 65]); o.z = pk2(s[4 * 65], s[5 * 65]); o.w = pk2(s[6 * 65], s[7 * 65]);
        *(u32x4*)(WT + (size_t)(dst_row0 + n) * K + k0 + 8 * c) = o; }
    asm volatile("s_waitcnt lgkmcnt(0)" ::: "memory");
}
DI void transpose_matrix(const Ctx& C, const float* W, int K, int N, bf16* WT, const float* gain, int mode  ) {
    LAS float* scr = (LAS float*)(C.lds + C.wave * 8704);
    const int nkb = K / 64, nnb = N / 32, nit = nkb * nnb, gw = C.vcu * 8 + C.wave, ngw = C.nb * 8;
    for (int it = gw; it < nit; it += ngw) {
        const int kb = it / nnb, nbk = it % nnb, n0 = nbk * 32;
        int d0 = n0; if (mode) d0 = (n0 >> 7) * 256 + (n0 & 127) + (mode == 2 ? 128 : 0);
        transpose_item(W, K, N, WT, d0, gain, scr, kb * 64, n0, C.lane);
    }
}
DI void moe_weight_prep(const Ctx& C, const float* w1, const float* w3, const float* w2, bf16* W13, bf16* W2) {
    LAS float* scr = (LAS float*)(C.lds + C.wave * 16640);
    const int gw = C.vcu * 8 + C.wave, ngw = C.nb * 8;
    constexpr int PER = 16 * 16;
    for (int it = gw; it < NEXP * 3 * PER; it += ngw) {
        const int e = it / (3 * PER), r = it % (3 * PER), which = r / PER, q = r % PER, kb = q / 16, n0 = (q % 16) * 64;
        if (which == 0)      transpose_item64(w1 + (size_t)e * DM * DM, DM, DM, W13 + (size_t)e * 2048 * DM, (n0 >> 7) * 256 + (n0 & 127), scr, kb * 64, n0, C.lane);
        else if (which == 1) transpose_item64(w3 + (size_t)e * DM * DM, DM, DM, W13 + (size_t)e * 2048 * DM, (n0 >> 7) * 256 + (n0 & 127) + 128, scr, kb * 64, n0, C.lane);
        else                 transpose_item64(w2 + (size_t)e * DM * DM, DM, DM, W2 + (size_t)e * DM * DM, n0, scr, kb * 64, n0, C.lane);
    }
}

DI void ph_prologue(const Ctx& C, const Args& a) {
    unsigned char* ws = a.ws;
    {
        LAS float* sv = (LAS float*)C.lds;
        LAS float* red = sv + 9 * 1024;
        for (int i = C.tid; i < 9 * 1024; i += 512) { const int m = i >> 10, k = i & 1023; const float c = (m < 8) ? a.in[I_C][m * 1024 + k] : a.in[I_CCTX][k]; sv[i] = siluf_(c); }
        __syncthreads();
        float* MOD = (float*)(ws + WS_MOD);
        for (int it = C.bid; it < 4 * 96; it += C.nb) {
            const int layer = it / 96, col = (it % 96) * 64 + C.lane;
            const float* wp = a.in[I_ADAW] + (size_t)layer * 1024 * 6144 + col;
            float acc[9];
#pragma unroll
            for (int m = 0; m < 9; ++m) acc[m] = 0.f;
            const int kb = C.wave * 128;
#pragma unroll 4
            for (int k = 0; k < 128; ++k) { const float w = wp[(size_t)(kb + k) * 6144];
#pragma unroll
                for (int m = 0; m < 9; ++m) acc[m] += sv[m * 1024 + kb + k] * w; }
#pragma unroll
            for (int m = 0; m < 9; ++m) red[(C.wave * 9 + m) * 64 + C.lane] = acc[m];
            __syncthreads();
            for (int i = C.tid; i < 576; i += 512) { const int m = i >> 6, l = i & 63; float s = 0.f;
#pragma unroll
                for (int w = 0; w < 8; ++w) s += red[(w * 9 + m) * 64 + l];
                const int cc = (it % 96) * 64 + l;
                MOD[(size_t)(layer * 9 + m) * 6144 + cc] = s + a.in[I_ADAB][layer * 6144 + cc]; }
            __syncthreads();
        }
    }
    {
        f32x2* CS = (f32x2*)(ws + WS_ROPE);
        for (int i = C.bid * 512 + C.tid; i < 4096 * 16; i += C.nb * 512) {
            const int pos = i >> 4, j = i & 15, f = j & 7;
            const float inv = powf(10000.f, -(float)(2 * f) / 16.f);
            const float ang = (float)((j < 8) ? (pos >> 6) : (pos & 63)) * inv;
            const double tw = 6.283185307179586476925;
            const double x = (double)ang, n = __builtin_rint(x / tw), rr = x - n * tw;
            CS[i] = (f32x2){__cosf((float)rr), __sinf((float)rr)};
        }
    }
    for (int j = 0; j < 2; ++j) {
        transpose_matrix(C, a.in[I_EVWIN] + (size_t)j * DM * EV_IN, DM, EV_IN, (bf16*)(ws + WS_WEVIN) + (size_t)j * EV_INP * DM, nullptr, 0);
        transpose_matrix(C, a.in[I_EVWOUT] + (size_t)j * DM * DM, DM, DM, (bf16*)(ws + WS_WEVOUT) + (size_t)j * DM * DM, nullptr, 0);
        transpose_matrix(C, a.in[I_WUQ] + (size_t)j * 384 * 768, 384, 768, (bf16*)(ws + WS_WUQ) + (size_t)j * 768 * 384, a.in[I_QNORM] + j * 384, 0);
        transpose_matrix(C, a.in[I_WUKV] + (size_t)j * 256 * 1024, 256, 1024, (bf16*)(ws + WS_WUKV) + (size_t)j * 1024 * 256, a.in[I_KVNORM] + j * 256, 0);
        transpose_matrix(C, a.in[I_ODWIN] + (size_t)j * DM * OD_IN, DM, OD_IN, (bf16*)(ws + WS_WODIN) + (size_t)j * OD_INP * DM, nullptr, 0);
        transpose_matrix(C, a.in[I_ODWOUT] + (size_t)j * DM * DM, DM, DM, (bf16*)(ws + WS_WODOUT) + (size_t)j * DM * DM, nullptr, 0);
    }
    {
        const int gt = C.bid * 512 + C.tid, ngt = C.nb * 512;
        for (int j = 0; j < 2; ++j) {
            u32x4* p0 = (u32x4*)((bf16*)(ws + WS_WEVIN) + (size_t)j * EV_INP * DM + (size_t)EV_IN * DM);
            for (int i = gt; i < (EV_INP - EV_IN) * DM / 8; i += ngt) p0[i] = (u32x4){0u, 0u, 0u, 0u};
            u32x4* p1 = (u32x4*)((bf16*)(ws + WS_WODIN) + (size_t)j * OD_INP * DM + (size_t)OD_IN * DM);
            for (int i = gt; i < (OD_INP - OD_IN) * DM / 8; i += ngt) p1[i] = (u32x4){0u, 0u, 0u, 0u};
            bf16* WL = (bf16*)(ws + WS_WLORA) + (size_t)j * 655360;
            const float* w2 = a.in[I_W2L] + (size_t)j * 2 * 64 * 512; const float* a2 = a.in[I_A2] + (size_t)j * 2 * 64 * 512; const float* g2 = a.in[I_G2] + (size_t)j * 128 * 512;
            for (int i = gt; i < 655360; i += ngt) {
                const int n = i >> 8, k = i & 255; float v = 0.f;
                if (n < 1024) { const int d = n >> 9, c = n & 511; if (k >= d * 64 && k < d * 64 + 64) v = w2[(size_t)k * 512 + c]; }
                else if (n < 2048) { const int d = (n - 1024) >> 9, c = n & 511; if (k >= 128 + d * 64 && k < 192 + d * 64) v = a2[(size_t)(k - 128) * 512 + c]; }
                else { const int c = n - 2048; if (k >= 128) v = g2[(size_t)(k - 128) * 512 + c]; }
                WL[i] = f2bf(v);
            }
        }
    }
}

template <bool ROUTER>
DI void ph_norm(const Ctx& C, const float* xlat, const float* xctx, const float* gain, const float* mod  , int shift_off, int scale_off, bf16* H,
                const float* router  , float* AFFT, float* AFFC, int* SLOT) {
    LAS float* RT = (LAS float*)C.lds;
    if (ROUTER) { for (int i = C.tid; i < 16384; i += 512) { const int c = i >> 4, e = i & 15; RT[e * 1024 + c] = router[i]; } __syncthreads(); }
    const int gw = C.bid * 8 + C.wave, ngw = C.nb * 8, lane = C.lane;
    for (int row = gw; row < MT; row += ngw) {
        const float* xr = row < NLAT ? xlat + (size_t)row * DM : xctx + (size_t)(row - NLAT) * DM;
        const int mi = row < NLAT ? (row >> 12) : 8;
        const float* mp = mod + mi * 6144;
        f32x4 v[4]; float ss = 0.f;
#pragma unroll
        for (int j = 0; j < 4; ++j) { v[j] = *(const f32x4*)(xr + 256 * j + 4 * lane); ss += v[j].x * v[j].x + v[j].y * v[j].y + v[j].z * v[j].z + v[j].w * v[j].w; }
        ss = wave_sum(ss);
        const float rs = 1.0f / sqrtf(ss * (1.f / 1024.f) + EPS);
#pragma unroll
        for (int j = 0; j < 4; ++j) {
            const int c = 256 * j + 4 * lane;
            const f32x4 g = *(const f32x4*)(gain + c), sc = *(const f32x4*)(mp + scale_off + c), sh = *(const f32x4*)(mp + shift_off + c);
            v[j] = (v[j] * rs) * g * (sc + 1.0f) + sh;
            *(u32x2*)(H + (size_t)row * DM + c) = (u32x2){pk2(v[j].x, v[j].y), pk2(v[j].z, v[j].w)};
        }
        if (ROUTER) {
            float mylg = 0.f;
#pragma unroll 1
            for (int e = 0; e < 16; ++e) { float p = 0.f;
#pragma unroll
                for (int j = 0; j < 4; ++j) { const f32x4 w = *(const LAS f32x4*)(RT + e * 1024 + 256 * j + 4 * lane); p += v[j].x * w.x + v[j].y * w.y + v[j].z * w.z + v[j].w * w.w; }
                p = wave_sum(p); mylg = (lane == e) ? p : mylg; }
            const float mx = max16(mylg);
            const float ex = expf(mylg - mx);
            const float mine = ex / sum16(ex);
            if (lane < 16) {
                if (row < NLAT) AFFT[(size_t)((row >> 12) * 16 + lane) * TL + (row & 4095)] = mine;
                else { const int rc = row - NLAT; AFFC[(size_t)((rc >> 8) * 16 + lane) * LCX + (rc & 255)] = mine; }
                SLOT[(size_t)row * 16 + lane] = -1;
            }
        }
    }
}

template <class Epi>
DI void gemm_unit(const bf16* __restrict__ A, int lda, const int* __restrict__ rows, const bf16* __restrict__ Bt, int K, int pm, int pn, const Epi& E, int wave, int lane) {
    const int wr = wave >> 2, wc = wave & 3, r = lane & 31, h = lane >> 5;
    const bf16* ap[2][2]; const bf16* bp[2];
#pragma unroll
    for (int ai = 0; ai < 2; ++ai)
#pragma unroll
        for (int mm = 0; mm < 2; ++mm) { const int lr = 256 * pm + 128 * ai + 64 * wr + 32 * mm + r; const int gr = rows ? rows[lr] : lr; ap[ai][mm] = A + (size_t)gr * lda + 8 * h; }
#pragma unroll
    for (int bj = 0; bj < 2; ++bj) bp[bj] = Bt + (size_t)(256 * pn + 128 * bj + 32 * wc + r) * K + 8 * h;
    f32x16 acc[2][2][2];
#pragma unroll
    for (int ai = 0; ai < 2; ++ai)
#pragma unroll
        for (int mm = 0; mm < 2; ++mm)
#pragma unroll
            for (int bj = 0; bj < 2; ++bj)
#pragma unroll
                for (int i = 0; i < 16; ++i) acc[ai][mm][bj][i] = 0.f;
#pragma unroll 2
    for (int k0 = 0; k0 < K; k0 += 16) {
        bf16x8 af[2][2], bfr[2];
#pragma unroll
        for (int ai = 0; ai < 2; ++ai)
#pragma unroll
            for (int mm = 0; mm < 2; ++mm) af[ai][mm] = *(const bf16x8*)(ap[ai][mm] + k0);
#pragma unroll
        for (int bj = 0; bj < 2; ++bj) bfr[bj] = *(const bf16x8*)(bp[bj] + k0);
#pragma unroll
        for (int ai = 0; ai < 2; ++ai)
#pragma unroll
            for (int mm = 0; mm < 2; ++mm)
#pragma unroll
                for (int bj = 0; bj < 2; ++bj) acc[ai][mm][bj] = MFMA32(bfr[bj], af[ai][mm], acc[ai][mm][bj]);
    }
#pragma unroll
    for (int ai = 0; ai < 2; ++ai)
#pragma unroll
        for (int mm = 0; mm < 2; ++mm) {
            const int row = 256 * pm + 128 * ai + 64 * wr + 32 * mm + r;
#pragma unroll
            for (int g = 0; g < 4; ++g) {
                const int col = 256 * pn + 32 * wc + 8 * g + 4 * h;
                const f32x4 v0 = {acc[ai][mm][0][4 * g], acc[ai][mm][0][4 * g + 1], acc[ai][mm][0][4 * g + 2], acc[ai][mm][0][4 * g + 3]};
                const f32x4 v1 = {acc[ai][mm][1][4 * g], acc[ai][mm][1][4 * g + 1], acc[ai][mm][1][4 * g + 2], acc[ai][mm][1][4 * g + 3]};
                E(row, col, v0, v1);
            }
        }
}
template <class Epi>
DI void gemm_phase(const Ctx& C, const bf16* A, int lda, const bf16* Bt, int K, int nM, int nN, const Epi& E) {
    for (int u = C.vcu; u < nM * nN; u += C.nb) gemm_unit(A, lda, nullptr, Bt, K, u / nN, u % nN, E, C.wave, C.lane);
}

struct EpiBf16 { bf16* O; int ldo;
    DI void operator()(int row, int col, f32x4 v0, f32x4 v1) const { bf16* p = O + (size_t)row * ldo + col;
        *(u32x2*)p = (u32x2){pk2(v0[0], v0[1]), pk2(v0[2], v0[3])}; *(u32x2*)(p + 128) = (u32x2){pk2(v1[0], v1[1]), pk2(v1[2], v1[3])}; } };
struct EpiF32 { float* O; int ldo;
    DI void operator()(int row, int col, f32x4 v0, f32x4 v1) const { float* p = O + (size_t)row * ldo + col; *(f32x4*)p = v0; *(f32x4*)(p + 128) = v1; } };
struct EpiResid { const float* xin_lat; const float* xin_ctx; float* xout_lat; float* xout_ctx; const float* modg;
    DI void operator()(int row, int col, f32x4 v0, f32x4 v1) const {
        const float* xi; float* xo; int mi;
        if (row < NLAT) { xi = xin_lat + (size_t)row * DM; xo = xout_lat + (size_t)row * DM; mi = row >> 12; }
        else { xi = xin_ctx + (size_t)(row - NLAT) * DM; xo = xout_ctx + (size_t)(row - NLAT) * DM; mi = 8; }
        const float* g = modg + mi * 6144 + col;
        const f32x4 g0 = *(const f32x4*)g, g1 = *(const f32x4*)(g + 128), x0 = *(const f32x4*)(xi + col), x1 = *(const f32x4*)(xi + col + 128);
        *(f32x4*)(xo + col) = x0 + g0 * v0; *(f32x4*)(xo + col + 128) = x1 + g1 * v1; } };
struct EpiGlu { bf16* O;
    DI void operator()(int row, int col, f32x4 v0, f32x4 v1) const { const int f = ((col & 2047) >> 8) * 128 + (col & 255);
        *(u32x2*)(O + (size_t)row * DM + f) = (u32x2){pk2(siluf_(v0[0]) * v1[0], siluf_(v0[1]) * v1[1]), pk2(siluf_(v0[2]) * v1[2], siluf_(v0[3]) * v1[3])}; } };
struct EpiGate { bf16* O; const float* gate;
    DI void operator()(int row, int col, f32x4 v0, f32x4 v1) const { const float g = gate[row]; bf16* p = O + (size_t)row * DM + (col & 1023);
        *(u32x2*)p = (u32x2){pk2(v0[0] * g, v0[1] * g), pk2(v0[2] * g, v0[3] * g)}; *(u32x2*)(p + 128) = (u32x2){pk2(v1[0] * g, v1[1] * g), pk2(v1[2] * g, v1[3] * g)}; } };
struct EpiLoraW { float* W; const float* w0;
    DI void one(int row, int col, f32x4 v) const { const int d = col >> 9, c = col & 511; f32x4 o;
#pragma unroll
        for (int e = 0; e < 4; ++e) { const float lw = w0[col + e] + v[e]; const float z = -lw; const float sp = fmaxf(z, 0.f) + __logf(1.f + __expf(-fabsf(z))); o[e] = -__expf(-sp - 0.5f); }
        *(f32x4*)(W + ((size_t)d * MT + row) * 512 + c) = o; }
    DI void operator()(int row, int col, f32x4 v0, f32x4 v1) const { one(row, col, v0); one(row, col + 128, v1); } };
struct EpiLoraA { bf16* Aout; const float* a0;
    DI void one(int row, int col, f32x4 v) const { const int d = col >> 9, c = col & 511; const f32x4 b = *(const f32x4*)(a0 + col);
        *(u32x2*)(Aout + ((size_t)d * MT + row) * 512 + c) = (u32x2){pk2(sigmoidf_(b[0] + v[0]), sigmoidf_(b[1] + v[1])), pk2(sigmoidf_(b[2] + v[2]), sigmoidf_(b[3] + v[3]))}; }
    DI void operator()(int row, int col, f32x4 v0, f32x4 v1) const { one(row, col, v0); one(row, col + 128, v1); } };

namespace pg8 {
constexpr int BM = 256, BK = 64, HALF = 128, HTB = HALF * BK * 2, STAGE_BYTES = 8 * HTB;
DI int lds_byte(int r, int c) { const int st = (r >> 4) * 2 + (c >> 5), rr = r & 15, cc = c & 31, ob = rr * 64 + cc * 2; return st * 1024 + (ob ^ (((ob >> 9) & 1) << 5)); }
DI void stage_rc(int b, int& R, int& C) { const int st = b / 1024, sb = b % 1024, swz = sb ^ (((sb >> 9) & 1) << 5); R = (st >> 1) * 16 + swz / 64; C = (st & 1) * 32 + (swz % 64) / 2; }
DI int perm32(int rho) { const int n = rho >> 4, i = rho & 15; return 8 * (i >> 2) + 4 * n + (i & 3); }
struct Unit { int pm, pn; };
struct Gemm { const bf16* A; const bf16* Bt; int lda, K; const int* rows; };
struct OrderMN { int nM, nN, G, c;
    DI bool next(int i, Unit& u) const { const int L = i * G + c; if (L >= nM * nN) return false; u.pm = L / nN; u.pn = L % nN; return true; } };
struct OrderMoE { int nMt, nN, mstride  , G, c;
    DI bool next(int i, Unit& u) const { const int L = i * G + c, per = nMt * nN; if (L >= NEXP * per) return false; const int e = L / per, q = L % per; u.pm = e * mstride + q / nN; u.pn = e * nN + q % nN; return true; } };
template <class E4> struct EpiAdapt { E4 e;
    DI void operator()(const f32x4 (&acc)[2][2][4][2], const Unit& u, int wr, int wc, int fr, int fq) const {
#pragma unroll
        for (int ai = 0; ai < 2; ++ai)
#pragma unroll
            for (int m = 0; m < 4; ++m) { const int row = u.pm * BM + ai * HALF + wr * 64 + m * 16 + fr;
#pragma unroll
                for (int n = 0; n < 2; ++n) e(row, u.pn * BM + wc * 32 + 8 * fq + 4 * n, acc[ai][0][m][n], acc[ai][1][m][n]); } } };

template <class Epi, class Sched>
DI void gemm_phase(LAS unsigned char* lds, const Gemm g, const Sched& S, const Epi& E, const int tid) {
    const int wid = __builtin_amdgcn_readfirstlane(tid >> 6), lane = tid & 63, wr = wid >> 2, wc = wid & 3, fr = lane & 15, fq = lane >> 4;
    const int K = g.K, nt = K / BK;
    int RA[2], CA[2]; unsigned voffB[2];
#pragma unroll
    for (int i = 0; i < 2; ++i) { int R, C; stage_rc(tid * 16 + i * 8192, R, C); RA[i] = R; CA[i] = C; const int Rb = (R & ~31) + perm32(R & 31); voffB[i] = (unsigned)(Rb * K + C) * 2u; }
    const size_t kstep = (size_t)(BK * 2), hstep = (size_t)HALF * K * 2, tstep = 2 * hstep;
    const unsigned ldsw = (unsigned)wid * 1024u;
    const int aoff = lds_byte(wr * 64 + fr, fq * 8), boff = lds_byte(wc * 32 + fr, fq * 8);
    const char* const gA = (const char*)g.A;
#define PG8_SA(b, h) (((b) * 2 + (h)) * HTB)
#define PG8_SB(b, h) ((4 + (b) * 2 + (h)) * HTB)
#define PG8_STAGE(bufoff, gbase, voff) do { _Pragma("unroll") for (int _i = 0; _i < 2; ++_i) \
        __builtin_amdgcn_global_load_lds((const unsigned*)((const char*)(gbase) + (voff)[_i]), (LAS unsigned*)(lds + (bufoff) + ldsw + _i * 8192), 16, 0, 0); } while (0)
#define PG8_LDA(dst, b, h) do { _Pragma("unroll") for (int m = 0; m < 4; ++m) _Pragma("unroll") for (int k = 0; k < 2; ++k) dst[m][k] = *(const LAS bf16x8*)(lds + PG8_SA(b, h) + aoff + m * 2048 + k * 1024); } while (0)
#define PG8_LDB(dst, b, h) do { _Pragma("unroll") for (int n = 0; n < 2; ++n) _Pragma("unroll") for (int k = 0; k < 2; ++k) dst[n][k] = *(const LAS bf16x8*)(lds + PG8_SB(b, h) + boff + n * 2048 + k * 1024); } while (0)
#define PG8_MMA(ai, bj, At, Bt) do { __builtin_amdgcn_s_setprio(1); _Pragma("unroll") for (int m = 0; m < 4; ++m) _Pragma("unroll") for (int n = 0; n < 2; ++n) _Pragma("unroll") for (int k = 0; k < 2; ++k) \
        acc[ai][bj][m][n] = __builtin_amdgcn_mfma_f32_16x16x32_bf16(Bt[n][k], At[m][k], acc[ai][bj][m][n], 0, 0, 0); __builtin_amdgcn_s_setprio(0); } while (0)
#define PG8_WAIT_V(n) asm volatile("s_waitcnt vmcnt(" #n ")" ::: "memory")
#define PG8_WAIT_L(n) asm volatile("s_waitcnt lgkmcnt(" #n ")" ::: "memory")
#define PG8_BAR __builtin_amdgcn_s_barrier()
#define PG8_SCHED __builtin_amdgcn_sched_barrier(0)
#define PG8_AOFF(vo, u) do { _Pragma("unroll") for (int _h = 0; _h < 2; ++_h) _Pragma("unroll") for (int _i = 0; _i < 2; ++_i) { const int _lr = (u).pm * BM + _h * HALF + RA[_i]; \
        const int _gr = g.rows ? g.rows[_lr] : _lr; vo[_h][_i] = (unsigned)(((size_t)_gr * g.lda + CA[_i]) * 2u); } } while (0)
    Unit cur, nxt; int ui = 0;
    if (!S.next(0, cur)) return;
    f32x4 acc[2][2][4][2];
#pragma unroll
    for (int a = 0; a < 2; ++a)
#pragma unroll
        for (int b = 0; b < 2; ++b)
#pragma unroll
            for (int m = 0; m < 4; ++m)
#pragma unroll
                for (int n = 0; n < 2; ++n) acc[a][b][m][n] = (f32x4){0.f, 0.f, 0.f, 0.f};
    bf16x8 At[4][2], B0[2][2], B1[2][2];
    unsigned cvo[2][2], nvo[2][2];
    PG8_AOFF(cvo, cur);
    const char* cB = (const char*)g.Bt + (size_t)cur.pn * tstep;
    PG8_STAGE(PG8_SB(0, 0), cB, voffB); PG8_STAGE(PG8_SB(0, 1), cB + hstep, voffB); PG8_STAGE(PG8_SA(0, 0), gA, cvo[0]); PG8_STAGE(PG8_SA(0, 1), gA, cvo[1]);
    if (wr == 1) PG8_BAR;
    PG8_WAIT_V(2); PG8_BAR;
    PG8_STAGE(PG8_SB(1, 0), cB + kstep, voffB); PG8_STAGE(PG8_SA(1, 0), gA + kstep, cvo[0]); PG8_STAGE(PG8_SB(1, 1), cB + hstep + kstep, voffB);
    PG8_WAIT_V(6); PG8_BAR;
    for (;;) {
        const bool has_next = S.next(ui + 1, nxt);
        if (has_next) { PG8_AOFF(nvo, nxt); } else {
#pragma unroll
            for (int _h = 0; _h < 2; ++_h)
#pragma unroll
                for (int _i = 0; _i < 2; ++_i) nvo[_h][_i] = cvo[_h][_i]; }
        const char* nB = has_next ? (const char*)g.Bt + (size_t)nxt.pn * tstep : cB;
        for (int t = 0; t < nt; t += 2) {
            const bool last = (t == nt - 2);
            const char* a1 = gA + (size_t)(t + 1) * kstep;
            const char* a2 = last ? gA : gA + (size_t)(t + 2) * kstep; const char* b2 = last ? nB : cB + (size_t)(t + 2) * kstep;
            const char* a3 = a2 + kstep; const char* b3 = b2 + kstep;
            unsigned v20[2], v21[2];
#pragma unroll
            for (int _i = 0; _i < 2; ++_i) { v20[_i] = last ? nvo[0][_i] : cvo[0][_i]; v21[_i] = last ? nvo[1][_i] : cvo[1][_i]; }
            PG8_LDB(B0, 0, 0); PG8_LDB(B1, 0, 1); PG8_SCHED; PG8_LDA(At, 0, 0); PG8_STAGE(PG8_SA(1, 1), a1, cvo[1]);
            PG8_WAIT_V(8); PG8_WAIT_L(0); PG8_BAR; PG8_MMA(0, 0, At, B0); PG8_MMA(0, 1, At, B1); PG8_BAR; PG8_SCHED;
            PG8_LDA(At, 0, 1); PG8_STAGE(PG8_SB(0, 0), b2, voffB); PG8_STAGE(PG8_SB(0, 1), b2 + hstep, voffB); PG8_STAGE(PG8_SA(0, 0), a2, v20);
            PG8_WAIT_V(8); PG8_WAIT_L(0); PG8_BAR; PG8_MMA(1, 0, At, B0); PG8_MMA(1, 1, At, B1); PG8_BAR; PG8_SCHED;
            PG8_LDB(B0, 1, 0); PG8_LDB(B1, 1, 1); PG8_SCHED; PG8_LDA(At, 1, 0); PG8_STAGE(PG8_SA(0, 1), a2, v21);
            PG8_WAIT_V(8); PG8_WAIT_L(0); PG8_BAR; PG8_MMA(0, 0, At, B0); PG8_MMA(0, 1, At, B1); PG8_BAR; PG8_SCHED;
            PG8_LDA(At, 1, 1); PG8_STAGE(PG8_SB(1, 0), b3, voffB); PG8_STAGE(PG8_SB(1, 1), b3 + hstep, voffB); PG8_STAGE(PG8_SA(1, 0), a3, v20);
            PG8_WAIT_V(8); PG8_WAIT_L(0); PG8_BAR; PG8_MMA(1, 0, At, B0); PG8_MMA(1, 1, At, B1); PG8_BAR; PG8_SCHED;
        }
        if (wr == 0) PG8_BAR;
        E(acc, cur, wr, wc, fr, fq);
        if (!has_next) break;
#pragma unroll
        for (int a = 0; a < 2; ++a)
#pragma unroll
            for (int b = 0; b < 2; ++b)
#pragma unroll
                for (int m = 0; m < 4; ++m)
#pragma unroll
                    for (int n = 0; n < 2; ++n) acc[a][b][m][n] = (f32x4){0.f, 0.f, 0.f, 0.f};
        cur = nxt; cB = nB; ++ui;
#pragma unroll
        for (int _h = 0; _h < 2; ++_h)
#pragma unroll
            for (int _i = 0; _i < 2; ++_i) cvo[_h][_i] = nvo[_h][_i];
        if (wr == 1) PG8_BAR;
    }
    PG8_WAIT_V(0);
    PG8_BAR;
#undef PG8_SA
#undef PG8_SB
#undef PG8_STAGE
#undef PG8_LDA
#undef PG8_LDB
#undef PG8_MMA
#undef PG8_WAIT_V
#undef PG8_WAIT_L
#undef PG8_BAR
#undef PG8_SCHED
#undef PG8_AOFF
}
}
template <class E4> DI void fast_gemm(const Ctx& C, const bf16* A, int lda, const bf16* Bt, int K, int nM, int nN, const E4& e, bool rev = false) {
    pg8::Gemm g{A, Bt, lda, K, nullptr}; pg8::OrderMN S{nM, nN, C.nb, rev ? C.nb - 1 - C.vcu : C.vcu}; pg8::EpiAdapt<E4> E{e};
    pg8::gemm_phase(C.lds, g, S, E, C.tid);
}

DI int swap23(int x) { return (x & ~12) | ((x & 4) << 1) | ((x & 8) >> 1); }
template <int DQK, bool NAT>
DI void flash_range(f32x16 (&o)[2], float& m, float& l, const bf16x8 (&qf)[DQK / 16], const bf16* __restrict__ Kb, const bf16* __restrict__ Vt, int pos0, int nblk, int r, int h,
                    const LAS float* tab, int qc, int cs, int drow0) {
    const int kr = swap23(r);
    for (int blk = 0; blk < nblk; ++blk) {
        const int pos = pos0 + 32 * blk;
        f32x16 s;
#pragma unroll
        for (int i = 0; i < 16; ++i) s[i] = 0.f;
        const bf16* kp = Kb + (size_t)(pos + kr) * DQK + 8 * h;
#pragma unroll
        for (int kk = 0; kk < DQK / 16; ++kk) s = MFMA32(*(const bf16x8*)(kp + 16 * kk), qf[kk], s);
        if (NAT) {
            const int irow = blk >> 1, cc0 = (blk & 1) * 32;
            const LAS float* trow = tab + (drow0 + irow) * 31;
#pragma unroll
            for (int i = 0; i < 16; ++i) {
                const int kib = (i & 3) | (((i >> 2) & 1) << 2) | (h << 3) | ((i >> 3) << 4);
                const int cc = cc0 + kib; const bool ok = (cc >= cs) && (cc < cs + 16);
                int dc = cc - qc + 15; dc = dc < 0 ? 0 : (dc > 30 ? 30 : dc);
                s[i] = ok ? s[i] + trow[dc] : -1e30f;
            }
        }
        float mx = s[0];
#pragma unroll
        for (int i = 1; i < 16; ++i) mx = fmaxf(mx, s[i]);
        mx = fmaxf(mx, xor32(mx, r + 32 * h));
        const float mn = fmaxf(m, mx), alpha = __builtin_amdgcn_exp2f(m - mn);
        float rs = 0.f; f32x16 p;
#pragma unroll
        for (int i = 0; i < 16; ++i) { float e = __builtin_amdgcn_exp2f(s[i] - mn); if (NAT) e = (s[i] > -1e29f) ? e : 0.f; p[i] = e; rs += e; }
        rs += xor32(rs, r + 32 * h);
        l = l * alpha + rs; m = mn;
#pragma unroll
        for (int i = 0; i < 16; ++i) { o[0][i] *= alpha; o[1][i] *= alpha; }
#pragma unroll
        for (int s2 = 0; s2 < 2; ++s2) {
            u32x4 pw; pw.x = pk2(p[8 * s2], p[8 * s2 + 1]); pw.y = pk2(p[8 * s2 + 2], p[8 * s2 + 3]); pw.z = pk2(p[8 * s2 + 4], p[8 * s2 + 5]); pw.w = pk2(p[8 * s2 + 6], p[8 * s2 + 7]);
            const bf16x8 pb = __builtin_bit_cast(bf16x8, pw);
#pragma unroll
            for (int dt = 0; dt < 2; ++dt) { const bf16x8 va = *(const bf16x8*)(Vt + (size_t)(32 * dt + r) * KPOS + pos + 16 * s2 + 8 * h); o[dt] = MFMA32(va, pb, o[dt]); }
        }
    }
}
DI void flash_store(const f32x16 (&o)[2], float l, bf16* orow  , int h) {
    const float inv = 1.f / l;
#pragma unroll
    for (int dt = 0; dt < 2; ++dt)
#pragma unroll
        for (int g = 0; g < 4; ++g)
            *(u32x2*)(orow + 32 * dt + 8 * g + 4 * h) = (u32x2){pk2(o[dt][4 * g] * inv, o[dt][4 * g + 1] * inv), pk2(o[dt][4 * g + 2] * inv, o[dt][4 * g + 3] * inv)};
}

DI void ph_attn_mla(const Ctx& C, const bf16* QB, const bf16* KB, const bf16* VT, bf16* OCAT, bool last) {
    const int r = C.lane & 31, h = C.lane >> 5;
    for (int u = C.vcu; u < 64 * 17; u += C.nb) {
        const int bh = u / 17, qblk = u % 17, b = bh >> 3, hh = bh & 7;
        if (last && qblk == 16) continue;
        const int qpos = qblk * 256 + 32 * C.wave + r;
        const bf16* qp = QB + ((size_t)bh * KPOS + qpos) * 96 + 8 * h;
        bf16x8 qf[6];
#pragma unroll
        for (int kk = 0; kk < 6; ++kk) qf[kk] = *(const bf16x8*)(qp + 16 * kk);
        f32x16 o[2];
#pragma unroll
        for (int i = 0; i < 16; ++i) { o[0][i] = 0.f; o[1][i] = 0.f; }
        float m = -1e30f, l = 0.f;
        flash_range<96, false>(o, m, l, qf, KB + (size_t)bh * KPOS * 96, VT + (size_t)bh * 64 * KPOS, qblk < 16 ? 0 : TL, qblk < 16 ? KPOS / 32 : LCX / 32, r, h, nullptr, 0, 0, 0);
        const int row = qblk < 16 ? b * TL + qpos : NLAT + b * LCX + (qpos - TL);
        flash_store(o, l, OCAT + (size_t)row * DM + hh * 64, h);
    }
}

template <int DQK> struct AttnGeo { static constexpr int KSTR = DQK * 2 + 16, KBYTES = 64 * KSTR, VSTR = 144, VBYTES = 64 * VSTR, BUF = KBYTES + VBYTES, KPIECES = 64 * DQK / 8; };
template <int DQK, bool NAT>
DI void attn_tile_loop(const Ctx& C, f32x16 (&o)[2], float& l, const bf16x8 (&qf)[DQK / 16], const bf16* __restrict__ Kb, const bf16* __restrict__ Vt, int pos1, int n1, int pos2, int n2,
                       const LAS float* tab, int grow, int rs, int qc, int cs) {
    typedef AttnGeo<DQK> G;
    const int tid = C.tid, r = C.lane & 31, h = C.lane >> 5, kr = swap23(r), ntiles = n1 + n2;
    constexpr bool K2 = G::KPIECES > 512;
    const int kq0 = tid, kq1 = tid + 512;
    const int kl0 = (kq0 / (DQK / 8)) * G::KSTR + (kq0 % (DQK / 8)) * 16, kl1 = (kq1 / (DQK / 8)) * G::KSTR + (kq1 % (DQK / 8)) * 16;
    const int vl = G::KBYTES + (tid >> 3) * G::VSTR + (tid & 7) * 16;
    const bf16* vg = Vt + (size_t)(tid >> 3) * KPOS + 8 * (tid & 7);
    u32x4 rk0, rk1, rv;
    rk1 = (u32x4){0u, 0u, 0u, 0u};
#define ATT_POS(t) ((t) < n1 ? pos1 + 64 * (t) : pos2 + 64 * ((t) - n1))
    { const int pos0 = ATT_POS(0); rk0 = *(const u32x4*)(Kb + (size_t)pos0 * DQK + 8 * kq0); if (K2 && tid < 256) rk1 = *(const u32x4*)(Kb + (size_t)pos0 * DQK + 8 * kq1); rv = *(const u32x4*)(vg + pos0); }
    __syncthreads();
    *(LAS u32x4*)(C.lds + kl0) = rk0; if (K2 && tid < 256) *(LAS u32x4*)(C.lds + kl1) = rk1; *(LAS u32x4*)(C.lds + vl) = rv;
    __syncthreads();
    float mref = 0.f; bool first = true;
    constexpr float THR = 8.f;
    for (int t = 0; t < ntiles; ++t) {
        const LAS unsigned char* B = C.lds + (t & 1) * G::BUF;
        if (t + 1 < ntiles) { const int pos0 = ATT_POS(t + 1);
            rk0 = *(const u32x4*)(Kb + (size_t)pos0 * DQK + 8 * kq0); if (K2 && tid < 256) rk1 = *(const u32x4*)(Kb + (size_t)pos0 * DQK + 8 * kq1); rv = *(const u32x4*)(vg + pos0); }
        const int gr = (pos1 >> 6) + t;
        const bool active = !NAT || t >= n1 || (gr >= rs && gr < rs + 8);
        if (active) {
            f32x16 sc[2];
#pragma unroll
            for (int j = 0; j < 2; ++j) {
#pragma unroll
                for (int i = 0; i < 16; ++i) sc[j][i] = -mref;
                const LAS unsigned char* kp = B + (32 * j + kr) * G::KSTR + 16 * h;
#pragma unroll
                for (int kk = 0; kk < DQK / 16; ++kk) sc[j] = MFMA32(*(const LAS bf16x8*)(kp + 32 * kk), qf[kk], sc[j]);
            }
            if (NAT && t < n1) {
                const LAS float* trow = tab + (gr - grow + 7) * 31;
#pragma unroll
                for (int j = 0; j < 2; ++j)
#pragma unroll
                    for (int i = 0; i < 16; ++i) {
                        const int cc = 32 * j + ((i & 3) | (((i >> 2) & 1) << 2) | (h << 3) | ((i >> 3) << 4)); const bool ok = (cc >= cs) && (cc < cs + 16);
                        int dc = cc - qc + 15; dc = dc < 0 ? 0 : (dc > 30 ? 30 : dc);
                        sc[j][i] = ok ? sc[j][i] + trow[dc] : -1e30f;
                    }
            }
            float mx = fmaxf(sc[0][0], sc[1][0]);
#pragma unroll
            for (int i = 1; i < 16; ++i) mx = fmaxf(mx, fmaxf(sc[0][i], sc[1][i]));
            mx = fmaxf(mx, xor32(mx, C.lane));
            if (first || __builtin_amdgcn_ballot_w64(mx > THR) != 0ull) {
                const float delta = first ? mx : fmaxf(mx, 0.f);
#pragma unroll
                for (int i = 0; i < 16; ++i) { sc[0][i] -= delta; sc[1][i] -= delta; }
                if (!first) { const float alpha = __builtin_amdgcn_exp2f(-delta); l *= alpha;
#pragma unroll
                    for (int i = 0; i < 16; ++i) { o[0][i] *= alpha; o[1][i] *= alpha; } }
                mref += delta; first = false;
            }
            f32x2 rs2 = {0.f, 0.f};
#pragma unroll
            for (int j = 0; j < 2; ++j)
#pragma unroll
                for (int i = 0; i < 16; i += 2) { sc[j][i] = __builtin_amdgcn_exp2f(sc[j][i]); sc[j][i + 1] = __builtin_amdgcn_exp2f(sc[j][i + 1]); rs2 += (f32x2){sc[j][i], sc[j][i + 1]}; }
            float rsum = rs2.x + rs2.y;
            rsum += xor32(rsum, C.lane);
            l += rsum;
#pragma unroll
            for (int j = 0; j < 2; ++j)
#pragma unroll
                for (int s2 = 0; s2 < 2; ++s2) {
                    u32x4 pw; pw.x = pk2(sc[j][8 * s2], sc[j][8 * s2 + 1]); pw.y = pk2(sc[j][8 * s2 + 2], sc[j][8 * s2 + 3]); pw.z = pk2(sc[j][8 * s2 + 4], sc[j][8 * s2 + 5]); pw.w = pk2(sc[j][8 * s2 + 6], sc[j][8 * s2 + 7]);
                    const bf16x8 pb = __builtin_bit_cast(bf16x8, pw);
#pragma unroll
                    for (int dt = 0; dt < 2; ++dt) o[dt] = MFMA32(*(const LAS bf16x8*)(B + G::KBYTES + (32 * dt + r) * G::VSTR + (32 * j + 16 * s2 + 8 * h) * 2), pb, o[dt]);
                }
        }
        if (t + 1 < ntiles) { LAS unsigned char* Bn = C.lds + ((t + 1) & 1) * G::BUF;
            *(LAS u32x4*)(Bn + kl0) = rk0; if (K2 && tid < 256) *(LAS u32x4*)(Bn + kl1) = rk1; *(LAS u32x4*)(Bn + vl) = rv; }
        __syncthreads();
    }
#undef ATT_POS
}
DI void ph_attn_mla2(const Ctx& C, const bf16* QB, const bf16* KB, const bf16* VT, bf16* OCAT, bool last) {
    const int r = C.lane & 31, h = C.lane >> 5;
    const int nunits = 1024 + (last ? 0 : 64);
    for (int u = C.vcu; u < nunits; u += C.nb) {
        const int bh = u < 1024 ? (u >> 4) : u - 1024, qblk = u < 1024 ? (u & 15) : 16, b = bh >> 3, hh = bh & 7;
        const int qpos = qblk * 256 + 32 * C.wave + r;
        const bf16* qp = QB + ((size_t)bh * KPOS + qpos) * 96 + 8 * h;
        bf16x8 qf[6];
#pragma unroll
        for (int kk = 0; kk < 6; ++kk) qf[kk] = *(const bf16x8*)(qp + 16 * kk);
        f32x16 o[2];
#pragma unroll
        for (int i = 0; i < 16; ++i) { o[0][i] = 0.f; o[1][i] = 0.f; }
        float l = 0.f;
        attn_tile_loop<96, false>(C, o, l, qf, KB + (size_t)bh * KPOS * 96, VT + (size_t)bh * 64 * KPOS, qblk < 16 ? 0 : TL, qblk < 16 ? KPOS / 64 : LCX / 64, 0, 0, nullptr, 0, 0, 0, 0);
        const int row = qblk < 16 ? b * TL + qpos : NLAT + b * LCX + (qpos - TL);
        flash_store(o, l, OCAT + (size_t)row * DM + hh * 64, h);
    }
}

DI void ph_natten2(const Ctx& C, const bf16* QN, const bf16* KN, const bf16* VTN, bf16* OCAT, const float* rpb  , bool last) {
    const int r = C.lane & 31, h = C.lane >> 5;
    LAS float* tab = (LAS float*)(C.lds + 2 * AttnGeo<64>::BUF);
    const int nunits = 1024 + (last ? 0 : 64);
    for (int u = C.vcu; u < nunits; u += C.nb) {
        const bool isctx = u >= 1024;
        const int bh = isctx ? u - 1024 : (u >> 4), b = bh >> 3, hh = bh & 7;
        __syncthreads();
        for (int i = C.tid; i < 465; i += 512) tab[i] = rpb[hh * 465 + i] * LOG2E;
        int qpos, row, grow = 0, qc = 0, rs = 0, cs = 0, rlo = 0, nband = 0;
        if (!isctx) { const int rg = u & 15; grow = 4 * rg + (C.wave >> 1); qc = 32 * (C.wave & 1) + r; qpos = grow * 64 + qc; row = b * TL + qpos;
            rs = grow - 4; rs = rs < 0 ? 0 : (rs > 56 ? 56 : rs); cs = qc - 8; cs = cs < 0 ? 0 : (cs > 48 ? 48 : cs);
            rlo = 4 * rg - 4; rlo = rlo < 0 ? 0 : (rlo > 56 ? 56 : rlo); int rhi = 4 * rg + 3 - 4; rhi = rhi < 0 ? 0 : (rhi > 56 ? 56 : rhi); nband = rhi + 8 - rlo; }
        else { qpos = TL + 32 * C.wave + r; row = NLAT + b * LCX + 32 * C.wave + r; }
        const bf16* qp = QN + ((size_t)bh * KPOS + qpos) * 64 + 8 * h;
        bf16x8 qf[4];
#pragma unroll
        for (int kk = 0; kk < 4; ++kk) qf[kk] = *(const bf16x8*)(qp + 16 * kk);
        f32x16 o[2];
#pragma unroll
        for (int i = 0; i < 16; ++i) { o[0][i] = 0.f; o[1][i] = 0.f; }
        float l = 0.f;
        attn_tile_loop<64, true>(C, o, l, qf, KN + (size_t)bh * KPOS * 64, VTN + (size_t)bh * 64 * KPOS, rlo * 64, nband, TL, LCX / 64, tab, grow, rs, qc, cs);
        flash_store(o, l, OCAT + (size_t)row * DM + 512 + hh * 64, h);
    }
}

DI void ph_natten(const Ctx& C, const bf16* QN, const bf16* KN, const bf16* VTN, bf16* OCAT, const float* rpb  , bool last) {
    const int r = C.lane & 31, h = C.lane >> 5;
    LAS float* tab = (LAS float*)C.lds;
    const int nunits = 1024 + (last ? 0 : 64);
    for (int u = C.vcu; u < nunits; u += C.nb) {
        const bool isctx = u >= 1024;
        const int bh = isctx ? u - 1024 : (u >> 4), b = bh >> 3, hh = bh & 7;
        __syncthreads();
        for (int i = C.tid; i < 465; i += 512) tab[i] = rpb[hh * 465 + i] * LOG2E;
        __syncthreads();
        int qpos, row, grow = 0, qc = 0, rs = 0, cs = 0;
        if (!isctx) { const int rg = u & 15; grow = 4 * rg + (C.wave >> 1); qc = 32 * (C.wave & 1) + r; qpos = grow * 64 + qc; row = b * TL + qpos;
            rs = grow - 4; rs = rs < 0 ? 0 : (rs > 56 ? 56 : rs); cs = qc - 8; cs = cs < 0 ? 0 : (cs > 48 ? 48 : cs); }
        else { qpos = TL + 32 * C.wave + r; row = NLAT + b * LCX + 32 * C.wave + r; }
        const bf16* qp = QN + ((size_t)bh * KPOS + qpos) * 64 + 8 * h;
        bf16x8 qf[4];
#pragma unroll
        for (int kk = 0; kk < 4; ++kk) qf[kk] = *(const bf16x8*)(qp + 16 * kk);
        f32x16 o[2];
#pragma unroll
        for (int i = 0; i < 16; ++i) { o[0][i] = 0.f; o[1][i] = 0.f; }
        float m = -1e30f, l = 0.f;
        const bf16* Kb = KN + (size_t)bh * KPOS * 64; const bf16* Vt = VTN + (size_t)bh * 64 * KPOS;
        if (!isctx) flash_range<64, true>(o, m, l, qf, Kb, Vt, rs * 64, 16, r, h, tab, qc, cs, rs - grow + 7);
        flash_range<64, false>(o, m, l, qf, Kb, Vt, TL, LCX / 32, r, h, nullptr, 0, 0, 0);
        flash_store(o, l, OCAT + (size_t)row * DM + 512 + hh * 64, h);
    }
}

DI void ph_mla_fin(const Ctx& C, const bf16* U, const float* QPRE, const float* KVPRE, const float* qg, const float* kg, const f32x2* CS, bf16* QB, bf16* KB, bf16* VT) {
    LAS bf16* VL = (LAS bf16*)C.lds;
    const int lane = C.lane, j = lane >> 3, sub = lane & 7;
    const float C2 = 0.10206207261596575f * LOG2E;
    float qgn[8], qgr[4], kgn[8], kgr[4];
#pragma unroll
    for (int e = 0; e < 8; ++e) { qgn[e] = qg[8 * sub + e] * C2; kgn[e] = kg[8 * sub + e]; }
#pragma unroll
    for (int m = 0; m < 4; ++m) { qgr[m] = qg[64 + sub + 8 * m] * C2; kgr[m] = kg[64 + sub + 8 * m]; }
    for (int u = C.vcu; u < MT / 64; u += C.nb) {
        const int row0 = 64 * u, b = row0 < NLAT ? (row0 >> 12) : ((row0 - NLAT) >> 8), pos0 = row0 < NLAT ? (row0 & 4095) : TL + ((row0 - NLAT) & 255);
        const bool lat = row0 < NLAT;
        const int pl = 8 * C.wave + j, row = row0 + pl, pos = pos0 + pl;
        const bf16* ur = U + (size_t)row * EV_INP;
        float sq = 0.f, skv = 0.f;
#pragma unroll
        for (int m = 0; m < 6; ++m) { float x[8]; unpack8(*(const u32x4*)(ur + 8 * (sub + 8 * m)), x);
#pragma unroll
            for (int e = 0; e < 8; ++e) sq += x[e] * x[e]; }
#pragma unroll
        for (int m = 0; m < 4; ++m) { float x[8]; unpack8(*(const u32x4*)(ur + 384 + 8 * (sub + 8 * m)), x);
#pragma unroll
            for (int e = 0; e < 8; ++e) skv += x[e] * x[e]; }
        sq = sum8(sq); skv = sum8(skv);
        const float rsq = 1.0f / sqrtf(sq * (1.f / 384.f) + EPS), rskv = 1.0f / sqrtf(skv * (1.f / 256.f) + EPS);
        float krv[4];
#pragma unroll
        for (int m = 0; m < 4; ++m) krv[m] = bf2f(ur[640 + sub + 8 * m]);
        float cr = 1.f, sr = 0.f, cc = 1.f, sc = 0.f;
        if (lat) { const f32x2 a0 = CS[pos * 16 + sub], a1 = CS[pos * 16 + 8 + sub]; cr = a0.x; sr = a0.y; cc = a1.x; sc = a1.y; }
        const float* qrow = QPRE + (size_t)row * 768; const float* kvrow = KVPRE + (size_t)row * 1024;
#pragma unroll 2
        for (int hh = 0; hh < 8; ++hh) {
            { const f32x4 n0 = *(const f32x4*)(qrow + hh * 96 + 8 * sub), n1 = *(const f32x4*)(qrow + hh * 96 + 8 * sub + 4);
              float qn[8] = {n0.x * rsq, n0.y * rsq, n0.z * rsq, n0.w * rsq, n1.x * rsq, n1.y * rsq, n1.z * rsq, n1.w * rsq}, qr[4]; float ss = 0.f;
#pragma unroll
              for (int m = 0; m < 4; ++m) { qr[m] = qrow[hh * 96 + 64 + sub + 8 * m] * rsq; ss += qr[m] * qr[m]; }
#pragma unroll
              for (int e = 0; e < 8; ++e) ss += qn[e] * qn[e];
              const float rn = 1.0f / sqrtf(sum8(ss) * (1.f / 96.f) + EPS);
#pragma unroll
              for (int e = 0; e < 8; ++e) qn[e] *= rn * qgn[e];
#pragma unroll
              for (int m = 0; m < 4; ++m) qr[m] *= rn * qgr[m];
              { const float x0 = qr[0], x1 = qr[1], y0 = qr[2], y1 = qr[3]; qr[0] = x0 * cr - x1 * sr; qr[1] = x1 * cr + x0 * sr; qr[2] = y0 * cc - y1 * sc; qr[3] = y1 * cc + y0 * sc; }
              bf16* qo = QB + ((size_t)(b * 8 + hh) * KPOS + pos) * 96;
              *(u32x4*)(qo + 8 * sub) = pack8(qn);
#pragma unroll
              for (int m = 0; m < 4; ++m) qo[64 + sub + 8 * m] = f2bf(qr[m]); }
            { const f32x4 n0 = *(const f32x4*)(kvrow + hh * 128 + 8 * sub), n1 = *(const f32x4*)(kvrow + hh * 128 + 8 * sub + 4);
              float kn[8] = {n0.x * rskv, n0.y * rskv, n0.z * rskv, n0.w * rskv, n1.x * rskv, n1.y * rskv, n1.z * rskv, n1.w * rskv}, kr[4]; float ss = 0.f;
#pragma unroll
              for (int m = 0; m < 4; ++m) { kr[m] = krv[m]; ss += kr[m] * kr[m]; }
#pragma unroll
              for (int e = 0; e < 8; ++e) ss += kn[e] * kn[e];
              const float rn = 1.0f / sqrtf(sum8(ss) * (1.f / 96.f) + EPS);
#pragma unroll
              for (int e = 0; e < 8; ++e) kn[e] *= rn * kgn[e];
#pragma unroll
              for (int m = 0; m < 4; ++m) kr[m] *= rn * kgr[m];
              { const float x0 = kr[0], x1 = kr[1], y0 = kr[2], y1 = kr[3]; kr[0] = x0 * cr - x1 * sr; kr[1] = x1 * cr + x0 * sr; kr[2] = y0 * cc - y1 * sc; kr[3] = y1 * cc + y0 * sc; }
              bf16* ko = KB + ((size_t)(b * 8 + hh) * KPOS + pos) * 96;
              *(u32x4*)(ko + 8 * sub) = pack8(kn);
#pragma unroll
              for (int m = 0; m < 4; ++m) ko[64 + sub + 8 * m] = f2bf(kr[m]); }
            { const f32x4 v0 = *(const f32x4*)(kvrow + hh * 128 + 64 + 8 * sub), v1 = *(const f32x4*)(kvrow + hh * 128 + 64 + 8 * sub + 4);
              const float vv[8] = {v0.x, v0.y, v0.z, v0.w, v1.x, v1.y, v1.z, v1.w};
#pragma unroll
              for (int e = 0; e < 8; ++e) VL[(hh * 64 + 8 * sub + e) * 64 + pl] = f2bf(vv[e] * rskv); }
        }
        __syncthreads();
        { const int hd = C.tid;
            bf16* dst = VT + ((size_t)(b * 8 + (hd >> 6)) * 64 + (hd & 63)) * KPOS + pos0;
#pragma unroll
            for (int q = 0; q < 8; ++q) *(u32x4*)(dst + 8 * q) = *(const LAS u32x4*)(VL + hd * 64 + 8 * q); }
        __syncthreads();
    }
}

DI void ph_conv(const Ctx& C, const bf16* U, const float* dww  , const float* dwb, const float* lng, const float* lnb, bf16* OCAT) {
    LAS float* G = (LAS float*)C.lds;
    const int c = C.tid;
    float wk[31];
#pragma unroll
    for (int k = 0; k < 31; ++k) wk[k] = dww[k * 512 + c];
    const float bias = dwb[c];
    for (int u = C.nb - 1 - C.vcu; u < MT / 32; u += C.nb) {
        const int row0 = 32 * u; int base, t0, tseq;
        if (row0 < NLAT) { base = row0 & ~4095; t0 = row0 & 4095; tseq = TL; } else { const int rc = row0 - NLAT; base = NLAT + (rc & ~255); t0 = rc & 255; tseq = LCX; }
        __syncthreads();
        for (int rr = C.wave; rr < 62; rr += 8) { const int tt = t0 - 15 + rr; float g[8];
#pragma unroll
            for (int e = 0; e < 8; ++e) g[e] = 0.f;
            if (tt >= 0 && tt < tseq) { const bf16* ur = U + (size_t)(base + tt) * EV_INP; float av[8], gv[8]; unpack8(*(const u32x4*)(ur + 672 + 8 * C.lane), av); unpack8(*(const u32x4*)(ur + 1184 + 8 * C.lane), gv);
#pragma unroll
                for (int e = 0; e < 8; ++e) g[e] = av[e] * sigmoidf_(gv[e]); }
            *(LAS f32x4*)(G + rr * 512 + 8 * C.lane) = (f32x4){g[0], g[1], g[2], g[3]}; *(LAS f32x4*)(G + rr * 512 + 8 * C.lane + 4) = (f32x4){g[4], g[5], g[6], g[7]}; }
        __syncthreads();
        float acc[32];
#pragma unroll
        for (int t = 0; t < 32; ++t) acc[t] = bias;
#pragma unroll
        for (int rr = 0; rr < 62; ++rr) { const float gv = G[rr * 512 + c];
#pragma unroll
            for (int t = 0; t < 32; ++t) { const int k = rr - t; if (k >= 0 && k < 31) acc[t] += gv * wk[k]; } }
        __syncthreads();
#pragma unroll
        for (int t = 0; t < 32; ++t) G[t * 512 + c] = acc[t];
        __syncthreads();
#pragma unroll
        for (int q = 0; q < 4; ++q) {
            const int t = 4 * C.wave + q, row = row0 + t;
            const f32x4 a0 = *(const LAS f32x4*)(G + t * 512 + 8 * C.lane), a1 = *(const LAS f32x4*)(G + t * 512 + 8 * C.lane + 4);
            float x[8] = {a0.x, a0.y, a0.z, a0.w, a1.x, a1.y, a1.z, a1.w}; float s = 0.f;
#pragma unroll
            for (int e = 0; e < 8; ++e) s += x[e];
            const float mu = wave_sum(s) * (1.f / 512.f); float s2 = 0.f;
#pragma unroll
            for (int e = 0; e < 8; ++e) { x[e] -= mu; s2 += x[e] * x[e]; }
            const float rstd = 1.0f / sqrtf(wave_sum(s2) * (1.f / 512.f) + EPS);
            float y[8];
#pragma unroll
            for (int e = 0; e < 8; ++e) { const float z = x[e] * rstd * lng[8 * C.lane + e] + lnb[8 * C.lane + e]; y[e] = siluf_(z); }
            *(u32x4*)(OCAT + (size_t)row * DM + 512 + 8 * C.lane) = pack8(y);
        }
    }
}

DI void shifted8(const bf16* up, const bf16* uc, const bf16* un, bool hp, bool hn, const float* sw, int c0, float (&o)[8]) {
    const u32x4 z = {0u, 0u, 0u, 0u};
    const u32x4 vp = hp ? *(const u32x4*)(up + c0) : z, vc = *(const u32x4*)(uc + c0), vn = hn ? *(const u32x4*)(un + c0) : z;
    float p[8], c[8], n[8]; unpack8(vp, p); unpack8(vc, c); unpack8(vn, n);
#pragma unroll
    for (int e = 0; e < 8; ++e) o[e] = p[e] * sw[c0 + e] + c[e] * sw[RW_IN + c0 + e] + n[e] * sw[2 * RW_IN + c0 + e];
}
DI void ph_prep(const Ctx& C, const bf16* U, const float* sw  , const float* kkw  , const float* naqg, const float* nakg,
                bf16* R, bf16* V, bf16* K, bf16* KK, bf16* L, bf16* QN, bf16* KN, bf16* VTN) {
    LAS bf16* VL = (LAS bf16*)C.lds;
    const int lane = C.lane, hh = lane >> 3, sub = lane & 7;
    const float C2 = 0.125f * LOG2E;
    for (int u = C.vcu; u < MT / 32; u += C.nb) {
        const int row0 = 32 * u; const bool lat = row0 < NLAT;
        const int b = lat ? (row0 >> 12) : ((row0 - NLAT) >> 8), pos0 = lat ? (row0 & 4095) : TL + ((row0 - NLAT) & 255), tseq = lat ? TL : LCX, tb = lat ? (row0 & 4095) : ((row0 - NLAT) & 255);
        for (int i = 0; i < 4; ++i) {
            const int pl = 4 * C.wave + i, row = row0 + pl, pos = pos0 + pl, t = tb + pl;
            const bool hp = t > 0, hn = t < tseq - 1;
            const bf16* uc = U + (size_t)row * OD_INP; const bf16* up = uc - OD_INP; const bf16* un = uc + OD_INP;
            float o[8];
            shifted8(up, uc, un, hp, hn, sw, 8 * lane, o);          *(u32x4*)(R + (size_t)row * 512 + 8 * lane) = pack8(o);
            shifted8(up, uc, un, hp, hn, sw, 1024 + 8 * lane, o);   *(u32x4*)(V + (size_t)row * 512 + 8 * lane) = pack8(o);
            shifted8(up, uc, un, hp, hn, sw, 512 + 8 * lane, o);    *(u32x4*)(K + (size_t)row * 512 + 8 * lane) = pack8(o);
            { float kk[8]; float ss = 0.f;
#pragma unroll
                for (int e = 0; e < 8; ++e) { kk[e] = o[e] * kkw[8 * lane + e]; ss += kk[e] * kk[e]; }
                ss = sum8(ss); const float rn = 1.0f / sqrtf(ss + 1e-12f);
#pragma unroll
                for (int e = 0; e < 8; ++e) kk[e] *= rn;
                *(u32x4*)(KK + (size_t)row * 512 + 8 * lane) = pack8(kk); }
            if (lane < 48) {
                shifted8(up, uc, un, hp, hn, sw, 1536 + 8 * lane, o);
                if (lane < 16) {
#pragma unroll
                    for (int e = 0; e < 8; ++e) { const float ex = __expf(2.f * o[e]); o[e] = 1.f - 2.f / (ex + 1.f); }
                } else if (lane >= 32) {
#pragma unroll
                    for (int e = 0; e < 8; ++e) o[e] = sigmoidf_(o[e]);
                }
                *(u32x4*)(L + (size_t)row * 384 + 8 * lane) = pack8(o);
            }
            { float x[8]; unpack8(*(const u32x4*)(uc + RW_IN + 8 * lane), x); float ss = 0.f;
#pragma unroll
                for (int e = 0; e < 8; ++e) ss += x[e] * x[e];
                ss = sum8(ss); const float rn = 1.0f / sqrtf(ss * (1.f / 64.f) + EPS);
#pragma unroll
                for (int e = 0; e < 8; ++e) x[e] = x[e] * rn * naqg[8 * sub + e] * C2;
                *(u32x4*)(QN + ((size_t)(b * 8 + hh) * KPOS + pos) * 64 + 8 * sub) = pack8(x); }
            { float x[8]; unpack8(*(const u32x4*)(uc + RW_IN + 512 + 8 * lane), x); float ss = 0.f;
#pragma unroll
                for (int e = 0; e < 8; ++e) ss += x[e] * x[e];
                ss = sum8(ss); const float rn = 1.0f / sqrtf(ss * (1.f / 64.f) + EPS);
#pragma unroll
                for (int e = 0; e < 8; ++e) x[e] = x[e] * rn * nakg[8 * sub + e];
                *(u32x4*)(KN + ((size_t)(b * 8 + hh) * KPOS + pos) * 64 + 8 * sub) = pack8(x); }
            { const u32x4 vv = *(const u32x4*)(uc + RW_IN + 1024 + 8 * lane); const unsigned w4[4] = {vv.x, vv.y, vv.z, vv.w};
#pragma unroll
                for (int e = 0; e < 8; ++e) { const int dv = 8 * sub + e; VL[(hh * 64 + dv) * 32 + pl] = (bf16)((e & 1) ? (w4[e >> 1] >> 16) : (w4[e >> 1] & 0xffffu)); } }
        }
        __syncthreads();
        { const int hd = C.tid; bf16* dst = VTN + ((size_t)(b * 8 + (hd >> 6)) * 64 + (hd & 63)) * KPOS + pos0;
#pragma unroll
            for (int q = 0; q < 4; ++q) *(u32x4*)(dst + 8 * q) = *(const LAS u32x4*)(VL + hd * 32 + 8 * q); }
        __syncthreads();
    }
}

DI int scan_row(int s, int d, int b) { if (s < LCX) return NLAT + b * LCX + (d ? (LCX - 1 - s) : s); const int t = s - LCX; return b * TL + (d ? (TL - 1 - t) : t); }
DI void ph_scan(const Ctx& C, const bf16* R, const bf16* V, const bf16* KK, const float* W, const bf16* KEFF, const bf16* BSC, float* YS) {
    constexpr int CH = 32, BUF = 5 * CH * 64 + CH * 32;
    LAS float* lds = (LAS float*)C.lds;
    LAS float* ystage = lds + 2 * BUF;
    const int tid = C.tid, i = tid >> 4, kq = tid & 15;
    for (int cid = C.bid; cid < 256; cid += C.nb) {
        const int b = cid >> 5, hh = (cid >> 2) & 7, d = (cid >> 1) & 1, hf = cid & 1;
        const float* Wd = W + (size_t)d * MT * 512; const bf16* KEd = KEFF + (size_t)d * MT * 512; const bf16* BSd = BSC + (size_t)d * MT * 512; float* Yd = YS + (size_t)d * MT * 512;
        float S[4] = {0.f, 0.f, 0.f, 0.f};
        const int sl = tid >> 4, sub = tid & 15;
        f32x4 lw; u32x4 l1, l2, l3;
        auto issue = [&](int ck) {
            const int row = scan_row(ck * CH + sl, d, b);
            lw = *(const f32x4*)(Wd + (size_t)row * 512 + hh * 64 + 4 * sub);
            if (sub < 8) { l1 = *(const u32x4*)(R + (size_t)row * 512 + hh * 64 + 8 * sub); l2 = *(const u32x4*)(KEd + (size_t)row * 512 + hh * 64 + 8 * sub); }
            else { l1 = *(const u32x4*)(KK + (size_t)row * 512 + hh * 64 + 8 * (sub - 8)); l2 = *(const u32x4*)(BSd + (size_t)row * 512 + hh * 64 + 8 * (sub - 8)); }
            if (sub < 4) l3 = *(const u32x4*)(V + (size_t)row * 512 + hh * 64 + 32 * hf + 8 * sub);
        };
        auto commit = [&](int bufi) {
            LAS float* B = lds + bufi * BUF;
            *(LAS f32x4*)(B + (1 * CH + sl) * 64 + 4 * sub) = lw;
            float f1[8], f2[8]; unpack8(l1, f1); unpack8(l2, f2);
            const int a1 = sub < 8 ? 0 : 3, a2 = sub < 8 ? 2 : 4, off = 8 * (sub & 7);
            *(LAS f32x4*)(B + (a1 * CH + sl) * 64 + off) = (f32x4){f1[0], f1[1], f1[2], f1[3]}; *(LAS f32x4*)(B + (a1 * CH + sl) * 64 + off + 4) = (f32x4){f1[4], f1[5], f1[6], f1[7]};
            *(LAS f32x4*)(B + (a2 * CH + sl) * 64 + off) = (f32x4){f2[0], f2[1], f2[2], f2[3]}; *(LAS f32x4*)(B + (a2 * CH + sl) * 64 + off + 4) = (f32x4){f2[4], f2[5], f2[6], f2[7]};
            if (sub < 4) { float f3[8]; unpack8(l3, f3); LAS float* vp = B + 5 * CH * 64 + sl * 32 + 8 * sub;
                *(LAS f32x4*)vp = (f32x4){f3[0], f3[1], f3[2], f3[3]}; *(LAS f32x4*)(vp + 4) = (f32x4){f3[4], f3[5], f3[6], f3[7]}; }
        };
        __syncthreads();
        issue(0); commit(0);
        __syncthreads();
        constexpr int NCK = KPOS / CH;
        for (int ck = 0; ck < NCK; ++ck) {
            if (ck + 1 < NCK) issue(ck + 1);
            const LAS float* B = lds + (ck & 1) * BUF; LAS float* ys = ystage + (ck & 1) * CH * 32;
#pragma unroll 4
            for (int s = 0; s < CH; ++s) {
                const f32x4 rr = *(const LAS f32x4*)(B + (0 * CH + s) * 64 + 4 * kq), ww = *(const LAS f32x4*)(B + (1 * CH + s) * 64 + 4 * kq), ke = *(const LAS f32x4*)(B + (2 * CH + s) * 64 + 4 * kq),
                            kk = *(const LAS f32x4*)(B + (3 * CH + s) * 64 + 4 * kq), bs = *(const LAS f32x4*)(B + (4 * CH + s) * 64 + 4 * kq);
                const float v = B[5 * CH * 64 + s * 32 + i];
                float sa = -(S[0] * kk.x + S[1] * kk.y + S[2] * kk.z + S[3] * kk.w);
                sa = sum16(sa);
                S[0] = S[0] * ww.x + (sa * bs.x + v * ke.x); S[1] = S[1] * ww.y + (sa * bs.y + v * ke.y); S[2] = S[2] * ww.z + (sa * bs.z + v * ke.z); S[3] = S[3] * ww.w + (sa * bs.w + v * ke.w);
                float y = S[0] * rr.x + S[1] * rr.y + S[2] * rr.z + S[3] * rr.w;
                y = sum16(y);
                if (kq == 0) ys[s * 32 + i] = y;
            }
            if (ck + 1 < NCK) commit((ck + 1) & 1);
            __syncthreads();
            if (tid < 256) { const int s = tid >> 3, q = tid & 7; const int row = scan_row(ck * CH + s, d, b);
                *(f32x4*)(Yd + (size_t)row * 512 + hh * 64 + 32 * hf + 4 * q) = *(const LAS f32x4*)(ys + s * 32 + 4 * q); }
        }
    }
}


DI void ph_scan2(const Ctx& C, const bf16* R, const bf16* V, const bf16* K, const bf16* KK, const float* W, const bf16* AR_  , const float* ka, float* YS) {
    constexpr int CH = 16, BUF = 5 * CH * 64 + CH * 32, NCK = KPOS / CH, DEPTH = 4, YP = CH * 32 * 16;
    static_assert(NCK % DEPTH == 0, "chunk loop is unrolled by DEPTH");
    LAS float* lds = (LAS float*)C.lds;
    LAS float* ypart = lds + 2 * BUF;
    const bool comp = C.wave < 4;
    const int rp = 4 * (C.wave & 3) + (C.lane >> 4), kq = C.lane & 15, lt = C.tid - 256;
    for (int cid0 = C.bid; cid0 < 256; cid0 += C.nb) {
        const int hf = (cid0 >> 3) & 1, chain = (cid0 & 7) | ((cid0 >> 4) << 3), b = chain >> 4, hh = (chain >> 1) & 7, d = chain & 1;
        const float* Wd = W + (size_t)d * MT * 512; const bf16* Ad = AR_ + (size_t)d * MT * 512; float* Yd = YS + (size_t)d * MT * 512;
        u32x4 reg[DEPTH][4];
        float kav[8];
#pragma unroll
        for (int e = 0; e < 8; ++e) kav[e] = ka[hh * 64 + 8 * (lt & 7) + e];
        auto issue = [&](int ck, u32x4 (&rg)[4]) {
            { const size_t base = (size_t)scan_row(ck * CH + (lt >> 4), d, b) * 512 + hh * 64; rg[0] = *(const u32x4*)(Wd + base + 4 * (lt & 15)); }
            rg[1] = (u32x4){0u, 0u, 0u, 0u};
            if (lt < 128) { const size_t base = (size_t)scan_row(ck * CH + (lt >> 3), d, b) * 512 + hh * 64; rg[1] = *(const u32x4*)(R + base + 8 * (lt & 7)); }
            else if (lt < 192) { const int x = lt - 128; const size_t base = (size_t)scan_row(ck * CH + (x >> 2), d, b) * 512 + hh * 64; rg[1] = *(const u32x4*)(V + base + 32 * hf + 8 * (x & 3)); }
            { const size_t base = (size_t)scan_row(ck * CH + ((lt & 127) >> 3), d, b) * 512 + hh * 64 + 8 * (lt & 7); rg[2] = *(const u32x4*)((lt < 128 ? K : KK) + base); rg[3] = *(const u32x4*)(Ad + base); }
        };
        auto commit = [&](int bufi, const u32x4 (&rg)[4]) {
            LAS float* B = lds + bufi * BUF;
            *(LAS u32x4*)(B + (1 * CH + (lt >> 4)) * 64 + 4 * (lt & 15)) = rg[0];
            if (lt < 192) { float f[8]; unpack8(rg[1], f); LAS float* dst = lt < 128 ? B + (0 * CH + (lt >> 3)) * 64 + 8 * (lt & 7) : B + 5 * CH * 64 + ((lt - 128) >> 2) * 32 + 8 * ((lt - 128) & 3);
                *(LAS f32x4*)dst = (f32x4){f[0], f[1], f[2], f[3]}; *(LAS f32x4*)(dst + 4) = (f32x4){f[4], f[5], f[6], f[7]}; }
            { float x[8], av[8]; unpack8(rg[2], x); unpack8(rg[3], av); const int sl = (lt & 127) >> 3, pc = lt & 7;
                if (lt < 128) {
#pragma unroll
                    for (int e = 0; e < 8; ++e) x[e] = x[e] * (1.f + (av[e] - 1.f) * kav[e]);
                    LAS float* dst = B + (2 * CH + sl) * 64 + 8 * pc; *(LAS f32x4*)dst = (f32x4){x[0], x[1], x[2], x[3]}; *(LAS f32x4*)(dst + 4) = (f32x4){x[4], x[5], x[6], x[7]};
                } else {
                    LAS float* dk = B + (3 * CH + sl) * 64 + 8 * pc; *(LAS f32x4*)dk = (f32x4){x[0], x[1], x[2], x[3]}; *(LAS f32x4*)(dk + 4) = (f32x4){x[4], x[5], x[6], x[7]};
#pragma unroll
                    for (int e = 0; e < 8; ++e) x[e] *= av[e];
                    LAS float* db = B + (4 * CH + sl) * 64 + 8 * pc; *(LAS f32x4*)db = (f32x4){x[0], x[1], x[2], x[3]}; *(LAS f32x4*)(db + 4) = (f32x4){x[4], x[5], x[6], x[7]};
                } }
        };
        auto y_reduce = [&](int ck) {
            const LAS float* yp = ypart + (ck & 1) * YP + lt * 32;
            float y[2];
#pragma unroll
            for (int j = 0; j < 2; ++j) { const f32x4 a0 = *(const LAS f32x4*)(yp + 16 * j), a1 = *(const LAS f32x4*)(yp + 16 * j + 4), a2 = *(const LAS f32x4*)(yp + 16 * j + 8), a3 = *(const LAS f32x4*)(yp + 16 * j + 12);
                y[j] = (((a0.x + a0.y) + (a0.z + a0.w)) + ((a1.x + a1.y) + (a1.z + a1.w))) + (((a2.x + a2.y) + (a2.z + a2.w)) + ((a3.x + a3.y) + (a3.z + a3.w))); }
            const int row = scan_row(ck * CH + (lt >> 4), d, b);
            *(f32x2*)(Yd + (size_t)row * 512 + hh * 64 + 32 * hf + 2 * (lt & 15)) = (f32x2){y[0], y[1]};
        };
        f32x2 S[2][2];
#pragma unroll
        for (int j = 0; j < 2; ++j) { S[j][0] = (f32x2){0.f, 0.f}; S[j][1] = (f32x2){0.f, 0.f}; }
        __syncthreads();
        if (!comp) { issue(0, reg[0]); commit(0, reg[0]);
#pragma unroll
            for (int k = 1; k < DEPTH; ++k) issue(k, reg[k]); }
        __syncthreads();
        for (int ck0 = 0; ck0 < NCK; ck0 += DEPTH) {
#pragma unroll
            for (int kk = 0; kk < DEPTH; ++kk) {
                const int ck = ck0 + kk;
                if (comp) {
                    const LAS float* B = lds + (ck & 1) * BUF + 4 * kq; const LAS float* vb = lds + (ck & 1) * BUF + 5 * CH * 64 + 2 * rp; LAS float* yq = ypart + (ck & 1) * YP + (2 * rp) * 16 + kq;
                    f32x4 op[2][5]; f32x2 vv[2];
#define SCAN_LOAD(set, sI) do { const LAS float* bp_ = B + (sI) * 64; _Pragma("unroll") for (int a_ = 0; a_ < 5; ++a_) op[set][a_] = *(const LAS f32x4*)(bp_ + a_ * CH * 64); vv[set] = *(const LAS f32x2*)(vb + (sI) * 32); } while (0)
#define SCAN_ROW(set, sI, j, vj) do { f32x2 acc = S[j][0] * (f32x2){op[set][3].x, op[set][3].y}; acc = __builtin_elementwise_fma(S[j][1], (f32x2){op[set][3].z, op[set][3].w}, acc); \
                        const float sa = sum16(-(acc.x + acc.y)); const f32x2 sa2 = {sa, sa}, v2 = {vj, vj}; \
                        S[j][0] = __builtin_elementwise_fma(S[j][0], (f32x2){op[set][1].x, op[set][1].y}, __builtin_elementwise_fma(sa2, (f32x2){op[set][4].x, op[set][4].y}, v2 * (f32x2){op[set][2].x, op[set][2].y})); \
                        S[j][1] = __builtin_elementwise_fma(S[j][1], (f32x2){op[set][1].z, op[set][1].w}, __builtin_elementwise_fma(sa2, (f32x2){op[set][4].z, op[set][4].w}, v2 * (f32x2){op[set][2].z, op[set][2].w})); \
                        const f32x2 ya = __builtin_elementwise_fma(S[j][1], (f32x2){op[set][0].z, op[set][0].w}, S[j][0] * (f32x2){op[set][0].x, op[set][0].y}); \
                        yq[(sI) * 512 + (j) * 16] = ya.x + ya.y; } while (0)
#define SCAN_STEP(set, sI) do { SCAN_ROW(set, sI, 0, vv[set].x); SCAN_ROW(set, sI, 1, vv[set].y); } while (0)
                    SCAN_LOAD(0, 0);
#pragma unroll
                    for (int sI = 0; sI < CH; sI += 2) {
                        SCAN_LOAD(1, sI + 1);
                        SCAN_STEP(0, sI);
                        if (sI + 2 < CH) SCAN_LOAD(0, sI + 2);
                        SCAN_STEP(1, sI + 1);
                    }
#undef SCAN_LOAD
#undef SCAN_ROW
#undef SCAN_STEP
                } else {
                    if (ck + 1 < NCK) commit((ck + 1) & 1, reg[(kk + 1) % DEPTH]);
                    if (ck + DEPTH < NCK) issue(ck + DEPTH, reg[kk]);
                    if (ck > 0) y_reduce(ck - 1);
                }
                __syncthreads();
            }
        }
        if (!comp) y_reduce(NCK - 1);
    }
}


constexpr int CCH = 16, NCHK = KPOS / CCH, NPROB = NB * 8 * 2 * NCHK, IMG_ELEMS = 3 * 32 * 16;
template <int N> struct ICk { static constexpr int value = N; };
DI int crow_(int reg, int h) { return (reg & 3) + 8 * (reg >> 2) + 4 * h; }
DI bf16x8 pack_lo8(const f32x16& x) {
    u32x4 p; p.x = pk2(x[0], x[1]); p.y = pk2(x[2], x[3]); p.z = pk2(x[4], x[5]); p.w = pk2(x[6], x[7]); return __builtin_bit_cast(bf16x8, p); }
DI bf16x8 pack_hi8(const f32x16& x) { u32x4 p; p.x = pk2(x[8], x[9]); p.y = pk2(x[10], x[11]); p.z = pk2(x[12], x[13]); p.w = pk2(x[14], x[15]); return __builtin_bit_cast(bf16x8, p); }
DI int perm16(int k) { return (k & ~15) | swap23(k & 15); }

DI void ph_wkv_pre(const Ctx& C, const bf16* R, const bf16* K, const bf16* KK, const float* LW, const bf16* AR_, const float* ka, bf16* IMG) {
    LAS unsigned char* wl = C.lds + C.wave * 13312;
    LAS bf16* ARl = (LAS bf16*)wl; LAS bf16* BKl = (LAS bf16*)(wl + 4608); LAS float* Ll = (LAS float*)(wl + 9216); LAS bf16* OUT = (LAS bf16*)(wl + 10240);
    const int lane = C.lane, r = lane & 31, h = lane >> 5;
    const int gw = C.vcu * 8 + C.wave, ngw = C.nb * 8;
    for (int p = gw; p < NPROB; p += ngw) {
        const int j = p % NCHK, rest = p / NCHK, d = rest & 1, hh = (rest >> 1) & 7, b = rest >> 4;
        const float* Wd = LW + (size_t)d * MT * 512; const bf16* Ad = AR_ + (size_t)d * MT * 512;
        const float kav = ka[hh * 64 + lane];
        const int row0 = scan_row(j * CCH, d, b), sg = d ? -1 : 1;
        float lw[16]; bf16 rr[16], kx[16], kkx[16], ax[16];
#pragma unroll
        for (int t = 0; t < 16; ++t) { const size_t off = (size_t)(row0 + sg * t) * 512 + hh * 64 + lane; lw[t] = Wd[off]; rr[t] = R[off]; kx[t] = K[off]; kkx[t] = KK[off]; ax[t] = Ad[off]; }
        float cum = 0.f, e0 = 1.f;
#pragma unroll
        for (int t = 0; t < 16; ++t) {
            cum += lw[t]; const float e1 = __expf(cum), ei = __builtin_amdgcn_rcpf(e1);
            const float kkv = bf2f(kkx[t]), av = bf2f(ax[t]), keff = bf2f(kx[t]) * (1.f + (av - 1.f) * kav);
            ARl[t * 72 + lane] = f2bf(-kkv * e0); ARl[(16 + t) * 72 + lane] = f2bf(bf2f(rr[t]) * e1);
            BKl[t * 72 + lane] = f2bf(kkv * av * ei); BKl[(16 + t) * 72 + lane] = f2bf(keff * ei);
            e0 = e1;
        }
        asm volatile("s_waitcnt lgkmcnt(0)" ::: "memory");
        f32x16 g;
#pragma unroll
        for (int i = 0; i < 16; ++i) g[i] = 0.f;
#pragma unroll
        for (int q = 0; q < 4; ++q) g = MFMA32(*(const LAS bf16x8*)(ARl + r * 72 + 16 * q + 8 * h), *(const LAS bf16x8*)(BKl + r * 72 + 16 * q + 8 * h), g);
        const int sI = r & 15; const bool isk = r >= 16;
#pragma unroll
        for (int i = 0; i < 16; ++i) {
            const int row = crow_(i, h), t = row & 15; const bool keep = (i < 8) ? (sI < t) : (sI <= t); const float val = keep ? g[i] : 0.f;
            if (i < 8) { if (!isk) { Ll[t * 16 + sI] = val; OUT[512 + row * 16 + perm16(sI)] = 0; } else OUT[row * 16 + sI] = f2bf(val); }
            else       { if (!isk) OUT[512 + row * 16 + perm16(sI)] = f2bf(val); else OUT[row * 16 + sI] = f2bf(val); }
        }
        asm volatile("s_waitcnt lgkmcnt(0)" ::: "memory");
        { const int c = lane & 15; float Pr[16];
            Pr[0] = (c == 0) ? 1.f : 0.f;
#pragma unroll
            for (int t = 1; t < 16; ++t) { const float lrow = Ll[t * 16 + c]; float acc = (c == t) ? 1.f : 0.f;
#pragma unroll
                for (int u = 0; u < t; ++u) acc += rdlane(lrow, u) * Pr[u];
                Pr[t] = acc; }
            if (lane < 16) {
#pragma unroll
                for (int t = 0; t < 16; ++t) { OUT[1024 + t * 16 + perm16(c)] = f2bf(Pr[t]); OUT[1024 + (16 + t) * 16 + c] = 0; } } }
        asm volatile("s_waitcnt lgkmcnt(0)" ::: "memory");
        { bf16* dst = IMG + (size_t)p * IMG_ELEMS;
#pragma unroll
            for (int q = 0; q < 3; ++q) *(u32x4*)(dst + (q * 64 + lane) * 8) = *(const LAS u32x4*)(OUT + (q * 64 + lane) * 8); }
        asm volatile("s_waitcnt lgkmcnt(0)" ::: "memory");
    }
}

DI void ph_wkv_chunk(const Ctx& C, const bf16* R, const bf16* V, const bf16* K, const bf16* KK, const float* LW, const bf16* AR_, const float* ka, const bf16* IMG, float* YS) {
    constexpr int S_AR = 0, S_BKT = 4608, S_VT = 9728, S_GC = 11264, S_MM = 11520, S_MRB = 13056, S_PP = 14592, SLOT = 16128, CUMO = 2 * SLOT, YSTO = CUMO + 8192, DEPTH = 4;
    const int lane = C.lane, wv = C.wave, r = lane & 31, h = lane >> 5;
    const bool isE = (wv >= 1 && wv <= 3) || wv == 5;
    const int te = (wv == 5 ? 3 : wv - 1) * 64 + lane, et = te >> 4, ekq = te & 15;
    for (int cid0 = C.bid; cid0 < 256; cid0 += C.nb) {
        const int hf = (cid0 >> 3) & 1, chain = (cid0 & 7) | ((cid0 >> 4) << 3), b = chain >> 4, hh = (chain >> 1) & 7, d = chain & 1;
        const float* Wd = LW + (size_t)d * MT * 512; const bf16* Ad = AR_ + (size_t)d * MT * 512; float* Yd = YS + (size_t)d * MT * 512;
        const bf16* img = IMG + (size_t)(((b * 8 + hh) * 2 + d) * NCHK) * IMG_ELEMS;
        f32x16 ST[2];
#pragma unroll
        for (int i = 0; i < 16; ++i) { ST[0][i] = 0.f; ST[1][i] = 0.f; }
        const f32x4 kav = *(const f32x4*)(ka + hh * 64 + 4 * ekq);
        unsigned ring[DEPTH][16];
        __syncthreads();
        auto issue = [&](int ch, unsigned (&rg)[16]) __attribute__((always_inline)) {
            if (ch < 0 || ch >= NCHK) return;
            const int row0 = scan_row(ch * CCH, d, b), sg = d ? -1 : 1;
            if (isE) {
                const size_t off = (size_t)(row0 + sg * et) * 512 + hh * 64 + 4 * ekq;
                const u32x2 x0 = *(const u32x2*)(R + off), x1 = *(const u32x2*)(K + off), x2 = *(const u32x2*)(KK + off), x3 = *(const u32x2*)(Ad + off);
                rg[0] = x0.x; rg[1] = x0.y; rg[2] = x1.x; rg[3] = x1.y; rg[4] = x2.x; rg[5] = x2.y; rg[6] = x3.x; rg[7] = x3.y;
                asm volatile("; wkv issue role E" ::);
            } else if (wv == 4) {
#define W5_(t) rg[(t)] = __builtin_bit_cast(unsigned, Wd[(size_t)(row0 + sg * (t)) * 512 + hh * 64 + lane])
                W5_(0); W5_(1); W5_(2); W5_(3); W5_(4); W5_(5); W5_(6); W5_(7); W5_(8); W5_(9); W5_(10); W5_(11); W5_(12); W5_(13); W5_(14); W5_(15);
#undef W5_
                asm volatile("; wkv issue role C" ::);
            } else if (wv == 6) {
#define W6_(q) do { const u32x4 x = *(const u32x4*)(img + (size_t)ch * IMG_ELEMS + ((q) * 64 + lane) * 8); rg[4 * (q)] = x.x; rg[4 * (q) + 1] = x.y; rg[4 * (q) + 2] = x.z; rg[4 * (q) + 3] = x.w; } while (0)
                W6_(0); W6_(1); W6_(2);
#undef W6_
#define VPAIR_(m) rg[12 + (m)] = (unsigned)V[(size_t)(row0 + sg * (4 * (m) + h)) * 512 + hh * 64 + 32 * hf + r] | ((unsigned)V[(size_t)(row0 + sg * (4 * (m) + 2 + h)) * 512 + hh * 64 + 32 * hf + r] << 16)
                VPAIR_(0); VPAIR_(1); VPAIR_(2); VPAIR_(3);
#undef VPAIR_
                asm volatile("; wkv issue role V" ::);
            }
        };
        issue(0, ring[0]); issue(1, ring[1]); issue(2, ring[2]); issue(3, ring[3]);
#define WKV_BAR() asm volatile("s_waitcnt lgkmcnt(0)\n\ts_barrier" ::: "memory")
#define WKV_LOOP(...) for (int n0 = -2; n0 < NCHK; n0 += DEPTH) { auto iter = [&](auto kc) __attribute__((always_inline)) { constexpr int kk = decltype(kc)::value; \
            constexpr int riE = (kk + 3) % DEPTH, riW = kk % DEPTH; (void)riE; (void)riW; const int n = n0 + kk; (void)n; __VA_ARGS__; WKV_BAR(); }; iter(ICk<0>{}); iter(ICk<1>{}); iter(ICk<2>{}); iter(ICk<3>{}); }
        if (wv == 0) {
            WKV_LOOP({
                if (n >= 0 && n < NCHK) {
                    const LAS unsigned char* B = C.lds + (n & 1) * SLOT;
                    f32x16 T1;
                    _Pragma("unroll") for (int i = 0; i < 16; ++i) T1[i] = 0.f;
                    _Pragma("unroll") for (int tau = 0; tau < 2; ++tau) {
                        T1 = MFMA32(*(const LAS bf16x8*)(B + S_AR + r * 144 + (32 * tau + 8 * h) * 2), pack_lo8(ST[tau]), T1);
                        T1 = MFMA32(*(const LAS bf16x8*)(B + S_AR + r * 144 + (32 * tau + 16 + 8 * h) * 2), pack_hi8(ST[tau]), T1);
                    }
                    const bf16x8 vt = *(const LAS bf16x8*)(B + S_VT + r * 48 + 16 * h);
                    T1 = MFMA32(*(const LAS bf16x8*)(B + S_MM + r * 48 + 16 * h), vt, T1);
                    f32x16 ET;
                    _Pragma("unroll") for (int i = 0; i < 16; ++i) ET[i] = 0.f;
                    ET = MFMA32(*(const LAS bf16x8*)(B + S_PP + r * 48 + 16 * h), pack_lo8(T1), ET);
                    const bf16x8 ef = pack_lo8(ET);
                    T1 = MFMA32(*(const LAS bf16x8*)(B + S_MRB + r * 48 + 16 * h), ef, T1);
                    _Pragma("unroll") for (int tau = 0; tau < 2; ++tau) {
                        ST[tau] = MFMA32(*(const LAS bf16x8*)(B + S_BKT + (32 * tau + r) * 80 + 16 * h), ef, ST[tau]);
                        ST[tau] = MFMA32(*(const LAS bf16x8*)(B + S_BKT + (32 * tau + r) * 80 + 32 + 16 * h), vt, ST[tau]);
                        _Pragma("unroll") for (int g4 = 0; g4 < 4; ++g4) { const f32x4 gc = *(const LAS f32x4*)(B + S_GC + (32 * tau + 8 * g4 + 4 * h) * 4);
                            ST[tau][4 * g4] *= gc.x; ST[tau][4 * g4 + 1] *= gc.y; ST[tau][4 * g4 + 2] *= gc.z; ST[tau][4 * g4 + 3] *= gc.w; }
                    }
                    LAS float* ys = (LAS float*)(C.lds + YSTO) + (n & 1) * 512;
                    _Pragma("unroll") for (int q = 0; q < 8; ++q) ys[(8 * (q >> 2) + 4 * h + (q & 3)) * 32 + r] = T1[8 + q];
                }
            });
        } else if (isE) {
            WKV_LOOP({
                const int ch = n + 1;
                if (ch >= 0) {
                    if (ch < NCHK) {
                        LAS unsigned char* B = C.lds + (ch & 1) * SLOT; const LAS float* ec = (const LAS float*)(C.lds + CUMO) + (ch & 1) * 1024;
                        const f32x4 e1 = *(const LAS f32x4*)(ec + et * 64 + 4 * ekq);
                        f32x4 e0 = {1.f, 1.f, 1.f, 1.f}; if (et > 0) e0 = *(const LAS f32x4*)(ec + (et - 1) * 64 + 4 * ekq);
                        const float rv[4] = {bflo(ring[riE][0]), bfhi(ring[riE][0]), bflo(ring[riE][1]), bfhi(ring[riE][1])}; const float kv[4] = {bflo(ring[riE][2]), bfhi(ring[riE][2]), bflo(ring[riE][3]), bfhi(ring[riE][3])};
                        const float kkv[4] = {bflo(ring[riE][4]), bfhi(ring[riE][4]), bflo(ring[riE][5]), bfhi(ring[riE][5])}; const float av[4] = {bflo(ring[riE][6]), bfhi(ring[riE][6]), bflo(ring[riE][7]), bfhi(ring[riE][7])};
                        float ah[4]; float rh[4]; float bc[4]; float kc4[4];
                        _Pragma("unroll") for (int e = 0; e < 4; ++e) { const float ei = __builtin_amdgcn_rcpf(e1[e]);
                            ah[e] = -kkv[e] * e0[e]; rh[e] = rv[e] * e1[e]; bc[e] = kkv[e] * av[e] * ei; kc4[e] = kv[e] * (1.f + (av[e] - 1.f) * kav[e]) * ei; }
                        const int pk = perm16(4 * ekq);
                        *(LAS u32x2*)((LAS bf16*)(B + S_AR) + et * 72 + pk) = (u32x2){pk2(ah[0], ah[1]), pk2(ah[2], ah[3])};
                        *(LAS u32x2*)((LAS bf16*)(B + S_AR) + (16 + et) * 72 + pk) = (u32x2){pk2(rh[0], rh[1]), pk2(rh[2], rh[3])};
                        const int pt = perm16(et);
                        _Pragma("unroll") for (int e = 0; e < 4; ++e) { ((LAS bf16*)(B + S_BKT))[(4 * ekq + e) * 40 + pt] = f2bf(bc[e]); ((LAS bf16*)(B + S_BKT))[(4 * ekq + e) * 40 + 16 + et] = f2bf(kc4[e]); }
                        if (et == 15) *(LAS f32x4*)((LAS float*)(B + S_GC) + 4 * ekq) = e1;
                    }
                    issue(ch + DEPTH, ring[riE]);
                }
            });
        } else if (wv == 4) {
            WKV_LOOP({
                const int ch = n + 2;
                if (ch < NCHK) { LAS float* ec = (LAS float*)(C.lds + CUMO) + (ch & 1) * 1024; float c = 0.f;
#define C5_(t) do { c += __builtin_bit_cast(float, ring[riW][(t)]); ec[(t) * 64 + lane] = __expf(c); } while (0)
                    C5_(0); C5_(1); C5_(2); C5_(3); C5_(4); C5_(5); C5_(6); C5_(7); C5_(8); C5_(9); C5_(10); C5_(11); C5_(12); C5_(13); C5_(14); C5_(15);
                }
                issue(ch + DEPTH, ring[riW]);
            });
        } else if (wv == 6) {
            WKV_LOOP({
                const int ch = n + 1;
                if (ch >= 0) {
                    if (ch < NCHK) { LAS unsigned char* B = C.lds + (ch & 1) * SLOT;
                        const int irow = lane >> 1; const int ihv = lane & 1;
                        *(LAS u32x4*)(B + S_MM + irow * 48 + ihv * 16) = (u32x4){ring[riE][0], ring[riE][1], ring[riE][2], ring[riE][3]};
                        *(LAS u32x4*)(B + S_MRB + irow * 48 + ihv * 16) = (u32x4){ring[riE][4], ring[riE][5], ring[riE][6], ring[riE][7]};
                        *(LAS u32x4*)(B + S_PP + irow * 48 + ihv * 16) = (u32x4){ring[riE][8], ring[riE][9], ring[riE][10], ring[riE][11]};
#define V6_(m) do { ((LAS bf16*)(B + S_VT))[r * 24 + 4 * (m) + h] = (bf16)(ring[riE][12 + (m)] & 0xffffu); ((LAS bf16*)(B + S_VT))[r * 24 + 4 * (m) + 2 + h] = (bf16)(ring[riE][12 + (m)] >> 16); } while (0)
                        V6_(0); V6_(1); V6_(2); V6_(3);
                    }
                    issue(ch + DEPTH, ring[riE]);
                }
            });
        } else if (wv == 7) {
            WKV_LOOP({
                const int ch = n - 1;
                if (ch >= 0 && ch < NCHK) { const LAS float* ys = (const LAS float*)(C.lds + YSTO) + (ch & 1) * 512 + (lane >> 2) * 32 + 8 * (lane & 3);
                    const f32x4 y0 = *(const LAS f32x4*)ys; const f32x4 y1 = *(const LAS f32x4*)(ys + 4);
                    float* dst = Yd + (size_t)(scan_row(ch * CCH, d, b) + (d ? -1 : 1) * (lane >> 2)) * 512 + hh * 64 + 32 * hf + 8 * (lane & 3);
                    *(f32x4*)dst = y0; *(f32x4*)(dst + 4) = y1; }
            });
        } else {
            WKV_LOOP({ });
        }
#undef C5_
#undef V6_
#undef WKV_LOOP
#undef WKV_BAR
    }
}

DI void ph_post(const Ctx& C, const float* YS, const bf16* R, const bf16* V, const bf16* K, const bf16* A2, const float* ka, const bf16* G, const float* rk, const float* gng, const float* gnb, bf16* OCAT, bool last) {
    const int gw = C.bid * 8 + C.wave, ngw = C.nb * 8, lane = C.lane, nrows = last ? NLAT : MT;
    for (int row = gw; row < nrows; row += ngw) {
        const size_t o = (size_t)row * 512 + 8 * lane;
        const f32x4 y0a = *(const f32x4*)(YS + o), y0b = *(const f32x4*)(YS + o + 4), y1a = *(const f32x4*)(YS + (size_t)MT * 512 + o), y1b = *(const f32x4*)(YS + (size_t)MT * 512 + o + 4);
        float y[8] = {y0a.x + y1a.x, y0a.y + y1a.y, y0a.z + y1a.z, y0a.w + y1a.w, y0b.x + y1b.x, y0b.y + y1b.y, y0b.z + y1b.z, y0b.w + y1b.w};
        float r[8], v[8], kx[8], a0[8], a1[8], g[8];
        unpack8(*(const u32x4*)(R + o), r); unpack8(*(const u32x4*)(V + o), v); unpack8(*(const u32x4*)(K + o), kx); unpack8(*(const u32x4*)(A2 + o), a0); unpack8(*(const u32x4*)(A2 + (size_t)MT * 512 + o), a1); unpack8(*(const u32x4*)(G + o), g);
        float bsum = 0.f;
#pragma unroll
        for (int e = 0; e < 8; ++e) { const float kae = ka[8 * lane + e]; bsum += r[e] * (kx[e] * (1.f + (a0[e] - 1.f) * kae) + kx[e] * (1.f + (a1[e] - 1.f) * kae)) * rk[8 * lane + e]; }
        bsum = sum8(bsum);
        float s = 0.f;
#pragma unroll
        for (int e = 0; e < 8; ++e) { y[e] += bsum * v[e]; s += y[e]; }
        const float mu = sum8(s) * (1.f / 64.f); float s2 = 0.f;
#pragma unroll
        for (int e = 0; e < 8; ++e) { y[e] -= mu; s2 += y[e] * y[e]; }
        const float rstd = 1.0f / sqrtf(sum8(s2) * (1.f / 64.f) + GN_EPS);
        float out[8];
#pragma unroll
        for (int e = 0; e < 8; ++e) out[e] = (y[e] * rstd * gng[8 * lane + e] + gnb[8 * lane + e]) * g[e];
        *(u32x4*)(OCAT + (size_t)row * DM + 8 * lane) = pack8(out);
    }
}

DI void ph_topk(const Ctx& C, const float* AFFT, const float* AFFC, int* ROWS, float* GATE, int* SLOT, bool last) {
    LAS unsigned long long* key = (LAS unsigned long long*)C.lds;
    const int nprob = last ? 128 : 256;
    for (int p = C.bid; p < nprob; p += C.nb) {
        const bool isctx = p >= 128; const int be = p & 127, b = be >> 4, e = be & 15;
        const int n = isctx ? LCX : TL, cap = isctx ? CAPC : CAPL;
        const float* src = isctx ? AFFC + (size_t)be * LCX : AFFT + (size_t)be * TL;
        __syncthreads();
        for (int t = C.tid; t < n; t += 512) key[t] = ((unsigned long long)__builtin_bit_cast(unsigned, src[t]) << 32) | (unsigned long long)(0xFFFFFFFFu - (unsigned)t);
        __syncthreads();
        for (int k = 2; k <= n; k <<= 1)
            for (int j = k >> 1; j > 0; j >>= 1) {
                for (int q = C.tid; q < n / 2; q += 512) {
                    const int i = ((q & ~(j - 1)) << 1) | (q & (j - 1)), ix = i | j;
                    const unsigned long long a = key[i], bb = key[ix];
                    const bool desc = ((i & k) == 0);
                    if (desc ? (a < bb) : (a > bb)) { key[i] = bb; key[ix] = a; }
                }
                __syncthreads();
            }
        for (int jx = C.tid; jx < cap; jx += 512) {
            const unsigned long long kv = key[jx]; const int t = (int)(0xFFFFFFFFu - (unsigned)(kv & 0xFFFFFFFFull)); const float g = __builtin_bit_cast(float, (unsigned)(kv >> 32));
            const int slot = isctx ? NB * CAPL + b * CAPC + jx : b * CAPL + jx, row = isctx ? NLAT + b * LCX + t : b * TL + t;
            ROWS[e * ESLOTS + slot] = row; GATE[e * ESLOTS + slot] = g; SLOT[(size_t)row * 16 + e] = slot;
        }
    }
}

DI void ph_combine(const Ctx& C, float* xlat, float* xctx, const float* modg2  , const int* SLOT, const bf16* Y2, bool last,
                   const float* ngain  , const float* nmod  , bf16* H) {
    const int gw = C.bid * 8 + C.wave, ngw = C.nb * 8, lane = C.lane, nrows = last ? NLAT : MT;
    for (int row = gw; row < nrows; row += ngw) {
        float* xr = row < NLAT ? xlat + (size_t)row * DM : xctx + (size_t)(row - NLAT) * DM;
        const int mi = row < NLAT ? (row >> 12) : 8;
        const int sv = SLOT[(size_t)row * 16 + (lane & 15)];
        f32x4 acc[4];
#pragma unroll
        for (int j = 0; j < 4; ++j) acc[j] = (f32x4){0.f, 0.f, 0.f, 0.f};
#pragma unroll
        for (int e = 0; e < 16; ++e) {
            const int s = __builtin_amdgcn_readlane(sv, e);
            if (s >= 0) { const bf16* yp = Y2 + ((size_t)e * ESLOTS + s) * DM + 4 * lane;
#pragma unroll
                for (int j = 0; j < 4; ++j) { const u32x2 w = *(const u32x2*)(yp + 256 * j); acc[j] += (f32x4){bflo(w.x), bfhi(w.x), bflo(w.y), bfhi(w.y)}; } }
        }
#pragma unroll
        for (int j = 0; j < 4; ++j) { const int c = 256 * j + 4 * lane; const f32x4 g = *(const f32x4*)(modg2 + mi * 6144 + c); f32x4 x = *(const f32x4*)(xr + c); x += g * acc[j]; *(f32x4*)(xr + c) = x; acc[j] = x; }
        if (ngain) {
            float ss = 0.f;
#pragma unroll
            for (int j = 0; j < 4; ++j) ss += acc[j].x * acc[j].x + acc[j].y * acc[j].y + acc[j].z * acc[j].z + acc[j].w * acc[j].w;
            const float rs = 1.0f / sqrtf(wave_sum(ss) * (1.f / 1024.f) + EPS);
            const float* mp = nmod + mi * 6144;
#pragma unroll
            for (int j = 0; j < 4; ++j) { const int c = 256 * j + 4 * lane;
                const f32x4 g = *(const f32x4*)(ngain + c), sc = *(const f32x4*)(mp + 1024 + c), sh = *(const f32x4*)(mp + c);
                const f32x4 hv = (acc[j] * rs) * g * (sc + 1.0f) + sh;
                *(u32x2*)(H + (size_t)row * DM + c) = (u32x2){pk2(hv.x, hv.y), pk2(hv.z, hv.w)}; }
        }
    }
}

template <int N> struct IC { static constexpr int value = N; };
DI const float* in_ptr(const unsigned char* ws, int k) { const unsigned long long v = ((const unsigned long long*)(ws + 128 * 1024))[k];
    const unsigned lo = __builtin_amdgcn_readfirstlane((unsigned)v), hi = __builtin_amdgcn_readfirstlane((unsigned)(v >> 32));
    return (const float*)(__attribute__((address_space(1))) const float*)(((unsigned long long)hi << 32) | lo); }
template <class T> DI T* launder_ptr(T* p) { unsigned long long v = (unsigned long long)p; unsigned lo = (unsigned)v, hi = (unsigned)(v >> 32); asm volatile("" : "+v"(lo), "+v"(hi));
    lo = __builtin_amdgcn_readfirstlane(lo); hi = __builtin_amdgcn_readfirstlane(hi); return (T*)(__attribute__((address_space(1))) T*)(((unsigned long long)hi << 32) | lo); }
constexpr int N_PHASES = 1 + 23 + 22;
constexpr size_t WS_PTRS = 128 * 1024;
#define P_XC    ((float*)(ws + WS_XC))
#define P_MOD   ((const float*)(ws + WS_MOD))
#define P_HB    ((bf16*)(ws + WS_HB))
#define P_OCAT  ((bf16*)(ws + WS_OCAT))
#define P_AR    (ws + WS_ARENA)
#define P_ROWS  ((int*)(ws + WS_ROWS))
#define P_GATE  ((float*)(ws + WS_GATE))
#define P_SLOT  ((int*)(ws + WS_SLOT))
#define P_AFFT  ((float*)(ws + WS_AFFT))
#define P_AFFC  ((float*)(ws + WS_AFFC))
#define P_W13   ((bf16*)(ws + WS_W13))
#define P_W2    ((bf16*)(ws + WS_W2))
#define P_U     ((bf16*)(P_AR + A_U))
#define P_QPRE  ((float*)(P_AR + A_QPRE))
#define P_KVPRE ((float*)(P_AR + A_KVPRE))
#define P_QB    ((bf16*)(P_AR + A_QB))
#define P_KB    ((bf16*)(P_AR + A_KB))
#define P_VT    ((bf16*)(P_AR + A_VT))
#define P_W     ((float*)(P_AR + A_W))
#define P_KEFF  ((bf16*)(P_AR + A_KEFF))
#define P_R     ((bf16*)(P_AR + A_R))
#define P_V     ((bf16*)(P_AR + A_V))
#define P_KK    ((bf16*)(P_AR + A_KK))
#define P_G     ((bf16*)(P_AR + A_G))
#define P_K     ((bf16*)(P_AR + A_K))
#define P_L     ((bf16*)(P_AR + A_L))
#define P_QN    ((bf16*)(P_AR + A_QN))
#define P_KN    ((bf16*)(P_AR + A_KN))
#define P_VTN   ((bf16*)(P_AR + A_VTN))
#define P_YS    ((float*)(P_AR + A_YS))
#define P_IMG   ((bf16*)(P_AR + A_IMG))
#define P_HID   ((bf16*)(P_AR + A_HID))
#define P_Y2    ((bf16*)(P_AR + A_Y2))
#define MODL(i) (P_MOD + (size_t)(i) * 9 * 6144)
#define RELAUNDER() do { int l_ = C.lane; asm volatile("" : "+v"(l_)); C.lane = l_; C.tid = (C.wave << 6) | l_; } while (0)
__global__ void __launch_bounds__(512, 2) fwd_kernel(Args a) {
    extern __shared__ __attribute__((aligned(16))) unsigned char smem[];
    Ctx C0; C0.lds = (LAS unsigned char*)smem; C0.tid = threadIdx.x; C0.lane = C0.tid & 63; C0.wave = __builtin_amdgcn_readfirstlane(C0.tid >> 6); C0.bid = blockIdx.x; C0.nb = gridDim.x;
    C0.vcu = (C0.nb % 8 == 0) ? (C0.bid % 8) * (C0.nb / 8) + C0.bid / 8 : C0.bid;
    volatile LAS unsigned* bst = (volatile LAS unsigned*)(C0.lds + LDS_BYTES - 16);
#if MEGA
    if (C0.tid == 0) { bst[0] = 0u; bst[1] = 0u; }
    __syncthreads();
    const unsigned bar_x = xcd_barrier_post((unsigned*)(a.ws + WS_CTL) + 4096, bst, C0.tid == 0).x;
#define SEAM() do { if (ph < hi) { XcdBarrier b2_; b2_.bar = (unsigned*)(ws + WS_CTL) + 4096; b2_.x = bar_x; b2_.st = bst; xcd_barrier(b2_, C.tid == 0); } } while (0)
#else
#define SEAM() do { } while (0)
#endif
#if MEGA
    constexpr int lo = 0, hi = N_PHASES;
#else
    const int lo = a.ph_lo, hi = a.ph_hi;
#endif
    int ph = 0;
#ifndef ONLY
#define ONLY -1
#endif
#ifndef REPMASK
#define REPMASK 0
#endif
#ifndef SITE_LO
#define SITE_LO 0
#define SITE_HI 99
#endif
#define PHASE(SITE, ...) do { if ((ONLY < 0 || ONLY == (SITE)) && (SITE) >= SITE_LO && (SITE) <= SITE_HI && ph >= lo && ph < hi) { Ctx C; C.lds = C0.lds; \
        { int w_ = C0.wave; asm volatile("" : "+s"(w_)); unsigned m_ = ~0u; asm volatile("" : "+s"(m_)); int l_ = (int)__builtin_amdgcn_mbcnt_hi(m_, __builtin_amdgcn_mbcnt_lo(m_, 0u)); C.wave = w_; C.lane = l_; C.tid = (w_ << 6) | l_; } \
        { int b_ = C0.bid, n_ = C0.nb, v_ = C0.vcu; asm volatile("" : "+s"(b_), "+s"(n_), "+s"(v_)); C.bid = b_; C.nb = n_; C.vcu = v_; } \
        unsigned z_ = 0u; asm volatile("" : "+s"(z_)); unsigned char* ws = a.ws + z_; float* XL = a.out + z_; const int lq = __builtin_amdgcn_readfirstlane(lp); typedef const __attribute__((address_space(1))) float* gfp_t; const gfp_t* INT_ = (const gfp_t*)(ws + WS_PTRS); (void)INT_; (void)XL; (void)lq; \
        for (int rep_ = 0; rep_ < ((((REPMASK) >> (SITE)) & 1) ? 2 : 1); ++rep_) { __VA_ARGS__; if ((((REPMASK) >> (SITE)) & 1)) __syncthreads(); } ++ph; SEAM(); } else ++ph; } while (0)

    { const int lp = 0;
      PHASE(0, { if (C.bid == 0) { _Pragma("unroll") for (int k = 0; k < 40; ++k) if (C.tid == k) ((const float**)(ws + WS_PTRS))[k] = a.in[k]; }
                 ph_prologue(C, a); }); }

    auto layer_pair = [&](auto lpc) __attribute__((always_inline)) {
        constexpr int lp = decltype(lpc)::value;
        if constexpr (lp == 0) PHASE(1, { const int i = 2 * lq; const float* xl = (i == 0) ? in_ptr(ws, I_X) : XL; const float* xc = (i == 0) ? in_ptr(ws, I_CTX) : P_XC;
                   ph_norm<false>(C, xl, xc, in_ptr(ws, I_N1G) + i * DM, MODL(i), 0, 1024, P_HB, nullptr, nullptr, nullptr, nullptr);
                   moe_weight_prep(C, in_ptr(ws, I_MW1) + (size_t)i * NEXP * DM * DM, in_ptr(ws, I_MW3) + (size_t)i * NEXP * DM * DM, in_ptr(ws, I_MW2) + (size_t)i * NEXP * DM * DM, P_W13, P_W2); });
        PHASE(2, { EpiBf16 E{P_U, EV_INP}; fast_gemm(C, P_HB, DM, (const bf16*)(ws + WS_WEVIN) + (size_t)lq * EV_INP * DM, DM, MT / 256, EV_INP / 256, E); });
        PHASE(3, { EpiF32 Eq{P_QPRE, 768}; fast_gemm(C, P_U, EV_INP, (const bf16*)(ws + WS_WUQ) + (size_t)lq * 768 * 384, 384, MT / 256, 3, Eq); RELAUNDER();
                   EpiF32 Ek{P_KVPRE, 1024}; fast_gemm(C, P_U + 384, EV_INP, (const bf16*)(ws + WS_WUKV) + (size_t)lq * 1024 * 256, 256, MT / 256, 4, Ek, true); });
        PHASE(4, { ph_mla_fin(C, P_U, P_QPRE, P_KVPRE, in_ptr(ws, I_QG) + lq * 96, in_ptr(ws, I_KG) + lq * 96, (const f32x2*)(ws + WS_ROPE), P_QB, P_KB, P_VT);
                   ph_conv(C, P_U, in_ptr(ws, I_DWW) + (size_t)lq * 31 * 512, in_ptr(ws, I_DWB) + lq * 512, in_ptr(ws, I_LNG) + lq * 512, in_ptr(ws, I_LNB) + lq * 512, P_OCAT); });
        PHASE(5, ph_attn_mla2(C, P_QB, P_KB, P_VT, P_OCAT, false));
        PHASE(6, { const int i = 2 * lq; const float* xl = (i == 0) ? in_ptr(ws, I_X) : XL; const float* xc = (i == 0) ? in_ptr(ws, I_CTX) : P_XC;
                   EpiResid E{xl, xc, XL, P_XC, MODL(i) + 2048}; fast_gemm(C, P_OCAT, DM, (const bf16*)(ws + WS_WEVOUT) + (size_t)lq * DM * DM, DM, MT / 256, 4, E); });
        PHASE(7, { const int i = 2 * lq; ph_norm<true>(C, XL, P_XC, in_ptr(ws, I_N2G) + i * DM, MODL(i), 3072, 4096, P_HB, in_ptr(ws, I_ROUTER) + (size_t)i * DM * 16, P_AFFT, P_AFFC, P_SLOT); });
        PHASE(8, ph_topk(C, P_AFFT, P_AFFC, P_ROWS, P_GATE, P_SLOT, false));
        PHASE(9, { pg8::Gemm g{P_HB, P_W13, DM, DM, P_ROWS}; pg8::OrderMoE S{17, 8, 17, C.nb, C.vcu}; pg8::EpiAdapt<EpiGlu> E{EpiGlu{P_HID}}; pg8::gemm_phase(C.lds, g, S, E, C.tid); });
        PHASE(10, { pg8::Gemm g{P_HID, P_W2, DM, DM, nullptr}; pg8::OrderMoE S{17, 4, 17, C.nb, C.vcu}; pg8::EpiAdapt<EpiGate> E{EpiGate{P_Y2, P_GATE}}; pg8::gemm_phase(C.lds, g, S, E, C.tid); });
        PHASE(11, { const int i = 2 * lq; ph_combine(C, XL, P_XC, MODL(i) + 5120, P_SLOT, P_Y2, false, in_ptr(ws, I_N1G) + (i + 1) * DM, MODL(i + 1), P_HB);
                    moe_weight_prep(C, in_ptr(ws, I_MW1) + (size_t)(i + 1) * NEXP * DM * DM, in_ptr(ws, I_MW3) + (size_t)(i + 1) * NEXP * DM * DM, in_ptr(ws, I_MW2) + (size_t)(i + 1) * NEXP * DM * DM, P_W13, P_W2); });
        PHASE(13, { EpiBf16 E{P_U, OD_INP}; fast_gemm(C, P_HB, DM, (const bf16*)(ws + WS_WODIN) + (size_t)lq * OD_INP * DM, DM, MT / 256, OD_INP / 256, E); });
        PHASE(14, ph_prep(C, P_U, in_ptr(ws, I_SHIFTW) + (size_t)lq * 3 * RW_IN, in_ptr(ws, I_KKW) + lq * 512, in_ptr(ws, I_NAQG) + lq * 64, in_ptr(ws, I_NAKG) + lq * 64, P_R, P_V, P_K, P_KK, P_L, P_QN, P_KN, P_VTN));
        PHASE(15, { const bf16* WL = (const bf16*)(ws + WS_WLORA) + (size_t)lq * 655360;
                    { EpiLoraW E{P_W, in_ptr(ws, I_W0) + lq * 1024}; fast_gemm(C, P_L, 384, WL, 256, MT / 256, 4, E); } RELAUNDER();
                    { EpiLoraA E{P_KEFF, in_ptr(ws, I_A0) + lq * 1024}; fast_gemm(C, P_L, 384, WL + (size_t)1024 * 256, 256, MT / 256, 4, E, true); } RELAUNDER();
                    { EpiBf16 E{P_G, 512}; fast_gemm(C, P_L + 128, 384, WL + (size_t)2048 * 256, 256, MT / 256, 2, E); } });
        PHASE(16, { ph_natten2(C, P_QN, P_KN, P_VTN, P_OCAT, in_ptr(ws, I_RPB) + (size_t)lq * 8 * 465, lq == 1); __syncthreads();
                    ph_wkv_pre(C, P_R, P_K, P_KK, P_W, P_KEFF, in_ptr(ws, I_KA) + lq * 512, P_IMG); });
        PHASE(17, ph_wkv_chunk(C, P_R, P_V, P_K, P_KK, P_W, P_KEFF, in_ptr(ws, I_KA) + lq * 512, P_IMG, P_YS));
        PHASE(18, ph_post(C, P_YS, P_R, P_V, P_K, P_KEFF, in_ptr(ws, I_KA) + lq * 512, P_G, in_ptr(ws, I_RK) + lq * 512, in_ptr(ws, I_GNG) + lq * 512, in_ptr(ws, I_GNB) + lq * 512, P_OCAT, lq == 1));
        PHASE(19, { const int i = 2 * lq + 1; EpiResid E{XL, P_XC, XL, P_XC, MODL(i) + 2048};
                    fast_gemm(C, P_OCAT, DM, (const bf16*)(ws + WS_WODOUT) + (size_t)lq * DM * DM, DM, (lq == 1) ? NLAT / 256 : MT / 256, 4, E); });
        PHASE(20, { const int i = 2 * lq + 1; ph_norm<true>(C, XL, P_XC, in_ptr(ws, I_N2G) + i * DM, MODL(i), 3072, 4096, P_HB, in_ptr(ws, I_ROUTER) + (size_t)i * DM * 16, P_AFFT, P_AFFC, P_SLOT); });
        PHASE(21, ph_topk(C, P_AFFT, P_AFFC, P_ROWS, P_GATE, P_SLOT, lq == 1));
        PHASE(22, { pg8::Gemm g{P_HB, P_W13, DM, DM, P_ROWS}; pg8::OrderMoE S{(lq == 1) ? 16 : 17, 8, 17, C.nb, C.vcu}; pg8::EpiAdapt<EpiGlu> E{EpiGlu{P_HID}}; pg8::gemm_phase(C.lds, g, S, E, C.tid); });
        PHASE(23, { pg8::Gemm g{P_HID, P_W2, DM, DM, nullptr}; pg8::OrderMoE S{(lq == 1) ? 16 : 17, 4, 17, C.nb, C.vcu}; pg8::EpiAdapt<EpiGate> E{EpiGate{P_Y2, P_GATE}}; pg8::gemm_phase(C.lds, g, S, E, C.tid); });
        PHASE(24, { const int i = 2 * lq + 1;
                    if (lp == 0) { ph_combine(C, XL, P_XC, MODL(i) + 5120, P_SLOT, P_Y2, false, in_ptr(ws, I_N1G) + (i + 1) * DM, MODL(i + 1), P_HB);
                        moe_weight_prep(C, in_ptr(ws, I_MW1) + (size_t)(i + 1) * NEXP * DM * DM, in_ptr(ws, I_MW3) + (size_t)(i + 1) * NEXP * DM * DM, in_ptr(ws, I_MW2) + (size_t)(i + 1) * NEXP * DM * DM, P_W13, P_W2); }
                    else ph_combine(C, XL, P_XC, MODL(i) + 5120, P_SLOT, P_Y2, true, nullptr, nullptr, nullptr); });
    };
    layer_pair(IC<0>{}); layer_pair(IC<1>{});
}

extern "C" void kernel_launch(void* const* d_in, const int* in_sizes, int n_in, void* d_out, int out_size, void* d_ws, size_t ws_size, hipStream_t stream) {
    static int grid = 0;
    if (grid == 0) {
        if (n_in != 40 || out_size != NLAT * DM || ws_size < WS_END) { fprintf(stderr, "kernel_launch: unexpected shapes (n_in %d out %d ws %zu need %zu)\n", n_in, out_size, ws_size, (size_t)WS_END); grid = -1; return; }
        int dev = 0, cus = 0, per_cu = 0;
        if (hipGetDevice(&dev) != hipSuccess || hipDeviceGetAttribute(&cus, hipDeviceAttributeMultiprocessorCount, dev) != hipSuccess) { grid = -1; return; }
        if (hipFuncSetAttribute((const void*)fwd_kernel, hipFuncAttributeMaxDynamicSharedMemorySize, LDS_BYTES) != hipSuccess) { fprintf(stderr, "kernel_launch: hipFuncSetAttribute failed\n"); grid = -1; return; }
        if (hipOccupancyMaxActiveBlocksPerMultiprocessor(&per_cu, (const void*)fwd_kernel, 512, LDS_BYTES) != hipSuccess || per_cu < 1) { fprintf(stderr, "kernel_launch: occupancy query says %d\n", per_cu); per_cu = 1; }
        (void)hipGetLastError();
        grid = cus;
    }
    if (grid < 0) return;
    (void)hipMemsetAsync((char*)d_ws + WS_CTL, 0, CTL_BYTES, stream);
    Args a{};
    for (int i = 0; i < 40; ++i) a.in[i] = (const float*)d_in[i];
    a.out = (float*)d_out; a.ws = (unsigned char*)d_ws;
#if MEGA
    a.ph_lo = 0; a.ph_hi = N_PHASES;
    hipLaunchKernelGGL(fwd_kernel, dim3(grid), dim3(512), LDS_BYTES, stream, a);
#else
    for (int p = 0; p < N_PHASES; ++p) { a.ph_lo = p; a.ph_hi = p + 1; hipLaunchKernelGGL(fwd_kernel, dim3(grid), dim3(512), LDS_BYTES, stream, a); }
#endif
}
```

```cpp
#include <hip/hip_runtime.h>
#include <cstdio>
#include <cstdint>

#ifndef MEGA
#define MEGA 1
#endif

#define LAS __attribute__((address_space(3)))
#define DI __device__ __forceinline__

typedef unsigned short bf16;
typedef short bf16x8 __attribute__((ext_vector_type(8)));
typedef float f32x4 __attribute__((ext_vector_type(4)));
typedef float f32x2 __attribute__((ext_vector_type(2)));
typedef float f32x16 __attribute__((ext_vector_type(16)));
typedef unsigned u32x4 __attribute__((ext_vector_type(4)));
typedef unsigned u32x2 __attribute__((ext_vector_type(2)));
typedef __bf16 bf16x2_t __attribute__((ext_vector_type(2)));

constexpr int DM = 1024, NB = 8, TL = 4096, LCX = 256;
constexpr int NLAT = NB * TL, NCTX = NB * LCX, MT = NLAT + NCTX;
constexpr int KPOS = TL + LCX;
constexpr float EPS = 1e-6f, GN_EPS = 64e-5f;
constexpr int EV_IN = 1696, EV_INP = 1792, OD_IN = 3456, OD_INP = 3584, RW_IN = 1920;
constexpr int NEXP = 16, CAPL = 512, CAPC = 32, ESLOTS = NB * CAPL + NB * CAPC;
constexpr float LOG2E = 1.4426950408889634f;

constexpr size_t MiB = 1ull << 20;
constexpr size_t WS_CTL = 0, CTL_BYTES = 1 * MiB;
constexpr size_t WS_MOD = 1 * MiB, WS_ROPE = 2 * MiB, WS_XC = 4 * MiB;
constexpr size_t WS_ROWS = 12 * MiB, WS_GATE = 12 * MiB + 512 * 1024, WS_SLOT = 13 * MiB, WS_AFFT = 16 * MiB, WS_AFFC = 18 * MiB;
constexpr size_t WS_WEVIN = 20 * MiB, WS_WEVOUT = 27 * MiB, WS_WUQ = 31 * MiB, WS_WUKV = 33 * MiB, WS_WODIN = 34 * MiB, WS_WODOUT = 48 * MiB, WS_WLORA = 52 * MiB;
constexpr size_t WS_W13 = 56 * MiB, WS_W2 = 120 * MiB, WS_HB = 152 * MiB, WS_OCAT = 220 * MiB, WS_ARENA = 288 * MiB;
constexpr size_t A_U = 0, A_QPRE = 119 * MiB, A_KVPRE = 221 * MiB, A_QB = 357 * MiB, A_KB = 408 * MiB, A_VT = 459 * MiB;
constexpr size_t A_W = 0, A_KEFF = 136 * MiB  , A_G = 204 * MiB, A_R = 238 * MiB, A_V = 272 * MiB, A_KK = 306 * MiB, A_K = 340 * MiB, A_L = 374 * MiB,
                 A_QN = 400 * MiB, A_KN = 434 * MiB, A_VTN = 468 * MiB, A_YS = 612 * MiB  ;
constexpr size_t A_HID = 0, A_Y2 = 136 * MiB;
constexpr size_t A_IMG = 510 * MiB;
constexpr size_t WS_END = WS_ARENA + 680 * MiB;
constexpr int LDS_BYTES = 147456;

DI unsigned pk2(float lo, float hi) { f32x2 v = {lo, hi}; bf16x2_t b = __builtin_convertvector(v, bf16x2_t); return __builtin_bit_cast(unsigned, b); }
DI float bflo(unsigned u) { return __builtin_bit_cast(float, u << 16); }
DI float bfhi(unsigned u) { return __builtin_bit_cast(float, u & 0xffff0000u); }
DI float bf2f(bf16 x) { return __builtin_bit_cast(float, ((unsigned)x) << 16); }
DI bf16 f2bf(float f) { return (bf16)(pk2(f, 0.f) & 0xffffu); }
DI void unpack8(u32x4 v, float (&f)[8]) { f[0] = bflo(v.x); f[1] = bfhi(v.x); f[2] = bflo(v.y); f[3] = bfhi(v.y); f[4] = bflo(v.z); f[5] = bfhi(v.z); f[6] = bflo(v.w); f[7] = bfhi(v.w); }
DI u32x4 pack8(const float (&f)[8]) { u32x4 r; r.x = pk2(f[0], f[1]); r.y = pk2(f[2], f[3]); r.z = pk2(f[4], f[5]); r.w = pk2(f[6], f[7]); return r; }
#define DPP_ADD(x, ctrl) ((x) + __builtin_bit_cast(float, __builtin_amdgcn_update_dpp(0, __builtin_bit_cast(int, (x)), (ctrl), 0xf, 0xf, false)))
#define DPP_MAX(x, ctrl) fmaxf((x), __builtin_bit_cast(float, __builtin_amdgcn_update_dpp(0, __builtin_bit_cast(int, (x)), (ctrl), 0xf, 0xf, false)))
DI float sum8(float x) { x = DPP_ADD(x, 0xB1); x = DPP_ADD(x, 0x4E); x = DPP_ADD(x, 0x141); return x; }
DI float sum16(float x) { x = DPP_ADD(x, 0xB1); x = DPP_ADD(x, 0x4E); x = DPP_ADD(x, 0x141); x = DPP_ADD(x, 0x140); return x; }
DI float max16(float x) { x = DPP_MAX(x, 0xB1); x = DPP_MAX(x, 0x4E); x = DPP_MAX(x, 0x141); x = DPP_MAX(x, 0x140); return x; }
DI float rdlane(float x, int l) { return __builtin_bit_cast(float, __builtin_amdgcn_readlane(__builtin_bit_cast(int, x), l)); }
DI float wave_sum(float v) { const float x = sum16(v); return (rdlane(x, 0) + rdlane(x, 16)) + (rdlane(x, 32) + rdlane(x, 48)); }
DI float xor32(float v, int lane) { return __builtin_bit_cast(float, __builtin_amdgcn_ds_bpermute((lane ^ 32) << 2, __builtin_bit_cast(int, v))); }
DI float sigmoidf_(float x) { return __builtin_amdgcn_rcpf(1.f + __expf(-x)); }
DI float siluf_(float x) { return x * __builtin_amdgcn_rcpf(1.f + __expf(-x)); }
#define MFMA32(a, b, c) __builtin_amdgcn_mfma_f32_32x32x16_bf16((a), (b), (c), 0, 0, 0)

#define XB_TMO      128
#define XB_XCNT(j)  (256  + 64 * (j))
#define XB_XSUB(j)  (1280 + 64 * (j))
#define XB_XGEN(j)  (2304 + 64 * (j))
#define XB_TOP      3328
#define XB_TOPGEN   3392
#define XCD_BAR_WORDS 3456
#define XB_SPIN_CAP (1u << 22)
__device__ __forceinline__ unsigned xb_ld(unsigned* p)              { return __hip_atomic_load(p, __ATOMIC_RELAXED, __HIP_MEMORY_SCOPE_AGENT); }
__device__ __forceinline__ unsigned xb_add(unsigned* p, unsigned v) { return __hip_atomic_fetch_add(p, v, __ATOMIC_RELAXED, __HIP_MEMORY_SCOPE_AGENT); }
__device__ __forceinline__ unsigned xb_xcc_id() { return (unsigned)__builtin_amdgcn_s_getreg((3 << 11) | 20) & 0xFu; }
#define XB_SPIN(cond, bar) do { unsigned _sp = 0; while (cond) { __builtin_amdgcn_s_sleep(1); \
    if ((++_sp & 255u) == 0u) { if (xb_ld(&(bar)[XB_TMO])) break; if (_sp > XB_SPIN_CAP) { atomicAdd(&(bar)[XB_TMO], 1u); break; } } } } while (0)
struct XcdBarrier { unsigned* bar; unsigned x; volatile LAS unsigned* st; };
__device__ __forceinline__ XcdBarrier xcd_barrier_post(unsigned* bar, volatile LAS unsigned* st, bool leader) {
    XcdBarrier b; b.bar = bar; b.x = xb_xcc_id(); b.st = st;
    if (leader) (void)xb_add(&bar[XB_XCNT(b.x)], 1u);
    return b;
}
__device__ __forceinline__ void xcd_barrier_complete(unsigned* bar, unsigned x, unsigned& nloc, unsigned& nx) {
    const unsigned G = gridDim.x * gridDim.y * gridDim.z;
    unsigned sum, cnt, mine, sp = 0u;
    for (;;) {
        sum = 0u; cnt = 0u; mine = 0u;
#pragma unroll
        for (unsigned j = 0; j < 16; ++j) { const unsigned c = xb_ld(&bar[XB_XCNT(j)]); sum += c; cnt += (c > 0u) ? 1u : 0u; mine = (j == x) ? c : mine; }
        if (sum == G) break;
        __builtin_amdgcn_s_sleep(1);
        if ((++sp & 255u) == 0u) { if (xb_ld(&bar[XB_TMO])) break; if (sp > XB_SPIN_CAP) { atomicAdd(&bar[XB_TMO], 1u); break; } }
    }
    nloc = mine > 0u ? mine : 1u; nx = cnt > 0u ? cnt : 1u;
}
__device__ __forceinline__ void xcd_barrier(const XcdBarrier& b, bool leader) {
    asm volatile("s_waitcnt vmcnt(0)" ::: "memory");
    __syncthreads();
    if (leader) {
        unsigned* bar = b.bar;
        __builtin_amdgcn_s_waitcnt(0);
        unsigned nloc = b.st[0], nx = b.st[1];
        if (nloc == 0u) { xcd_barrier_complete(bar, b.x, nloc, nx); b.st[0] = nloc; b.st[1] = nx; }
        const unsigned old = xb_add(&bar[XB_XSUB(b.x)], 1u);
        const unsigned gen = old / nloc;
        if (old + 1u == (gen + 1u) * nloc) {
            __builtin_amdgcn_fence(__ATOMIC_RELEASE, "agent");
            asm volatile("s_waitcnt vmcnt(0)" ::: "memory");
            const unsigned og = xb_add(&bar[XB_TOP], 1u);
            const unsigned tg = og / nx;
            if (og + 1u == (tg + 1u) * nx) xb_add(&bar[XB_TOPGEN], 1u);
            else XB_SPIN(xb_ld(&bar[XB_TOPGEN]) == tg, bar);
            __builtin_amdgcn_fence(__ATOMIC_ACQUIRE, "agent");
            xb_add(&bar[XB_XGEN(b.x)], 1u);
            asm volatile("s_waitcnt vmcnt(0)" ::: "memory");
        } else {
            XB_SPIN(xb_ld(&bar[XB_XGEN(b.x)]) == gen, bar);
            __builtin_amdgcn_fence(__ATOMIC_ACQUIRE, "agent");
            asm volatile("s_waitcnt vmcnt(0)" ::: "memory");
        }
    }
    __syncthreads();
}

struct Ctx { LAS unsigned char* lds; int tid, lane, wave, bid, nb, vcu; };
struct Args { const float* in[40]; float* out; unsigned char* ws; int ph_lo, ph_hi; };
enum { I_X = 0, I_C, I_CTX, I_CCTX, I_ADAW, I_ADAB, I_N1G, I_N2G, I_EVWIN, I_EVWOUT, I_QNORM, I_WUQ, I_KVNORM, I_WUKV, I_QG, I_KG, I_DWW, I_DWB, I_LNG, I_LNB,
       I_ODWIN, I_ODWOUT, I_SHIFTW, I_W0, I_W2L, I_A0, I_A2, I_G2, I_KKW, I_KA, I_RK, I_GNG, I_GNB, I_NAQG, I_NAKG, I_RPB, I_ROUTER, I_MW1, I_MW3, I_MW2 };

DI void transpose_item(const float* __restrict__ W, int K, int N, bf16* __restrict__ WT, int dst_row0, const float* __restrict__ gain, LAS float* scr, int k0, int n0, int lane) {
#pragma unroll 8
    for (int i = 0; i < 32; ++i) { const int kk = 2 * i + (lane >> 5); float v = W[(size_t)(k0 + kk) * N + n0 + (lane & 31)]; if (gain) v *= gain[k0 + kk]; scr[kk * 33 + (lane & 31)] = v; }
    asm volatile("s_waitcnt lgkmcnt(0)" ::: "memory");
    const int c = lane & 7;
#pragma unroll
    for (int j = 0; j < 4; ++j) { const int n = (lane >> 3) + 8 * j; const LAS float* s = scr + (8 * c) * 33 + n;
        u32x4 o; o.x = pk2(s[0 * 33], s[1 * 33]); o.y = pk2(s[2 * 33], s[3 * 33]); o.z = pk2(s[4 * 33], s[5 * 33]); o.w = pk2(s[6 * 33], s[7 * 33]);
        *(u32x4*)(WT + (size_t)(dst_row0 + n) * K + k0 + 8 * c) = o; }
    asm volatile("s_waitcnt lgkmcnt(0)" ::: "memory");
}
DI void transpose_item64(const float* __restrict__ W, int K, int N, bf16* __restrict__ WT, int dst_row0, LAS float* scr, int k0, int n0, int lane) {
    f32x4 v[16];
#pragma unroll
    for (int i = 0; i < 16; ++i) v[i] = *(const f32x4*)(W + (size_t)(k0 + 4 * i + (lane >> 4)) * N + n0 + 4 * (lane & 15));
#pragma unroll
    for (int i = 0; i < 16; ++i) { LAS float* d = scr + (4 * i + (lane >> 4)) * 65 + 4 * (lane & 15); d[0] = v[i].x; d[1] = v[i].y; d[2] = v[i].z; d[3] = v[i].w; }
    asm volatile("s_waitcnt lgkmcnt(0)" ::: "memory");
    const int c = lane & 7;
#pragma unroll
    for (int j = 0; j < 8; ++j) { const int n = (lane >> 3) + 8 * j; const LAS float* s = scr + (8 * c) * 65 + n;
        u32x4 o; o.x = pk2(s[0 * 65], s[1 * 65]); o.y = pk2(s[2 * 65], s[3 * 65]); o.z = pk2(s[4 * 65], s[5 * 65]); o.w = pk2(s[6 * 65], s[7 * 65]);
        *(u32x4*)(WT + (size_t)(dst_row0 + n) * K + k0 + 8 * c) = o; }
    asm volatile("s_waitcnt lgkmcnt(0)" ::: "memory");
}
DI void transpose_matrix(const Ctx& C, const float* W, int K, int N, bf16* WT, const float* gain, int mode  ) {
    LAS float* scr = (LAS float*)(C.lds + C.wave * 8704);
    const int nkb = K / 64, nnb = N / 32, nit = nkb * nnb, gw = C.vcu * 8 + C.wave, ngw = C.nb * 8;
    for (int it = gw; it < nit; it += ngw) {
        const int kb = it / nnb, nbk = it % nnb, n0 = nbk * 32;
        int d0 = n0; if (mode) d0 = (n0 >> 7) * 256 + (n0 & 127) + (mode == 2 ? 128 : 0);
        transpose_item(W, K, N, WT, d0, gain, scr, kb * 64, n0, C.lane);
    }
}
DI void moe_weight_prep(const Ctx& C, const float* w1, const float* w3, const float* w2, bf16* W13, bf16* W2) {
    LAS float* scr = (LAS float*)(C.lds + C.wave * 16640);
    const int gw = C.vcu * 8 + C.wave, ngw = C.nb * 8;
    constexpr int PER = 16 * 16;
    for (int it = gw; it < NEXP * 3 * PER; it += ngw) {
        const int e = it / (3 * PER), r = it % (3 * PER), which = r / PER, q = r % PER, kb = q / 16, n0 = (q % 16) * 64;
        if (which == 0)      transpose_item64(w1 + (size_t)e * DM * DM, DM, DM, W13 + (size_t)e * 2048 * DM, (n0 >> 7) * 256 + (n0 & 127), scr, kb * 64, n0, C.lane);
        else if (which == 1) transpose_item64(w3 + (size_t)e * DM * DM, DM, DM, W13 + (size_t)e * 2048 * DM, (n0 >> 7) * 256 + (n0 & 127) + 128, scr, kb * 64, n0, C.lane);
        else                 transpose_item64(w2 + (size_t)e * DM * DM, DM, DM, W2 + (size_t)e * DM * DM, n0, scr, kb * 64, n0, C.lane);
    }
}

DI void ph_prologue(const Ctx& C, const Args& a) {
    unsigned char* ws = a.ws;
    {
        LAS float* sv = (LAS float*)C.lds;
        LAS float* red = sv + 9 * 1024;
        for (int i = C.tid; i < 9 * 1024; i += 512) { const int m = i >> 10, k = i & 1023; const float c = (m < 8) ? a.in[I_C][m * 1024 + k] : a.in[I_CCTX][k]; sv[i] = siluf_(c); }
        __syncthreads();
        float* MOD = (float*)(ws + WS_MOD);
        for (int it = C.bid; it < 4 * 96; it += C.nb) {
            const int layer = it / 96, col = (it % 96) * 64 + C.lane;
            const float* wp = a.in[I_ADAW] + (size_t)layer * 1024 * 6144 + col;
            float acc[9];
#pragma unroll
            for (int m = 0; m < 9; ++m) acc[m] = 0.f;
            const int kb = C.wave * 128;
#pragma unroll 4
            for (int k = 0; k < 128; ++k) { const float w = wp[(size_t)(kb + k) * 6144];
#pragma unroll
                for (int m = 0; m < 9; ++m) acc[m] += sv[m * 1024 + kb + k] * w; }
#pragma unroll
            for (int m = 0; m < 9; ++m) red[(C.wave * 9 + m) * 64 + C.lane] = acc[m];
            __syncthreads();
            for (int i = C.tid; i < 576; i += 512) { const int m = i >> 6, l = i & 63; float s = 0.f;
#pragma unroll
                for (int w = 0; w < 8; ++w) s += red[(w * 9 + m) * 64 + l];
                const int cc = (it % 96) * 64 + l;
                MOD[(size_t)(layer * 9 + m) * 6144 + cc] = s + a.in[I_ADAB][layer * 6144 + cc]; }
            __syncthreads();
        }
    }
    {
        f32x2* CS = (f32x2*)(ws + WS_ROPE);
        for (int i = C.bid * 512 + C.tid; i < 4096 * 16; i += C.nb * 512) {
            const int pos = i >> 4, j = i & 15, f = j & 7;
            const float inv = powf(10000.f, -(float)(2 * f) / 16.f);
            const float ang = (float)((j < 8) ? (pos >> 6) : (pos & 63)) * inv;
            const double tw = 6.283185307179586476925;
            const double x = (double)ang, n = __builtin_rint(x / tw), rr = x - n * tw;
            CS[i] = (f32x2){__cosf((float)rr), __sinf((float)rr)};
        }
    }
    for (int j = 0; j < 2; ++j) {
        transpose_matrix(C, a.in[I_EVWIN] + (size_t)j * DM * EV_IN, DM, EV_IN, (bf16*)(ws + WS_WEVIN) + (size_t)j * EV_INP * DM, nullptr, 0);
        transpose_matrix(C, a.in[I_EVWOUT] + (size_t)j * DM * DM, DM, DM, (bf16*)(ws + WS_WEVOUT) + (size_t)j * DM * DM, nullptr, 0);
        transpose_matrix(C, a.in[I_WUQ] + (size_t)j * 384 * 768, 384, 768, (bf16*)(ws + WS_WUQ) + (size_t)j * 768 * 384, a.in[I_QNORM] + j * 384, 0);
        transpose_matrix(C, a.in[I_WUKV] + (size_t)j * 256 * 1024, 256, 1024, (bf16*)(ws + WS_WUKV) + (size_t)j * 1024 * 256, a.in[I_KVNORM] + j * 256, 0);
        transpose_matrix(C, a.in[I_ODWIN] + (size_t)j * DM * OD_IN, DM, OD_IN, (bf16*)(ws + WS_WODIN) + (size_t)j * OD_INP * DM, nullptr, 0);
        transpose_matrix(C, a.in[I_ODWOUT] + (size_t)j * DM * DM, DM, DM, (bf16*)(ws + WS_WODOUT) + (size_t)j * DM * DM, nullptr, 0);
    }
    {
        const int gt = C.bid * 512 + C.tid, ngt = C.nb * 512;
        for (int j = 0; j < 2; ++j) {
            u32x4* p0 = (u32x4*)((bf16*)(ws + WS_WEVIN) + (size_t)j * EV_INP * DM + (size_t)EV_IN * DM);
            for (int i = gt; i < (EV_INP - EV_IN) * DM / 8; i += ngt) p0[i] = (u32x4){0u, 0u, 0u, 0u};
            u32x4* p1 = (u32x4*)((bf16*)(ws + WS_WODIN) + (size_t)j * OD_INP * DM + (size_t)OD_IN * DM);
            for (int i = gt; i < (OD_INP - OD_IN) * DM / 8; i += ngt) p1[i] = (u32x4){0u, 0u, 0u, 0u};
            bf16* WL = (bf16*)(ws + WS_WLORA) + (size_t)j * 655360;
            const float* w2 = a.in[I_W2L] + (size_t)j * 2 * 64 * 512; const float* a2 = a.in[I_A2] + (size_t)j * 2 * 64 * 512; const float* g2 = a.in[I_G2] + (size_t)j * 128 * 512;
            for (int i = gt; i < 655360; i += ngt) {
                const int n = i >> 8, k = i & 255; float v = 0.f;
                if (n < 1024) { const int d = n >> 9, c = n & 511; if (k >= d * 64 && k < d * 64 + 64) v = w2[(size_t)k * 512 + c]; }
                else if (n < 2048) { const int d = (n - 1024) >> 9, c = n & 511; if (k >= 128 + d * 64 && k < 192 + d * 64) v = a2[(size_t)(k - 128) * 512 + c]; }
                else { const int c = n - 2048; if (k >= 128) v = g2[(size_t)(k - 128) * 512 + c]; }
                WL[i] = f2bf(v);
            }
        }
    }
}

template <bool ROUTER>
DI void ph_norm(const Ctx& C, const float* xlat, const float* xctx, const float* gain, const float* mod  , int shift_off, int scale_off, bf16* H,
                const float* router  , float* AFFT, float* AFFC, int* SLOT) {
    LAS float* RT = (LAS float*)C.lds;
    if (ROUTER) { for (int i = C.tid; i < 16384; i += 512) { const int c = i >> 4, e = i & 15; RT[e * 1024 + c] = router[i]; } __syncthreads(); }
    const int gw = C.bid * 8 + C.wave, ngw = C.nb * 8, lane = C.lane;
    for (int row = gw; row < MT; row += ngw) {
        const float* xr = row < NLAT ? xlat + (size_t)row * DM : xctx + (size_t)(row - NLAT) * DM;
        const int mi = row < NLAT ? (row >> 12) : 8;
        const float* mp = mod + mi * 6144;
        f32x4 v[4]; float ss = 0.f;
#pragma unroll
        for (int j = 0; j < 4; ++j) { v[j] = *(const f32x4*)(xr + 256 * j + 4 * lane); ss += v[j].x * v[j].x + v[j].y * v[j].y + v[j].z * v[j].z + v[j].w * v[j].w; }
        ss = wave_sum(ss);
        const float rs = 1.0f / sqrtf(ss * (1.f / 1024.f) + EPS);
#pragma unroll
        for (int j = 0; j < 4; ++j) {
            const int c = 256 * j + 4 * lane;
            const f32x4 g = *(const f32x4*)(gain + c), sc = *(const f32x4*)(mp + scale_off + c), sh = *(const f32x4*)(mp + shift_off + c);
            v[j] = (v[j] * rs) * g * (sc + 1.0f) + sh;
            *(u32x2*)(H + (size_t)row * DM + c) = (u32x2){pk2(v[j].x, v[j].y), pk2(v[j].z, v[j].w)};
        }
        if (ROUTER) {
            float mylg = 0.f;
#pragma unroll 1
            for (int e = 0; e < 16; ++e) { float p = 0.f;
#pragma unroll
                for (int j = 0; j < 4; ++j) { const f32x4 w = *(const LAS f32x4*)(RT + e * 1024 + 256 * j + 4 * lane); p += v[j].x * w.x + v[j].y * w.y + v[j].z * w.z + v[j].w * w.w; }
                p = wave_sum(p); mylg = (lane == e) ? p : mylg; }
            const float mx = max16(mylg);
            const float ex = expf(mylg - mx);
            const float mine = ex / sum16(ex);
            if (lane < 16) {
                if (row < NLAT) AFFT[(size_t)((row >> 12) * 16 + lane) * TL + (row & 4095)] = mine;
                else { const int rc = row - NLAT; AFFC[(size_t)((rc >> 8) * 16 + lane) * LCX + (rc & 255)] = mine; }
                SLOT[(size_t)row * 16 + lane] = -1;
            }
        }
    }
}

template <class Epi>
DI void gemm_unit(const bf16* __restrict__ A, int lda, const int* __restrict__ rows, const bf16* __restrict__ Bt, int K, int pm, int pn, const Epi& E, int wave, int lane) {
    const int wr = wave >> 2, wc = wave & 3, r = lane & 31, h = lane >> 5;
    const bf16* ap[2][2]; const bf16* bp[2];
#pragma unroll
    for (int ai = 0; ai < 2; ++ai)
#pragma unroll
        for (int mm = 0; mm < 2; ++mm) { const int lr = 256 * pm + 128 * ai + 64 * wr + 32 * mm + r; const int gr = rows ? rows[lr] : lr; ap[ai][mm] = A + (size_t)gr * lda + 8 * h; }
#pragma unroll
    for (int bj = 0; bj < 2; ++bj) bp[bj] = Bt + (size_t)(256 * pn + 128 * bj + 32 * wc + r) * K + 8 * h;
    f32x16 acc[2][2][2];
#pragma unroll
    for (int ai = 0; ai < 2; ++ai)
#pragma unroll
        for (int mm = 0; mm < 2; ++mm)
#pragma unroll
            for (int bj = 0; bj < 2; ++bj)
#pragma unroll
                for (int i = 0; i < 16; ++i) acc[ai][mm][bj][i] = 0.f;
#pragma unroll 2
    for (int k0 = 0; k0 < K; k0 += 16) {
        bf16x8 af[2][2], bfr[2];
#pragma unroll
        for (int ai = 0; ai < 2; ++ai)
#pragma unroll
            for (int mm = 0; mm < 2; ++mm) af[ai][mm] = *(const bf16x8*)(ap[ai][mm] + k0);
#pragma unroll
        for (int bj = 0; bj < 2; ++bj) bfr[bj] = *(const bf16x8*)(bp[bj] + k0);
#pragma unroll
        for (int ai = 0; ai < 2; ++ai)
#pragma unroll
            for (int mm = 0; mm < 2; ++mm)
#pragma unroll
                for (int bj = 0; bj < 2; ++bj) acc[ai][mm][bj] = MFMA32(bfr[bj], af[ai][mm], acc[ai][mm][bj]);
    }
#pragma unroll
    for (int ai = 0; ai < 2; ++ai)
#pragma unroll
        for (int mm = 0; mm < 2; ++mm) {
            const int row = 256 * pm + 128 * ai + 64 * wr + 32 * mm + r;
#pragma unroll
            for (int g = 0; g < 4; ++g) {
                const int col = 256 * pn + 32 * wc + 8 * g + 4 * h;
                const f32x4 v0 = {acc[ai][mm][0][4 * g], acc[ai][mm][0][4 * g + 1], acc[ai][mm][0][4 * g + 2], acc[ai][mm][0][4 * g + 3]};
                const f32x4 v1 = {acc[ai][mm][1][4 * g], acc[ai][mm][1][4 * g + 1], acc[ai][mm][1][4 * g + 2], acc[ai][mm][1][4 * g + 3]};
                E(row, col, v0, v1);
            }
        }
}
template <class Epi>
DI void gemm_phase(const Ctx& C, const bf16* A, int lda, const bf16* Bt, int K, int nM, int nN, const Epi& E) {
    for (int u = C.vcu; u < nM * nN; u += C.nb) gemm_unit(A, lda, nullptr, Bt, K, u / nN, u % nN, E, C.wave, C.lane);
}

struct EpiBf16 { bf16* O; int ldo;
    DI void operator()(int row, int col, f32x4 v0, f32x4 v1) const { bf16* p = O + (size_t)row * ldo + col;
        *(u32x2*)p = (u32x2){pk2(v0[0], v0[1]), pk2(v0[2], v0[3])}; *(u32x2*)(p + 128) = (u32x2){pk2(v1[0], v1[1]), pk2(v1[2], v1[3])}; } };
struct EpiF32 { float* O; int ldo;
    DI void operator()(int row, int col, f32x4 v0, f32x4 v1) const { float* p = O + (size_t)row * ldo + col; *(f32x4*)p = v0; *(f32x4*)(p + 128) = v1; } };
struct EpiResid { const float* xin_lat; const float* xin_ctx; float* xout_lat; float* xout_ctx; const float* modg;
    DI void operator()(int row, int col, f32x4 v0, f32x4 v1) const {
        const float* xi; float* xo; int mi;
        if (row < NLAT) { xi = xin_lat + (size_t)row * DM; xo = xout_lat + (size_t)row * DM; mi = row >> 12; }
        else { xi = xin_ctx + (size_t)(row - NLAT) * DM; xo = xout_ctx + (size_t)(row - NLAT) * DM; mi = 8; }
        const float* g = modg + mi * 6144 + col;
        const f32x4 g0 = *(const f32x4*)g, g1 = *(const f32x4*)(g + 128), x0 = *(const f32x4*)(xi + col), x1 = *(const f32x4*)(xi + col + 128);
        *(f32x4*)(xo + col) = x0 + g0 * v0; *(f32x4*)(xo + col + 128) = x1 + g1 * v1; } };
struct EpiGlu { bf16* O;
    DI void operator()(int row, int col, f32x4 v0, f32x4 v1) const { const int f = ((col & 2047) >> 8) * 128 + (col & 255);
        *(u32x2*)(O + (size_t)row * DM + f) = (u32x2){pk2(siluf_(v0[0]) * v1[0], siluf_(v0[1]) * v1[1]), pk2(siluf_(v0[2]) * v1[2], siluf_(v0[3]) * v1[3])}; } };
struct EpiGate { bf16* O; const float* gate;
    DI void operator()(int row, int col, f32x4 v0, f32x4 v1) const { const float g = gate[row]; bf16* p = O + (size_t)row * DM + (col & 1023);
        *(u32x2*)p = (u32x2){pk2(v0[0] * g, v0[1] * g), pk2(v0[2] * g, v0[3] * g)}; *(u32x2*)(p + 128) = (u32x2){pk2(v1[0] * g, v1[1] * g), pk2(v1[2] * g, v1[3] * g)}; } };
struct EpiLoraW { float* W; const float* w0;
    DI void one(int row, int col, f32x4 v) const { const int d = col >> 9, c = col & 511; f32x4 o;
#pragma unroll
        for (int e = 0; e < 4; ++e) { const float lw = w0[col + e] + v[e]; const float z = -lw; const float sp = fmaxf(z, 0.f) + __logf(1.f + __expf(-fabsf(z))); o[e] = -__expf(-sp - 0.5f); }
        *(f32x4*)(W + ((size_t)d * MT + row) * 512 + c) = o; }
    DI void operator()(int row, int col, f32x4 v0, f32x4 v1) const { one(row, col, v0); one(row, col + 128, v1); } };
struct EpiLoraA { bf16* Aout; const float* a0;
    DI void one(int row, int col, f32x4 v) const { const int d = col >> 9, c = col & 511; const f32x4 b = *(const f32x4*)(a0 + col);
        *(u32x2*)(Aout + ((size_t)d * MT + row) * 512 + c) = (u32x2){pk2(sigmoidf_(b[0] + v[0]), sigmoidf_(b[1] + v[1])), pk2(sigmoidf_(b[2] + v[2]), sigmoidf_(b[3] + v[3]))}; }
    DI void operator()(int row, int col, f32x4 v0, f32x4 v1) const { one(row, col, v0); one(row, col + 128, v1); } };

namespace pg8 {
constexpr int BM = 256, BK = 64, HALF = 128, HTB = HALF * BK * 2, STAGE_BYTES = 8 * HTB;
DI int lds_byte(int r, int c) { const int st = (r >> 4) * 2 + (c >> 5), rr = r & 15, cc = c & 31, ob = rr * 64 + cc * 2; return st * 1024 + (ob ^ (((ob >> 9) & 1) << 5)); }
DI void stage_rc(int b, int& R, int& C) { const int st = b / 1024, sb = b % 1024, swz = sb ^ (((sb >> 9) & 1) << 5); R = (st >> 1) * 16 + swz / 64; C = (st & 1) * 32 + (swz % 64) / 2; }
DI int perm32(int rho) { const int n = rho >> 4, i = rho & 15; return 8 * (i >> 2) + 4 * n + (i & 3); }
struct Unit { int pm, pn; };
struct Gemm { const bf16* A; const bf16* Bt; int lda, K; const int* rows; };
struct OrderMN { int nM, nN, G, c;
    DI bool next(int i, Unit& u) const { const int L = i * G + c; if (L >= nM * nN) return false; u.pm = L / nN; u.pn = L % nN; return true; } };
struct OrderMoE { int nMt, nN, mstride  , G, c;
    DI bool next(int i, Unit& u) const { const int L = i * G + c, per = nMt * nN; if (L >= NEXP * per) return false; const int e = L / per, q = L % per; u.pm = e * mstride + q / nN; u.pn = e * nN + q % nN; return true; } };
template <class E4> struct EpiAdapt { E4 e;
    DI void operator()(const f32x4 (&acc)[2][2][4][2], const Unit& u, int wr, int wc, int fr, int fq) const {
#pragma unroll
        for (int ai = 0; ai < 2; ++ai)
#pragma unroll
            for (int m = 0; m < 4; ++m) { const int row = u.pm * BM + ai * HALF + wr * 64 + m * 16 + fr;
#pragma unroll
                for (int n = 0; n < 2; ++n) e(row, u.pn * BM + wc * 32 + 8 * fq + 4 * n, acc[ai][0][m][n], acc[ai][1][m][n]); } } };

template <class Epi, class Sched>
DI void gemm_phase(LAS unsigned char* lds, const Gemm g, const Sched& S, const Epi& E, const int tid) {
    const int wid = __builtin_amdgcn_readfirstlane(tid >> 6), lane = tid & 63, wr = wid >> 2, wc = wid & 3, fr = lane & 15, fq = lane >> 4;
    const int K = g.K, nt = K / BK;
    int RA[2], CA[2]; unsigned voffB[2];
#pragma unroll
    for (int i = 0; i < 2; ++i) { int R, C; stage_rc(tid * 16 + i * 8192, R, C); RA[i] = R; CA[i] = C; const int Rb = (R & ~31) + perm32(R & 31); voffB[i] = (unsigned)(Rb * K + C) * 2u; }
    const size_t kstep = (size_t)(BK * 2), hstep = (size_t)HALF * K * 2, tstep = 2 * hstep;
    const unsigned ldsw = (unsigned)wid * 1024u;
    const int aoff = lds_byte(wr * 64 + fr, fq * 8), boff = lds_byte(wc * 32 + fr, fq * 8);
    const char* const gA = (const char*)g.A;
#define PG8_SA(b, h) (((b) * 2 + (h)) * HTB)
#define PG8_SB(b, h) ((4 + (b) * 2 + (h)) * HTB)
#define PG8_STAGE(bufoff, gbase, voff) do { _Pragma("unroll") for (int _i = 0; _i < 2; ++_i) \
        __builtin_amdgcn_global_load_lds((const unsigned*)((const char*)(gbase) + (voff)[_i]), (LAS unsigned*)(lds + (bufoff) + ldsw + _i * 8192), 16, 0, 0); } while (0)
#define PG8_LDA(dst, b, h) do { _Pragma("unroll") for (int m = 0; m < 4; ++m) _Pragma("unroll") for (int k = 0; k < 2; ++k) dst[m][k] = *(const LAS bf16x8*)(lds + PG8_SA(b, h) + aoff + m * 2048 + k * 1024); } while (0)
#define PG8_LDB(dst, b, h) do { _Pragma("unroll") for (int n = 0; n < 2; ++n) _Pragma("unroll") for (int k = 0; k < 2; ++k) dst[n][k] = *(const LAS bf16x8*)(lds + PG8_SB(b, h) + boff + n * 2048 + k * 1024); } while (0)
#define PG8_MMA(ai, bj, At, Bt) do { __builtin_amdgcn_s_setprio(1); _Pragma("unroll") for (int m = 0; m < 4; ++m) _Pragma("unroll") for (int n = 0; n < 2; ++n) _Pragma("unroll") for (int k = 0; k < 2; ++k) \
        acc[ai][bj][m][n] = __builtin_amdgcn_mfma_f32_16x16x32_bf16(Bt[n][k], At[m][k], acc[ai][bj][m][n], 0, 0, 0); __builtin_amdgcn_s_setprio(0); } while (0)
#define PG8_WAIT_V(n) asm volatile("s_waitcnt vmcnt(" #n ")" ::: "memory")
#define PG8_WAIT_L(n) asm volatile("s_waitcnt lgkmcnt(" #n ")" ::: "memory")
#define PG8_BAR __builtin_amdgcn_s_barrier()
#define PG8_SCHED __builtin_amdgcn_sched_barrier(0)
#define PG8_AOFF(vo, u) do { _Pragma("unroll") for (int _h = 0; _h < 2; ++_h) _Pragma("unroll") for (int _i = 0; _i < 2; ++_i) { const int _lr = (u).pm * BM + _h * HALF + RA[_i]; \
        const int _gr = g.rows ? g.rows[_lr] : _lr; vo[_h][_i] = (unsigned)(((size_t)_gr * g.lda + CA[_i]) * 2u); } } while (0)
    Unit cur, nxt; int ui = 0;
    if (!S.next(0, cur)) return;
    f32x4 acc[2][2][4][2];
#pragma unroll
    for (int a = 0; a < 2; ++a)
#pragma unroll
        for (int b = 0; b < 2; ++b)
#pragma unroll
            for (int m = 0; m < 4; ++m)
#pragma unroll
                for (int n = 0; n < 2; ++n) acc[a][b][m][n] = (f32x4){0.f, 0.f, 0.f, 0.f};
    bf16x8 At[4][2], B0[2][2], B1[2][2];
    unsigned cvo[2][2], nvo[2][2];
    PG8_AOFF(cvo, cur);
    const char* cB = (const char*)g.Bt + (size_t)cur.pn * tstep;
    PG8_STAGE(PG8_SB(0, 0), cB, voffB); PG8_STAGE(PG8_SB(0, 1), cB + hstep, voffB); PG8_STAGE(PG8_SA(0, 0), gA, cvo[0]); PG8_STAGE(PG8_SA(0, 1), gA, cvo[1]);
    if (wr == 1) PG8_BAR;
    PG8_WAIT_V(2); PG8_BAR;
    PG8_STAGE(PG8_SB(1, 0), cB + kstep, voffB); PG8_STAGE(PG8_SA(1, 0), gA + kstep, cvo[0]); PG8_STAGE(PG8_SB(1, 1), cB + hstep + kstep, voffB);
    PG8_WAIT_V(6); PG8_BAR;
    for (;;) {
        const bool has_next = S.next(ui + 1, nxt);
        if (has_next) { PG8_AOFF(nvo, nxt); } else {
#pragma unroll
            for (int _h = 0; _h < 2; ++_h)
#pragma unroll
                for (int _i = 0; _i < 2; ++_i) nvo[_h][_i] = cvo[_h][_i]; }
        const char* nB = has_next ? (const char*)g.Bt + (size_t)nxt.pn * tstep : cB;
        for (int t = 0; t < nt; t += 2) {
            const bool last = (t == nt - 2);
            const char* a1 = gA + (size_t)(t + 1) * kstep;
            const char* a2 = last ? gA : gA + (size_t)(t + 2) * kstep; const char* b2 = last ? nB : cB + (size_t)(t + 2) * kstep;
            const char* a3 = a2 + kstep; const char* b3 = b2 + kstep;
            unsigned v20[2], v21[2];
#pragma unroll
            for (int _i = 0; _i < 2; ++_i) { v20[_i] = last ? nvo[0][_i] : cvo[0][_i]; v21[_i] = last ? nvo[1][_i] : cvo[1][_i]; }
            PG8_LDB(B0, 0, 0); PG8_LDB(B1, 0, 1); PG8_SCHED; PG8_LDA(At, 0, 0); PG8_STAGE(PG8_SA(1, 1), a1, cvo[1]);
            PG8_WAIT_V(8); PG8_WAIT_L(0); PG8_BAR; PG8_MMA(0, 0, At, B0); PG8_MMA(0, 1, At, B1); PG8_BAR; PG8_SCHED;
            PG8_LDA(At, 0, 1); PG8_STAGE(PG8_SB(0, 0), b2, voffB); PG8_STAGE(PG8_SB(0, 1), b2 + hstep, voffB); PG8_STAGE(PG8_SA(0, 0), a2, v20);
            PG8_WAIT_V(8); PG8_WAIT_L(0); PG8_BAR; PG8_MMA(1, 0, At, B0); PG8_MMA(1, 1, At, B1); PG8_BAR; PG8_SCHED;
            PG8_LDB(B0, 1, 0); PG8_LDB(B1, 1, 1); PG8_SCHED; PG8_LDA(At, 1, 0); PG8_STAGE(PG8_SA(0, 1), a2, v21);
            PG8_WAIT_V(8); PG8_WAIT_L(0); PG8_BAR; PG8_MMA(0, 0, At, B0); PG8_MMA(0, 1, At, B1); PG8_BAR; PG8_SCHED;
            PG8_LDA(At, 1, 1); PG8_STAGE(PG8_SB(1, 0), b3, voffB); PG8_STAGE(PG8_SB(1, 1), b3 + hstep, voffB); PG8_STAGE(PG8_SA(1, 0), a3, v20);
            PG8_WAIT_V(8); PG8_WAIT_L(0); PG8_BAR; PG8_MMA(1, 0, At, B0); PG8_MMA(1, 1, At, B1); PG8_BAR; PG8_SCHED;
        }
        if (wr == 0) PG8_BAR;
        E(acc, cur, wr, wc, fr, fq);
        if (!has_next) break;
#pragma unroll
        for (int a = 0; a < 2; ++a)
#pragma unroll
            for (int b = 0; b < 2; ++b)
#pragma unroll
                for (int m = 0; m < 4; ++m)
#pragma unroll
                    for (int n = 0; n < 2; ++n) acc[a][b][m][n] = (f32x4){0.f, 0.f, 0.f, 0.f};
        cur = nxt; cB = nB; ++ui;
#pragma unroll
        for (int _h = 0; _h < 2; ++_h)
#pragma unroll
            for (int _i = 0; _i < 2; ++_i) cvo[_h][_i] = nvo[_h][_i];
        if (wr == 1) PG8_BAR;
    }
    PG8_WAIT_V(0);
    PG8_BAR;
#undef PG8_SA
#undef PG8_SB
#undef PG8_STAGE
#undef PG8_LDA
#undef PG8_LDB
#undef PG8_MMA
#undef PG8_WAIT_V
#undef PG8_WAIT_L
#undef PG8_BAR
#undef PG8_SCHED
#undef PG8_AOFF
}
}
template <class E4> DI void fast_gemm(const Ctx& C, const bf16* A, int lda, const bf16* Bt, int K, int nM, int nN, const E4& e, bool rev = false) {
    pg8::Gemm g{A, Bt, lda, K, nullptr}; pg8::OrderMN S{nM, nN, C.nb, rev ? C.nb - 1 - C.vcu : C.vcu}; pg8::EpiAdapt<E4> E{e};
    pg8::gemm_phase(C.lds, g, S, E, C.tid);
}

DI float max16_acc(float m, const f32x16& x) {
    asm volatile("s_nop 15\n\tv_max3_f32 %0, %0, %1, %2\n\tv_max3_f32 %0, %0, %3, %4\n\tv_max3_f32 %0, %0, %5, %6\n\tv_max3_f32 %0, %0, %7, %8\n\tv_max3_f32 %0, %0, %9, %10\n\tv_max3_f32 %0, %0, %11, %12\n\tv_max3_f32 %0, %0, %13, %14\n\tv_max3_f32 %0, %0, %15, %16"
                 : "+v"(m) : "v"(x[0]), "v"(x[1]), "v"(x[2]), "v"(x[3]), "v"(x[4]), "v"(x[5]), "v"(x[6]), "v"(x[7]), "v"(x[8]), "v"(x[9]), "v"(x[10]), "v"(x[11]), "v"(x[12]), "v"(x[13]), "v"(x[14]), "v"(x[15]));
    return m; }
DI int swap23(int x) { return (x & ~12) | ((x & 4) << 1) | ((x & 8) >> 1); }
template <int DQK, bool NAT>
DI void flash_range(f32x16 (&o)[2], float& m, float& l, const bf16x8 (&qf)[DQK / 16], const bf16* __restrict__ Kb, const bf16* __restrict__ Vt, int pos0, int nblk, int r, int h,
                    const LAS float* tab, int qc, int cs, int drow0) {
    const int kr = swap23(r);
    for (int blk = 0; blk < nblk; ++blk) {
        const int pos = pos0 + 32 * blk;
        f32x16 s;
#pragma unroll
        for (int i = 0; i < 16; ++i) s[i] = 0.f;
        const bf16* kp = Kb + (size_t)(pos + kr) * DQK + 8 * h;
#pragma unroll
        for (int kk = 0; kk < DQK / 16; ++kk) s = MFMA32(*(const bf16x8*)(kp + 16 * kk), qf[kk], s);
        if (NAT) {
            const int irow = blk >> 1, cc0 = (blk & 1) * 32;
            const LAS float* trow = tab + (drow0 + irow) * 31;
#pragma unroll
            for (int i = 0; i < 16; ++i) {
                const int kib = (i & 3) | (((i >> 2) & 1) << 2) | (h << 3) | ((i >> 3) << 4);
                const int cc = cc0 + kib; const bool ok = (cc >= cs) && (cc < cs + 16);
                int dc = cc - qc + 15; dc = dc < 0 ? 0 : (dc > 30 ? 30 : dc);
                s[i] = ok ? s[i] + trow[dc] : -1e30f;
            }
        }
        float mx = s[0];
#pragma unroll
        for (int i = 1; i < 16; ++i) mx = fmaxf(mx, s[i]);
        mx = fmaxf(mx, xor32(mx, r + 32 * h));
        const float mn = fmaxf(m, mx), alpha = __builtin_amdgcn_exp2f(m - mn);
        float rs = 0.f; f32x16 p;
#pragma unroll
        for (int i = 0; i < 16; ++i) { float e = __builtin_amdgcn_exp2f(s[i] - mn); if (NAT) e = (s[i] > -1e29f) ? e : 0.f; p[i] = e; rs += e; }
        rs += xor32(rs, r + 32 * h);
        l = l * alpha + rs; m = mn;
#pragma unroll
        for (int i = 0; i < 16; ++i) { o[0][i] *= alpha; o[1][i] *= alpha; }
#pragma unroll
        for (int s2 = 0; s2 < 2; ++s2) {
            u32x4 pw; pw.x = pk2(p[8 * s2], p[8 * s2 + 1]); pw.y = pk2(p[8 * s2 + 2], p[8 * s2 + 3]); pw.z = pk2(p[8 * s2 + 4], p[8 * s2 + 5]); pw.w = pk2(p[8 * s2 + 6], p[8 * s2 + 7]);
            const bf16x8 pb = __builtin_bit_cast(bf16x8, pw);
#pragma unroll
            for (int dt = 0; dt < 2; ++dt) { const bf16x8 va = *(const bf16x8*)(Vt + (size_t)(32 * dt + r) * KPOS + pos + 16 * s2 + 8 * h); o[dt] = MFMA32(va, pb, o[dt]); }
        }
    }
}
DI void flash_store(const f32x16 (&o)[2], float l, bf16* orow  , int h) {
    const float inv = 1.f / l;
#pragma unroll
    for (int dt = 0; dt < 2; ++dt)
#pragma unroll
        for (int g = 0; g < 4; ++g)
            *(u32x2*)(orow + 32 * dt + 8 * g + 4 * h) = (u32x2){pk2(o[dt][4 * g] * inv, o[dt][4 * g + 1] * inv), pk2(o[dt][4 * g + 2] * inv, o[dt][4 * g + 3] * inv)};
}

DI void ph_attn_mla(const Ctx& C, const bf16* QB, const bf16* KB, const bf16* VT, bf16* OCAT, bool last) {
    const int r = C.lane & 31, h = C.lane >> 5;
    for (int u = C.vcu; u < 64 * 17; u += C.nb) {
        const int bh = u / 17, qblk = u % 17, b = bh >> 3, hh = bh & 7;
        if (last && qblk == 16) continue;
        const int qpos = qblk * 256 + 32 * C.wave + r;
        const bf16* qp = QB + ((size_t)bh * KPOS + qpos) * 96 + 8 * h;
        bf16x8 qf[6];
#pragma unroll
        for (int kk = 0; kk < 6; ++kk) qf[kk] = *(const bf16x8*)(qp + 16 * kk);
        f32x16 o[2];
#pragma unroll
        for (int i = 0; i < 16; ++i) { o[0][i] = 0.f; o[1][i] = 0.f; }
        float m = -1e30f, l = 0.f;
        flash_range<96, false>(o, m, l, qf, KB + (size_t)bh * KPOS * 96, VT + (size_t)bh * 64 * KPOS, qblk < 16 ? 0 : TL, qblk < 16 ? KPOS / 32 : LCX / 32, r, h, nullptr, 0, 0, 0);
        const int row = qblk < 16 ? b * TL + qpos : NLAT + b * LCX + (qpos - TL);
        flash_store(o, l, OCAT + (size_t)row * DM + hh * 64, h);
    }
}

template <int DQK> struct AttnGeo { static constexpr int KSTR = DQK * 2 + 16, KBYTES = 64 * KSTR, VSTR = 144, VBYTES = 64 * VSTR, BUF = KBYTES + VBYTES, KPIECES = 64 * DQK / 8; };
template <int DQK, bool NAT>
DI void attn_tile_loop(const Ctx& C, f32x16 (&o)[2], float& l, const bf16x8 (&qf)[DQK / 16], const bf16* __restrict__ Kb, const bf16* __restrict__ Vt, int pos1, int n1, int pos2, int n2,
                       const LAS float* tab, int grow, int rs, int qc, int cs) {
    typedef AttnGeo<DQK> G;
    const int tid = C.tid, r = C.lane & 31, h = C.lane >> 5, kr = swap23(r), ntiles = n1 + n2;
    constexpr bool K2 = G::KPIECES > 512;
    const int kq0 = tid, kq1 = tid + 512;
    const int kl0 = (kq0 / (DQK / 8)) * G::KSTR + (kq0 % (DQK / 8)) * 16, kl1 = (kq1 / (DQK / 8)) * G::KSTR + (kq1 % (DQK / 8)) * 16;
    const int vl = G::KBYTES + (tid >> 3) * G::VSTR + (tid & 7) * 16;
    const bf16* vg = Vt + (size_t)(tid >> 3) * KPOS + 8 * (tid & 7);
    u32x4 rk0, rk1, rv;
    rk1 = (u32x4){0u, 0u, 0u, 0u};
#define ATT_POS(t) ((t) < n1 ? pos1 + 64 * (t) : pos2 + 64 * ((t) - n1))
    { const int pos0 = ATT_POS(0); rk0 = *(const u32x4*)(Kb + (size_t)pos0 * DQK + 8 * kq0); if (K2 && tid < 256) rk1 = *(const u32x4*)(Kb + (size_t)pos0 * DQK + 8 * kq1); rv = *(const u32x4*)(vg + pos0); }
    __syncthreads();
    *(LAS u32x4*)(C.lds + kl0) = rk0; if (K2 && tid < 256) *(LAS u32x4*)(C.lds + kl1) = rk1; *(LAS u32x4*)(C.lds + vl) = rv;
    __syncthreads();
    float mref = 0.f; bool first = true;
    constexpr float THR = 8.f;
    for (int t = 0; t < ntiles; ++t) {
        const LAS unsigned char* B = C.lds + (t & 1) * G::BUF;
        if (t + 1 < ntiles) { const int pos0 = ATT_POS(t + 1);
            rk0 = *(const u32x4*)(Kb + (size_t)pos0 * DQK + 8 * kq0); if (K2 && tid < 256) rk1 = *(const u32x4*)(Kb + (size_t)pos0 * DQK + 8 * kq1); rv = *(const u32x4*)(vg + pos0); }
        const int gr = (pos1 >> 6) + t;
        const bool active = !NAT || t >= n1 || (gr >= rs && gr < rs + 8);
        if (active) {
            f32x16 sc[2];
#pragma unroll
            for (int j = 0; j < 2; ++j) {
#pragma unroll
                for (int i = 0; i < 16; ++i) sc[j][i] = -mref;
                const LAS unsigned char* kp = B + (32 * j + kr) * G::KSTR + 16 * h;
#pragma unroll
                for (int kk = 0; kk < DQK / 16; ++kk) sc[j] = MFMA32(*(const LAS bf16x8*)(kp + 32 * kk), qf[kk], sc[j]);
            }
            if (NAT && t < n1) {
                const LAS float* trow = tab + (gr - grow + 7) * 31;
#pragma unroll
                for (int j = 0; j < 2; ++j)
#pragma unroll
                    for (int i = 0; i < 16; ++i) {
                        const int cc = 32 * j + ((i & 3) | (((i >> 2) & 1) << 2) | (h << 3) | ((i >> 3) << 4)); const bool ok = (cc >= cs) && (cc < cs + 16);
                        int dc = cc - qc + 15; dc = dc < 0 ? 0 : (dc > 30 ? 30 : dc);
                        sc[j][i] = ok ? sc[j][i] + trow[dc] : -1e30f;
                    }
            }
            float mx = max16_acc(max16_acc(-3.0e38f, sc[0]), sc[1]);
            if (first || __builtin_amdgcn_ballot_w64(mx > THR) != 0ull) {
                mx = fmaxf(mx, xor32(mx, C.lane));
                const float delta = first ? mx : fmaxf(mx, 0.f);
#pragma unroll
                for (int i = 0; i < 16; ++i) { sc[0][i] -= delta; sc[1][i] -= delta; }
                if (!first) { const float alpha = __builtin_amdgcn_exp2f(-delta); l *= alpha;
#pragma unroll
                    for (int i = 0; i < 16; ++i) { o[0][i] *= alpha; o[1][i] *= alpha; } }
                mref += delta; first = false;
            }
            f32x2 rs2 = {0.f, 0.f};
#pragma unroll
            for (int j = 0; j < 2; ++j)
#pragma unroll
                for (int i = 0; i < 16; i += 2) { sc[j][i] = __builtin_amdgcn_exp2f(sc[j][i]); sc[j][i + 1] = __builtin_amdgcn_exp2f(sc[j][i + 1]); rs2 += (f32x2){sc[j][i], sc[j][i + 1]}; }
            l += rs2.x + rs2.y;
#pragma unroll
            for (int j = 0; j < 2; ++j)
#pragma unroll
                for (int s2 = 0; s2 < 2; ++s2) {
                    u32x4 pw; pw.x = pk2(sc[j][8 * s2], sc[j][8 * s2 + 1]); pw.y = pk2(sc[j][8 * s2 + 2], sc[j][8 * s2 + 3]); pw.z = pk2(sc[j][8 * s2 + 4], sc[j][8 * s2 + 5]); pw.w = pk2(sc[j][8 * s2 + 6], sc[j][8 * s2 + 7]);
                    const bf16x8 pb = __builtin_bit_cast(bf16x8, pw);
#pragma unroll
                    for (int dt = 0; dt < 2; ++dt) o[dt] = MFMA32(*(const LAS bf16x8*)(B + G::KBYTES + (32 * dt + r) * G::VSTR + (32 * j + 16 * s2 + 8 * h) * 2), pb, o[dt]);
                }
        }
        if (t + 1 < ntiles) { LAS unsigned char* Bn = C.lds + ((t + 1) & 1) * G::BUF;
            *(LAS u32x4*)(Bn + kl0) = rk0; if (K2 && tid < 256) *(LAS u32x4*)(Bn + kl1) = rk1; *(LAS u32x4*)(Bn + vl) = rv; }
        __syncthreads();
    }
    l += xor32(l, C.lane);
#undef ATT_POS
}
DI void ph_attn_mla2(const Ctx& C, const bf16* QB, const bf16* KB, const bf16* VT, bf16* OCAT, bool last) {
    const int r = C.lane & 31, h = C.lane >> 5;
    const int nunits = 1024 + (last ? 0 : 64);
    for (int u = C.vcu; u < nunits; u += C.nb) {
        const int bh = u < 1024 ? (u >> 4) : u - 1024, qblk = u < 1024 ? (u & 15) : 16, b = bh >> 3, hh = bh & 7;
        const int qpos = qblk * 256 + 32 * C.wave + r;
        const bf16* qp = QB + ((size_t)bh * KPOS + qpos) * 96 + 8 * h;
        bf16x8 qf[6];
#pragma unroll
        for (int kk = 0; kk < 6; ++kk) qf[kk] = *(const bf16x8*)(qp + 16 * kk);
        f32x16 o[2];
#pragma unroll
        for (int i = 0; i < 16; ++i) { o[0][i] = 0.f; o[1][i] = 0.f; }
        float l = 0.f;
        attn_tile_loop<96, false>(C, o, l, qf, KB + (size_t)bh * KPOS * 96, VT + (size_t)bh * 64 * KPOS, qblk < 16 ? 0 : TL, qblk < 16 ? KPOS / 64 : LCX / 64, 0, 0, nullptr, 0, 0, 0, 0);
        const int row = qblk < 16 ? b * TL + qpos : NLAT + b * LCX + (qpos - TL);
        flash_store(o, l, OCAT + (size_t)row * DM + hh * 64, h);
    }
}

DI void ph_natten2(const Ctx& C, const bf16* QN, const bf16* KN, const bf16* VTN, bf16* OCAT, const float* rpb  , bool last, unsigned* work_ctr) {
    const int r = C.lane & 31, h = C.lane >> 5;
    LAS float* tab = (LAS float*)(C.lds + 2 * AttnGeo<64>::BUF);
    LAS int* uslot = (LAS int*)(tab + 480);
    const int nunits = 1024 + (last ? 0 : 64);
    for (;;) {
        __syncthreads();
        if (C.tid == 0) *uslot = (int)__hip_atomic_fetch_add(work_ctr, 1u, __ATOMIC_RELAXED, __HIP_MEMORY_SCOPE_AGENT);
        __syncthreads();
        const int u = *uslot;
        if (u >= nunits) break;
        const bool isctx = u >= 1024;
        const int bh = isctx ? u - 1024 : (u >> 4), b = bh >> 3, hh = bh & 7;
        for (int i = C.tid; i < 465; i += 512) tab[i] = rpb[hh * 465 + i] * LOG2E;
        int qpos, row, grow = 0, qc = 0, rs = 0, cs = 0, rlo = 0, nband = 0;
        if (!isctx) { const int rg = u & 15; grow = 4 * rg + (C.wave >> 1); qc = 32 * (C.wave & 1) + r; qpos = grow * 64 + qc; row = b * TL + qpos;
            rs = grow - 4; rs = rs < 0 ? 0 : (rs > 56 ? 56 : rs); cs = qc - 8; cs = cs < 0 ? 0 : (cs > 48 ? 48 : cs);
            rlo = 4 * rg - 4; rlo = rlo < 0 ? 0 : (rlo > 56 ? 56 : rlo); int rhi = 4 * rg + 3 - 4; rhi = rhi < 0 ? 0 : (rhi > 56 ? 56 : rhi); nband = rhi + 8 - rlo; }
        else { qpos = TL + 32 * C.wave + r; row = NLAT + b * LCX + 32 * C.wave + r; }
        const bf16* qp = QN + ((size_t)bh * KPOS + qpos) * 64 + 8 * h;
        bf16x8 qf[4];
#pragma unroll
        for (int kk = 0; kk < 4; ++kk) qf[kk] = *(const bf16x8*)(qp + 16 * kk);
        f32x16 o[2];
#pragma unroll
        for (int i = 0; i < 16; ++i) { o[0][i] = 0.f; o[1][i] = 0.f; }
        float l = 0.f;
        attn_tile_loop<64, true>(C, o, l, qf, KN + (size_t)bh * KPOS * 64, VTN + (size_t)bh * 64 * KPOS, rlo * 64, nband, TL, LCX / 64, tab, grow, rs, qc, cs);
        flash_store(o, l, OCAT + (size_t)row * DM + 512 + hh * 64, h);
    }
}

DI void ph_natten(const Ctx& C, const bf16* QN, const bf16* KN, const bf16* VTN, bf16* OCAT, const float* rpb  , bool last) {
    const int r = C.lane & 31, h = C.lane >> 5;
    LAS float* tab = (LAS float*)C.lds;
    const int nunits = 1024 + (last ? 0 : 64);
    for (int u = C.vcu; u < nunits; u += C.nb) {
        const bool isctx = u >= 1024;
        const int bh = isctx ? u - 1024 : (u >> 4), b = bh >> 3, hh = bh & 7;
        __syncthreads();
        for (int i = C.tid; i < 465; i += 512) tab[i] = rpb[hh * 465 + i] * LOG2E;
        __syncthreads();
        int qpos, row, grow = 0, qc = 0, rs = 0, cs = 0;
        if (!isctx) { const int rg = u & 15; grow = 4 * rg + (C.wave >> 1); qc = 32 * (C.wave & 1) + r; qpos = grow * 64 + qc; row = b * TL + qpos;
            rs = grow - 4; rs = rs < 0 ? 0 : (rs > 56 ? 56 : rs); cs = qc - 8; cs = cs < 0 ? 0 : (cs > 48 ? 48 : cs); }
        else { qpos = TL + 32 * C.wave + r; row = NLAT + b * LCX + 32 * C.wave + r; }
        const bf16* qp = QN + ((size_t)bh * KPOS + qpos) * 64 + 8 * h;
        bf16x8 qf[4];
#pragma unroll
        for (int kk = 0; kk < 4; ++kk) qf[kk] = *(const bf16x8*)(qp + 16 * kk);
        f32x16 o[2];
#pragma unroll
        for (int i = 0; i < 16; ++i) { o[0][i] = 0.f; o[1][i] = 0.f; }
        float m = -1e30f, l = 0.f;
        const bf16* Kb = KN + (size_t)bh * KPOS * 64; const bf16* Vt = VTN + (size_t)bh * 64 * KPOS;
        if (!isctx) flash_range<64, true>(o, m, l, qf, Kb, Vt, rs * 64, 16, r, h, tab, qc, cs, rs - grow + 7);
        flash_range<64, false>(o, m, l, qf, Kb, Vt, TL, LCX / 32, r, h, nullptr, 0, 0, 0);
        flash_store(o, l, OCAT + (size_t)row * DM + 512 + hh * 64, h);
    }
}

DI void ph_mla_fin(const Ctx& C, const bf16* U, const bf16* QPRE, const bf16* KVPRE, const float* qg, const float* kg, const f32x2* CS, bf16* QB, bf16* KB, bf16* VT) {
    LAS bf16* VL = (LAS bf16*)C.lds;
    const int lane = C.lane, j = lane >> 3, sub = lane & 7;
    const float C2 = 0.10206207261596575f * LOG2E;
    float qgn[8], qgr[4], kgn[8], kgr[4];
#pragma unroll
    for (int e = 0; e < 8; ++e) { qgn[e] = qg[8 * sub + e] * C2; kgn[e] = kg[8 * sub + e]; }
#pragma unroll
    for (int m = 0; m < 4; ++m) { qgr[m] = qg[64 + sub + 8 * m] * C2; kgr[m] = kg[64 + sub + 8 * m]; }
    for (int u = C.vcu; u < MT / 64; u += C.nb) {
        const int row0 = 64 * u, b = row0 < NLAT ? (row0 >> 12) : ((row0 - NLAT) >> 8), pos0 = row0 < NLAT ? (row0 & 4095) : TL + ((row0 - NLAT) & 255);
        const bool lat = row0 < NLAT;
        const int pl = 8 * C.wave + j, row = row0 + pl, pos = pos0 + pl;
        const bf16* ur = U + (size_t)row * EV_INP;
        float sq = 0.f, skv = 0.f;
#pragma unroll
        for (int m = 0; m < 6; ++m) { float x[8]; unpack8(*(const u32x4*)(ur + 8 * (sub + 8 * m)), x);
#pragma unroll
            for (int e = 0; e < 8; ++e) sq += x[e] * x[e]; }
#pragma unroll
        for (int m = 0; m < 4; ++m) { float x[8]; unpack8(*(const u32x4*)(ur + 384 + 8 * (sub + 8 * m)), x);
#pragma unroll
            for (int e = 0; e < 8; ++e) skv += x[e] * x[e]; }
        sq = sum8(sq); skv = sum8(skv);
        const float rsq = 1.0f / sqrtf(sq * (1.f / 384.f) + EPS), rskv = 1.0f / sqrtf(skv * (1.f / 256.f) + EPS);
        float krv[4];
#pragma unroll
        for (int m = 0; m < 4; ++m) krv[m] = bf2f(ur[640 + sub + 8 * m]);
        float cr = 1.f, sr = 0.f, cc = 1.f, sc = 0.f;
        if (lat) { const f32x2 a0 = CS[pos * 16 + sub], a1 = CS[pos * 16 + 8 + sub]; cr = a0.x; sr = a0.y; cc = a1.x; sc = a1.y; }
        const bf16* qrow = QPRE + (size_t)row * 768; const bf16* kvrow = KVPRE + (size_t)row * 1024;
#pragma unroll 2
        for (int hh = 0; hh < 8; ++hh) {
            { float qn[8], qr[4]; unpack8(*(const u32x4*)(qrow + hh * 96 + 8 * sub), qn); float ss = 0.f;
#pragma unroll
              for (int e = 0; e < 8; ++e) qn[e] *= rsq;
#pragma unroll
              for (int m = 0; m < 4; ++m) { qr[m] = bf2f(qrow[hh * 96 + 64 + sub + 8 * m]) * rsq; ss += qr[m] * qr[m]; }
#pragma unroll
              for (int e = 0; e < 8; ++e) ss += qn[e] * qn[e];
              const float rn = 1.0f / sqrtf(sum8(ss) * (1.f / 96.f) + EPS);
#pragma unroll
              for (int e = 0; e < 8; ++e) qn[e] *= rn * qgn[e];
#pragma unroll
              for (int m = 0; m < 4; ++m) qr[m] *= rn * qgr[m];
              { const float x0 = qr[0], x1 = qr[1], y0 = qr[2], y1 = qr[3]; qr[0] = x0 * cr - x1 * sr; qr[1] = x1 * cr + x0 * sr; qr[2] = y0 * cc - y1 * sc; qr[3] = y1 * cc + y0 * sc; }
              bf16* qo = QB + ((size_t)(b * 8 + hh) * KPOS + pos) * 96;
              *(u32x4*)(qo + 8 * sub) = pack8(qn);
#pragma unroll
              for (int m = 0; m < 4; ++m) qo[64 + sub + 8 * m] = f2bf(qr[m]); }
            { float kn[8], kr[4]; unpack8(*(const u32x4*)(kvrow + hh * 128 + 8 * sub), kn); float ss = 0.f;
#pragma unroll
              for (int e = 0; e < 8; ++e) kn[e] *= rskv;
#pragma unroll
              for (int m = 0; m < 4; ++m) { kr[m] = krv[m]; ss += kr[m] * kr[m]; }
#pragma unroll
              for (int e = 0; e < 8; ++e) ss += kn[e] * kn[e];
              const float rn = 1.0f / sqrtf(sum8(ss) * (1.f / 96.f) + EPS);
#pragma unroll
              for (int e = 0; e < 8; ++e) kn[e] *= rn * kgn[e];
#pragma unroll
              for (int m = 0; m < 4; ++m) kr[m] *= rn * kgr[m];
              { const float x0 = kr[0], x1 = kr[1], y0 = kr[2], y1 = kr[3]; kr[0] = x0 * cr - x1 * sr; kr[1] = x1 * cr + x0 * sr; kr[2] = y0 * cc - y1 * sc; kr[3] = y1 * cc + y0 * sc; }
              bf16* ko = KB + ((size_t)(b * 8 + hh) * KPOS + pos) * 96;
              *(u32x4*)(ko + 8 * sub) = pack8(kn);
#pragma unroll
              for (int m = 0; m < 4; ++m) ko[64 + sub + 8 * m] = f2bf(kr[m]); }
            { float vv[8]; unpack8(*(const u32x4*)(kvrow + hh * 128 + 64 + 8 * sub), vv);
#pragma unroll
              for (int e = 0; e < 8; ++e) VL[(hh * 64 + 8 * sub + e) * 64 + pl] = f2bf(vv[e] * rskv); }
        }
        __syncthreads();
        { const int hd = C.tid;
            bf16* dst = VT + ((size_t)(b * 8 + (hd >> 6)) * 64 + (hd & 63)) * KPOS + pos0;
#pragma unroll
            for (int q = 0; q < 8; ++q) *(u32x4*)(dst + 8 * q) = *(const LAS u32x4*)(VL + hd * 64 + 8 * q); }
        __syncthreads();
    }
}

DI void ph_conv(const Ctx& C, const bf16* U, const float* dww  , const float* dwb, const float* lng, const float* lnb, bf16* OCAT) {
    LAS float* G = (LAS float*)C.lds;
    const int c = C.tid;
    float wk[31];
#pragma unroll
    for (int k = 0; k < 31; ++k) wk[k] = dww[k * 512 + c];
    const float bias = dwb[c];
    for (int u = C.nb - 1 - C.vcu; u < MT / 32; u += C.nb) {
        const int row0 = 32 * u; int base, t0, tseq;
        if (row0 < NLAT) { base = row0 & ~4095; t0 = row0 & 4095; tseq = TL; } else { const int rc = row0 - NLAT; base = NLAT + (rc & ~255); t0 = rc & 255; tseq = LCX; }
        __syncthreads();
        for (int rr = C.wave; rr < 62; rr += 8) { const int tt = t0 - 15 + rr; float g[8];
#pragma unroll
            for (int e = 0; e < 8; ++e) g[e] = 0.f;
            if (tt >= 0 && tt < tseq) { const bf16* ur = U + (size_t)(base + tt) * EV_INP; float av[8], gv[8]; unpack8(*(const u32x4*)(ur + 672 + 8 * C.lane), av); unpack8(*(const u32x4*)(ur + 1184 + 8 * C.lane), gv);
#pragma unroll
                for (int e = 0; e < 8; ++e) g[e] = av[e] * sigmoidf_(gv[e]); }
            *(LAS f32x4*)(G + rr * 512 + 8 * C.lane) = (f32x4){g[0], g[1], g[2], g[3]}; *(LAS f32x4*)(G + rr * 512 + 8 * C.lane + 4) = (f32x4){g[4], g[5], g[6], g[7]}; }
        __syncthreads();
        float acc[32];
#pragma unroll
        for (int t = 0; t < 32; ++t) acc[t] = bias;
#pragma unroll
        for (int rr = 0; rr < 62; ++rr) { const float gv = G[rr * 512 + c];
#pragma unroll
            for (int t = 0; t < 32; ++t) { const int k = rr - t; if (k >= 0 && k < 31) acc[t] += gv * wk[k]; } }
        __syncthreads();
#pragma unroll
        for (int t = 0; t < 32; ++t) G[t * 512 + c] = acc[t];
        __syncthreads();
#pragma unroll
        for (int q = 0; q < 4; ++q) {
            const int t = 4 * C.wave + q, row = row0 + t;
            const f32x4 a0 = *(const LAS f32x4*)(G + t * 512 + 8 * C.lane), a1 = *(const LAS f32x4*)(G + t * 512 + 8 * C.lane + 4);
            float x[8] = {a0.x, a0.y, a0.z, a0.w, a1.x, a1.y, a1.z, a1.w}; float s = 0.f;
#pragma unroll
            for (int e = 0; e < 8; ++e) s += x[e];
            const float mu = wave_sum(s) * (1.f / 512.f); float s2 = 0.f;
#pragma unroll
            for (int e = 0; e < 8; ++e) { x[e] -= mu; s2 += x[e] * x[e]; }
            const float rstd = 1.0f / sqrtf(wave_sum(s2) * (1.f / 512.f) + EPS);
            float y[8];
#pragma unroll
            for (int e = 0; e < 8; ++e) { const float z = x[e] * rstd * lng[8 * C.lane + e] + lnb[8 * C.lane + e]; y[e] = siluf_(z); }
            *(u32x4*)(OCAT + (size_t)row * DM + 512 + 8 * C.lane) = pack8(y);
        }
    }
}

DI void shifted8(const bf16* up, const bf16* uc, const bf16* un, bool hp, bool hn, const float (&s0)[8], const float (&s1)[8], const float (&s2)[8], int c0, float (&o)[8]) {
    const u32x4 z = {0u, 0u, 0u, 0u};
    const u32x4 vp = hp ? *(const u32x4*)(up + c0) : z, vc = *(const u32x4*)(uc + c0), vn = hn ? *(const u32x4*)(un + c0) : z;
    float p[8], c[8], n[8]; unpack8(vp, p); unpack8(vc, c); unpack8(vn, n);
#pragma unroll
    for (int e = 0; e < 8; ++e) o[e] = p[e] * s0[e] + c[e] * s1[e] + n[e] * s2[e];
}
DI void load_sw(const float* sw, int c0, float (&s0)[8], float (&s1)[8], float (&s2)[8]) {
#pragma unroll
    for (int e = 0; e < 8; ++e) { s0[e] = sw[c0 + e]; s1[e] = sw[RW_IN + c0 + e]; s2[e] = sw[2 * RW_IN + c0 + e]; }
}
DI void ph_prep(const Ctx& C, const bf16* U, const float* sw  , const float* kkw  , const float* naqg, const float* nakg,
                bf16* R, bf16* V, bf16* K, bf16* KK, bf16* L, bf16* QN, bf16* KN, bf16* VTN) {
    LAS bf16* VL = (LAS bf16*)C.lds;
    const int lane = C.lane, hh = lane >> 3, sub = lane & 7;
    const float C2 = 0.125f * LOG2E;
    for (int u = C.vcu; u < MT / 32; u += C.nb) {
        const int row0 = 32 * u; const bool lat = row0 < NLAT;
        const int b = lat ? (row0 >> 12) : ((row0 - NLAT) >> 8), pos0 = lat ? (row0 & 4095) : TL + ((row0 - NLAT) & 255), tseq = lat ? TL : LCX, tb = lat ? (row0 & 4095) : ((row0 - NLAT) & 255);
#define PREP_ROWVARS(i) const int pl = 4 * C.wave + (i), row = row0 + pl, t = tb + pl; const bool hp = t > 0, hn = t < tseq - 1; \
            const bf16* uc = U + (size_t)row * OD_INP; const bf16* up = uc - OD_INP; const bf16* un = uc + OD_INP
        { float s0[8], s1[8], s2[8]; load_sw(sw, 8 * lane, s0, s1, s2);
          for (int i = 0; i < 4; ++i) { PREP_ROWVARS(i); float o[8]; shifted8(up, uc, un, hp, hn, s0, s1, s2, 8 * lane, o); *(u32x4*)(R + (size_t)row * 512 + 8 * lane) = pack8(o); } }
        { float s0[8], s1[8], s2[8]; load_sw(sw, 1024 + 8 * lane, s0, s1, s2);
          for (int i = 0; i < 4; ++i) { PREP_ROWVARS(i); float o[8]; shifted8(up, uc, un, hp, hn, s0, s1, s2, 1024 + 8 * lane, o); *(u32x4*)(V + (size_t)row * 512 + 8 * lane) = pack8(o); } }
        { float s0[8], s1[8], s2[8]; load_sw(sw, 512 + 8 * lane, s0, s1, s2); float kw[8];
#pragma unroll
          for (int e = 0; e < 8; ++e) kw[e] = kkw[8 * lane + e];
          for (int i = 0; i < 4; ++i) { PREP_ROWVARS(i); float o[8]; shifted8(up, uc, un, hp, hn, s0, s1, s2, 512 + 8 * lane, o); *(u32x4*)(K + (size_t)row * 512 + 8 * lane) = pack8(o);
              float kk[8]; float ss = 0.f;
#pragma unroll
              for (int e = 0; e < 8; ++e) { kk[e] = o[e] * kw[e]; ss += kk[e] * kk[e]; }
              ss = sum8(ss); const float rn = 1.0f / sqrtf(ss + 1e-12f);
#pragma unroll
              for (int e = 0; e < 8; ++e) kk[e] *= rn;
              *(u32x4*)(KK + (size_t)row * 512 + 8 * lane) = pack8(kk); } }
        if (lane < 48) { float s0[8], s1[8], s2[8]; load_sw(sw, 1536 + 8 * lane, s0, s1, s2);
          for (int i = 0; i < 4; ++i) { PREP_ROWVARS(i); float o[8]; shifted8(up, uc, un, hp, hn, s0, s1, s2, 1536 + 8 * lane, o);
              if (lane < 16) {
#pragma unroll
                  for (int e = 0; e < 8; ++e) { const float ex = __expf(2.f * o[e]); o[e] = 1.f - 2.f * __builtin_amdgcn_rcpf(ex + 1.f); }
              } else if (lane >= 32) {
#pragma unroll
                  for (int e = 0; e < 8; ++e) o[e] = sigmoidf_(o[e]);
              }
              *(u32x4*)(L + (size_t)row * 384 + 8 * lane) = pack8(o); } }
        { float gq[8], gk[8];
#pragma unroll
          for (int e = 0; e < 8; ++e) { gq[e] = naqg[8 * sub + e] * C2; gk[e] = nakg[8 * sub + e]; }
          for (int i = 0; i < 4; ++i) { const int pl = 4 * C.wave + i, row = row0 + pl, pos = pos0 + pl; const bf16* uc = U + (size_t)row * OD_INP;
            { float x[8]; unpack8(*(const u32x4*)(uc + RW_IN + 8 * lane), x); float ss = 0.f;
#pragma unroll
                for (int e = 0; e < 8; ++e) ss += x[e] * x[e];
                ss = sum8(ss); const float rn = 1.0f / sqrtf(ss * (1.f / 64.f) + EPS);
#pragma unroll
                for (int e = 0; e < 8; ++e) x[e] = x[e] * rn * gq[e];
                *(u32x4*)(QN + ((size_t)(b * 8 + hh) * KPOS + pos) * 64 + 8 * sub) = pack8(x); }
            { float x[8]; unpack8(*(const u32x4*)(uc + RW_IN + 512 + 8 * lane), x); float ss = 0.f;
#pragma unroll
                for (int e = 0; e < 8; ++e) ss += x[e] * x[e];
                ss = sum8(ss); const float rn = 1.0f / sqrtf(ss * (1.f / 64.f) + EPS);
#pragma unroll
                for (int e = 0; e < 8; ++e) x[e] = x[e] * rn * gk[e];
                *(u32x4*)(KN + ((size_t)(b * 8 + hh) * KPOS + pos) * 64 + 8 * sub) = pack8(x); }
            { const u32x4 vv = *(const u32x4*)(uc + RW_IN + 1024 + 8 * lane); const unsigned w4[4] = {vv.x, vv.y, vv.z, vv.w};
#pragma unroll
                for (int e = 0; e < 8; ++e) { const int dv = 8 * sub + e; VL[(hh * 64 + dv) * 32 + pl] = (bf16)((e & 1) ? (w4[e >> 1] >> 16) : (w4[e >> 1] & 0xffffu)); } } } }
#undef PREP_ROWVARS
        __syncthreads();
        { const int hd = C.tid; bf16* dst = VTN + ((size_t)(b * 8 + (hd >> 6)) * 64 + (hd & 63)) * KPOS + pos0;
#pragma unroll
            for (int q = 0; q < 4; ++q) *(u32x4*)(dst + 8 * q) = *(const LAS u32x4*)(VL + hd * 32 + 8 * q); }
        __syncthreads();
    }
}

DI int scan_row(int s, int d, int b) { if (s < LCX) return NLAT + b * LCX + (d ? (LCX - 1 - s) : s); const int t = s - LCX; return b * TL + (d ? (TL - 1 - t) : t); }
DI void ph_scan(const Ctx& C, const bf16* R, const bf16* V, const bf16* KK, const float* W, const bf16* KEFF, const bf16* BSC, float* YS) {
    constexpr int CH = 32, BUF = 5 * CH * 64 + CH * 32;
    LAS float* lds = (LAS float*)C.lds;
    LAS float* ystage = lds + 2 * BUF;
    const int tid = C.tid, i = tid >> 4, kq = tid & 15;
    for (int cid = C.bid; cid < 256; cid += C.nb) {
        const int b = cid >> 5, hh = (cid >> 2) & 7, d = (cid >> 1) & 1, hf = cid & 1;
        const float* Wd = W + (size_t)d * MT * 512; const bf16* KEd = KEFF + (size_t)d * MT * 512; const bf16* BSd = BSC + (size_t)d * MT * 512; float* Yd = YS + (size_t)d * MT * 512;
        float S[4] = {0.f, 0.f, 0.f, 0.f};
        const int sl = tid >> 4, sub = tid & 15;
        f32x4 lw; u32x4 l1, l2, l3;
        auto issue = [&](int ck) {
            const int row = scan_row(ck * CH + sl, d, b);
            lw = *(const f32x4*)(Wd + (size_t)row * 512 + hh * 64 + 4 * sub);
            if (sub < 8) { l1 = *(const u32x4*)(R + (size_t)row * 512 + hh * 64 + 8 * sub); l2 = *(const u32x4*)(KEd + (size_t)row * 512 + hh * 64 + 8 * sub); }
            else { l1 = *(const u32x4*)(KK + (size_t)row * 512 + hh * 64 + 8 * (sub - 8)); l2 = *(const u32x4*)(BSd + (size_t)row * 512 + hh * 64 + 8 * (sub - 8)); }
            if (sub < 4) l3 = *(const u32x4*)(V + (size_t)row * 512 + hh * 64 + 32 * hf + 8 * sub);
        };
        auto commit = [&](int bufi) {
            LAS float* B = lds + bufi * BUF;
            *(LAS f32x4*)(B + (1 * CH + sl) * 64 + 4 * sub) = lw;
            float f1[8], f2[8]; unpack8(l1, f1); unpack8(l2, f2);
            const int a1 = sub < 8 ? 0 : 3, a2 = sub < 8 ? 2 : 4, off = 8 * (sub & 7);
            *(LAS f32x4*)(B + (a1 * CH + sl) * 64 + off) = (f32x4){f1[0], f1[1], f1[2], f1[3]}; *(LAS f32x4*)(B + (a1 * CH + sl) * 64 + off + 4) = (f32x4){f1[4], f1[5], f1[6], f1[7]};
            *(LAS f32x4*)(B + (a2 * CH + sl) * 64 + off) = (f32x4){f2[0], f2[1], f2[2], f2[3]}; *(LAS f32x4*)(B + (a2 * CH + sl) * 64 + off + 4) = (f32x4){f2[4], f2[5], f2[6], f2[7]};
            if (sub < 4) { float f3[8]; unpack8(l3, f3); LAS float* vp = B + 5 * CH * 64 + sl * 32 + 8 * sub;
                *(LAS f32x4*)vp = (f32x4){f3[0], f3[1], f3[2], f3[3]}; *(LAS f32x4*)(vp + 4) = (f32x4){f3[4], f3[5], f3[6], f3[7]}; }
        };
        __syncthreads();
        issue(0); commit(0);
        __syncthreads();
        constexpr int NCK = KPOS / CH;
        for (int ck = 0; ck < NCK; ++ck) {
            if (ck + 1 < NCK) issue(ck + 1);
            const LAS float* B = lds + (ck & 1) * BUF; LAS float* ys = ystage + (ck & 1) * CH * 32;
#pragma unroll 4
            for (int s = 0; s < CH; ++s) {
                const f32x4 rr = *(const LAS f32x4*)(B + (0 * CH + s) * 64 + 4 * kq), ww = *(const LAS f32x4*)(B + (1 * CH + s) * 64 + 4 * kq), ke = *(const LAS f32x4*)(B + (2 * CH + s) * 64 + 4 * kq),
                            kk = *(const LAS f32x4*)(B + (3 * CH + s) * 64 + 4 * kq), bs = *(const LAS f32x4*)(B + (4 * CH + s) * 64 + 4 * kq);
                const float v = B[5 * CH * 64 + s * 32 + i];
                float sa = -(S[0] * kk.x + S[1] * kk.y + S[2] * kk.z + S[3] * kk.w);
                sa = sum16(sa);
                S[0] = S[0] * ww.x + (sa * bs.x + v * ke.x); S[1] = S[1] * ww.y + (sa * bs.y + v * ke.y); S[2] = S[2] * ww.z + (sa * bs.z + v * ke.z); S[3] = S[3] * ww.w + (sa * bs.w + v * ke.w);
                float y = S[0] * rr.x + S[1] * rr.y + S[2] * rr.z + S[3] * rr.w;
                y = sum16(y);
                if (kq == 0) ys[s * 32 + i] = y;
            }
            if (ck + 1 < NCK) commit((ck + 1) & 1);
            __syncthreads();
            if (tid < 256) { const int s = tid >> 3, q = tid & 7; const int row = scan_row(ck * CH + s, d, b);
                *(f32x4*)(Yd + (size_t)row * 512 + hh * 64 + 32 * hf + 4 * q) = *(const LAS f32x4*)(ys + s * 32 + 4 * q); }
        }
    }
}


DI void ph_scan2(const Ctx& C, const bf16* R, const bf16* V, const bf16* K, const bf16* KK, const float* W, const bf16* AR_  , const float* ka, float* YS) {
    constexpr int CH = 16, BUF = 5 * CH * 64 + CH * 32, NCK = KPOS / CH, DEPTH = 4, YP = CH * 32 * 16;
    static_assert(NCK % DEPTH == 0, "chunk loop is unrolled by DEPTH");
    LAS float* lds = (LAS float*)C.lds;
    LAS float* ypart = lds + 2 * BUF;
    const bool comp = C.wave < 4;
    const int rp = 4 * (C.wave & 3) + (C.lane >> 4), kq = C.lane & 15, lt = C.tid - 256;
    for (int cid0 = C.bid; cid0 < 256; cid0 += C.nb) {
        const int hf = (cid0 >> 3) & 1, chain = (cid0 & 7) | ((cid0 >> 4) << 3), b = chain >> 4, hh = (chain >> 1) & 7, d = chain & 1;
        const float* Wd = W + (size_t)d * MT * 512; const bf16* Ad = AR_ + (size_t)d * MT * 512; float* Yd = YS + (size_t)d * MT * 512;
        u32x4 reg[DEPTH][4];
        float kav[8];
#pragma unroll
        for (int e = 0; e < 8; ++e) kav[e] = ka[hh * 64 + 8 * (lt & 7) + e];
        auto issue = [&](int ck, u32x4 (&rg)[4]) {
            { const size_t base = (size_t)scan_row(ck * CH + (lt >> 4), d, b) * 512 + hh * 64; rg[0] = *(const u32x4*)(Wd + base + 4 * (lt & 15)); }
            rg[1] = (u32x4){0u, 0u, 0u, 0u};
            if (lt < 128) { const size_t base = (size_t)scan_row(ck * CH + (lt >> 3), d, b) * 512 + hh * 64; rg[1] = *(const u32x4*)(R + base + 8 * (lt & 7)); }
            else if (lt < 192) { const int x = lt - 128; const size_t base = (size_t)scan_row(ck * CH + (x >> 2), d, b) * 512 + hh * 64; rg[1] = *(const u32x4*)(V + base + 32 * hf + 8 * (x & 3)); }
            { const size_t base = (size_t)scan_row(ck * CH + ((lt & 127) >> 3), d, b) * 512 + hh * 64 + 8 * (lt & 7); rg[2] = *(const u32x4*)((lt < 128 ? K : KK) + base); rg[3] = *(const u32x4*)(Ad + base); }
        };
        auto commit = [&](int bufi, const u32x4 (&rg)[4]) {
            LAS float* B = lds + bufi * BUF;
            *(LAS u32x4*)(B + (1 * CH + (lt >> 4)) * 64 + 4 * (lt & 15)) = rg[0];
            if (lt < 192) { float f[8]; unpack8(rg[1], f); LAS float* dst = lt < 128 ? B + (0 * CH + (lt >> 3)) * 64 + 8 * (lt & 7) : B + 5 * CH * 64 + ((lt - 128) >> 2) * 32 + 8 * ((lt - 128) & 3);
                *(LAS f32x4*)dst = (f32x4){f[0], f[1], f[2], f[3]}; *(LAS f32x4*)(dst + 4) = (f32x4){f[4], f[5], f[6], f[7]}; }
            { float x[8], av[8]; unpack8(rg[2], x); unpack8(rg[3], av); const int sl = (lt & 127) >> 3, pc = lt & 7;
                if (lt < 128) {
#pragma unroll
                    for (int e = 0; e < 8; ++e) x[e] = x[e] * (1.f + (av[e] - 1.f) * kav[e]);
                    LAS float* dst = B + (2 * CH + sl) * 64 + 8 * pc; *(LAS f32x4*)dst = (f32x4){x[0], x[1], x[2], x[3]}; *(LAS f32x4*)(dst + 4) = (f32x4){x[4], x[5], x[6], x[7]};
                } else {
                    LAS float* dk = B + (3 * CH + sl) * 64 + 8 * pc; *(LAS f32x4*)dk = (f32x4){x[0], x[1], x[2], x[3]}; *(LAS f32x4*)(dk + 4) = (f32x4){x[4], x[5], x[6], x[7]};
#pragma unroll
                    for (int e = 0; e < 8; ++e) x[e] *= av[e];
                    LAS float* db = B + (4 * CH + sl) * 64 + 8 * pc; *(LAS f32x4*)db = (f32x4){x[0], x[1], x[2], x[3]}; *(LAS f32x4*)(db + 4) = (f32x4){x[4], x[5], x[6], x[7]};
                } }
        };
        auto y_reduce = [&](int ck) {
            const LAS float* yp = ypart + (ck & 1) * YP + lt * 32;
            float y[2];
#pragma unroll
            for (int j = 0; j < 2; ++j) { const f32x4 a0 = *(const LAS f32x4*)(yp + 16 * j), a1 = *(const LAS f32x4*)(yp + 16 * j + 4), a2 = *(const LAS f32x4*)(yp + 16 * j + 8), a3 = *(const LAS f32x4*)(yp + 16 * j + 12);
                y[j] = (((a0.x + a0.y) + (a0.z + a0.w)) + ((a1.x + a1.y) + (a1.z + a1.w))) + (((a2.x + a2.y) + (a2.z + a2.w)) + ((a3.x + a3.y) + (a3.z + a3.w))); }
            const int row = scan_row(ck * CH + (lt >> 4), d, b);
            *(f32x2*)(Yd + (size_t)row * 512 + hh * 64 + 32 * hf + 2 * (lt & 15)) = (f32x2){y[0], y[1]};
        };
        f32x2 S[2][2];
#pragma unroll
        for (int j = 0; j < 2; ++j) { S[j][0] = (f32x2){0.f, 0.f}; S[j][1] = (f32x2){0.f, 0.f}; }
        __syncthreads();
        if (!comp) { issue(0, reg[0]); commit(0, reg[0]);
#pragma unroll
            for (int k = 1; k < DEPTH; ++k) issue(k, reg[k]); }
        __syncthreads();
        for (int ck0 = 0; ck0 < NCK; ck0 += DEPTH) {
#pragma unroll
            for (int kk = 0; kk < DEPTH; ++kk) {
                const int ck = ck0 + kk;
                if (comp) {
                    const LAS float* B = lds + (ck & 1) * BUF + 4 * kq; const LAS float* vb = lds + (ck & 1) * BUF + 5 * CH * 64 + 2 * rp; LAS float* yq = ypart + (ck & 1) * YP + (2 * rp) * 16 + kq;
                    f32x4 op[2][5]; f32x2 vv[2];
#define SCAN_LOAD(set, sI) do { const LAS float* bp_ = B + (sI) * 64; _Pragma("unroll") for (int a_ = 0; a_ < 5; ++a_) op[set][a_] = *(const LAS f32x4*)(bp_ + a_ * CH * 64); vv[set] = *(const LAS f32x2*)(vb + (sI) * 32); } while (0)
#define SCAN_ROW(set, sI, j, vj) do { f32x2 acc = S[j][0] * (f32x2){op[set][3].x, op[set][3].y}; acc = __builtin_elementwise_fma(S[j][1], (f32x2){op[set][3].z, op[set][3].w}, acc); \
                        const float sa = sum16(-(acc.x + acc.y)); const f32x2 sa2 = {sa, sa}, v2 = {vj, vj}; \
                        S[j][0] = __builtin_elementwise_fma(S[j][0], (f32x2){op[set][1].x, op[set][1].y}, __builtin_elementwise_fma(sa2, (f32x2){op[set][4].x, op[set][4].y}, v2 * (f32x2){op[set][2].x, op[set][2].y})); \
                        S[j][1] = __builtin_elementwise_fma(S[j][1], (f32x2){op[set][1].z, op[set][1].w}, __builtin_elementwise_fma(sa2, (f32x2){op[set][4].z, op[set][4].w}, v2 * (f32x2){op[set][2].z, op[set][2].w})); \
                        const f32x2 ya = __builtin_elementwise_fma(S[j][1], (f32x2){op[set][0].z, op[set][0].w}, S[j][0] * (f32x2){op[set][0].x, op[set][0].y}); \
                        yq[(sI) * 512 + (j) * 16] = ya.x + ya.y; } while (0)
#define SCAN_STEP(set, sI) do { SCAN_ROW(set, sI, 0, vv[set].x); SCAN_ROW(set, sI, 1, vv[set].y); } while (0)
                    SCAN_LOAD(0, 0);
#pragma unroll
                    for (int sI = 0; sI < CH; sI += 2) {
                        SCAN_LOAD(1, sI + 1);
                        SCAN_STEP(0, sI);
                        if (sI + 2 < CH) SCAN_LOAD(0, sI + 2);
                        SCAN_STEP(1, sI + 1);
                    }
#undef SCAN_LOAD
#undef SCAN_ROW
#undef SCAN_STEP
                } else {
                    if (ck + 1 < NCK) commit((ck + 1) & 1, reg[(kk + 1) % DEPTH]);
                    if (ck + DEPTH < NCK) issue(ck + DEPTH, reg[kk]);
                    if (ck > 0) y_reduce(ck - 1);
                }
                __syncthreads();
            }
        }
        if (!comp) y_reduce(NCK - 1);
    }
}


constexpr int CCH = 16, NCHK = KPOS / CCH, NPROB = NB * 8 * 2 * NCHK, IMG_ELEMS = 3 * 32 * 16;
template <int N> struct ICk { static constexpr int value = N; };
DI int crow_(int reg, int h) { return (reg & 3) + 8 * (reg >> 2) + 4 * h; }
DI bf16x8 pack_lo8(const f32x16& x) {
    u32x4 p; p.x = pk2(x[0], x[1]); p.y = pk2(x[2], x[3]); p.z = pk2(x[4], x[5]); p.w = pk2(x[6], x[7]); return __builtin_bit_cast(bf16x8, p); }
DI bf16x8 pack_hi8(const f32x16& x) { u32x4 p; p.x = pk2(x[8], x[9]); p.y = pk2(x[10], x[11]); p.z = pk2(x[12], x[13]); p.w = pk2(x[14], x[15]); return __builtin_bit_cast(bf16x8, p); }
DI int perm16(int k) { return (k & ~15) | swap23(k & 15); }

DI void ph_wkv_pre(const Ctx& C, const bf16* R, const bf16* K, const bf16* KK, const float* LW, const bf16* AR_, const float* ka, bf16* IMG) {
    LAS unsigned char* wl = C.lds + C.wave * 13312;
    LAS bf16* ARl = (LAS bf16*)wl; LAS bf16* BKl = (LAS bf16*)(wl + 4608); LAS float* Ll = (LAS float*)(wl + 9216); LAS bf16* OUT = (LAS bf16*)(wl + 10240);
    const int lane = C.lane, r = lane & 31, h = lane >> 5;
    const int gw = C.vcu * 8 + C.wave, ngw = C.nb * 8;
    for (int p = gw; p < NPROB; p += ngw) {
        const int j = p % NCHK, rest = p / NCHK, d = rest & 1, hh = (rest >> 1) & 7, b = rest >> 4;
        const float* Wd = LW + (size_t)d * MT * 512; const bf16* Ad = AR_ + (size_t)d * MT * 512;
        const float kav = ka[hh * 64 + lane];
        const int row0 = scan_row(j * CCH, d, b), sg = d ? -1 : 1;
        float lw[16]; bf16 rr[16], kx[16], kkx[16], ax[16];
#pragma unroll
        for (int t = 0; t < 16; ++t) { const size_t off = (size_t)(row0 + sg * t) * 512 + hh * 64 + lane; lw[t] = Wd[off]; rr[t] = R[off]; kx[t] = K[off]; kkx[t] = KK[off]; ax[t] = Ad[off]; }
        float cum = 0.f, e0 = 1.f;
#pragma unroll
        for (int t = 0; t < 16; ++t) {
            cum += lw[t]; const float e1 = __expf(cum), ei = __builtin_amdgcn_rcpf(e1);
            const float kkv = bf2f(kkx[t]), av = bf2f(ax[t]), keff = bf2f(kx[t]) * (1.f + (av - 1.f) * kav);
            ARl[t * 72 + lane] = f2bf(-kkv * e0); ARl[(16 + t) * 72 + lane] = f2bf(bf2f(rr[t]) * e1);
            BKl[t * 72 + lane] = f2bf(kkv * av * ei); BKl[(16 + t) * 72 + lane] = f2bf(keff * ei);
            e0 = e1;
        }
        asm volatile("s_waitcnt lgkmcnt(0)" ::: "memory");
        f32x16 g;
#pragma unroll
        for (int i = 0; i < 16; ++i) g[i] = 0.f;
#pragma unroll
        for (int q = 0; q < 4; ++q) g = MFMA32(*(const LAS bf16x8*)(ARl + r * 72 + 16 * q + 8 * h), *(const LAS bf16x8*)(BKl + r * 72 + 16 * q + 8 * h), g);
        const int sI = r & 15; const bool isk = r >= 16;
#pragma unroll
        for (int i = 0; i < 16; ++i) {
            const int row = crow_(i, h), t = row & 15; const bool keep = (i < 8) ? (sI < t) : (sI <= t); const float val = keep ? g[i] : 0.f;
            if (i < 8) { if (!isk) { Ll[t * 16 + sI] = val; OUT[512 + row * 16 + perm16(sI)] = 0; } else OUT[row * 16 + sI] = f2bf(val); }
            else       { if (!isk) OUT[512 + row * 16 + perm16(sI)] = f2bf(val); else OUT[row * 16 + sI] = f2bf(val); }
        }
        asm volatile("s_waitcnt lgkmcnt(0)" ::: "memory");
        { const int c = lane & 15; float Pr[16];
            Pr[0] = (c == 0) ? 1.f : 0.f;
#pragma unroll
            for (int t = 1; t < 16; ++t) { const float lrow = Ll[t * 16 + c]; float acc = (c == t) ? 1.f : 0.f;
#pragma unroll
                for (int u = 0; u < t; ++u) acc += rdlane(lrow, u) * Pr[u];
                Pr[t] = acc; }
            if (lane < 16) {
#pragma unroll
                for (int t = 0; t < 16; ++t) { OUT[1024 + t * 16 + perm16(c)] = f2bf(Pr[t]); OUT[1024 + (16 + t) * 16 + c] = 0; } } }
        asm volatile("s_waitcnt lgkmcnt(0)" ::: "memory");
        { bf16* dst = IMG + (size_t)p * IMG_ELEMS;
#pragma unroll
            for (int q = 0; q < 3; ++q) *(u32x4*)(dst + (q * 64 + lane) * 8) = *(const LAS u32x4*)(OUT + (q * 64 + lane) * 8); }
        asm volatile("s_waitcnt lgkmcnt(0)" ::: "memory");
    }
}

DI void ph_wkv_chunk(const Ctx& C, const bf16* R, const bf16* V, const bf16* K, const bf16* KK, const float* LW, const bf16* AR_, const float* ka, const bf16* IMG, bf16* YS) {
    constexpr int S_AR = 0, S_BKT = 4608, S_VT = 9728, S_VT2 = 11264, S_GC = 12800, S_MM = 13056, S_MRB = 14592, S_PP = 16128, SLOT = 17664, CUMO = 2 * SLOT, YSTO = CUMO + 8192, DEPTH = 4;
    const int lane = C.lane, wv = C.wave, r = lane & 31, h = lane >> 5;
    const bool isE = wv == 2 || wv == 3 || wv == 6 || wv == 7, isS = wv < 2;
    const int te = (wv == 2 ? 0 : (wv == 3 ? 1 : (wv == 6 ? 2 : 3))) * 64 + lane, et = te >> 4, ekq = te & 15;
    const int vhf = te >> 7, vt = (te >> 3) & 15, viq = te & 7;
    const int hf = wv & 1;
    for (int cid0 = C.bid; cid0 < 128; cid0 += C.nb) {
        const int chain = cid0, b = chain >> 4, hh = (chain >> 1) & 7, d = chain & 1;
        const float* Wd = LW + (size_t)d * MT * 512; const bf16* Ad = AR_ + (size_t)d * MT * 512; bf16* Yd = YS + (size_t)d * MT * 512;
        const bf16* img = IMG + (size_t)(((b * 8 + hh) * 2 + d) * NCHK) * IMG_ELEMS;
        f32x16 ST[2];
#pragma unroll
        for (int i = 0; i < 16; ++i) { ST[0][i] = 0.f; ST[1][i] = 0.f; }
        const f32x4 kav = *(const f32x4*)(ka + hh * 64 + 4 * ekq);
        unsigned ring[DEPTH][16];
        __syncthreads();
        auto issue = [&](int ch, unsigned (&rg)[16]) __attribute__((always_inline)) {
            if (ch < 0 || ch >= NCHK) return;
            const int row0 = scan_row(ch * CCH, d, b), sg = d ? -1 : 1;
            if (isE) {
                const size_t off = (size_t)(row0 + sg * et) * 512 + hh * 64 + 4 * ekq;
                const u32x2 x0 = *(const u32x2*)(R + off), x1 = *(const u32x2*)(K + off), x2 = *(const u32x2*)(KK + off), x3 = *(const u32x2*)(Ad + off);
                const u32x2 x4 = *(const u32x2*)(V + (size_t)(row0 + sg * vt) * 512 + hh * 64 + 32 * vhf + 4 * viq);
                rg[0] = x0.x; rg[1] = x0.y; rg[2] = x1.x; rg[3] = x1.y; rg[4] = x2.x; rg[5] = x2.y; rg[6] = x3.x; rg[7] = x3.y; rg[8] = x4.x; rg[9] = x4.y;
                asm volatile("; wkv issue role E" ::);
            } else if (wv == 4) {
#define W5_(t) rg[(t)] = __builtin_bit_cast(unsigned, Wd[(size_t)(row0 + sg * (t)) * 512 + hh * 64 + lane])
                W5_(0); W5_(1); W5_(2); W5_(3); W5_(4); W5_(5); W5_(6); W5_(7); W5_(8); W5_(9); W5_(10); W5_(11); W5_(12); W5_(13); W5_(14); W5_(15);
#undef W5_
                asm volatile("; wkv issue role C" ::);
            } else if (wv == 5) {
#define W6_(q) do { const u32x4 x = *(const u32x4*)(img + (size_t)ch * IMG_ELEMS + ((q) * 64 + lane) * 8); rg[4 * (q)] = x.x; rg[4 * (q) + 1] = x.y; rg[4 * (q) + 2] = x.z; rg[4 * (q) + 3] = x.w; } while (0)
                W6_(0); W6_(1); W6_(2);
#undef W6_
                asm volatile("; wkv issue role V" ::);
            }
        };
        issue(0, ring[0]); issue(1, ring[1]); issue(2, ring[2]); issue(3, ring[3]);
#define WKV_BAR() asm volatile("s_waitcnt lgkmcnt(0)\n\ts_barrier" ::: "memory")
#define WKV_LOOP(...) for (int n0 = -2; n0 < NCHK; n0 += DEPTH) { auto iter = [&](auto kc) __attribute__((always_inline)) { constexpr int kk = decltype(kc)::value; \
            constexpr int riE = (kk + 3) % DEPTH, riW = kk % DEPTH; (void)riE; (void)riW; const int n = n0 + kk; (void)n; __VA_ARGS__; WKV_BAR(); }; iter(ICk<0>{}); iter(ICk<1>{}); iter(ICk<2>{}); iter(ICk<3>{}); }
        if (isS) {
            WKV_LOOP({
                if (n >= 0 && n < NCHK) {
                    const LAS unsigned char* B = C.lds + (n & 1) * SLOT;
                    f32x16 T1;
                    _Pragma("unroll") for (int i = 0; i < 16; ++i) T1[i] = 0.f;
                    _Pragma("unroll") for (int tau = 0; tau < 2; ++tau) {
                        T1 = MFMA32(*(const LAS bf16x8*)(B + S_AR + r * 144 + (32 * tau + 8 * h) * 2), pack_lo8(ST[tau]), T1);
                        T1 = MFMA32(*(const LAS bf16x8*)(B + S_AR + r * 144 + (32 * tau + 16 + 8 * h) * 2), pack_hi8(ST[tau]), T1);
                    }
                    const bf16x8 vtf = *(const LAS bf16x8*)(B + (hf ? S_VT2 : S_VT) + r * 48 + 16 * h);
                    T1 = MFMA32(*(const LAS bf16x8*)(B + S_MM + r * 48 + 16 * h), vtf, T1);
                    f32x16 ET;
                    _Pragma("unroll") for (int i = 0; i < 16; ++i) ET[i] = 0.f;
                    ET = MFMA32(*(const LAS bf16x8*)(B + S_PP + r * 48 + 16 * h), pack_lo8(T1), ET);
                    const bf16x8 ef = pack_lo8(ET);
                    T1 = MFMA32(*(const LAS bf16x8*)(B + S_MRB + r * 48 + 16 * h), ef, T1);
                    _Pragma("unroll") for (int tau = 0; tau < 2; ++tau) {
                        ST[tau] = MFMA32(*(const LAS bf16x8*)(B + S_BKT + (32 * tau + r) * 80 + 16 * h), ef, ST[tau]);
                        ST[tau] = MFMA32(*(const LAS bf16x8*)(B + S_BKT + (32 * tau + r) * 80 + 32 + 16 * h), vtf, ST[tau]);
                        _Pragma("unroll") for (int g4 = 0; g4 < 4; ++g4) { const f32x4 gc = *(const LAS f32x4*)(B + S_GC + (32 * tau + 8 * g4 + 4 * h) * 4);
                            ST[tau][4 * g4] *= gc.x; ST[tau][4 * g4 + 1] *= gc.y; ST[tau][4 * g4 + 2] *= gc.z; ST[tau][4 * g4 + 3] *= gc.w; }
                    }
                    LAS float* ys = (LAS float*)(C.lds + YSTO) + ((n & 1) * 2 + hf) * 512;
                    _Pragma("unroll") for (int q = 0; q < 8; ++q) ys[(8 * (q >> 2) + 4 * h + (q & 3)) * 32 + r] = T1[8 + q];
                }
            });
        } else if (isE) {
            WKV_LOOP({
                const int ch = n + 1;
                if (ch >= 0) {
                    if (ch < NCHK) {
                        LAS unsigned char* B = C.lds + (ch & 1) * SLOT; const LAS float* ec = (const LAS float*)(C.lds + CUMO) + (ch & 1) * 1024;
                        const f32x4 e1 = *(const LAS f32x4*)(ec + et * 64 + 4 * ekq);
                        f32x4 e0 = {1.f, 1.f, 1.f, 1.f}; if (et > 0) e0 = *(const LAS f32x4*)(ec + (et - 1) * 64 + 4 * ekq);
                        const float rv[4] = {bflo(ring[riE][0]), bfhi(ring[riE][0]), bflo(ring[riE][1]), bfhi(ring[riE][1])}; const float kv[4] = {bflo(ring[riE][2]), bfhi(ring[riE][2]), bflo(ring[riE][3]), bfhi(ring[riE][3])};
                        const float kkv[4] = {bflo(ring[riE][4]), bfhi(ring[riE][4]), bflo(ring[riE][5]), bfhi(ring[riE][5])}; const float av[4] = {bflo(ring[riE][6]), bfhi(ring[riE][6]), bflo(ring[riE][7]), bfhi(ring[riE][7])};
                        float ah[4]; float rh[4]; float bc[4]; float kc4[4];
                        _Pragma("unroll") for (int e = 0; e < 4; ++e) { const float ei = __builtin_amdgcn_rcpf(e1[e]);
                            ah[e] = -kkv[e] * e0[e]; rh[e] = rv[e] * e1[e]; bc[e] = kkv[e] * av[e] * ei; kc4[e] = kv[e] * (1.f + (av[e] - 1.f) * kav[e]) * ei; }
                        const int pk = perm16(4 * ekq);
                        *(LAS u32x2*)((LAS bf16*)(B + S_AR) + et * 72 + pk) = (u32x2){pk2(ah[0], ah[1]), pk2(ah[2], ah[3])};
                        *(LAS u32x2*)((LAS bf16*)(B + S_AR) + (16 + et) * 72 + pk) = (u32x2){pk2(rh[0], rh[1]), pk2(rh[2], rh[3])};
                        const int pt = perm16(et);
                        _Pragma("unroll") for (int e = 0; e < 4; ++e) { ((LAS bf16*)(B + S_BKT))[(4 * ekq + e) * 40 + pt] = f2bf(bc[e]); ((LAS bf16*)(B + S_BKT))[(4 * ekq + e) * 40 + 16 + et] = f2bf(kc4[e]); }
                        if (et == 15) *(LAS f32x4*)((LAS float*)(B + S_GC) + 4 * ekq) = e1;
                        LAS bf16* vtp = (LAS bf16*)(B + (vhf ? S_VT2 : S_VT)) + (4 * viq) * 24 + vt;
                        vtp[0] = (bf16)(ring[riE][8] & 0xffffu); vtp[24] = (bf16)(ring[riE][8] >> 16); vtp[48] = (bf16)(ring[riE][9] & 0xffffu); vtp[72] = (bf16)(ring[riE][9] >> 16);
                    }
                    issue(ch + DEPTH, ring[riE]);
                }
            });
        } else if (wv == 4) {
            WKV_LOOP({
                const int ch = n + 2;
                if (ch < NCHK) { LAS float* ec = (LAS float*)(C.lds + CUMO) + (ch & 1) * 1024; float c = 0.f;
#define C5_(t) do { c += __builtin_bit_cast(float, ring[riW][(t)]); ec[(t) * 64 + lane] = __expf(c); } while (0)
                    C5_(0); C5_(1); C5_(2); C5_(3); C5_(4); C5_(5); C5_(6); C5_(7); C5_(8); C5_(9); C5_(10); C5_(11); C5_(12); C5_(13); C5_(14); C5_(15);
                }
                issue(ch + DEPTH, ring[riW]);
            });
        } else {
            WKV_LOOP({
                { const int chy = n - 1;
                  if (chy >= 0 && chy < NCHK) { const int yh = lane >> 5, yt = (lane & 31) >> 1, yi = 16 * (lane & 1);
                    const LAS float* ys = (const LAS float*)(C.lds + YSTO) + ((chy & 1) * 2 + yh) * 512 + yt * 32 + yi;
                    bf16* dst = Yd + (size_t)(scan_row(chy * CCH, d, b) + (d ? -1 : 1) * yt) * 512 + hh * 64 + 32 * yh + yi;
                    _Pragma("unroll") for (int q = 0; q < 2; ++q) { const f32x4 a0 = *(const LAS f32x4*)(ys + 8 * q); const f32x4 a1 = *(const LAS f32x4*)(ys + 8 * q + 4);
                        *(u32x4*)(dst + 8 * q) = (u32x4){pk2(a0.x, a0.y), pk2(a0.z, a0.w), pk2(a1.x, a1.y), pk2(a1.z, a1.w)}; } } }
                const int ch = n + 1;
                if (ch >= 0) {
                    if (ch < NCHK) { LAS unsigned char* B = C.lds + (ch & 1) * SLOT;
                        const int irow = lane >> 1; const int ihv = lane & 1;
                        *(LAS u32x4*)(B + S_MM + irow * 48 + ihv * 16) = (u32x4){ring[riE][0], ring[riE][1], ring[riE][2], ring[riE][3]};
                        *(LAS u32x4*)(B + S_MRB + irow * 48 + ihv * 16) = (u32x4){ring[riE][4], ring[riE][5], ring[riE][6], ring[riE][7]};
                        *(LAS u32x4*)(B + S_PP + irow * 48 + ihv * 16) = (u32x4){ring[riE][8], ring[riE][9], ring[riE][10], ring[riE][11]};
                    }
                    issue(ch + DEPTH, ring[riE]);
                }
            });
        }
#undef C5_
#undef WKV_LOOP
#undef WKV_BAR
    }
}

DI void ph_post(const Ctx& C, const bf16* YS, const bf16* R, const bf16* V, const bf16* K, const bf16* A2, const float* ka, const bf16* G, const float* rk, const float* gng, const float* gnb, bf16* OCAT, bool last) {
    const int gw = C.bid * 8 + C.wave, ngw = C.nb * 8, lane = C.lane, nrows = last ? NLAT : MT;
    for (int row = gw; row < nrows; row += ngw) {
        const size_t o = (size_t)row * 512 + 8 * lane;
        float y[8], y1[8]; unpack8(*(const u32x4*)(YS + o), y); unpack8(*(const u32x4*)(YS + (size_t)MT * 512 + o), y1);
#pragma unroll
        for (int e = 0; e < 8; ++e) y[e] += y1[e];
        float r[8], v[8], kx[8], a0[8], a1[8], g[8];
        unpack8(*(const u32x4*)(R + o), r); unpack8(*(const u32x4*)(V + o), v); unpack8(*(const u32x4*)(K + o), kx); unpack8(*(const u32x4*)(A2 + o), a0); unpack8(*(const u32x4*)(A2 + (size_t)MT * 512 + o), a1); unpack8(*(const u32x4*)(G + o), g);
        float bsum = 0.f;
#pragma unroll
        for (int e = 0; e < 8; ++e) { const float kae = ka[8 * lane + e]; bsum += r[e] * (kx[e] * (1.f + (a0[e] - 1.f) * kae) + kx[e] * (1.f + (a1[e] - 1.f) * kae)) * rk[8 * lane + e]; }
        bsum = sum8(bsum);
        float s = 0.f;
#pragma unroll
        for (int e = 0; e < 8; ++e) { y[e] += bsum * v[e]; s += y[e]; }
        const float mu = sum8(s) * (1.f / 64.f); float s2 = 0.f;
#pragma unroll
        for (int e = 0; e < 8; ++e) { y[e] -= mu; s2 += y[e] * y[e]; }
        const float rstd = 1.0f / sqrtf(sum8(s2) * (1.f / 64.f) + GN_EPS);
        float out[8];
#pragma unroll
        for (int e = 0; e < 8; ++e) out[e] = (y[e] * rstd * gng[8 * lane + e] + gnb[8 * lane + e]) * g[e];
        *(u32x4*)(OCAT + (size_t)row * DM + 8 * lane) = pack8(out);
    }
}

DI void ph_topk2(const Ctx& C, const float* AFFT, const float* AFFC, int* ROWS, float* GATE, int* SLOT, bool last) {
    LAS unsigned* bits = (LAS unsigned*)C.lds;
    LAS unsigned* hist = bits + 4096;
    LAS unsigned* ctl = hist + 256;
    LAS unsigned* cnt = ctl + 8;
    const int tid = C.tid, nprob = last ? 128 : 256;
    for (int p = C.bid; p < nprob; p += C.nb) {
        const bool isctx = p >= 128; const int be = p & 127, b = be >> 4, e = be & 15;
        const int n = isctx ? LCX : TL, cap = isctx ? CAPC : CAPL, per = n / 512 > 0 ? n / 512 : 1;
        const float* src = isctx ? AFFC + (size_t)be * LCX : AFFT + (size_t)be * TL;
        __syncthreads();
        for (int t = tid; t < n; t += 512) bits[t] = __builtin_bit_cast(unsigned, src[t]);
        if (tid == 0) { ctl[0] = 0u; ctl[1] = (unsigned)cap; }
        __syncthreads();
        for (int pass = 0; pass < 4; ++pass) {
            const int shift = 24 - 8 * pass;
            if (tid < 256) hist[tid] = 0u;
            __syncthreads();
            const unsigned prefix = ctl[0], himask = pass == 0 ? 0u : (0xFFFFFFFFu << (shift + 8));
            for (int t = tid; t < n; t += 512) { const unsigned v = bits[t]; if ((v & himask) == prefix) __hip_atomic_fetch_add(&hist[(v >> shift) & 255u], 1u, __ATOMIC_RELAXED, __HIP_MEMORY_SCOPE_WORKGROUP); }
            __syncthreads();
            if (tid == 0) { unsigned k = ctl[1], acc = 0u; int bsel = 0;
                for (int bb = 255; bb >= 0; --bb) { const unsigned c = hist[bb]; if (acc + c >= k) { bsel = bb; break; } acc += c; }
                ctl[0] = prefix | ((unsigned)bsel << shift); ctl[1] = k - acc; }
            __syncthreads();
        }
        const unsigned T = ctl[0], keq = ctl[1];
        const int t0 = tid * per; unsigned myc = 0u;
        if (t0 < n) for (int q = 0; q < per; ++q) { const unsigned v = bits[t0 + q]; myc += (v > T ? 0x10000u : 0u) + (v == T ? 1u : 0u); }
        cnt[tid] = myc;
        __syncthreads();
        for (int off = 1; off < 512; off <<= 1) { const unsigned add = tid >= off ? cnt[tid - off] : 0u; __syncthreads(); cnt[tid] += add; __syncthreads(); }
        unsigned before = cnt[tid] - myc;
        if (t0 < n) for (int q = 0; q < per; ++q) { const int t = t0 + q; const unsigned v = bits[t]; const unsigned gtb = before >> 16, eqb = before & 0xFFFFu;
            const bool sel = v > T || (v == T && eqb < keq);
            if (sel) { const int jx = (int)(gtb + (eqb < keq ? eqb : keq));
                const int slot = isctx ? NB * CAPL + b * CAPC + jx : b * CAPL + jx, row = isctx ? NLAT + b * LCX + t : b * TL + t;
                ROWS[e * ESLOTS + slot] = row; GATE[e * ESLOTS + slot] = __builtin_bit_cast(float, v); SLOT[(size_t)row * 16 + e] = slot; }
            before += (v > T ? 0x10000u : 0u) + (v == T ? 1u : 0u); }
    }
}

DI void ph_topk(const Ctx& C, const float* AFFT, const float* AFFC, int* ROWS, float* GATE, int* SLOT, bool last) {
    LAS unsigned long long* key = (LAS unsigned long long*)C.lds;
    const int nprob = last ? 128 : 256;
    for (int p = C.bid; p < nprob; p += C.nb) {
        const bool isctx = p >= 128; const int be = p & 127, b = be >> 4, e = be & 15;
        const int n = isctx ? LCX : TL, cap = isctx ? CAPC : CAPL;
        const float* src = isctx ? AFFC + (size_t)be * LCX : AFFT + (size_t)be * TL;
        __syncthreads();
        for (int t = C.tid; t < n; t += 512) key[t] = ((unsigned long long)__builtin_bit_cast(unsigned, src[t]) << 32) | (unsigned long long)(0xFFFFFFFFu - (unsigned)t);
        __syncthreads();
        for (int k = 2; k <= n; k <<= 1)
            for (int j = k >> 1; j > 0; j >>= 1) {
                for (int q = C.tid; q < n / 2; q += 512) {
                    const int i = ((q & ~(j - 1)) << 1) | (q & (j - 1)), ix = i | j;
                    const unsigned long long a = key[i], bb = key[ix];
                    const bool desc = ((i & k) == 0);
                    if (desc ? (a < bb) : (a > bb)) { key[i] = bb; key[ix] = a; }
                }
                __syncthreads();
            }
        for (int jx = C.tid; jx < cap; jx += 512) {
            const unsigned long long kv = key[jx]; const int t = (int)(0xFFFFFFFFu - (unsigned)(kv & 0xFFFFFFFFull)); const float g = __builtin_bit_cast(float, (unsigned)(kv >> 32));
            const int slot = isctx ? NB * CAPL + b * CAPC + jx : b * CAPL + jx, row = isctx ? NLAT + b * LCX + t : b * TL + t;
            ROWS[e * ESLOTS + slot] = row; GATE[e * ESLOTS + slot] = g; SLOT[(size_t)row * 16 + e] = slot;
        }
    }
}

DI void ph_combine(const Ctx& C, float* xlat, float* xctx, const float* modg2  , const int* SLOT, const bf16* Y2, bool last,
                   const float* ngain  , const float* nmod  , bf16* H) {
    const int gw = C.bid * 8 + C.wave, ngw = C.nb * 8, lane = C.lane, nrows = last ? NLAT : MT;
    for (int row = gw; row < nrows; row += ngw) {
        float* xr = row < NLAT ? xlat + (size_t)row * DM : xctx + (size_t)(row - NLAT) * DM;
        const int mi = row < NLAT ? (row >> 12) : 8;
        const int sv = SLOT[(size_t)row * 16 + (lane & 15)];
        f32x4 acc[4];
#pragma unroll
        for (int j = 0; j < 4; ++j) acc[j] = (f32x4){0.f, 0.f, 0.f, 0.f};
#pragma unroll
        for (int e = 0; e < 16; ++e) {
            const int s = __builtin_amdgcn_readlane(sv, e);
            if (s >= 0) { const bf16* yp = Y2 + ((size_t)e * ESLOTS + s) * DM + 4 * lane;
#pragma unroll
                for (int j = 0; j < 4; ++j) { const u32x2 w = *(const u32x2*)(yp + 256 * j); acc[j] += (f32x4){bflo(w.x), bfhi(w.x), bflo(w.y), bfhi(w.y)}; } }
        }
#pragma unroll
        for (int j = 0; j < 4; ++j) { const int c = 256 * j + 4 * lane; const f32x4 g = *(const f32x4*)(modg2 + mi * 6144 + c); f32x4 x = *(const f32x4*)(xr + c); x += g * acc[j]; *(f32x4*)(xr + c) = x; acc[j] = x; }
        if (ngain) {
            float ss = 0.f;
#pragma unroll
            for (int j = 0; j < 4; ++j) ss += acc[j].x * acc[j].x + acc[j].y * acc[j].y + acc[j].z * acc[j].z + acc[j].w * acc[j].w;
            const float rs = 1.0f / sqrtf(wave_sum(ss) * (1.f / 1024.f) + EPS);
            const float* mp = nmod + mi * 6144;
#pragma unroll
            for (int j = 0; j < 4; ++j) { const int c = 256 * j + 4 * lane;
                const f32x4 g = *(const f32x4*)(ngain + c), sc = *(const f32x4*)(mp + 1024 + c), sh = *(const f32x4*)(mp + c);
                const f32x4 hv = (acc[j] * rs) * g * (sc + 1.0f) + sh;
                *(u32x2*)(H + (size_t)row * DM + c) = (u32x2){pk2(hv.x, hv.y), pk2(hv.z, hv.w)}; }
        }
    }
}

template <int N> struct IC { static constexpr int value = N; };
DI const float* in_ptr(const unsigned char* ws, int k) { const unsigned long long v = ((const unsigned long long*)(ws + 128 * 1024))[k];
    const unsigned lo = __builtin_amdgcn_readfirstlane((unsigned)v), hi = __builtin_amdgcn_readfirstlane((unsigned)(v >> 32));
    return (const float*)(__attribute__((address_space(1))) const float*)(((unsigned long long)hi << 32) | lo); }
template <class T> DI T* launder_ptr(T* p) { unsigned long long v = (unsigned long long)p; unsigned lo = (unsigned)v, hi = (unsigned)(v >> 32); asm volatile("" : "+v"(lo), "+v"(hi));
    lo = __builtin_amdgcn_readfirstlane(lo); hi = __builtin_amdgcn_readfirstlane(hi); return (T*)(__attribute__((address_space(1))) T*)(((unsigned long long)hi << 32) | lo); }
constexpr int N_PHASES = 1 + 23 + 22;
constexpr size_t WS_PTRS = 128 * 1024;
#define P_XC    ((float*)(ws + WS_XC))
#define P_MOD   ((const float*)(ws + WS_MOD))
#define P_HB    ((bf16*)(ws + WS_HB))
#define P_OCAT  ((bf16*)(ws + WS_OCAT))
#define P_AR    (ws + WS_ARENA)
#define P_ROWS  ((int*)(ws + WS_ROWS))
#define P_GATE  ((float*)(ws + WS_GATE))
#define P_SLOT  ((int*)(ws + WS_SLOT))
#define P_AFFT  ((float*)(ws + WS_AFFT))
#define P_AFFC  ((float*)(ws + WS_AFFC))
#define P_W13   ((bf16*)(ws + WS_W13))
#define P_W2    ((bf16*)(ws + WS_W2))
#define P_U     ((bf16*)(P_AR + A_U))
#define P_QPRE  ((float*)(P_AR + A_QPRE))
#define P_KVPRE ((float*)(P_AR + A_KVPRE))
#define P_QB    ((bf16*)(P_AR + A_QB))
#define P_KB    ((bf16*)(P_AR + A_KB))
#define P_VT    ((bf16*)(P_AR + A_VT))
#define P_W     ((float*)(P_AR + A_W))
#define P_KEFF  ((bf16*)(P_AR + A_KEFF))
#define P_R     ((bf16*)(P_AR + A_R))
#define P_V     ((bf16*)(P_AR + A_V))
#define P_KK    ((bf16*)(P_AR + A_KK))
#define P_G     ((bf16*)(P_AR + A_G))
#define P_K     ((bf16*)(P_AR + A_K))
#define P_L     ((bf16*)(P_AR + A_L))
#define P_QN    ((bf16*)(P_AR + A_QN))
#define P_KN    ((bf16*)(P_AR + A_KN))
#define P_VTN   ((bf16*)(P_AR + A_VTN))
#define P_YS    ((bf16*)(P_AR + A_YS))
#define P_IMG   ((bf16*)(P_AR + A_IMG))
#define P_HID   ((bf16*)(P_AR + A_HID))
#define P_Y2    ((bf16*)(P_AR + A_Y2))
#define MODL(i) (P_MOD + (size_t)(i) * 9 * 6144)
#define RELAUNDER() do { int l_ = C.lane; asm volatile("" : "+v"(l_)); C.lane = l_; C.tid = (C.wave << 6) | l_; } while (0)
__global__ void __launch_bounds__(512, 2) fwd_kernel(Args a) {
    extern __shared__ __attribute__((aligned(16))) unsigned char smem[];
    Ctx C0; C0.lds = (LAS unsigned char*)smem; C0.tid = threadIdx.x; C0.lane = C0.tid & 63; C0.wave = __builtin_amdgcn_readfirstlane(C0.tid >> 6); C0.bid = blockIdx.x; C0.nb = gridDim.x;
    C0.vcu = (C0.nb % 8 == 0) ? (C0.bid % 8) * (C0.nb / 8) + C0.bid / 8 : C0.bid;
    volatile LAS unsigned* bst = (volatile LAS unsigned*)(C0.lds + LDS_BYTES - 16);
#if MEGA
    if (C0.tid == 0) { bst[0] = 0u; bst[1] = 0u; }
    __syncthreads();
    const unsigned bar_x = xcd_barrier_post((unsigned*)(a.ws + WS_CTL) + 4096, bst, C0.tid == 0).x;
#define SEAM() do { if (ph < hi) { XcdBarrier b2_; b2_.bar = (unsigned*)(ws + WS_CTL) + 4096; b2_.x = bar_x; b2_.st = bst; xcd_barrier(b2_, C.tid == 0); } } while (0)
#else
#define SEAM() do { } while (0)
#endif
#if MEGA
    constexpr int lo = 0, hi = N_PHASES;
#else
    const int lo = a.ph_lo, hi = a.ph_hi;
#endif
    int ph = 0;
#ifndef ONLY
#define ONLY -1
#endif
#ifndef REPMASK
#define REPMASK 0
#endif
#ifndef SITE_LO
#define SITE_LO 0
#define SITE_HI 99
#endif
#define PHASE(SITE, ...) do { if ((ONLY < 0 || ONLY == (SITE)) && (SITE) >= SITE_LO && (SITE) <= SITE_HI && ph >= lo && ph < hi) { Ctx C; C.lds = C0.lds; \
        { int w_ = C0.wave; asm volatile("" : "+s"(w_)); unsigned m_ = ~0u; asm volatile("" : "+s"(m_)); int l_ = (int)__builtin_amdgcn_mbcnt_hi(m_, __builtin_amdgcn_mbcnt_lo(m_, 0u)); C.wave = w_; C.lane = l_; C.tid = (w_ << 6) | l_; } \
        { int b_ = C0.bid, n_ = C0.nb, v_ = C0.vcu; asm volatile("" : "+s"(b_), "+s"(n_), "+s"(v_)); C.bid = b_; C.nb = n_; C.vcu = v_; } \
        unsigned z_ = 0u; asm volatile("" : "+s"(z_)); unsigned char* ws = a.ws + z_; float* XL = a.out + z_; const int lq = __builtin_amdgcn_readfirstlane(lp); typedef const __attribute__((address_space(1))) float* gfp_t; const gfp_t* INT_ = (const gfp_t*)(ws + WS_PTRS); (void)INT_; (void)XL; (void)lq; \
        for (int rep_ = 0; rep_ < ((((REPMASK) >> (SITE)) & 1) ? 2 : 1); ++rep_) { __VA_ARGS__; if ((((REPMASK) >> (SITE)) & 1)) __syncthreads(); } ++ph; SEAM(); } else ++ph; } while (0)

    { const int lp = 0;
      PHASE(0, { if (C.bid == 0) { _Pragma("unroll") for (int k = 0; k < 40; ++k) if (C.tid == k) ((const float**)(ws + WS_PTRS))[k] = a.in[k]; }
                 ph_prologue(C, a); }); }

    auto layer_pair = [&](auto lpc) __attribute__((always_inline)) {
        constexpr int lp = decltype(lpc)::value;
        if constexpr (lp == 0) PHASE(1, { const int i = 2 * lq; const float* xl = (i == 0) ? in_ptr(ws, I_X) : XL; const float* xc = (i == 0) ? in_ptr(ws, I_CTX) : P_XC;
                   ph_norm<false>(C, xl, xc, in_ptr(ws, I_N1G) + i * DM, MODL(i), 0, 1024, P_HB, nullptr, nullptr, nullptr, nullptr);
                   moe_weight_prep(C, in_ptr(ws, I_MW1) + (size_t)i * NEXP * DM * DM, in_ptr(ws, I_MW3) + (size_t)i * NEXP * DM * DM, in_ptr(ws, I_MW2) + (size_t)i * NEXP * DM * DM, P_W13, P_W2); });
        PHASE(2, { EpiBf16 E{P_U, EV_INP}; fast_gemm(C, P_HB, DM, (const bf16*)(ws + WS_WEVIN) + (size_t)lq * EV_INP * DM, DM, MT / 256, EV_INP / 256, E); });
        PHASE(3, { EpiBf16 Eq{(bf16*)P_QPRE, 768}; fast_gemm(C, P_U, EV_INP, (const bf16*)(ws + WS_WUQ) + (size_t)lq * 768 * 384, 384, MT / 256, 3, Eq); RELAUNDER();
                   EpiBf16 Ek{(bf16*)P_KVPRE, 1024}; fast_gemm(C, P_U + 384, EV_INP, (const bf16*)(ws + WS_WUKV) + (size_t)lq * 1024 * 256, 256, MT / 256, 4, Ek, true); });
        PHASE(4, { ph_mla_fin(C, P_U, (const bf16*)P_QPRE, (const bf16*)P_KVPRE, in_ptr(ws, I_QG) + lq * 96, in_ptr(ws, I_KG) + lq * 96, (const f32x2*)(ws + WS_ROPE), P_QB, P_KB, P_VT);
                   ph_conv(C, P_U, in_ptr(ws, I_DWW) + (size_t)lq * 31 * 512, in_ptr(ws, I_DWB) + lq * 512, in_ptr(ws, I_LNG) + lq * 512, in_ptr(ws, I_LNB) + lq * 512, P_OCAT); });
        PHASE(5, ph_attn_mla2(C, P_QB, P_KB, P_VT, P_OCAT, false));
        PHASE(6, { const int i = 2 * lq; const float* xl = (i == 0) ? in_ptr(ws, I_X) : XL; const float* xc = (i == 0) ? in_ptr(ws, I_CTX) : P_XC;
                   EpiResid E{xl, xc, XL, P_XC, MODL(i) + 2048}; fast_gemm(C, P_OCAT, DM, (const bf16*)(ws + WS_WEVOUT) + (size_t)lq * DM * DM, DM, MT / 256, 4, E); });
        PHASE(7, { const int i = 2 * lq; ph_norm<true>(C, XL, P_XC, in_ptr(ws, I_N2G) + i * DM, MODL(i), 3072, 4096, P_HB, in_ptr(ws, I_ROUTER) + (size_t)i * DM * 16, P_AFFT, P_AFFC, P_SLOT); });
        PHASE(8, ph_topk2(C, P_AFFT, P_AFFC, P_ROWS, P_GATE, P_SLOT, false));
        PHASE(9, { pg8::Gemm g{P_HB, P_W13, DM, DM, P_ROWS}; pg8::OrderMoE S{17, 8, 17, C.nb, C.vcu}; pg8::EpiAdapt<EpiGlu> E{EpiGlu{P_HID}}; pg8::gemm_phase(C.lds, g, S, E, C.tid); });
        PHASE(10, { pg8::Gemm g{P_HID, P_W2, DM, DM, nullptr}; pg8::OrderMoE S{17, 4, 17, C.nb, C.vcu}; pg8::EpiAdapt<EpiGate> E{EpiGate{P_Y2, P_GATE}}; pg8::gemm_phase(C.lds, g, S, E, C.tid); });
        PHASE(11, { const int i = 2 * lq; ph_combine(C, XL, P_XC, MODL(i) + 5120, P_SLOT, P_Y2, false, in_ptr(ws, I_N1G) + (i + 1) * DM, MODL(i + 1), P_HB);
                    moe_weight_prep(C, in_ptr(ws, I_MW1) + (size_t)(i + 1) * NEXP * DM * DM, in_ptr(ws, I_MW3) + (size_t)(i + 1) * NEXP * DM * DM, in_ptr(ws, I_MW2) + (size_t)(i + 1) * NEXP * DM * DM, P_W13, P_W2); });
        PHASE(13, { EpiBf16 E{P_U, OD_INP}; fast_gemm(C, P_HB, DM, (const bf16*)(ws + WS_WODIN) + (size_t)lq * OD_INP * DM, DM, MT / 256, OD_INP / 256, E); });
        PHASE(14, ph_prep(C, P_U, in_ptr(ws, I_SHIFTW) + (size_t)lq * 3 * RW_IN, in_ptr(ws, I_KKW) + lq * 512, in_ptr(ws, I_NAQG) + lq * 64, in_ptr(ws, I_NAKG) + lq * 64, P_R, P_V, P_K, P_KK, P_L, P_QN, P_KN, P_VTN));
        PHASE(15, { const bf16* WL = (const bf16*)(ws + WS_WLORA) + (size_t)lq * 655360;
                    { EpiLoraW E{P_W, in_ptr(ws, I_W0) + lq * 1024}; fast_gemm(C, P_L, 384, WL, 256, MT / 256, 4, E); } RELAUNDER();
                    { EpiLoraA E{P_KEFF, in_ptr(ws, I_A0) + lq * 1024}; fast_gemm(C, P_L, 384, WL + (size_t)1024 * 256, 256, MT / 256, 4, E, true); } RELAUNDER();
                    { EpiBf16 E{P_G, 512}; fast_gemm(C, P_L + 128, 384, WL + (size_t)2048 * 256, 256, MT / 256, 2, E); } });
        PHASE(16, ph_wkv_pre(C, P_R, P_K, P_KK, P_W, P_KEFF, in_ptr(ws, I_KA) + lq * 512, P_IMG));
        PHASE(17, { ph_wkv_chunk(C, P_R, P_V, P_K, P_KK, P_W, P_KEFF, in_ptr(ws, I_KA) + lq * 512, P_IMG, P_YS); __syncthreads();
                    ph_natten2(C, P_QN, P_KN, P_VTN, P_OCAT, in_ptr(ws, I_RPB) + (size_t)lq * 8 * 465, lq == 1, (unsigned*)(ws + WS_CTL) + 8192 + 64 * lq); });
        PHASE(18, ph_post(C, P_YS, P_R, P_V, P_K, P_KEFF, in_ptr(ws, I_KA) + lq * 512, P_G, in_ptr(ws, I_RK) + lq * 512, in_ptr(ws, I_GNG) + lq * 512, in_ptr(ws, I_GNB) + lq * 512, P_OCAT, lq == 1));
        PHASE(19, { const int i = 2 * lq + 1; EpiResid E{XL, P_XC, XL, P_XC, MODL(i) + 2048};
                    fast_gemm(C, P_OCAT, DM, (const bf16*)(ws + WS_WODOUT) + (size_t)lq * DM * DM, DM, (lq == 1) ? NLAT / 256 : MT / 256, 4, E); });
        PHASE(20, { const int i = 2 * lq + 1; ph_norm<true>(C, XL, P_XC, in_ptr(ws, I_N2G) + i * DM, MODL(i), 3072, 4096, P_HB, in_ptr(ws, I_ROUTER) + (size_t)i * DM * 16, P_AFFT, P_AFFC, P_SLOT); });
        PHASE(21, ph_topk2(C, P_AFFT, P_AFFC, P_ROWS, P_GATE, P_SLOT, lq == 1));
        PHASE(22, { pg8::Gemm g{P_HB, P_W13, DM, DM, P_ROWS}; pg8::OrderMoE S{(lq == 1) ? 16 : 17, 8, 17, C.nb, C.vcu}; pg8::EpiAdapt<EpiGlu> E{EpiGlu{P_HID}}; pg8::gemm_phase(C.lds, g, S, E, C.tid); });
        PHASE(23, { pg8::Gemm g{P_HID, P_W2, DM, DM, nullptr}; pg8::OrderMoE S{(lq == 1) ? 16 : 17, 4, 17, C.nb, C.vcu}; pg8::EpiAdapt<EpiGate> E{EpiGate{P_Y2, P_GATE}}; pg8::gemm_phase(C.lds, g, S, E, C.tid); });
        PHASE(24, { const int i = 2 * lq + 1;
                    if (lp == 0) { ph_combine(C, XL, P_XC, MODL(i) + 5120, P_SLOT, P_Y2, false, in_ptr(ws, I_N1G) + (i + 1) * DM, MODL(i + 1), P_HB);
                        moe_weight_prep(C, in_ptr(ws, I_MW1) + (size_t)(i + 1) * NEXP * DM * DM, in_ptr(ws, I_MW3) + (size_t)(i + 1) * NEXP * DM * DM, in_ptr(ws, I_MW2) + (size_t)(i + 1) * NEXP * DM * DM, P_W13, P_W2); }
                    else ph_combine(C, XL, P_XC, MODL(i) + 5120, P_SLOT, P_Y2, true, nullptr, nullptr, nullptr); });
    };
    layer_pair(IC<0>{}); layer_pair(IC<1>{});
}

extern "C" void kernel_launch(void* const* d_in, const int* in_sizes, int n_in, void* d_out, int out_size, void* d_ws, size_t ws_size, hipStream_t stream) {
    static int grid = 0;
    if (grid == 0) {
        if (n_in != 40 || out_size != NLAT * DM || ws_size < WS_END) { fprintf(stderr, "kernel_launch: unexpected shapes (n_in %d out %d ws %zu need %zu)\n", n_in, out_size, ws_size, (size_t)WS_END); grid = -1; return; }
        int dev = 0, cus = 0, per_cu = 0;
        if (hipGetDevice(&dev) != hipSuccess || hipDeviceGetAttribute(&cus, hipDeviceAttributeMultiprocessorCount, dev) != hipSuccess) { grid = -1; return; }
        if (hipFuncSetAttribute((const void*)fwd_kernel, hipFuncAttributeMaxDynamicSharedMemorySize, LDS_BYTES) != hipSuccess) { fprintf(stderr, "kernel_launch: hipFuncSetAttribute failed\n"); grid = -1; return; }
        if (hipOccupancyMaxActiveBlocksPerMultiprocessor(&per_cu, (const void*)fwd_kernel, 512, LDS_BYTES) != hipSuccess || per_cu < 1) { fprintf(stderr, "kernel_launch: occupancy query says %d\n", per_cu); per_cu = 1; }
        (void)hipGetLastError();
        grid = cus;
    }
    if (grid < 0) return;
    (void)hipMemsetAsync((char*)d_ws + WS_CTL, 0, CTL_BYTES, stream);
    Args a{};
    for (int i = 0; i < 40; ++i) a.in[i] = (const float*)d_in[i];
    a.out = (float*)d_out; a.ws = (unsigned char*)d_ws;
#if MEGA
    a.ph_lo = 0; a.ph_hi = N_PHASES;
    hipLaunchKernelGGL(fwd_kernel, dim3(grid), dim3(512), LDS_BYTES, stream, a);
#else
    for (int p = 0; p < N_PHASES; ++p) { a.ph_lo = p; a.ph_hi = p + 1; hipLaunchKernelGGL(fwd_kernel, dim3(grid), dim3(512), LDS_BYTES, stream, a); }
#endif
}
```

```cpp
#include <hip/hip_runtime.h>
#include <cstdio>
#include <cstdint>

#ifndef MEGA
#define MEGA 1
#endif

#define LAS __attribute__((address_space(3)))
#define DI __device__ __forceinline__

typedef unsigned short bf16;
typedef short bf16x8 __attribute__((ext_vector_type(8)));
typedef float f32x4 __attribute__((ext_vector_type(4)));
typedef float f32x2 __attribute__((ext_vector_type(2)));
typedef float f32x16 __attribute__((ext_vector_type(16)));
typedef unsigned u32x4 __attribute__((ext_vector_type(4)));
typedef unsigned u32x2 __attribute__((ext_vector_type(2)));
typedef __bf16 bf16x2_t __attribute__((ext_vector_type(2)));

constexpr int DM = 1024, NB = 8, TL = 4096, LCX = 256;
constexpr int NLAT = NB * TL, NCTX = NB * LCX, MT = NLAT + NCTX;
constexpr int KPOS = TL + LCX;
constexpr float EPS = 1e-6f, GN_EPS = 64e-5f;
constexpr int EV_IN = 1696, EV_INP = 1792, OD_IN = 3456, OD_INP = 3584, RW_IN = 1920;
constexpr int NEXP = 16, CAPL = 512, CAPC = 32, ESLOTS = NB * CAPL + NB * CAPC;
constexpr float LOG2E = 1.4426950408889634f;

constexpr size_t MiB = 1ull << 20;
constexpr size_t WS_CTL = 0, CTL_BYTES = 1 * MiB;
constexpr size_t WS_MOD = 1 * MiB, WS_ROPE = 2 * MiB, WS_XC = 4 * MiB;
constexpr size_t WS_ROWS = 12 * MiB, WS_GATE = 12 * MiB + 512 * 1024, WS_SLOT = 13 * MiB, WS_AFFT = 16 * MiB, WS_AFFC = 18 * MiB;
constexpr size_t WS_WEVIN = 20 * MiB, WS_WEVOUT = 27 * MiB, WS_WUQ = 31 * MiB, WS_WUKV = 33 * MiB, WS_WODIN = 34 * MiB, WS_WODOUT = 48 * MiB, WS_WLORA = 52 * MiB;
constexpr size_t WS_W13 = 56 * MiB, WS_W2 = 120 * MiB, WS_HB = 152 * MiB, WS_OCAT = 220 * MiB, WS_ARENA = 288 * MiB;
constexpr size_t A_U = 0, A_QPRE = 119 * MiB, A_KVPRE = 221 * MiB, A_QB = 357 * MiB, A_KB = 408 * MiB, A_VT = 459 * MiB;
constexpr size_t A_W = 0, A_KEFF = 136 * MiB  , A_G = 204 * MiB, A_R = 238 * MiB, A_V = 272 * MiB, A_KK = 306 * MiB, A_K = 340 * MiB, A_L = 374 * MiB,
                 A_QN = 400 * MiB, A_KN = 434 * MiB, A_VTN = 468 * MiB, A_YS = 612 * MiB  ;
constexpr size_t A_HID = 0, A_Y2 = 136 * MiB;
constexpr size_t A_IMG = 510 * MiB;
constexpr size_t WS_END = WS_ARENA + 680 * MiB;
constexpr int LDS_BYTES = 147456;

DI unsigned pk2(float lo, float hi) { f32x2 v = {lo, hi}; bf16x2_t b = __builtin_convertvector(v, bf16x2_t); return __builtin_bit_cast(unsigned, b); }
DI float bflo(unsigned u) { return __builtin_bit_cast(float, u << 16); }
DI float bfhi(unsigned u) { return __builtin_bit_cast(float, u & 0xffff0000u); }
DI float bf2f(bf16 x) { return __builtin_bit_cast(float, ((unsigned)x) << 16); }
DI bf16 f2bf(float f) { return (bf16)(pk2(f, 0.f) & 0xffffu); }
DI void unpack8(u32x4 v, float (&f)[8]) { f[0] = bflo(v.x); f[1] = bfhi(v.x); f[2] = bflo(v.y); f[3] = bfhi(v.y); f[4] = bflo(v.z); f[5] = bfhi(v.z); f[6] = bflo(v.w); f[7] = bfhi(v.w); }
DI u32x4 pack8(const float (&f)[8]) { u32x4 r; r.x = pk2(f[0], f[1]); r.y = pk2(f[2], f[3]); r.z = pk2(f[4], f[5]); r.w = pk2(f[6], f[7]); return r; }
#define DPP_ADD(x, ctrl) ((x) + __builtin_bit_cast(float, __builtin_amdgcn_update_dpp(0, __builtin_bit_cast(int, (x)), (ctrl), 0xf, 0xf, false)))
#define DPP_MAX(x, ctrl) fmaxf((x), __builtin_bit_cast(float, __builtin_amdgcn_update_dpp(0, __builtin_bit_cast(int, (x)), (ctrl), 0xf, 0xf, false)))
DI float sum8(float x) { x = DPP_ADD(x, 0xB1); x = DPP_ADD(x, 0x4E); x = DPP_ADD(x, 0x141); return x; }
DI float sum16(float x) { x = DPP_ADD(x, 0xB1); x = DPP_ADD(x, 0x4E); x = DPP_ADD(x, 0x141); x = DPP_ADD(x, 0x140); return x; }
DI float max16(float x) { x = DPP_MAX(x, 0xB1); x = DPP_MAX(x, 0x4E); x = DPP_MAX(x, 0x141); x = DPP_MAX(x, 0x140); return x; }
DI float rdlane(float x, int l) { return __builtin_bit_cast(float, __builtin_amdgcn_readlane(__builtin_bit_cast(int, x), l)); }
DI float wave_sum(float v) { const float x = sum16(v); return (rdlane(x, 0) + rdlane(x, 16)) + (rdlane(x, 32) + rdlane(x, 48)); }
DI float xor32(float v, int lane) { return __builtin_bit_cast(float, __builtin_amdgcn_ds_bpermute((lane ^ 32) << 2, __builtin_bit_cast(int, v))); }
typedef int v8i_t __attribute__((ext_vector_type(8)));
typedef int i32x4_t __attribute__((ext_vector_type(4)));
DI unsigned pk4_fp8(float a, float b, float c, float d) {
    a = __builtin_amdgcn_fmed3f(a, -448.f, 448.f); b = __builtin_amdgcn_fmed3f(b, -448.f, 448.f); c = __builtin_amdgcn_fmed3f(c, -448.f, 448.f); d = __builtin_amdgcn_fmed3f(d, -448.f, 448.f);
    int p = __builtin_amdgcn_cvt_pk_fp8_f32(a, b, 0, false); p = __builtin_amdgcn_cvt_pk_fp8_f32(c, d, p, true); return (unsigned)p; }
#ifndef MOE_F8
#define MOE_F8 1
#endif
constexpr int SCALE_ONE = 0x7f7f7f7f, SCALE_W = 0x79797979  , SCALE_HID = 0x7c7c7c7c  ;
DI float sigmoidf_(float x) { return __builtin_amdgcn_rcpf(1.f + __expf(-x)); }
DI float siluf_(float x) { return x * __builtin_amdgcn_rcpf(1.f + __expf(-x)); }
#define MFMA32(a, b, c) __builtin_amdgcn_mfma_f32_32x32x16_bf16((a), (b), (c), 0, 0, 0)

#define XB_TMO      128
#define XB_XCNT(j)  (256  + 64 * (j))
#define XB_XSUB(j)  (1280 + 64 * (j))
#define XB_XGEN(j)  (2304 + 64 * (j))
#define XB_TOP      3328
#define XB_TOPGEN   3392
#define XCD_BAR_WORDS 3456
#define XB_SPIN_CAP (1u << 22)
__device__ __forceinline__ unsigned xb_ld(unsigned* p)              { return __hip_atomic_load(p, __ATOMIC_RELAXED, __HIP_MEMORY_SCOPE_AGENT); }
__device__ __forceinline__ unsigned xb_add(unsigned* p, unsigned v) { return __hip_atomic_fetch_add(p, v, __ATOMIC_RELAXED, __HIP_MEMORY_SCOPE_AGENT); }
__device__ __forceinline__ unsigned xb_xcc_id() { return (unsigned)__builtin_amdgcn_s_getreg((3 << 11) | 20) & 0xFu; }
#define XB_SPIN(cond, bar) do { unsigned _sp = 0; while (cond) { __builtin_amdgcn_s_sleep(1); \
    if ((++_sp & 255u) == 0u) { if (xb_ld(&(bar)[XB_TMO])) break; if (_sp > XB_SPIN_CAP) { atomicAdd(&(bar)[XB_TMO], 1u); break; } } } } while (0)
struct XcdBarrier { unsigned* bar; unsigned x; volatile LAS unsigned* st; };
__device__ __forceinline__ XcdBarrier xcd_barrier_post(unsigned* bar, volatile LAS unsigned* st, bool leader) {
    XcdBarrier b; b.bar = bar; b.x = xb_xcc_id(); b.st = st;
    if (leader) (void)xb_add(&bar[XB_XCNT(b.x)], 1u);
    return b;
}
__device__ __forceinline__ void xcd_barrier_complete(unsigned* bar, unsigned x, unsigned& nloc, unsigned& nx) {
    const unsigned G = gridDim.x * gridDim.y * gridDim.z;
    unsigned sum, cnt, mine, sp = 0u;
    for (;;) {
        sum = 0u; cnt = 0u; mine = 0u;
#pragma unroll
        for (unsigned j = 0; j < 16; ++j) { const unsigned c = xb_ld(&bar[XB_XCNT(j)]); sum += c; cnt += (c > 0u) ? 1u : 0u; mine = (j == x) ? c : mine; }
        if (sum == G) break;
        __builtin_amdgcn_s_sleep(1);
        if ((++sp & 255u) == 0u) { if (xb_ld(&bar[XB_TMO])) break; if (sp > XB_SPIN_CAP) { atomicAdd(&bar[XB_TMO], 1u); break; } }
    }
    nloc = mine > 0u ? mine : 1u; nx = cnt > 0u ? cnt : 1u;
}
__device__ __forceinline__ void xcd_barrier(const XcdBarrier& b, bool leader) {
    asm volatile("s_waitcnt vmcnt(0)" ::: "memory");
    __syncthreads();
    if (leader) {
        unsigned* bar = b.bar;
        __builtin_amdgcn_s_waitcnt(0);
        unsigned nloc = b.st[0], nx = b.st[1];
        if (nloc == 0u) { xcd_barrier_complete(bar, b.x, nloc, nx); b.st[0] = nloc; b.st[1] = nx; }
        const unsigned old = xb_add(&bar[XB_XSUB(b.x)], 1u);
        const unsigned gen = old / nloc;
        if (old + 1u == (gen + 1u) * nloc) {
            __builtin_amdgcn_fence(__ATOMIC_RELEASE, "agent");
            asm volatile("s_waitcnt vmcnt(0)" ::: "memory");
            const unsigned og = xb_add(&bar[XB_TOP], 1u);
            const unsigned tg = og / nx;
            if (og + 1u == (tg + 1u) * nx) xb_add(&bar[XB_TOPGEN], 1u);
            else XB_SPIN(xb_ld(&bar[XB_TOPGEN]) == tg, bar);
            __builtin_amdgcn_fence(__ATOMIC_ACQUIRE, "agent");
            xb_add(&bar[XB_XGEN(b.x)], 1u);
            asm volatile("s_waitcnt vmcnt(0)" ::: "memory");
        } else {
            XB_SPIN(xb_ld(&bar[XB_XGEN(b.x)]) == gen, bar);
            __builtin_amdgcn_fence(__ATOMIC_ACQUIRE, "agent");
            asm volatile("s_waitcnt vmcnt(0)" ::: "memory");
        }
    }
    __syncthreads();
}

struct Ctx { LAS unsigned char* lds; int tid, lane, wave, bid, nb, vcu; };
struct Args { const float* in[40]; float* out; unsigned char* ws; int ph_lo, ph_hi; };
enum { I_X = 0, I_C, I_CTX, I_CCTX, I_ADAW, I_ADAB, I_N1G, I_N2G, I_EVWIN, I_EVWOUT, I_QNORM, I_WUQ, I_KVNORM, I_WUKV, I_QG, I_KG, I_DWW, I_DWB, I_LNG, I_LNB,
       I_ODWIN, I_ODWOUT, I_SHIFTW, I_W0, I_W2L, I_A0, I_A2, I_G2, I_KKW, I_KA, I_RK, I_GNG, I_GNB, I_NAQG, I_NAKG, I_RPB, I_ROUTER, I_MW1, I_MW3, I_MW2 };

DI void transpose_item(const float* __restrict__ W, int K, int N, bf16* __restrict__ WT, int dst_row0, const float* __restrict__ gain, LAS float* scr, int k0, int n0, int lane) {
#pragma unroll 8
    for (int i = 0; i < 32; ++i) { const int kk = 2 * i + (lane >> 5); float v = W[(size_t)(k0 + kk) * N + n0 + (lane & 31)]; if (gain) v *= gain[k0 + kk]; scr[kk * 33 + (lane & 31)] = v; }
    asm volatile("s_waitcnt lgkmcnt(0)" ::: "memory");
    const int c = lane & 7;
#pragma unroll
    for (int j = 0; j < 4; ++j) { const int n = (lane >> 3) + 8 * j; const LAS float* s = scr + (8 * c) * 33 + n;
        u32x4 o; o.x = pk2(s[0 * 33], s[1 * 33]); o.y = pk2(s[2 * 33], s[3 * 33]); o.z = pk2(s[4 * 33], s[5 * 33]); o.w = pk2(s[6 * 33], s[7 * 33]);
        *(u32x4*)(WT + (size_t)(dst_row0 + n) * K + k0 + 8 * c) = o; }
    asm volatile("s_waitcnt lgkmcnt(0)" ::: "memory");
}
DI void transpose_item64(const float* __restrict__ W, int K, int N, bf16* __restrict__ WT, int dst_row0, LAS float* scr, int k0, int n0, int lane) {
    f32x4 v[16];
#pragma unroll
    for (int i = 0; i < 16; ++i) v[i] = *(const f32x4*)(W + (size_t)(k0 + 4 * i + (lane >> 4)) * N + n0 + 4 * (lane & 15));
#pragma unroll
    for (int i = 0; i < 16; ++i) { LAS float* d = scr + (4 * i + (lane >> 4)) * 65 + 4 * (lane & 15); d[0] = v[i].x; d[1] = v[i].y; d[2] = v[i].z; d[3] = v[i].w; }
    asm volatile("s_waitcnt lgkmcnt(0)" ::: "memory");
    const int c = lane & 7;
#pragma unroll
    for (int j = 0; j < 8; ++j) { const int n = (lane >> 3) + 8 * j; const LAS float* s = scr + (8 * c) * 65 + n;
        u32x4 o; o.x = pk2(s[0 * 65], s[1 * 65]); o.y = pk2(s[2 * 65], s[3 * 65]); o.z = pk2(s[4 * 65], s[5 * 65]); o.w = pk2(s[6 * 65], s[7 * 65]);
        *(u32x4*)(WT + (size_t)(dst_row0 + n) * K + k0 + 8 * c) = o; }
    asm volatile("s_waitcnt lgkmcnt(0)" ::: "memory");
}
DI void transpose_item64_f8(const float* __restrict__ W, int K, int N, unsigned char* __restrict__ WT8, int dst_row0, LAS float* scr, int k0, int n0, int lane) {
    f32x4 v[16];
#pragma unroll
    for (int i = 0; i < 16; ++i) v[i] = *(const f32x4*)(W + (size_t)(k0 + 4 * i + (lane >> 4)) * N + n0 + 4 * (lane & 15));
#pragma unroll
    for (int i = 0; i < 16; ++i) { LAS float* d = scr + (4 * i + (lane >> 4)) * 65 + 4 * (lane & 15); d[0] = v[i].x; d[1] = v[i].y; d[2] = v[i].z; d[3] = v[i].w; }
    asm volatile("s_waitcnt lgkmcnt(0)" ::: "memory");
    const int c = lane & 7;
#pragma unroll
    for (int j = 0; j < 8; ++j) { const int n = (lane >> 3) + 8 * j; const LAS float* s = scr + (8 * c) * 65 + n;
        u32x2 o; o.x = pk4_fp8(64.f * s[0 * 65], 64.f * s[1 * 65], 64.f * s[2 * 65], 64.f * s[3 * 65]); o.y = pk4_fp8(64.f * s[4 * 65], 64.f * s[5 * 65], 64.f * s[6 * 65], 64.f * s[7 * 65]);
        *(u32x2*)(WT8 + (size_t)(dst_row0 + n) * K + k0 + 8 * c) = o; }
    asm volatile("s_waitcnt lgkmcnt(0)" ::: "memory");
}
DI void transpose_matrix(const Ctx& C, const float* W, int K, int N, bf16* WT, const float* gain, int mode  ) {
    LAS float* scr = (LAS float*)(C.lds + C.wave * 8704);
    const int nkb = K / 64, nnb = N / 32, nit = nkb * nnb, gw = C.vcu * 8 + C.wave, ngw = C.nb * 8;
    for (int it = gw; it < nit; it += ngw) {
        const int kb = it / nnb, nbk = it % nnb, n0 = nbk * 32;
        int d0 = n0; if (mode) d0 = (n0 >> 7) * 256 + (n0 & 127) + (mode == 2 ? 128 : 0);
        transpose_item(W, K, N, WT, d0, gain, scr, kb * 64, n0, C.lane);
    }
}
DI void moe_weight_prep(const Ctx& C, const float* w1, const float* w3, const float* w2, bf16* W13, bf16* W2) {
    LAS float* scr = (LAS float*)(C.lds + C.wave * 16640);
    const int gw = C.vcu * 8 + C.wave, ngw = C.nb * 8;
    constexpr int PER = 16 * 16;
    for (int it = gw; it < NEXP * 3 * PER; it += ngw) {
        const int e = it / (3 * PER), r = it % (3 * PER), which = r / PER, q = r % PER, kb = q / 16, n0 = (q % 16) * 64;
        if (which == 0)      transpose_item64(w1 + (size_t)e * DM * DM, DM, DM, W13 + (size_t)e * 2048 * DM, (n0 >> 7) * 256 + (n0 & 127), scr, kb * 64, n0, C.lane);
        else if (which == 1) transpose_item64(w3 + (size_t)e * DM * DM, DM, DM, W13 + (size_t)e * 2048 * DM, (n0 >> 7) * 256 + (n0 & 127) + 128, scr, kb * 64, n0, C.lane);
        else                 transpose_item64(w2 + (size_t)e * DM * DM, DM, DM, W2 + (size_t)e * DM * DM, n0, scr, kb * 64, n0, C.lane);
    }
}

DI void ph_prologue(const Ctx& C, const Args& a) {
    unsigned char* ws = a.ws;
    {
        LAS float* sv = (LAS float*)C.lds;
        LAS float* red = sv + 9 * 1024;
        for (int i = C.tid; i < 9 * 1024; i += 512) { const int m = i >> 10, k = i & 1023; const float c = (m < 8) ? a.in[I_C][m * 1024 + k] : a.in[I_CCTX][k]; sv[i] = siluf_(c); }
        __syncthreads();
        float* MOD = (float*)(ws + WS_MOD);
        for (int it = C.bid; it < 4 * 96; it += C.nb) {
            const int layer = it / 96, col = (it % 96) * 64 + C.lane;
            const float* wp = a.in[I_ADAW] + (size_t)layer * 1024 * 6144 + col;
            float acc[9];
#pragma unroll
            for (int m = 0; m < 9; ++m) acc[m] = 0.f;
            const int kb = C.wave * 128;
#pragma unroll 4
            for (int k = 0; k < 128; ++k) { const float w = wp[(size_t)(kb + k) * 6144];
#pragma unroll
                for (int m = 0; m < 9; ++m) acc[m] += sv[m * 1024 + kb + k] * w; }
#pragma unroll
            for (int m = 0; m < 9; ++m) red[(C.wave * 9 + m) * 64 + C.lane] = acc[m];
            __syncthreads();
            for (int i = C.tid; i < 576; i += 512) { const int m = i >> 6, l = i & 63; float s = 0.f;
#pragma unroll
                for (int w = 0; w < 8; ++w) s += red[(w * 9 + m) * 64 + l];
                const int cc = (it % 96) * 64 + l;
                MOD[(size_t)(layer * 9 + m) * 6144 + cc] = s + a.in[I_ADAB][layer * 6144 + cc]; }
            __syncthreads();
        }
    }
    {
        f32x2* CS = (f32x2*)(ws + WS_ROPE);
        for (int i = C.bid * 512 + C.tid; i < 4096 * 16; i += C.nb * 512) {
            const int pos = i >> 4, j = i & 15, f = j & 7;
            const float inv = powf(10000.f, -(float)(2 * f) / 16.f);
            const float ang = (float)((j < 8) ? (pos >> 6) : (pos & 63)) * inv;
            const double tw = 6.283185307179586476925;
            const double x = (double)ang, n = __builtin_rint(x / tw), rr = x - n * tw;
            CS[i] = (f32x2){__cosf((float)rr), __sinf((float)rr)};
        }
    }
    for (int j = 0; j < 2; ++j) {
        transpose_matrix(C, a.in[I_EVWIN] + (size_t)j * DM * EV_IN, DM, EV_IN, (bf16*)(ws + WS_WEVIN) + (size_t)j * EV_INP * DM, nullptr, 0);
        transpose_matrix(C, a.in[I_EVWOUT] + (size_t)j * DM * DM, DM, DM, (bf16*)(ws + WS_WEVOUT) + (size_t)j * DM * DM, nullptr, 0);
        transpose_matrix(C, a.in[I_WUQ] + (size_t)j * 384 * 768, 384, 768, (bf16*)(ws + WS_WUQ) + (size_t)j * 768 * 384, a.in[I_QNORM] + j * 384, 0);
        transpose_matrix(C, a.in[I_WUKV] + (size_t)j * 256 * 1024, 256, 1024, (bf16*)(ws + WS_WUKV) + (size_t)j * 1024 * 256, a.in[I_KVNORM] + j * 256, 0);
        transpose_matrix(C, a.in[I_ODWIN] + (size_t)j * DM * OD_IN, DM, OD_IN, (bf16*)(ws + WS_WODIN) + (size_t)j * OD_INP * DM, nullptr, 0);
        transpose_matrix(C, a.in[I_ODWOUT] + (size_t)j * DM * DM, DM, DM, (bf16*)(ws + WS_WODOUT) + (size_t)j * DM * DM, nullptr, 0);
    }
    {
        const int gt = C.bid * 512 + C.tid, ngt = C.nb * 512;
        for (int j = 0; j < 2; ++j) {
            u32x4* p0 = (u32x4*)((bf16*)(ws + WS_WEVIN) + (size_t)j * EV_INP * DM + (size_t)EV_IN * DM);
            for (int i = gt; i < (EV_INP - EV_IN) * DM / 8; i += ngt) p0[i] = (u32x4){0u, 0u, 0u, 0u};
            u32x4* p1 = (u32x4*)((bf16*)(ws + WS_WODIN) + (size_t)j * OD_INP * DM + (size_t)OD_IN * DM);
            for (int i = gt; i < (OD_INP - OD_IN) * DM / 8; i += ngt) p1[i] = (u32x4){0u, 0u, 0u, 0u};
            bf16* WL = (bf16*)(ws + WS_WLORA) + (size_t)j * 655360;
            const float* w2 = a.in[I_W2L] + (size_t)j * 2 * 64 * 512; const float* a2 = a.in[I_A2] + (size_t)j * 2 * 64 * 512; const float* g2 = a.in[I_G2] + (size_t)j * 128 * 512;
            for (int i = gt; i < 655360; i += ngt) {
                const int n = i >> 8, k = i & 255; float v = 0.f;
                if (n < 1024) { const int d = n >> 9, c = n & 511; if (k >= d * 64 && k < d * 64 + 64) v = w2[(size_t)k * 512 + c]; }
                else if (n < 2048) { const int d = (n - 1024) >> 9, c = n & 511; if (k >= 128 + d * 64 && k < 192 + d * 64) v = a2[(size_t)(k - 128) * 512 + c]; }
                else { const int c = n - 2048; if (k >= 128) v = g2[(size_t)(k - 128) * 512 + c]; }
                WL[i] = f2bf(v);
            }
        }
    }
}

template <bool ROUTER>
DI void ph_norm(const Ctx& C, const float* xlat, const float* xctx, const float* gain, const float* mod  , int shift_off, int scale_off, bf16* H,
                const float* router  , float* AFFT, float* AFFC, int* SLOT) {
    LAS float* RT = (LAS float*)C.lds;
    if (ROUTER) { for (int i = C.tid; i < 16384; i += 512) { const int c = i >> 4, e = i & 15; RT[e * 1024 + c] = router[i]; } __syncthreads(); }
    const int gw = C.bid * 8 + C.wave, ngw = C.nb * 8, lane = C.lane;
    for (int row = gw; row < MT; row += ngw) {
        const float* xr = row < NLAT ? xlat + (size_t)row * DM : xctx + (size_t)(row - NLAT) * DM;
        const int mi = row < NLAT ? (row >> 12) : 8;
        const float* mp = mod + mi * 6144;
        f32x4 v[4]; float ss = 0.f;
#pragma unroll
        for (int j = 0; j < 4; ++j) { v[j] = *(const f32x4*)(xr + 256 * j + 4 * lane); ss += v[j].x * v[j].x + v[j].y * v[j].y + v[j].z * v[j].z + v[j].w * v[j].w; }
        ss = wave_sum(ss);
        const float rs = 1.0f / sqrtf(ss * (1.f / 1024.f) + EPS);
#pragma unroll
        for (int j = 0; j < 4; ++j) {
            const int c = 256 * j + 4 * lane;
            const f32x4 g = *(const f32x4*)(gain + c), sc = *(const f32x4*)(mp + scale_off + c), sh = *(const f32x4*)(mp + shift_off + c);
            v[j] = (v[j] * rs) * g * (sc + 1.0f) + sh;
            if (ROUTER && MOE_F8) *(unsigned*)((unsigned char*)H + (size_t)row * DM + c) = pk4_fp8(v[j].x, v[j].y, v[j].z, v[j].w);
            else *(u32x2*)(H + (size_t)row * DM + c) = (u32x2){pk2(v[j].x, v[j].y), pk2(v[j].z, v[j].w)};
        }
        if (ROUTER) {
            float mylg = 0.f;
#pragma unroll 1
            for (int e = 0; e < 16; ++e) { float p = 0.f;
#pragma unroll
                for (int j = 0; j < 4; ++j) { const f32x4 w = *(const LAS f32x4*)(RT + e * 1024 + 256 * j + 4 * lane); p += v[j].x * w.x + v[j].y * w.y + v[j].z * w.z + v[j].w * w.w; }
                p = wave_sum(p); mylg = (lane == e) ? p : mylg; }
            const float mx = max16(mylg);
            const float ex = expf(mylg - mx);
            const float mine = ex / sum16(ex);
            if (lane < 16) {
                if (row < NLAT) AFFT[(size_t)((row >> 12) * 16 + lane) * TL + (row & 4095)] = mine;
                else { const int rc = row - NLAT; AFFC[(size_t)((rc >> 8) * 16 + lane) * LCX + (rc & 255)] = mine; }
                SLOT[(size_t)row * 16 + lane] = -1;
            }
        }
    }
}

template <class Epi>
DI void gemm_unit(const bf16* __restrict__ A, int lda, const int* __restrict__ rows, const bf16* __restrict__ Bt, int K, int pm, int pn, const Epi& E, int wave, int lane) {
    const int wr = wave >> 2, wc = wave & 3, r = lane & 31, h = lane >> 5;
    const bf16* ap[2][2]; const bf16* bp[2];
#pragma unroll
    for (int ai = 0; ai < 2; ++ai)
#pragma unroll
        for (int mm = 0; mm < 2; ++mm) { const int lr = 256 * pm + 128 * ai + 64 * wr + 32 * mm + r; const int gr = rows ? rows[lr] : lr; ap[ai][mm] = A + (size_t)gr * lda + 8 * h; }
#pragma unroll
    for (int bj = 0; bj < 2; ++bj) bp[bj] = Bt + (size_t)(256 * pn + 128 * bj + 32 * wc + r) * K + 8 * h;
    f32x16 acc[2][2][2];
#pragma unroll
    for (int ai = 0; ai < 2; ++ai)
#pragma unroll
        for (int mm = 0; mm < 2; ++mm)
#pragma unroll
            for (int bj = 0; bj < 2; ++bj)
#pragma unroll
                for (int i = 0; i < 16; ++i) acc[ai][mm][bj][i] = 0.f;
#pragma unroll 2
    for (int k0 = 0; k0 < K; k0 += 16) {
        bf16x8 af[2][2], bfr[2];
#pragma unroll
        for (int ai = 0; ai < 2; ++ai)
#pragma unroll
            for (int mm = 0; mm < 2; ++mm) af[ai][mm] = *(const bf16x8*)(ap[ai][mm] + k0);
#pragma unroll
        for (int bj = 0; bj < 2; ++bj) bfr[bj] = *(const bf16x8*)(bp[bj] + k0);
#pragma unroll
        for (int ai = 0; ai < 2; ++ai)
#pragma unroll
            for (int mm = 0; mm < 2; ++mm)
#pragma unroll
                for (int bj = 0; bj < 2; ++bj) acc[ai][mm][bj] = MFMA32(bfr[bj], af[ai][mm], acc[ai][mm][bj]);
    }
#pragma unroll
    for (int ai = 0; ai < 2; ++ai)
#pragma unroll
        for (int mm = 0; mm < 2; ++mm) {
            const int row = 256 * pm + 128 * ai + 64 * wr + 32 * mm + r;
#pragma unroll
            for (int g = 0; g < 4; ++g) {
                const int col = 256 * pn + 32 * wc + 8 * g + 4 * h;
                const f32x4 v0 = {acc[ai][mm][0][4 * g], acc[ai][mm][0][4 * g + 1], acc[ai][mm][0][4 * g + 2], acc[ai][mm][0][4 * g + 3]};
                const f32x4 v1 = {acc[ai][mm][1][4 * g], acc[ai][mm][1][4 * g + 1], acc[ai][mm][1][4 * g + 2], acc[ai][mm][1][4 * g + 3]};
                E(row, col, v0, v1);
            }
        }
}
template <class Epi>
DI void gemm_phase(const Ctx& C, const bf16* A, int lda, const bf16* Bt, int K, int nM, int nN, const Epi& E) {
    for (int u = C.vcu; u < nM * nN; u += C.nb) gemm_unit(A, lda, nullptr, Bt, K, u / nN, u % nN, E, C.wave, C.lane);
}

struct EpiBf16 { bf16* O; int ldo;
    DI void operator()(int row, int col, f32x4 v0, f32x4 v1) const { bf16* p = O + (size_t)row * ldo + col;
        *(u32x2*)p = (u32x2){pk2(v0[0], v0[1]), pk2(v0[2], v0[3])}; *(u32x2*)(p + 128) = (u32x2){pk2(v1[0], v1[1]), pk2(v1[2], v1[3])}; } };
struct EpiF32 { float* O; int ldo;
    DI void operator()(int row, int col, f32x4 v0, f32x4 v1) const { float* p = O + (size_t)row * ldo + col; *(f32x4*)p = v0; *(f32x4*)(p + 128) = v1; } };
struct EpiResid { const float* xin_lat; const float* xin_ctx; float* xout_lat; float* xout_ctx; const float* modg;
    DI void operator()(int row, int col, f32x4 v0, f32x4 v1) const {
        const float* xi; float* xo; int mi;
        if (row < NLAT) { xi = xin_lat + (size_t)row * DM; xo = xout_lat + (size_t)row * DM; mi = row >> 12; }
        else { xi = xin_ctx + (size_t)(row - NLAT) * DM; xo = xout_ctx + (size_t)(row - NLAT) * DM; mi = 8; }
        const float* g = modg + mi * 6144 + col;
        const f32x4 g0 = *(const f32x4*)g, g1 = *(const f32x4*)(g + 128), x0 = *(const f32x4*)(xi + col), x1 = *(const f32x4*)(xi + col + 128);
        *(f32x4*)(xo + col) = x0 + g0 * v0; *(f32x4*)(xo + col + 128) = x1 + g1 * v1; } };
struct EpiGlu { bf16* O;
    DI void operator()(int row, int col, f32x4 v0, f32x4 v1) const { const int f = ((col & 2047) >> 8) * 128 + (col & 255);
        *(u32x2*)(O + (size_t)row * DM + f) = (u32x2){pk2(siluf_(v0[0]) * v1[0], siluf_(v0[1]) * v1[1]), pk2(siluf_(v0[2]) * v1[2], siluf_(v0[3]) * v1[3])}; } };
struct EpiGlu8 { unsigned char* O;
    DI void operator()(int row, int col, f32x4 v0, f32x4 v1) const { const int f = ((col & 2047) >> 8) * 128 + (col & 255);
        *(unsigned*)(O + (size_t)row * DM + f) = pk4_fp8(8.f * siluf_(v0[0]) * v1[0], 8.f * siluf_(v0[1]) * v1[1], 8.f * siluf_(v0[2]) * v1[2], 8.f * siluf_(v0[3]) * v1[3]); } };
struct EpiGate { bf16* O; const float* gate;
    DI void operator()(int row, int col, f32x4 v0, f32x4 v1) const { const float g = gate[row]; bf16* p = O + (size_t)row * DM + (col & 1023);
        *(u32x2*)p = (u32x2){pk2(v0[0] * g, v0[1] * g), pk2(v0[2] * g, v0[3] * g)}; *(u32x2*)(p + 128) = (u32x2){pk2(v1[0] * g, v1[1] * g), pk2(v1[2] * g, v1[3] * g)}; } };
struct EpiLoraW { float* W; const float* w0;
    DI void one(int row, int col, f32x4 v) const { const int d = col >> 9, c = col & 511; f32x4 o;
#pragma unroll
        for (int e = 0; e < 4; ++e) { const float lw = w0[col + e] + v[e]; const float z = -lw; const float sp = fmaxf(z, 0.f) + __logf(1.f + __expf(-fabsf(z))); o[e] = -__expf(-sp - 0.5f); }
        *(f32x4*)(W + ((size_t)d * MT + row) * 512 + c) = o; }
    DI void operator()(int row, int col, f32x4 v0, f32x4 v1) const { one(row, col, v0); one(row, col + 128, v1); } };
struct EpiLoraA { bf16* Aout; const float* a0;
    DI void one(int row, int col, f32x4 v) const { const int d = col >> 9, c = col & 511; const f32x4 b = *(const f32x4*)(a0 + col);
        *(u32x2*)(Aout + ((size_t)d * MT + row) * 512 + c) = (u32x2){pk2(sigmoidf_(b[0] + v[0]), sigmoidf_(b[1] + v[1])), pk2(sigmoidf_(b[2] + v[2]), sigmoidf_(b[3] + v[3]))}; }
    DI void operator()(int row, int col, f32x4 v0, f32x4 v1) const { one(row, col, v0); one(row, col + 128, v1); } };

namespace pg8 {
constexpr int BM = 256, BK = 64, HALF = 128, HTB = HALF * BK * 2, STAGE_BYTES = 8 * HTB;
DI int lds_byte(int r, int c) { const int st = (r >> 4) * 2 + (c >> 5), rr = r & 15, cc = c & 31, ob = rr * 64 + cc * 2; return st * 1024 + (ob ^ (((ob >> 9) & 1) << 5)); }
DI void stage_rc(int b, int& R, int& C) { const int st = b / 1024, sb = b % 1024, swz = sb ^ (((sb >> 9) & 1) << 5); R = (st >> 1) * 16 + swz / 64; C = (st & 1) * 32 + (swz % 64) / 2; }
DI int perm32(int rho) { const int n = rho >> 4, i = rho & 15; return 8 * (i >> 2) + 4 * n + (i & 3); }
struct Unit { int pm, pn; };
struct Gemm { const bf16* A; const bf16* Bt; int lda, K; const int* rows; int scale_w = 0x7f7f7f7f, scale_a = 0x7f7f7f7f; };
struct OrderMN { int nM, nN, G, c;
    DI bool next(int i, Unit& u) const { const int L = i * G + c; if (L >= nM * nN) return false; u.pm = L / nN; u.pn = L % nN; return true; } };
struct OrderMoE { int nMt, nN, mstride  , G, c;
    DI bool next(int i, Unit& u) const { const int L = i * G + c, per = nMt * nN; if (L >= NEXP * per) return false; const int e = L / per, q = L % per; u.pm = e * mstride + q / nN; u.pn = e * nN + q % nN; return true; } };
template <class E4> struct EpiAdapt { E4 e;
    DI void operator()(const f32x4 (&acc)[2][2][4][2], const Unit& u, int wr, int wc, int fr, int fq) const {
#pragma unroll
        for (int ai = 0; ai < 2; ++ai)
#pragma unroll
            for (int m = 0; m < 4; ++m) { const int row = u.pm * BM + ai * HALF + wr * 64 + m * 16 + fr;
#pragma unroll
                for (int n = 0; n < 2; ++n) e(row, u.pn * BM + wc * 32 + 8 * fq + 4 * n, acc[ai][0][m][n], acc[ai][1][m][n]); } } };

template <class Epi, class Sched, bool F8 = false>
DI void gemm_phase(LAS unsigned char* lds, const Gemm g, const Sched& S, const Epi& E, const int tid) {
    const int wid = __builtin_amdgcn_readfirstlane(tid >> 6), lane = tid & 63, wr = wid >> 2, wc = wid & 3, fr = lane & 15, fq = lane >> 4;
    const int K = g.K, nt = K / BK;
    unsigned voffB[2];
#pragma unroll
    for (int i = 0; i < 2; ++i) { int R, C; stage_rc(tid * 16 + i * 8192, R, C); const int Rb = (R & ~31) + perm32(R & 31); voffB[i] = (unsigned)(Rb * K + C) * 2u; }
    const size_t kstep = (size_t)(BK * 2), hstep = (size_t)HALF * K * 2, tstep = 2 * hstep;
    const unsigned ldsw = (unsigned)wid * 1024u;
    const int aoff = lds_byte(wr * 64 + fr, fq * 8), boff = lds_byte(wc * 32 + fr, fq * 8);
    const char* const gA = (const char*)g.A;
#define PG8_SA(b, h) (((b) * 2 + (h)) * HTB)
#define PG8_SB(b, h) ((4 + (b) * 2 + (h)) * HTB)
#define PG8_STAGE(bufoff, gbase, voff) do { _Pragma("unroll") for (int _i = 0; _i < 2; ++_i) \
        __builtin_amdgcn_global_load_lds((const unsigned*)((const char*)(gbase) + (voff)[_i]), (LAS unsigned*)(lds + (bufoff) + ldsw + _i * 8192), 16, 0, 0); } while (0)
#define PG8_LDA(dst, b, h) do { _Pragma("unroll") for (int m = 0; m < 4; ++m) _Pragma("unroll") for (int k = 0; k < 2; ++k) dst[m][k] = *(const LAS bf16x8*)(lds + PG8_SA(b, h) + aoff + m * 2048 + k * 1024); } while (0)
#define PG8_LDB(dst, b, h) do { _Pragma("unroll") for (int n = 0; n < 2; ++n) _Pragma("unroll") for (int k = 0; k < 2; ++k) dst[n][k] = *(const LAS bf16x8*)(lds + PG8_SB(b, h) + boff + n * 2048 + k * 1024); } while (0)
#define PG8_MMA(ai, bj, At, Bt) do { __builtin_amdgcn_s_setprio(1); _Pragma("unroll") for (int m = 0; m < 4; ++m) _Pragma("unroll") for (int n = 0; n < 2; ++n) { \
        if constexpr (F8) { const v8i_t w8 = __builtin_shufflevector(__builtin_bit_cast(i32x4_t, Bt[n][0]), __builtin_bit_cast(i32x4_t, Bt[n][1]), 0, 1, 2, 3, 4, 5, 6, 7), x8 = __builtin_shufflevector(__builtin_bit_cast(i32x4_t, At[m][0]), __builtin_bit_cast(i32x4_t, At[m][1]), 0, 1, 2, 3, 4, 5, 6, 7); \
            acc[ai][bj][m][n] = __builtin_amdgcn_mfma_scale_f32_16x16x128_f8f6f4(w8, x8, acc[ai][bj][m][n], 0, 0, 0, g.scale_w, 0, g.scale_a); } \
        else { _Pragma("unroll") for (int k = 0; k < 2; ++k) acc[ai][bj][m][n] = __builtin_amdgcn_mfma_f32_16x16x32_bf16(Bt[n][k], At[m][k], acc[ai][bj][m][n], 0, 0, 0); } } __builtin_amdgcn_s_setprio(0); } while (0)
#define PG8_WAIT_V(n) asm volatile("s_waitcnt vmcnt(" #n ")" ::: "memory")
#define PG8_WAIT_L(n) asm volatile("s_waitcnt lgkmcnt(" #n ")" ::: "memory")
#define PG8_BAR __builtin_amdgcn_s_barrier()
#define PG8_SCHED __builtin_amdgcn_sched_barrier(0)
#define PG8_ROWIDX(ri, u) do { _Pragma("unroll") for (int _h = 0; _h < 2; ++_h) _Pragma("unroll") for (int _i = 0; _i < 2; ++_i) { int _R, _C; stage_rc(tid * 16 + _i * 8192, _R, _C); (void)_C; \
        const int _lr = (u).pm * BM + _h * HALF + _R; ri[_h][_i] = g.rows ? g.rows[_lr] : _lr; } } while (0)
#define PG8_AOFF_FROM(vo, ri) do { _Pragma("unroll") for (int _h = 0; _h < 2; ++_h) _Pragma("unroll") for (int _i = 0; _i < 2; ++_i) { int _R, _C; stage_rc(tid * 16 + _i * 8192, _R, _C); (void)_R; \
        vo[_h][_i] = (unsigned)(((size_t)ri[_h][_i] * g.lda + _C) * 2u); } } while (0)
    Unit cur, nxt; int ui = 0;
    if (!S.next(0, cur)) return;
    f32x4 acc[2][2][4][2];
#pragma unroll
    for (int a = 0; a < 2; ++a)
#pragma unroll
        for (int b = 0; b < 2; ++b)
#pragma unroll
            for (int m = 0; m < 4; ++m)
#pragma unroll
                for (int n = 0; n < 2; ++n) acc[a][b][m][n] = (f32x4){0.f, 0.f, 0.f, 0.f};
    bf16x8 At[4][2], B0[2][2], B1[2][2];
    unsigned cvo[2][2]; int nri[2][2];
    PG8_ROWIDX(nri, cur); PG8_AOFF_FROM(cvo, nri);
    const char* cB = (const char*)g.Bt + (size_t)cur.pn * tstep;
    PG8_STAGE(PG8_SB(0, 0), cB, voffB); PG8_STAGE(PG8_SB(0, 1), cB + hstep, voffB); PG8_STAGE(PG8_SA(0, 0), gA, cvo[0]); PG8_STAGE(PG8_SA(0, 1), gA, cvo[1]);
    if (wr == 1) PG8_BAR;
    PG8_WAIT_V(2); PG8_BAR;
    PG8_STAGE(PG8_SB(1, 0), cB + kstep, voffB); PG8_STAGE(PG8_SA(1, 0), gA + kstep, cvo[0]); PG8_STAGE(PG8_SB(1, 1), cB + hstep + kstep, voffB);
    PG8_WAIT_V(6); PG8_BAR;
    for (;;) {
        const bool has_next = S.next(ui + 1, nxt);
        const char* nB = has_next ? (const char*)g.Bt + (size_t)nxt.pn * tstep : cB;
#pragma nounroll
        for (int t = 0; t < nt; t += 2) {
            const bool last = (t == nt - 2);
            const char* a1 = gA + (size_t)(t + 1) * kstep;
            const char* a2 = last ? gA : gA + (size_t)(t + 2) * kstep; const char* b2 = last ? nB : cB + (size_t)(t + 2) * kstep;
            const char* a3 = a2 + kstep; const char* b3 = b2 + kstep;
            if (t == nt - 4 && has_next) PG8_ROWIDX(nri, nxt);
            PG8_LDB(B0, 0, 0); PG8_LDB(B1, 0, 1); PG8_SCHED; PG8_LDA(At, 0, 0); PG8_STAGE(PG8_SA(1, 1), a1, cvo[1]);
            if (last && has_next) { if (nt < 4) PG8_ROWIDX(nri, nxt); PG8_AOFF_FROM(cvo, nri); }
            PG8_WAIT_V(8); PG8_WAIT_L(0); PG8_BAR; PG8_MMA(0, 0, At, B0); PG8_MMA(0, 1, At, B1); PG8_BAR; PG8_SCHED;
            PG8_LDA(At, 0, 1); PG8_STAGE(PG8_SB(0, 0), b2, voffB); PG8_STAGE(PG8_SB(0, 1), b2 + hstep, voffB); PG8_STAGE(PG8_SA(0, 0), a2, cvo[0]);
            PG8_WAIT_V(8); PG8_WAIT_L(0); PG8_BAR; PG8_MMA(1, 0, At, B0); PG8_MMA(1, 1, At, B1); PG8_BAR; PG8_SCHED;
            PG8_LDB(B0, 1, 0); PG8_LDB(B1, 1, 1); PG8_SCHED; PG8_LDA(At, 1, 0); PG8_STAGE(PG8_SA(0, 1), a2, cvo[1]);
            PG8_WAIT_V(8); PG8_WAIT_L(0); PG8_BAR; PG8_MMA(0, 0, At, B0); PG8_MMA(0, 1, At, B1); PG8_BAR; PG8_SCHED;
            PG8_LDA(At, 1, 1); PG8_STAGE(PG8_SB(1, 0), b3, voffB); PG8_STAGE(PG8_SB(1, 1), b3 + hstep, voffB); PG8_STAGE(PG8_SA(1, 0), a3, cvo[0]);
            PG8_WAIT_V(8); PG8_WAIT_L(0); PG8_BAR; PG8_MMA(1, 0, At, B0); PG8_MMA(1, 1, At, B1); PG8_BAR; PG8_SCHED;
        }
        if (wr == 0) PG8_BAR;
        E(acc, cur, wr, wc, fr, fq);
        if (!has_next) break;
#pragma unroll
        for (int a = 0; a < 2; ++a)
#pragma unroll
            for (int b = 0; b < 2; ++b)
#pragma unroll
                for (int m = 0; m < 4; ++m)
#pragma unroll
                    for (int n = 0; n < 2; ++n) acc[a][b][m][n] = (f32x4){0.f, 0.f, 0.f, 0.f};
        cur = nxt; cB = nB; ++ui;
        if (wr == 1) PG8_BAR;
    }
    PG8_WAIT_V(0);
    PG8_BAR;
#undef PG8_SA
#undef PG8_SB
#undef PG8_STAGE
#undef PG8_LDA
#undef PG8_LDB
#undef PG8_MMA
#undef PG8_WAIT_V
#undef PG8_WAIT_L
#undef PG8_BAR
#undef PG8_SCHED
#undef PG8_ROWIDX
#undef PG8_AOFF_FROM
}
}
template <class E4> DI void fast_gemm(const Ctx& C, const bf16* A, int lda, const bf16* Bt, int K, int nM, int nN, const E4& e, bool rev = false) {
    pg8::Gemm g{A, Bt, lda, K, nullptr}; pg8::OrderMN S{nM, nN, C.nb, rev ? C.nb - 1 - C.vcu : C.vcu}; pg8::EpiAdapt<E4> E{e};
    pg8::gemm_phase(C.lds, g, S, E, C.tid);
}

DI float max16_acc(float m, const f32x16& x) {
    asm volatile("s_nop 15\n\tv_max3_f32 %0, %0, %1, %2\n\tv_max3_f32 %0, %0, %3, %4\n\tv_max3_f32 %0, %0, %5, %6\n\tv_max3_f32 %0, %0, %7, %8\n\tv_max3_f32 %0, %0, %9, %10\n\tv_max3_f32 %0, %0, %11, %12\n\tv_max3_f32 %0, %0, %13, %14\n\tv_max3_f32 %0, %0, %15, %16"
                 : "+v"(m) : "v"(x[0]), "v"(x[1]), "v"(x[2]), "v"(x[3]), "v"(x[4]), "v"(x[5]), "v"(x[6]), "v"(x[7]), "v"(x[8]), "v"(x[9]), "v"(x[10]), "v"(x[11]), "v"(x[12]), "v"(x[13]), "v"(x[14]), "v"(x[15]));
    return m; }
DI int swap23(int x) { return (x & ~12) | ((x & 4) << 1) | ((x & 8) >> 1); }
template <int DQK, bool NAT>
DI void flash_range(f32x16 (&o)[2], float& m, float& l, const bf16x8 (&qf)[DQK / 16], const bf16* __restrict__ Kb, const bf16* __restrict__ Vt, int pos0, int nblk, int r, int h,
                    const LAS float* tab, int qc, int cs, int drow0) {
    const int kr = swap23(r);
    for (int blk = 0; blk < nblk; ++blk) {
        const int pos = pos0 + 32 * blk;
        f32x16 s;
#pragma unroll
        for (int i = 0; i < 16; ++i) s[i] = 0.f;
        const bf16* kp = Kb + (size_t)(pos + kr) * DQK + 8 * h;
#pragma unroll
        for (int kk = 0; kk < DQK / 16; ++kk) s = MFMA32(*(const bf16x8*)(kp + 16 * kk), qf[kk], s);
        if (NAT) {
            const int irow = blk >> 1, cc0 = (blk & 1) * 32;
            const LAS float* trow = tab + (drow0 + irow) * 31;
#pragma unroll
            for (int i = 0; i < 16; ++i) {
                const int kib = (i & 3) | (((i >> 2) & 1) << 2) | (h << 3) | ((i >> 3) << 4);
                const int cc = cc0 + kib; const bool ok = (cc >= cs) && (cc < cs + 16);
                int dc = cc - qc + 15; dc = dc < 0 ? 0 : (dc > 30 ? 30 : dc);
                s[i] = ok ? s[i] + trow[dc] : -1e30f;
            }
        }
        float mx = s[0];
#pragma unroll
        for (int i = 1; i < 16; ++i) mx = fmaxf(mx, s[i]);
        mx = fmaxf(mx, xor32(mx, r + 32 * h));
        const float mn = fmaxf(m, mx), alpha = __builtin_amdgcn_exp2f(m - mn);
        float rs = 0.f; f32x16 p;
#pragma unroll
        for (int i = 0; i < 16; ++i) { float e = __builtin_amdgcn_exp2f(s[i] - mn); if (NAT) e = (s[i] > -1e29f) ? e : 0.f; p[i] = e; rs += e; }
        rs += xor32(rs, r + 32 * h);
        l = l * alpha + rs; m = mn;
#pragma unroll
        for (int i = 0; i < 16; ++i) { o[0][i] *= alpha; o[1][i] *= alpha; }
#pragma unroll
        for (int s2 = 0; s2 < 2; ++s2) {
            u32x4 pw; pw.x = pk2(p[8 * s2], p[8 * s2 + 1]); pw.y = pk2(p[8 * s2 + 2], p[8 * s2 + 3]); pw.z = pk2(p[8 * s2 + 4], p[8 * s2 + 5]); pw.w = pk2(p[8 * s2 + 6], p[8 * s2 + 7]);
            const bf16x8 pb = __builtin_bit_cast(bf16x8, pw);
#pragma unroll
            for (int dt = 0; dt < 2; ++dt) { const bf16x8 va = *(const bf16x8*)(Vt + (size_t)(32 * dt + r) * KPOS + pos + 16 * s2 + 8 * h); o[dt] = MFMA32(va, pb, o[dt]); }
        }
    }
}
DI void flash_store(const f32x16 (&o)[2], float l, bf16* orow  , int h) {
    const float inv = 1.f / l;
#pragma unroll
    for (int dt = 0; dt < 2; ++dt)
#pragma unroll
        for (int g = 0; g < 4; ++g)
            *(u32x2*)(orow + 32 * dt + 8 * g + 4 * h) = (u32x2){pk2(o[dt][4 * g] * inv, o[dt][4 * g + 1] * inv), pk2(o[dt][4 * g + 2] * inv, o[dt][4 * g + 3] * inv)};
}

DI void ph_attn_mla(const Ctx& C, const bf16* QB, const bf16* KB, const bf16* VT, bf16* OCAT, bool last) {
    const int r = C.lane & 31, h = C.lane >> 5;
    for (int u = C.vcu; u < 64 * 17; u += C.nb) {
        const int bh = u / 17, qblk = u % 17, b = bh >> 3, hh = bh & 7;
        if (last && qblk == 16) continue;
        const int qpos = qblk * 256 + 32 * C.wave + r;
        const bf16* qp = QB + ((size_t)bh * KPOS + qpos) * 96 + 8 * h;
        bf16x8 qf[6];
#pragma unroll
        for (int kk = 0; kk < 6; ++kk) qf[kk] = *(const bf16x8*)(qp + 16 * kk);
        f32x16 o[2];
#pragma unroll
        for (int i = 0; i < 16; ++i) { o[0][i] = 0.f; o[1][i] = 0.f; }
        float m = -1e30f, l = 0.f;
        flash_range<96, false>(o, m, l, qf, KB + (size_t)bh * KPOS * 96, VT + (size_t)bh * 64 * KPOS, qblk < 16 ? 0 : TL, qblk < 16 ? KPOS / 32 : LCX / 32, r, h, nullptr, 0, 0, 0);
        const int row = qblk < 16 ? b * TL + qpos : NLAT + b * LCX + (qpos - TL);
        flash_store(o, l, OCAT + (size_t)row * DM + hh * 64, h);
    }
}

template <int DQK> struct AttnGeo { static constexpr int KSTR = DQK * 2 + 16, KBYTES = 64 * KSTR, VSTR = 144, VBYTES = 64 * VSTR, BUF = KBYTES + VBYTES, KPIECES = 64 * DQK / 8; };
template <int DQK, bool NAT>
DI void attn_tile_loop(const Ctx& C, f32x16 (&o)[2], float& l, const bf16x8 (&qf)[DQK / 16], const bf16* __restrict__ Kb, const bf16* __restrict__ Vt, int pos1, int n1, int pos2, int n2,
                       const LAS float* tab, int grow, int rs, int qc, int cs) {
    typedef AttnGeo<DQK> G;
    const int tid = C.tid, r = C.lane & 31, h = C.lane >> 5, kr = swap23(r), ntiles = n1 + n2;
    constexpr bool K2 = G::KPIECES > 512;
    const int kq0 = tid, kq1 = tid + 512;
    const int kl0 = (kq0 / (DQK / 8)) * G::KSTR + (kq0 % (DQK / 8)) * 16, kl1 = (kq1 / (DQK / 8)) * G::KSTR + (kq1 % (DQK / 8)) * 16;
    const int vl = G::KBYTES + (tid >> 3) * G::VSTR + (tid & 7) * 16;
    const bf16* vg = Vt + (size_t)(tid >> 3) * KPOS + 8 * (tid & 7);
    u32x4 rk0, rk1, rv;
    rk1 = (u32x4){0u, 0u, 0u, 0u};
#define ATT_POS(t) ((t) < n1 ? pos1 + 64 * (t) : pos2 + 64 * ((t) - n1))
    { const int pos0 = ATT_POS(0); rk0 = *(const u32x4*)(Kb + (size_t)pos0 * DQK + 8 * kq0); if (K2 && tid < 256) rk1 = *(const u32x4*)(Kb + (size_t)pos0 * DQK + 8 * kq1); rv = *(const u32x4*)(vg + pos0); }
    __syncthreads();
    *(LAS u32x4*)(C.lds + kl0) = rk0; if (K2 && tid < 256) *(LAS u32x4*)(C.lds + kl1) = rk1; *(LAS u32x4*)(C.lds + vl) = rv;
    __syncthreads();
    float mref = 0.f; bool first = true;
    constexpr float THR = 8.f;
    for (int t = 0; t < ntiles; ++t) {
        const LAS unsigned char* B = C.lds + (t & 1) * G::BUF;
        if (t + 1 < ntiles) { const int pos0 = ATT_POS(t + 1);
            rk0 = *(const u32x4*)(Kb + (size_t)pos0 * DQK + 8 * kq0); if (K2 && tid < 256) rk1 = *(const u32x4*)(Kb + (size_t)pos0 * DQK + 8 * kq1); rv = *(const u32x4*)(vg + pos0); }
        const int gr = (pos1 >> 6) + t;
        const bool active = !NAT || t >= n1 || (gr >= rs && gr < rs + 8);
        if (active) {
            f32x16 sc[2];
#pragma unroll
            for (int j = 0; j < 2; ++j) {
#pragma unroll
                for (int i = 0; i < 16; ++i) sc[j][i] = -mref;
                const LAS unsigned char* kp = B + (32 * j + kr) * G::KSTR + 16 * h;
#pragma unroll
                for (int kk = 0; kk < DQK / 16; ++kk) sc[j] = MFMA32(*(const LAS bf16x8*)(kp + 32 * kk), qf[kk], sc[j]);
            }
            if (NAT && t < n1) {
                const LAS float* trow = tab + (gr - grow + 7) * 31;
#pragma unroll
                for (int j = 0; j < 2; ++j)
#pragma unroll
                    for (int i = 0; i < 16; ++i) {
                        const int cc = 32 * j + ((i & 3) | (((i >> 2) & 1) << 2) | (h << 3) | ((i >> 3) << 4)); const bool ok = (cc >= cs) && (cc < cs + 16);
                        int dc = cc - qc + 15; dc = dc < 0 ? 0 : (dc > 30 ? 30 : dc);
                        sc[j][i] = ok ? sc[j][i] + trow[dc] : -1e30f;
                    }
            }
            float mx = max16_acc(max16_acc(-3.0e38f, sc[0]), sc[1]);
            if (first || __builtin_amdgcn_ballot_w64(mx > THR) != 0ull) {
                mx = fmaxf(mx, xor32(mx, C.lane));
                const float delta = first ? mx : fmaxf(mx, 0.f);
#pragma unroll
                for (int i = 0; i < 16; ++i) { sc[0][i] -= delta; sc[1][i] -= delta; }
                if (!first) { const float alpha = __builtin_amdgcn_exp2f(-delta); l *= alpha;
#pragma unroll
                    for (int i = 0; i < 16; ++i) { o[0][i] *= alpha; o[1][i] *= alpha; } }
                mref += delta; first = false;
            }
            f32x2 rs2 = {0.f, 0.f};
#pragma unroll
            for (int j = 0; j < 2; ++j)
#pragma unroll
                for (int i = 0; i < 16; i += 2) { sc[j][i] = __builtin_amdgcn_exp2f(sc[j][i]); sc[j][i + 1] = __builtin_amdgcn_exp2f(sc[j][i + 1]); rs2 += (f32x2){sc[j][i], sc[j][i + 1]}; }
            l += rs2.x + rs2.y;
#pragma unroll
            for (int j = 0; j < 2; ++j)
#pragma unroll
                for (int s2 = 0; s2 < 2; ++s2) {
                    u32x4 pw; pw.x = pk2(sc[j][8 * s2], sc[j][8 * s2 + 1]); pw.y = pk2(sc[j][8 * s2 + 2], sc[j][8 * s2 + 3]); pw.z = pk2(sc[j][8 * s2 + 4], sc[j][8 * s2 + 5]); pw.w = pk2(sc[j][8 * s2 + 6], sc[j][8 * s2 + 7]);
                    const bf16x8 pb = __builtin_bit_cast(bf16x8, pw);
#pragma unroll
                    for (int dt = 0; dt < 2; ++dt) o[dt] = MFMA32(*(const LAS bf16x8*)(B + G::KBYTES + (32 * dt + r) * G::VSTR + (32 * j + 16 * s2 + 8 * h) * 2), pb, o[dt]);
                }
        }
        if (t + 1 < ntiles) { LAS unsigned char* Bn = C.lds + ((t + 1) & 1) * G::BUF;
            *(LAS u32x4*)(Bn + kl0) = rk0; if (K2 && tid < 256) *(LAS u32x4*)(Bn + kl1) = rk1; *(LAS u32x4*)(Bn + vl) = rv; }
        __syncthreads();
    }
    l += xor32(l, C.lane);
#undef ATT_POS
}
DI void conv_unit(const Ctx& C, int u, const bf16* U, const float (&wk)[31], float bias, const float* lng, const float* lnb, bf16* OCAT);
DI void wprep_items(const Ctx& C, int k0, int k1, const float* w1, const float* w3, const float* w2, bf16* W13, bf16* W2);
DI const float* in_ptr(const unsigned char* ws, int k);
DI void ph_attn_mla2(const Ctx& C, const bf16* QB, const bf16* KB, const bf16* VT, bf16* OCAT, bool last, unsigned char* ws, int lq) {
    const int r = C.lane & 31, h = C.lane >> 5;
    const int nunits = 1024 + (last ? 0 : 64);
    const int nwp = (NEXP * 3 * 256 + C.nb * 8 - 1) / (C.nb * 8);
    int k = 0;
    for (;; ++k) {
        const int u = C.vcu + k * C.nb, cu = (C.nb - 1 - C.vcu) + k * C.nb;
        const bool a_on = u < nunits, c_on = cu < MT / 32, w_on = 2 * k < nwp;
        if (!a_on && !c_on && !w_on) break;
        if (a_on) {
            const int bh = u < 1024 ? (u >> 4) : u - 1024, qblk = u < 1024 ? (u & 15) : 16, b = bh >> 3, hh = bh & 7;
            const int qpos = qblk * 256 + 32 * C.wave + r;
            const bf16* qp = QB + ((size_t)bh * KPOS + qpos) * 96 + 8 * h;
            bf16x8 qf[6];
#pragma unroll
            for (int kk = 0; kk < 6; ++kk) qf[kk] = *(const bf16x8*)(qp + 16 * kk);
            f32x16 o[2];
#pragma unroll
            for (int i = 0; i < 16; ++i) { o[0][i] = 0.f; o[1][i] = 0.f; }
            float l = 0.f;
            attn_tile_loop<96, false>(C, o, l, qf, KB + (size_t)bh * KPOS * 96, VT + (size_t)bh * 64 * KPOS, qblk < 16 ? 0 : TL, qblk < 16 ? KPOS / 64 : LCX / 64, 0, 0, nullptr, 0, 0, 0, 0);
            const int row = qblk < 16 ? b * TL + qpos : NLAT + b * LCX + (qpos - TL);
            flash_store(o, l, OCAT + (size_t)row * DM + hh * 64, h);
        }
        if (c_on) { float wk[31]; const float* dww = in_ptr(ws, I_DWW) + (size_t)lq * 31 * 512;
#pragma unroll
            for (int kt = 0; kt < 31; ++kt) wk[kt] = dww[kt * 512 + C.tid];
            conv_unit(C, cu, (const bf16*)(ws + WS_ARENA + A_U), wk, in_ptr(ws, I_DWB)[lq * 512 + C.tid], in_ptr(ws, I_LNG) + lq * 512, in_ptr(ws, I_LNB) + lq * 512, OCAT); }
        if (w_on) { __syncthreads(); const size_t wo = (size_t)(2 * lq) * NEXP * DM * DM;
            wprep_items(C, 2 * k, 2 * k + 2, in_ptr(ws, I_MW1) + wo, in_ptr(ws, I_MW3) + wo, in_ptr(ws, I_MW2) + wo, (bf16*)(ws + WS_W13), (bf16*)(ws + WS_W2)); }
    }
}
DI void ph_natten2(const Ctx& C, const bf16* QN, const bf16* KN, const bf16* VTN, bf16* OCAT, const float* rpb  , bool last, unsigned* work_ctr, unsigned char* ws, int lq) {
    const int r = C.lane & 31, h = C.lane >> 5;
    LAS float* tab = (LAS float*)(C.lds + 2 * AttnGeo<64>::BUF);
    LAS int* uslot = (LAS int*)(tab + 480);
    const int nunits = 1024 + (last ? 0 : 64);
    const int nwp = (NEXP * 3 * 256 + C.nb * 8 - 1) / (C.nb * 8); int wdone = 0;
    for (;;) {
        __syncthreads();
        if (wdone < nwp) { const size_t wo = (size_t)(2 * lq + 1) * NEXP * DM * DM; wprep_items(C, wdone, wdone + 2, in_ptr(ws, I_MW1) + wo, in_ptr(ws, I_MW3) + wo, in_ptr(ws, I_MW2) + wo, (bf16*)(ws + WS_W13), (bf16*)(ws + WS_W2)); wdone += 2; __syncthreads(); }
        if (C.tid == 0) *uslot = (int)__hip_atomic_fetch_add(work_ctr, 1u, __ATOMIC_RELAXED, __HIP_MEMORY_SCOPE_AGENT);
        __syncthreads();
        const int u = *uslot;
        if (u >= nunits) { if (wdone < nwp) { const size_t wo = (size_t)(2 * lq + 1) * NEXP * DM * DM; wprep_items(C, wdone, nwp, in_ptr(ws, I_MW1) + wo, in_ptr(ws, I_MW3) + wo, in_ptr(ws, I_MW2) + wo, (bf16*)(ws + WS_W13), (bf16*)(ws + WS_W2)); } break; }
        const bool isctx = u >= 1024;
        const int bh = isctx ? u - 1024 : (u >> 4), b = bh >> 3, hh = bh & 7;
        for (int i = C.tid; i < 465; i += 512) tab[i] = rpb[hh * 465 + i] * LOG2E;
        int qpos, row, grow = 0, qc = 0, rs = 0, cs = 0, rlo = 0, nband = 0;
        if (!isctx) { const int rg = u & 15; grow = 4 * rg + (C.wave >> 1); qc = 32 * (C.wave & 1) + r; qpos = grow * 64 + qc; row = b * TL + qpos;
            rs = grow - 4; rs = rs < 0 ? 0 : (rs > 56 ? 56 : rs); cs = qc - 8; cs = cs < 0 ? 0 : (cs > 48 ? 48 : cs);
            rlo = 4 * rg - 4; rlo = rlo < 0 ? 0 : (rlo > 56 ? 56 : rlo); int rhi = 4 * rg + 3 - 4; rhi = rhi < 0 ? 0 : (rhi > 56 ? 56 : rhi); nband = rhi + 8 - rlo; }
        else { qpos = TL + 32 * C.wave + r; row = NLAT + b * LCX + 32 * C.wave + r; }
        const bf16* qp = QN + ((size_t)bh * KPOS + qpos) * 64 + 8 * h;
        bf16x8 qf[4];
#pragma unroll
        for (int kk = 0; kk < 4; ++kk) qf[kk] = *(const bf16x8*)(qp + 16 * kk);
        f32x16 o[2];
#pragma unroll
        for (int i = 0; i < 16; ++i) { o[0][i] = 0.f; o[1][i] = 0.f; }
        float l = 0.f;
        attn_tile_loop<64, true>(C, o, l, qf, KN + (size_t)bh * KPOS * 64, VTN + (size_t)bh * 64 * KPOS, rlo * 64, nband, TL, LCX / 64, tab, grow, rs, qc, cs);
        flash_store(o, l, OCAT + (size_t)row * DM + 512 + hh * 64, h);
    }
}

DI void ph_natten(const Ctx& C, const bf16* QN, const bf16* KN, const bf16* VTN, bf16* OCAT, const float* rpb  , bool last) {
    const int r = C.lane & 31, h = C.lane >> 5;
    LAS float* tab = (LAS float*)C.lds;
    const int nunits = 1024 + (last ? 0 : 64);
    for (int u = C.vcu; u < nunits; u += C.nb) {
        const bool isctx = u >= 1024;
        const int bh = isctx ? u - 1024 : (u >> 4), b = bh >> 3, hh = bh & 7;
        __syncthreads();
        for (int i = C.tid; i < 465; i += 512) tab[i] = rpb[hh * 465 + i] * LOG2E;
        __syncthreads();
        int qpos, row, grow = 0, qc = 0, rs = 0, cs = 0;
        if (!isctx) { const int rg = u & 15; grow = 4 * rg + (C.wave >> 1); qc = 32 * (C.wave & 1) + r; qpos = grow * 64 + qc; row = b * TL + qpos;
            rs = grow - 4; rs = rs < 0 ? 0 : (rs > 56 ? 56 : rs); cs = qc - 8; cs = cs < 0 ? 0 : (cs > 48 ? 48 : cs); }
        else { qpos = TL + 32 * C.wave + r; row = NLAT + b * LCX + 32 * C.wave + r; }
        const bf16* qp = QN + ((size_t)bh * KPOS + qpos) * 64 + 8 * h;
        bf16x8 qf[4];
#pragma unroll
        for (int kk = 0; kk < 4; ++kk) qf[kk] = *(const bf16x8*)(qp + 16 * kk);
        f32x16 o[2];
#pragma unroll
        for (int i = 0; i < 16; ++i) { o[0][i] = 0.f; o[1][i] = 0.f; }
        float m = -1e30f, l = 0.f;
        const bf16* Kb = KN + (size_t)bh * KPOS * 64; const bf16* Vt = VTN + (size_t)bh * 64 * KPOS;
        if (!isctx) flash_range<64, true>(o, m, l, qf, Kb, Vt, rs * 64, 16, r, h, tab, qc, cs, rs - grow + 7);
        flash_range<64, false>(o, m, l, qf, Kb, Vt, TL, LCX / 32, r, h, nullptr, 0, 0, 0);
        flash_store(o, l, OCAT + (size_t)row * DM + 512 + hh * 64, h);
    }
}

DI void ph_mla_fin(const Ctx& C, const bf16* U, const bf16* QPRE, const bf16* KVPRE, const float* qg, const float* kg, const f32x2* CS, bf16* QB, bf16* KB, bf16* VT) {
    LAS bf16* VL = (LAS bf16*)C.lds;
    const int lane = C.lane, j = lane >> 3, sub = lane & 7;
    const float C2 = 0.10206207261596575f * LOG2E;
    float qgn[8], qgr[4], kgn[8], kgr[4];
#pragma unroll
    for (int e = 0; e < 8; ++e) { qgn[e] = qg[8 * sub + e] * C2; kgn[e] = kg[8 * sub + e]; }
#pragma unroll
    for (int m = 0; m < 4; ++m) { qgr[m] = qg[64 + sub + 8 * m] * C2; kgr[m] = kg[64 + sub + 8 * m]; }
    for (int u = C.vcu; u < MT / 64; u += C.nb) {
        const int row0 = 64 * u, b = row0 < NLAT ? (row0 >> 12) : ((row0 - NLAT) >> 8), pos0 = row0 < NLAT ? (row0 & 4095) : TL + ((row0 - NLAT) & 255);
        const bool lat = row0 < NLAT;
        const int pl = 8 * C.wave + j, row = row0 + pl, pos = pos0 + pl;
        const bf16* ur = U + (size_t)row * EV_INP;
        float sq = 0.f, skv = 0.f;
#pragma unroll
        for (int m = 0; m < 6; ++m) { float x[8]; unpack8(*(const u32x4*)(ur + 8 * (sub + 8 * m)), x);
#pragma unroll
            for (int e = 0; e < 8; ++e) sq += x[e] * x[e]; }
#pragma unroll
        for (int m = 0; m < 4; ++m) { float x[8]; unpack8(*(const u32x4*)(ur + 384 + 8 * (sub + 8 * m)), x);
#pragma unroll
            for (int e = 0; e < 8; ++e) skv += x[e] * x[e]; }
        sq = sum8(sq); skv = sum8(skv);
        const float rsq = 1.0f / sqrtf(sq * (1.f / 384.f) + EPS), rskv = 1.0f / sqrtf(skv * (1.f / 256.f) + EPS);
        float krv[4];
#pragma unroll
        for (int m = 0; m < 4; ++m) krv[m] = bf2f(ur[640 + sub + 8 * m]);
        float cr = 1.f, sr = 0.f, cc = 1.f, sc = 0.f;
        if (lat) { const f32x2 a0 = CS[pos * 16 + sub], a1 = CS[pos * 16 + 8 + sub]; cr = a0.x; sr = a0.y; cc = a1.x; sc = a1.y; }
        const bf16* qrow = QPRE + (size_t)row * 768; const bf16* kvrow = KVPRE + (size_t)row * 1024;
#pragma unroll 2
        for (int hh = 0; hh < 8; ++hh) {
            { float qn[8], qr[4]; unpack8(*(const u32x4*)(qrow + hh * 96 + 8 * sub), qn); float ss = 0.f;
#pragma unroll
              for (int e = 0; e < 8; ++e) qn[e] *= rsq;
#pragma unroll
              for (int m = 0; m < 4; ++m) { qr[m] = bf2f(qrow[hh * 96 + 64 + sub + 8 * m]) * rsq; ss += qr[m] * qr[m]; }
#pragma unroll
              for (int e = 0; e < 8; ++e) ss += qn[e] * qn[e];
              const float rn = 1.0f / sqrtf(sum8(ss) * (1.f / 96.f) + EPS);
#pragma unroll
              for (int e = 0; e < 8; ++e) qn[e] *= rn * qgn[e];
#pragma unroll
              for (int m = 0; m < 4; ++m) qr[m] *= rn * qgr[m];
              { const float x0 = qr[0], x1 = qr[1], y0 = qr[2], y1 = qr[3]; qr[0] = x0 * cr - x1 * sr; qr[1] = x1 * cr + x0 * sr; qr[2] = y0 * cc - y1 * sc; qr[3] = y1 * cc + y0 * sc; }
              bf16* qo = QB + ((size_t)(b * 8 + hh) * KPOS + pos) * 96;
              *(u32x4*)(qo + 8 * sub) = pack8(qn);
#pragma unroll
              for (int m = 0; m < 4; ++m) qo[64 + sub + 8 * m] = f2bf(qr[m]); }
            { float kn[8], kr[4]; unpack8(*(const u32x4*)(kvrow + hh * 128 + 8 * sub), kn); float ss = 0.f;
#pragma unroll
              for (int e = 0; e < 8; ++e) kn[e] *= rskv;
#pragma unroll
              for (int m = 0; m < 4; ++m) { kr[m] = krv[m]; ss += kr[m] * kr[m]; }
#pragma unroll
              for (int e = 0; e < 8; ++e) ss += kn[e] * kn[e];
              const float rn = 1.0f / sqrtf(sum8(ss) * (1.f / 96.f) + EPS);
#pragma unroll
              for (int e = 0; e < 8; ++e) kn[e] *= rn * kgn[e];
#pragma unroll
              for (int m = 0; m < 4; ++m) kr[m] *= rn * kgr[m];
              { const float x0 = kr[0], x1 = kr[1], y0 = kr[2], y1 = kr[3]; kr[0] = x0 * cr - x1 * sr; kr[1] = x1 * cr + x0 * sr; kr[2] = y0 * cc - y1 * sc; kr[3] = y1 * cc + y0 * sc; }
              bf16* ko = KB + ((size_t)(b * 8 + hh) * KPOS + pos) * 96;
              *(u32x4*)(ko + 8 * sub) = pack8(kn);
#pragma unroll
              for (int m = 0; m < 4; ++m) ko[64 + sub + 8 * m] = f2bf(kr[m]); }
            { float vv[8]; unpack8(*(const u32x4*)(kvrow + hh * 128 + 64 + 8 * sub), vv);
#pragma unroll
              for (int e = 0; e < 8; ++e) VL[(hh * 64 + 8 * sub + e) * 64 + pl] = f2bf(vv[e] * rskv); }
        }
        __syncthreads();
        { const int hd = C.tid;
            bf16* dst = VT + ((size_t)(b * 8 + (hd >> 6)) * 64 + (hd & 63)) * KPOS + pos0;
#pragma unroll
            for (int q = 0; q < 8; ++q) *(u32x4*)(dst + 8 * q) = *(const LAS u32x4*)(VL + hd * 64 + 8 * q); }
        __syncthreads();
    }
}

DI void conv_unit(const Ctx& C, int u, const bf16* U, const float (&wk)[31], float bias, const float* lng, const float* lnb, bf16* OCAT) {
    LAS float* G = (LAS float*)C.lds;
    const int c = C.tid;
    const int row0 = 32 * u; int base, t0, tseq;
    if (row0 < NLAT) { base = row0 & ~4095; t0 = row0 & 4095; tseq = TL; } else { const int rc = row0 - NLAT; base = NLAT + (rc & ~255); t0 = rc & 255; tseq = LCX; }
    __syncthreads();
    for (int rr = C.wave; rr < 62; rr += 8) { const int tt = t0 - 15 + rr; float g[8];
#pragma unroll
        for (int e = 0; e < 8; ++e) g[e] = 0.f;
        if (tt >= 0 && tt < tseq) { const bf16* ur = U + (size_t)(base + tt) * EV_INP; float av[8], gv[8]; unpack8(*(const u32x4*)(ur + 672 + 8 * C.lane), av); unpack8(*(const u32x4*)(ur + 1184 + 8 * C.lane), gv);
#pragma unroll
            for (int e = 0; e < 8; ++e) g[e] = av[e] * sigmoidf_(gv[e]); }
        *(LAS f32x4*)(G + rr * 512 + 8 * C.lane) = (f32x4){g[0], g[1], g[2], g[3]}; *(LAS f32x4*)(G + rr * 512 + 8 * C.lane + 4) = (f32x4){g[4], g[5], g[6], g[7]}; }
    __syncthreads();
    float acc[32];
#pragma unroll
    for (int t = 0; t < 32; ++t) acc[t] = bias;
#pragma unroll
    for (int rr = 0; rr < 62; ++rr) { const float gv = G[rr * 512 + c];
#pragma unroll
        for (int t = 0; t < 32; ++t) { const int k = rr - t; if (k >= 0 && k < 31) acc[t] += gv * wk[k]; } }
    __syncthreads();
#pragma unroll
    for (int t = 0; t < 32; ++t) G[t * 512 + c] = acc[t];
    __syncthreads();
#pragma unroll
    for (int q = 0; q < 4; ++q) {
        const int t = 4 * C.wave + q, row = row0 + t;
        const f32x4 a0 = *(const LAS f32x4*)(G + t * 512 + 8 * C.lane), a1 = *(const LAS f32x4*)(G + t * 512 + 8 * C.lane + 4);
        float x[8] = {a0.x, a0.y, a0.z, a0.w, a1.x, a1.y, a1.z, a1.w}; float s = 0.f;
#pragma unroll
        for (int e = 0; e < 8; ++e) s += x[e];
        const float mu = wave_sum(s) * (1.f / 512.f); float s2 = 0.f;
#pragma unroll
        for (int e = 0; e < 8; ++e) { x[e] -= mu; s2 += x[e] * x[e]; }
        const float rstd = 1.0f / sqrtf(wave_sum(s2) * (1.f / 512.f) + EPS);
        float y[8];
#pragma unroll
        for (int e = 0; e < 8; ++e) { const float z = x[e] * rstd * lng[8 * C.lane + e] + lnb[8 * C.lane + e]; y[e] = siluf_(z); }
        *(u32x4*)(OCAT + (size_t)row * DM + 512 + 8 * C.lane) = pack8(y);
    }
    __syncthreads();
}
DI void wprep_items(const Ctx& C, int k0, int k1, const float* w1, const float* w3, const float* w2, bf16* W13, bf16* W2) {
    LAS float* scr = (LAS float*)(C.lds + C.wave * 16640);
    const int gw = C.vcu * 8 + C.wave, ngw = C.nb * 8;
    constexpr int PER = 16 * 16, NIT = NEXP * 3 * PER;
    for (int k = k0; k < k1; ++k) { const int it = gw + k * ngw; if (it >= NIT) break;
        const int e = it / (3 * PER), r = it % (3 * PER), which = r / PER, q = r % PER, kb = q / 16, n0 = (q % 16) * 64;
#if MOE_F8
        if (which == 0)      transpose_item64_f8(w1 + (size_t)e * DM * DM, DM, DM, (unsigned char*)W13 + (size_t)e * 2048 * DM, (n0 >> 7) * 256 + (n0 & 127), scr, kb * 64, n0, C.lane);
        else if (which == 1) transpose_item64_f8(w3 + (size_t)e * DM * DM, DM, DM, (unsigned char*)W13 + (size_t)e * 2048 * DM, (n0 >> 7) * 256 + (n0 & 127) + 128, scr, kb * 64, n0, C.lane);
        else                 transpose_item64_f8(w2 + (size_t)e * DM * DM, DM, DM, (unsigned char*)W2 + (size_t)e * DM * DM, n0, scr, kb * 64, n0, C.lane); }
#else
        if (which == 0)      transpose_item64(w1 + (size_t)e * DM * DM, DM, DM, W13 + (size_t)e * 2048 * DM, (n0 >> 7) * 256 + (n0 & 127), scr, kb * 64, n0, C.lane);
        else if (which == 1) transpose_item64(w3 + (size_t)e * DM * DM, DM, DM, W13 + (size_t)e * 2048 * DM, (n0 >> 7) * 256 + (n0 & 127) + 128, scr, kb * 64, n0, C.lane);
        else                 transpose_item64(w2 + (size_t)e * DM * DM, DM, DM, W2 + (size_t)e * DM * DM, n0, scr, kb * 64, n0, C.lane); }
#endif
}
constexpr int WPREP_PER_WAVE = (NEXP * 3 * 256 + 2047) / 2048;

DI void shifted8(const bf16* up, const bf16* uc, const bf16* un, bool hp, bool hn, const float (&s0)[8], const float (&s1)[8], const float (&s2)[8], int c0, float (&o)[8]) {
    const u32x4 z = {0u, 0u, 0u, 0u};
    const u32x4 vp = hp ? *(const u32x4*)(up + c0) : z, vc = *(const u32x4*)(uc + c0), vn = hn ? *(const u32x4*)(un + c0) : z;
    float p[8], c[8], n[8]; unpack8(vp, p); unpack8(vc, c); unpack8(vn, n);
#pragma unroll
    for (int e = 0; e < 8; ++e) o[e] = p[e] * s0[e] + c[e] * s1[e] + n[e] * s2[e];
}
DI void load_sw(const float* sw, int c0, float (&s0)[8], float (&s1)[8], float (&s2)[8]) {
#pragma unroll
    for (int e = 0; e < 8; ++e) { s0[e] = sw[c0 + e]; s1[e] = sw[RW_IN + c0 + e]; s2[e] = sw[2 * RW_IN + c0 + e]; }
}
DI void ph_prep(const Ctx& C, const bf16* U, const float* sw  , const float* kkw  , const float* naqg, const float* nakg,
                bf16* R, bf16* V, bf16* K, bf16* KK, bf16* L, bf16* QN, bf16* KN, bf16* VTN) {
    LAS bf16* VL = (LAS bf16*)C.lds;
    const int lane = C.lane, hh = lane >> 3, sub = lane & 7;
    const float C2 = 0.125f * LOG2E;
    for (int u = C.vcu; u < MT / 32; u += C.nb) {
        const int row0 = 32 * u; const bool lat = row0 < NLAT;
        const int b = lat ? (row0 >> 12) : ((row0 - NLAT) >> 8), pos0 = lat ? (row0 & 4095) : TL + ((row0 - NLAT) & 255), tseq = lat ? TL : LCX, tb = lat ? (row0 & 4095) : ((row0 - NLAT) & 255);
#define PREP_ROWVARS(i) const int pl = 4 * C.wave + (i), row = row0 + pl, t = tb + pl; const bool hp = t > 0, hn = t < tseq - 1; \
            const bf16* uc = U + (size_t)row * OD_INP; const bf16* up = uc - OD_INP; const bf16* un = uc + OD_INP
        { float s0[8], s1[8], s2[8]; load_sw(sw, 8 * lane, s0, s1, s2);
          for (int i = 0; i < 4; ++i) { PREP_ROWVARS(i); float o[8]; shifted8(up, uc, un, hp, hn, s0, s1, s2, 8 * lane, o); *(u32x4*)(R + (size_t)row * 512 + 8 * lane) = pack8(o); } }
        { float s0[8], s1[8], s2[8]; load_sw(sw, 1024 + 8 * lane, s0, s1, s2);
          for (int i = 0; i < 4; ++i) { PREP_ROWVARS(i); float o[8]; shifted8(up, uc, un, hp, hn, s0, s1, s2, 1024 + 8 * lane, o); *(u32x4*)(V + (size_t)row * 512 + 8 * lane) = pack8(o); } }
        { float s0[8], s1[8], s2[8]; load_sw(sw, 512 + 8 * lane, s0, s1, s2); float kw[8];
#pragma unroll
          for (int e = 0; e < 8; ++e) kw[e] = kkw[8 * lane + e];
          for (int i = 0; i < 4; ++i) { PREP_ROWVARS(i); float o[8]; shifted8(up, uc, un, hp, hn, s0, s1, s2, 512 + 8 * lane, o); *(u32x4*)(K + (size_t)row * 512 + 8 * lane) = pack8(o);
              float kk[8]; float ss = 0.f;
#pragma unroll
              for (int e = 0; e < 8; ++e) { kk[e] = o[e] * kw[e]; ss += kk[e] * kk[e]; }
              ss = sum8(ss); const float rn = 1.0f / sqrtf(ss + 1e-12f);
#pragma unroll
              for (int e = 0; e < 8; ++e) kk[e] *= rn;
              *(u32x4*)(KK + (size_t)row * 512 + 8 * lane) = pack8(kk); } }
        if (lane < 48) { float s0[8], s1[8], s2[8]; load_sw(sw, 1536 + 8 * lane, s0, s1, s2);
          for (int i = 0; i < 4; ++i) { PREP_ROWVARS(i); float o[8]; shifted8(up, uc, un, hp, hn, s0, s1, s2, 1536 + 8 * lane, o);
              if (lane < 16) {
#pragma unroll
                  for (int e = 0; e < 8; ++e) { const float ex = __expf(2.f * o[e]); o[e] = 1.f - 2.f * __builtin_amdgcn_rcpf(ex + 1.f); }
              } else if (lane >= 32) {
#pragma unroll
                  for (int e = 0; e < 8; ++e) o[e] = sigmoidf_(o[e]);
              }
              *(u32x4*)(L + (size_t)row * 384 + 8 * lane) = pack8(o); } }
        { float gq[8], gk[8];
#pragma unroll
          for (int e = 0; e < 8; ++e) { gq[e] = naqg[8 * sub + e] * C2; gk[e] = nakg[8 * sub + e]; }
          for (int i = 0; i < 4; ++i) { const int pl = 4 * C.wave + i, row = row0 + pl, pos = pos0 + pl; const bf16* uc = U + (size_t)row * OD_INP;
            { float x[8]; unpack8(*(const u32x4*)(uc + RW_IN + 8 * lane), x); float ss = 0.f;
#pragma unroll
                for (int e = 0; e < 8; ++e) ss += x[e] * x[e];
                ss = sum8(ss); const float rn = 1.0f / sqrtf(ss * (1.f / 64.f) + EPS);
#pragma unroll
                for (int e = 0; e < 8; ++e) x[e] = x[e] * rn * gq[e];
                *(u32x4*)(QN + ((size_t)(b * 8 + hh) * KPOS + pos) * 64 + 8 * sub) = pack8(x); }
            { float x[8]; unpack8(*(const u32x4*)(uc + RW_IN + 512 + 8 * lane), x); float ss = 0.f;
#pragma unroll
                for (int e = 0; e < 8; ++e) ss += x[e] * x[e];
                ss = sum8(ss); const float rn = 1.0f / sqrtf(ss * (1.f / 64.f) + EPS);
#pragma unroll
                for (int e = 0; e < 8; ++e) x[e] = x[e] * rn * gk[e];
                *(u32x4*)(KN + ((size_t)(b * 8 + hh) * KPOS + pos) * 64 + 8 * sub) = pack8(x); }
            { const u32x4 vv = *(const u32x4*)(uc + RW_IN + 1024 + 8 * lane); const unsigned w4[4] = {vv.x, vv.y, vv.z, vv.w};
#pragma unroll
                for (int e = 0; e < 8; ++e) { const int dv = 8 * sub + e; VL[(hh * 64 + dv) * 32 + pl] = (bf16)((e & 1) ? (w4[e >> 1] >> 16) : (w4[e >> 1] & 0xffffu)); } } } }
#undef PREP_ROWVARS
        __syncthreads();
        { const int hd = C.tid; bf16* dst = VTN + ((size_t)(b * 8 + (hd >> 6)) * 64 + (hd & 63)) * KPOS + pos0;
#pragma unroll
            for (int q = 0; q < 4; ++q) *(u32x4*)(dst + 8 * q) = *(const LAS u32x4*)(VL + hd * 32 + 8 * q); }
        __syncthreads();
    }
}

DI int scan_row(int s, int d, int b) { if (s < LCX) return NLAT + b * LCX + (d ? (LCX - 1 - s) : s); const int t = s - LCX; return b * TL + (d ? (TL - 1 - t) : t); }
DI void ph_scan(const Ctx& C, const bf16* R, const bf16* V, const bf16* KK, const float* W, const bf16* KEFF, const bf16* BSC, float* YS) {
    constexpr int CH = 32, BUF = 5 * CH * 64 + CH * 32;
    LAS float* lds = (LAS float*)C.lds;
    LAS float* ystage = lds + 2 * BUF;
    const int tid = C.tid, i = tid >> 4, kq = tid & 15;
    for (int cid = C.bid; cid < 256; cid += C.nb) {
        const int b = cid >> 5, hh = (cid >> 2) & 7, d = (cid >> 1) & 1, hf = cid & 1;
        const float* Wd = W + (size_t)d * MT * 512; const bf16* KEd = KEFF + (size_t)d * MT * 512; const bf16* BSd = BSC + (size_t)d * MT * 512; float* Yd = YS + (size_t)d * MT * 512;
        float S[4] = {0.f, 0.f, 0.f, 0.f};
        const int sl = tid >> 4, sub = tid & 15;
        f32x4 lw; u32x4 l1, l2, l3;
        auto issue = [&](int ck) {
            const int row = scan_row(ck * CH + sl, d, b);
            lw = *(const f32x4*)(Wd + (size_t)row * 512 + hh * 64 + 4 * sub);
            if (sub < 8) { l1 = *(const u32x4*)(R + (size_t)row * 512 + hh * 64 + 8 * sub); l2 = *(const u32x4*)(KEd + (size_t)row * 512 + hh * 64 + 8 * sub); }
            else { l1 = *(const u32x4*)(KK + (size_t)row * 512 + hh * 64 + 8 * (sub - 8)); l2 = *(const u32x4*)(BSd + (size_t)row * 512 + hh * 64 + 8 * (sub - 8)); }
            if (sub < 4) l3 = *(const u32x4*)(V + (size_t)row * 512 + hh * 64 + 32 * hf + 8 * sub);
        };
        auto commit = [&](int bufi) {
            LAS float* B = lds + bufi * BUF;
            *(LAS f32x4*)(B + (1 * CH + sl) * 64 + 4 * sub) = lw;
            float f1[8], f2[8]; unpack8(l1, f1); unpack8(l2, f2);
            const int a1 = sub < 8 ? 0 : 3, a2 = sub < 8 ? 2 : 4, off = 8 * (sub & 7);
            *(LAS f32x4*)(B + (a1 * CH + sl) * 64 + off) = (f32x4){f1[0], f1[1], f1[2], f1[3]}; *(LAS f32x4*)(B + (a1 * CH + sl) * 64 + off + 4) = (f32x4){f1[4], f1[5], f1[6], f1[7]};
            *(LAS f32x4*)(B + (a2 * CH + sl) * 64 + off) = (f32x4){f2[0], f2[1], f2[2], f2[3]}; *(LAS f32x4*)(B + (a2 * CH + sl) * 64 + off + 4) = (f32x4){f2[4], f2[5], f2[6], f2[7]};
            if (sub < 4) { float f3[8]; unpack8(l3, f3); LAS float* vp = B + 5 * CH * 64 + sl * 32 + 8 * sub;
                *(LAS f32x4*)vp = (f32x4){f3[0], f3[1], f3[2], f3[3]}; *(LAS f32x4*)(vp + 4) = (f32x4){f3[4], f3[5], f3[6], f3[7]}; }
        };
        __syncthreads();
        issue(0); commit(0);
        __syncthreads();
        constexpr int NCK = KPOS / CH;
        for (int ck = 0; ck < NCK; ++ck) {
            if (ck + 1 < NCK) issue(ck + 1);
            const LAS float* B = lds + (ck & 1) * BUF; LAS float* ys = ystage + (ck & 1) * CH * 32;
#pragma unroll 4
            for (int s = 0; s < CH; ++s) {
                const f32x4 rr = *(const LAS f32x4*)(B + (0 * CH + s) * 64 + 4 * kq), ww = *(const LAS f32x4*)(B + (1 * CH + s) * 64 + 4 * kq), ke = *(const LAS f32x4*)(B + (2 * CH + s) * 64 + 4 * kq),
                            kk = *(const LAS f32x4*)(B + (3 * CH + s) * 64 + 4 * kq), bs = *(const LAS f32x4*)(B + (4 * CH + s) * 64 + 4 * kq);
                const float v = B[5 * CH * 64 + s * 32 + i];
                float sa = -(S[0] * kk.x + S[1] * kk.y + S[2] * kk.z + S[3] * kk.w);
                sa = sum16(sa);
                S[0] = S[0] * ww.x + (sa * bs.x + v * ke.x); S[1] = S[1] * ww.y + (sa * bs.y + v * ke.y); S[2] = S[2] * ww.z + (sa * bs.z + v * ke.z); S[3] = S[3] * ww.w + (sa * bs.w + v * ke.w);
                float y = S[0] * rr.x + S[1] * rr.y + S[2] * rr.z + S[3] * rr.w;
                y = sum16(y);
                if (kq == 0) ys[s * 32 + i] = y;
            }
            if (ck + 1 < NCK) commit((ck + 1) & 1);
            __syncthreads();
            if (tid < 256) { const int s = tid >> 3, q = tid & 7; const int row = scan_row(ck * CH + s, d, b);
                *(f32x4*)(Yd + (size_t)row * 512 + hh * 64 + 32 * hf + 4 * q) = *(const LAS f32x4*)(ys + s * 32 + 4 * q); }
        }
    }
}


DI void ph_scan2(const Ctx& C, const bf16* R, const bf16* V, const bf16* K, const bf16* KK, const float* W, const bf16* AR_  , const float* ka, float* YS) {
    constexpr int CH = 16, BUF = 5 * CH * 64 + CH * 32, NCK = KPOS / CH, DEPTH = 4, YP = CH * 32 * 16;
    static_assert(NCK % DEPTH == 0, "chunk loop is unrolled by DEPTH");
    LAS float* lds = (LAS float*)C.lds;
    LAS float* ypart = lds + 2 * BUF;
    const bool comp = C.wave < 4;
    const int rp = 4 * (C.wave & 3) + (C.lane >> 4), kq = C.lane & 15, lt = C.tid - 256;
    for (int cid0 = C.bid; cid0 < 256; cid0 += C.nb) {
        const int hf = (cid0 >> 3) & 1, chain = (cid0 & 7) | ((cid0 >> 4) << 3), b = chain >> 4, hh = (chain >> 1) & 7, d = chain & 1;
        const float* Wd = W + (size_t)d * MT * 512; const bf16* Ad = AR_ + (size_t)d * MT * 512; float* Yd = YS + (size_t)d * MT * 512;
        u32x4 reg[DEPTH][4];
        float kav[8];
#pragma unroll
        for (int e = 0; e < 8; ++e) kav[e] = ka[hh * 64 + 8 * (lt & 7) + e];
        auto issue = [&](int ck, u32x4 (&rg)[4]) {
            { const size_t base = (size_t)scan_row(ck * CH + (lt >> 4), d, b) * 512 + hh * 64; rg[0] = *(const u32x4*)(Wd + base + 4 * (lt & 15)); }
            rg[1] = (u32x4){0u, 0u, 0u, 0u};
            if (lt < 128) { const size_t base = (size_t)scan_row(ck * CH + (lt >> 3), d, b) * 512 + hh * 64; rg[1] = *(const u32x4*)(R + base + 8 * (lt & 7)); }
            else if (lt < 192) { const int x = lt - 128; const size_t base = (size_t)scan_row(ck * CH + (x >> 2), d, b) * 512 + hh * 64; rg[1] = *(const u32x4*)(V + base + 32 * hf + 8 * (x & 3)); }
            { const size_t base = (size_t)scan_row(ck * CH + ((lt & 127) >> 3), d, b) * 512 + hh * 64 + 8 * (lt & 7); rg[2] = *(const u32x4*)((lt < 128 ? K : KK) + base); rg[3] = *(const u32x4*)(Ad + base); }
        };
        auto commit = [&](int bufi, const u32x4 (&rg)[4]) {
            LAS float* B = lds + bufi * BUF;
            *(LAS u32x4*)(B + (1 * CH + (lt >> 4)) * 64 + 4 * (lt & 15)) = rg[0];
            if (lt < 192) { float f[8]; unpack8(rg[1], f); LAS float* dst = lt < 128 ? B + (0 * CH + (lt >> 3)) * 64 + 8 * (lt & 7) : B + 5 * CH * 64 + ((lt - 128) >> 2) * 32 + 8 * ((lt - 128) & 3);
                *(LAS f32x4*)dst = (f32x4){f[0], f[1], f[2], f[3]}; *(LAS f32x4*)(dst + 4) = (f32x4){f[4], f[5], f[6], f[7]}; }
            { float x[8], av[8]; unpack8(rg[2], x); unpack8(rg[3], av); const int sl = (lt & 127) >> 3, pc = lt & 7;
                if (lt < 128) {
#pragma unroll
                    for (int e = 0; e < 8; ++e) x[e] = x[e] * (1.f + (av[e] - 1.f) * kav[e]);
                    LAS float* dst = B + (2 * CH + sl) * 64 + 8 * pc; *(LAS f32x4*)dst = (f32x4){x[0], x[1], x[2], x[3]}; *(LAS f32x4*)(dst + 4) = (f32x4){x[4], x[5], x[6], x[7]};
                } else {
                    LAS float* dk = B + (3 * CH + sl) * 64 + 8 * pc; *(LAS f32x4*)dk = (f32x4){x[0], x[1], x[2], x[3]}; *(LAS f32x4*)(dk + 4) = (f32x4){x[4], x[5], x[6], x[7]};
#pragma unroll
                    for (int e = 0; e < 8; ++e) x[e] *= av[e];
                    LAS float* db = B + (4 * CH + sl) * 64 + 8 * pc; *(LAS f32x4*)db = (f32x4){x[0], x[1], x[2], x[3]}; *(LAS f32x4*)(db + 4) = (f32x4){x[4], x[5], x[6], x[7]};
                } }
        };
        auto y_reduce = [&](int ck) {
            const LAS float* yp = ypart + (ck & 1) * YP + lt * 32;
            float y[2];
#pragma unroll
            for (int j = 0; j < 2; ++j) { const f32x4 a0 = *(const LAS f32x4*)(yp + 16 * j), a1 = *(const LAS f32x4*)(yp + 16 * j + 4), a2 = *(const LAS f32x4*)(yp + 16 * j + 8), a3 = *(const LAS f32x4*)(yp + 16 * j + 12);
                y[j] = (((a0.x + a0.y) + (a0.z + a0.w)) + ((a1.x + a1.y) + (a1.z + a1.w))) + (((a2.x + a2.y) + (a2.z + a2.w)) + ((a3.x + a3.y) + (a3.z + a3.w))); }
            const int row = scan_row(ck * CH + (lt >> 4), d, b);
            *(f32x2*)(Yd + (size_t)row * 512 + hh * 64 + 32 * hf + 2 * (lt & 15)) = (f32x2){y[0], y[1]};
        };
        f32x2 S[2][2];
#pragma unroll
        for (int j = 0; j < 2; ++j) { S[j][0] = (f32x2){0.f, 0.f}; S[j][1] = (f32x2){0.f, 0.f}; }
        __syncthreads();
        if (!comp) { issue(0, reg[0]); commit(0, reg[0]);
#pragma unroll
            for (int k = 1; k < DEPTH; ++k) issue(k, reg[k]); }
        __syncthreads();
        for (int ck0 = 0; ck0 < NCK; ck0 += DEPTH) {
#pragma unroll
            for (int kk = 0; kk < DEPTH; ++kk) {
                const int ck = ck0 + kk;
                if (comp) {
                    const LAS float* B = lds + (ck & 1) * BUF + 4 * kq; const LAS float* vb = lds + (ck & 1) * BUF + 5 * CH * 64 + 2 * rp; LAS float* yq = ypart + (ck & 1) * YP + (2 * rp) * 16 + kq;
                    f32x4 op[2][5]; f32x2 vv[2];
#define SCAN_LOAD(set, sI) do { const LAS float* bp_ = B + (sI) * 64; _Pragma("unroll") for (int a_ = 0; a_ < 5; ++a_) op[set][a_] = *(const LAS f32x4*)(bp_ + a_ * CH * 64); vv[set] = *(const LAS f32x2*)(vb + (sI) * 32); } while (0)
#define SCAN_ROW(set, sI, j, vj) do { f32x2 acc = S[j][0] * (f32x2){op[set][3].x, op[set][3].y}; acc = __builtin_elementwise_fma(S[j][1], (f32x2){op[set][3].z, op[set][3].w}, acc); \
                        const float sa = sum16(-(acc.x + acc.y)); const f32x2 sa2 = {sa, sa}, v2 = {vj, vj}; \
                        S[j][0] = __builtin_elementwise_fma(S[j][0], (f32x2){op[set][1].x, op[set][1].y}, __builtin_elementwise_fma(sa2, (f32x2){op[set][4].x, op[set][4].y}, v2 * (f32x2){op[set][2].x, op[set][2].y})); \
                        S[j][1] = __builtin_elementwise_fma(S[j][1], (f32x2){op[set][1].z, op[set][1].w}, __builtin_elementwise_fma(sa2, (f32x2){op[set][4].z, op[set][4].w}, v2 * (f32x2){op[set][2].z, op[set][2].w})); \
                        const f32x2 ya = __builtin_elementwise_fma(S[j][1], (f32x2){op[set][0].z, op[set][0].w}, S[j][0] * (f32x2){op[set][0].x, op[set][0].y}); \
                        yq[(sI) * 512 + (j) * 16] = ya.x + ya.y; } while (0)
#define SCAN_STEP(set, sI) do { SCAN_ROW(set, sI, 0, vv[set].x); SCAN_ROW(set, sI, 1, vv[set].y); } while (0)
                    SCAN_LOAD(0, 0);
#pragma unroll
                    for (int sI = 0; sI < CH; sI += 2) {
                        SCAN_LOAD(1, sI + 1);
                        SCAN_STEP(0, sI);
                        if (sI + 2 < CH) SCAN_LOAD(0, sI + 2);
                        SCAN_STEP(1, sI + 1);
                    }
#undef SCAN_LOAD
#undef SCAN_ROW
#undef SCAN_STEP
                } else {
                    if (ck + 1 < NCK) commit((ck + 1) & 1, reg[(kk + 1) % DEPTH]);
                    if (ck + DEPTH < NCK) issue(ck + DEPTH, reg[kk]);
                    if (ck > 0) y_reduce(ck - 1);
                }
                __syncthreads();
            }
        }
        if (!comp) y_reduce(NCK - 1);
    }
}


constexpr int CCH = 16, NCHK = KPOS / CCH, NPROB = NB * 8 * 2 * NCHK, IMG_ELEMS = 3 * 32 * 16;
template <int N> struct ICk { static constexpr int value = N; };
DI int crow_(int reg, int h) { return (reg & 3) + 8 * (reg >> 2) + 4 * h; }
DI bf16x8 pack_lo8(const f32x16& x) {
    u32x4 p; p.x = pk2(x[0], x[1]); p.y = pk2(x[2], x[3]); p.z = pk2(x[4], x[5]); p.w = pk2(x[6], x[7]); return __builtin_bit_cast(bf16x8, p); }
DI bf16x8 pack_hi8(const f32x16& x) { u32x4 p; p.x = pk2(x[8], x[9]); p.y = pk2(x[10], x[11]); p.z = pk2(x[12], x[13]); p.w = pk2(x[14], x[15]); return __builtin_bit_cast(bf16x8, p); }
DI int perm16(int k) { return (k & ~15) | swap23(k & 15); }

DI void ph_wkv_pre(const Ctx& C, const bf16* R, const bf16* K, const bf16* KK, const float* LW, const bf16* AR_, const float* ka, bf16* IMG) {
    LAS unsigned char* wl = C.lds + C.wave * 13312;
    LAS bf16* ARl = (LAS bf16*)wl; LAS bf16* BKl = (LAS bf16*)(wl + 4608); LAS float* Ll = (LAS float*)(wl + 9216); LAS bf16* OUT = (LAS bf16*)(wl + 10240);
    const int lane = C.lane, r = lane & 31, h = lane >> 5;
    const int gw = C.vcu * 8 + C.wave, ngw = C.nb * 8;
    for (int p = gw; p < NPROB; p += ngw) {
        const int j = p % NCHK, rest = p / NCHK, d = rest & 1, hh = (rest >> 1) & 7, b = rest >> 4;
        const float* Wd = LW + (size_t)d * MT * 512; const bf16* Ad = AR_ + (size_t)d * MT * 512;
        const float kav = ka[hh * 64 + lane];
        const int row0 = scan_row(j * CCH, d, b), sg = d ? -1 : 1;
        float lw[16]; bf16 rr[16], kx[16], kkx[16], ax[16];
#pragma unroll
        for (int t = 0; t < 16; ++t) { const size_t off = (size_t)(row0 + sg * t) * 512 + hh * 64 + lane; lw[t] = Wd[off]; rr[t] = R[off]; kx[t] = K[off]; kkx[t] = KK[off]; ax[t] = Ad[off]; }
        float cum = 0.f, e0 = 1.f;
#pragma unroll
        for (int t = 0; t < 16; ++t) {
            cum += lw[t]; const float e1 = __expf(cum), ei = __builtin_amdgcn_rcpf(e1);
            const float kkv = bf2f(kkx[t]), av = bf2f(ax[t]), keff = bf2f(kx[t]) * (1.f + (av - 1.f) * kav);
            ARl[t * 72 + lane] = f2bf(-kkv * e0); ARl[(16 + t) * 72 + lane] = f2bf(bf2f(rr[t]) * e1);
            BKl[t * 72 + lane] = f2bf(kkv * av * ei); BKl[(16 + t) * 72 + lane] = f2bf(keff * ei);
            e0 = e1;
        }
        asm volatile("s_waitcnt lgkmcnt(0)" ::: "memory");
        f32x16 g;
#pragma unroll
        for (int i = 0; i < 16; ++i) g[i] = 0.f;
#pragma unroll
        for (int q = 0; q < 4; ++q) g = MFMA32(*(const LAS bf16x8*)(ARl + r * 72 + 16 * q + 8 * h), *(const LAS bf16x8*)(BKl + r * 72 + 16 * q + 8 * h), g);
        const int sI = r & 15; const bool isk = r >= 16;
#pragma unroll
        for (int i = 0; i < 16; ++i) {
            const int row = crow_(i, h), t = row & 15; const bool keep = (i < 8) ? (sI < t) : (sI <= t); const float val = keep ? g[i] : 0.f;
            if (i < 8) { if (!isk) { Ll[t * 16 + sI] = val; OUT[512 + row * 16 + perm16(sI)] = 0; } else OUT[row * 16 + sI] = f2bf(val); }
            else       { if (!isk) OUT[512 + row * 16 + perm16(sI)] = f2bf(val); else OUT[row * 16 + sI] = f2bf(val); }
        }
        asm volatile("s_waitcnt lgkmcnt(0)" ::: "memory");
        { const int c = lane & 15; float Pr[16];
            Pr[0] = (c == 0) ? 1.f : 0.f;
#pragma unroll
            for (int t = 1; t < 16; ++t) { const float lrow = Ll[t * 16 + c]; float acc = (c == t) ? 1.f : 0.f;
#pragma unroll
                for (int u = 0; u < t; ++u) acc += rdlane(lrow, u) * Pr[u];
                Pr[t] = acc; }
            if (lane < 16) {
#pragma unroll
                for (int t = 0; t < 16; ++t) { OUT[1024 + t * 16 + perm16(c)] = f2bf(Pr[t]); OUT[1024 + (16 + t) * 16 + c] = 0; } } }
        asm volatile("s_waitcnt lgkmcnt(0)" ::: "memory");
        { bf16* dst = IMG + (size_t)p * IMG_ELEMS;
#pragma unroll
            for (int q = 0; q < 3; ++q) *(u32x4*)(dst + (q * 64 + lane) * 8) = *(const LAS u32x4*)(OUT + (q * 64 + lane) * 8); }
        asm volatile("s_waitcnt lgkmcnt(0)" ::: "memory");
    }
}

DI void ph_wkv_chunk(const Ctx& C, const bf16* R, const bf16* V, const bf16* K, const bf16* KK, const float* LW, const bf16* AR_, const float* ka, const bf16* IMG, bf16* YS) {
    constexpr int S_AR = 0, S_BKT = 4608, S_VT = 9728, S_VT2 = 11264, S_GC = 12800, S_MM = 13056, S_MRB = 14592, S_PP = 16128, SLOT = 17664, CUMO = 2 * SLOT, YSTO = CUMO + 8192, DEPTH = 4;
    const int lane = C.lane, wv = C.wave, r = lane & 31, h = lane >> 5;
    const bool isE = wv == 2 || wv == 3 || wv == 6 || wv == 7, isS = wv < 2;
    const int te = (wv == 2 ? 0 : (wv == 3 ? 1 : (wv == 6 ? 2 : 3))) * 64 + lane, et = te >> 4, ekq = te & 15;
    const int vhf = te >> 7, vt = (te >> 3) & 15, viq = te & 7;
    const int hf = wv & 1;
    for (int cid0 = C.bid; cid0 < 128; cid0 += C.nb) {
        const int chain = cid0, b = chain >> 4, hh = (chain >> 1) & 7, d = chain & 1;
        const float* Wd = LW + (size_t)d * MT * 512; const bf16* Ad = AR_ + (size_t)d * MT * 512; bf16* Yd = YS + (size_t)d * MT * 512;
        const bf16* img = IMG + (size_t)(((b * 8 + hh) * 2 + d) * NCHK) * IMG_ELEMS;
        f32x16 ST[2];
#pragma unroll
        for (int i = 0; i < 16; ++i) { ST[0][i] = 0.f; ST[1][i] = 0.f; }
        const f32x4 kav = *(const f32x4*)(ka + hh * 64 + 4 * ekq);
        unsigned ring[DEPTH][16];
        __syncthreads();
        auto issue = [&](int ch, unsigned (&rg)[16]) __attribute__((always_inline)) {
            if (ch < 0 || ch >= NCHK) return;
            const int row0 = scan_row(ch * CCH, d, b), sg = d ? -1 : 1;
            if (isE) {
                const size_t off = (size_t)(row0 + sg * et) * 512 + hh * 64 + 4 * ekq;
                const u32x2 x0 = *(const u32x2*)(R + off), x1 = *(const u32x2*)(K + off), x2 = *(const u32x2*)(KK + off), x3 = *(const u32x2*)(Ad + off);
                const u32x2 x4 = *(const u32x2*)(V + (size_t)(row0 + sg * vt) * 512 + hh * 64 + 32 * vhf + 4 * viq);
                rg[0] = x0.x; rg[1] = x0.y; rg[2] = x1.x; rg[3] = x1.y; rg[4] = x2.x; rg[5] = x2.y; rg[6] = x3.x; rg[7] = x3.y; rg[8] = x4.x; rg[9] = x4.y;
                asm volatile("; wkv issue role E" ::);
            } else if (wv == 4) {
#define W5_(t) rg[(t)] = __builtin_bit_cast(unsigned, Wd[(size_t)(row0 + sg * (t)) * 512 + hh * 64 + lane])
                W5_(0); W5_(1); W5_(2); W5_(3); W5_(4); W5_(5); W5_(6); W5_(7); W5_(8); W5_(9); W5_(10); W5_(11); W5_(12); W5_(13); W5_(14); W5_(15);
#undef W5_
                asm volatile("; wkv issue role C" ::);
            } else if (wv == 5) {
#define W6_(q) do { const u32x4 x = *(const u32x4*)(img + (size_t)ch * IMG_ELEMS + ((q) * 64 + lane) * 8); rg[4 * (q)] = x.x; rg[4 * (q) + 1] = x.y; rg[4 * (q) + 2] = x.z; rg[4 * (q) + 3] = x.w; } while (0)
                W6_(0); W6_(1); W6_(2);
#undef W6_
                asm volatile("; wkv issue role V" ::);
            }
        };
        issue(0, ring[0]); issue(1, ring[1]); issue(2, ring[2]); issue(3, ring[3]);
#define WKV_BAR() asm volatile("s_waitcnt lgkmcnt(0)\n\ts_barrier" ::: "memory")
#define WKV_LOOP(...) for (int n0 = -2; n0 < NCHK; n0 += DEPTH) { auto iter = [&](auto kc) __attribute__((always_inline)) { constexpr int kk = decltype(kc)::value; \
            constexpr int riE = (kk + 3) % DEPTH, riW = kk % DEPTH; (void)riE; (void)riW; const int n = n0 + kk; (void)n; __VA_ARGS__; WKV_BAR(); }; iter(ICk<0>{}); iter(ICk<1>{}); iter(ICk<2>{}); iter(ICk<3>{}); }
        if (isS) {
            WKV_LOOP({
                if (n >= 0 && n < NCHK) {
                    const LAS unsigned char* B = C.lds + (n & 1) * SLOT;
                    f32x16 T1;
                    _Pragma("unroll") for (int i = 0; i < 16; ++i) T1[i] = 0.f;
                    _Pragma("unroll") for (int tau = 0; tau < 2; ++tau) {
                        T1 = MFMA32(*(const LAS bf16x8*)(B + S_AR + r * 144 + (32 * tau + 8 * h) * 2), pack_lo8(ST[tau]), T1);
                        T1 = MFMA32(*(const LAS bf16x8*)(B + S_AR + r * 144 + (32 * tau + 16 + 8 * h) * 2), pack_hi8(ST[tau]), T1);
                    }
                    const bf16x8 vtf = *(const LAS bf16x8*)(B + (hf ? S_VT2 : S_VT) + r * 48 + 16 * h);
                    T1 = MFMA32(*(const LAS bf16x8*)(B + S_MM + r * 48 + 16 * h), vtf, T1);
                    f32x16 ET;
                    _Pragma("unroll") for (int i = 0; i < 16; ++i) ET[i] = 0.f;
                    ET = MFMA32(*(const LAS bf16x8*)(B + S_PP + r * 48 + 16 * h), pack_lo8(T1), ET);
                    const bf16x8 ef = pack_lo8(ET);
                    T1 = MFMA32(*(const LAS bf16x8*)(B + S_MRB + r * 48 + 16 * h), ef, T1);
                    _Pragma("unroll") for (int tau = 0; tau < 2; ++tau) {
                        ST[tau] = MFMA32(*(const LAS bf16x8*)(B + S_BKT + (32 * tau + r) * 80 + 16 * h), ef, ST[tau]);
                        ST[tau] = MFMA32(*(const LAS bf16x8*)(B + S_BKT + (32 * tau + r) * 80 + 32 + 16 * h), vtf, ST[tau]);
                        _Pragma("unroll") for (int g4 = 0; g4 < 4; ++g4) { const f32x4 gc = *(const LAS f32x4*)(B + S_GC + (32 * tau + 8 * g4 + 4 * h) * 4);
                            ST[tau][4 * g4] *= gc.x; ST[tau][4 * g4 + 1] *= gc.y; ST[tau][4 * g4 + 2] *= gc.z; ST[tau][4 * g4 + 3] *= gc.w; }
                    }
                    LAS float* ys = (LAS float*)(C.lds + YSTO) + ((n & 1) * 2 + hf) * 512;
                    _Pragma("unroll") for (int q = 0; q < 8; ++q) ys[(8 * (q >> 2) + 4 * h + (q & 3)) * 32 + r] = T1[8 + q];
                }
            });
        } else if (isE) {
            WKV_LOOP({
                const int ch = n + 1;
                if (ch >= 0) {
                    if (ch < NCHK) {
                        LAS unsigned char* B = C.lds + (ch & 1) * SLOT; const LAS float* ec = (const LAS float*)(C.lds + CUMO) + (ch & 1) * 1024;
                        const f32x4 e1 = *(const LAS f32x4*)(ec + et * 64 + 4 * ekq);
                        f32x4 e0 = {1.f, 1.f, 1.f, 1.f}; if (et > 0) e0 = *(const LAS f32x4*)(ec + (et - 1) * 64 + 4 * ekq);
                        const float rv[4] = {bflo(ring[riE][0]), bfhi(ring[riE][0]), bflo(ring[riE][1]), bfhi(ring[riE][1])}; const float kv[4] = {bflo(ring[riE][2]), bfhi(ring[riE][2]), bflo(ring[riE][3]), bfhi(ring[riE][3])};
                        const float kkv[4] = {bflo(ring[riE][4]), bfhi(ring[riE][4]), bflo(ring[riE][5]), bfhi(ring[riE][5])}; const float av[4] = {bflo(ring[riE][6]), bfhi(ring[riE][6]), bflo(ring[riE][7]), bfhi(ring[riE][7])};
                        float ah[4]; float rh[4]; float bc[4]; float kc4[4];
                        _Pragma("unroll") for (int e = 0; e < 4; ++e) { const float ei = __builtin_amdgcn_rcpf(e1[e]);
                            ah[e] = -kkv[e] * e0[e]; rh[e] = rv[e] * e1[e]; bc[e] = kkv[e] * av[e] * ei; kc4[e] = kv[e] * (1.f + (av[e] - 1.f) * kav[e]) * ei; }
                        const int pk = perm16(4 * ekq);
                        *(LAS u32x2*)((LAS bf16*)(B + S_AR) + et * 72 + pk) = (u32x2){pk2(ah[0], ah[1]), pk2(ah[2], ah[3])};
                        *(LAS u32x2*)((LAS bf16*)(B + S_AR) + (16 + et) * 72 + pk) = (u32x2){pk2(rh[0], rh[1]), pk2(rh[2], rh[3])};
                        const int pt = perm16(et);
                        _Pragma("unroll") for (int e = 0; e < 4; ++e) { ((LAS bf16*)(B + S_BKT))[(4 * ekq + e) * 40 + pt] = f2bf(bc[e]); ((LAS bf16*)(B + S_BKT))[(4 * ekq + e) * 40 + 16 + et] = f2bf(kc4[e]); }
                        if (et == 15) *(LAS f32x4*)((LAS float*)(B + S_GC) + 4 * ekq) = e1;
                        LAS bf16* vtp = (LAS bf16*)(B + (vhf ? S_VT2 : S_VT)) + (4 * viq) * 24 + vt;
                        vtp[0] = (bf16)(ring[riE][8] & 0xffffu); vtp[24] = (bf16)(ring[riE][8] >> 16); vtp[48] = (bf16)(ring[riE][9] & 0xffffu); vtp[72] = (bf16)(ring[riE][9] >> 16);
                    }
                    issue(ch + DEPTH, ring[riE]);
                }
            });
        } else if (wv == 4) {
            WKV_LOOP({
                const int ch = n + 2;
                if (ch < NCHK) { LAS float* ec = (LAS float*)(C.lds + CUMO) + (ch & 1) * 1024; float c = 0.f;
#define C5_(t) do { c += __builtin_bit_cast(float, ring[riW][(t)]); ec[(t) * 64 + lane] = __expf(c); } while (0)
                    C5_(0); C5_(1); C5_(2); C5_(3); C5_(4); C5_(5); C5_(6); C5_(7); C5_(8); C5_(9); C5_(10); C5_(11); C5_(12); C5_(13); C5_(14); C5_(15);
                }
                issue(ch + DEPTH, ring[riW]);
            });
        } else {
            WKV_LOOP({
                { const int chy = n - 1;
                  if (chy >= 0 && chy < NCHK) { const int yh = lane >> 5, yt = (lane & 31) >> 1, yi = 16 * (lane & 1);
                    const LAS float* ys = (const LAS float*)(C.lds + YSTO) + ((chy & 1) * 2 + yh) * 512 + yt * 32 + yi;
                    bf16* dst = Yd + (size_t)(scan_row(chy * CCH, d, b) + (d ? -1 : 1) * yt) * 512 + hh * 64 + 32 * yh + yi;
                    _Pragma("unroll") for (int q = 0; q < 2; ++q) { const f32x4 a0 = *(const LAS f32x4*)(ys + 8 * q); const f32x4 a1 = *(const LAS f32x4*)(ys + 8 * q + 4);
                        *(u32x4*)(dst + 8 * q) = (u32x4){pk2(a0.x, a0.y), pk2(a0.z, a0.w), pk2(a1.x, a1.y), pk2(a1.z, a1.w)}; } } }
                const int ch = n + 1;
                if (ch >= 0) {
                    if (ch < NCHK) { LAS unsigned char* B = C.lds + (ch & 1) * SLOT;
                        const int irow = lane >> 1; const int ihv = lane & 1;
                        *(LAS u32x4*)(B + S_MM + irow * 48 + ihv * 16) = (u32x4){ring[riE][0], ring[riE][1], ring[riE][2], ring[riE][3]};
                        *(LAS u32x4*)(B + S_MRB + irow * 48 + ihv * 16) = (u32x4){ring[riE][4], ring[riE][5], ring[riE][6], ring[riE][7]};
                        *(LAS u32x4*)(B + S_PP + irow * 48 + ihv * 16) = (u32x4){ring[riE][8], ring[riE][9], ring[riE][10], ring[riE][11]};
                    }
                    issue(ch + DEPTH, ring[riE]);
                }
            });
        }
#undef C5_
#undef WKV_LOOP
#undef WKV_BAR
    }
}

DI void ph_post(const Ctx& C, const bf16* YS, const bf16* R, const bf16* V, const bf16* K, const bf16* A2, const float* ka, const bf16* G, const float* rk, const float* gng, const float* gnb, bf16* OCAT, bool last) {
    const int gw = C.bid * 8 + C.wave, ngw = C.nb * 8, lane = C.lane, nrows = last ? NLAT : MT;
    for (int row = gw; row < nrows; row += ngw) {
        const size_t o = (size_t)row * 512 + 8 * lane;
        float y[8], y1[8]; unpack8(*(const u32x4*)(YS + o), y); unpack8(*(const u32x4*)(YS + (size_t)MT * 512 + o), y1);
#pragma unroll
        for (int e = 0; e < 8; ++e) y[e] += y1[e];
        float r[8], v[8], kx[8], a0[8], a1[8], g[8];
        unpack8(*(const u32x4*)(R + o), r); unpack8(*(const u32x4*)(V + o), v); unpack8(*(const u32x4*)(K + o), kx); unpack8(*(const u32x4*)(A2 + o), a0); unpack8(*(const u32x4*)(A2 + (size_t)MT * 512 + o), a1); unpack8(*(const u32x4*)(G + o), g);
        float bsum = 0.f;
#pragma unroll
        for (int e = 0; e < 8; ++e) { const float kae = ka[8 * lane + e]; bsum += r[e] * (kx[e] * (1.f + (a0[e] - 1.f) * kae) + kx[e] * (1.f + (a1[e] - 1.f) * kae)) * rk[8 * lane + e]; }
        bsum = sum8(bsum);
        float s = 0.f;
#pragma unroll
        for (int e = 0; e < 8; ++e) { y[e] += bsum * v[e]; s += y[e]; }
        const float mu = sum8(s) * (1.f / 64.f); float s2 = 0.f;
#pragma unroll
        for (int e = 0; e < 8; ++e) { y[e] -= mu; s2 += y[e] * y[e]; }
        const float rstd = 1.0f / sqrtf(sum8(s2) * (1.f / 64.f) + GN_EPS);
        float out[8];
#pragma unroll
        for (int e = 0; e < 8; ++e) out[e] = (y[e] * rstd * gng[8 * lane + e] + gnb[8 * lane + e]) * g[e];
        *(u32x4*)(OCAT + (size_t)row * DM + 8 * lane) = pack8(out);
    }
}

DI void ph_topk2(const Ctx& C, const float* AFFT, const float* AFFC, int* ROWS, float* GATE, int* SLOT, bool last) {
    LAS unsigned* bits = (LAS unsigned*)C.lds;
    LAS unsigned* hist = bits + 4096;
    LAS unsigned* ctl = hist + 256;
    LAS unsigned* cnt = ctl + 8;
    const int tid = C.tid, nprob = last ? 128 : 256;
    for (int p = C.bid; p < nprob; p += C.nb) {
        const bool isctx = p >= 128; const int be = p & 127, b = be >> 4, e = be & 15;
        const int n = isctx ? LCX : TL, cap = isctx ? CAPC : CAPL, per = n / 512 > 0 ? n / 512 : 1;
        const float* src = isctx ? AFFC + (size_t)be * LCX : AFFT + (size_t)be * TL;
        __syncthreads();
        for (int t = tid; t < n; t += 512) bits[t] = __builtin_bit_cast(unsigned, src[t]);
        if (tid == 0) { ctl[0] = 0u; ctl[1] = (unsigned)cap; }
        __syncthreads();
        for (int pass = 0; pass < 4; ++pass) {
            const int shift = 24 - 8 * pass;
            if (tid < 256) hist[tid] = 0u;
            __syncthreads();
            const unsigned prefix = ctl[0], himask = pass == 0 ? 0u : (0xFFFFFFFFu << (shift + 8));
            for (int t = tid; t < n; t += 512) { const unsigned v = bits[t]; if ((v & himask) == prefix) __hip_atomic_fetch_add(&hist[(v >> shift) & 255u], 1u, __ATOMIC_RELAXED, __HIP_MEMORY_SCOPE_WORKGROUP); }
            __syncthreads();
            if (tid == 0) { unsigned k = ctl[1], acc = 0u; int bsel = 0;
                for (int bb = 255; bb >= 0; --bb) { const unsigned c = hist[bb]; if (acc + c >= k) { bsel = bb; break; } acc += c; }
                ctl[0] = prefix | ((unsigned)bsel << shift); ctl[1] = k - acc; }
            __syncthreads();
        }
        const unsigned T = ctl[0], keq = ctl[1];
        const int t0 = tid * per; unsigned myc = 0u;
        if (t0 < n) for (int q = 0; q < per; ++q) { const unsigned v = bits[t0 + q]; myc += (v > T ? 0x10000u : 0u) + (v == T ? 1u : 0u); }
        cnt[tid] = myc;
        __syncthreads();
        for (int off = 1; off < 512; off <<= 1) { const unsigned add = tid >= off ? cnt[tid - off] : 0u; __syncthreads(); cnt[tid] += add; __syncthreads(); }
        unsigned before = cnt[tid] - myc;
        if (t0 < n) for (int q = 0; q < per; ++q) { const int t = t0 + q; const unsigned v = bits[t]; const unsigned gtb = before >> 16, eqb = before & 0xFFFFu;
            const bool sel = v > T || (v == T && eqb < keq);
            if (sel) { const int jx = (int)(gtb + (eqb < keq ? eqb : keq));
                const int slot = isctx ? NB * CAPL + b * CAPC + jx : b * CAPL + jx, row = isctx ? NLAT + b * LCX + t : b * TL + t;
                ROWS[e * ESLOTS + slot] = row; GATE[e * ESLOTS + slot] = __builtin_bit_cast(float, v); SLOT[(size_t)row * 16 + e] = slot; }
            before += (v > T ? 0x10000u : 0u) + (v == T ? 1u : 0u); }
    }
}

DI void ph_topk(const Ctx& C, const float* AFFT, const float* AFFC, int* ROWS, float* GATE, int* SLOT, bool last) {
    LAS unsigned long long* key = (LAS unsigned long long*)C.lds;
    const int nprob = last ? 128 : 256;
    for (int p = C.bid; p < nprob; p += C.nb) {
        const bool isctx = p >= 128; const int be = p & 127, b = be >> 4, e = be & 15;
        const int n = isctx ? LCX : TL, cap = isctx ? CAPC : CAPL;
        const float* src = isctx ? AFFC + (size_t)be * LCX : AFFT + (size_t)be * TL;
        __syncthreads();
        for (int t = C.tid; t < n; t += 512) key[t] = ((unsigned long long)__builtin_bit_cast(unsigned, src[t]) << 32) | (unsigned long long)(0xFFFFFFFFu - (unsigned)t);
        __syncthreads();
        for (int k = 2; k <= n; k <<= 1)
            for (int j = k >> 1; j > 0; j >>= 1) {
                for (int q = C.tid; q < n / 2; q += 512) {
                    const int i = ((q & ~(j - 1)) << 1) | (q & (j - 1)), ix = i | j;
                    const unsigned long long a = key[i], bb = key[ix];
                    const bool desc = ((i & k) == 0);
                    if (desc ? (a < bb) : (a > bb)) { key[i] = bb; key[ix] = a; }
                }
                __syncthreads();
            }
        for (int jx = C.tid; jx < cap; jx += 512) {
            const unsigned long long kv = key[jx]; const int t = (int)(0xFFFFFFFFu - (unsigned)(kv & 0xFFFFFFFFull)); const float g = __builtin_bit_cast(float, (unsigned)(kv >> 32));
            const int slot = isctx ? NB * CAPL + b * CAPC + jx : b * CAPL + jx, row = isctx ? NLAT + b * LCX + t : b * TL + t;
            ROWS[e * ESLOTS + slot] = row; GATE[e * ESLOTS + slot] = g; SLOT[(size_t)row * 16 + e] = slot;
        }
    }
}

DI void ph_combine(const Ctx& C, float* xlat, float* xctx, const float* modg2  , const int* SLOT, const bf16* Y2, bool last,
                   const float* ngain  , const float* nmod  , bf16* H) {
    const int gw = C.bid * 8 + C.wave, ngw = C.nb * 8, lane = C.lane, nrows = last ? NLAT : MT;
    for (int row = gw; row < nrows; row += ngw) {
        float* xr = row < NLAT ? xlat + (size_t)row * DM : xctx + (size_t)(row - NLAT) * DM;
        const int mi = row < NLAT ? (row >> 12) : 8;
        const int sv = SLOT[(size_t)row * 16 + (lane & 15)];
        f32x4 acc[4];
#pragma unroll
        for (int j = 0; j < 4; ++j) acc[j] = (f32x4){0.f, 0.f, 0.f, 0.f};
#pragma unroll
        for (int e = 0; e < 16; ++e) {
            const int s = __builtin_amdgcn_readlane(sv, e);
            if (s >= 0) { const bf16* yp = Y2 + ((size_t)e * ESLOTS + s) * DM + 4 * lane;
#pragma unroll
                for (int j = 0; j < 4; ++j) { const u32x2 w = *(const u32x2*)(yp + 256 * j); acc[j] += (f32x4){bflo(w.x), bfhi(w.x), bflo(w.y), bfhi(w.y)}; } }
        }
#pragma unroll
        for (int j = 0; j < 4; ++j) { const int c = 256 * j + 4 * lane; const f32x4 g = *(const f32x4*)(modg2 + mi * 6144 + c); f32x4 x = *(const f32x4*)(xr + c); x += g * acc[j]; *(f32x4*)(xr + c) = x; acc[j] = x; }
        if (ngain) {
            float ss = 0.f;
#pragma unroll
            for (int j = 0; j < 4; ++j) ss += acc[j].x * acc[j].x + acc[j].y * acc[j].y + acc[j].z * acc[j].z + acc[j].w * acc[j].w;
            const float rs = 1.0f / sqrtf(wave_sum(ss) * (1.f / 1024.f) + EPS);
            const float* mp = nmod + mi * 6144;
#pragma unroll
            for (int j = 0; j < 4; ++j) { const int c = 256 * j + 4 * lane;
                const f32x4 g = *(const f32x4*)(ngain + c), sc = *(const f32x4*)(mp + 1024 + c), sh = *(const f32x4*)(mp + c);
                const f32x4 hv = (acc[j] * rs) * g * (sc + 1.0f) + sh;
                *(u32x2*)(H + (size_t)row * DM + c) = (u32x2){pk2(hv.x, hv.y), pk2(hv.z, hv.w)}; }
        }
    }
}

template <int N> struct IC { static constexpr int value = N; };
DI const float* in_ptr(const unsigned char* ws, int k) { const unsigned long long v = ((const unsigned long long*)(ws + 128 * 1024))[k];
    const unsigned lo = __builtin_amdgcn_readfirstlane((unsigned)v), hi = __builtin_amdgcn_readfirstlane((unsigned)(v >> 32));
    return (const float*)(__attribute__((address_space(1))) const float*)(((unsigned long long)hi << 32) | lo); }
template <class T> DI T* launder_ptr(T* p) { unsigned long long v = (unsigned long long)p; unsigned lo = (unsigned)v, hi = (unsigned)(v >> 32); asm volatile("" : "+v"(lo), "+v"(hi));
    lo = __builtin_amdgcn_readfirstlane(lo); hi = __builtin_amdgcn_readfirstlane(hi); return (T*)(__attribute__((address_space(1))) T*)(((unsigned long long)hi << 32) | lo); }
constexpr int N_PHASES = 1 + 23 + 22;
constexpr size_t WS_PTRS = 128 * 1024;
#define P_XC    ((float*)(ws + WS_XC))
#define P_MOD   ((const float*)(ws + WS_MOD))
#define P_HB    ((bf16*)(ws + WS_HB))
#define P_OCAT  ((bf16*)(ws + WS_OCAT))
#define P_AR    (ws + WS_ARENA)
#define P_ROWS  ((int*)(ws + WS_ROWS))
#define P_GATE  ((float*)(ws + WS_GATE))
#define P_SLOT  ((int*)(ws + WS_SLOT))
#define P_AFFT  ((float*)(ws + WS_AFFT))
#define P_AFFC  ((float*)(ws + WS_AFFC))
#define P_W13   ((bf16*)(ws + WS_W13))
#define P_W2    ((bf16*)(ws + WS_W2))
#define P_U     ((bf16*)(P_AR + A_U))
#define P_QPRE  ((float*)(P_AR + A_QPRE))
#define P_KVPRE ((float*)(P_AR + A_KVPRE))
#define P_QB    ((bf16*)(P_AR + A_QB))
#define P_KB    ((bf16*)(P_AR + A_KB))
#define P_VT    ((bf16*)(P_AR + A_VT))
#define P_W     ((float*)(P_AR + A_W))
#define P_KEFF  ((bf16*)(P_AR + A_KEFF))
#define P_R     ((bf16*)(P_AR + A_R))
#define P_V     ((bf16*)(P_AR + A_V))
#define P_KK    ((bf16*)(P_AR + A_KK))
#define P_G     ((bf16*)(P_AR + A_G))
#define P_K     ((bf16*)(P_AR + A_K))
#define P_L     ((bf16*)(P_AR + A_L))
#define P_QN    ((bf16*)(P_AR + A_QN))
#define P_KN    ((bf16*)(P_AR + A_KN))
#define P_VTN   ((bf16*)(P_AR + A_VTN))
#define P_YS    ((bf16*)(P_AR + A_YS))
#define P_IMG   ((bf16*)(P_AR + A_IMG))
#define P_HID   ((bf16*)(P_AR + A_HID))
#define P_Y2    ((bf16*)(P_AR + A_Y2))
#define MODL(i) (P_MOD + (size_t)(i) * 9 * 6144)
#if MOE_F8
#define MOE1_PHASE(NMT) do { pg8::Gemm g{P_HB, P_W13, DM / 2, DM / 2, P_ROWS, SCALE_W, SCALE_ONE}; pg8::OrderMoE S{(NMT), 8, 17, C.nb, C.vcu}; pg8::EpiAdapt<EpiGlu8> E{EpiGlu8{(unsigned char*)P_HID}}; \
        pg8::gemm_phase<pg8::EpiAdapt<EpiGlu8>, pg8::OrderMoE, true>(C.lds, g, S, E, C.tid); } while (0)
#define MOE2_PHASE(NMT) do { pg8::Gemm g{P_HID, P_W2, DM / 2, DM / 2, nullptr, SCALE_W, SCALE_HID}; pg8::OrderMoE S{(NMT), 4, 17, C.nb, C.vcu}; pg8::EpiAdapt<EpiGate> E{EpiGate{P_Y2, P_GATE}}; \
        pg8::gemm_phase<pg8::EpiAdapt<EpiGate>, pg8::OrderMoE, true>(C.lds, g, S, E, C.tid); } while (0)
#else
#define MOE1_PHASE(NMT) do { pg8::Gemm g{P_HB, P_W13, DM, DM, P_ROWS}; pg8::OrderMoE S{(NMT), 8, 17, C.nb, C.vcu}; pg8::EpiAdapt<EpiGlu> E{EpiGlu{P_HID}}; pg8::gemm_phase(C.lds, g, S, E, C.tid); } while (0)
#define MOE2_PHASE(NMT) do { pg8::Gemm g{P_HID, P_W2, DM, DM, nullptr}; pg8::OrderMoE S{(NMT), 4, 17, C.nb, C.vcu}; pg8::EpiAdapt<EpiGate> E{EpiGate{P_Y2, P_GATE}}; pg8::gemm_phase(C.lds, g, S, E, C.tid); } while (0)
#endif
#define RELAUNDER() do { int l_ = C.lane; asm volatile("" : "+v"(l_)); C.lane = l_; C.tid = (C.wave << 6) | l_; } while (0)
__global__ void __launch_bounds__(512, 2) fwd_kernel(Args a) {
    extern __shared__ __attribute__((aligned(16))) unsigned char smem[];
    Ctx C0; C0.lds = (LAS unsigned char*)smem; C0.tid = threadIdx.x; C0.lane = C0.tid & 63; C0.wave = __builtin_amdgcn_readfirstlane(C0.tid >> 6); C0.bid = blockIdx.x; C0.nb = gridDim.x;
    C0.vcu = (C0.nb % 8 == 0) ? (C0.bid % 8) * (C0.nb / 8) + C0.bid / 8 : C0.bid;
    volatile LAS unsigned* bst = (volatile LAS unsigned*)(C0.lds + LDS_BYTES - 16);
#if MEGA
    if (C0.tid == 0) { bst[0] = 0u; bst[1] = 0u; }
    __syncthreads();
    const unsigned bar_x = xcd_barrier_post((unsigned*)(a.ws + WS_CTL) + 4096, bst, C0.tid == 0).x;
#define SEAM() do { if (ph < hi) { XcdBarrier b2_; b2_.bar = (unsigned*)(ws + WS_CTL) + 4096; b2_.x = bar_x; b2_.st = bst; xcd_barrier(b2_, C.tid == 0); } } while (0)
#else
#define SEAM() do { } while (0)
#endif
#if MEGA
    constexpr int lo = 0, hi = N_PHASES;
#else
    const int lo = a.ph_lo, hi = a.ph_hi;
#endif
    int ph = 0;
#ifndef ONLY
#define ONLY -1
#endif
#ifndef REPMASK
#define REPMASK 0
#endif
#ifndef SITE_LO
#define SITE_LO 0
#define SITE_HI 99
#endif
#define PHASE(SITE, ...) do { if ((ONLY < 0 || ONLY == (SITE)) && (SITE) >= SITE_LO && (SITE) <= SITE_HI && ph >= lo && ph < hi) { Ctx C; C.lds = C0.lds; \
        { int w_ = C0.wave; asm volatile("" : "+s"(w_)); unsigned m_ = ~0u; asm volatile("" : "+s"(m_)); int l_ = (int)__builtin_amdgcn_mbcnt_hi(m_, __builtin_amdgcn_mbcnt_lo(m_, 0u)); C.wave = w_; C.lane = l_; C.tid = (w_ << 6) | l_; } \
        { int b_ = C0.bid, n_ = C0.nb, v_ = C0.vcu; asm volatile("" : "+s"(b_), "+s"(n_), "+s"(v_)); C.bid = b_; C.nb = n_; C.vcu = v_; } \
        unsigned z_ = 0u; asm volatile("" : "+s"(z_)); unsigned char* ws = a.ws + z_; float* XL = a.out + z_; const int lq = __builtin_amdgcn_readfirstlane(lp); typedef const __attribute__((address_space(1))) float* gfp_t; const gfp_t* INT_ = (const gfp_t*)(ws + WS_PTRS); (void)INT_; (void)XL; (void)lq; \
        for (int rep_ = 0; rep_ < ((((REPMASK) >> (SITE)) & 1) ? 2 : 1); ++rep_) { __VA_ARGS__; if ((((REPMASK) >> (SITE)) & 1)) __syncthreads(); } ++ph; SEAM(); } else ++ph; } while (0)

    { const int lp = 0;
      PHASE(0, { if (C.bid == 0) { _Pragma("unroll") for (int k = 0; k < 40; ++k) if (C.tid == k) ((const float**)(ws + WS_PTRS))[k] = a.in[k]; }
                 ph_prologue(C, a); }); }

    auto layer_pair = [&](auto lpc) __attribute__((always_inline)) {
        constexpr int lp = decltype(lpc)::value;
        if constexpr (lp == 0) PHASE(1, { const int i = 2 * lq; const float* xl = (i == 0) ? in_ptr(ws, I_X) : XL; const float* xc = (i == 0) ? in_ptr(ws, I_CTX) : P_XC;
                   ph_norm<false>(C, xl, xc, in_ptr(ws, I_N1G) + i * DM, MODL(i), 0, 1024, P_HB, nullptr, nullptr, nullptr, nullptr); });
        PHASE(2, { EpiBf16 E{P_U, EV_INP}; fast_gemm(C, P_HB, DM, (const bf16*)(ws + WS_WEVIN) + (size_t)lq * EV_INP * DM, DM, MT / 256, EV_INP / 256, E); });
        PHASE(3, { EpiBf16 Eq{(bf16*)P_QPRE, 768}; fast_gemm(C, P_U, EV_INP, (const bf16*)(ws + WS_WUQ) + (size_t)lq * 768 * 384, 384, MT / 256, 3, Eq); RELAUNDER();
                   EpiBf16 Ek{(bf16*)P_KVPRE, 1024}; fast_gemm(C, P_U + 384, EV_INP, (const bf16*)(ws + WS_WUKV) + (size_t)lq * 1024 * 256, 256, MT / 256, 4, Ek, true); });
        PHASE(4, ph_mla_fin(C, P_U, (const bf16*)P_QPRE, (const bf16*)P_KVPRE, in_ptr(ws, I_QG) + lq * 96, in_ptr(ws, I_KG) + lq * 96, (const f32x2*)(ws + WS_ROPE), P_QB, P_KB, P_VT));
        PHASE(5, ph_attn_mla2(C, P_QB, P_KB, P_VT, P_OCAT, false, ws, lq));
        PHASE(6, { const int i = 2 * lq; const float* xl = (i == 0) ? in_ptr(ws, I_X) : XL; const float* xc = (i == 0) ? in_ptr(ws, I_CTX) : P_XC;
                   EpiResid E{xl, xc, XL, P_XC, MODL(i) + 2048}; fast_gemm(C, P_OCAT, DM, (const bf16*)(ws + WS_WEVOUT) + (size_t)lq * DM * DM, DM, MT / 256, 4, E); });
        PHASE(7, { const int i = 2 * lq; ph_norm<true>(C, XL, P_XC, in_ptr(ws, I_N2G) + i * DM, MODL(i), 3072, 4096, P_HB, in_ptr(ws, I_ROUTER) + (size_t)i * DM * 16, P_AFFT, P_AFFC, P_SLOT); });
        PHASE(8, ph_topk2(C, P_AFFT, P_AFFC, P_ROWS, P_GATE, P_SLOT, false));
        PHASE(9, { MOE1_PHASE(17); });
        PHASE(10, { MOE2_PHASE(17); });
        PHASE(11, { const int i = 2 * lq; ph_combine(C, XL, P_XC, MODL(i) + 5120, P_SLOT, P_Y2, false, in_ptr(ws, I_N1G) + (i + 1) * DM, MODL(i + 1), P_HB); });
        PHASE(13, { EpiBf16 E{P_U, OD_INP}; fast_gemm(C, P_HB, DM, (const bf16*)(ws + WS_WODIN) + (size_t)lq * OD_INP * DM, DM, MT / 256, OD_INP / 256, E); });
        PHASE(14, ph_prep(C, P_U, in_ptr(ws, I_SHIFTW) + (size_t)lq * 3 * RW_IN, in_ptr(ws, I_KKW) + lq * 512, in_ptr(ws, I_NAQG) + lq * 64, in_ptr(ws, I_NAKG) + lq * 64, P_R, P_V, P_K, P_KK, P_L, P_QN, P_KN, P_VTN));
        PHASE(15, { const bf16* WL = (const bf16*)(ws + WS_WLORA) + (size_t)lq * 655360;
                    { EpiLoraW E{P_W, in_ptr(ws, I_W0) + lq * 1024}; fast_gemm(C, P_L, 384, WL, 256, MT / 256, 4, E); } RELAUNDER();
                    { EpiLoraA E{P_KEFF, in_ptr(ws, I_A0) + lq * 1024}; fast_gemm(C, P_L, 384, WL + (size_t)1024 * 256, 256, MT / 256, 4, E, true); } RELAUNDER();
                    { EpiBf16 E{P_G, 512}; fast_gemm(C, P_L + 128, 384, WL + (size_t)2048 * 256, 256, MT / 256, 2, E); } });
        PHASE(16, ph_wkv_pre(C, P_R, P_K, P_KK, P_W, P_KEFF, in_ptr(ws, I_KA) + lq * 512, P_IMG));
        PHASE(17, { ph_wkv_chunk(C, P_R, P_V, P_K, P_KK, P_W, P_KEFF, in_ptr(ws, I_KA) + lq * 512, P_IMG, P_YS); __syncthreads();
                    ph_natten2(C, P_QN, P_KN, P_VTN, P_OCAT, in_ptr(ws, I_RPB) + (size_t)lq * 8 * 465, lq == 1, (unsigned*)(ws + WS_CTL) + 8192 + 64 * lq, ws, lq); });
        PHASE(18, ph_post(C, P_YS, P_R, P_V, P_K, P_KEFF, in_ptr(ws, I_KA) + lq * 512, P_G, in_ptr(ws, I_RK) + lq * 512, in_ptr(ws, I_GNG) + lq * 512, in_ptr(ws, I_GNB) + lq * 512, P_OCAT, lq == 1));
        PHASE(19, { const int i = 2 * lq + 1; EpiResid E{XL, P_XC, XL, P_XC, MODL(i) + 2048};
                    fast_gemm(C, P_OCAT, DM, (const bf16*)(ws + WS_WODOUT) + (size_t)lq * DM * DM, DM, (lq == 1) ? NLAT / 256 : MT / 256, 4, E); });
        PHASE(20, { const int i = 2 * lq + 1; ph_norm<true>(C, XL, P_XC, in_ptr(ws, I_N2G) + i * DM, MODL(i), 3072, 4096, P_HB, in_ptr(ws, I_ROUTER) + (size_t)i * DM * 16, P_AFFT, P_AFFC, P_SLOT); });
        PHASE(21, ph_topk2(C, P_AFFT, P_AFFC, P_ROWS, P_GATE, P_SLOT, lq == 1));
        PHASE(22, { MOE1_PHASE((lq == 1) ? 16 : 17); });
        PHASE(23, { MOE2_PHASE((lq == 1) ? 16 : 17); });
        PHASE(24, { const int i = 2 * lq + 1;
                    if (lp == 0) ph_combine(C, XL, P_XC, MODL(i) + 5120, P_SLOT, P_Y2, false, in_ptr(ws, I_N1G) + (i + 1) * DM, MODL(i + 1), P_HB);
                    else ph_combine(C, XL, P_XC, MODL(i) + 5120, P_SLOT, P_Y2, true, nullptr, nullptr, nullptr); });
    };
    layer_pair(IC<0>{}); layer_pair(IC<1>{});
}

extern "C" void kernel_launch(void* const* d_in, const int* in_sizes, int n_in, void* d_out, int out_size, void* d_ws, size_t ws_size, hipStream_t stream) {
    static int grid = 0;
    if (grid == 0) {
        if (n_in != 40 || out_size != NLAT * DM || ws_size < WS_END) { fprintf(stderr, "kernel_launch: unexpected shapes (n_in %d out %d ws %zu need %zu)\n", n_in, out_size, ws_size, (size_t)WS_END); grid = -1; return; }
        int dev = 0, cus = 0, per_cu = 0;
        if (hipGetDevice(&dev) != hipSuccess || hipDeviceGetAttribute(&cus, hipDeviceAttributeMultiprocessorCount, dev) != hipSuccess) { grid = -1; return; }
        if (hipFuncSetAttribute((const void*)fwd_kernel, hipFuncAttributeMaxDynamicSharedMemorySize, LDS_BYTES) != hipSuccess) { fprintf(stderr, "kernel_launch: hipFuncSetAttribute failed\n"); grid = -1; return; }
        if (hipOccupancyMaxActiveBlocksPerMultiprocessor(&per_cu, (const void*)fwd_kernel, 512, LDS_BYTES) != hipSuccess || per_cu < 1) { fprintf(stderr, "kernel_launch: occupancy query says %d\n", per_cu); per_cu = 1; }
        (void)hipGetLastError();
        grid = cus;
    }
    if (grid < 0) return;
    (void)hipMemsetAsync((char*)d_ws + WS_CTL, 0, CTL_BYTES, stream);
    Args a{};
    for (int i = 0; i < 40; ++i) a.in[i] = (const float*)d_in[i];
    a.out = (float*)d_out; a.ws = (unsigned char*)d_ws;
#if MEGA
    a.ph_lo = 0; a.ph_hi = N_PHASES;
    hipLaunchKernelGGL(fwd_kernel, dim3(grid), dim3(512), LDS_BYTES, stream, a);
#else
    for (int p = 0; p < N_PHASES; ++p) { a.ph_lo = p; a.ph_hi = p + 1; hipLaunchKernelGGL(fwd_kernel, dim3(grid), dim3(512), LDS_BYTES, stream, a); }
#endif
}
```

```cpp
#include <hip/hip_runtime.h>
#include <cstdio>
#include <cstdint>

#ifndef MEGA
#define MEGA 1
#endif

#define LAS __attribute__((address_space(3)))
#define DI __device__ __forceinline__

typedef unsigned short bf16;
typedef short bf16x8 __attribute__((ext_vector_type(8)));
typedef float f32x4 __attribute__((ext_vector_type(4)));
typedef float f32x2 __attribute__((ext_vector_type(2)));
typedef float f32x16 __attribute__((ext_vector_type(16)));
typedef unsigned u32x4 __attribute__((ext_vector_type(4)));
typedef unsigned u32x2 __attribute__((ext_vector_type(2)));
typedef __bf16 bf16x2_t __attribute__((ext_vector_type(2)));

constexpr int DM = 1024, NB = 8, TL = 4096, LCX = 256;
constexpr int NLAT = NB * TL, NCTX = NB * LCX, MT = NLAT + NCTX;
constexpr int KPOS = TL + LCX;
constexpr float EPS = 1e-6f, GN_EPS = 64e-5f;
constexpr int EV_IN = 1696, EV_INP = 1792, OD_IN = 3456, OD_INP = 3584, RW_IN = 1920;
constexpr int NEXP = 16, CAPL = 512, CAPC = 32, ESLOTS = NB * CAPL + NB * CAPC;
constexpr float LOG2E = 1.4426950408889634f;

constexpr size_t MiB = 1ull << 20;
constexpr size_t WS_CTL = 0, CTL_BYTES = 1 * MiB;
constexpr size_t WS_MOD = 1 * MiB, WS_ROPE = 2 * MiB, WS_XC = 4 * MiB;
constexpr size_t WS_ROWS = 12 * MiB, WS_GATE = 12 * MiB + 512 * 1024, WS_SLOT = 13 * MiB, WS_AFFT = 16 * MiB, WS_AFFC = 18 * MiB;
constexpr size_t WS_WEVIN = 20 * MiB, WS_WEVOUT = 27 * MiB, WS_WUQ = 31 * MiB, WS_WUKV = 33 * MiB, WS_WODIN = 34 * MiB, WS_WODOUT = 48 * MiB, WS_WLORA = 52 * MiB;
constexpr size_t WS_W13 = 56 * MiB, WS_W2 = 120 * MiB, WS_HB = 152 * MiB, WS_OCAT = 220 * MiB, WS_ARENA = 288 * MiB;
constexpr size_t A_U = 0, A_QPRE = 119 * MiB, A_KVPRE = 221 * MiB, A_QB = 357 * MiB, A_KB = 408 * MiB, A_VT = 459 * MiB;
constexpr size_t A_W = 0, A_KEFF = 136 * MiB  , A_G = 204 * MiB, A_R = 238 * MiB, A_V = 272 * MiB, A_KK = 306 * MiB, A_K = 340 * MiB, A_L = 374 * MiB,
                 A_QN = 400 * MiB, A_KN = 434 * MiB, A_VTN = 468 * MiB, A_YS = 612 * MiB  ;
constexpr size_t A_HID = 0, A_Y2 = 136 * MiB;
constexpr size_t A_IMG = 510 * MiB;
constexpr size_t WS_END = WS_ARENA + 680 * MiB;
constexpr int LDS_BYTES = 147456;

DI unsigned pk2(float lo, float hi) { f32x2 v = {lo, hi}; bf16x2_t b = __builtin_convertvector(v, bf16x2_t); return __builtin_bit_cast(unsigned, b); }
DI float bflo(unsigned u) { return __builtin_bit_cast(float, u << 16); }
DI float bfhi(unsigned u) { return __builtin_bit_cast(float, u & 0xffff0000u); }
DI float bf2f(bf16 x) { return __builtin_bit_cast(float, ((unsigned)x) << 16); }
DI bf16 f2bf(float f) { return (bf16)(pk2(f, 0.f) & 0xffffu); }
DI void unpack8(u32x4 v, float (&f)[8]) { f[0] = bflo(v.x); f[1] = bfhi(v.x); f[2] = bflo(v.y); f[3] = bfhi(v.y); f[4] = bflo(v.z); f[5] = bfhi(v.z); f[6] = bflo(v.w); f[7] = bfhi(v.w); }
DI u32x4 pack8(const float (&f)[8]) { u32x4 r; r.x = pk2(f[0], f[1]); r.y = pk2(f[2], f[3]); r.z = pk2(f[4], f[5]); r.w = pk2(f[6], f[7]); return r; }
#define DPP_ADD(x, ctrl) ((x) + __builtin_bit_cast(float, __builtin_amdgcn_update_dpp(0, __builtin_bit_cast(int, (x)), (ctrl), 0xf, 0xf, false)))
#define DPP_MAX(x, ctrl) fmaxf((x), __builtin_bit_cast(float, __builtin_amdgcn_update_dpp(0, __builtin_bit_cast(int, (x)), (ctrl), 0xf, 0xf, false)))
DI float sum8(float x) { x = DPP_ADD(x, 0xB1); x = DPP_ADD(x, 0x4E); x = DPP_ADD(x, 0x141); return x; }
DI float sum16(float x) { x = DPP_ADD(x, 0xB1); x = DPP_ADD(x, 0x4E); x = DPP_ADD(x, 0x141); x = DPP_ADD(x, 0x140); return x; }
DI float max16(float x) { x = DPP_MAX(x, 0xB1); x = DPP_MAX(x, 0x4E); x = DPP_MAX(x, 0x141); x = DPP_MAX(x, 0x140); return x; }
DI float rdlane(float x, int l) { return __builtin_bit_cast(float, __builtin_amdgcn_readlane(__builtin_bit_cast(int, x), l)); }
DI float wave_sum(float v) { const float x = sum16(v); return (rdlane(x, 0) + rdlane(x, 16)) + (rdlane(x, 32) + rdlane(x, 48)); }
DI float xor32(float v, int lane) { return __builtin_bit_cast(float, __builtin_amdgcn_ds_bpermute((lane ^ 32) << 2, __builtin_bit_cast(int, v))); }
typedef int v8i_t __attribute__((ext_vector_type(8)));
typedef int i32x4_t __attribute__((ext_vector_type(4)));
DI unsigned pk4_fp8(float a, float b, float c, float d) {
    a = __builtin_amdgcn_fmed3f(a, -448.f, 448.f); b = __builtin_amdgcn_fmed3f(b, -448.f, 448.f); c = __builtin_amdgcn_fmed3f(c, -448.f, 448.f); d = __builtin_amdgcn_fmed3f(d, -448.f, 448.f);
    int p = __builtin_amdgcn_cvt_pk_fp8_f32(a, b, 0, false); p = __builtin_amdgcn_cvt_pk_fp8_f32(c, d, p, true); return (unsigned)p; }
#ifndef MOE_F8
#define MOE_F8 1
#endif
constexpr int SCALE_ONE = 0x7f7f7f7f, SCALE_W = 0x79797979  , SCALE_HID = 0x7c7c7c7c  ;
DI float sigmoidf_(float x) { return __builtin_amdgcn_rcpf(1.f + __expf(-x)); }
DI float siluf_(float x) { return x * __builtin_amdgcn_rcpf(1.f + __expf(-x)); }
#define MFMA32(a, b, c) __builtin_amdgcn_mfma_f32_32x32x16_bf16((a), (b), (c), 0, 0, 0)

#define XB_TMO      128
#define XB_XCNT(j)  (256  + 64 * (j))
#define XB_XSUB(j)  (1280 + 64 * (j))
#define XB_XGEN(j)  (2304 + 64 * (j))
#define XB_TOP      3328
#define XB_TOPGEN   3392
#define XCD_BAR_WORDS 3456
#define XB_SPIN_CAP (1u << 22)
__device__ __forceinline__ unsigned xb_ld(unsigned* p)              { return __hip_atomic_load(p, __ATOMIC_RELAXED, __HIP_MEMORY_SCOPE_AGENT); }
__device__ __forceinline__ unsigned xb_add(unsigned* p, unsigned v) { return __hip_atomic_fetch_add(p, v, __ATOMIC_RELAXED, __HIP_MEMORY_SCOPE_AGENT); }
__device__ __forceinline__ unsigned xb_xcc_id() { return (unsigned)__builtin_amdgcn_s_getreg((3 << 11) | 20) & 0xFu; }
#define XB_SPIN(cond, bar) do { unsigned _sp = 0; while (cond) { __builtin_amdgcn_s_sleep(1); \
    if ((++_sp & 255u) == 0u) { if (xb_ld(&(bar)[XB_TMO])) break; if (_sp > XB_SPIN_CAP) { atomicAdd(&(bar)[XB_TMO], 1u); break; } } } } while (0)
struct XcdBarrier { unsigned* bar; unsigned x; volatile LAS unsigned* st; };
__device__ __forceinline__ XcdBarrier xcd_barrier_post(unsigned* bar, volatile LAS unsigned* st, bool leader) {
    XcdBarrier b; b.bar = bar; b.x = xb_xcc_id(); b.st = st;
    if (leader) (void)xb_add(&bar[XB_XCNT(b.x)], 1u);
    return b;
}
__device__ __forceinline__ void xcd_barrier_complete(unsigned* bar, unsigned x, unsigned& nloc, unsigned& nx) {
    const unsigned G = gridDim.x * gridDim.y * gridDim.z;
    unsigned sum, cnt, mine, sp = 0u;
    for (;;) {
        sum = 0u; cnt = 0u; mine = 0u;
#pragma unroll
        for (unsigned j = 0; j < 16; ++j) { const unsigned c = xb_ld(&bar[XB_XCNT(j)]); sum += c; cnt += (c > 0u) ? 1u : 0u; mine = (j == x) ? c : mine; }
        if (sum == G) break;
        __builtin_amdgcn_s_sleep(1);
        if ((++sp & 255u) == 0u) { if (xb_ld(&bar[XB_TMO])) break; if (sp > XB_SPIN_CAP) { atomicAdd(&bar[XB_TMO], 1u); break; } }
    }
    nloc = mine > 0u ? mine : 1u; nx = cnt > 0u ? cnt : 1u;
}
__device__ __forceinline__ void xcd_barrier(const XcdBarrier& b, bool leader) {
    asm volatile("s_waitcnt vmcnt(0)" ::: "memory");
    __syncthreads();
    if (leader) {
        unsigned* bar = b.bar;
        __builtin_amdgcn_s_waitcnt(0);
        unsigned nloc = b.st[0], nx = b.st[1];
        if (nloc == 0u) { xcd_barrier_complete(bar, b.x, nloc, nx); b.st[0] = nloc; b.st[1] = nx; }
        const unsigned old = xb_add(&bar[XB_XSUB(b.x)], 1u);
        const unsigned gen = old / nloc;
        if (old + 1u == (gen + 1u) * nloc) {
            __builtin_amdgcn_fence(__ATOMIC_RELEASE, "agent");
            asm volatile("s_waitcnt vmcnt(0)" ::: "memory");
            const unsigned og = xb_add(&bar[XB_TOP], 1u);
            const unsigned tg = og / nx;
            if (og + 1u == (tg + 1u) * nx) xb_add(&bar[XB_TOPGEN], 1u);
            else XB_SPIN(xb_ld(&bar[XB_TOPGEN]) == tg, bar);
            __builtin_amdgcn_fence(__ATOMIC_ACQUIRE, "agent");
            xb_add(&bar[XB_XGEN(b.x)], 1u);
            asm volatile("s_waitcnt vmcnt(0)" ::: "memory");
        } else {
            XB_SPIN(xb_ld(&bar[XB_XGEN(b.x)]) == gen, bar);
            __builtin_amdgcn_fence(__ATOMIC_ACQUIRE, "agent");
            asm volatile("s_waitcnt vmcnt(0)" ::: "memory");
        }
    }
    __syncthreads();
}

struct Ctx { LAS unsigned char* lds; int tid, lane, wave, bid, nb, vcu; };
struct Args { const float* in[40]; float* out; unsigned char* ws; int ph_lo, ph_hi; };
enum { I_X = 0, I_C, I_CTX, I_CCTX, I_ADAW, I_ADAB, I_N1G, I_N2G, I_EVWIN, I_EVWOUT, I_QNORM, I_WUQ, I_KVNORM, I_WUKV, I_QG, I_KG, I_DWW, I_DWB, I_LNG, I_LNB,
       I_ODWIN, I_ODWOUT, I_SHIFTW, I_W0, I_W2L, I_A0, I_A2, I_G2, I_KKW, I_KA, I_RK, I_GNG, I_GNB, I_NAQG, I_NAKG, I_RPB, I_ROUTER, I_MW1, I_MW3, I_MW2 };

DI void transpose_item(const float* __restrict__ W, int K, int N, bf16* __restrict__ WT, int dst_row0, const float* __restrict__ gain, LAS float* scr, int k0, int n0, int lane) {
#pragma unroll 8
    for (int i = 0; i < 32; ++i) { const int kk = 2 * i + (lane >> 5); float v = W[(size_t)(k0 + kk) * N + n0 + (lane & 31)]; if (gain) v *= gain[k0 + kk]; scr[kk * 33 + (lane & 31)] = v; }
    asm volatile("s_waitcnt lgkmcnt(0)" ::: "memory");
    const int c = lane & 7;
#pragma unroll
    for (int j = 0; j < 4; ++j) { const int n = (lane >> 3) + 8 * j; const LAS float* s = scr + (8 * c) * 33 + n;
        u32x4 o; o.x = pk2(s[0 * 33], s[1 * 33]); o.y = pk2(s[2 * 33], s[3 * 33]); o.z = pk2(s[4 * 33], s[5 * 33]); o.w = pk2(s[6 * 33], s[7 * 33]);
        *(u32x4*)(WT + (size_t)(dst_row0 + n) * K + k0 + 8 * c) = o; }
    asm volatile("s_waitcnt lgkmcnt(0)" ::: "memory");
}
DI void transpose_item64(const float* __restrict__ W, int K, int N, bf16* __restrict__ WT, int dst_row0, LAS float* scr, int k0, int n0, int lane) {
    f32x4 v[16];
#pragma unroll
    for (int i = 0; i < 16; ++i) v[i] = *(const f32x4*)(W + (size_t)(k0 + 4 * i + (lane >> 4)) * N + n0 + 4 * (lane & 15));
#pragma unroll
    for (int i = 0; i < 16; ++i) { LAS float* d = scr + (4 * i + (lane >> 4)) * 65 + 4 * (lane & 15); d[0] = v[i].x; d[1] = v[i].y; d[2] = v[i].z; d[3] = v[i].w; }
    asm volatile("s_waitcnt lgkmcnt(0)" ::: "memory");
    const int c = lane & 7;
#pragma unroll
    for (int j = 0; j < 8; ++j) { const int n = (lane >> 3) + 8 * j; const LAS float* s = scr + (8 * c) * 65 + n;
        u32x4 o; o.x = pk2(s[0 * 65], s[1 * 65]); o.y = pk2(s[2 * 65], s[3 * 65]); o.z = pk2(s[4 * 65], s[5 * 65]); o.w = pk2(s[6 * 65], s[7 * 65]);
        *(u32x4*)(WT + (size_t)(dst_row0 + n) * K + k0 + 8 * c) = o; }
    asm volatile("s_waitcnt lgkmcnt(0)" ::: "memory");
}
DI void transpose_item64_f8(const float* __restrict__ W, int K, int N, unsigned char* __restrict__ WT8, int dst_row0, LAS float* scr, int k0, int n0, int lane) {
    f32x4 v[16];
#pragma unroll
    for (int i = 0; i < 16; ++i) v[i] = *(const f32x4*)(W + (size_t)(k0 + 4 * i + (lane >> 4)) * N + n0 + 4 * (lane & 15));
#pragma unroll
    for (int i = 0; i < 16; ++i) { LAS float* d = scr + (4 * i + (lane >> 4)) * 65 + 4 * (lane & 15); d[0] = v[i].x; d[1] = v[i].y; d[2] = v[i].z; d[3] = v[i].w; }
    asm volatile("s_waitcnt lgkmcnt(0)" ::: "memory");
    const int c = lane & 7;
#pragma unroll
    for (int j = 0; j < 8; ++j) { const int n = (lane >> 3) + 8 * j; const LAS float* s = scr + (8 * c) * 65 + n;
        u32x2 o; o.x = pk4_fp8(64.f * s[0 * 65], 64.f * s[1 * 65], 64.f * s[2 * 65], 64.f * s[3 * 65]); o.y = pk4_fp8(64.f * s[4 * 65], 64.f * s[5 * 65], 64.f * s[6 * 65], 64.f * s[7 * 65]);
        *(u32x2*)(WT8 + (size_t)(dst_row0 + n) * K + k0 + 8 * c) = o; }
    asm volatile("s_waitcnt lgkmcnt(0)" ::: "memory");
}
DI void transpose_matrix(const Ctx& C, const float* W, int K, int N, bf16* WT, const float* gain, int mode  ) {
    LAS float* scr = (LAS float*)(C.lds + C.wave * 8704);
    const int nkb = K / 64, nnb = N / 32, nit = nkb * nnb, gw = C.vcu * 8 + C.wave, ngw = C.nb * 8;
    for (int it = gw; it < nit; it += ngw) {
        const int kb = it / nnb, nbk = it % nnb, n0 = nbk * 32;
        int d0 = n0; if (mode) d0 = (n0 >> 7) * 256 + (n0 & 127) + (mode == 2 ? 128 : 0);
        transpose_item(W, K, N, WT, d0, gain, scr, kb * 64, n0, C.lane);
    }
}

DI void ph_prologue(const Ctx& C, const Args& a) {
    unsigned char* ws = a.ws;
    {
        LAS float* sv = (LAS float*)C.lds;
        LAS float* red = sv + 9 * 1024;
        for (int i = C.tid; i < 9 * 1024; i += 512) { const int m = i >> 10, k = i & 1023; const float c = (m < 8) ? a.in[I_C][m * 1024 + k] : a.in[I_CCTX][k]; sv[i] = siluf_(c); }
        __syncthreads();
        float* MOD = (float*)(ws + WS_MOD);
        for (int it = C.bid; it < 4 * 96; it += C.nb) {
            const int layer = it / 96, col = (it % 96) * 64 + C.lane;
            const float* wp = a.in[I_ADAW] + (size_t)layer * 1024 * 6144 + col;
            float acc[9];
#pragma unroll
            for (int m = 0; m < 9; ++m) acc[m] = 0.f;
            const int kb = C.wave * 128;
#pragma unroll 4
            for (int k = 0; k < 128; ++k) { const float w = wp[(size_t)(kb + k) * 6144];
#pragma unroll
                for (int m = 0; m < 9; ++m) acc[m] += sv[m * 1024 + kb + k] * w; }
#pragma unroll
            for (int m = 0; m < 9; ++m) red[(C.wave * 9 + m) * 64 + C.lane] = acc[m];
            __syncthreads();
            for (int i = C.tid; i < 576; i += 512) { const int m = i >> 6, l = i & 63; float s = 0.f;
#pragma unroll
                for (int w = 0; w < 8; ++w) s += red[(w * 9 + m) * 64 + l];
                const int cc = (it % 96) * 64 + l;
                MOD[(size_t)(layer * 9 + m) * 6144 + cc] = s + a.in[I_ADAB][layer * 6144 + cc]; }
            __syncthreads();
        }
    }
    {
        f32x2* CS = (f32x2*)(ws + WS_ROPE);
        for (int i = C.bid * 512 + C.tid; i < 4096 * 16; i += C.nb * 512) {
            const int pos = i >> 4, j = i & 15, f = j & 7;
            const float inv = powf(10000.f, -(float)(2 * f) / 16.f);
            const float ang = (float)((j < 8) ? (pos >> 6) : (pos & 63)) * inv;
            const double tw = 6.283185307179586476925;
            const double x = (double)ang, n = __builtin_rint(x / tw), rr = x - n * tw;
            CS[i] = (f32x2){__cosf((float)rr), __sinf((float)rr)};
        }
    }
    for (int j = 0; j < 2; ++j) {
        transpose_matrix(C, a.in[I_EVWIN] + (size_t)j * DM * EV_IN, DM, EV_IN, (bf16*)(ws + WS_WEVIN) + (size_t)j * EV_INP * DM, nullptr, 0);
        transpose_matrix(C, a.in[I_EVWOUT] + (size_t)j * DM * DM, DM, DM, (bf16*)(ws + WS_WEVOUT) + (size_t)j * DM * DM, nullptr, 0);
        transpose_matrix(C, a.in[I_WUQ] + (size_t)j * 384 * 768, 384, 768, (bf16*)(ws + WS_WUQ) + (size_t)j * 768 * 384, a.in[I_QNORM] + j * 384, 0);
        transpose_matrix(C, a.in[I_WUKV] + (size_t)j * 256 * 1024, 256, 1024, (bf16*)(ws + WS_WUKV) + (size_t)j * 1024 * 256, a.in[I_KVNORM] + j * 256, 0);
        transpose_matrix(C, a.in[I_ODWIN] + (size_t)j * DM * OD_IN, DM, OD_IN, (bf16*)(ws + WS_WODIN) + (size_t)j * OD_INP * DM, nullptr, 0);
        transpose_matrix(C, a.in[I_ODWOUT] + (size_t)j * DM * DM, DM, DM, (bf16*)(ws + WS_WODOUT) + (size_t)j * DM * DM, nullptr, 0);
    }
    {
        const int gt = C.bid * 512 + C.tid, ngt = C.nb * 512;
        for (int j = 0; j < 2; ++j) {
            u32x4* p0 = (u32x4*)((bf16*)(ws + WS_WEVIN) + (size_t)j * EV_INP * DM + (size_t)EV_IN * DM);
            for (int i = gt; i < (EV_INP - EV_IN) * DM / 8; i += ngt) p0[i] = (u32x4){0u, 0u, 0u, 0u};
            u32x4* p1 = (u32x4*)((bf16*)(ws + WS_WODIN) + (size_t)j * OD_INP * DM + (size_t)OD_IN * DM);
            for (int i = gt; i < (OD_INP - OD_IN) * DM / 8; i += ngt) p1[i] = (u32x4){0u, 0u, 0u, 0u};
            bf16* WL = (bf16*)(ws + WS_WLORA) + (size_t)j * 655360;
            const float* w2 = a.in[I_W2L] + (size_t)j * 2 * 64 * 512; const float* a2 = a.in[I_A2] + (size_t)j * 2 * 64 * 512; const float* g2 = a.in[I_G2] + (size_t)j * 128 * 512;
            for (int i = gt; i < 655360; i += ngt) {
                const int n = i >> 8, k = i & 255; float v = 0.f;
                if (n < 1024) { const int d = n >> 9, c = n & 511; if (k >= d * 64 && k < d * 64 + 64) v = w2[(size_t)k * 512 + c]; }
                else if (n < 2048) { const int d = (n - 1024) >> 9, c = n & 511; if (k >= 128 + d * 64 && k < 192 + d * 64) v = a2[(size_t)(k - 128) * 512 + c]; }
                else { const int c = n - 2048; if (k >= 128) v = g2[(size_t)(k - 128) * 512 + c]; }
                WL[i] = f2bf(v);
            }
        }
    }
}

template <bool ROUTER>
DI void ph_norm(const Ctx& C, const float* xlat, const float* xctx, const float* gain, const float* mod  , int shift_off, int scale_off, bf16* H,
                const float* router  , float* AFFT, float* AFFC, int* SLOT) {
    LAS float* RT = (LAS float*)C.lds;
    if (ROUTER) { for (int i = C.tid; i < 16384; i += 512) { const int c = i >> 4, e = i & 15; RT[e * 1024 + c] = router[i]; } __syncthreads(); }
    const int gw = C.bid * 8 + C.wave, ngw = C.nb * 8, lane = C.lane;
    for (int row = gw; row < MT; row += ngw) {
        const float* xr = row < NLAT ? xlat + (size_t)row * DM : xctx + (size_t)(row - NLAT) * DM;
        const int mi = row < NLAT ? (row >> 12) : 8;
        const float* mp = mod + mi * 6144;
        f32x4 v[4]; float ss = 0.f;
#pragma unroll
        for (int j = 0; j < 4; ++j) { v[j] = *(const f32x4*)(xr + 256 * j + 4 * lane); ss += v[j].x * v[j].x + v[j].y * v[j].y + v[j].z * v[j].z + v[j].w * v[j].w; }
        ss = wave_sum(ss);
        const float rs = 1.0f / sqrtf(ss * (1.f / 1024.f) + EPS);
#pragma unroll
        for (int j = 0; j < 4; ++j) {
            const int c = 256 * j + 4 * lane;
            const f32x4 g = *(const f32x4*)(gain + c), sc = *(const f32x4*)(mp + scale_off + c), sh = *(const f32x4*)(mp + shift_off + c);
            v[j] = (v[j] * rs) * g * (sc + 1.0f) + sh;
            if (ROUTER && MOE_F8) *(unsigned*)((unsigned char*)H + (size_t)row * DM + c) = pk4_fp8(v[j].x, v[j].y, v[j].z, v[j].w);
            else *(u32x2*)(H + (size_t)row * DM + c) = (u32x2){pk2(v[j].x, v[j].y), pk2(v[j].z, v[j].w)};
        }
        if (ROUTER) {
            float mylg = 0.f;
#pragma unroll 1
            for (int e = 0; e < 16; ++e) { float p = 0.f;
#pragma unroll
                for (int j = 0; j < 4; ++j) { const f32x4 w = *(const LAS f32x4*)(RT + e * 1024 + 256 * j + 4 * lane); p += v[j].x * w.x + v[j].y * w.y + v[j].z * w.z + v[j].w * w.w; }
                p = wave_sum(p); mylg = (lane == e) ? p : mylg; }
            const float mx = max16(mylg);
            const float ex = expf(mylg - mx);
            const float mine = ex / sum16(ex);
            if (lane < 16) {
                if (row < NLAT) AFFT[(size_t)((row >> 12) * 16 + lane) * TL + (row & 4095)] = mine;
                else { const int rc = row - NLAT; AFFC[(size_t)((rc >> 8) * 16 + lane) * LCX + (rc & 255)] = mine; }
                SLOT[(size_t)row * 16 + lane] = -1;
            }
        }
    }
}


struct EpiBf16 { static constexpr bool WIDE = true; bf16* O; int ldo;
    DI void operator()(int row, int col, f32x4 v0, f32x4 v1) const { bf16* p = O + (size_t)row * ldo + col;
        *(u32x2*)p = (u32x2){pk2(v0[0], v0[1]), pk2(v0[2], v0[3])}; *(u32x2*)(p + 128) = (u32x2){pk2(v1[0], v1[1]), pk2(v1[2], v1[3])}; }
    DI void wide(int row, int col, f32x4 a0, f32x4 a1, f32x4 b0, f32x4 b1) const { bf16* p = O + (size_t)row * ldo + col;
        *(u32x4*)p = (u32x4){pk2(a0[0], a0[1]), pk2(a0[2], a0[3]), pk2(a1[0], a1[1]), pk2(a1[2], a1[3])}; *(u32x4*)(p + 128) = (u32x4){pk2(b0[0], b0[1]), pk2(b0[2], b0[3]), pk2(b1[0], b1[1]), pk2(b1[2], b1[3])}; } };
struct EpiF32 { static constexpr bool WIDE = false; float* O; int ldo;
    DI void operator()(int row, int col, f32x4 v0, f32x4 v1) const { float* p = O + (size_t)row * ldo + col; *(f32x4*)p = v0; *(f32x4*)(p + 128) = v1; } };
struct EpiResid { static constexpr bool WIDE = false; const float* xin_lat; const float* xin_ctx; float* xout_lat; float* xout_ctx; const float* modg;
    DI void operator()(int row, int col, f32x4 v0, f32x4 v1) const {
        const float* xi; float* xo; int mi;
        if (row < NLAT) { xi = xin_lat + (size_t)row * DM; xo = xout_lat + (size_t)row * DM; mi = row >> 12; }
        else { xi = xin_ctx + (size_t)(row - NLAT) * DM; xo = xout_ctx + (size_t)(row - NLAT) * DM; mi = 8; }
        const float* g = modg + mi * 6144 + col;
        const f32x4 g0 = *(const f32x4*)g, g1 = *(const f32x4*)(g + 128), x0 = *(const f32x4*)(xi + col), x1 = *(const f32x4*)(xi + col + 128);
        *(f32x4*)(xo + col) = x0 + g0 * v0; *(f32x4*)(xo + col + 128) = x1 + g1 * v1; } };
struct EpiGlu { static constexpr bool WIDE = false; bf16* O;
    DI void operator()(int row, int col, f32x4 v0, f32x4 v1) const { const int f = ((col & 2047) >> 8) * 128 + (col & 255);
        *(u32x2*)(O + (size_t)row * DM + f) = (u32x2){pk2(siluf_(v0[0]) * v1[0], siluf_(v0[1]) * v1[1]), pk2(siluf_(v0[2]) * v1[2], siluf_(v0[3]) * v1[3])}; } };
struct EpiGlu8 { static constexpr bool WIDE = true; unsigned char* O;
    DI void operator()(int row, int col, f32x4 v0, f32x4 v1) const { const int f = ((col & 2047) >> 8) * 128 + (col & 255);
        *(unsigned*)(O + (size_t)row * DM + f) = pk4_fp8(8.f * siluf_(v0[0]) * v1[0], 8.f * siluf_(v0[1]) * v1[1], 8.f * siluf_(v0[2]) * v1[2], 8.f * siluf_(v0[3]) * v1[3]); }
    DI void wide(int row, int col, f32x4 a0, f32x4 a1, f32x4 b0, f32x4 b1) const { const int f = ((col & 2047) >> 8) * 128 + (col & 255);
        *(u32x2*)(O + (size_t)row * DM + f) = (u32x2){pk4_fp8(8.f * siluf_(a0[0]) * b0[0], 8.f * siluf_(a0[1]) * b0[1], 8.f * siluf_(a0[2]) * b0[2], 8.f * siluf_(a0[3]) * b0[3]),
                                                    pk4_fp8(8.f * siluf_(a1[0]) * b1[0], 8.f * siluf_(a1[1]) * b1[1], 8.f * siluf_(a1[2]) * b1[2], 8.f * siluf_(a1[3]) * b1[3])}; } };
struct EpiGate { static constexpr bool WIDE = true; bf16* O; const float* gate;
    DI void operator()(int row, int col, f32x4 v0, f32x4 v1) const { const float g = gate[row]; bf16* p = O + (size_t)row * DM + (col & 1023);
        *(u32x2*)p = (u32x2){pk2(v0[0] * g, v0[1] * g), pk2(v0[2] * g, v0[3] * g)}; *(u32x2*)(p + 128) = (u32x2){pk2(v1[0] * g, v1[1] * g), pk2(v1[2] * g, v1[3] * g)}; }
    DI void wide(int row, int col, f32x4 a0, f32x4 a1, f32x4 b0, f32x4 b1) const { const float g = gate[row]; bf16* p = O + (size_t)row * DM + (col & 1023);
        *(u32x4*)p = (u32x4){pk2(a0[0] * g, a0[1] * g), pk2(a0[2] * g, a0[3] * g), pk2(a1[0] * g, a1[1] * g), pk2(a1[2] * g, a1[3] * g)};
        *(u32x4*)(p + 128) = (u32x4){pk2(b0[0] * g, b0[1] * g), pk2(b0[2] * g, b0[3] * g), pk2(b1[0] * g, b1[1] * g), pk2(b1[2] * g, b1[3] * g)}; } };
struct EpiLoraW { static constexpr bool WIDE = false; float* W; const float* w0;
    DI void one(int row, int col, f32x4 v) const { const int d = col >> 9, c = col & 511; f32x4 o;
#pragma unroll
        for (int e = 0; e < 4; ++e) { const float lw = w0[col + e] + v[e]; const float z = -lw; const float sp = fmaxf(z, 0.f) + __logf(1.f + __expf(-fabsf(z))); o[e] = -__expf(-sp - 0.5f); }
        *(f32x4*)(W + ((size_t)d * MT + row) * 512 + c) = o; }
    DI void operator()(int row, int col, f32x4 v0, f32x4 v1) const { one(row, col, v0); one(row, col + 128, v1); } };
struct EpiLoraA { static constexpr bool WIDE = false; bf16* Aout; const float* a0;
    DI void one(int row, int col, f32x4 v) const { const int d = col >> 9, c = col & 511; const f32x4 b = *(const f32x4*)(a0 + col);
        *(u32x2*)(Aout + ((size_t)d * MT + row) * 512 + c) = (u32x2){pk2(sigmoidf_(b[0] + v[0]), sigmoidf_(b[1] + v[1])), pk2(sigmoidf_(b[2] + v[2]), sigmoidf_(b[3] + v[3]))}; }
    DI void operator()(int row, int col, f32x4 v0, f32x4 v1) const { one(row, col, v0); one(row, col + 128, v1); } };

namespace pg8 {
constexpr int BM = 256, BK = 64, HALF = 128, HTB = HALF * BK * 2, STAGE_BYTES = 8 * HTB;
DI int lds_byte(int r, int c) { const int st = (r >> 4) * 2 + (c >> 5), rr = r & 15, cc = c & 31, ob = rr * 64 + cc * 2; return st * 1024 + (ob ^ (((ob >> 9) & 1) << 5)); }
DI void stage_rc(int b, int& R, int& C) { const int st = b / 1024, sb = b % 1024, swz = sb ^ (((sb >> 9) & 1) << 5); R = (st >> 1) * 16 + swz / 64; C = (st & 1) * 32 + (swz % 64) / 2; }
DI int perm32(int rho) { const int n = rho >> 4, i = rho & 15; return 8 * (i >> 2) + 4 * n + (i & 3); }
struct Unit { int pm, pn; };
struct Gemm { const bf16* A; const bf16* Bt; int lda, K; const int* rows; int scale_w = 0x7f7f7f7f, scale_a = 0x7f7f7f7f; };
struct OrderMN { int nM, nN, G, c;
    DI bool next(int i, Unit& u) const { const int L = i * G + c; if (L >= nM * nN) return false; u.pm = L / nN; u.pn = L % nN; return true; } };
struct OrderMoE { int nMt, nN, mstride  , G, c;
    DI bool next(int i, Unit& u) const { const int L = i * G + c, per = nMt * nN; if (L >= NEXP * per) return false; const int e = L / per, q = L % per; u.pm = e * mstride + q / nN; u.pn = e * nN + q % nN; return true; } };
template <class E4> struct EpiAdapt { E4 e;
    DI void operator()(const f32x4 (&acc)[2][2][4][2], const Unit& u, int wr, int wc, int fr, int fq) const {
#pragma unroll
        for (int ai = 0; ai < 2; ++ai)
#pragma unroll
            for (int m = 0; m < 4; ++m) { const int row = u.pm * BM + ai * HALF + wr * 64 + m * 16 + fr;
                if constexpr (E4::WIDE) e.wide(row, u.pn * BM + wc * 32 + 8 * fq, acc[ai][0][m][0], acc[ai][0][m][1], acc[ai][1][m][0], acc[ai][1][m][1]);
                else {
#pragma unroll
                    for (int n = 0; n < 2; ++n) e(row, u.pn * BM + wc * 32 + 8 * fq + 4 * n, acc[ai][0][m][n], acc[ai][1][m][n]); } } } };

template <class Epi, class Sched, bool F8 = false>
DI void gemm_phase(LAS unsigned char* lds, const Gemm g, const Sched& S, const Epi& E, const int tid) {
    const int wid = __builtin_amdgcn_readfirstlane(tid >> 6), lane = tid & 63, wr = wid >> 2, wc = wid & 3, fr = lane & 15, fq = lane >> 4;
    const int K = g.K, nt = K / BK;
    unsigned voffB[2];
#pragma unroll
    for (int i = 0; i < 2; ++i) { int R, C; stage_rc(tid * 16 + i * 8192, R, C); const int Rb = (R & ~31) + perm32(R & 31); voffB[i] = (unsigned)(Rb * K + C) * 2u; }
    const size_t kstep = (size_t)(BK * 2), hstep = (size_t)HALF * K * 2, tstep = 2 * hstep;
    const unsigned ldsw = (unsigned)wid * 1024u;
    const int aoff = lds_byte(wr * 64 + fr, fq * 8), boff = lds_byte(wc * 32 + fr, fq * 8);
    const char* const gA = (const char*)g.A;
#define PG8_SA(b, h) (((b) * 2 + (h)) * HTB)
#define PG8_SB(b, h) ((4 + (b) * 2 + (h)) * HTB)
#define PG8_STAGE(bufoff, gbase, voff) do { _Pragma("unroll") for (int _i = 0; _i < 2; ++_i) \
        __builtin_amdgcn_global_load_lds((const unsigned*)((const char*)(gbase) + (voff)[_i]), (LAS unsigned*)(lds + (bufoff) + ldsw + _i * 8192), 16, 0, 0); } while (0)
#define PG8_LDA(dst, b, h) do { _Pragma("unroll") for (int m = 0; m < 4; ++m) _Pragma("unroll") for (int k = 0; k < 2; ++k) dst[m][k] = *(const LAS bf16x8*)(lds + PG8_SA(b, h) + aoff + m * 2048 + k * 1024); } while (0)
#define PG8_LDB(dst, b, h) do { _Pragma("unroll") for (int n = 0; n < 2; ++n) _Pragma("unroll") for (int k = 0; k < 2; ++k) dst[n][k] = *(const LAS bf16x8*)(lds + PG8_SB(b, h) + boff + n * 2048 + k * 1024); } while (0)
#define PG8_MMA(ai, bj, At, Bt) do { __builtin_amdgcn_s_setprio(1); _Pragma("unroll") for (int m = 0; m < 4; ++m) _Pragma("unroll") for (int n = 0; n < 2; ++n) { \
        if constexpr (F8) { const v8i_t w8 = __builtin_shufflevector(__builtin_bit_cast(i32x4_t, Bt[n][0]), __builtin_bit_cast(i32x4_t, Bt[n][1]), 0, 1, 2, 3, 4, 5, 6, 7), x8 = __builtin_shufflevector(__builtin_bit_cast(i32x4_t, At[m][0]), __builtin_bit_cast(i32x4_t, At[m][1]), 0, 1, 2, 3, 4, 5, 6, 7); \
            acc[ai][bj][m][n] = __builtin_amdgcn_mfma_scale_f32_16x16x128_f8f6f4(w8, x8, acc[ai][bj][m][n], 0, 0, 0, g.scale_w, 0, g.scale_a); } \
        else { _Pragma("unroll") for (int k = 0; k < 2; ++k) acc[ai][bj][m][n] = __builtin_amdgcn_mfma_f32_16x16x32_bf16(Bt[n][k], At[m][k], acc[ai][bj][m][n], 0, 0, 0); } } __builtin_amdgcn_s_setprio(0); } while (0)
#define PG8_WAIT_V(n) asm volatile("s_waitcnt vmcnt(" #n ")" ::: "memory")
#define PG8_WAIT_L(n) asm volatile("s_waitcnt lgkmcnt(" #n ")" ::: "memory")
#define PG8_BAR __builtin_amdgcn_s_barrier()
#define PG8_SCHED __builtin_amdgcn_sched_barrier(0)
#define PG8_ROWIDX(ri, u) do { _Pragma("unroll") for (int _h = 0; _h < 2; ++_h) _Pragma("unroll") for (int _i = 0; _i < 2; ++_i) { int _R, _C; stage_rc(tid * 16 + _i * 8192, _R, _C); (void)_C; \
        const int _lr = (u).pm * BM + _h * HALF + _R; ri[_h][_i] = g.rows ? g.rows[_lr] : _lr; } } while (0)
#define PG8_AOFF_FROM(vo, ri) do { _Pragma("unroll") for (int _h = 0; _h < 2; ++_h) _Pragma("unroll") for (int _i = 0; _i < 2; ++_i) { int _R, _C; stage_rc(tid * 16 + _i * 8192, _R, _C); (void)_R; \
        vo[_h][_i] = (unsigned)(((size_t)ri[_h][_i] * g.lda + _C) * 2u); } } while (0)
    Unit cur, nxt; int ui = 0;
    if (!S.next(0, cur)) return;
    f32x4 acc[2][2][4][2];
#pragma unroll
    for (int a = 0; a < 2; ++a)
#pragma unroll
        for (int b = 0; b < 2; ++b)
#pragma unroll
            for (int m = 0; m < 4; ++m)
#pragma unroll
                for (int n = 0; n < 2; ++n) acc[a][b][m][n] = (f32x4){0.f, 0.f, 0.f, 0.f};
    bf16x8 At[4][2], B0[2][2], B1[2][2];
    unsigned cvo[2][2]; int nri[2][2];
    PG8_ROWIDX(nri, cur); PG8_AOFF_FROM(cvo, nri);
    const char* cB = (const char*)g.Bt + (size_t)cur.pn * tstep;
    PG8_STAGE(PG8_SB(0, 0), cB, voffB); PG8_STAGE(PG8_SB(0, 1), cB + hstep, voffB); PG8_STAGE(PG8_SA(0, 0), gA, cvo[0]); PG8_STAGE(PG8_SA(0, 1), gA, cvo[1]);
    if (wr == 1) PG8_BAR;
    PG8_WAIT_V(2); PG8_BAR;
    PG8_STAGE(PG8_SB(1, 0), cB + kstep, voffB); PG8_STAGE(PG8_SA(1, 0), gA + kstep, cvo[0]); PG8_STAGE(PG8_SB(1, 1), cB + hstep + kstep, voffB);
    PG8_WAIT_V(6); PG8_BAR;
    for (;;) {
        const bool has_next = S.next(ui + 1, nxt);
        const char* nB = has_next ? (const char*)g.Bt + (size_t)nxt.pn * tstep : cB;
#pragma nounroll
        for (int t = 0; t < nt; t += 2) {
            const bool last = (t == nt - 2);
            const char* a1 = gA + (size_t)(t + 1) * kstep;
            const char* a2 = last ? gA : gA + (size_t)(t + 2) * kstep; const char* b2 = last ? nB : cB + (size_t)(t + 2) * kstep;
            const char* a3 = a2 + kstep; const char* b3 = b2 + kstep;
            if (t == nt - 4 && has_next) PG8_ROWIDX(nri, nxt);
            PG8_LDB(B0, 0, 0); PG8_LDB(B1, 0, 1); PG8_SCHED; PG8_LDA(At, 0, 0); PG8_STAGE(PG8_SA(1, 1), a1, cvo[1]);
            if (last && has_next) { if (nt < 4) PG8_ROWIDX(nri, nxt); PG8_AOFF_FROM(cvo, nri); }
            PG8_WAIT_V(8); PG8_WAIT_L(0); PG8_BAR; PG8_MMA(0, 0, At, B0); PG8_MMA(0, 1, At, B1); PG8_BAR; PG8_SCHED;
            PG8_LDA(At, 0, 1); PG8_STAGE(PG8_SB(0, 0), b2, voffB); PG8_STAGE(PG8_SB(0, 1), b2 + hstep, voffB); PG8_STAGE(PG8_SA(0, 0), a2, cvo[0]);
            PG8_WAIT_V(8); PG8_WAIT_L(0); PG8_BAR; PG8_MMA(1, 0, At, B0); PG8_MMA(1, 1, At, B1); PG8_BAR; PG8_SCHED;
            PG8_LDB(B0, 1, 0); PG8_LDB(B1, 1, 1); PG8_SCHED; PG8_LDA(At, 1, 0); PG8_STAGE(PG8_SA(0, 1), a2, cvo[1]);
            PG8_WAIT_V(8); PG8_WAIT_L(0); PG8_BAR; PG8_MMA(0, 0, At, B0); PG8_MMA(0, 1, At, B1); PG8_BAR; PG8_SCHED;
            PG8_LDA(At, 1, 1); PG8_STAGE(PG8_SB(1, 0), b3, voffB); PG8_STAGE(PG8_SB(1, 1), b3 + hstep, voffB); PG8_STAGE(PG8_SA(1, 0), a3, cvo[0]);
            PG8_WAIT_V(8); PG8_WAIT_L(0); PG8_BAR; PG8_MMA(1, 0, At, B0); PG8_MMA(1, 1, At, B1); PG8_BAR; PG8_SCHED;
        }
        if (wr == 0) PG8_BAR;
        E(acc, cur, wr, wc, fr, fq);
        if (!has_next) break;
#pragma unroll
        for (int a = 0; a < 2; ++a)
#pragma unroll
            for (int b = 0; b < 2; ++b)
#pragma unroll
                for (int m = 0; m < 4; ++m)
#pragma unroll
                    for (int n = 0; n < 2; ++n) acc[a][b][m][n] = (f32x4){0.f, 0.f, 0.f, 0.f};
        cur = nxt; cB = nB; ++ui;
        if (wr == 1) PG8_BAR;
    }
    PG8_WAIT_V(0);
    PG8_BAR;
#undef PG8_SA
#undef PG8_SB
#undef PG8_STAGE
#undef PG8_LDA
#undef PG8_LDB
#undef PG8_MMA
#undef PG8_WAIT_V
#undef PG8_WAIT_L
#undef PG8_BAR
#undef PG8_SCHED
#undef PG8_ROWIDX
#undef PG8_AOFF_FROM
}
}
template <class E4> DI void fast_gemm(const Ctx& C, const bf16* A, int lda, const bf16* Bt, int K, int nM, int nN, const E4& e, bool rev = false) {
    pg8::Gemm g{A, Bt, lda, K, nullptr}; pg8::OrderMN S{nM, nN, C.nb, rev ? C.nb - 1 - C.vcu : C.vcu}; pg8::EpiAdapt<E4> E{e};
    pg8::gemm_phase(C.lds, g, S, E, C.tid);
}

DI float max16_acc(float m, const f32x16& x) {
    asm volatile("s_nop 15\n\tv_max3_f32 %0, %0, %1, %2\n\tv_max3_f32 %0, %0, %3, %4\n\tv_max3_f32 %0, %0, %5, %6\n\tv_max3_f32 %0, %0, %7, %8\n\tv_max3_f32 %0, %0, %9, %10\n\tv_max3_f32 %0, %0, %11, %12\n\tv_max3_f32 %0, %0, %13, %14\n\tv_max3_f32 %0, %0, %15, %16"
                 : "+v"(m) : "v"(x[0]), "v"(x[1]), "v"(x[2]), "v"(x[3]), "v"(x[4]), "v"(x[5]), "v"(x[6]), "v"(x[7]), "v"(x[8]), "v"(x[9]), "v"(x[10]), "v"(x[11]), "v"(x[12]), "v"(x[13]), "v"(x[14]), "v"(x[15]));
    return m; }
DI int swap23(int x) { return (x & ~12) | ((x & 4) << 1) | ((x & 8) >> 1); }
DI void flash_store(const f32x16 (&o)[2], float l, bf16* orow  , int h) {
    const float inv = 1.f / l;
#pragma unroll
    for (int dt = 0; dt < 2; ++dt)
#pragma unroll
        for (int g = 0; g < 4; ++g)
            *(u32x2*)(orow + 32 * dt + 8 * g + 4 * h) = (u32x2){pk2(o[dt][4 * g] * inv, o[dt][4 * g + 1] * inv), pk2(o[dt][4 * g + 2] * inv, o[dt][4 * g + 3] * inv)};
}


template <int DQK> struct AttnGeo { static constexpr int KSTR = DQK * 2 + 16, KBYTES = 64 * KSTR, VSTR = 144, VBYTES = 64 * VSTR, BUF = KBYTES + VBYTES, KPIECES = 64 * DQK / 8; };
template <int DQK, bool NAT>
DI void attn_tile_loop(const Ctx& C, f32x16 (&o)[2], float& l, const bf16x8 (&qf)[DQK / 16], const bf16* __restrict__ Kb, const bf16* __restrict__ Vt, int pos1, int n1, int pos2, int n2,
                       const LAS float* tab, int grow, int rs, int qc, int cs) {
    typedef AttnGeo<DQK> G;
    const int tid = C.tid, r = C.lane & 31, h = C.lane >> 5, kr = swap23(r), ntiles = n1 + n2;
    constexpr bool K2 = G::KPIECES > 512;
    const int kq0 = tid, kq1 = tid + 512;
    const int kl0 = (kq0 / (DQK / 8)) * G::KSTR + (kq0 % (DQK / 8)) * 16, kl1 = (kq1 / (DQK / 8)) * G::KSTR + (kq1 % (DQK / 8)) * 16;
    const int vl = G::KBYTES + (tid >> 3) * G::VSTR + (tid & 7) * 16;
    const bf16* vg = Vt + (size_t)(tid >> 3) * KPOS + 8 * (tid & 7);
    u32x4 rk0, rk1, rv;
    rk1 = (u32x4){0u, 0u, 0u, 0u};
#define ATT_POS(t) ((t) < n1 ? pos1 + 64 * (t) : pos2 + 64 * ((t) - n1))
    { const int pos0 = ATT_POS(0); rk0 = *(const u32x4*)(Kb + (size_t)pos0 * DQK + 8 * kq0); if (K2 && tid < 256) rk1 = *(const u32x4*)(Kb + (size_t)pos0 * DQK + 8 * kq1); rv = *(const u32x4*)(vg + pos0); }
    __syncthreads();
    *(LAS u32x4*)(C.lds + kl0) = rk0; if (K2 && tid < 256) *(LAS u32x4*)(C.lds + kl1) = rk1; *(LAS u32x4*)(C.lds + vl) = rv;
    __syncthreads();
    float mref = 0.f; bool first = true;
    constexpr float THR = 8.f;
    for (int t = 0; t < ntiles; ++t) {
        const LAS unsigned char* B = C.lds + (t & 1) * G::BUF;
        if (t + 1 < ntiles) { const int pos0 = ATT_POS(t + 1);
            rk0 = *(const u32x4*)(Kb + (size_t)pos0 * DQK + 8 * kq0); if (K2 && tid < 256) rk1 = *(const u32x4*)(Kb + (size_t)pos0 * DQK + 8 * kq1); rv = *(const u32x4*)(vg + pos0); }
        const int gr = (pos1 >> 6) + t;
        const bool active = !NAT || t >= n1 || (gr >= rs && gr < rs + 8);
        if (active) {
            f32x16 sc[2];
#pragma unroll
            for (int j = 0; j < 2; ++j) {
#pragma unroll
                for (int i = 0; i < 16; ++i) sc[j][i] = -mref;
                const LAS unsigned char* kp = B + (32 * j + kr) * G::KSTR + 16 * h;
#pragma unroll
                for (int kk = 0; kk < DQK / 16; ++kk) sc[j] = MFMA32(*(const LAS bf16x8*)(kp + 32 * kk), qf[kk], sc[j]);
            }
            if (NAT && t < n1) {
                const LAS float* trow = tab + (gr - grow + 7) * 31;
#pragma unroll
                for (int j = 0; j < 2; ++j)
#pragma unroll
                    for (int i = 0; i < 16; ++i) {
                        const int cc = 32 * j + ((i & 3) | (((i >> 2) & 1) << 2) | (h << 3) | ((i >> 3) << 4)); const bool ok = (cc >= cs) && (cc < cs + 16);
                        int dc = cc - qc + 15; dc = dc < 0 ? 0 : (dc > 30 ? 30 : dc);
                        sc[j][i] = ok ? sc[j][i] + trow[dc] : -1e30f;
                    }
            }
            float mx = max16_acc(max16_acc(-3.0e38f, sc[0]), sc[1]);
            if (first || __builtin_amdgcn_ballot_w64(mx > THR) != 0ull) {
                mx = fmaxf(mx, xor32(mx, C.lane));
                const float delta = first ? mx : fmaxf(mx, 0.f);
#pragma unroll
                for (int i = 0; i < 16; ++i) { sc[0][i] -= delta; sc[1][i] -= delta; }
                if (!first) { const float alpha = __builtin_amdgcn_exp2f(-delta); l *= alpha;
#pragma unroll
                    for (int i = 0; i < 16; ++i) { o[0][i] *= alpha; o[1][i] *= alpha; } }
                mref += delta; first = false;
            }
            f32x2 rs2 = {0.f, 0.f};
#pragma unroll
            for (int j = 0; j < 2; ++j)
#pragma unroll
                for (int i = 0; i < 16; i += 2) { sc[j][i] = __builtin_amdgcn_exp2f(sc[j][i]); sc[j][i + 1] = __builtin_amdgcn_exp2f(sc[j][i + 1]); rs2 += (f32x2){sc[j][i], sc[j][i + 1]}; }
            l += rs2.x + rs2.y;
#pragma unroll
            for (int j = 0; j < 2; ++j)
#pragma unroll
                for (int s2 = 0; s2 < 2; ++s2) {
                    u32x4 pw; pw.x = pk2(sc[j][8 * s2], sc[j][8 * s2 + 1]); pw.y = pk2(sc[j][8 * s2 + 2], sc[j][8 * s2 + 3]); pw.z = pk2(sc[j][8 * s2 + 4], sc[j][8 * s2 + 5]); pw.w = pk2(sc[j][8 * s2 + 6], sc[j][8 * s2 + 7]);
                    const bf16x8 pb = __builtin_bit_cast(bf16x8, pw);
#pragma unroll
                    for (int dt = 0; dt < 2; ++dt) o[dt] = MFMA32(*(const LAS bf16x8*)(B + G::KBYTES + (32 * dt + r) * G::VSTR + (32 * j + 16 * s2 + 8 * h) * 2), pb, o[dt]);
                }
        }
        if (t + 1 < ntiles) { LAS unsigned char* Bn = C.lds + ((t + 1) & 1) * G::BUF;
            *(LAS u32x4*)(Bn + kl0) = rk0; if (K2 && tid < 256) *(LAS u32x4*)(Bn + kl1) = rk1; *(LAS u32x4*)(Bn + vl) = rv; }
        __syncthreads();
    }
    l += xor32(l, C.lane);
#undef ATT_POS
}
DI void conv_unit(const Ctx& C, int u, const bf16* U, const float (&wk)[31], float bias, const float* lng, const float* lnb, bf16* OCAT);
DI void wprep_items(const Ctx& C, int k0, int k1, const float* w1, const float* w3, const float* w2, bf16* W13, bf16* W2);
DI const float* in_ptr(const unsigned char* ws, int k);
DI void ph_attn_mla2(const Ctx& C, const bf16* QB, const bf16* KB, const bf16* VT, bf16* OCAT, bool last, unsigned char* ws, int lq) {
    const int r = C.lane & 31, h = C.lane >> 5;
    const int nunits = 1024 + (last ? 0 : 64);
    const int nwp = (NEXP * 3 * 256 + C.nb * 8 - 1) / (C.nb * 8);
    int k = 0;
    for (;; ++k) {
        const int u = C.vcu + k * C.nb, cu = (C.nb - 1 - C.vcu) + k * C.nb;
        const bool a_on = u < nunits, c_on = cu < MT / 32, w_on = 2 * k < nwp;
        if (!a_on && !c_on && !w_on) break;
        if (a_on) {
            const int bh = u < 1024 ? (u >> 4) : u - 1024, qblk = u < 1024 ? (u & 15) : 16, b = bh >> 3, hh = bh & 7;
            const int qpos = qblk * 256 + 32 * C.wave + r;
            const bf16* qp = QB + ((size_t)bh * KPOS + qpos) * 96 + 8 * h;
            bf16x8 qf[6];
#pragma unroll
            for (int kk = 0; kk < 6; ++kk) qf[kk] = *(const bf16x8*)(qp + 16 * kk);
            f32x16 o[2];
#pragma unroll
            for (int i = 0; i < 16; ++i) { o[0][i] = 0.f; o[1][i] = 0.f; }
            float l = 0.f;
            attn_tile_loop<96, false>(C, o, l, qf, KB + (size_t)bh * KPOS * 96, VT + (size_t)bh * 64 * KPOS, qblk < 16 ? 0 : TL, qblk < 16 ? KPOS / 64 : LCX / 64, 0, 0, nullptr, 0, 0, 0, 0);
            const int row = qblk < 16 ? b * TL + qpos : NLAT + b * LCX + (qpos - TL);
            flash_store(o, l, OCAT + (size_t)row * DM + hh * 64, h);
        }
        if (c_on) { float wk[31]; const float* dww = in_ptr(ws, I_DWW) + (size_t)lq * 31 * 512;
#pragma unroll
            for (int kt = 0; kt < 31; ++kt) wk[kt] = dww[kt * 512 + C.tid];
            conv_unit(C, cu, (const bf16*)(ws + WS_ARENA + A_U), wk, in_ptr(ws, I_DWB)[lq * 512 + C.tid], in_ptr(ws, I_LNG) + lq * 512, in_ptr(ws, I_LNB) + lq * 512, OCAT); }
        if (w_on) { __syncthreads(); const size_t wo = (size_t)(2 * lq) * NEXP * DM * DM;
            wprep_items(C, 2 * k, 2 * k + 2, in_ptr(ws, I_MW1) + wo, in_ptr(ws, I_MW3) + wo, in_ptr(ws, I_MW2) + wo, (bf16*)(ws + WS_W13), (bf16*)(ws + WS_W2)); }
    }
}
DI void ph_natten2(const Ctx& C, const bf16* QN, const bf16* KN, const bf16* VTN, bf16* OCAT, const float* rpb  , bool last, unsigned* work_ctr, unsigned char* ws, int lq) {
    const int r = C.lane & 31, h = C.lane >> 5;
    LAS float* tab = (LAS float*)(C.lds + 2 * AttnGeo<64>::BUF);
    LAS int* uslot = (LAS int*)(tab + 480);
    const int nunits = 1024 + (last ? 0 : 64);
    const int nwp = (NEXP * 3 * 256 + C.nb * 8 - 1) / (C.nb * 8); int wdone = 0;
    for (;;) {
        __syncthreads();
        if (wdone < nwp) { const size_t wo = (size_t)(2 * lq + 1) * NEXP * DM * DM; wprep_items(C, wdone, wdone + 2, in_ptr(ws, I_MW1) + wo, in_ptr(ws, I_MW3) + wo, in_ptr(ws, I_MW2) + wo, (bf16*)(ws + WS_W13), (bf16*)(ws + WS_W2)); wdone += 2; __syncthreads(); }
        if (C.tid == 0) *uslot = (int)__hip_atomic_fetch_add(work_ctr, 1u, __ATOMIC_RELAXED, __HIP_MEMORY_SCOPE_AGENT);
        __syncthreads();
        const int u = *uslot;
        if (u >= nunits) { if (wdone < nwp) { const size_t wo = (size_t)(2 * lq + 1) * NEXP * DM * DM; wprep_items(C, wdone, nwp, in_ptr(ws, I_MW1) + wo, in_ptr(ws, I_MW3) + wo, in_ptr(ws, I_MW2) + wo, (bf16*)(ws + WS_W13), (bf16*)(ws + WS_W2)); } break; }
        const bool isctx = u >= 1024;
        const int bh = isctx ? u - 1024 : (u >> 4), b = bh >> 3, hh = bh & 7;
        for (int i = C.tid; i < 465; i += 512) tab[i] = rpb[hh * 465 + i] * LOG2E;
        int qpos, row, grow = 0, qc = 0, rs = 0, cs = 0, rlo = 0, nband = 0;
        if (!isctx) { const int rg = u & 15; grow = 4 * rg + (C.wave >> 1); qc = 32 * (C.wave & 1) + r; qpos = grow * 64 + qc; row = b * TL + qpos;
            rs = grow - 4; rs = rs < 0 ? 0 : (rs > 56 ? 56 : rs); cs = qc - 8; cs = cs < 0 ? 0 : (cs > 48 ? 48 : cs);
            rlo = 4 * rg - 4; rlo = rlo < 0 ? 0 : (rlo > 56 ? 56 : rlo); int rhi = 4 * rg + 3 - 4; rhi = rhi < 0 ? 0 : (rhi > 56 ? 56 : rhi); nband = rhi + 8 - rlo; }
        else { qpos = TL + 32 * C.wave + r; row = NLAT + b * LCX + 32 * C.wave + r; }
        const bf16* qp = QN + ((size_t)bh * KPOS + qpos) * 64 + 8 * h;
        bf16x8 qf[4];
#pragma unroll
        for (int kk = 0; kk < 4; ++kk) qf[kk] = *(const bf16x8*)(qp + 16 * kk);
        f32x16 o[2];
#pragma unroll
        for (int i = 0; i < 16; ++i) { o[0][i] = 0.f; o[1][i] = 0.f; }
        float l = 0.f;
        attn_tile_loop<64, true>(C, o, l, qf, KN + (size_t)bh * KPOS * 64, VTN + (size_t)bh * 64 * KPOS, rlo * 64, nband, TL, LCX / 64, tab, grow, rs, qc, cs);
        flash_store(o, l, OCAT + (size_t)row * DM + 512 + hh * 64, h);
    }
}


DI void ph_mla_fin(const Ctx& C, const bf16* U, const bf16* QPRE, const bf16* KVPRE, const float* qg, const float* kg, const f32x2* CS, bf16* QB, bf16* KB, bf16* VT) {
    LAS bf16* VL = (LAS bf16*)C.lds;
    const int lane = C.lane, j = lane >> 3, sub = lane & 7;
    const float C2 = 0.10206207261596575f * LOG2E;
    float qgn[8], qgr[4], kgn[8], kgr[4];
#pragma unroll
    for (int e = 0; e < 8; ++e) { qgn[e] = qg[8 * sub + e] * C2; kgn[e] = kg[8 * sub + e]; }
#pragma unroll
    for (int m = 0; m < 4; ++m) { qgr[m] = qg[64 + sub + 8 * m] * C2; kgr[m] = kg[64 + sub + 8 * m]; }
    for (int u = C.vcu; u < MT / 64; u += C.nb) {
        const int row0 = 64 * u, b = row0 < NLAT ? (row0 >> 12) : ((row0 - NLAT) >> 8), pos0 = row0 < NLAT ? (row0 & 4095) : TL + ((row0 - NLAT) & 255);
        const bool lat = row0 < NLAT;
        const int pl = 8 * C.wave + j, row = row0 + pl, pos = pos0 + pl;
        const bf16* ur = U + (size_t)row * EV_INP;
        float sq = 0.f, skv = 0.f;
#pragma unroll
        for (int m = 0; m < 6; ++m) { float x[8]; unpack8(*(const u32x4*)(ur + 8 * (sub + 8 * m)), x);
#pragma unroll
            for (int e = 0; e < 8; ++e) sq += x[e] * x[e]; }
#pragma unroll
        for (int m = 0; m < 4; ++m) { float x[8]; unpack8(*(const u32x4*)(ur + 384 + 8 * (sub + 8 * m)), x);
#pragma unroll
            for (int e = 0; e < 8; ++e) skv += x[e] * x[e]; }
        sq = sum8(sq); skv = sum8(skv);
        const float rsq = 1.0f / sqrtf(sq * (1.f / 384.f) + EPS), rskv = 1.0f / sqrtf(skv * (1.f / 256.f) + EPS);
        float krv[4];
#pragma unroll
        for (int m = 0; m < 4; ++m) krv[m] = bf2f(ur[640 + sub + 8 * m]);
        float cr = 1.f, sr = 0.f, cc = 1.f, sc = 0.f;
        if (lat) { const f32x2 a0 = CS[pos * 16 + sub], a1 = CS[pos * 16 + 8 + sub]; cr = a0.x; sr = a0.y; cc = a1.x; sc = a1.y; }
        const bf16* qrow = QPRE + (size_t)row * 768; const bf16* kvrow = KVPRE + (size_t)row * 1024;
#pragma unroll 2
        for (int hh = 0; hh < 8; ++hh) {
            { float qn[8], qr[4]; unpack8(*(const u32x4*)(qrow + hh * 96 + 8 * sub), qn); float ss = 0.f;
#pragma unroll
              for (int e = 0; e < 8; ++e) qn[e] *= rsq;
#pragma unroll
              for (int m = 0; m < 4; ++m) { qr[m] = bf2f(qrow[hh * 96 + 64 + sub + 8 * m]) * rsq; ss += qr[m] * qr[m]; }
#pragma unroll
              for (int e = 0; e < 8; ++e) ss += qn[e] * qn[e];
              const float rn = 1.0f / sqrtf(sum8(ss) * (1.f / 96.f) + EPS);
#pragma unroll
              for (int e = 0; e < 8; ++e) qn[e] *= rn * qgn[e];
#pragma unroll
              for (int m = 0; m < 4; ++m) qr[m] *= rn * qgr[m];
              { const float x0 = qr[0], x1 = qr[1], y0 = qr[2], y1 = qr[3]; qr[0] = x0 * cr - x1 * sr; qr[1] = x1 * cr + x0 * sr; qr[2] = y0 * cc - y1 * sc; qr[3] = y1 * cc + y0 * sc; }
              bf16* qo = QB + ((size_t)(b * 8 + hh) * KPOS + pos) * 96;
              *(u32x4*)(qo + 8 * sub) = pack8(qn);
#pragma unroll
              for (int m = 0; m < 4; ++m) qo[64 + sub + 8 * m] = f2bf(qr[m]); }
            { float kn[8], kr[4]; unpack8(*(const u32x4*)(kvrow + hh * 128 + 8 * sub), kn); float ss = 0.f;
#pragma unroll
              for (int e = 0; e < 8; ++e) kn[e] *= rskv;
#pragma unroll
              for (int m = 0; m < 4; ++m) { kr[m] = krv[m]; ss += kr[m] * kr[m]; }
#pragma unroll
              for (int e = 0; e < 8; ++e) ss += kn[e] * kn[e];
              const float rn = 1.0f / sqrtf(sum8(ss) * (1.f / 96.f) + EPS);
#pragma unroll
              for (int e = 0; e < 8; ++e) kn[e] *= rn * kgn[e];
#pragma unroll
              for (int m = 0; m < 4; ++m) kr[m] *= rn * kgr[m];
              { const float x0 = kr[0], x1 = kr[1], y0 = kr[2], y1 = kr[3]; kr[0] = x0 * cr - x1 * sr; kr[1] = x1 * cr + x0 * sr; kr[2] = y0 * cc - y1 * sc; kr[3] = y1 * cc + y0 * sc; }
              bf16* ko = KB + ((size_t)(b * 8 + hh) * KPOS + pos) * 96;
              *(u32x4*)(ko + 8 * sub) = pack8(kn);
#pragma unroll
              for (int m = 0; m < 4; ++m) ko[64 + sub + 8 * m] = f2bf(kr[m]); }
            { float vv[8]; unpack8(*(const u32x4*)(kvrow + hh * 128 + 64 + 8 * sub), vv);
#pragma unroll
              for (int e = 0; e < 8; ++e) VL[(hh * 64 + 8 * sub + e) * 64 + pl] = f2bf(vv[e] * rskv); }
        }
        __syncthreads();
        { const int hd = C.tid;
            bf16* dst = VT + ((size_t)(b * 8 + (hd >> 6)) * 64 + (hd & 63)) * KPOS + pos0;
#pragma unroll
            for (int q = 0; q < 8; ++q) *(u32x4*)(dst + 8 * q) = *(const LAS u32x4*)(VL + hd * 64 + 8 * q); }
        __syncthreads();
    }
}

DI void conv_unit(const Ctx& C, int u, const bf16* U, const float (&wk)[31], float bias, const float* lng, const float* lnb, bf16* OCAT) {
    LAS float* G = (LAS float*)C.lds;
    const int c = C.tid;
    const int row0 = 32 * u; int base, t0, tseq;
    if (row0 < NLAT) { base = row0 & ~4095; t0 = row0 & 4095; tseq = TL; } else { const int rc = row0 - NLAT; base = NLAT + (rc & ~255); t0 = rc & 255; tseq = LCX; }
    __syncthreads();
    for (int rr = C.wave; rr < 62; rr += 8) { const int tt = t0 - 15 + rr; float g[8];
#pragma unroll
        for (int e = 0; e < 8; ++e) g[e] = 0.f;
        if (tt >= 0 && tt < tseq) { const bf16* ur = U + (size_t)(base + tt) * EV_INP; float av[8], gv[8]; unpack8(*(const u32x4*)(ur + 672 + 8 * C.lane), av); unpack8(*(const u32x4*)(ur + 1184 + 8 * C.lane), gv);
#pragma unroll
            for (int e = 0; e < 8; ++e) g[e] = av[e] * sigmoidf_(gv[e]); }
        *(LAS f32x4*)(G + rr * 512 + 8 * C.lane) = (f32x4){g[0], g[1], g[2], g[3]}; *(LAS f32x4*)(G + rr * 512 + 8 * C.lane + 4) = (f32x4){g[4], g[5], g[6], g[7]}; }
    __syncthreads();
    float acc[32];
#pragma unroll
    for (int t = 0; t < 32; ++t) acc[t] = bias;
#pragma unroll
    for (int rr = 0; rr < 62; ++rr) { const float gv = G[rr * 512 + c];
#pragma unroll
        for (int t = 0; t < 32; ++t) { const int k = rr - t; if (k >= 0 && k < 31) acc[t] += gv * wk[k]; } }
    __syncthreads();
#pragma unroll
    for (int t = 0; t < 32; ++t) G[t * 512 + c] = acc[t];
    __syncthreads();
#pragma unroll
    for (int q = 0; q < 4; ++q) {
        const int t = 4 * C.wave + q, row = row0 + t;
        const f32x4 a0 = *(const LAS f32x4*)(G + t * 512 + 8 * C.lane), a1 = *(const LAS f32x4*)(G + t * 512 + 8 * C.lane + 4);
        float x[8] = {a0.x, a0.y, a0.z, a0.w, a1.x, a1.y, a1.z, a1.w}; float s = 0.f;
#pragma unroll
        for (int e = 0; e < 8; ++e) s += x[e];
        const float mu = wave_sum(s) * (1.f / 512.f); float s2 = 0.f;
#pragma unroll
        for (int e = 0; e < 8; ++e) { x[e] -= mu; s2 += x[e] * x[e]; }
        const float rstd = 1.0f / sqrtf(wave_sum(s2) * (1.f / 512.f) + EPS);
        float y[8];
#pragma unroll
        for (int e = 0; e < 8; ++e) { const float z = x[e] * rstd * lng[8 * C.lane + e] + lnb[8 * C.lane + e]; y[e] = siluf_(z); }
        *(u32x4*)(OCAT + (size_t)row * DM + 512 + 8 * C.lane) = pack8(y);
    }
    __syncthreads();
}
DI void wprep_items(const Ctx& C, int k0, int k1, const float* w1, const float* w3, const float* w2, bf16* W13, bf16* W2) {
    LAS float* scr = (LAS float*)(C.lds + C.wave * 16640);
    const int gw = C.vcu * 8 + C.wave, ngw = C.nb * 8;
    constexpr int PER = 16 * 16, NIT = NEXP * 3 * PER;
    for (int k = k0; k < k1; ++k) { const int it = gw + k * ngw; if (it >= NIT) break;
        const int e = it / (3 * PER), r = it % (3 * PER), which = r / PER, q = r % PER, kb = q / 16, n0 = (q % 16) * 64;
#if MOE_F8
        if (which == 0)      transpose_item64_f8(w1 + (size_t)e * DM * DM, DM, DM, (unsigned char*)W13 + (size_t)e * 2048 * DM, (n0 >> 7) * 256 + (n0 & 127), scr, kb * 64, n0, C.lane);
        else if (which == 1) transpose_item64_f8(w3 + (size_t)e * DM * DM, DM, DM, (unsigned char*)W13 + (size_t)e * 2048 * DM, (n0 >> 7) * 256 + (n0 & 127) + 128, scr, kb * 64, n0, C.lane);
        else                 transpose_item64_f8(w2 + (size_t)e * DM * DM, DM, DM, (unsigned char*)W2 + (size_t)e * DM * DM, n0, scr, kb * 64, n0, C.lane); }
#else
        if (which == 0)      transpose_item64(w1 + (size_t)e * DM * DM, DM, DM, W13 + (size_t)e * 2048 * DM, (n0 >> 7) * 256 + (n0 & 127), scr, kb * 64, n0, C.lane);
        else if (which == 1) transpose_item64(w3 + (size_t)e * DM * DM, DM, DM, W13 + (size_t)e * 2048 * DM, (n0 >> 7) * 256 + (n0 & 127) + 128, scr, kb * 64, n0, C.lane);
        else                 transpose_item64(w2 + (size_t)e * DM * DM, DM, DM, W2 + (size_t)e * DM * DM, n0, scr, kb * 64, n0, C.lane); }
#endif
}
constexpr int WPREP_PER_WAVE = (NEXP * 3 * 256 + 2047) / 2048;

DI void shifted8(const bf16* up, const bf16* uc, const bf16* un, bool hp, bool hn, const float (&s0)[8], const float (&s1)[8], const float (&s2)[8], int c0, float (&o)[8]) {
    const u32x4 z = {0u, 0u, 0u, 0u};
    const u32x4 vp = hp ? *(const u32x4*)(up + c0) : z, vc = *(const u32x4*)(uc + c0), vn = hn ? *(const u32x4*)(un + c0) : z;
    float p[8], c[8], n[8]; unpack8(vp, p); unpack8(vc, c); unpack8(vn, n);
#pragma unroll
    for (int e = 0; e < 8; ++e) o[e] = p[e] * s0[e] + c[e] * s1[e] + n[e] * s2[e];
}
DI void load_sw(const float* sw, int c0, float (&s0)[8], float (&s1)[8], float (&s2)[8]) {
#pragma unroll
    for (int e = 0; e < 8; ++e) { s0[e] = sw[c0 + e]; s1[e] = sw[RW_IN + c0 + e]; s2[e] = sw[2 * RW_IN + c0 + e]; }
}
DI void ph_prep(const Ctx& C, const bf16* U, const float* sw  , const float* kkw  , const float* naqg, const float* nakg,
                bf16* R, bf16* V, bf16* K, bf16* KK, bf16* L, bf16* QN, bf16* KN, bf16* VTN) {
    LAS bf16* VL = (LAS bf16*)C.lds;
    const int lane = C.lane, hh = lane >> 3, sub = lane & 7;
    const float C2 = 0.125f * LOG2E;
    for (int u = C.vcu; u < MT / 32; u += C.nb) {
        const int row0 = 32 * u; const bool lat = row0 < NLAT;
        const int b = lat ? (row0 >> 12) : ((row0 - NLAT) >> 8), pos0 = lat ? (row0 & 4095) : TL + ((row0 - NLAT) & 255), tseq = lat ? TL : LCX, tb = lat ? (row0 & 4095) : ((row0 - NLAT) & 255);
#define PREP_ROWVARS(i) const int pl = 4 * C.wave + (i), row = row0 + pl, t = tb + pl; const bool hp = t > 0, hn = t < tseq - 1; \
            const bf16* uc = U + (size_t)row * OD_INP; const bf16* up = uc - OD_INP; const bf16* un = uc + OD_INP
        { float s0[8], s1[8], s2[8]; load_sw(sw, 8 * lane, s0, s1, s2);
          for (int i = 0; i < 4; ++i) { PREP_ROWVARS(i); float o[8]; shifted8(up, uc, un, hp, hn, s0, s1, s2, 8 * lane, o); *(u32x4*)(R + (size_t)row * 512 + 8 * lane) = pack8(o); } }
        { float s0[8], s1[8], s2[8]; load_sw(sw, 1024 + 8 * lane, s0, s1, s2);
          for (int i = 0; i < 4; ++i) { PREP_ROWVARS(i); float o[8]; shifted8(up, uc, un, hp, hn, s0, s1, s2, 1024 + 8 * lane, o); *(u32x4*)(V + (size_t)row * 512 + 8 * lane) = pack8(o); } }
        { float s0[8], s1[8], s2[8]; load_sw(sw, 512 + 8 * lane, s0, s1, s2); float kw[8];
#pragma unroll
          for (int e = 0; e < 8; ++e) kw[e] = kkw[8 * lane + e];
          for (int i = 0; i < 4; ++i) { PREP_ROWVARS(i); float o[8]; shifted8(up, uc, un, hp, hn, s0, s1, s2, 512 + 8 * lane, o); *(u32x4*)(K + (size_t)row * 512 + 8 * lane) = pack8(o);
              float kk[8]; float ss = 0.f;
#pragma unroll
              for (int e = 0; e < 8; ++e) { kk[e] = o[e] * kw[e]; ss += kk[e] * kk[e]; }
              ss = sum8(ss); const float rn = 1.0f / sqrtf(ss + 1e-12f);
#pragma unroll
              for (int e = 0; e < 8; ++e) kk[e] *= rn;
              *(u32x4*)(KK + (size_t)row * 512 + 8 * lane) = pack8(kk); } }
        if (lane < 48) { float s0[8], s1[8], s2[8]; load_sw(sw, 1536 + 8 * lane, s0, s1, s2);
          for (int i = 0; i < 4; ++i) { PREP_ROWVARS(i); float o[8]; shifted8(up, uc, un, hp, hn, s0, s1, s2, 1536 + 8 * lane, o);
              if (lane < 16) {
#pragma unroll
                  for (int e = 0; e < 8; ++e) { const float ex = __expf(2.f * o[e]); o[e] = 1.f - 2.f * __builtin_amdgcn_rcpf(ex + 1.f); }
              } else if (lane >= 32) {
#pragma unroll
                  for (int e = 0; e < 8; ++e) o[e] = sigmoidf_(o[e]);
              }
              *(u32x4*)(L + (size_t)row * 384 + 8 * lane) = pack8(o); } }
        { float gq[8], gk[8];
#pragma unroll
          for (int e = 0; e < 8; ++e) { gq[e] = naqg[8 * sub + e] * C2; gk[e] = nakg[8 * sub + e]; }
          for (int i = 0; i < 4; ++i) { const int pl = 4 * C.wave + i, row = row0 + pl, pos = pos0 + pl; const bf16* uc = U + (size_t)row * OD_INP;
            { float x[8]; unpack8(*(const u32x4*)(uc + RW_IN + 8 * lane), x); float ss = 0.f;
#pragma unroll
                for (int e = 0; e < 8; ++e) ss += x[e] * x[e];
                ss = sum8(ss); const float rn = 1.0f / sqrtf(ss * (1.f / 64.f) + EPS);
#pragma unroll
                for (int e = 0; e < 8; ++e) x[e] = x[e] * rn * gq[e];
                *(u32x4*)(QN + ((size_t)(b * 8 + hh) * KPOS + pos) * 64 + 8 * sub) = pack8(x); }
            { float x[8]; unpack8(*(const u32x4*)(uc + RW_IN + 512 + 8 * lane), x); float ss = 0.f;
#pragma unroll
                for (int e = 0; e < 8; ++e) ss += x[e] * x[e];
                ss = sum8(ss); const float rn = 1.0f / sqrtf(ss * (1.f / 64.f) + EPS);
#pragma unroll
                for (int e = 0; e < 8; ++e) x[e] = x[e] * rn * gk[e];
                *(u32x4*)(KN + ((size_t)(b * 8 + hh) * KPOS + pos) * 64 + 8 * sub) = pack8(x); }
            { const u32x4 vv = *(const u32x4*)(uc + RW_IN + 1024 + 8 * lane); const unsigned w4[4] = {vv.x, vv.y, vv.z, vv.w};
#pragma unroll
                for (int e = 0; e < 8; ++e) { const int dv = 8 * sub + e; VL[(hh * 64 + dv) * 32 + pl] = (bf16)((e & 1) ? (w4[e >> 1] >> 16) : (w4[e >> 1] & 0xffffu)); } } } }
#undef PREP_ROWVARS
        __syncthreads();
        { const int hd = C.tid; bf16* dst = VTN + ((size_t)(b * 8 + (hd >> 6)) * 64 + (hd & 63)) * KPOS + pos0;
#pragma unroll
            for (int q = 0; q < 4; ++q) *(u32x4*)(dst + 8 * q) = *(const LAS u32x4*)(VL + hd * 32 + 8 * q); }
        __syncthreads();
    }
}

DI int scan_row(int s, int d, int b) { if (s < LCX) return NLAT + b * LCX + (d ? (LCX - 1 - s) : s); const int t = s - LCX; return b * TL + (d ? (TL - 1 - t) : t); }


constexpr int CCH = 16, NCHK = KPOS / CCH, NPROB = NB * 8 * 2 * NCHK, IMG_ELEMS = 3 * 32 * 16;
template <int N> struct ICk { static constexpr int value = N; };
DI int crow_(int reg, int h) { return (reg & 3) + 8 * (reg >> 2) + 4 * h; }
DI bf16x8 pack_lo8(const f32x16& x) {
    u32x4 p; p.x = pk2(x[0], x[1]); p.y = pk2(x[2], x[3]); p.z = pk2(x[4], x[5]); p.w = pk2(x[6], x[7]); return __builtin_bit_cast(bf16x8, p); }
DI bf16x8 pack_hi8(const f32x16& x) { u32x4 p; p.x = pk2(x[8], x[9]); p.y = pk2(x[10], x[11]); p.z = pk2(x[12], x[13]); p.w = pk2(x[14], x[15]); return __builtin_bit_cast(bf16x8, p); }
DI int perm16(int k) { return (k & ~15) | swap23(k & 15); }

DI void ph_wkv_pre(const Ctx& C, const bf16* R, const bf16* K, const bf16* KK, const float* LW, const bf16* AR_, const float* ka, bf16* IMG) {
    LAS unsigned char* wl = C.lds + C.wave * 13312;
    LAS bf16* ARl = (LAS bf16*)wl; LAS bf16* BKl = (LAS bf16*)(wl + 4608); LAS float* Ll = (LAS float*)(wl + 9216); LAS bf16* OUT = (LAS bf16*)(wl + 10240);
    const int lane = C.lane, r = lane & 31, h = lane >> 5;
    const int gw = C.vcu * 8 + C.wave, ngw = C.nb * 8;
    for (int p = gw; p < NPROB; p += ngw) {
        const int j = p % NCHK, rest = p / NCHK, d = rest & 1, hh = (rest >> 1) & 7, b = rest >> 4;
        const float* Wd = LW + (size_t)d * MT * 512; const bf16* Ad = AR_ + (size_t)d * MT * 512;
        const float kav = ka[hh * 64 + lane];
        const int row0 = scan_row(j * CCH, d, b), sg = d ? -1 : 1;
        float lw[16]; bf16 rr[16], kx[16], kkx[16], ax[16];
#pragma unroll
        for (int t = 0; t < 16; ++t) { const size_t off = (size_t)(row0 + sg * t) * 512 + hh * 64 + lane; lw[t] = Wd[off]; rr[t] = R[off]; kx[t] = K[off]; kkx[t] = KK[off]; ax[t] = Ad[off]; }
        float cum = 0.f, e0 = 1.f;
#pragma unroll
        for (int t = 0; t < 16; ++t) {
            cum += lw[t]; const float e1 = __expf(cum), ei = __builtin_amdgcn_rcpf(e1);
            const float kkv = bf2f(kkx[t]), av = bf2f(ax[t]), keff = bf2f(kx[t]) * (1.f + (av - 1.f) * kav);
            ARl[t * 72 + lane] = f2bf(-kkv * e0); ARl[(16 + t) * 72 + lane] = f2bf(bf2f(rr[t]) * e1);
            BKl[t * 72 + lane] = f2bf(kkv * av * ei); BKl[(16 + t) * 72 + lane] = f2bf(keff * ei);
            e0 = e1;
        }
        asm volatile("s_waitcnt lgkmcnt(0)" ::: "memory");
        f32x16 g;
#pragma unroll
        for (int i = 0; i < 16; ++i) g[i] = 0.f;
#pragma unroll
        for (int q = 0; q < 4; ++q) g = MFMA32(*(const LAS bf16x8*)(ARl + r * 72 + 16 * q + 8 * h), *(const LAS bf16x8*)(BKl + r * 72 + 16 * q + 8 * h), g);
        const int sI = r & 15; const bool isk = r >= 16;
#pragma unroll
        for (int i = 0; i < 16; ++i) {
            const int row = crow_(i, h), t = row & 15; const bool keep = (i < 8) ? (sI < t) : (sI <= t); const float val = keep ? g[i] : 0.f;
            if (i < 8) { if (!isk) { Ll[t * 16 + sI] = val; OUT[512 + row * 16 + perm16(sI)] = 0; } else OUT[row * 16 + sI] = f2bf(val); }
            else       { if (!isk) OUT[512 + row * 16 + perm16(sI)] = f2bf(val); else OUT[row * 16 + sI] = f2bf(val); }
        }
        asm volatile("s_waitcnt lgkmcnt(0)" ::: "memory");
        { const int c = lane & 15; float Pr[16];
            Pr[0] = (c == 0) ? 1.f : 0.f;
#pragma unroll
            for (int t = 1; t < 16; ++t) { const float lrow = Ll[t * 16 + c]; float acc = (c == t) ? 1.f : 0.f;
#pragma unroll
                for (int u = 0; u < t; ++u) acc += rdlane(lrow, u) * Pr[u];
                Pr[t] = acc; }
            if (lane < 16) {
#pragma unroll
                for (int t = 0; t < 16; ++t) { OUT[1024 + t * 16 + perm16(c)] = f2bf(Pr[t]); OUT[1024 + (16 + t) * 16 + c] = 0; } } }
        asm volatile("s_waitcnt lgkmcnt(0)" ::: "memory");
        { bf16* dst = IMG + (size_t)p * IMG_ELEMS;
#pragma unroll
            for (int q = 0; q < 3; ++q) *(u32x4*)(dst + (q * 64 + lane) * 8) = *(const LAS u32x4*)(OUT + (q * 64 + lane) * 8); }
        asm volatile("s_waitcnt lgkmcnt(0)" ::: "memory");
    }
}

DI void ph_wkv_chunk(const Ctx& C, const bf16* R, const bf16* V, const bf16* K, const bf16* KK, const float* LW, const bf16* AR_, const float* ka, const bf16* IMG, bf16* YS) {
    constexpr int S_AR = 0, S_BKT = 4608, S_VT = 9728, S_VT2 = 11264, S_GC = 12800, S_MM = 13056, S_MRB = 14592, S_PP = 16128, SLOT = 17664, CUMO = 2 * SLOT, YSTO = CUMO + 8192, DEPTH = 4;
    const int lane = C.lane, wv = C.wave, r = lane & 31, h = lane >> 5;
    const bool isE = wv == 2 || wv == 3 || wv == 6 || wv == 7, isS = wv < 2;
    const int te = (wv == 2 ? 0 : (wv == 3 ? 1 : (wv == 6 ? 2 : 3))) * 64 + lane, et = te >> 4, ekq = te & 15;
    const int vhf = te >> 7, vt = (te >> 3) & 15, viq = te & 7;
    const int hf = wv & 1;
    for (int cid0 = C.bid; cid0 < 128; cid0 += C.nb) {
        const int chain = cid0, b = chain >> 4, hh = (chain >> 1) & 7, d = chain & 1;
        const float* Wd = LW + (size_t)d * MT * 512; const bf16* Ad = AR_ + (size_t)d * MT * 512; bf16* Yd = YS + (size_t)d * MT * 512;
        const bf16* img = IMG + (size_t)(((b * 8 + hh) * 2 + d) * NCHK) * IMG_ELEMS;
        f32x16 ST[2];
#pragma unroll
        for (int i = 0; i < 16; ++i) { ST[0][i] = 0.f; ST[1][i] = 0.f; }
        const f32x4 kav = *(const f32x4*)(ka + hh * 64 + 4 * ekq);
        unsigned ring[DEPTH][16];
        __syncthreads();
        auto issue = [&](int ch, unsigned (&rg)[16]) __attribute__((always_inline)) {
            if (ch < 0 || ch >= NCHK) return;
            const int row0 = scan_row(ch * CCH, d, b), sg = d ? -1 : 1;
            if (isE) {
                const size_t off = (size_t)(row0 + sg * et) * 512 + hh * 64 + 4 * ekq;
                const u32x2 x0 = *(const u32x2*)(R + off), x1 = *(const u32x2*)(K + off), x2 = *(const u32x2*)(KK + off), x3 = *(const u32x2*)(Ad + off);
                const u32x2 x4 = *(const u32x2*)(V + (size_t)(row0 + sg * vt) * 512 + hh * 64 + 32 * vhf + 4 * viq);
                rg[0] = x0.x; rg[1] = x0.y; rg[2] = x1.x; rg[3] = x1.y; rg[4] = x2.x; rg[5] = x2.y; rg[6] = x3.x; rg[7] = x3.y; rg[8] = x4.x; rg[9] = x4.y;
                asm volatile("; wkv issue role E" ::);
            } else if (wv == 4) {
#define W5_(t) rg[(t)] = __builtin_bit_cast(unsigned, Wd[(size_t)(row0 + sg * (t)) * 512 + hh * 64 + lane])
                W5_(0); W5_(1); W5_(2); W5_(3); W5_(4); W5_(5); W5_(6); W5_(7); W5_(8); W5_(9); W5_(10); W5_(11); W5_(12); W5_(13); W5_(14); W5_(15);
#undef W5_
                asm volatile("; wkv issue role C" ::);
            } else if (wv == 5) {
#define W6_(q) do { const u32x4 x = *(const u32x4*)(img + (size_t)ch * IMG_ELEMS + ((q) * 64 + lane) * 8); rg[4 * (q)] = x.x; rg[4 * (q) + 1] = x.y; rg[4 * (q) + 2] = x.z; rg[4 * (q) + 3] = x.w; } while (0)
                W6_(0); W6_(1); W6_(2);
#undef W6_
                asm volatile("; wkv issue role V" ::);
            }
        };
        issue(0, ring[0]); issue(1, ring[1]); issue(2, ring[2]); issue(3, ring[3]);
#define WKV_BAR() asm volatile("s_waitcnt lgkmcnt(0)\n\ts_barrier" ::: "memory")
#define WKV_LOOP(...) for (int n0 = -2; n0 < NCHK; n0 += DEPTH) { auto iter = [&](auto kc) __attribute__((always_inline)) { constexpr int kk = decltype(kc)::value; \
            constexpr int riE = (kk + 3) % DEPTH, riW = kk % DEPTH; (void)riE; (void)riW; const int n = n0 + kk; (void)n; __VA_ARGS__; WKV_BAR(); }; iter(ICk<0>{}); iter(ICk<1>{}); iter(ICk<2>{}); iter(ICk<3>{}); }
        if (isS) {
            WKV_LOOP({
                if (n >= 0 && n < NCHK) {
                    const LAS unsigned char* B = C.lds + (n & 1) * SLOT;
                    f32x16 T1;
                    _Pragma("unroll") for (int i = 0; i < 16; ++i) T1[i] = 0.f;
                    _Pragma("unroll") for (int tau = 0; tau < 2; ++tau) {
                        T1 = MFMA32(*(const LAS bf16x8*)(B + S_AR + r * 144 + (32 * tau + 8 * h) * 2), pack_lo8(ST[tau]), T1);
                        T1 = MFMA32(*(const LAS bf16x8*)(B + S_AR + r * 144 + (32 * tau + 16 + 8 * h) * 2), pack_hi8(ST[tau]), T1);
                    }
                    const bf16x8 vtf = *(const LAS bf16x8*)(B + (hf ? S_VT2 : S_VT) + r * 48 + 16 * h);
                    T1 = MFMA32(*(const LAS bf16x8*)(B + S_MM + r * 48 + 16 * h), vtf, T1);
                    f32x16 ET;
                    _Pragma("unroll") for (int i = 0; i < 16; ++i) ET[i] = 0.f;
                    ET = MFMA32(*(const LAS bf16x8*)(B + S_PP + r * 48 + 16 * h), pack_lo8(T1), ET);
                    const bf16x8 ef = pack_lo8(ET);
                    T1 = MFMA32(*(const LAS bf16x8*)(B + S_MRB + r * 48 + 16 * h), ef, T1);
                    _Pragma("unroll") for (int tau = 0; tau < 2; ++tau) {
                        ST[tau] = MFMA32(*(const LAS bf16x8*)(B + S_BKT + (32 * tau + r) * 80 + 16 * h), ef, ST[tau]);
                        ST[tau] = MFMA32(*(const LAS bf16x8*)(B + S_BKT + (32 * tau + r) * 80 + 32 + 16 * h), vtf, ST[tau]);
                        _Pragma("unroll") for (int g4 = 0; g4 < 4; ++g4) { const f32x4 gc = *(const LAS f32x4*)(B + S_GC + (32 * tau + 8 * g4 + 4 * h) * 4);
                            ST[tau][4 * g4] *= gc.x; ST[tau][4 * g4 + 1] *= gc.y; ST[tau][4 * g4 + 2] *= gc.z; ST[tau][4 * g4 + 3] *= gc.w; }
                    }
                    LAS float* ys = (LAS float*)(C.lds + YSTO) + ((n & 1) * 2 + hf) * 512;
                    _Pragma("unroll") for (int q = 0; q < 8; ++q) ys[(8 * (q >> 2) + 4 * h + (q & 3)) * 32 + r] = T1[8 + q];
                }
            });
        } else if (isE) {
            WKV_LOOP({
                const int ch = n + 1;
                if (ch >= 0) {
                    if (ch < NCHK) {
                        LAS unsigned char* B = C.lds + (ch & 1) * SLOT; const LAS float* ec = (const LAS float*)(C.lds + CUMO) + (ch & 1) * 1024;
                        const f32x4 e1 = *(const LAS f32x4*)(ec + et * 64 + 4 * ekq);
                        f32x4 e0 = {1.f, 1.f, 1.f, 1.f}; if (et > 0) e0 = *(const LAS f32x4*)(ec + (et - 1) * 64 + 4 * ekq);
                        const float rv[4] = {bflo(ring[riE][0]), bfhi(ring[riE][0]), bflo(ring[riE][1]), bfhi(ring[riE][1])}; const float kv[4] = {bflo(ring[riE][2]), bfhi(ring[riE][2]), bflo(ring[riE][3]), bfhi(ring[riE][3])};
                        const float kkv[4] = {bflo(ring[riE][4]), bfhi(ring[riE][4]), bflo(ring[riE][5]), bfhi(ring[riE][5])}; const float av[4] = {bflo(ring[riE][6]), bfhi(ring[riE][6]), bflo(ring[riE][7]), bfhi(ring[riE][7])};
                        float ah[4]; float rh[4]; float bc[4]; float kc4[4];
                        _Pragma("unroll") for (int e = 0; e < 4; ++e) { const float ei = __builtin_amdgcn_rcpf(e1[e]);
                            ah[e] = -kkv[e] * e0[e]; rh[e] = rv[e] * e1[e]; bc[e] = kkv[e] * av[e] * ei; kc4[e] = kv[e] * (1.f + (av[e] - 1.f) * kav[e]) * ei; }
                        const int pk = perm16(4 * ekq);
                        *(LAS u32x2*)((LAS bf16*)(B + S_AR) + et * 72 + pk) = (u32x2){pk2(ah[0], ah[1]), pk2(ah[2], ah[3])};
                        *(LAS u32x2*)((LAS bf16*)(B + S_AR) + (16 + et) * 72 + pk) = (u32x2){pk2(rh[0], rh[1]), pk2(rh[2], rh[3])};
                        const int pt = perm16(et);
                        _Pragma("unroll") for (int e = 0; e < 4; ++e) { ((LAS bf16*)(B + S_BKT))[(4 * ekq + e) * 40 + pt] = f2bf(bc[e]); ((LAS bf16*)(B + S_BKT))[(4 * ekq + e) * 40 + 16 + et] = f2bf(kc4[e]); }
                        if (et == 15) *(LAS f32x4*)((LAS float*)(B + S_GC) + 4 * ekq) = e1;
                        LAS bf16* vtp = (LAS bf16*)(B + (vhf ? S_VT2 : S_VT)) + (4 * viq) * 24 + vt;
                        vtp[0] = (bf16)(ring[riE][8] & 0xffffu); vtp[24] = (bf16)(ring[riE][8] >> 16); vtp[48] = (bf16)(ring[riE][9] & 0xffffu); vtp[72] = (bf16)(ring[riE][9] >> 16);
                    }
                    issue(ch + DEPTH, ring[riE]);
                }
            });
        } else if (wv == 4) {
            WKV_LOOP({
                const int ch = n + 2;
                if (ch < NCHK) { LAS float* ec = (LAS float*)(C.lds + CUMO) + (ch & 1) * 1024; float c = 0.f;
#define C5_(t) do { c += __builtin_bit_cast(float, ring[riW][(t)]); ec[(t) * 64 + lane] = __expf(c); } while (0)
                    C5_(0); C5_(1); C5_(2); C5_(3); C5_(4); C5_(5); C5_(6); C5_(7); C5_(8); C5_(9); C5_(10); C5_(11); C5_(12); C5_(13); C5_(14); C5_(15);
                }
                issue(ch + DEPTH, ring[riW]);
            });
        } else {
            WKV_LOOP({
                { const int chy = n - 1;
                  if (chy >= 0 && chy < NCHK) { const int yh = lane >> 5, yt = (lane & 31) >> 1, yi = 16 * (lane & 1);
                    const LAS float* ys = (const LAS float*)(C.lds + YSTO) + ((chy & 1) * 2 + yh) * 512 + yt * 32 + yi;
                    bf16* dst = Yd + (size_t)(scan_row(chy * CCH, d, b) + (d ? -1 : 1) * yt) * 512 + hh * 64 + 32 * yh + yi;
                    _Pragma("unroll") for (int q = 0; q < 2; ++q) { const f32x4 a0 = *(const LAS f32x4*)(ys + 8 * q); const f32x4 a1 = *(const LAS f32x4*)(ys + 8 * q + 4);
                        *(u32x4*)(dst + 8 * q) = (u32x4){pk2(a0.x, a0.y), pk2(a0.z, a0.w), pk2(a1.x, a1.y), pk2(a1.z, a1.w)}; } } }
                const int ch = n + 1;
                if (ch >= 0) {
                    if (ch < NCHK) { LAS unsigned char* B = C.lds + (ch & 1) * SLOT;
                        const int irow = lane >> 1; const int ihv = lane & 1;
                        *(LAS u32x4*)(B + S_MM + irow * 48 + ihv * 16) = (u32x4){ring[riE][0], ring[riE][1], ring[riE][2], ring[riE][3]};
                        *(LAS u32x4*)(B + S_MRB + irow * 48 + ihv * 16) = (u32x4){ring[riE][4], ring[riE][5], ring[riE][6], ring[riE][7]};
                        *(LAS u32x4*)(B + S_PP + irow * 48 + ihv * 16) = (u32x4){ring[riE][8], ring[riE][9], ring[riE][10], ring[riE][11]};
                    }
                    issue(ch + DEPTH, ring[riE]);
                }
            });
        }
#undef C5_
#undef WKV_LOOP
#undef WKV_BAR
    }
}

DI void ph_post(const Ctx& C, const bf16* YS, const bf16* R, const bf16* V, const bf16* K, const bf16* A2, const float* ka, const bf16* G, const float* rk, const float* gng, const float* gnb, bf16* OCAT, bool last) {
    const int gw = C.bid * 8 + C.wave, ngw = C.nb * 8, lane = C.lane, nrows = last ? NLAT : MT;
    for (int row = gw; row < nrows; row += ngw) {
        const size_t o = (size_t)row * 512 + 8 * lane;
        float y[8], y1[8]; unpack8(*(const u32x4*)(YS + o), y); unpack8(*(const u32x4*)(YS + (size_t)MT * 512 + o), y1);
#pragma unroll
        for (int e = 0; e < 8; ++e) y[e] += y1[e];
        float r[8], v[8], kx[8], a0[8], a1[8], g[8];
        unpack8(*(const u32x4*)(R + o), r); unpack8(*(const u32x4*)(V + o), v); unpack8(*(const u32x4*)(K + o), kx); unpack8(*(const u32x4*)(A2 + o), a0); unpack8(*(const u32x4*)(A2 + (size_t)MT * 512 + o), a1); unpack8(*(const u32x4*)(G + o), g);
        float bsum = 0.f;
#pragma unroll
        for (int e = 0; e < 8; ++e) { const float kae = ka[8 * lane + e]; bsum += r[e] * (kx[e] * (1.f + (a0[e] - 1.f) * kae) + kx[e] * (1.f + (a1[e] - 1.f) * kae)) * rk[8 * lane + e]; }
        bsum = sum8(bsum);
        float s = 0.f;
#pragma unroll
        for (int e = 0; e < 8; ++e) { y[e] += bsum * v[e]; s += y[e]; }
        const float mu = sum8(s) * (1.f / 64.f); float s2 = 0.f;
#pragma unroll
        for (int e = 0; e < 8; ++e) { y[e] -= mu; s2 += y[e] * y[e]; }
        const float rstd = 1.0f / sqrtf(sum8(s2) * (1.f / 64.f) + GN_EPS);
        float out[8];
#pragma unroll
        for (int e = 0; e < 8; ++e) out[e] = (y[e] * rstd * gng[8 * lane + e] + gnb[8 * lane + e]) * g[e];
        *(u32x4*)(OCAT + (size_t)row * DM + 8 * lane) = pack8(out);
    }
}

DI void ph_topk2(const Ctx& C, const float* AFFT, const float* AFFC, int* ROWS, float* GATE, int* SLOT, bool last) {
    LAS unsigned* wcnt = (LAS unsigned*)C.lds;
    LAS unsigned* cnt = wcnt + 16;
    const int tid = C.tid, nprob = last ? 128 : 256;
    for (int p = C.bid; p < nprob; p += C.nb) {
        const bool isctx = p >= 128; const int be = p & 127, b = be >> 4, e = be & 15;
        const int n = isctx ? LCX : TL, cap = isctx ? CAPC : CAPL;
        const float* src = isctx ? AFFC + (size_t)be * LCX : AFFT + (size_t)be * TL;
        unsigned v[8]; const int per = isctx ? 1 : 8, t0 = tid * per;
#pragma unroll
        for (int q = 0; q < 8; ++q) v[q] = 0u;
        if (!isctx) { const u32x4 a0 = *(const u32x4*)(src + t0), a1 = *(const u32x4*)(src + t0 + 4); v[0] = a0.x; v[1] = a0.y; v[2] = a0.z; v[3] = a0.w; v[4] = a1.x; v[5] = a1.y; v[6] = a1.z; v[7] = a1.w; }
        else if (tid < LCX) v[0] = __builtin_bit_cast(unsigned, src[tid]);
        __syncthreads();
        unsigned T = 0u;
        for (int bit = 30; bit >= 0; --bit) {
            const unsigned cand = T | (1u << bit); unsigned c = 0u;
#pragma unroll
            for (int q = 0; q < 8; ++q) c += (unsigned)__builtin_popcountll(__builtin_amdgcn_ballot_w64(v[q] >= cand));
            LAS unsigned* wc = wcnt + (bit & 1) * 8;
            if (C.lane == 0) wc[C.wave] = c;
            __syncthreads();
            const unsigned tot = wc[0] + wc[1] + wc[2] + wc[3] + wc[4] + wc[5] + wc[6] + wc[7];
            if (tot >= (unsigned)cap) T = cand;
        }
        unsigned myc = 0u;
#pragma unroll
        for (int q = 0; q < 8; ++q) myc += (v[q] > T ? 0x10000u : 0u) + ((v[q] == T && (isctx ? (q == 0 && tid < LCX) : true)) ? 1u : 0u);
        __syncthreads();
        cnt[tid] = myc;
        __syncthreads();
        for (int off = 1; off < 512; off <<= 1) { const unsigned add = tid >= off ? cnt[tid - off] : 0u; __syncthreads(); cnt[tid] += add; __syncthreads(); }
        const unsigned total = cnt[511], keq = (unsigned)cap - (total >> 16);
        unsigned before = cnt[tid] - myc;
        for (int q = 0; q < per; ++q) { const int t = t0 + q; if (t >= n) break; const unsigned x = v[q]; const unsigned gtb = before >> 16, eqb = before & 0xFFFFu;
            const bool sel = x > T || (x == T && eqb < keq);
            if (sel) { const int jx = (int)(gtb + (eqb < keq ? eqb : keq));
                const int slot = isctx ? NB * CAPL + b * CAPC + jx : b * CAPL + jx, row = isctx ? NLAT + b * LCX + t : b * TL + t;
                ROWS[e * ESLOTS + slot] = row; GATE[e * ESLOTS + slot] = __builtin_bit_cast(float, x); SLOT[(size_t)row * 16 + e] = slot; }
            before += (x > T ? 0x10000u : 0u) + (x == T ? 1u : 0u); }
        __syncthreads();
    }
}


DI void ph_combine(const Ctx& C, float* xlat, float* xctx, const float* modg2  , const int* SLOT, const bf16* Y2, bool last,
                   const float* ngain  , const float* nmod  , bf16* H) {
    const int gw = C.bid * 8 + C.wave, ngw = C.nb * 8, lane = C.lane, nrows = last ? NLAT : MT;
    for (int row = gw; row < nrows; row += ngw) {
        float* xr = row < NLAT ? xlat + (size_t)row * DM : xctx + (size_t)(row - NLAT) * DM;
        const int mi = row < NLAT ? (row >> 12) : 8;
        const int sv = SLOT[(size_t)row * 16 + (lane & 15)];
        f32x4 acc[4];
#pragma unroll
        for (int j = 0; j < 4; ++j) acc[j] = (f32x4){0.f, 0.f, 0.f, 0.f};
#pragma unroll
        for (int e = 0; e < 16; ++e) {
            const int s = __builtin_amdgcn_readlane(sv, e);
            if (s >= 0) { const bf16* yp = Y2 + ((size_t)e * ESLOTS + s) * DM + 4 * lane;
#pragma unroll
                for (int j = 0; j < 4; ++j) { const u32x2 w = *(const u32x2*)(yp + 256 * j); acc[j] += (f32x4){bflo(w.x), bfhi(w.x), bflo(w.y), bfhi(w.y)}; } }
        }
#pragma unroll
        for (int j = 0; j < 4; ++j) { const int c = 256 * j + 4 * lane; const f32x4 g = *(const f32x4*)(modg2 + mi * 6144 + c); f32x4 x = *(const f32x4*)(xr + c); x += g * acc[j]; *(f32x4*)(xr + c) = x; acc[j] = x; }
        if (ngain) {
            float ss = 0.f;
#pragma unroll
            for (int j = 0; j < 4; ++j) ss += acc[j].x * acc[j].x + acc[j].y * acc[j].y + acc[j].z * acc[j].z + acc[j].w * acc[j].w;
            const float rs = 1.0f / sqrtf(wave_sum(ss) * (1.f / 1024.f) + EPS);
            const float* mp = nmod + mi * 6144;
#pragma unroll
            for (int j = 0; j < 4; ++j) { const int c = 256 * j + 4 * lane;
                const f32x4 g = *(const f32x4*)(ngain + c), sc = *(const f32x4*)(mp + 1024 + c), sh = *(const f32x4*)(mp + c);
                const f32x4 hv = (acc[j] * rs) * g * (sc + 1.0f) + sh;
                *(u32x2*)(H + (size_t)row * DM + c) = (u32x2){pk2(hv.x, hv.y), pk2(hv.z, hv.w)}; }
        }
    }
}

template <int N> struct IC { static constexpr int value = N; };
DI const float* in_ptr(const unsigned char* ws, int k) { const unsigned long long v = ((const unsigned long long*)(ws + 128 * 1024))[k];
    const unsigned lo = __builtin_amdgcn_readfirstlane((unsigned)v), hi = __builtin_amdgcn_readfirstlane((unsigned)(v >> 32));
    return (const float*)(__attribute__((address_space(1))) const float*)(((unsigned long long)hi << 32) | lo); }
template <class T> DI T* launder_ptr(T* p) { unsigned long long v = (unsigned long long)p; unsigned lo = (unsigned)v, hi = (unsigned)(v >> 32); asm volatile("" : "+v"(lo), "+v"(hi));
    lo = __builtin_amdgcn_readfirstlane(lo); hi = __builtin_amdgcn_readfirstlane(hi); return (T*)(__attribute__((address_space(1))) T*)(((unsigned long long)hi << 32) | lo); }
constexpr int N_PHASES = 1 + 23 + 22;
constexpr size_t WS_PTRS = 128 * 1024;
#define P_XC    ((float*)(ws + WS_XC))
#define P_MOD   ((const float*)(ws + WS_MOD))
#define P_HB    ((bf16*)(ws + WS_HB))
#define P_OCAT  ((bf16*)(ws + WS_OCAT))
#define P_AR    (ws + WS_ARENA)
#define P_ROWS  ((int*)(ws + WS_ROWS))
#define P_GATE  ((float*)(ws + WS_GATE))
#define P_SLOT  ((int*)(ws + WS_SLOT))
#define P_AFFT  ((float*)(ws + WS_AFFT))
#define P_AFFC  ((float*)(ws + WS_AFFC))
#define P_W13   ((bf16*)(ws + WS_W13))
#define P_W2    ((bf16*)(ws + WS_W2))
#define P_U     ((bf16*)(P_AR + A_U))
#define P_QPRE  ((float*)(P_AR + A_QPRE))
#define P_KVPRE ((float*)(P_AR + A_KVPRE))
#define P_QB    ((bf16*)(P_AR + A_QB))
#define P_KB    ((bf16*)(P_AR + A_KB))
#define P_VT    ((bf16*)(P_AR + A_VT))
#define P_W     ((float*)(P_AR + A_W))
#define P_KEFF  ((bf16*)(P_AR + A_KEFF))
#define P_R     ((bf16*)(P_AR + A_R))
#define P_V     ((bf16*)(P_AR + A_V))
#define P_KK    ((bf16*)(P_AR + A_KK))
#define P_G     ((bf16*)(P_AR + A_G))
#define P_K     ((bf16*)(P_AR + A_K))
#define P_L     ((bf16*)(P_AR + A_L))
#define P_QN    ((bf16*)(P_AR + A_QN))
#define P_KN    ((bf16*)(P_AR + A_KN))
#define P_VTN   ((bf16*)(P_AR + A_VTN))
#define P_YS    ((bf16*)(P_AR + A_YS))
#define P_IMG   ((bf16*)(P_AR + A_IMG))
#define P_HID   ((bf16*)(P_AR + A_HID))
#define P_Y2    ((bf16*)(P_AR + A_Y2))
#define MODL(i) (P_MOD + (size_t)(i) * 9 * 6144)
#if MOE_F8
#define MOE1_PHASE(NMT) do { pg8::Gemm g{P_HB, P_W13, DM / 2, DM / 2, P_ROWS, SCALE_W, SCALE_ONE}; pg8::OrderMoE S{(NMT), 8, 17, C.nb, C.vcu}; pg8::EpiAdapt<EpiGlu8> E{EpiGlu8{(unsigned char*)P_HID}}; \
        pg8::gemm_phase<pg8::EpiAdapt<EpiGlu8>, pg8::OrderMoE, true>(C.lds, g, S, E, C.tid); } while (0)
#define MOE2_PHASE(NMT) do { pg8::Gemm g{P_HID, P_W2, DM / 2, DM / 2, nullptr, SCALE_W, SCALE_HID}; pg8::OrderMoE S{(NMT), 4, 17, C.nb, C.vcu}; pg8::EpiAdapt<EpiGate> E{EpiGate{P_Y2, P_GATE}}; \
        pg8::gemm_phase<pg8::EpiAdapt<EpiGate>, pg8::OrderMoE, true>(C.lds, g, S, E, C.tid); } while (0)
#else
#define MOE1_PHASE(NMT) do { pg8::Gemm g{P_HB, P_W13, DM, DM, P_ROWS}; pg8::OrderMoE S{(NMT), 8, 17, C.nb, C.vcu}; pg8::EpiAdapt<EpiGlu> E{EpiGlu{P_HID}}; pg8::gemm_phase(C.lds, g, S, E, C.tid); } while (0)
#define MOE2_PHASE(NMT) do { pg8::Gemm g{P_HID, P_W2, DM, DM, nullptr}; pg8::OrderMoE S{(NMT), 4, 17, C.nb, C.vcu}; pg8::EpiAdapt<EpiGate> E{EpiGate{P_Y2, P_GATE}}; pg8::gemm_phase(C.lds, g, S, E, C.tid); } while (0)
#endif
#define RELAUNDER() do { int l_ = C.lane; asm volatile("" : "+v"(l_)); C.lane = l_; C.tid = (C.wave << 6) | l_; } while (0)
__global__ void __launch_bounds__(512, 2) fwd_kernel(Args a) {
    extern __shared__ __attribute__((aligned(16))) unsigned char smem[];
    Ctx C0; C0.lds = (LAS unsigned char*)smem; C0.tid = threadIdx.x; C0.lane = C0.tid & 63; C0.wave = __builtin_amdgcn_readfirstlane(C0.tid >> 6); C0.bid = blockIdx.x; C0.nb = gridDim.x;
    C0.vcu = (C0.nb % 8 == 0) ? (C0.bid % 8) * (C0.nb / 8) + C0.bid / 8 : C0.bid;
    volatile LAS unsigned* bst = (volatile LAS unsigned*)(C0.lds + LDS_BYTES - 16);
#if MEGA
    if (C0.tid == 0) { bst[0] = 0u; bst[1] = 0u; }
    __syncthreads();
    const unsigned bar_x = xcd_barrier_post((unsigned*)(a.ws + WS_CTL) + 4096, bst, C0.tid == 0).x;
#define SEAM() do { if (ph < hi) { XcdBarrier b2_; b2_.bar = (unsigned*)(ws + WS_CTL) + 4096; b2_.x = bar_x; b2_.st = bst; xcd_barrier(b2_, C.tid == 0); } } while (0)
#else
#define SEAM() do { } while (0)
#endif
#if MEGA
    constexpr int lo = 0, hi = N_PHASES;
#else
    const int lo = a.ph_lo, hi = a.ph_hi;
#endif
    int ph = 0;
#ifndef ONLY
#define ONLY -1
#endif
#ifndef REPMASK
#define REPMASK 0
#endif
#ifndef SITE_LO
#define SITE_LO 0
#define SITE_HI 99
#endif
#define PHASE(SITE, ...) do { if ((ONLY < 0 || ONLY == (SITE)) && (SITE) >= SITE_LO && (SITE) <= SITE_HI && ph >= lo && ph < hi) { Ctx C; C.lds = C0.lds; \
        { int w_ = C0.wave; asm volatile("" : "+s"(w_)); unsigned m_ = ~0u; asm volatile("" : "+s"(m_)); int l_ = (int)__builtin_amdgcn_mbcnt_hi(m_, __builtin_amdgcn_mbcnt_lo(m_, 0u)); C.wave = w_; C.lane = l_; C.tid = (w_ << 6) | l_; } \
        { int b_ = C0.bid, n_ = C0.nb, v_ = C0.vcu; asm volatile("" : "+s"(b_), "+s"(n_), "+s"(v_)); C.bid = b_; C.nb = n_; C.vcu = v_; } \
        unsigned z_ = 0u; asm volatile("" : "+s"(z_)); unsigned char* ws = a.ws + z_; float* XL = a.out + z_; const int lq = __builtin_amdgcn_readfirstlane(lp); typedef const __attribute__((address_space(1))) float* gfp_t; const gfp_t* INT_ = (const gfp_t*)(ws + WS_PTRS); (void)INT_; (void)XL; (void)lq; \
        for (int rep_ = 0; rep_ < ((((REPMASK) >> (SITE)) & 1) ? 2 : 1); ++rep_) { __VA_ARGS__; if ((((REPMASK) >> (SITE)) & 1)) __syncthreads(); } ++ph; SEAM(); } else ++ph; } while (0)

    { const int lp = 0;
      PHASE(0, { if (C.bid == 0) { _Pragma("unroll") for (int k = 0; k < 40; ++k) if (C.tid == k) ((const float**)(ws + WS_PTRS))[k] = a.in[k]; }
                 ph_prologue(C, a); }); }

    auto layer_pair = [&](auto lpc) __attribute__((always_inline)) {
        constexpr int lp = decltype(lpc)::value;
        if constexpr (lp == 0) PHASE(1, { const int i = 2 * lq; const float* xl = (i == 0) ? in_ptr(ws, I_X) : XL; const float* xc = (i == 0) ? in_ptr(ws, I_CTX) : P_XC;
                   ph_norm<false>(C, xl, xc, in_ptr(ws, I_N1G) + i * DM, MODL(i), 0, 1024, P_HB, nullptr, nullptr, nullptr, nullptr); });
        PHASE(2, { EpiBf16 E{P_U, EV_INP}; fast_gemm(C, P_HB, DM, (const bf16*)(ws + WS_WEVIN) + (size_t)lq * EV_INP * DM, DM, MT / 256, EV_INP / 256, E); });
        PHASE(3, { EpiBf16 Eq{(bf16*)P_QPRE, 768}; fast_gemm(C, P_U, EV_INP, (const bf16*)(ws + WS_WUQ) + (size_t)lq * 768 * 384, 384, MT / 256, 3, Eq); RELAUNDER();
                   EpiBf16 Ek{(bf16*)P_KVPRE, 1024}; fast_gemm(C, P_U + 384, EV_INP, (const bf16*)(ws + WS_WUKV) + (size_t)lq * 1024 * 256, 256, MT / 256, 4, Ek, true); });
        PHASE(4, ph_mla_fin(C, P_U, (const bf16*)P_QPRE, (const bf16*)P_KVPRE, in_ptr(ws, I_QG) + lq * 96, in_ptr(ws, I_KG) + lq * 96, (const f32x2*)(ws + WS_ROPE), P_QB, P_KB, P_VT));
        PHASE(5, ph_attn_mla2(C, P_QB, P_KB, P_VT, P_OCAT, false, ws, lq));
        PHASE(6, { const int i = 2 * lq; const float* xl = (i == 0) ? in_ptr(ws, I_X) : XL; const float* xc = (i == 0) ? in_ptr(ws, I_CTX) : P_XC;
                   EpiResid E{xl, xc, XL, P_XC, MODL(i) + 2048}; fast_gemm(C, P_OCAT, DM, (const bf16*)(ws + WS_WEVOUT) + (size_t)lq * DM * DM, DM, MT / 256, 4, E); });
        PHASE(7, { const int i = 2 * lq; ph_norm<true>(C, XL, P_XC, in_ptr(ws, I_N2G) + i * DM, MODL(i), 3072, 4096, P_HB, in_ptr(ws, I_ROUTER) + (size_t)i * DM * 16, P_AFFT, P_AFFC, P_SLOT); });
        PHASE(8, ph_topk2(C, P_AFFT, P_AFFC, P_ROWS, P_GATE, P_SLOT, false));
        PHASE(9, { MOE1_PHASE(17); });
        PHASE(10, { MOE2_PHASE(17); });
        PHASE(11, { const int i = 2 * lq; ph_combine(C, XL, P_XC, MODL(i) + 5120, P_SLOT, P_Y2, false, in_ptr(ws, I_N1G) + (i + 1) * DM, MODL(i + 1), P_HB); });
        PHASE(13, { EpiBf16 E{P_U, OD_INP}; fast_gemm(C, P_HB, DM, (const bf16*)(ws + WS_WODIN) + (size_t)lq * OD_INP * DM, DM, MT / 256, OD_INP / 256, E); });
        PHASE(14, ph_prep(C, P_U, in_ptr(ws, I_SHIFTW) + (size_t)lq * 3 * RW_IN, in_ptr(ws, I_KKW) + lq * 512, in_ptr(ws, I_NAQG) + lq * 64, in_ptr(ws, I_NAKG) + lq * 64, P_R, P_V, P_K, P_KK, P_L, P_QN, P_KN, P_VTN));
        PHASE(15, { const bf16* WL = (const bf16*)(ws + WS_WLORA) + (size_t)lq * 655360;
                    { EpiLoraW E{P_W, in_ptr(ws, I_W0) + lq * 1024}; fast_gemm(C, P_L, 384, WL, 256, MT / 256, 4, E); } RELAUNDER();
                    { EpiLoraA E{P_KEFF, in_ptr(ws, I_A0) + lq * 1024}; fast_gemm(C, P_L, 384, WL + (size_t)1024 * 256, 256, MT / 256, 4, E, true); } RELAUNDER();
                    { EpiBf16 E{P_G, 512}; fast_gemm(C, P_L + 128, 384, WL + (size_t)2048 * 256, 256, MT / 256, 2, E); } });
        PHASE(16, ph_wkv_pre(C, P_R, P_K, P_KK, P_W, P_KEFF, in_ptr(ws, I_KA) + lq * 512, P_IMG));
        PHASE(17, { ph_wkv_chunk(C, P_R, P_V, P_K, P_KK, P_W, P_KEFF, in_ptr(ws, I_KA) + lq * 512, P_IMG, P_YS); __syncthreads();
                    ph_natten2(C, P_QN, P_KN, P_VTN, P_OCAT, in_ptr(ws, I_RPB) + (size_t)lq * 8 * 465, lq == 1, (unsigned*)(ws + WS_CTL) + 8192 + 64 * lq, ws, lq); });
        PHASE(18, ph_post(C, P_YS, P_R, P_V, P_K, P_KEFF, in_ptr(ws, I_KA) + lq * 512, P_G, in_ptr(ws, I_RK) + lq * 512, in_ptr(ws, I_GNG) + lq * 512, in_ptr(ws, I_GNB) + lq * 512, P_OCAT, lq == 1));
        PHASE(19, { const int i = 2 * lq + 1; EpiResid E{XL, P_XC, XL, P_XC, MODL(i) + 2048};
                    fast_gemm(C, P_OCAT, DM, (const bf16*)(ws + WS_WODOUT) + (size_t)lq * DM * DM, DM, (lq == 1) ? NLAT / 256 : MT / 256, 4, E); });
        PHASE(20, { const int i = 2 * lq + 1; ph_norm<true>(C, XL, P_XC, in_ptr(ws, I_N2G) + i * DM, MODL(i), 3072, 4096, P_HB, in_ptr(ws, I_ROUTER) + (size_t)i * DM * 16, P_AFFT, P_AFFC, P_SLOT); });
        PHASE(21, ph_topk2(C, P_AFFT, P_AFFC, P_ROWS, P_GATE, P_SLOT, lq == 1));
        PHASE(22, { MOE1_PHASE((lq == 1) ? 16 : 17); });
        PHASE(23, { MOE2_PHASE((lq == 1) ? 16 : 17); });
        PHASE(24, { const int i = 2 * lq + 1;
                    if (lp == 0) ph_combine(C, XL, P_XC, MODL(i) + 5120, P_SLOT, P_Y2, false, in_ptr(ws, I_N1G) + (i + 1) * DM, MODL(i + 1), P_HB);
                    else ph_combine(C, XL, P_XC, MODL(i) + 5120, P_SLOT, P_Y2, true, nullptr, nullptr, nullptr); });
    };
    layer_pair(IC<0>{}); layer_pair(IC<1>{});
}

extern "C" void kernel_launch(void* const* d_in, const int* in_sizes, int n_in, void* d_out, int out_size, void* d_ws, size_t ws_size, hipStream_t stream) {
    static int grid = 0;
    if (grid == 0) {
        if (n_in != 40 || out_size != NLAT * DM || ws_size < WS_END) { fprintf(stderr, "kernel_launch: unexpected shapes (n_in %d out %d ws %zu need %zu)\n", n_in, out_size, ws_size, (size_t)WS_END); grid = -1; return; }
        int dev = 0, cus = 0, per_cu = 0;
        if (hipGetDevice(&dev) != hipSuccess || hipDeviceGetAttribute(&cus, hipDeviceAttributeMultiprocessorCount, dev) != hipSuccess) { grid = -1; return; }
        if (hipFuncSetAttribute((const void*)fwd_kernel, hipFuncAttributeMaxDynamicSharedMemorySize, LDS_BYTES) != hipSuccess) { fprintf(stderr, "kernel_launch: hipFuncSetAttribute failed\n"); grid = -1; return; }
        if (hipOccupancyMaxActiveBlocksPerMultiprocessor(&per_cu, (const void*)fwd_kernel, 512, LDS_BYTES) != hipSuccess || per_cu < 1) { fprintf(stderr, "kernel_launch: occupancy query says %d\n", per_cu); per_cu = 1; }
        (void)hipGetLastError();
        grid = cus;
    }
    if (grid < 0) return;
    (void)hipMemsetAsync((char*)d_ws + WS_CTL, 0, CTL_BYTES, stream);
    Args a{};
    for (int i = 0; i < 40; ++i) a.in[i] = (const float*)d_in[i];
    a.out = (float*)d_out; a.ws = (unsigned char*)d_ws;
#if MEGA
    a.ph_lo = 0; a.ph_hi = N_PHASES;
    hipLaunchKernelGGL(fwd_kernel, dim3(grid), dim3(512), LDS_BYTES, stream, a);
#else
    for (int p = 0; p < N_PHASES; ++p) { a.ph_lo = p; a.ph_hi = p + 1; hipLaunchKernelGGL(fwd_kernel, dim3(grid), dim3(512), LDS_BYTES, stream, a); }
#endif
}
```

```cpp
#include <hip/hip_runtime.h>
#include <cstdio>
#include <cstdint>

#ifndef MEGA
#define MEGA 1
#endif

#define LAS __attribute__((address_space(3)))
#define DI __device__ __forceinline__

typedef unsigned short bf16;
typedef short bf16x8 __attribute__((ext_vector_type(8)));
typedef float f32x4 __attribute__((ext_vector_type(4)));
typedef float f32x2 __attribute__((ext_vector_type(2)));
typedef float f32x16 __attribute__((ext_vector_type(16)));
typedef unsigned u32x4 __attribute__((ext_vector_type(4)));
typedef unsigned u32x2 __attribute__((ext_vector_type(2)));
typedef __bf16 bf16x2_t __attribute__((ext_vector_type(2)));

constexpr int DM = 1024, NB = 8, TL = 4096, LCX = 256;
constexpr int NLAT = NB * TL, NCTX = NB * LCX, MT = NLAT + NCTX;
constexpr int KPOS = TL + LCX;
constexpr float EPS = 1e-6f, GN_EPS = 64e-5f;
constexpr int EV_IN = 1696, EV_INP = 1792, OD_IN = 3456, OD_INP = 3584, RW_IN = 1920;
constexpr int NEXP = 16, CAPL = 512, CAPC = 32, ESLOTS = NB * CAPL + NB * CAPC;
constexpr float LOG2E = 1.4426950408889634f;

constexpr size_t MiB = 1ull << 20;
constexpr size_t WS_CTL = 0, CTL_BYTES = 1 * MiB;
constexpr size_t WS_MOD = 1 * MiB, WS_ROPE = 2 * MiB, WS_XC = 4 * MiB;
constexpr size_t WS_ROWS = 12 * MiB, WS_GATE = 12 * MiB + 512 * 1024, WS_SLOT = 13 * MiB, WS_AFFT = 16 * MiB, WS_AFFC = 18 * MiB;
constexpr size_t WS_WEVIN = 20 * MiB, WS_WEVOUT = 27 * MiB, WS_WUQ = 31 * MiB, WS_WUKV = 33 * MiB, WS_WODIN = 34 * MiB, WS_WODOUT = 48 * MiB, WS_WLORA = 52 * MiB;
constexpr size_t WS_W13 = 56 * MiB, WS_W2 = 120 * MiB, WS_HB = 152 * MiB, WS_OCAT = 220 * MiB, WS_ARENA = 288 * MiB;
constexpr size_t A_U = 0, A_QPRE = 119 * MiB, A_KVPRE = 221 * MiB, A_QB = 357 * MiB, A_KB = 408 * MiB, A_VT = 459 * MiB;
constexpr size_t A_W = 0, A_KEFF = 136 * MiB  , A_G = 204 * MiB, A_R = 238 * MiB, A_V = 272 * MiB, A_KK = 306 * MiB, A_K = 340 * MiB, A_L = 374 * MiB,
                 A_QN = 400 * MiB, A_KN = 434 * MiB, A_VTN = 468 * MiB, A_YS = 612 * MiB  ;
constexpr size_t A_HID = 0, A_Y2 = 136 * MiB;
constexpr size_t A_IMG = 510 * MiB;
constexpr size_t WS_END = WS_ARENA + 680 * MiB;
constexpr int LDS_BYTES = 147456;

DI unsigned pk2(float lo, float hi) { f32x2 v = {lo, hi}; bf16x2_t b = __builtin_convertvector(v, bf16x2_t); return __builtin_bit_cast(unsigned, b); }
DI float bflo(unsigned u) { return __builtin_bit_cast(float, u << 16); }
DI float bfhi(unsigned u) { return __builtin_bit_cast(float, u & 0xffff0000u); }
DI float bf2f(bf16 x) { return __builtin_bit_cast(float, ((unsigned)x) << 16); }
DI bf16 f2bf(float f) { return (bf16)(pk2(f, 0.f) & 0xffffu); }
DI void unpack8(u32x4 v, float (&f)[8]) { f[0] = bflo(v.x); f[1] = bfhi(v.x); f[2] = bflo(v.y); f[3] = bfhi(v.y); f[4] = bflo(v.z); f[5] = bfhi(v.z); f[6] = bflo(v.w); f[7] = bfhi(v.w); }
DI u32x4 pack8(const float (&f)[8]) { u32x4 r; r.x = pk2(f[0], f[1]); r.y = pk2(f[2], f[3]); r.z = pk2(f[4], f[5]); r.w = pk2(f[6], f[7]); return r; }
#define DPP_ADD(x, ctrl) ((x) + __builtin_bit_cast(float, __builtin_amdgcn_update_dpp(0, __builtin_bit_cast(int, (x)), (ctrl), 0xf, 0xf, false)))
#define DPP_MAX(x, ctrl) fmaxf((x), __builtin_bit_cast(float, __builtin_amdgcn_update_dpp(0, __builtin_bit_cast(int, (x)), (ctrl), 0xf, 0xf, false)))
DI float sum8(float x) { x = DPP_ADD(x, 0xB1); x = DPP_ADD(x, 0x4E); x = DPP_ADD(x, 0x141); return x; }
DI float sum16(float x) { x = DPP_ADD(x, 0xB1); x = DPP_ADD(x, 0x4E); x = DPP_ADD(x, 0x141); x = DPP_ADD(x, 0x140); return x; }
DI float max16(float x) { x = DPP_MAX(x, 0xB1); x = DPP_MAX(x, 0x4E); x = DPP_MAX(x, 0x141); x = DPP_MAX(x, 0x140); return x; }
DI float rdlane(float x, int l) { return __builtin_bit_cast(float, __builtin_amdgcn_readlane(__builtin_bit_cast(int, x), l)); }
DI float wave_sum(float v) { const float x = sum16(v); return (rdlane(x, 0) + rdlane(x, 16)) + (rdlane(x, 32) + rdlane(x, 48)); }
DI float xor32(float v, int lane) { return __builtin_bit_cast(float, __builtin_amdgcn_ds_bpermute((lane ^ 32) << 2, __builtin_bit_cast(int, v))); }
typedef int v8i_t __attribute__((ext_vector_type(8)));
typedef int i32x4_t __attribute__((ext_vector_type(4)));
DI unsigned pk4_fp8(float a, float b, float c, float d) {
    a = __builtin_amdgcn_fmed3f(a, -448.f, 448.f); b = __builtin_amdgcn_fmed3f(b, -448.f, 448.f); c = __builtin_amdgcn_fmed3f(c, -448.f, 448.f); d = __builtin_amdgcn_fmed3f(d, -448.f, 448.f);
    int p = __builtin_amdgcn_cvt_pk_fp8_f32(a, b, 0, false); p = __builtin_amdgcn_cvt_pk_fp8_f32(c, d, p, true); return (unsigned)p; }
#ifndef MOE_F8
#define MOE_F8 1
#endif
constexpr int SCALE_ONE = 0x7f7f7f7f, SCALE_W = 0x79797979  , SCALE_HID = 0x7c7c7c7c  ;
DI float sigmoidf_(float x) { return __builtin_amdgcn_rcpf(1.f + __expf(-x)); }
DI float siluf_(float x) { return x * __builtin_amdgcn_rcpf(1.f + __expf(-x)); }
#define MFMA32(a, b, c) __builtin_amdgcn_mfma_f32_32x32x16_bf16((a), (b), (c), 0, 0, 0)

#define XB_TMO      128
#define XB_XCNT(j)  (256  + 64 * (j))
#define XB_XSUB(j)  (1280 + 64 * (j))
#define XB_XGEN(j)  (2304 + 64 * (j))
#define XB_TOP      3328
#define XB_TOPGEN   3392
#define XCD_BAR_WORDS 3456
#define XB_SPIN_CAP (1u << 22)
__device__ __forceinline__ unsigned xb_ld(unsigned* p)              { return __hip_atomic_load(p, __ATOMIC_RELAXED, __HIP_MEMORY_SCOPE_AGENT); }
__device__ __forceinline__ unsigned xb_add(unsigned* p, unsigned v) { return __hip_atomic_fetch_add(p, v, __ATOMIC_RELAXED, __HIP_MEMORY_SCOPE_AGENT); }
__device__ __forceinline__ unsigned xb_xcc_id() { return (unsigned)__builtin_amdgcn_s_getreg((3 << 11) | 20) & 0xFu; }
#define XB_SPIN(cond, bar) do { unsigned _sp = 0; while (cond) { __builtin_amdgcn_s_sleep(1); \
    if ((++_sp & 255u) == 0u) { if (xb_ld(&(bar)[XB_TMO])) break; if (_sp > XB_SPIN_CAP) { atomicAdd(&(bar)[XB_TMO], 1u); break; } } } } while (0)
struct XcdBarrier { unsigned* bar; unsigned x; volatile LAS unsigned* st; };
__device__ __forceinline__ XcdBarrier xcd_barrier_post(unsigned* bar, volatile LAS unsigned* st, bool leader) {
    XcdBarrier b; b.bar = bar; b.x = xb_xcc_id(); b.st = st;
    if (leader) (void)xb_add(&bar[XB_XCNT(b.x)], 1u);
    return b;
}
__device__ __forceinline__ void xcd_barrier_complete(unsigned* bar, unsigned x, unsigned& nloc, unsigned& nx) {
    const unsigned G = gridDim.x * gridDim.y * gridDim.z;
    unsigned sum, cnt, mine, sp = 0u;
    for (;;) {
        sum = 0u; cnt = 0u; mine = 0u;
#pragma unroll
        for (unsigned j = 0; j < 16; ++j) { const unsigned c = xb_ld(&bar[XB_XCNT(j)]); sum += c; cnt += (c > 0u) ? 1u : 0u; mine = (j == x) ? c : mine; }
        if (sum == G) break;
        __builtin_amdgcn_s_sleep(1);
        if ((++sp & 255u) == 0u) { if (xb_ld(&bar[XB_TMO])) break; if (sp > XB_SPIN_CAP) { atomicAdd(&bar[XB_TMO], 1u); break; } }
    }
    nloc = mine > 0u ? mine : 1u; nx = cnt > 0u ? cnt : 1u;
}
__device__ __forceinline__ void xcd_barrier(const XcdBarrier& b, bool leader) {
    asm volatile("s_waitcnt vmcnt(0)" ::: "memory");
    __syncthreads();
    if (leader) {
        unsigned* bar = b.bar;
        __builtin_amdgcn_s_waitcnt(0);
        unsigned nloc = b.st[0], nx = b.st[1];
        if (nloc == 0u) { xcd_barrier_complete(bar, b.x, nloc, nx); b.st[0] = nloc; b.st[1] = nx; }
        const unsigned old = xb_add(&bar[XB_XSUB(b.x)], 1u);
        const unsigned gen = old / nloc;
        if (old + 1u == (gen + 1u) * nloc) {
            __builtin_amdgcn_fence(__ATOMIC_RELEASE, "agent");
            asm volatile("s_waitcnt vmcnt(0)" ::: "memory");
            const unsigned og = xb_add(&bar[XB_TOP], 1u);
            const unsigned tg = og / nx;
            if (og + 1u == (tg + 1u) * nx) xb_add(&bar[XB_TOPGEN], 1u);
            else XB_SPIN(xb_ld(&bar[XB_TOPGEN]) == tg, bar);
            __builtin_amdgcn_fence(__ATOMIC_ACQUIRE, "agent");
            xb_add(&bar[XB_XGEN(b.x)], 1u);
            asm volatile("s_waitcnt vmcnt(0)" ::: "memory");
        } else {
            XB_SPIN(xb_ld(&bar[XB_XGEN(b.x)]) == gen, bar);
            __builtin_amdgcn_fence(__ATOMIC_ACQUIRE, "agent");
            asm volatile("s_waitcnt vmcnt(0)" ::: "memory");
        }
    }
    __syncthreads();
}

struct Ctx { LAS unsigned char* lds; int tid, lane, wave, bid, nb, vcu; };
struct Args { const float* in[40]; float* out; unsigned char* ws; int ph_lo, ph_hi; };
enum { I_X = 0, I_C, I_CTX, I_CCTX, I_ADAW, I_ADAB, I_N1G, I_N2G, I_EVWIN, I_EVWOUT, I_QNORM, I_WUQ, I_KVNORM, I_WUKV, I_QG, I_KG, I_DWW, I_DWB, I_LNG, I_LNB,
       I_ODWIN, I_ODWOUT, I_SHIFTW, I_W0, I_W2L, I_A0, I_A2, I_G2, I_KKW, I_KA, I_RK, I_GNG, I_GNB, I_NAQG, I_NAKG, I_RPB, I_ROUTER, I_MW1, I_MW3, I_MW2 };

DI void transpose_item(const float* __restrict__ W, int K, int N, bf16* __restrict__ WT, int dst_row0, const float* __restrict__ gain, LAS float* scr, int k0, int n0, int lane) {
#pragma unroll 8
    for (int i = 0; i < 32; ++i) { const int kk = 2 * i + (lane >> 5); float v = W[(size_t)(k0 + kk) * N + n0 + (lane & 31)]; if (gain) v *= gain[k0 + kk]; scr[kk * 33 + (lane & 31)] = v; }
    asm volatile("s_waitcnt lgkmcnt(0)" ::: "memory");
    const int c = lane & 7;
#pragma unroll
    for (int j = 0; j < 4; ++j) { const int n = (lane >> 3) + 8 * j; const LAS float* s = scr + (8 * c) * 33 + n;
        u32x4 o; o.x = pk2(s[0 * 33], s[1 * 33]); o.y = pk2(s[2 * 33], s[3 * 33]); o.z = pk2(s[4 * 33], s[5 * 33]); o.w = pk2(s[6 * 33], s[7 * 33]);
        *(u32x4*)(WT + (size_t)(dst_row0 + n) * K + k0 + 8 * c) = o; }
    asm volatile("s_waitcnt lgkmcnt(0)" ::: "memory");
}
DI void transpose_item64(const float* __restrict__ W, int K, int N, bf16* __restrict__ WT, int dst_row0, LAS float* scr, int k0, int n0, int lane) {
    f32x4 v[16];
#pragma unroll
    for (int i = 0; i < 16; ++i) v[i] = *(const f32x4*)(W + (size_t)(k0 + 4 * i + (lane >> 4)) * N + n0 + 4 * (lane & 15));
#pragma unroll
    for (int i = 0; i < 16; ++i) { LAS float* d = scr + (4 * i + (lane >> 4)) * 65 + 4 * (lane & 15); d[0] = v[i].x; d[1] = v[i].y; d[2] = v[i].z; d[3] = v[i].w; }
    asm volatile("s_waitcnt lgkmcnt(0)" ::: "memory");
    const int c = lane & 7;
#pragma unroll
    for (int j = 0; j < 8; ++j) { const int n = (lane >> 3) + 8 * j; const LAS float* s = scr + (8 * c) * 65 + n;
        u32x4 o; o.x = pk2(s[0 * 65], s[1 * 65]); o.y = pk2(s[2 * 65], s[3 * 65]); o.z = pk2(s[4 * 65], s[5 * 65]); o.w = pk2(s[6 * 65], s[7 * 65]);
        *(u32x4*)(WT + (size_t)(dst_row0 + n) * K + k0 + 8 * c) = o; }
    asm volatile("s_waitcnt lgkmcnt(0)" ::: "memory");
}
DI void transpose_item64_f8(const float* __restrict__ W, int K, int N, unsigned char* __restrict__ WT8, int dst_row0, LAS float* scr, int k0, int n0, int lane) {
    f32x4 v[16];
#pragma unroll
    for (int i = 0; i < 16; ++i) v[i] = *(const f32x4*)(W + (size_t)(k0 + 4 * i + (lane >> 4)) * N + n0 + 4 * (lane & 15));
#pragma unroll
    for (int i = 0; i < 16; ++i) { LAS float* d = scr + (4 * i + (lane >> 4)) * 65 + 4 * (lane & 15); d[0] = v[i].x; d[1] = v[i].y; d[2] = v[i].z; d[3] = v[i].w; }
    asm volatile("s_waitcnt lgkmcnt(0)" ::: "memory");
    const int c = lane & 7;
#pragma unroll
    for (int j = 0; j < 8; ++j) { const int n = (lane >> 3) + 8 * j; const LAS float* s = scr + (8 * c) * 65 + n;
        u32x2 o; o.x = pk4_fp8(64.f * s[0 * 65], 64.f * s[1 * 65], 64.f * s[2 * 65], 64.f * s[3 * 65]); o.y = pk4_fp8(64.f * s[4 * 65], 64.f * s[5 * 65], 64.f * s[6 * 65], 64.f * s[7 * 65]);
        *(u32x2*)(WT8 + (size_t)(dst_row0 + n) * K + k0 + 8 * c) = o; }
    asm volatile("s_waitcnt lgkmcnt(0)" ::: "memory");
}
DI void transpose_matrix(const Ctx& C, const float* W, int K, int N, bf16* WT, const float* gain, int mode  ) {
    LAS float* scr = (LAS float*)(C.lds + C.wave * 8704);
    const int nkb = K / 64, nnb = N / 32, nit = nkb * nnb, gw = C.vcu * 8 + C.wave, ngw = C.nb * 8;
    for (int it = gw; it < nit; it += ngw) {
        const int kb = it / nnb, nbk = it % nnb, n0 = nbk * 32;
        int d0 = n0; if (mode) d0 = (n0 >> 7) * 256 + (n0 & 127) + (mode == 2 ? 128 : 0);
        transpose_item(W, K, N, WT, d0, gain, scr, kb * 64, n0, C.lane);
    }
}

DI void ph_prologue(const Ctx& C, const Args& a) {
    unsigned char* ws = a.ws;
    {
        LAS float* sv = (LAS float*)C.lds;
        LAS float* red = sv + 9 * 1024;
        for (int i = C.tid; i < 9 * 1024; i += 512) { const int m = i >> 10, k = i & 1023; const float c = (m < 8) ? a.in[I_C][m * 1024 + k] : a.in[I_CCTX][k]; sv[i] = siluf_(c); }
        __syncthreads();
        float* MOD = (float*)(ws + WS_MOD);
        for (int it = C.bid; it < 4 * 96; it += C.nb) {
            const int layer = it / 96, col = (it % 96) * 64 + C.lane;
            const float* wp = a.in[I_ADAW] + (size_t)layer * 1024 * 6144 + col;
            float acc[9];
#pragma unroll
            for (int m = 0; m < 9; ++m) acc[m] = 0.f;
            const int kb = C.wave * 128;
#pragma unroll 16
            for (int k = 0; k < 128; ++k) { const float w = wp[(size_t)(kb + k) * 6144];
#pragma unroll
                for (int m = 0; m < 9; ++m) acc[m] += sv[m * 1024 + kb + k] * w; }
#pragma unroll
            for (int m = 0; m < 9; ++m) red[(C.wave * 9 + m) * 64 + C.lane] = acc[m];
            __syncthreads();
            for (int i = C.tid; i < 576; i += 512) { const int m = i >> 6, l = i & 63; float s = 0.f;
#pragma unroll
                for (int w = 0; w < 8; ++w) s += red[(w * 9 + m) * 64 + l];
                const int cc = (it % 96) * 64 + l;
                MOD[(size_t)(layer * 9 + m) * 6144 + cc] = s + a.in[I_ADAB][layer * 6144 + cc]; }
            __syncthreads();
        }
    }
    {
        f32x2* CS = (f32x2*)(ws + WS_ROPE);
        for (int i = C.bid * 512 + C.tid; i < 4096 * 16; i += C.nb * 512) {
            const int pos = i >> 4, j = i & 15, f = j & 7;
            const float inv = powf(10000.f, -(float)(2 * f) / 16.f);
            const float ang = (float)((j < 8) ? (pos >> 6) : (pos & 63)) * inv;
            const double tw = 6.283185307179586476925;
            const double x = (double)ang, n = __builtin_rint(x / tw), rr = x - n * tw;
            CS[i] = (f32x2){__cosf((float)rr), __sinf((float)rr)};
        }
    }
    for (int j = 0; j < 2; ++j) {
        transpose_matrix(C, a.in[I_EVWIN] + (size_t)j * DM * EV_IN, DM, EV_IN, (bf16*)(ws + WS_WEVIN) + (size_t)j * EV_INP * DM, nullptr, 0);
        transpose_matrix(C, a.in[I_EVWOUT] + (size_t)j * DM * DM, DM, DM, (bf16*)(ws + WS_WEVOUT) + (size_t)j * DM * DM, nullptr, 0);
        transpose_matrix(C, a.in[I_WUQ] + (size_t)j * 384 * 768, 384, 768, (bf16*)(ws + WS_WUQ) + (size_t)j * 768 * 384, a.in[I_QNORM] + j * 384, 0);
        transpose_matrix(C, a.in[I_WUKV] + (size_t)j * 256 * 1024, 256, 1024, (bf16*)(ws + WS_WUKV) + (size_t)j * 1024 * 256, a.in[I_KVNORM] + j * 256, 0);
        transpose_matrix(C, a.in[I_ODWIN] + (size_t)j * DM * OD_IN, DM, OD_IN, (bf16*)(ws + WS_WODIN) + (size_t)j * OD_INP * DM, nullptr, 0);
        transpose_matrix(C, a.in[I_ODWOUT] + (size_t)j * DM * DM, DM, DM, (bf16*)(ws + WS_WODOUT) + (size_t)j * DM * DM, nullptr, 0);
    }
    {
        const int gt = C.bid * 512 + C.tid, ngt = C.nb * 512;
        for (int j = 0; j < 2; ++j) {
            u32x4* p0 = (u32x4*)((bf16*)(ws + WS_WEVIN) + (size_t)j * EV_INP * DM + (size_t)EV_IN * DM);
            for (int i = gt; i < (EV_INP - EV_IN) * DM / 8; i += ngt) p0[i] = (u32x4){0u, 0u, 0u, 0u};
            u32x4* p1 = (u32x4*)((bf16*)(ws + WS_WODIN) + (size_t)j * OD_INP * DM + (size_t)OD_IN * DM);
            for (int i = gt; i < (OD_INP - OD_IN) * DM / 8; i += ngt) p1[i] = (u32x4){0u, 0u, 0u, 0u};
            bf16* WL = (bf16*)(ws + WS_WLORA) + (size_t)j * 655360;
            const float* w2 = a.in[I_W2L] + (size_t)j * 2 * 64 * 512; const float* a2 = a.in[I_A2] + (size_t)j * 2 * 64 * 512; const float* g2 = a.in[I_G2] + (size_t)j * 128 * 512;
            for (int i = gt; i < 655360; i += ngt) {
                const int n = i >> 8, k = i & 255; float v = 0.f;
                if (n < 1024) { const int d = n >> 9, c = n & 511; if (k >= d * 64 && k < d * 64 + 64) v = w2[(size_t)k * 512 + c]; }
                else if (n < 2048) { const int d = (n - 1024) >> 9, c = n & 511; if (k >= 128 + d * 64 && k < 192 + d * 64) v = a2[(size_t)(k - 128) * 512 + c]; }
                else { const int c = n - 2048; if (k >= 128) v = g2[(size_t)(k - 128) * 512 + c]; }
                WL[i] = f2bf(v);
            }
        }
    }
}

template <bool ROUTER>
DI void ph_norm(const Ctx& C, const float* xlat, const float* xctx, const float* gain, const float* mod  , int shift_off, int scale_off, bf16* H,
                const float* router  , float* AFFT, float* AFFC, int* SLOT) {
    LAS float* RT = (LAS float*)C.lds;
    if (ROUTER) { for (int i = C.tid; i < 16384; i += 512) { const int c = i >> 4, e = i & 15; RT[e * 1024 + c] = router[i]; } __syncthreads(); }
    const int gw = C.bid * 8 + C.wave, ngw = C.nb * 8, lane = C.lane;
    for (int row = gw; row < MT; row += ngw) {
        const float* xr = row < NLAT ? xlat + (size_t)row * DM : xctx + (size_t)(row - NLAT) * DM;
        const int mi = row < NLAT ? (row >> 12) : 8;
        const float* mp = mod + mi * 6144;
        f32x4 v[4]; float ss = 0.f;
#pragma unroll
        for (int j = 0; j < 4; ++j) { v[j] = *(const f32x4*)(xr + 256 * j + 4 * lane); ss += v[j].x * v[j].x + v[j].y * v[j].y + v[j].z * v[j].z + v[j].w * v[j].w; }
        ss = wave_sum(ss);
        const float rs = 1.0f / sqrtf(ss * (1.f / 1024.f) + EPS);
#pragma unroll
        for (int j = 0; j < 4; ++j) {
            const int c = 256 * j + 4 * lane;
            const f32x4 g = *(const f32x4*)(gain + c), sc = *(const f32x4*)(mp + scale_off + c), sh = *(const f32x4*)(mp + shift_off + c);
            v[j] = (v[j] * rs) * g * (sc + 1.0f) + sh;
            if (ROUTER && MOE_F8) *(unsigned*)((unsigned char*)H + (size_t)row * DM + c) = pk4_fp8(v[j].x, v[j].y, v[j].z, v[j].w);
            else *(u32x2*)(H + (size_t)row * DM + c) = (u32x2){pk2(v[j].x, v[j].y), pk2(v[j].z, v[j].w)};
        }
        if (ROUTER) {
            float mylg = 0.f;
#pragma unroll 1
            for (int e = 0; e < 16; ++e) { float p = 0.f;
#pragma unroll
                for (int j = 0; j < 4; ++j) { const f32x4 w = *(const LAS f32x4*)(RT + e * 1024 + 256 * j + 4 * lane); p += v[j].x * w.x + v[j].y * w.y + v[j].z * w.z + v[j].w * w.w; }
                p = wave_sum(p); mylg = (lane == e) ? p : mylg; }
            const float mx = max16(mylg);
            const float ex = expf(mylg - mx);
            const float mine = ex / sum16(ex);
            if (lane < 16) {
                if (row < NLAT) AFFT[(size_t)((row >> 12) * 16 + lane) * TL + (row & 4095)] = mine;
                else { const int rc = row - NLAT; AFFC[(size_t)((rc >> 8) * 16 + lane) * LCX + (rc & 255)] = mine; }
                SLOT[(size_t)row * 16 + lane] = -1;
            }
        }
    }
}


struct EpiBf16 { static constexpr bool WIDE = true; bf16* O; int ldo;
    DI void operator()(int row, int col, f32x4 v0, f32x4 v1) const { bf16* p = O + (size_t)row * ldo + col;
        *(u32x2*)p = (u32x2){pk2(v0[0], v0[1]), pk2(v0[2], v0[3])}; *(u32x2*)(p + 128) = (u32x2){pk2(v1[0], v1[1]), pk2(v1[2], v1[3])}; }
    DI void wide(int row, int col, f32x4 a0, f32x4 a1, f32x4 b0, f32x4 b1) const { bf16* p = O + (size_t)row * ldo + col;
        *(u32x4*)p = (u32x4){pk2(a0[0], a0[1]), pk2(a0[2], a0[3]), pk2(a1[0], a1[1]), pk2(a1[2], a1[3])}; *(u32x4*)(p + 128) = (u32x4){pk2(b0[0], b0[1]), pk2(b0[2], b0[3]), pk2(b1[0], b1[1]), pk2(b1[2], b1[3])}; } };
struct EpiF32 { static constexpr bool WIDE = false; float* O; int ldo;
    DI void operator()(int row, int col, f32x4 v0, f32x4 v1) const { float* p = O + (size_t)row * ldo + col; *(f32x4*)p = v0; *(f32x4*)(p + 128) = v1; } };
struct EpiResid { static constexpr bool WIDE = false; const float* xin_lat; const float* xin_ctx; float* xout_lat; float* xout_ctx; const float* modg;
    DI void operator()(int row, int col, f32x4 v0, f32x4 v1) const {
        const float* xi; float* xo; int mi;
        if (row < NLAT) { xi = xin_lat + (size_t)row * DM; xo = xout_lat + (size_t)row * DM; mi = row >> 12; }
        else { xi = xin_ctx + (size_t)(row - NLAT) * DM; xo = xout_ctx + (size_t)(row - NLAT) * DM; mi = 8; }
        const float* g = modg + mi * 6144 + col;
        const f32x4 g0 = *(const f32x4*)g, g1 = *(const f32x4*)(g + 128), x0 = *(const f32x4*)(xi + col), x1 = *(const f32x4*)(xi + col + 128);
        *(f32x4*)(xo + col) = x0 + g0 * v0; *(f32x4*)(xo + col + 128) = x1 + g1 * v1; } };
struct EpiGlu { static constexpr bool WIDE = false; bf16* O;
    DI void operator()(int row, int col, f32x4 v0, f32x4 v1) const { const int f = ((col & 2047) >> 8) * 128 + (col & 255);
        *(u32x2*)(O + (size_t)row * DM + f) = (u32x2){pk2(siluf_(v0[0]) * v1[0], siluf_(v0[1]) * v1[1]), pk2(siluf_(v0[2]) * v1[2], siluf_(v0[3]) * v1[3])}; } };
struct EpiGlu8 { static constexpr bool WIDE = true; unsigned char* O;
    DI void operator()(int row, int col, f32x4 v0, f32x4 v1) const { const int f = ((col & 2047) >> 8) * 128 + (col & 255);
        *(unsigned*)(O + (size_t)row * DM + f) = pk4_fp8(8.f * siluf_(v0[0]) * v1[0], 8.f * siluf_(v0[1]) * v1[1], 8.f * siluf_(v0[2]) * v1[2], 8.f * siluf_(v0[3]) * v1[3]); }
    DI void wide(int row, int col, f32x4 a0, f32x4 a1, f32x4 b0, f32x4 b1) const { const int f = ((col & 2047) >> 8) * 128 + (col & 255);
        *(u32x2*)(O + (size_t)row * DM + f) = (u32x2){pk4_fp8(8.f * siluf_(a0[0]) * b0[0], 8.f * siluf_(a0[1]) * b0[1], 8.f * siluf_(a0[2]) * b0[2], 8.f * siluf_(a0[3]) * b0[3]),
                                                    pk4_fp8(8.f * siluf_(a1[0]) * b1[0], 8.f * siluf_(a1[1]) * b1[1], 8.f * siluf_(a1[2]) * b1[2], 8.f * siluf_(a1[3]) * b1[3])}; } };
struct EpiGate { static constexpr bool WIDE = true; bf16* O; const float* gate;
    DI void operator()(int row, int col, f32x4 v0, f32x4 v1) const { const float g = gate[row]; bf16* p = O + (size_t)row * DM + (col & 1023);
        *(u32x2*)p = (u32x2){pk2(v0[0] * g, v0[1] * g), pk2(v0[2] * g, v0[3] * g)}; *(u32x2*)(p + 128) = (u32x2){pk2(v1[0] * g, v1[1] * g), pk2(v1[2] * g, v1[3] * g)}; }
    DI void wide(int row, int col, f32x4 a0, f32x4 a1, f32x4 b0, f32x4 b1) const { const float g = gate[row]; bf16* p = O + (size_t)row * DM + (col & 1023);
        *(u32x4*)p = (u32x4){pk2(a0[0] * g, a0[1] * g), pk2(a0[2] * g, a0[3] * g), pk2(a1[0] * g, a1[1] * g), pk2(a1[2] * g, a1[3] * g)};
        *(u32x4*)(p + 128) = (u32x4){pk2(b0[0] * g, b0[1] * g), pk2(b0[2] * g, b0[3] * g), pk2(b1[0] * g, b1[1] * g), pk2(b1[2] * g, b1[3] * g)}; } };
struct EpiLoraW { static constexpr bool WIDE = false; float* W; const float* w0;
    DI void one(int row, int col, f32x4 v) const { const int d = col >> 9, c = col & 511; f32x4 o;
#pragma unroll
        for (int e = 0; e < 4; ++e) { const float lw = w0[col + e] + v[e]; const float z = -lw; const float sp = fmaxf(z, 0.f) + __logf(1.f + __expf(-fabsf(z))); o[e] = -__expf(-sp - 0.5f); }
        *(f32x4*)(W + ((size_t)d * MT + row) * 512 + c) = o; }
    DI void operator()(int row, int col, f32x4 v0, f32x4 v1) const { one(row, col, v0); one(row, col + 128, v1); } };
struct EpiLoraA { static constexpr bool WIDE = false; bf16* Aout; const float* a0;
    DI void one(int row, int col, f32x4 v) const { const int d = col >> 9, c = col & 511; const f32x4 b = *(const f32x4*)(a0 + col);
        *(u32x2*)(Aout + ((size_t)d * MT + row) * 512 + c) = (u32x2){pk2(sigmoidf_(b[0] + v[0]), sigmoidf_(b[1] + v[1])), pk2(sigmoidf_(b[2] + v[2]), sigmoidf_(b[3] + v[3]))}; }
    DI void operator()(int row, int col, f32x4 v0, f32x4 v1) const { one(row, col, v0); one(row, col + 128, v1); } };

namespace pg8 {
constexpr int BM = 256, BK = 64, HALF = 128, HTB = HALF * BK * 2, STAGE_BYTES = 8 * HTB;
DI int lds_byte(int r, int c) { const int st = (r >> 4) * 2 + (c >> 5), rr = r & 15, cc = c & 31, ob = rr * 64 + cc * 2; return st * 1024 + (ob ^ (((ob >> 9) & 1) << 5)); }
DI void stage_rc(int b, int& R, int& C) { const int st = b / 1024, sb = b % 1024, swz = sb ^ (((sb >> 9) & 1) << 5); R = (st >> 1) * 16 + swz / 64; C = (st & 1) * 32 + (swz % 64) / 2; }
DI int perm32(int rho) { const int n = rho >> 4, i = rho & 15; return 8 * (i >> 2) + 4 * n + (i & 3); }
struct Unit { int pm, pn; };
struct Gemm { const bf16* A; const bf16* Bt; int lda, K; const int* rows; int scale_w = 0x7f7f7f7f, scale_a = 0x7f7f7f7f; };
struct OrderMN { int nM, nN, G, c;
    DI bool next(int i, Unit& u) const { const int L = i * G + c; if (L >= nM * nN) return false; u.pm = L / nN; u.pn = L % nN; return true; } };
struct OrderMoE { int nMt, nN, mstride  , G, c;
    DI bool next(int i, Unit& u) const { const int L = i * G + c, per = nMt * nN; if (L >= NEXP * per) return false; const int e = L / per, q = L % per; u.pm = e * mstride + q / nN; u.pn = e * nN + q % nN; return true; } };
template <class E4> struct EpiAdapt { E4 e;
    DI void operator()(const f32x4 (&acc)[2][2][4][2], const Unit& u, int wr, int wc, int fr, int fq) const {
#pragma unroll
        for (int ai = 0; ai < 2; ++ai)
#pragma unroll
            for (int m = 0; m < 4; ++m) { const int row = u.pm * BM + ai * HALF + wr * 64 + m * 16 + fr;
                if constexpr (E4::WIDE) e.wide(row, u.pn * BM + wc * 32 + 8 * fq, acc[ai][0][m][0], acc[ai][0][m][1], acc[ai][1][m][0], acc[ai][1][m][1]);
                else {
#pragma unroll
                    for (int n = 0; n < 2; ++n) e(row, u.pn * BM + wc * 32 + 8 * fq + 4 * n, acc[ai][0][m][n], acc[ai][1][m][n]); } } } };

template <class Epi, class Sched, bool F8 = false>
DI void gemm_phase(LAS unsigned char* lds, const Gemm g, const Sched& S, const Epi& E, const int tid) {
    const int wid = __builtin_amdgcn_readfirstlane(tid >> 6), lane = tid & 63, wr = wid >> 2, wc = wid & 3, fr = lane & 15, fq = lane >> 4;
    const int K = g.K, nt = K / BK;
    unsigned voffB[2];
#pragma unroll
    for (int i = 0; i < 2; ++i) { int R, C; stage_rc(tid * 16 + i * 8192, R, C); const int Rb = (R & ~31) + perm32(R & 31); voffB[i] = (unsigned)(Rb * K + C) * 2u; }
    const size_t kstep = (size_t)(BK * 2), hstep = (size_t)HALF * K * 2, tstep = 2 * hstep;
    const unsigned ldsw = (unsigned)wid * 1024u;
    const int aoff = lds_byte(wr * 64 + fr, fq * 8), boff = lds_byte(wc * 32 + fr, fq * 8);
    const char* const gA = (const char*)g.A;
#define PG8_SA(b, h) (((b) * 2 + (h)) * HTB)
#define PG8_SB(b, h) ((4 + (b) * 2 + (h)) * HTB)
#define PG8_STAGE(bufoff, gbase, voff) do { _Pragma("unroll") for (int _i = 0; _i < 2; ++_i) \
        __builtin_amdgcn_global_load_lds((const unsigned*)((const char*)(gbase) + (voff)[_i]), (LAS unsigned*)(lds + (bufoff) + ldsw + _i * 8192), 16, 0, 0); } while (0)
#define PG8_LDA(dst, b, h) do { _Pragma("unroll") for (int m = 0; m < 4; ++m) _Pragma("unroll") for (int k = 0; k < 2; ++k) dst[m][k] = *(const LAS bf16x8*)(lds + PG8_SA(b, h) + aoff + m * 2048 + k * 1024); } while (0)
#define PG8_LDB(dst, b, h) do { _Pragma("unroll") for (int n = 0; n < 2; ++n) _Pragma("unroll") for (int k = 0; k < 2; ++k) dst[n][k] = *(const LAS bf16x8*)(lds + PG8_SB(b, h) + boff + n * 2048 + k * 1024); } while (0)
#define PG8_MMA(ai, bj, At, Bt) do { __builtin_amdgcn_s_setprio(1); _Pragma("unroll") for (int m = 0; m < 4; ++m) _Pragma("unroll") for (int n = 0; n < 2; ++n) { \
        if constexpr (F8) { const v8i_t w8 = __builtin_shufflevector(__builtin_bit_cast(i32x4_t, Bt[n][0]), __builtin_bit_cast(i32x4_t, Bt[n][1]), 0, 1, 2, 3, 4, 5, 6, 7), x8 = __builtin_shufflevector(__builtin_bit_cast(i32x4_t, At[m][0]), __builtin_bit_cast(i32x4_t, At[m][1]), 0, 1, 2, 3, 4, 5, 6, 7); \
            acc[ai][bj][m][n] = __builtin_amdgcn_mfma_scale_f32_16x16x128_f8f6f4(w8, x8, acc[ai][bj][m][n], 0, 0, 0, g.scale_w, 0, g.scale_a); } \
        else { _Pragma("unroll") for (int k = 0; k < 2; ++k) acc[ai][bj][m][n] = __builtin_amdgcn_mfma_f32_16x16x32_bf16(Bt[n][k], At[m][k], acc[ai][bj][m][n], 0, 0, 0); } } __builtin_amdgcn_s_setprio(0); } while (0)
#define PG8_WAIT_V(n) asm volatile("s_waitcnt vmcnt(" #n ")" ::: "memory")
#define PG8_WAIT_L(n) asm volatile("s_waitcnt lgkmcnt(" #n ")" ::: "memory")
#define PG8_BAR __builtin_amdgcn_s_barrier()
#define PG8_SCHED __builtin_amdgcn_sched_barrier(0)
#define PG8_ROWIDX(ri, u) do { _Pragma("unroll") for (int _h = 0; _h < 2; ++_h) _Pragma("unroll") for (int _i = 0; _i < 2; ++_i) { int _R, _C; stage_rc(tid * 16 + _i * 8192, _R, _C); (void)_C; \
        const int _lr = (u).pm * BM + _h * HALF + _R; ri[_h][_i] = g.rows ? g.rows[_lr] : _lr; } } while (0)
#define PG8_AOFF_FROM(vo, ri) do { _Pragma("unroll") for (int _h = 0; _h < 2; ++_h) _Pragma("unroll") for (int _i = 0; _i < 2; ++_i) { int _R, _C; stage_rc(tid * 16 + _i * 8192, _R, _C); (void)_R; \
        vo[_h][_i] = (unsigned)(((size_t)ri[_h][_i] * g.lda + _C) * 2u); } } while (0)
    Unit cur, nxt; int ui = 0;
    if (!S.next(0, cur)) return;
    f32x4 acc[2][2][4][2];
#pragma unroll
    for (int a = 0; a < 2; ++a)
#pragma unroll
        for (int b = 0; b < 2; ++b)
#pragma unroll
            for (int m = 0; m < 4; ++m)
#pragma unroll
                for (int n = 0; n < 2; ++n) acc[a][b][m][n] = (f32x4){0.f, 0.f, 0.f, 0.f};
    bf16x8 At[4][2], B0[2][2], B1[2][2];
    unsigned cvo[2][2]; int nri[2][2];
    PG8_ROWIDX(nri, cur); PG8_AOFF_FROM(cvo, nri);
    const char* cB = (const char*)g.Bt + (size_t)cur.pn * tstep;
    PG8_STAGE(PG8_SB(0, 0), cB, voffB); PG8_STAGE(PG8_SB(0, 1), cB + hstep, voffB); PG8_STAGE(PG8_SA(0, 0), gA, cvo[0]); PG8_STAGE(PG8_SA(0, 1), gA, cvo[1]);
    if (wr == 1) PG8_BAR;
    PG8_WAIT_V(2); PG8_BAR;
    PG8_STAGE(PG8_SB(1, 0), cB + kstep, voffB); PG8_STAGE(PG8_SA(1, 0), gA + kstep, cvo[0]); PG8_STAGE(PG8_SB(1, 1), cB + hstep + kstep, voffB);
    PG8_WAIT_V(6); PG8_BAR;
    for (;;) {
        const bool has_next = S.next(ui + 1, nxt);
        const char* nB = has_next ? (const char*)g.Bt + (size_t)nxt.pn * tstep : cB;
#pragma nounroll
        for (int t = 0; t < nt; t += 2) {
            const bool last = (t == nt - 2);
            const char* a1 = gA + (size_t)(t + 1) * kstep;
            const char* a2 = last ? gA : gA + (size_t)(t + 2) * kstep; const char* b2 = last ? nB : cB + (size_t)(t + 2) * kstep;
            const char* a3 = a2 + kstep; const char* b3 = b2 + kstep;
            if (t == nt - 4 && has_next) PG8_ROWIDX(nri, nxt);
            PG8_LDB(B0, 0, 0); PG8_LDB(B1, 0, 1); PG8_SCHED; PG8_LDA(At, 0, 0); PG8_STAGE(PG8_SA(1, 1), a1, cvo[1]);
            if (last && has_next) { if (nt < 4) PG8_ROWIDX(nri, nxt); PG8_AOFF_FROM(cvo, nri); }
            PG8_WAIT_V(8); PG8_WAIT_L(0); PG8_BAR; PG8_MMA(0, 0, At, B0); PG8_MMA(0, 1, At, B1); PG8_BAR; PG8_SCHED;
            PG8_LDA(At, 0, 1); PG8_STAGE(PG8_SB(0, 0), b2, voffB); PG8_STAGE(PG8_SB(0, 1), b2 + hstep, voffB); PG8_STAGE(PG8_SA(0, 0), a2, cvo[0]);
            PG8_WAIT_V(8); PG8_WAIT_L(0); PG8_BAR; PG8_MMA(1, 0, At, B0); PG8_MMA(1, 1, At, B1); PG8_BAR; PG8_SCHED;
            PG8_LDB(B0, 1, 0); PG8_LDB(B1, 1, 1); PG8_SCHED; PG8_LDA(At, 1, 0); PG8_STAGE(PG8_SA(0, 1), a2, cvo[1]);
            PG8_WAIT_V(8); PG8_WAIT_L(0); PG8_BAR; PG8_MMA(0, 0, At, B0); PG8_MMA(0, 1, At, B1); PG8_BAR; PG8_SCHED;
            PG8_LDA(At, 1, 1); PG8_STAGE(PG8_SB(1, 0), b3, voffB); PG8_STAGE(PG8_SB(1, 1), b3 + hstep, voffB); PG8_STAGE(PG8_SA(1, 0), a3, cvo[0]);
            PG8_WAIT_V(8); PG8_WAIT_L(0); PG8_BAR; PG8_MMA(1, 0, At, B0); PG8_MMA(1, 1, At, B1); PG8_BAR; PG8_SCHED;
        }
        if (wr == 0) PG8_BAR;
        E(acc, cur, wr, wc, fr, fq);
        if (!has_next) break;
#pragma unroll
        for (int a = 0; a < 2; ++a)
#pragma unroll
            for (int b = 0; b < 2; ++b)
#pragma unroll
                for (int m = 0; m < 4; ++m)
#pragma unroll
                    for (int n = 0; n < 2; ++n) acc[a][b][m][n] = (f32x4){0.f, 0.f, 0.f, 0.f};
        cur = nxt; cB = nB; ++ui;
        if (wr == 1) PG8_BAR;
    }
    PG8_WAIT_V(0);
    PG8_BAR;
#undef PG8_SA
#undef PG8_SB
#undef PG8_STAGE
#undef PG8_LDA
#undef PG8_LDB
#undef PG8_MMA
#undef PG8_WAIT_V
#undef PG8_WAIT_L
#undef PG8_BAR
#undef PG8_SCHED
#undef PG8_ROWIDX
#undef PG8_AOFF_FROM
}
}
template <class E4> DI void fast_gemm(const Ctx& C, const bf16* A, int lda, const bf16* Bt, int K, int nM, int nN, const E4& e, bool rev = false) {
    pg8::Gemm g{A, Bt, lda, K, nullptr}; pg8::OrderMN S{nM, nN, C.nb, rev ? C.nb - 1 - C.vcu : C.vcu}; pg8::EpiAdapt<E4> E{e};
    pg8::gemm_phase(C.lds, g, S, E, C.tid);
}

DI float max16_acc(float m, const f32x16& x) {
    asm volatile("s_nop 15\n\tv_max3_f32 %0, %0, %1, %2\n\tv_max3_f32 %0, %0, %3, %4\n\tv_max3_f32 %0, %0, %5, %6\n\tv_max3_f32 %0, %0, %7, %8\n\tv_max3_f32 %0, %0, %9, %10\n\tv_max3_f32 %0, %0, %11, %12\n\tv_max3_f32 %0, %0, %13, %14\n\tv_max3_f32 %0, %0, %15, %16"
                 : "+v"(m) : "v"(x[0]), "v"(x[1]), "v"(x[2]), "v"(x[3]), "v"(x[4]), "v"(x[5]), "v"(x[6]), "v"(x[7]), "v"(x[8]), "v"(x[9]), "v"(x[10]), "v"(x[11]), "v"(x[12]), "v"(x[13]), "v"(x[14]), "v"(x[15]));
    return m; }
DI int swap23(int x) { return (x & ~12) | ((x & 4) << 1) | ((x & 8) >> 1); }
DI void flash_store(const f32x16 (&o)[2], float l, bf16* orow  , int h) {
    const float inv = 1.f / l;
#pragma unroll
    for (int dt = 0; dt < 2; ++dt)
#pragma unroll
        for (int g = 0; g < 4; ++g)
            *(u32x2*)(orow + 32 * dt + 8 * g + 4 * h) = (u32x2){pk2(o[dt][4 * g] * inv, o[dt][4 * g + 1] * inv), pk2(o[dt][4 * g + 2] * inv, o[dt][4 * g + 3] * inv)};
}


template <int DQK> struct AttnGeo { static constexpr int KSTR = DQK * 2 + 16, KBYTES = 64 * KSTR, VSTR = 144, VBYTES = 64 * VSTR, BUF = KBYTES + VBYTES, KPIECES = 64 * DQK / 8; };
template <int DQK, bool NAT>
DI void attn_tile_loop(const Ctx& C, f32x16 (&o)[2], float& l, const bf16x8 (&qf)[DQK / 16], const bf16* __restrict__ Kb, const bf16* __restrict__ Vt, int pos1, int n1, int pos2, int n2,
                       const LAS float* tab, int grow, int rs, int qc, int cs) {
    typedef AttnGeo<DQK> G;
    const int tid = C.tid, r = C.lane & 31, h = C.lane >> 5, kr = swap23(r), ntiles = n1 + n2;
    constexpr bool K2 = G::KPIECES > 512;
    const int kq0 = tid, kq1 = tid + 512;
    const int kl0 = (kq0 / (DQK / 8)) * G::KSTR + (kq0 % (DQK / 8)) * 16, kl1 = (kq1 / (DQK / 8)) * G::KSTR + (kq1 % (DQK / 8)) * 16;
    const int vl = G::KBYTES + (tid >> 3) * G::VSTR + (tid & 7) * 16;
    const bf16* vg = Vt + (size_t)(tid >> 3) * KPOS + 8 * (tid & 7);
    u32x4 rk0, rk1, rv;
    rk1 = (u32x4){0u, 0u, 0u, 0u};
#define ATT_POS(t) ((t) < n1 ? pos1 + 64 * (t) : pos2 + 64 * ((t) - n1))
    { const int pos0 = ATT_POS(0); rk0 = *(const u32x4*)(Kb + (size_t)pos0 * DQK + 8 * kq0); if (K2 && tid < 256) rk1 = *(const u32x4*)(Kb + (size_t)pos0 * DQK + 8 * kq1); rv = *(const u32x4*)(vg + pos0); }
    __syncthreads();
    *(LAS u32x4*)(C.lds + kl0) = rk0; if (K2 && tid < 256) *(LAS u32x4*)(C.lds + kl1) = rk1; *(LAS u32x4*)(C.lds + vl) = rv;
    __syncthreads();
    float mref = 0.f; bool first = true;
    constexpr float THR = 8.f;
    for (int t = 0; t < ntiles; ++t) {
        const LAS unsigned char* B = C.lds + (t & 1) * G::BUF;
        if (t + 1 < ntiles) { const int pos0 = ATT_POS(t + 1);
            rk0 = *(const u32x4*)(Kb + (size_t)pos0 * DQK + 8 * kq0); if (K2 && tid < 256) rk1 = *(const u32x4*)(Kb + (size_t)pos0 * DQK + 8 * kq1); rv = *(const u32x4*)(vg + pos0); }
        const int gr = (pos1 >> 6) + t;
        const bool active = !NAT || t >= n1 || (gr >= rs && gr < rs + 8);
        if (active) {
            f32x16 sc[2];
#pragma unroll
            for (int j = 0; j < 2; ++j) {
#pragma unroll
                for (int i = 0; i < 16; ++i) sc[j][i] = -mref;
                const LAS unsigned char* kp = B + (32 * j + kr) * G::KSTR + 16 * h;
#pragma unroll
                for (int kk = 0; kk < DQK / 16; ++kk) sc[j] = MFMA32(*(const LAS bf16x8*)(kp + 32 * kk), qf[kk], sc[j]);
            }
            if (NAT && t < n1) {
                const LAS float* trow = tab + (gr - grow + 7) * 31;
#pragma unroll
                for (int j = 0; j < 2; ++j)
#pragma unroll
                    for (int i = 0; i < 16; ++i) {
                        const int cc = 32 * j + ((i & 3) | (((i >> 2) & 1) << 2) | (h << 3) | ((i >> 3) << 4)); const bool ok = (cc >= cs) && (cc < cs + 16);
                        int dc = cc - qc + 15; dc = dc < 0 ? 0 : (dc > 30 ? 30 : dc);
                        sc[j][i] = ok ? sc[j][i] + trow[dc] : -1e30f;
                    }
            }
            float mx = max16_acc(max16_acc(-3.0e38f, sc[0]), sc[1]);
            if (first || __builtin_amdgcn_ballot_w64(mx > THR) != 0ull) {
                mx = fmaxf(mx, xor32(mx, C.lane));
                const float delta = first ? mx : fmaxf(mx, 0.f);
#pragma unroll
                for (int i = 0; i < 16; ++i) { sc[0][i] -= delta; sc[1][i] -= delta; }
                if (!first) { const float alpha = __builtin_amdgcn_exp2f(-delta); l *= alpha;
#pragma unroll
                    for (int i = 0; i < 16; ++i) { o[0][i] *= alpha; o[1][i] *= alpha; } }
                mref += delta; first = false;
            }
            f32x2 rs2 = {0.f, 0.f};
#pragma unroll
            for (int j = 0; j < 2; ++j)
#pragma unroll
                for (int i = 0; i < 16; i += 2) { sc[j][i] = __builtin_amdgcn_exp2f(sc[j][i]); sc[j][i + 1] = __builtin_amdgcn_exp2f(sc[j][i + 1]); rs2 += (f32x2){sc[j][i], sc[j][i + 1]}; }
            l += rs2.x + rs2.y;
#pragma unroll
            for (int j = 0; j < 2; ++j)
#pragma unroll
                for (int s2 = 0; s2 < 2; ++s2) {
                    u32x4 pw; pw.x = pk2(sc[j][8 * s2], sc[j][8 * s2 + 1]); pw.y = pk2(sc[j][8 * s2 + 2], sc[j][8 * s2 + 3]); pw.z = pk2(sc[j][8 * s2 + 4], sc[j][8 * s2 + 5]); pw.w = pk2(sc[j][8 * s2 + 6], sc[j][8 * s2 + 7]);
                    const bf16x8 pb = __builtin_bit_cast(bf16x8, pw);
#pragma unroll
                    for (int dt = 0; dt < 2; ++dt) o[dt] = MFMA32(*(const LAS bf16x8*)(B + G::KBYTES + (32 * dt + r) * G::VSTR + (32 * j + 16 * s2 + 8 * h) * 2), pb, o[dt]);
                }
        }
        if (t + 1 < ntiles) { LAS unsigned char* Bn = C.lds + ((t + 1) & 1) * G::BUF;
            *(LAS u32x4*)(Bn + kl0) = rk0; if (K2 && tid < 256) *(LAS u32x4*)(Bn + kl1) = rk1; *(LAS u32x4*)(Bn + vl) = rv; }
        __syncthreads();
    }
    l += xor32(l, C.lane);
#undef ATT_POS
}
DI void conv_unit(const Ctx& C, int u, const bf16* U, const float (&wk)[31], float bias, const float* lng, const float* lnb, bf16* OCAT);
DI void wprep_items(const Ctx& C, int k0, int k1, const float* w1, const float* w3, const float* w2, bf16* W13, bf16* W2);
DI const float* in_ptr(const unsigned char* ws, int k);
DI void ph_attn_mla2(const Ctx& C, const bf16* QB, const bf16* KB, const bf16* VT, bf16* OCAT, bool last, unsigned char* ws, int lq) {
    const int r = C.lane & 31, h = C.lane >> 5;
    const int nunits = 1024 + (last ? 0 : 64);
    const int nwp = (NEXP * 3 * 256 + C.nb * 8 - 1) / (C.nb * 8);
    int k = 0;
    for (;; ++k) {
        const int u = C.vcu + k * C.nb, cu = (C.nb - 1 - C.vcu) + k * C.nb;
        const bool a_on = u < nunits, c_on = cu < MT / 32, w_on = 2 * k < nwp;
        if (!a_on && !c_on && !w_on) break;
        if (a_on) {
            const int bh = u < 1024 ? (u >> 4) : u - 1024, qblk = u < 1024 ? (u & 15) : 16, b = bh >> 3, hh = bh & 7;
            const int qpos = qblk * 256 + 32 * C.wave + r;
            const bf16* qp = QB + ((size_t)bh * KPOS + qpos) * 96 + 8 * h;
            bf16x8 qf[6];
#pragma unroll
            for (int kk = 0; kk < 6; ++kk) qf[kk] = *(const bf16x8*)(qp + 16 * kk);
            f32x16 o[2];
#pragma unroll
            for (int i = 0; i < 16; ++i) { o[0][i] = 0.f; o[1][i] = 0.f; }
            float l = 0.f;
            attn_tile_loop<96, false>(C, o, l, qf, KB + (size_t)bh * KPOS * 96, VT + (size_t)bh * 64 * KPOS, qblk < 16 ? 0 : TL, qblk < 16 ? KPOS / 64 : LCX / 64, 0, 0, nullptr, 0, 0, 0, 0);
            const int row = qblk < 16 ? b * TL + qpos : NLAT + b * LCX + (qpos - TL);
            flash_store(o, l, OCAT + (size_t)row * DM + hh * 64, h);
        }
        if (c_on) { float wk[31]; const float* dww = in_ptr(ws, I_DWW) + (size_t)lq * 31 * 512;
#pragma unroll
            for (int kt = 0; kt < 31; ++kt) wk[kt] = dww[kt * 512 + C.tid];
            conv_unit(C, cu, (const bf16*)(ws + WS_ARENA + A_U), wk, in_ptr(ws, I_DWB)[lq * 512 + C.tid], in_ptr(ws, I_LNG) + lq * 512, in_ptr(ws, I_LNB) + lq * 512, OCAT); }
        if (w_on) { __syncthreads(); const size_t wo = (size_t)(2 * lq) * NEXP * DM * DM;
            wprep_items(C, 2 * k, 2 * k + 2, in_ptr(ws, I_MW1) + wo, in_ptr(ws, I_MW3) + wo, in_ptr(ws, I_MW2) + wo, (bf16*)(ws + WS_W13), (bf16*)(ws + WS_W2)); }
    }
}
DI void ph_natten2(const Ctx& C, const bf16* QN, const bf16* KN, const bf16* VTN, bf16* OCAT, const float* rpb  , bool last, unsigned* work_ctr, unsigned char* ws, int lq) {
    const int r = C.lane & 31, h = C.lane >> 5;
    LAS float* tab = (LAS float*)(C.lds + 2 * AttnGeo<64>::BUF);
    LAS int* uslot = (LAS int*)(tab + 480);
    const int nunits = 1024 + (last ? 0 : 64);
    const int nwp = (NEXP * 3 * 256 + C.nb * 8 - 1) / (C.nb * 8); int wdone = 0;
    for (;;) {
        __syncthreads();
        if (wdone < nwp) { const size_t wo = (size_t)(2 * lq + 1) * NEXP * DM * DM; wprep_items(C, wdone, wdone + 2, in_ptr(ws, I_MW1) + wo, in_ptr(ws, I_MW3) + wo, in_ptr(ws, I_MW2) + wo, (bf16*)(ws + WS_W13), (bf16*)(ws + WS_W2)); wdone += 2; __syncthreads(); }
        if (C.tid == 0) *uslot = (int)__hip_atomic_fetch_add(work_ctr, 1u, __ATOMIC_RELAXED, __HIP_MEMORY_SCOPE_AGENT);
        __syncthreads();
        const int u = *uslot;
        if (u >= nunits) { if (wdone < nwp) { const size_t wo = (size_t)(2 * lq + 1) * NEXP * DM * DM; wprep_items(C, wdone, nwp, in_ptr(ws, I_MW1) + wo, in_ptr(ws, I_MW3) + wo, in_ptr(ws, I_MW2) + wo, (bf16*)(ws + WS_W13), (bf16*)(ws + WS_W2)); } break; }
        const bool isctx = u >= 1024;
        const int bh = isctx ? u - 1024 : (u >> 4), b = bh >> 3, hh = bh & 7;
        for (int i = C.tid; i < 465; i += 512) tab[i] = rpb[hh * 465 + i] * LOG2E;
        int qpos, row, grow = 0, qc = 0, rs = 0, cs = 0, rlo = 0, nband = 0;
        if (!isctx) { const int rg = u & 15; grow = 4 * rg + (C.wave >> 1); qc = 32 * (C.wave & 1) + r; qpos = grow * 64 + qc; row = b * TL + qpos;
            rs = grow - 4; rs = rs < 0 ? 0 : (rs > 56 ? 56 : rs); cs = qc - 8; cs = cs < 0 ? 0 : (cs > 48 ? 48 : cs);
            rlo = 4 * rg - 4; rlo = rlo < 0 ? 0 : (rlo > 56 ? 56 : rlo); int rhi = 4 * rg + 3 - 4; rhi = rhi < 0 ? 0 : (rhi > 56 ? 56 : rhi); nband = rhi + 8 - rlo; }
        else { qpos = TL + 32 * C.wave + r; row = NLAT + b * LCX + 32 * C.wave + r; }
        const bf16* qp = QN + ((size_t)bh * KPOS + qpos) * 64 + 8 * h;
        bf16x8 qf[4];
#pragma unroll
        for (int kk = 0; kk < 4; ++kk) qf[kk] = *(const bf16x8*)(qp + 16 * kk);
        f32x16 o[2];
#pragma unroll
        for (int i = 0; i < 16; ++i) { o[0][i] = 0.f; o[1][i] = 0.f; }
        float l = 0.f;
        attn_tile_loop<64, true>(C, o, l, qf, KN + (size_t)bh * KPOS * 64, VTN + (size_t)bh * 64 * KPOS, rlo * 64, nband, TL, LCX / 64, tab, grow, rs, qc, cs);
        flash_store(o, l, OCAT + (size_t)row * DM + 512 + hh * 64, h);
    }
}


DI void ph_mla_fin(const Ctx& C, const bf16* U, const bf16* QPRE, const bf16* KVPRE, const float* qg, const float* kg, const f32x2* CS, bf16* QB, bf16* KB, bf16* VT) {
    LAS bf16* VL = (LAS bf16*)C.lds;
    const int lane = C.lane, j = lane >> 3, sub = lane & 7;
    const float C2 = 0.10206207261596575f * LOG2E;
    float qgn[8], qgr[4], kgn[8], kgr[4];
#pragma unroll
    for (int e = 0; e < 8; ++e) { qgn[e] = qg[8 * sub + e] * C2; kgn[e] = kg[8 * sub + e]; }
#pragma unroll
    for (int m = 0; m < 4; ++m) { qgr[m] = qg[64 + sub + 8 * m] * C2; kgr[m] = kg[64 + sub + 8 * m]; }
    for (int u = C.vcu; u < MT / 64; u += C.nb) {
        const int row0 = 64 * u, b = row0 < NLAT ? (row0 >> 12) : ((row0 - NLAT) >> 8), pos0 = row0 < NLAT ? (row0 & 4095) : TL + ((row0 - NLAT) & 255);
        const bool lat = row0 < NLAT;
        const int pl = 8 * C.wave + j, row = row0 + pl, pos = pos0 + pl;
        const bf16* ur = U + (size_t)row * EV_INP;
        float sq = 0.f, skv = 0.f;
#pragma unroll
        for (int m = 0; m < 6; ++m) { float x[8]; unpack8(*(const u32x4*)(ur + 8 * (sub + 8 * m)), x);
#pragma unroll
            for (int e = 0; e < 8; ++e) sq += x[e] * x[e]; }
#pragma unroll
        for (int m = 0; m < 4; ++m) { float x[8]; unpack8(*(const u32x4*)(ur + 384 + 8 * (sub + 8 * m)), x);
#pragma unroll
            for (int e = 0; e < 8; ++e) skv += x[e] * x[e]; }
        sq = sum8(sq); skv = sum8(skv);
        const float rsq = 1.0f / sqrtf(sq * (1.f / 384.f) + EPS), rskv = 1.0f / sqrtf(skv * (1.f / 256.f) + EPS);
        float krv[4];
#pragma unroll
        for (int m = 0; m < 4; ++m) krv[m] = bf2f(ur[640 + sub + 8 * m]);
        float cr = 1.f, sr = 0.f, cc = 1.f, sc = 0.f;
        if (lat) { const f32x2 a0 = CS[pos * 16 + sub], a1 = CS[pos * 16 + 8 + sub]; cr = a0.x; sr = a0.y; cc = a1.x; sc = a1.y; }
        const bf16* qrow = QPRE + (size_t)row * 768; const bf16* kvrow = KVPRE + (size_t)row * 1024;
#pragma unroll 2
        for (int hh = 0; hh < 8; ++hh) {
            { float qn[8], qr[4]; unpack8(*(const u32x4*)(qrow + hh * 96 + 8 * sub), qn); float ss = 0.f;
#pragma unroll
              for (int e = 0; e < 8; ++e) qn[e] *= rsq;
#pragma unroll
              for (int m = 0; m < 4; ++m) { qr[m] = bf2f(qrow[hh * 96 + 64 + sub + 8 * m]) * rsq; ss += qr[m] * qr[m]; }
#pragma unroll
              for (int e = 0; e < 8; ++e) ss += qn[e] * qn[e];
              const float rn = 1.0f / sqrtf(sum8(ss) * (1.f / 96.f) + EPS);
#pragma unroll
              for (int e = 0; e < 8; ++e) qn[e] *= rn * qgn[e];
#pragma unroll
              for (int m = 0; m < 4; ++m) qr[m] *= rn * qgr[m];
              { const float x0 = qr[0], x1 = qr[1], y0 = qr[2], y1 = qr[3]; qr[0] = x0 * cr - x1 * sr; qr[1] = x1 * cr + x0 * sr; qr[2] = y0 * cc - y1 * sc; qr[3] = y1 * cc + y0 * sc; }
              bf16* qo = QB + ((size_t)(b * 8 + hh) * KPOS + pos) * 96;
              *(u32x4*)(qo + 8 * sub) = pack8(qn);
#pragma unroll
              for (int m = 0; m < 4; ++m) qo[64 + sub + 8 * m] = f2bf(qr[m]); }
            { float kn[8], kr[4]; unpack8(*(const u32x4*)(kvrow + hh * 128 + 8 * sub), kn); float ss = 0.f;
#pragma unroll
              for (int e = 0; e < 8; ++e) kn[e] *= rskv;
#pragma unroll
              for (int m = 0; m < 4; ++m) { kr[m] = krv[m]; ss += kr[m] * kr[m]; }
#pragma unroll
              for (int e = 0; e < 8; ++e) ss += kn[e] * kn[e];
              const float rn = 1.0f / sqrtf(sum8(ss) * (1.f / 96.f) + EPS);
#pragma unroll
              for (int e = 0; e < 8; ++e) kn[e] *= rn * kgn[e];
#pragma unroll
              for (int m = 0; m < 4; ++m) kr[m] *= rn * kgr[m];
              { const float x0 = kr[0], x1 = kr[1], y0 = kr[2], y1 = kr[3]; kr[0] = x0 * cr - x1 * sr; kr[1] = x1 * cr + x0 * sr; kr[2] = y0 * cc - y1 * sc; kr[3] = y1 * cc + y0 * sc; }
              bf16* ko = KB + ((size_t)(b * 8 + hh) * KPOS + pos) * 96;
              *(u32x4*)(ko + 8 * sub) = pack8(kn);
#pragma unroll
              for (int m = 0; m < 4; ++m) ko[64 + sub + 8 * m] = f2bf(kr[m]); }
            { float vv[8]; unpack8(*(const u32x4*)(kvrow + hh * 128 + 64 + 8 * sub), vv);
#pragma unroll
              for (int e = 0; e < 8; ++e) VL[(hh * 64 + 8 * sub + e) * 64 + pl] = f2bf(vv[e] * rskv); }
        }
        __syncthreads();
        { const int hd = C.tid;
            bf16* dst = VT + ((size_t)(b * 8 + (hd >> 6)) * 64 + (hd & 63)) * KPOS + pos0;
#pragma unroll
            for (int q = 0; q < 8; ++q) *(u32x4*)(dst + 8 * q) = *(const LAS u32x4*)(VL + hd * 64 + 8 * q); }
        __syncthreads();
    }
}

DI void conv_unit(const Ctx& C, int u, const bf16* U, const float (&wk)[31], float bias, const float* lng, const float* lnb, bf16* OCAT) {
    LAS float* G = (LAS float*)C.lds;
    const int c = C.tid;
    const int row0 = 32 * u; int base, t0, tseq;
    if (row0 < NLAT) { base = row0 & ~4095; t0 = row0 & 4095; tseq = TL; } else { const int rc = row0 - NLAT; base = NLAT + (rc & ~255); t0 = rc & 255; tseq = LCX; }
    __syncthreads();
    for (int rr = C.wave; rr < 62; rr += 8) { const int tt = t0 - 15 + rr; float g[8];
#pragma unroll
        for (int e = 0; e < 8; ++e) g[e] = 0.f;
        if (tt >= 0 && tt < tseq) { const bf16* ur = U + (size_t)(base + tt) * EV_INP; float av[8], gv[8]; unpack8(*(const u32x4*)(ur + 672 + 8 * C.lane), av); unpack8(*(const u32x4*)(ur + 1184 + 8 * C.lane), gv);
#pragma unroll
            for (int e = 0; e < 8; ++e) g[e] = av[e] * sigmoidf_(gv[e]); }
        *(LAS f32x4*)(G + rr * 512 + 8 * C.lane) = (f32x4){g[0], g[1], g[2], g[3]}; *(LAS f32x4*)(G + rr * 512 + 8 * C.lane + 4) = (f32x4){g[4], g[5], g[6], g[7]}; }
    __syncthreads();
    float acc[32];
#pragma unroll
    for (int t = 0; t < 32; ++t) acc[t] = bias;
#pragma unroll
    for (int rr = 0; rr < 62; ++rr) { const float gv = G[rr * 512 + c];
#pragma unroll
        for (int t = 0; t < 32; ++t) { const int k = rr - t; if (k >= 0 && k < 31) acc[t] += gv * wk[k]; } }
    __syncthreads();
#pragma unroll
    for (int t = 0; t < 32; ++t) G[t * 512 + c] = acc[t];
    __syncthreads();
#pragma unroll
    for (int q = 0; q < 4; ++q) {
        const int t = 4 * C.wave + q, row = row0 + t;
        const f32x4 a0 = *(const LAS f32x4*)(G + t * 512 + 8 * C.lane), a1 = *(const LAS f32x4*)(G + t * 512 + 8 * C.lane + 4);
        float x[8] = {a0.x, a0.y, a0.z, a0.w, a1.x, a1.y, a1.z, a1.w}; float s = 0.f;
#pragma unroll
        for (int e = 0; e < 8; ++e) s += x[e];
        const float mu = wave_sum(s) * (1.f / 512.f); float s2 = 0.f;
#pragma unroll
        for (int e = 0; e < 8; ++e) { x[e] -= mu; s2 += x[e] * x[e]; }
        const float rstd = 1.0f / sqrtf(wave_sum(s2) * (1.f / 512.f) + EPS);
        float y[8];
#pragma unroll
        for (int e = 0; e < 8; ++e) { const float z = x[e] * rstd * lng[8 * C.lane + e] + lnb[8 * C.lane + e]; y[e] = siluf_(z); }
        *(u32x4*)(OCAT + (size_t)row * DM + 512 + 8 * C.lane) = pack8(y);
    }
    __syncthreads();
}
DI void wprep_items(const Ctx& C, int k0, int k1, const float* w1, const float* w3, const float* w2, bf16* W13, bf16* W2) {
    LAS float* scr = (LAS float*)(C.lds + C.wave * 16640);
    const int gw = C.vcu * 8 + C.wave, ngw = C.nb * 8;
    constexpr int PER = 16 * 16, NIT = NEXP * 3 * PER;
    for (int k = k0; k < k1; ++k) { const int it = gw + k * ngw; if (it >= NIT) break;
        const int e = it / (3 * PER), r = it % (3 * PER), which = r / PER, q = r % PER, kb = q / 16, n0 = (q % 16) * 64;
#if MOE_F8
        if (which == 0)      transpose_item64_f8(w1 + (size_t)e * DM * DM, DM, DM, (unsigned char*)W13 + (size_t)e * 2048 * DM, (n0 >> 7) * 256 + (n0 & 127), scr, kb * 64, n0, C.lane);
        else if (which == 1) transpose_item64_f8(w3 + (size_t)e * DM * DM, DM, DM, (unsigned char*)W13 + (size_t)e * 2048 * DM, (n0 >> 7) * 256 + (n0 & 127) + 128, scr, kb * 64, n0, C.lane);
        else                 transpose_item64_f8(w2 + (size_t)e * DM * DM, DM, DM, (unsigned char*)W2 + (size_t)e * DM * DM, n0, scr, kb * 64, n0, C.lane); }
#else
        if (which == 0)      transpose_item64(w1 + (size_t)e * DM * DM, DM, DM, W13 + (size_t)e * 2048 * DM, (n0 >> 7) * 256 + (n0 & 127), scr, kb * 64, n0, C.lane);
        else if (which == 1) transpose_item64(w3 + (size_t)e * DM * DM, DM, DM, W13 + (size_t)e * 2048 * DM, (n0 >> 7) * 256 + (n0 & 127) + 128, scr, kb * 64, n0, C.lane);
        else                 transpose_item64(w2 + (size_t)e * DM * DM, DM, DM, W2 + (size_t)e * DM * DM, n0, scr, kb * 64, n0, C.lane); }
#endif
}
constexpr int WPREP_PER_WAVE = (NEXP * 3 * 256 + 2047) / 2048;

DI void shifted8(const bf16* up, const bf16* uc, const bf16* un, bool hp, bool hn, const float (&s0)[8], const float (&s1)[8], const float (&s2)[8], int c0, float (&o)[8]) {
    const u32x4 z = {0u, 0u, 0u, 0u};
    const u32x4 vp = hp ? *(const u32x4*)(up + c0) : z, vc = *(const u32x4*)(uc + c0), vn = hn ? *(const u32x4*)(un + c0) : z;
    float p[8], c[8], n[8]; unpack8(vp, p); unpack8(vc, c); unpack8(vn, n);
#pragma unroll
    for (int e = 0; e < 8; ++e) o[e] = p[e] * s0[e] + c[e] * s1[e] + n[e] * s2[e];
}
DI void load_sw(const float* sw, int c0, float (&s0)[8], float (&s1)[8], float (&s2)[8]) {
#pragma unroll
    for (int e = 0; e < 8; ++e) { s0[e] = sw[c0 + e]; s1[e] = sw[RW_IN + c0 + e]; s2[e] = sw[2 * RW_IN + c0 + e]; }
}
DI void ph_prep(const Ctx& C, const bf16* U, const float* sw  , const float* kkw  , const float* naqg, const float* nakg,
                bf16* R, bf16* V, bf16* K, bf16* KK, bf16* L, bf16* QN, bf16* KN, bf16* VTN) {
    LAS bf16* VL = (LAS bf16*)C.lds;
    const int lane = C.lane, hh = lane >> 3, sub = lane & 7;
    const float C2 = 0.125f * LOG2E;
    for (int u = C.vcu; u < MT / 32; u += C.nb) {
        const int row0 = 32 * u; const bool lat = row0 < NLAT;
        const int b = lat ? (row0 >> 12) : ((row0 - NLAT) >> 8), pos0 = lat ? (row0 & 4095) : TL + ((row0 - NLAT) & 255), tseq = lat ? TL : LCX, tb = lat ? (row0 & 4095) : ((row0 - NLAT) & 255);
#define PREP_ROWVARS(i) const int pl = 4 * C.wave + (i), row = row0 + pl, t = tb + pl; const bool hp = t > 0, hn = t < tseq - 1; \
            const bf16* uc = U + (size_t)row * OD_INP; const bf16* up = uc - OD_INP; const bf16* un = uc + OD_INP
        { float s0[8], s1[8], s2[8]; load_sw(sw, 8 * lane, s0, s1, s2);
          for (int i = 0; i < 4; ++i) { PREP_ROWVARS(i); float o[8]; shifted8(up, uc, un, hp, hn, s0, s1, s2, 8 * lane, o); *(u32x4*)(R + (size_t)row * 512 + 8 * lane) = pack8(o); } }
        { float s0[8], s1[8], s2[8]; load_sw(sw, 1024 + 8 * lane, s0, s1, s2);
          for (int i = 0; i < 4; ++i) { PREP_ROWVARS(i); float o[8]; shifted8(up, uc, un, hp, hn, s0, s1, s2, 1024 + 8 * lane, o); *(u32x4*)(V + (size_t)row * 512 + 8 * lane) = pack8(o); } }
        { float s0[8], s1[8], s2[8]; load_sw(sw, 512 + 8 * lane, s0, s1, s2); float kw[8];
#pragma unroll
          for (int e = 0; e < 8; ++e) kw[e] = kkw[8 * lane + e];
          for (int i = 0; i < 4; ++i) { PREP_ROWVARS(i); float o[8]; shifted8(up, uc, un, hp, hn, s0, s1, s2, 512 + 8 * lane, o); *(u32x4*)(K + (size_t)row * 512 + 8 * lane) = pack8(o);
              float kk[8]; float ss = 0.f;
#pragma unroll
              for (int e = 0; e < 8; ++e) { kk[e] = o[e] * kw[e]; ss += kk[e] * kk[e]; }
              ss = sum8(ss); const float rn = 1.0f / sqrtf(ss + 1e-12f);
#pragma unroll
              for (int e = 0; e < 8; ++e) kk[e] *= rn;
              *(u32x4*)(KK + (size_t)row * 512 + 8 * lane) = pack8(kk); } }
        if (lane < 48) { float s0[8], s1[8], s2[8]; load_sw(sw, 1536 + 8 * lane, s0, s1, s2);
          for (int i = 0; i < 4; ++i) { PREP_ROWVARS(i); float o[8]; shifted8(up, uc, un, hp, hn, s0, s1, s2, 1536 + 8 * lane, o);
              if (lane < 16) {
#pragma unroll
                  for (int e = 0; e < 8; ++e) { const float ex = __expf(2.f * o[e]); o[e] = 1.f - 2.f * __builtin_amdgcn_rcpf(ex + 1.f); }
              } else if (lane >= 32) {
#pragma unroll
                  for (int e = 0; e < 8; ++e) o[e] = sigmoidf_(o[e]);
              }
              *(u32x4*)(L + (size_t)row * 384 + 8 * lane) = pack8(o); } }
        { float gq[8], gk[8];
#pragma unroll
          for (int e = 0; e < 8; ++e) { gq[e] = naqg[8 * sub + e] * C2; gk[e] = nakg[8 * sub + e]; }
          for (int i = 0; i < 4; ++i) { const int pl = 4 * C.wave + i, row = row0 + pl, pos = pos0 + pl; const bf16* uc = U + (size_t)row * OD_INP;
            { float x[8]; unpack8(*(const u32x4*)(uc + RW_IN + 8 * lane), x); float ss = 0.f;
#pragma unroll
                for (int e = 0; e < 8; ++e) ss += x[e] * x[e];
                ss = sum8(ss); const float rn = 1.0f / sqrtf(ss * (1.f / 64.f) + EPS);
#pragma unroll
                for (int e = 0; e < 8; ++e) x[e] = x[e] * rn * gq[e];
                *(u32x4*)(QN + ((size_t)(b * 8 + hh) * KPOS + pos) * 64 + 8 * sub) = pack8(x); }
            { float x[8]; unpack8(*(const u32x4*)(uc + RW_IN + 512 + 8 * lane), x); float ss = 0.f;
#pragma unroll
                for (int e = 0; e < 8; ++e) ss += x[e] * x[e];
                ss = sum8(ss); const float rn = 1.0f / sqrtf(ss * (1.f / 64.f) + EPS);
#pragma unroll
                for (int e = 0; e < 8; ++e) x[e] = x[e] * rn * gk[e];
                *(u32x4*)(KN + ((size_t)(b * 8 + hh) * KPOS + pos) * 64 + 8 * sub) = pack8(x); }
            { const u32x4 vv = *(const u32x4*)(uc + RW_IN + 1024 + 8 * lane); const unsigned w4[4] = {vv.x, vv.y, vv.z, vv.w};
#pragma unroll
                for (int e = 0; e < 8; ++e) { const int dv = 8 * sub + e; VL[(hh * 64 + dv) * 32 + pl] = (bf16)((e & 1) ? (w4[e >> 1] >> 16) : (w4[e >> 1] & 0xffffu)); } } } }
#undef PREP_ROWVARS
        __syncthreads();
        { const int hd = C.tid; bf16* dst = VTN + ((size_t)(b * 8 + (hd >> 6)) * 64 + (hd & 63)) * KPOS + pos0;
#pragma unroll
            for (int q = 0; q < 4; ++q) *(u32x4*)(dst + 8 * q) = *(const LAS u32x4*)(VL + hd * 32 + 8 * q); }
        __syncthreads();
    }
}

DI int scan_row(int s, int d, int b) { if (s < LCX) return NLAT + b * LCX + (d ? (LCX - 1 - s) : s); const int t = s - LCX; return b * TL + (d ? (TL - 1 - t) : t); }


constexpr int CCH = 16, NCHK = KPOS / CCH, NPROB = NB * 8 * 2 * NCHK, IMG_ELEMS = 3 * 32 * 16;
template <int N> struct ICk { static constexpr int value = N; };
DI int crow_(int reg, int h) { return (reg & 3) + 8 * (reg >> 2) + 4 * h; }
DI bf16x8 pack_lo8(const f32x16& x) {
    u32x4 p; p.x = pk2(x[0], x[1]); p.y = pk2(x[2], x[3]); p.z = pk2(x[4], x[5]); p.w = pk2(x[6], x[7]); return __builtin_bit_cast(bf16x8, p); }
DI bf16x8 pack_hi8(const f32x16& x) { u32x4 p; p.x = pk2(x[8], x[9]); p.y = pk2(x[10], x[11]); p.z = pk2(x[12], x[13]); p.w = pk2(x[14], x[15]); return __builtin_bit_cast(bf16x8, p); }
DI int perm16(int k) { return (k & ~15) | swap23(k & 15); }

DI void ph_wkv_pre(const Ctx& C, const bf16* R, const bf16* K, const bf16* KK, const float* LW, const bf16* AR_, const float* ka, bf16* IMG) {
    LAS unsigned char* wl = C.lds + C.wave * 13312;
    LAS bf16* ARl = (LAS bf16*)wl; LAS bf16* BKl = (LAS bf16*)(wl + 4608); LAS float* Ll = (LAS float*)(wl + 9216); LAS bf16* OUT = (LAS bf16*)(wl + 10240);
    const int lane = C.lane, r = lane & 31, h = lane >> 5;
    const int gw = C.vcu * 8 + C.wave, ngw = C.nb * 8;
    for (int p = gw; p < NPROB; p += ngw) {
        const int j = p % NCHK, rest = p / NCHK, d = rest & 1, hh = (rest >> 1) & 7, b = rest >> 4;
        const float* Wd = LW + (size_t)d * MT * 512; const bf16* Ad = AR_ + (size_t)d * MT * 512;
        const float kav = ka[hh * 64 + lane];
        const int row0 = scan_row(j * CCH, d, b), sg = d ? -1 : 1;
        float lw[16]; bf16 rr[16], kx[16], kkx[16], ax[16];
#pragma unroll
        for (int t = 0; t < 16; ++t) { const size_t off = (size_t)(row0 + sg * t) * 512 + hh * 64 + lane; lw[t] = Wd[off]; rr[t] = R[off]; kx[t] = K[off]; kkx[t] = KK[off]; ax[t] = Ad[off]; }
        float cum = 0.f, e0 = 1.f;
#pragma unroll
        for (int t = 0; t < 16; ++t) {
            cum += lw[t]; const float e1 = __expf(cum), ei = __builtin_amdgcn_rcpf(e1);
            const float kkv = bf2f(kkx[t]), av = bf2f(ax[t]), keff = bf2f(kx[t]) * (1.f + (av - 1.f) * kav);
            ARl[t * 72 + lane] = f2bf(-kkv * e0); ARl[(16 + t) * 72 + lane] = f2bf(bf2f(rr[t]) * e1);
            BKl[t * 72 + lane] = f2bf(kkv * av * ei); BKl[(16 + t) * 72 + lane] = f2bf(keff * ei);
            e0 = e1;
        }
        asm volatile("s_waitcnt lgkmcnt(0)" ::: "memory");
        f32x16 g;
#pragma unroll
        for (int i = 0; i < 16; ++i) g[i] = 0.f;
#pragma unroll
        for (int q = 0; q < 4; ++q) g = MFMA32(*(const LAS bf16x8*)(ARl + r * 72 + 16 * q + 8 * h), *(const LAS bf16x8*)(BKl + r * 72 + 16 * q + 8 * h), g);
        const int sI = r & 15; const bool isk = r >= 16;
#pragma unroll
        for (int i = 0; i < 16; ++i) {
            const int row = crow_(i, h), t = row & 15; const bool keep = (i < 8) ? (sI < t) : (sI <= t); const float val = keep ? g[i] : 0.f;
            if (i < 8) { if (!isk) { Ll[t * 16 + sI] = val; OUT[512 + row * 16 + perm16(sI)] = 0; } else OUT[row * 16 + sI] = f2bf(val); }
            else       { if (!isk) OUT[512 + row * 16 + perm16(sI)] = f2bf(val); else OUT[row * 16 + sI] = f2bf(val); }
        }
        asm volatile("s_waitcnt lgkmcnt(0)" ::: "memory");
        { const int c = lane & 15; float Pr[16];
            Pr[0] = (c == 0) ? 1.f : 0.f;
#pragma unroll
            for (int t = 1; t < 16; ++t) { const float lrow = Ll[t * 16 + c]; float acc = (c == t) ? 1.f : 0.f;
#pragma unroll
                for (int u = 0; u < t; ++u) acc += rdlane(lrow, u) * Pr[u];
                Pr[t] = acc; }
            if (lane < 16) {
#pragma unroll
                for (int t = 0; t < 16; ++t) { OUT[1024 + t * 16 + perm16(c)] = f2bf(Pr[t]); OUT[1024 + (16 + t) * 16 + c] = 0; } } }
        asm volatile("s_waitcnt lgkmcnt(0)" ::: "memory");
        { bf16* dst = IMG + (size_t)p * IMG_ELEMS;
#pragma unroll
            for (int q = 0; q < 3; ++q) *(u32x4*)(dst + (q * 64 + lane) * 8) = *(const LAS u32x4*)(OUT + (q * 64 + lane) * 8); }
        asm volatile("s_waitcnt lgkmcnt(0)" ::: "memory");
    }
}

DI void ph_wkv_chunk(const Ctx& C, const bf16* R, const bf16* V, const bf16* K, const bf16* KK, const float* LW, const bf16* AR_, const float* ka, const bf16* IMG, bf16* YS) {
    constexpr int S_AR = 0, S_BKT = 4608, S_VT = 9728, S_VT2 = 11264, S_GC = 12800, S_MM = 13056, S_MRB = 14592, S_PP = 16128, SLOT = 17664, CUMO = 2 * SLOT, YSTO = CUMO + 8192, DEPTH = 4;
    const int lane = C.lane, wv = C.wave, r = lane & 31, h = lane >> 5;
    const bool isE = wv == 2 || wv == 3 || wv == 6 || wv == 7, isS = wv < 2;
    const int te = (wv == 2 ? 0 : (wv == 3 ? 1 : (wv == 6 ? 2 : 3))) * 64 + lane, et = te >> 4, ekq = te & 15;
    const int vhf = te >> 7, vt = (te >> 3) & 15, viq = te & 7;
    const int hf = wv & 1;
    for (int cid0 = C.bid; cid0 < 128; cid0 += C.nb) {
        const int chain = cid0, b = chain >> 4, hh = (chain >> 1) & 7, d = chain & 1;
        const float* Wd = LW + (size_t)d * MT * 512; const bf16* Ad = AR_ + (size_t)d * MT * 512; bf16* Yd = YS + (size_t)d * MT * 512;
        const bf16* img = IMG + (size_t)(((b * 8 + hh) * 2 + d) * NCHK) * IMG_ELEMS;
        f32x16 ST[2];
#pragma unroll
        for (int i = 0; i < 16; ++i) { ST[0][i] = 0.f; ST[1][i] = 0.f; }
        const f32x4 kav = *(const f32x4*)(ka + hh * 64 + 4 * ekq);
        unsigned ring[DEPTH][16];
        __syncthreads();
        auto issue = [&](int ch, unsigned (&rg)[16]) __attribute__((always_inline)) {
            if (ch < 0 || ch >= NCHK) return;
            const int row0 = scan_row(ch * CCH, d, b), sg = d ? -1 : 1;
            if (isE) {
                const size_t off = (size_t)(row0 + sg * et) * 512 + hh * 64 + 4 * ekq;
                const u32x2 x0 = *(const u32x2*)(R + off), x1 = *(const u32x2*)(K + off), x2 = *(const u32x2*)(KK + off), x3 = *(const u32x2*)(Ad + off);
                const u32x2 x4 = *(const u32x2*)(V + (size_t)(row0 + sg * vt) * 512 + hh * 64 + 32 * vhf + 4 * viq);
                rg[0] = x0.x; rg[1] = x0.y; rg[2] = x1.x; rg[3] = x1.y; rg[4] = x2.x; rg[5] = x2.y; rg[6] = x3.x; rg[7] = x3.y; rg[8] = x4.x; rg[9] = x4.y;
                asm volatile("; wkv issue role E" ::);
            } else if (wv == 4) {
#define W5_(t) rg[(t)] = __builtin_bit_cast(unsigned, Wd[(size_t)(row0 + sg * (t)) * 512 + hh * 64 + lane])
                W5_(0); W5_(1); W5_(2); W5_(3); W5_(4); W5_(5); W5_(6); W5_(7); W5_(8); W5_(9); W5_(10); W5_(11); W5_(12); W5_(13); W5_(14); W5_(15);
#undef W5_
                asm volatile("; wkv issue role C" ::);
            } else if (wv == 5) {
#define W6_(q) do { const u32x4 x = *(const u32x4*)(img + (size_t)ch * IMG_ELEMS + ((q) * 64 + lane) * 8); rg[4 * (q)] = x.x; rg[4 * (q) + 1] = x.y; rg[4 * (q) + 2] = x.z; rg[4 * (q) + 3] = x.w; } while (0)
                W6_(0); W6_(1); W6_(2);
#undef W6_
                asm volatile("; wkv issue role V" ::);
            }
        };
        issue(0, ring[0]); issue(1, ring[1]); issue(2, ring[2]); issue(3, ring[3]);
#define WKV_BAR() asm volatile("s_waitcnt lgkmcnt(0)\n\ts_barrier" ::: "memory")
#define WKV_LOOP(...) for (int n0 = -2; n0 < NCHK; n0 += DEPTH) { auto iter = [&](auto kc) __attribute__((always_inline)) { constexpr int kk = decltype(kc)::value; \
            constexpr int riE = (kk + 3) % DEPTH, riW = kk % DEPTH; (void)riE; (void)riW; const int n = n0 + kk; (void)n; __VA_ARGS__; WKV_BAR(); }; iter(ICk<0>{}); iter(ICk<1>{}); iter(ICk<2>{}); iter(ICk<3>{}); }
        if (isS) {
            WKV_LOOP({
                if (n >= 0 && n < NCHK) {
                    const LAS unsigned char* B = C.lds + (n & 1) * SLOT;
                    f32x16 T1;
                    _Pragma("unroll") for (int i = 0; i < 16; ++i) T1[i] = 0.f;
                    _Pragma("unroll") for (int tau = 0; tau < 2; ++tau) {
                        T1 = MFMA32(*(const LAS bf16x8*)(B + S_AR + r * 144 + (32 * tau + 8 * h) * 2), pack_lo8(ST[tau]), T1);
                        T1 = MFMA32(*(const LAS bf16x8*)(B + S_AR + r * 144 + (32 * tau + 16 + 8 * h) * 2), pack_hi8(ST[tau]), T1);
                    }
                    const bf16x8 vtf = *(const LAS bf16x8*)(B + (hf ? S_VT2 : S_VT) + r * 48 + 16 * h);
                    T1 = MFMA32(*(const LAS bf16x8*)(B + S_MM + r * 48 + 16 * h), vtf, T1);
                    f32x16 ET;
                    _Pragma("unroll") for (int i = 0; i < 16; ++i) ET[i] = 0.f;
                    ET = MFMA32(*(const LAS bf16x8*)(B + S_PP + r * 48 + 16 * h), pack_lo8(T1), ET);
                    const bf16x8 ef = pack_lo8(ET);
                    T1 = MFMA32(*(const LAS bf16x8*)(B + S_MRB + r * 48 + 16 * h), ef, T1);
                    _Pragma("unroll") for (int tau = 0; tau < 2; ++tau) {
                        ST[tau] = MFMA32(*(const LAS bf16x8*)(B + S_BKT + (32 * tau + r) * 80 + 16 * h), ef, ST[tau]);
                        ST[tau] = MFMA32(*(const LAS bf16x8*)(B + S_BKT + (32 * tau + r) * 80 + 32 + 16 * h), vtf, ST[tau]);
                        _Pragma("unroll") for (int g4 = 0; g4 < 4; ++g4) { const f32x4 gc = *(const LAS f32x4*)(B + S_GC + (32 * tau + 8 * g4 + 4 * h) * 4);
                            ST[tau][4 * g4] *= gc.x; ST[tau][4 * g4 + 1] *= gc.y; ST[tau][4 * g4 + 2] *= gc.z; ST[tau][4 * g4 + 3] *= gc.w; }
                    }
                    LAS float* ys = (LAS float*)(C.lds + YSTO) + ((n & 1) * 2 + hf) * 512;
                    _Pragma("unroll") for (int q = 0; q < 8; ++q) ys[(8 * (q >> 2) + 4 * h + (q & 3)) * 32 + r] = T1[8 + q];
                }
            });
        } else if (isE) {
            WKV_LOOP({
                const int ch = n + 1;
                if (ch >= 0) {
                    if (ch < NCHK) {
                        LAS unsigned char* B = C.lds + (ch & 1) * SLOT; const LAS float* ec = (const LAS float*)(C.lds + CUMO) + (ch & 1) * 1024;
                        const f32x4 e1 = *(const LAS f32x4*)(ec + et * 64 + 4 * ekq);
                        f32x4 e0 = {1.f, 1.f, 1.f, 1.f}; if (et > 0) e0 = *(const LAS f32x4*)(ec + (et - 1) * 64 + 4 * ekq);
                        const float rv[4] = {bflo(ring[riE][0]), bfhi(ring[riE][0]), bflo(ring[riE][1]), bfhi(ring[riE][1])}; const float kv[4] = {bflo(ring[riE][2]), bfhi(ring[riE][2]), bflo(ring[riE][3]), bfhi(ring[riE][3])};
                        const float kkv[4] = {bflo(ring[riE][4]), bfhi(ring[riE][4]), bflo(ring[riE][5]), bfhi(ring[riE][5])}; const float av[4] = {bflo(ring[riE][6]), bfhi(ring[riE][6]), bflo(ring[riE][7]), bfhi(ring[riE][7])};
                        float ah[4]; float rh[4]; float bc[4]; float kc4[4];
                        _Pragma("unroll") for (int e = 0; e < 4; ++e) { const float ei = __builtin_amdgcn_rcpf(e1[e]);
                            ah[e] = -kkv[e] * e0[e]; rh[e] = rv[e] * e1[e]; bc[e] = kkv[e] * av[e] * ei; kc4[e] = kv[e] * (1.f + (av[e] - 1.f) * kav[e]) * ei; }
                        const int pk = perm16(4 * ekq);
                        *(LAS u32x2*)((LAS bf16*)(B + S_AR) + et * 72 + pk) = (u32x2){pk2(ah[0], ah[1]), pk2(ah[2], ah[3])};
                        *(LAS u32x2*)((LAS bf16*)(B + S_AR) + (16 + et) * 72 + pk) = (u32x2){pk2(rh[0], rh[1]), pk2(rh[2], rh[3])};
                        const int pt = perm16(et);
                        _Pragma("unroll") for (int e = 0; e < 4; ++e) { ((LAS bf16*)(B + S_BKT))[(4 * ekq + e) * 40 + pt] = f2bf(bc[e]); ((LAS bf16*)(B + S_BKT))[(4 * ekq + e) * 40 + 16 + et] = f2bf(kc4[e]); }
                        if (et == 15) *(LAS f32x4*)((LAS float*)(B + S_GC) + 4 * ekq) = e1;
                        LAS bf16* vtp = (LAS bf16*)(B + (vhf ? S_VT2 : S_VT)) + (4 * viq) * 24 + vt;
                        vtp[0] = (bf16)(ring[riE][8] & 0xffffu); vtp[24] = (bf16)(ring[riE][8] >> 16); vtp[48] = (bf16)(ring[riE][9] & 0xffffu); vtp[72] = (bf16)(ring[riE][9] >> 16);
                    }
                    issue(ch + DEPTH, ring[riE]);
                }
            });
        } else if (wv == 4) {
            WKV_LOOP({
                const int ch = n + 2;
                if (ch < NCHK) { LAS float* ec = (LAS float*)(C.lds + CUMO) + (ch & 1) * 1024; float c = 0.f;
#define C5_(t) do { c += __builtin_bit_cast(float, ring[riW][(t)]); ec[(t) * 64 + lane] = __expf(c); } while (0)
                    C5_(0); C5_(1); C5_(2); C5_(3); C5_(4); C5_(5); C5_(6); C5_(7); C5_(8); C5_(9); C5_(10); C5_(11); C5_(12); C5_(13); C5_(14); C5_(15);
                }
                issue(ch + DEPTH, ring[riW]);
            });
        } else {
            WKV_LOOP({
                { const int chy = n - 1;
                  if (chy >= 0 && chy < NCHK) { const int yh = lane >> 5, yt = (lane & 31) >> 1, yi = 16 * (lane & 1);
                    const LAS float* ys = (const LAS float*)(C.lds + YSTO) + ((chy & 1) * 2 + yh) * 512 + yt * 32 + yi;
                    bf16* dst = Yd + (size_t)(scan_row(chy * CCH, d, b) + (d ? -1 : 1) * yt) * 512 + hh * 64 + 32 * yh + yi;
                    _Pragma("unroll") for (int q = 0; q < 2; ++q) { const f32x4 a0 = *(const LAS f32x4*)(ys + 8 * q); const f32x4 a1 = *(const LAS f32x4*)(ys + 8 * q + 4);
                        *(u32x4*)(dst + 8 * q) = (u32x4){pk2(a0.x, a0.y), pk2(a0.z, a0.w), pk2(a1.x, a1.y), pk2(a1.z, a1.w)}; } } }
                const int ch = n + 1;
                if (ch >= 0) {
                    if (ch < NCHK) { LAS unsigned char* B = C.lds + (ch & 1) * SLOT;
                        const int irow = lane >> 1; const int ihv = lane & 1;
                        *(LAS u32x4*)(B + S_MM + irow * 48 + ihv * 16) = (u32x4){ring[riE][0], ring[riE][1], ring[riE][2], ring[riE][3]};
                        *(LAS u32x4*)(B + S_MRB + irow * 48 + ihv * 16) = (u32x4){ring[riE][4], ring[riE][5], ring[riE][6], ring[riE][7]};
                        *(LAS u32x4*)(B + S_PP + irow * 48 + ihv * 16) = (u32x4){ring[riE][8], ring[riE][9], ring[riE][10], ring[riE][11]};
                    }
                    issue(ch + DEPTH, ring[riE]);
                }
            });
        }
#undef C5_
#undef WKV_LOOP
#undef WKV_BAR
    }
}

DI void ph_post(const Ctx& C, const bf16* YS, const bf16* R, const bf16* V, const bf16* K, const bf16* A2, const float* ka, const bf16* G, const float* rk, const float* gng, const float* gnb, bf16* OCAT, bool last) {
    const int gw = C.bid * 8 + C.wave, ngw = C.nb * 8, lane = C.lane, nrows = last ? NLAT : MT;
    for (int row = gw; row < nrows; row += ngw) {
        const size_t o = (size_t)row * 512 + 8 * lane;
        float y[8], y1[8]; unpack8(*(const u32x4*)(YS + o), y); unpack8(*(const u32x4*)(YS + (size_t)MT * 512 + o), y1);
#pragma unroll
        for (int e = 0; e < 8; ++e) y[e] += y1[e];
        float r[8], v[8], kx[8], a0[8], a1[8], g[8];
        unpack8(*(const u32x4*)(R + o), r); unpack8(*(const u32x4*)(V + o), v); unpack8(*(const u32x4*)(K + o), kx); unpack8(*(const u32x4*)(A2 + o), a0); unpack8(*(const u32x4*)(A2 + (size_t)MT * 512 + o), a1); unpack8(*(const u32x4*)(G + o), g);
        float bsum = 0.f;
#pragma unroll
        for (int e = 0; e < 8; ++e) { const float kae = ka[8 * lane + e]; bsum += r[e] * (kx[e] * (1.f + (a0[e] - 1.f) * kae) + kx[e] * (1.f + (a1[e] - 1.f) * kae)) * rk[8 * lane + e]; }
        bsum = sum8(bsum);
        float s = 0.f;
#pragma unroll
        for (int e = 0; e < 8; ++e) { y[e] += bsum * v[e]; s += y[e]; }
        const float mu = sum8(s) * (1.f / 64.f); float s2 = 0.f;
#pragma unroll
        for (int e = 0; e < 8; ++e) { y[e] -= mu; s2 += y[e] * y[e]; }
        const float rstd = 1.0f / sqrtf(sum8(s2) * (1.f / 64.f) + GN_EPS);
        float out[8];
#pragma unroll
        for (int e = 0; e < 8; ++e) out[e] = (y[e] * rstd * gng[8 * lane + e] + gnb[8 * lane + e]) * g[e];
        *(u32x4*)(OCAT + (size_t)row * DM + 8 * lane) = pack8(out);
    }
}

DI void ph_topk2(const Ctx& C, const float* AFFT, const float* AFFC, int* ROWS, float* GATE, int* SLOT, bool last) {
    LAS unsigned* wcnt = (LAS unsigned*)C.lds;
    LAS unsigned* cnt = wcnt + 16;
    const int tid = C.tid, nprob = last ? 128 : 256;
    for (int p = C.bid; p < nprob; p += C.nb) {
        const bool isctx = p >= 128; const int be = p & 127, b = be >> 4, e = be & 15;
        const int n = isctx ? LCX : TL, cap = isctx ? CAPC : CAPL;
        const float* src = isctx ? AFFC + (size_t)be * LCX : AFFT + (size_t)be * TL;
        unsigned v[8]; const int per = isctx ? 1 : 8, t0 = tid * per;
#pragma unroll
        for (int q = 0; q < 8; ++q) v[q] = 0u;
        if (!isctx) { const u32x4 a0 = *(const u32x4*)(src + t0), a1 = *(const u32x4*)(src + t0 + 4); v[0] = a0.x; v[1] = a0.y; v[2] = a0.z; v[3] = a0.w; v[4] = a1.x; v[5] = a1.y; v[6] = a1.z; v[7] = a1.w; }
        else if (tid < LCX) v[0] = __builtin_bit_cast(unsigned, src[tid]);
        __syncthreads();
        unsigned T = 0u;
        for (int bit = 30; bit >= 0; --bit) {
            const unsigned cand = T | (1u << bit); unsigned c = 0u;
#pragma unroll
            for (int q = 0; q < 8; ++q) c += (unsigned)__builtin_popcountll(__builtin_amdgcn_ballot_w64(v[q] >= cand));
            LAS unsigned* wc = wcnt + (bit & 1) * 8;
            if (C.lane == 0) wc[C.wave] = c;
            __syncthreads();
            const unsigned tot = wc[0] + wc[1] + wc[2] + wc[3] + wc[4] + wc[5] + wc[6] + wc[7];
            if (tot >= (unsigned)cap) T = cand;
        }
        unsigned myc = 0u;
#pragma unroll
        for (int q = 0; q < 8; ++q) myc += (v[q] > T ? 0x10000u : 0u) + ((v[q] == T && (isctx ? (q == 0 && tid < LCX) : true)) ? 1u : 0u);
        __syncthreads();
        cnt[tid] = myc;
        __syncthreads();
        for (int off = 1; off < 512; off <<= 1) { const unsigned add = tid >= off ? cnt[tid - off] : 0u; __syncthreads(); cnt[tid] += add; __syncthreads(); }
        const unsigned total = cnt[511], keq = (unsigned)cap - (total >> 16);
        unsigned before = cnt[tid] - myc;
        for (int q = 0; q < per; ++q) { const int t = t0 + q; if (t >= n) break; const unsigned x = v[q]; const unsigned gtb = before >> 16, eqb = before & 0xFFFFu;
            const bool sel = x > T || (x == T && eqb < keq);
            if (sel) { const int jx = (int)(gtb + (eqb < keq ? eqb : keq));
                const int slot = isctx ? NB * CAPL + b * CAPC + jx : b * CAPL + jx, row = isctx ? NLAT + b * LCX + t : b * TL + t;
                ROWS[e * ESLOTS + slot] = row; GATE[e * ESLOTS + slot] = __builtin_bit_cast(float, x); SLOT[(size_t)row * 16 + e] = slot; }
            before += (x > T ? 0x10000u : 0u) + (x == T ? 1u : 0u); }
        __syncthreads();
    }
}


DI void ph_combine(const Ctx& C, float* xlat, float* xctx, const float* modg2  , const int* SLOT, const bf16* Y2, bool last,
                   const float* ngain  , const float* nmod  , bf16* H) {
    const int gw = C.bid * 8 + C.wave, ngw = C.nb * 8, lane = C.lane, nrows = last ? NLAT : MT;
    for (int row = gw; row < nrows; row += ngw) {
        float* xr = row < NLAT ? xlat + (size_t)row * DM : xctx + (size_t)(row - NLAT) * DM;
        const int mi = row < NLAT ? (row >> 12) : 8;
        const int sv = SLOT[(size_t)row * 16 + (lane & 15)];
        f32x4 acc[4];
#pragma unroll
        for (int j = 0; j < 4; ++j) acc[j] = (f32x4){0.f, 0.f, 0.f, 0.f};
#pragma unroll
        for (int e = 0; e < 16; ++e) {
            const int s = __builtin_amdgcn_readlane(sv, e);
            if (s >= 0) { const bf16* yp = Y2 + ((size_t)e * ESLOTS + s) * DM + 4 * lane;
#pragma unroll
                for (int j = 0; j < 4; ++j) { const u32x2 w = *(const u32x2*)(yp + 256 * j); acc[j] += (f32x4){bflo(w.x), bfhi(w.x), bflo(w.y), bfhi(w.y)}; } }
        }
#pragma unroll
        for (int j = 0; j < 4; ++j) { const int c = 256 * j + 4 * lane; const f32x4 g = *(const f32x4*)(modg2 + mi * 6144 + c); f32x4 x = *(const f32x4*)(xr + c); x += g * acc[j]; *(f32x4*)(xr + c) = x; acc[j] = x; }
        if (ngain) {
            float ss = 0.f;
#pragma unroll
            for (int j = 0; j < 4; ++j) ss += acc[j].x * acc[j].x + acc[j].y * acc[j].y + acc[j].z * acc[j].z + acc[j].w * acc[j].w;
            const float rs = 1.0f / sqrtf(wave_sum(ss) * (1.f / 1024.f) + EPS);
            const float* mp = nmod + mi * 6144;
#pragma unroll
            for (int j = 0; j < 4; ++j) { const int c = 256 * j + 4 * lane;
                const f32x4 g = *(const f32x4*)(ngain + c), sc = *(const f32x4*)(mp + 1024 + c), sh = *(const f32x4*)(mp + c);
                const f32x4 hv = (acc[j] * rs) * g * (sc + 1.0f) + sh;
                *(u32x2*)(H + (size_t)row * DM + c) = (u32x2){pk2(hv.x, hv.y), pk2(hv.z, hv.w)}; }
        }
    }
}

template <int N> struct IC { static constexpr int value = N; };
DI const float* in_ptr(const unsigned char* ws, int k) { const unsigned long long v = ((const unsigned long long*)(ws + 128 * 1024))[k];
    const unsigned lo = __builtin_amdgcn_readfirstlane((unsigned)v), hi = __builtin_amdgcn_readfirstlane((unsigned)(v >> 32));
    return (const float*)(__attribute__((address_space(1))) const float*)(((unsigned long long)hi << 32) | lo); }
template <class T> DI T* launder_ptr(T* p) { unsigned long long v = (unsigned long long)p; unsigned lo = (unsigned)v, hi = (unsigned)(v >> 32); asm volatile("" : "+v"(lo), "+v"(hi));
    lo = __builtin_amdgcn_readfirstlane(lo); hi = __builtin_amdgcn_readfirstlane(hi); return (T*)(__attribute__((address_space(1))) T*)(((unsigned long long)hi << 32) | lo); }
constexpr int N_PHASES = 1 + 23 + 22;
constexpr size_t WS_PTRS = 128 * 1024;
#define P_XC    ((float*)(ws + WS_XC))
#define P_MOD   ((const float*)(ws + WS_MOD))
#define P_HB    ((bf16*)(ws + WS_HB))
#define P_OCAT  ((bf16*)(ws + WS_OCAT))
#define P_AR    (ws + WS_ARENA)
#define P_ROWS  ((int*)(ws + WS_ROWS))
#define P_GATE  ((float*)(ws + WS_GATE))
#define P_SLOT  ((int*)(ws + WS_SLOT))
#define P_AFFT  ((float*)(ws + WS_AFFT))
#define P_AFFC  ((float*)(ws + WS_AFFC))
#define P_W13   ((bf16*)(ws + WS_W13))
#define P_W2    ((bf16*)(ws + WS_W2))
#define P_U     ((bf16*)(P_AR + A_U))
#define P_QPRE  ((float*)(P_AR + A_QPRE))
#define P_KVPRE ((float*)(P_AR + A_KVPRE))
#define P_QB    ((bf16*)(P_AR + A_QB))
#define P_KB    ((bf16*)(P_AR + A_KB))
#define P_VT    ((bf16*)(P_AR + A_VT))
#define P_W     ((float*)(P_AR + A_W))
#define P_KEFF  ((bf16*)(P_AR + A_KEFF))
#define P_R     ((bf16*)(P_AR + A_R))
#define P_V     ((bf16*)(P_AR + A_V))
#define P_KK    ((bf16*)(P_AR + A_KK))
#define P_G     ((bf16*)(P_AR + A_G))
#define P_K     ((bf16*)(P_AR + A_K))
#define P_L     ((bf16*)(P_AR + A_L))
#define P_QN    ((bf16*)(P_AR + A_QN))
#define P_KN    ((bf16*)(P_AR + A_KN))
#define P_VTN   ((bf16*)(P_AR + A_VTN))
#define P_YS    ((bf16*)(P_AR + A_YS))
#define P_IMG   ((bf16*)(P_AR + A_IMG))
#define P_HID   ((bf16*)(P_AR + A_HID))
#define P_Y2    ((bf16*)(P_AR + A_Y2))
#define MODL(i) (P_MOD + (size_t)(i) * 9 * 6144)
#if MOE_F8
#define MOE1_PHASE(NMT) do { pg8::Gemm g{P_HB, P_W13, DM / 2, DM / 2, P_ROWS, SCALE_W, SCALE_ONE}; pg8::OrderMoE S{(NMT), 8, 17, C.nb, C.vcu}; pg8::EpiAdapt<EpiGlu8> E{EpiGlu8{(unsigned char*)P_HID}}; \
        pg8::gemm_phase<pg8::EpiAdapt<EpiGlu8>, pg8::OrderMoE, true>(C.lds, g, S, E, C.tid); } while (0)
#define MOE2_PHASE(NMT) do { pg8::Gemm g{P_HID, P_W2, DM / 2, DM / 2, nullptr, SCALE_W, SCALE_HID}; pg8::OrderMoE S{(NMT), 4, 17, C.nb, C.vcu}; pg8::EpiAdapt<EpiGate> E{EpiGate{P_Y2, P_GATE}}; \
        pg8::gemm_phase<pg8::EpiAdapt<EpiGate>, pg8::OrderMoE, true>(C.lds, g, S, E, C.tid); } while (0)
#else
#define MOE1_PHASE(NMT) do { pg8::Gemm g{P_HB, P_W13, DM, DM, P_ROWS}; pg8::OrderMoE S{(NMT), 8, 17, C.nb, C.vcu}; pg8::EpiAdapt<EpiGlu> E{EpiGlu{P_HID}}; pg8::gemm_phase(C.lds, g, S, E, C.tid); } while (0)
#define MOE2_PHASE(NMT) do { pg8::Gemm g{P_HID, P_W2, DM, DM, nullptr}; pg8::OrderMoE S{(NMT), 4, 17, C.nb, C.vcu}; pg8::EpiAdapt<EpiGate> E{EpiGate{P_Y2, P_GATE}}; pg8::gemm_phase(C.lds, g, S, E, C.tid); } while (0)
#endif
#define RELAUNDER() do { int l_ = C.lane; asm volatile("" : "+v"(l_)); C.lane = l_; C.tid = (C.wave << 6) | l_; } while (0)
__global__ void __launch_bounds__(512, 2) fwd_kernel(Args a) {
    extern __shared__ __attribute__((aligned(16))) unsigned char smem[];
    Ctx C0; C0.lds = (LAS unsigned char*)smem; C0.tid = threadIdx.x; C0.lane = C0.tid & 63; C0.wave = __builtin_amdgcn_readfirstlane(C0.tid >> 6); C0.bid = blockIdx.x; C0.nb = gridDim.x;
    C0.vcu = (C0.nb % 8 == 0) ? (C0.bid % 8) * (C0.nb / 8) + C0.bid / 8 : C0.bid;
    volatile LAS unsigned* bst = (volatile LAS unsigned*)(C0.lds + LDS_BYTES - 16);
#if MEGA
    if (C0.tid == 0) { bst[0] = 0u; bst[1] = 0u; }
    __syncthreads();
    const unsigned bar_x = xcd_barrier_post((unsigned*)(a.ws + WS_CTL) + 4096, bst, C0.tid == 0).x;
#define SEAM() do { if (ph < hi) { XcdBarrier b2_; b2_.bar = (unsigned*)(ws + WS_CTL) + 4096; b2_.x = bar_x; b2_.st = bst; xcd_barrier(b2_, C.tid == 0); } } while (0)
#else
#define SEAM() do { } while (0)
#endif
#if MEGA
    constexpr int lo = 0, hi = N_PHASES;
#else
    const int lo = a.ph_lo, hi = a.ph_hi;
#endif
    int ph = 0;
#ifndef ONLY
#define ONLY -1
#endif
#ifndef REPMASK
#define REPMASK 0
#endif
#ifndef SITE_LO
#define SITE_LO 0
#define SITE_HI 99
#endif
#define PHASE(SITE, ...) do { if ((ONLY < 0 || ONLY == (SITE)) && (SITE) >= SITE_LO && (SITE) <= SITE_HI && ph >= lo && ph < hi) { Ctx C; C.lds = C0.lds; \
        { int w_ = C0.wave; asm volatile("" : "+s"(w_)); unsigned m_ = ~0u; asm volatile("" : "+s"(m_)); int l_ = (int)__builtin_amdgcn_mbcnt_hi(m_, __builtin_amdgcn_mbcnt_lo(m_, 0u)); C.wave = w_; C.lane = l_; C.tid = (w_ << 6) | l_; } \
        { int b_ = C0.bid, n_ = C0.nb, v_ = C0.vcu; asm volatile("" : "+s"(b_), "+s"(n_), "+s"(v_)); C.bid = b_; C.nb = n_; C.vcu = v_; } \
        unsigned z_ = 0u; asm volatile("" : "+s"(z_)); unsigned char* ws = a.ws + z_; float* XL = a.out + z_; const int lq = __builtin_amdgcn_readfirstlane(lp); typedef const __attribute__((address_space(1))) float* gfp_t; const gfp_t* INT_ = (const gfp_t*)(ws + WS_PTRS); (void)INT_; (void)XL; (void)lq; \
        for (int rep_ = 0; rep_ < ((((REPMASK) >> (SITE)) & 1) ? 2 : 1); ++rep_) { __VA_ARGS__; if ((((REPMASK) >> (SITE)) & 1)) __syncthreads(); } ++ph; SEAM(); } else ++ph; } while (0)

    { const int lp = 0;
      PHASE(0, { if (C.bid == 0) { _Pragma("unroll") for (int k = 0; k < 40; ++k) if (C.tid == k) ((const float**)(ws + WS_PTRS))[k] = a.in[k]; }
                 ph_prologue(C, a); }); }

    auto layer_pair = [&](auto lpc) __attribute__((always_inline)) {
        constexpr int lp = decltype(lpc)::value;
        if constexpr (lp == 0) PHASE(1, { const int i = 2 * lq; const float* xl = (i == 0) ? in_ptr(ws, I_X) : XL; const float* xc = (i == 0) ? in_ptr(ws, I_CTX) : P_XC;
                   ph_norm<false>(C, xl, xc, in_ptr(ws, I_N1G) + i * DM, MODL(i), 0, 1024, P_HB, nullptr, nullptr, nullptr, nullptr); });
        PHASE(2, { EpiBf16 E{P_U, EV_INP}; fast_gemm(C, P_HB, DM, (const bf16*)(ws + WS_WEVIN) + (size_t)lq * EV_INP * DM, DM, MT / 256, EV_INP / 256, E); });
        PHASE(3, { EpiBf16 Eq{(bf16*)P_QPRE, 768}; fast_gemm(C, P_U, EV_INP, (const bf16*)(ws + WS_WUQ) + (size_t)lq * 768 * 384, 384, MT / 256, 3, Eq); RELAUNDER();
                   EpiBf16 Ek{(bf16*)P_KVPRE, 1024}; fast_gemm(C, P_U + 384, EV_INP, (const bf16*)(ws + WS_WUKV) + (size_t)lq * 1024 * 256, 256, MT / 256, 4, Ek, true); });
        PHASE(4, ph_mla_fin(C, P_U, (const bf16*)P_QPRE, (const bf16*)P_KVPRE, in_ptr(ws, I_QG) + lq * 96, in_ptr(ws, I_KG) + lq * 96, (const f32x2*)(ws + WS_ROPE), P_QB, P_KB, P_VT));
        PHASE(5, ph_attn_mla2(C, P_QB, P_KB, P_VT, P_OCAT, false, ws, lq));
        PHASE(6, { const int i = 2 * lq; const float* xl = (i == 0) ? in_ptr(ws, I_X) : XL; const float* xc = (i == 0) ? in_ptr(ws, I_CTX) : P_XC;
                   EpiResid E{xl, xc, XL, P_XC, MODL(i) + 2048}; fast_gemm(C, P_OCAT, DM, (const bf16*)(ws + WS_WEVOUT) + (size_t)lq * DM * DM, DM, MT / 256, 4, E); });
        PHASE(7, { const int i = 2 * lq; ph_norm<true>(C, XL, P_XC, in_ptr(ws, I_N2G) + i * DM, MODL(i), 3072, 4096, P_HB, in_ptr(ws, I_ROUTER) + (size_t)i * DM * 16, P_AFFT, P_AFFC, P_SLOT); });
        PHASE(8, ph_topk2(C, P_AFFT, P_AFFC, P_ROWS, P_GATE, P_SLOT, false));
        PHASE(9, { MOE1_PHASE(17); });
        PHASE(10, { MOE2_PHASE(17); });
        PHASE(11, { const int i = 2 * lq; ph_combine(C, XL, P_XC, MODL(i) + 5120, P_SLOT, P_Y2, false, in_ptr(ws, I_N1G) + (i + 1) * DM, MODL(i + 1), P_HB); });
        PHASE(13, { EpiBf16 E{P_U, OD_INP}; fast_gemm(C, P_HB, DM, (const bf16*)(ws + WS_WODIN) + (size_t)lq * OD_INP * DM, DM, MT / 256, OD_INP / 256, E); });
        PHASE(14, ph_prep(C, P_U, in_ptr(ws, I_SHIFTW) + (size_t)lq * 3 * RW_IN, in_ptr(ws, I_KKW) + lq * 512, in_ptr(ws, I_NAQG) + lq * 64, in_ptr(ws, I_NAKG) + lq * 64, P_R, P_V, P_K, P_KK, P_L, P_QN, P_KN, P_VTN));
        PHASE(15, { const bf16* WL = (const bf16*)(ws + WS_WLORA) + (size_t)lq * 655360;
                    { EpiLoraW E{P_W, in_ptr(ws, I_W0) + lq * 1024}; fast_gemm(C, P_L, 384, WL, 256, MT / 256, 4, E); } RELAUNDER();
                    { EpiLoraA E{P_KEFF, in_ptr(ws, I_A0) + lq * 1024}; fast_gemm(C, P_L, 384, WL + (size_t)1024 * 256, 256, MT / 256, 4, E, true); } RELAUNDER();
                    { EpiBf16 E{P_G, 512}; fast_gemm(C, P_L + 128, 384, WL + (size_t)2048 * 256, 256, MT / 256, 2, E); } });
        PHASE(16, ph_wkv_pre(C, P_R, P_K, P_KK, P_W, P_KEFF, in_ptr(ws, I_KA) + lq * 512, P_IMG));
        PHASE(17, { ph_wkv_chunk(C, P_R, P_V, P_K, P_KK, P_W, P_KEFF, in_ptr(ws, I_KA) + lq * 512, P_IMG, P_YS); __syncthreads();
                    ph_natten2(C, P_QN, P_KN, P_VTN, P_OCAT, in_ptr(ws, I_RPB) + (size_t)lq * 8 * 465, lq == 1, (unsigned*)(ws + WS_CTL) + 8192 + 64 * lq, ws, lq); });
        PHASE(18, ph_post(C, P_YS, P_R, P_V, P_K, P_KEFF, in_ptr(ws, I_KA) + lq * 512, P_G, in_ptr(ws, I_RK) + lq * 512, in_ptr(ws, I_GNG) + lq * 512, in_ptr(ws, I_GNB) + lq * 512, P_OCAT, lq == 1));
        PHASE(19, { const int i = 2 * lq + 1; EpiResid E{XL, P_XC, XL, P_XC, MODL(i) + 2048};
                    fast_gemm(C, P_OCAT, DM, (const bf16*)(ws + WS_WODOUT) + (size_t)lq * DM * DM, DM, (lq == 1) ? NLAT / 256 : MT / 256, 4, E); });
        PHASE(20, { const int i = 2 * lq + 1; ph_norm<true>(C, XL, P_XC, in_ptr(ws, I_N2G) + i * DM, MODL(i), 3072, 4096, P_HB, in_ptr(ws, I_ROUTER) + (size_t)i * DM * 16, P_AFFT, P_AFFC, P_SLOT); });
        PHASE(21, ph_topk2(C, P_AFFT, P_AFFC, P_ROWS, P_GATE, P_SLOT, lq == 1));
        PHASE(22, { MOE1_PHASE((lq == 1) ? 16 : 17); });
        PHASE(23, { MOE2_PHASE((lq == 1) ? 16 : 17); });
        PHASE(24, { const int i = 2 * lq + 1;
                    if (lp == 0) ph_combine(C, XL, P_XC, MODL(i) + 5120, P_SLOT, P_Y2, false, in_ptr(ws, I_N1G) + (i + 1) * DM, MODL(i + 1), P_HB);
                    else ph_combine(C, XL, P_XC, MODL(i) + 5120, P_SLOT, P_Y2, true, nullptr, nullptr, nullptr); });
    };
    layer_pair(IC<0>{}); layer_pair(IC<1>{});
}

extern "C" void kernel_launch(void* const* d_in, const int* in_sizes, int n_in, void* d_out, int out_size, void* d_ws, size_t ws_size, hipStream_t stream) {
    static int grid = 0;
    if (grid == 0) {
        if (n_in != 40 || out_size != NLAT * DM || ws_size < WS_END) { fprintf(stderr, "kernel_launch: unexpected shapes (n_in %d out %d ws %zu need %zu)\n", n_in, out_size, ws_size, (size_t)WS_END); grid = -1; return; }
        int dev = 0, cus = 0, per_cu = 0;
        if (hipGetDevice(&dev) != hipSuccess || hipDeviceGetAttribute(&cus, hipDeviceAttributeMultiprocessorCount, dev) != hipSuccess) { grid = -1; return; }
        if (hipFuncSetAttribute((const void*)fwd_kernel, hipFuncAttributeMaxDynamicSharedMemorySize, LDS_BYTES) != hipSuccess) { fprintf(stderr, "kernel_launch: hipFuncSetAttribute failed\n"); grid = -1; return; }
        if (hipOccupancyMaxActiveBlocksPerMultiprocessor(&per_cu, (const void*)fwd_kernel, 512, LDS_BYTES) != hipSuccess || per_cu < 1) { fprintf(stderr, "kernel_launch: occupancy query says %d\n", per_cu); per_cu = 1; }
        (void)hipGetLastError();
        grid = cus;
    }
    if (grid < 0) return;
    (void)hipMemsetAsync((char*)d_ws + WS_CTL, 0, CTL_BYTES, stream);
    Args a{};
    for (int i = 0; i < 40; ++i) a.in[i] = (const float*)d_in[i];
    a.out = (float*)d_out; a.ws = (unsigned char*)d_ws;
#if MEGA
    a.ph_lo = 0; a.ph_hi = N_PHASES;
    hipLaunchKernelGGL(fwd_kernel, dim3(grid), dim3(512), LDS_BYTES, stream, a);
#else
    for (int p = 0; p < N_PHASES; ++p) { a.ph_lo = p; a.ph_hi = p + 1; hipLaunchKernelGGL(fwd_kernel, dim3(grid), dim3(512), LDS_BYTES, stream, a); }
#endif
}
```

```cpp
#include <hip/hip_runtime.h>
#include <cstdio>
#include <cstdint>

#ifndef MEGA
#define MEGA 1
#endif

#define LAS __attribute__((address_space(3)))
#define DI __device__ __forceinline__

typedef unsigned short bf16;
typedef short bf16x8 __attribute__((ext_vector_type(8)));
typedef float f32x4 __attribute__((ext_vector_type(4)));
typedef float f32x2 __attribute__((ext_vector_type(2)));
typedef float f32x16 __attribute__((ext_vector_type(16)));
typedef unsigned u32x4 __attribute__((ext_vector_type(4)));
typedef unsigned u32x2 __attribute__((ext_vector_type(2)));
typedef __bf16 bf16x2_t __attribute__((ext_vector_type(2)));

constexpr int DM = 1024, NB = 8, TL = 4096, LCX = 256;
constexpr int NLAT = NB * TL, NCTX = NB * LCX, MT = NLAT + NCTX;
constexpr int KPOS = TL + LCX;
constexpr float EPS = 1e-6f, GN_EPS = 64e-5f;
constexpr int EV_IN = 1696, EV_INP = 1792, OD_IN = 3456, OD_INP = 3584, RW_IN = 1920;
constexpr int NEXP = 16, CAPL = 512, CAPC = 32, ESLOTS = NB * CAPL + NB * CAPC;
constexpr float LOG2E = 1.4426950408889634f;

constexpr size_t MiB = 1ull << 20;
constexpr size_t WS_CTL = 0, CTL_BYTES = 1 * MiB;
constexpr size_t WS_MOD = 1 * MiB, WS_ROPE = 2 * MiB, WS_XC = 4 * MiB;
constexpr size_t WS_ROWS = 12 * MiB, WS_GATE = 12 * MiB + 512 * 1024, WS_SLOT = 13 * MiB, WS_AFFT = 16 * MiB, WS_AFFC = 18 * MiB;
constexpr size_t WS_WEVIN = 20 * MiB, WS_WEVOUT = 27 * MiB, WS_WUQ = 31 * MiB, WS_WUKV = 33 * MiB, WS_WODIN = 34 * MiB, WS_WODOUT = 48 * MiB, WS_WLORA = 52 * MiB;
constexpr size_t WS_W13 = 56 * MiB, WS_W2 = 120 * MiB, WS_HB = 152 * MiB, WS_OCAT = 220 * MiB, WS_ARENA = 288 * MiB;
constexpr size_t A_U = 0, A_QPRE = 119 * MiB, A_KVPRE = 221 * MiB, A_QB = 357 * MiB, A_KB = 408 * MiB, A_VT = 459 * MiB;
constexpr size_t A_W = 0, A_KEFF = 136 * MiB  , A_G = 204 * MiB, A_R = 238 * MiB, A_V = 272 * MiB, A_KK = 306 * MiB, A_K = 340 * MiB, A_L = 374 * MiB,
                 A_QN = 400 * MiB, A_KN = 434 * MiB, A_VTN = 468 * MiB, A_YS = 612 * MiB  ;
constexpr size_t A_HID = 0, A_Y2 = 136 * MiB;
constexpr size_t A_IMG = 510 * MiB;
constexpr size_t WS_END = WS_ARENA + 680 * MiB;
constexpr int LDS_BYTES = 147456;

DI unsigned pk2(float lo, float hi) { f32x2 v = {lo, hi}; bf16x2_t b = __builtin_convertvector(v, bf16x2_t); return __builtin_bit_cast(unsigned, b); }
DI float bflo(unsigned u) { return __builtin_bit_cast(float, u << 16); }
DI float bfhi(unsigned u) { return __builtin_bit_cast(float, u & 0xffff0000u); }
DI float bf2f(bf16 x) { return __builtin_bit_cast(float, ((unsigned)x) << 16); }
DI bf16 f2bf(float f) { return (bf16)(pk2(f, 0.f) & 0xffffu); }
DI void unpack8(u32x4 v, float (&f)[8]) { f[0] = bflo(v.x); f[1] = bfhi(v.x); f[2] = bflo(v.y); f[3] = bfhi(v.y); f[4] = bflo(v.z); f[5] = bfhi(v.z); f[6] = bflo(v.w); f[7] = bfhi(v.w); }
DI u32x4 pack8(const float (&f)[8]) { u32x4 r; r.x = pk2(f[0], f[1]); r.y = pk2(f[2], f[3]); r.z = pk2(f[4], f[5]); r.w = pk2(f[6], f[7]); return r; }
#define DPP_ADD(x, ctrl) ((x) + __builtin_bit_cast(float, __builtin_amdgcn_update_dpp(0, __builtin_bit_cast(int, (x)), (ctrl), 0xf, 0xf, false)))
#define DPP_MAX(x, ctrl) fmaxf((x), __builtin_bit_cast(float, __builtin_amdgcn_update_dpp(0, __builtin_bit_cast(int, (x)), (ctrl), 0xf, 0xf, false)))
DI float sum8(float x) { x = DPP_ADD(x, 0xB1); x = DPP_ADD(x, 0x4E); x = DPP_ADD(x, 0x141); return x; }
DI float sum16(float x) { x = DPP_ADD(x, 0xB1); x = DPP_ADD(x, 0x4E); x = DPP_ADD(x, 0x141); x = DPP_ADD(x, 0x140); return x; }
DI float max16(float x) { x = DPP_MAX(x, 0xB1); x = DPP_MAX(x, 0x4E); x = DPP_MAX(x, 0x141); x = DPP_MAX(x, 0x140); return x; }
DI float rdlane(float x, int l) { return __builtin_bit_cast(float, __builtin_amdgcn_readlane(__builtin_bit_cast(int, x), l)); }
DI float wave_sum(float v) { const float x = sum16(v); return (rdlane(x, 0) + rdlane(x, 16)) + (rdlane(x, 32) + rdlane(x, 48)); }
DI float xor32(float v, int lane) { return __builtin_bit_cast(float, __builtin_amdgcn_ds_bpermute((lane ^ 32) << 2, __builtin_bit_cast(int, v))); }
typedef int v8i_t __attribute__((ext_vector_type(8)));
typedef int i32x4_t __attribute__((ext_vector_type(4)));
DI unsigned pk4_fp8(float a, float b, float c, float d) {
    a = __builtin_amdgcn_fmed3f(a, -448.f, 448.f); b = __builtin_amdgcn_fmed3f(b, -448.f, 448.f); c = __builtin_amdgcn_fmed3f(c, -448.f, 448.f); d = __builtin_amdgcn_fmed3f(d, -448.f, 448.f);
    int p = __builtin_amdgcn_cvt_pk_fp8_f32(a, b, 0, false); p = __builtin_amdgcn_cvt_pk_fp8_f32(c, d, p, true); return (unsigned)p; }
#ifndef MOE_F8
#define MOE_F8 1
#endif
constexpr int SCALE_ONE = 0x7f7f7f7f, SCALE_W = 0x79797979  , SCALE_HID = 0x7c7c7c7c  ;
DI float sigmoidf_(float x) { return __builtin_amdgcn_rcpf(1.f + __expf(-x)); }
DI float siluf_(float x) { return x * __builtin_amdgcn_rcpf(1.f + __expf(-x)); }
#define MFMA32(a, b, c) __builtin_amdgcn_mfma_f32_32x32x16_bf16((a), (b), (c), 0, 0, 0)

#define XB_TMO      128
#define XB_XCNT(j)  (256  + 64 * (j))
#define XB_XSUB(j)  (1280 + 64 * (j))
#define XB_XGEN(j)  (2304 + 64 * (j))
#define XB_TOP      3328
#define XB_TOPGEN   3392
#define XCD_BAR_WORDS 3456
#define XB_SPIN_CAP (1u << 22)
__device__ __forceinline__ unsigned xb_ld(unsigned* p)              { return __hip_atomic_load(p, __ATOMIC_RELAXED, __HIP_MEMORY_SCOPE_AGENT); }
__device__ __forceinline__ unsigned xb_add(unsigned* p, unsigned v) { return __hip_atomic_fetch_add(p, v, __ATOMIC_RELAXED, __HIP_MEMORY_SCOPE_AGENT); }
__device__ __forceinline__ unsigned xb_xcc_id() { return (unsigned)__builtin_amdgcn_s_getreg((3 << 11) | 20) & 0xFu; }
#define XB_SPIN(cond, bar) do { unsigned _sp = 0; while (cond) { __builtin_amdgcn_s_sleep(1); \
    if ((++_sp & 255u) == 0u) { if (xb_ld(&(bar)[XB_TMO])) break; if (_sp > XB_SPIN_CAP) { atomicAdd(&(bar)[XB_TMO], 1u); break; } } } } while (0)
struct XcdBarrier { unsigned* bar; unsigned x; volatile LAS unsigned* st; };
__device__ __forceinline__ XcdBarrier xcd_barrier_post(unsigned* bar, volatile LAS unsigned* st, bool leader) {
    XcdBarrier b; b.bar = bar; b.x = xb_xcc_id(); b.st = st;
    if (leader) (void)xb_add(&bar[XB_XCNT(b.x)], 1u);
    return b;
}
__device__ __forceinline__ void xcd_barrier_complete(unsigned* bar, unsigned x, unsigned& nloc, unsigned& nx) {
    const unsigned G = gridDim.x * gridDim.y * gridDim.z;
    unsigned sum, cnt, mine, sp = 0u;
    for (;;) {
        sum = 0u; cnt = 0u; mine = 0u;
#pragma unroll
        for (unsigned j = 0; j < 16; ++j) { const unsigned c = xb_ld(&bar[XB_XCNT(j)]); sum += c; cnt += (c > 0u) ? 1u : 0u; mine = (j == x) ? c : mine; }
        if (sum == G) break;
        __builtin_amdgcn_s_sleep(1);
        if ((++sp & 255u) == 0u) { if (xb_ld(&bar[XB_TMO])) break; if (sp > XB_SPIN_CAP) { atomicAdd(&bar[XB_TMO], 1u); break; } }
    }
    nloc = mine > 0u ? mine : 1u; nx = cnt > 0u ? cnt : 1u;
}
__device__ __forceinline__ void xcd_barrier(const XcdBarrier& b, bool leader) {
    asm volatile("s_waitcnt vmcnt(0)" ::: "memory");
    __syncthreads();
    if (leader) {
        unsigned* bar = b.bar;
        __builtin_amdgcn_s_waitcnt(0);
        unsigned nloc = b.st[0], nx = b.st[1];
        if (nloc == 0u) { xcd_barrier_complete(bar, b.x, nloc, nx); b.st[0] = nloc; b.st[1] = nx; }
        const unsigned old = xb_add(&bar[XB_XSUB(b.x)], 1u);
        const unsigned gen = old / nloc;
        if (old + 1u == (gen + 1u) * nloc) {
            __builtin_amdgcn_fence(__ATOMIC_RELEASE, "agent");
            asm volatile("s_waitcnt vmcnt(0)" ::: "memory");
            const unsigned og = xb_add(&bar[XB_TOP], 1u);
            const unsigned tg = og / nx;
            if (og + 1u == (tg + 1u) * nx) xb_add(&bar[XB_TOPGEN], 1u);
            else XB_SPIN(xb_ld(&bar[XB_TOPGEN]) == tg, bar);
            __builtin_amdgcn_fence(__ATOMIC_ACQUIRE, "agent");
            xb_add(&bar[XB_XGEN(b.x)], 1u);
            asm volatile("s_waitcnt vmcnt(0)" ::: "memory");
        } else {
            XB_SPIN(xb_ld(&bar[XB_XGEN(b.x)]) == gen, bar);
            __builtin_amdgcn_fence(__ATOMIC_ACQUIRE, "agent");
            asm volatile("s_waitcnt vmcnt(0)" ::: "memory");
        }
    }
    __syncthreads();
}

struct Ctx { LAS unsigned char* lds; int tid, lane, wave, bid, nb, vcu; };
struct Args { const float* in[40]; float* out; unsigned char* ws; int ph_lo, ph_hi; };
enum { I_X = 0, I_C, I_CTX, I_CCTX, I_ADAW, I_ADAB, I_N1G, I_N2G, I_EVWIN, I_EVWOUT, I_QNORM, I_WUQ, I_KVNORM, I_WUKV, I_QG, I_KG, I_DWW, I_DWB, I_LNG, I_LNB,
       I_ODWIN, I_ODWOUT, I_SHIFTW, I_W0, I_W2L, I_A0, I_A2, I_G2, I_KKW, I_KA, I_RK, I_GNG, I_GNB, I_NAQG, I_NAKG, I_RPB, I_ROUTER, I_MW1, I_MW3, I_MW2 };

DI void transpose_item(const float* __restrict__ W, int K, int N, bf16* __restrict__ WT, int dst_row0, const float* __restrict__ gain, LAS float* scr, int k0, int n0, int lane) {
#pragma unroll 8
    for (int i = 0; i < 32; ++i) { const int kk = 2 * i + (lane >> 5); float v = W[(size_t)(k0 + kk) * N + n0 + (lane & 31)]; if (gain) v *= gain[k0 + kk]; scr[kk * 33 + (lane & 31)] = v; }
    asm volatile("s_waitcnt lgkmcnt(0)" ::: "memory");
    const int c = lane & 7;
#pragma unroll
    for (int j = 0; j < 4; ++j) { const int n = (lane >> 3) + 8 * j; const LAS float* s = scr + (8 * c) * 33 + n;
        u32x4 o; o.x = pk2(s[0 * 33], s[1 * 33]); o.y = pk2(s[2 * 33], s[3 * 33]); o.z = pk2(s[4 * 33], s[5 * 33]); o.w = pk2(s[6 * 33], s[7 * 33]);
        *(u32x4*)(WT + (size_t)(dst_row0 + n) * K + k0 + 8 * c) = o; }
    asm volatile("s_waitcnt lgkmcnt(0)" ::: "memory");
}
DI void transpose_item64(const float* __restrict__ W, int K, int N, bf16* __restrict__ WT, int dst_row0, LAS float* scr, int k0, int n0, int lane) {
    f32x4 v[16];
#pragma unroll
    for (int i = 0; i < 16; ++i) v[i] = *(const f32x4*)(W + (size_t)(k0 + 4 * i + (lane >> 4)) * N + n0 + 4 * (lane & 15));
#pragma unroll
    for (int i = 0; i < 16; ++i) { LAS float* d = scr + (4 * i + (lane >> 4)) * 65 + 4 * (lane & 15); d[0] = v[i].x; d[1] = v[i].y; d[2] = v[i].z; d[3] = v[i].w; }
    asm volatile("s_waitcnt lgkmcnt(0)" ::: "memory");
    const int c = lane & 7;
#pragma unroll
    for (int j = 0; j < 8; ++j) { const int n = (lane >> 3) + 8 * j; const LAS float* s = scr + (8 * c) * 65 + n;
        u32x4 o; o.x = pk2(s[0 * 65], s[1 * 65]); o.y = pk2(s[2 * 65], s[3 * 65]); o.z = pk2(s[4 * 65], s[5 * 65]); o.w = pk2(s[6 * 65], s[7 * 65]);
        *(u32x4*)(WT + (size_t)(dst_row0 + n) * K + k0 + 8 * c) = o; }
    asm volatile("s_waitcnt lgkmcnt(0)" ::: "memory");
}
DI void transpose_item64_f8(const float* __restrict__ W, int K, int N, unsigned char* __restrict__ WT8, int dst_row0, LAS float* scr, int k0, int n0, int lane) {
    f32x4 v[16];
#pragma unroll
    for (int i = 0; i < 16; ++i) v[i] = *(const f32x4*)(W + (size_t)(k0 + 4 * i + (lane >> 4)) * N + n0 + 4 * (lane & 15));
#pragma unroll
    for (int i = 0; i < 16; ++i) { LAS float* d = scr + (4 * i + (lane >> 4)) * 65 + 4 * (lane & 15); d[0] = v[i].x; d[1] = v[i].y; d[2] = v[i].z; d[3] = v[i].w; }
    asm volatile("s_waitcnt lgkmcnt(0)" ::: "memory");
    const int c = lane & 7;
#pragma unroll
    for (int j = 0; j < 8; ++j) { const int n = (lane >> 3) + 8 * j; const LAS float* s = scr + (8 * c) * 65 + n;
        u32x2 o; o.x = pk4_fp8(64.f * s[0 * 65], 64.f * s[1 * 65], 64.f * s[2 * 65], 64.f * s[3 * 65]); o.y = pk4_fp8(64.f * s[4 * 65], 64.f * s[5 * 65], 64.f * s[6 * 65], 64.f * s[7 * 65]);
        *(u32x2*)(WT8 + (size_t)(dst_row0 + n) * K + k0 + 8 * c) = o; }
    asm volatile("s_waitcnt lgkmcnt(0)" ::: "memory");
}
DI void transpose_matrix(const Ctx& C, const float* W, int K, int N, bf16* WT, const float* gain, int mode  ) {
    LAS float* scr = (LAS float*)(C.lds + C.wave * 8704);
    const int nkb = K / 64, nnb = N / 32, nit = nkb * nnb, gw = C.vcu * 8 + C.wave, ngw = C.nb * 8;
    for (int it = gw; it < nit; it += ngw) {
        const int kb = it / nnb, nbk = it % nnb, n0 = nbk * 32;
        int d0 = n0; if (mode) d0 = (n0 >> 7) * 256 + (n0 & 127) + (mode == 2 ? 128 : 0);
        transpose_item(W, K, N, WT, d0, gain, scr, kb * 64, n0, C.lane);
    }
}

DI void ph_prologue(const Ctx& C, const Args& a) {
    unsigned char* ws = a.ws;
    {
        LAS float* sv = (LAS float*)C.lds;
        LAS float* red = sv + 9 * 1024;
        for (int i = C.tid; i < 9 * 1024; i += 512) { const int m = i >> 10, k = i & 1023; const float c = (m < 8) ? a.in[I_C][m * 1024 + k] : a.in[I_CCTX][k]; sv[i] = siluf_(c); }
        __syncthreads();
        float* MOD = (float*)(ws + WS_MOD);
        for (int it = C.bid; it < 4 * 96; it += C.nb) {
            const int layer = it / 96, col = (it % 96) * 64 + C.lane;
            const float* wp = a.in[I_ADAW] + (size_t)layer * 1024 * 6144 + col;
            float acc[9];
#pragma unroll
            for (int m = 0; m < 9; ++m) acc[m] = 0.f;
            const int kb = C.wave * 128;
#pragma unroll 16
            for (int k = 0; k < 128; ++k) { const float w = wp[(size_t)(kb + k) * 6144];
#pragma unroll
                for (int m = 0; m < 9; ++m) acc[m] += sv[m * 1024 + kb + k] * w; }
#pragma unroll
            for (int m = 0; m < 9; ++m) red[(C.wave * 9 + m) * 64 + C.lane] = acc[m];
            __syncthreads();
            for (int i = C.tid; i < 576; i += 512) { const int m = i >> 6, l = i & 63; float s = 0.f;
#pragma unroll
                for (int w = 0; w < 8; ++w) s += red[(w * 9 + m) * 64 + l];
                const int cc = (it % 96) * 64 + l;
                MOD[(size_t)(layer * 9 + m) * 6144 + cc] = s + a.in[I_ADAB][layer * 6144 + cc]; }
            __syncthreads();
        }
    }
    {
        f32x2* CS = (f32x2*)(ws + WS_ROPE);
        for (int i = C.bid * 512 + C.tid; i < 4096 * 16; i += C.nb * 512) {
            const int pos = i >> 4, j = i & 15, f = j & 7;
            const float inv = powf(10000.f, -(float)(2 * f) / 16.f);
            const float ang = (float)((j < 8) ? (pos >> 6) : (pos & 63)) * inv;
            const double tw = 6.283185307179586476925;
            const double x = (double)ang, n = __builtin_rint(x / tw), rr = x - n * tw;
            CS[i] = (f32x2){__cosf((float)rr), __sinf((float)rr)};
        }
    }
    for (int j = 0; j < 2; ++j) {
        transpose_matrix(C, a.in[I_EVWIN] + (size_t)j * DM * EV_IN, DM, EV_IN, (bf16*)(ws + WS_WEVIN) + (size_t)j * EV_INP * DM, nullptr, 0);
        transpose_matrix(C, a.in[I_EVWOUT] + (size_t)j * DM * DM, DM, DM, (bf16*)(ws + WS_WEVOUT) + (size_t)j * DM * DM, nullptr, 0);
        transpose_matrix(C, a.in[I_WUQ] + (size_t)j * 384 * 768, 384, 768, (bf16*)(ws + WS_WUQ) + (size_t)j * 768 * 384, a.in[I_QNORM] + j * 384, 0);
        transpose_matrix(C, a.in[I_WUKV] + (size_t)j * 256 * 1024, 256, 1024, (bf16*)(ws + WS_WUKV) + (size_t)j * 1024 * 256, a.in[I_KVNORM] + j * 256, 0);
        transpose_matrix(C, a.in[I_ODWIN] + (size_t)j * DM * OD_IN, DM, OD_IN, (bf16*)(ws + WS_WODIN) + (size_t)j * OD_INP * DM, nullptr, 0);
        transpose_matrix(C, a.in[I_ODWOUT] + (size_t)j * DM * DM, DM, DM, (bf16*)(ws + WS_WODOUT) + (size_t)j * DM * DM, nullptr, 0);
    }
    {
        const int gt = C.bid * 512 + C.tid, ngt = C.nb * 512;
        for (int j = 0; j < 2; ++j) {
            u32x4* p0 = (u32x4*)((bf16*)(ws + WS_WEVIN) + (size_t)j * EV_INP * DM + (size_t)EV_IN * DM);
            for (int i = gt; i < (EV_INP - EV_IN) * DM / 8; i += ngt) p0[i] = (u32x4){0u, 0u, 0u, 0u};
            u32x4* p1 = (u32x4*)((bf16*)(ws + WS_WODIN) + (size_t)j * OD_INP * DM + (size_t)OD_IN * DM);
            for (int i = gt; i < (OD_INP - OD_IN) * DM / 8; i += ngt) p1[i] = (u32x4){0u, 0u, 0u, 0u};
            bf16* WL = (bf16*)(ws + WS_WLORA) + (size_t)j * 655360;
            const float* w2 = a.in[I_W2L] + (size_t)j * 2 * 64 * 512; const float* a2 = a.in[I_A2] + (size_t)j * 2 * 64 * 512; const float* g2 = a.in[I_G2] + (size_t)j * 128 * 512;
            for (int i = gt; i < 655360; i += ngt) {
                const int n = i >> 8, k = i & 255; float v = 0.f;
                if (n < 1024) { const int d = n >> 9, c = n & 511; if (k >= d * 64 && k < d * 64 + 64) v = w2[(size_t)k * 512 + c]; }
                else if (n < 2048) { const int d = (n - 1024) >> 9, c = n & 511; if (k >= 128 + d * 64 && k < 192 + d * 64) v = a2[(size_t)(k - 128) * 512 + c]; }
                else { const int c = n - 2048; if (k >= 128) v = g2[(size_t)(k - 128) * 512 + c]; }
                WL[i] = f2bf(v);
            }
        }
    }
}

template <bool ROUTER>
DI void ph_norm(const Ctx& C, const float* xlat, const float* xctx, const float* gain, const float* mod  , int shift_off, int scale_off, bf16* H,
                const float* router  , float* AFFT, float* AFFC, int* SLOT) {
    LAS float* RT = (LAS float*)C.lds;
    if (ROUTER) { for (int i = C.tid; i < 16384; i += 512) { const int c = i >> 4, e = i & 15; RT[e * 1024 + c] = router[i]; } __syncthreads(); }
    const int gw = C.bid * 8 + C.wave, ngw = C.nb * 8, lane = C.lane;
    for (int row = gw; row < MT; row += ngw) {
        const float* xr = row < NLAT ? xlat + (size_t)row * DM : xctx + (size_t)(row - NLAT) * DM;
        const int mi = row < NLAT ? (row >> 12) : 8;
        const float* mp = mod + mi * 6144;
        f32x4 v[4]; float ss = 0.f;
#pragma unroll
        for (int j = 0; j < 4; ++j) { v[j] = *(const f32x4*)(xr + 256 * j + 4 * lane); ss += v[j].x * v[j].x + v[j].y * v[j].y + v[j].z * v[j].z + v[j].w * v[j].w; }
        ss = wave_sum(ss);
        const float rs = 1.0f / sqrtf(ss * (1.f / 1024.f) + EPS);
#pragma unroll
        for (int j = 0; j < 4; ++j) {
            const int c = 256 * j + 4 * lane;
            const f32x4 g = *(const f32x4*)(gain + c), sc = *(const f32x4*)(mp + scale_off + c), sh = *(const f32x4*)(mp + shift_off + c);
            v[j] = (v[j] * rs) * g * (sc + 1.0f) + sh;
            if (ROUTER && MOE_F8) *(unsigned*)((unsigned char*)H + (size_t)row * DM + c) = pk4_fp8(v[j].x, v[j].y, v[j].z, v[j].w);
            else *(u32x2*)(H + (size_t)row * DM + c) = (u32x2){pk2(v[j].x, v[j].y), pk2(v[j].z, v[j].w)};
        }
        if (ROUTER) {
            float mylg = 0.f;
#pragma unroll 1
            for (int e = 0; e < 16; ++e) { float p = 0.f;
#pragma unroll
                for (int j = 0; j < 4; ++j) { const f32x4 w = *(const LAS f32x4*)(RT + e * 1024 + 256 * j + 4 * lane); p += v[j].x * w.x + v[j].y * w.y + v[j].z * w.z + v[j].w * w.w; }
                p = wave_sum(p); mylg = (lane == e) ? p : mylg; }
            const float mx = max16(mylg);
            const float ex = expf(mylg - mx);
            const float mine = ex / sum16(ex);
            if (lane < 16) {
                if (row < NLAT) AFFT[(size_t)((row >> 12) * 16 + lane) * TL + (row & 4095)] = mine;
                else { const int rc = row - NLAT; AFFC[(size_t)((rc >> 8) * 16 + lane) * LCX + (rc & 255)] = mine; }
                SLOT[(size_t)row * 16 + lane] = -1;
            }
        }
    }
}


struct EpiBf16 { static constexpr bool WIDE = true; bf16* O; int ldo;
    DI void operator()(int row, int col, f32x4 v0, f32x4 v1) const { bf16* p = O + (size_t)row * ldo + col;
        *(u32x2*)p = (u32x2){pk2(v0[0], v0[1]), pk2(v0[2], v0[3])}; *(u32x2*)(p + 128) = (u32x2){pk2(v1[0], v1[1]), pk2(v1[2], v1[3])}; }
    DI void wide(int row, int col, f32x4 a0, f32x4 a1, f32x4 b0, f32x4 b1) const { bf16* p = O + (size_t)row * ldo + col;
        *(u32x4*)p = (u32x4){pk2(a0[0], a0[1]), pk2(a0[2], a0[3]), pk2(a1[0], a1[1]), pk2(a1[2], a1[3])}; *(u32x4*)(p + 128) = (u32x4){pk2(b0[0], b0[1]), pk2(b0[2], b0[3]), pk2(b1[0], b1[1]), pk2(b1[2], b1[3])}; } };
struct EpiF32 { static constexpr bool WIDE = false; float* O; int ldo;
    DI void operator()(int row, int col, f32x4 v0, f32x4 v1) const { float* p = O + (size_t)row * ldo + col; *(f32x4*)p = v0; *(f32x4*)(p + 128) = v1; } };
struct EpiResid { static constexpr bool WIDE = false; const float* xin_lat; const float* xin_ctx; float* xout_lat; float* xout_ctx; const float* modg;
    DI void operator()(int row, int col, f32x4 v0, f32x4 v1) const {
        const float* xi; float* xo; int mi;
        if (row < NLAT) { xi = xin_lat + (size_t)row * DM; xo = xout_lat + (size_t)row * DM; mi = row >> 12; }
        else { xi = xin_ctx + (size_t)(row - NLAT) * DM; xo = xout_ctx + (size_t)(row - NLAT) * DM; mi = 8; }
        const float* g = modg + mi * 6144 + col;
        const f32x4 g0 = *(const f32x4*)g, g1 = *(const f32x4*)(g + 128), x0 = *(const f32x4*)(xi + col), x1 = *(const f32x4*)(xi + col + 128);
        *(f32x4*)(xo + col) = x0 + g0 * v0; *(f32x4*)(xo + col + 128) = x1 + g1 * v1; } };
struct EpiGlu { static constexpr bool WIDE = false; bf16* O;
    DI void operator()(int row, int col, f32x4 v0, f32x4 v1) const { const int f = ((col & 2047) >> 8) * 128 + (col & 255);
        *(u32x2*)(O + (size_t)row * DM + f) = (u32x2){pk2(siluf_(v0[0]) * v1[0], siluf_(v0[1]) * v1[1]), pk2(siluf_(v0[2]) * v1[2], siluf_(v0[3]) * v1[3])}; } };
struct EpiGlu8 { static constexpr bool WIDE = true; unsigned char* O;
    DI void operator()(int row, int col, f32x4 v0, f32x4 v1) const { const int f = ((col & 2047) >> 8) * 128 + (col & 255);
        *(unsigned*)(O + (size_t)row * DM + f) = pk4_fp8(8.f * siluf_(v0[0]) * v1[0], 8.f * siluf_(v0[1]) * v1[1], 8.f * siluf_(v0[2]) * v1[2], 8.f * siluf_(v0[3]) * v1[3]); }
    DI void wide(int row, int col, f32x4 a0, f32x4 a1, f32x4 b0, f32x4 b1) const { const int f = ((col & 2047) >> 8) * 128 + (col & 255);
        *(u32x2*)(O + (size_t)row * DM + f) = (u32x2){pk4_fp8(8.f * siluf_(a0[0]) * b0[0], 8.f * siluf_(a0[1]) * b0[1], 8.f * siluf_(a0[2]) * b0[2], 8.f * siluf_(a0[3]) * b0[3]),
                                                    pk4_fp8(8.f * siluf_(a1[0]) * b1[0], 8.f * siluf_(a1[1]) * b1[1], 8.f * siluf_(a1[2]) * b1[2], 8.f * siluf_(a1[3]) * b1[3])}; } };
struct EpiGate { static constexpr bool WIDE = true; bf16* O; const float* gate;
    DI void operator()(int row, int col, f32x4 v0, f32x4 v1) const { const float g = gate[row]; bf16* p = O + (size_t)row * DM + (col & 1023);
        *(u32x2*)p = (u32x2){pk2(v0[0] * g, v0[1] * g), pk2(v0[2] * g, v0[3] * g)}; *(u32x2*)(p + 128) = (u32x2){pk2(v1[0] * g, v1[1] * g), pk2(v1[2] * g, v1[3] * g)}; }
    DI void wide(int row, int col, f32x4 a0, f32x4 a1, f32x4 b0, f32x4 b1) const { const float g = gate[row]; bf16* p = O + (size_t)row * DM + (col & 1023);
        *(u32x4*)p = (u32x4){pk2(a0[0] * g, a0[1] * g), pk2(a0[2] * g, a0[3] * g), pk2(a1[0] * g, a1[1] * g), pk2(a1[2] * g, a1[3] * g)};
        *(u32x4*)(p + 128) = (u32x4){pk2(b0[0] * g, b0[1] * g), pk2(b0[2] * g, b0[3] * g), pk2(b1[0] * g, b1[1] * g), pk2(b1[2] * g, b1[3] * g)}; } };
struct EpiLoraW { static constexpr bool WIDE = false; float* W; const float* w0;
    DI void one(int row, int col, f32x4 v) const { const int d = col >> 9, c = col & 511; f32x4 o;
#pragma unroll
        for (int e = 0; e < 4; ++e) { const float lw = w0[col + e] + v[e]; const float z = -lw; const float sp = fmaxf(z, 0.f) + __logf(1.f + __expf(-fabsf(z))); o[e] = -__expf(-sp - 0.5f); }
        *(f32x4*)(W + ((size_t)d * MT + row) * 512 + c) = o; }
    DI void operator()(int row, int col, f32x4 v0, f32x4 v1) const { one(row, col, v0); one(row, col + 128, v1); } };
struct EpiLoraA { static constexpr bool WIDE = false; bf16* Aout; const float* a0;
    DI void one(int row, int col, f32x4 v) const { const int d = col >> 9, c = col & 511; const f32x4 b = *(const f32x4*)(a0 + col);
        *(u32x2*)(Aout + ((size_t)d * MT + row) * 512 + c) = (u32x2){pk2(sigmoidf_(b[0] + v[0]), sigmoidf_(b[1] + v[1])), pk2(sigmoidf_(b[2] + v[2]), sigmoidf_(b[3] + v[3]))}; }
    DI void operator()(int row, int col, f32x4 v0, f32x4 v1) const { one(row, col, v0); one(row, col + 128, v1); } };

namespace pg8 {
constexpr int BM = 256, BK = 64, HALF = 128, HTB = HALF * BK * 2, STAGE_BYTES = 8 * HTB;
DI int lds_byte(int r, int c) { const int st = (r >> 4) * 2 + (c >> 5), rr = r & 15, cc = c & 31, ob = rr * 64 + cc * 2; return st * 1024 + (ob ^ (((ob >> 9) & 1) << 5)); }
DI void stage_rc(int b, int& R, int& C) { const int st = b / 1024, sb = b % 1024, swz = sb ^ (((sb >> 9) & 1) << 5); R = (st >> 1) * 16 + swz / 64; C = (st & 1) * 32 + (swz % 64) / 2; }
DI int perm32(int rho) { const int n = rho >> 4, i = rho & 15; return 8 * (i >> 2) + 4 * n + (i & 3); }
struct Unit { int pm, pn; };
struct Gemm { const bf16* A; const bf16* Bt; int lda, K; const int* rows; int scale_w = 0x7f7f7f7f, scale_a = 0x7f7f7f7f; };
struct OrderMN { int nM, nN, G, c;
    DI bool next(int i, Unit& u) const { const int L = i * G + c; if (L >= nM * nN) return false; u.pm = L / nN; u.pn = L % nN; return true; } };
struct OrderMoE { int nMt, nN, mstride  , G, c;
    DI bool next(int i, Unit& u) const { const int L = i * G + c, per = nMt * nN; if (L >= NEXP * per) return false; const int e = L / per, q = L % per; u.pm = e * mstride + q / nN; u.pn = e * nN + q % nN; return true; } };
template <class E4> struct EpiAdapt { E4 e;
    DI void operator()(const f32x4 (&acc)[2][2][4][2], const Unit& u, int wr, int wc, int fr, int fq) const {
#pragma unroll
        for (int ai = 0; ai < 2; ++ai)
#pragma unroll
            for (int m = 0; m < 4; ++m) { const int row = u.pm * BM + ai * HALF + wr * 64 + m * 16 + fr;
                if constexpr (E4::WIDE) e.wide(row, u.pn * BM + wc * 32 + 8 * fq, acc[ai][0][m][0], acc[ai][0][m][1], acc[ai][1][m][0], acc[ai][1][m][1]);
                else {
#pragma unroll
                    for (int n = 0; n < 2; ++n) e(row, u.pn * BM + wc * 32 + 8 * fq + 4 * n, acc[ai][0][m][n], acc[ai][1][m][n]); } } } };

template <class Epi, class Sched, bool F8 = false>
DI void gemm_phase(LAS unsigned char* lds, const Gemm g, const Sched& S, const Epi& E, const int tid) {
    const int wid = __builtin_amdgcn_readfirstlane(tid >> 6), lane = tid & 63, wr = wid >> 2, wc = wid & 3, fr = lane & 15, fq = lane >> 4;
    const int K = g.K, nt = K / BK;
    unsigned voffB[2];
#pragma unroll
    for (int i = 0; i < 2; ++i) { int R, C; stage_rc(tid * 16 + i * 8192, R, C); const int Rb = (R & ~31) + perm32(R & 31); voffB[i] = (unsigned)(Rb * K + C) * 2u; }
    const size_t kstep = (size_t)(BK * 2), hstep = (size_t)HALF * K * 2, tstep = 2 * hstep;
    const unsigned ldsw = (unsigned)wid * 1024u;
    const int aoff = lds_byte(wr * 64 + fr, fq * 8), boff = lds_byte(wc * 32 + fr, fq * 8);
    const char* const gA = (const char*)g.A;
#define PG8_SA(b, h) (((b) * 2 + (h)) * HTB)
#define PG8_SB(b, h) ((4 + (b) * 2 + (h)) * HTB)
#define PG8_STAGE(bufoff, gbase, voff) do { _Pragma("unroll") for (int _i = 0; _i < 2; ++_i) \
        __builtin_amdgcn_global_load_lds((const unsigned*)((const char*)(gbase) + (voff)[_i]), (LAS unsigned*)(lds + (bufoff) + ldsw + _i * 8192), 16, 0, 0); } while (0)
#define PG8_LDA(dst, b, h) do { _Pragma("unroll") for (int m = 0; m < 4; ++m) _Pragma("unroll") for (int k = 0; k < 2; ++k) dst[m][k] = *(const LAS bf16x8*)(lds + PG8_SA(b, h) + aoff + m * 2048 + k * 1024); } while (0)
#define PG8_LDB(dst, b, h) do { _Pragma("unroll") for (int n = 0; n < 2; ++n) _Pragma("unroll") for (int k = 0; k < 2; ++k) dst[n][k] = *(const LAS bf16x8*)(lds + PG8_SB(b, h) + boff + n * 2048 + k * 1024); } while (0)
#define PG8_MMA(ai, bj, At, Bt) do { __builtin_amdgcn_s_setprio(1); _Pragma("unroll") for (int m = 0; m < 4; ++m) _Pragma("unroll") for (int n = 0; n < 2; ++n) { \
        if constexpr (F8) { const v8i_t w8 = __builtin_shufflevector(__builtin_bit_cast(i32x4_t, Bt[n][0]), __builtin_bit_cast(i32x4_t, Bt[n][1]), 0, 1, 2, 3, 4, 5, 6, 7), x8 = __builtin_shufflevector(__builtin_bit_cast(i32x4_t, At[m][0]), __builtin_bit_cast(i32x4_t, At[m][1]), 0, 1, 2, 3, 4, 5, 6, 7); \
            acc[ai][bj][m][n] = __builtin_amdgcn_mfma_scale_f32_16x16x128_f8f6f4(w8, x8, acc[ai][bj][m][n], 0, 0, 0, g.scale_w, 0, g.scale_a); } \
        else { _Pragma("unroll") for (int k = 0; k < 2; ++k) acc[ai][bj][m][n] = __builtin_amdgcn_mfma_f32_16x16x32_bf16(Bt[n][k], At[m][k], acc[ai][bj][m][n], 0, 0, 0); } } __builtin_amdgcn_s_setprio(0); } while (0)
#define PG8_WAIT_V(n) asm volatile("s_waitcnt vmcnt(" #n ")" ::: "memory")
#define PG8_WAIT_L(n) asm volatile("s_waitcnt lgkmcnt(" #n ")" ::: "memory")
#define PG8_BAR __builtin_amdgcn_s_barrier()
#define PG8_SCHED __builtin_amdgcn_sched_barrier(0)
#define PG8_ROWIDX(ri, u) do { _Pragma("unroll") for (int _h = 0; _h < 2; ++_h) _Pragma("unroll") for (int _i = 0; _i < 2; ++_i) { int _R, _C; stage_rc(tid * 16 + _i * 8192, _R, _C); (void)_C; \
        const int _lr = (u).pm * BM + _h * HALF + _R; ri[_h][_i] = g.rows ? g.rows[_lr] : _lr; } } while (0)
#define PG8_AOFF_FROM(vo, ri) do { _Pragma("unroll") for (int _h = 0; _h < 2; ++_h) _Pragma("unroll") for (int _i = 0; _i < 2; ++_i) { int _R, _C; stage_rc(tid * 16 + _i * 8192, _R, _C); (void)_R; \
        vo[_h][_i] = (unsigned)(((size_t)ri[_h][_i] * g.lda + _C) * 2u); } } while (0)
    Unit cur, nxt; int ui = 0;
    if (!S.next(0, cur)) return;
    f32x4 acc[2][2][4][2];
#pragma unroll
    for (int a = 0; a < 2; ++a)
#pragma unroll
        for (int b = 0; b < 2; ++b)
#pragma unroll
            for (int m = 0; m < 4; ++m)
#pragma unroll
                for (int n = 0; n < 2; ++n) acc[a][b][m][n] = (f32x4){0.f, 0.f, 0.f, 0.f};
    bf16x8 At[4][2], B0[2][2], B1[2][2];
    unsigned cvo[2][2]; int nri[2][2];
    PG8_ROWIDX(nri, cur); PG8_AOFF_FROM(cvo, nri);
    const char* cB = (const char*)g.Bt + (size_t)cur.pn * tstep;
    PG8_STAGE(PG8_SB(0, 0), cB, voffB); PG8_STAGE(PG8_SB(0, 1), cB + hstep, voffB); PG8_STAGE(PG8_SA(0, 0), gA, cvo[0]); PG8_STAGE(PG8_SA(0, 1), gA, cvo[1]);
    if (wr == 1) PG8_BAR;
    PG8_WAIT_V(2); PG8_BAR;
    PG8_STAGE(PG8_SB(1, 0), cB + kstep, voffB); PG8_STAGE(PG8_SA(1, 0), gA + kstep, cvo[0]); PG8_STAGE(PG8_SB(1, 1), cB + hstep + kstep, voffB);
    PG8_WAIT_V(6); PG8_BAR;
    for (;;) {
        const bool has_next = S.next(ui + 1, nxt);
        const char* nB = has_next ? (const char*)g.Bt + (size_t)nxt.pn * tstep : cB;
#pragma nounroll
        for (int t = 0; t < nt; t += 2) {
            const bool last = (t == nt - 2);
            const char* a1 = gA + (size_t)(t + 1) * kstep;
            const char* a2 = last ? gA : gA + (size_t)(t + 2) * kstep; const char* b2 = last ? nB : cB + (size_t)(t + 2) * kstep;
            const char* a3 = a2 + kstep; const char* b3 = b2 + kstep;
            if (t == nt - 4 && has_next) PG8_ROWIDX(nri, nxt);
            PG8_LDB(B0, 0, 0); PG8_LDB(B1, 0, 1); PG8_SCHED; PG8_LDA(At, 0, 0); PG8_STAGE(PG8_SA(1, 1), a1, cvo[1]);
            if (last && has_next) { if (nt < 4) PG8_ROWIDX(nri, nxt); PG8_AOFF_FROM(cvo, nri); }
            PG8_WAIT_V(8); PG8_WAIT_L(0); PG8_BAR; PG8_MMA(0, 0, At, B0); PG8_MMA(0, 1, At, B1); PG8_BAR; PG8_SCHED;
            PG8_LDA(At, 0, 1); PG8_STAGE(PG8_SB(0, 0), b2, voffB); PG8_STAGE(PG8_SB(0, 1), b2 + hstep, voffB); PG8_STAGE(PG8_SA(0, 0), a2, cvo[0]);
            PG8_WAIT_V(8); PG8_WAIT_L(0); PG8_BAR; PG8_MMA(1, 0, At, B0); PG8_MMA(1, 1, At, B1); PG8_BAR; PG8_SCHED;
            PG8_LDB(B0, 1, 0); PG8_LDB(B1, 1, 1); PG8_SCHED; PG8_LDA(At, 1, 0); PG8_STAGE(PG8_SA(0, 1), a2, cvo[1]);
            PG8_WAIT_V(8); PG8_WAIT_L(0); PG8_BAR; PG8_MMA(0, 0, At, B0); PG8_MMA(0, 1, At, B1); PG8_BAR; PG8_SCHED;
            PG8_LDA(At, 1, 1); PG8_STAGE(PG8_SB(1, 0), b3, voffB); PG8_STAGE(PG8_SB(1, 1), b3 + hstep, voffB); PG8_STAGE(PG8_SA(1, 0), a3, cvo[0]);
            PG8_WAIT_V(8); PG8_WAIT_L(0); PG8_BAR; PG8_MMA(1, 0, At, B0); PG8_MMA(1, 1, At, B1); PG8_BAR; PG8_SCHED;
        }
        if (wr == 0) PG8_BAR;
        E(acc, cur, wr, wc, fr, fq);
        if (!has_next) break;
#pragma unroll
        for (int a = 0; a < 2; ++a)
#pragma unroll
            for (int b = 0; b < 2; ++b)
#pragma unroll
                for (int m = 0; m < 4; ++m)
#pragma unroll
                    for (int n = 0; n < 2; ++n) acc[a][b][m][n] = (f32x4){0.f, 0.f, 0.f, 0.f};
        cur = nxt; cB = nB; ++ui;
        if (wr == 1) PG8_BAR;
    }
    PG8_WAIT_V(0);
    PG8_BAR;
#undef PG8_SA
#undef PG8_SB
#undef PG8_STAGE
#undef PG8_LDA
#undef PG8_LDB
#undef PG8_MMA
#undef PG8_WAIT_V
#undef PG8_WAIT_L
#undef PG8_BAR
#undef PG8_SCHED
#undef PG8_ROWIDX
#undef PG8_AOFF_FROM
}
}
template <class E4> DI void fast_gemm(const Ctx& C, const bf16* A, int lda, const bf16* Bt, int K, int nM, int nN, const E4& e, bool rev = false) {
    pg8::Gemm g{A, Bt, lda, K, nullptr}; pg8::OrderMN S{nM, nN, C.nb, rev ? C.nb - 1 - C.vcu : C.vcu}; pg8::EpiAdapt<E4> E{e};
    pg8::gemm_phase(C.lds, g, S, E, C.tid);
}

DI float max16_acc(float m, const f32x16& x) {
    asm volatile("s_nop 15\n\tv_max3_f32 %0, %0, %1, %2\n\tv_max3_f32 %0, %0, %3, %4\n\tv_max3_f32 %0, %0, %5, %6\n\tv_max3_f32 %0, %0, %7, %8\n\tv_max3_f32 %0, %0, %9, %10\n\tv_max3_f32 %0, %0, %11, %12\n\tv_max3_f32 %0, %0, %13, %14\n\tv_max3_f32 %0, %0, %15, %16"
                 : "+v"(m) : "v"(x[0]), "v"(x[1]), "v"(x[2]), "v"(x[3]), "v"(x[4]), "v"(x[5]), "v"(x[6]), "v"(x[7]), "v"(x[8]), "v"(x[9]), "v"(x[10]), "v"(x[11]), "v"(x[12]), "v"(x[13]), "v"(x[14]), "v"(x[15]));
    return m; }
DI int swap23(int x) { return (x & ~12) | ((x & 4) << 1) | ((x & 8) >> 1); }
DI void flash_store(const f32x16 (&o)[2], float l, bf16* orow  , int h) {
    const float inv = 1.f / l;
#pragma unroll
    for (int dt = 0; dt < 2; ++dt)
#pragma unroll
        for (int g = 0; g < 4; ++g)
            *(u32x2*)(orow + 32 * dt + 8 * g + 4 * h) = (u32x2){pk2(o[dt][4 * g] * inv, o[dt][4 * g + 1] * inv), pk2(o[dt][4 * g + 2] * inv, o[dt][4 * g + 3] * inv)};
}


template <int DQK> struct AttnGeo { static constexpr int KSTR = DQK * 2 + 16, KBYTES = 64 * KSTR, VSTR = 144, VBYTES = 64 * VSTR, BUF = KBYTES + VBYTES, KPIECES = 64 * DQK / 8; };
template <int DQK, bool NAT>
DI void attn_tile_loop(const Ctx& C, f32x16 (&o)[2], float& l, const bf16x8 (&qf)[DQK / 16], const bf16* __restrict__ Kb, const bf16* __restrict__ Vt, int pos1, int n1, int pos2, int n2,
                       const LAS float* tab, int grow, int rs, int qc, int cs) {
    typedef AttnGeo<DQK> G;
    const int tid = C.tid, r = C.lane & 31, h = C.lane >> 5, kr = swap23(r), ntiles = n1 + n2;
    constexpr bool K2 = G::KPIECES > 512;
    const int kq0 = tid, kq1 = tid + 512;
    const int kl0 = (kq0 / (DQK / 8)) * G::KSTR + (kq0 % (DQK / 8)) * 16, kl1 = (kq1 / (DQK / 8)) * G::KSTR + (kq1 % (DQK / 8)) * 16;
    const int vl = G::KBYTES + (tid >> 3) * G::VSTR + (tid & 7) * 16;
    const bf16* vg = Vt + (size_t)(tid >> 3) * KPOS + 8 * (tid & 7);
    u32x4 rk0, rk1, rv;
    rk1 = (u32x4){0u, 0u, 0u, 0u};
#define ATT_POS(t) ((t) < n1 ? pos1 + 64 * (t) : pos2 + 64 * ((t) - n1))
    { const int pos0 = ATT_POS(0); rk0 = *(const u32x4*)(Kb + (size_t)pos0 * DQK + 8 * kq0); if (K2 && tid < 256) rk1 = *(const u32x4*)(Kb + (size_t)pos0 * DQK + 8 * kq1); rv = *(const u32x4*)(vg + pos0); }
    __syncthreads();
    *(LAS u32x4*)(C.lds + kl0) = rk0; if (K2 && tid < 256) *(LAS u32x4*)(C.lds + kl1) = rk1; *(LAS u32x4*)(C.lds + vl) = rv;
    __syncthreads();
    float mref = 0.f; bool first = true;
    constexpr float THR = 8.f;
    for (int t = 0; t < ntiles; ++t) {
        const LAS unsigned char* B = C.lds + (t & 1) * G::BUF;
        if (t + 1 < ntiles) { const int pos0 = ATT_POS(t + 1);
            rk0 = *(const u32x4*)(Kb + (size_t)pos0 * DQK + 8 * kq0); if (K2 && tid < 256) rk1 = *(const u32x4*)(Kb + (size_t)pos0 * DQK + 8 * kq1); rv = *(const u32x4*)(vg + pos0); }
        const int gr = (pos1 >> 6) + t;
        const bool active = !NAT || t >= n1 || (gr >= rs && gr < rs + 8);
        if (active) {
            f32x16 sc[2];
#pragma unroll
            for (int j = 0; j < 2; ++j)
#pragma unroll
                for (int i = 0; i < 16; ++i) sc[j][i] = -mref;
            constexpr int NK = DQK / 16, NS = 2 * NK, RD = 4;
            const LAS unsigned char* kp = B + kr * G::KSTR + 16 * h;
            bf16x8 fr[RD];
#pragma unroll
            for (int s = 0; s < RD; ++s) fr[s] = *(const LAS bf16x8*)(kp + (s / NK) * 32 * G::KSTR + 32 * (s % NK));
#pragma unroll
            for (int s = 0; s < NS; ++s) { sc[s / NK] = MFMA32(fr[s % RD], qf[s % NK], sc[s / NK]);
                if (s + RD < NS) fr[s % RD] = *(const LAS bf16x8*)(kp + ((s + RD) / NK) * 32 * G::KSTR + 32 * ((s + RD) % NK)); }
            const LAS unsigned char* vp = B + G::KBYTES + r * G::VSTR + 16 * h;
#pragma unroll
            for (int v = 0; v < RD; ++v) fr[v] = *(const LAS bf16x8*)(vp + (v & 1) * 32 * G::VSTR + (v >> 1) * 32);
            __builtin_amdgcn_sched_group_barrier(0x100, RD, 0);
#pragma unroll
            for (int s = 0; s < NS - RD; ++s) { __builtin_amdgcn_sched_group_barrier(0x008, 1, 0); __builtin_amdgcn_sched_group_barrier(0x100, 1, 0); }
            __builtin_amdgcn_sched_group_barrier(0x008, RD, 0);
            __builtin_amdgcn_sched_group_barrier(0x100, RD, 0);
            if (NAT && t < n1) {
                const LAS float* trl = tab + (gr - grow + 7) * 128 + (8 * h - qc + 63);
#pragma unroll
                for (int j = 0; j < 2; ++j)
#pragma unroll
                    for (int i = 0; i < 16; ++i) {
                        const int c0 = 32 * j + ((i & 3) | (((i >> 2) & 1) << 2) | ((i >> 3) << 4)), cc = c0 + 8 * h; const bool ok = (cc >= cs) && (cc < cs + 16);
                        const float bv = trl[c0];
                        sc[j][i] = ok ? sc[j][i] + bv : -1e30f;
                    }
            }
            float mx = max16_acc(max16_acc(-3.0e38f, sc[0]), sc[1]);
            if (first || __builtin_amdgcn_ballot_w64(mx > THR) != 0ull) {
                mx = fmaxf(mx, xor32(mx, C.lane));
                const float delta = first ? mx : fmaxf(mx, 0.f);
#pragma unroll
                for (int i = 0; i < 16; ++i) { sc[0][i] -= delta; sc[1][i] -= delta; }
                if (!first) { const float alpha = __builtin_amdgcn_exp2f(-delta); l *= alpha;
#pragma unroll
                    for (int i = 0; i < 16; ++i) { o[0][i] *= alpha; o[1][i] *= alpha; } }
                mref += delta; first = false;
            }
            f32x2 rs2 = {0.f, 0.f};
#pragma unroll
            for (int j = 0; j < 2; ++j)
#pragma unroll
                for (int i = 0; i < 16; i += 2) { sc[j][i] = __builtin_amdgcn_exp2f(sc[j][i]); sc[j][i + 1] = __builtin_amdgcn_exp2f(sc[j][i + 1]); rs2 += (f32x2){sc[j][i], sc[j][i + 1]}; }
            l += rs2.x + rs2.y;
#pragma unroll
            for (int j = 0; j < 2; ++j)
#pragma unroll
                for (int s2 = 0; s2 < 2; ++s2) {
                    u32x4 pw; pw.x = pk2(sc[j][8 * s2], sc[j][8 * s2 + 1]); pw.y = pk2(sc[j][8 * s2 + 2], sc[j][8 * s2 + 3]); pw.z = pk2(sc[j][8 * s2 + 4], sc[j][8 * s2 + 5]); pw.w = pk2(sc[j][8 * s2 + 6], sc[j][8 * s2 + 7]);
                    const bf16x8 pb = __builtin_bit_cast(bf16x8, pw);
#pragma unroll
                    for (int dt = 0; dt < 2; ++dt) { const int v = 4 * j + 2 * s2 + dt;
                        o[dt] = MFMA32(fr[v % RD], pb, o[dt]);
                        if (v + RD < 8) fr[v % RD] = *(const LAS bf16x8*)(vp + ((v + RD) & 1) * 32 * G::VSTR + ((v + RD) >> 1) * 32); }
                }
#pragma unroll
            for (int v = 0; v < 8 - RD; ++v) { __builtin_amdgcn_sched_group_barrier(0x008, 1, 1); __builtin_amdgcn_sched_group_barrier(0x100, 1, 1); }
            __builtin_amdgcn_sched_group_barrier(0x008, RD, 1);
        }
        if (t + 1 < ntiles) { LAS unsigned char* Bn = C.lds + ((t + 1) & 1) * G::BUF;
            *(LAS u32x4*)(Bn + kl0) = rk0; if (K2 && tid < 256) *(LAS u32x4*)(Bn + kl1) = rk1; *(LAS u32x4*)(Bn + vl) = rv; }
        __syncthreads();
    }
    l += xor32(l, C.lane);
#undef ATT_POS
}
DI void conv_unit(const Ctx& C, int u, const bf16* U, const float (&wk)[31], float bias, const float* lng, const float* lnb, bf16* OCAT);
DI void wprep_items(const Ctx& C, int k0, int k1, const float* w1, const float* w3, const float* w2, bf16* W13, bf16* W2);
DI const float* in_ptr(const unsigned char* ws, int k);
DI void ph_attn_mla2(const Ctx& C, const bf16* QB, const bf16* KB, const bf16* VT, bf16* OCAT, bool last, unsigned char* ws, int lq) {
    const int r = C.lane & 31, h = C.lane >> 5;
    const int nunits = 1024 + (last ? 0 : 64);
    const int nwp = (NEXP * 3 * 256 + C.nb * 8 - 1) / (C.nb * 8);
    int k = 0;
    for (;; ++k) {
        const int u = C.vcu + k * C.nb, cu = (C.nb - 1 - C.vcu) + k * C.nb;
        const bool a_on = u < nunits, c_on = cu < MT / 32, w_on = 2 * k < nwp;
        if (!a_on && !c_on && !w_on) break;
        if (a_on) {
            const int bh = u < 1024 ? (u >> 4) : u - 1024, qblk = u < 1024 ? (u & 15) : 16, b = bh >> 3, hh = bh & 7;
            const int qpos = qblk * 256 + 32 * C.wave + r;
            const bf16* qp = QB + ((size_t)bh * KPOS + qpos) * 96 + 8 * h;
            bf16x8 qf[6];
#pragma unroll
            for (int kk = 0; kk < 6; ++kk) qf[kk] = *(const bf16x8*)(qp + 16 * kk);
            f32x16 o[2];
#pragma unroll
            for (int i = 0; i < 16; ++i) { o[0][i] = 0.f; o[1][i] = 0.f; }
            float l = 0.f;
            attn_tile_loop<96, false>(C, o, l, qf, KB + (size_t)bh * KPOS * 96, VT + (size_t)bh * 64 * KPOS, qblk < 16 ? 0 : TL, qblk < 16 ? KPOS / 64 : LCX / 64, 0, 0, nullptr, 0, 0, 0, 0);
            const int row = qblk < 16 ? b * TL + qpos : NLAT + b * LCX + (qpos - TL);
            flash_store(o, l, OCAT + (size_t)row * DM + hh * 64, h);
        }
        if (c_on) { float wk[31]; const float* dww = in_ptr(ws, I_DWW) + (size_t)lq * 31 * 512;
#pragma unroll
            for (int kt = 0; kt < 31; ++kt) wk[kt] = dww[kt * 512 + C.tid];
            conv_unit(C, cu, (const bf16*)(ws + WS_ARENA + A_U), wk, in_ptr(ws, I_DWB)[lq * 512 + C.tid], in_ptr(ws, I_LNG) + lq * 512, in_ptr(ws, I_LNB) + lq * 512, OCAT); }
        if (w_on) { __syncthreads(); const size_t wo = (size_t)(2 * lq) * NEXP * DM * DM;
            wprep_items(C, 2 * k, 2 * k + 2, in_ptr(ws, I_MW1) + wo, in_ptr(ws, I_MW3) + wo, in_ptr(ws, I_MW2) + wo, (bf16*)(ws + WS_W13), (bf16*)(ws + WS_W2)); }
    }
}
DI void ph_natten2(const Ctx& C, const bf16* QN, const bf16* KN, const bf16* VTN, bf16* OCAT, const float* rpb  , bool last, unsigned* work_ctr, unsigned char* ws, int lq) {
    const int r = C.lane & 31, h = C.lane >> 5;
    LAS float* tab = (LAS float*)(C.lds + 2 * AttnGeo<64>::BUF);
    LAS int* uslot = (LAS int*)(tab + 1920);
    const int nunits = 1024 + (last ? 0 : 64);
    const int nwp = (NEXP * 3 * 256 + C.nb * 8 - 1) / (C.nb * 8); int wdone = 0;
    for (;;) {
        __syncthreads();
        if (wdone < nwp) { const size_t wo = (size_t)(2 * lq + 1) * NEXP * DM * DM; wprep_items(C, wdone, wdone + 2, in_ptr(ws, I_MW1) + wo, in_ptr(ws, I_MW3) + wo, in_ptr(ws, I_MW2) + wo, (bf16*)(ws + WS_W13), (bf16*)(ws + WS_W2)); wdone += 2; __syncthreads(); }
        if (C.tid == 0) *uslot = (int)__hip_atomic_fetch_add(work_ctr, 1u, __ATOMIC_RELAXED, __HIP_MEMORY_SCOPE_AGENT);
        __syncthreads();
        const int u = *uslot;
        if (u >= nunits) { if (wdone < nwp) { const size_t wo = (size_t)(2 * lq + 1) * NEXP * DM * DM; wprep_items(C, wdone, nwp, in_ptr(ws, I_MW1) + wo, in_ptr(ws, I_MW3) + wo, in_ptr(ws, I_MW2) + wo, (bf16*)(ws + WS_W13), (bf16*)(ws + WS_W2)); } break; }
        const bool isctx = u >= 1024;
        const int bh = isctx ? u - 1024 : (u >> 4), b = bh >> 3, hh = bh & 7;
        for (int i = C.tid; i < 15 * 128; i += 512) { const int dc = (i & 127) - 48; tab[i] = (dc >= 0 && dc < 31) ? rpb[hh * 465 + (i >> 7) * 31 + dc] * LOG2E : 0.f; }
        int qpos, row, grow = 0, qc = 0, rs = 0, cs = 0, rlo = 0, nband = 0;
        if (!isctx) { const int rg = u & 15; grow = 4 * rg + (C.wave >> 1); qc = 32 * (C.wave & 1) + r; qpos = grow * 64 + qc; row = b * TL + qpos;
            rs = grow - 4; rs = rs < 0 ? 0 : (rs > 56 ? 56 : rs); cs = qc - 8; cs = cs < 0 ? 0 : (cs > 48 ? 48 : cs);
            rlo = 4 * rg - 4; rlo = rlo < 0 ? 0 : (rlo > 56 ? 56 : rlo); int rhi = 4 * rg + 3 - 4; rhi = rhi < 0 ? 0 : (rhi > 56 ? 56 : rhi); nband = rhi + 8 - rlo; }
        else { qpos = TL + 32 * C.wave + r; row = NLAT + b * LCX + 32 * C.wave + r; }
        const bf16* qp = QN + ((size_t)bh * KPOS + qpos) * 64 + 8 * h;
        bf16x8 qf[4];
#pragma unroll
        for (int kk = 0; kk < 4; ++kk) qf[kk] = *(const bf16x8*)(qp + 16 * kk);
        f32x16 o[2];
#pragma unroll
        for (int i = 0; i < 16; ++i) { o[0][i] = 0.f; o[1][i] = 0.f; }
        float l = 0.f;
        attn_tile_loop<64, true>(C, o, l, qf, KN + (size_t)bh * KPOS * 64, VTN + (size_t)bh * 64 * KPOS, rlo * 64, nband, TL, LCX / 64, tab, grow, rs, qc, cs);
        flash_store(o, l, OCAT + (size_t)row * DM + 512 + hh * 64, h);
    }
}


DI void ph_mla_fin(const Ctx& C, const bf16* U, const bf16* QPRE, const bf16* KVPRE, const float* qg, const float* kg, const f32x2* CS, bf16* QB, bf16* KB, bf16* VT) {
    LAS bf16* VL = (LAS bf16*)C.lds;
    const int lane = C.lane, j = lane >> 3, sub = lane & 7;
    const float C2 = 0.10206207261596575f * LOG2E;
    float qgn[8], qgr[4], kgn[8], kgr[4];
#pragma unroll
    for (int e = 0; e < 8; ++e) { qgn[e] = qg[8 * sub + e] * C2; kgn[e] = kg[8 * sub + e]; }
#pragma unroll
    for (int m = 0; m < 4; ++m) { qgr[m] = qg[64 + sub + 8 * m] * C2; kgr[m] = kg[64 + sub + 8 * m]; }
    for (int u = C.vcu; u < MT / 64; u += C.nb) {
        const int row0 = 64 * u, b = row0 < NLAT ? (row0 >> 12) : ((row0 - NLAT) >> 8), pos0 = row0 < NLAT ? (row0 & 4095) : TL + ((row0 - NLAT) & 255);
        const bool lat = row0 < NLAT;
        const int pl = 8 * C.wave + j, row = row0 + pl, pos = pos0 + pl;
        const bf16* ur = U + (size_t)row * EV_INP;
        float sq = 0.f, skv = 0.f;
#pragma unroll
        for (int m = 0; m < 6; ++m) { float x[8]; unpack8(*(const u32x4*)(ur + 8 * (sub + 8 * m)), x);
#pragma unroll
            for (int e = 0; e < 8; ++e) sq += x[e] * x[e]; }
#pragma unroll
        for (int m = 0; m < 4; ++m) { float x[8]; unpack8(*(const u32x4*)(ur + 384 + 8 * (sub + 8 * m)), x);
#pragma unroll
            for (int e = 0; e < 8; ++e) skv += x[e] * x[e]; }
        sq = sum8(sq); skv = sum8(skv);
        const float rsq = 1.0f / sqrtf(sq * (1.f / 384.f) + EPS), rskv = 1.0f / sqrtf(skv * (1.f / 256.f) + EPS);
        float krv[4];
#pragma unroll
        for (int m = 0; m < 4; ++m) krv[m] = bf2f(ur[640 + sub + 8 * m]);
        float cr = 1.f, sr = 0.f, cc = 1.f, sc = 0.f;
        if (lat) { const f32x2 a0 = CS[pos * 16 + sub], a1 = CS[pos * 16 + 8 + sub]; cr = a0.x; sr = a0.y; cc = a1.x; sc = a1.y; }
        const bf16* qrow = QPRE + (size_t)row * 768; const bf16* kvrow = KVPRE + (size_t)row * 1024;
#pragma unroll 2
        for (int hh = 0; hh < 8; ++hh) {
            { float qn[8], qr[4]; unpack8(*(const u32x4*)(qrow + hh * 96 + 8 * sub), qn); float ss = 0.f;
#pragma unroll
              for (int e = 0; e < 8; ++e) qn[e] *= rsq;
#pragma unroll
              for (int m = 0; m < 4; ++m) { qr[m] = bf2f(qrow[hh * 96 + 64 + sub + 8 * m]) * rsq; ss += qr[m] * qr[m]; }
#pragma unroll
              for (int e = 0; e < 8; ++e) ss += qn[e] * qn[e];
              const float rn = 1.0f / sqrtf(sum8(ss) * (1.f / 96.f) + EPS);
#pragma unroll
              for (int e = 0; e < 8; ++e) qn[e] *= rn * qgn[e];
#pragma unroll
              for (int m = 0; m < 4; ++m) qr[m] *= rn * qgr[m];
              { const float x0 = qr[0], x1 = qr[1], y0 = qr[2], y1 = qr[3]; qr[0] = x0 * cr - x1 * sr; qr[1] = x1 * cr + x0 * sr; qr[2] = y0 * cc - y1 * sc; qr[3] = y1 * cc + y0 * sc; }
              bf16* qo = QB + ((size_t)(b * 8 + hh) * KPOS + pos) * 96;
              *(u32x4*)(qo + 8 * sub) = pack8(qn);
#pragma unroll
              for (int m = 0; m < 4; ++m) qo[64 + sub + 8 * m] = f2bf(qr[m]); }
            { float kn[8], kr[4]; unpack8(*(const u32x4*)(kvrow + hh * 128 + 8 * sub), kn); float ss = 0.f;
#pragma unroll
              for (int e = 0; e < 8; ++e) kn[e] *= rskv;
#pragma unroll
              for (int m = 0; m < 4; ++m) { kr[m] = krv[m]; ss += kr[m] * kr[m]; }
#pragma unroll
              for (int e = 0; e < 8; ++e) ss += kn[e] * kn[e];
              const float rn = 1.0f / sqrtf(sum8(ss) * (1.f / 96.f) + EPS);
#pragma unroll
              for (int e = 0; e < 8; ++e) kn[e] *= rn * kgn[e];
#pragma unroll
              for (int m = 0; m < 4; ++m) kr[m] *= rn * kgr[m];
              { const float x0 = kr[0], x1 = kr[1], y0 = kr[2], y1 = kr[3]; kr[0] = x0 * cr - x1 * sr; kr[1] = x1 * cr + x0 * sr; kr[2] = y0 * cc - y1 * sc; kr[3] = y1 * cc + y0 * sc; }
              bf16* ko = KB + ((size_t)(b * 8 + hh) * KPOS + pos) * 96;
              *(u32x4*)(ko + 8 * sub) = pack8(kn);
#pragma unroll
              for (int m = 0; m < 4; ++m) ko[64 + sub + 8 * m] = f2bf(kr[m]); }
            { float vv[8]; unpack8(*(const u32x4*)(kvrow + hh * 128 + 64 + 8 * sub), vv);
#pragma unroll
              for (int e = 0; e < 8; ++e) VL[(hh * 64 + 8 * sub + e) * 64 + pl] = f2bf(vv[e] * rskv); }
        }
        __syncthreads();
        { const int hd = C.tid;
            bf16* dst = VT + ((size_t)(b * 8 + (hd >> 6)) * 64 + (hd & 63)) * KPOS + pos0;
#pragma unroll
            for (int q = 0; q < 8; ++q) *(u32x4*)(dst + 8 * q) = *(const LAS u32x4*)(VL + hd * 64 + 8 * q); }
        __syncthreads();
    }
}

DI void conv_unit(const Ctx& C, int u, const bf16* U, const float (&wk)[31], float bias, const float* lng, const float* lnb, bf16* OCAT) {
    LAS float* G = (LAS float*)C.lds;
    const int c = C.tid;
    const int row0 = 32 * u; int base, t0, tseq;
    if (row0 < NLAT) { base = row0 & ~4095; t0 = row0 & 4095; tseq = TL; } else { const int rc = row0 - NLAT; base = NLAT + (rc & ~255); t0 = rc & 255; tseq = LCX; }
    __syncthreads();
    for (int rr = C.wave; rr < 62; rr += 8) { const int tt = t0 - 15 + rr; float g[8];
#pragma unroll
        for (int e = 0; e < 8; ++e) g[e] = 0.f;
        if (tt >= 0 && tt < tseq) { const bf16* ur = U + (size_t)(base + tt) * EV_INP; float av[8], gv[8]; unpack8(*(const u32x4*)(ur + 672 + 8 * C.lane), av); unpack8(*(const u32x4*)(ur + 1184 + 8 * C.lane), gv);
#pragma unroll
            for (int e = 0; e < 8; ++e) g[e] = av[e] * sigmoidf_(gv[e]); }
        *(LAS f32x4*)(G + rr * 512 + 8 * C.lane) = (f32x4){g[0], g[1], g[2], g[3]}; *(LAS f32x4*)(G + rr * 512 + 8 * C.lane + 4) = (f32x4){g[4], g[5], g[6], g[7]}; }
    __syncthreads();
    float acc[32];
#pragma unroll
    for (int t = 0; t < 32; ++t) acc[t] = bias;
#pragma unroll
    for (int rr = 0; rr < 62; ++rr) { const float gv = G[rr * 512 + c];
#pragma unroll
        for (int t = 0; t < 32; ++t) { const int k = rr - t; if (k >= 0 && k < 31) acc[t] += gv * wk[k]; } }
    __syncthreads();
#pragma unroll
    for (int t = 0; t < 32; ++t) G[t * 512 + c] = acc[t];
    __syncthreads();
#pragma unroll
    for (int q = 0; q < 4; ++q) {
        const int t = 4 * C.wave + q, row = row0 + t;
        const f32x4 a0 = *(const LAS f32x4*)(G + t * 512 + 8 * C.lane), a1 = *(const LAS f32x4*)(G + t * 512 + 8 * C.lane + 4);
        float x[8] = {a0.x, a0.y, a0.z, a0.w, a1.x, a1.y, a1.z, a1.w}; float s = 0.f;
#pragma unroll
        for (int e = 0; e < 8; ++e) s += x[e];
        const float mu = wave_sum(s) * (1.f / 512.f); float s2 = 0.f;
#pragma unroll
        for (int e = 0; e < 8; ++e) { x[e] -= mu; s2 += x[e] * x[e]; }
        const float rstd = 1.0f / sqrtf(wave_sum(s2) * (1.f / 512.f) + EPS);
        float y[8];
#pragma unroll
        for (int e = 0; e < 8; ++e) { const float z = x[e] * rstd * lng[8 * C.lane + e] + lnb[8 * C.lane + e]; y[e] = siluf_(z); }
        *(u32x4*)(OCAT + (size_t)row * DM + 512 + 8 * C.lane) = pack8(y);
    }
    __syncthreads();
}
DI void wprep_items(const Ctx& C, int k0, int k1, const float* w1, const float* w3, const float* w2, bf16* W13, bf16* W2) {
    LAS float* scr = (LAS float*)(C.lds + C.wave * 16640);
    const int gw = C.vcu * 8 + C.wave, ngw = C.nb * 8;
    constexpr int PER = 16 * 16, NIT = NEXP * 3 * PER;
    for (int k = k0; k < k1; ++k) { const int it = gw + k * ngw; if (it >= NIT) break;
        const int e = it / (3 * PER), r = it % (3 * PER), which = r / PER, q = r % PER, kb = q / 16, n0 = (q % 16) * 64;
#if MOE_F8
        if (which == 0)      transpose_item64_f8(w1 + (size_t)e * DM * DM, DM, DM, (unsigned char*)W13 + (size_t)e * 2048 * DM, (n0 >> 7) * 256 + (n0 & 127), scr, kb * 64, n0, C.lane);
        else if (which == 1) transpose_item64_f8(w3 + (size_t)e * DM * DM, DM, DM, (unsigned char*)W13 + (size_t)e * 2048 * DM, (n0 >> 7) * 256 + (n0 & 127) + 128, scr, kb * 64, n0, C.lane);
        else                 transpose_item64_f8(w2 + (size_t)e * DM * DM, DM, DM, (unsigned char*)W2 + (size_t)e * DM * DM, n0, scr, kb * 64, n0, C.lane); }
#else
        if (which == 0)      transpose_item64(w1 + (size_t)e * DM * DM, DM, DM, W13 + (size_t)e * 2048 * DM, (n0 >> 7) * 256 + (n0 & 127), scr, kb * 64, n0, C.lane);
        else if (which == 1) transpose_item64(w3 + (size_t)e * DM * DM, DM, DM, W13 + (size_t)e * 2048 * DM, (n0 >> 7) * 256 + (n0 & 127) + 128, scr, kb * 64, n0, C.lane);
        else                 transpose_item64(w2 + (size_t)e * DM * DM, DM, DM, W2 + (size_t)e * DM * DM, n0, scr, kb * 64, n0, C.lane); }
#endif
}
constexpr int WPREP_PER_WAVE = (NEXP * 3 * 256 + 2047) / 2048;

DI void shifted8(const bf16* up, const bf16* uc, const bf16* un, bool hp, bool hn, const float (&s0)[8], const float (&s1)[8], const float (&s2)[8], int c0, float (&o)[8]) {
    const u32x4 z = {0u, 0u, 0u, 0u};
    const u32x4 vp = hp ? *(const u32x4*)(up + c0) : z, vc = *(const u32x4*)(uc + c0), vn = hn ? *(const u32x4*)(un + c0) : z;
    float p[8], c[8], n[8]; unpack8(vp, p); unpack8(vc, c); unpack8(vn, n);
#pragma unroll
    for (int e = 0; e < 8; ++e) o[e] = p[e] * s0[e] + c[e] * s1[e] + n[e] * s2[e];
}
DI void load_sw(const float* sw, int c0, float (&s0)[8], float (&s1)[8], float (&s2)[8]) {
#pragma unroll
    for (int e = 0; e < 8; ++e) { s0[e] = sw[c0 + e]; s1[e] = sw[RW_IN + c0 + e]; s2[e] = sw[2 * RW_IN + c0 + e]; }
}
DI void ph_prep(const Ctx& C, const bf16* U, const float* sw  , const float* kkw  , const float* naqg, const float* nakg,
                bf16* R, bf16* V, bf16* K, bf16* KK, bf16* L, bf16* QN, bf16* KN, bf16* VTN) {
    LAS bf16* VL = (LAS bf16*)C.lds;
    const int lane = C.lane, hh = lane >> 3, sub = lane & 7;
    const float C2 = 0.125f * LOG2E;
    for (int u = C.vcu; u < MT / 32; u += C.nb) {
        const int row0 = 32 * u; const bool lat = row0 < NLAT;
        const int b = lat ? (row0 >> 12) : ((row0 - NLAT) >> 8), pos0 = lat ? (row0 & 4095) : TL + ((row0 - NLAT) & 255), tseq = lat ? TL : LCX, tb = lat ? (row0 & 4095) : ((row0 - NLAT) & 255);
#define PREP_ROWVARS(i) const int pl = 4 * C.wave + (i), row = row0 + pl, t = tb + pl; const bool hp = t > 0, hn = t < tseq - 1; \
            const bf16* uc = U + (size_t)row * OD_INP; const bf16* up = uc - OD_INP; const bf16* un = uc + OD_INP
        { float s0[8], s1[8], s2[8]; load_sw(sw, 8 * lane, s0, s1, s2);
          for (int i = 0; i < 4; ++i) { PREP_ROWVARS(i); float o[8]; shifted8(up, uc, un, hp, hn, s0, s1, s2, 8 * lane, o); *(u32x4*)(R + (size_t)row * 512 + 8 * lane) = pack8(o); } }
        { float s0[8], s1[8], s2[8]; load_sw(sw, 1024 + 8 * lane, s0, s1, s2);
          for (int i = 0; i < 4; ++i) { PREP_ROWVARS(i); float o[8]; shifted8(up, uc, un, hp, hn, s0, s1, s2, 1024 + 8 * lane, o); *(u32x4*)(V + (size_t)row * 512 + 8 * lane) = pack8(o); } }
        { float s0[8], s1[8], s2[8]; load_sw(sw, 512 + 8 * lane, s0, s1, s2); float kw[8];
#pragma unroll
          for (int e = 0; e < 8; ++e) kw[e] = kkw[8 * lane + e];
          for (int i = 0; i < 4; ++i) { PREP_ROWVARS(i); float o[8]; shifted8(up, uc, un, hp, hn, s0, s1, s2, 512 + 8 * lane, o); *(u32x4*)(K + (size_t)row * 512 + 8 * lane) = pack8(o);
              float kk[8]; float ss = 0.f;
#pragma unroll
              for (int e = 0; e < 8; ++e) { kk[e] = o[e] * kw[e]; ss += kk[e] * kk[e]; }
              ss = sum8(ss); const float rn = 1.0f / sqrtf(ss + 1e-12f);
#pragma unroll
              for (int e = 0; e < 8; ++e) kk[e] *= rn;
              *(u32x4*)(KK + (size_t)row * 512 + 8 * lane) = pack8(kk); } }
        if (lane < 48) { float s0[8], s1[8], s2[8]; load_sw(sw, 1536 + 8 * lane, s0, s1, s2);
          for (int i = 0; i < 4; ++i) { PREP_ROWVARS(i); float o[8]; shifted8(up, uc, un, hp, hn, s0, s1, s2, 1536 + 8 * lane, o);
              if (lane < 16) {
#pragma unroll
                  for (int e = 0; e < 8; ++e) { const float ex = __expf(2.f * o[e]); o[e] = 1.f - 2.f * __builtin_amdgcn_rcpf(ex + 1.f); }
              } else if (lane >= 32) {
#pragma unroll
                  for (int e = 0; e < 8; ++e) o[e] = sigmoidf_(o[e]);
              }
              *(u32x4*)(L + (size_t)row * 384 + 8 * lane) = pack8(o); } }
        { float gq[8], gk[8];
#pragma unroll
          for (int e = 0; e < 8; ++e) { gq[e] = naqg[8 * sub + e] * C2; gk[e] = nakg[8 * sub + e]; }
          for (int i = 0; i < 4; ++i) { const int pl = 4 * C.wave + i, row = row0 + pl, pos = pos0 + pl; const bf16* uc = U + (size_t)row * OD_INP;
            { float x[8]; unpack8(*(const u32x4*)(uc + RW_IN + 8 * lane), x); float ss = 0.f;
#pragma unroll
                for (int e = 0; e < 8; ++e) ss += x[e] * x[e];
                ss = sum8(ss); const float rn = 1.0f / sqrtf(ss * (1.f / 64.f) + EPS);
#pragma unroll
                for (int e = 0; e < 8; ++e) x[e] = x[e] * rn * gq[e];
                *(u32x4*)(QN + ((size_t)(b * 8 + hh) * KPOS + pos) * 64 + 8 * sub) = pack8(x); }
            { float x[8]; unpack8(*(const u32x4*)(uc + RW_IN + 512 + 8 * lane), x); float ss = 0.f;
#pragma unroll
                for (int e = 0; e < 8; ++e) ss += x[e] * x[e];
                ss = sum8(ss); const float rn = 1.0f / sqrtf(ss * (1.f / 64.f) + EPS);
#pragma unroll
                for (int e = 0; e < 8; ++e) x[e] = x[e] * rn * gk[e];
                *(u32x4*)(KN + ((size_t)(b * 8 + hh) * KPOS + pos) * 64 + 8 * sub) = pack8(x); }
            { const u32x4 vv = *(const u32x4*)(uc + RW_IN + 1024 + 8 * lane); const unsigned w4[4] = {vv.x, vv.y, vv.z, vv.w};
#pragma unroll
                for (int e = 0; e < 8; ++e) { const int dv = 8 * sub + e; VL[(hh * 64 + dv) * 32 + pl] = (bf16)((e & 1) ? (w4[e >> 1] >> 16) : (w4[e >> 1] & 0xffffu)); } } } }
#undef PREP_ROWVARS
        __syncthreads();
        { const int hd = C.tid; bf16* dst = VTN + ((size_t)(b * 8 + (hd >> 6)) * 64 + (hd & 63)) * KPOS + pos0;
#pragma unroll
            for (int q = 0; q < 4; ++q) *(u32x4*)(dst + 8 * q) = *(const LAS u32x4*)(VL + hd * 32 + 8 * q); }
        __syncthreads();
    }
}

DI int scan_row(int s, int d, int b) { if (s < LCX) return NLAT + b * LCX + (d ? (LCX - 1 - s) : s); const int t = s - LCX; return b * TL + (d ? (TL - 1 - t) : t); }


constexpr int CCH = 16, NCHK = KPOS / CCH, NPROB = NB * 8 * 2 * NCHK, IMG_ELEMS = 3 * 32 * 16;
template <int N> struct ICk { static constexpr int value = N; };
DI int crow_(int reg, int h) { return (reg & 3) + 8 * (reg >> 2) + 4 * h; }
DI bf16x8 pack_lo8(const f32x16& x) {
    u32x4 p; p.x = pk2(x[0], x[1]); p.y = pk2(x[2], x[3]); p.z = pk2(x[4], x[5]); p.w = pk2(x[6], x[7]); return __builtin_bit_cast(bf16x8, p); }
DI bf16x8 pack_hi8(const f32x16& x) { u32x4 p; p.x = pk2(x[8], x[9]); p.y = pk2(x[10], x[11]); p.z = pk2(x[12], x[13]); p.w = pk2(x[14], x[15]); return __builtin_bit_cast(bf16x8, p); }
DI int perm16(int k) { return (k & ~15) | swap23(k & 15); }

DI void ph_wkv_pre(const Ctx& C, const bf16* R, const bf16* K, const bf16* KK, const float* LW, const bf16* AR_, const float* ka, bf16* IMG) {
    LAS unsigned char* wl = C.lds + C.wave * 13312;
    LAS bf16* ARl = (LAS bf16*)wl; LAS bf16* BKl = (LAS bf16*)(wl + 4608); LAS float* Ll = (LAS float*)(wl + 9216); LAS bf16* OUT = (LAS bf16*)(wl + 10240);
    const int lane = C.lane, r = lane & 31, h = lane >> 5;
    const int gw = C.vcu * 8 + C.wave, ngw = C.nb * 8;
    for (int p = gw; p < NPROB; p += ngw) {
        const int j = p % NCHK, rest = p / NCHK, d = rest & 1, hh = (rest >> 1) & 7, b = rest >> 4;
        const float* Wd = LW + (size_t)d * MT * 512; const bf16* Ad = AR_ + (size_t)d * MT * 512;
        const float kav = ka[hh * 64 + lane];
        const int row0 = scan_row(j * CCH, d, b), sg = d ? -1 : 1;
        float lw[16]; bf16 rr[16], kx[16], kkx[16], ax[16];
#pragma unroll
        for (int t = 0; t < 16; ++t) { const size_t off = (size_t)(row0 + sg * t) * 512 + hh * 64 + lane; lw[t] = Wd[off]; rr[t] = R[off]; kx[t] = K[off]; kkx[t] = KK[off]; ax[t] = Ad[off]; }
        float cum = 0.f, e0 = 1.f;
#pragma unroll
        for (int t = 0; t < 16; ++t) {
            cum += lw[t]; const float e1 = __expf(cum), ei = __builtin_amdgcn_rcpf(e1);
            const float kkv = bf2f(kkx[t]), av = bf2f(ax[t]), keff = bf2f(kx[t]) * (1.f + (av - 1.f) * kav);
            ARl[t * 72 + lane] = f2bf(-kkv * e0); ARl[(16 + t) * 72 + lane] = f2bf(bf2f(rr[t]) * e1);
            BKl[t * 72 + lane] = f2bf(kkv * av * ei); BKl[(16 + t) * 72 + lane] = f2bf(keff * ei);
            e0 = e1;
        }
        asm volatile("s_waitcnt lgkmcnt(0)" ::: "memory");
        f32x16 g;
#pragma unroll
        for (int i = 0; i < 16; ++i) g[i] = 0.f;
#pragma unroll
        for (int q = 0; q < 4; ++q) g = MFMA32(*(const LAS bf16x8*)(ARl + r * 72 + 16 * q + 8 * h), *(const LAS bf16x8*)(BKl + r * 72 + 16 * q + 8 * h), g);
        const int sI = r & 15; const bool isk = r >= 16;
#pragma unroll
        for (int i = 0; i < 16; ++i) {
            const int row = crow_(i, h), t = row & 15; const bool keep = (i < 8) ? (sI < t) : (sI <= t); const float val = keep ? g[i] : 0.f;
            if (i < 8) { if (!isk) { Ll[t * 16 + sI] = val; OUT[512 + row * 16 + perm16(sI)] = 0; } else OUT[row * 16 + sI] = f2bf(val); }
            else       { if (!isk) OUT[512 + row * 16 + perm16(sI)] = f2bf(val); else OUT[row * 16 + sI] = f2bf(val); }
        }
        asm volatile("s_waitcnt lgkmcnt(0)" ::: "memory");
        { const int c = lane & 15; float Pr[16];
            Pr[0] = (c == 0) ? 1.f : 0.f;
#pragma unroll
            for (int t = 1; t < 16; ++t) { const float lrow = Ll[t * 16 + c]; float acc = (c == t) ? 1.f : 0.f;
#pragma unroll
                for (int u = 0; u < t; ++u) acc += rdlane(lrow, u) * Pr[u];
                Pr[t] = acc; }
            if (lane < 16) {
#pragma unroll
                for (int t = 0; t < 16; ++t) { OUT[1024 + t * 16 + perm16(c)] = f2bf(Pr[t]); OUT[1024 + (16 + t) * 16 + c] = 0; } } }
        asm volatile("s_waitcnt lgkmcnt(0)" ::: "memory");
        { bf16* dst = IMG + (size_t)p * IMG_ELEMS;
#pragma unroll
            for (int q = 0; q < 3; ++q) *(u32x4*)(dst + (q * 64 + lane) * 8) = *(const LAS u32x4*)(OUT + (q * 64 + lane) * 8); }
        asm volatile("s_waitcnt lgkmcnt(0)" ::: "memory");
    }
}

DI void ph_wkv_chunk(const Ctx& C, const bf16* R, const bf16* V, const bf16* K, const bf16* KK, const float* LW, const bf16* AR_, const float* ka, const bf16* IMG, bf16* YS) {
    constexpr int S_AR = 0, S_BKT = 4608, S_VT = 9728, S_VT2 = 11264, S_GC = 12800, S_MM = 13056, S_MRB = 14592, S_PP = 16128, SLOT = 17664, CUMO = 2 * SLOT, YSTO = CUMO + 8192, DEPTH = 4;
    const int lane = C.lane, wv = C.wave, r = lane & 31, h = lane >> 5;
    const bool isE = wv == 2 || wv == 3 || wv == 6 || wv == 7, isS = wv < 2;
    const int te = (wv == 2 ? 0 : (wv == 3 ? 1 : (wv == 6 ? 2 : 3))) * 64 + lane, et = te >> 4, ekq = te & 15;
    const int vhf = te >> 7, vt = (te >> 3) & 15, viq = te & 7;
    const int hf = wv & 1;
    for (int cid0 = C.bid; cid0 < 128; cid0 += C.nb) {
        const int chain = cid0, b = chain >> 4, hh = (chain >> 1) & 7, d = chain & 1;
        const float* Wd = LW + (size_t)d * MT * 512; const bf16* Ad = AR_ + (size_t)d * MT * 512; bf16* Yd = YS + (size_t)d * MT * 512;
        const bf16* img = IMG + (size_t)(((b * 8 + hh) * 2 + d) * NCHK) * IMG_ELEMS;
        f32x16 ST[2];
#pragma unroll
        for (int i = 0; i < 16; ++i) { ST[0][i] = 0.f; ST[1][i] = 0.f; }
        const f32x4 kav = *(const f32x4*)(ka + hh * 64 + 4 * ekq);
        unsigned ring[DEPTH][16];
        __syncthreads();
        auto issue = [&](int ch, unsigned (&rg)[16]) __attribute__((always_inline)) {
            if (ch < 0 || ch >= NCHK) return;
            const int row0 = scan_row(ch * CCH, d, b), sg = d ? -1 : 1;
            if (isE) {
                const size_t off = (size_t)(row0 + sg * et) * 512 + hh * 64 + 4 * ekq;
                const u32x2 x0 = *(const u32x2*)(R + off), x1 = *(const u32x2*)(K + off), x2 = *(const u32x2*)(KK + off), x3 = *(const u32x2*)(Ad + off);
                const u32x2 x4 = *(const u32x2*)(V + (size_t)(row0 + sg * vt) * 512 + hh * 64 + 32 * vhf + 4 * viq);
                rg[0] = x0.x; rg[1] = x0.y; rg[2] = x1.x; rg[3] = x1.y; rg[4] = x2.x; rg[5] = x2.y; rg[6] = x3.x; rg[7] = x3.y; rg[8] = x4.x; rg[9] = x4.y;
                asm volatile("; wkv issue role E" ::);
            } else if (wv == 4) {
#define W5_(t) rg[(t)] = __builtin_bit_cast(unsigned, Wd[(size_t)(row0 + sg * (t)) * 512 + hh * 64 + lane])
                W5_(0); W5_(1); W5_(2); W5_(3); W5_(4); W5_(5); W5_(6); W5_(7); W5_(8); W5_(9); W5_(10); W5_(11); W5_(12); W5_(13); W5_(14); W5_(15);
#undef W5_
                asm volatile("; wkv issue role C" ::);
            } else if (wv == 5) {
#define W6_(q) do { const u32x4 x = *(const u32x4*)(img + (size_t)ch * IMG_ELEMS + ((q) * 64 + lane) * 8); rg[4 * (q)] = x.x; rg[4 * (q) + 1] = x.y; rg[4 * (q) + 2] = x.z; rg[4 * (q) + 3] = x.w; } while (0)
                W6_(0); W6_(1); W6_(2);
#undef W6_
                asm volatile("; wkv issue role V" ::);
            }
        };
        issue(0, ring[0]); issue(1, ring[1]); issue(2, ring[2]); issue(3, ring[3]);
#define WKV_BAR() asm volatile("s_waitcnt lgkmcnt(0)\n\ts_barrier" ::: "memory")
#define WKV_LOOP(...) for (int n0 = -2; n0 < NCHK; n0 += DEPTH) { auto iter = [&](auto kc) __attribute__((always_inline)) { constexpr int kk = decltype(kc)::value; \
            constexpr int riE = (kk + 3) % DEPTH, riW = kk % DEPTH; (void)riE; (void)riW; const int n = n0 + kk; (void)n; __VA_ARGS__; WKV_BAR(); }; iter(ICk<0>{}); iter(ICk<1>{}); iter(ICk<2>{}); iter(ICk<3>{}); }
        if (isS) {
            WKV_LOOP({
                if (n >= 0 && n < NCHK) {
                    const LAS unsigned char* B = C.lds + (n & 1) * SLOT;
                    f32x16 T1;
                    _Pragma("unroll") for (int i = 0; i < 16; ++i) T1[i] = 0.f;
                    _Pragma("unroll") for (int tau = 0; tau < 2; ++tau) {
                        T1 = MFMA32(*(const LAS bf16x8*)(B + S_AR + r * 144 + (32 * tau + 8 * h) * 2), pack_lo8(ST[tau]), T1);
                        T1 = MFMA32(*(const LAS bf16x8*)(B + S_AR + r * 144 + (32 * tau + 16 + 8 * h) * 2), pack_hi8(ST[tau]), T1);
                    }
                    const bf16x8 vtf = *(const LAS bf16x8*)(B + (hf ? S_VT2 : S_VT) + r * 48 + 16 * h);
                    T1 = MFMA32(*(const LAS bf16x8*)(B + S_MM + r * 48 + 16 * h), vtf, T1);
                    f32x16 ET;
                    _Pragma("unroll") for (int i = 0; i < 16; ++i) ET[i] = 0.f;
                    ET = MFMA32(*(const LAS bf16x8*)(B + S_PP + r * 48 + 16 * h), pack_lo8(T1), ET);
                    const bf16x8 ef = pack_lo8(ET);
                    T1 = MFMA32(*(const LAS bf16x8*)(B + S_MRB + r * 48 + 16 * h), ef, T1);
                    _Pragma("unroll") for (int tau = 0; tau < 2; ++tau) {
                        ST[tau] = MFMA32(*(const LAS bf16x8*)(B + S_BKT + (32 * tau + r) * 80 + 16 * h), ef, ST[tau]);
                        ST[tau] = MFMA32(*(const LAS bf16x8*)(B + S_BKT + (32 * tau + r) * 80 + 32 + 16 * h), vtf, ST[tau]);
                        _Pragma("unroll") for (int g4 = 0; g4 < 4; ++g4) { const f32x4 gc = *(const LAS f32x4*)(B + S_GC + (32 * tau + 8 * g4 + 4 * h) * 4);
                            ST[tau][4 * g4] *= gc.x; ST[tau][4 * g4 + 1] *= gc.y; ST[tau][4 * g4 + 2] *= gc.z; ST[tau][4 * g4 + 3] *= gc.w; }
                    }
                    LAS float* ys = (LAS float*)(C.lds + YSTO) + ((n & 1) * 2 + hf) * 512;
                    _Pragma("unroll") for (int q = 0; q < 8; ++q) ys[(8 * (q >> 2) + 4 * h + (q & 3)) * 32 + r] = T1[8 + q];
                }
            });
        } else if (isE) {
            WKV_LOOP({
                const int ch = n + 1;
                if (ch >= 0) {
                    if (ch < NCHK) {
                        LAS unsigned char* B = C.lds + (ch & 1) * SLOT; const LAS float* ec = (const LAS float*)(C.lds + CUMO) + (ch & 1) * 1024;
                        const f32x4 e1 = *(const LAS f32x4*)(ec + et * 64 + 4 * ekq);
                        f32x4 e0 = {1.f, 1.f, 1.f, 1.f}; if (et > 0) e0 = *(const LAS f32x4*)(ec + (et - 1) * 64 + 4 * ekq);
                        const float rv[4] = {bflo(ring[riE][0]), bfhi(ring[riE][0]), bflo(ring[riE][1]), bfhi(ring[riE][1])}; const float kv[4] = {bflo(ring[riE][2]), bfhi(ring[riE][2]), bflo(ring[riE][3]), bfhi(ring[riE][3])};
                        const float kkv[4] = {bflo(ring[riE][4]), bfhi(ring[riE][4]), bflo(ring[riE][5]), bfhi(ring[riE][5])}; const float av[4] = {bflo(ring[riE][6]), bfhi(ring[riE][6]), bflo(ring[riE][7]), bfhi(ring[riE][7])};
                        float ah[4]; float rh[4]; float bc[4]; float kc4[4];
                        _Pragma("unroll") for (int e = 0; e < 4; ++e) { const float ei = __builtin_amdgcn_rcpf(e1[e]);
                            ah[e] = -kkv[e] * e0[e]; rh[e] = rv[e] * e1[e]; bc[e] = kkv[e] * av[e] * ei; kc4[e] = kv[e] * (1.f + (av[e] - 1.f) * kav[e]) * ei; }
                        const int pk = perm16(4 * ekq);
                        *(LAS u32x2*)((LAS bf16*)(B + S_AR) + et * 72 + pk) = (u32x2){pk2(ah[0], ah[1]), pk2(ah[2], ah[3])};
                        *(LAS u32x2*)((LAS bf16*)(B + S_AR) + (16 + et) * 72 + pk) = (u32x2){pk2(rh[0], rh[1]), pk2(rh[2], rh[3])};
                        const int pt = perm16(et);
                        _Pragma("unroll") for (int e = 0; e < 4; ++e) { ((LAS bf16*)(B + S_BKT))[(4 * ekq + e) * 40 + pt] = f2bf(bc[e]); ((LAS bf16*)(B + S_BKT))[(4 * ekq + e) * 40 + 16 + et] = f2bf(kc4[e]); }
                        if (et == 15) *(LAS f32x4*)((LAS float*)(B + S_GC) + 4 * ekq) = e1;
                        LAS bf16* vtp = (LAS bf16*)(B + (vhf ? S_VT2 : S_VT)) + (4 * viq) * 24 + vt;
                        vtp[0] = (bf16)(ring[riE][8] & 0xffffu); vtp[24] = (bf16)(ring[riE][8] >> 16); vtp[48] = (bf16)(ring[riE][9] & 0xffffu); vtp[72] = (bf16)(ring[riE][9] >> 16);
                    }
                    issue(ch + DEPTH, ring[riE]);
                }
            });
        } else if (wv == 4) {
            WKV_LOOP({
                const int ch = n + 2;
                if (ch < NCHK) { LAS float* ec = (LAS float*)(C.lds + CUMO) + (ch & 1) * 1024; float c = 0.f;
#define C5_(t) do { c += __builtin_bit_cast(float, ring[riW][(t)]); ec[(t) * 64 + lane] = __expf(c); } while (0)
                    C5_(0); C5_(1); C5_(2); C5_(3); C5_(4); C5_(5); C5_(6); C5_(7); C5_(8); C5_(9); C5_(10); C5_(11); C5_(12); C5_(13); C5_(14); C5_(15);
                }
                issue(ch + DEPTH, ring[riW]);
            });
        } else {
            WKV_LOOP({
                { const int chy = n - 1;
                  if (chy >= 0 && chy < NCHK) { const int yh = lane >> 5, yt = (lane & 31) >> 1, yi = 16 * (lane & 1);
                    const LAS float* ys = (const LAS float*)(C.lds + YSTO) + ((chy & 1) * 2 + yh) * 512 + yt * 32 + yi;
                    bf16* dst = Yd + (size_t)(scan_row(chy * CCH, d, b) + (d ? -1 : 1) * yt) * 512 + hh * 64 + 32 * yh + yi;
                    _Pragma("unroll") for (int q = 0; q < 2; ++q) { const f32x4 a0 = *(const LAS f32x4*)(ys + 8 * q); const f32x4 a1 = *(const LAS f32x4*)(ys + 8 * q + 4);
                        *(u32x4*)(dst + 8 * q) = (u32x4){pk2(a0.x, a0.y), pk2(a0.z, a0.w), pk2(a1.x, a1.y), pk2(a1.z, a1.w)}; } } }
                const int ch = n + 1;
                if (ch >= 0) {
                    if (ch < NCHK) { LAS unsigned char* B = C.lds + (ch & 1) * SLOT;
                        const int irow = lane >> 1; const int ihv = lane & 1;
                        *(LAS u32x4*)(B + S_MM + irow * 48 + ihv * 16) = (u32x4){ring[riE][0], ring[riE][1], ring[riE][2], ring[riE][3]};
                        *(LAS u32x4*)(B + S_MRB + irow * 48 + ihv * 16) = (u32x4){ring[riE][4], ring[riE][5], ring[riE][6], ring[riE][7]};
                        *(LAS u32x4*)(B + S_PP + irow * 48 + ihv * 16) = (u32x4){ring[riE][8], ring[riE][9], ring[riE][10], ring[riE][11]};
                    }
                    issue(ch + DEPTH, ring[riE]);
                }
            });
        }
#undef C5_
#undef WKV_LOOP
#undef WKV_BAR
    }
}

DI void ph_post(const Ctx& C, const bf16* YS, const bf16* R, const bf16* V, const bf16* K, const bf16* A2, const float* ka, const bf16* G, const float* rk, const float* gng, const float* gnb, bf16* OCAT, bool last) {
    const int gw = C.bid * 8 + C.wave, ngw = C.nb * 8, lane = C.lane, nrows = last ? NLAT : MT;
    for (int row = gw; row < nrows; row += ngw) {
        const size_t o = (size_t)row * 512 + 8 * lane;
        float y[8], y1[8]; unpack8(*(const u32x4*)(YS + o), y); unpack8(*(const u32x4*)(YS + (size_t)MT * 512 + o), y1);
#pragma unroll
        for (int e = 0; e < 8; ++e) y[e] += y1[e];
        float r[8], v[8], kx[8], a0[8], a1[8], g[8];
        unpack8(*(const u32x4*)(R + o), r); unpack8(*(const u32x4*)(V + o), v); unpack8(*(const u32x4*)(K + o), kx); unpack8(*(const u32x4*)(A2 + o), a0); unpack8(*(const u32x4*)(A2 + (size_t)MT * 512 + o), a1); unpack8(*(const u32x4*)(G + o), g);
        float bsum = 0.f;
#pragma unroll
        for (int e = 0; e < 8; ++e) { const float kae = ka[8 * lane + e]; bsum += r[e] * (kx[e] * (1.f + (a0[e] - 1.f) * kae) + kx[e] * (1.f + (a1[e] - 1.f) * kae)) * rk[8 * lane + e]; }
        bsum = sum8(bsum);
        float s = 0.f;
#pragma unroll
        for (int e = 0; e < 8; ++e) { y[e] += bsum * v[e]; s += y[e]; }
        const float mu = sum8(s) * (1.f / 64.f); float s2 = 0.f;
#pragma unroll
        for (int e = 0; e < 8; ++e) { y[e] -= mu; s2 += y[e] * y[e]; }
        const float rstd = 1.0f / sqrtf(sum8(s2) * (1.f / 64.f) + GN_EPS);
        float out[8];
#pragma unroll
        for (int e = 0; e < 8; ++e) out[e] = (y[e] * rstd * gng[8 * lane + e] + gnb[8 * lane + e]) * g[e];
        *(u32x4*)(OCAT + (size_t)row * DM + 8 * lane) = pack8(out);
    }
}

DI void ph_topk2(const Ctx& C, const float* AFFT, const float* AFFC, int* ROWS, float* GATE, int* SLOT, bool last) {
    LAS unsigned* wcnt = (LAS unsigned*)C.lds;
    LAS unsigned* cnt = wcnt + 16;
    const int tid = C.tid, nprob = last ? 128 : 256;
    for (int p = C.bid; p < nprob; p += C.nb) {
        const bool isctx = p >= 128; const int be = p & 127, b = be >> 4, e = be & 15;
        const int n = isctx ? LCX : TL, cap = isctx ? CAPC : CAPL;
        const float* src = isctx ? AFFC + (size_t)be * LCX : AFFT + (size_t)be * TL;
        unsigned v[8]; const int per = isctx ? 1 : 8, t0 = tid * per;
#pragma unroll
        for (int q = 0; q < 8; ++q) v[q] = 0u;
        if (!isctx) { const u32x4 a0 = *(const u32x4*)(src + t0), a1 = *(const u32x4*)(src + t0 + 4); v[0] = a0.x; v[1] = a0.y; v[2] = a0.z; v[3] = a0.w; v[4] = a1.x; v[5] = a1.y; v[6] = a1.z; v[7] = a1.w; }
        else if (tid < LCX) v[0] = __builtin_bit_cast(unsigned, src[tid]);
        __syncthreads();
        unsigned T = 0u;
        for (int bit = 30; bit >= 0; --bit) {
            const unsigned cand = T | (1u << bit); unsigned c = 0u;
#pragma unroll
            for (int q = 0; q < 8; ++q) c += (unsigned)__builtin_popcountll(__builtin_amdgcn_ballot_w64(v[q] >= cand));
            LAS unsigned* wc = wcnt + (bit & 1) * 8;
            if (C.lane == 0) wc[C.wave] = c;
            __syncthreads();
            const unsigned tot = wc[0] + wc[1] + wc[2] + wc[3] + wc[4] + wc[5] + wc[6] + wc[7];
            if (tot >= (unsigned)cap) T = cand;
        }
        unsigned myc = 0u;
#pragma unroll
        for (int q = 0; q < 8; ++q) myc += (v[q] > T ? 0x10000u : 0u) + ((v[q] == T && (isctx ? (q == 0 && tid < LCX) : true)) ? 1u : 0u);
        __syncthreads();
        cnt[tid] = myc;
        __syncthreads();
        for (int off = 1; off < 512; off <<= 1) { const unsigned add = tid >= off ? cnt[tid - off] : 0u; __syncthreads(); cnt[tid] += add; __syncthreads(); }
        const unsigned total = cnt[511], keq = (unsigned)cap - (total >> 16);
        unsigned before = cnt[tid] - myc;
        for (int q = 0; q < per; ++q) { const int t = t0 + q; if (t >= n) break; const unsigned x = v[q]; const unsigned gtb = before >> 16, eqb = before & 0xFFFFu;
            const bool sel = x > T || (x == T && eqb < keq);
            if (sel) { const int jx = (int)(gtb + (eqb < keq ? eqb : keq));
                const int slot = isctx ? NB * CAPL + b * CAPC + jx : b * CAPL + jx, row = isctx ? NLAT + b * LCX + t : b * TL + t;
                ROWS[e * ESLOTS + slot] = row; GATE[e * ESLOTS + slot] = __builtin_bit_cast(float, x); SLOT[(size_t)row * 16 + e] = slot; }
            before += (x > T ? 0x10000u : 0u) + (x == T ? 1u : 0u); }
        __syncthreads();
    }
}


DI void ph_combine(const Ctx& C, float* xlat, float* xctx, const float* modg2  , const int* SLOT, const bf16* Y2, bool last,
                   const float* ngain  , const float* nmod  , bf16* H) {
    const int gw = C.bid * 8 + C.wave, ngw = C.nb * 8, lane = C.lane, nrows = last ? NLAT : MT;
    for (int row = gw; row < nrows; row += ngw) {
        float* xr = row < NLAT ? xlat + (size_t)row * DM : xctx + (size_t)(row - NLAT) * DM;
        const int mi = row < NLAT ? (row >> 12) : 8;
        const int sv = SLOT[(size_t)row * 16 + (lane & 15)];
        f32x4 acc[4];
#pragma unroll
        for (int j = 0; j < 4; ++j) acc[j] = (f32x4){0.f, 0.f, 0.f, 0.f};
#pragma unroll
        for (int e = 0; e < 16; ++e) {
            const int s = __builtin_amdgcn_readlane(sv, e);
            if (s >= 0) { const bf16* yp = Y2 + ((size_t)e * ESLOTS + s) * DM + 4 * lane;
#pragma unroll
                for (int j = 0; j < 4; ++j) { const u32x2 w = *(const u32x2*)(yp + 256 * j); acc[j] += (f32x4){bflo(w.x), bfhi(w.x), bflo(w.y), bfhi(w.y)}; } }
        }
#pragma unroll
        for (int j = 0; j < 4; ++j) { const int c = 256 * j + 4 * lane; const f32x4 g = *(const f32x4*)(modg2 + mi * 6144 + c); f32x4 x = *(const f32x4*)(xr + c); x += g * acc[j]; *(f32x4*)(xr + c) = x; acc[j] = x; }
        if (ngain) {
            float ss = 0.f;
#pragma unroll
            for (int j = 0; j < 4; ++j) ss += acc[j].x * acc[j].x + acc[j].y * acc[j].y + acc[j].z * acc[j].z + acc[j].w * acc[j].w;
            const float rs = 1.0f / sqrtf(wave_sum(ss) * (1.f / 1024.f) + EPS);
            const float* mp = nmod + mi * 6144;
#pragma unroll
            for (int j = 0; j < 4; ++j) { const int c = 256 * j + 4 * lane;
                const f32x4 g = *(const f32x4*)(ngain + c), sc = *(const f32x4*)(mp + 1024 + c), sh = *(const f32x4*)(mp + c);
                const f32x4 hv = (acc[j] * rs) * g * (sc + 1.0f) + sh;
                *(u32x2*)(H + (size_t)row * DM + c) = (u32x2){pk2(hv.x, hv.y), pk2(hv.z, hv.w)}; }
        }
    }
}

template <int N> struct IC { static constexpr int value = N; };
DI const float* in_ptr(const unsigned char* ws, int k) { const unsigned long long v = ((const unsigned long long*)(ws + 128 * 1024))[k];
    const unsigned lo = __builtin_amdgcn_readfirstlane((unsigned)v), hi = __builtin_amdgcn_readfirstlane((unsigned)(v >> 32));
    return (const float*)(__attribute__((address_space(1))) const float*)(((unsigned long long)hi << 32) | lo); }
template <class T> DI T* launder_ptr(T* p) { unsigned long long v = (unsigned long long)p; unsigned lo = (unsigned)v, hi = (unsigned)(v >> 32); asm volatile("" : "+v"(lo), "+v"(hi));
    lo = __builtin_amdgcn_readfirstlane(lo); hi = __builtin_amdgcn_readfirstlane(hi); return (T*)(__attribute__((address_space(1))) T*)(((unsigned long long)hi << 32) | lo); }
constexpr int N_PHASES = 1 + 23 + 22;
constexpr size_t WS_PTRS = 128 * 1024;
#define P_XC    ((float*)(ws + WS_XC))
#define P_MOD   ((const float*)(ws + WS_MOD))
#define P_HB    ((bf16*)(ws + WS_HB))
#define P_OCAT  ((bf16*)(ws + WS_OCAT))
#define P_AR    (ws + WS_ARENA)
#define P_ROWS  ((int*)(ws + WS_ROWS))
#define P_GATE  ((float*)(ws + WS_GATE))
#define P_SLOT  ((int*)(ws + WS_SLOT))
#define P_AFFT  ((float*)(ws + WS_AFFT))
#define P_AFFC  ((float*)(ws + WS_AFFC))
#define P_W13   ((bf16*)(ws + WS_W13))
#define P_W2    ((bf16*)(ws + WS_W2))
#define P_U     ((bf16*)(P_AR + A_U))
#define P_QPRE  ((float*)(P_AR + A_QPRE))
#define P_KVPRE ((float*)(P_AR + A_KVPRE))
#define P_QB    ((bf16*)(P_AR + A_QB))
#define P_KB    ((bf16*)(P_AR + A_KB))
#define P_VT    ((bf16*)(P_AR + A_VT))
#define P_W     ((float*)(P_AR + A_W))
#define P_KEFF  ((bf16*)(P_AR + A_KEFF))
#define P_R     ((bf16*)(P_AR + A_R))
#define P_V     ((bf16*)(P_AR + A_V))
#define P_KK    ((bf16*)(P_AR + A_KK))
#define P_G     ((bf16*)(P_AR + A_G))
#define P_K     ((bf16*)(P_AR + A_K))
#define P_L     ((bf16*)(P_AR + A_L))
#define P_QN    ((bf16*)(P_AR + A_QN))
#define P_KN    ((bf16*)(P_AR + A_KN))
#define P_VTN   ((bf16*)(P_AR + A_VTN))
#define P_YS    ((bf16*)(P_AR + A_YS))
#define P_IMG   ((bf16*)(P_AR + A_IMG))
#define P_HID   ((bf16*)(P_AR + A_HID))
#define P_Y2    ((bf16*)(P_AR + A_Y2))
#define MODL(i) (P_MOD + (size_t)(i) * 9 * 6144)
#if MOE_F8
#define MOE1_PHASE(NMT) do { pg8::Gemm g{P_HB, P_W13, DM / 2, DM / 2, P_ROWS, SCALE_W, SCALE_ONE}; pg8::OrderMoE S{(NMT), 8, 17, C.nb, C.vcu}; pg8::EpiAdapt<EpiGlu8> E{EpiGlu8{(unsigned char*)P_HID}}; \
        pg8::gemm_phase<pg8::EpiAdapt<EpiGlu8>, pg8::OrderMoE, true>(C.lds, g, S, E, C.tid); } while (0)
#define MOE2_PHASE(NMT) do { pg8::Gemm g{P_HID, P_W2, DM / 2, DM / 2, nullptr, SCALE_W, SCALE_HID}; pg8::OrderMoE S{(NMT), 4, 17, C.nb, C.vcu}; pg8::EpiAdapt<EpiGate> E{EpiGate{P_Y2, P_GATE}}; \
        pg8::gemm_phase<pg8::EpiAdapt<EpiGate>, pg8::OrderMoE, true>(C.lds, g, S, E, C.tid); } while (0)
#else
#define MOE1_PHASE(NMT) do { pg8::Gemm g{P_HB, P_W13, DM, DM, P_ROWS}; pg8::OrderMoE S{(NMT), 8, 17, C.nb, C.vcu}; pg8::EpiAdapt<EpiGlu> E{EpiGlu{P_HID}}; pg8::gemm_phase(C.lds, g, S, E, C.tid); } while (0)
#define MOE2_PHASE(NMT) do { pg8::Gemm g{P_HID, P_W2, DM, DM, nullptr}; pg8::OrderMoE S{(NMT), 4, 17, C.nb, C.vcu}; pg8::EpiAdapt<EpiGate> E{EpiGate{P_Y2, P_GATE}}; pg8::gemm_phase(C.lds, g, S, E, C.tid); } while (0)
#endif
#define RELAUNDER() do { int l_ = C.lane; asm volatile("" : "+v"(l_)); C.lane = l_; C.tid = (C.wave << 6) | l_; } while (0)
__global__ void __launch_bounds__(512, 2) fwd_kernel(Args a) {
    extern __shared__ __attribute__((aligned(16))) unsigned char smem[];
    Ctx C0; C0.lds = (LAS unsigned char*)smem; C0.tid = threadIdx.x; C0.lane = C0.tid & 63; C0.wave = __builtin_amdgcn_readfirstlane(C0.tid >> 6); C0.bid = blockIdx.x; C0.nb = gridDim.x;
    C0.vcu = (C0.nb % 8 == 0) ? (C0.bid % 8) * (C0.nb / 8) + C0.bid / 8 : C0.bid;
    volatile LAS unsigned* bst = (volatile LAS unsigned*)(C0.lds + LDS_BYTES - 16);
#if MEGA
    if (C0.tid == 0) { bst[0] = 0u; bst[1] = 0u; }
    __syncthreads();
    const unsigned bar_x = xcd_barrier_post((unsigned*)(a.ws + WS_CTL) + 4096, bst, C0.tid == 0).x;
#define SEAM() do { if (ph < hi) { XcdBarrier b2_; b2_.bar = (unsigned*)(ws + WS_CTL) + 4096; b2_.x = bar_x; b2_.st = bst; xcd_barrier(b2_, C.tid == 0); } } while (0)
#else
#define SEAM() do { } while (0)
#endif
#if MEGA
    constexpr int lo = 0, hi = N_PHASES;
#else
    const int lo = a.ph_lo, hi = a.ph_hi;
#endif
    int ph = 0;
#ifndef ONLY
#define ONLY -1
#endif
#ifndef REPMASK
#define REPMASK 0
#endif
#ifndef SITE_LO
#define SITE_LO 0
#define SITE_HI 99
#endif
#define PHASE(SITE, ...) do { if ((ONLY < 0 || ONLY == (SITE)) && (SITE) >= SITE_LO && (SITE) <= SITE_HI && ph >= lo && ph < hi) { Ctx C; C.lds = C0.lds; \
        { int w_ = C0.wave; asm volatile("" : "+s"(w_)); unsigned m_ = ~0u; asm volatile("" : "+s"(m_)); int l_ = (int)__builtin_amdgcn_mbcnt_hi(m_, __builtin_amdgcn_mbcnt_lo(m_, 0u)); C.wave = w_; C.lane = l_; C.tid = (w_ << 6) | l_; } \
        { int b_ = C0.bid, n_ = C0.nb, v_ = C0.vcu; asm volatile("" : "+s"(b_), "+s"(n_), "+s"(v_)); C.bid = b_; C.nb = n_; C.vcu = v_; } \
        unsigned z_ = 0u; asm volatile("" : "+s"(z_)); unsigned char* ws = a.ws + z_; float* XL = a.out + z_; const int lq = __builtin_amdgcn_readfirstlane(lp); typedef const __attribute__((address_space(1))) float* gfp_t; const gfp_t* INT_ = (const gfp_t*)(ws + WS_PTRS); (void)INT_; (void)XL; (void)lq; \
        for (int rep_ = 0; rep_ < ((((REPMASK) >> (SITE)) & 1) ? 2 : 1); ++rep_) { __VA_ARGS__; if ((((REPMASK) >> (SITE)) & 1)) __syncthreads(); } ++ph; SEAM(); } else ++ph; } while (0)

    { const int lp = 0;
      PHASE(0, { if (C.bid == 0) { _Pragma("unroll") for (int k = 0; k < 40; ++k) if (C.tid == k) ((const float**)(ws + WS_PTRS))[k] = a.in[k]; }
                 ph_prologue(C, a); }); }

    auto layer_pair = [&](auto lpc) __attribute__((always_inline)) {
        constexpr int lp = decltype(lpc)::value;
        if constexpr (lp == 0) PHASE(1, { const int i = 2 * lq; const float* xl = (i == 0) ? in_ptr(ws, I_X) : XL; const float* xc = (i == 0) ? in_ptr(ws, I_CTX) : P_XC;
                   ph_norm<false>(C, xl, xc, in_ptr(ws, I_N1G) + i * DM, MODL(i), 0, 1024, P_HB, nullptr, nullptr, nullptr, nullptr); });
        PHASE(2, { EpiBf16 E{P_U, EV_INP}; fast_gemm(C, P_HB, DM, (const bf16*)(ws + WS_WEVIN) + (size_t)lq * EV_INP * DM, DM, MT / 256, EV_INP / 256, E); });
        PHASE(3, { EpiBf16 Eq{(bf16*)P_QPRE, 768}; fast_gemm(C, P_U, EV_INP, (const bf16*)(ws + WS_WUQ) + (size_t)lq * 768 * 384, 384, MT / 256, 3, Eq); RELAUNDER();
                   EpiBf16 Ek{(bf16*)P_KVPRE, 1024}; fast_gemm(C, P_U + 384, EV_INP, (const bf16*)(ws + WS_WUKV) + (size_t)lq * 1024 * 256, 256, MT / 256, 4, Ek, true); });
        PHASE(4, ph_mla_fin(C, P_U, (const bf16*)P_QPRE, (const bf16*)P_KVPRE, in_ptr(ws, I_QG) + lq * 96, in_ptr(ws, I_KG) + lq * 96, (const f32x2*)(ws + WS_ROPE), P_QB, P_KB, P_VT));
        PHASE(5, ph_attn_mla2(C, P_QB, P_KB, P_VT, P_OCAT, false, ws, lq));
        PHASE(6, { const int i = 2 * lq; const float* xl = (i == 0) ? in_ptr(ws, I_X) : XL; const float* xc = (i == 0) ? in_ptr(ws, I_CTX) : P_XC;
                   EpiResid E{xl, xc, XL, P_XC, MODL(i) + 2048}; fast_gemm(C, P_OCAT, DM, (const bf16*)(ws + WS_WEVOUT) + (size_t)lq * DM * DM, DM, MT / 256, 4, E); });
        PHASE(7, { const int i = 2 * lq; ph_norm<true>(C, XL, P_XC, in_ptr(ws, I_N2G) + i * DM, MODL(i), 3072, 4096, P_HB, in_ptr(ws, I_ROUTER) + (size_t)i * DM * 16, P_AFFT, P_AFFC, P_SLOT); });
        PHASE(8, ph_topk2(C, P_AFFT, P_AFFC, P_ROWS, P_GATE, P_SLOT, false));
        PHASE(9, { MOE1_PHASE(17); });
        PHASE(10, { MOE2_PHASE(17); });
        PHASE(11, { const int i = 2 * lq; ph_combine(C, XL, P_XC, MODL(i) + 5120, P_SLOT, P_Y2, false, in_ptr(ws, I_N1G) + (i + 1) * DM, MODL(i + 1), P_HB); });
        PHASE(13, { EpiBf16 E{P_U, OD_INP}; fast_gemm(C, P_HB, DM, (const bf16*)(ws + WS_WODIN) + (size_t)lq * OD_INP * DM, DM, MT / 256, OD_INP / 256, E); });
        PHASE(14, ph_prep(C, P_U, in_ptr(ws, I_SHIFTW) + (size_t)lq * 3 * RW_IN, in_ptr(ws, I_KKW) + lq * 512, in_ptr(ws, I_NAQG) + lq * 64, in_ptr(ws, I_NAKG) + lq * 64, P_R, P_V, P_K, P_KK, P_L, P_QN, P_KN, P_VTN));
        PHASE(15, { const bf16* WL = (const bf16*)(ws + WS_WLORA) + (size_t)lq * 655360;
                    { EpiLoraW E{P_W, in_ptr(ws, I_W0) + lq * 1024}; fast_gemm(C, P_L, 384, WL, 256, MT / 256, 4, E); } RELAUNDER();
                    { EpiLoraA E{P_KEFF, in_ptr(ws, I_A0) + lq * 1024}; fast_gemm(C, P_L, 384, WL + (size_t)1024 * 256, 256, MT / 256, 4, E, true); } RELAUNDER();
                    { EpiBf16 E{P_G, 512}; fast_gemm(C, P_L + 128, 384, WL + (size_t)2048 * 256, 256, MT / 256, 2, E); } });
        PHASE(16, ph_wkv_pre(C, P_R, P_K, P_KK, P_W, P_KEFF, in_ptr(ws, I_KA) + lq * 512, P_IMG));
        PHASE(17, { ph_wkv_chunk(C, P_R, P_V, P_K, P_KK, P_W, P_KEFF, in_ptr(ws, I_KA) + lq * 512, P_IMG, P_YS); __syncthreads();
                    ph_natten2(C, P_QN, P_KN, P_VTN, P_OCAT, in_ptr(ws, I_RPB) + (size_t)lq * 8 * 465, lq == 1, (unsigned*)(ws + WS_CTL) + 8192 + 64 * lq, ws, lq); });
        PHASE(18, ph_post(C, P_YS, P_R, P_V, P_K, P_KEFF, in_ptr(ws, I_KA) + lq * 512, P_G, in_ptr(ws, I_RK) + lq * 512, in_ptr(ws, I_GNG) + lq * 512, in_ptr(ws, I_GNB) + lq * 512, P_OCAT, lq == 1));
        PHASE(19, { const int i = 2 * lq + 1; EpiResid E{XL, P_XC, XL, P_XC, MODL(i) + 2048};
                    fast_gemm(C, P_OCAT, DM, (const bf16*)(ws + WS_WODOUT) + (size_t)lq * DM * DM, DM, (lq == 1) ? NLAT / 256 : MT / 256, 4, E); });
        PHASE(20, { const int i = 2 * lq + 1; ph_norm<true>(C, XL, P_XC, in_ptr(ws, I_N2G) + i * DM, MODL(i), 3072, 4096, P_HB, in_ptr(ws, I_ROUTER) + (size_t)i * DM * 16, P_AFFT, P_AFFC, P_SLOT); });
        PHASE(21, ph_topk2(C, P_AFFT, P_AFFC, P_ROWS, P_GATE, P_SLOT, lq == 1));
        PHASE(22, { MOE1_PHASE((lq == 1) ? 16 : 17); });
        PHASE(23, { MOE2_PHASE((lq == 1) ? 16 : 17); });
        PHASE(24, { const int i = 2 * lq + 1;
                    if (lp == 0) ph_combine(C, XL, P_XC, MODL(i) + 5120, P_SLOT, P_Y2, false, in_ptr(ws, I_N1G) + (i + 1) * DM, MODL(i + 1), P_HB);
                    else ph_combine(C, XL, P_XC, MODL(i) + 5120, P_SLOT, P_Y2, true, nullptr, nullptr, nullptr); });
    };
    layer_pair(IC<0>{}); layer_pair(IC<1>{});
}

extern "C" void kernel_launch(void* const* d_in, const int* in_sizes, int n_in, void* d_out, int out_size, void* d_ws, size_t ws_size, hipStream_t stream) {
    static int grid = 0;
    if (grid == 0) {
        if (n_in != 40 || out_size != NLAT * DM || ws_size < WS_END) { fprintf(stderr, "kernel_launch: unexpected shapes (n_in %d out %d ws %zu need %zu)\n", n_in, out_size, ws_size, (size_t)WS_END); grid = -1; return; }
        int dev = 0, cus = 0, per_cu = 0;
        if (hipGetDevice(&dev) != hipSuccess || hipDeviceGetAttribute(&cus, hipDeviceAttributeMultiprocessorCount, dev) != hipSuccess) { grid = -1; return; }
        if (hipFuncSetAttribute((const void*)fwd_kernel, hipFuncAttributeMaxDynamicSharedMemorySize, LDS_BYTES) != hipSuccess) { fprintf(stderr, "kernel_launch: hipFuncSetAttribute failed\n"); grid = -1; return; }
        if (hipOccupancyMaxActiveBlocksPerMultiprocessor(&per_cu, (const void*)fwd_kernel, 512, LDS_BYTES) != hipSuccess || per_cu < 1) { fprintf(stderr, "kernel_launch: occupancy query says %d\n", per_cu); per_cu = 1; }
        (void)hipGetLastError();
        grid = cus;
    }
    if (grid < 0) return;
    (void)hipMemsetAsync((char*)d_ws + WS_CTL, 0, CTL_BYTES, stream);
    Args a{};
    for (int i = 0; i < 40; ++i) a.in[i] = (const float*)d_in[i];
    a.out = (float*)d_out; a.ws = (unsigned char*)d_ws;
#if MEGA
    a.ph_lo = 0; a.ph_hi = N_PHASES;
    hipLaunchKernelGGL(fwd_kernel, dim3(grid), dim3(512), LDS_BYTES, stream, a);
#else
    for (int p = 0; p < N_PHASES; ++p) { a.ph_lo = p; a.ph_hi = p + 1; hipLaunchKernelGGL(fwd_kernel, dim3(grid), dim3(512), LDS_BYTES, stream, a); }
#endif
}
```

```cpp
#include <hip/hip_runtime.h>
#include <cstdio>
#include <cstdint>

#ifndef MEGA
#define MEGA 1
#endif

#define LAS __attribute__((address_space(3)))
#define DI __device__ __forceinline__

typedef unsigned short bf16;
typedef short bf16x8 __attribute__((ext_vector_type(8)));
typedef float f32x4 __attribute__((ext_vector_type(4)));
typedef float f32x2 __attribute__((ext_vector_type(2)));
typedef float f32x16 __attribute__((ext_vector_type(16)));
typedef unsigned u32x4 __attribute__((ext_vector_type(4)));
typedef unsigned u32x2 __attribute__((ext_vector_type(2)));
typedef __bf16 bf16x2_t __attribute__((ext_vector_type(2)));

constexpr int DM = 1024, NB = 8, TL = 4096, LCX = 256;
constexpr int NLAT = NB * TL, NCTX = NB * LCX, MT = NLAT + NCTX;
constexpr int KPOS = TL + LCX;
constexpr float EPS = 1e-6f, GN_EPS = 64e-5f;
constexpr int EV_IN = 1696, EV_INP = 1792, OD_IN = 3456, OD_INP = 3584, RW_IN = 1920;
constexpr int NEXP = 16, CAPL = 512, CAPC = 32, ESLOTS = NB * CAPL + NB * CAPC;
constexpr float LOG2E = 1.4426950408889634f;

constexpr size_t MiB = 1ull << 20;
constexpr size_t WS_CTL = 0, CTL_BYTES = 1 * MiB;
constexpr size_t WS_MOD = 1 * MiB, WS_ROPE = 2 * MiB, WS_XC = 4 * MiB;
constexpr size_t WS_ROWS = 12 * MiB, WS_GATE = 12 * MiB + 512 * 1024, WS_SLOT = 13 * MiB, WS_AFFT = 16 * MiB, WS_AFFC = 18 * MiB;
constexpr size_t WS_WEVIN = 20 * MiB, WS_WEVOUT = 27 * MiB, WS_WUQ = 31 * MiB, WS_WUKV = 33 * MiB, WS_WODIN = 34 * MiB, WS_WODOUT = 48 * MiB, WS_WLORA = 52 * MiB;
constexpr size_t WS_W13 = 56 * MiB, WS_W2 = 120 * MiB, WS_HB = 152 * MiB, WS_OCAT = 220 * MiB, WS_ARENA = 288 * MiB;
constexpr size_t A_U = 0, A_QPRE = 119 * MiB, A_KVPRE = 221 * MiB, A_QB = 357 * MiB, A_KB = 408 * MiB, A_VT = 459 * MiB;
constexpr size_t A_W = 0, A_KEFF = 136 * MiB  , A_G = 204 * MiB, A_R = 238 * MiB, A_V = 272 * MiB, A_KK = 306 * MiB, A_K = 340 * MiB, A_L = 374 * MiB,
                 A_QN = 400 * MiB, A_KN = 434 * MiB, A_VTN = 468 * MiB, A_YS = 612 * MiB  ;
constexpr size_t A_HID = 0, A_Y2 = 136 * MiB;
constexpr size_t A_IMG = 510 * MiB;
constexpr size_t WS_END = WS_ARENA + 680 * MiB;
constexpr int LDS_BYTES = 147456;

DI unsigned pk2(float lo, float hi) { f32x2 v = {lo, hi}; bf16x2_t b = __builtin_convertvector(v, bf16x2_t); return __builtin_bit_cast(unsigned, b); }
DI float bflo(unsigned u) { return __builtin_bit_cast(float, u << 16); }
DI float bfhi(unsigned u) { return __builtin_bit_cast(float, u & 0xffff0000u); }
DI float bf2f(bf16 x) { return __builtin_bit_cast(float, ((unsigned)x) << 16); }
DI bf16 f2bf(float f) { return (bf16)(pk2(f, 0.f) & 0xffffu); }
DI void unpack8(u32x4 v, float (&f)[8]) { f[0] = bflo(v.x); f[1] = bfhi(v.x); f[2] = bflo(v.y); f[3] = bfhi(v.y); f[4] = bflo(v.z); f[5] = bfhi(v.z); f[6] = bflo(v.w); f[7] = bfhi(v.w); }
DI u32x4 pack8(const float (&f)[8]) { u32x4 r; r.x = pk2(f[0], f[1]); r.y = pk2(f[2], f[3]); r.z = pk2(f[4], f[5]); r.w = pk2(f[6], f[7]); return r; }
#define DPP_ADD(x, ctrl) ((x) + __builtin_bit_cast(float, __builtin_amdgcn_update_dpp(0, __builtin_bit_cast(int, (x)), (ctrl), 0xf, 0xf, false)))
#define DPP_MAX(x, ctrl) fmaxf((x), __builtin_bit_cast(float, __builtin_amdgcn_update_dpp(0, __builtin_bit_cast(int, (x)), (ctrl), 0xf, 0xf, false)))
DI float sum8(float x) { x = DPP_ADD(x, 0xB1); x = DPP_ADD(x, 0x4E); x = DPP_ADD(x, 0x141); return x; }
DI float sum16(float x) { x = DPP_ADD(x, 0xB1); x = DPP_ADD(x, 0x4E); x = DPP_ADD(x, 0x141); x = DPP_ADD(x, 0x140); return x; }
DI float max16(float x) { x = DPP_MAX(x, 0xB1); x = DPP_MAX(x, 0x4E); x = DPP_MAX(x, 0x141); x = DPP_MAX(x, 0x140); return x; }
DI float rdlane(float x, int l) { return __builtin_bit_cast(float, __builtin_amdgcn_readlane(__builtin_bit_cast(int, x), l)); }
DI float wave_sum(float v) { const float x = sum16(v); return (rdlane(x, 0) + rdlane(x, 16)) + (rdlane(x, 32) + rdlane(x, 48)); }
DI float xor32(float v, int lane) { return __builtin_bit_cast(float, __builtin_amdgcn_ds_bpermute((lane ^ 32) << 2, __builtin_bit_cast(int, v))); }
typedef int v8i_t __attribute__((ext_vector_type(8)));
typedef int i32x4_t __attribute__((ext_vector_type(4)));
DI unsigned pk4_fp8(float a, float b, float c, float d) {
    a = __builtin_amdgcn_fmed3f(a, -448.f, 448.f); b = __builtin_amdgcn_fmed3f(b, -448.f, 448.f); c = __builtin_amdgcn_fmed3f(c, -448.f, 448.f); d = __builtin_amdgcn_fmed3f(d, -448.f, 448.f);
    int p = __builtin_amdgcn_cvt_pk_fp8_f32(a, b, 0, false); p = __builtin_amdgcn_cvt_pk_fp8_f32(c, d, p, true); return (unsigned)p; }
#ifndef MOE_F8
#define MOE_F8 1
#endif
constexpr int SCALE_ONE = 0x7f7f7f7f, SCALE_W = 0x79797979  , SCALE_HID = 0x7c7c7c7c  ;
DI float sigmoidf_(float x) { return __builtin_amdgcn_rcpf(1.f + __expf(-x)); }
DI float siluf_(float x) { return x * __builtin_amdgcn_rcpf(1.f + __expf(-x)); }
#define MFMA32(a, b, c) __builtin_amdgcn_mfma_f32_32x32x16_bf16((a), (b), (c), 0, 0, 0)

#define XB_TMO      128
#define XB_XCNT(j)  (256  + 64 * (j))
#define XB_XSUB(j)  (1280 + 64 * (j))
#define XB_XGEN(j)  (2304 + 64 * (j))
#define XB_TOP      3328
#define XB_TOPGEN   3392
#define XCD_BAR_WORDS 3456
#define XB_SPIN_CAP (1u << 22)
__device__ __forceinline__ unsigned xb_ld(unsigned* p)              { return __hip_atomic_load(p, __ATOMIC_RELAXED, __HIP_MEMORY_SCOPE_AGENT); }
__device__ __forceinline__ unsigned xb_add(unsigned* p, unsigned v) { return __hip_atomic_fetch_add(p, v, __ATOMIC_RELAXED, __HIP_MEMORY_SCOPE_AGENT); }
__device__ __forceinline__ unsigned xb_xcc_id() { return (unsigned)__builtin_amdgcn_s_getreg((3 << 11) | 20) & 0xFu; }
#define XB_SPIN(cond, bar) do { unsigned _sp = 0; while (cond) { __builtin_amdgcn_s_sleep(1); \
    if ((++_sp & 255u) == 0u) { if (xb_ld(&(bar)[XB_TMO])) break; if (_sp > XB_SPIN_CAP) { atomicAdd(&(bar)[XB_TMO], 1u); break; } } } } while (0)
struct XcdBarrier { unsigned* bar; unsigned x; volatile LAS unsigned* st; };
__device__ __forceinline__ XcdBarrier xcd_barrier_post(unsigned* bar, volatile LAS unsigned* st, bool leader) {
    XcdBarrier b; b.bar = bar; b.x = xb_xcc_id(); b.st = st;
    if (leader) (void)xb_add(&bar[XB_XCNT(b.x)], 1u);
    return b;
}
__device__ __forceinline__ void xcd_barrier_complete(unsigned* bar, unsigned x, unsigned& nloc, unsigned& nx) {
    const unsigned G = gridDim.x * gridDim.y * gridDim.z;
    unsigned sum, cnt, mine, sp = 0u;
    for (;;) {
        sum = 0u; cnt = 0u; mine = 0u;
#pragma unroll
        for (unsigned j = 0; j < 16; ++j) { const unsigned c = xb_ld(&bar[XB_XCNT(j)]); sum += c; cnt += (c > 0u) ? 1u : 0u; mine = (j == x) ? c : mine; }
        if (sum == G) break;
        __builtin_amdgcn_s_sleep(1);
        if ((++sp & 255u) == 0u) { if (xb_ld(&bar[XB_TMO])) break; if (sp > XB_SPIN_CAP) { atomicAdd(&bar[XB_TMO], 1u); break; } }
    }
    nloc = mine > 0u ? mine : 1u; nx = cnt > 0u ? cnt : 1u;
}
__device__ __forceinline__ void xcd_barrier(const XcdBarrier& b, bool leader) {
    asm volatile("s_waitcnt vmcnt(0)" ::: "memory");
    __syncthreads();
    if (leader) {
        unsigned* bar = b.bar;
        __builtin_amdgcn_s_waitcnt(0);
        unsigned nloc = b.st[0], nx = b.st[1];
        if (nloc == 0u) { xcd_barrier_complete(bar, b.x, nloc, nx); b.st[0] = nloc; b.st[1] = nx; }
        const unsigned old = xb_add(&bar[XB_XSUB(b.x)], 1u);
        const unsigned gen = old / nloc;
        if (old + 1u == (gen + 1u) * nloc) {
            __builtin_amdgcn_fence(__ATOMIC_RELEASE, "agent");
            asm volatile("s_waitcnt vmcnt(0)" ::: "memory");
            const unsigned og = xb_add(&bar[XB_TOP], 1u);
            const unsigned tg = og / nx;
            if (og + 1u == (tg + 1u) * nx) xb_add(&bar[XB_TOPGEN], 1u);
            else XB_SPIN(xb_ld(&bar[XB_TOPGEN]) == tg, bar);
            __builtin_amdgcn_fence(__ATOMIC_ACQUIRE, "agent");
            xb_add(&bar[XB_XGEN(b.x)], 1u);
            asm volatile("s_waitcnt vmcnt(0)" ::: "memory");
        } else {
            XB_SPIN(xb_ld(&bar[XB_XGEN(b.x)]) == gen, bar);
            __builtin_amdgcn_fence(__ATOMIC_ACQUIRE, "agent");
            asm volatile("s_waitcnt vmcnt(0)" ::: "memory");
        }
    }
    __syncthreads();
}

struct Ctx { LAS unsigned char* lds; int tid, lane, wave, bid, nb, vcu; };
struct Args { const float* in[40]; float* out; unsigned char* ws; int ph_lo, ph_hi; };
enum { I_X = 0, I_C, I_CTX, I_CCTX, I_ADAW, I_ADAB, I_N1G, I_N2G, I_EVWIN, I_EVWOUT, I_QNORM, I_WUQ, I_KVNORM, I_WUKV, I_QG, I_KG, I_DWW, I_DWB, I_LNG, I_LNB,
       I_ODWIN, I_ODWOUT, I_SHIFTW, I_W0, I_W2L, I_A0, I_A2, I_G2, I_KKW, I_KA, I_RK, I_GNG, I_GNB, I_NAQG, I_NAKG, I_RPB, I_ROUTER, I_MW1, I_MW3, I_MW2 };

DI void transpose_item(const float* __restrict__ W, int K, int N, bf16* __restrict__ WT, int dst_row0, const float* __restrict__ gain, LAS float* scr, int k0, int n0, int lane) {
#pragma unroll 8
    for (int i = 0; i < 32; ++i) { const int kk = 2 * i + (lane >> 5); float v = W[(size_t)(k0 + kk) * N + n0 + (lane & 31)]; if (gain) v *= gain[k0 + kk]; scr[kk * 33 + (lane & 31)] = v; }
    asm volatile("s_waitcnt lgkmcnt(0)" ::: "memory");
    const int c = lane & 7;
#pragma unroll
    for (int j = 0; j < 4; ++j) { const int n = (lane >> 3) + 8 * j; const LAS float* s = scr + (8 * c) * 33 + n;
        u32x4 o; o.x = pk2(s[0 * 33], s[1 * 33]); o.y = pk2(s[2 * 33], s[3 * 33]); o.z = pk2(s[4 * 33], s[5 * 33]); o.w = pk2(s[6 * 33], s[7 * 33]);
        *(u32x4*)(WT + (size_t)(dst_row0 + n) * K + k0 + 8 * c) = o; }
    asm volatile("s_waitcnt lgkmcnt(0)" ::: "memory");
}
DI void transpose_item64(const float* __restrict__ W, int K, int N, bf16* __restrict__ WT, int dst_row0, LAS float* scr, int k0, int n0, int lane) {
    f32x4 v[16];
#pragma unroll
    for (int i = 0; i < 16; ++i) v[i] = *(const f32x4*)(W + (size_t)(k0 + 4 * i + (lane >> 4)) * N + n0 + 4 * (lane & 15));
#pragma unroll
    for (int i = 0; i < 16; ++i) { LAS float* d = scr + (4 * i + (lane >> 4)) * 65 + 4 * (lane & 15); d[0] = v[i].x; d[1] = v[i].y; d[2] = v[i].z; d[3] = v[i].w; }
    asm volatile("s_waitcnt lgkmcnt(0)" ::: "memory");
    const int c = lane & 7;
#pragma unroll
    for (int j = 0; j < 8; ++j) { const int n = (lane >> 3) + 8 * j; const LAS float* s = scr + (8 * c) * 65 + n;
        u32x4 o; o.x = pk2(s[0 * 65], s[1 * 65]); o.y = pk2(s[2 * 65], s[3 * 65]); o.z = pk2(s[4 * 65], s[5 * 65]); o.w = pk2(s[6 * 65], s[7 * 65]);
        *(u32x4*)(WT + (size_t)(dst_row0 + n) * K + k0 + 8 * c) = o; }
    asm volatile("s_waitcnt lgkmcnt(0)" ::: "memory");
}
DI void transpose_item64_f8(const float* __restrict__ W, int K, int N, unsigned char* __restrict__ WT8, int dst_row0, LAS float* scr, int k0, int n0, int lane) {
    f32x4 v[16];
#pragma unroll
    for (int i = 0; i < 16; ++i) v[i] = *(const f32x4*)(W + (size_t)(k0 + 4 * i + (lane >> 4)) * N + n0 + 4 * (lane & 15));
#pragma unroll
    for (int i = 0; i < 16; ++i) { LAS float* d = scr + (4 * i + (lane >> 4)) * 65 + 4 * (lane & 15); d[0] = v[i].x; d[1] = v[i].y; d[2] = v[i].z; d[3] = v[i].w; }
    asm volatile("s_waitcnt lgkmcnt(0)" ::: "memory");
    const int c = lane & 7;
#pragma unroll
    for (int j = 0; j < 8; ++j) { const int n = (lane >> 3) + 8 * j; const LAS float* s = scr + (8 * c) * 65 + n;
        u32x2 o; o.x = pk4_fp8(64.f * s[0 * 65], 64.f * s[1 * 65], 64.f * s[2 * 65], 64.f * s[3 * 65]); o.y = pk4_fp8(64.f * s[4 * 65], 64.f * s[5 * 65], 64.f * s[6 * 65], 64.f * s[7 * 65]);
        *(u32x2*)(WT8 + (size_t)(dst_row0 + n) * K + k0 + 8 * c) = o; }
    asm volatile("s_waitcnt lgkmcnt(0)" ::: "memory");
}
DI void transpose_matrix(const Ctx& C, const float* W, int K, int N, bf16* WT, const float* gain, int mode  ) {
    LAS float* scr = (LAS float*)(C.lds + C.wave * 8704);
    const int nkb = K / 64, nnb = N / 32, nit = nkb * nnb, gw = C.vcu * 8 + C.wave, ngw = C.nb * 8;
    for (int it = gw; it < nit; it += ngw) {
        const int kb = it / nnb, nbk = it % nnb, n0 = nbk * 32;
        int d0 = n0; if (mode) d0 = (n0 >> 7) * 256 + (n0 & 127) + (mode == 2 ? 128 : 0);
        transpose_item(W, K, N, WT, d0, gain, scr, kb * 64, n0, C.lane);
    }
}

DI void ph_prologue(const Ctx& C, const Args& a) {
    unsigned char* ws = a.ws;
    {
        LAS float* sv = (LAS float*)C.lds;
        LAS float* red = sv + 9 * 1024;
        for (int i = C.tid; i < 9 * 1024; i += 512) { const int m = i >> 10, k = i & 1023; const float c = (m < 8) ? a.in[I_C][m * 1024 + k] : a.in[I_CCTX][k]; sv[i] = siluf_(c); }
        __syncthreads();
        float* MOD = (float*)(ws + WS_MOD);
        for (int it = C.bid; it < 4 * 96; it += C.nb) {
            const int layer = it / 96, col = (it % 96) * 64 + C.lane;
            const float* wp = a.in[I_ADAW] + (size_t)layer * 1024 * 6144 + col;
            float acc[9];
#pragma unroll
            for (int m = 0; m < 9; ++m) acc[m] = 0.f;
            const int kb = C.wave * 128;
#pragma unroll 16
            for (int k = 0; k < 128; ++k) { const float w = wp[(size_t)(kb + k) * 6144];
#pragma unroll
                for (int m = 0; m < 9; ++m) acc[m] += sv[m * 1024 + kb + k] * w; }
#pragma unroll
            for (int m = 0; m < 9; ++m) red[(C.wave * 9 + m) * 64 + C.lane] = acc[m];
            __syncthreads();
            for (int i = C.tid; i < 576; i += 512) { const int m = i >> 6, l = i & 63; float s = 0.f;
#pragma unroll
                for (int w = 0; w < 8; ++w) s += red[(w * 9 + m) * 64 + l];
                const int cc = (it % 96) * 64 + l;
                MOD[(size_t)(layer * 9 + m) * 6144 + cc] = s + a.in[I_ADAB][layer * 6144 + cc]; }
            __syncthreads();
        }
    }
    {
        f32x2* CS = (f32x2*)(ws + WS_ROPE);
        for (int i = C.bid * 512 + C.tid; i < 4096 * 16; i += C.nb * 512) {
            const int pos = i >> 4, j = i & 15, f = j & 7;
            const float inv = powf(10000.f, -(float)(2 * f) / 16.f);
            const float ang = (float)((j < 8) ? (pos >> 6) : (pos & 63)) * inv;
            const double tw = 6.283185307179586476925;
            const double x = (double)ang, n = __builtin_rint(x / tw), rr = x - n * tw;
            CS[i] = (f32x2){__cosf((float)rr), __sinf((float)rr)};
        }
    }
    for (int j = 0; j < 2; ++j) {
        transpose_matrix(C, a.in[I_EVWIN] + (size_t)j * DM * EV_IN, DM, EV_IN, (bf16*)(ws + WS_WEVIN) + (size_t)j * EV_INP * DM, nullptr, 0);
        transpose_matrix(C, a.in[I_EVWOUT] + (size_t)j * DM * DM, DM, DM, (bf16*)(ws + WS_WEVOUT) + (size_t)j * DM * DM, nullptr, 0);
        transpose_matrix(C, a.in[I_WUQ] + (size_t)j * 384 * 768, 384, 768, (bf16*)(ws + WS_WUQ) + (size_t)j * 768 * 384, a.in[I_QNORM] + j * 384, 0);
        transpose_matrix(C, a.in[I_WUKV] + (size_t)j * 256 * 1024, 256, 1024, (bf16*)(ws + WS_WUKV) + (size_t)j * 1024 * 256, a.in[I_KVNORM] + j * 256, 0);
        transpose_matrix(C, a.in[I_ODWIN] + (size_t)j * DM * OD_IN, DM, OD_IN, (bf16*)(ws + WS_WODIN) + (size_t)j * OD_INP * DM, nullptr, 0);
        transpose_matrix(C, a.in[I_ODWOUT] + (size_t)j * DM * DM, DM, DM, (bf16*)(ws + WS_WODOUT) + (size_t)j * DM * DM, nullptr, 0);
    }
    {
        const int gt = C.bid * 512 + C.tid, ngt = C.nb * 512;
        for (int j = 0; j < 2; ++j) {
            u32x4* p0 = (u32x4*)((bf16*)(ws + WS_WEVIN) + (size_t)j * EV_INP * DM + (size_t)EV_IN * DM);
            for (int i = gt; i < (EV_INP - EV_IN) * DM / 8; i += ngt) p0[i] = (u32x4){0u, 0u, 0u, 0u};
            u32x4* p1 = (u32x4*)((bf16*)(ws + WS_WODIN) + (size_t)j * OD_INP * DM + (size_t)OD_IN * DM);
            for (int i = gt; i < (OD_INP - OD_IN) * DM / 8; i += ngt) p1[i] = (u32x4){0u, 0u, 0u, 0u};
            bf16* WL = (bf16*)(ws + WS_WLORA) + (size_t)j * 655360;
            const float* w2 = a.in[I_W2L] + (size_t)j * 2 * 64 * 512; const float* a2 = a.in[I_A2] + (size_t)j * 2 * 64 * 512; const float* g2 = a.in[I_G2] + (size_t)j * 128 * 512;
            for (int i = gt; i < 655360; i += ngt) {
                const int n = i >> 8, k = i & 255; float v = 0.f;
                if (n < 1024) { const int d = n >> 9, c = n & 511; if (k >= d * 64 && k < d * 64 + 64) v = w2[(size_t)k * 512 + c]; }
                else if (n < 2048) { const int d = (n - 1024) >> 9, c = n & 511; if (k >= 128 + d * 64 && k < 192 + d * 64) v = a2[(size_t)(k - 128) * 512 + c]; }
                else { const int c = n - 2048; if (k >= 128) v = g2[(size_t)(k - 128) * 512 + c]; }
                WL[i] = f2bf(v);
            }
        }
    }
}

template <bool ROUTER>
DI void ph_norm(const Ctx& C, const float* xlat, const float* xctx, const float* gain, const float* mod  , int shift_off, int scale_off, bf16* H,
                const float* router  , float* AFFT, float* AFFC, int* SLOT) {
    LAS float* RT = (LAS float*)C.lds;
    if (ROUTER) { for (int i = C.tid; i < 16384; i += 512) { const int c = i >> 4, e = i & 15; RT[e * 1024 + c] = router[i]; } __syncthreads(); }
    const int gw = C.bid * 8 + C.wave, ngw = C.nb * 8, lane = C.lane;
    for (int row = gw; row < MT; row += ngw) {
        const float* xr = row < NLAT ? xlat + (size_t)row * DM : xctx + (size_t)(row - NLAT) * DM;
        const int mi = row < NLAT ? (row >> 12) : 8;
        const float* mp = mod + mi * 6144;
        f32x4 v[4]; float ss = 0.f;
#pragma unroll
        for (int j = 0; j < 4; ++j) { v[j] = *(const f32x4*)(xr + 256 * j + 4 * lane); ss += v[j].x * v[j].x + v[j].y * v[j].y + v[j].z * v[j].z + v[j].w * v[j].w; }
        ss = wave_sum(ss);
        const float rs = 1.0f / sqrtf(ss * (1.f / 1024.f) + EPS);
#pragma unroll
        for (int j = 0; j < 4; ++j) {
            const int c = 256 * j + 4 * lane;
            const f32x4 g = *(const f32x4*)(gain + c), sc = *(const f32x4*)(mp + scale_off + c), sh = *(const f32x4*)(mp + shift_off + c);
            v[j] = (v[j] * rs) * g * (sc + 1.0f) + sh;
            if (ROUTER && MOE_F8) *(unsigned*)((unsigned char*)H + (size_t)row * DM + c) = pk4_fp8(v[j].x, v[j].y, v[j].z, v[j].w);
            else *(u32x2*)(H + (size_t)row * DM + c) = (u32x2){pk2(v[j].x, v[j].y), pk2(v[j].z, v[j].w)};
        }
        if (ROUTER) {
            float mylg = 0.f;
#pragma unroll 1
            for (int e = 0; e < 16; ++e) { float p = 0.f;
#pragma unroll
                for (int j = 0; j < 4; ++j) { const f32x4 w = *(const LAS f32x4*)(RT + e * 1024 + 256 * j + 4 * lane); p += v[j].x * w.x + v[j].y * w.y + v[j].z * w.z + v[j].w * w.w; }
                p = wave_sum(p); mylg = (lane == e) ? p : mylg; }
            const float mx = max16(mylg);
            const float ex = expf(mylg - mx);
            const float mine = ex / sum16(ex);
            if (lane < 16) {
                if (row < NLAT) AFFT[(size_t)((row >> 12) * 16 + lane) * TL + (row & 4095)] = mine;
                else { const int rc = row - NLAT; AFFC[(size_t)((rc >> 8) * 16 + lane) * LCX + (rc & 255)] = mine; }
                SLOT[(size_t)row * 16 + lane] = -1;
            }
        }
    }
}


struct EpiBf16 { static constexpr bool WIDE = true; bf16* O; int ldo;
    DI void operator()(int row, int col, f32x4 v0, f32x4 v1) const { bf16* p = O + (size_t)row * ldo + col;
        *(u32x2*)p = (u32x2){pk2(v0[0], v0[1]), pk2(v0[2], v0[3])}; *(u32x2*)(p + 128) = (u32x2){pk2(v1[0], v1[1]), pk2(v1[2], v1[3])}; }
    DI void wide(int row, int col, f32x4 a0, f32x4 a1, f32x4 b0, f32x4 b1) const { bf16* p = O + (size_t)row * ldo + col;
        *(u32x4*)p = (u32x4){pk2(a0[0], a0[1]), pk2(a0[2], a0[3]), pk2(a1[0], a1[1]), pk2(a1[2], a1[3])}; *(u32x4*)(p + 128) = (u32x4){pk2(b0[0], b0[1]), pk2(b0[2], b0[3]), pk2(b1[0], b1[1]), pk2(b1[2], b1[3])}; } };
struct EpiF32 { static constexpr bool WIDE = false; float* O; int ldo;
    DI void operator()(int row, int col, f32x4 v0, f32x4 v1) const { float* p = O + (size_t)row * ldo + col; *(f32x4*)p = v0; *(f32x4*)(p + 128) = v1; } };
struct EpiResid { static constexpr bool WIDE = false; const float* xin_lat; const float* xin_ctx; float* xout_lat; float* xout_ctx; const float* modg;
    DI void operator()(int row, int col, f32x4 v0, f32x4 v1) const {
        const float* xi; float* xo; int mi;
        if (row < NLAT) { xi = xin_lat + (size_t)row * DM; xo = xout_lat + (size_t)row * DM; mi = row >> 12; }
        else { xi = xin_ctx + (size_t)(row - NLAT) * DM; xo = xout_ctx + (size_t)(row - NLAT) * DM; mi = 8; }
        const float* g = modg + mi * 6144 + col;
        const f32x4 g0 = *(const f32x4*)g, g1 = *(const f32x4*)(g + 128), x0 = *(const f32x4*)(xi + col), x1 = *(const f32x4*)(xi + col + 128);
        *(f32x4*)(xo + col) = x0 + g0 * v0; *(f32x4*)(xo + col + 128) = x1 + g1 * v1; } };
struct EpiGlu { static constexpr bool WIDE = false; bf16* O;
    DI void operator()(int row, int col, f32x4 v0, f32x4 v1) const { const int f = ((col & 2047) >> 8) * 128 + (col & 255);
        *(u32x2*)(O + (size_t)row * DM + f) = (u32x2){pk2(siluf_(v0[0]) * v1[0], siluf_(v0[1]) * v1[1]), pk2(siluf_(v0[2]) * v1[2], siluf_(v0[3]) * v1[3])}; } };
struct EpiGlu8 { static constexpr bool WIDE = true; unsigned char* O;
    DI void operator()(int row, int col, f32x4 v0, f32x4 v1) const { const int f = ((col & 2047) >> 8) * 128 + (col & 255);
        *(unsigned*)(O + (size_t)row * DM + f) = pk4_fp8(8.f * siluf_(v0[0]) * v1[0], 8.f * siluf_(v0[1]) * v1[1], 8.f * siluf_(v0[2]) * v1[2], 8.f * siluf_(v0[3]) * v1[3]); }
    DI void wide(int row, int col, f32x4 a0, f32x4 a1, f32x4 b0, f32x4 b1) const { const int f = ((col & 2047) >> 8) * 128 + (col & 255);
        *(u32x2*)(O + (size_t)row * DM + f) = (u32x2){pk4_fp8(8.f * siluf_(a0[0]) * b0[0], 8.f * siluf_(a0[1]) * b0[1], 8.f * siluf_(a0[2]) * b0[2], 8.f * siluf_(a0[3]) * b0[3]),
                                                    pk4_fp8(8.f * siluf_(a1[0]) * b1[0], 8.f * siluf_(a1[1]) * b1[1], 8.f * siluf_(a1[2]) * b1[2], 8.f * siluf_(a1[3]) * b1[3])}; } };
struct EpiGate { static constexpr bool WIDE = true; bf16* O; const float* gate;
    DI void operator()(int row, int col, f32x4 v0, f32x4 v1) const { const float g = gate[row]; bf16* p = O + (size_t)row * DM + (col & 1023);
        *(u32x2*)p = (u32x2){pk2(v0[0] * g, v0[1] * g), pk2(v0[2] * g, v0[3] * g)}; *(u32x2*)(p + 128) = (u32x2){pk2(v1[0] * g, v1[1] * g), pk2(v1[2] * g, v1[3] * g)}; }
    DI void wide(int row, int col, f32x4 a0, f32x4 a1, f32x4 b0, f32x4 b1) const { const float g = gate[row]; bf16* p = O + (size_t)row * DM + (col & 1023);
        *(u32x4*)p = (u32x4){pk2(a0[0] * g, a0[1] * g), pk2(a0[2] * g, a0[3] * g), pk2(a1[0] * g, a1[1] * g), pk2(a1[2] * g, a1[3] * g)};
        *(u32x4*)(p + 128) = (u32x4){pk2(b0[0] * g, b0[1] * g), pk2(b0[2] * g, b0[3] * g), pk2(b1[0] * g, b1[1] * g), pk2(b1[2] * g, b1[3] * g)}; } };
struct EpiLoraW { static constexpr bool WIDE = false; float* W; const float* w0;
    DI void one(int row, int col, f32x4 v) const { const int d = col >> 9, c = col & 511; f32x4 o;
#pragma unroll
        for (int e = 0; e < 4; ++e) { const float lw = w0[col + e] + v[e]; const float z = -lw; const float sp = fmaxf(z, 0.f) + __logf(1.f + __expf(-fabsf(z))); o[e] = -__expf(-sp - 0.5f); }
        *(f32x4*)(W + ((size_t)d * MT + row) * 512 + c) = o; }
    DI void operator()(int row, int col, f32x4 v0, f32x4 v1) const { one(row, col, v0); one(row, col + 128, v1); } };
struct EpiLoraA { static constexpr bool WIDE = false; bf16* Aout; const float* a0;
    DI void one(int row, int col, f32x4 v) const { const int d = col >> 9, c = col & 511; const f32x4 b = *(const f32x4*)(a0 + col);
        *(u32x2*)(Aout + ((size_t)d * MT + row) * 512 + c) = (u32x2){pk2(sigmoidf_(b[0] + v[0]), sigmoidf_(b[1] + v[1])), pk2(sigmoidf_(b[2] + v[2]), sigmoidf_(b[3] + v[3]))}; }
    DI void operator()(int row, int col, f32x4 v0, f32x4 v1) const { one(row, col, v0); one(row, col + 128, v1); } };

namespace pg8 {
constexpr int BM = 256, BK = 64, HALF = 128, HTB = HALF * BK * 2, STAGE_BYTES = 8 * HTB;
DI int lds_byte(int r, int c) { const int st = (r >> 4) * 2 + (c >> 5), rr = r & 15, cc = c & 31, ob = rr * 64 + cc * 2; return st * 1024 + (ob ^ (((ob >> 9) & 1) << 5)); }
DI void stage_rc(int b, int& R, int& C) { const int st = b / 1024, sb = b % 1024, swz = sb ^ (((sb >> 9) & 1) << 5); R = (st >> 1) * 16 + swz / 64; C = (st & 1) * 32 + (swz % 64) / 2; }
DI int perm32(int rho) { const int n = rho >> 4, i = rho & 15; return 8 * (i >> 2) + 4 * n + (i & 3); }
struct Unit { int pm, pn; };
struct Gemm { const bf16* A; const bf16* Bt; int lda, K; const int* rows; int scale_w = 0x7f7f7f7f, scale_a = 0x7f7f7f7f; };
struct OrderMN { int nM, nN, G, c;
    DI bool next(int i, Unit& u) const { const int L = i * G + c; if (L >= nM * nN) return false; u.pm = L / nN; u.pn = L % nN; return true; } };
struct OrderMoE { int nMt, nN, mstride  , G, c;
    DI bool next(int i, Unit& u) const { const int L = i * G + c, per = nMt * nN; if (L >= NEXP * per) return false; const int e = L / per, q = L % per; u.pm = e * mstride + q / nN; u.pn = e * nN + q % nN; return true; } };
template <class E4> struct EpiAdapt { E4 e;
    DI void operator()(const f32x4 (&acc)[2][2][4][2], const Unit& u, int wr, int wc, int fr, int fq) const {
#pragma unroll
        for (int ai = 0; ai < 2; ++ai)
#pragma unroll
            for (int m = 0; m < 4; ++m) { const int row = u.pm * BM + ai * HALF + wr * 64 + m * 16 + fr;
                if constexpr (E4::WIDE) e.wide(row, u.pn * BM + wc * 32 + 8 * fq, acc[ai][0][m][0], acc[ai][0][m][1], acc[ai][1][m][0], acc[ai][1][m][1]);
                else {
#pragma unroll
                    for (int n = 0; n < 2; ++n) e(row, u.pn * BM + wc * 32 + 8 * fq + 4 * n, acc[ai][0][m][n], acc[ai][1][m][n]); } } } };

template <class Epi, class Sched, bool F8 = false>
DI void gemm_phase(LAS unsigned char* lds, const Gemm g, const Sched& S, const Epi& E, const int tid) {
    const int wid = __builtin_amdgcn_readfirstlane(tid >> 6), lane = tid & 63, wr = wid >> 2, wc = wid & 3, fr = lane & 15, fq = lane >> 4;
    const int K = g.K, nt = K / BK;
    unsigned voffB[2];
#pragma unroll
    for (int i = 0; i < 2; ++i) { int R, C; stage_rc(tid * 16 + i * 8192, R, C); const int Rb = (R & ~31) + perm32(R & 31); voffB[i] = (unsigned)(Rb * K + C) * 2u; }
    const size_t kstep = (size_t)(BK * 2), hstep = (size_t)HALF * K * 2, tstep = 2 * hstep;
    const unsigned ldsw = (unsigned)wid * 1024u;
    const int aoff = lds_byte(wr * 64 + fr, fq * 8), boff = lds_byte(wc * 32 + fr, fq * 8);
    const char* const gA = (const char*)g.A;
#define PG8_SA(b, h) (((b) * 2 + (h)) * HTB)
#define PG8_SB(b, h) ((4 + (b) * 2 + (h)) * HTB)
#define PG8_STAGE(bufoff, gbase, voff) do { _Pragma("unroll") for (int _i = 0; _i < 2; ++_i) \
        __builtin_amdgcn_global_load_lds((const unsigned*)((const char*)(gbase) + (voff)[_i]), (LAS unsigned*)(lds + (bufoff) + ldsw + _i * 8192), 16, 0, 0); } while (0)
#define PG8_LDA(dst, b, h) do { _Pragma("unroll") for (int m = 0; m < 4; ++m) _Pragma("unroll") for (int k = 0; k < 2; ++k) dst[m][k] = *(const LAS bf16x8*)(lds + PG8_SA(b, h) + aoff + m * 2048 + k * 1024); } while (0)
#define PG8_LDB(dst, b, h) do { _Pragma("unroll") for (int n = 0; n < 2; ++n) _Pragma("unroll") for (int k = 0; k < 2; ++k) dst[n][k] = *(const LAS bf16x8*)(lds + PG8_SB(b, h) + boff + n * 2048 + k * 1024); } while (0)
#define PG8_MMA(ai, bj, At, Bt) do { __builtin_amdgcn_s_setprio(1); _Pragma("unroll") for (int m = 0; m < 4; ++m) _Pragma("unroll") for (int n = 0; n < 2; ++n) { \
        if constexpr (F8) { const v8i_t w8 = __builtin_shufflevector(__builtin_bit_cast(i32x4_t, Bt[n][0]), __builtin_bit_cast(i32x4_t, Bt[n][1]), 0, 1, 2, 3, 4, 5, 6, 7), x8 = __builtin_shufflevector(__builtin_bit_cast(i32x4_t, At[m][0]), __builtin_bit_cast(i32x4_t, At[m][1]), 0, 1, 2, 3, 4, 5, 6, 7); \
            acc[ai][bj][m][n] = __builtin_amdgcn_mfma_scale_f32_16x16x128_f8f6f4(w8, x8, acc[ai][bj][m][n], 0, 0, 0, g.scale_w, 0, g.scale_a); } \
        else { _Pragma("unroll") for (int k = 0; k < 2; ++k) acc[ai][bj][m][n] = __builtin_amdgcn_mfma_f32_16x16x32_bf16(Bt[n][k], At[m][k], acc[ai][bj][m][n], 0, 0, 0); } } __builtin_amdgcn_s_setprio(0); } while (0)
#define PG8_WAIT_V(n) asm volatile("s_waitcnt vmcnt(" #n ")" ::: "memory")
#define PG8_WAIT_L(n) asm volatile("s_waitcnt lgkmcnt(" #n ")" ::: "memory")
#define PG8_BAR __builtin_amdgcn_s_barrier()
#define PG8_SCHED __builtin_amdgcn_sched_barrier(0)
#define PG8_ROWIDX(ri, u) do { _Pragma("unroll") for (int _h = 0; _h < 2; ++_h) _Pragma("unroll") for (int _i = 0; _i < 2; ++_i) { int _R, _C; stage_rc(tid * 16 + _i * 8192, _R, _C); (void)_C; \
        const int _lr = (u).pm * BM + _h * HALF + _R; ri[_h][_i] = g.rows ? g.rows[_lr] : _lr; } } while (0)
#define PG8_AOFF_FROM(vo, ri) do { _Pragma("unroll") for (int _h = 0; _h < 2; ++_h) _Pragma("unroll") for (int _i = 0; _i < 2; ++_i) { int _R, _C; stage_rc(tid * 16 + _i * 8192, _R, _C); (void)_R; \
        vo[_h][_i] = (unsigned)(((size_t)ri[_h][_i] * g.lda + _C) * 2u); } } while (0)
    Unit cur, nxt; int ui = 0;
    if (!S.next(0, cur)) return;
    f32x4 acc[2][2][4][2];
#pragma unroll
    for (int a = 0; a < 2; ++a)
#pragma unroll
        for (int b = 0; b < 2; ++b)
#pragma unroll
            for (int m = 0; m < 4; ++m)
#pragma unroll
                for (int n = 0; n < 2; ++n) acc[a][b][m][n] = (f32x4){0.f, 0.f, 0.f, 0.f};
    bf16x8 At[4][2], B0[2][2], B1[2][2];
    unsigned cvo[2][2]; int nri[2][2];
    PG8_ROWIDX(nri, cur); PG8_AOFF_FROM(cvo, nri);
    const char* cB = (const char*)g.Bt + (size_t)cur.pn * tstep;
    PG8_STAGE(PG8_SB(0, 0), cB, voffB); PG8_STAGE(PG8_SB(0, 1), cB + hstep, voffB); PG8_STAGE(PG8_SA(0, 0), gA, cvo[0]); PG8_STAGE(PG8_SA(0, 1), gA, cvo[1]);
    if (wr == 1) PG8_BAR;
    PG8_WAIT_V(2); PG8_BAR;
    PG8_STAGE(PG8_SB(1, 0), cB + kstep, voffB); PG8_STAGE(PG8_SA(1, 0), gA + kstep, cvo[0]); PG8_STAGE(PG8_SB(1, 1), cB + hstep + kstep, voffB);
    PG8_WAIT_V(6); PG8_BAR;
    for (;;) {
        const bool has_next = S.next(ui + 1, nxt);
        const char* nB = has_next ? (const char*)g.Bt + (size_t)nxt.pn * tstep : cB;
#pragma nounroll
        for (int t = 0; t < nt; t += 2) {
            const bool last = (t == nt - 2);
            const char* a1 = gA + (size_t)(t + 1) * kstep;
            const char* a2 = last ? gA : gA + (size_t)(t + 2) * kstep; const char* b2 = last ? nB : cB + (size_t)(t + 2) * kstep;
            const char* a3 = a2 + kstep; const char* b3 = b2 + kstep;
            if (t == nt - 4 && has_next) PG8_ROWIDX(nri, nxt);
            PG8_LDB(B0, 0, 0); PG8_LDB(B1, 0, 1); PG8_SCHED; PG8_LDA(At, 0, 0); PG8_STAGE(PG8_SA(1, 1), a1, cvo[1]);
            if (last && has_next) { if (nt < 4) PG8_ROWIDX(nri, nxt); PG8_AOFF_FROM(cvo, nri); }
            PG8_WAIT_V(8); PG8_WAIT_L(0); PG8_BAR; PG8_MMA(0, 0, At, B0); PG8_MMA(0, 1, At, B1); PG8_BAR; PG8_SCHED;
            PG8_LDA(At, 0, 1); PG8_STAGE(PG8_SB(0, 0), b2, voffB); PG8_STAGE(PG8_SB(0, 1), b2 + hstep, voffB); PG8_STAGE(PG8_SA(0, 0), a2, cvo[0]);
            PG8_WAIT_V(8); PG8_WAIT_L(0); PG8_BAR; PG8_MMA(1, 0, At, B0); PG8_MMA(1, 1, At, B1); PG8_BAR; PG8_SCHED;
            PG8_LDB(B0, 1, 0); PG8_LDB(B1, 1, 1); PG8_SCHED; PG8_LDA(At, 1, 0); PG8_STAGE(PG8_SA(0, 1), a2, cvo[1]);
            PG8_WAIT_V(8); PG8_WAIT_L(0); PG8_BAR; PG8_MMA(0, 0, At, B0); PG8_MMA(0, 1, At, B1); PG8_BAR; PG8_SCHED;
            PG8_LDA(At, 1, 1); PG8_STAGE(PG8_SB(1, 0), b3, voffB); PG8_STAGE(PG8_SB(1, 1), b3 + hstep, voffB); PG8_STAGE(PG8_SA(1, 0), a3, cvo[0]);
            PG8_WAIT_V(8); PG8_WAIT_L(0); PG8_BAR; PG8_MMA(1, 0, At, B0); PG8_MMA(1, 1, At, B1); PG8_BAR; PG8_SCHED;
        }
        if (wr == 0) PG8_BAR;
        E(acc, cur, wr, wc, fr, fq);
        if (!has_next) break;
#pragma unroll
        for (int a = 0; a < 2; ++a)
#pragma unroll
            for (int b = 0; b < 2; ++b)
#pragma unroll
                for (int m = 0; m < 4; ++m)
#pragma unroll
                    for (int n = 0; n < 2; ++n) acc[a][b][m][n] = (f32x4){0.f, 0.f, 0.f, 0.f};
        cur = nxt; cB = nB; ++ui;
        if (wr == 1) PG8_BAR;
    }
    PG8_WAIT_V(0);
    PG8_BAR;
#undef PG8_SA
#undef PG8_SB
#undef PG8_STAGE
#undef PG8_LDA
#undef PG8_LDB
#undef PG8_MMA
#undef PG8_WAIT_V
#undef PG8_WAIT_L
#undef PG8_BAR
#undef PG8_SCHED
#undef PG8_ROWIDX
#undef PG8_AOFF_FROM
}
}
template <class E4> DI void fast_gemm(const Ctx& C, const bf16* A, int lda, const bf16* Bt, int K, int nM, int nN, const E4& e, bool rev = false) {
    pg8::Gemm g{A, Bt, lda, K, nullptr}; pg8::OrderMN S{nM, nN, C.nb, rev ? C.nb - 1 - C.vcu : C.vcu}; pg8::EpiAdapt<E4> E{e};
    pg8::gemm_phase(C.lds, g, S, E, C.tid);
}

DI float max16_acc(float m, const f32x16& x) {
    asm volatile("s_nop 15\n\tv_max3_f32 %0, %0, %1, %2\n\tv_max3_f32 %0, %0, %3, %4\n\tv_max3_f32 %0, %0, %5, %6\n\tv_max3_f32 %0, %0, %7, %8\n\tv_max3_f32 %0, %0, %9, %10\n\tv_max3_f32 %0, %0, %11, %12\n\tv_max3_f32 %0, %0, %13, %14\n\tv_max3_f32 %0, %0, %15, %16"
                 : "+v"(m) : "v"(x[0]), "v"(x[1]), "v"(x[2]), "v"(x[3]), "v"(x[4]), "v"(x[5]), "v"(x[6]), "v"(x[7]), "v"(x[8]), "v"(x[9]), "v"(x[10]), "v"(x[11]), "v"(x[12]), "v"(x[13]), "v"(x[14]), "v"(x[15]));
    return m; }
DI int swap23(int x) { return (x & ~12) | ((x & 4) << 1) | ((x & 8) >> 1); }
DI void flash_store(const f32x16 (&o)[2], float l, bf16* orow  , int h) {
    const float inv = 1.f / l;
#pragma unroll
    for (int dt = 0; dt < 2; ++dt)
#pragma unroll
        for (int g = 0; g < 4; ++g)
            *(u32x2*)(orow + 32 * dt + 8 * g + 4 * h) = (u32x2){pk2(o[dt][4 * g] * inv, o[dt][4 * g + 1] * inv), pk2(o[dt][4 * g + 2] * inv, o[dt][4 * g + 3] * inv)};
}


template <int DQK> struct AttnGeo { static constexpr int KSTR = DQK * 2 + 16, KBYTES = 64 * KSTR, VSTR = 144, VBYTES = 64 * VSTR, BUF = KBYTES + VBYTES, KPIECES = 64 * DQK / 8; };
template <int DQK, bool NAT>
DI void attn_tile_loop(const Ctx& C, f32x16 (&o)[2], float& l, const bf16x8 (&qf)[DQK / 16], const bf16* __restrict__ Kb, const bf16* __restrict__ Vt, int pos1, int n1, int pos2, int n2,
                       const LAS float* tab, int grow, int rs, int qc, int cs) {
    typedef AttnGeo<DQK> G;
    const int tid = C.tid, r = C.lane & 31, h = C.lane >> 5, kr = swap23(r), ntiles = n1 + n2;
    constexpr bool K2 = G::KPIECES > 512;
    const int kq0 = tid, kq1 = tid + 512;
    const int kl0 = (kq0 / (DQK / 8)) * G::KSTR + (kq0 % (DQK / 8)) * 16, kl1 = (kq1 / (DQK / 8)) * G::KSTR + (kq1 % (DQK / 8)) * 16;
    const int vl = G::KBYTES + (tid >> 3) * G::VSTR + (tid & 7) * 16;
    const bf16* vg = Vt + (size_t)(tid >> 3) * KPOS + 8 * (tid & 7);
    u32x4 rk0, rk1, rv;
    rk1 = (u32x4){0u, 0u, 0u, 0u};
#define ATT_POS(t) ((t) < n1 ? pos1 + 64 * (t) : pos2 + 64 * ((t) - n1))
    { const int pos0 = ATT_POS(0); rk0 = *(const u32x4*)(Kb + (size_t)pos0 * DQK + 8 * kq0); if (K2 && tid < 256) rk1 = *(const u32x4*)(Kb + (size_t)pos0 * DQK + 8 * kq1); rv = *(const u32x4*)(vg + pos0); }
    __syncthreads();
    *(LAS u32x4*)(C.lds + kl0) = rk0; if (K2 && tid < 256) *(LAS u32x4*)(C.lds + kl1) = rk1; *(LAS u32x4*)(C.lds + vl) = rv;
    __syncthreads();
    float mref = 0.f; bool first = true;
    f32x16 nmref;
#pragma unroll
    for (int i = 0; i < 16; ++i) nmref[i] = 0.f;
    constexpr float THR = 8.f;
    for (int t = 0; t < ntiles; ++t) {
        const LAS unsigned char* B = C.lds + (t & 1) * G::BUF;
        if (t + 1 < ntiles) { const int pos0 = ATT_POS(t + 1);
            rk0 = *(const u32x4*)(Kb + (size_t)pos0 * DQK + 8 * kq0); if (K2 && tid < 256) rk1 = *(const u32x4*)(Kb + (size_t)pos0 * DQK + 8 * kq1); rv = *(const u32x4*)(vg + pos0); }
        const int gr = (pos1 >> 6) + t;
        const bool active = !NAT || t >= n1 || (gr >= rs && gr < rs + 8);
        if (active) {
            f32x16 sc[2];
            constexpr int NK = DQK / 16, NS = 2 * NK, RD = 4;
            const LAS unsigned char* kp = B + kr * G::KSTR + 16 * h;
            bf16x8 fr[RD];
#pragma unroll
            for (int s = 0; s < RD; ++s) fr[s] = *(const LAS bf16x8*)(kp + (s / NK) * 32 * G::KSTR + 32 * (s % NK));
#pragma unroll
            for (int s = 0; s < NS; ++s) { sc[s / NK] = MFMA32(fr[s % RD], qf[s % NK], (s % NK == 0) ? nmref : sc[s / NK]);
                if (s + RD < NS) fr[s % RD] = *(const LAS bf16x8*)(kp + ((s + RD) / NK) * 32 * G::KSTR + 32 * ((s + RD) % NK)); }
            const LAS unsigned char* vp = B + G::KBYTES + r * G::VSTR + 16 * h;
#pragma unroll
            for (int v = 0; v < RD; ++v) fr[v] = *(const LAS bf16x8*)(vp + (v & 1) * 32 * G::VSTR + (v >> 1) * 32);
            __builtin_amdgcn_sched_group_barrier(0x100, RD, 0);
#pragma unroll
            for (int s = 0; s < NS - RD; ++s) { __builtin_amdgcn_sched_group_barrier(0x008, 1, 0); __builtin_amdgcn_sched_group_barrier(0x100, 1, 0); }
            __builtin_amdgcn_sched_group_barrier(0x008, RD, 0);
            __builtin_amdgcn_sched_group_barrier(0x100, RD, 0);
            if (NAT && t < n1) {
                const LAS float* trl = tab + (gr - grow + 7) * 128 + (8 * h - qc + 63);
#pragma unroll
                for (int j = 0; j < 2; ++j) { float bv[16];
#pragma unroll
                    for (int i = 0; i < 16; ++i) bv[i] = trl[32 * j + ((i & 3) | (((i >> 2) & 1) << 2) | ((i >> 3) << 4))];
                    asm volatile("" : "+v"(bv[0]), "+v"(bv[1]), "+v"(bv[2]), "+v"(bv[3]), "+v"(bv[4]), "+v"(bv[5]), "+v"(bv[6]), "+v"(bv[7]), "+v"(bv[8]), "+v"(bv[9]), "+v"(bv[10]), "+v"(bv[11]), "+v"(bv[12]), "+v"(bv[13]), "+v"(bv[14]), "+v"(bv[15]));
#pragma unroll
                    for (int i = 0; i < 16; ++i) {
                        const int cc = 32 * j + ((i & 3) | (((i >> 2) & 1) << 2) | ((i >> 3) << 4)) + 8 * h; const bool ok = (cc >= cs) && (cc < cs + 16);
                        sc[j][i] = ok ? sc[j][i] + bv[i] : -1e30f;
                    } }
            }
            float mx = max16_acc(max16_acc(-3.0e38f, sc[0]), sc[1]);
            if (first || __builtin_amdgcn_ballot_w64(mx > THR) != 0ull) {
                mx = fmaxf(mx, xor32(mx, C.lane));
                const float delta = first ? mx : fmaxf(mx, 0.f);
#pragma unroll
                for (int i = 0; i < 16; ++i) { sc[0][i] -= delta; sc[1][i] -= delta; }
                if (!first) { const float alpha = __builtin_amdgcn_exp2f(-delta); l *= alpha;
#pragma unroll
                    for (int i = 0; i < 16; ++i) { o[0][i] *= alpha; o[1][i] *= alpha; } }
                mref += delta; first = false;
#pragma unroll
                for (int i = 0; i < 16; ++i) nmref[i] = -mref;
            }
            float rs1 = 0.f;
#pragma unroll
            for (int j = 0; j < 2; ++j)
#pragma unroll
                for (int i = 0; i < 16; ++i) { sc[j][i] = __builtin_amdgcn_exp2f(sc[j][i]); rs1 += sc[j][i]; }
            l += rs1;
#pragma unroll
            for (int j = 0; j < 2; ++j)
#pragma unroll
                for (int s2 = 0; s2 < 2; ++s2) {
                    u32x4 pw; pw.x = pk2(sc[j][8 * s2], sc[j][8 * s2 + 1]); pw.y = pk2(sc[j][8 * s2 + 2], sc[j][8 * s2 + 3]); pw.z = pk2(sc[j][8 * s2 + 4], sc[j][8 * s2 + 5]); pw.w = pk2(sc[j][8 * s2 + 6], sc[j][8 * s2 + 7]);
                    const bf16x8 pb = __builtin_bit_cast(bf16x8, pw);
#pragma unroll
                    for (int dt = 0; dt < 2; ++dt) { const int v = 4 * j + 2 * s2 + dt;
                        o[dt] = MFMA32(fr[v % RD], pb, o[dt]);
                        if (v + RD < 8) fr[v % RD] = *(const LAS bf16x8*)(vp + ((v + RD) & 1) * 32 * G::VSTR + ((v + RD) >> 1) * 32); }
                }
#pragma unroll
            for (int v = 0; v < 8 - RD; ++v) { __builtin_amdgcn_sched_group_barrier(0x008, 1, 1); __builtin_amdgcn_sched_group_barrier(0x100, 1, 1); }
            __builtin_amdgcn_sched_group_barrier(0x008, RD, 1);
        }
        if (t + 1 < ntiles) { LAS unsigned char* Bn = C.lds + ((t + 1) & 1) * G::BUF;
            *(LAS u32x4*)(Bn + kl0) = rk0; if (K2 && tid < 256) *(LAS u32x4*)(Bn + kl1) = rk1; *(LAS u32x4*)(Bn + vl) = rv; }
        __syncthreads();
    }
    l += xor32(l, C.lane);
#undef ATT_POS
}
DI void conv_unit(const Ctx& C, int u, const bf16* U, const float (&wk)[31], float bias, const float* lng, const float* lnb, bf16* OCAT);
DI void wprep_items(const Ctx& C, int k0, int k1, const float* w1, const float* w3, const float* w2, bf16* W13, bf16* W2);
DI const float* in_ptr(const unsigned char* ws, int k);
DI void ph_attn_mla2(const Ctx& C, const bf16* QB, const bf16* KB, const bf16* VT, bf16* OCAT, bool last, unsigned char* ws, int lq) {
    const int r = C.lane & 31, h = C.lane >> 5;
    const int nunits = 1024 + (last ? 0 : 64);
    const int nwp = (NEXP * 3 * 256 + C.nb * 8 - 1) / (C.nb * 8);
    int k = 0;
    for (;; ++k) {
        const int u = C.vcu + k * C.nb, cu = (C.nb - 1 - C.vcu) + k * C.nb;
        const bool a_on = u < nunits, c_on = cu < MT / 32, w_on = 2 * k < nwp;
        if (!a_on && !c_on && !w_on) break;
        if (a_on) {
            const int bh = u < 1024 ? (u >> 4) : u - 1024, qblk = u < 1024 ? (u & 15) : 16, b = bh >> 3, hh = bh & 7;
            const int qpos = qblk * 256 + 32 * C.wave + r;
            const bf16* qp = QB + ((size_t)bh * KPOS + qpos) * 96 + 8 * h;
            bf16x8 qf[6];
#pragma unroll
            for (int kk = 0; kk < 6; ++kk) qf[kk] = *(const bf16x8*)(qp + 16 * kk);
            f32x16 o[2];
#pragma unroll
            for (int i = 0; i < 16; ++i) { o[0][i] = 0.f; o[1][i] = 0.f; }
            float l = 0.f;
            attn_tile_loop<96, false>(C, o, l, qf, KB + (size_t)bh * KPOS * 96, VT + (size_t)bh * 64 * KPOS, qblk < 16 ? 0 : TL, qblk < 16 ? KPOS / 64 : LCX / 64, 0, 0, nullptr, 0, 0, 0, 0);
            const int row = qblk < 16 ? b * TL + qpos : NLAT + b * LCX + (qpos - TL);
            flash_store(o, l, OCAT + (size_t)row * DM + hh * 64, h);
        }
        if (c_on) { float wk[31]; const float* dww = in_ptr(ws, I_DWW) + (size_t)lq * 31 * 512;
#pragma unroll
            for (int kt = 0; kt < 31; ++kt) wk[kt] = dww[kt * 512 + C.tid];
            conv_unit(C, cu, (const bf16*)(ws + WS_ARENA + A_U), wk, in_ptr(ws, I_DWB)[lq * 512 + C.tid], in_ptr(ws, I_LNG) + lq * 512, in_ptr(ws, I_LNB) + lq * 512, OCAT); }
        if (w_on) { __syncthreads(); const size_t wo = (size_t)(2 * lq) * NEXP * DM * DM;
            wprep_items(C, 2 * k, 2 * k + 2, in_ptr(ws, I_MW1) + wo, in_ptr(ws, I_MW3) + wo, in_ptr(ws, I_MW2) + wo, (bf16*)(ws + WS_W13), (bf16*)(ws + WS_W2)); }
    }
}
DI void ph_natten2(const Ctx& C, const bf16* QN, const bf16* KN, const bf16* VTN, bf16* OCAT, const float* rpb  , bool last, unsigned* work_ctr, unsigned char* ws, int lq) {
    const int r = C.lane & 31, h = C.lane >> 5;
    LAS float* tab = (LAS float*)(C.lds + 2 * AttnGeo<64>::BUF);
    LAS int* uslot = (LAS int*)(tab + 1920);
    const int nunits = 1024 + (last ? 0 : 64);
    const int nwp = (NEXP * 3 * 256 + C.nb * 8 - 1) / (C.nb * 8); int wdone = 0;
    for (;;) {
        __syncthreads();
        if (wdone < nwp) { const size_t wo = (size_t)(2 * lq + 1) * NEXP * DM * DM; wprep_items(C, wdone, wdone + 2, in_ptr(ws, I_MW1) + wo, in_ptr(ws, I_MW3) + wo, in_ptr(ws, I_MW2) + wo, (bf16*)(ws + WS_W13), (bf16*)(ws + WS_W2)); wdone += 2; __syncthreads(); }
        if (C.tid == 0) *uslot = (int)__hip_atomic_fetch_add(work_ctr, 1u, __ATOMIC_RELAXED, __HIP_MEMORY_SCOPE_AGENT);
        __syncthreads();
        const int u = *uslot;
        if (u >= nunits) { if (wdone < nwp) { const size_t wo = (size_t)(2 * lq + 1) * NEXP * DM * DM; wprep_items(C, wdone, nwp, in_ptr(ws, I_MW1) + wo, in_ptr(ws, I_MW3) + wo, in_ptr(ws, I_MW2) + wo, (bf16*)(ws + WS_W13), (bf16*)(ws + WS_W2)); } break; }
        const bool isctx = u >= 1024;
        const int bh = isctx ? u - 1024 : (u >> 4), b = bh >> 3, hh = bh & 7;
        for (int i = C.tid; i < 15 * 128; i += 512) { const int dc = (i & 127) - 48; tab[i] = (dc >= 0 && dc < 31) ? rpb[hh * 465 + (i >> 7) * 31 + dc] * LOG2E : 0.f; }
        int qpos, row, grow = 0, qc = 0, rs = 0, cs = 0, rlo = 0, nband = 0;
        if (!isctx) { const int rg = u & 15; grow = 4 * rg + (C.wave >> 1); qc = 32 * (C.wave & 1) + r; qpos = grow * 64 + qc; row = b * TL + qpos;
            rs = grow - 4; rs = rs < 0 ? 0 : (rs > 56 ? 56 : rs); cs = qc - 8; cs = cs < 0 ? 0 : (cs > 48 ? 48 : cs);
            rlo = 4 * rg - 4; rlo = rlo < 0 ? 0 : (rlo > 56 ? 56 : rlo); int rhi = 4 * rg + 3 - 4; rhi = rhi < 0 ? 0 : (rhi > 56 ? 56 : rhi); nband = rhi + 8 - rlo; }
        else { qpos = TL + 32 * C.wave + r; row = NLAT + b * LCX + 32 * C.wave + r; }
        const bf16* qp = QN + ((size_t)bh * KPOS + qpos) * 64 + 8 * h;
        bf16x8 qf[4];
#pragma unroll
        for (int kk = 0; kk < 4; ++kk) qf[kk] = *(const bf16x8*)(qp + 16 * kk);
        f32x16 o[2];
#pragma unroll
        for (int i = 0; i < 16; ++i) { o[0][i] = 0.f; o[1][i] = 0.f; }
        float l = 0.f;
        attn_tile_loop<64, true>(C, o, l, qf, KN + (size_t)bh * KPOS * 64, VTN + (size_t)bh * 64 * KPOS, rlo * 64, nband, TL, LCX / 64, tab, grow, rs, qc, cs);
        flash_store(o, l, OCAT + (size_t)row * DM + 512 + hh * 64, h);
    }
}


DI void ph_mla_fin(const Ctx& C, const bf16* U, const bf16* QPRE, const bf16* KVPRE, const float* qg, const float* kg, const f32x2* CS, bf16* QB, bf16* KB, bf16* VT) {
    LAS bf16* VL = (LAS bf16*)C.lds;
    const int lane = C.lane, j = lane >> 3, sub = lane & 7;
    const float C2 = 0.10206207261596575f * LOG2E;
    float qgn[8], qgr[4], kgn[8], kgr[4];
#pragma unroll
    for (int e = 0; e < 8; ++e) { qgn[e] = qg[8 * sub + e] * C2; kgn[e] = kg[8 * sub + e]; }
#pragma unroll
    for (int m = 0; m < 4; ++m) { qgr[m] = qg[64 + sub + 8 * m] * C2; kgr[m] = kg[64 + sub + 8 * m]; }
    for (int u = C.vcu; u < MT / 64; u += C.nb) {
        const int row0 = 64 * u, b = row0 < NLAT ? (row0 >> 12) : ((row0 - NLAT) >> 8), pos0 = row0 < NLAT ? (row0 & 4095) : TL + ((row0 - NLAT) & 255);
        const bool lat = row0 < NLAT;
        const int pl = 8 * C.wave + j, row = row0 + pl, pos = pos0 + pl;
        const bf16* ur = U + (size_t)row * EV_INP;
        float sq = 0.f, skv = 0.f;
#pragma unroll
        for (int m = 0; m < 6; ++m) { float x[8]; unpack8(*(const u32x4*)(ur + 8 * (sub + 8 * m)), x);
#pragma unroll
            for (int e = 0; e < 8; ++e) sq += x[e] * x[e]; }
#pragma unroll
        for (int m = 0; m < 4; ++m) { float x[8]; unpack8(*(const u32x4*)(ur + 384 + 8 * (sub + 8 * m)), x);
#pragma unroll
            for (int e = 0; e < 8; ++e) skv += x[e] * x[e]; }
        sq = sum8(sq); skv = sum8(skv);
        const float rsq = 1.0f / sqrtf(sq * (1.f / 384.f) + EPS), rskv = 1.0f / sqrtf(skv * (1.f / 256.f) + EPS);
        float krv[4];
#pragma unroll
        for (int m = 0; m < 4; ++m) krv[m] = bf2f(ur[640 + sub + 8 * m]);
        float cr = 1.f, sr = 0.f, cc = 1.f, sc = 0.f;
        if (lat) { const f32x2 a0 = CS[pos * 16 + sub], a1 = CS[pos * 16 + 8 + sub]; cr = a0.x; sr = a0.y; cc = a1.x; sc = a1.y; }
        const bf16* qrow = QPRE + (size_t)row * 768; const bf16* kvrow = KVPRE + (size_t)row * 1024;
#pragma unroll 2
        for (int hh = 0; hh < 8; ++hh) {
            { float qn[8], qr[4]; unpack8(*(const u32x4*)(qrow + hh * 96 + 8 * sub), qn); float ss = 0.f;
#pragma unroll
              for (int e = 0; e < 8; ++e) qn[e] *= rsq;
#pragma unroll
              for (int m = 0; m < 4; ++m) { qr[m] = bf2f(qrow[hh * 96 + 64 + sub + 8 * m]) * rsq; ss += qr[m] * qr[m]; }
#pragma unroll
              for (int e = 0; e < 8; ++e) ss += qn[e] * qn[e];
              const float rn = 1.0f / sqrtf(sum8(ss) * (1.f / 96.f) + EPS);
#pragma unroll
              for (int e = 0; e < 8; ++e) qn[e] *= rn * qgn[e];
#pragma unroll
              for (int m = 0; m < 4; ++m) qr[m] *= rn * qgr[m];
              { const float x0 = qr[0], x1 = qr[1], y0 = qr[2], y1 = qr[3]; qr[0] = x0 * cr - x1 * sr; qr[1] = x1 * cr + x0 * sr; qr[2] = y0 * cc - y1 * sc; qr[3] = y1 * cc + y0 * sc; }
              bf16* qo = QB + ((size_t)(b * 8 + hh) * KPOS + pos) * 96;
              *(u32x4*)(qo + 8 * sub) = pack8(qn);
#pragma unroll
              for (int m = 0; m < 4; ++m) qo[64 + sub + 8 * m] = f2bf(qr[m]); }
            { float kn[8], kr[4]; unpack8(*(const u32x4*)(kvrow + hh * 128 + 8 * sub), kn); float ss = 0.f;
#pragma unroll
              for (int e = 0; e < 8; ++e) kn[e] *= rskv;
#pragma unroll
              for (int m = 0; m < 4; ++m) { kr[m] = krv[m]; ss += kr[m] * kr[m]; }
#pragma unroll
              for (int e = 0; e < 8; ++e) ss += kn[e] * kn[e];
              const float rn = 1.0f / sqrtf(sum8(ss) * (1.f / 96.f) + EPS);
#pragma unroll
              for (int e = 0; e < 8; ++e) kn[e] *= rn * kgn[e];
#pragma unroll
              for (int m = 0; m < 4; ++m) kr[m] *= rn * kgr[m];
              { const float x0 = kr[0], x1 = kr[1], y0 = kr[2], y1 = kr[3]; kr[0] = x0 * cr - x1 * sr; kr[1] = x1 * cr + x0 * sr; kr[2] = y0 * cc - y1 * sc; kr[3] = y1 * cc + y0 * sc; }
              bf16* ko = KB + ((size_t)(b * 8 + hh) * KPOS + pos) * 96;
              *(u32x4*)(ko + 8 * sub) = pack8(kn);
#pragma unroll
              for (int m = 0; m < 4; ++m) ko[64 + sub + 8 * m] = f2bf(kr[m]); }
            { float vv[8]; unpack8(*(const u32x4*)(kvrow + hh * 128 + 64 + 8 * sub), vv);
#pragma unroll
              for (int e = 0; e < 8; ++e) VL[(hh * 64 + 8 * sub + e) * 64 + pl] = f2bf(vv[e] * rskv); }
        }
        __syncthreads();
        { const int hd = C.tid;
            bf16* dst = VT + ((size_t)(b * 8 + (hd >> 6)) * 64 + (hd & 63)) * KPOS + pos0;
#pragma unroll
            for (int q = 0; q < 8; ++q) *(u32x4*)(dst + 8 * q) = *(const LAS u32x4*)(VL + hd * 64 + 8 * q); }
        __syncthreads();
    }
}

DI void conv_unit(const Ctx& C, int u, const bf16* U, const float (&wk)[31], float bias, const float* lng, const float* lnb, bf16* OCAT) {
    LAS float* G = (LAS float*)C.lds;
    const int c = C.tid;
    const int row0 = 32 * u; int base, t0, tseq;
    if (row0 < NLAT) { base = row0 & ~4095; t0 = row0 & 4095; tseq = TL; } else { const int rc = row0 - NLAT; base = NLAT + (rc & ~255); t0 = rc & 255; tseq = LCX; }
    __syncthreads();
    for (int rr = C.wave; rr < 62; rr += 8) { const int tt = t0 - 15 + rr; float g[8];
#pragma unroll
        for (int e = 0; e < 8; ++e) g[e] = 0.f;
        if (tt >= 0 && tt < tseq) { const bf16* ur = U + (size_t)(base + tt) * EV_INP; float av[8], gv[8]; unpack8(*(const u32x4*)(ur + 672 + 8 * C.lane), av); unpack8(*(const u32x4*)(ur + 1184 + 8 * C.lane), gv);
#pragma unroll
            for (int e = 0; e < 8; ++e) g[e] = av[e] * sigmoidf_(gv[e]); }
        *(LAS f32x4*)(G + rr * 512 + 8 * C.lane) = (f32x4){g[0], g[1], g[2], g[3]}; *(LAS f32x4*)(G + rr * 512 + 8 * C.lane + 4) = (f32x4){g[4], g[5], g[6], g[7]}; }
    __syncthreads();
    float acc[32];
#pragma unroll
    for (int t = 0; t < 32; ++t) acc[t] = bias;
#pragma unroll
    for (int rr = 0; rr < 62; ++rr) { const float gv = G[rr * 512 + c];
#pragma unroll
        for (int t = 0; t < 32; ++t) { const int k = rr - t; if (k >= 0 && k < 31) acc[t] += gv * wk[k]; } }
    __syncthreads();
#pragma unroll
    for (int t = 0; t < 32; ++t) G[t * 512 + c] = acc[t];
    __syncthreads();
#pragma unroll
    for (int q = 0; q < 4; ++q) {
        const int t = 4 * C.wave + q, row = row0 + t;
        const f32x4 a0 = *(const LAS f32x4*)(G + t * 512 + 8 * C.lane), a1 = *(const LAS f32x4*)(G + t * 512 + 8 * C.lane + 4);
        float x[8] = {a0.x, a0.y, a0.z, a0.w, a1.x, a1.y, a1.z, a1.w}; float s = 0.f;
#pragma unroll
        for (int e = 0; e < 8; ++e) s += x[e];
        const float mu = wave_sum(s) * (1.f / 512.f); float s2 = 0.f;
#pragma unroll
        for (int e = 0; e < 8; ++e) { x[e] -= mu; s2 += x[e] * x[e]; }
        const float rstd = 1.0f / sqrtf(wave_sum(s2) * (1.f / 512.f) + EPS);
        float y[8];
#pragma unroll
        for (int e = 0; e < 8; ++e) { const float z = x[e] * rstd * lng[8 * C.lane + e] + lnb[8 * C.lane + e]; y[e] = siluf_(z); }
        *(u32x4*)(OCAT + (size_t)row * DM + 512 + 8 * C.lane) = pack8(y);
    }
    __syncthreads();
}
DI void wprep_items(const Ctx& C, int k0, int k1, const float* w1, const float* w3, const float* w2, bf16* W13, bf16* W2) {
    LAS float* scr = (LAS float*)(C.lds + C.wave * 16640);
    const int gw = C.vcu * 8 + C.wave, ngw = C.nb * 8;
    constexpr int PER = 16 * 16, NIT = NEXP * 3 * PER;
    for (int k = k0; k < k1; ++k) { const int it = gw + k * ngw; if (it >= NIT) break;
        const int e = it / (3 * PER), r = it % (3 * PER), which = r / PER, q = r % PER, kb = q / 16, n0 = (q % 16) * 64;
#if MOE_F8
        if (which == 0)      transpose_item64_f8(w1 + (size_t)e * DM * DM, DM, DM, (unsigned char*)W13 + (size_t)e * 2048 * DM, (n0 >> 7) * 256 + (n0 & 127), scr, kb * 64, n0, C.lane);
        else if (which == 1) transpose_item64_f8(w3 + (size_t)e * DM * DM, DM, DM, (unsigned char*)W13 + (size_t)e * 2048 * DM, (n0 >> 7) * 256 + (n0 & 127) + 128, scr, kb * 64, n0, C.lane);
        else                 transpose_item64_f8(w2 + (size_t)e * DM * DM, DM, DM, (unsigned char*)W2 + (size_t)e * DM * DM, n0, scr, kb * 64, n0, C.lane); }
#else
        if (which == 0)      transpose_item64(w1 + (size_t)e * DM * DM, DM, DM, W13 + (size_t)e * 2048 * DM, (n0 >> 7) * 256 + (n0 & 127), scr, kb * 64, n0, C.lane);
        else if (which == 1) transpose_item64(w3 + (size_t)e * DM * DM, DM, DM, W13 + (size_t)e * 2048 * DM, (n0 >> 7) * 256 + (n0 & 127) + 128, scr, kb * 64, n0, C.lane);
        else                 transpose_item64(w2 + (size_t)e * DM * DM, DM, DM, W2 + (size_t)e * DM * DM, n0, scr, kb * 64, n0, C.lane); }
#endif
}
constexpr int WPREP_PER_WAVE = (NEXP * 3 * 256 + 2047) / 2048;

DI void shifted8(const bf16* up, const bf16* uc, const bf16* un, bool hp, bool hn, const float (&s0)[8], const float (&s1)[8], const float (&s2)[8], int c0, float (&o)[8]) {
    const u32x4 z = {0u, 0u, 0u, 0u};
    const u32x4 vp = hp ? *(const u32x4*)(up + c0) : z, vc = *(const u32x4*)(uc + c0), vn = hn ? *(const u32x4*)(un + c0) : z;
    float p[8], c[8], n[8]; unpack8(vp, p); unpack8(vc, c); unpack8(vn, n);
#pragma unroll
    for (int e = 0; e < 8; ++e) o[e] = p[e] * s0[e] + c[e] * s1[e] + n[e] * s2[e];
}
DI void load_sw(const float* sw, int c0, float (&s0)[8], float (&s1)[8], float (&s2)[8]) {
#pragma unroll
    for (int e = 0; e < 8; ++e) { s0[e] = sw[c0 + e]; s1[e] = sw[RW_IN + c0 + e]; s2[e] = sw[2 * RW_IN + c0 + e]; }
}
DI void ph_prep(const Ctx& C, const bf16* U, const float* sw  , const float* kkw  , const float* naqg, const float* nakg,
                bf16* R, bf16* V, bf16* K, bf16* KK, bf16* L, bf16* QN, bf16* KN, bf16* VTN) {
    LAS bf16* VL = (LAS bf16*)C.lds;
    const int lane = C.lane, hh = lane >> 3, sub = lane & 7;
    const float C2 = 0.125f * LOG2E;
    for (int u = C.vcu; u < MT / 32; u += C.nb) {
        const int row0 = 32 * u; const bool lat = row0 < NLAT;
        const int b = lat ? (row0 >> 12) : ((row0 - NLAT) >> 8), pos0 = lat ? (row0 & 4095) : TL + ((row0 - NLAT) & 255), tseq = lat ? TL : LCX, tb = lat ? (row0 & 4095) : ((row0 - NLAT) & 255);
#define PREP_ROWVARS(i) const int pl = 4 * C.wave + (i), row = row0 + pl, t = tb + pl; const bool hp = t > 0, hn = t < tseq - 1; \
            const bf16* uc = U + (size_t)row * OD_INP; const bf16* up = uc - OD_INP; const bf16* un = uc + OD_INP
        { float s0[8], s1[8], s2[8]; load_sw(sw, 8 * lane, s0, s1, s2);
          for (int i = 0; i < 4; ++i) { PREP_ROWVARS(i); float o[8]; shifted8(up, uc, un, hp, hn, s0, s1, s2, 8 * lane, o); *(u32x4*)(R + (size_t)row * 512 + 8 * lane) = pack8(o); } }
        { float s0[8], s1[8], s2[8]; load_sw(sw, 1024 + 8 * lane, s0, s1, s2);
          for (int i = 0; i < 4; ++i) { PREP_ROWVARS(i); float o[8]; shifted8(up, uc, un, hp, hn, s0, s1, s2, 1024 + 8 * lane, o); *(u32x4*)(V + (size_t)row * 512 + 8 * lane) = pack8(o); } }
        { float s0[8], s1[8], s2[8]; load_sw(sw, 512 + 8 * lane, s0, s1, s2); float kw[8];
#pragma unroll
          for (int e = 0; e < 8; ++e) kw[e] = kkw[8 * lane + e];
          for (int i = 0; i < 4; ++i) { PREP_ROWVARS(i); float o[8]; shifted8(up, uc, un, hp, hn, s0, s1, s2, 512 + 8 * lane, o); *(u32x4*)(K + (size_t)row * 512 + 8 * lane) = pack8(o);
              float kk[8]; float ss = 0.f;
#pragma unroll
              for (int e = 0; e < 8; ++e) { kk[e] = o[e] * kw[e]; ss += kk[e] * kk[e]; }
              ss = sum8(ss); const float rn = 1.0f / sqrtf(ss + 1e-12f);
#pragma unroll
              for (int e = 0; e < 8; ++e) kk[e] *= rn;
              *(u32x4*)(KK + (size_t)row * 512 + 8 * lane) = pack8(kk); } }
        if (lane < 48) { float s0[8], s1[8], s2[8]; load_sw(sw, 1536 + 8 * lane, s0, s1, s2);
          for (int i = 0; i < 4; ++i) { PREP_ROWVARS(i); float o[8]; shifted8(up, uc, un, hp, hn, s0, s1, s2, 1536 + 8 * lane, o);
              if (lane < 16) {
#pragma unroll
                  for (int e = 0; e < 8; ++e) { const float ex = __expf(2.f * o[e]); o[e] = 1.f - 2.f * __builtin_amdgcn_rcpf(ex + 1.f); }
              } else if (lane >= 32) {
#pragma unroll
                  for (int e = 0; e < 8; ++e) o[e] = sigmoidf_(o[e]);
              }
              *(u32x4*)(L + (size_t)row * 384 + 8 * lane) = pack8(o); } }
        { float gq[8], gk[8];
#pragma unroll
          for (int e = 0; e < 8; ++e) { gq[e] = naqg[8 * sub + e] * C2; gk[e] = nakg[8 * sub + e]; }
          for (int i = 0; i < 4; ++i) { const int pl = 4 * C.wave + i, row = row0 + pl, pos = pos0 + pl; const bf16* uc = U + (size_t)row * OD_INP;
            { float x[8]; unpack8(*(const u32x4*)(uc + RW_IN + 8 * lane), x); float ss = 0.f;
#pragma unroll
                for (int e = 0; e < 8; ++e) ss += x[e] * x[e];
                ss = sum8(ss); const float rn = 1.0f / sqrtf(ss * (1.f / 64.f) + EPS);
#pragma unroll
                for (int e = 0; e < 8; ++e) x[e] = x[e] * rn * gq[e];
                *(u32x4*)(QN + ((size_t)(b * 8 + hh) * KPOS + pos) * 64 + 8 * sub) = pack8(x); }
            { float x[8]; unpack8(*(const u32x4*)(uc + RW_IN + 512 + 8 * lane), x); float ss = 0.f;
#pragma unroll
                for (int e = 0; e < 8; ++e) ss += x[e] * x[e];
                ss = sum8(ss); const float rn = 1.0f / sqrtf(ss * (1.f / 64.f) + EPS);
#pragma unroll
                for (int e = 0; e < 8; ++e) x[e] = x[e] * rn * gk[e];
                *(u32x4*)(KN + ((size_t)(b * 8 + hh) * KPOS + pos) * 64 + 8 * sub) = pack8(x); }
            { const u32x4 vv = *(const u32x4*)(uc + RW_IN + 1024 + 8 * lane); const unsigned w4[4] = {vv.x, vv.y, vv.z, vv.w};
#pragma unroll
                for (int e = 0; e < 8; ++e) { const int dv = 8 * sub + e; VL[(hh * 64 + dv) * 32 + pl] = (bf16)((e & 1) ? (w4[e >> 1] >> 16) : (w4[e >> 1] & 0xffffu)); } } } }
#undef PREP_ROWVARS
        __syncthreads();
        { const int hd = C.tid; bf16* dst = VTN + ((size_t)(b * 8 + (hd >> 6)) * 64 + (hd & 63)) * KPOS + pos0;
#pragma unroll
            for (int q = 0; q < 4; ++q) *(u32x4*)(dst + 8 * q) = *(const LAS u32x4*)(VL + hd * 32 + 8 * q); }
        __syncthreads();
    }
}

DI int scan_row(int s, int d, int b) { if (s < LCX) return NLAT + b * LCX + (d ? (LCX - 1 - s) : s); const int t = s - LCX; return b * TL + (d ? (TL - 1 - t) : t); }


constexpr int CCH = 16, NCHK = KPOS / CCH, NPROB = NB * 8 * 2 * NCHK, IMG_ELEMS = 3 * 32 * 16;
template <int N> struct ICk { static constexpr int value = N; };
DI int crow_(int reg, int h) { return (reg & 3) + 8 * (reg >> 2) + 4 * h; }
DI bf16x8 pack_lo8(const f32x16& x) {
    u32x4 p; p.x = pk2(x[0], x[1]); p.y = pk2(x[2], x[3]); p.z = pk2(x[4], x[5]); p.w = pk2(x[6], x[7]); return __builtin_bit_cast(bf16x8, p); }
DI bf16x8 pack_hi8(const f32x16& x) { u32x4 p; p.x = pk2(x[8], x[9]); p.y = pk2(x[10], x[11]); p.z = pk2(x[12], x[13]); p.w = pk2(x[14], x[15]); return __builtin_bit_cast(bf16x8, p); }
DI int perm16(int k) { return (k & ~15) | swap23(k & 15); }

DI void ph_wkv_pre(const Ctx& C, const bf16* R, const bf16* K, const bf16* KK, const float* LW, const bf16* AR_, const float* ka, bf16* IMG) {
    LAS unsigned char* wl = C.lds + C.wave * 13312;
    LAS bf16* ARl = (LAS bf16*)wl; LAS bf16* BKl = (LAS bf16*)(wl + 4608); LAS float* Ll = (LAS float*)(wl + 9216); LAS bf16* OUT = (LAS bf16*)(wl + 10240);
    const int lane = C.lane, r = lane & 31, h = lane >> 5;
    const int gw = C.vcu * 8 + C.wave, ngw = C.nb * 8;
    for (int p = gw; p < NPROB; p += ngw) {
        const int j = p % NCHK, rest = p / NCHK, d = rest & 1, hh = (rest >> 1) & 7, b = rest >> 4;
        const float* Wd = LW + (size_t)d * MT * 512; const bf16* Ad = AR_ + (size_t)d * MT * 512;
        const float kav = ka[hh * 64 + lane];
        const int row0 = scan_row(j * CCH, d, b), sg = d ? -1 : 1;
        float lw[16]; bf16 rr[16], kx[16], kkx[16], ax[16];
#pragma unroll
        for (int t = 0; t < 16; ++t) { const size_t off = (size_t)(row0 + sg * t) * 512 + hh * 64 + lane; lw[t] = Wd[off]; rr[t] = R[off]; kx[t] = K[off]; kkx[t] = KK[off]; ax[t] = Ad[off]; }
        float cum = 0.f, e0 = 1.f;
#pragma unroll
        for (int t = 0; t < 16; ++t) {
            cum += lw[t]; const float e1 = __expf(cum), ei = __builtin_amdgcn_rcpf(e1);
            const float kkv = bf2f(kkx[t]), av = bf2f(ax[t]), keff = bf2f(kx[t]) * (1.f + (av - 1.f) * kav);
            ARl[t * 72 + lane] = f2bf(-kkv * e0); ARl[(16 + t) * 72 + lane] = f2bf(bf2f(rr[t]) * e1);
            BKl[t * 72 + lane] = f2bf(kkv * av * ei); BKl[(16 + t) * 72 + lane] = f2bf(keff * ei);
            e0 = e1;
        }
        asm volatile("s_waitcnt lgkmcnt(0)" ::: "memory");
        f32x16 g;
#pragma unroll
        for (int i = 0; i < 16; ++i) g[i] = 0.f;
#pragma unroll
        for (int q = 0; q < 4; ++q) g = MFMA32(*(const LAS bf16x8*)(ARl + r * 72 + 16 * q + 8 * h), *(const LAS bf16x8*)(BKl + r * 72 + 16 * q + 8 * h), g);
        const int sI = r & 15; const bool isk = r >= 16;
#pragma unroll
        for (int i = 0; i < 16; ++i) {
            const int row = crow_(i, h), t = row & 15; const bool keep = (i < 8) ? (sI < t) : (sI <= t); const float val = keep ? g[i] : 0.f;
            if (i < 8) { if (!isk) { Ll[t * 16 + sI] = val; OUT[512 + row * 16 + perm16(sI)] = 0; } else OUT[row * 16 + sI] = f2bf(val); }
            else       { if (!isk) OUT[512 + row * 16 + perm16(sI)] = f2bf(val); else OUT[row * 16 + sI] = f2bf(val); }
        }
        asm volatile("s_waitcnt lgkmcnt(0)" ::: "memory");
        { const int c = lane & 15; float Pr[16];
            Pr[0] = (c == 0) ? 1.f : 0.f;
#pragma unroll
            for (int t = 1; t < 16; ++t) { const float lrow = Ll[t * 16 + c]; float acc = (c == t) ? 1.f : 0.f;
#pragma unroll
                for (int u = 0; u < t; ++u) acc += rdlane(lrow, u) * Pr[u];
                Pr[t] = acc; }
            if (lane < 16) {
#pragma unroll
                for (int t = 0; t < 16; ++t) { OUT[1024 + t * 16 + perm16(c)] = f2bf(Pr[t]); OUT[1024 + (16 + t) * 16 + c] = 0; } } }
        asm volatile("s_waitcnt lgkmcnt(0)" ::: "memory");
        { bf16* dst = IMG + (size_t)p * IMG_ELEMS;
#pragma unroll
            for (int q = 0; q < 3; ++q) *(u32x4*)(dst + (q * 64 + lane) * 8) = *(const LAS u32x4*)(OUT + (q * 64 + lane) * 8); }
        asm volatile("s_waitcnt lgkmcnt(0)" ::: "memory");
    }
}

DI void ph_wkv_chunk(const Ctx& C, const bf16* R, const bf16* V, const bf16* K, const bf16* KK, const float* LW, const bf16* AR_, const float* ka, const bf16* IMG, bf16* YS) {
    constexpr int S_AR = 0, S_BKT = 4608, S_VT = 9728, S_VT2 = 11264, S_GC = 12800, S_MM = 13056, S_MRB = 14592, S_PP = 16128, SLOT = 17664, CUMO = 2 * SLOT, YSTO = CUMO + 8192, DEPTH = 4;
    const int lane = C.lane, wv = C.wave, r = lane & 31, h = lane >> 5;
    const bool isE = wv == 2 || wv == 3 || wv == 6 || wv == 7, isS = wv < 2;
    const int te = (wv == 2 ? 0 : (wv == 3 ? 1 : (wv == 6 ? 2 : 3))) * 64 + lane, et = te >> 4, ekq = te & 15;
    const int vhf = te >> 7, vt = (te >> 3) & 15, viq = te & 7;
    const int hf = wv & 1;
    for (int cid0 = C.bid; cid0 < 128; cid0 += C.nb) {
        const int chain = cid0, b = chain >> 4, hh = (chain >> 1) & 7, d = chain & 1;
        const float* Wd = LW + (size_t)d * MT * 512; const bf16* Ad = AR_ + (size_t)d * MT * 512; bf16* Yd = YS + (size_t)d * MT * 512;
        const bf16* img = IMG + (size_t)(((b * 8 + hh) * 2 + d) * NCHK) * IMG_ELEMS;
        f32x16 ST[2];
#pragma unroll
        for (int i = 0; i < 16; ++i) { ST[0][i] = 0.f; ST[1][i] = 0.f; }
        const f32x4 kav = *(const f32x4*)(ka + hh * 64 + 4 * ekq);
        unsigned ring[DEPTH][16];
        __syncthreads();
        auto issue = [&](int ch, unsigned (&rg)[16]) __attribute__((always_inline)) {
            if (ch < 0 || ch >= NCHK) return;
            const int row0 = scan_row(ch * CCH, d, b), sg = d ? -1 : 1;
            if (isE) {
                const size_t off = (size_t)(row0 + sg * et) * 512 + hh * 64 + 4 * ekq;
                const u32x2 x0 = *(const u32x2*)(R + off), x1 = *(const u32x2*)(K + off), x2 = *(const u32x2*)(KK + off), x3 = *(const u32x2*)(Ad + off);
                const u32x2 x4 = *(const u32x2*)(V + (size_t)(row0 + sg * vt) * 512 + hh * 64 + 32 * vhf + 4 * viq);
                rg[0] = x0.x; rg[1] = x0.y; rg[2] = x1.x; rg[3] = x1.y; rg[4] = x2.x; rg[5] = x2.y; rg[6] = x3.x; rg[7] = x3.y; rg[8] = x4.x; rg[9] = x4.y;
                asm volatile("; wkv issue role E" ::);
            } else if (wv == 4) {
#define W5_(t) rg[(t)] = __builtin_bit_cast(unsigned, Wd[(size_t)(row0 + sg * (t)) * 512 + hh * 64 + lane])
                W5_(0); W5_(1); W5_(2); W5_(3); W5_(4); W5_(5); W5_(6); W5_(7); W5_(8); W5_(9); W5_(10); W5_(11); W5_(12); W5_(13); W5_(14); W5_(15);
#undef W5_
                asm volatile("; wkv issue role C" ::);
            } else if (wv == 5) {
#define W6_(q) do { const u32x4 x = *(const u32x4*)(img + (size_t)ch * IMG_ELEMS + ((q) * 64 + lane) * 8); rg[4 * (q)] = x.x; rg[4 * (q) + 1] = x.y; rg[4 * (q) + 2] = x.z; rg[4 * (q) + 3] = x.w; } while (0)
                W6_(0); W6_(1); W6_(2);
#undef W6_
                asm volatile("; wkv issue role V" ::);
            }
        };
        issue(0, ring[0]); issue(1, ring[1]); issue(2, ring[2]); issue(3, ring[3]);
#define WKV_BAR() asm volatile("s_waitcnt lgkmcnt(0)\n\ts_barrier" ::: "memory")
#define WKV_LOOP(...) for (int n0 = -2; n0 < NCHK; n0 += DEPTH) { auto iter = [&](auto kc) __attribute__((always_inline)) { constexpr int kk = decltype(kc)::value; \
            constexpr int riE = (kk + 3) % DEPTH, riW = kk % DEPTH; (void)riE; (void)riW; const int n = n0 + kk; (void)n; __VA_ARGS__; WKV_BAR(); }; iter(ICk<0>{}); iter(ICk<1>{}); iter(ICk<2>{}); iter(ICk<3>{}); }
        if (isS) {
            WKV_LOOP({
                if (n >= 0 && n < NCHK) {
                    const LAS unsigned char* B = C.lds + (n & 1) * SLOT;
                    f32x16 T1;
                    _Pragma("unroll") for (int i = 0; i < 16; ++i) T1[i] = 0.f;
                    _Pragma("unroll") for (int tau = 0; tau < 2; ++tau) {
                        T1 = MFMA32(*(const LAS bf16x8*)(B + S_AR + r * 144 + (32 * tau + 8 * h) * 2), pack_lo8(ST[tau]), T1);
                        T1 = MFMA32(*(const LAS bf16x8*)(B + S_AR + r * 144 + (32 * tau + 16 + 8 * h) * 2), pack_hi8(ST[tau]), T1);
                    }
                    const bf16x8 vtf = *(const LAS bf16x8*)(B + (hf ? S_VT2 : S_VT) + r * 48 + 16 * h);
                    T1 = MFMA32(*(const LAS bf16x8*)(B + S_MM + r * 48 + 16 * h), vtf, T1);
                    f32x16 ET;
                    _Pragma("unroll") for (int i = 0; i < 16; ++i) ET[i] = 0.f;
                    ET = MFMA32(*(const LAS bf16x8*)(B + S_PP + r * 48 + 16 * h), pack_lo8(T1), ET);
                    const bf16x8 ef = pack_lo8(ET);
                    T1 = MFMA32(*(const LAS bf16x8*)(B + S_MRB + r * 48 + 16 * h), ef, T1);
                    _Pragma("unroll") for (int tau = 0; tau < 2; ++tau) {
                        ST[tau] = MFMA32(*(const LAS bf16x8*)(B + S_BKT + (32 * tau + r) * 80 + 16 * h), ef, ST[tau]);
                        ST[tau] = MFMA32(*(const LAS bf16x8*)(B + S_BKT + (32 * tau + r) * 80 + 32 + 16 * h), vtf, ST[tau]);
                        _Pragma("unroll") for (int g4 = 0; g4 < 4; ++g4) { const f32x4 gc = *(const LAS f32x4*)(B + S_GC + (32 * tau + 8 * g4 + 4 * h) * 4);
                            ST[tau][4 * g4] *= gc.x; ST[tau][4 * g4 + 1] *= gc.y; ST[tau][4 * g4 + 2] *= gc.z; ST[tau][4 * g4 + 3] *= gc.w; }
                    }
                    LAS float* ys = (LAS float*)(C.lds + YSTO) + ((n & 1) * 2 + hf) * 512;
                    _Pragma("unroll") for (int q = 0; q < 8; ++q) ys[(8 * (q >> 2) + 4 * h + (q & 3)) * 32 + r] = T1[8 + q];
                }
            });
        } else if (isE) {
            WKV_LOOP({
                const int ch = n + 1;
                if (ch >= 0) {
                    if (ch < NCHK) {
                        LAS unsigned char* B = C.lds + (ch & 1) * SLOT; const LAS float* ec = (const LAS float*)(C.lds + CUMO) + (ch & 1) * 1024;
                        const f32x4 e1 = *(const LAS f32x4*)(ec + et * 64 + 4 * ekq);
                        f32x4 e0 = {1.f, 1.f, 1.f, 1.f}; if (et > 0) e0 = *(const LAS f32x4*)(ec + (et - 1) * 64 + 4 * ekq);
                        const float rv[4] = {bflo(ring[riE][0]), bfhi(ring[riE][0]), bflo(ring[riE][1]), bfhi(ring[riE][1])}; const float kv[4] = {bflo(ring[riE][2]), bfhi(ring[riE][2]), bflo(ring[riE][3]), bfhi(ring[riE][3])};
                        const float kkv[4] = {bflo(ring[riE][4]), bfhi(ring[riE][4]), bflo(ring[riE][5]), bfhi(ring[riE][5])}; const float av[4] = {bflo(ring[riE][6]), bfhi(ring[riE][6]), bflo(ring[riE][7]), bfhi(ring[riE][7])};
                        float ah[4]; float rh[4]; float bc[4]; float kc4[4];
                        _Pragma("unroll") for (int e = 0; e < 4; ++e) { const float ei = __builtin_amdgcn_rcpf(e1[e]);
                            ah[e] = -kkv[e] * e0[e]; rh[e] = rv[e] * e1[e]; bc[e] = kkv[e] * av[e] * ei; kc4[e] = kv[e] * (1.f + (av[e] - 1.f) * kav[e]) * ei; }
                        const int pk = perm16(4 * ekq);
                        *(LAS u32x2*)((LAS bf16*)(B + S_AR) + et * 72 + pk) = (u32x2){pk2(ah[0], ah[1]), pk2(ah[2], ah[3])};
                        *(LAS u32x2*)((LAS bf16*)(B + S_AR) + (16 + et) * 72 + pk) = (u32x2){pk2(rh[0], rh[1]), pk2(rh[2], rh[3])};
                        const int pt = perm16(et);
                        _Pragma("unroll") for (int e = 0; e < 4; ++e) { ((LAS bf16*)(B + S_BKT))[(4 * ekq + e) * 40 + pt] = f2bf(bc[e]); ((LAS bf16*)(B + S_BKT))[(4 * ekq + e) * 40 + 16 + et] = f2bf(kc4[e]); }
                        if (et == 15) *(LAS f32x4*)((LAS float*)(B + S_GC) + 4 * ekq) = e1;
                        LAS bf16* vtp = (LAS bf16*)(B + (vhf ? S_VT2 : S_VT)) + (4 * viq) * 24 + vt;
                        vtp[0] = (bf16)(ring[riE][8] & 0xffffu); vtp[24] = (bf16)(ring[riE][8] >> 16); vtp[48] = (bf16)(ring[riE][9] & 0xffffu); vtp[72] = (bf16)(ring[riE][9] >> 16);
                    }
                    issue(ch + DEPTH, ring[riE]);
                }
            });
        } else if (wv == 4) {
            WKV_LOOP({
                const int ch = n + 2;
                if (ch < NCHK) { LAS float* ec = (LAS float*)(C.lds + CUMO) + (ch & 1) * 1024; float c = 0.f;
#define C5_(t) do { c += __builtin_bit_cast(float, ring[riW][(t)]); ec[(t) * 64 + lane] = __expf(c); } while (0)
                    C5_(0); C5_(1); C5_(2); C5_(3); C5_(4); C5_(5); C5_(6); C5_(7); C5_(8); C5_(9); C5_(10); C5_(11); C5_(12); C5_(13); C5_(14); C5_(15);
                }
                issue(ch + DEPTH, ring[riW]);
            });
        } else {
            WKV_LOOP({
                { const int chy = n - 1;
                  if (chy >= 0 && chy < NCHK) { const int yh = lane >> 5, yt = (lane & 31) >> 1, yi = 16 * (lane & 1);
                    const LAS float* ys = (const LAS float*)(C.lds + YSTO) + ((chy & 1) * 2 + yh) * 512 + yt * 32 + yi;
                    bf16* dst = Yd + (size_t)(scan_row(chy * CCH, d, b) + (d ? -1 : 1) * yt) * 512 + hh * 64 + 32 * yh + yi;
                    _Pragma("unroll") for (int q = 0; q < 2; ++q) { const f32x4 a0 = *(const LAS f32x4*)(ys + 8 * q); const f32x4 a1 = *(const LAS f32x4*)(ys + 8 * q + 4);
                        *(u32x4*)(dst + 8 * q) = (u32x4){pk2(a0.x, a0.y), pk2(a0.z, a0.w), pk2(a1.x, a1.y), pk2(a1.z, a1.w)}; } } }
                const int ch = n + 1;
                if (ch >= 0) {
                    if (ch < NCHK) { LAS unsigned char* B = C.lds + (ch & 1) * SLOT;
                        const int irow = lane >> 1; const int ihv = lane & 1;
                        *(LAS u32x4*)(B + S_MM + irow * 48 + ihv * 16) = (u32x4){ring[riE][0], ring[riE][1], ring[riE][2], ring[riE][3]};
                        *(LAS u32x4*)(B + S_MRB + irow * 48 + ihv * 16) = (u32x4){ring[riE][4], ring[riE][5], ring[riE][6], ring[riE][7]};
                        *(LAS u32x4*)(B + S_PP + irow * 48 + ihv * 16) = (u32x4){ring[riE][8], ring[riE][9], ring[riE][10], ring[riE][11]};
                    }
                    issue(ch + DEPTH, ring[riE]);
                }
            });
        }
#undef C5_
#undef WKV_LOOP
#undef WKV_BAR
    }
}

DI void ph_post(const Ctx& C, const bf16* YS, const bf16* R, const bf16* V, const bf16* K, const bf16* A2, const float* ka, const bf16* G, const float* rk, const float* gng, const float* gnb, bf16* OCAT, bool last) {
    const int gw = C.bid * 8 + C.wave, ngw = C.nb * 8, lane = C.lane, nrows = last ? NLAT : MT;
    for (int row = gw; row < nrows; row += ngw) {
        const size_t o = (size_t)row * 512 + 8 * lane;
        float y[8], y1[8]; unpack8(*(const u32x4*)(YS + o), y); unpack8(*(const u32x4*)(YS + (size_t)MT * 512 + o), y1);
#pragma unroll
        for (int e = 0; e < 8; ++e) y[e] += y1[e];
        float r[8], v[8], kx[8], a0[8], a1[8], g[8];
        unpack8(*(const u32x4*)(R + o), r); unpack8(*(const u32x4*)(V + o), v); unpack8(*(const u32x4*)(K + o), kx); unpack8(*(const u32x4*)(A2 + o), a0); unpack8(*(const u32x4*)(A2 + (size_t)MT * 512 + o), a1); unpack8(*(const u32x4*)(G + o), g);
        float bsum = 0.f;
#pragma unroll
        for (int e = 0; e < 8; ++e) { const float kae = ka[8 * lane + e]; bsum += r[e] * (kx[e] * (1.f + (a0[e] - 1.f) * kae) + kx[e] * (1.f + (a1[e] - 1.f) * kae)) * rk[8 * lane + e]; }
        bsum = sum8(bsum);
        float s = 0.f;
#pragma unroll
        for (int e = 0; e < 8; ++e) { y[e] += bsum * v[e]; s += y[e]; }
        const float mu = sum8(s) * (1.f / 64.f); float s2 = 0.f;
#pragma unroll
        for (int e = 0; e < 8; ++e) { y[e] -= mu; s2 += y[e] * y[e]; }
        const float rstd = 1.0f / sqrtf(sum8(s2) * (1.f / 64.f) + GN_EPS);
        float out[8];
#pragma unroll
        for (int e = 0; e < 8; ++e) out[e] = (y[e] * rstd * gng[8 * lane + e] + gnb[8 * lane + e]) * g[e];
        *(u32x4*)(OCAT + (size_t)row * DM + 8 * lane) = pack8(out);
    }
}

DI void ph_topk2(const Ctx& C, const float* AFFT, const float* AFFC, int* ROWS, float* GATE, int* SLOT, bool last) {
    LAS unsigned* wcnt = (LAS unsigned*)C.lds;
    LAS unsigned* cnt = wcnt + 16;
    const int tid = C.tid, nprob = last ? 128 : 256;
    for (int p = C.bid; p < nprob; p += C.nb) {
        const bool isctx = p >= 128; const int be = p & 127, b = be >> 4, e = be & 15;
        const int n = isctx ? LCX : TL, cap = isctx ? CAPC : CAPL;
        const float* src = isctx ? AFFC + (size_t)be * LCX : AFFT + (size_t)be * TL;
        unsigned v[8]; const int per = isctx ? 1 : 8, t0 = tid * per;
#pragma unroll
        for (int q = 0; q < 8; ++q) v[q] = 0u;
        if (!isctx) { const u32x4 a0 = *(const u32x4*)(src + t0), a1 = *(const u32x4*)(src + t0 + 4); v[0] = a0.x; v[1] = a0.y; v[2] = a0.z; v[3] = a0.w; v[4] = a1.x; v[5] = a1.y; v[6] = a1.z; v[7] = a1.w; }
        else if (tid < LCX) v[0] = __builtin_bit_cast(unsigned, src[tid]);
        __syncthreads();
        unsigned T = 0u;
        for (int bit = 30; bit >= 0; --bit) {
            const unsigned cand = T | (1u << bit); unsigned c = 0u;
#pragma unroll
            for (int q = 0; q < 8; ++q) c += (unsigned)__builtin_popcountll(__builtin_amdgcn_ballot_w64(v[q] >= cand));
            LAS unsigned* wc = wcnt + (bit & 1) * 8;
            if (C.lane == 0) wc[C.wave] = c;
            __syncthreads();
            const unsigned tot = wc[0] + wc[1] + wc[2] + wc[3] + wc[4] + wc[5] + wc[6] + wc[7];
            if (tot >= (unsigned)cap) T = cand;
        }
        unsigned myc = 0u;
#pragma unroll
        for (int q = 0; q < 8; ++q) myc += (v[q] > T ? 0x10000u : 0u) + ((v[q] == T && (isctx ? (q == 0 && tid < LCX) : true)) ? 1u : 0u);
        __syncthreads();
        cnt[tid] = myc;
        __syncthreads();
        for (int off = 1; off < 512; off <<= 1) { const unsigned add = tid >= off ? cnt[tid - off] : 0u; __syncthreads(); cnt[tid] += add; __syncthreads(); }
        const unsigned total = cnt[511], keq = (unsigned)cap - (total >> 16);
        unsigned before = cnt[tid] - myc;
        for (int q = 0; q < per; ++q) { const int t = t0 + q; if (t >= n) break; const unsigned x = v[q]; const unsigned gtb = before >> 16, eqb = before & 0xFFFFu;
            const bool sel = x > T || (x == T && eqb < keq);
            if (sel) { const int jx = (int)(gtb + (eqb < keq ? eqb : keq));
                const int slot = isctx ? NB * CAPL + b * CAPC + jx : b * CAPL + jx, row = isctx ? NLAT + b * LCX + t : b * TL + t;
                ROWS[e * ESLOTS + slot] = row; GATE[e * ESLOTS + slot] = __builtin_bit_cast(float, x); SLOT[(size_t)row * 16 + e] = slot; }
            before += (x > T ? 0x10000u : 0u) + (x == T ? 1u : 0u); }
        __syncthreads();
    }
}


DI void ph_combine(const Ctx& C, float* xlat, float* xctx, const float* modg2  , const int* SLOT, const bf16* Y2, bool last,
                   const float* ngain  , const float* nmod  , bf16* H) {
    const int gw = C.bid * 8 + C.wave, ngw = C.nb * 8, lane = C.lane, nrows = last ? NLAT : MT;
    for (int row = gw; row < nrows; row += ngw) {
        float* xr = row < NLAT ? xlat + (size_t)row * DM : xctx + (size_t)(row - NLAT) * DM;
        const int mi = row < NLAT ? (row >> 12) : 8;
        const int sv = SLOT[(size_t)row * 16 + (lane & 15)];
        f32x4 acc[4];
#pragma unroll
        for (int j = 0; j < 4; ++j) acc[j] = (f32x4){0.f, 0.f, 0.f, 0.f};
#pragma unroll
        for (int e = 0; e < 16; ++e) {
            const int s = __builtin_amdgcn_readlane(sv, e);
            if (s >= 0) { const bf16* yp = Y2 + ((size_t)e * ESLOTS + s) * DM + 4 * lane;
#pragma unroll
                for (int j = 0; j < 4; ++j) { const u32x2 w = *(const u32x2*)(yp + 256 * j); acc[j] += (f32x4){bflo(w.x), bfhi(w.x), bflo(w.y), bfhi(w.y)}; } }
        }
#pragma unroll
        for (int j = 0; j < 4; ++j) { const int c = 256 * j + 4 * lane; const f32x4 g = *(const f32x4*)(modg2 + mi * 6144 + c); f32x4 x = *(const f32x4*)(xr + c); x += g * acc[j]; *(f32x4*)(xr + c) = x; acc[j] = x; }
        if (ngain) {
            float ss = 0.f;
#pragma unroll
            for (int j = 0; j < 4; ++j) ss += acc[j].x * acc[j].x + acc[j].y * acc[j].y + acc[j].z * acc[j].z + acc[j].w * acc[j].w;
            const float rs = 1.0f / sqrtf(wave_sum(ss) * (1.f / 1024.f) + EPS);
            const float* mp = nmod + mi * 6144;
#pragma unroll
            for (int j = 0; j < 4; ++j) { const int c = 256 * j + 4 * lane;
                const f32x4 g = *(const f32x4*)(ngain + c), sc = *(const f32x4*)(mp + 1024 + c), sh = *(const f32x4*)(mp + c);
                const f32x4 hv = (acc[j] * rs) * g * (sc + 1.0f) + sh;
                *(u32x2*)(H + (size_t)row * DM + c) = (u32x2){pk2(hv.x, hv.y), pk2(hv.z, hv.w)}; }
        }
    }
}

template <int N> struct IC { static constexpr int value = N; };
DI const float* in_ptr(const unsigned char* ws, int k) { const unsigned long long v = ((const unsigned long long*)(ws + 128 * 1024))[k];
    const unsigned lo = __builtin_amdgcn_readfirstlane((unsigned)v), hi = __builtin_amdgcn_readfirstlane((unsigned)(v >> 32));
    return (const float*)(__attribute__((address_space(1))) const float*)(((unsigned long long)hi << 32) | lo); }
template <class T> DI T* launder_ptr(T* p) { unsigned long long v = (unsigned long long)p; unsigned lo = (unsigned)v, hi = (unsigned)(v >> 32); asm volatile("" : "+v"(lo), "+v"(hi));
    lo = __builtin_amdgcn_readfirstlane(lo); hi = __builtin_amdgcn_readfirstlane(hi); return (T*)(__attribute__((address_space(1))) T*)(((unsigned long long)hi << 32) | lo); }
constexpr int N_PHASES = 1 + 23 + 22;
constexpr size_t WS_PTRS = 128 * 1024;
#define P_XC    ((float*)(ws + WS_XC))
#define P_MOD   ((const float*)(ws + WS_MOD))
#define P_HB    ((bf16*)(ws + WS_HB))
#define P_OCAT  ((bf16*)(ws + WS_OCAT))
#define P_AR    (ws + WS_ARENA)
#define P_ROWS  ((int*)(ws + WS_ROWS))
#define P_GATE  ((float*)(ws + WS_GATE))
#define P_SLOT  ((int*)(ws + WS_SLOT))
#define P_AFFT  ((float*)(ws + WS_AFFT))
#define P_AFFC  ((float*)(ws + WS_AFFC))
#define P_W13   ((bf16*)(ws + WS_W13))
#define P_W2    ((bf16*)(ws + WS_W2))
#define P_U     ((bf16*)(P_AR + A_U))
#define P_QPRE  ((float*)(P_AR + A_QPRE))
#define P_KVPRE ((float*)(P_AR + A_KVPRE))
#define P_QB    ((bf16*)(P_AR + A_QB))
#define P_KB    ((bf16*)(P_AR + A_KB))
#define P_VT    ((bf16*)(P_AR + A_VT))
#define P_W     ((float*)(P_AR + A_W))
#define P_KEFF  ((bf16*)(P_AR + A_KEFF))
#define P_R     ((bf16*)(P_AR + A_R))
#define P_V     ((bf16*)(P_AR + A_V))
#define P_KK    ((bf16*)(P_AR + A_KK))
#define P_G     ((bf16*)(P_AR + A_G))
#define P_K     ((bf16*)(P_AR + A_K))
#define P_L     ((bf16*)(P_AR + A_L))
#define P_QN    ((bf16*)(P_AR + A_QN))
#define P_KN    ((bf16*)(P_AR + A_KN))
#define P_VTN   ((bf16*)(P_AR + A_VTN))
#define P_YS    ((bf16*)(P_AR + A_YS))
#define P_IMG   ((bf16*)(P_AR + A_IMG))
#define P_HID   ((bf16*)(P_AR + A_HID))
#define P_Y2    ((bf16*)(P_AR + A_Y2))
#define MODL(i) (P_MOD + (size_t)(i) * 9 * 6144)
#if MOE_F8
#define MOE1_PHASE(NMT) do { pg8::Gemm g{P_HB, P_W13, DM / 2, DM / 2, P_ROWS, SCALE_W, SCALE_ONE}; pg8::OrderMoE S{(NMT), 8, 17, C.nb, C.vcu}; pg8::EpiAdapt<EpiGlu8> E{EpiGlu8{(unsigned char*)P_HID}}; \
        pg8::gemm_phase<pg8::EpiAdapt<EpiGlu8>, pg8::OrderMoE, true>(C.lds, g, S, E, C.tid); } while (0)
#define MOE2_PHASE(NMT) do { pg8::Gemm g{P_HID, P_W2, DM / 2, DM / 2, nullptr, SCALE_W, SCALE_HID}; pg8::OrderMoE S{(NMT), 4, 17, C.nb, C.vcu}; pg8::EpiAdapt<EpiGate> E{EpiGate{P_Y2, P_GATE}}; \
        pg8::gemm_phase<pg8::EpiAdapt<EpiGate>, pg8::OrderMoE, true>(C.lds, g, S, E, C.tid); } while (0)
#else
#define MOE1_PHASE(NMT) do { pg8::Gemm g{P_HB, P_W13, DM, DM, P_ROWS}; pg8::OrderMoE S{(NMT), 8, 17, C.nb, C.vcu}; pg8::EpiAdapt<EpiGlu> E{EpiGlu{P_HID}}; pg8::gemm_phase(C.lds, g, S, E, C.tid); } while (0)
#define MOE2_PHASE(NMT) do { pg8::Gemm g{P_HID, P_W2, DM, DM, nullptr}; pg8::OrderMoE S{(NMT), 4, 17, C.nb, C.vcu}; pg8::EpiAdapt<EpiGate> E{EpiGate{P_Y2, P_GATE}}; pg8::gemm_phase(C.lds, g, S, E, C.tid); } while (0)
#endif
#define RELAUNDER() do { int l_ = C.lane; asm volatile("" : "+v"(l_)); C.lane = l_; C.tid = (C.wave << 6) | l_; } while (0)
__global__ void __launch_bounds__(512, 2) fwd_kernel(Args a) {
    extern __shared__ __attribute__((aligned(16))) unsigned char smem[];
    Ctx C0; C0.lds = (LAS unsigned char*)smem; C0.tid = threadIdx.x; C0.lane = C0.tid & 63; C0.wave = __builtin_amdgcn_readfirstlane(C0.tid >> 6); C0.bid = blockIdx.x; C0.nb = gridDim.x;
    C0.vcu = (C0.nb % 8 == 0) ? (C0.bid % 8) * (C0.nb / 8) + C0.bid / 8 : C0.bid;
    volatile LAS unsigned* bst = (volatile LAS unsigned*)(C0.lds + LDS_BYTES - 16);
#if MEGA
    if (C0.tid == 0) { bst[0] = 0u; bst[1] = 0u; }
    __syncthreads();
    const unsigned bar_x = xcd_barrier_post((unsigned*)(a.ws + WS_CTL) + 4096, bst, C0.tid == 0).x;
#define SEAM() do { if (ph < hi) { XcdBarrier b2_; b2_.bar = (unsigned*)(ws + WS_CTL) + 4096; b2_.x = bar_x; b2_.st = bst; xcd_barrier(b2_, C.tid == 0); } } while (0)
#else
#define SEAM() do { } while (0)
#endif
#if MEGA
    constexpr int lo = 0, hi = N_PHASES;
#else
    const int lo = a.ph_lo, hi = a.ph_hi;
#endif
    int ph = 0;
#ifndef ONLY
#define ONLY -1
#endif
#ifndef REPMASK
#define REPMASK 0
#endif
#ifndef SITE_LO
#define SITE_LO 0
#define SITE_HI 99
#endif
#define PHASE(SITE, ...) do { if ((ONLY < 0 || ONLY == (SITE)) && (SITE) >= SITE_LO && (SITE) <= SITE_HI && ph >= lo && ph < hi) { Ctx C; C.lds = C0.lds; \
        { int w_ = C0.wave; asm volatile("" : "+s"(w_)); unsigned m_ = ~0u; asm volatile("" : "+s"(m_)); int l_ = (int)__builtin_amdgcn_mbcnt_hi(m_, __builtin_amdgcn_mbcnt_lo(m_, 0u)); C.wave = w_; C.lane = l_; C.tid = (w_ << 6) | l_; } \
        { int b_ = C0.bid, n_ = C0.nb, v_ = C0.vcu; asm volatile("" : "+s"(b_), "+s"(n_), "+s"(v_)); C.bid = b_; C.nb = n_; C.vcu = v_; } \
        unsigned z_ = 0u; asm volatile("" : "+s"(z_)); unsigned char* ws = a.ws + z_; float* XL = a.out + z_; const int lq = __builtin_amdgcn_readfirstlane(lp); typedef const __attribute__((address_space(1))) float* gfp_t; const gfp_t* INT_ = (const gfp_t*)(ws + WS_PTRS); (void)INT_; (void)XL; (void)lq; \
        for (int rep_ = 0; rep_ < ((((REPMASK) >> (SITE)) & 1) ? 2 : 1); ++rep_) { __VA_ARGS__; if ((((REPMASK) >> (SITE)) & 1)) __syncthreads(); } ++ph; SEAM(); } else ++ph; } while (0)

    { const int lp = 0;
      PHASE(0, { if (C.bid == 0) { _Pragma("unroll") for (int k = 0; k < 40; ++k) if (C.tid == k) ((const float**)(ws + WS_PTRS))[k] = a.in[k]; }
                 ph_prologue(C, a); }); }

    auto layer_pair = [&](auto lpc) __attribute__((always_inline)) {
        constexpr int lp = decltype(lpc)::value;
        if constexpr (lp == 0) PHASE(1, { const int i = 2 * lq; const float* xl = (i == 0) ? in_ptr(ws, I_X) : XL; const float* xc = (i == 0) ? in_ptr(ws, I_CTX) : P_XC;
                   ph_norm<false>(C, xl, xc, in_ptr(ws, I_N1G) + i * DM, MODL(i), 0, 1024, P_HB, nullptr, nullptr, nullptr, nullptr); });
        PHASE(2, { EpiBf16 E{P_U, EV_INP}; fast_gemm(C, P_HB, DM, (const bf16*)(ws + WS_WEVIN) + (size_t)lq * EV_INP * DM, DM, MT / 256, EV_INP / 256, E); });
        PHASE(3, { EpiBf16 Eq{(bf16*)P_QPRE, 768}; fast_gemm(C, P_U, EV_INP, (const bf16*)(ws + WS_WUQ) + (size_t)lq * 768 * 384, 384, MT / 256, 3, Eq); RELAUNDER();
                   EpiBf16 Ek{(bf16*)P_KVPRE, 1024}; fast_gemm(C, P_U + 384, EV_INP, (const bf16*)(ws + WS_WUKV) + (size_t)lq * 1024 * 256, 256, MT / 256, 4, Ek, true); });
        PHASE(4, ph_mla_fin(C, P_U, (const bf16*)P_QPRE, (const bf16*)P_KVPRE, in_ptr(ws, I_QG) + lq * 96, in_ptr(ws, I_KG) + lq * 96, (const f32x2*)(ws + WS_ROPE), P_QB, P_KB, P_VT));
        PHASE(5, ph_attn_mla2(C, P_QB, P_KB, P_VT, P_OCAT, false, ws, lq));
        PHASE(6, { const int i = 2 * lq; const float* xl = (i == 0) ? in_ptr(ws, I_X) : XL; const float* xc = (i == 0) ? in_ptr(ws, I_CTX) : P_XC;
                   EpiResid E{xl, xc, XL, P_XC, MODL(i) + 2048}; fast_gemm(C, P_OCAT, DM, (const bf16*)(ws + WS_WEVOUT) + (size_t)lq * DM * DM, DM, MT / 256, 4, E); });
        PHASE(7, { const int i = 2 * lq; ph_norm<true>(C, XL, P_XC, in_ptr(ws, I_N2G) + i * DM, MODL(i), 3072, 4096, P_HB, in_ptr(ws, I_ROUTER) + (size_t)i * DM * 16, P_AFFT, P_AFFC, P_SLOT); });
        PHASE(8, ph_topk2(C, P_AFFT, P_AFFC, P_ROWS, P_GATE, P_SLOT, false));
        PHASE(9, { MOE1_PHASE(17); });
        PHASE(10, { MOE2_PHASE(17); });
        PHASE(11, { const int i = 2 * lq; ph_combine(C, XL, P_XC, MODL(i) + 5120, P_SLOT, P_Y2, false, in_ptr(ws, I_N1G) + (i + 1) * DM, MODL(i + 1), P_HB); });
        PHASE(13, { EpiBf16 E{P_U, OD_INP}; fast_gemm(C, P_HB, DM, (const bf16*)(ws + WS_WODIN) + (size_t)lq * OD_INP * DM, DM, MT / 256, OD_INP / 256, E); });
        PHASE(14, ph_prep(C, P_U, in_ptr(ws, I_SHIFTW) + (size_t)lq * 3 * RW_IN, in_ptr(ws, I_KKW) + lq * 512, in_ptr(ws, I_NAQG) + lq * 64, in_ptr(ws, I_NAKG) + lq * 64, P_R, P_V, P_K, P_KK, P_L, P_QN, P_KN, P_VTN));
        PHASE(15, { const bf16* WL = (const bf16*)(ws + WS_WLORA) + (size_t)lq * 655360;
                    { EpiLoraW E{P_W, in_ptr(ws, I_W0) + lq * 1024}; fast_gemm(C, P_L, 384, WL, 256, MT / 256, 4, E); } RELAUNDER();
                    { EpiLoraA E{P_KEFF, in_ptr(ws, I_A0) + lq * 1024}; fast_gemm(C, P_L, 384, WL + (size_t)1024 * 256, 256, MT / 256, 4, E, true); } RELAUNDER();
                    { EpiBf16 E{P_G, 512}; fast_gemm(C, P_L + 128, 384, WL + (size_t)2048 * 256, 256, MT / 256, 2, E); } });
        PHASE(16, ph_wkv_pre(C, P_R, P_K, P_KK, P_W, P_KEFF, in_ptr(ws, I_KA) + lq * 512, P_IMG));
        PHASE(17, { ph_wkv_chunk(C, P_R, P_V, P_K, P_KK, P_W, P_KEFF, in_ptr(ws, I_KA) + lq * 512, P_IMG, P_YS); __syncthreads();
                    ph_natten2(C, P_QN, P_KN, P_VTN, P_OCAT, in_ptr(ws, I_RPB) + (size_t)lq * 8 * 465, lq == 1, (unsigned*)(ws + WS_CTL) + 8192 + 64 * lq, ws, lq); });
        PHASE(18, ph_post(C, P_YS, P_R, P_V, P_K, P_KEFF, in_ptr(ws, I_KA) + lq * 512, P_G, in_ptr(ws, I_RK) + lq * 512, in_ptr(ws, I_GNG) + lq * 512, in_ptr(ws, I_GNB) + lq * 512, P_OCAT, lq == 1));
        PHASE(19, { const int i = 2 * lq + 1; EpiResid E{XL, P_XC, XL, P_XC, MODL(i) + 2048};
                    fast_gemm(C, P_OCAT, DM, (const bf16*)(ws + WS_WODOUT) + (size_t)lq * DM * DM, DM, (lq == 1) ? NLAT / 256 : MT / 256, 4, E); });
        PHASE(20, { const int i = 2 * lq + 1; ph_norm<true>(C, XL, P_XC, in_ptr(ws, I_N2G) + i * DM, MODL(i), 3072, 4096, P_HB, in_ptr(ws, I_ROUTER) + (size_t)i * DM * 16, P_AFFT, P_AFFC, P_SLOT); });
        PHASE(21, ph_topk2(C, P_AFFT, P_AFFC, P_ROWS, P_GATE, P_SLOT, lq == 1));
        PHASE(22, { MOE1_PHASE((lq == 1) ? 16 : 17); });
        PHASE(23, { MOE2_PHASE((lq == 1) ? 16 : 17); });
        PHASE(24, { const int i = 2 * lq + 1;
                    if (lp == 0) ph_combine(C, XL, P_XC, MODL(i) + 5120, P_SLOT, P_Y2, false, in_ptr(ws, I_N1G) + (i + 1) * DM, MODL(i + 1), P_HB);
                    else ph_combine(C, XL, P_XC, MODL(i) + 5120, P_SLOT, P_Y2, true, nullptr, nullptr, nullptr); });
    };
    layer_pair(IC<0>{}); layer_pair(IC<1>{});
}

extern "C" void kernel_launch(void* const* d_in, const int* in_sizes, int n_in, void* d_out, int out_size, void* d_ws, size_t ws_size, hipStream_t stream) {
    static int grid = 0;
    if (grid == 0) {
        if (n_in != 40 || out_size != NLAT * DM || ws_size < WS_END) { fprintf(stderr, "kernel_launch: unexpected shapes (n_in %d out %d ws %zu need %zu)\n", n_in, out_size, ws_size, (size_t)WS_END); grid = -1; return; }
        int dev = 0, cus = 0, per_cu = 0;
        if (hipGetDevice(&dev) != hipSuccess || hipDeviceGetAttribute(&cus, hipDeviceAttributeMultiprocessorCount, dev) != hipSuccess) { grid = -1; return; }
        if (hipFuncSetAttribute((const void*)fwd_kernel, hipFuncAttributeMaxDynamicSharedMemorySize, LDS_BYTES) != hipSuccess) { fprintf(stderr, "kernel_launch: hipFuncSetAttribute failed\n"); grid = -1; return; }
        if (hipOccupancyMaxActiveBlocksPerMultiprocessor(&per_cu, (const void*)fwd_kernel, 512, LDS_BYTES) != hipSuccess || per_cu < 1) { fprintf(stderr, "kernel_launch: occupancy query says %d\n", per_cu); per_cu = 1; }
        (void)hipGetLastError();
        grid = cus;
    }
    if (grid < 0) return;
    (void)hipMemsetAsync((char*)d_ws + WS_CTL, 0, CTL_BYTES, stream);
    Args a{};
    for (int i = 0; i < 40; ++i) a.in[i] = (const float*)d_in[i];
    a.out = (float*)d_out; a.ws = (unsigned char*)d_ws;
#if MEGA
    a.ph_lo = 0; a.ph_hi = N_PHASES;
    hipLaunchKernelGGL(fwd_kernel, dim3(grid), dim3(512), LDS_BYTES, stream, a);
#else
    for (int p = 0; p < N_PHASES; ++p) { a.ph_lo = p; a.ph_hi = p + 1; hipLaunchKernelGGL(fwd_kernel, dim3(grid), dim3(512), LDS_BYTES, stream, a); }
#endif
}
```

```cpp
#include <hip/hip_runtime.h>
#include <cstdio>
#include <cstdint>

#ifndef MEGA
#define MEGA 1
#endif

#define LAS __attribute__((address_space(3)))
#define DI __device__ __forceinline__

typedef unsigned short bf16;
typedef short bf16x8 __attribute__((ext_vector_type(8)));
typedef float f32x4 __attribute__((ext_vector_type(4)));
typedef float f32x2 __attribute__((ext_vector_type(2)));
typedef float f32x16 __attribute__((ext_vector_type(16)));
typedef unsigned u32x4 __attribute__((ext_vector_type(4)));
typedef unsigned u32x2 __attribute__((ext_vector_type(2)));
typedef __bf16 bf16x2_t __attribute__((ext_vector_type(2)));

constexpr int DM = 1024, NB = 8, TL = 4096, LCX = 256;
constexpr int NLAT = NB * TL, NCTX = NB * LCX, MT = NLAT + NCTX;
constexpr int KPOS = TL + LCX;
constexpr float EPS = 1e-6f, GN_EPS = 64e-5f;
constexpr int EV_IN = 1696, EV_INP = 1792, OD_IN = 3456, OD_INP = 3584, RW_IN = 1920;
constexpr int NEXP = 16, CAPL = 512, CAPC = 32, ESLOTS = NB * CAPL + NB * CAPC;
constexpr float LOG2E = 1.4426950408889634f;

constexpr size_t MiB = 1ull << 20;
constexpr size_t WS_CTL = 0, CTL_BYTES = 1 * MiB;
constexpr size_t WS_MOD = 1 * MiB, WS_ROPE = 2 * MiB, WS_XC = 4 * MiB;
constexpr size_t WS_ROWS = 12 * MiB, WS_GATE = 12 * MiB + 512 * 1024, WS_SLOT = 13 * MiB, WS_AFFT = 16 * MiB, WS_AFFC = 18 * MiB;
constexpr size_t WS_WEVIN = 20 * MiB, WS_WEVOUT = 27 * MiB, WS_WUQ = 31 * MiB, WS_WUKV = 33 * MiB, WS_WODIN = 34 * MiB, WS_WODOUT = 48 * MiB, WS_WLORA = 52 * MiB;
constexpr size_t WS_W13 = 56 * MiB, WS_W2 = 120 * MiB, WS_HB = 152 * MiB, WS_OCAT = 220 * MiB, WS_ARENA = 288 * MiB;
constexpr size_t A_U = 0, A_QPRE = 119 * MiB, A_KVPRE = 221 * MiB, A_QB = 357 * MiB, A_KB = 408 * MiB, A_VT = 459 * MiB;
constexpr size_t A_W = 0, A_KEFF = 136 * MiB  , A_G = 204 * MiB, A_R = 238 * MiB, A_V = 272 * MiB, A_KK = 306 * MiB, A_K = 340 * MiB, A_L = 374 * MiB,
                 A_QN = 400 * MiB, A_KN = 434 * MiB, A_VTN = 468 * MiB, A_YS = 612 * MiB  ;
constexpr size_t A_HID = 0, A_Y2 = 136 * MiB;
constexpr size_t A_IMG = 510 * MiB;
constexpr size_t WS_END = WS_ARENA + 680 * MiB;
constexpr int LDS_BYTES = 147456;

DI unsigned pk2(float lo, float hi) { f32x2 v = {lo, hi}; bf16x2_t b = __builtin_convertvector(v, bf16x2_t); return __builtin_bit_cast(unsigned, b); }
DI float bflo(unsigned u) { return __builtin_bit_cast(float, u << 16); }
DI float bfhi(unsigned u) { return __builtin_bit_cast(float, u & 0xffff0000u); }
DI float bf2f(bf16 x) { return __builtin_bit_cast(float, ((unsigned)x) << 16); }
DI bf16 f2bf(float f) { return (bf16)(pk2(f, 0.f) & 0xffffu); }
DI void unpack8(u32x4 v, float (&f)[8]) { f[0] = bflo(v.x); f[1] = bfhi(v.x); f[2] = bflo(v.y); f[3] = bfhi(v.y); f[4] = bflo(v.z); f[5] = bfhi(v.z); f[6] = bflo(v.w); f[7] = bfhi(v.w); }
DI u32x4 pack8(const float (&f)[8]) { u32x4 r; r.x = pk2(f[0], f[1]); r.y = pk2(f[2], f[3]); r.z = pk2(f[4], f[5]); r.w = pk2(f[6], f[7]); return r; }
#define DPP_ADD(x, ctrl) ((x) + __builtin_bit_cast(float, __builtin_amdgcn_update_dpp(0, __builtin_bit_cast(int, (x)), (ctrl), 0xf, 0xf, false)))
#define DPP_MAX(x, ctrl) fmaxf((x), __builtin_bit_cast(float, __builtin_amdgcn_update_dpp(0, __builtin_bit_cast(int, (x)), (ctrl), 0xf, 0xf, false)))
DI float sum8(float x) { x = DPP_ADD(x, 0xB1); x = DPP_ADD(x, 0x4E); x = DPP_ADD(x, 0x141); return x; }
DI float sum16(float x) { x = DPP_ADD(x, 0xB1); x = DPP_ADD(x, 0x4E); x = DPP_ADD(x, 0x141); x = DPP_ADD(x, 0x140); return x; }
DI float max16(float x) { x = DPP_MAX(x, 0xB1); x = DPP_MAX(x, 0x4E); x = DPP_MAX(x, 0x141); x = DPP_MAX(x, 0x140); return x; }
DI float rdlane(float x, int l) { return __builtin_bit_cast(float, __builtin_amdgcn_readlane(__builtin_bit_cast(int, x), l)); }
DI float wave_sum(float v) { const float x = sum16(v); return (rdlane(x, 0) + rdlane(x, 16)) + (rdlane(x, 32) + rdlane(x, 48)); }
DI float xor32(float v, int lane) { return __builtin_bit_cast(float, __builtin_amdgcn_ds_bpermute((lane ^ 32) << 2, __builtin_bit_cast(int, v))); }
typedef int v8i_t __attribute__((ext_vector_type(8)));
typedef int i32x4_t __attribute__((ext_vector_type(4)));
DI unsigned pk4_fp8(float a, float b, float c, float d) {
    a = __builtin_amdgcn_fmed3f(a, -448.f, 448.f); b = __builtin_amdgcn_fmed3f(b, -448.f, 448.f); c = __builtin_amdgcn_fmed3f(c, -448.f, 448.f); d = __builtin_amdgcn_fmed3f(d, -448.f, 448.f);
    int p = __builtin_amdgcn_cvt_pk_fp8_f32(a, b, 0, false); p = __builtin_amdgcn_cvt_pk_fp8_f32(c, d, p, true); return (unsigned)p; }
#ifndef MOE_F8
#define MOE_F8 1
#endif
constexpr int SCALE_ONE = 0x7f7f7f7f, SCALE_W = 0x79797979  , SCALE_HID = 0x7c7c7c7c  ;
DI float sigmoidf_(float x) { return __builtin_amdgcn_rcpf(1.f + __expf(-x)); }
DI float siluf_(float x) { return x * __builtin_amdgcn_rcpf(1.f + __expf(-x)); }
#define MFMA32(a, b, c) __builtin_amdgcn_mfma_f32_32x32x16_bf16((a), (b), (c), 0, 0, 0)

#define XB_TMO      128
#define XB_XCNT(j)  (256  + 64 * (j))
#define XB_XSUB(j)  (1280 + 64 * (j))
#define XB_XGEN(j)  (2304 + 64 * (j))
#define XB_TOP      3328
#define XB_TOPGEN   3392
#define XCD_BAR_WORDS 3456
#define XB_SPIN_CAP (1u << 22)
__device__ __forceinline__ unsigned xb_ld(unsigned* p)              { return __hip_atomic_load(p, __ATOMIC_RELAXED, __HIP_MEMORY_SCOPE_AGENT); }
__device__ __forceinline__ unsigned xb_add(unsigned* p, unsigned v) { return __hip_atomic_fetch_add(p, v, __ATOMIC_RELAXED, __HIP_MEMORY_SCOPE_AGENT); }
__device__ __forceinline__ unsigned xb_xcc_id() { return (unsigned)__builtin_amdgcn_s_getreg((3 << 11) | 20) & 0xFu; }
#define XB_SPIN(cond, bar) do { unsigned _sp = 0; while (cond) { __builtin_amdgcn_s_sleep(1); \
    if ((++_sp & 255u) == 0u) { if (xb_ld(&(bar)[XB_TMO])) break; if (_sp > XB_SPIN_CAP) { atomicAdd(&(bar)[XB_TMO], 1u); break; } } } } while (0)
struct XcdBarrier { unsigned* bar; unsigned x; volatile LAS unsigned* st; };
__device__ __forceinline__ XcdBarrier xcd_barrier_post(unsigned* bar, volatile LAS unsigned* st, bool leader) {
    XcdBarrier b; b.bar = bar; b.x = xb_xcc_id(); b.st = st;
    if (leader) (void)xb_add(&bar[XB_XCNT(b.x)], 1u);
    return b;
}
__device__ __forceinline__ void xcd_barrier_complete(unsigned* bar, unsigned x, unsigned& nloc, unsigned& nx) {
    const unsigned G = gridDim.x * gridDim.y * gridDim.z;
    unsigned sum, cnt, mine, sp = 0u;
    for (;;) {
        sum = 0u; cnt = 0u; mine = 0u;
#pragma unroll
        for (unsigned j = 0; j < 16; ++j) { const unsigned c = xb_ld(&bar[XB_XCNT(j)]); sum += c; cnt += (c > 0u) ? 1u : 0u; mine = (j == x) ? c : mine; }
        if (sum == G) break;
        __builtin_amdgcn_s_sleep(1);
        if ((++sp & 255u) == 0u) { if (xb_ld(&bar[XB_TMO])) break; if (sp > XB_SPIN_CAP) { atomicAdd(&bar[XB_TMO], 1u); break; } }
    }
    nloc = mine > 0u ? mine : 1u; nx = cnt > 0u ? cnt : 1u;
}
__device__ __forceinline__ void xcd_barrier(const XcdBarrier& b, bool leader) {
    asm volatile("s_waitcnt vmcnt(0)" ::: "memory");
    __syncthreads();
    if (leader) {
        unsigned* bar = b.bar;
        __builtin_amdgcn_s_waitcnt(0);
        unsigned nloc = b.st[0], nx = b.st[1];
        if (nloc == 0u) { xcd_barrier_complete(bar, b.x, nloc, nx); b.st[0] = nloc; b.st[1] = nx; }
        const unsigned old = xb_add(&bar[XB_XSUB(b.x)], 1u);
        const unsigned gen = old / nloc;
        if (old + 1u == (gen + 1u) * nloc) {
            __builtin_amdgcn_fence(__ATOMIC_RELEASE, "agent");
            asm volatile("s_waitcnt vmcnt(0)" ::: "memory");
            const unsigned og = xb_add(&bar[XB_TOP], 1u);
            const unsigned tg = og / nx;
            if (og + 1u == (tg + 1u) * nx) xb_add(&bar[XB_TOPGEN], 1u);
            else XB_SPIN(xb_ld(&bar[XB_TOPGEN]) == tg, bar);
            __builtin_amdgcn_fence(__ATOMIC_ACQUIRE, "agent");
            xb_add(&bar[XB_XGEN(b.x)], 1u);
            asm volatile("s_waitcnt vmcnt(0)" ::: "memory");
        } else {
            XB_SPIN(xb_ld(&bar[XB_XGEN(b.x)]) == gen, bar);
            __builtin_amdgcn_fence(__ATOMIC_ACQUIRE, "agent");
            asm volatile("s_waitcnt vmcnt(0)" ::: "memory");
        }
    }
    __syncthreads();
}

struct Ctx { LAS unsigned char* lds; int tid, lane, wave, bid, nb, vcu; };
struct Args { const float* in[40]; float* out; unsigned char* ws; int ph_lo, ph_hi; };
enum { I_X = 0, I_C, I_CTX, I_CCTX, I_ADAW, I_ADAB, I_N1G, I_N2G, I_EVWIN, I_EVWOUT, I_QNORM, I_WUQ, I_KVNORM, I_WUKV, I_QG, I_KG, I_DWW, I_DWB, I_LNG, I_LNB,
       I_ODWIN, I_ODWOUT, I_SHIFTW, I_W0, I_W2L, I_A0, I_A2, I_G2, I_KKW, I_KA, I_RK, I_GNG, I_GNB, I_NAQG, I_NAKG, I_RPB, I_ROUTER, I_MW1, I_MW3, I_MW2 };

DI void transpose_item(const float* __restrict__ W, int K, int N, bf16* __restrict__ WT, int dst_row0, const float* __restrict__ gain, LAS float* scr, int k0, int n0, int lane) {
#pragma unroll 8
    for (int i = 0; i < 32; ++i) { const int kk = 2 * i + (lane >> 5); float v = W[(size_t)(k0 + kk) * N + n0 + (lane & 31)]; if (gain) v *= gain[k0 + kk]; scr[kk * 33 + (lane & 31)] = v; }
    asm volatile("s_waitcnt lgkmcnt(0)" ::: "memory");
    const int c = lane & 7;
#pragma unroll
    for (int j = 0; j < 4; ++j) { const int n = (lane >> 3) + 8 * j; const LAS float* s = scr + (8 * c) * 33 + n;
        u32x4 o; o.x = pk2(s[0 * 33], s[1 * 33]); o.y = pk2(s[2 * 33], s[3 * 33]); o.z = pk2(s[4 * 33], s[5 * 33]); o.w = pk2(s[6 * 33], s[7 * 33]);
        *(u32x4*)(WT + (size_t)(dst_row0 + n) * K + k0 + 8 * c) = o; }
    asm volatile("s_waitcnt lgkmcnt(0)" ::: "memory");
}
DI void transpose_item64(const float* __restrict__ W, int K, int N, bf16* __restrict__ WT, int dst_row0, LAS float* scr, int k0, int n0, int lane) {
    f32x4 v[16];
#pragma unroll
    for (int i = 0; i < 16; ++i) v[i] = *(const f32x4*)(W + (size_t)(k0 + 4 * i + (lane >> 4)) * N + n0 + 4 * (lane & 15));
#pragma unroll
    for (int i = 0; i < 16; ++i) { LAS float* d = scr + (4 * i + (lane >> 4)) * 65 + 4 * (lane & 15); d[0] = v[i].x; d[1] = v[i].y; d[2] = v[i].z; d[3] = v[i].w; }
    asm volatile("s_waitcnt lgkmcnt(0)" ::: "memory");
    const int c = lane & 7;
#pragma unroll
    for (int j = 0; j < 8; ++j) { const int n = (lane >> 3) + 8 * j; const LAS float* s = scr + (8 * c) * 65 + n;
        u32x4 o; o.x = pk2(s[0 * 65], s[1 * 65]); o.y = pk2(s[2 * 65], s[3 * 65]); o.z = pk2(s[4 * 65], s[5 * 65]); o.w = pk2(s[6 * 65], s[7 * 65]);
        *(u32x4*)(WT + (size_t)(dst_row0 + n) * K + k0 + 8 * c) = o; }
    asm volatile("s_waitcnt lgkmcnt(0)" ::: "memory");
}
DI void transpose_item64_f8(const float* __restrict__ W, int K, int N, unsigned char* __restrict__ WT8, int dst_row0, LAS float* scr, int k0, int n0, int lane) {
    f32x4 v[16];
#pragma unroll
    for (int i = 0; i < 16; ++i) v[i] = *(const f32x4*)(W + (size_t)(k0 + 4 * i + (lane >> 4)) * N + n0 + 4 * (lane & 15));
#pragma unroll
    for (int i = 0; i < 16; ++i) { LAS float* d = scr + (4 * i + (lane >> 4)) * 65 + 4 * (lane & 15); d[0] = v[i].x; d[1] = v[i].y; d[2] = v[i].z; d[3] = v[i].w; }
    asm volatile("s_waitcnt lgkmcnt(0)" ::: "memory");
    const int c = lane & 7;
#pragma unroll
    for (int j = 0; j < 8; ++j) { const int n = (lane >> 3) + 8 * j; const LAS float* s = scr + (8 * c) * 65 + n;
        u32x2 o; o.x = pk4_fp8(64.f * s[0 * 65], 64.f * s[1 * 65], 64.f * s[2 * 65], 64.f * s[3 * 65]); o.y = pk4_fp8(64.f * s[4 * 65], 64.f * s[5 * 65], 64.f * s[6 * 65], 64.f * s[7 * 65]);
        *(u32x2*)(WT8 + (size_t)(dst_row0 + n) * K + k0 + 8 * c) = o; }
    asm volatile("s_waitcnt lgkmcnt(0)" ::: "memory");
}
DI void transpose_matrix(const Ctx& C, const float* W, int K, int N, bf16* WT, const float* gain, int mode  ) {
    LAS float* scr = (LAS float*)(C.lds + C.wave * 8704);
    const int nkb = K / 64, nnb = N / 32, nit = nkb * nnb, gw = C.vcu * 8 + C.wave, ngw = C.nb * 8;
    for (int it = gw; it < nit; it += ngw) {
        const int kb = it / nnb, nbk = it % nnb, n0 = nbk * 32;
        int d0 = n0; if (mode) d0 = (n0 >> 7) * 256 + (n0 & 127) + (mode == 2 ? 128 : 0);
        transpose_item(W, K, N, WT, d0, gain, scr, kb * 64, n0, C.lane);
    }
}

DI void ph_prologue(const Ctx& C, const Args& a) {
    unsigned char* ws = a.ws;
    {
        LAS float* sv = (LAS float*)C.lds;
        LAS float* red = sv + 9 * 1024;
        for (int i = C.tid; i < 9 * 1024; i += 512) { const int m = i >> 10, k = i & 1023; const float c = (m < 8) ? a.in[I_C][m * 1024 + k] : a.in[I_CCTX][k]; sv[i] = siluf_(c); }
        __syncthreads();
        float* MOD = (float*)(ws + WS_MOD);
        for (int it = C.bid; it < 4 * 96; it += C.nb) {
            const int layer = it / 96, col = (it % 96) * 64 + C.lane;
            const float* wp = a.in[I_ADAW] + (size_t)layer * 1024 * 6144 + col;
            float acc[9];
#pragma unroll
            for (int m = 0; m < 9; ++m) acc[m] = 0.f;
            const int kb = C.wave * 128;
#pragma unroll 16
            for (int k = 0; k < 128; ++k) { const float w = wp[(size_t)(kb + k) * 6144];
#pragma unroll
                for (int m = 0; m < 9; ++m) acc[m] += sv[m * 1024 + kb + k] * w; }
#pragma unroll
            for (int m = 0; m < 9; ++m) red[(C.wave * 9 + m) * 64 + C.lane] = acc[m];
            __syncthreads();
            for (int i = C.tid; i < 576; i += 512) { const int m = i >> 6, l = i & 63; float s = 0.f;
#pragma unroll
                for (int w = 0; w < 8; ++w) s += red[(w * 9 + m) * 64 + l];
                const int cc = (it % 96) * 64 + l;
                MOD[(size_t)(layer * 9 + m) * 6144 + cc] = s + a.in[I_ADAB][layer * 6144 + cc]; }
            __syncthreads();
        }
    }
    {
        f32x2* CS = (f32x2*)(ws + WS_ROPE);
        for (int i = C.bid * 512 + C.tid; i < 4096 * 16; i += C.nb * 512) {
            const int pos = i >> 4, j = i & 15, f = j & 7;
            const float inv = powf(10000.f, -(float)(2 * f) / 16.f);
            const float ang = (float)((j < 8) ? (pos >> 6) : (pos & 63)) * inv;
            const double tw = 6.283185307179586476925;
            const double x = (double)ang, n = __builtin_rint(x / tw), rr = x - n * tw;
            CS[i] = (f32x2){__cosf((float)rr), __sinf((float)rr)};
        }
    }
    for (int j = 0; j < 2; ++j) {
        transpose_matrix(C, a.in[I_EVWIN] + (size_t)j * DM * EV_IN, DM, EV_IN, (bf16*)(ws + WS_WEVIN) + (size_t)j * EV_INP * DM, nullptr, 0);
        transpose_matrix(C, a.in[I_EVWOUT] + (size_t)j * DM * DM, DM, DM, (bf16*)(ws + WS_WEVOUT) + (size_t)j * DM * DM, nullptr, 0);
        transpose_matrix(C, a.in[I_WUQ] + (size_t)j * 384 * 768, 384, 768, (bf16*)(ws + WS_WUQ) + (size_t)j * 768 * 384, a.in[I_QNORM] + j * 384, 0);
        transpose_matrix(C, a.in[I_WUKV] + (size_t)j * 256 * 1024, 256, 1024, (bf16*)(ws + WS_WUKV) + (size_t)j * 1024 * 256, a.in[I_KVNORM] + j * 256, 0);
        transpose_matrix(C, a.in[I_ODWIN] + (size_t)j * DM * OD_IN, DM, OD_IN, (bf16*)(ws + WS_WODIN) + (size_t)j * OD_INP * DM, nullptr, 0);
        transpose_matrix(C, a.in[I_ODWOUT] + (size_t)j * DM * DM, DM, DM, (bf16*)(ws + WS_WODOUT) + (size_t)j * DM * DM, nullptr, 0);
    }
    {
        const int gt = C.bid * 512 + C.tid, ngt = C.nb * 512;
        for (int j = 0; j < 2; ++j) {
            u32x4* p0 = (u32x4*)((bf16*)(ws + WS_WEVIN) + (size_t)j * EV_INP * DM + (size_t)EV_IN * DM);
            for (int i = gt; i < (EV_INP - EV_IN) * DM / 8; i += ngt) p0[i] = (u32x4){0u, 0u, 0u, 0u};
            u32x4* p1 = (u32x4*)((bf16*)(ws + WS_WODIN) + (size_t)j * OD_INP * DM + (size_t)OD_IN * DM);
            for (int i = gt; i < (OD_INP - OD_IN) * DM / 8; i += ngt) p1[i] = (u32x4){0u, 0u, 0u, 0u};
            bf16* WL = (bf16*)(ws + WS_WLORA) + (size_t)j * 655360;
            const float* w2 = a.in[I_W2L] + (size_t)j * 2 * 64 * 512; const float* a2 = a.in[I_A2] + (size_t)j * 2 * 64 * 512; const float* g2 = a.in[I_G2] + (size_t)j * 128 * 512;
            for (int i = gt; i < 655360; i += ngt) {
                const int n = i >> 8, k = i & 255; float v = 0.f;
                if (n < 1024) { const int d = n >> 9, c = n & 511; if (k >= d * 64 && k < d * 64 + 64) v = w2[(size_t)k * 512 + c]; }
                else if (n < 2048) { const int d = (n - 1024) >> 9, c = n & 511; if (k >= 128 + d * 64 && k < 192 + d * 64) v = a2[(size_t)(k - 128) * 512 + c]; }
                else { const int c = n - 2048; if (k >= 128) v = g2[(size_t)(k - 128) * 512 + c]; }
                WL[i] = f2bf(v);
            }
        }
    }
}

template <bool ROUTER>
DI void ph_norm(const Ctx& C, const float* xlat, const float* xctx, const float* gain, const float* mod  , int shift_off, int scale_off, bf16* H,
                const float* router  , float* AFFT, float* AFFC, int* SLOT) {
    LAS float* RT = (LAS float*)C.lds;
    if (ROUTER) { for (int i = C.tid; i < 16384; i += 512) { const int c = i >> 4, e = i & 15; RT[e * 1024 + c] = router[i]; } __syncthreads(); }
    const int gw = C.bid * 8 + C.wave, ngw = C.nb * 8, lane = C.lane;
    for (int row = gw; row < MT; row += ngw) {
        const float* xr = row < NLAT ? xlat + (size_t)row * DM : xctx + (size_t)(row - NLAT) * DM;
        const int mi = row < NLAT ? (row >> 12) : 8;
        const float* mp = mod + mi * 6144;
        f32x4 v[4]; float ss = 0.f;
#pragma unroll
        for (int j = 0; j < 4; ++j) { v[j] = *(const f32x4*)(xr + 256 * j + 4 * lane); ss += v[j].x * v[j].x + v[j].y * v[j].y + v[j].z * v[j].z + v[j].w * v[j].w; }
        ss = wave_sum(ss);
        const float rs = 1.0f / sqrtf(ss * (1.f / 1024.f) + EPS);
#pragma unroll
        for (int j = 0; j < 4; ++j) {
            const int c = 256 * j + 4 * lane;
            const f32x4 g = *(const f32x4*)(gain + c), sc = *(const f32x4*)(mp + scale_off + c), sh = *(const f32x4*)(mp + shift_off + c);
            v[j] = (v[j] * rs) * g * (sc + 1.0f) + sh;
            if (ROUTER && MOE_F8) *(unsigned*)((unsigned char*)H + (size_t)row * DM + c) = pk4_fp8(v[j].x, v[j].y, v[j].z, v[j].w);
            else *(u32x2*)(H + (size_t)row * DM + c) = (u32x2){pk2(v[j].x, v[j].y), pk2(v[j].z, v[j].w)};
        }
        if (ROUTER) {
            float mylg = 0.f;
#pragma unroll 1
            for (int e = 0; e < 16; ++e) { float p = 0.f;
#pragma unroll
                for (int j = 0; j < 4; ++j) { const f32x4 w = *(const LAS f32x4*)(RT + e * 1024 + 256 * j + 4 * lane); p += v[j].x * w.x + v[j].y * w.y + v[j].z * w.z + v[j].w * w.w; }
                p = wave_sum(p); mylg = (lane == e) ? p : mylg; }
            const float mx = max16(mylg);
            const float ex = expf(mylg - mx);
            const float mine = ex / sum16(ex);
            if (lane < 16) {
                if (row < NLAT) AFFT[(size_t)((row >> 12) * 16 + lane) * TL + (row & 4095)] = mine;
                else { const int rc = row - NLAT; AFFC[(size_t)((rc >> 8) * 16 + lane) * LCX + (rc & 255)] = mine; }
                SLOT[(size_t)row * 16 + lane] = -1;
            }
        }
    }
}


struct EpiBf16 { static constexpr bool WIDE = true; bf16* O; int ldo;
    DI void operator()(int row, int col, f32x4 v0, f32x4 v1) const { bf16* p = O + (size_t)row * ldo + col;
        *(u32x2*)p = (u32x2){pk2(v0[0], v0[1]), pk2(v0[2], v0[3])}; *(u32x2*)(p + 128) = (u32x2){pk2(v1[0], v1[1]), pk2(v1[2], v1[3])}; }
    DI void wide(int row, int col, f32x4 a0, f32x4 a1, f32x4 b0, f32x4 b1) const { bf16* p = O + (size_t)row * ldo + col;
        *(u32x4*)p = (u32x4){pk2(a0[0], a0[1]), pk2(a0[2], a0[3]), pk2(a1[0], a1[1]), pk2(a1[2], a1[3])}; *(u32x4*)(p + 128) = (u32x4){pk2(b0[0], b0[1]), pk2(b0[2], b0[3]), pk2(b1[0], b1[1]), pk2(b1[2], b1[3])}; } };
struct EpiF32 { static constexpr bool WIDE = false; float* O; int ldo;
    DI void operator()(int row, int col, f32x4 v0, f32x4 v1) const { float* p = O + (size_t)row * ldo + col; *(f32x4*)p = v0; *(f32x4*)(p + 128) = v1; } };
struct EpiResid { static constexpr bool WIDE = false; const float* xin_lat; const float* xin_ctx; float* xout_lat; float* xout_ctx; const float* modg;
    DI void operator()(int row, int col, f32x4 v0, f32x4 v1) const {
        const float* xi; float* xo; int mi;
        if (row < NLAT) { xi = xin_lat + (size_t)row * DM; xo = xout_lat + (size_t)row * DM; mi = row >> 12; }
        else { xi = xin_ctx + (size_t)(row - NLAT) * DM; xo = xout_ctx + (size_t)(row - NLAT) * DM; mi = 8; }
        const float* g = modg + mi * 6144 + col;
        const f32x4 g0 = *(const f32x4*)g, g1 = *(const f32x4*)(g + 128), x0 = *(const f32x4*)(xi + col), x1 = *(const f32x4*)(xi + col + 128);
        *(f32x4*)(xo + col) = x0 + g0 * v0; *(f32x4*)(xo + col + 128) = x1 + g1 * v1; } };
struct EpiGlu { static constexpr bool WIDE = false; bf16* O;
    DI void operator()(int row, int col, f32x4 v0, f32x4 v1) const { const int f = ((col & 2047) >> 8) * 128 + (col & 255);
        *(u32x2*)(O + (size_t)row * DM + f) = (u32x2){pk2(siluf_(v0[0]) * v1[0], siluf_(v0[1]) * v1[1]), pk2(siluf_(v0[2]) * v1[2], siluf_(v0[3]) * v1[3])}; } };
struct EpiGlu8 { static constexpr bool WIDE = true; unsigned char* O;
    DI void operator()(int row, int col, f32x4 v0, f32x4 v1) const { const int f = ((col & 2047) >> 8) * 128 + (col & 255);
        *(unsigned*)(O + (size_t)row * DM + f) = pk4_fp8(8.f * siluf_(v0[0]) * v1[0], 8.f * siluf_(v0[1]) * v1[1], 8.f * siluf_(v0[2]) * v1[2], 8.f * siluf_(v0[3]) * v1[3]); }
    DI void wide(int row, int col, f32x4 a0, f32x4 a1, f32x4 b0, f32x4 b1) const { const int f = ((col & 2047) >> 8) * 128 + (col & 255);
        *(u32x2*)(O + (size_t)row * DM + f) = (u32x2){pk4_fp8(8.f * siluf_(a0[0]) * b0[0], 8.f * siluf_(a0[1]) * b0[1], 8.f * siluf_(a0[2]) * b0[2], 8.f * siluf_(a0[3]) * b0[3]),
                                                    pk4_fp8(8.f * siluf_(a1[0]) * b1[0], 8.f * siluf_(a1[1]) * b1[1], 8.f * siluf_(a1[2]) * b1[2], 8.f * siluf_(a1[3]) * b1[3])}; } };
struct EpiGate { static constexpr bool WIDE = true; bf16* O; const float* gate;
    DI void operator()(int row, int col, f32x4 v0, f32x4 v1) const { const float g = gate[row]; bf16* p = O + (size_t)row * DM + (col & 1023);
        *(u32x2*)p = (u32x2){pk2(v0[0] * g, v0[1] * g), pk2(v0[2] * g, v0[3] * g)}; *(u32x2*)(p + 128) = (u32x2){pk2(v1[0] * g, v1[1] * g), pk2(v1[2] * g, v1[3] * g)}; }
    DI void wide(int row, int col, f32x4 a0, f32x4 a1, f32x4 b0, f32x4 b1) const { const float g = gate[row]; bf16* p = O + (size_t)row * DM + (col & 1023);
        *(u32x4*)p = (u32x4){pk2(a0[0] * g, a0[1] * g), pk2(a0[2] * g, a0[3] * g), pk2(a1[0] * g, a1[1] * g), pk2(a1[2] * g, a1[3] * g)};
        *(u32x4*)(p + 128) = (u32x4){pk2(b0[0] * g, b0[1] * g), pk2(b0[2] * g, b0[3] * g), pk2(b1[0] * g, b1[1] * g), pk2(b1[2] * g, b1[3] * g)}; } };
struct EpiLoraW { static constexpr bool WIDE = false; float* W; const float* w0;
    DI void one(int row, int col, f32x4 v) const { const int d = col >> 9, c = col & 511; f32x4 o;
#pragma unroll
        for (int e = 0; e < 4; ++e) { const float lw = w0[col + e] + v[e]; const float z = -lw; const float sp = fmaxf(z, 0.f) + __logf(1.f + __expf(-fabsf(z))); o[e] = -__expf(-sp - 0.5f); }
        *(f32x4*)(W + ((size_t)d * MT + row) * 512 + c) = o; }
    DI void operator()(int row, int col, f32x4 v0, f32x4 v1) const { one(row, col, v0); one(row, col + 128, v1); } };
struct EpiLoraA { static constexpr bool WIDE = false; bf16* Aout; const float* a0;
    DI void one(int row, int col, f32x4 v) const { const int d = col >> 9, c = col & 511; const f32x4 b = *(const f32x4*)(a0 + col);
        *(u32x2*)(Aout + ((size_t)d * MT + row) * 512 + c) = (u32x2){pk2(sigmoidf_(b[0] + v[0]), sigmoidf_(b[1] + v[1])), pk2(sigmoidf_(b[2] + v[2]), sigmoidf_(b[3] + v[3]))}; }
    DI void operator()(int row, int col, f32x4 v0, f32x4 v1) const { one(row, col, v0); one(row, col + 128, v1); } };

namespace pg8 {
constexpr int BM = 256, BK = 64, HALF = 128, HTB = HALF * BK * 2, STAGE_BYTES = 8 * HTB;
DI int lds_byte(int r, int c) { const int st = (r >> 4) * 2 + (c >> 5), rr = r & 15, cc = c & 31, ob = rr * 64 + cc * 2; return st * 1024 + (ob ^ (((ob >> 9) & 1) << 5)); }
DI void stage_rc(int b, int& R, int& C) { const int st = b / 1024, sb = b % 1024, swz = sb ^ (((sb >> 9) & 1) << 5); R = (st >> 1) * 16 + swz / 64; C = (st & 1) * 32 + (swz % 64) / 2; }
DI int perm32(int rho) { const int n = rho >> 4, i = rho & 15; return 8 * (i >> 2) + 4 * n + (i & 3); }
struct Unit { int pm, pn; };
struct Gemm { const bf16* A; const bf16* Bt; int lda, K; const int* rows; int scale_w = 0x7f7f7f7f, scale_a = 0x7f7f7f7f; };
struct OrderMN { int nM, nN, G, c;
    DI bool next(int i, Unit& u) const { const int L = i * G + c; if (L >= nM * nN) return false; u.pm = L / nN; u.pn = L % nN; return true; } };
struct OrderMoE { int nMt, nN, mstride  , G, c;
    DI bool next(int i, Unit& u) const { const int L = i * G + c, per = nMt * nN; if (L >= NEXP * per) return false; const int e = L / per, q = L % per; u.pm = e * mstride + q / nN; u.pn = e * nN + q % nN; return true; } };
template <class E4> struct EpiAdapt { E4 e;
    DI void operator()(const f32x4 (&acc)[2][2][4][2], const Unit& u, int wr, int wc, int fr, int fq) const {
#pragma unroll
        for (int ai = 0; ai < 2; ++ai)
#pragma unroll
            for (int m = 0; m < 4; ++m) { const int row = u.pm * BM + ai * HALF + wr * 64 + m * 16 + fr;
                if constexpr (E4::WIDE) e.wide(row, u.pn * BM + wc * 32 + 8 * fq, acc[ai][0][m][0], acc[ai][0][m][1], acc[ai][1][m][0], acc[ai][1][m][1]);
                else {
#pragma unroll
                    for (int n = 0; n < 2; ++n) e(row, u.pn * BM + wc * 32 + 8 * fq + 4 * n, acc[ai][0][m][n], acc[ai][1][m][n]); } } } };

template <class Epi, class Sched, bool F8 = false>
DI void gemm_phase(LAS unsigned char* lds, const Gemm g, const Sched& S, const Epi& E, const int tid) {
    const int wid = __builtin_amdgcn_readfirstlane(tid >> 6), lane = tid & 63, wr = wid >> 2, wc = wid & 3, fr = lane & 15, fq = lane >> 4;
    const int K = g.K, nt = K / BK;
    unsigned voffB[2];
#pragma unroll
    for (int i = 0; i < 2; ++i) { int R, C; stage_rc(tid * 16 + i * 8192, R, C); const int Rb = (R & ~31) + perm32(R & 31); voffB[i] = (unsigned)(Rb * K + C) * 2u; }
    const size_t kstep = (size_t)(BK * 2), hstep = (size_t)HALF * K * 2, tstep = 2 * hstep;
    const unsigned ldsw = (unsigned)wid * 1024u;
    const int aoff = lds_byte(wr * 64 + fr, fq * 8), boff = lds_byte(wc * 32 + fr, fq * 8);
    const char* const gA = (const char*)g.A;
#define PG8_SA(b, h) (((b) * 2 + (h)) * HTB)
#define PG8_SB(b, h) ((4 + (b) * 2 + (h)) * HTB)
#define PG8_STAGE(bufoff, gbase, voff) do { _Pragma("unroll") for (int _i = 0; _i < 2; ++_i) \
        __builtin_amdgcn_global_load_lds((const unsigned*)((const char*)(gbase) + (voff)[_i]), (LAS unsigned*)(lds + (bufoff) + ldsw + _i * 8192), 16, 0, 0); } while (0)
#define PG8_LDA(dst, b, h) do { _Pragma("unroll") for (int m = 0; m < 4; ++m) _Pragma("unroll") for (int k = 0; k < 2; ++k) dst[m][k] = *(const LAS bf16x8*)(lds + PG8_SA(b, h) + aoff + m * 2048 + k * 1024); } while (0)
#define PG8_LDB(dst, b, h) do { _Pragma("unroll") for (int n = 0; n < 2; ++n) _Pragma("unroll") for (int k = 0; k < 2; ++k) dst[n][k] = *(const LAS bf16x8*)(lds + PG8_SB(b, h) + boff + n * 2048 + k * 1024); } while (0)
#define PG8_MMA(ai, bj, At, Bt) do { __builtin_amdgcn_s_setprio(1); _Pragma("unroll") for (int m = 0; m < 4; ++m) _Pragma("unroll") for (int n = 0; n < 2; ++n) { \
        if constexpr (F8) { const v8i_t w8 = __builtin_shufflevector(__builtin_bit_cast(i32x4_t, Bt[n][0]), __builtin_bit_cast(i32x4_t, Bt[n][1]), 0, 1, 2, 3, 4, 5, 6, 7), x8 = __builtin_shufflevector(__builtin_bit_cast(i32x4_t, At[m][0]), __builtin_bit_cast(i32x4_t, At[m][1]), 0, 1, 2, 3, 4, 5, 6, 7); \
            acc[ai][bj][m][n] = __builtin_amdgcn_mfma_scale_f32_16x16x128_f8f6f4(w8, x8, acc[ai][bj][m][n], 0, 0, 0, g.scale_w, 0, g.scale_a); } \
        else { _Pragma("unroll") for (int k = 0; k < 2; ++k) acc[ai][bj][m][n] = __builtin_amdgcn_mfma_f32_16x16x32_bf16(Bt[n][k], At[m][k], acc[ai][bj][m][n], 0, 0, 0); } } __builtin_amdgcn_s_setprio(0); } while (0)
#define PG8_WAIT_V(n) asm volatile("s_waitcnt vmcnt(" #n ")" ::: "memory")
#define PG8_WAIT_L(n) asm volatile("s_waitcnt lgkmcnt(" #n ")" ::: "memory")
#define PG8_BAR __builtin_amdgcn_s_barrier()
#define PG8_SCHED __builtin_amdgcn_sched_barrier(0)
#define PG8_ROWIDX(ri, u) do { _Pragma("unroll") for (int _h = 0; _h < 2; ++_h) _Pragma("unroll") for (int _i = 0; _i < 2; ++_i) { int _R, _C; stage_rc(tid * 16 + _i * 8192, _R, _C); (void)_C; \
        const int _lr = (u).pm * BM + _h * HALF + _R; ri[_h][_i] = g.rows ? g.rows[_lr] : _lr; } } while (0)
#define PG8_AOFF_FROM(vo, ri) do { _Pragma("unroll") for (int _h = 0; _h < 2; ++_h) _Pragma("unroll") for (int _i = 0; _i < 2; ++_i) { int _R, _C; stage_rc(tid * 16 + _i * 8192, _R, _C); (void)_R; \
        vo[_h][_i] = (unsigned)(((size_t)ri[_h][_i] * g.lda + _C) * 2u); } } while (0)
    Unit cur, nxt; int ui = 0;
    if (!S.next(0, cur)) return;
    f32x4 acc[2][2][4][2];
#pragma unroll
    for (int a = 0; a < 2; ++a)
#pragma unroll
        for (int b = 0; b < 2; ++b)
#pragma unroll
            for (int m = 0; m < 4; ++m)
#pragma unroll
                for (int n = 0; n < 2; ++n) acc[a][b][m][n] = (f32x4){0.f, 0.f, 0.f, 0.f};
    bf16x8 At[4][2], B0[2][2], B1[2][2];
    unsigned cvo[2][2]; int nri[2][2];
    PG8_ROWIDX(nri, cur); PG8_AOFF_FROM(cvo, nri);
    const char* cB = (const char*)g.Bt + (size_t)cur.pn * tstep;
    PG8_STAGE(PG8_SB(0, 0), cB, voffB); PG8_STAGE(PG8_SB(0, 1), cB + hstep, voffB); PG8_STAGE(PG8_SA(0, 0), gA, cvo[0]); PG8_STAGE(PG8_SA(0, 1), gA, cvo[1]);
    if (wr == 1) PG8_BAR;
    PG8_WAIT_V(2); PG8_BAR;
    PG8_STAGE(PG8_SB(1, 0), cB + kstep, voffB); PG8_STAGE(PG8_SA(1, 0), gA + kstep, cvo[0]); PG8_STAGE(PG8_SB(1, 1), cB + hstep + kstep, voffB);
    PG8_WAIT_V(6); PG8_BAR;
    for (;;) {
        const bool has_next = S.next(ui + 1, nxt);
        const char* nB = has_next ? (const char*)g.Bt + (size_t)nxt.pn * tstep : cB;
#pragma nounroll
        for (int t = 0; t < nt; t += 2) {
            const bool last = (t == nt - 2);
            const char* a1 = gA + (size_t)(t + 1) * kstep;
            const char* a2 = last ? gA : gA + (size_t)(t + 2) * kstep; const char* b2 = last ? nB : cB + (size_t)(t + 2) * kstep;
            const char* a3 = a2 + kstep; const char* b3 = b2 + kstep;
            if (t == nt - 4 && has_next) PG8_ROWIDX(nri, nxt);
            PG8_LDB(B0, 0, 0); PG8_LDB(B1, 0, 1); PG8_SCHED; PG8_LDA(At, 0, 0); PG8_STAGE(PG8_SA(1, 1), a1, cvo[1]);
            if (last && has_next) { if (nt < 4) PG8_ROWIDX(nri, nxt); PG8_AOFF_FROM(cvo, nri); }
            PG8_WAIT_V(8); PG8_WAIT_L(0); PG8_BAR; PG8_MMA(0, 0, At, B0); PG8_MMA(0, 1, At, B1); PG8_BAR; PG8_SCHED;
            PG8_LDA(At, 0, 1); PG8_STAGE(PG8_SB(0, 0), b2, voffB); PG8_STAGE(PG8_SB(0, 1), b2 + hstep, voffB); PG8_STAGE(PG8_SA(0, 0), a2, cvo[0]);
            PG8_WAIT_V(8); PG8_WAIT_L(0); PG8_BAR; PG8_MMA(1, 0, At, B0); PG8_MMA(1, 1, At, B1); PG8_BAR; PG8_SCHED;
            PG8_LDB(B0, 1, 0); PG8_LDB(B1, 1, 1); PG8_SCHED; PG8_LDA(At, 1, 0); PG8_STAGE(PG8_SA(0, 1), a2, cvo[1]);
            PG8_WAIT_V(8); PG8_WAIT_L(0); PG8_BAR; PG8_MMA(0, 0, At, B0); PG8_MMA(0, 1, At, B1); PG8_BAR; PG8_SCHED;
            PG8_LDA(At, 1, 1); PG8_STAGE(PG8_SB(1, 0), b3, voffB); PG8_STAGE(PG8_SB(1, 1), b3 + hstep, voffB); PG8_STAGE(PG8_SA(1, 0), a3, cvo[0]);
            PG8_WAIT_V(8); PG8_WAIT_L(0); PG8_BAR; PG8_MMA(1, 0, At, B0); PG8_MMA(1, 1, At, B1); PG8_BAR; PG8_SCHED;
        }
        if (wr == 0) PG8_BAR;
        E(acc, cur, wr, wc, fr, fq);
        if (!has_next) break;
#pragma unroll
        for (int a = 0; a < 2; ++a)
#pragma unroll
            for (int b = 0; b < 2; ++b)
#pragma unroll
                for (int m = 0; m < 4; ++m)
#pragma unroll
                    for (int n = 0; n < 2; ++n) acc[a][b][m][n] = (f32x4){0.f, 0.f, 0.f, 0.f};
        cur = nxt; cB = nB; ++ui;
        if (wr == 1) PG8_BAR;
    }
    PG8_WAIT_V(0);
    PG8_BAR;
#undef PG8_SA
#undef PG8_SB
#undef PG8_STAGE
#undef PG8_LDA
#undef PG8_LDB
#undef PG8_MMA
#undef PG8_WAIT_V
#undef PG8_WAIT_L
#undef PG8_BAR
#undef PG8_SCHED
#undef PG8_ROWIDX
#undef PG8_AOFF_FROM
}
}
template <class E4> DI void fast_gemm(const Ctx& C, const bf16* A, int lda, const bf16* Bt, int K, int nM, int nN, const E4& e, bool rev = false) {
    pg8::Gemm g{A, Bt, lda, K, nullptr}; pg8::OrderMN S{nM, nN, C.nb, rev ? C.nb - 1 - C.vcu : C.vcu}; pg8::EpiAdapt<E4> E{e};
    pg8::gemm_phase(C.lds, g, S, E, C.tid);
}

DI float max16_acc(float m, const f32x16& x) {
    asm volatile("s_nop 15\n\tv_max3_f32 %0, %0, %1, %2\n\tv_max3_f32 %0, %0, %3, %4\n\tv_max3_f32 %0, %0, %5, %6\n\tv_max3_f32 %0, %0, %7, %8\n\tv_max3_f32 %0, %0, %9, %10\n\tv_max3_f32 %0, %0, %11, %12\n\tv_max3_f32 %0, %0, %13, %14\n\tv_max3_f32 %0, %0, %15, %16"
                 : "+v"(m) : "v"(x[0]), "v"(x[1]), "v"(x[2]), "v"(x[3]), "v"(x[4]), "v"(x[5]), "v"(x[6]), "v"(x[7]), "v"(x[8]), "v"(x[9]), "v"(x[10]), "v"(x[11]), "v"(x[12]), "v"(x[13]), "v"(x[14]), "v"(x[15]));
    return m; }
DI int swap23(int x) { return (x & ~12) | ((x & 4) << 1) | ((x & 8) >> 1); }
DI void flash_store(const f32x16 (&o)[2], float l, bf16* orow  , int h) {
    const float inv = 1.f / l;
#pragma unroll
    for (int dt = 0; dt < 2; ++dt)
#pragma unroll
        for (int g = 0; g < 4; ++g)
            *(u32x2*)(orow + 32 * dt + 8 * g + 4 * h) = (u32x2){pk2(o[dt][4 * g] * inv, o[dt][4 * g + 1] * inv), pk2(o[dt][4 * g + 2] * inv, o[dt][4 * g + 3] * inv)};
}


template <int DQK> struct AttnGeo { static constexpr int KSTR = DQK * 2 + 16, KBYTES = 64 * KSTR, VSTR = 144, VBYTES = 64 * VSTR, BUF = KBYTES + VBYTES, KPIECES = 64 * DQK / 8; };
template <int DQK, bool NAT>
DI void attn_tile_loop(const Ctx& C, f32x16 (&o)[2], float& l, const bf16x8 (&qf)[DQK / 16], const bf16* __restrict__ Kb, const bf16* __restrict__ Vt, int pos1, int n1, int pos2, int n2,
                       const LAS float* tab, int grow, int rs, int qc, int cs) {
    typedef AttnGeo<DQK> G;
    const int tid = C.tid, r = C.lane & 31, h = C.lane >> 5, kr = swap23(r), ntiles = n1 + n2;
    constexpr bool K2 = G::KPIECES > 512;
    const int kq0 = tid, kq1 = tid + 512;
    const int kl0 = (kq0 / (DQK / 8)) * G::KSTR + (kq0 % (DQK / 8)) * 16, kl1 = (kq1 / (DQK / 8)) * G::KSTR + (kq1 % (DQK / 8)) * 16;
    const int vl = G::KBYTES + (tid >> 3) * G::VSTR + (tid & 7) * 16;
    const bf16* vg = Vt + (size_t)(tid >> 3) * KPOS + 8 * (tid & 7);
    u32x4 rk0, rk1, rv;
    rk1 = (u32x4){0u, 0u, 0u, 0u};
#define ATT_POS(t) ((t) < n1 ? pos1 + 64 * (t) : pos2 + 64 * ((t) - n1))
    { const int pos0 = ATT_POS(0); rk0 = *(const u32x4*)(Kb + (size_t)pos0 * DQK + 8 * kq0); if (K2 && tid < 256) rk1 = *(const u32x4*)(Kb + (size_t)pos0 * DQK + 8 * kq1); rv = *(const u32x4*)(vg + pos0); }
    __syncthreads();
    *(LAS u32x4*)(C.lds + kl0) = rk0; if (K2 && tid < 256) *(LAS u32x4*)(C.lds + kl1) = rk1; *(LAS u32x4*)(C.lds + vl) = rv;
    __syncthreads();
    if (C.wave >= 4) __builtin_amdgcn_s_setprio(1);
    float mref = 0.f; bool first = true;
    f32x16 nmref;
#pragma unroll
    for (int i = 0; i < 16; ++i) nmref[i] = 0.f;
    constexpr float THR = 8.f;
    for (int t = 0; t < ntiles; ++t) {
        const LAS unsigned char* B = C.lds + (t & 1) * G::BUF;
        if (t + 1 < ntiles) { const int pos0 = ATT_POS(t + 1);
            rk0 = *(const u32x4*)(Kb + (size_t)pos0 * DQK + 8 * kq0); if (K2 && tid < 256) rk1 = *(const u32x4*)(Kb + (size_t)pos0 * DQK + 8 * kq1); rv = *(const u32x4*)(vg + pos0); }
        const int gr = (pos1 >> 6) + t;
        const bool active = !NAT || t >= n1 || (gr >= rs && gr < rs + 8);
        if (active) {
            f32x16 sc[2];
            constexpr int NK = DQK / 16, NS = 2 * NK, RD = 4;
            const LAS unsigned char* kp = B + kr * G::KSTR + 16 * h;
            bf16x8 fr[RD];
#pragma unroll
            for (int s = 0; s < RD; ++s) fr[s] = *(const LAS bf16x8*)(kp + (s / NK) * 32 * G::KSTR + 32 * (s % NK));
#pragma unroll
            for (int s = 0; s < NS; ++s) { sc[s / NK] = MFMA32(fr[s % RD], qf[s % NK], (s % NK == 0) ? nmref : sc[s / NK]);
                if (s + RD < NS) fr[s % RD] = *(const LAS bf16x8*)(kp + ((s + RD) / NK) * 32 * G::KSTR + 32 * ((s + RD) % NK)); }
            const LAS unsigned char* vp = B + G::KBYTES + r * G::VSTR + 16 * h;
#pragma unroll
            for (int v = 0; v < RD; ++v) fr[v] = *(const LAS bf16x8*)(vp + (v & 1) * 32 * G::VSTR + (v >> 1) * 32);
            __builtin_amdgcn_sched_group_barrier(0x100, RD, 0);
#pragma unroll
            for (int s = 0; s < NS - RD; ++s) { __builtin_amdgcn_sched_group_barrier(0x008, 1, 0); __builtin_amdgcn_sched_group_barrier(0x100, 1, 0); }
            __builtin_amdgcn_sched_group_barrier(0x008, RD, 0);
            __builtin_amdgcn_sched_group_barrier(0x100, RD, 0);
            if (NAT && t < n1) {
                const LAS float* trl = tab + (gr - grow + 7) * 128 + (8 * h - qc + 63);
#pragma unroll
                for (int j = 0; j < 2; ++j) { float bv[16];
#pragma unroll
                    for (int i = 0; i < 16; ++i) bv[i] = trl[32 * j + ((i & 3) | (((i >> 2) & 1) << 2) | ((i >> 3) << 4))];
                    asm volatile("" : "+v"(bv[0]), "+v"(bv[1]), "+v"(bv[2]), "+v"(bv[3]), "+v"(bv[4]), "+v"(bv[5]), "+v"(bv[6]), "+v"(bv[7]), "+v"(bv[8]), "+v"(bv[9]), "+v"(bv[10]), "+v"(bv[11]), "+v"(bv[12]), "+v"(bv[13]), "+v"(bv[14]), "+v"(bv[15]));
#pragma unroll
                    for (int i = 0; i < 16; ++i) {
                        const int cc = 32 * j + ((i & 3) | (((i >> 2) & 1) << 2) | ((i >> 3) << 4)) + 8 * h; const bool ok = (cc >= cs) && (cc < cs + 16);
                        sc[j][i] = ok ? sc[j][i] + bv[i] : -1e30f;
                    } }
            }
            float mx = max16_acc(max16_acc(-3.0e38f, sc[0]), sc[1]);
            if (first || __builtin_amdgcn_ballot_w64(mx > THR) != 0ull) {
                mx = fmaxf(mx, xor32(mx, C.lane));
                const float delta = first ? mx : fmaxf(mx, 0.f);
#pragma unroll
                for (int i = 0; i < 16; ++i) { sc[0][i] -= delta; sc[1][i] -= delta; }
                if (!first) { const float alpha = __builtin_amdgcn_exp2f(-delta); l *= alpha;
#pragma unroll
                    for (int i = 0; i < 16; ++i) { o[0][i] *= alpha; o[1][i] *= alpha; } }
                mref += delta; first = false;
#pragma unroll
                for (int i = 0; i < 16; ++i) nmref[i] = -mref;
            }
            float rs1 = 0.f;
#pragma unroll
            for (int j = 0; j < 2; ++j)
#pragma unroll
                for (int i = 0; i < 16; ++i) { sc[j][i] = __builtin_amdgcn_exp2f(sc[j][i]); rs1 += sc[j][i]; }
            l += rs1;
#pragma unroll
            for (int j = 0; j < 2; ++j)
#pragma unroll
                for (int s2 = 0; s2 < 2; ++s2) {
                    u32x4 pw; pw.x = pk2(sc[j][8 * s2], sc[j][8 * s2 + 1]); pw.y = pk2(sc[j][8 * s2 + 2], sc[j][8 * s2 + 3]); pw.z = pk2(sc[j][8 * s2 + 4], sc[j][8 * s2 + 5]); pw.w = pk2(sc[j][8 * s2 + 6], sc[j][8 * s2 + 7]);
                    const bf16x8 pb = __builtin_bit_cast(bf16x8, pw);
#pragma unroll
                    for (int dt = 0; dt < 2; ++dt) { const int v = 4 * j + 2 * s2 + dt;
                        o[dt] = MFMA32(fr[v % RD], pb, o[dt]);
                        if (v + RD < 8) fr[v % RD] = *(const LAS bf16x8*)(vp + ((v + RD) & 1) * 32 * G::VSTR + ((v + RD) >> 1) * 32); }
                }
#pragma unroll
            for (int v = 0; v < 8 - RD; ++v) { __builtin_amdgcn_sched_group_barrier(0x008, 1, 1); __builtin_amdgcn_sched_group_barrier(0x100, 1, 1); }
            __builtin_amdgcn_sched_group_barrier(0x008, RD, 1);
        }
        if (t + 1 < ntiles) { LAS unsigned char* Bn = C.lds + ((t + 1) & 1) * G::BUF;
            *(LAS u32x4*)(Bn + kl0) = rk0; if (K2 && tid < 256) *(LAS u32x4*)(Bn + kl1) = rk1; *(LAS u32x4*)(Bn + vl) = rv; }
        __syncthreads();
    }
    __builtin_amdgcn_s_setprio(0);
    l += xor32(l, C.lane);
#undef ATT_POS
}
DI void conv_unit(const Ctx& C, int u, const bf16* U, const float (&wk)[31], float bias, const float* lng, const float* lnb, bf16* OCAT);
DI void wprep_items(const Ctx& C, int k0, int k1, const float* w1, const float* w3, const float* w2, bf16* W13, bf16* W2);
DI const float* in_ptr(const unsigned char* ws, int k);
DI void ph_attn_mla2(const Ctx& C, const bf16* QB, const bf16* KB, const bf16* VT, bf16* OCAT, bool last, unsigned char* ws, int lq) {
    const int r = C.lane & 31, h = C.lane >> 5;
    const int nunits = 1024 + (last ? 0 : 64);
    const int nwp = (NEXP * 3 * 256 + C.nb * 8 - 1) / (C.nb * 8);
    int k = 0;
    for (;; ++k) {
        const int u = C.vcu + k * C.nb, cu = (C.nb - 1 - C.vcu) + k * C.nb;
        const bool a_on = u < nunits, c_on = cu < MT / 32, w_on = 2 * k < nwp;
        if (!a_on && !c_on && !w_on) break;
        if (a_on) {
            const int bh = u < 1024 ? (u >> 4) : u - 1024, qblk = u < 1024 ? (u & 15) : 16, b = bh >> 3, hh = bh & 7;
            const int qpos = qblk * 256 + 32 * C.wave + r;
            const bf16* qp = QB + ((size_t)bh * KPOS + qpos) * 96 + 8 * h;
            bf16x8 qf[6];
#pragma unroll
            for (int kk = 0; kk < 6; ++kk) qf[kk] = *(const bf16x8*)(qp + 16 * kk);
            f32x16 o[2];
#pragma unroll
            for (int i = 0; i < 16; ++i) { o[0][i] = 0.f; o[1][i] = 0.f; }
            float l = 0.f;
            attn_tile_loop<96, false>(C, o, l, qf, KB + (size_t)bh * KPOS * 96, VT + (size_t)bh * 64 * KPOS, qblk < 16 ? 0 : TL, qblk < 16 ? KPOS / 64 : LCX / 64, 0, 0, nullptr, 0, 0, 0, 0);
            const int row = qblk < 16 ? b * TL + qpos : NLAT + b * LCX + (qpos - TL);
            flash_store(o, l, OCAT + (size_t)row * DM + hh * 64, h);
        }
        if (c_on) { float wk[31]; const float* dww = in_ptr(ws, I_DWW) + (size_t)lq * 31 * 512;
#pragma unroll
            for (int kt = 0; kt < 31; ++kt) wk[kt] = dww[kt * 512 + C.tid];
            conv_unit(C, cu, (const bf16*)(ws + WS_ARENA + A_U), wk, in_ptr(ws, I_DWB)[lq * 512 + C.tid], in_ptr(ws, I_LNG) + lq * 512, in_ptr(ws, I_LNB) + lq * 512, OCAT); }
        if (w_on) { __syncthreads(); const size_t wo = (size_t)(2 * lq) * NEXP * DM * DM;
            wprep_items(C, 2 * k, 2 * k + 2, in_ptr(ws, I_MW1) + wo, in_ptr(ws, I_MW3) + wo, in_ptr(ws, I_MW2) + wo, (bf16*)(ws + WS_W13), (bf16*)(ws + WS_W2)); }
    }
}
DI void ph_natten2(const Ctx& C, const bf16* QN, const bf16* KN, const bf16* VTN, bf16* OCAT, const float* rpb  , bool last, unsigned* work_ctr, unsigned char* ws, int lq) {
    const int r = C.lane & 31, h = C.lane >> 5;
    LAS float* tab = (LAS float*)(C.lds + 2 * AttnGeo<64>::BUF);
    LAS int* uslot = (LAS int*)(tab + 1920);
    const int nunits = 1024 + (last ? 0 : 64);
    const int nwp = (NEXP * 3 * 256 + C.nb * 8 - 1) / (C.nb * 8); int wdone = 0;
    for (;;) {
        __syncthreads();
        if (wdone < nwp) { const size_t wo = (size_t)(2 * lq + 1) * NEXP * DM * DM; wprep_items(C, wdone, wdone + 2, in_ptr(ws, I_MW1) + wo, in_ptr(ws, I_MW3) + wo, in_ptr(ws, I_MW2) + wo, (bf16*)(ws + WS_W13), (bf16*)(ws + WS_W2)); wdone += 2; __syncthreads(); }
        if (C.tid == 0) *uslot = (int)__hip_atomic_fetch_add(work_ctr, 1u, __ATOMIC_RELAXED, __HIP_MEMORY_SCOPE_AGENT);
        __syncthreads();
        const int u = *uslot;
        if (u >= nunits) { if (wdone < nwp) { const size_t wo = (size_t)(2 * lq + 1) * NEXP * DM * DM; wprep_items(C, wdone, nwp, in_ptr(ws, I_MW1) + wo, in_ptr(ws, I_MW3) + wo, in_ptr(ws, I_MW2) + wo, (bf16*)(ws + WS_W13), (bf16*)(ws + WS_W2)); } break; }
        const bool isctx = u >= 1024;
        const int bh = isctx ? u - 1024 : (u >> 4), b = bh >> 3, hh = bh & 7;
        for (int i = C.tid; i < 15 * 128; i += 512) { const int dc = (i & 127) - 48; tab[i] = (dc >= 0 && dc < 31) ? rpb[hh * 465 + (i >> 7) * 31 + dc] * LOG2E : 0.f; }
        int qpos, row, grow = 0, qc = 0, rs = 0, cs = 0, rlo = 0, nband = 0;
        if (!isctx) { const int rg = u & 15; grow = 4 * rg + (C.wave >> 1); qc = 32 * (C.wave & 1) + r; qpos = grow * 64 + qc; row = b * TL + qpos;
            rs = grow - 4; rs = rs < 0 ? 0 : (rs > 56 ? 56 : rs); cs = qc - 8; cs = cs < 0 ? 0 : (cs > 48 ? 48 : cs);
            rlo = 4 * rg - 4; rlo = rlo < 0 ? 0 : (rlo > 56 ? 56 : rlo); int rhi = 4 * rg + 3 - 4; rhi = rhi < 0 ? 0 : (rhi > 56 ? 56 : rhi); nband = rhi + 8 - rlo; }
        else { qpos = TL + 32 * C.wave + r; row = NLAT + b * LCX + 32 * C.wave + r; }
        const bf16* qp = QN + ((size_t)bh * KPOS + qpos) * 64 + 8 * h;
        bf16x8 qf[4];
#pragma unroll
        for (int kk = 0; kk < 4; ++kk) qf[kk] = *(const bf16x8*)(qp + 16 * kk);
        f32x16 o[2];
#pragma unroll
        for (int i = 0; i < 16; ++i) { o[0][i] = 0.f; o[1][i] = 0.f; }
        float l = 0.f;
        attn_tile_loop<64, true>(C, o, l, qf, KN + (size_t)bh * KPOS * 64, VTN + (size_t)bh * 64 * KPOS, rlo * 64, nband, TL, LCX / 64, tab, grow, rs, qc, cs);
        flash_store(o, l, OCAT + (size_t)row * DM + 512 + hh * 64, h);
    }
}


DI void ph_mla_fin(const Ctx& C, const bf16* U, const bf16* QPRE, const bf16* KVPRE, const float* qg, const float* kg, const f32x2* CS, bf16* QB, bf16* KB, bf16* VT) {
    LAS bf16* VL = (LAS bf16*)C.lds;
    const int lane = C.lane, j = lane >> 3, sub = lane & 7;
    const float C2 = 0.10206207261596575f * LOG2E;
    float qgn[8], qgr[4], kgn[8], kgr[4];
#pragma unroll
    for (int e = 0; e < 8; ++e) { qgn[e] = qg[8 * sub + e] * C2; kgn[e] = kg[8 * sub + e]; }
#pragma unroll
    for (int m = 0; m < 4; ++m) { qgr[m] = qg[64 + sub + 8 * m] * C2; kgr[m] = kg[64 + sub + 8 * m]; }
    for (int u = C.vcu; u < MT / 64; u += C.nb) {
        const int row0 = 64 * u, b = row0 < NLAT ? (row0 >> 12) : ((row0 - NLAT) >> 8), pos0 = row0 < NLAT ? (row0 & 4095) : TL + ((row0 - NLAT) & 255);
        const bool lat = row0 < NLAT;
        const int pl = 8 * C.wave + j, row = row0 + pl, pos = pos0 + pl;
        const bf16* ur = U + (size_t)row * EV_INP;
        float sq = 0.f, skv = 0.f;
#pragma unroll
        for (int m = 0; m < 6; ++m) { float x[8]; unpack8(*(const u32x4*)(ur + 8 * (sub + 8 * m)), x);
#pragma unroll
            for (int e = 0; e < 8; ++e) sq += x[e] * x[e]; }
#pragma unroll
        for (int m = 0; m < 4; ++m) { float x[8]; unpack8(*(const u32x4*)(ur + 384 + 8 * (sub + 8 * m)), x);
#pragma unroll
            for (int e = 0; e < 8; ++e) skv += x[e] * x[e]; }
        sq = sum8(sq); skv = sum8(skv);
        const float rsq = 1.0f / sqrtf(sq * (1.f / 384.f) + EPS), rskv = 1.0f / sqrtf(skv * (1.f / 256.f) + EPS);
        float krv[4];
#pragma unroll
        for (int m = 0; m < 4; ++m) krv[m] = bf2f(ur[640 + sub + 8 * m]);
        float cr = 1.f, sr = 0.f, cc = 1.f, sc = 0.f;
        if (lat) { const f32x2 a0 = CS[pos * 16 + sub], a1 = CS[pos * 16 + 8 + sub]; cr = a0.x; sr = a0.y; cc = a1.x; sc = a1.y; }
        const bf16* qrow = QPRE + (size_t)row * 768; const bf16* kvrow = KVPRE + (size_t)row * 1024;
#pragma unroll 2
        for (int hh = 0; hh < 8; ++hh) {
            { float qn[8], qr[4]; unpack8(*(const u32x4*)(qrow + hh * 96 + 8 * sub), qn); float ss = 0.f;
#pragma unroll
              for (int e = 0; e < 8; ++e) qn[e] *= rsq;
#pragma unroll
              for (int m = 0; m < 4; ++m) { qr[m] = bf2f(qrow[hh * 96 + 64 + sub + 8 * m]) * rsq; ss += qr[m] * qr[m]; }
#pragma unroll
              for (int e = 0; e < 8; ++e) ss += qn[e] * qn[e];
              const float rn = 1.0f / sqrtf(sum8(ss) * (1.f / 96.f) + EPS);
#pragma unroll
              for (int e = 0; e < 8; ++e) qn[e] *= rn * qgn[e];
#pragma unroll
              for (int m = 0; m < 4; ++m) qr[m] *= rn * qgr[m];
              { const float x0 = qr[0], x1 = qr[1], y0 = qr[2], y1 = qr[3]; qr[0] = x0 * cr - x1 * sr; qr[1] = x1 * cr + x0 * sr; qr[2] = y0 * cc - y1 * sc; qr[3] = y1 * cc + y0 * sc; }
              bf16* qo = QB + ((size_t)(b * 8 + hh) * KPOS + pos) * 96;
              *(u32x4*)(qo + 8 * sub) = pack8(qn);
#pragma unroll
              for (int m = 0; m < 4; ++m) qo[64 + sub + 8 * m] = f2bf(qr[m]); }
            { float kn[8], kr[4]; unpack8(*(const u32x4*)(kvrow + hh * 128 + 8 * sub), kn); float ss = 0.f;
#pragma unroll
              for (int e = 0; e < 8; ++e) kn[e] *= rskv;
#pragma unroll
              for (int m = 0; m < 4; ++m) { kr[m] = krv[m]; ss += kr[m] * kr[m]; }
#pragma unroll
              for (int e = 0; e < 8; ++e) ss += kn[e] * kn[e];
              const float rn = 1.0f / sqrtf(sum8(ss) * (1.f / 96.f) + EPS);
#pragma unroll
              for (int e = 0; e < 8; ++e) kn[e] *= rn * kgn[e];
#pragma unroll
              for (int m = 0; m < 4; ++m) kr[m] *= rn * kgr[m];
              { const float x0 = kr[0], x1 = kr[1], y0 = kr[2], y1 = kr[3]; kr[0] = x0 * cr - x1 * sr; kr[1] = x1 * cr + x0 * sr; kr[2] = y0 * cc - y1 * sc; kr[3] = y1 * cc + y0 * sc; }
              bf16* ko = KB + ((size_t)(b * 8 + hh) * KPOS + pos) * 96;
              *(u32x4*)(ko + 8 * sub) = pack8(kn);
#pragma unroll
              for (int m = 0; m < 4; ++m) ko[64 + sub + 8 * m] = f2bf(kr[m]); }
            { float vv[8]; unpack8(*(const u32x4*)(kvrow + hh * 128 + 64 + 8 * sub), vv);
#pragma unroll
              for (int e = 0; e < 8; ++e) VL[(hh * 64 + 8 * sub + e) * 64 + pl] = f2bf(vv[e] * rskv); }
        }
        __syncthreads();
        { const int hd = C.tid;
            bf16* dst = VT + ((size_t)(b * 8 + (hd >> 6)) * 64 + (hd & 63)) * KPOS + pos0;
#pragma unroll
            for (int q = 0; q < 8; ++q) *(u32x4*)(dst + 8 * q) = *(const LAS u32x4*)(VL + hd * 64 + 8 * q); }
        __syncthreads();
    }
}

DI void conv_unit(const Ctx& C, int u, const bf16* U, const float (&wk)[31], float bias, const float* lng, const float* lnb, bf16* OCAT) {
    LAS float* G = (LAS float*)C.lds;
    const int c = C.tid;
    const int row0 = 32 * u; int base, t0, tseq;
    if (row0 < NLAT) { base = row0 & ~4095; t0 = row0 & 4095; tseq = TL; } else { const int rc = row0 - NLAT; base = NLAT + (rc & ~255); t0 = rc & 255; tseq = LCX; }
    __syncthreads();
    for (int rr = C.wave; rr < 62; rr += 8) { const int tt = t0 - 15 + rr; float g[8];
#pragma unroll
        for (int e = 0; e < 8; ++e) g[e] = 0.f;
        if (tt >= 0 && tt < tseq) { const bf16* ur = U + (size_t)(base + tt) * EV_INP; float av[8], gv[8]; unpack8(*(const u32x4*)(ur + 672 + 8 * C.lane), av); unpack8(*(const u32x4*)(ur + 1184 + 8 * C.lane), gv);
#pragma unroll
            for (int e = 0; e < 8; ++e) g[e] = av[e] * sigmoidf_(gv[e]); }
        *(LAS f32x4*)(G + rr * 512 + 8 * C.lane) = (f32x4){g[0], g[1], g[2], g[3]}; *(LAS f32x4*)(G + rr * 512 + 8 * C.lane + 4) = (f32x4){g[4], g[5], g[6], g[7]}; }
    __syncthreads();
    float acc[32];
#pragma unroll
    for (int t = 0; t < 32; ++t) acc[t] = bias;
#pragma unroll
    for (int rr = 0; rr < 62; ++rr) { const float gv = G[rr * 512 + c];
#pragma unroll
        for (int t = 0; t < 32; ++t) { const int k = rr - t; if (k >= 0 && k < 31) acc[t] += gv * wk[k]; } }
    __syncthreads();
#pragma unroll
    for (int t = 0; t < 32; ++t) G[t * 512 + c] = acc[t];
    __syncthreads();
#pragma unroll
    for (int q = 0; q < 4; ++q) {
        const int t = 4 * C.wave + q, row = row0 + t;
        const f32x4 a0 = *(const LAS f32x4*)(G + t * 512 + 8 * C.lane), a1 = *(const LAS f32x4*)(G + t * 512 + 8 * C.lane + 4);
        float x[8] = {a0.x, a0.y, a0.z, a0.w, a1.x, a1.y, a1.z, a1.w}; float s = 0.f;
#pragma unroll
        for (int e = 0; e < 8; ++e) s += x[e];
        const float mu = wave_sum(s) * (1.f / 512.f); float s2 = 0.f;
#pragma unroll
        for (int e = 0; e < 8; ++e) { x[e] -= mu; s2 += x[e] * x[e]; }
        const float rstd = 1.0f / sqrtf(wave_sum(s2) * (1.f / 512.f) + EPS);
        float y[8];
#pragma unroll
        for (int e = 0; e < 8; ++e) { const float z = x[e] * rstd * lng[8 * C.lane + e] + lnb[8 * C.lane + e]; y[e] = siluf_(z); }
        *(u32x4*)(OCAT + (size_t)row * DM + 512 + 8 * C.lane) = pack8(y);
    }
    __syncthreads();
}
DI void wprep_items(const Ctx& C, int k0, int k1, const float* w1, const float* w3, const float* w2, bf16* W13, bf16* W2) {
    LAS float* scr = (LAS float*)(C.lds + C.wave * 16640);
    const int gw = C.vcu * 8 + C.wave, ngw = C.nb * 8;
    constexpr int PER = 16 * 16, NIT = NEXP * 3 * PER;
    for (int k = k0; k < k1; ++k) { const int it = gw + k * ngw; if (it >= NIT) break;
        const int e = it / (3 * PER), r = it % (3 * PER), which = r / PER, q = r % PER, kb = q / 16, n0 = (q % 16) * 64;
#if MOE_F8
        if (which == 0)      transpose_item64_f8(w1 + (size_t)e * DM * DM, DM, DM, (unsigned char*)W13 + (size_t)e * 2048 * DM, (n0 >> 7) * 256 + (n0 & 127), scr, kb * 64, n0, C.lane);
        else if (which == 1) transpose_item64_f8(w3 + (size_t)e * DM * DM, DM, DM, (unsigned char*)W13 + (size_t)e * 2048 * DM, (n0 >> 7) * 256 + (n0 & 127) + 128, scr, kb * 64, n0, C.lane);
        else                 transpose_item64_f8(w2 + (size_t)e * DM * DM, DM, DM, (unsigned char*)W2 + (size_t)e * DM * DM, n0, scr, kb * 64, n0, C.lane); }
#else
        if (which == 0)      transpose_item64(w1 + (size_t)e * DM * DM, DM, DM, W13 + (size_t)e * 2048 * DM, (n0 >> 7) * 256 + (n0 & 127), scr, kb * 64, n0, C.lane);
        else if (which == 1) transpose_item64(w3 + (size_t)e * DM * DM, DM, DM, W13 + (size_t)e * 2048 * DM, (n0 >> 7) * 256 + (n0 & 127) + 128, scr, kb * 64, n0, C.lane);
        else                 transpose_item64(w2 + (size_t)e * DM * DM, DM, DM, W2 + (size_t)e * DM * DM, n0, scr, kb * 64, n0, C.lane); }
#endif
}
constexpr int WPREP_PER_WAVE = (NEXP * 3 * 256 + 2047) / 2048;

DI void shifted8(const bf16* up, const bf16* uc, const bf16* un, bool hp, bool hn, const float (&s0)[8], const float (&s1)[8], const float (&s2)[8], int c0, float (&o)[8]) {
    const u32x4 z = {0u, 0u, 0u, 0u};
    const u32x4 vp = hp ? *(const u32x4*)(up + c0) : z, vc = *(const u32x4*)(uc + c0), vn = hn ? *(const u32x4*)(un + c0) : z;
    float p[8], c[8], n[8]; unpack8(vp, p); unpack8(vc, c); unpack8(vn, n);
#pragma unroll
    for (int e = 0; e < 8; ++e) o[e] = p[e] * s0[e] + c[e] * s1[e] + n[e] * s2[e];
}
DI void load_sw(const float* sw, int c0, float (&s0)[8], float (&s1)[8], float (&s2)[8]) {
#pragma unroll
    for (int e = 0; e < 8; ++e) { s0[e] = sw[c0 + e]; s1[e] = sw[RW_IN + c0 + e]; s2[e] = sw[2 * RW_IN + c0 + e]; }
}
DI void ph_prep(const Ctx& C, const bf16* U, const float* sw  , const float* kkw  , const float* naqg, const float* nakg,
                bf16* R, bf16* V, bf16* K, bf16* KK, bf16* L, bf16* QN, bf16* KN, bf16* VTN) {
    LAS bf16* VL = (LAS bf16*)C.lds;
    const int lane = C.lane, hh = lane >> 3, sub = lane & 7;
    const float C2 = 0.125f * LOG2E;
    for (int u = C.vcu; u < MT / 32; u += C.nb) {
        const int row0 = 32 * u; const bool lat = row0 < NLAT;
        const int b = lat ? (row0 >> 12) : ((row0 - NLAT) >> 8), pos0 = lat ? (row0 & 4095) : TL + ((row0 - NLAT) & 255), tseq = lat ? TL : LCX, tb = lat ? (row0 & 4095) : ((row0 - NLAT) & 255);
#define PREP_ROWVARS(i) const int pl = 4 * C.wave + (i), row = row0 + pl, t = tb + pl; const bool hp = t > 0, hn = t < tseq - 1; \
            const bf16* uc = U + (size_t)row * OD_INP; const bf16* up = uc - OD_INP; const bf16* un = uc + OD_INP
        { float s0[8], s1[8], s2[8]; load_sw(sw, 8 * lane, s0, s1, s2);
          for (int i = 0; i < 4; ++i) { PREP_ROWVARS(i); float o[8]; shifted8(up, uc, un, hp, hn, s0, s1, s2, 8 * lane, o); *(u32x4*)(R + (size_t)row * 512 + 8 * lane) = pack8(o); } }
        { float s0[8], s1[8], s2[8]; load_sw(sw, 1024 + 8 * lane, s0, s1, s2);
          for (int i = 0; i < 4; ++i) { PREP_ROWVARS(i); float o[8]; shifted8(up, uc, un, hp, hn, s0, s1, s2, 1024 + 8 * lane, o); *(u32x4*)(V + (size_t)row * 512 + 8 * lane) = pack8(o); } }
        { float s0[8], s1[8], s2[8]; load_sw(sw, 512 + 8 * lane, s0, s1, s2); float kw[8];
#pragma unroll
          for (int e = 0; e < 8; ++e) kw[e] = kkw[8 * lane + e];
          for (int i = 0; i < 4; ++i) { PREP_ROWVARS(i); float o[8]; shifted8(up, uc, un, hp, hn, s0, s1, s2, 512 + 8 * lane, o); *(u32x4*)(K + (size_t)row * 512 + 8 * lane) = pack8(o);
              float kk[8]; float ss = 0.f;
#pragma unroll
              for (int e = 0; e < 8; ++e) { kk[e] = o[e] * kw[e]; ss += kk[e] * kk[e]; }
              ss = sum8(ss); const float rn = 1.0f / sqrtf(ss + 1e-12f);
#pragma unroll
              for (int e = 0; e < 8; ++e) kk[e] *= rn;
              *(u32x4*)(KK + (size_t)row * 512 + 8 * lane) = pack8(kk); } }
        if (lane < 48) { float s0[8], s1[8], s2[8]; load_sw(sw, 1536 + 8 * lane, s0, s1, s2);
          for (int i = 0; i < 4; ++i) { PREP_ROWVARS(i); float o[8]; shifted8(up, uc, un, hp, hn, s0, s1, s2, 1536 + 8 * lane, o);
              if (lane < 16) {
#pragma unroll
                  for (int e = 0; e < 8; ++e) { const float ex = __expf(2.f * o[e]); o[e] = 1.f - 2.f * __builtin_amdgcn_rcpf(ex + 1.f); }
              } else if (lane >= 32) {
#pragma unroll
                  for (int e = 0; e < 8; ++e) o[e] = sigmoidf_(o[e]);
              }
              *(u32x4*)(L + (size_t)row * 384 + 8 * lane) = pack8(o); } }
        { float gq[8], gk[8];
#pragma unroll
          for (int e = 0; e < 8; ++e) { gq[e] = naqg[8 * sub + e] * C2; gk[e] = nakg[8 * sub + e]; }
          for (int i = 0; i < 4; ++i) { const int pl = 4 * C.wave + i, row = row0 + pl, pos = pos0 + pl; const bf16* uc = U + (size_t)row * OD_INP;
            { float x[8]; unpack8(*(const u32x4*)(uc + RW_IN + 8 * lane), x); float ss = 0.f;
#pragma unroll
                for (int e = 0; e < 8; ++e) ss += x[e] * x[e];
                ss = sum8(ss); const float rn = 1.0f / sqrtf(ss * (1.f / 64.f) + EPS);
#pragma unroll
                for (int e = 0; e < 8; ++e) x[e] = x[e] * rn * gq[e];
                *(u32x4*)(QN + ((size_t)(b * 8 + hh) * KPOS + pos) * 64 + 8 * sub) = pack8(x); }
            { float x[8]; unpack8(*(const u32x4*)(uc + RW_IN + 512 + 8 * lane), x); float ss = 0.f;
#pragma unroll
                for (int e = 0; e < 8; ++e) ss += x[e] * x[e];
                ss = sum8(ss); const float rn = 1.0f / sqrtf(ss * (1.f / 64.f) + EPS);
#pragma unroll
                for (int e = 0; e < 8; ++e) x[e] = x[e] * rn * gk[e];
                *(u32x4*)(KN + ((size_t)(b * 8 + hh) * KPOS + pos) * 64 + 8 * sub) = pack8(x); }
            { const u32x4 vv = *(const u32x4*)(uc + RW_IN + 1024 + 8 * lane); const unsigned w4[4] = {vv.x, vv.y, vv.z, vv.w};
#pragma unroll
                for (int e = 0; e < 8; ++e) { const int dv = 8 * sub + e; VL[(hh * 64 + dv) * 32 + pl] = (bf16)((e & 1) ? (w4[e >> 1] >> 16) : (w4[e >> 1] & 0xffffu)); } } } }
#undef PREP_ROWVARS
        __syncthreads();
        { const int hd = C.tid; bf16* dst = VTN + ((size_t)(b * 8 + (hd >> 6)) * 64 + (hd & 63)) * KPOS + pos0;
#pragma unroll
            for (int q = 0; q < 4; ++q) *(u32x4*)(dst + 8 * q) = *(const LAS u32x4*)(VL + hd * 32 + 8 * q); }
        __syncthreads();
    }
}

DI int scan_row(int s, int d, int b) { if (s < LCX) return NLAT + b * LCX + (d ? (LCX - 1 - s) : s); const int t = s - LCX; return b * TL + (d ? (TL - 1 - t) : t); }


constexpr int CCH = 16, NCHK = KPOS / CCH, NPROB = NB * 8 * 2 * NCHK, IMG_ELEMS = 3 * 32 * 16;
template <int N> struct ICk { static constexpr int value = N; };
DI int crow_(int reg, int h) { return (reg & 3) + 8 * (reg >> 2) + 4 * h; }
DI bf16x8 pack_lo8(const f32x16& x) {
    u32x4 p; p.x = pk2(x[0], x[1]); p.y = pk2(x[2], x[3]); p.z = pk2(x[4], x[5]); p.w = pk2(x[6], x[7]); return __builtin_bit_cast(bf16x8, p); }
DI bf16x8 pack_hi8(const f32x16& x) { u32x4 p; p.x = pk2(x[8], x[9]); p.y = pk2(x[10], x[11]); p.z = pk2(x[12], x[13]); p.w = pk2(x[14], x[15]); return __builtin_bit_cast(bf16x8, p); }
DI int perm16(int k) { return (k & ~15) | swap23(k & 15); }

DI void ph_wkv_pre(const Ctx& C, const bf16* R, const bf16* K, const bf16* KK, const float* LW, const bf16* AR_, const float* ka, bf16* IMG) {
    LAS unsigned char* wl = C.lds + C.wave * 13312;
    LAS bf16* ARl = (LAS bf16*)wl; LAS bf16* BKl = (LAS bf16*)(wl + 4608); LAS float* Ll = (LAS float*)(wl + 9216); LAS bf16* OUT = (LAS bf16*)(wl + 10240);
    const int lane = C.lane, r = lane & 31, h = lane >> 5;
    const int gw = C.vcu * 8 + C.wave, ngw = C.nb * 8;
    for (int p = gw; p < NPROB; p += ngw) {
        const int j = p % NCHK, rest = p / NCHK, d = rest & 1, hh = (rest >> 1) & 7, b = rest >> 4;
        const float* Wd = LW + (size_t)d * MT * 512; const bf16* Ad = AR_ + (size_t)d * MT * 512;
        const float kav = ka[hh * 64 + lane];
        const int row0 = scan_row(j * CCH, d, b), sg = d ? -1 : 1;
        float lw[16]; bf16 rr[16], kx[16], kkx[16], ax[16];
#pragma unroll
        for (int t = 0; t < 16; ++t) { const size_t off = (size_t)(row0 + sg * t) * 512 + hh * 64 + lane; lw[t] = Wd[off]; rr[t] = R[off]; kx[t] = K[off]; kkx[t] = KK[off]; ax[t] = Ad[off]; }
        float cum = 0.f, e0 = 1.f;
#pragma unroll
        for (int t = 0; t < 16; ++t) {
            cum += lw[t]; const float e1 = __expf(cum), ei = __builtin_amdgcn_rcpf(e1);
            const float kkv = bf2f(kkx[t]), av = bf2f(ax[t]), keff = bf2f(kx[t]) * (1.f + (av - 1.f) * kav);
            ARl[t * 72 + lane] = f2bf(-kkv * e0); ARl[(16 + t) * 72 + lane] = f2bf(bf2f(rr[t]) * e1);
            BKl[t * 72 + lane] = f2bf(kkv * av * ei); BKl[(16 + t) * 72 + lane] = f2bf(keff * ei);
            e0 = e1;
        }
        asm volatile("s_waitcnt lgkmcnt(0)" ::: "memory");
        f32x16 g;
#pragma unroll
        for (int i = 0; i < 16; ++i) g[i] = 0.f;
#pragma unroll
        for (int q = 0; q < 4; ++q) g = MFMA32(*(const LAS bf16x8*)(ARl + r * 72 + 16 * q + 8 * h), *(const LAS bf16x8*)(BKl + r * 72 + 16 * q + 8 * h), g);
        const int sI = r & 15; const bool isk = r >= 16;
#pragma unroll
        for (int i = 0; i < 16; ++i) {
            const int row = crow_(i, h), t = row & 15; const bool keep = (i < 8) ? (sI < t) : (sI <= t); const float val = keep ? g[i] : 0.f;
            if (i < 8) { if (!isk) { Ll[t * 16 + sI] = val; OUT[512 + row * 16 + perm16(sI)] = 0; } else OUT[row * 16 + sI] = f2bf(val); }
            else       { if (!isk) OUT[512 + row * 16 + perm16(sI)] = f2bf(val); else OUT[row * 16 + sI] = f2bf(val); }
        }
        asm volatile("s_waitcnt lgkmcnt(0)" ::: "memory");
        { const int c = lane & 15; float Pr[16];
            Pr[0] = (c == 0) ? 1.f : 0.f;
#pragma unroll
            for (int t = 1; t < 16; ++t) { const float lrow = Ll[t * 16 + c]; float acc = (c == t) ? 1.f : 0.f;
#pragma unroll
                for (int u = 0; u < t; ++u) acc += rdlane(lrow, u) * Pr[u];
                Pr[t] = acc; }
            if (lane < 16) {
#pragma unroll
                for (int t = 0; t < 16; ++t) { OUT[1024 + t * 16 + perm16(c)] = f2bf(Pr[t]); OUT[1024 + (16 + t) * 16 + c] = 0; } } }
        asm volatile("s_waitcnt lgkmcnt(0)" ::: "memory");
        { bf16* dst = IMG + (size_t)p * IMG_ELEMS;
#pragma unroll
            for (int q = 0; q < 3; ++q) *(u32x4*)(dst + (q * 64 + lane) * 8) = *(const LAS u32x4*)(OUT + (q * 64 + lane) * 8); }
        asm volatile("s_waitcnt lgkmcnt(0)" ::: "memory");
    }
}

DI void ph_wkv_chunk(const Ctx& C, const bf16* R, const bf16* V, const bf16* K, const bf16* KK, const float* LW, const bf16* AR_, const float* ka, const bf16* IMG, bf16* YS) {
    constexpr int S_AR = 0, S_BKT = 4608, S_VT = 9728, S_VT2 = 11264, S_GC = 12800, S_MM = 13056, S_MRB = 14592, S_PP = 16128, SLOT = 17664, CUMO = 2 * SLOT, YSTO = CUMO + 8192, DEPTH = 4;
    const int lane = C.lane, wv = C.wave, r = lane & 31, h = lane >> 5;
    const bool isE = wv == 2 || wv == 3 || wv == 6 || wv == 7, isS = wv < 2;
    const int te = (wv == 2 ? 0 : (wv == 3 ? 1 : (wv == 6 ? 2 : 3))) * 64 + lane, et = te >> 4, ekq = te & 15;
    const int vhf = te >> 7, vt = (te >> 3) & 15, viq = te & 7;
    const int hf = wv & 1;
    for (int cid0 = C.bid; cid0 < 128; cid0 += C.nb) {
        const int chain = cid0, b = chain >> 4, hh = (chain >> 1) & 7, d = chain & 1;
        const float* Wd = LW + (size_t)d * MT * 512; const bf16* Ad = AR_ + (size_t)d * MT * 512; bf16* Yd = YS + (size_t)d * MT * 512;
        const bf16* img = IMG + (size_t)(((b * 8 + hh) * 2 + d) * NCHK) * IMG_ELEMS;
        f32x16 ST[2];
#pragma unroll
        for (int i = 0; i < 16; ++i) { ST[0][i] = 0.f; ST[1][i] = 0.f; }
        const f32x4 kav = *(const f32x4*)(ka + hh * 64 + 4 * ekq);
        unsigned ring[DEPTH][16];
        __syncthreads();
        auto issue = [&](int ch, unsigned (&rg)[16]) __attribute__((always_inline)) {
            if (ch < 0 || ch >= NCHK) return;
            const int row0 = scan_row(ch * CCH, d, b), sg = d ? -1 : 1;
            if (isE) {
                const size_t off = (size_t)(row0 + sg * et) * 512 + hh * 64 + 4 * ekq;
                const u32x2 x0 = *(const u32x2*)(R + off), x1 = *(const u32x2*)(K + off), x2 = *(const u32x2*)(KK + off), x3 = *(const u32x2*)(Ad + off);
                const u32x2 x4 = *(const u32x2*)(V + (size_t)(row0 + sg * vt) * 512 + hh * 64 + 32 * vhf + 4 * viq);
                rg[0] = x0.x; rg[1] = x0.y; rg[2] = x1.x; rg[3] = x1.y; rg[4] = x2.x; rg[5] = x2.y; rg[6] = x3.x; rg[7] = x3.y; rg[8] = x4.x; rg[9] = x4.y;
                asm volatile("; wkv issue role E" ::);
            } else if (wv == 4) {
#define W5_(t) rg[(t)] = __builtin_bit_cast(unsigned, Wd[(size_t)(row0 + sg * (t)) * 512 + hh * 64 + lane])
                W5_(0); W5_(1); W5_(2); W5_(3); W5_(4); W5_(5); W5_(6); W5_(7); W5_(8); W5_(9); W5_(10); W5_(11); W5_(12); W5_(13); W5_(14); W5_(15);
#undef W5_
                asm volatile("; wkv issue role C" ::);
            } else if (wv == 5) {
#define W6_(q) do { const u32x4 x = *(const u32x4*)(img + (size_t)ch * IMG_ELEMS + ((q) * 64 + lane) * 8); rg[4 * (q)] = x.x; rg[4 * (q) + 1] = x.y; rg[4 * (q) + 2] = x.z; rg[4 * (q) + 3] = x.w; } while (0)
                W6_(0); W6_(1); W6_(2);
#undef W6_
                asm volatile("; wkv issue role V" ::);
            }
        };
        issue(0, ring[0]); issue(1, ring[1]); issue(2, ring[2]); issue(3, ring[3]);
#define WKV_BAR() asm volatile("s_waitcnt lgkmcnt(0)\n\ts_barrier" ::: "memory")
#define WKV_LOOP(...) for (int n0 = -2; n0 < NCHK; n0 += DEPTH) { auto iter = [&](auto kc) __attribute__((always_inline)) { constexpr int kk = decltype(kc)::value; \
            constexpr int riE = (kk + 3) % DEPTH, riW = kk % DEPTH; (void)riE; (void)riW; const int n = n0 + kk; (void)n; __VA_ARGS__; WKV_BAR(); }; iter(ICk<0>{}); iter(ICk<1>{}); iter(ICk<2>{}); iter(ICk<3>{}); }
        if (isS) {
            WKV_LOOP({
                if (n >= 0 && n < NCHK) {
                    const LAS unsigned char* B = C.lds + (n & 1) * SLOT;
                    f32x16 T1;
                    _Pragma("unroll") for (int i = 0; i < 16; ++i) T1[i] = 0.f;
                    _Pragma("unroll") for (int tau = 0; tau < 2; ++tau) {
                        T1 = MFMA32(*(const LAS bf16x8*)(B + S_AR + r * 144 + (32 * tau + 8 * h) * 2), pack_lo8(ST[tau]), T1);
                        T1 = MFMA32(*(const LAS bf16x8*)(B + S_AR + r * 144 + (32 * tau + 16 + 8 * h) * 2), pack_hi8(ST[tau]), T1);
                    }
                    const bf16x8 vtf = *(const LAS bf16x8*)(B + (hf ? S_VT2 : S_VT) + r * 48 + 16 * h);
                    T1 = MFMA32(*(const LAS bf16x8*)(B + S_MM + r * 48 + 16 * h), vtf, T1);
                    f32x16 ET;
                    _Pragma("unroll") for (int i = 0; i < 16; ++i) ET[i] = 0.f;
                    ET = MFMA32(*(const LAS bf16x8*)(B + S_PP + r * 48 + 16 * h), pack_lo8(T1), ET);
                    const bf16x8 ef = pack_lo8(ET);
                    T1 = MFMA32(*(const LAS bf16x8*)(B + S_MRB + r * 48 + 16 * h), ef, T1);
                    _Pragma("unroll") for (int tau = 0; tau < 2; ++tau) {
                        ST[tau] = MFMA32(*(const LAS bf16x8*)(B + S_BKT + (32 * tau + r) * 80 + 16 * h), ef, ST[tau]);
                        ST[tau] = MFMA32(*(const LAS bf16x8*)(B + S_BKT + (32 * tau + r) * 80 + 32 + 16 * h), vtf, ST[tau]);
                        _Pragma("unroll") for (int g4 = 0; g4 < 4; ++g4) { const f32x4 gc = *(const LAS f32x4*)(B + S_GC + (32 * tau + 8 * g4 + 4 * h) * 4);
                            ST[tau][4 * g4] *= gc.x; ST[tau][4 * g4 + 1] *= gc.y; ST[tau][4 * g4 + 2] *= gc.z; ST[tau][4 * g4 + 3] *= gc.w; }
                    }
                    LAS float* ys = (LAS float*)(C.lds + YSTO) + ((n & 1) * 2 + hf) * 512;
                    _Pragma("unroll") for (int q = 0; q < 8; ++q) ys[(8 * (q >> 2) + 4 * h + (q & 3)) * 32 + r] = T1[8 + q];
                }
            });
        } else if (isE) {
            WKV_LOOP({
                const int ch = n + 1;
                if (ch >= 0) {
                    if (ch < NCHK) {
                        LAS unsigned char* B = C.lds + (ch & 1) * SLOT; const LAS float* ec = (const LAS float*)(C.lds + CUMO) + (ch & 1) * 1024;
                        const f32x4 e1 = *(const LAS f32x4*)(ec + et * 64 + 4 * ekq);
                        f32x4 e0 = {1.f, 1.f, 1.f, 1.f}; if (et > 0) e0 = *(const LAS f32x4*)(ec + (et - 1) * 64 + 4 * ekq);
                        const float rv[4] = {bflo(ring[riE][0]), bfhi(ring[riE][0]), bflo(ring[riE][1]), bfhi(ring[riE][1])}; const float kv[4] = {bflo(ring[riE][2]), bfhi(ring[riE][2]), bflo(ring[riE][3]), bfhi(ring[riE][3])};
                        const float kkv[4] = {bflo(ring[riE][4]), bfhi(ring[riE][4]), bflo(ring[riE][5]), bfhi(ring[riE][5])}; const float av[4] = {bflo(ring[riE][6]), bfhi(ring[riE][6]), bflo(ring[riE][7]), bfhi(ring[riE][7])};
                        float ah[4]; float rh[4]; float bc[4]; float kc4[4];
                        _Pragma("unroll") for (int e = 0; e < 4; ++e) { const float ei = __builtin_amdgcn_rcpf(e1[e]);
                            ah[e] = -kkv[e] * e0[e]; rh[e] = rv[e] * e1[e]; bc[e] = kkv[e] * av[e] * ei; kc4[e] = kv[e] * (1.f + (av[e] - 1.f) * kav[e]) * ei; }
                        const int pk = perm16(4 * ekq);
                        *(LAS u32x2*)((LAS bf16*)(B + S_AR) + et * 72 + pk) = (u32x2){pk2(ah[0], ah[1]), pk2(ah[2], ah[3])};
                        *(LAS u32x2*)((LAS bf16*)(B + S_AR) + (16 + et) * 72 + pk) = (u32x2){pk2(rh[0], rh[1]), pk2(rh[2], rh[3])};
                        const int pt = perm16(et);
                        _Pragma("unroll") for (int e = 0; e < 4; ++e) { ((LAS bf16*)(B + S_BKT))[(4 * ekq + e) * 40 + pt] = f2bf(bc[e]); ((LAS bf16*)(B + S_BKT))[(4 * ekq + e) * 40 + 16 + et] = f2bf(kc4[e]); }
                        if (et == 15) *(LAS f32x4*)((LAS float*)(B + S_GC) + 4 * ekq) = e1;
                        LAS bf16* vtp = (LAS bf16*)(B + (vhf ? S_VT2 : S_VT)) + (4 * viq) * 24 + vt;
                        vtp[0] = (bf16)(ring[riE][8] & 0xffffu); vtp[24] = (bf16)(ring[riE][8] >> 16); vtp[48] = (bf16)(ring[riE][9] & 0xffffu); vtp[72] = (bf16)(ring[riE][9] >> 16);
                    }
                    issue(ch + DEPTH, ring[riE]);
                }
            });
        } else if (wv == 4) {
            WKV_LOOP({
                const int ch = n + 2;
                if (ch < NCHK) { LAS float* ec = (LAS float*)(C.lds + CUMO) + (ch & 1) * 1024; float c = 0.f;
#define C5_(t) do { c += __builtin_bit_cast(float, ring[riW][(t)]); ec[(t) * 64 + lane] = __expf(c); } while (0)
                    C5_(0); C5_(1); C5_(2); C5_(3); C5_(4); C5_(5); C5_(6); C5_(7); C5_(8); C5_(9); C5_(10); C5_(11); C5_(12); C5_(13); C5_(14); C5_(15);
                }
                issue(ch + DEPTH, ring[riW]);
            });
        } else {
            WKV_LOOP({
                { const int chy = n - 1;
                  if (chy >= 0 && chy < NCHK) { const int yh = lane >> 5, yt = (lane & 31) >> 1, yi = 16 * (lane & 1);
                    const LAS float* ys = (const LAS float*)(C.lds + YSTO) + ((chy & 1) * 2 + yh) * 512 + yt * 32 + yi;
                    bf16* dst = Yd + (size_t)(scan_row(chy * CCH, d, b) + (d ? -1 : 1) * yt) * 512 + hh * 64 + 32 * yh + yi;
                    _Pragma("unroll") for (int q = 0; q < 2; ++q) { const f32x4 a0 = *(const LAS f32x4*)(ys + 8 * q); const f32x4 a1 = *(const LAS f32x4*)(ys + 8 * q + 4);
                        *(u32x4*)(dst + 8 * q) = (u32x4){pk2(a0.x, a0.y), pk2(a0.z, a0.w), pk2(a1.x, a1.y), pk2(a1.z, a1.w)}; } } }
                const int ch = n + 1;
                if (ch >= 0) {
                    if (ch < NCHK) { LAS unsigned char* B = C.lds + (ch & 1) * SLOT;
                        const int irow = lane >> 1; const int ihv = lane & 1;
                        *(LAS u32x4*)(B + S_MM + irow * 48 + ihv * 16) = (u32x4){ring[riE][0], ring[riE][1], ring[riE][2], ring[riE][3]};
                        *(LAS u32x4*)(B + S_MRB + irow * 48 + ihv * 16) = (u32x4){ring[riE][4], ring[riE][5], ring[riE][6], ring[riE][7]};
                        *(LAS u32x4*)(B + S_PP + irow * 48 + ihv * 16) = (u32x4){ring[riE][8], ring[riE][9], ring[riE][10], ring[riE][11]};
                    }
                    issue(ch + DEPTH, ring[riE]);
                }
            });
        }
#undef C5_
#undef WKV_LOOP
#undef WKV_BAR
    }
}

DI void ph_post(const Ctx& C, const bf16* YS, const bf16* R, const bf16* V, const bf16* K, const bf16* A2, const float* ka, const bf16* G, const float* rk, const float* gng, const float* gnb, bf16* OCAT, bool last) {
    const int gw = C.bid * 8 + C.wave, ngw = C.nb * 8, lane = C.lane, nrows = last ? NLAT : MT;
    for (int row = gw; row < nrows; row += ngw) {
        const size_t o = (size_t)row * 512 + 8 * lane;
        float y[8], y1[8]; unpack8(*(const u32x4*)(YS + o), y); unpack8(*(const u32x4*)(YS + (size_t)MT * 512 + o), y1);
#pragma unroll
        for (int e = 0; e < 8; ++e) y[e] += y1[e];
        float r[8], v[8], kx[8], a0[8], a1[8], g[8];
        unpack8(*(const u32x4*)(R + o), r); unpack8(*(const u32x4*)(V + o), v); unpack8(*(const u32x4*)(K + o), kx); unpack8(*(const u32x4*)(A2 + o), a0); unpack8(*(const u32x4*)(A2 + (size_t)MT * 512 + o), a1); unpack8(*(const u32x4*)(G + o), g);
        float bsum = 0.f;
#pragma unroll
        for (int e = 0; e < 8; ++e) { const float kae = ka[8 * lane + e]; bsum += r[e] * (kx[e] * (1.f + (a0[e] - 1.f) * kae) + kx[e] * (1.f + (a1[e] - 1.f) * kae)) * rk[8 * lane + e]; }
        bsum = sum8(bsum);
        float s = 0.f;
#pragma unroll
        for (int e = 0; e < 8; ++e) { y[e] += bsum * v[e]; s += y[e]; }
        const float mu = sum8(s) * (1.f / 64.f); float s2 = 0.f;
#pragma unroll
        for (int e = 0; e < 8; ++e) { y[e] -= mu; s2 += y[e] * y[e]; }
        const float rstd = 1.0f / sqrtf(sum8(s2) * (1.f / 64.f) + GN_EPS);
        float out[8];
#pragma unroll
        for (int e = 0; e < 8; ++e) out[e] = (y[e] * rstd * gng[8 * lane + e] + gnb[8 * lane + e]) * g[e];
        *(u32x4*)(OCAT + (size_t)row * DM + 8 * lane) = pack8(out);
    }
}

DI void ph_topk2(const Ctx& C, const float* AFFT, const float* AFFC, int* ROWS, float* GATE, int* SLOT, bool last) {
    LAS unsigned* wcnt = (LAS unsigned*)C.lds;
    LAS unsigned* cnt = wcnt + 16;
    const int tid = C.tid, nprob = last ? 128 : 256;
    for (int p = C.bid; p < nprob; p += C.nb) {
        const bool isctx = p >= 128; const int be = p & 127, b = be >> 4, e = be & 15;
        const int n = isctx ? LCX : TL, cap = isctx ? CAPC : CAPL;
        const float* src = isctx ? AFFC + (size_t)be * LCX : AFFT + (size_t)be * TL;
        unsigned v[8]; const int per = isctx ? 1 : 8, t0 = tid * per;
#pragma unroll
        for (int q = 0; q < 8; ++q) v[q] = 0u;
        if (!isctx) { const u32x4 a0 = *(const u32x4*)(src + t0), a1 = *(const u32x4*)(src + t0 + 4); v[0] = a0.x; v[1] = a0.y; v[2] = a0.z; v[3] = a0.w; v[4] = a1.x; v[5] = a1.y; v[6] = a1.z; v[7] = a1.w; }
        else if (tid < LCX) v[0] = __builtin_bit_cast(unsigned, src[tid]);
        __syncthreads();
        unsigned T = 0u;
        for (int bit = 30; bit >= 0; --bit) {
            const unsigned cand = T | (1u << bit); unsigned c = 0u;
#pragma unroll
            for (int q = 0; q < 8; ++q) c += (unsigned)__builtin_popcountll(__builtin_amdgcn_ballot_w64(v[q] >= cand));
            LAS unsigned* wc = wcnt + (bit & 1) * 8;
            if (C.lane == 0) wc[C.wave] = c;
            __syncthreads();
            const unsigned tot = wc[0] + wc[1] + wc[2] + wc[3] + wc[4] + wc[5] + wc[6] + wc[7];
            if (tot >= (unsigned)cap) T = cand;
        }
        unsigned myc = 0u;
#pragma unroll
        for (int q = 0; q < 8; ++q) myc += (v[q] > T ? 0x10000u : 0u) + ((v[q] == T && (isctx ? (q == 0 && tid < LCX) : true)) ? 1u : 0u);
        __syncthreads();
        cnt[tid] = myc;
        __syncthreads();
        for (int off = 1; off < 512; off <<= 1) { const unsigned add = tid >= off ? cnt[tid - off] : 0u; __syncthreads(); cnt[tid] += add; __syncthreads(); }
        const unsigned total = cnt[511], keq = (unsigned)cap - (total >> 16);
        unsigned before = cnt[tid] - myc;
        for (int q = 0; q < per; ++q) { const int t = t0 + q; if (t >= n) break; const unsigned x = v[q]; const unsigned gtb = before >> 16, eqb = before & 0xFFFFu;
            const bool sel = x > T || (x == T && eqb < keq);
            if (sel) { const int jx = (int)(gtb + (eqb < keq ? eqb : keq));
                const int slot = isctx ? NB * CAPL + b * CAPC + jx : b * CAPL + jx, row = isctx ? NLAT + b * LCX + t : b * TL + t;
                ROWS[e * ESLOTS + slot] = row; GATE[e * ESLOTS + slot] = __builtin_bit_cast(float, x); SLOT[(size_t)row * 16 + e] = slot; }
            before += (x > T ? 0x10000u : 0u) + (x == T ? 1u : 0u); }
        __syncthreads();
    }
}


DI void ph_combine(const Ctx& C, float* xlat, float* xctx, const float* modg2  , const int* SLOT, const bf16* Y2, bool last,
                   const float* ngain  , const float* nmod  , bf16* H) {
    const int gw = C.bid * 8 + C.wave, ngw = C.nb * 8, lane = C.lane, nrows = last ? NLAT : MT;
    for (int row = gw; row < nrows; row += ngw) {
        float* xr = row < NLAT ? xlat + (size_t)row * DM : xctx + (size_t)(row - NLAT) * DM;
        const int mi = row < NLAT ? (row >> 12) : 8;
        const int sv = SLOT[(size_t)row * 16 + (lane & 15)];
        f32x4 acc[4];
#pragma unroll
        for (int j = 0; j < 4; ++j) acc[j] = (f32x4){0.f, 0.f, 0.f, 0.f};
#pragma unroll
        for (int e = 0; e < 16; ++e) {
            const int s = __builtin_amdgcn_readlane(sv, e);
            if (s >= 0) { const bf16* yp = Y2 + ((size_t)e * ESLOTS + s) * DM + 4 * lane;
#pragma unroll
                for (int j = 0; j < 4; ++j) { const u32x2 w = *(const u32x2*)(yp + 256 * j); acc[j] += (f32x4){bflo(w.x), bfhi(w.x), bflo(w.y), bfhi(w.y)}; } }
        }
#pragma unroll
        for (int j = 0; j < 4; ++j) { const int c = 256 * j + 4 * lane; const f32x4 g = *(const f32x4*)(modg2 + mi * 6144 + c); f32x4 x = *(const f32x4*)(xr + c); x += g * acc[j]; *(f32x4*)(xr + c) = x; acc[j] = x; }
        if (ngain) {
            float ss = 0.f;
#pragma unroll
            for (int j = 0; j < 4; ++j) ss += acc[j].x * acc[j].x + acc[j].y * acc[j].y + acc[j].z * acc[j].z + acc[j].w * acc[j].w;
            const float rs = 1.0f / sqrtf(wave_sum(ss) * (1.f / 1024.f) + EPS);
            const float* mp = nmod + mi * 6144;
#pragma unroll
            for (int j = 0; j < 4; ++j) { const int c = 256 * j + 4 * lane;
                const f32x4 g = *(const f32x4*)(ngain + c), sc = *(const f32x4*)(mp + 1024 + c), sh = *(const f32x4*)(mp + c);
                const f32x4 hv = (acc[j] * rs) * g * (sc + 1.0f) + sh;
                *(u32x2*)(H + (size_t)row * DM + c) = (u32x2){pk2(hv.x, hv.y), pk2(hv.z, hv.w)}; }
        }
    }
}

template <int N> struct IC { static constexpr int value = N; };
DI const float* in_ptr(const unsigned char* ws, int k) { const unsigned long long v = ((const unsigned long long*)(ws + 128 * 1024))[k];
    const unsigned lo = __builtin_amdgcn_readfirstlane((unsigned)v), hi = __builtin_amdgcn_readfirstlane((unsigned)(v >> 32));
    return (const float*)(__attribute__((address_space(1))) const float*)(((unsigned long long)hi << 32) | lo); }
template <class T> DI T* launder_ptr(T* p) { unsigned long long v = (unsigned long long)p; unsigned lo = (unsigned)v, hi = (unsigned)(v >> 32); asm volatile("" : "+v"(lo), "+v"(hi));
    lo = __builtin_amdgcn_readfirstlane(lo); hi = __builtin_amdgcn_readfirstlane(hi); return (T*)(__attribute__((address_space(1))) T*)(((unsigned long long)hi << 32) | lo); }
constexpr int N_PHASES = 1 + 23 + 22;
constexpr size_t WS_PTRS = 128 * 1024;
#define P_XC    ((float*)(ws + WS_XC))
#define P_MOD   ((const float*)(ws + WS_MOD))
#define P_HB    ((bf16*)(ws + WS_HB))
#define P_OCAT  ((bf16*)(ws + WS_OCAT))
#define P_AR    (ws + WS_ARENA)
#define P_ROWS  ((int*)(ws + WS_ROWS))
#define P_GATE  ((float*)(ws + WS_GATE))
#define P_SLOT  ((int*)(ws + WS_SLOT))
#define P_AFFT  ((float*)(ws + WS_AFFT))
#define P_AFFC  ((float*)(ws + WS_AFFC))
#define P_W13   ((bf16*)(ws + WS_W13))
#define P_W2    ((bf16*)(ws + WS_W2))
#define P_U     ((bf16*)(P_AR + A_U))
#define P_QPRE  ((float*)(P_AR + A_QPRE))
#define P_KVPRE ((float*)(P_AR + A_KVPRE))
#define P_QB    ((bf16*)(P_AR + A_QB))
#define P_KB    ((bf16*)(P_AR + A_KB))
#define P_VT    ((bf16*)(P_AR + A_VT))
#define P_W     ((float*)(P_AR + A_W))
#define P_KEFF  ((bf16*)(P_AR + A_KEFF))
#define P_R     ((bf16*)(P_AR + A_R))
#define P_V     ((bf16*)(P_AR + A_V))
#define P_KK    ((bf16*)(P_AR + A_KK))
#define P_G     ((bf16*)(P_AR + A_G))
#define P_K     ((bf16*)(P_AR + A_K))
#define P_L     ((bf16*)(P_AR + A_L))
#define P_QN    ((bf16*)(P_AR + A_QN))
#define P_KN    ((bf16*)(P_AR + A_KN))
#define P_VTN   ((bf16*)(P_AR + A_VTN))
#define P_YS    ((bf16*)(P_AR + A_YS))
#define P_IMG   ((bf16*)(P_AR + A_IMG))
#define P_HID   ((bf16*)(P_AR + A_HID))
#define P_Y2    ((bf16*)(P_AR + A_Y2))
#define MODL(i) (P_MOD + (size_t)(i) * 9 * 6144)
#if MOE_F8
#define MOE1_PHASE(NMT) do { pg8::Gemm g{P_HB, P_W13, DM / 2, DM / 2, P_ROWS, SCALE_W, SCALE_ONE}; pg8::OrderMoE S{(NMT), 8, 17, C.nb, C.vcu}; pg8::EpiAdapt<EpiGlu8> E{EpiGlu8{(unsigned char*)P_HID}}; \
        pg8::gemm_phase<pg8::EpiAdapt<EpiGlu8>, pg8::OrderMoE, true>(C.lds, g, S, E, C.tid); } while (0)
#define MOE2_PHASE(NMT) do { pg8::Gemm g{P_HID, P_W2, DM / 2, DM / 2, nullptr, SCALE_W, SCALE_HID}; pg8::OrderMoE S{(NMT), 4, 17, C.nb, C.vcu}; pg8::EpiAdapt<EpiGate> E{EpiGate{P_Y2, P_GATE}}; \
        pg8::gemm_phase<pg8::EpiAdapt<EpiGate>, pg8::OrderMoE, true>(C.lds, g, S, E, C.tid); } while (0)
#else
#define MOE1_PHASE(NMT) do { pg8::Gemm g{P_HB, P_W13, DM, DM, P_ROWS}; pg8::OrderMoE S{(NMT), 8, 17, C.nb, C.vcu}; pg8::EpiAdapt<EpiGlu> E{EpiGlu{P_HID}}; pg8::gemm_phase(C.lds, g, S, E, C.tid); } while (0)
#define MOE2_PHASE(NMT) do { pg8::Gemm g{P_HID, P_W2, DM, DM, nullptr}; pg8::OrderMoE S{(NMT), 4, 17, C.nb, C.vcu}; pg8::EpiAdapt<EpiGate> E{EpiGate{P_Y2, P_GATE}}; pg8::gemm_phase(C.lds, g, S, E, C.tid); } while (0)
#endif
#define RELAUNDER() do { int l_ = C.lane; asm volatile("" : "+v"(l_)); C.lane = l_; C.tid = (C.wave << 6) | l_; } while (0)
__global__ void __launch_bounds__(512, 2) fwd_kernel(Args a) {
    extern __shared__ __attribute__((aligned(16))) unsigned char smem[];
    Ctx C0; C0.lds = (LAS unsigned char*)smem; C0.tid = threadIdx.x; C0.lane = C0.tid & 63; C0.wave = __builtin_amdgcn_readfirstlane(C0.tid >> 6); C0.bid = blockIdx.x; C0.nb = gridDim.x;
    C0.vcu = (C0.nb % 8 == 0) ? (C0.bid % 8) * (C0.nb / 8) + C0.bid / 8 : C0.bid;
    volatile LAS unsigned* bst = (volatile LAS unsigned*)(C0.lds + LDS_BYTES - 16);
#if MEGA
    if (C0.tid == 0) { bst[0] = 0u; bst[1] = 0u; }
    __syncthreads();
    const unsigned bar_x = xcd_barrier_post((unsigned*)(a.ws + WS_CTL) + 4096, bst, C0.tid == 0).x;
#define SEAM() do { if (ph < hi) { XcdBarrier b2_; b2_.bar = (unsigned*)(ws + WS_CTL) + 4096; b2_.x = bar_x; b2_.st = bst; xcd_barrier(b2_, C.tid == 0); } } while (0)
#else
#define SEAM() do { } while (0)
#endif
#if MEGA
    constexpr int lo = 0, hi = N_PHASES;
#else
    const int lo = a.ph_lo, hi = a.ph_hi;
#endif
    int ph = 0;
#ifndef ONLY
#define ONLY -1
#endif
#ifndef REPMASK
#define REPMASK 0
#endif
#ifndef SITE_LO
#define SITE_LO 0
#define SITE_HI 99
#endif
#define PHASE(SITE, ...) do { if ((ONLY < 0 || ONLY == (SITE)) && (SITE) >= SITE_LO && (SITE) <= SITE_HI && ph >= lo && ph < hi) { Ctx C; C.lds = C0.lds; \
        { int w_ = C0.wave; asm volatile("" : "+s"(w_)); unsigned m_ = ~0u; asm volatile("" : "+s"(m_)); int l_ = (int)__builtin_amdgcn_mbcnt_hi(m_, __builtin_amdgcn_mbcnt_lo(m_, 0u)); C.wave = w_; C.lane = l_; C.tid = (w_ << 6) | l_; } \
        { int b_ = C0.bid, n_ = C0.nb, v_ = C0.vcu; asm volatile("" : "+s"(b_), "+s"(n_), "+s"(v_)); C.bid = b_; C.nb = n_; C.vcu = v_; } \
        unsigned z_ = 0u; asm volatile("" : "+s"(z_)); unsigned char* ws = a.ws + z_; float* XL = a.out + z_; const int lq = __builtin_amdgcn_readfirstlane(lp); typedef const __attribute__((address_space(1))) float* gfp_t; const gfp_t* INT_ = (const gfp_t*)(ws + WS_PTRS); (void)INT_; (void)XL; (void)lq; \
        for (int rep_ = 0; rep_ < ((((REPMASK) >> (SITE)) & 1) ? 2 : 1); ++rep_) { __VA_ARGS__; if ((((REPMASK) >> (SITE)) & 1)) __syncthreads(); } ++ph; SEAM(); } else ++ph; } while (0)

    { const int lp = 0;
      PHASE(0, { if (C.bid == 0) { _Pragma("unroll") for (int k = 0; k < 40; ++k) if (C.tid == k) ((const float**)(ws + WS_PTRS))[k] = a.in[k]; }
                 ph_prologue(C, a); }); }

    auto layer_pair = [&](auto lpc) __attribute__((always_inline)) {
        constexpr int lp = decltype(lpc)::value;
        if constexpr (lp == 0) PHASE(1, { const int i = 2 * lq; const float* xl = (i == 0) ? in_ptr(ws, I_X) : XL; const float* xc = (i == 0) ? in_ptr(ws, I_CTX) : P_XC;
                   ph_norm<false>(C, xl, xc, in_ptr(ws, I_N1G) + i * DM, MODL(i), 0, 1024, P_HB, nullptr, nullptr, nullptr, nullptr); });
        PHASE(2, { EpiBf16 E{P_U, EV_INP}; fast_gemm(C, P_HB, DM, (const bf16*)(ws + WS_WEVIN) + (size_t)lq * EV_INP * DM, DM, MT / 256, EV_INP / 256, E); });
        PHASE(3, { EpiBf16 Eq{(bf16*)P_QPRE, 768}; fast_gemm(C, P_U, EV_INP, (const bf16*)(ws + WS_WUQ) + (size_t)lq * 768 * 384, 384, MT / 256, 3, Eq); RELAUNDER();
                   EpiBf16 Ek{(bf16*)P_KVPRE, 1024}; fast_gemm(C, P_U + 384, EV_INP, (const bf16*)(ws + WS_WUKV) + (size_t)lq * 1024 * 256, 256, MT / 256, 4, Ek, true); });
        PHASE(4, ph_mla_fin(C, P_U, (const bf16*)P_QPRE, (const bf16*)P_KVPRE, in_ptr(ws, I_QG) + lq * 96, in_ptr(ws, I_KG) + lq * 96, (const f32x2*)(ws + WS_ROPE), P_QB, P_KB, P_VT));
        PHASE(5, ph_attn_mla2(C, P_QB, P_KB, P_VT, P_OCAT, false, ws, lq));
        PHASE(6, { const int i = 2 * lq; const float* xl = (i == 0) ? in_ptr(ws, I_X) : XL; const float* xc = (i == 0) ? in_ptr(ws, I_CTX) : P_XC;
                   EpiResid E{xl, xc, XL, P_XC, MODL(i) + 2048}; fast_gemm(C, P_OCAT, DM, (const bf16*)(ws + WS_WEVOUT) + (size_t)lq * DM * DM, DM, MT / 256, 4, E); });
        PHASE(7, { const int i = 2 * lq; ph_norm<true>(C, XL, P_XC, in_ptr(ws, I_N2G) + i * DM, MODL(i), 3072, 4096, P_HB, in_ptr(ws, I_ROUTER) + (size_t)i * DM * 16, P_AFFT, P_AFFC, P_SLOT); });
        PHASE(8, ph_topk2(C, P_AFFT, P_AFFC, P_ROWS, P_GATE, P_SLOT, false));
        PHASE(9, { MOE1_PHASE(17); });
        PHASE(10, { MOE2_PHASE(17); });
        PHASE(11, { const int i = 2 * lq; ph_combine(C, XL, P_XC, MODL(i) + 5120, P_SLOT, P_Y2, false, in_ptr(ws, I_N1G) + (i + 1) * DM, MODL(i + 1), P_HB); });
        PHASE(13, { EpiBf16 E{P_U, OD_INP}; fast_gemm(C, P_HB, DM, (const bf16*)(ws + WS_WODIN) + (size_t)lq * OD_INP * DM, DM, MT / 256, OD_INP / 256, E); });
        PHASE(14, ph_prep(C, P_U, in_ptr(ws, I_SHIFTW) + (size_t)lq * 3 * RW_IN, in_ptr(ws, I_KKW) + lq * 512, in_ptr(ws, I_NAQG) + lq * 64, in_ptr(ws, I_NAKG) + lq * 64, P_R, P_V, P_K, P_KK, P_L, P_QN, P_KN, P_VTN));
        PHASE(15, { const bf16* WL = (const bf16*)(ws + WS_WLORA) + (size_t)lq * 655360;
                    { EpiLoraW E{P_W, in_ptr(ws, I_W0) + lq * 1024}; fast_gemm(C, P_L, 384, WL, 256, MT / 256, 4, E); } RELAUNDER();
                    { EpiLoraA E{P_KEFF, in_ptr(ws, I_A0) + lq * 1024}; fast_gemm(C, P_L, 384, WL + (size_t)1024 * 256, 256, MT / 256, 4, E, true); } RELAUNDER();
                    { EpiBf16 E{P_G, 512}; fast_gemm(C, P_L + 128, 384, WL + (size_t)2048 * 256, 256, MT / 256, 2, E); } });
        PHASE(16, ph_wkv_pre(C, P_R, P_K, P_KK, P_W, P_KEFF, in_ptr(ws, I_KA) + lq * 512, P_IMG));
        PHASE(17, { ph_wkv_chunk(C, P_R, P_V, P_K, P_KK, P_W, P_KEFF, in_ptr(ws, I_KA) + lq * 512, P_IMG, P_YS); __syncthreads();
                    ph_natten2(C, P_QN, P_KN, P_VTN, P_OCAT, in_ptr(ws, I_RPB) + (size_t)lq * 8 * 465, lq == 1, (unsigned*)(ws + WS_CTL) + 8192 + 64 * lq, ws, lq); });
        PHASE(18, ph_post(C, P_YS, P_R, P_V, P_K, P_KEFF, in_ptr(ws, I_KA) + lq * 512, P_G, in_ptr(ws, I_RK) + lq * 512, in_ptr(ws, I_GNG) + lq * 512, in_ptr(ws, I_GNB) + lq * 512, P_OCAT, lq == 1));
        PHASE(19, { const int i = 2 * lq + 1; EpiResid E{XL, P_XC, XL, P_XC, MODL(i) + 2048};
                    fast_gemm(C, P_OCAT, DM, (const bf16*)(ws + WS_WODOUT) + (size_t)lq * DM * DM, DM, (lq == 1) ? NLAT / 256 : MT / 256, 4, E); });
        PHASE(20, { const int i = 2 * lq + 1; ph_norm<true>(C, XL, P_XC, in_ptr(ws, I_N2G) + i * DM, MODL(i), 3072, 4096, P_HB, in_ptr(ws, I_ROUTER) + (size_t)i * DM * 16, P_AFFT, P_AFFC, P_SLOT); });
        PHASE(21, ph_topk2(C, P_AFFT, P_AFFC, P_ROWS, P_GATE, P_SLOT, lq == 1));
        PHASE(22, { MOE1_PHASE((lq == 1) ? 16 : 17); });
        PHASE(23, { MOE2_PHASE((lq == 1) ? 16 : 17); });
        PHASE(24, { const int i = 2 * lq + 1;
                    if (lp == 0) ph_combine(C, XL, P_XC, MODL(i) + 5120, P_SLOT, P_Y2, false, in_ptr(ws, I_N1G) + (i + 1) * DM, MODL(i + 1), P_HB);
                    else ph_combine(C, XL, P_XC, MODL(i) + 5120, P_SLOT, P_Y2, true, nullptr, nullptr, nullptr); });
    };
    layer_pair(IC<0>{}); layer_pair(IC<1>{});
}

extern "C" void kernel_launch(void* const* d_in, const int* in_sizes, int n_in, void* d_out, int out_size, void* d_ws, size_t ws_size, hipStream_t stream) {
    static int grid = 0;
    if (grid == 0) {
        if (n_in != 40 || out_size != NLAT * DM || ws_size < WS_END) { fprintf(stderr, "kernel_launch: unexpected shapes (n_in %d out %d ws %zu need %zu)\n", n_in, out_size, ws_size, (size_t)WS_END); grid = -1; return; }
        int dev = 0, cus = 0, per_cu = 0;
        if (hipGetDevice(&dev) != hipSuccess || hipDeviceGetAttribute(&cus, hipDeviceAttributeMultiprocessorCount, dev) != hipSuccess) { grid = -1; return; }
        if (hipFuncSetAttribute((const void*)fwd_kernel, hipFuncAttributeMaxDynamicSharedMemorySize, LDS_BYTES) != hipSuccess) { fprintf(stderr, "kernel_launch: hipFuncSetAttribute failed\n"); grid = -1; return; }
        if (hipOccupancyMaxActiveBlocksPerMultiprocessor(&per_cu, (const void*)fwd_kernel, 512, LDS_BYTES) != hipSuccess || per_cu < 1) { fprintf(stderr, "kernel_launch: occupancy query says %d\n", per_cu); per_cu = 1; }
        (void)hipGetLastError();
        grid = cus;
    }
    if (grid < 0) return;
    (void)hipMemsetAsync((char*)d_ws + WS_CTL, 0, CTL_BYTES, stream);
    Args a{};
    for (int i = 0; i < 40; ++i) a.in[i] = (const float*)d_in[i];
    a.out = (float*)d_out; a.ws = (unsigned char*)d_ws;
#if MEGA
    a.ph_lo = 0; a.ph_hi = N_PHASES;
    hipLaunchKernelGGL(fwd_kernel, dim3(grid), dim3(512), LDS_BYTES, stream, a);
#else
    for (int p = 0; p < N_PHASES; ++p) { a.ph_lo = p; a.ph_hi = p + 1; hipLaunchKernelGGL(fwd_kernel, dim3(grid), dim3(512), LDS_BYTES, stream, a); }
#endif
}
```

```cpp
#include <hip/hip_runtime.h>
#include <cstdio>
#include <cstdint>

#ifndef MEGA
#define MEGA 1
#endif

#define LAS __attribute__((address_space(3)))
#define DI __device__ __forceinline__

typedef unsigned short bf16;
typedef short bf16x8 __attribute__((ext_vector_type(8)));
typedef float f32x4 __attribute__((ext_vector_type(4)));
typedef float f32x2 __attribute__((ext_vector_type(2)));
typedef float f32x16 __attribute__((ext_vector_type(16)));
typedef unsigned u32x4 __attribute__((ext_vector_type(4)));
typedef unsigned u32x2 __attribute__((ext_vector_type(2)));
typedef __bf16 bf16x2_t __attribute__((ext_vector_type(2)));

constexpr int DM = 1024, NB = 8, TL = 4096, LCX = 256;
constexpr int NLAT = NB * TL, NCTX = NB * LCX, MT = NLAT + NCTX;
constexpr int KPOS = TL + LCX;
constexpr float EPS = 1e-6f, GN_EPS = 64e-5f;
constexpr int EV_IN = 1696, EV_INP = 1792, OD_IN = 3456, OD_INP = 3584, RW_IN = 1920;
constexpr int NEXP = 16, CAPL = 512, CAPC = 32, ESLOTS = NB * CAPL + NB * CAPC;
constexpr float LOG2E = 1.4426950408889634f;

constexpr size_t MiB = 1ull << 20;
constexpr size_t WS_CTL = 0, CTL_BYTES = 1 * MiB;
constexpr size_t WS_MOD = 1 * MiB, WS_ROPE = 2 * MiB, WS_XC = 4 * MiB;
constexpr size_t WS_ROWS = 12 * MiB, WS_GATE = 12 * MiB + 512 * 1024, WS_SLOT = 13 * MiB, WS_AFFT = 16 * MiB, WS_AFFC = 18 * MiB;
constexpr size_t WS_WEVIN = 20 * MiB, WS_WEVOUT = 27 * MiB, WS_WUQ = 31 * MiB, WS_WUKV = 33 * MiB, WS_WODIN = 34 * MiB, WS_WODOUT = 48 * MiB, WS_WLORA = 52 * MiB;
constexpr size_t WS_W13 = 56 * MiB, WS_W2 = 120 * MiB, WS_HB = 152 * MiB, WS_OCAT = 220 * MiB, WS_ARENA = 288 * MiB;
constexpr size_t A_U = 0, A_QPRE = 119 * MiB, A_KVPRE = 221 * MiB, A_QB = 357 * MiB, A_KB = 408 * MiB, A_VT = 459 * MiB;
constexpr size_t A_W = 0, A_KEFF = 136 * MiB  , A_G = 204 * MiB, A_R = 238 * MiB, A_V = 272 * MiB, A_KK = 306 * MiB, A_K = 340 * MiB, A_L = 374 * MiB,
                 A_QN = 400 * MiB, A_KN = 434 * MiB, A_VTN = 468 * MiB, A_YS = 612 * MiB  ;
constexpr size_t A_HID = 0, A_Y2 = 136 * MiB;
constexpr size_t A_IMG = 510 * MiB;
constexpr size_t WS_END = WS_ARENA + 680 * MiB;
constexpr int LDS_BYTES = 147456;

DI unsigned pk2(float lo, float hi) { f32x2 v = {lo, hi}; bf16x2_t b = __builtin_convertvector(v, bf16x2_t); return __builtin_bit_cast(unsigned, b); }
DI float bflo(unsigned u) { return __builtin_bit_cast(float, u << 16); }
DI float bfhi(unsigned u) { return __builtin_bit_cast(float, u & 0xffff0000u); }
DI float bf2f(bf16 x) { return __builtin_bit_cast(float, ((unsigned)x) << 16); }
DI bf16 f2bf(float f) { return (bf16)(pk2(f, 0.f) & 0xffffu); }
DI void unpack8(u32x4 v, float (&f)[8]) { f[0] = bflo(v.x); f[1] = bfhi(v.x); f[2] = bflo(v.y); f[3] = bfhi(v.y); f[4] = bflo(v.z); f[5] = bfhi(v.z); f[6] = bflo(v.w); f[7] = bfhi(v.w); }
DI u32x4 pack8(const float (&f)[8]) { u32x4 r; r.x = pk2(f[0], f[1]); r.y = pk2(f[2], f[3]); r.z = pk2(f[4], f[5]); r.w = pk2(f[6], f[7]); return r; }
#define DPP_ADD(x, ctrl) ((x) + __builtin_bit_cast(float, __builtin_amdgcn_update_dpp(0, __builtin_bit_cast(int, (x)), (ctrl), 0xf, 0xf, false)))
#define DPP_MAX(x, ctrl) fmaxf((x), __builtin_bit_cast(float, __builtin_amdgcn_update_dpp(0, __builtin_bit_cast(int, (x)), (ctrl), 0xf, 0xf, false)))
DI float sum8(float x) { x = DPP_ADD(x, 0xB1); x = DPP_ADD(x, 0x4E); x = DPP_ADD(x, 0x141); return x; }
DI float sum16(float x) { x = DPP_ADD(x, 0xB1); x = DPP_ADD(x, 0x4E); x = DPP_ADD(x, 0x141); x = DPP_ADD(x, 0x140); return x; }
DI float max16(float x) { x = DPP_MAX(x, 0xB1); x = DPP_MAX(x, 0x4E); x = DPP_MAX(x, 0x141); x = DPP_MAX(x, 0x140); return x; }
DI float rdlane(float x, int l) { return __builtin_bit_cast(float, __builtin_amdgcn_readlane(__builtin_bit_cast(int, x), l)); }
DI float wave_sum(float v) { const float x = sum16(v); return (rdlane(x, 0) + rdlane(x, 16)) + (rdlane(x, 32) + rdlane(x, 48)); }
DI float xor32(float v, int lane) { return __builtin_bit_cast(float, __builtin_amdgcn_ds_bpermute((lane ^ 32) << 2, __builtin_bit_cast(int, v))); }
typedef int v8i_t __attribute__((ext_vector_type(8)));
typedef int i32x4_t __attribute__((ext_vector_type(4)));
DI unsigned pk4_fp8(float a, float b, float c, float d) {
    a = __builtin_amdgcn_fmed3f(a, -448.f, 448.f); b = __builtin_amdgcn_fmed3f(b, -448.f, 448.f); c = __builtin_amdgcn_fmed3f(c, -448.f, 448.f); d = __builtin_amdgcn_fmed3f(d, -448.f, 448.f);
    int p = __builtin_amdgcn_cvt_pk_fp8_f32(a, b, 0, false); p = __builtin_amdgcn_cvt_pk_fp8_f32(c, d, p, true); return (unsigned)p; }
#ifndef MOE_F8
#define MOE_F8 1
#endif
constexpr int SCALE_ONE = 0x7f7f7f7f, SCALE_W = 0x79797979  , SCALE_HID = 0x7c7c7c7c  ;
DI float sigmoidf_(float x) { return __builtin_amdgcn_rcpf(1.f + __expf(-x)); }
DI float siluf_(float x) { return x * __builtin_amdgcn_rcpf(1.f + __expf(-x)); }
#define MFMA32(a, b, c) __builtin_amdgcn_mfma_f32_32x32x16_bf16((a), (b), (c), 0, 0, 0)

#define XB_TMO      128
#define XB_XCNT(j)  (256  + 64 * (j))
#define XB_XSUB(j)  (1280 + 64 * (j))
#define XB_XGEN(j)  (2304 + 64 * (j))
#define XB_TOP      3328
#define XB_TOPGEN   3392
#define XCD_BAR_WORDS 3456
#define XB_SPIN_CAP (1u << 22)
__device__ __forceinline__ unsigned xb_ld(unsigned* p)              { return __hip_atomic_load(p, __ATOMIC_RELAXED, __HIP_MEMORY_SCOPE_AGENT); }
__device__ __forceinline__ unsigned xb_add(unsigned* p, unsigned v) { return __hip_atomic_fetch_add(p, v, __ATOMIC_RELAXED, __HIP_MEMORY_SCOPE_AGENT); }
__device__ __forceinline__ unsigned xb_xcc_id() { return (unsigned)__builtin_amdgcn_s_getreg((3 << 11) | 20) & 0xFu; }
#define XB_SPIN(cond, bar) do { unsigned _sp = 0; while (cond) { __builtin_amdgcn_s_sleep(1); \
    if ((++_sp & 255u) == 0u) { if (xb_ld(&(bar)[XB_TMO])) break; if (_sp > XB_SPIN_CAP) { atomicAdd(&(bar)[XB_TMO], 1u); break; } } } } while (0)
struct XcdBarrier { unsigned* bar; unsigned x; volatile LAS unsigned* st; };
__device__ __forceinline__ XcdBarrier xcd_barrier_post(unsigned* bar, volatile LAS unsigned* st, bool leader) {
    XcdBarrier b; b.bar = bar; b.x = xb_xcc_id(); b.st = st;
    if (leader) (void)xb_add(&bar[XB_XCNT(b.x)], 1u);
    return b;
}
__device__ __forceinline__ void xcd_barrier_complete(unsigned* bar, unsigned x, unsigned& nloc, unsigned& nx) {
    const unsigned G = gridDim.x * gridDim.y * gridDim.z;
    unsigned sum, cnt, mine, sp = 0u;
    for (;;) {
        sum = 0u; cnt = 0u; mine = 0u;
#pragma unroll
        for (unsigned j = 0; j < 16; ++j) { const unsigned c = xb_ld(&bar[XB_XCNT(j)]); sum += c; cnt += (c > 0u) ? 1u : 0u; mine = (j == x) ? c : mine; }
        if (sum == G) break;
        __builtin_amdgcn_s_sleep(1);
        if ((++sp & 255u) == 0u) { if (xb_ld(&bar[XB_TMO])) break; if (sp > XB_SPIN_CAP) { atomicAdd(&bar[XB_TMO], 1u); break; } }
    }
    nloc = mine > 0u ? mine : 1u; nx = cnt > 0u ? cnt : 1u;
}
__device__ __forceinline__ void xcd_barrier(const XcdBarrier& b, bool leader) {
    asm volatile("s_waitcnt vmcnt(0)" ::: "memory");
    __syncthreads();
    if (leader) {
        unsigned* bar = b.bar;
        __builtin_amdgcn_s_waitcnt(0);
        unsigned nloc = b.st[0], nx = b.st[1];
        if (nloc == 0u) { xcd_barrier_complete(bar, b.x, nloc, nx); b.st[0] = nloc; b.st[1] = nx; }
        const unsigned old = xb_add(&bar[XB_XSUB(b.x)], 1u);
        const unsigned gen = old / nloc;
        if (old + 1u == (gen + 1u) * nloc) {
            __builtin_amdgcn_fence(__ATOMIC_RELEASE, "agent");
            asm volatile("s_waitcnt vmcnt(0)" ::: "memory");
            const unsigned og = xb_add(&bar[XB_TOP], 1u);
            const unsigned tg = og / nx;
            if (og + 1u == (tg + 1u) * nx) xb_add(&bar[XB_TOPGEN], 1u);
            else XB_SPIN(xb_ld(&bar[XB_TOPGEN]) == tg, bar);
            __builtin_amdgcn_fence(__ATOMIC_ACQUIRE, "agent");
            xb_add(&bar[XB_XGEN(b.x)], 1u);
            asm volatile("s_waitcnt vmcnt(0)" ::: "memory");
        } else {
            XB_SPIN(xb_ld(&bar[XB_XGEN(b.x)]) == gen, bar);
            __builtin_amdgcn_fence(__ATOMIC_ACQUIRE, "agent");
            asm volatile("s_waitcnt vmcnt(0)" ::: "memory");
        }
    }
    __syncthreads();
}

struct Ctx { LAS unsigned char* lds; int tid, lane, wave, bid, nb, vcu; };
struct Args { const float* in[40]; float* out; unsigned char* ws; int ph_lo, ph_hi; };
enum { I_X = 0, I_C, I_CTX, I_CCTX, I_ADAW, I_ADAB, I_N1G, I_N2G, I_EVWIN, I_EVWOUT, I_QNORM, I_WUQ, I_KVNORM, I_WUKV, I_QG, I_KG, I_DWW, I_DWB, I_LNG, I_LNB,
       I_ODWIN, I_ODWOUT, I_SHIFTW, I_W0, I_W2L, I_A0, I_A2, I_G2, I_KKW, I_KA, I_RK, I_GNG, I_GNB, I_NAQG, I_NAKG, I_RPB, I_ROUTER, I_MW1, I_MW3, I_MW2 };

DI void transpose_item(const float* __restrict__ W, int K, int N, bf16* __restrict__ WT, int dst_row0, const float* __restrict__ gain, LAS float* scr, int k0, int n0, int lane) {
#pragma unroll 8
    for (int i = 0; i < 32; ++i) { const int kk = 2 * i + (lane >> 5); float v = W[(size_t)(k0 + kk) * N + n0 + (lane & 31)]; if (gain) v *= gain[k0 + kk]; scr[kk * 33 + (lane & 31)] = v; }
    asm volatile("s_waitcnt lgkmcnt(0)" ::: "memory");
    const int c = lane & 7;
#pragma unroll
    for (int j = 0; j < 4; ++j) { const int n = (lane >> 3) + 8 * j; const LAS float* s = scr + (8 * c) * 33 + n;
        u32x4 o; o.x = pk2(s[0 * 33], s[1 * 33]); o.y = pk2(s[2 * 33], s[3 * 33]); o.z = pk2(s[4 * 33], s[5 * 33]); o.w = pk2(s[6 * 33], s[7 * 33]);
        *(u32x4*)(WT + (size_t)(dst_row0 + n) * K + k0 + 8 * c) = o; }
    asm volatile("s_waitcnt lgkmcnt(0)" ::: "memory");
}
DI void transpose_item64(const float* __restrict__ W, int K, int N, bf16* __restrict__ WT, int dst_row0, LAS float* scr, int k0, int n0, int lane) {
    f32x4 v[16];
#pragma unroll
    for (int i = 0; i < 16; ++i) v[i] = *(const f32x4*)(W + (size_t)(k0 + 4 * i + (lane >> 4)) * N + n0 + 4 * (lane & 15));
#pragma unroll
    for (int i = 0; i < 16; ++i) { LAS float* d = scr + (4 * i + (lane >> 4)) * 65 + 4 * (lane & 15); d[0] = v[i].x; d[1] = v[i].y; d[2] = v[i].z; d[3] = v[i].w; }
    asm volatile("s_waitcnt lgkmcnt(0)" ::: "memory");
    const int c = lane & 7;
#pragma unroll
    for (int j = 0; j < 8; ++j) { const int n = (lane >> 3) + 8 * j; const LAS float* s = scr + (8 * c) * 65 + n;
        u32x4 o; o.x = pk2(s[0 * 65], s[1 * 65]); o.y = pk2(s[2 * 65], s[3 * 65]); o.z = pk2(s[4 * 65], s[5 * 65]); o.w = pk2(s[6 * 65], s[7 * 65]);
        *(u32x4*)(WT + (size_t)(dst_row0 + n) * K + k0 + 8 * c) = o; }
    asm volatile("s_waitcnt lgkmcnt(0)" ::: "memory");
}
DI void transpose_item64_f8(const float* __restrict__ W, int K, int N, unsigned char* __restrict__ WT8, int dst_row0, LAS float* scr, int k0, int n0, int lane) {
    f32x4 v[16];
#pragma unroll
    for (int i = 0; i < 16; ++i) v[i] = *(const f32x4*)(W + (size_t)(k0 + 4 * i + (lane >> 4)) * N + n0 + 4 * (lane & 15));
#pragma unroll
    for (int i = 0; i < 16; ++i) { LAS float* d = scr + (4 * i + (lane >> 4)) * 65 + 4 * (lane & 15); d[0] = v[i].x; d[1] = v[i].y; d[2] = v[i].z; d[3] = v[i].w; }
    asm volatile("s_waitcnt lgkmcnt(0)" ::: "memory");
    const int c = lane & 7;
#pragma unroll
    for (int j = 0; j < 8; ++j) { const int n = (lane >> 3) + 8 * j; const LAS float* s = scr + (8 * c) * 65 + n;
        u32x2 o; o.x = pk4_fp8(64.f * s[0 * 65], 64.f * s[1 * 65], 64.f * s[2 * 65], 64.f * s[3 * 65]); o.y = pk4_fp8(64.f * s[4 * 65], 64.f * s[5 * 65], 64.f * s[6 * 65], 64.f * s[7 * 65]);
        *(u32x2*)(WT8 + (size_t)(dst_row0 + n) * K + k0 + 8 * c) = o; }
    asm volatile("s_waitcnt lgkmcnt(0)" ::: "memory");
}
DI void transpose_matrix(const Ctx& C, const float* W, int K, int N, bf16* WT, const float* gain, int mode  ) {
    LAS float* scr = (LAS float*)(C.lds + C.wave * 8704);
    const int nkb = K / 64, nnb = N / 32, nit = nkb * nnb, gw = C.vcu * 8 + C.wave, ngw = C.nb * 8;
    for (int it = gw; it < nit; it += ngw) {
        const int kb = it / nnb, nbk = it % nnb, n0 = nbk * 32;
        int d0 = n0; if (mode) d0 = (n0 >> 7) * 256 + (n0 & 127) + (mode == 2 ? 128 : 0);
        transpose_item(W, K, N, WT, d0, gain, scr, kb * 64, n0, C.lane);
    }
}

DI void ph_prologue(const Ctx& C, const Args& a) {
    unsigned char* ws = a.ws;
    {
        LAS float* sv = (LAS float*)C.lds;
        LAS float* red = sv + 9 * 1024;
        for (int i = C.tid; i < 9 * 1024; i += 512) { const int m = i >> 10, k = i & 1023; const float c = (m < 8) ? a.in[I_C][m * 1024 + k] : a.in[I_CCTX][k]; sv[i] = siluf_(c); }
        __syncthreads();
        float* MOD = (float*)(ws + WS_MOD);
        for (int it = C.bid; it < 4 * 96; it += C.nb) {
            const int layer = it / 96, col = (it % 96) * 64 + C.lane;
            const float* wp = a.in[I_ADAW] + (size_t)layer * 1024 * 6144 + col;
            float acc[9];
#pragma unroll
            for (int m = 0; m < 9; ++m) acc[m] = 0.f;
            const int kb = C.wave * 128;
#pragma unroll 16
            for (int k = 0; k < 128; ++k) { const float w = wp[(size_t)(kb + k) * 6144];
#pragma unroll
                for (int m = 0; m < 9; ++m) acc[m] += sv[m * 1024 + kb + k] * w; }
#pragma unroll
            for (int m = 0; m < 9; ++m) red[(C.wave * 9 + m) * 64 + C.lane] = acc[m];
            __syncthreads();
            for (int i = C.tid; i < 576; i += 512) { const int m = i >> 6, l = i & 63; float s = 0.f;
#pragma unroll
                for (int w = 0; w < 8; ++w) s += red[(w * 9 + m) * 64 + l];
                const int cc = (it % 96) * 64 + l;
                MOD[(size_t)(layer * 9 + m) * 6144 + cc] = s + a.in[I_ADAB][layer * 6144 + cc]; }
            __syncthreads();
        }
    }
    {
        f32x2* CS = (f32x2*)(ws + WS_ROPE);
        for (int i = C.bid * 512 + C.tid; i < 4096 * 16; i += C.nb * 512) {
            const int pos = i >> 4, j = i & 15, f = j & 7;
            const float inv = powf(10000.f, -(float)(2 * f) / 16.f);
            const float ang = (float)((j < 8) ? (pos >> 6) : (pos & 63)) * inv;
            const double tw = 6.283185307179586476925;
            const double x = (double)ang, n = __builtin_rint(x / tw), rr = x - n * tw;
            CS[i] = (f32x2){__cosf((float)rr), __sinf((float)rr)};
        }
    }
    for (int j = 0; j < 2; ++j) {
        transpose_matrix(C, a.in[I_EVWIN] + (size_t)j * DM * EV_IN, DM, EV_IN, (bf16*)(ws + WS_WEVIN) + (size_t)j * EV_INP * DM, nullptr, 0);
        transpose_matrix(C, a.in[I_EVWOUT] + (size_t)j * DM * DM, DM, DM, (bf16*)(ws + WS_WEVOUT) + (size_t)j * DM * DM, nullptr, 0);
        transpose_matrix(C, a.in[I_WUQ] + (size_t)j * 384 * 768, 384, 768, (bf16*)(ws + WS_WUQ) + (size_t)j * 768 * 384, a.in[I_QNORM] + j * 384, 0);
        transpose_matrix(C, a.in[I_WUKV] + (size_t)j * 256 * 1024, 256, 1024, (bf16*)(ws + WS_WUKV) + (size_t)j * 1024 * 256, a.in[I_KVNORM] + j * 256, 0);
        transpose_matrix(C, a.in[I_ODWIN] + (size_t)j * DM * OD_IN, DM, OD_IN, (bf16*)(ws + WS_WODIN) + (size_t)j * OD_INP * DM, nullptr, 0);
        transpose_matrix(C, a.in[I_ODWOUT] + (size_t)j * DM * DM, DM, DM, (bf16*)(ws + WS_WODOUT) + (size_t)j * DM * DM, nullptr, 0);
    }
    {
        const int gt = C.bid * 512 + C.tid, ngt = C.nb * 512;
        for (int j = 0; j < 2; ++j) {
            u32x4* p0 = (u32x4*)((bf16*)(ws + WS_WEVIN) + (size_t)j * EV_INP * DM + (size_t)EV_IN * DM);
            for (int i = gt; i < (EV_INP - EV_IN) * DM / 8; i += ngt) p0[i] = (u32x4){0u, 0u, 0u, 0u};
            u32x4* p1 = (u32x4*)((bf16*)(ws + WS_WODIN) + (size_t)j * OD_INP * DM + (size_t)OD_IN * DM);
            for (int i = gt; i < (OD_INP - OD_IN) * DM / 8; i += ngt) p1[i] = (u32x4){0u, 0u, 0u, 0u};
            bf16* WL = (bf16*)(ws + WS_WLORA) + (size_t)j * 655360;
            const float* w2 = a.in[I_W2L] + (size_t)j * 2 * 64 * 512; const float* a2 = a.in[I_A2] + (size_t)j * 2 * 64 * 512; const float* g2 = a.in[I_G2] + (size_t)j * 128 * 512;
            for (int i = gt; i < 655360; i += ngt) {
                const int n = i >> 8, k = i & 255; float v = 0.f;
                if (n < 1024) { const int d = n >> 9, c = n & 511; if (k >= d * 64 && k < d * 64 + 64) v = w2[(size_t)k * 512 + c]; }
                else if (n < 2048) { const int d = (n - 1024) >> 9, c = n & 511; if (k >= 128 + d * 64 && k < 192 + d * 64) v = a2[(size_t)(k - 128) * 512 + c]; }
                else { const int c = n - 2048; if (k >= 128) v = g2[(size_t)(k - 128) * 512 + c]; }
                WL[i] = f2bf(v);
            }
        }
    }
}

template <bool ROUTER>
DI void ph_norm(const Ctx& C, const float* xlat, const float* xctx, const float* gain, const float* mod  , int shift_off, int scale_off, bf16* H,
                const float* router  , float* AFFT, float* AFFC, int* SLOT) {
    LAS float* RT = (LAS float*)C.lds;
    if (ROUTER) { for (int i = C.tid; i < 16384; i += 512) { const int c = i >> 4, e = i & 15; RT[e * 1024 + c] = router[i]; } __syncthreads(); }
    const int gw = C.bid * 8 + C.wave, ngw = C.nb * 8, lane = C.lane;
    for (int row = gw; row < MT; row += ngw) {
        const float* xr = row < NLAT ? xlat + (size_t)row * DM : xctx + (size_t)(row - NLAT) * DM;
        const int mi = row < NLAT ? (row >> 12) : 8;
        const float* mp = mod + mi * 6144;
        f32x4 v[4]; float ss = 0.f;
#pragma unroll
        for (int j = 0; j < 4; ++j) { v[j] = *(const f32x4*)(xr + 256 * j + 4 * lane); ss += v[j].x * v[j].x + v[j].y * v[j].y + v[j].z * v[j].z + v[j].w * v[j].w; }
        ss = wave_sum(ss);
        const float rs = 1.0f / sqrtf(ss * (1.f / 1024.f) + EPS);
#pragma unroll
        for (int j = 0; j < 4; ++j) {
            const int c = 256 * j + 4 * lane;
            const f32x4 g = *(const f32x4*)(gain + c), sc = *(const f32x4*)(mp + scale_off + c), sh = *(const f32x4*)(mp + shift_off + c);
            v[j] = (v[j] * rs) * g * (sc + 1.0f) + sh;
            if (ROUTER && MOE_F8) *(unsigned*)((unsigned char*)H + (size_t)row * DM + c) = pk4_fp8(v[j].x, v[j].y, v[j].z, v[j].w);
            else *(u32x2*)(H + (size_t)row * DM + c) = (u32x2){pk2(v[j].x, v[j].y), pk2(v[j].z, v[j].w)};
        }
        if (ROUTER) {
            float mylg = 0.f;
#pragma unroll 1
            for (int e = 0; e < 16; ++e) { float p = 0.f;
#pragma unroll
                for (int j = 0; j < 4; ++j) { const f32x4 w = *(const LAS f32x4*)(RT + e * 1024 + 256 * j + 4 * lane); p += v[j].x * w.x + v[j].y * w.y + v[j].z * w.z + v[j].w * w.w; }
                p = wave_sum(p); mylg = (lane == e) ? p : mylg; }
            const float mx = max16(mylg);
            const float ex = expf(mylg - mx);
            const float mine = ex / sum16(ex);
            if (lane < 16) {
                if (row < NLAT) AFFT[(size_t)((row >> 12) * 16 + lane) * TL + (row & 4095)] = mine;
                else { const int rc = row - NLAT; AFFC[(size_t)((rc >> 8) * 16 + lane) * LCX + (rc & 255)] = mine; }
                SLOT[(size_t)row * 16 + lane] = -1;
            }
        }
    }
}


struct EpiBf16 { static constexpr bool WIDE = true; bf16* O; int ldo;
    DI void operator()(int row, int col, f32x4 v0, f32x4 v1) const { bf16* p = O + (size_t)row * ldo + col;
        *(u32x2*)p = (u32x2){pk2(v0[0], v0[1]), pk2(v0[2], v0[3])}; *(u32x2*)(p + 128) = (u32x2){pk2(v1[0], v1[1]), pk2(v1[2], v1[3])}; }
    DI void wide(int row, int col, f32x4 a0, f32x4 a1, f32x4 b0, f32x4 b1) const { bf16* p = O + (size_t)row * ldo + col;
        *(u32x4*)p = (u32x4){pk2(a0[0], a0[1]), pk2(a0[2], a0[3]), pk2(a1[0], a1[1]), pk2(a1[2], a1[3])}; *(u32x4*)(p + 128) = (u32x4){pk2(b0[0], b0[1]), pk2(b0[2], b0[3]), pk2(b1[0], b1[1]), pk2(b1[2], b1[3])}; } };
struct EpiF32 { static constexpr bool WIDE = false; float* O; int ldo;
    DI void operator()(int row, int col, f32x4 v0, f32x4 v1) const { float* p = O + (size_t)row * ldo + col; *(f32x4*)p = v0; *(f32x4*)(p + 128) = v1; } };
struct EpiResid { static constexpr bool WIDE = false; const float* xin_lat; const float* xin_ctx; float* xout_lat; float* xout_ctx; const float* modg;
    DI void operator()(int row, int col, f32x4 v0, f32x4 v1) const {
        const float* xi; float* xo; int mi;
        if (row < NLAT) { xi = xin_lat + (size_t)row * DM; xo = xout_lat + (size_t)row * DM; mi = row >> 12; }
        else { xi = xin_ctx + (size_t)(row - NLAT) * DM; xo = xout_ctx + (size_t)(row - NLAT) * DM; mi = 8; }
        const float* g = modg + mi * 6144 + col;
        const f32x4 g0 = *(const f32x4*)g, g1 = *(const f32x4*)(g + 128), x0 = *(const f32x4*)(xi + col), x1 = *(const f32x4*)(xi + col + 128);
        *(f32x4*)(xo + col) = x0 + g0 * v0; *(f32x4*)(xo + col + 128) = x1 + g1 * v1; } };
struct EpiGlu { static constexpr bool WIDE = false; bf16* O;
    DI void operator()(int row, int col, f32x4 v0, f32x4 v1) const { const int f = ((col & 2047) >> 8) * 128 + (col & 255);
        *(u32x2*)(O + (size_t)row * DM + f) = (u32x2){pk2(siluf_(v0[0]) * v1[0], siluf_(v0[1]) * v1[1]), pk2(siluf_(v0[2]) * v1[2], siluf_(v0[3]) * v1[3])}; } };
struct EpiGlu8 { static constexpr bool WIDE = true; unsigned char* O;
    DI void operator()(int row, int col, f32x4 v0, f32x4 v1) const { const int f = ((col & 2047) >> 8) * 128 + (col & 255);
        *(unsigned*)(O + (size_t)row * DM + f) = pk4_fp8(8.f * siluf_(v0[0]) * v1[0], 8.f * siluf_(v0[1]) * v1[1], 8.f * siluf_(v0[2]) * v1[2], 8.f * siluf_(v0[3]) * v1[3]); }
    DI void wide(int row, int col, f32x4 a0, f32x4 a1, f32x4 b0, f32x4 b1) const { const int f = ((col & 2047) >> 8) * 128 + (col & 255);
        *(u32x2*)(O + (size_t)row * DM + f) = (u32x2){pk4_fp8(8.f * siluf_(a0[0]) * b0[0], 8.f * siluf_(a0[1]) * b0[1], 8.f * siluf_(a0[2]) * b0[2], 8.f * siluf_(a0[3]) * b0[3]),
                                                    pk4_fp8(8.f * siluf_(a1[0]) * b1[0], 8.f * siluf_(a1[1]) * b1[1], 8.f * siluf_(a1[2]) * b1[2], 8.f * siluf_(a1[3]) * b1[3])}; } };
struct EpiGate { static constexpr bool WIDE = true; bf16* O; const float* gate;
    DI void operator()(int row, int col, f32x4 v0, f32x4 v1) const { const float g = gate[row]; bf16* p = O + (size_t)row * DM + (col & 1023);
        *(u32x2*)p = (u32x2){pk2(v0[0] * g, v0[1] * g), pk2(v0[2] * g, v0[3] * g)}; *(u32x2*)(p + 128) = (u32x2){pk2(v1[0] * g, v1[1] * g), pk2(v1[2] * g, v1[3] * g)}; }
    DI void wide(int row, int col, f32x4 a0, f32x4 a1, f32x4 b0, f32x4 b1) const { const float g = gate[row]; bf16* p = O + (size_t)row * DM + (col & 1023);
        *(u32x4*)p = (u32x4){pk2(a0[0] * g, a0[1] * g), pk2(a0[2] * g, a0[3] * g), pk2(a1[0] * g, a1[1] * g), pk2(a1[2] * g, a1[3] * g)};
        *(u32x4*)(p + 128) = (u32x4){pk2(b0[0] * g, b0[1] * g), pk2(b0[2] * g, b0[3] * g), pk2(b1[0] * g, b1[1] * g), pk2(b1[2] * g, b1[3] * g)}; } };
typedef _Float16 f16x2_t __attribute__((ext_vector_type(2)));
DI unsigned pk2h(float a, float b) { f16x2_t h; h.x = (_Float16)a; h.y = (_Float16)b; return __builtin_bit_cast(unsigned, h); }
DI float h2f(unsigned short x) { return (float)__builtin_bit_cast(_Float16, x); }
struct EpiLoraW { static constexpr bool WIDE = false; unsigned short* W; const float* w0;
    DI void one(int row, int col, f32x4 v) const { const int d = col >> 9, c = col & 511; f32x4 o;
#pragma unroll
        for (int e = 0; e < 4; ++e) { const float lw = w0[col + e] + v[e]; const float z = -lw; const float sp = fmaxf(z, 0.f) + __logf(1.f + __expf(-fabsf(z))); o[e] = -__expf(-sp - 0.5f); }
        *(u32x2*)(W + ((size_t)d * MT + row) * 512 + c) = (u32x2){pk2h(o[0], o[1]), pk2h(o[2], o[3])}; }
    DI void operator()(int row, int col, f32x4 v0, f32x4 v1) const { one(row, col, v0); one(row, col + 128, v1); } };
struct EpiLoraA { static constexpr bool WIDE = false; bf16* Aout; const float* a0;
    DI void one(int row, int col, f32x4 v) const { const int d = col >> 9, c = col & 511; const f32x4 b = *(const f32x4*)(a0 + col);
        *(u32x2*)(Aout + ((size_t)d * MT + row) * 512 + c) = (u32x2){pk2(sigmoidf_(b[0] + v[0]), sigmoidf_(b[1] + v[1])), pk2(sigmoidf_(b[2] + v[2]), sigmoidf_(b[3] + v[3]))}; }
    DI void operator()(int row, int col, f32x4 v0, f32x4 v1) const { one(row, col, v0); one(row, col + 128, v1); } };

namespace pg8 {
constexpr int BM = 256, BK = 64, HALF = 128, HTB = HALF * BK * 2, STAGE_BYTES = 8 * HTB;
DI int lds_byte(int r, int c) { const int st = (r >> 4) * 2 + (c >> 5), rr = r & 15, cc = c & 31, ob = rr * 64 + cc * 2; return st * 1024 + (ob ^ (((ob >> 9) & 1) << 5)); }
DI void stage_rc(int b, int& R, int& C) { const int st = b / 1024, sb = b % 1024, swz = sb ^ (((sb >> 9) & 1) << 5); R = (st >> 1) * 16 + swz / 64; C = (st & 1) * 32 + (swz % 64) / 2; }
DI int perm32(int rho) { const int n = rho >> 4, i = rho & 15; return 8 * (i >> 2) + 4 * n + (i & 3); }
struct Unit { int pm, pn; };
struct Gemm { const bf16* A; const bf16* Bt; int lda, K; const int* rows; int scale_w = 0x7f7f7f7f, scale_a = 0x7f7f7f7f; };
struct OrderMN { int nM, nN, G, c;
    DI bool next(int i, Unit& u) const { const int L = i * G + c; if (L >= nM * nN) return false; u.pm = L / nN; u.pn = L % nN; return true; } };
struct OrderMoE { int nMt, nN, mstride  , G, c;
    DI bool next(int i, Unit& u) const { const int L = i * G + c, per = nMt * nN; if (L >= NEXP * per) return false; const int e = L / per, q = L % per; u.pm = e * mstride + q / nN; u.pn = e * nN + q % nN; return true; } };
template <class E4> struct EpiAdapt { E4 e;
    DI void operator()(const f32x4 (&acc)[2][2][4][2], const Unit& u, int wr, int wc, int fr, int fq) const {
#pragma unroll
        for (int ai = 0; ai < 2; ++ai)
#pragma unroll
            for (int m = 0; m < 4; ++m) { const int row = u.pm * BM + ai * HALF + wr * 64 + m * 16 + fr;
                if constexpr (E4::WIDE) e.wide(row, u.pn * BM + wc * 32 + 8 * fq, acc[ai][0][m][0], acc[ai][0][m][1], acc[ai][1][m][0], acc[ai][1][m][1]);
                else {
#pragma unroll
                    for (int n = 0; n < 2; ++n) e(row, u.pn * BM + wc * 32 + 8 * fq + 4 * n, acc[ai][0][m][n], acc[ai][1][m][n]); } } } };

template <class Epi, class Sched, bool F8 = false>
DI void gemm_phase(LAS unsigned char* lds, const Gemm g, const Sched& S, const Epi& E, const int tid) {
    const int wid = __builtin_amdgcn_readfirstlane(tid >> 6), lane = tid & 63, wr = wid >> 2, wc = wid & 3, fr = lane & 15, fq = lane >> 4;
    const int K = g.K, nt = K / BK;
    unsigned voffB[2];
#pragma unroll
    for (int i = 0; i < 2; ++i) { int R, C; stage_rc(tid * 16 + i * 8192, R, C); const int Rb = (R & ~31) + perm32(R & 31); voffB[i] = (unsigned)(Rb * K + C) * 2u; }
    const size_t kstep = (size_t)(BK * 2), hstep = (size_t)HALF * K * 2, tstep = 2 * hstep;
    const unsigned ldsw = (unsigned)wid * 1024u;
    const int aoff = lds_byte(wr * 64 + fr, fq * 8), boff = lds_byte(wc * 32 + fr, fq * 8);
    const char* const gA = (const char*)g.A;
#define PG8_SA(b, h) (((b) * 2 + (h)) * HTB)
#define PG8_SB(b, h) ((4 + (b) * 2 + (h)) * HTB)
#define PG8_STAGE(bufoff, gbase, voff) do { _Pragma("unroll") for (int _i = 0; _i < 2; ++_i) \
        __builtin_amdgcn_global_load_lds((const unsigned*)((const char*)(gbase) + (voff)[_i]), (LAS unsigned*)(lds + (bufoff) + ldsw + _i * 8192), 16, 0, 0); } while (0)
#define PG8_LDA(dst, b, h) do { _Pragma("unroll") for (int m = 0; m < 4; ++m) _Pragma("unroll") for (int k = 0; k < 2; ++k) dst[m][k] = *(const LAS bf16x8*)(lds + PG8_SA(b, h) + aoff + m * 2048 + k * 1024); } while (0)
#define PG8_LDB(dst, b, h) do { _Pragma("unroll") for (int n = 0; n < 2; ++n) _Pragma("unroll") for (int k = 0; k < 2; ++k) dst[n][k] = *(const LAS bf16x8*)(lds + PG8_SB(b, h) + boff + n * 2048 + k * 1024); } while (0)
#define PG8_MMA(ai, bj, At, Bt) do { __builtin_amdgcn_s_setprio(1); _Pragma("unroll") for (int m = 0; m < 4; ++m) _Pragma("unroll") for (int n = 0; n < 2; ++n) { \
        if constexpr (F8) { const v8i_t w8 = __builtin_shufflevector(__builtin_bit_cast(i32x4_t, Bt[n][0]), __builtin_bit_cast(i32x4_t, Bt[n][1]), 0, 1, 2, 3, 4, 5, 6, 7), x8 = __builtin_shufflevector(__builtin_bit_cast(i32x4_t, At[m][0]), __builtin_bit_cast(i32x4_t, At[m][1]), 0, 1, 2, 3, 4, 5, 6, 7); \
            acc[ai][bj][m][n] = __builtin_amdgcn_mfma_scale_f32_16x16x128_f8f6f4(w8, x8, acc[ai][bj][m][n], 0, 0, 0, g.scale_w, 0, g.scale_a); } \
        else { _Pragma("unroll") for (int k = 0; k < 2; ++k) acc[ai][bj][m][n] = __builtin_amdgcn_mfma_f32_16x16x32_bf16(Bt[n][k], At[m][k], acc[ai][bj][m][n], 0, 0, 0); } } __builtin_amdgcn_s_setprio(0); } while (0)
#define PG8_WAIT_V(n) asm volatile("s_waitcnt vmcnt(" #n ")" ::: "memory")
#define PG8_WAIT_L(n) asm volatile("s_waitcnt lgkmcnt(" #n ")" ::: "memory")
#define PG8_BAR __builtin_amdgcn_s_barrier()
#define PG8_SCHED __builtin_amdgcn_sched_barrier(0)
#define PG8_ROWIDX(ri, u) do { _Pragma("unroll") for (int _h = 0; _h < 2; ++_h) _Pragma("unroll") for (int _i = 0; _i < 2; ++_i) { int _R, _C; stage_rc(tid * 16 + _i * 8192, _R, _C); (void)_C; \
        const int _lr = (u).pm * BM + _h * HALF + _R; ri[_h][_i] = g.rows ? g.rows[_lr] : _lr; } } while (0)
#define PG8_AOFF_FROM(vo, ri) do { _Pragma("unroll") for (int _h = 0; _h < 2; ++_h) _Pragma("unroll") for (int _i = 0; _i < 2; ++_i) { int _R, _C; stage_rc(tid * 16 + _i * 8192, _R, _C); (void)_R; \
        vo[_h][_i] = (unsigned)(((size_t)ri[_h][_i] * g.lda + _C) * 2u); } } while (0)
    Unit cur, nxt; int ui = 0;
    if (!S.next(0, cur)) return;
    f32x4 acc[2][2][4][2];
#pragma unroll
    for (int a = 0; a < 2; ++a)
#pragma unroll
        for (int b = 0; b < 2; ++b)
#pragma unroll
            for (int m = 0; m < 4; ++m)
#pragma unroll
                for (int n = 0; n < 2; ++n) acc[a][b][m][n] = (f32x4){0.f, 0.f, 0.f, 0.f};
    bf16x8 At[4][2], B0[2][2], B1[2][2];
    unsigned cvo[2][2]; int nri[2][2];
    PG8_ROWIDX(nri, cur); PG8_AOFF_FROM(cvo, nri);
    const char* cB = (const char*)g.Bt + (size_t)cur.pn * tstep;
    PG8_STAGE(PG8_SB(0, 0), cB, voffB); PG8_STAGE(PG8_SB(0, 1), cB + hstep, voffB); PG8_STAGE(PG8_SA(0, 0), gA, cvo[0]); PG8_STAGE(PG8_SA(0, 1), gA, cvo[1]);
    if (wr == 1) PG8_BAR;
    PG8_WAIT_V(2); PG8_BAR;
    PG8_STAGE(PG8_SB(1, 0), cB + kstep, voffB); PG8_STAGE(PG8_SA(1, 0), gA + kstep, cvo[0]); PG8_STAGE(PG8_SB(1, 1), cB + hstep + kstep, voffB);
    PG8_WAIT_V(6); PG8_BAR;
    for (;;) {
        const bool has_next = S.next(ui + 1, nxt);
        const char* nB = has_next ? (const char*)g.Bt + (size_t)nxt.pn * tstep : cB;
#pragma nounroll
        for (int t = 0; t < nt; t += 2) {
            const bool last = (t == nt - 2);
            const char* a1 = gA + (size_t)(t + 1) * kstep;
            const char* a2 = last ? gA : gA + (size_t)(t + 2) * kstep; const char* b2 = last ? nB : cB + (size_t)(t + 2) * kstep;
            const char* a3 = a2 + kstep; const char* b3 = b2 + kstep;
            if (t == nt - 4 && has_next) PG8_ROWIDX(nri, nxt);
            PG8_LDB(B0, 0, 0); PG8_LDB(B1, 0, 1); PG8_SCHED; PG8_LDA(At, 0, 0); PG8_STAGE(PG8_SA(1, 1), a1, cvo[1]);
            if (last && has_next) { if (nt < 4) PG8_ROWIDX(nri, nxt); PG8_AOFF_FROM(cvo, nri); }
            PG8_WAIT_V(8); PG8_WAIT_L(0); PG8_BAR; PG8_MMA(0, 0, At, B0); PG8_MMA(0, 1, At, B1); PG8_BAR; PG8_SCHED;
            PG8_LDA(At, 0, 1); PG8_STAGE(PG8_SB(0, 0), b2, voffB); PG8_STAGE(PG8_SB(0, 1), b2 + hstep, voffB); PG8_STAGE(PG8_SA(0, 0), a2, cvo[0]);
            PG8_WAIT_V(8); PG8_WAIT_L(0); PG8_BAR; PG8_MMA(1, 0, At, B0); PG8_MMA(1, 1, At, B1); PG8_BAR; PG8_SCHED;
            PG8_LDB(B0, 1, 0); PG8_LDB(B1, 1, 1); PG8_SCHED; PG8_LDA(At, 1, 0); PG8_STAGE(PG8_SA(0, 1), a2, cvo[1]);
            PG8_WAIT_V(8); PG8_WAIT_L(0); PG8_BAR; PG8_MMA(0, 0, At, B0); PG8_MMA(0, 1, At, B1); PG8_BAR; PG8_SCHED;
            PG8_LDA(At, 1, 1); PG8_STAGE(PG8_SB(1, 0), b3, voffB); PG8_STAGE(PG8_SB(1, 1), b3 + hstep, voffB); PG8_STAGE(PG8_SA(1, 0), a3, cvo[0]);
            PG8_WAIT_V(8); PG8_WAIT_L(0); PG8_BAR; PG8_MMA(1, 0, At, B0); PG8_MMA(1, 1, At, B1); PG8_BAR; PG8_SCHED;
        }
        if (wr == 0) PG8_BAR;
        E(acc, cur, wr, wc, fr, fq);
        if (!has_next) break;
#pragma unroll
        for (int a = 0; a < 2; ++a)
#pragma unroll
            for (int b = 0; b < 2; ++b)
#pragma unroll
                for (int m = 0; m < 4; ++m)
#pragma unroll
                    for (int n = 0; n < 2; ++n) acc[a][b][m][n] = (f32x4){0.f, 0.f, 0.f, 0.f};
        cur = nxt; cB = nB; ++ui;
        if (wr == 1) PG8_BAR;
    }
    PG8_WAIT_V(0);
    PG8_BAR;
#undef PG8_SA
#undef PG8_SB
#undef PG8_STAGE
#undef PG8_LDA
#undef PG8_LDB
#undef PG8_MMA
#undef PG8_WAIT_V
#undef PG8_WAIT_L
#undef PG8_BAR
#undef PG8_SCHED
#undef PG8_ROWIDX
#undef PG8_AOFF_FROM
}
}
template <class E4> DI void fast_gemm(const Ctx& C, const bf16* A, int lda, const bf16* Bt, int K, int nM, int nN, const E4& e, bool rev = false) {
    pg8::Gemm g{A, Bt, lda, K, nullptr}; pg8::OrderMN S{nM, nN, C.nb, rev ? C.nb - 1 - C.vcu : C.vcu}; pg8::EpiAdapt<E4> E{e};
    pg8::gemm_phase(C.lds, g, S, E, C.tid);
}

DI float max16_acc(float m, const f32x16& x) {
    asm volatile("s_nop 15\n\tv_max3_f32 %0, %0, %1, %2\n\tv_max3_f32 %0, %0, %3, %4\n\tv_max3_f32 %0, %0, %5, %6\n\tv_max3_f32 %0, %0, %7, %8\n\tv_max3_f32 %0, %0, %9, %10\n\tv_max3_f32 %0, %0, %11, %12\n\tv_max3_f32 %0, %0, %13, %14\n\tv_max3_f32 %0, %0, %15, %16"
                 : "+v"(m) : "v"(x[0]), "v"(x[1]), "v"(x[2]), "v"(x[3]), "v"(x[4]), "v"(x[5]), "v"(x[6]), "v"(x[7]), "v"(x[8]), "v"(x[9]), "v"(x[10]), "v"(x[11]), "v"(x[12]), "v"(x[13]), "v"(x[14]), "v"(x[15]));
    return m; }
DI int swap23(int x) { return (x & ~12) | ((x & 4) << 1) | ((x & 8) >> 1); }
DI void flash_store(const f32x16 (&o)[2], float l, bf16* orow  , int h) {
    const float inv = 1.f / l;
#pragma unroll
    for (int dt = 0; dt < 2; ++dt)
#pragma unroll
        for (int g = 0; g < 4; ++g)
            *(u32x2*)(orow + 32 * dt + 8 * g + 4 * h) = (u32x2){pk2(o[dt][4 * g] * inv, o[dt][4 * g + 1] * inv), pk2(o[dt][4 * g + 2] * inv, o[dt][4 * g + 3] * inv)};
}


template <int DQK> struct AttnGeo { static constexpr int KSTR = DQK * 2 + 16, KBYTES = 64 * KSTR, VSTR = 144, VBYTES = 64 * VSTR, BUF = KBYTES + VBYTES, KPIECES = 64 * DQK / 8; };
template <int DQK, bool NAT>
DI void attn_tile_loop(const Ctx& C, f32x16 (&o)[2], float& l, const bf16x8 (&qf)[DQK / 16], const bf16* __restrict__ Kb, const bf16* __restrict__ Vt, int pos1, int n1, int pos2, int n2,
                       const LAS float* tab, int grow, int rs, int qc, int cs) {
    typedef AttnGeo<DQK> G;
    const int tid = C.tid, r = C.lane & 31, h = C.lane >> 5, kr = swap23(r), ntiles = n1 + n2;
    constexpr bool K2 = G::KPIECES > 512;
    const int kq0 = tid, kq1 = tid + 512;
    const int kl0 = (kq0 / (DQK / 8)) * G::KSTR + (kq0 % (DQK / 8)) * 16, kl1 = (kq1 / (DQK / 8)) * G::KSTR + (kq1 % (DQK / 8)) * 16;
    const int vl = G::KBYTES + (tid >> 3) * G::VSTR + (tid & 7) * 16;
    const bf16* vg = Vt + (size_t)(tid >> 3) * KPOS + 8 * (tid & 7);
    u32x4 rk0, rk1, rv;
    rk1 = (u32x4){0u, 0u, 0u, 0u};
#define ATT_POS(t) ((t) < n1 ? pos1 + 64 * (t) : pos2 + 64 * ((t) - n1))
    { const int pos0 = ATT_POS(0); rk0 = *(const u32x4*)(Kb + (size_t)pos0 * DQK + 8 * kq0); if (K2 && tid < 256) rk1 = *(const u32x4*)(Kb + (size_t)pos0 * DQK + 8 * kq1); rv = *(const u32x4*)(vg + pos0); }
    __syncthreads();
    *(LAS u32x4*)(C.lds + kl0) = rk0; if (K2 && tid < 256) *(LAS u32x4*)(C.lds + kl1) = rk1; *(LAS u32x4*)(C.lds + vl) = rv;
    __syncthreads();
    if (C.wave >= 4) __builtin_amdgcn_s_setprio(1);
    float mref = 0.f; bool first = true;
    f32x16 nmref;
#pragma unroll
    for (int i = 0; i < 16; ++i) nmref[i] = 0.f;
    constexpr float THR = 8.f;
    for (int t = 0; t < ntiles; ++t) {
        const LAS unsigned char* B = C.lds + (t & 1) * G::BUF;
        if (t + 1 < ntiles) { const int pos0 = ATT_POS(t + 1);
            rk0 = *(const u32x4*)(Kb + (size_t)pos0 * DQK + 8 * kq0); if (K2 && tid < 256) rk1 = *(const u32x4*)(Kb + (size_t)pos0 * DQK + 8 * kq1); rv = *(const u32x4*)(vg + pos0); }
        const int gr = (pos1 >> 6) + t;
        const bool active = !NAT || t >= n1 || (gr >= rs && gr < rs + 8);
        if (active) {
            f32x16 sc[2];
            constexpr int NK = DQK / 16, NS = 2 * NK, RD = 4;
            const LAS unsigned char* kp = B + kr * G::KSTR + 16 * h;
            bf16x8 fr[RD];
#pragma unroll
            for (int s = 0; s < RD; ++s) fr[s] = *(const LAS bf16x8*)(kp + (s / NK) * 32 * G::KSTR + 32 * (s % NK));
#pragma unroll
            for (int s = 0; s < NS; ++s) { sc[s / NK] = MFMA32(fr[s % RD], qf[s % NK], (s % NK == 0) ? nmref : sc[s / NK]);
                if (s + RD < NS) fr[s % RD] = *(const LAS bf16x8*)(kp + ((s + RD) / NK) * 32 * G::KSTR + 32 * ((s + RD) % NK)); }
            const LAS unsigned char* vp = B + G::KBYTES + r * G::VSTR + 16 * h;
#pragma unroll
            for (int v = 0; v < RD; ++v) fr[v] = *(const LAS bf16x8*)(vp + (v & 1) * 32 * G::VSTR + (v >> 1) * 32);
            __builtin_amdgcn_sched_group_barrier(0x100, RD, 0);
#pragma unroll
            for (int s = 0; s < NS - RD; ++s) { __builtin_amdgcn_sched_group_barrier(0x008, 1, 0); __builtin_amdgcn_sched_group_barrier(0x100, 1, 0); }
            __builtin_amdgcn_sched_group_barrier(0x008, RD, 0);
            __builtin_amdgcn_sched_group_barrier(0x100, RD, 0);
            if (NAT && t < n1) {
                const LAS float* trl = tab + (gr - grow + 7) * 128 + (8 * h - qc + 63);
#pragma unroll
                for (int j = 0; j < 2; ++j) { float bv[16];
#pragma unroll
                    for (int i = 0; i < 16; ++i) bv[i] = trl[32 * j + ((i & 3) | (((i >> 2) & 1) << 2) | ((i >> 3) << 4))];
                    asm volatile("" : "+v"(bv[0]), "+v"(bv[1]), "+v"(bv[2]), "+v"(bv[3]), "+v"(bv[4]), "+v"(bv[5]), "+v"(bv[6]), "+v"(bv[7]), "+v"(bv[8]), "+v"(bv[9]), "+v"(bv[10]), "+v"(bv[11]), "+v"(bv[12]), "+v"(bv[13]), "+v"(bv[14]), "+v"(bv[15]));
#pragma unroll
                    for (int i = 0; i < 16; ++i) {
                        const int cc = 32 * j + ((i & 3) | (((i >> 2) & 1) << 2) | ((i >> 3) << 4)) + 8 * h; const bool ok = (cc >= cs) && (cc < cs + 16);
                        sc[j][i] = ok ? sc[j][i] + bv[i] : -1e30f;
                    } }
            }
            float mx = max16_acc(max16_acc(-3.0e38f, sc[0]), sc[1]);
            if (first || __builtin_amdgcn_ballot_w64(mx > THR) != 0ull) {
                mx = fmaxf(mx, xor32(mx, C.lane));
                const float delta = first ? mx : fmaxf(mx, 0.f);
#pragma unroll
                for (int i = 0; i < 16; ++i) { sc[0][i] -= delta; sc[1][i] -= delta; }
                if (!first) { const float alpha = __builtin_amdgcn_exp2f(-delta); l *= alpha;
#pragma unroll
                    for (int i = 0; i < 16; ++i) { o[0][i] *= alpha; o[1][i] *= alpha; } }
                mref += delta; first = false;
#pragma unroll
                for (int i = 0; i < 16; ++i) nmref[i] = -mref;
            }
            float rs1 = 0.f;
#pragma unroll
            for (int j = 0; j < 2; ++j)
#pragma unroll
                for (int i = 0; i < 16; ++i) { sc[j][i] = __builtin_amdgcn_exp2f(sc[j][i]); rs1 += sc[j][i]; }
            l += rs1;
#pragma unroll
            for (int j = 0; j < 2; ++j)
#pragma unroll
                for (int s2 = 0; s2 < 2; ++s2) {
                    u32x4 pw; pw.x = pk2(sc[j][8 * s2], sc[j][8 * s2 + 1]); pw.y = pk2(sc[j][8 * s2 + 2], sc[j][8 * s2 + 3]); pw.z = pk2(sc[j][8 * s2 + 4], sc[j][8 * s2 + 5]); pw.w = pk2(sc[j][8 * s2 + 6], sc[j][8 * s2 + 7]);
                    const bf16x8 pb = __builtin_bit_cast(bf16x8, pw);
#pragma unroll
                    for (int dt = 0; dt < 2; ++dt) { const int v = 4 * j + 2 * s2 + dt;
                        o[dt] = MFMA32(fr[v % RD], pb, o[dt]);
                        if (v + RD < 8) fr[v % RD] = *(const LAS bf16x8*)(vp + ((v + RD) & 1) * 32 * G::VSTR + ((v + RD) >> 1) * 32); }
                }
#pragma unroll
            for (int v = 0; v < 8 - RD; ++v) { __builtin_amdgcn_sched_group_barrier(0x008, 1, 1); __builtin_amdgcn_sched_group_barrier(0x100, 1, 1); }
            __builtin_amdgcn_sched_group_barrier(0x008, RD, 1);
        }
        if (t + 1 < ntiles) { LAS unsigned char* Bn = C.lds + ((t + 1) & 1) * G::BUF;
            *(LAS u32x4*)(Bn + kl0) = rk0; if (K2 && tid < 256) *(LAS u32x4*)(Bn + kl1) = rk1; *(LAS u32x4*)(Bn + vl) = rv; }
        __syncthreads();
    }
    __builtin_amdgcn_s_setprio(0);
    l += xor32(l, C.lane);
#undef ATT_POS
}
DI void conv_unit(const Ctx& C, int u, const bf16* U, const float (&wk)[31], float bias, const float* lng, const float* lnb, bf16* OCAT);
DI const float* in_ptr(const unsigned char* ws, int k);
constexpr int CONV_PER_TAIL = 3;
DI int conv_in_fin(int nb) { const int extra = (MT / 64) % nb; const int n = CONV_PER_TAIL * (nb - extra); return n < MT / 32 ? n : MT / 32; }
DI void ph_attn_mla2(const Ctx& C, const bf16* QB, const bf16* KB, const bf16* VT, bf16* OCAT, bool last, unsigned char* ws, int lq) {
    const int r = C.lane & 31, h = C.lane >> 5;
    const int nunits = 1024 + (last ? 0 : 64);
    int k = 0;
    for (;; ++k) {
        const int u = C.vcu + k * C.nb, cu = conv_in_fin(C.nb) + (C.nb - 1 - C.vcu) + k * C.nb;
        const bool a_on = u < nunits, c_on = cu < MT / 32;
        if (!a_on && !c_on) break;
        if (a_on) {
            const int bh = u < 1024 ? (u >> 4) : u - 1024, qblk = u < 1024 ? (u & 15) : 16, b = bh >> 3, hh = bh & 7;
            const int qpos = qblk * 256 + 32 * C.wave + r;
            const bf16* qp = QB + ((size_t)bh * KPOS + qpos) * 96 + 8 * h;
            bf16x8 qf[6];
#pragma unroll
            for (int kk = 0; kk < 6; ++kk) qf[kk] = *(const bf16x8*)(qp + 16 * kk);
            f32x16 o[2];
#pragma unroll
            for (int i = 0; i < 16; ++i) { o[0][i] = 0.f; o[1][i] = 0.f; }
            float l = 0.f;
            attn_tile_loop<96, false>(C, o, l, qf, KB + (size_t)bh * KPOS * 96, VT + (size_t)bh * 64 * KPOS, qblk < 16 ? 0 : TL, qblk < 16 ? KPOS / 64 : LCX / 64, 0, 0, nullptr, 0, 0, 0, 0);
            const int row = qblk < 16 ? b * TL + qpos : NLAT + b * LCX + (qpos - TL);
            flash_store(o, l, OCAT + (size_t)row * DM + hh * 64, h);
        }
        if (c_on) { float wk[31]; const float* dww = in_ptr(ws, I_DWW) + (size_t)lq * 31 * 512;
#pragma unroll
            for (int kt = 0; kt < 31; ++kt) wk[kt] = dww[kt * 512 + C.tid];
            conv_unit(C, cu, (const bf16*)(ws + WS_ARENA + A_U), wk, in_ptr(ws, I_DWB)[lq * 512 + C.tid], in_ptr(ws, I_LNG) + lq * 512, in_ptr(ws, I_LNB) + lq * 512, OCAT); }
    }
}
DI void ph_natten2(const Ctx& C, const bf16* QN, const bf16* KN, const bf16* VTN, bf16* OCAT, const float* rpb  , bool last, unsigned* work_ctr, unsigned char* ws, int lq) {
    const int r = C.lane & 31, h = C.lane >> 5;
    LAS float* tab = (LAS float*)(C.lds + 2 * AttnGeo<64>::BUF);
    LAS int* uslot = (LAS int*)(tab + 1920);
    const int nunits = 1024 + (last ? 0 : 64);
    for (;;) {
        __syncthreads();
        if (C.tid == 0) *uslot = (int)__hip_atomic_fetch_add(work_ctr, 1u, __ATOMIC_RELAXED, __HIP_MEMORY_SCOPE_AGENT);
        __syncthreads();
        const int u = *uslot;
        if (u >= nunits) break;
        const bool isctx = u >= 1024;
        const int bh = isctx ? u - 1024 : (u >> 4), b = bh >> 3, hh = bh & 7;
        for (int i = C.tid; i < 15 * 128; i += 512) { const int dc = (i & 127) - 48; tab[i] = (dc >= 0 && dc < 31) ? rpb[hh * 465 + (i >> 7) * 31 + dc] * LOG2E : 0.f; }
        int qpos, row, grow = 0, qc = 0, rs = 0, cs = 0, rlo = 0, nband = 0;
        if (!isctx) { const int rg = u & 15; grow = 4 * rg + (C.wave >> 1); qc = 32 * (C.wave & 1) + r; qpos = grow * 64 + qc; row = b * TL + qpos;
            rs = grow - 4; rs = rs < 0 ? 0 : (rs > 56 ? 56 : rs); cs = qc - 8; cs = cs < 0 ? 0 : (cs > 48 ? 48 : cs);
            rlo = 4 * rg - 4; rlo = rlo < 0 ? 0 : (rlo > 56 ? 56 : rlo); int rhi = 4 * rg + 3 - 4; rhi = rhi < 0 ? 0 : (rhi > 56 ? 56 : rhi); nband = rhi + 8 - rlo; }
        else { qpos = TL + 32 * C.wave + r; row = NLAT + b * LCX + 32 * C.wave + r; }
        const bf16* qp = QN + ((size_t)bh * KPOS + qpos) * 64 + 8 * h;
        bf16x8 qf[4];
#pragma unroll
        for (int kk = 0; kk < 4; ++kk) qf[kk] = *(const bf16x8*)(qp + 16 * kk);
        f32x16 o[2];
#pragma unroll
        for (int i = 0; i < 16; ++i) { o[0][i] = 0.f; o[1][i] = 0.f; }
        float l = 0.f;
        attn_tile_loop<64, true>(C, o, l, qf, KN + (size_t)bh * KPOS * 64, VTN + (size_t)bh * 64 * KPOS, rlo * 64, nband, TL, LCX / 64, tab, grow, rs, qc, cs);
        flash_store(o, l, OCAT + (size_t)row * DM + 512 + hh * 64, h);
    }
}


DI void ph_mla_fin(const Ctx& C, const bf16* U, const bf16* QPRE, const bf16* KVPRE, const float* qg, const float* kg, const f32x2* CS, bf16* QB, bf16* KB, bf16* VT) {
    LAS bf16* VL = (LAS bf16*)C.lds;
    const int lane = C.lane, j = lane >> 3, sub = lane & 7;
    const float C2 = 0.10206207261596575f * LOG2E;
    float qgn[8], qgr[4], kgn[8], kgr[4];
#pragma unroll
    for (int e = 0; e < 8; ++e) { qgn[e] = qg[8 * sub + e] * C2; kgn[e] = kg[8 * sub + e]; }
#pragma unroll
    for (int m = 0; m < 4; ++m) { qgr[m] = qg[64 + sub + 8 * m] * C2; kgr[m] = kg[64 + sub + 8 * m]; }
    for (int u = C.vcu; u < MT / 64; u += C.nb) {
        const int row0 = 64 * u, b = row0 < NLAT ? (row0 >> 12) : ((row0 - NLAT) >> 8), pos0 = row0 < NLAT ? (row0 & 4095) : TL + ((row0 - NLAT) & 255);
        const bool lat = row0 < NLAT;
        const int pl = 8 * C.wave + j, row = row0 + pl, pos = pos0 + pl;
        const bf16* ur = U + (size_t)row * EV_INP;
        float sq = 0.f, skv = 0.f;
#pragma unroll
        for (int m = 0; m < 6; ++m) { float x[8]; unpack8(*(const u32x4*)(ur + 8 * (sub + 8 * m)), x);
#pragma unroll
            for (int e = 0; e < 8; ++e) sq += x[e] * x[e]; }
#pragma unroll
        for (int m = 0; m < 4; ++m) { float x[8]; unpack8(*(const u32x4*)(ur + 384 + 8 * (sub + 8 * m)), x);
#pragma unroll
            for (int e = 0; e < 8; ++e) skv += x[e] * x[e]; }
        sq = sum8(sq); skv = sum8(skv);
        const float rsq = 1.0f / sqrtf(sq * (1.f / 384.f) + EPS), rskv = 1.0f / sqrtf(skv * (1.f / 256.f) + EPS);
        float krv[4];
#pragma unroll
        for (int m = 0; m < 4; ++m) krv[m] = bf2f(ur[640 + sub + 8 * m]);
        float cr = 1.f, sr = 0.f, cc = 1.f, sc = 0.f;
        if (lat) { const f32x2 a0 = CS[pos * 16 + sub], a1 = CS[pos * 16 + 8 + sub]; cr = a0.x; sr = a0.y; cc = a1.x; sc = a1.y; }
        const bf16* qrow = QPRE + (size_t)row * 768; const bf16* kvrow = KVPRE + (size_t)row * 1024;
#pragma unroll 2
        for (int hh = 0; hh < 8; ++hh) {
            { float qn[8], qr[4]; unpack8(*(const u32x4*)(qrow + hh * 96 + 8 * sub), qn); float ss = 0.f;
#pragma unroll
              for (int e = 0; e < 8; ++e) qn[e] *= rsq;
#pragma unroll
              for (int m = 0; m < 4; ++m) { qr[m] = bf2f(qrow[hh * 96 + 64 + sub + 8 * m]) * rsq; ss += qr[m] * qr[m]; }
#pragma unroll
              for (int e = 0; e < 8; ++e) ss += qn[e] * qn[e];
              const float rn = 1.0f / sqrtf(sum8(ss) * (1.f / 96.f) + EPS);
#pragma unroll
              for (int e = 0; e < 8; ++e) qn[e] *= rn * qgn[e];
#pragma unroll
              for (int m = 0; m < 4; ++m) qr[m] *= rn * qgr[m];
              { const float x0 = qr[0], x1 = qr[1], y0 = qr[2], y1 = qr[3]; qr[0] = x0 * cr - x1 * sr; qr[1] = x1 * cr + x0 * sr; qr[2] = y0 * cc - y1 * sc; qr[3] = y1 * cc + y0 * sc; }
              bf16* qo = QB + ((size_t)(b * 8 + hh) * KPOS + pos) * 96;
              *(u32x4*)(qo + 8 * sub) = pack8(qn);
#pragma unroll
              for (int m = 0; m < 4; ++m) qo[64 + sub + 8 * m] = f2bf(qr[m]); }
            { float kn[8], kr[4]; unpack8(*(const u32x4*)(kvrow + hh * 128 + 8 * sub), kn); float ss = 0.f;
#pragma unroll
              for (int e = 0; e < 8; ++e) kn[e] *= rskv;
#pragma unroll
              for (int m = 0; m < 4; ++m) { kr[m] = krv[m]; ss += kr[m] * kr[m]; }
#pragma unroll
              for (int e = 0; e < 8; ++e) ss += kn[e] * kn[e];
              const float rn = 1.0f / sqrtf(sum8(ss) * (1.f / 96.f) + EPS);
#pragma unroll
              for (int e = 0; e < 8; ++e) kn[e] *= rn * kgn[e];
#pragma unroll
              for (int m = 0; m < 4; ++m) kr[m] *= rn * kgr[m];
              { const float x0 = kr[0], x1 = kr[1], y0 = kr[2], y1 = kr[3]; kr[0] = x0 * cr - x1 * sr; kr[1] = x1 * cr + x0 * sr; kr[2] = y0 * cc - y1 * sc; kr[3] = y1 * cc + y0 * sc; }
              bf16* ko = KB + ((size_t)(b * 8 + hh) * KPOS + pos) * 96;
              *(u32x4*)(ko + 8 * sub) = pack8(kn);
#pragma unroll
              for (int m = 0; m < 4; ++m) ko[64 + sub + 8 * m] = f2bf(kr[m]); }
            { float vv[8]; unpack8(*(const u32x4*)(kvrow + hh * 128 + 64 + 8 * sub), vv);
#pragma unroll
              for (int e = 0; e < 8; ++e) VL[(hh * 64 + 8 * sub + e) * 64 + pl] = f2bf(vv[e] * rskv); }
        }
        __syncthreads();
        { const int hd = C.tid;
            bf16* dst = VT + ((size_t)(b * 8 + (hd >> 6)) * 64 + (hd & 63)) * KPOS + pos0;
#pragma unroll
            for (int q = 0; q < 8; ++q) *(u32x4*)(dst + 8 * q) = *(const LAS u32x4*)(VL + hd * 64 + 8 * q); }
        __syncthreads();
    }
}

DI void conv_unit(const Ctx& C, int u, const bf16* U, const float (&wk)[31], float bias, const float* lng, const float* lnb, bf16* OCAT) {
    LAS float* G = (LAS float*)C.lds;
    const int c = C.tid;
    const int row0 = 32 * u; int base, t0, tseq;
    if (row0 < NLAT) { base = row0 & ~4095; t0 = row0 & 4095; tseq = TL; } else { const int rc = row0 - NLAT; base = NLAT + (rc & ~255); t0 = rc & 255; tseq = LCX; }
    __syncthreads();
    for (int rr = C.wave; rr < 62; rr += 8) { const int tt = t0 - 15 + rr; float g[8];
#pragma unroll
        for (int e = 0; e < 8; ++e) g[e] = 0.f;
        if (tt >= 0 && tt < tseq) { const bf16* ur = U + (size_t)(base + tt) * EV_INP; float av[8], gv[8]; unpack8(*(const u32x4*)(ur + 672 + 8 * C.lane), av); unpack8(*(const u32x4*)(ur + 1184 + 8 * C.lane), gv);
#pragma unroll
            for (int e = 0; e < 8; ++e) g[e] = av[e] * sigmoidf_(gv[e]); }
        *(LAS f32x4*)(G + rr * 512 + 8 * C.lane) = (f32x4){g[0], g[1], g[2], g[3]}; *(LAS f32x4*)(G + rr * 512 + 8 * C.lane + 4) = (f32x4){g[4], g[5], g[6], g[7]}; }
    __syncthreads();
    float acc[32];
#pragma unroll
    for (int t = 0; t < 32; ++t) acc[t] = bias;
#pragma unroll
    for (int rr = 0; rr < 62; ++rr) { const float gv = G[rr * 512 + c];
#pragma unroll
        for (int t = 0; t < 32; ++t) { const int k = rr - t; if (k >= 0 && k < 31) acc[t] += gv * wk[k]; } }
    __syncthreads();
#pragma unroll
    for (int t = 0; t < 32; ++t) G[t * 512 + c] = acc[t];
    __syncthreads();
#pragma unroll
    for (int q = 0; q < 4; ++q) {
        const int t = 4 * C.wave + q, row = row0 + t;
        const f32x4 a0 = *(const LAS f32x4*)(G + t * 512 + 8 * C.lane), a1 = *(const LAS f32x4*)(G + t * 512 + 8 * C.lane + 4);
        float x[8] = {a0.x, a0.y, a0.z, a0.w, a1.x, a1.y, a1.z, a1.w}; float s = 0.f;
#pragma unroll
        for (int e = 0; e < 8; ++e) s += x[e];
        const float mu = wave_sum(s) * (1.f / 512.f); float s2 = 0.f;
#pragma unroll
        for (int e = 0; e < 8; ++e) { x[e] -= mu; s2 += x[e] * x[e]; }
        const float rstd = 1.0f / sqrtf(wave_sum(s2) * (1.f / 512.f) + EPS);
        float y[8];
#pragma unroll
        for (int e = 0; e < 8; ++e) { const float z = x[e] * rstd * lng[8 * C.lane + e] + lnb[8 * C.lane + e]; y[e] = siluf_(z); }
        *(u32x4*)(OCAT + (size_t)row * DM + 512 + 8 * C.lane) = pack8(y);
    }
    __syncthreads();
}
DI void wprep_span(const Ctx& C, int first, int stride, const float* w1, const float* w3, const float* w2, bf16* W13, bf16* W2) {
    LAS float* scr = (LAS float*)(C.lds + C.wave * 16640);
    constexpr int PER = 16 * 16, NIT = NEXP * 3 * PER;
    for (int it = first; it < NIT; it += stride) {
        const int e = it / (3 * PER), r = it % (3 * PER), which = r / PER, q = r % PER, kb = q / 16, n0 = (q % 16) * 64;
#if MOE_F8
        if (which == 0)      transpose_item64_f8(w1 + (size_t)e * DM * DM, DM, DM, (unsigned char*)W13 + (size_t)e * 2048 * DM, (n0 >> 7) * 256 + (n0 & 127), scr, kb * 64, n0, C.lane);
        else if (which == 1) transpose_item64_f8(w3 + (size_t)e * DM * DM, DM, DM, (unsigned char*)W13 + (size_t)e * 2048 * DM, (n0 >> 7) * 256 + (n0 & 127) + 128, scr, kb * 64, n0, C.lane);
        else                 transpose_item64_f8(w2 + (size_t)e * DM * DM, DM, DM, (unsigned char*)W2 + (size_t)e * DM * DM, n0, scr, kb * 64, n0, C.lane); }
#else
        if (which == 0)      transpose_item64(w1 + (size_t)e * DM * DM, DM, DM, W13 + (size_t)e * 2048 * DM, (n0 >> 7) * 256 + (n0 & 127), scr, kb * 64, n0, C.lane);
        else if (which == 1) transpose_item64(w3 + (size_t)e * DM * DM, DM, DM, W13 + (size_t)e * 2048 * DM, (n0 >> 7) * 256 + (n0 & 127) + 128, scr, kb * 64, n0, C.lane);
        else                 transpose_item64(w2 + (size_t)e * DM * DM, DM, DM, W2 + (size_t)e * DM * DM, n0, scr, kb * 64, n0, C.lane); }
#endif
}
constexpr int WPREP_PER_WAVE = (NEXP * 3 * 256 + 2047) / 2048;

DI void shifted8(const bf16* up, const bf16* uc, const bf16* un, bool hp, bool hn, const float (&s0)[8], const float (&s1)[8], const float (&s2)[8], int c0, float (&o)[8]) {
    const u32x4 z = {0u, 0u, 0u, 0u};
    const u32x4 vp = hp ? *(const u32x4*)(up + c0) : z, vc = *(const u32x4*)(uc + c0), vn = hn ? *(const u32x4*)(un + c0) : z;
    float p[8], c[8], n[8]; unpack8(vp, p); unpack8(vc, c); unpack8(vn, n);
#pragma unroll
    for (int e = 0; e < 8; ++e) o[e] = p[e] * s0[e] + c[e] * s1[e] + n[e] * s2[e];
}
DI void load_sw(const float* sw, int c0, float (&s0)[8], float (&s1)[8], float (&s2)[8]) {
#pragma unroll
    for (int e = 0; e < 8; ++e) { s0[e] = sw[c0 + e]; s1[e] = sw[RW_IN + c0 + e]; s2[e] = sw[2 * RW_IN + c0 + e]; }
}
DI void ph_prep(const Ctx& C, const bf16* U, const float* sw  , const float* kkw  , const float* naqg, const float* nakg,
                bf16* R, bf16* V, bf16* K, bf16* KK, bf16* L, bf16* QN, bf16* KN, bf16* VTN) {
    LAS bf16* VL = (LAS bf16*)C.lds;
    const int lane = C.lane, hh = lane >> 3, sub = lane & 7;
    const float C2 = 0.125f * LOG2E;
    for (int u = C.vcu; u < MT / 32; u += C.nb) {
        const int row0 = 32 * u; const bool lat = row0 < NLAT;
        const int b = lat ? (row0 >> 12) : ((row0 - NLAT) >> 8), pos0 = lat ? (row0 & 4095) : TL + ((row0 - NLAT) & 255), tseq = lat ? TL : LCX, tb = lat ? (row0 & 4095) : ((row0 - NLAT) & 255);
#define PREP_ROWVARS(i) const int pl = 4 * C.wave + (i), row = row0 + pl, t = tb + pl; const bool hp = t > 0, hn = t < tseq - 1; \
            const bf16* uc = U + (size_t)row * OD_INP; const bf16* up = uc - OD_INP; const bf16* un = uc + OD_INP
        { float s0[8], s1[8], s2[8]; load_sw(sw, 8 * lane, s0, s1, s2);
          for (int i = 0; i < 4; ++i) { PREP_ROWVARS(i); float o[8]; shifted8(up, uc, un, hp, hn, s0, s1, s2, 8 * lane, o); *(u32x4*)(R + (size_t)row * 512 + 8 * lane) = pack8(o); } }
        { float s0[8], s1[8], s2[8]; load_sw(sw, 1024 + 8 * lane, s0, s1, s2);
          for (int i = 0; i < 4; ++i) { PREP_ROWVARS(i); float o[8]; shifted8(up, uc, un, hp, hn, s0, s1, s2, 1024 + 8 * lane, o); *(u32x4*)(V + (size_t)row * 512 + 8 * lane) = pack8(o); } }
        { float s0[8], s1[8], s2[8]; load_sw(sw, 512 + 8 * lane, s0, s1, s2); float kw[8];
#pragma unroll
          for (int e = 0; e < 8; ++e) kw[e] = kkw[8 * lane + e];
          for (int i = 0; i < 4; ++i) { PREP_ROWVARS(i); float o[8]; shifted8(up, uc, un, hp, hn, s0, s1, s2, 512 + 8 * lane, o); *(u32x4*)(K + (size_t)row * 512 + 8 * lane) = pack8(o);
              float kk[8]; float ss = 0.f;
#pragma unroll
              for (int e = 0; e < 8; ++e) { kk[e] = o[e] * kw[e]; ss += kk[e] * kk[e]; }
              ss = sum8(ss); const float rn = 1.0f / sqrtf(ss + 1e-12f);
#pragma unroll
              for (int e = 0; e < 8; ++e) kk[e] *= rn;
              *(u32x4*)(KK + (size_t)row * 512 + 8 * lane) = pack8(kk); } }
        if (lane < 48) { float s0[8], s1[8], s2[8]; load_sw(sw, 1536 + 8 * lane, s0, s1, s2);
          for (int i = 0; i < 4; ++i) { PREP_ROWVARS(i); float o[8]; shifted8(up, uc, un, hp, hn, s0, s1, s2, 1536 + 8 * lane, o);
              if (lane < 16) {
#pragma unroll
                  for (int e = 0; e < 8; ++e) { const float ex = __expf(2.f * o[e]); o[e] = 1.f - 2.f * __builtin_amdgcn_rcpf(ex + 1.f); }
              } else if (lane >= 32) {
#pragma unroll
                  for (int e = 0; e < 8; ++e) o[e] = sigmoidf_(o[e]);
              }
              *(u32x4*)(L + (size_t)row * 384 + 8 * lane) = pack8(o); } }
        { float gq[8], gk[8];
#pragma unroll
          for (int e = 0; e < 8; ++e) { gq[e] = naqg[8 * sub + e] * C2; gk[e] = nakg[8 * sub + e]; }
          for (int i = 0; i < 4; ++i) { const int pl = 4 * C.wave + i, row = row0 + pl, pos = pos0 + pl; const bf16* uc = U + (size_t)row * OD_INP;
            { float x[8]; unpack8(*(const u32x4*)(uc + RW_IN + 8 * lane), x); float ss = 0.f;
#pragma unroll
                for (int e = 0; e < 8; ++e) ss += x[e] * x[e];
                ss = sum8(ss); const float rn = 1.0f / sqrtf(ss * (1.f / 64.f) + EPS);
#pragma unroll
                for (int e = 0; e < 8; ++e) x[e] = x[e] * rn * gq[e];
                *(u32x4*)(QN + ((size_t)(b * 8 + hh) * KPOS + pos) * 64 + 8 * sub) = pack8(x); }
            { float x[8]; unpack8(*(const u32x4*)(uc + RW_IN + 512 + 8 * lane), x); float ss = 0.f;
#pragma unroll
                for (int e = 0; e < 8; ++e) ss += x[e] * x[e];
                ss = sum8(ss); const float rn = 1.0f / sqrtf(ss * (1.f / 64.f) + EPS);
#pragma unroll
                for (int e = 0; e < 8; ++e) x[e] = x[e] * rn * gk[e];
                *(u32x4*)(KN + ((size_t)(b * 8 + hh) * KPOS + pos) * 64 + 8 * sub) = pack8(x); }
            { const u32x4 vv = *(const u32x4*)(uc + RW_IN + 1024 + 8 * lane); const unsigned w4[4] = {vv.x, vv.y, vv.z, vv.w};
#pragma unroll
                for (int e = 0; e < 8; ++e) { const int dv = 8 * sub + e; VL[(hh * 64 + dv) * 32 + pl] = (bf16)((e & 1) ? (w4[e >> 1] >> 16) : (w4[e >> 1] & 0xffffu)); } } } }
#undef PREP_ROWVARS
        __syncthreads();
        { const int hd = C.tid; bf16* dst = VTN + ((size_t)(b * 8 + (hd >> 6)) * 64 + (hd & 63)) * KPOS + pos0;
#pragma unroll
            for (int q = 0; q < 4; ++q) *(u32x4*)(dst + 8 * q) = *(const LAS u32x4*)(VL + hd * 32 + 8 * q); }
        __syncthreads();
    }
}

DI int scan_row(int s, int d, int b) { if (s < LCX) return NLAT + b * LCX + (d ? (LCX - 1 - s) : s); const int t = s - LCX; return b * TL + (d ? (TL - 1 - t) : t); }


constexpr int CCH = 16, NCHK = KPOS / CCH, NPROB = NB * 8 * 2 * NCHK, IMG_ELEMS = 3 * 32 * 16;
template <int N> struct ICk { static constexpr int value = N; };
DI int crow_(int reg, int h) { return (reg & 3) + 8 * (reg >> 2) + 4 * h; }
DI bf16x8 pack_lo8(const f32x16& x) {
    u32x4 p; p.x = pk2(x[0], x[1]); p.y = pk2(x[2], x[3]); p.z = pk2(x[4], x[5]); p.w = pk2(x[6], x[7]); return __builtin_bit_cast(bf16x8, p); }
DI bf16x8 pack_hi8(const f32x16& x) { u32x4 p; p.x = pk2(x[8], x[9]); p.y = pk2(x[10], x[11]); p.z = pk2(x[12], x[13]); p.w = pk2(x[14], x[15]); return __builtin_bit_cast(bf16x8, p); }
DI int perm16(int k) { return (k & ~15) | swap23(k & 15); }

DI void ph_wkv_pre(const Ctx& C, const bf16* R, const bf16* K, const bf16* KK, const unsigned short* LW, const bf16* AR_, const float* ka, bf16* IMG) {
    LAS unsigned char* wl = C.lds + C.wave * 13312;
    LAS bf16* ARl = (LAS bf16*)wl; LAS bf16* BKl = (LAS bf16*)(wl + 4608); LAS float* Ll = (LAS float*)(wl + 9216); LAS bf16* OUT = (LAS bf16*)(wl + 10240);
    const int lane = C.lane, r = lane & 31, h = lane >> 5;
    const int gw = C.vcu * 8 + C.wave, ngw = C.nb * 8;
    for (int p = gw; p < NPROB; p += ngw) {
        const int j = p % NCHK, rest = p / NCHK, d = rest & 1, hh = (rest >> 1) & 7, b = rest >> 4;
        const unsigned short* Wd = LW + (size_t)d * MT * 512; const bf16* Ad = AR_ + (size_t)d * MT * 512;
        const float kav = ka[hh * 64 + lane];
        const int row0 = scan_row(j * CCH, d, b), sg = d ? -1 : 1;
        float lw[16]; bf16 rr[16], kx[16], kkx[16], ax[16];
#pragma unroll
        for (int t = 0; t < 16; ++t) { const size_t off = (size_t)(row0 + sg * t) * 512 + hh * 64 + lane; lw[t] = h2f(Wd[off]); rr[t] = R[off]; kx[t] = K[off]; kkx[t] = KK[off]; ax[t] = Ad[off]; }
        float cum = 0.f, e0 = 1.f;
#pragma unroll
        for (int t = 0; t < 16; ++t) {
            cum += lw[t]; const float e1 = __expf(cum), ei = __builtin_amdgcn_rcpf(e1);
            const float kkv = bf2f(kkx[t]), av = bf2f(ax[t]), keff = bf2f(kx[t]) * (1.f + (av - 1.f) * kav);
            ARl[t * 72 + lane] = f2bf(-kkv * e0); ARl[(16 + t) * 72 + lane] = f2bf(bf2f(rr[t]) * e1);
            BKl[t * 72 + lane] = f2bf(kkv * av * ei); BKl[(16 + t) * 72 + lane] = f2bf(keff * ei);
            e0 = e1;
        }
        asm volatile("s_waitcnt lgkmcnt(0)" ::: "memory");
        f32x16 g;
#pragma unroll
        for (int i = 0; i < 16; ++i) g[i] = 0.f;
#pragma unroll
        for (int q = 0; q < 4; ++q) g = MFMA32(*(const LAS bf16x8*)(ARl + r * 72 + 16 * q + 8 * h), *(const LAS bf16x8*)(BKl + r * 72 + 16 * q + 8 * h), g);
        const int sI = r & 15; const bool isk = r >= 16;
#pragma unroll
        for (int i = 0; i < 16; ++i) {
            const int row = crow_(i, h), t = row & 15; const bool keep = (i < 8) ? (sI < t) : (sI <= t); const float val = keep ? g[i] : 0.f;
            if (i < 8) { if (!isk) { Ll[t * 16 + sI] = val; OUT[512 + row * 16 + perm16(sI)] = 0; } else OUT[row * 16 + sI] = f2bf(val); }
            else       { if (!isk) OUT[512 + row * 16 + perm16(sI)] = f2bf(val); else OUT[row * 16 + sI] = f2bf(val); }
        }
        asm volatile("s_waitcnt lgkmcnt(0)" ::: "memory");
        { const int c = lane & 15; float Pr[16];
            Pr[0] = (c == 0) ? 1.f : 0.f;
#pragma unroll
            for (int t = 1; t < 16; ++t) { const float lrow = Ll[t * 16 + c]; float acc = (c == t) ? 1.f : 0.f;
#pragma unroll
                for (int u = 0; u < t; ++u) acc += rdlane(lrow, u) * Pr[u];
                Pr[t] = acc; }
            if (lane < 16) {
#pragma unroll
                for (int t = 0; t < 16; ++t) { OUT[1024 + t * 16 + perm16(c)] = f2bf(Pr[t]); OUT[1024 + (16 + t) * 16 + c] = 0; } } }
        asm volatile("s_waitcnt lgkmcnt(0)" ::: "memory");
        { bf16* dst = IMG + (size_t)p * IMG_ELEMS;
#pragma unroll
            for (int q = 0; q < 3; ++q) *(u32x4*)(dst + (q * 64 + lane) * 8) = *(const LAS u32x4*)(OUT + (q * 64 + lane) * 8); }
        asm volatile("s_waitcnt lgkmcnt(0)" ::: "memory");
    }
}

DI void ph_wkv_chunk(const Ctx& C, const bf16* R, const bf16* V, const bf16* K, const bf16* KK, const unsigned short* LW, const bf16* AR_, const float* ka, const bf16* IMG, bf16* YS) {
    constexpr int S_AR = 0, S_BKT = 4608, S_VT = 9728, S_VT2 = 11264, S_GC = 12800, S_MM = 13056, S_MRB = 14592, S_PP = 16128, SLOT = 17664, CUMO = 2 * SLOT, YSTO = CUMO + 8192, DEPTH = 4;
    const int lane = C.lane, wv = C.wave, r = lane & 31, h = lane >> 5;
    const bool isE = wv == 2 || wv == 3 || wv == 6 || wv == 7, isS = wv < 2;
    const int te = (wv == 2 ? 0 : (wv == 3 ? 1 : (wv == 6 ? 2 : 3))) * 64 + lane, et = te >> 4, ekq = te & 15;
    const int vhf = te >> 7, vt = (te >> 3) & 15, viq = te & 7;
    const int hf = wv & 1;
    for (int cid0 = C.bid; cid0 < 128; cid0 += C.nb) {
        const int chain = cid0, b = chain >> 4, hh = (chain >> 1) & 7, d = chain & 1;
        const unsigned short* Wd = LW + (size_t)d * MT * 512; const bf16* Ad = AR_ + (size_t)d * MT * 512; bf16* Yd = YS + (size_t)d * MT * 512;
        const bf16* img = IMG + (size_t)(((b * 8 + hh) * 2 + d) * NCHK) * IMG_ELEMS;
        f32x16 ST[2];
#pragma unroll
        for (int i = 0; i < 16; ++i) { ST[0][i] = 0.f; ST[1][i] = 0.f; }
        const f32x4 kav = *(const f32x4*)(ka + hh * 64 + 4 * ekq);
        unsigned ring[DEPTH][16];
        __syncthreads();
        auto issue = [&](int ch, unsigned (&rg)[16]) __attribute__((always_inline)) {
            if (ch < 0 || ch >= NCHK) return;
            const int row0 = scan_row(ch * CCH, d, b), sg = d ? -1 : 1;
            if (isE) {
                const size_t off = (size_t)(row0 + sg * et) * 512 + hh * 64 + 4 * ekq;
                const u32x2 x0 = *(const u32x2*)(R + off), x1 = *(const u32x2*)(K + off), x2 = *(const u32x2*)(KK + off), x3 = *(const u32x2*)(Ad + off);
                const u32x2 x4 = *(const u32x2*)(V + (size_t)(row0 + sg * vt) * 512 + hh * 64 + 32 * vhf + 4 * viq);
                rg[0] = x0.x; rg[1] = x0.y; rg[2] = x1.x; rg[3] = x1.y; rg[4] = x2.x; rg[5] = x2.y; rg[6] = x3.x; rg[7] = x3.y; rg[8] = x4.x; rg[9] = x4.y;
                asm volatile("; wkv issue role E" ::);
            } else if (wv == 4) {
#define W5_(t) rg[(t)] = (unsigned)Wd[(size_t)(row0 + sg * (t)) * 512 + hh * 64 + lane]
                W5_(0); W5_(1); W5_(2); W5_(3); W5_(4); W5_(5); W5_(6); W5_(7); W5_(8); W5_(9); W5_(10); W5_(11); W5_(12); W5_(13); W5_(14); W5_(15);
#undef W5_
                asm volatile("; wkv issue role C" ::);
            } else if (wv == 5) {
#define W6_(q) do { const u32x4 x = *(const u32x4*)(img + (size_t)ch * IMG_ELEMS + ((q) * 64 + lane) * 8); rg[4 * (q)] = x.x; rg[4 * (q) + 1] = x.y; rg[4 * (q) + 2] = x.z; rg[4 * (q) + 3] = x.w; } while (0)
                W6_(0); W6_(1); W6_(2);
#undef W6_
                asm volatile("; wkv issue role V" ::);
            }
        };
        issue(0, ring[0]); issue(1, ring[1]); issue(2, ring[2]); issue(3, ring[3]);
#define WKV_BAR() asm volatile("s_waitcnt lgkmcnt(0)\n\ts_barrier" ::: "memory")
#define WKV_LOOP(...) for (int n0 = -2; n0 < NCHK; n0 += DEPTH) { auto iter = [&](auto kc) __attribute__((always_inline)) { constexpr int kk = decltype(kc)::value; \
            constexpr int riE = (kk + 3) % DEPTH, riW = kk % DEPTH; (void)riE; (void)riW; const int n = n0 + kk; (void)n; __VA_ARGS__; WKV_BAR(); }; iter(ICk<0>{}); iter(ICk<1>{}); iter(ICk<2>{}); iter(ICk<3>{}); }
        if (isS) {
            WKV_LOOP({
                if (n >= 0 && n < NCHK) {
                    const LAS unsigned char* B = C.lds + (n & 1) * SLOT;
                    f32x16 T1;
                    _Pragma("unroll") for (int i = 0; i < 16; ++i) T1[i] = 0.f;
                    _Pragma("unroll") for (int tau = 0; tau < 2; ++tau) {
                        T1 = MFMA32(*(const LAS bf16x8*)(B + S_AR + r * 144 + (32 * tau + 8 * h) * 2), pack_lo8(ST[tau]), T1);
                        T1 = MFMA32(*(const LAS bf16x8*)(B + S_AR + r * 144 + (32 * tau + 16 + 8 * h) * 2), pack_hi8(ST[tau]), T1);
                    }
                    const bf16x8 vtf = *(const LAS bf16x8*)(B + (hf ? S_VT2 : S_VT) + r * 48 + 16 * h);
                    T1 = MFMA32(*(const LAS bf16x8*)(B + S_MM + r * 48 + 16 * h), vtf, T1);
                    f32x16 ET;
                    _Pragma("unroll") for (int i = 0; i < 16; ++i) ET[i] = 0.f;
                    ET = MFMA32(*(const LAS bf16x8*)(B + S_PP + r * 48 + 16 * h), pack_lo8(T1), ET);
                    const bf16x8 ef = pack_lo8(ET);
                    T1 = MFMA32(*(const LAS bf16x8*)(B + S_MRB + r * 48 + 16 * h), ef, T1);
                    _Pragma("unroll") for (int tau = 0; tau < 2; ++tau) {
                        ST[tau] = MFMA32(*(const LAS bf16x8*)(B + S_BKT + (32 * tau + r) * 80 + 16 * h), ef, ST[tau]);
                        ST[tau] = MFMA32(*(const LAS bf16x8*)(B + S_BKT + (32 * tau + r) * 80 + 32 + 16 * h), vtf, ST[tau]);
                        _Pragma("unroll") for (int g4 = 0; g4 < 4; ++g4) { const f32x4 gc = *(const LAS f32x4*)(B + S_GC + (32 * tau + 8 * g4 + 4 * h) * 4);
                            ST[tau][4 * g4] *= gc.x; ST[tau][4 * g4 + 1] *= gc.y; ST[tau][4 * g4 + 2] *= gc.z; ST[tau][4 * g4 + 3] *= gc.w; }
                    }
                    LAS float* ys = (LAS float*)(C.lds + YSTO) + ((n & 1) * 2 + hf) * 512;
                    _Pragma("unroll") for (int q = 0; q < 8; ++q) ys[(8 * (q >> 2) + 4 * h + (q & 3)) * 32 + r] = T1[8 + q];
                }
            });
        } else if (isE) {
            WKV_LOOP({
                const int ch = n + 1;
                if (ch >= 0) {
                    if (ch < NCHK) {
                        LAS unsigned char* B = C.lds + (ch & 1) * SLOT; const LAS float* ec = (const LAS float*)(C.lds + CUMO) + (ch & 1) * 1024;
                        const f32x4 e1 = *(const LAS f32x4*)(ec + et * 64 + 4 * ekq);
                        f32x4 e0 = {1.f, 1.f, 1.f, 1.f}; if (et > 0) e0 = *(const LAS f32x4*)(ec + (et - 1) * 64 + 4 * ekq);
                        const float rv[4] = {bflo(ring[riE][0]), bfhi(ring[riE][0]), bflo(ring[riE][1]), bfhi(ring[riE][1])}; const float kv[4] = {bflo(ring[riE][2]), bfhi(ring[riE][2]), bflo(ring[riE][3]), bfhi(ring[riE][3])};
                        const float kkv[4] = {bflo(ring[riE][4]), bfhi(ring[riE][4]), bflo(ring[riE][5]), bfhi(ring[riE][5])}; const float av[4] = {bflo(ring[riE][6]), bfhi(ring[riE][6]), bflo(ring[riE][7]), bfhi(ring[riE][7])};
                        float ah[4]; float rh[4]; float bc[4]; float kc4[4];
                        _Pragma("unroll") for (int e = 0; e < 4; ++e) { const float ei = __builtin_amdgcn_rcpf(e1[e]);
                            ah[e] = -kkv[e] * e0[e]; rh[e] = rv[e] * e1[e]; bc[e] = kkv[e] * av[e] * ei; kc4[e] = kv[e] * (1.f + (av[e] - 1.f) * kav[e]) * ei; }
                        const int pk = perm16(4 * ekq);
                        *(LAS u32x2*)((LAS bf16*)(B + S_AR) + et * 72 + pk) = (u32x2){pk2(ah[0], ah[1]), pk2(ah[2], ah[3])};
                        *(LAS u32x2*)((LAS bf16*)(B + S_AR) + (16 + et) * 72 + pk) = (u32x2){pk2(rh[0], rh[1]), pk2(rh[2], rh[3])};
                        const int pt = perm16(et);
                        _Pragma("unroll") for (int e = 0; e < 4; ++e) { ((LAS bf16*)(B + S_BKT))[(4 * ekq + e) * 40 + pt] = f2bf(bc[e]); ((LAS bf16*)(B + S_BKT))[(4 * ekq + e) * 40 + 16 + et] = f2bf(kc4[e]); }
                        if (et == 15) *(LAS f32x4*)((LAS float*)(B + S_GC) + 4 * ekq) = e1;
                        LAS bf16* vtp = (LAS bf16*)(B + (vhf ? S_VT2 : S_VT)) + (4 * viq) * 24 + vt;
                        vtp[0] = (bf16)(ring[riE][8] & 0xffffu); vtp[24] = (bf16)(ring[riE][8] >> 16); vtp[48] = (bf16)(ring[riE][9] & 0xffffu); vtp[72] = (bf16)(ring[riE][9] >> 16);
                    }
                    issue(ch + DEPTH, ring[riE]);
                }
            });
        } else if (wv == 4) {
            WKV_LOOP({
                const int ch = n + 2;
                if (ch < NCHK) { LAS float* ec = (LAS float*)(C.lds + CUMO) + (ch & 1) * 1024; float c = 0.f;
#define C5_(t) do { c += h2f((unsigned short)ring[riW][(t)]); ec[(t) * 64 + lane] = __expf(c); } while (0)
                    C5_(0); C5_(1); C5_(2); C5_(3); C5_(4); C5_(5); C5_(6); C5_(7); C5_(8); C5_(9); C5_(10); C5_(11); C5_(12); C5_(13); C5_(14); C5_(15);
                }
                issue(ch + DEPTH, ring[riW]);
            });
        } else {
            WKV_LOOP({
                { const int chy = n - 1;
                  if (chy >= 0 && chy < NCHK) { const int yh = lane >> 5, yt = (lane & 31) >> 1, yi = 16 * (lane & 1);
                    const LAS float* ys = (const LAS float*)(C.lds + YSTO) + ((chy & 1) * 2 + yh) * 512 + yt * 32 + yi;
                    bf16* dst = Yd + (size_t)(scan_row(chy * CCH, d, b) + (d ? -1 : 1) * yt) * 512 + hh * 64 + 32 * yh + yi;
                    _Pragma("unroll") for (int q = 0; q < 2; ++q) { const f32x4 a0 = *(const LAS f32x4*)(ys + 8 * q); const f32x4 a1 = *(const LAS f32x4*)(ys + 8 * q + 4);
                        *(u32x4*)(dst + 8 * q) = (u32x4){pk2(a0.x, a0.y), pk2(a0.z, a0.w), pk2(a1.x, a1.y), pk2(a1.z, a1.w)}; } } }
                const int ch = n + 1;
                if (ch >= 0) {
                    if (ch < NCHK) { LAS unsigned char* B = C.lds + (ch & 1) * SLOT;
                        const int irow = lane >> 1; const int ihv = lane & 1;
                        *(LAS u32x4*)(B + S_MM + irow * 48 + ihv * 16) = (u32x4){ring[riE][0], ring[riE][1], ring[riE][2], ring[riE][3]};
                        *(LAS u32x4*)(B + S_MRB + irow * 48 + ihv * 16) = (u32x4){ring[riE][4], ring[riE][5], ring[riE][6], ring[riE][7]};
                        *(LAS u32x4*)(B + S_PP + irow * 48 + ihv * 16) = (u32x4){ring[riE][8], ring[riE][9], ring[riE][10], ring[riE][11]};
                    }
                    issue(ch + DEPTH, ring[riE]);
                }
            });
        }
#undef C5_
#undef WKV_LOOP
#undef WKV_BAR
    }
}

DI void ph_post(const Ctx& C, const bf16* YS, const bf16* R, const bf16* V, const bf16* K, const bf16* A2, const float* ka, const bf16* G, const float* rk, const float* gng, const float* gnb, bf16* OCAT, bool last) {
    const int gw = C.bid * 8 + C.wave, ngw = C.nb * 8, lane = C.lane, nrows = last ? NLAT : MT;
    for (int row = gw; row < nrows; row += ngw) {
        const size_t o = (size_t)row * 512 + 8 * lane;
        float y[8], y1[8]; unpack8(*(const u32x4*)(YS + o), y); unpack8(*(const u32x4*)(YS + (size_t)MT * 512 + o), y1);
#pragma unroll
        for (int e = 0; e < 8; ++e) y[e] += y1[e];
        float r[8], v[8], kx[8], a0[8], a1[8], g[8];
        unpack8(*(const u32x4*)(R + o), r); unpack8(*(const u32x4*)(V + o), v); unpack8(*(const u32x4*)(K + o), kx); unpack8(*(const u32x4*)(A2 + o), a0); unpack8(*(const u32x4*)(A2 + (size_t)MT * 512 + o), a1); unpack8(*(const u32x4*)(G + o), g);
        float bsum = 0.f;
#pragma unroll
        for (int e = 0; e < 8; ++e) { const float kae = ka[8 * lane + e]; bsum += r[e] * (kx[e] * (1.f + (a0[e] - 1.f) * kae) + kx[e] * (1.f + (a1[e] - 1.f) * kae)) * rk[8 * lane + e]; }
        bsum = sum8(bsum);
        float s = 0.f;
#pragma unroll
        for (int e = 0; e < 8; ++e) { y[e] += bsum * v[e]; s += y[e]; }
        const float mu = sum8(s) * (1.f / 64.f); float s2 = 0.f;
#pragma unroll
        for (int e = 0; e < 8; ++e) { y[e] -= mu; s2 += y[e] * y[e]; }
        const float rstd = 1.0f / sqrtf(sum8(s2) * (1.f / 64.f) + GN_EPS);
        float out[8];
#pragma unroll
        for (int e = 0; e < 8; ++e) out[e] = (y[e] * rstd * gng[8 * lane + e] + gnb[8 * lane + e]) * g[e];
        *(u32x4*)(OCAT + (size_t)row * DM + 8 * lane) = pack8(out);
    }
}

DI void ph_topk2(const Ctx& C, const float* AFFT, const float* AFFC, int* ROWS, float* GATE, int* SLOT, bool last) {
    LAS unsigned* wcnt = (LAS unsigned*)C.lds;
    LAS unsigned* cnt = wcnt + 16;
    const int tid = C.tid, nprob = last ? 128 : 256;
    for (int p = C.bid; p < nprob; p += C.nb) {
        const bool isctx = p >= 128; const int be = p & 127, b = be >> 4, e = be & 15;
        const int n = isctx ? LCX : TL, cap = isctx ? CAPC : CAPL;
        const float* src = isctx ? AFFC + (size_t)be * LCX : AFFT + (size_t)be * TL;
        unsigned v[8]; const int per = isctx ? 1 : 8, t0 = tid * per;
#pragma unroll
        for (int q = 0; q < 8; ++q) v[q] = 0u;
        if (!isctx) { const u32x4 a0 = *(const u32x4*)(src + t0), a1 = *(const u32x4*)(src + t0 + 4); v[0] = a0.x; v[1] = a0.y; v[2] = a0.z; v[3] = a0.w; v[4] = a1.x; v[5] = a1.y; v[6] = a1.z; v[7] = a1.w; }
        else if (tid < LCX) v[0] = __builtin_bit_cast(unsigned, src[tid]);
        __syncthreads();
        unsigned T = 0u;
        for (int bit = 30; bit >= 0; --bit) {
            const unsigned cand = T | (1u << bit); unsigned c = 0u;
#pragma unroll
            for (int q = 0; q < 8; ++q) c += (unsigned)__builtin_popcountll(__builtin_amdgcn_ballot_w64(v[q] >= cand));
            LAS unsigned* wc = wcnt + (bit & 1) * 8;
            if (C.lane == 0) wc[C.wave] = c;
            __syncthreads();
            const unsigned tot = wc[0] + wc[1] + wc[2] + wc[3] + wc[4] + wc[5] + wc[6] + wc[7];
            if (tot >= (unsigned)cap) T = cand;
        }
        unsigned myc = 0u;
#pragma unroll
        for (int q = 0; q < 8; ++q) myc += (v[q] > T ? 0x10000u : 0u) + ((v[q] == T && (isctx ? (q == 0 && tid < LCX) : true)) ? 1u : 0u);
        __syncthreads();
        cnt[tid] = myc;
        __syncthreads();
        for (int off = 1; off < 512; off <<= 1) { const unsigned add = tid >= off ? cnt[tid - off] : 0u; __syncthreads(); cnt[tid] += add; __syncthreads(); }
        const unsigned total = cnt[511], keq = (unsigned)cap - (total >> 16);
        unsigned before = cnt[tid] - myc;
        for (int q = 0; q < per; ++q) { const int t = t0 + q; if (t >= n) break; const unsigned x = v[q]; const unsigned gtb = before >> 16, eqb = before & 0xFFFFu;
            const bool sel = x > T || (x == T && eqb < keq);
            if (sel) { const int jx = (int)(gtb + (eqb < keq ? eqb : keq));
                const int slot = isctx ? NB * CAPL + b * CAPC + jx : b * CAPL + jx, row = isctx ? NLAT + b * LCX + t : b * TL + t;
                ROWS[e * ESLOTS + slot] = row; GATE[e * ESLOTS + slot] = __builtin_bit_cast(float, x); SLOT[(size_t)row * 16 + e] = slot; }
            before += (x > T ? 0x10000u : 0u) + (x == T ? 1u : 0u); }
        __syncthreads();
    }
}


DI void ph_combine(const Ctx& C, float* xlat, float* xctx, const float* modg2  , const int* SLOT, const bf16* Y2, bool last,
                   const float* ngain  , const float* nmod  , bf16* H) {
    const int gw = C.bid * 8 + C.wave, ngw = C.nb * 8, lane = C.lane, nrows = last ? NLAT : MT;
    for (int row = gw; row < nrows; row += ngw) {
        float* xr = row < NLAT ? xlat + (size_t)row * DM : xctx + (size_t)(row - NLAT) * DM;
        const int mi = row < NLAT ? (row >> 12) : 8;
        const int sv = SLOT[(size_t)row * 16 + (lane & 15)];
        f32x4 acc[4];
#pragma unroll
        for (int j = 0; j < 4; ++j) acc[j] = (f32x4){0.f, 0.f, 0.f, 0.f};
#pragma unroll
        for (int e = 0; e < 16; ++e) {
            const int s = __builtin_amdgcn_readlane(sv, e);
            if (s >= 0) { const bf16* yp = Y2 + ((size_t)e * ESLOTS + s) * DM + 4 * lane;
#pragma unroll
                for (int j = 0; j < 4; ++j) { const u32x2 w = *(const u32x2*)(yp + 256 * j); acc[j] += (f32x4){bflo(w.x), bfhi(w.x), bflo(w.y), bfhi(w.y)}; } }
        }
#pragma unroll
        for (int j = 0; j < 4; ++j) { const int c = 256 * j + 4 * lane; const f32x4 g = *(const f32x4*)(modg2 + mi * 6144 + c); f32x4 x = *(const f32x4*)(xr + c); x += g * acc[j]; *(f32x4*)(xr + c) = x; acc[j] = x; }
        if (ngain) {
            float ss = 0.f;
#pragma unroll
            for (int j = 0; j < 4; ++j) ss += acc[j].x * acc[j].x + acc[j].y * acc[j].y + acc[j].z * acc[j].z + acc[j].w * acc[j].w;
            const float rs = 1.0f / sqrtf(wave_sum(ss) * (1.f / 1024.f) + EPS);
            const float* mp = nmod + mi * 6144;
#pragma unroll
            for (int j = 0; j < 4; ++j) { const int c = 256 * j + 4 * lane;
                const f32x4 g = *(const f32x4*)(ngain + c), sc = *(const f32x4*)(mp + 1024 + c), sh = *(const f32x4*)(mp + c);
                const f32x4 hv = (acc[j] * rs) * g * (sc + 1.0f) + sh;
                *(u32x2*)(H + (size_t)row * DM + c) = (u32x2){pk2(hv.x, hv.y), pk2(hv.z, hv.w)}; }
        }
    }
}

template <int N> struct IC { static constexpr int value = N; };
DI const float* in_ptr(const unsigned char* ws, int k) { const unsigned long long v = ((const unsigned long long*)(ws + 128 * 1024))[k];
    const unsigned lo = __builtin_amdgcn_readfirstlane((unsigned)v), hi = __builtin_amdgcn_readfirstlane((unsigned)(v >> 32));
    return (const float*)(__attribute__((address_space(1))) const float*)(((unsigned long long)hi << 32) | lo); }
template <class T> DI T* launder_ptr(T* p) { unsigned long long v = (unsigned long long)p; unsigned lo = (unsigned)v, hi = (unsigned)(v >> 32); asm volatile("" : "+v"(lo), "+v"(hi));
    lo = __builtin_amdgcn_readfirstlane(lo); hi = __builtin_amdgcn_readfirstlane(hi); return (T*)(__attribute__((address_space(1))) T*)(((unsigned long long)hi << 32) | lo); }
constexpr int N_PHASES = 1 + 23 + 22;
constexpr size_t WS_PTRS = 128 * 1024;
#define P_XC    ((float*)(ws + WS_XC))
#define P_MOD   ((const float*)(ws + WS_MOD))
#define P_HB    ((bf16*)(ws + WS_HB))
#define P_OCAT  ((bf16*)(ws + WS_OCAT))
#define P_AR    (ws + WS_ARENA)
#define P_ROWS  ((int*)(ws + WS_ROWS))
#define P_GATE  ((float*)(ws + WS_GATE))
#define P_SLOT  ((int*)(ws + WS_SLOT))
#define P_AFFT  ((float*)(ws + WS_AFFT))
#define P_AFFC  ((float*)(ws + WS_AFFC))
#define P_W13   ((bf16*)(ws + WS_W13))
#define P_W2    ((bf16*)(ws + WS_W2))
#define P_U     ((bf16*)(P_AR + A_U))
#define P_QPRE  ((float*)(P_AR + A_QPRE))
#define P_KVPRE ((float*)(P_AR + A_KVPRE))
#define P_QB    ((bf16*)(P_AR + A_QB))
#define P_KB    ((bf16*)(P_AR + A_KB))
#define P_VT    ((bf16*)(P_AR + A_VT))
#define P_W     ((unsigned short*)(P_AR + A_W))
#define P_KEFF  ((bf16*)(P_AR + A_KEFF))
#define P_R     ((bf16*)(P_AR + A_R))
#define P_V     ((bf16*)(P_AR + A_V))
#define P_KK    ((bf16*)(P_AR + A_KK))
#define P_G     ((bf16*)(P_AR + A_G))
#define P_K     ((bf16*)(P_AR + A_K))
#define P_L     ((bf16*)(P_AR + A_L))
#define P_QN    ((bf16*)(P_AR + A_QN))
#define P_KN    ((bf16*)(P_AR + A_KN))
#define P_VTN   ((bf16*)(P_AR + A_VTN))
#define P_YS    ((bf16*)(P_AR + A_YS))
#define P_IMG   ((bf16*)(P_AR + A_IMG))
#define P_HID   ((bf16*)(P_AR + A_HID))
#define P_Y2    ((bf16*)(P_AR + A_Y2))
#define MODL(i) (P_MOD + (size_t)(i) * 9 * 6144)
#if MOE_F8
#define MOE1_PHASE(NMT) do { pg8::Gemm g{P_HB, P_W13, DM / 2, DM / 2, P_ROWS, SCALE_W, SCALE_ONE}; pg8::OrderMoE S{(NMT), 8, 17, C.nb, C.vcu}; pg8::EpiAdapt<EpiGlu8> E{EpiGlu8{(unsigned char*)P_HID}}; \
        pg8::gemm_phase<pg8::EpiAdapt<EpiGlu8>, pg8::OrderMoE, true>(C.lds, g, S, E, C.tid); } while (0)
#define MOE2_PHASE(NMT) do { pg8::Gemm g{P_HID, P_W2, DM / 2, DM / 2, nullptr, SCALE_W, SCALE_HID}; pg8::OrderMoE S{(NMT), 4, 17, C.nb, C.vcu}; pg8::EpiAdapt<EpiGate> E{EpiGate{P_Y2, P_GATE}}; \
        pg8::gemm_phase<pg8::EpiAdapt<EpiGate>, pg8::OrderMoE, true>(C.lds, g, S, E, C.tid); } while (0)
#else
#define MOE1_PHASE(NMT) do { pg8::Gemm g{P_HB, P_W13, DM, DM, P_ROWS}; pg8::OrderMoE S{(NMT), 8, 17, C.nb, C.vcu}; pg8::EpiAdapt<EpiGlu> E{EpiGlu{P_HID}}; pg8::gemm_phase(C.lds, g, S, E, C.tid); } while (0)
#define MOE2_PHASE(NMT) do { pg8::Gemm g{P_HID, P_W2, DM, DM, nullptr}; pg8::OrderMoE S{(NMT), 4, 17, C.nb, C.vcu}; pg8::EpiAdapt<EpiGate> E{EpiGate{P_Y2, P_GATE}}; pg8::gemm_phase(C.lds, g, S, E, C.tid); } while (0)
#endif
#define WPREP_TAIL(NUNITS, LAYER) do { __syncthreads(); const int extra_ = (NUNITS) % C.nb, j_ = C.vcu - extra_; const size_t wo_ = (size_t)(LAYER) * NEXP * DM * DM; \
        if (j_ >= 0) wprep_span(C, j_ * 8 + C.wave, (C.nb - extra_) * 8, in_ptr(ws, I_MW1) + wo_, in_ptr(ws, I_MW3) + wo_, in_ptr(ws, I_MW2) + wo_, (bf16*)(ws + WS_W13), (bf16*)(ws + WS_W2)); } while (0)
#define RELAUNDER() do { int l_ = C.lane; asm volatile("" : "+v"(l_)); C.lane = l_; C.tid = (C.wave << 6) | l_; } while (0)
__global__ void __launch_bounds__(512, 2) fwd_kernel(Args a) {
    extern __shared__ __attribute__((aligned(16))) unsigned char smem[];
    Ctx C0; C0.lds = (LAS unsigned char*)smem; C0.tid = threadIdx.x; C0.lane = C0.tid & 63; C0.wave = __builtin_amdgcn_readfirstlane(C0.tid >> 6); C0.bid = blockIdx.x; C0.nb = gridDim.x;
    C0.vcu = (C0.nb % 8 == 0) ? (C0.bid % 8) * (C0.nb / 8) + C0.bid / 8 : C0.bid;
    volatile LAS unsigned* bst = (volatile LAS unsigned*)(C0.lds + LDS_BYTES - 16);
#if MEGA
    if (C0.tid == 0) { bst[0] = 0u; bst[1] = 0u; }
    __syncthreads();
    const unsigned bar_x = xcd_barrier_post((unsigned*)(a.ws + WS_CTL) + 4096, bst, C0.tid == 0).x;
#define SEAM() do { if (ph < hi) { XcdBarrier b2_; b2_.bar = (unsigned*)(ws + WS_CTL) + 4096; b2_.x = bar_x; b2_.st = bst; xcd_barrier(b2_, C.tid == 0); } } while (0)
#else
#define SEAM() do { } while (0)
#endif
#if MEGA
    constexpr int lo = 0, hi = N_PHASES;
#else
    const int lo = a.ph_lo, hi = a.ph_hi;
#endif
    int ph = 0;
#ifndef ONLY
#define ONLY -1
#endif
#ifndef REPMASK
#define REPMASK 0
#endif
#ifndef SITE_LO
#define SITE_LO 0
#define SITE_HI 99
#endif
#define PHASE(SITE, ...) do { if ((ONLY < 0 || ONLY == (SITE)) && (SITE) >= SITE_LO && (SITE) <= SITE_HI && ph >= lo && ph < hi) { Ctx C; C.lds = C0.lds; \
        { int w_ = C0.wave; asm volatile("" : "+s"(w_)); unsigned m_ = ~0u; asm volatile("" : "+s"(m_)); int l_ = (int)__builtin_amdgcn_mbcnt_hi(m_, __builtin_amdgcn_mbcnt_lo(m_, 0u)); C.wave = w_; C.lane = l_; C.tid = (w_ << 6) | l_; } \
        { int b_ = C0.bid, n_ = C0.nb, v_ = C0.vcu; asm volatile("" : "+s"(b_), "+s"(n_), "+s"(v_)); C.bid = b_; C.nb = n_; C.vcu = v_; } \
        unsigned z_ = 0u; asm volatile("" : "+s"(z_)); unsigned char* ws = a.ws + z_; float* XL = a.out + z_; const int lq = __builtin_amdgcn_readfirstlane(lp); typedef const __attribute__((address_space(1))) float* gfp_t; const gfp_t* INT_ = (const gfp_t*)(ws + WS_PTRS); (void)INT_; (void)XL; (void)lq; \
        for (int rep_ = 0; rep_ < ((((REPMASK) >> (SITE)) & 1) ? 2 : 1); ++rep_) { __VA_ARGS__; if ((((REPMASK) >> (SITE)) & 1)) __syncthreads(); } ++ph; SEAM(); } else ++ph; } while (0)

    { const int lp = 0;
      PHASE(0, { if (C.bid == 0) { _Pragma("unroll") for (int k = 0; k < 40; ++k) if (C.tid == k) ((const float**)(ws + WS_PTRS))[k] = a.in[k]; }
                 ph_prologue(C, a); }); }

    auto layer_pair = [&](auto lpc) __attribute__((always_inline)) {
        constexpr int lp = decltype(lpc)::value;
        if constexpr (lp == 0) PHASE(1, { const int i = 2 * lq; const float* xl = (i == 0) ? in_ptr(ws, I_X) : XL; const float* xc = (i == 0) ? in_ptr(ws, I_CTX) : P_XC;
                   ph_norm<false>(C, xl, xc, in_ptr(ws, I_N1G) + i * DM, MODL(i), 0, 1024, P_HB, nullptr, nullptr, nullptr, nullptr); });
        PHASE(2, { EpiBf16 E{P_U, EV_INP}; fast_gemm(C, P_HB, DM, (const bf16*)(ws + WS_WEVIN) + (size_t)lq * EV_INP * DM, DM, MT / 256, EV_INP / 256, E); });
        PHASE(3, { EpiBf16 Eq{(bf16*)P_QPRE, 768}; fast_gemm(C, P_U, EV_INP, (const bf16*)(ws + WS_WUQ) + (size_t)lq * 768 * 384, 384, MT / 256, 3, Eq); RELAUNDER();
                   EpiBf16 Ek{(bf16*)P_KVPRE, 1024}; fast_gemm(C, P_U + 384, EV_INP, (const bf16*)(ws + WS_WUKV) + (size_t)lq * 1024 * 256, 256, MT / 256, 4, Ek, true); });
        PHASE(4, { ph_mla_fin(C, P_U, (const bf16*)P_QPRE, (const bf16*)P_KVPRE, in_ptr(ws, I_QG) + lq * 96, in_ptr(ws, I_KG) + lq * 96, (const f32x2*)(ws + WS_ROPE), P_QB, P_KB, P_VT);
                   const int extra_ = (MT / 64) % C.nb, j_ = C.vcu - extra_;
                   if (j_ >= 0) { for (int q_ = 0; q_ < CONV_PER_TAIL; ++q_) { const int cu_ = j_ + q_ * (C.nb - extra_); if (cu_ >= conv_in_fin(C.nb)) break;
                       float wk[31]; const float* dww = in_ptr(ws, I_DWW) + (size_t)lq * 31 * 512;
                       _Pragma("unroll") for (int kt = 0; kt < 31; ++kt) wk[kt] = dww[kt * 512 + C.tid];
                       conv_unit(C, cu_, P_U, wk, in_ptr(ws, I_DWB)[lq * 512 + C.tid], in_ptr(ws, I_LNG) + lq * 512, in_ptr(ws, I_LNB) + lq * 512, P_OCAT); } } });
        PHASE(5, ph_attn_mla2(C, P_QB, P_KB, P_VT, P_OCAT, false, ws, lq));
        PHASE(6, { const int i = 2 * lq; const float* xl = (i == 0) ? in_ptr(ws, I_X) : XL; const float* xc = (i == 0) ? in_ptr(ws, I_CTX) : P_XC;
                   { EpiResid E{xl, xc, XL, P_XC, MODL(i) + 2048}; fast_gemm(C, P_OCAT, DM, (const bf16*)(ws + WS_WEVOUT) + (size_t)lq * DM * DM, DM, MT / 256, 4, E); }
                   WPREP_TAIL(MT / 256 * 4, i); });
        PHASE(7, { const int i = 2 * lq; ph_norm<true>(C, XL, P_XC, in_ptr(ws, I_N2G) + i * DM, MODL(i), 3072, 4096, P_HB, in_ptr(ws, I_ROUTER) + (size_t)i * DM * 16, P_AFFT, P_AFFC, P_SLOT); });
        PHASE(8, ph_topk2(C, P_AFFT, P_AFFC, P_ROWS, P_GATE, P_SLOT, false));
        PHASE(9, { MOE1_PHASE(17); });
        PHASE(10, { MOE2_PHASE(17); });
        PHASE(11, { const int i = 2 * lq; ph_combine(C, XL, P_XC, MODL(i) + 5120, P_SLOT, P_Y2, false, in_ptr(ws, I_N1G) + (i + 1) * DM, MODL(i + 1), P_HB); });
        PHASE(13, { EpiBf16 E{P_U, OD_INP}; fast_gemm(C, P_HB, DM, (const bf16*)(ws + WS_WODIN) + (size_t)lq * OD_INP * DM, DM, MT / 256, OD_INP / 256, E); });
        PHASE(14, ph_prep(C, P_U, in_ptr(ws, I_SHIFTW) + (size_t)lq * 3 * RW_IN, in_ptr(ws, I_KKW) + lq * 512, in_ptr(ws, I_NAQG) + lq * 64, in_ptr(ws, I_NAKG) + lq * 64, P_R, P_V, P_K, P_KK, P_L, P_QN, P_KN, P_VTN));
        PHASE(15, { const bf16* WL = (const bf16*)(ws + WS_WLORA) + (size_t)lq * 655360;
                    { EpiLoraW E{P_W, in_ptr(ws, I_W0) + lq * 1024}; fast_gemm(C, P_L, 384, WL, 256, MT / 256, 4, E); } RELAUNDER();
                    { EpiLoraA E{P_KEFF, in_ptr(ws, I_A0) + lq * 1024}; fast_gemm(C, P_L, 384, WL + (size_t)1024 * 256, 256, MT / 256, 4, E, true); } RELAUNDER();
                    { EpiBf16 E{P_G, 512}; fast_gemm(C, P_L + 128, 384, WL + (size_t)2048 * 256, 256, MT / 256, 2, E); } });
        PHASE(16, ph_wkv_pre(C, P_R, P_K, P_KK, P_W, P_KEFF, in_ptr(ws, I_KA) + lq * 512, P_IMG));
        PHASE(17, { ph_wkv_chunk(C, P_R, P_V, P_K, P_KK, P_W, P_KEFF, in_ptr(ws, I_KA) + lq * 512, P_IMG, P_YS); __syncthreads();
                    ph_natten2(C, P_QN, P_KN, P_VTN, P_OCAT, in_ptr(ws, I_RPB) + (size_t)lq * 8 * 465, lq == 1, (unsigned*)(ws + WS_CTL) + 8192 + 64 * lq, ws, lq); });
        PHASE(18, ph_post(C, P_YS, P_R, P_V, P_K, P_KEFF, in_ptr(ws, I_KA) + lq * 512, P_G, in_ptr(ws, I_RK) + lq * 512, in_ptr(ws, I_GNG) + lq * 512, in_ptr(ws, I_GNB) + lq * 512, P_OCAT, lq == 1));
        PHASE(19, { const int i = 2 * lq + 1; EpiResid E{XL, P_XC, XL, P_XC, MODL(i) + 2048};
                    fast_gemm(C, P_OCAT, DM, (const bf16*)(ws + WS_WODOUT) + (size_t)lq * DM * DM, DM, (lq == 1) ? NLAT / 256 : MT / 256, 4, E);
                    WPREP_TAIL(((lq == 1) ? NLAT / 256 : MT / 256) * 4, i); });
        PHASE(20, { const int i = 2 * lq + 1; ph_norm<true>(C, XL, P_XC, in_ptr(ws, I_N2G) + i * DM, MODL(i), 3072, 4096, P_HB, in_ptr(ws, I_ROUTER) + (size_t)i * DM * 16, P_AFFT, P_AFFC, P_SLOT); });
        PHASE(21, ph_topk2(C, P_AFFT, P_AFFC, P_ROWS, P_GATE, P_SLOT, lq == 1));
        PHASE(22, { MOE1_PHASE((lq == 1) ? 16 : 17); });
        PHASE(23, { MOE2_PHASE((lq == 1) ? 16 : 17); });
        PHASE(24, { const int i = 2 * lq + 1;
                    if (lp == 0) ph_combine(C, XL, P_XC, MODL(i) + 5120, P_SLOT, P_Y2, false, in_ptr(ws, I_N1G) + (i + 1) * DM, MODL(i + 1), P_HB);
                    else ph_combine(C, XL, P_XC, MODL(i) + 5120, P_SLOT, P_Y2, true, nullptr, nullptr, nullptr); });
    };
    layer_pair(IC<0>{}); layer_pair(IC<1>{});
}

extern "C" void kernel_launch(void* const* d_in, const int* in_sizes, int n_in, void* d_out, int out_size, void* d_ws, size_t ws_size, hipStream_t stream) {
    static int grid = 0;
    if (grid == 0) {
        if (n_in != 40 || out_size != NLAT * DM || ws_size < WS_END) { fprintf(stderr, "kernel_launch: unexpected shapes (n_in %d out %d ws %zu need %zu)\n", n_in, out_size, ws_size, (size_t)WS_END); grid = -1; return; }
        int dev = 0, cus = 0, per_cu = 0;
        if (hipGetDevice(&dev) != hipSuccess || hipDeviceGetAttribute(&cus, hipDeviceAttributeMultiprocessorCount, dev) != hipSuccess) { grid = -1; return; }
        if (hipFuncSetAttribute((const void*)fwd_kernel, hipFuncAttributeMaxDynamicSharedMemorySize, LDS_BYTES) != hipSuccess) { fprintf(stderr, "kernel_launch: hipFuncSetAttribute failed\n"); grid = -1; return; }
        if (hipOccupancyMaxActiveBlocksPerMultiprocessor(&per_cu, (const void*)fwd_kernel, 512, LDS_BYTES) != hipSuccess || per_cu < 1) { fprintf(stderr, "kernel_launch: occupancy query says %d\n", per_cu); per_cu = 1; }
        (void)hipGetLastError();
        grid = cus;
    }
    if (grid < 0) return;
    (void)hipMemsetAsync((char*)d_ws + WS_CTL, 0, CTL_BYTES, stream);
    Args a{};
    for (int i = 0; i < 40; ++i) a.in[i] = (const float*)d_in[i];
    a.out = (float*)d_out; a.ws = (unsigned char*)d_ws;
#if MEGA
    a.ph_lo = 0; a.ph_hi = N_PHASES;
    hipLaunchKernelGGL(fwd_kernel, dim3(grid), dim3(512), LDS_BYTES, stream, a);
#else
    for (int p = 0; p < N_PHASES; ++p) { a.ph_lo = p; a.ph_hi = p + 1; hipLaunchKernelGGL(fwd_kernel, dim3(grid), dim3(512), LDS_BYTES, stream, a); }
#endif
}
```

```cpp
#include <hip/hip_runtime.h>
#include <cstdio>
#include <cstdint>

#ifndef MEGA
#define MEGA 1
#endif

#define LAS __attribute__((address_space(3)))
#define DI __device__ __forceinline__

typedef unsigned short bf16;
typedef short bf16x8 __attribute__((ext_vector_type(8)));
typedef float f32x4 __attribute__((ext_vector_type(4)));
typedef float f32x2 __attribute__((ext_vector_type(2)));
typedef float f32x16 __attribute__((ext_vector_type(16)));
typedef unsigned u32x4 __attribute__((ext_vector_type(4)));
typedef unsigned u32x2 __attribute__((ext_vector_type(2)));
typedef __bf16 bf16x2_t __attribute__((ext_vector_type(2)));

constexpr int DM = 1024, NB = 8, TL = 4096, LCX = 256;
constexpr int NLAT = NB * TL, NCTX = NB * LCX, MT = NLAT + NCTX;
constexpr int KPOS = TL + LCX;
constexpr float EPS = 1e-6f, GN_EPS = 64e-5f;
constexpr int EV_IN = 1696, EV_INP = 1792, OD_IN = 3456, OD_INP = 3584, RW_IN = 1920;
constexpr int NEXP = 16, CAPL = 512, CAPC = 32, ESLOTS = NB * CAPL + NB * CAPC;
constexpr float LOG2E = 1.4426950408889634f;

constexpr size_t MiB = 1ull << 20;
constexpr size_t WS_CTL = 0, CTL_BYTES = 1 * MiB;
constexpr size_t WS_MOD = 1 * MiB, WS_ROPE = 2 * MiB, WS_XC = 4 * MiB;
constexpr size_t WS_ROWS = 12 * MiB, WS_GATE = 12 * MiB + 512 * 1024, WS_SLOT = 13 * MiB, WS_AFFT = 16 * MiB, WS_AFFC = 18 * MiB;
constexpr size_t WS_WEVIN = 20 * MiB, WS_WEVOUT = 27 * MiB, WS_WUQ = 31 * MiB, WS_WUKV = 33 * MiB, WS_WODIN = 34 * MiB, WS_WODOUT = 48 * MiB, WS_WLORA = 52 * MiB;
constexpr size_t WS_W13 = 56 * MiB, WS_W2 = 120 * MiB, WS_HB = 152 * MiB, WS_OCAT = 220 * MiB, WS_ARENA = 288 * MiB;
constexpr size_t A_U = 0, A_QPRE = 119 * MiB, A_KVPRE = 221 * MiB, A_QB = 357 * MiB, A_KB = 408 * MiB, A_VT = 459 * MiB;
constexpr size_t A_W = 0, A_KEFF = 136 * MiB  , A_G = 204 * MiB, A_R = 238 * MiB, A_V = 272 * MiB, A_KK = 306 * MiB, A_K = 340 * MiB, A_L = 374 * MiB,
                 A_QN = 400 * MiB, A_KN = 434 * MiB, A_VTN = 468 * MiB, A_YS = 612 * MiB  ;
constexpr size_t A_HID = 0, A_Y2 = 136 * MiB;
constexpr size_t A_IMG = 510 * MiB;
constexpr size_t WS_END = WS_ARENA + 680 * MiB;
constexpr int LDS_BYTES = 147456;

DI unsigned pk2(float lo, float hi) { f32x2 v = {lo, hi}; bf16x2_t b = __builtin_convertvector(v, bf16x2_t); return __builtin_bit_cast(unsigned, b); }
DI float bflo(unsigned u) { return __builtin_bit_cast(float, u << 16); }
DI float bfhi(unsigned u) { return __builtin_bit_cast(float, u & 0xffff0000u); }
DI float bf2f(bf16 x) { return __builtin_bit_cast(float, ((unsigned)x) << 16); }
DI bf16 f2bf(float f) { return (bf16)(pk2(f, 0.f) & 0xffffu); }
DI void unpack8(u32x4 v, float (&f)[8]) { f[0] = bflo(v.x); f[1] = bfhi(v.x); f[2] = bflo(v.y); f[3] = bfhi(v.y); f[4] = bflo(v.z); f[5] = bfhi(v.z); f[6] = bflo(v.w); f[7] = bfhi(v.w); }
DI u32x4 pack8(const float (&f)[8]) { u32x4 r; r.x = pk2(f[0], f[1]); r.y = pk2(f[2], f[3]); r.z = pk2(f[4], f[5]); r.w = pk2(f[6], f[7]); return r; }
#define DPP_ADD(x, ctrl) ((x) + __builtin_bit_cast(float, __builtin_amdgcn_update_dpp(0, __builtin_bit_cast(int, (x)), (ctrl), 0xf, 0xf, false)))
#define DPP_MAX(x, ctrl) fmaxf((x), __builtin_bit_cast(float, __builtin_amdgcn_update_dpp(0, __builtin_bit_cast(int, (x)), (ctrl), 0xf, 0xf, false)))
DI float sum8(float x) { x = DPP_ADD(x, 0xB1); x = DPP_ADD(x, 0x4E); x = DPP_ADD(x, 0x141); return x; }
DI float sum16(float x) { x = DPP_ADD(x, 0xB1); x = DPP_ADD(x, 0x4E); x = DPP_ADD(x, 0x141); x = DPP_ADD(x, 0x140); return x; }
DI float max16(float x) { x = DPP_MAX(x, 0xB1); x = DPP_MAX(x, 0x4E); x = DPP_MAX(x, 0x141); x = DPP_MAX(x, 0x140); return x; }
DI float rdlane(float x, int l) { return __builtin_bit_cast(float, __builtin_amdgcn_readlane(__builtin_bit_cast(int, x), l)); }
DI float wave_sum(float v) { const float x = sum16(v); return (rdlane(x, 0) + rdlane(x, 16)) + (rdlane(x, 32) + rdlane(x, 48)); }
DI float xor32(float v, int lane) { return __builtin_bit_cast(float, __builtin_amdgcn_ds_bpermute((lane ^ 32) << 2, __builtin_bit_cast(int, v))); }
typedef int v8i_t __attribute__((ext_vector_type(8)));
typedef int i32x4_t __attribute__((ext_vector_type(4)));
DI unsigned pk4_fp8(float a, float b, float c, float d) {
    a = __builtin_amdgcn_fmed3f(a, -448.f, 448.f); b = __builtin_amdgcn_fmed3f(b, -448.f, 448.f); c = __builtin_amdgcn_fmed3f(c, -448.f, 448.f); d = __builtin_amdgcn_fmed3f(d, -448.f, 448.f);
    int p = __builtin_amdgcn_cvt_pk_fp8_f32(a, b, 0, false); p = __builtin_amdgcn_cvt_pk_fp8_f32(c, d, p, true); return (unsigned)p; }
#ifndef MOE_F8
#define MOE_F8 1
#endif
constexpr int SCALE_ONE = 0x7f7f7f7f, SCALE_W = 0x79797979  , SCALE_HID = 0x7c7c7c7c  ;
DI float sigmoidf_(float x) { return __builtin_amdgcn_rcpf(1.f + __expf(-x)); }
DI float siluf_(float x) { return x * __builtin_amdgcn_rcpf(1.f + __expf(-x)); }
#define MFMA32(a, b, c) __builtin_amdgcn_mfma_f32_32x32x16_bf16((a), (b), (c), 0, 0, 0)

#define XB_TMO      128
#define XB_XCNT(j)  (256  + 64 * (j))
#define XB_XSUB(j)  (1280 + 64 * (j))
#define XB_XGEN(j)  (2304 + 64 * (j))
#define XB_TOP      3328
#define XB_TOPGEN   3392
#define XCD_BAR_WORDS 3456
#define XB_SPIN_CAP (1u << 22)
__device__ __forceinline__ unsigned xb_ld(unsigned* p)              { return __hip_atomic_load(p, __ATOMIC_RELAXED, __HIP_MEMORY_SCOPE_AGENT); }
__device__ __forceinline__ unsigned xb_add(unsigned* p, unsigned v) { return __hip_atomic_fetch_add(p, v, __ATOMIC_RELAXED, __HIP_MEMORY_SCOPE_AGENT); }
__device__ __forceinline__ unsigned xb_xcc_id() { return (unsigned)__builtin_amdgcn_s_getreg((3 << 11) | 20) & 0xFu; }
#define XB_SPIN(cond, bar) do { unsigned _sp = 0; while (cond) { __builtin_amdgcn_s_sleep(1); \
    if ((++_sp & 255u) == 0u) { if (xb_ld(&(bar)[XB_TMO])) break; if (_sp > XB_SPIN_CAP) { atomicAdd(&(bar)[XB_TMO], 1u); break; } } } } while (0)
struct XcdBarrier { unsigned* bar; unsigned x; volatile LAS unsigned* st; };
__device__ __forceinline__ XcdBarrier xcd_barrier_post(unsigned* bar, volatile LAS unsigned* st, bool leader) {
    XcdBarrier b; b.bar = bar; b.x = xb_xcc_id(); b.st = st;
    if (leader) (void)xb_add(&bar[XB_XCNT(b.x)], 1u);
    return b;
}
__device__ __forceinline__ void xcd_barrier_complete(unsigned* bar, unsigned x, unsigned& nloc, unsigned& nx) {
    const unsigned G = gridDim.x * gridDim.y * gridDim.z;
    unsigned sum, cnt, mine, sp = 0u;
    for (;;) {
        sum = 0u; cnt = 0u; mine = 0u;
#pragma unroll
        for (unsigned j = 0; j < 16; ++j) { const unsigned c = xb_ld(&bar[XB_XCNT(j)]); sum += c; cnt += (c > 0u) ? 1u : 0u; mine = (j == x) ? c : mine; }
        if (sum == G) break;
        __builtin_amdgcn_s_sleep(1);
        if ((++sp & 255u) == 0u) { if (xb_ld(&bar[XB_TMO])) break; if (sp > XB_SPIN_CAP) { atomicAdd(&bar[XB_TMO], 1u); break; } }
    }
    nloc = mine > 0u ? mine : 1u; nx = cnt > 0u ? cnt : 1u;
}
__device__ __forceinline__ void xcd_barrier(const XcdBarrier& b, bool leader) {
    asm volatile("s_waitcnt vmcnt(0)" ::: "memory");
    __syncthreads();
    if (leader) {
        unsigned* bar = b.bar;
        __builtin_amdgcn_s_waitcnt(0);
        unsigned nloc = b.st[0], nx = b.st[1];
        if (nloc == 0u) { xcd_barrier_complete(bar, b.x, nloc, nx); b.st[0] = nloc; b.st[1] = nx; }
        const unsigned old = xb_add(&bar[XB_XSUB(b.x)], 1u);
        const unsigned gen = old / nloc;
        if (old + 1u == (gen + 1u) * nloc) {
            __builtin_amdgcn_fence(__ATOMIC_RELEASE, "agent");
            asm volatile("s_waitcnt vmcnt(0)" ::: "memory");
            const unsigned og = xb_add(&bar[XB_TOP], 1u);
            const unsigned tg = og / nx;
            if (og + 1u == (tg + 1u) * nx) xb_add(&bar[XB_TOPGEN], 1u);
            else XB_SPIN(xb_ld(&bar[XB_TOPGEN]) == tg, bar);
            __builtin_amdgcn_fence(__ATOMIC_ACQUIRE, "agent");
            xb_add(&bar[XB_XGEN(b.x)], 1u);
            asm volatile("s_waitcnt vmcnt(0)" ::: "memory");
        } else {
            XB_SPIN(xb_ld(&bar[XB_XGEN(b.x)]) == gen, bar);
            __builtin_amdgcn_fence(__ATOMIC_ACQUIRE, "agent");
            asm volatile("s_waitcnt vmcnt(0)" ::: "memory");
        }
    }
    __syncthreads();
}

struct Ctx { LAS unsigned char* lds; int tid, lane, wave, bid, nb, vcu; };
struct Args { const float* in[40]; float* out; unsigned char* ws; int ph_lo, ph_hi; };
enum { I_X = 0, I_C, I_CTX, I_CCTX, I_ADAW, I_ADAB, I_N1G, I_N2G, I_EVWIN, I_EVWOUT, I_QNORM, I_WUQ, I_KVNORM, I_WUKV, I_QG, I_KG, I_DWW, I_DWB, I_LNG, I_LNB,
       I_ODWIN, I_ODWOUT, I_SHIFTW, I_W0, I_W2L, I_A0, I_A2, I_G2, I_KKW, I_KA, I_RK, I_GNG, I_GNB, I_NAQG, I_NAKG, I_RPB, I_ROUTER, I_MW1, I_MW3, I_MW2 };

DI void transpose_item(const float* __restrict__ W, int K, int N, bf16* __restrict__ WT, int dst_row0, const float* __restrict__ gain, LAS float* scr, int k0, int n0, int lane) {
#pragma unroll 8
    for (int i = 0; i < 32; ++i) { const int kk = 2 * i + (lane >> 5); float v = W[(size_t)(k0 + kk) * N + n0 + (lane & 31)]; if (gain) v *= gain[k0 + kk]; scr[kk * 33 + (lane & 31)] = v; }
    asm volatile("s_waitcnt lgkmcnt(0)" ::: "memory");
    const int c = lane & 7;
#pragma unroll
    for (int j = 0; j < 4; ++j) { const int n = (lane >> 3) + 8 * j; const LAS float* s = scr + (8 * c) * 33 + n;
        u32x4 o; o.x = pk2(s[0 * 33], s[1 * 33]); o.y = pk2(s[2 * 33], s[3 * 33]); o.z = pk2(s[4 * 33], s[5 * 33]); o.w = pk2(s[6 * 33], s[7 * 33]);
        *(u32x4*)(WT + (size_t)(dst_row0 + n) * K + k0 + 8 * c) = o; }
    asm volatile("s_waitcnt lgkmcnt(0)" ::: "memory");
}
DI void transpose_item64(const float* __restrict__ W, int K, int N, bf16* __restrict__ WT, int dst_row0, LAS float* scr, int k0, int n0, int lane) {
    f32x4 v[16];
#pragma unroll
    for (int i = 0; i < 16; ++i) v[i] = *(const f32x4*)(W + (size_t)(k0 + 4 * i + (lane >> 4)) * N + n0 + 4 * (lane & 15));
#pragma unroll
    for (int i = 0; i < 16; ++i) { LAS float* d = scr + (4 * i + (lane >> 4)) * 65 + 4 * (lane & 15); d[0] = v[i].x; d[1] = v[i].y; d[2] = v[i].z; d[3] = v[i].w; }
    asm volatile("s_waitcnt lgkmcnt(0)" ::: "memory");
    const int c = lane & 7;
#pragma unroll
    for (int j = 0; j < 8; ++j) { const int n = (lane >> 3) + 8 * j; const LAS float* s = scr + (8 * c) * 65 + n;
        u32x4 o; o.x = pk2(s[0 * 65], s[1 * 65]); o.y = pk2(s[2 * 65], s[3 * 65]); o.z = pk2(s[4 * 65], s[5 * 65]); o.w = pk2(s[6 * 65], s[7 * 65]);
        *(u32x4*)(WT + (size_t)(dst_row0 + n) * K + k0 + 8 * c) = o; }
    asm volatile("s_waitcnt lgkmcnt(0)" ::: "memory");
}
DI void transpose_item64_f8(const float* __restrict__ W, int K, int N, unsigned char* __restrict__ WT8, int dst_row0, LAS float* scr, int k0, int n0, int lane) {
    f32x4 v[16];
#pragma unroll
    for (int i = 0; i < 16; ++i) v[i] = *(const f32x4*)(W + (size_t)(k0 + 4 * i + (lane >> 4)) * N + n0 + 4 * (lane & 15));
#pragma unroll
    for (int i = 0; i < 16; ++i) { LAS float* d = scr + (4 * i + (lane >> 4)) * 65 + 4 * (lane & 15); d[0] = v[i].x; d[1] = v[i].y; d[2] = v[i].z; d[3] = v[i].w; }
    asm volatile("s_waitcnt lgkmcnt(0)" ::: "memory");
    const int c = lane & 7;
#pragma unroll
    for (int j = 0; j < 8; ++j) { const int n = (lane >> 3) + 8 * j; const LAS float* s = scr + (8 * c) * 65 + n;
        u32x2 o; o.x = pk4_fp8(64.f * s[0 * 65], 64.f * s[1 * 65], 64.f * s[2 * 65], 64.f * s[3 * 65]); o.y = pk4_fp8(64.f * s[4 * 65], 64.f * s[5 * 65], 64.f * s[6 * 65], 64.f * s[7 * 65]);
        *(u32x2*)(WT8 + (size_t)(dst_row0 + n) * K + k0 + 8 * c) = o; }
    asm volatile("s_waitcnt lgkmcnt(0)" ::: "memory");
}
DI void transpose_matrix(const Ctx& C, const float* W, int K, int N, bf16* WT, const float* gain, int mode  ) {
    LAS float* scr = (LAS float*)(C.lds + C.wave * 8704);
    const int nkb = K / 64, nnb = N / 32, nit = nkb * nnb, gw = C.vcu * 8 + C.wave, ngw = C.nb * 8;
    for (int it = gw; it < nit; it += ngw) {
        const int kb = it / nnb, nbk = it % nnb, n0 = nbk * 32;
        int d0 = n0; if (mode) d0 = (n0 >> 7) * 256 + (n0 & 127) + (mode == 2 ? 128 : 0);
        transpose_item(W, K, N, WT, d0, gain, scr, kb * 64, n0, C.lane);
    }
}

DI void ph_prologue(const Ctx& C, const Args& a) {
    unsigned char* ws = a.ws;
    {
        LAS float* sv = (LAS float*)C.lds;
        LAS float* red = sv + 9 * 1024;
        for (int i = C.tid; i < 9 * 1024; i += 512) { const int m = i >> 10, k = i & 1023; const float c = (m < 8) ? a.in[I_C][m * 1024 + k] : a.in[I_CCTX][k]; sv[i] = siluf_(c); }
        __syncthreads();
        float* MOD = (float*)(ws + WS_MOD);
        for (int it = C.bid; it < 4 * 96; it += C.nb) {
            const int layer = it / 96, col = (it % 96) * 64 + C.lane;
            const float* wp = a.in[I_ADAW] + (size_t)layer * 1024 * 6144 + col;
            float acc[9];
#pragma unroll
            for (int m = 0; m < 9; ++m) acc[m] = 0.f;
            const int kb = C.wave * 128;
#pragma unroll 16
            for (int k = 0; k < 128; ++k) { const float w = wp[(size_t)(kb + k) * 6144];
#pragma unroll
                for (int m = 0; m < 9; ++m) acc[m] += sv[m * 1024 + kb + k] * w; }
#pragma unroll
            for (int m = 0; m < 9; ++m) red[(C.wave * 9 + m) * 64 + C.lane] = acc[m];
            __syncthreads();
            for (int i = C.tid; i < 576; i += 512) { const int m = i >> 6, l = i & 63; float s = 0.f;
#pragma unroll
                for (int w = 0; w < 8; ++w) s += red[(w * 9 + m) * 64 + l];
                const int cc = (it % 96) * 64 + l;
                MOD[(size_t)(layer * 9 + m) * 6144 + cc] = s + a.in[I_ADAB][layer * 6144 + cc]; }
            __syncthreads();
        }
    }
    {
        f32x2* CS = (f32x2*)(ws + WS_ROPE);
        for (int i = C.bid * 512 + C.tid; i < 4096 * 16; i += C.nb * 512) {
            const int pos = i >> 4, j = i & 15, f = j & 7;
            const float inv = powf(10000.f, -(float)(2 * f) / 16.f);
            const float ang = (float)((j < 8) ? (pos >> 6) : (pos & 63)) * inv;
            const double tw = 6.283185307179586476925;
            const double x = (double)ang, n = __builtin_rint(x / tw), rr = x - n * tw;
            CS[i] = (f32x2){__cosf((float)rr), __sinf((float)rr)};
        }
    }
    for (int j = 0; j < 2; ++j) {
        transpose_matrix(C, a.in[I_EVWIN] + (size_t)j * DM * EV_IN, DM, EV_IN, (bf16*)(ws + WS_WEVIN) + (size_t)j * EV_INP * DM, nullptr, 0);
        transpose_matrix(C, a.in[I_EVWOUT] + (size_t)j * DM * DM, DM, DM, (bf16*)(ws + WS_WEVOUT) + (size_t)j * DM * DM, nullptr, 0);
        transpose_matrix(C, a.in[I_WUQ] + (size_t)j * 384 * 768, 384, 768, (bf16*)(ws + WS_WUQ) + (size_t)j * 768 * 384, a.in[I_QNORM] + j * 384, 0);
        transpose_matrix(C, a.in[I_WUKV] + (size_t)j * 256 * 1024, 256, 1024, (bf16*)(ws + WS_WUKV) + (size_t)j * 1024 * 256, a.in[I_KVNORM] + j * 256, 0);
        transpose_matrix(C, a.in[I_ODWIN] + (size_t)j * DM * OD_IN, DM, OD_IN, (bf16*)(ws + WS_WODIN) + (size_t)j * OD_INP * DM, nullptr, 0);
        transpose_matrix(C, a.in[I_ODWOUT] + (size_t)j * DM * DM, DM, DM, (bf16*)(ws + WS_WODOUT) + (size_t)j * DM * DM, nullptr, 0);
    }
    {
        const int gt = C.bid * 512 + C.tid, ngt = C.nb * 512;
        for (int j = 0; j < 2; ++j) {
            u32x4* p0 = (u32x4*)((bf16*)(ws + WS_WEVIN) + (size_t)j * EV_INP * DM + (size_t)EV_IN * DM);
            for (int i = gt; i < (EV_INP - EV_IN) * DM / 8; i += ngt) p0[i] = (u32x4){0u, 0u, 0u, 0u};
            u32x4* p1 = (u32x4*)((bf16*)(ws + WS_WODIN) + (size_t)j * OD_INP * DM + (size_t)OD_IN * DM);
            for (int i = gt; i < (OD_INP - OD_IN) * DM / 8; i += ngt) p1[i] = (u32x4){0u, 0u, 0u, 0u};
            bf16* WL = (bf16*)(ws + WS_WLORA) + (size_t)j * 655360;
            const float* w2 = a.in[I_W2L] + (size_t)j * 2 * 64 * 512; const float* a2 = a.in[I_A2] + (size_t)j * 2 * 64 * 512; const float* g2 = a.in[I_G2] + (size_t)j * 128 * 512;
            for (int i = gt; i < 655360; i += ngt) {
                const int n = i >> 8, k = i & 255; float v = 0.f;
                if (n < 1024) { const int d = n >> 9, c = n & 511; if (k >= d * 64 && k < d * 64 + 64) v = w2[(size_t)k * 512 + c]; }
                else if (n < 2048) { const int d = (n - 1024) >> 9, c = n & 511; if (k >= 128 + d * 64 && k < 192 + d * 64) v = a2[(size_t)(k - 128) * 512 + c]; }
                else { const int c = n - 2048; if (k >= 128) v = g2[(size_t)(k - 128) * 512 + c]; }
                WL[i] = f2bf(v);
            }
        }
    }
}

template <bool ROUTER> DI void norm_row(const Ctx& C, int row, const float* xlat, const float* xctx, const float* gain, const float* mod, int shift_off, int scale_off, bf16* H, float* AFFT, float* AFFC, int* SLOT);
template <bool ROUTER> DI void norm_rows2(const Ctx& C, int row, const float* xlat, const float* gain, const float* mod, int shift_off, int scale_off, bf16* H, float* AFFT, int* SLOT);
template <bool ROUTER>
DI void ph_norm(const Ctx& C, const float* xlat, const float* xctx, const float* gain, const float* mod  , int shift_off, int scale_off, bf16* H,
                const float* router  , float* AFFT, float* AFFC, int* SLOT) {
    LAS float* RT = (LAS float*)C.lds;
    if (ROUTER) { for (int i = C.tid; i < 16384; i += 512) { const int c = i >> 4, e = i & 15; RT[e * 1024 + c] = router[i]; } __syncthreads(); }
    const int gw = C.bid * 8 + C.wave, ngw = C.nb * 8;
    for (int p = gw; p < NLAT / 2; p += ngw) norm_rows2<ROUTER>(C, 2 * p, xlat, gain, mod, shift_off, scale_off, H, AFFT, SLOT);
    for (int row = NLAT + gw; row < MT; row += ngw) norm_row<ROUTER>(C, row, xlat, xctx, gain, mod, shift_off, scale_off, H, AFFT, AFFC, SLOT);
}
template <bool ROUTER>
DI void norm_rows2(const Ctx& C, int row, const float* xlat, const float* gain, const float* mod, int shift_off, int scale_off, bf16* H, float* AFFT, int* SLOT) {
    const LAS float* RT = (const LAS float*)C.lds; const int lane = C.lane;
    const float* xr = xlat + (size_t)row * DM;
    const float* mp = mod + (row >> 12) * 6144;
    f32x4 v[2][4]; float ss[2] = {0.f, 0.f};
#pragma unroll
    for (int q = 0; q < 2; ++q)
#pragma unroll
        for (int j = 0; j < 4; ++j) { v[q][j] = *(const f32x4*)(xr + q * DM + 256 * j + 4 * lane); ss[q] += v[q][j].x * v[q][j].x + v[q][j].y * v[q][j].y + v[q][j].z * v[q][j].z + v[q][j].w * v[q][j].w; }
    float rs[2];
#pragma unroll
    for (int q = 0; q < 2; ++q) rs[q] = 1.0f / sqrtf(wave_sum(ss[q]) * (1.f / 1024.f) + EPS);
#pragma unroll
    for (int j = 0; j < 4; ++j) {
        const int c = 256 * j + 4 * lane;
        const f32x4 g = *(const f32x4*)(gain + c), sc = *(const f32x4*)(mp + scale_off + c), sh = *(const f32x4*)(mp + shift_off + c);
#pragma unroll
        for (int q = 0; q < 2; ++q) {
            v[q][j] = (v[q][j] * rs[q]) * g * (sc + 1.0f) + sh;
            if (ROUTER && MOE_F8) *(unsigned*)((unsigned char*)H + (size_t)(row + q) * DM + c) = pk4_fp8(v[q][j].x, v[q][j].y, v[q][j].z, v[q][j].w);
            else *(u32x2*)(H + (size_t)(row + q) * DM + c) = (u32x2){pk2(v[q][j].x, v[q][j].y), pk2(v[q][j].z, v[q][j].w)};
        }
    }
    if (ROUTER) {
        float lg0 = 0.f, lg1 = 0.f;
#pragma unroll 1
        for (int e = 0; e < 16; ++e) { float p0 = 0.f, p1 = 0.f;
#pragma unroll
            for (int j = 0; j < 4; ++j) { const f32x4 w = *(const LAS f32x4*)(RT + e * 1024 + 256 * j + 4 * lane);
                p0 += v[0][j].x * w.x + v[0][j].y * w.y + v[0][j].z * w.z + v[0][j].w * w.w; p1 += v[1][j].x * w.x + v[1][j].y * w.y + v[1][j].z * w.z + v[1][j].w * w.w; }
            p0 = wave_sum(p0); p1 = wave_sum(p1); lg0 = (lane == e) ? p0 : lg0; lg1 = (lane == e) ? p1 : lg1; }
        const float e0 = expf(lg0 - max16(lg0)), e1 = expf(lg1 - max16(lg1));
        const float a0 = e0 / sum16(e0), a1 = e1 / sum16(e1);
        if (lane < 16) { float* ap = AFFT + (size_t)((row >> 12) * 16 + lane) * TL + (row & 4095);
            ap[0] = a0; ap[1] = a1; SLOT[(size_t)row * 16 + lane] = -1; SLOT[(size_t)(row + 1) * 16 + lane] = -1; }
    }
}
template <bool ROUTER>
DI void norm_row(const Ctx& C, int row, const float* xlat, const float* xctx, const float* gain, const float* mod, int shift_off, int scale_off, bf16* H, float* AFFT, float* AFFC, int* SLOT) {
    const LAS float* RT = (const LAS float*)C.lds; const int lane = C.lane;
    {
        const float* xr = row < NLAT ? xlat + (size_t)row * DM : xctx + (size_t)(row - NLAT) * DM;
        const int mi = row < NLAT ? (row >> 12) : 8;
        const float* mp = mod + mi * 6144;
        f32x4 v[4]; float ss = 0.f;
#pragma unroll
        for (int j = 0; j < 4; ++j) { v[j] = *(const f32x4*)(xr + 256 * j + 4 * lane); ss += v[j].x * v[j].x + v[j].y * v[j].y + v[j].z * v[j].z + v[j].w * v[j].w; }
        ss = wave_sum(ss);
        const float rs = 1.0f / sqrtf(ss * (1.f / 1024.f) + EPS);
#pragma unroll
        for (int j = 0; j < 4; ++j) {
            const int c = 256 * j + 4 * lane;
            const f32x4 g = *(const f32x4*)(gain + c), sc = *(const f32x4*)(mp + scale_off + c), sh = *(const f32x4*)(mp + shift_off + c);
            v[j] = (v[j] * rs) * g * (sc + 1.0f) + sh;
            if (ROUTER && MOE_F8) *(unsigned*)((unsigned char*)H + (size_t)row * DM + c) = pk4_fp8(v[j].x, v[j].y, v[j].z, v[j].w);
            else *(u32x2*)(H + (size_t)row * DM + c) = (u32x2){pk2(v[j].x, v[j].y), pk2(v[j].z, v[j].w)};
        }
        if (ROUTER) {
            float mylg = 0.f;
#pragma unroll 1
            for (int e = 0; e < 16; ++e) { float p = 0.f;
#pragma unroll
                for (int j = 0; j < 4; ++j) { const f32x4 w = *(const LAS f32x4*)(RT + e * 1024 + 256 * j + 4 * lane); p += v[j].x * w.x + v[j].y * w.y + v[j].z * w.z + v[j].w * w.w; }
                p = wave_sum(p); mylg = (lane == e) ? p : mylg; }
            const float mx = max16(mylg);
            const float ex = expf(mylg - mx);
            const float mine = ex / sum16(ex);
            if (lane < 16) {
                if (row < NLAT) AFFT[(size_t)((row >> 12) * 16 + lane) * TL + (row & 4095)] = mine;
                else { const int rc = row - NLAT; AFFC[(size_t)((rc >> 8) * 16 + lane) * LCX + (rc & 255)] = mine; }
                SLOT[(size_t)row * 16 + lane] = -1;
            }
        }
    }
}


struct EpiBf16 { static constexpr bool WIDE = true; bf16* O; int ldo;
    DI void operator()(int row, int col, f32x4 v0, f32x4 v1) const { bf16* p = O + (size_t)row * ldo + col;
        *(u32x2*)p = (u32x2){pk2(v0[0], v0[1]), pk2(v0[2], v0[3])}; *(u32x2*)(p + 128) = (u32x2){pk2(v1[0], v1[1]), pk2(v1[2], v1[3])}; }
    DI void wide(int row, int col, f32x4 a0, f32x4 a1, f32x4 b0, f32x4 b1) const { bf16* p = O + (size_t)row * ldo + col;
        *(u32x4*)p = (u32x4){pk2(a0[0], a0[1]), pk2(a0[2], a0[3]), pk2(a1[0], a1[1]), pk2(a1[2], a1[3])}; *(u32x4*)(p + 128) = (u32x4){pk2(b0[0], b0[1]), pk2(b0[2], b0[3]), pk2(b1[0], b1[1]), pk2(b1[2], b1[3])}; } };
struct EpiF32 { static constexpr bool WIDE = false; float* O; int ldo;
    DI void operator()(int row, int col, f32x4 v0, f32x4 v1) const { float* p = O + (size_t)row * ldo + col; *(f32x4*)p = v0; *(f32x4*)(p + 128) = v1; } };
struct EpiResid { static constexpr bool WIDE = false; const float* xin_lat; const float* xin_ctx; float* xout_lat; float* xout_ctx; const float* modg;
    DI void operator()(int row, int col, f32x4 v0, f32x4 v1) const {
        const float* xi; float* xo; int mi;
        if (row < NLAT) { xi = xin_lat + (size_t)row * DM; xo = xout_lat + (size_t)row * DM; mi = row >> 12; }
        else { xi = xin_ctx + (size_t)(row - NLAT) * DM; xo = xout_ctx + (size_t)(row - NLAT) * DM; mi = 8; }
        const float* g = modg + mi * 6144 + col;
        const f32x4 g0 = *(const f32x4*)g, g1 = *(const f32x4*)(g + 128), x0 = *(const f32x4*)(xi + col), x1 = *(const f32x4*)(xi + col + 128);
        *(f32x4*)(xo + col) = x0 + g0 * v0; *(f32x4*)(xo + col + 128) = x1 + g1 * v1; } };
struct EpiGlu { static constexpr bool WIDE = false; bf16* O;
    DI void operator()(int row, int col, f32x4 v0, f32x4 v1) const { const int f = ((col & 2047) >> 8) * 128 + (col & 255);
        *(u32x2*)(O + (size_t)row * DM + f) = (u32x2){pk2(siluf_(v0[0]) * v1[0], siluf_(v0[1]) * v1[1]), pk2(siluf_(v0[2]) * v1[2], siluf_(v0[3]) * v1[3])}; } };
struct EpiGlu8 { static constexpr bool WIDE = true; unsigned char* O;
    DI void operator()(int row, int col, f32x4 v0, f32x4 v1) const { const int f = ((col & 2047) >> 8) * 128 + (col & 255);
        *(unsigned*)(O + (size_t)row * DM + f) = pk4_fp8(8.f * siluf_(v0[0]) * v1[0], 8.f * siluf_(v0[1]) * v1[1], 8.f * siluf_(v0[2]) * v1[2], 8.f * siluf_(v0[3]) * v1[3]); }
    DI void wide(int row, int col, f32x4 a0, f32x4 a1, f32x4 b0, f32x4 b1) const { const int f = ((col & 2047) >> 8) * 128 + (col & 255);
        *(u32x2*)(O + (size_t)row * DM + f) = (u32x2){pk4_fp8(8.f * siluf_(a0[0]) * b0[0], 8.f * siluf_(a0[1]) * b0[1], 8.f * siluf_(a0[2]) * b0[2], 8.f * siluf_(a0[3]) * b0[3]),
                                                    pk4_fp8(8.f * siluf_(a1[0]) * b1[0], 8.f * siluf_(a1[1]) * b1[1], 8.f * siluf_(a1[2]) * b1[2], 8.f * siluf_(a1[3]) * b1[3])}; } };
struct EpiGate { static constexpr bool WIDE = true; bf16* O; const float* gate;
    DI void operator()(int row, int col, f32x4 v0, f32x4 v1) const { const float g = gate[row]; bf16* p = O + (size_t)row * DM + (col & 1023);
        *(u32x2*)p = (u32x2){pk2(v0[0] * g, v0[1] * g), pk2(v0[2] * g, v0[3] * g)}; *(u32x2*)(p + 128) = (u32x2){pk2(v1[0] * g, v1[1] * g), pk2(v1[2] * g, v1[3] * g)}; }
    DI void wide(int row, int col, f32x4 a0, f32x4 a1, f32x4 b0, f32x4 b1) const { const float g = gate[row]; bf16* p = O + (size_t)row * DM + (col & 1023);
        *(u32x4*)p = (u32x4){pk2(a0[0] * g, a0[1] * g), pk2(a0[2] * g, a0[3] * g), pk2(a1[0] * g, a1[1] * g), pk2(a1[2] * g, a1[3] * g)};
        *(u32x4*)(p + 128) = (u32x4){pk2(b0[0] * g, b0[1] * g), pk2(b0[2] * g, b0[3] * g), pk2(b1[0] * g, b1[1] * g), pk2(b1[2] * g, b1[3] * g)}; } };
typedef _Float16 f16x2_t __attribute__((ext_vector_type(2)));
DI unsigned pk2h(float a, float b) { f16x2_t h; h.x = (_Float16)a; h.y = (_Float16)b; return __builtin_bit_cast(unsigned, h); }
DI float h2f(unsigned short x) { return (float)__builtin_bit_cast(_Float16, x); }
struct EpiLoraW { static constexpr bool WIDE = false; unsigned short* W; const float* w0;
    DI void one(int row, int col, f32x4 v) const { const int d = col >> 9, c = col & 511; f32x4 o;
#pragma unroll
        for (int e = 0; e < 4; ++e) { const float lw = w0[col + e] + v[e]; const float z = -lw; const float sp = fmaxf(z, 0.f) + __logf(1.f + __expf(-fabsf(z))); o[e] = -__expf(-sp - 0.5f); }
        *(u32x2*)(W + ((size_t)d * MT + row) * 512 + c) = (u32x2){pk2h(o[0], o[1]), pk2h(o[2], o[3])}; }
    DI void operator()(int row, int col, f32x4 v0, f32x4 v1) const { one(row, col, v0); one(row, col + 128, v1); } };
struct EpiLoraA { static constexpr bool WIDE = false; bf16* Aout; const float* a0;
    DI void one(int row, int col, f32x4 v) const { const int d = col >> 9, c = col & 511; const f32x4 b = *(const f32x4*)(a0 + col);
        *(u32x2*)(Aout + ((size_t)d * MT + row) * 512 + c) = (u32x2){pk2(sigmoidf_(b[0] + v[0]), sigmoidf_(b[1] + v[1])), pk2(sigmoidf_(b[2] + v[2]), sigmoidf_(b[3] + v[3]))}; }
    DI void operator()(int row, int col, f32x4 v0, f32x4 v1) const { one(row, col, v0); one(row, col + 128, v1); } };

namespace pg8 {
constexpr int BM = 256, BK = 64, HALF = 128, HTB = HALF * BK * 2, STAGE_BYTES = 8 * HTB;
DI int lds_byte(int r, int c) { const int st = (r >> 4) * 2 + (c >> 5), rr = r & 15, cc = c & 31, ob = rr * 64 + cc * 2; return st * 1024 + (ob ^ (((ob >> 9) & 1) << 5)); }
DI void stage_rc(int b, int& R, int& C) { const int st = b / 1024, sb = b % 1024, swz = sb ^ (((sb >> 9) & 1) << 5); R = (st >> 1) * 16 + swz / 64; C = (st & 1) * 32 + (swz % 64) / 2; }
DI int perm32(int rho) { const int n = rho >> 4, i = rho & 15; return 8 * (i >> 2) + 4 * n + (i & 3); }
struct Unit { int pm, pn; };
struct Gemm { const bf16* A; const bf16* Bt; int lda, K; const int* rows; int scale_w = 0x7f7f7f7f, scale_a = 0x7f7f7f7f; };
struct OrderMN { int nM, nN, G, c;
    DI bool next(int i, Unit& u) const { const int L = i * G + c; if (L >= nM * nN) return false; u.pm = L / nN; u.pn = L % nN; return true; } };
struct OrderMoE { int nMt, nN, mstride  , G, c;
    DI bool next(int i, Unit& u) const { const int L = i * G + c, per = nMt * nN; if (L >= NEXP * per) return false; const int e = L / per, q = L % per; u.pm = e * mstride + q / nN; u.pn = e * nN + q % nN; return true; } };
template <class E4> struct EpiAdapt { E4 e;
    DI void operator()(const f32x4 (&acc)[2][2][4][2], const Unit& u, int wr, int wc, int fr, int fq) const {
#pragma unroll
        for (int ai = 0; ai < 2; ++ai)
#pragma unroll
            for (int m = 0; m < 4; ++m) { const int row = u.pm * BM + ai * HALF + wr * 64 + m * 16 + fr;
                if constexpr (E4::WIDE) e.wide(row, u.pn * BM + wc * 32 + 8 * fq, acc[ai][0][m][0], acc[ai][0][m][1], acc[ai][1][m][0], acc[ai][1][m][1]);
                else {
#pragma unroll
                    for (int n = 0; n < 2; ++n) e(row, u.pn * BM + wc * 32 + 8 * fq + 4 * n, acc[ai][0][m][n], acc[ai][1][m][n]); } } } };

template <class Epi, class Sched, bool F8 = false>
DI void gemm_phase(LAS unsigned char* lds, const Gemm g, const Sched& S, const Epi& E, const int tid) {
    const int wid = __builtin_amdgcn_readfirstlane(tid >> 6), lane = tid & 63, wr = wid >> 2, wc = wid & 3, fr = lane & 15, fq = lane >> 4;
    const int K = g.K, nt = K / BK;
    unsigned voffB[2];
#pragma unroll
    for (int i = 0; i < 2; ++i) { int R, C; stage_rc(tid * 16 + i * 8192, R, C); const int Rb = (R & ~31) + perm32(R & 31); voffB[i] = (unsigned)(Rb * K + C) * 2u; }
    const size_t kstep = (size_t)(BK * 2), hstep = (size_t)HALF * K * 2, tstep = 2 * hstep;
    const unsigned ldsw = (unsigned)wid * 1024u;
    const int aoff = lds_byte(wr * 64 + fr, fq * 8), boff = lds_byte(wc * 32 + fr, fq * 8);
    const char* const gA = (const char*)g.A;
#define PG8_SA(b, h) (((b) * 2 + (h)) * HTB)
#define PG8_SB(b, h) ((4 + (b) * 2 + (h)) * HTB)
#define PG8_STAGE(bufoff, gbase, voff) do { _Pragma("unroll") for (int _i = 0; _i < 2; ++_i) \
        __builtin_amdgcn_global_load_lds((const unsigned*)((const char*)(gbase) + (voff)[_i]), (LAS unsigned*)(lds + (bufoff) + ldsw + _i * 8192), 16, 0, 0); } while (0)
#define PG8_LDA(dst, b, h) do { _Pragma("unroll") for (int m = 0; m < 4; ++m) _Pragma("unroll") for (int k = 0; k < 2; ++k) dst[m][k] = *(const LAS bf16x8*)(lds + PG8_SA(b, h) + aoff + m * 2048 + k * 1024); } while (0)
#define PG8_LDB(dst, b, h) do { _Pragma("unroll") for (int n = 0; n < 2; ++n) _Pragma("unroll") for (int k = 0; k < 2; ++k) dst[n][k] = *(const LAS bf16x8*)(lds + PG8_SB(b, h) + boff + n * 2048 + k * 1024); } while (0)
#define PG8_MMA(ai, bj, At, Bt) do { __builtin_amdgcn_s_setprio(1); _Pragma("unroll") for (int m = 0; m < 4; ++m) _Pragma("unroll") for (int n = 0; n < 2; ++n) { \
        if constexpr (F8) { const v8i_t w8 = __builtin_shufflevector(__builtin_bit_cast(i32x4_t, Bt[n][0]), __builtin_bit_cast(i32x4_t, Bt[n][1]), 0, 1, 2, 3, 4, 5, 6, 7), x8 = __builtin_shufflevector(__builtin_bit_cast(i32x4_t, At[m][0]), __builtin_bit_cast(i32x4_t, At[m][1]), 0, 1, 2, 3, 4, 5, 6, 7); \
            acc[ai][bj][m][n] = __builtin_amdgcn_mfma_scale_f32_16x16x128_f8f6f4(w8, x8, acc[ai][bj][m][n], 0, 0, 0, g.scale_w, 0, g.scale_a); } \
        else { _Pragma("unroll") for (int k = 0; k < 2; ++k) acc[ai][bj][m][n] = __builtin_amdgcn_mfma_f32_16x16x32_bf16(Bt[n][k], At[m][k], acc[ai][bj][m][n], 0, 0, 0); } } __builtin_amdgcn_s_setprio(0); } while (0)
#define PG8_WAIT_V(n) asm volatile("s_waitcnt vmcnt(" #n ")" ::: "memory")
#define PG8_WAIT_L(n) asm volatile("s_waitcnt lgkmcnt(" #n ")" ::: "memory")
#define PG8_BAR __builtin_amdgcn_s_barrier()
#define PG8_SCHED __builtin_amdgcn_sched_barrier(0)
#define PG8_ROWIDX(ri, u) do { _Pragma("unroll") for (int _h = 0; _h < 2; ++_h) _Pragma("unroll") for (int _i = 0; _i < 2; ++_i) { int _R, _C; stage_rc(tid * 16 + _i * 8192, _R, _C); (void)_C; \
        const int _lr = (u).pm * BM + _h * HALF + _R; ri[_h][_i] = g.rows ? g.rows[_lr] : _lr; } } while (0)
#define PG8_AOFF_FROM(vo, ri) do { _Pragma("unroll") for (int _h = 0; _h < 2; ++_h) _Pragma("unroll") for (int _i = 0; _i < 2; ++_i) { int _R, _C; stage_rc(tid * 16 + _i * 8192, _R, _C); (void)_R; \
        vo[_h][_i] = (unsigned)(((size_t)ri[_h][_i] * g.lda + _C) * 2u); } } while (0)
    Unit cur, nxt; int ui = 0;
    if (!S.next(0, cur)) return;
    f32x4 acc[2][2][4][2];
#pragma unroll
    for (int a = 0; a < 2; ++a)
#pragma unroll
        for (int b = 0; b < 2; ++b)
#pragma unroll
            for (int m = 0; m < 4; ++m)
#pragma unroll
                for (int n = 0; n < 2; ++n) acc[a][b][m][n] = (f32x4){0.f, 0.f, 0.f, 0.f};
    bf16x8 At[4][2], B0[2][2], B1[2][2];
    unsigned cvo[2][2]; int nri[2][2];
    PG8_ROWIDX(nri, cur); PG8_AOFF_FROM(cvo, nri);
    const char* cB = (const char*)g.Bt + (size_t)cur.pn * tstep;
    PG8_STAGE(PG8_SB(0, 0), cB, voffB); PG8_STAGE(PG8_SB(0, 1), cB + hstep, voffB); PG8_STAGE(PG8_SA(0, 0), gA, cvo[0]); PG8_STAGE(PG8_SA(0, 1), gA, cvo[1]);
    if (wr == 1) PG8_BAR;
    PG8_WAIT_V(2); PG8_BAR;
    PG8_STAGE(PG8_SB(1, 0), cB + kstep, voffB); PG8_STAGE(PG8_SA(1, 0), gA + kstep, cvo[0]); PG8_STAGE(PG8_SB(1, 1), cB + hstep + kstep, voffB);
    PG8_WAIT_V(6); PG8_BAR;
    for (;;) {
        const bool has_next = S.next(ui + 1, nxt);
        const char* nB = has_next ? (const char*)g.Bt + (size_t)nxt.pn * tstep : cB;
#pragma nounroll
        for (int t = 0; t < nt; t += 2) {
            const bool last = (t == nt - 2);
            const char* a1 = gA + (size_t)(t + 1) * kstep;
            const char* a2 = last ? gA : gA + (size_t)(t + 2) * kstep; const char* b2 = last ? nB : cB + (size_t)(t + 2) * kstep;
            const char* a3 = a2 + kstep; const char* b3 = b2 + kstep;
            if (t == nt - 4 && has_next) PG8_ROWIDX(nri, nxt);
            PG8_LDB(B0, 0, 0); PG8_LDB(B1, 0, 1); PG8_SCHED; PG8_LDA(At, 0, 0); PG8_STAGE(PG8_SA(1, 1), a1, cvo[1]);
            if (last && has_next) { if (nt < 4) PG8_ROWIDX(nri, nxt); PG8_AOFF_FROM(cvo, nri); }
            PG8_WAIT_V(8); PG8_WAIT_L(0); PG8_BAR; PG8_MMA(0, 0, At, B0); PG8_MMA(0, 1, At, B1); PG8_BAR; PG8_SCHED;
            PG8_LDA(At, 0, 1); PG8_STAGE(PG8_SB(0, 0), b2, voffB); PG8_STAGE(PG8_SB(0, 1), b2 + hstep, voffB); PG8_STAGE(PG8_SA(0, 0), a2, cvo[0]);
            PG8_WAIT_V(8); PG8_WAIT_L(0); PG8_BAR; PG8_MMA(1, 0, At, B0); PG8_MMA(1, 1, At, B1); PG8_BAR; PG8_SCHED;
            PG8_LDB(B0, 1, 0); PG8_LDB(B1, 1, 1); PG8_SCHED; PG8_LDA(At, 1, 0); PG8_STAGE(PG8_SA(0, 1), a2, cvo[1]);
            PG8_WAIT_V(8); PG8_WAIT_L(0); PG8_BAR; PG8_MMA(0, 0, At, B0); PG8_MMA(0, 1, At, B1); PG8_BAR; PG8_SCHED;
            PG8_LDA(At, 1, 1); PG8_STAGE(PG8_SB(1, 0), b3, voffB); PG8_STAGE(PG8_SB(1, 1), b3 + hstep, voffB); PG8_STAGE(PG8_SA(1, 0), a3, cvo[0]);
            PG8_WAIT_V(8); PG8_WAIT_L(0); PG8_BAR; PG8_MMA(1, 0, At, B0); PG8_MMA(1, 1, At, B1); PG8_BAR; PG8_SCHED;
        }
        if (wr == 0) PG8_BAR;
        E(acc, cur, wr, wc, fr, fq);
        if (!has_next) break;
#pragma unroll
        for (int a = 0; a < 2; ++a)
#pragma unroll
            for (int b = 0; b < 2; ++b)
#pragma unroll
                for (int m = 0; m < 4; ++m)
#pragma unroll
                    for (int n = 0; n < 2; ++n) acc[a][b][m][n] = (f32x4){0.f, 0.f, 0.f, 0.f};
        cur = nxt; cB = nB; ++ui;
        if (wr == 1) PG8_BAR;
    }
    PG8_WAIT_V(0);
    PG8_BAR;
#undef PG8_SA
#undef PG8_SB
#undef PG8_STAGE
#undef PG8_LDA
#undef PG8_LDB
#undef PG8_MMA
#undef PG8_WAIT_V
#undef PG8_WAIT_L
#undef PG8_BAR
#undef PG8_SCHED
#undef PG8_ROWIDX
#undef PG8_AOFF_FROM
}
}
template <class E4> DI void fast_gemm(const Ctx& C, const bf16* A, int lda, const bf16* Bt, int K, int nM, int nN, const E4& e, bool rev = false) {
    pg8::Gemm g{A, Bt, lda, K, nullptr}; pg8::OrderMN S{nM, nN, C.nb, rev ? C.nb - 1 - C.vcu : C.vcu}; pg8::EpiAdapt<E4> E{e};
    pg8::gemm_phase(C.lds, g, S, E, C.tid);
}

DI float max16_acc(float m, const f32x16& x) {
    asm volatile("s_nop 15\n\tv_max3_f32 %0, %0, %1, %2\n\tv_max3_f32 %0, %0, %3, %4\n\tv_max3_f32 %0, %0, %5, %6\n\tv_max3_f32 %0, %0, %7, %8\n\tv_max3_f32 %0, %0, %9, %10\n\tv_max3_f32 %0, %0, %11, %12\n\tv_max3_f32 %0, %0, %13, %14\n\tv_max3_f32 %0, %0, %15, %16"
                 : "+v"(m) : "v"(x[0]), "v"(x[1]), "v"(x[2]), "v"(x[3]), "v"(x[4]), "v"(x[5]), "v"(x[6]), "v"(x[7]), "v"(x[8]), "v"(x[9]), "v"(x[10]), "v"(x[11]), "v"(x[12]), "v"(x[13]), "v"(x[14]), "v"(x[15]));
    return m; }
DI int swap23(int x) { return (x & ~12) | ((x & 4) << 1) | ((x & 8) >> 1); }
DI void flash_store(const f32x16 (&o)[2], float l, bf16* orow  , int h) {
    const float inv = 1.f / l;
#pragma unroll
    for (int dt = 0; dt < 2; ++dt)
#pragma unroll
        for (int g = 0; g < 4; ++g)
            *(u32x2*)(orow + 32 * dt + 8 * g + 4 * h) = (u32x2){pk2(o[dt][4 * g] * inv, o[dt][4 * g + 1] * inv), pk2(o[dt][4 * g + 2] * inv, o[dt][4 * g + 3] * inv)};
}


template <int DQK> struct AttnGeo { static constexpr int KSTR = DQK * 2 + 16, KBYTES = 64 * KSTR, VSTR = 144, VBYTES = 64 * VSTR, BUF = KBYTES + VBYTES, KPIECES = 64 * DQK / 8; };
template <int DQK, bool NAT>
DI void attn_tile_loop(const Ctx& C, f32x16 (&o)[2], float& l, const bf16x8 (&qf)[DQK / 16], const bf16* __restrict__ Kb, const bf16* __restrict__ Vt, int pos1, int n1, int pos2, int n2,
                       const LAS float* tab, int grow, int rs, int qc, int cs) {
    typedef AttnGeo<DQK> G;
    const int tid = C.tid, r = C.lane & 31, h = C.lane >> 5, kr = swap23(r), ntiles = n1 + n2;
    constexpr bool K2 = G::KPIECES > 512;
    const int kq0 = tid, kq1 = tid + 512;
    const int kl0 = (kq0 / (DQK / 8)) * G::KSTR + (kq0 % (DQK / 8)) * 16, kl1 = (kq1 / (DQK / 8)) * G::KSTR + (kq1 % (DQK / 8)) * 16;
    const int vl = G::KBYTES + (tid >> 3) * G::VSTR + (tid & 7) * 16;
    const bf16* vg = Vt + (size_t)(tid >> 3) * KPOS + 8 * (tid & 7);
    u32x4 rk0, rk1, rv;
    rk1 = (u32x4){0u, 0u, 0u, 0u};
#define ATT_POS(t) ((t) < n1 ? pos1 + 64 * (t) : pos2 + 64 * ((t) - n1))
    { const int pos0 = ATT_POS(0); rk0 = *(const u32x4*)(Kb + (size_t)pos0 * DQK + 8 * kq0); if (K2 && tid < 256) rk1 = *(const u32x4*)(Kb + (size_t)pos0 * DQK + 8 * kq1); rv = *(const u32x4*)(vg + pos0); }
    __syncthreads();
    *(LAS u32x4*)(C.lds + kl0) = rk0; if (K2 && tid < 256) *(LAS u32x4*)(C.lds + kl1) = rk1; *(LAS u32x4*)(C.lds + vl) = rv;
    __syncthreads();
    if (C.wave >= 4) __builtin_amdgcn_s_setprio(1);
    float mref = 0.f; bool first = true;
    f32x16 nmref;
#pragma unroll
    for (int i = 0; i < 16; ++i) nmref[i] = 0.f;
    constexpr float THR = 8.f;
    for (int t = 0; t < ntiles; ++t) {
        const LAS unsigned char* B = C.lds + (t & 1) * G::BUF;
        if (t + 1 < ntiles) { const int pos0 = ATT_POS(t + 1);
            rk0 = *(const u32x4*)(Kb + (size_t)pos0 * DQK + 8 * kq0); if (K2 && tid < 256) rk1 = *(const u32x4*)(Kb + (size_t)pos0 * DQK + 8 * kq1); rv = *(const u32x4*)(vg + pos0); }
        const int gr = (pos1 >> 6) + t;
        const bool active = !NAT || t >= n1 || (gr >= rs && gr < rs + 8);
        if (active) {
            f32x16 sc[2];
            constexpr int NK = DQK / 16, NS = 2 * NK, RD = 4;
            const LAS unsigned char* kp = B + kr * G::KSTR + 16 * h;
            bf16x8 fr[RD];
#pragma unroll
            for (int s = 0; s < RD; ++s) fr[s] = *(const LAS bf16x8*)(kp + (s / NK) * 32 * G::KSTR + 32 * (s % NK));
#pragma unroll
            for (int s = 0; s < NS; ++s) { sc[s / NK] = MFMA32(fr[s % RD], qf[s % NK], (s % NK == 0) ? nmref : sc[s / NK]);
                if (s + RD < NS) fr[s % RD] = *(const LAS bf16x8*)(kp + ((s + RD) / NK) * 32 * G::KSTR + 32 * ((s + RD) % NK)); }
            const LAS unsigned char* vp = B + G::KBYTES + r * G::VSTR + 16 * h;
#pragma unroll
            for (int v = 0; v < RD; ++v) fr[v] = *(const LAS bf16x8*)(vp + (v & 1) * 32 * G::VSTR + (v >> 1) * 32);
            __builtin_amdgcn_sched_group_barrier(0x100, RD, 0);
#pragma unroll
            for (int s = 0; s < NS - RD; ++s) { __builtin_amdgcn_sched_group_barrier(0x008, 1, 0); __builtin_amdgcn_sched_group_barrier(0x100, 1, 0); }
            __builtin_amdgcn_sched_group_barrier(0x008, RD, 0);
            __builtin_amdgcn_sched_group_barrier(0x100, RD, 0);
            if (NAT && t < n1) {
                const LAS float* trl = tab + (gr - grow + 7) * 128 + (8 * h - qc + 63);
#pragma unroll
                for (int j = 0; j < 2; ++j) { float bv[16];
#pragma unroll
                    for (int i = 0; i < 16; ++i) bv[i] = trl[32 * j + ((i & 3) | (((i >> 2) & 1) << 2) | ((i >> 3) << 4))];
                    asm volatile("" : "+v"(bv[0]), "+v"(bv[1]), "+v"(bv[2]), "+v"(bv[3]), "+v"(bv[4]), "+v"(bv[5]), "+v"(bv[6]), "+v"(bv[7]), "+v"(bv[8]), "+v"(bv[9]), "+v"(bv[10]), "+v"(bv[11]), "+v"(bv[12]), "+v"(bv[13]), "+v"(bv[14]), "+v"(bv[15]));
#pragma unroll
                    for (int i = 0; i < 16; ++i) {
                        const int cc = 32 * j + ((i & 3) | (((i >> 2) & 1) << 2) | ((i >> 3) << 4)) + 8 * h; const bool ok = (cc >= cs) && (cc < cs + 16);
                        sc[j][i] = ok ? sc[j][i] + bv[i] : -1e30f;
                    } }
            }
            float mx = max16_acc(max16_acc(-3.0e38f, sc[0]), sc[1]);
            if (first || __builtin_amdgcn_ballot_w64(mx > THR) != 0ull) {
                mx = fmaxf(mx, xor32(mx, C.lane));
                const float delta = first ? mx : fmaxf(mx, 0.f);
#pragma unroll
                for (int i = 0; i < 16; ++i) { sc[0][i] -= delta; sc[1][i] -= delta; }
                if (!first) { const float alpha = __builtin_amdgcn_exp2f(-delta); l *= alpha;
#pragma unroll
                    for (int i = 0; i < 16; ++i) { o[0][i] *= alpha; o[1][i] *= alpha; } }
                mref += delta; first = false;
#pragma unroll
                for (int i = 0; i < 16; ++i) nmref[i] = -mref;
            }
            float rs1 = 0.f;
#pragma unroll
            for (int j = 0; j < 2; ++j)
#pragma unroll
                for (int i = 0; i < 16; ++i) { sc[j][i] = __builtin_amdgcn_exp2f(sc[j][i]); rs1 += sc[j][i]; }
            l += rs1;
#pragma unroll
            for (int j = 0; j < 2; ++j)
#pragma unroll
                for (int s2 = 0; s2 < 2; ++s2) {
                    u32x4 pw; pw.x = pk2(sc[j][8 * s2], sc[j][8 * s2 + 1]); pw.y = pk2(sc[j][8 * s2 + 2], sc[j][8 * s2 + 3]); pw.z = pk2(sc[j][8 * s2 + 4], sc[j][8 * s2 + 5]); pw.w = pk2(sc[j][8 * s2 + 6], sc[j][8 * s2 + 7]);
                    const bf16x8 pb = __builtin_bit_cast(bf16x8, pw);
#pragma unroll
                    for (int dt = 0; dt < 2; ++dt) { const int v = 4 * j + 2 * s2 + dt;
                        o[dt] = MFMA32(fr[v % RD], pb, o[dt]);
                        if (v + RD < 8) fr[v % RD] = *(const LAS bf16x8*)(vp + ((v + RD) & 1) * 32 * G::VSTR + ((v + RD) >> 1) * 32); }
                }
#pragma unroll
            for (int v = 0; v < 8 - RD; ++v) { __builtin_amdgcn_sched_group_barrier(0x008, 1, 1); __builtin_amdgcn_sched_group_barrier(0x100, 1, 1); }
            __builtin_amdgcn_sched_group_barrier(0x008, RD, 1);
        }
        if (t + 1 < ntiles) { LAS unsigned char* Bn = C.lds + ((t + 1) & 1) * G::BUF;
            *(LAS u32x4*)(Bn + kl0) = rk0; if (K2 && tid < 256) *(LAS u32x4*)(Bn + kl1) = rk1; *(LAS u32x4*)(Bn + vl) = rv; }
        __syncthreads();
    }
    __builtin_amdgcn_s_setprio(0);
    l += xor32(l, C.lane);
#undef ATT_POS
}
DI void conv_unit(const Ctx& C, int u, const bf16* U, const float (&wk)[31], float bias, const float* lng, const float* lnb, bf16* OCAT);
DI const float* in_ptr(const unsigned char* ws, int k);
constexpr int CONV_PER_TAIL = 3;
DI int conv_in_fin(int nb) { const int extra = (MT / 64) % nb; const int n = CONV_PER_TAIL * (nb - extra); return n < MT / 32 ? n : MT / 32; }
DI void ph_attn_mla2(const Ctx& C, const bf16* QB, const bf16* KB, const bf16* VT, bf16* OCAT, bool last, unsigned char* ws, int lq) {
    const int r = C.lane & 31, h = C.lane >> 5;
    const int nunits = 1024 + (last ? 0 : 64);
    int k = 0;
    for (;; ++k) {
        const int u = C.vcu + k * C.nb, cu = conv_in_fin(C.nb) + (C.nb - 1 - C.vcu) + k * C.nb;
        const bool a_on = u < nunits, c_on = cu < MT / 32;
        if (!a_on && !c_on) break;
        if (a_on) {
            const int bh = u < 1024 ? (u >> 4) : u - 1024, qblk = u < 1024 ? (u & 15) : 16, b = bh >> 3, hh = bh & 7;
            const int qpos = qblk * 256 + 32 * C.wave + r;
            const bf16* qp = QB + ((size_t)bh * KPOS + qpos) * 96 + 8 * h;
            bf16x8 qf[6];
#pragma unroll
            for (int kk = 0; kk < 6; ++kk) qf[kk] = *(const bf16x8*)(qp + 16 * kk);
            f32x16 o[2];
#pragma unroll
            for (int i = 0; i < 16; ++i) { o[0][i] = 0.f; o[1][i] = 0.f; }
            float l = 0.f;
            attn_tile_loop<96, false>(C, o, l, qf, KB + (size_t)bh * KPOS * 96, VT + (size_t)bh * 64 * KPOS, qblk < 16 ? 0 : TL, qblk < 16 ? KPOS / 64 : LCX / 64, 0, 0, nullptr, 0, 0, 0, 0);
            const int row = qblk < 16 ? b * TL + qpos : NLAT + b * LCX + (qpos - TL);
            flash_store(o, l, OCAT + (size_t)row * DM + hh * 64, h);
        }
        if (c_on) { float wk[31]; const float* dww = in_ptr(ws, I_DWW) + (size_t)lq * 31 * 512;
#pragma unroll
            for (int kt = 0; kt < 31; ++kt) wk[kt] = dww[kt * 512 + C.tid];
            conv_unit(C, cu, (const bf16*)(ws + WS_ARENA + A_U), wk, in_ptr(ws, I_DWB)[lq * 512 + C.tid], in_ptr(ws, I_LNG) + lq * 512, in_ptr(ws, I_LNB) + lq * 512, OCAT); }
    }
}
DI void ph_natten2(const Ctx& C, const bf16* QN, const bf16* KN, const bf16* VTN, bf16* OCAT, const float* rpb  , bool last, unsigned* work_ctr, unsigned char* ws, int lq) {
    const int r = C.lane & 31, h = C.lane >> 5;
    LAS float* tab = (LAS float*)(C.lds + 2 * AttnGeo<64>::BUF);
    LAS int* uslot = (LAS int*)(tab + 1920);
    const int nunits = 1024 + (last ? 0 : 64);
    for (;;) {
        __syncthreads();
        if (C.tid == 0) *uslot = (int)__hip_atomic_fetch_add(work_ctr, 1u, __ATOMIC_RELAXED, __HIP_MEMORY_SCOPE_AGENT);
        __syncthreads();
        const int u = *uslot;
        if (u >= nunits) break;
        const bool isctx = u >= 1024;
        const int bh = isctx ? u - 1024 : (u >> 4), b = bh >> 3, hh = bh & 7;
        for (int i = C.tid; i < 15 * 128; i += 512) { const int dc = (i & 127) - 48; tab[i] = (dc >= 0 && dc < 31) ? rpb[hh * 465 + (i >> 7) * 31 + dc] * LOG2E : 0.f; }
        int qpos, row, grow = 0, qc = 0, rs = 0, cs = 0, rlo = 0, nband = 0;
        if (!isctx) { const int rg = u & 15; grow = 4 * rg + (C.wave >> 1); qc = 32 * (C.wave & 1) + r; qpos = grow * 64 + qc; row = b * TL + qpos;
            rs = grow - 4; rs = rs < 0 ? 0 : (rs > 56 ? 56 : rs); cs = qc - 8; cs = cs < 0 ? 0 : (cs > 48 ? 48 : cs);
            rlo = 4 * rg - 4; rlo = rlo < 0 ? 0 : (rlo > 56 ? 56 : rlo); int rhi = 4 * rg + 3 - 4; rhi = rhi < 0 ? 0 : (rhi > 56 ? 56 : rhi); nband = rhi + 8 - rlo; }
        else { qpos = TL + 32 * C.wave + r; row = NLAT + b * LCX + 32 * C.wave + r; }
        const bf16* qp = QN + ((size_t)bh * KPOS + qpos) * 64 + 8 * h;
        bf16x8 qf[4];
#pragma unroll
        for (int kk = 0; kk < 4; ++kk) qf[kk] = *(const bf16x8*)(qp + 16 * kk);
        f32x16 o[2];
#pragma unroll
        for (int i = 0; i < 16; ++i) { o[0][i] = 0.f; o[1][i] = 0.f; }
        float l = 0.f;
        attn_tile_loop<64, true>(C, o, l, qf, KN + (size_t)bh * KPOS * 64, VTN + (size_t)bh * 64 * KPOS, rlo * 64, nband, TL, LCX / 64, tab, grow, rs, qc, cs);
        flash_store(o, l, OCAT + (size_t)row * DM + 512 + hh * 64, h);
    }
}


DI void ph_mla_fin(const Ctx& C, const bf16* U, const bf16* QPRE, const bf16* KVPRE, const float* qg, const float* kg, const f32x2* CS, bf16* QB, bf16* KB, bf16* VT) {
    LAS bf16* VL = (LAS bf16*)C.lds;
    const int lane = C.lane, j = lane >> 3, sub = lane & 7;
    const float C2 = 0.10206207261596575f * LOG2E;
    float qgn[8], qgr[4], kgn[8], kgr[4];
#pragma unroll
    for (int e = 0; e < 8; ++e) { qgn[e] = qg[8 * sub + e] * C2; kgn[e] = kg[8 * sub + e]; }
#pragma unroll
    for (int m = 0; m < 4; ++m) { qgr[m] = qg[64 + sub + 8 * m] * C2; kgr[m] = kg[64 + sub + 8 * m]; }
    for (int u = C.vcu; u < MT / 64; u += C.nb) {
        const int row0 = 64 * u, b = row0 < NLAT ? (row0 >> 12) : ((row0 - NLAT) >> 8), pos0 = row0 < NLAT ? (row0 & 4095) : TL + ((row0 - NLAT) & 255);
        const bool lat = row0 < NLAT;
        const int pl = 8 * C.wave + j, row = row0 + pl, pos = pos0 + pl;
        const bf16* ur = U + (size_t)row * EV_INP;
        float sq = 0.f, skv = 0.f;
#pragma unroll
        for (int m = 0; m < 6; ++m) { float x[8]; unpack8(*(const u32x4*)(ur + 8 * (sub + 8 * m)), x);
#pragma unroll
            for (int e = 0; e < 8; ++e) sq += x[e] * x[e]; }
#pragma unroll
        for (int m = 0; m < 4; ++m) { float x[8]; unpack8(*(const u32x4*)(ur + 384 + 8 * (sub + 8 * m)), x);
#pragma unroll
            for (int e = 0; e < 8; ++e) skv += x[e] * x[e]; }
        sq = sum8(sq); skv = sum8(skv);
        const float rsq = 1.0f / sqrtf(sq * (1.f / 384.f) + EPS), rskv = 1.0f / sqrtf(skv * (1.f / 256.f) + EPS);
        float krv[4];
#pragma unroll
        for (int m = 0; m < 4; ++m) krv[m] = bf2f(ur[640 + sub + 8 * m]);
        float cr = 1.f, sr = 0.f, cc = 1.f, sc = 0.f;
        if (lat) { const f32x2 a0 = CS[pos * 16 + sub], a1 = CS[pos * 16 + 8 + sub]; cr = a0.x; sr = a0.y; cc = a1.x; sc = a1.y; }
        const bf16* qrow = QPRE + (size_t)row * 768; const bf16* kvrow = KVPRE + (size_t)row * 1024;
#pragma unroll 2
        for (int hh = 0; hh < 8; ++hh) {
            { float qn[8], qr[4]; unpack8(*(const u32x4*)(qrow + hh * 96 + 8 * sub), qn); float ss = 0.f;
#pragma unroll
              for (int e = 0; e < 8; ++e) qn[e] *= rsq;
#pragma unroll
              for (int m = 0; m < 4; ++m) { qr[m] = bf2f(qrow[hh * 96 + 64 + sub + 8 * m]) * rsq; ss += qr[m] * qr[m]; }
#pragma unroll
              for (int e = 0; e < 8; ++e) ss += qn[e] * qn[e];
              const float rn = 1.0f / sqrtf(sum8(ss) * (1.f / 96.f) + EPS);
#pragma unroll
              for (int e = 0; e < 8; ++e) qn[e] *= rn * qgn[e];
#pragma unroll
              for (int m = 0; m < 4; ++m) qr[m] *= rn * qgr[m];
              { const float x0 = qr[0], x1 = qr[1], y0 = qr[2], y1 = qr[3]; qr[0] = x0 * cr - x1 * sr; qr[1] = x1 * cr + x0 * sr; qr[2] = y0 * cc - y1 * sc; qr[3] = y1 * cc + y0 * sc; }
              bf16* qo = QB + ((size_t)(b * 8 + hh) * KPOS + pos) * 96;
              *(u32x4*)(qo + 8 * sub) = pack8(qn);
#pragma unroll
              for (int m = 0; m < 4; ++m) qo[64 + sub + 8 * m] = f2bf(qr[m]); }
            { float kn[8], kr[4]; unpack8(*(const u32x4*)(kvrow + hh * 128 + 8 * sub), kn); float ss = 0.f;
#pragma unroll
              for (int e = 0; e < 8; ++e) kn[e] *= rskv;
#pragma unroll
              for (int m = 0; m < 4; ++m) { kr[m] = krv[m]; ss += kr[m] * kr[m]; }
#pragma unroll
              for (int e = 0; e < 8; ++e) ss += kn[e] * kn[e];
              const float rn = 1.0f / sqrtf(sum8(ss) * (1.f / 96.f) + EPS);
#pragma unroll
              for (int e = 0; e < 8; ++e) kn[e] *= rn * kgn[e];
#pragma unroll
              for (int m = 0; m < 4; ++m) kr[m] *= rn * kgr[m];
              { const float x0 = kr[0], x1 = kr[1], y0 = kr[2], y1 = kr[3]; kr[0] = x0 * cr - x1 * sr; kr[1] = x1 * cr + x0 * sr; kr[2] = y0 * cc - y1 * sc; kr[3] = y1 * cc + y0 * sc; }
              bf16* ko = KB + ((size_t)(b * 8 + hh) * KPOS + pos) * 96;
              *(u32x4*)(ko + 8 * sub) = pack8(kn);
#pragma unroll
              for (int m = 0; m < 4; ++m) ko[64 + sub + 8 * m] = f2bf(kr[m]); }
            { float vv[8]; unpack8(*(const u32x4*)(kvrow + hh * 128 + 64 + 8 * sub), vv);
#pragma unroll
              for (int e = 0; e < 8; ++e) VL[(hh * 64 + 8 * sub + e) * 64 + pl] = f2bf(vv[e] * rskv); }
        }
        __syncthreads();
        { const int hd = C.tid;
            bf16* dst = VT + ((size_t)(b * 8 + (hd >> 6)) * 64 + (hd & 63)) * KPOS + pos0;
#pragma unroll
            for (int q = 0; q < 8; ++q) *(u32x4*)(dst + 8 * q) = *(const LAS u32x4*)(VL + hd * 64 + 8 * q); }
        __syncthreads();
    }
}

DI void conv_unit(const Ctx& C, int u, const bf16* U, const float (&wk)[31], float bias, const float* lng, const float* lnb, bf16* OCAT) {
    LAS float* G = (LAS float*)C.lds;
    const int c = C.tid;
    const int row0 = 32 * u; int base, t0, tseq;
    if (row0 < NLAT) { base = row0 & ~4095; t0 = row0 & 4095; tseq = TL; } else { const int rc = row0 - NLAT; base = NLAT + (rc & ~255); t0 = rc & 255; tseq = LCX; }
    __syncthreads();
    for (int rr = C.wave; rr < 62; rr += 8) { const int tt = t0 - 15 + rr; float g[8];
#pragma unroll
        for (int e = 0; e < 8; ++e) g[e] = 0.f;
        if (tt >= 0 && tt < tseq) { const bf16* ur = U + (size_t)(base + tt) * EV_INP; float av[8], gv[8]; unpack8(*(const u32x4*)(ur + 672 + 8 * C.lane), av); unpack8(*(const u32x4*)(ur + 1184 + 8 * C.lane), gv);
#pragma unroll
            for (int e = 0; e < 8; ++e) g[e] = av[e] * sigmoidf_(gv[e]); }
        *(LAS f32x4*)(G + rr * 512 + 8 * C.lane) = (f32x4){g[0], g[1], g[2], g[3]}; *(LAS f32x4*)(G + rr * 512 + 8 * C.lane + 4) = (f32x4){g[4], g[5], g[6], g[7]}; }
    __syncthreads();
    float acc[32];
#pragma unroll
    for (int t = 0; t < 32; ++t) acc[t] = bias;
#pragma unroll
    for (int rr = 0; rr < 62; ++rr) { const float gv = G[rr * 512 + c];
#pragma unroll
        for (int t = 0; t < 32; ++t) { const int k = rr - t; if (k >= 0 && k < 31) acc[t] += gv * wk[k]; } }
    __syncthreads();
#pragma unroll
    for (int t = 0; t < 32; ++t) G[t * 512 + c] = acc[t];
    __syncthreads();
#pragma unroll
    for (int q = 0; q < 4; ++q) {
        const int t = 4 * C.wave + q, row = row0 + t;
        const f32x4 a0 = *(const LAS f32x4*)(G + t * 512 + 8 * C.lane), a1 = *(const LAS f32x4*)(G + t * 512 + 8 * C.lane + 4);
        float x[8] = {a0.x, a0.y, a0.z, a0.w, a1.x, a1.y, a1.z, a1.w}; float s = 0.f;
#pragma unroll
        for (int e = 0; e < 8; ++e) s += x[e];
        const float mu = wave_sum(s) * (1.f / 512.f); float s2 = 0.f;
#pragma unroll
        for (int e = 0; e < 8; ++e) { x[e] -= mu; s2 += x[e] * x[e]; }
        const float rstd = 1.0f / sqrtf(wave_sum(s2) * (1.f / 512.f) + EPS);
        float y[8];
#pragma unroll
        for (int e = 0; e < 8; ++e) { const float z = x[e] * rstd * lng[8 * C.lane + e] + lnb[8 * C.lane + e]; y[e] = siluf_(z); }
        *(u32x4*)(OCAT + (size_t)row * DM + 512 + 8 * C.lane) = pack8(y);
    }
    __syncthreads();
}
DI void wprep_span(const Ctx& C, int first, int stride, const float* w1, const float* w3, const float* w2, bf16* W13, bf16* W2) {
    LAS float* scr = (LAS float*)(C.lds + C.wave * 16640);
    constexpr int PER = 16 * 16, NIT = NEXP * 3 * PER;
    for (int it = first; it < NIT; it += stride) {
        const int e = it / (3 * PER), r = it % (3 * PER), which = r / PER, q = r % PER, kb = q / 16, n0 = (q % 16) * 64;
#if MOE_F8
        if (which == 0)      transpose_item64_f8(w1 + (size_t)e * DM * DM, DM, DM, (unsigned char*)W13 + (size_t)e * 2048 * DM, (n0 >> 7) * 256 + (n0 & 127), scr, kb * 64, n0, C.lane);
        else if (which == 1) transpose_item64_f8(w3 + (size_t)e * DM * DM, DM, DM, (unsigned char*)W13 + (size_t)e * 2048 * DM, (n0 >> 7) * 256 + (n0 & 127) + 128, scr, kb * 64, n0, C.lane);
        else                 transpose_item64_f8(w2 + (size_t)e * DM * DM, DM, DM, (unsigned char*)W2 + (size_t)e * DM * DM, n0, scr, kb * 64, n0, C.lane); }
#else
        if (which == 0)      transpose_item64(w1 + (size_t)e * DM * DM, DM, DM, W13 + (size_t)e * 2048 * DM, (n0 >> 7) * 256 + (n0 & 127), scr, kb * 64, n0, C.lane);
        else if (which == 1) transpose_item64(w3 + (size_t)e * DM * DM, DM, DM, W13 + (size_t)e * 2048 * DM, (n0 >> 7) * 256 + (n0 & 127) + 128, scr, kb * 64, n0, C.lane);
        else                 transpose_item64(w2 + (size_t)e * DM * DM, DM, DM, W2 + (size_t)e * DM * DM, n0, scr, kb * 64, n0, C.lane); }
#endif
}
constexpr int WPREP_PER_WAVE = (NEXP * 3 * 256 + 2047) / 2048;

DI void shifted8(const bf16* up, const bf16* uc, const bf16* un, bool hp, bool hn, const float (&s0)[8], const float (&s1)[8], const float (&s2)[8], int c0, float (&o)[8]) {
    const u32x4 z = {0u, 0u, 0u, 0u};
    const u32x4 vp = hp ? *(const u32x4*)(up + c0) : z, vc = *(const u32x4*)(uc + c0), vn = hn ? *(const u32x4*)(un + c0) : z;
    float p[8], c[8], n[8]; unpack8(vp, p); unpack8(vc, c); unpack8(vn, n);
#pragma unroll
    for (int e = 0; e < 8; ++e) o[e] = p[e] * s0[e] + c[e] * s1[e] + n[e] * s2[e];
}
DI void load_sw(const float* sw, int c0, float (&s0)[8], float (&s1)[8], float (&s2)[8]) {
#pragma unroll
    for (int e = 0; e < 8; ++e) { s0[e] = sw[c0 + e]; s1[e] = sw[RW_IN + c0 + e]; s2[e] = sw[2 * RW_IN + c0 + e]; }
}
DI void ph_prep(const Ctx& C, const bf16* U, const float* sw  , const float* kkw  , const float* naqg, const float* nakg,
                bf16* R, bf16* V, bf16* K, bf16* KK, bf16* L, bf16* QN, bf16* KN, bf16* VTN) {
    LAS bf16* VL = (LAS bf16*)C.lds;
    const int lane = C.lane, hh = lane >> 3, sub = lane & 7;
    const float C2 = 0.125f * LOG2E;
    for (int u = C.vcu; u < MT / 32; u += C.nb) {
        const int row0 = 32 * u; const bool lat = row0 < NLAT;
        const int b = lat ? (row0 >> 12) : ((row0 - NLAT) >> 8), pos0 = lat ? (row0 & 4095) : TL + ((row0 - NLAT) & 255), tseq = lat ? TL : LCX, tb = lat ? (row0 & 4095) : ((row0 - NLAT) & 255);
#define PREP_ROWVARS(i) const int pl = 4 * C.wave + (i), row = row0 + pl, t = tb + pl; const bool hp = t > 0, hn = t < tseq - 1; \
            const bf16* uc = U + (size_t)row * OD_INP; const bf16* up = uc - OD_INP; const bf16* un = uc + OD_INP
        { float s0[8], s1[8], s2[8]; load_sw(sw, 8 * lane, s0, s1, s2);
          for (int i = 0; i < 4; ++i) { PREP_ROWVARS(i); float o[8]; shifted8(up, uc, un, hp, hn, s0, s1, s2, 8 * lane, o); *(u32x4*)(R + (size_t)row * 512 + 8 * lane) = pack8(o); } }
        { float s0[8], s1[8], s2[8]; load_sw(sw, 1024 + 8 * lane, s0, s1, s2);
          for (int i = 0; i < 4; ++i) { PREP_ROWVARS(i); float o[8]; shifted8(up, uc, un, hp, hn, s0, s1, s2, 1024 + 8 * lane, o); *(u32x4*)(V + (size_t)row * 512 + 8 * lane) = pack8(o); } }
        { float s0[8], s1[8], s2[8]; load_sw(sw, 512 + 8 * lane, s0, s1, s2); float kw[8];
#pragma unroll
          for (int e = 0; e < 8; ++e) kw[e] = kkw[8 * lane + e];
          for (int i = 0; i < 4; ++i) { PREP_ROWVARS(i); float o[8]; shifted8(up, uc, un, hp, hn, s0, s1, s2, 512 + 8 * lane, o); *(u32x4*)(K + (size_t)row * 512 + 8 * lane) = pack8(o);
              float kk[8]; float ss = 0.f;
#pragma unroll
              for (int e = 0; e < 8; ++e) { kk[e] = o[e] * kw[e]; ss += kk[e] * kk[e]; }
              ss = sum8(ss); const float rn = 1.0f / sqrtf(ss + 1e-12f);
#pragma unroll
              for (int e = 0; e < 8; ++e) kk[e] *= rn;
              *(u32x4*)(KK + (size_t)row * 512 + 8 * lane) = pack8(kk); } }
        if (lane < 48) { float s0[8], s1[8], s2[8]; load_sw(sw, 1536 + 8 * lane, s0, s1, s2);
          for (int i = 0; i < 4; ++i) { PREP_ROWVARS(i); float o[8]; shifted8(up, uc, un, hp, hn, s0, s1, s2, 1536 + 8 * lane, o);
              if (lane < 16) {
#pragma unroll
                  for (int e = 0; e < 8; ++e) { const float ex = __expf(2.f * o[e]); o[e] = 1.f - 2.f * __builtin_amdgcn_rcpf(ex + 1.f); }
              } else if (lane >= 32) {
#pragma unroll
                  for (int e = 0; e < 8; ++e) o[e] = sigmoidf_(o[e]);
              }
              *(u32x4*)(L + (size_t)row * 384 + 8 * lane) = pack8(o); } }
        { float gq[8], gk[8];
#pragma unroll
          for (int e = 0; e < 8; ++e) { gq[e] = naqg[8 * sub + e] * C2; gk[e] = nakg[8 * sub + e]; }
          for (int i = 0; i < 4; ++i) { const int pl = 4 * C.wave + i, row = row0 + pl, pos = pos0 + pl; const bf16* uc = U + (size_t)row * OD_INP;
            { float x[8]; unpack8(*(const u32x4*)(uc + RW_IN + 8 * lane), x); float ss = 0.f;
#pragma unroll
                for (int e = 0; e < 8; ++e) ss += x[e] * x[e];
                ss = sum8(ss); const float rn = 1.0f / sqrtf(ss * (1.f / 64.f) + EPS);
#pragma unroll
                for (int e = 0; e < 8; ++e) x[e] = x[e] * rn * gq[e];
                *(u32x4*)(QN + ((size_t)(b * 8 + hh) * KPOS + pos) * 64 + 8 * sub) = pack8(x); }
            { float x[8]; unpack8(*(const u32x4*)(uc + RW_IN + 512 + 8 * lane), x); float ss = 0.f;
#pragma unroll
                for (int e = 0; e < 8; ++e) ss += x[e] * x[e];
                ss = sum8(ss); const float rn = 1.0f / sqrtf(ss * (1.f / 64.f) + EPS);
#pragma unroll
                for (int e = 0; e < 8; ++e) x[e] = x[e] * rn * gk[e];
                *(u32x4*)(KN + ((size_t)(b * 8 + hh) * KPOS + pos) * 64 + 8 * sub) = pack8(x); }
            { const u32x4 vv = *(const u32x4*)(uc + RW_IN + 1024 + 8 * lane); const unsigned w4[4] = {vv.x, vv.y, vv.z, vv.w};
#pragma unroll
                for (int e = 0; e < 8; ++e) { const int dv = 8 * sub + e; VL[(hh * 64 + dv) * 32 + pl] = (bf16)((e & 1) ? (w4[e >> 1] >> 16) : (w4[e >> 1] & 0xffffu)); } } } }
#undef PREP_ROWVARS
        __syncthreads();
        { const int hd = C.tid; bf16* dst = VTN + ((size_t)(b * 8 + (hd >> 6)) * 64 + (hd & 63)) * KPOS + pos0;
#pragma unroll
            for (int q = 0; q < 4; ++q) *(u32x4*)(dst + 8 * q) = *(const LAS u32x4*)(VL + hd * 32 + 8 * q); }
        __syncthreads();
    }
}

DI int scan_row(int s, int d, int b) { if (s < LCX) return NLAT + b * LCX + (d ? (LCX - 1 - s) : s); const int t = s - LCX; return b * TL + (d ? (TL - 1 - t) : t); }


constexpr int CCH = 16, NCHK = KPOS / CCH, NPROB = NB * 8 * 2 * NCHK, IMG_ELEMS = 3 * 32 * 16;
template <int N> struct ICk { static constexpr int value = N; };
DI int crow_(int reg, int h) { return (reg & 3) + 8 * (reg >> 2) + 4 * h; }
DI bf16x8 pack_lo8(const f32x16& x) {
    u32x4 p; p.x = pk2(x[0], x[1]); p.y = pk2(x[2], x[3]); p.z = pk2(x[4], x[5]); p.w = pk2(x[6], x[7]); return __builtin_bit_cast(bf16x8, p); }
DI bf16x8 pack_hi8(const f32x16& x) { u32x4 p; p.x = pk2(x[8], x[9]); p.y = pk2(x[10], x[11]); p.z = pk2(x[12], x[13]); p.w = pk2(x[14], x[15]); return __builtin_bit_cast(bf16x8, p); }
DI int perm16(int k) { return (k & ~15) | swap23(k & 15); }

DI void ph_wkv_pre(const Ctx& C, const bf16* R, const bf16* K, const bf16* KK, const unsigned short* LW, const bf16* AR_, const float* ka, bf16* IMG) {
    LAS unsigned char* wl = C.lds + C.wave * 13312;
    LAS bf16* ARl = (LAS bf16*)wl; LAS bf16* BKl = (LAS bf16*)(wl + 4608); LAS float* Ll = (LAS float*)(wl + 9216); LAS bf16* OUT = (LAS bf16*)(wl + 10240);
    const int lane = C.lane, r = lane & 31, h = lane >> 5;
    const int gw = C.vcu * 8 + C.wave, ngw = C.nb * 8;
    for (int p = gw; p < NPROB; p += ngw) {
        const int j = p % NCHK, rest = p / NCHK, d = rest & 1, hh = (rest >> 1) & 7, b = rest >> 4;
        const unsigned short* Wd = LW + (size_t)d * MT * 512; const bf16* Ad = AR_ + (size_t)d * MT * 512;
        const float kav = ka[hh * 64 + lane];
        const int row0 = scan_row(j * CCH, d, b), sg = d ? -1 : 1;
        float lw[16]; bf16 rr[16], kx[16], kkx[16], ax[16];
#pragma unroll
        for (int t = 0; t < 16; ++t) { const size_t off = (size_t)(row0 + sg * t) * 512 + hh * 64 + lane; lw[t] = h2f(Wd[off]); rr[t] = R[off]; kx[t] = K[off]; kkx[t] = KK[off]; ax[t] = Ad[off]; }
        float cum = 0.f, e0 = 1.f;
#pragma unroll
        for (int t = 0; t < 16; ++t) {
            cum += lw[t]; const float e1 = __expf(cum), ei = __builtin_amdgcn_rcpf(e1);
            const float kkv = bf2f(kkx[t]), av = bf2f(ax[t]), keff = bf2f(kx[t]) * (1.f + (av - 1.f) * kav);
            ARl[t * 72 + lane] = f2bf(-kkv * e0); ARl[(16 + t) * 72 + lane] = f2bf(bf2f(rr[t]) * e1);
            BKl[t * 72 + lane] = f2bf(kkv * av * ei); BKl[(16 + t) * 72 + lane] = f2bf(keff * ei);
            e0 = e1;
        }
        asm volatile("s_waitcnt lgkmcnt(0)" ::: "memory");
        f32x16 g;
#pragma unroll
        for (int i = 0; i < 16; ++i) g[i] = 0.f;
#pragma unroll
        for (int q = 0; q < 4; ++q) g = MFMA32(*(const LAS bf16x8*)(ARl + r * 72 + 16 * q + 8 * h), *(const LAS bf16x8*)(BKl + r * 72 + 16 * q + 8 * h), g);
        const int sI = r & 15; const bool isk = r >= 16;
#pragma unroll
        for (int i = 0; i < 16; ++i) {
            const int row = crow_(i, h), t = row & 15; const bool keep = (i < 8) ? (sI < t) : (sI <= t); const float val = keep ? g[i] : 0.f;
            if (i < 8) { if (!isk) { Ll[t * 16 + sI] = val; OUT[512 + row * 16 + perm16(sI)] = 0; } else OUT[row * 16 + sI] = f2bf(val); }
            else       { if (!isk) OUT[512 + row * 16 + perm16(sI)] = f2bf(val); else OUT[row * 16 + sI] = f2bf(val); }
        }
        asm volatile("s_waitcnt lgkmcnt(0)" ::: "memory");
        { const int c = lane & 15; float Pr[16];
            Pr[0] = (c == 0) ? 1.f : 0.f;
#pragma unroll
            for (int t = 1; t < 16; ++t) { const float lrow = Ll[t * 16 + c]; float acc = (c == t) ? 1.f : 0.f;
#pragma unroll
                for (int u = 0; u < t; ++u) acc += rdlane(lrow, u) * Pr[u];
                Pr[t] = acc; }
            if (lane < 16) {
#pragma unroll
                for (int t = 0; t < 16; ++t) { OUT[1024 + t * 16 + perm16(c)] = f2bf(Pr[t]); OUT[1024 + (16 + t) * 16 + c] = 0; } } }
        asm volatile("s_waitcnt lgkmcnt(0)" ::: "memory");
        { bf16* dst = IMG + (size_t)p * IMG_ELEMS;
#pragma unroll
            for (int q = 0; q < 3; ++q) *(u32x4*)(dst + (q * 64 + lane) * 8) = *(const LAS u32x4*)(OUT + (q * 64 + lane) * 8); }
        asm volatile("s_waitcnt lgkmcnt(0)" ::: "memory");
    }
}

DI void ph_wkv_chunk(const Ctx& C, const bf16* R, const bf16* V, const bf16* K, const bf16* KK, const unsigned short* LW, const bf16* AR_, const float* ka, const bf16* IMG, bf16* YS) {
    constexpr int S_AR = 0, S_BKT = 4608, S_VT = 9728, S_VT2 = 11264, S_GC = 12800, S_MM = 13056, S_MRB = 14592, S_PP = 16128, SLOT = 17664, CUMO = 2 * SLOT, YSTO = CUMO + 8192, DEPTH = 4;
    const int lane = C.lane, wv = C.wave, r = lane & 31, h = lane >> 5;
    const bool isE = wv == 2 || wv == 3 || wv == 6 || wv == 7, isS = wv < 2;
    const int te = (wv == 2 ? 0 : (wv == 3 ? 1 : (wv == 6 ? 2 : 3))) * 64 + lane, et = te >> 4, ekq = te & 15;
    const int vhf = te >> 7, vt = (te >> 3) & 15, viq = te & 7;
    const int hf = wv & 1;
    for (int cid0 = C.bid; cid0 < 128; cid0 += C.nb) {
        const int chain = cid0, b = chain >> 4, hh = (chain >> 1) & 7, d = chain & 1;
        const unsigned short* Wd = LW + (size_t)d * MT * 512; const bf16* Ad = AR_ + (size_t)d * MT * 512; bf16* Yd = YS + (size_t)d * MT * 512;
        const bf16* img = IMG + (size_t)(((b * 8 + hh) * 2 + d) * NCHK) * IMG_ELEMS;
        f32x16 ST[2];
#pragma unroll
        for (int i = 0; i < 16; ++i) { ST[0][i] = 0.f; ST[1][i] = 0.f; }
        const f32x4 kav = *(const f32x4*)(ka + hh * 64 + 4 * ekq);
        unsigned ring[DEPTH][16];
        __syncthreads();
        auto issue = [&](int ch, unsigned (&rg)[16]) __attribute__((always_inline)) {
            if (ch < 0 || ch >= NCHK) return;
            const int row0 = scan_row(ch * CCH, d, b), sg = d ? -1 : 1;
            if (isE) {
                const size_t off = (size_t)(row0 + sg * et) * 512 + hh * 64 + 4 * ekq;
                const u32x2 x0 = *(const u32x2*)(R + off), x1 = *(const u32x2*)(K + off), x2 = *(const u32x2*)(KK + off), x3 = *(const u32x2*)(Ad + off);
                const u32x2 x4 = *(const u32x2*)(V + (size_t)(row0 + sg * vt) * 512 + hh * 64 + 32 * vhf + 4 * viq);
                rg[0] = x0.x; rg[1] = x0.y; rg[2] = x1.x; rg[3] = x1.y; rg[4] = x2.x; rg[5] = x2.y; rg[6] = x3.x; rg[7] = x3.y; rg[8] = x4.x; rg[9] = x4.y;
                asm volatile("; wkv issue role E" ::);
            } else if (wv == 4) {
#define W5_(t) rg[(t)] = (unsigned)Wd[(size_t)(row0 + sg * (t)) * 512 + hh * 64 + lane]
                W5_(0); W5_(1); W5_(2); W5_(3); W5_(4); W5_(5); W5_(6); W5_(7); W5_(8); W5_(9); W5_(10); W5_(11); W5_(12); W5_(13); W5_(14); W5_(15);
#undef W5_
                asm volatile("; wkv issue role C" ::);
            } else if (wv == 5) {
#define W6_(q) do { const u32x4 x = *(const u32x4*)(img + (size_t)ch * IMG_ELEMS + ((q) * 64 + lane) * 8); rg[4 * (q)] = x.x; rg[4 * (q) + 1] = x.y; rg[4 * (q) + 2] = x.z; rg[4 * (q) + 3] = x.w; } while (0)
                W6_(0); W6_(1); W6_(2);
#undef W6_
                asm volatile("; wkv issue role V" ::);
            }
        };
        issue(0, ring[0]); issue(1, ring[1]); issue(2, ring[2]); issue(3, ring[3]);
#define WKV_BAR() asm volatile("s_waitcnt lgkmcnt(0)\n\ts_barrier" ::: "memory")
#define WKV_LOOP(...) for (int n0 = -2; n0 < NCHK; n0 += DEPTH) { auto iter = [&](auto kc) __attribute__((always_inline)) { constexpr int kk = decltype(kc)::value; \
            constexpr int riE = (kk + 3) % DEPTH, riW = kk % DEPTH; (void)riE; (void)riW; const int n = n0 + kk; (void)n; __VA_ARGS__; WKV_BAR(); }; iter(ICk<0>{}); iter(ICk<1>{}); iter(ICk<2>{}); iter(ICk<3>{}); }
        if (isS) {
            WKV_LOOP({
                if (n >= 0 && n < NCHK) {
                    const LAS unsigned char* B = C.lds + (n & 1) * SLOT;
                    f32x16 T1;
                    _Pragma("unroll") for (int i = 0; i < 16; ++i) T1[i] = 0.f;
                    _Pragma("unroll") for (int tau = 0; tau < 2; ++tau) {
                        T1 = MFMA32(*(const LAS bf16x8*)(B + S_AR + r * 144 + (32 * tau + 8 * h) * 2), pack_lo8(ST[tau]), T1);
                        T1 = MFMA32(*(const LAS bf16x8*)(B + S_AR + r * 144 + (32 * tau + 16 + 8 * h) * 2), pack_hi8(ST[tau]), T1);
                    }
                    const bf16x8 vtf = *(const LAS bf16x8*)(B + (hf ? S_VT2 : S_VT) + r * 48 + 16 * h);
                    T1 = MFMA32(*(const LAS bf16x8*)(B + S_MM + r * 48 + 16 * h), vtf, T1);
                    f32x16 ET;
                    _Pragma("unroll") for (int i = 0; i < 16; ++i) ET[i] = 0.f;
                    ET = MFMA32(*(const LAS bf16x8*)(B + S_PP + r * 48 + 16 * h), pack_lo8(T1), ET);
                    const bf16x8 ef = pack_lo8(ET);
                    T1 = MFMA32(*(const LAS bf16x8*)(B + S_MRB + r * 48 + 16 * h), ef, T1);
                    _Pragma("unroll") for (int tau = 0; tau < 2; ++tau) {
                        ST[tau] = MFMA32(*(const LAS bf16x8*)(B + S_BKT + (32 * tau + r) * 80 + 16 * h), ef, ST[tau]);
                        ST[tau] = MFMA32(*(const LAS bf16x8*)(B + S_BKT + (32 * tau + r) * 80 + 32 + 16 * h), vtf, ST[tau]);
                        _Pragma("unroll") for (int g4 = 0; g4 < 4; ++g4) { const f32x4 gc = *(const LAS f32x4*)(B + S_GC + (32 * tau + 8 * g4 + 4 * h) * 4);
                            ST[tau][4 * g4] *= gc.x; ST[tau][4 * g4 + 1] *= gc.y; ST[tau][4 * g4 + 2] *= gc.z; ST[tau][4 * g4 + 3] *= gc.w; }
                    }
                    LAS float* ys = (LAS float*)(C.lds + YSTO) + ((n & 1) * 2 + hf) * 512;
                    _Pragma("unroll") for (int q = 0; q < 8; ++q) ys[(8 * (q >> 2) + 4 * h + (q & 3)) * 32 + r] = T1[8 + q];
                }
            });
        } else if (isE) {
            WKV_LOOP({
                const int ch = n + 1;
                if (ch >= 0) {
                    if (ch < NCHK) {
                        LAS unsigned char* B = C.lds + (ch & 1) * SLOT; const LAS float* ec = (const LAS float*)(C.lds + CUMO) + (ch & 1) * 1024;
                        const f32x4 e1 = *(const LAS f32x4*)(ec + et * 64 + 4 * ekq);
                        f32x4 e0 = {1.f, 1.f, 1.f, 1.f}; if (et > 0) e0 = *(const LAS f32x4*)(ec + (et - 1) * 64 + 4 * ekq);
                        const float rv[4] = {bflo(ring[riE][0]), bfhi(ring[riE][0]), bflo(ring[riE][1]), bfhi(ring[riE][1])}; const float kv[4] = {bflo(ring[riE][2]), bfhi(ring[riE][2]), bflo(ring[riE][3]), bfhi(ring[riE][3])};
                        const float kkv[4] = {bflo(ring[riE][4]), bfhi(ring[riE][4]), bflo(ring[riE][5]), bfhi(ring[riE][5])}; const float av[4] = {bflo(ring[riE][6]), bfhi(ring[riE][6]), bflo(ring[riE][7]), bfhi(ring[riE][7])};
                        float ah[4]; float rh[4]; float bc[4]; float kc4[4];
                        _Pragma("unroll") for (int e = 0; e < 4; ++e) { const float ei = __builtin_amdgcn_rcpf(e1[e]);
                            ah[e] = -kkv[e] * e0[e]; rh[e] = rv[e] * e1[e]; bc[e] = kkv[e] * av[e] * ei; kc4[e] = kv[e] * (1.f + (av[e] - 1.f) * kav[e]) * ei; }
                        const int pk = perm16(4 * ekq);
                        *(LAS u32x2*)((LAS bf16*)(B + S_AR) + et * 72 + pk) = (u32x2){pk2(ah[0], ah[1]), pk2(ah[2], ah[3])};
                        *(LAS u32x2*)((LAS bf16*)(B + S_AR) + (16 + et) * 72 + pk) = (u32x2){pk2(rh[0], rh[1]), pk2(rh[2], rh[3])};
                        const int pt = perm16(et);
                        _Pragma("unroll") for (int e = 0; e < 4; ++e) { ((LAS bf16*)(B + S_BKT))[(4 * ekq + e) * 40 + pt] = f2bf(bc[e]); ((LAS bf16*)(B + S_BKT))[(4 * ekq + e) * 40 + 16 + et] = f2bf(kc4[e]); }
                        if (et == 15) *(LAS f32x4*)((LAS float*)(B + S_GC) + 4 * ekq) = e1;
                        LAS bf16* vtp = (LAS bf16*)(B + (vhf ? S_VT2 : S_VT)) + (4 * viq) * 24 + vt;
                        vtp[0] = (bf16)(ring[riE][8] & 0xffffu); vtp[24] = (bf16)(ring[riE][8] >> 16); vtp[48] = (bf16)(ring[riE][9] & 0xffffu); vtp[72] = (bf16)(ring[riE][9] >> 16);
                    }
                    issue(ch + DEPTH, ring[riE]);
                }
            });
        } else if (wv == 4) {
            WKV_LOOP({
                const int ch = n + 2;
                if (ch < NCHK) { LAS float* ec = (LAS float*)(C.lds + CUMO) + (ch & 1) * 1024; float c = 0.f;
#define C5_(t) do { c += h2f((unsigned short)ring[riW][(t)]); ec[(t) * 64 + lane] = __expf(c); } while (0)
                    C5_(0); C5_(1); C5_(2); C5_(3); C5_(4); C5_(5); C5_(6); C5_(7); C5_(8); C5_(9); C5_(10); C5_(11); C5_(12); C5_(13); C5_(14); C5_(15);
                }
                issue(ch + DEPTH, ring[riW]);
            });
        } else {
            WKV_LOOP({
                { const int chy = n - 1;
                  if (chy >= 0 && chy < NCHK) { const int yh = lane >> 5, yt = (lane & 31) >> 1, yi = 16 * (lane & 1);
                    const LAS float* ys = (const LAS float*)(C.lds + YSTO) + ((chy & 1) * 2 + yh) * 512 + yt * 32 + yi;
                    bf16* dst = Yd + (size_t)(scan_row(chy * CCH, d, b) + (d ? -1 : 1) * yt) * 512 + hh * 64 + 32 * yh + yi;
                    _Pragma("unroll") for (int q = 0; q < 2; ++q) { const f32x4 a0 = *(const LAS f32x4*)(ys + 8 * q); const f32x4 a1 = *(const LAS f32x4*)(ys + 8 * q + 4);
                        *(u32x4*)(dst + 8 * q) = (u32x4){pk2(a0.x, a0.y), pk2(a0.z, a0.w), pk2(a1.x, a1.y), pk2(a1.z, a1.w)}; } } }
                const int ch = n + 1;
                if (ch >= 0) {
                    if (ch < NCHK) { LAS unsigned char* B = C.lds + (ch & 1) * SLOT;
                        const int irow = lane >> 1; const int ihv = lane & 1;
                        *(LAS u32x4*)(B + S_MM + irow * 48 + ihv * 16) = (u32x4){ring[riE][0], ring[riE][1], ring[riE][2], ring[riE][3]};
                        *(LAS u32x4*)(B + S_MRB + irow * 48 + ihv * 16) = (u32x4){ring[riE][4], ring[riE][5], ring[riE][6], ring[riE][7]};
                        *(LAS u32x4*)(B + S_PP + irow * 48 + ihv * 16) = (u32x4){ring[riE][8], ring[riE][9], ring[riE][10], ring[riE][11]};
                    }
                    issue(ch + DEPTH, ring[riE]);
                }
            });
        }
#undef C5_
#undef WKV_LOOP
#undef WKV_BAR
    }
}

DI void ph_post(const Ctx& C, const bf16* YS, const bf16* R, const bf16* V, const bf16* K, const bf16* A2, const float* ka, const bf16* G, const float* rk, const float* gng, const float* gnb, bf16* OCAT, bool last) {
    const int gw = C.bid * 8 + C.wave, ngw = C.nb * 8, lane = C.lane, nrows = last ? NLAT : MT;
    for (int row = gw; row < nrows; row += ngw) {
        const size_t o = (size_t)row * 512 + 8 * lane;
        float y[8], y1[8]; unpack8(*(const u32x4*)(YS + o), y); unpack8(*(const u32x4*)(YS + (size_t)MT * 512 + o), y1);
#pragma unroll
        for (int e = 0; e < 8; ++e) y[e] += y1[e];
        float r[8], v[8], kx[8], a0[8], a1[8], g[8];
        unpack8(*(const u32x4*)(R + o), r); unpack8(*(const u32x4*)(V + o), v); unpack8(*(const u32x4*)(K + o), kx); unpack8(*(const u32x4*)(A2 + o), a0); unpack8(*(const u32x4*)(A2 + (size_t)MT * 512 + o), a1); unpack8(*(const u32x4*)(G + o), g);
        float bsum = 0.f;
#pragma unroll
        for (int e = 0; e < 8; ++e) { const float kae = ka[8 * lane + e]; bsum += r[e] * (kx[e] * (1.f + (a0[e] - 1.f) * kae) + kx[e] * (1.f + (a1[e] - 1.f) * kae)) * rk[8 * lane + e]; }
        bsum = sum8(bsum);
        float s = 0.f;
#pragma unroll
        for (int e = 0; e < 8; ++e) { y[e] += bsum * v[e]; s += y[e]; }
        const float mu = sum8(s) * (1.f / 64.f); float s2 = 0.f;
#pragma unroll
        for (int e = 0; e < 8; ++e) { y[e] -= mu; s2 += y[e] * y[e]; }
        const float rstd = 1.0f / sqrtf(sum8(s2) * (1.f / 64.f) + GN_EPS);
        float out[8];
#pragma unroll
        for (int e = 0; e < 8; ++e) out[e] = (y[e] * rstd * gng[8 * lane + e] + gnb[8 * lane + e]) * g[e];
        *(u32x4*)(OCAT + (size_t)row * DM + 8 * lane) = pack8(out);
    }
}

DI void ph_topk2(const Ctx& C, const float* AFFT, const float* AFFC, int* ROWS, float* GATE, int* SLOT, bool last) {
    LAS unsigned* wcnt = (LAS unsigned*)C.lds;
    LAS unsigned* cnt = wcnt + 16;
    const int tid = C.tid, nprob = last ? 128 : 256;
    for (int p = C.bid; p < nprob; p += C.nb) {
        const bool isctx = p >= 128; const int be = p & 127, b = be >> 4, e = be & 15;
        const int n = isctx ? LCX : TL, cap = isctx ? CAPC : CAPL;
        const float* src = isctx ? AFFC + (size_t)be * LCX : AFFT + (size_t)be * TL;
        unsigned v[8]; const int per = isctx ? 1 : 8, t0 = tid * per;
#pragma unroll
        for (int q = 0; q < 8; ++q) v[q] = 0u;
        if (!isctx) { const u32x4 a0 = *(const u32x4*)(src + t0), a1 = *(const u32x4*)(src + t0 + 4); v[0] = a0.x; v[1] = a0.y; v[2] = a0.z; v[3] = a0.w; v[4] = a1.x; v[5] = a1.y; v[6] = a1.z; v[7] = a1.w; }
        else if (tid < LCX) v[0] = __builtin_bit_cast(unsigned, src[tid]);
        __syncthreads();
        unsigned T = 0u;
        for (int bit = 30; bit >= 0; --bit) {
            const unsigned cand = T | (1u << bit); unsigned c = 0u;
#pragma unroll
            for (int q = 0; q < 8; ++q) c += (unsigned)__builtin_popcountll(__builtin_amdgcn_ballot_w64(v[q] >= cand));
            LAS unsigned* wc = wcnt + (bit & 1) * 8;
            if (C.lane == 0) wc[C.wave] = c;
            __syncthreads();
            const unsigned tot = wc[0] + wc[1] + wc[2] + wc[3] + wc[4] + wc[5] + wc[6] + wc[7];
            if (tot >= (unsigned)cap) T = cand;
        }
        unsigned myc = 0u;
#pragma unroll
        for (int q = 0; q < 8; ++q) myc += (v[q] > T ? 0x10000u : 0u) + ((v[q] == T && (isctx ? (q == 0 && tid < LCX) : true)) ? 1u : 0u);
        __syncthreads();
        cnt[tid] = myc;
        __syncthreads();
        for (int off = 1; off < 512; off <<= 1) { const unsigned add = tid >= off ? cnt[tid - off] : 0u; __syncthreads(); cnt[tid] += add; __syncthreads(); }
        const unsigned total = cnt[511], keq = (unsigned)cap - (total >> 16);
        unsigned before = cnt[tid] - myc;
        for (int q = 0; q < per; ++q) { const int t = t0 + q; if (t >= n) break; const unsigned x = v[q]; const unsigned gtb = before >> 16, eqb = before & 0xFFFFu;
            const bool sel = x > T || (x == T && eqb < keq);
            if (sel) { const int jx = (int)(gtb + (eqb < keq ? eqb : keq));
                const int slot = isctx ? NB * CAPL + b * CAPC + jx : b * CAPL + jx, row = isctx ? NLAT + b * LCX + t : b * TL + t;
                ROWS[e * ESLOTS + slot] = row; GATE[e * ESLOTS + slot] = __builtin_bit_cast(float, x); SLOT[(size_t)row * 16 + e] = slot; }
            before += (x > T ? 0x10000u : 0u) + (x == T ? 1u : 0u); }
        __syncthreads();
    }
}


DI void ph_combine(const Ctx& C, float* xlat, float* xctx, const float* modg2  , const int* SLOT, const bf16* Y2, bool last,
                   const float* ngain  , const float* nmod  , bf16* H) {
    const int gw = C.bid * 8 + C.wave, ngw = C.nb * 8, lane = C.lane, nrows = last ? NLAT : MT;
    for (int row = gw; row < nrows; row += ngw) {
        float* xr = row < NLAT ? xlat + (size_t)row * DM : xctx + (size_t)(row - NLAT) * DM;
        const int mi = row < NLAT ? (row >> 12) : 8;
        const int sv = SLOT[(size_t)row * 16 + (lane & 15)];
        f32x4 acc[4];
#pragma unroll
        for (int j = 0; j < 4; ++j) acc[j] = (f32x4){0.f, 0.f, 0.f, 0.f};
#pragma unroll
        for (int e = 0; e < 16; ++e) {
            const int s = __builtin_amdgcn_readlane(sv, e);
            if (s >= 0) { const bf16* yp = Y2 + ((size_t)e * ESLOTS + s) * DM + 4 * lane;
#pragma unroll
                for (int j = 0; j < 4; ++j) { const u32x2 w = *(const u32x2*)(yp + 256 * j); acc[j] += (f32x4){bflo(w.x), bfhi(w.x), bflo(w.y), bfhi(w.y)}; } }
        }
#pragma unroll
        for (int j = 0; j < 4; ++j) { const int c = 256 * j + 4 * lane; const f32x4 g = *(const f32x4*)(modg2 + mi * 6144 + c); f32x4 x = *(const f32x4*)(xr + c); x += g * acc[j]; *(f32x4*)(xr + c) = x; acc[j] = x; }
        if (ngain) {
            float ss = 0.f;
#pragma unroll
            for (int j = 0; j < 4; ++j) ss += acc[j].x * acc[j].x + acc[j].y * acc[j].y + acc[j].z * acc[j].z + acc[j].w * acc[j].w;
            const float rs = 1.0f / sqrtf(wave_sum(ss) * (1.f / 1024.f) + EPS);
            const float* mp = nmod + mi * 6144;
#pragma unroll
            for (int j = 0; j < 4; ++j) { const int c = 256 * j + 4 * lane;
                const f32x4 g = *(const f32x4*)(ngain + c), sc = *(const f32x4*)(mp + 1024 + c), sh = *(const f32x4*)(mp + c);
                const f32x4 hv = (acc[j] * rs) * g * (sc + 1.0f) + sh;
                *(u32x2*)(H + (size_t)row * DM + c) = (u32x2){pk2(hv.x, hv.y), pk2(hv.z, hv.w)}; }
        }
    }
}

template <int N> struct IC { static constexpr int value = N; };
DI const float* in_ptr(const unsigned char* ws, int k) { const unsigned long long v = ((const unsigned long long*)(ws + 128 * 1024))[k];
    const unsigned lo = __builtin_amdgcn_readfirstlane((unsigned)v), hi = __builtin_amdgcn_readfirstlane((unsigned)(v >> 32));
    return (const float*)(__attribute__((address_space(1))) const float*)(((unsigned long long)hi << 32) | lo); }
template <class T> DI T* launder_ptr(T* p) { unsigned long long v = (unsigned long long)p; unsigned lo = (unsigned)v, hi = (unsigned)(v >> 32); asm volatile("" : "+v"(lo), "+v"(hi));
    lo = __builtin_amdgcn_readfirstlane(lo); hi = __builtin_amdgcn_readfirstlane(hi); return (T*)(__attribute__((address_space(1))) T*)(((unsigned long long)hi << 32) | lo); }
constexpr int N_PHASES = 1 + 23 + 22;
constexpr size_t WS_PTRS = 128 * 1024;
#define P_XC    ((float*)(ws + WS_XC))
#define P_MOD   ((const float*)(ws + WS_MOD))
#define P_HB    ((bf16*)(ws + WS_HB))
#define P_OCAT  ((bf16*)(ws + WS_OCAT))
#define P_AR    (ws + WS_ARENA)
#define P_ROWS  ((int*)(ws + WS_ROWS))
#define P_GATE  ((float*)(ws + WS_GATE))
#define P_SLOT  ((int*)(ws + WS_SLOT))
#define P_AFFT  ((float*)(ws + WS_AFFT))
#define P_AFFC  ((float*)(ws + WS_AFFC))
#define P_W13   ((bf16*)(ws + WS_W13))
#define P_W2    ((bf16*)(ws + WS_W2))
#define P_U     ((bf16*)(P_AR + A_U))
#define P_QPRE  ((float*)(P_AR + A_QPRE))
#define P_KVPRE ((float*)(P_AR + A_KVPRE))
#define P_QB    ((bf16*)(P_AR + A_QB))
#define P_KB    ((bf16*)(P_AR + A_KB))
#define P_VT    ((bf16*)(P_AR + A_VT))
#define P_W     ((unsigned short*)(P_AR + A_W))
#define P_KEFF  ((bf16*)(P_AR + A_KEFF))
#define P_R     ((bf16*)(P_AR + A_R))
#define P_V     ((bf16*)(P_AR + A_V))
#define P_KK    ((bf16*)(P_AR + A_KK))
#define P_G     ((bf16*)(P_AR + A_G))
#define P_K     ((bf16*)(P_AR + A_K))
#define P_L     ((bf16*)(P_AR + A_L))
#define P_QN    ((bf16*)(P_AR + A_QN))
#define P_KN    ((bf16*)(P_AR + A_KN))
#define P_VTN   ((bf16*)(P_AR + A_VTN))
#define P_YS    ((bf16*)(P_AR + A_YS))
#define P_IMG   ((bf16*)(P_AR + A_IMG))
#define P_HID   ((bf16*)(P_AR + A_HID))
#define P_Y2    ((bf16*)(P_AR + A_Y2))
#define MODL(i) (P_MOD + (size_t)(i) * 9 * 6144)
#if MOE_F8
#define MOE1_PHASE(NMT) do { pg8::Gemm g{P_HB, P_W13, DM / 2, DM / 2, P_ROWS, SCALE_W, SCALE_ONE}; pg8::OrderMoE S{(NMT), 8, 17, C.nb, C.vcu}; pg8::EpiAdapt<EpiGlu8> E{EpiGlu8{(unsigned char*)P_HID}}; \
        pg8::gemm_phase<pg8::EpiAdapt<EpiGlu8>, pg8::OrderMoE, true>(C.lds, g, S, E, C.tid); } while (0)
#define MOE2_PHASE(NMT) do { pg8::Gemm g{P_HID, P_W2, DM / 2, DM / 2, nullptr, SCALE_W, SCALE_HID}; pg8::OrderMoE S{(NMT), 4, 17, C.nb, C.vcu}; pg8::EpiAdapt<EpiGate> E{EpiGate{P_Y2, P_GATE}}; \
        pg8::gemm_phase<pg8::EpiAdapt<EpiGate>, pg8::OrderMoE, true>(C.lds, g, S, E, C.tid); } while (0)
#else
#define MOE1_PHASE(NMT) do { pg8::Gemm g{P_HB, P_W13, DM, DM, P_ROWS}; pg8::OrderMoE S{(NMT), 8, 17, C.nb, C.vcu}; pg8::EpiAdapt<EpiGlu> E{EpiGlu{P_HID}}; pg8::gemm_phase(C.lds, g, S, E, C.tid); } while (0)
#define MOE2_PHASE(NMT) do { pg8::Gemm g{P_HID, P_W2, DM, DM, nullptr}; pg8::OrderMoE S{(NMT), 4, 17, C.nb, C.vcu}; pg8::EpiAdapt<EpiGate> E{EpiGate{P_Y2, P_GATE}}; pg8::gemm_phase(C.lds, g, S, E, C.tid); } while (0)
#endif
#define WPREP_TAIL(NUNITS, LAYER) do { __syncthreads(); const int extra_ = (NUNITS) % C.nb, j_ = C.vcu - extra_; const size_t wo_ = (size_t)(LAYER) * NEXP * DM * DM; \
        if (j_ >= 0) wprep_span(C, j_ * 8 + C.wave, (C.nb - extra_) * 8, in_ptr(ws, I_MW1) + wo_, in_ptr(ws, I_MW3) + wo_, in_ptr(ws, I_MW2) + wo_, (bf16*)(ws + WS_W13), (bf16*)(ws + WS_W2)); } while (0)
#define RELAUNDER() do { int l_ = C.lane; asm volatile("" : "+v"(l_)); C.lane = l_; C.tid = (C.wave << 6) | l_; } while (0)
__global__ void __launch_bounds__(512, 2) fwd_kernel(Args a) {
    extern __shared__ __attribute__((aligned(16))) unsigned char smem[];
    Ctx C0; C0.lds = (LAS unsigned char*)smem; C0.tid = threadIdx.x; C0.lane = C0.tid & 63; C0.wave = __builtin_amdgcn_readfirstlane(C0.tid >> 6); C0.bid = blockIdx.x; C0.nb = gridDim.x;
    C0.vcu = (C0.nb % 8 == 0) ? (C0.bid % 8) * (C0.nb / 8) + C0.bid / 8 : C0.bid;
    volatile LAS unsigned* bst = (volatile LAS unsigned*)(C0.lds + LDS_BYTES - 16);
#if MEGA
    if (C0.tid == 0) { bst[0] = 0u; bst[1] = 0u; }
    __syncthreads();
    const unsigned bar_x = xcd_barrier_post((unsigned*)(a.ws + WS_CTL) + 4096, bst, C0.tid == 0).x;
#define SEAM() do { if (ph < hi) { XcdBarrier b2_; b2_.bar = (unsigned*)(ws + WS_CTL) + 4096; b2_.x = bar_x; b2_.st = bst; xcd_barrier(b2_, C.tid == 0); } } while (0)
#else
#define SEAM() do { } while (0)
#endif
#if MEGA
    constexpr int lo = 0, hi = N_PHASES;
#else
    const int lo = a.ph_lo, hi = a.ph_hi;
#endif
    int ph = 0;
#ifndef ONLY
#define ONLY -1
#endif
#ifndef REPMASK
#define REPMASK 0
#endif
#ifndef SITE_LO
#define SITE_LO 0
#define SITE_HI 99
#endif
#define PHASE(SITE, ...) do { if ((ONLY < 0 || ONLY == (SITE)) && (SITE) >= SITE_LO && (SITE) <= SITE_HI && ph >= lo && ph < hi) { Ctx C; C.lds = C0.lds; \
        { int w_ = C0.wave; asm volatile("" : "+s"(w_)); unsigned m_ = ~0u; asm volatile("" : "+s"(m_)); int l_ = (int)__builtin_amdgcn_mbcnt_hi(m_, __builtin_amdgcn_mbcnt_lo(m_, 0u)); C.wave = w_; C.lane = l_; C.tid = (w_ << 6) | l_; } \
        { int b_ = C0.bid, n_ = C0.nb, v_ = C0.vcu; asm volatile("" : "+s"(b_), "+s"(n_), "+s"(v_)); C.bid = b_; C.nb = n_; C.vcu = v_; } \
        unsigned z_ = 0u; asm volatile("" : "+s"(z_)); unsigned char* ws = a.ws + z_; float* XL = a.out + z_; const int lq = __builtin_amdgcn_readfirstlane(lp); typedef const __attribute__((address_space(1))) float* gfp_t; const gfp_t* INT_ = (const gfp_t*)(ws + WS_PTRS); (void)INT_; (void)XL; (void)lq; \
        for (int rep_ = 0; rep_ < ((((REPMASK) >> (SITE)) & 1) ? 2 : 1); ++rep_) { __VA_ARGS__; if ((((REPMASK) >> (SITE)) & 1)) __syncthreads(); } ++ph; SEAM(); } else ++ph; } while (0)

    { const int lp = 0;
      PHASE(0, { if (C.bid == 0) { _Pragma("unroll") for (int k = 0; k < 40; ++k) if (C.tid == k) ((const float**)(ws + WS_PTRS))[k] = a.in[k]; }
                 ph_prologue(C, a); }); }

    auto layer_pair = [&](auto lpc) __attribute__((always_inline)) {
        constexpr int lp = decltype(lpc)::value;
        if constexpr (lp == 0) PHASE(1, { const int i = 2 * lq; const float* xl = (i == 0) ? in_ptr(ws, I_X) : XL; const float* xc = (i == 0) ? in_ptr(ws, I_CTX) : P_XC;
                   ph_norm<false>(C, xl, xc, in_ptr(ws, I_N1G) + i * DM, MODL(i), 0, 1024, P_HB, nullptr, nullptr, nullptr, nullptr); });
        PHASE(2, { EpiBf16 E{P_U, EV_INP}; fast_gemm(C, P_HB, DM, (const bf16*)(ws + WS_WEVIN) + (size_t)lq * EV_INP * DM, DM, MT / 256, EV_INP / 256, E); });
        PHASE(3, { EpiBf16 Eq{(bf16*)P_QPRE, 768}; fast_gemm(C, P_U, EV_INP, (const bf16*)(ws + WS_WUQ) + (size_t)lq * 768 * 384, 384, MT / 256, 3, Eq); RELAUNDER();
                   EpiBf16 Ek{(bf16*)P_KVPRE, 1024}; fast_gemm(C, P_U + 384, EV_INP, (const bf16*)(ws + WS_WUKV) + (size_t)lq * 1024 * 256, 256, MT / 256, 4, Ek, true); });
        PHASE(4, { ph_mla_fin(C, P_U, (const bf16*)P_QPRE, (const bf16*)P_KVPRE, in_ptr(ws, I_QG) + lq * 96, in_ptr(ws, I_KG) + lq * 96, (const f32x2*)(ws + WS_ROPE), P_QB, P_KB, P_VT);
                   const int extra_ = (MT / 64) % C.nb, j_ = C.vcu - extra_;
                   if (j_ >= 0) { for (int q_ = 0; q_ < CONV_PER_TAIL; ++q_) { const int cu_ = j_ + q_ * (C.nb - extra_); if (cu_ >= conv_in_fin(C.nb)) break;
                       float wk[31]; const float* dww = in_ptr(ws, I_DWW) + (size_t)lq * 31 * 512;
                       _Pragma("unroll") for (int kt = 0; kt < 31; ++kt) wk[kt] = dww[kt * 512 + C.tid];
                       conv_unit(C, cu_, P_U, wk, in_ptr(ws, I_DWB)[lq * 512 + C.tid], in_ptr(ws, I_LNG) + lq * 512, in_ptr(ws, I_LNB) + lq * 512, P_OCAT); } } });
        PHASE(5, ph_attn_mla2(C, P_QB, P_KB, P_VT, P_OCAT, false, ws, lq));
        PHASE(6, { const int i = 2 * lq; const float* xl = (i == 0) ? in_ptr(ws, I_X) : XL; const float* xc = (i == 0) ? in_ptr(ws, I_CTX) : P_XC;
                   { EpiResid E{xl, xc, XL, P_XC, MODL(i) + 2048}; fast_gemm(C, P_OCAT, DM, (const bf16*)(ws + WS_WEVOUT) + (size_t)lq * DM * DM, DM, MT / 256, 4, E); }
                   WPREP_TAIL(MT / 256 * 4, i); });
        PHASE(7, { const int i = 2 * lq; ph_norm<true>(C, XL, P_XC, in_ptr(ws, I_N2G) + i * DM, MODL(i), 3072, 4096, P_HB, in_ptr(ws, I_ROUTER) + (size_t)i * DM * 16, P_AFFT, P_AFFC, P_SLOT); });
        PHASE(8, ph_topk2(C, P_AFFT, P_AFFC, P_ROWS, P_GATE, P_SLOT, false));
        PHASE(9, { MOE1_PHASE(17); });
        PHASE(10, { MOE2_PHASE(17); });
        PHASE(11, { const int i = 2 * lq; ph_combine(C, XL, P_XC, MODL(i) + 5120, P_SLOT, P_Y2, false, in_ptr(ws, I_N1G) + (i + 1) * DM, MODL(i + 1), P_HB); });
        PHASE(13, { EpiBf16 E{P_U, OD_INP}; fast_gemm(C, P_HB, DM, (const bf16*)(ws + WS_WODIN) + (size_t)lq * OD_INP * DM, DM, MT / 256, OD_INP / 256, E); });
        PHASE(14, ph_prep(C, P_U, in_ptr(ws, I_SHIFTW) + (size_t)lq * 3 * RW_IN, in_ptr(ws, I_KKW) + lq * 512, in_ptr(ws, I_NAQG) + lq * 64, in_ptr(ws, I_NAKG) + lq * 64, P_R, P_V, P_K, P_KK, P_L, P_QN, P_KN, P_VTN));
        PHASE(15, { const bf16* WL = (const bf16*)(ws + WS_WLORA) + (size_t)lq * 655360;
                    { EpiLoraW E{P_W, in_ptr(ws, I_W0) + lq * 1024}; fast_gemm(C, P_L, 384, WL, 256, MT / 256, 4, E); } RELAUNDER();
                    { EpiLoraA E{P_KEFF, in_ptr(ws, I_A0) + lq * 1024}; fast_gemm(C, P_L, 384, WL + (size_t)1024 * 256, 256, MT / 256, 4, E, true); } RELAUNDER();
                    { EpiBf16 E{P_G, 512}; fast_gemm(C, P_L + 128, 384, WL + (size_t)2048 * 256, 256, MT / 256, 2, E); } });
        PHASE(16, ph_wkv_pre(C, P_R, P_K, P_KK, P_W, P_KEFF, in_ptr(ws, I_KA) + lq * 512, P_IMG));
        PHASE(17, { ph_wkv_chunk(C, P_R, P_V, P_K, P_KK, P_W, P_KEFF, in_ptr(ws, I_KA) + lq * 512, P_IMG, P_YS); __syncthreads();
                    ph_natten2(C, P_QN, P_KN, P_VTN, P_OCAT, in_ptr(ws, I_RPB) + (size_t)lq * 8 * 465, lq == 1, (unsigned*)(ws + WS_CTL) + 8192 + 64 * lq, ws, lq); });
        PHASE(18, ph_post(C, P_YS, P_R, P_V, P_K, P_KEFF, in_ptr(ws, I_KA) + lq * 512, P_G, in_ptr(ws, I_RK) + lq * 512, in_ptr(ws, I_GNG) + lq * 512, in_ptr(ws, I_GNB) + lq * 512, P_OCAT, lq == 1));
        PHASE(19, { const int i = 2 * lq + 1; EpiResid E{XL, P_XC, XL, P_XC, MODL(i) + 2048};
                    fast_gemm(C, P_OCAT, DM, (const bf16*)(ws + WS_WODOUT) + (size_t)lq * DM * DM, DM, (lq == 1) ? NLAT / 256 : MT / 256, 4, E);
                    WPREP_TAIL(((lq == 1) ? NLAT / 256 : MT / 256) * 4, i); });
        PHASE(20, { const int i = 2 * lq + 1; ph_norm<true>(C, XL, P_XC, in_ptr(ws, I_N2G) + i * DM, MODL(i), 3072, 4096, P_HB, in_ptr(ws, I_ROUTER) + (size_t)i * DM * 16, P_AFFT, P_AFFC, P_SLOT); });
        PHASE(21, ph_topk2(C, P_AFFT, P_AFFC, P_ROWS, P_GATE, P_SLOT, lq == 1));
        PHASE(22, { MOE1_PHASE((lq == 1) ? 16 : 17); });
        PHASE(23, { MOE2_PHASE((lq == 1) ? 16 : 17); });
        PHASE(24, { const int i = 2 * lq + 1;
                    if (lp == 0) ph_combine(C, XL, P_XC, MODL(i) + 5120, P_SLOT, P_Y2, false, in_ptr(ws, I_N1G) + (i + 1) * DM, MODL(i + 1), P_HB);
                    else ph_combine(C, XL, P_XC, MODL(i) + 5120, P_SLOT, P_Y2, true, nullptr, nullptr, nullptr); });
    };
    layer_pair(IC<0>{}); layer_pair(IC<1>{});
}

extern "C" void kernel_launch(void* const* d_in, const int* in_sizes, int n_in, void* d_out, int out_size, void* d_ws, size_t ws_size, hipStream_t stream) {
    static int grid = 0;
    if (grid == 0) {
        if (n_in != 40 || out_size != NLAT * DM || ws_size < WS_END) { fprintf(stderr, "kernel_launch: unexpected shapes (n_in %d out %d ws %zu need %zu)\n", n_in, out_size, ws_size, (size_t)WS_END); grid = -1; return; }
        int dev = 0, cus = 0, per_cu = 0;
        if (hipGetDevice(&dev) != hipSuccess || hipDeviceGetAttribute(&cus, hipDeviceAttributeMultiprocessorCount, dev) != hipSuccess) { grid = -1; return; }
        if (hipFuncSetAttribute((const void*)fwd_kernel, hipFuncAttributeMaxDynamicSharedMemorySize, LDS_BYTES) != hipSuccess) { fprintf(stderr, "kernel_launch: hipFuncSetAttribute failed\n"); grid = -1; return; }
        if (hipOccupancyMaxActiveBlocksPerMultiprocessor(&per_cu, (const void*)fwd_kernel, 512, LDS_BYTES) != hipSuccess || per_cu < 1) { fprintf(stderr, "kernel_launch: occupancy query says %d\n", per_cu); per_cu = 1; }
        (void)hipGetLastError();
        grid = cus;
    }
    if (grid < 0) return;
    (void)hipMemsetAsync((char*)d_ws + WS_CTL, 0, CTL_BYTES, stream);
    Args a{};
    for (int i = 0; i < 40; ++i) a.in[i] = (const float*)d_in[i];
    a.out = (float*)d_out; a.ws = (unsigned char*)d_ws;
#if MEGA
    a.ph_lo = 0; a.ph_hi = N_PHASES;
    hipLaunchKernelGGL(fwd_kernel, dim3(grid), dim3(512), LDS_BYTES, stream, a);
#else
    for (int p = 0; p < N_PHASES; ++p) { a.ph_lo = p; a.ph_hi = p + 1; hipLaunchKernelGGL(fwd_kernel, dim3(grid), dim3(512), LDS_BYTES, stream, a); }
#endif
}
```

```cpp
#include <hip/hip_runtime.h>
#include <cstdio>
#include <cstdint>

#ifndef MEGA
#define MEGA 1
#endif

#define LAS __attribute__((address_space(3)))
#define DI __device__ __forceinline__

typedef unsigned short bf16;
typedef short bf16x8 __attribute__((ext_vector_type(8)));
typedef float f32x4 __attribute__((ext_vector_type(4)));
typedef float f32x2 __attribute__((ext_vector_type(2)));
typedef float f32x16 __attribute__((ext_vector_type(16)));
typedef unsigned u32x4 __attribute__((ext_vector_type(4)));
typedef unsigned u32x2 __attribute__((ext_vector_type(2)));
typedef __bf16 bf16x2_t __attribute__((ext_vector_type(2)));

constexpr int DM = 1024, NB = 8, TL = 4096, LCX = 256;
constexpr int NLAT = NB * TL, NCTX = NB * LCX, MT = NLAT + NCTX;
constexpr int KPOS = TL + LCX;
constexpr float EPS = 1e-6f, GN_EPS = 64e-5f;
constexpr int EV_IN = 1696, EV_INP = 1792, OD_IN = 3456, OD_INP = 3584, RW_IN = 1920;
constexpr int NEXP = 16, CAPL = 512, CAPC = 32, ESLOTS = NB * CAPL + NB * CAPC;
constexpr float LOG2E = 1.4426950408889634f;

constexpr size_t MiB = 1ull << 20;
constexpr size_t WS_CTL = 0, CTL_BYTES = 1 * MiB;
constexpr size_t WS_MOD = 1 * MiB, WS_ROPE = 2 * MiB, WS_XC = 4 * MiB;
constexpr size_t WS_ROWS = 12 * MiB, WS_GATE = 12 * MiB + 512 * 1024, WS_SLOT = 13 * MiB, WS_AFFT = 16 * MiB, WS_AFFC = 18 * MiB;
constexpr size_t WS_WEVIN = 20 * MiB, WS_WEVOUT = 27 * MiB, WS_WUQ = 31 * MiB, WS_WUKV = 33 * MiB, WS_WODIN = 34 * MiB, WS_WODOUT = 48 * MiB, WS_WLORA = 52 * MiB;
constexpr size_t WS_W13 = 56 * MiB, WS_W2 = 120 * MiB, WS_HB = 152 * MiB, WS_OCAT = 220 * MiB, WS_ARENA = 288 * MiB;
constexpr size_t A_U = 0, A_QPRE = 119 * MiB, A_KVPRE = 221 * MiB, A_QB = 357 * MiB, A_KB = 408 * MiB, A_VT = 459 * MiB;
constexpr size_t A_W = 0, A_KEFF = 136 * MiB  , A_G = 204 * MiB, A_R = 238 * MiB, A_V = 272 * MiB, A_KK = 306 * MiB, A_K = 340 * MiB, A_L = 374 * MiB,
                 A_QN = 400 * MiB, A_KN = 434 * MiB, A_VTN = 468 * MiB, A_YS = 612 * MiB  ;
constexpr size_t A_HID = 0, A_Y2 = 136 * MiB;
constexpr size_t A_IMG = 510 * MiB;
constexpr size_t WS_END = WS_ARENA + 680 * MiB;
constexpr int LDS_BYTES = 147456;

DI unsigned pk2(float lo, float hi) { f32x2 v = {lo, hi}; bf16x2_t b = __builtin_convertvector(v, bf16x2_t); return __builtin_bit_cast(unsigned, b); }
DI float bflo(unsigned u) { return __builtin_bit_cast(float, u << 16); }
DI float bfhi(unsigned u) { return __builtin_bit_cast(float, u & 0xffff0000u); }
DI float bf2f(bf16 x) { return __builtin_bit_cast(float, ((unsigned)x) << 16); }
DI bf16 f2bf(float f) { return (bf16)(pk2(f, 0.f) & 0xffffu); }
DI void unpack8(u32x4 v, float (&f)[8]) { f[0] = bflo(v.x); f[1] = bfhi(v.x); f[2] = bflo(v.y); f[3] = bfhi(v.y); f[4] = bflo(v.z); f[5] = bfhi(v.z); f[6] = bflo(v.w); f[7] = bfhi(v.w); }
DI u32x4 pack8(const float (&f)[8]) { u32x4 r; r.x = pk2(f[0], f[1]); r.y = pk2(f[2], f[3]); r.z = pk2(f[4], f[5]); r.w = pk2(f[6], f[7]); return r; }
#define DPP_ADD(x, ctrl) ((x) + __builtin_bit_cast(float, __builtin_amdgcn_update_dpp(0, __builtin_bit_cast(int, (x)), (ctrl), 0xf, 0xf, false)))
#define DPP_MAX(x, ctrl) fmaxf((x), __builtin_bit_cast(float, __builtin_amdgcn_update_dpp(0, __builtin_bit_cast(int, (x)), (ctrl), 0xf, 0xf, false)))
DI float sum8(float x) { x = DPP_ADD(x, 0xB1); x = DPP_ADD(x, 0x4E); x = DPP_ADD(x, 0x141); return x; }
DI float sum16(float x) { x = DPP_ADD(x, 0xB1); x = DPP_ADD(x, 0x4E); x = DPP_ADD(x, 0x141); x = DPP_ADD(x, 0x140); return x; }
DI float max16(float x) { x = DPP_MAX(x, 0xB1); x = DPP_MAX(x, 0x4E); x = DPP_MAX(x, 0x141); x = DPP_MAX(x, 0x140); return x; }
DI float rdlane(float x, int l) { return __builtin_bit_cast(float, __builtin_amdgcn_readlane(__builtin_bit_cast(int, x), l)); }
DI float wave_sum(float v) { const float x = sum16(v); return (rdlane(x, 0) + rdlane(x, 16)) + (rdlane(x, 32) + rdlane(x, 48)); }
DI float xor32(float v, int lane) { return __builtin_bit_cast(float, __builtin_amdgcn_ds_bpermute((lane ^ 32) << 2, __builtin_bit_cast(int, v))); }
typedef int v8i_t __attribute__((ext_vector_type(8)));
typedef int i32x4_t __attribute__((ext_vector_type(4)));
DI unsigned pk4_fp8(float a, float b, float c, float d) {
    a = __builtin_amdgcn_fmed3f(a, -448.f, 448.f); b = __builtin_amdgcn_fmed3f(b, -448.f, 448.f); c = __builtin_amdgcn_fmed3f(c, -448.f, 448.f); d = __builtin_amdgcn_fmed3f(d, -448.f, 448.f);
    int p = __builtin_amdgcn_cvt_pk_fp8_f32(a, b, 0, false); p = __builtin_amdgcn_cvt_pk_fp8_f32(c, d, p, true); return (unsigned)p; }
#ifndef MOE_F8
#define MOE_F8 1
#endif
constexpr int SCALE_ONE = 0x7f7f7f7f, SCALE_W = 0x79797979  , SCALE_HID = 0x7c7c7c7c  ;
DI float sigmoidf_(float x) { return __builtin_amdgcn_rcpf(1.f + __expf(-x)); }
DI float siluf_(float x) { return x * __builtin_amdgcn_rcpf(1.f + __expf(-x)); }
#define MFMA32(a, b, c) __builtin_amdgcn_mfma_f32_32x32x16_bf16((a), (b), (c), 0, 0, 0)

#define XB_TMO      128
#define XB_XCNT(j)  (256  + 64 * (j))
#define XB_XSUB(j)  (1280 + 64 * (j))
#define XB_XGEN(j)  (2304 + 64 * (j))
#define XB_TOP      3328
#define XB_TOPGEN   3392
#define XCD_BAR_WORDS 3456
#define XB_SPIN_CAP (1u << 22)
__device__ __forceinline__ unsigned xb_ld(unsigned* p)              { return __hip_atomic_load(p, __ATOMIC_RELAXED, __HIP_MEMORY_SCOPE_AGENT); }
__device__ __forceinline__ unsigned xb_add(unsigned* p, unsigned v) { return __hip_atomic_fetch_add(p, v, __ATOMIC_RELAXED, __HIP_MEMORY_SCOPE_AGENT); }
__device__ __forceinline__ unsigned xb_xcc_id() { return (unsigned)__builtin_amdgcn_s_getreg((3 << 11) | 20) & 0xFu; }
#define XB_SPIN(cond, bar) do { unsigned _sp = 0; while (cond) { __builtin_amdgcn_s_sleep(1); \
    if ((++_sp & 255u) == 0u) { if (xb_ld(&(bar)[XB_TMO])) break; if (_sp > XB_SPIN_CAP) { atomicAdd(&(bar)[XB_TMO], 1u); break; } } } } while (0)
struct XcdBarrier { unsigned* bar; unsigned x; volatile LAS unsigned* st; };
__device__ __forceinline__ XcdBarrier xcd_barrier_post(unsigned* bar, volatile LAS unsigned* st, bool leader) {
    XcdBarrier b; b.bar = bar; b.x = xb_xcc_id(); b.st = st;
    if (leader) (void)xb_add(&bar[XB_XCNT(b.x)], 1u);
    return b;
}
__device__ __forceinline__ void xcd_barrier_complete(unsigned* bar, unsigned x, unsigned& nloc, unsigned& nx) {
    const unsigned G = gridDim.x * gridDim.y * gridDim.z;
    unsigned sum, cnt, mine, sp = 0u;
    for (;;) {
        sum = 0u; cnt = 0u; mine = 0u;
#pragma unroll
        for (unsigned j = 0; j < 16; ++j) { const unsigned c = xb_ld(&bar[XB_XCNT(j)]); sum += c; cnt += (c > 0u) ? 1u : 0u; mine = (j == x) ? c : mine; }
        if (sum == G) break;
        __builtin_amdgcn_s_sleep(1);
        if ((++sp & 255u) == 0u) { if (xb_ld(&bar[XB_TMO])) break; if (sp > XB_SPIN_CAP) { atomicAdd(&bar[XB_TMO], 1u); break; } }
    }
    nloc = mine > 0u ? mine : 1u; nx = cnt > 0u ? cnt : 1u;
}
__device__ __forceinline__ void xcd_barrier(const XcdBarrier& b, bool leader) {
    asm volatile("s_waitcnt vmcnt(0)" ::: "memory");
    __syncthreads();
    if (leader) {
        unsigned* bar = b.bar;
        __builtin_amdgcn_s_waitcnt(0);
        unsigned nloc = b.st[0], nx = b.st[1];
        if (nloc == 0u) { xcd_barrier_complete(bar, b.x, nloc, nx); b.st[0] = nloc; b.st[1] = nx; }
        const unsigned old = xb_add(&bar[XB_XSUB(b.x)], 1u);
        const unsigned gen = old / nloc;
        if (old + 1u == (gen + 1u) * nloc) {
            __builtin_amdgcn_fence(__ATOMIC_RELEASE, "agent");
            asm volatile("s_waitcnt vmcnt(0)" ::: "memory");
            const unsigned og = xb_add(&bar[XB_TOP], 1u);
            const unsigned tg = og / nx;
            if (og + 1u == (tg + 1u) * nx) xb_add(&bar[XB_TOPGEN], 1u);
            else XB_SPIN(xb_ld(&bar[XB_TOPGEN]) == tg, bar);
            __builtin_amdgcn_fence(__ATOMIC_ACQUIRE, "agent");
            xb_add(&bar[XB_XGEN(b.x)], 1u);
            asm volatile("s_waitcnt vmcnt(0)" ::: "memory");
        } else {
            XB_SPIN(xb_ld(&bar[XB_XGEN(b.x)]) == gen, bar);
            __builtin_amdgcn_fence(__ATOMIC_ACQUIRE, "agent");
            asm volatile("s_waitcnt vmcnt(0)" ::: "memory");
        }
    }
    __syncthreads();
}

struct Ctx { LAS unsigned char* lds; int tid, lane, wave, bid, nb, vcu; };
struct Args { const float* in[40]; float* out; unsigned char* ws; int ph_lo, ph_hi; };
enum { I_X = 0, I_C, I_CTX, I_CCTX, I_ADAW, I_ADAB, I_N1G, I_N2G, I_EVWIN, I_EVWOUT, I_QNORM, I_WUQ, I_KVNORM, I_WUKV, I_QG, I_KG, I_DWW, I_DWB, I_LNG, I_LNB,
       I_ODWIN, I_ODWOUT, I_SHIFTW, I_W0, I_W2L, I_A0, I_A2, I_G2, I_KKW, I_KA, I_RK, I_GNG, I_GNB, I_NAQG, I_NAKG, I_RPB, I_ROUTER, I_MW1, I_MW3, I_MW2 };

DI void transpose_item(const float* __restrict__ W, int K, int N, bf16* __restrict__ WT, int dst_row0, const float* __restrict__ gain, LAS float* scr, int k0, int n0, int lane) {
#pragma unroll 8
    for (int i = 0; i < 32; ++i) { const int kk = 2 * i + (lane >> 5); float v = W[(size_t)(k0 + kk) * N + n0 + (lane & 31)]; if (gain) v *= gain[k0 + kk]; scr[kk * 33 + (lane & 31)] = v; }
    asm volatile("s_waitcnt lgkmcnt(0)" ::: "memory");
    const int c = lane & 7;
#pragma unroll
    for (int j = 0; j < 4; ++j) { const int n = (lane >> 3) + 8 * j; const LAS float* s = scr + (8 * c) * 33 + n;
        u32x4 o; o.x = pk2(s[0 * 33], s[1 * 33]); o.y = pk2(s[2 * 33], s[3 * 33]); o.z = pk2(s[4 * 33], s[5 * 33]); o.w = pk2(s[6 * 33], s[7 * 33]);
        *(u32x4*)(WT + (size_t)(dst_row0 + n) * K + k0 + 8 * c) = o; }
    asm volatile("s_waitcnt lgkmcnt(0)" ::: "memory");
}
DI void transpose_item64(const float* __restrict__ W, int K, int N, bf16* __restrict__ WT, int dst_row0, LAS float* scr, int k0, int n0, int lane) {
    f32x4 v[16];
#pragma unroll
    for (int i = 0; i < 16; ++i) v[i] = *(const f32x4*)(W + (size_t)(k0 + 4 * i + (lane >> 4)) * N + n0 + 4 * (lane & 15));
#pragma unroll
    for (int i = 0; i < 16; ++i) { LAS float* d = scr + (4 * i + (lane >> 4)) * 65 + 4 * (lane & 15); d[0] = v[i].x; d[1] = v[i].y; d[2] = v[i].z; d[3] = v[i].w; }
    asm volatile("s_waitcnt lgkmcnt(0)" ::: "memory");
    const int c = lane & 7;
#pragma unroll
    for (int j = 0; j < 8; ++j) { const int n = (lane >> 3) + 8 * j; const LAS float* s = scr + (8 * c) * 65 + n;
        u32x4 o; o.x = pk2(s[0 * 65], s[1 * 65]); o.y = pk2(s[2 * 65], s[3 * 65]); o.z = pk2(s[4 * 65], s[5 * 65]); o.w = pk2(s[6 * 65], s[7 * 65]);
        *(u32x4*)(WT + (size_t)(dst_row0 + n) * K + k0 + 8 * c) = o; }
    asm volatile("s_waitcnt lgkmcnt(0)" ::: "memory");
}
DI void transpose_item64_f8(const float* __restrict__ W, int K, int N, unsigned char* __restrict__ WT8, int dst_row0, LAS float* scr, int k0, int n0, int lane) {
    f32x4 v[16];
#pragma unroll
    for (int i = 0; i < 16; ++i) v[i] = *(const f32x4*)(W + (size_t)(k0 + 4 * i + (lane >> 4)) * N + n0 + 4 * (lane & 15));
#pragma unroll
    for (int i = 0; i < 16; ++i) { LAS float* d = scr + (4 * i + (lane >> 4)) * 65 + 4 * (lane & 15); d[0] = v[i].x; d[1] = v[i].y; d[2] = v[i].z; d[3] = v[i].w; }
    asm volatile("s_waitcnt lgkmcnt(0)" ::: "memory");
    const int c = lane & 7;
#pragma unroll
    for (int j = 0; j < 8; ++j) { const int n = (lane >> 3) + 8 * j; const LAS float* s = scr + (8 * c) * 65 + n;
        u32x2 o; o.x = pk4_fp8(64.f * s[0 * 65], 64.f * s[1 * 65], 64.f * s[2 * 65], 64.f * s[3 * 65]); o.y = pk4_fp8(64.f * s[4 * 65], 64.f * s[5 * 65], 64.f * s[6 * 65], 64.f * s[7 * 65]);
        *(u32x2*)(WT8 + (size_t)(dst_row0 + n) * K + k0 + 8 * c) = o; }
    asm volatile("s_waitcnt lgkmcnt(0)" ::: "memory");
}
DI void transpose_matrix(const Ctx& C, const float* W, int K, int N, bf16* WT, const float* gain, int mode  ) {
    LAS float* scr = (LAS float*)(C.lds + C.wave * 8704);
    const int nkb = K / 64, nnb = N / 32, nit = nkb * nnb, gw = C.vcu * 8 + C.wave, ngw = C.nb * 8;
    for (int it = gw; it < nit; it += ngw) {
        const int kb = it / nnb, nbk = it % nnb, n0 = nbk * 32;
        int d0 = n0; if (mode) d0 = (n0 >> 7) * 256 + (n0 & 127) + (mode == 2 ? 128 : 0);
        transpose_item(W, K, N, WT, d0, gain, scr, kb * 64, n0, C.lane);
    }
}

DI void ph_prologue(const Ctx& C, const Args& a) {
    unsigned char* ws = a.ws;
    {
        LAS float* sv = (LAS float*)C.lds;
        LAS float* red = sv + 9 * 1024;
        for (int i = C.tid; i < 9 * 1024; i += 512) { const int m = i >> 10, k = i & 1023; const float c = (m < 8) ? a.in[I_C][m * 1024 + k] : a.in[I_CCTX][k]; sv[i] = siluf_(c); }
        __syncthreads();
        float* MOD = (float*)(ws + WS_MOD);
        for (int it = C.bid; it < 4 * 96; it += C.nb) {
            const int layer = it / 96, col = (it % 96) * 64 + C.lane;
            const float* wp = a.in[I_ADAW] + (size_t)layer * 1024 * 6144 + col;
            float acc[9];
#pragma unroll
            for (int m = 0; m < 9; ++m) acc[m] = 0.f;
            const int kb = C.wave * 128;
#pragma unroll 16
            for (int k = 0; k < 128; ++k) { const float w = wp[(size_t)(kb + k) * 6144];
#pragma unroll
                for (int m = 0; m < 9; ++m) acc[m] += sv[m * 1024 + kb + k] * w; }
#pragma unroll
            for (int m = 0; m < 9; ++m) red[(C.wave * 9 + m) * 64 + C.lane] = acc[m];
            __syncthreads();
            for (int i = C.tid; i < 576; i += 512) { const int m = i >> 6, l = i & 63; float s = 0.f;
#pragma unroll
                for (int w = 0; w < 8; ++w) s += red[(w * 9 + m) * 64 + l];
                const int cc = (it % 96) * 64 + l;
                MOD[(size_t)(layer * 9 + m) * 6144 + cc] = s + a.in[I_ADAB][layer * 6144 + cc]; }
            __syncthreads();
        }
    }
    {
        f32x2* CS = (f32x2*)(ws + WS_ROPE);
        for (int i = C.bid * 512 + C.tid; i < 4096 * 16; i += C.nb * 512) {
            const int pos = i >> 4, j = i & 15, f = j & 7;
            const float inv = powf(10000.f, -(float)(2 * f) / 16.f);
            const float ang = (float)((j < 8) ? (pos >> 6) : (pos & 63)) * inv;
            const double tw = 6.283185307179586476925;
            const double x = (double)ang, n = __builtin_rint(x / tw), rr = x - n * tw;
            CS[i] = (f32x2){__cosf((float)rr), __sinf((float)rr)};
        }
    }
    for (int j = 0; j < 2; ++j) {
        transpose_matrix(C, a.in[I_EVWIN] + (size_t)j * DM * EV_IN, DM, EV_IN, (bf16*)(ws + WS_WEVIN) + (size_t)j * EV_INP * DM, nullptr, 0);
        transpose_matrix(C, a.in[I_EVWOUT] + (size_t)j * DM * DM, DM, DM, (bf16*)(ws + WS_WEVOUT) + (size_t)j * DM * DM, nullptr, 0);
        transpose_matrix(C, a.in[I_WUQ] + (size_t)j * 384 * 768, 384, 768, (bf16*)(ws + WS_WUQ) + (size_t)j * 768 * 384, a.in[I_QNORM] + j * 384, 0);
        transpose_matrix(C, a.in[I_WUKV] + (size_t)j * 256 * 1024, 256, 1024, (bf16*)(ws + WS_WUKV) + (size_t)j * 1024 * 256, a.in[I_KVNORM] + j * 256, 0);
        transpose_matrix(C, a.in[I_ODWIN] + (size_t)j * DM * OD_IN, DM, OD_IN, (bf16*)(ws + WS_WODIN) + (size_t)j * OD_INP * DM, nullptr, 0);
        transpose_matrix(C, a.in[I_ODWOUT] + (size_t)j * DM * DM, DM, DM, (bf16*)(ws + WS_WODOUT) + (size_t)j * DM * DM, nullptr, 0);
    }
    {
        const int gt = C.bid * 512 + C.tid, ngt = C.nb * 512;
        for (int j = 0; j < 2; ++j) {
            u32x4* p0 = (u32x4*)((bf16*)(ws + WS_WEVIN) + (size_t)j * EV_INP * DM + (size_t)EV_IN * DM);
            for (int i = gt; i < (EV_INP - EV_IN) * DM / 8; i += ngt) p0[i] = (u32x4){0u, 0u, 0u, 0u};
            u32x4* p1 = (u32x4*)((bf16*)(ws + WS_WODIN) + (size_t)j * OD_INP * DM + (size_t)OD_IN * DM);
            for (int i = gt; i < (OD_INP - OD_IN) * DM / 8; i += ngt) p1[i] = (u32x4){0u, 0u, 0u, 0u};
            bf16* WL = (bf16*)(ws + WS_WLORA) + (size_t)j * 655360;
            const float* w2 = a.in[I_W2L] + (size_t)j * 2 * 64 * 512; const float* a2 = a.in[I_A2] + (size_t)j * 2 * 64 * 512; const float* g2 = a.in[I_G2] + (size_t)j * 128 * 512;
            for (int i = gt; i < 655360; i += ngt) {
                const int n = i >> 8, k = i & 255; float v = 0.f;
                if (n < 1024) { const int d = n >> 9, c = n & 511; if (k >= d * 64 && k < d * 64 + 64) v = w2[(size_t)k * 512 + c]; }
                else if (n < 2048) { const int d = (n - 1024) >> 9, c = n & 511; if (k >= 128 + d * 64 && k < 192 + d * 64) v = a2[(size_t)(k - 128) * 512 + c]; }
                else { const int c = n - 2048; if (k >= 128) v = g2[(size_t)(k - 128) * 512 + c]; }
                WL[i] = f2bf(v);
            }
        }
    }
}

template <bool ROUTER> DI void norm_row(const Ctx& C, int row, const float* xlat, const float* xctx, const float* gain, const float* mod, int shift_off, int scale_off, bf16* H, float* AFFT, float* AFFC, int* SLOT);
template <bool ROUTER, int NR> DI void norm_rowsN(const Ctx& C, int row, const float* xlat, const float* gain, const float* mod, int shift_off, int scale_off, bf16* H, float* AFFT, int* SLOT);
template <bool ROUTER>
DI void ph_norm(const Ctx& C, const float* xlat, const float* xctx, const float* gain, const float* mod  , int shift_off, int scale_off, bf16* H,
                const float* router  , float* AFFT, float* AFFC, int* SLOT) {
    LAS float* RT = (LAS float*)C.lds;
    if (ROUTER) { for (int i = C.tid; i < 16384; i += 512) { const int c = i >> 4, e = i & 15; RT[e * 1024 + c] = router[i]; } __syncthreads(); }
    const int gw = C.bid * 8 + C.wave, ngw = C.nb * 8;
    for (int p = gw; p < NLAT / 4; p += ngw) norm_rowsN<ROUTER, 4>(C, 4 * p, xlat, gain, mod, shift_off, scale_off, H, AFFT, SLOT);
    for (int row = NLAT + gw; row < MT; row += ngw) norm_row<ROUTER>(C, row, xlat, xctx, gain, mod, shift_off, scale_off, H, AFFT, AFFC, SLOT);
}
template <bool ROUTER, int NR>
DI void norm_rowsN(const Ctx& C, int row, const float* xlat, const float* gain, const float* mod, int shift_off, int scale_off, bf16* H, float* AFFT, int* SLOT) {
    const LAS float* RT = (const LAS float*)C.lds; const int lane = C.lane;
    const float* xr = xlat + (size_t)row * DM;
    const float* mp = mod + (row >> 12) * 6144;
    f32x4 v[NR][4]; float rs[NR];
#pragma unroll
    for (int q = 0; q < NR; ++q) { float ss = 0.f;
#pragma unroll
        for (int j = 0; j < 4; ++j) { v[q][j] = *(const f32x4*)(xr + q * DM + 256 * j + 4 * lane); ss += v[q][j].x * v[q][j].x + v[q][j].y * v[q][j].y + v[q][j].z * v[q][j].z + v[q][j].w * v[q][j].w; }
        rs[q] = 1.0f / sqrtf(wave_sum(ss) * (1.f / 1024.f) + EPS); }
#pragma unroll
    for (int j = 0; j < 4; ++j) {
        const int c = 256 * j + 4 * lane;
        const f32x4 g = *(const f32x4*)(gain + c), sc = *(const f32x4*)(mp + scale_off + c), sh = *(const f32x4*)(mp + shift_off + c);
#pragma unroll
        for (int q = 0; q < NR; ++q) {
            v[q][j] = (v[q][j] * rs[q]) * g * (sc + 1.0f) + sh;
            if (ROUTER && MOE_F8) *(unsigned*)((unsigned char*)H + (size_t)(row + q) * DM + c) = pk4_fp8(v[q][j].x, v[q][j].y, v[q][j].z, v[q][j].w);
            else *(u32x2*)(H + (size_t)(row + q) * DM + c) = (u32x2){pk2(v[q][j].x, v[q][j].y), pk2(v[q][j].z, v[q][j].w)};
        }
    }
    if (ROUTER) {
        float lg[NR];
#pragma unroll
        for (int q = 0; q < NR; ++q) lg[q] = 0.f;
#pragma unroll 1
        for (int e = 0; e < 16; ++e) { float p[NR];
#pragma unroll
            for (int q = 0; q < NR; ++q) p[q] = 0.f;
#pragma unroll
            for (int j = 0; j < 4; ++j) { const f32x4 w = *(const LAS f32x4*)(RT + e * 1024 + 256 * j + 4 * lane);
#pragma unroll
                for (int q = 0; q < NR; ++q) p[q] += v[q][j].x * w.x + v[q][j].y * w.y + v[q][j].z * w.z + v[q][j].w * w.w; }
#pragma unroll
            for (int q = 0; q < NR; ++q) { const float t = wave_sum(p[q]); lg[q] = (lane == e) ? t : lg[q]; } }
#pragma unroll
        for (int q = 0; q < NR; ++q) { const float ex = expf(lg[q] - max16(lg[q])); const float af = ex / sum16(ex);
            if (lane < 16) { AFFT[(size_t)((row >> 12) * 16 + lane) * TL + ((row + q) & 4095)] = af; SLOT[(size_t)(row + q) * 16 + lane] = -1; } }
    }
}
template <bool ROUTER>
DI void norm_row(const Ctx& C, int row, const float* xlat, const float* xctx, const float* gain, const float* mod, int shift_off, int scale_off, bf16* H, float* AFFT, float* AFFC, int* SLOT) {
    const LAS float* RT = (const LAS float*)C.lds; const int lane = C.lane;
    {
        const float* xr = row < NLAT ? xlat + (size_t)row * DM : xctx + (size_t)(row - NLAT) * DM;
        const int mi = row < NLAT ? (row >> 12) : 8;
        const float* mp = mod + mi * 6144;
        f32x4 v[4]; float ss = 0.f;
#pragma unroll
        for (int j = 0; j < 4; ++j) { v[j] = *(const f32x4*)(xr + 256 * j + 4 * lane); ss += v[j].x * v[j].x + v[j].y * v[j].y + v[j].z * v[j].z + v[j].w * v[j].w; }
        ss = wave_sum(ss);
        const float rs = 1.0f / sqrtf(ss * (1.f / 1024.f) + EPS);
#pragma unroll
        for (int j = 0; j < 4; ++j) {
            const int c = 256 * j + 4 * lane;
            const f32x4 g = *(const f32x4*)(gain + c), sc = *(const f32x4*)(mp + scale_off + c), sh = *(const f32x4*)(mp + shift_off + c);
            v[j] = (v[j] * rs) * g * (sc + 1.0f) + sh;
            if (ROUTER && MOE_F8) *(unsigned*)((unsigned char*)H + (size_t)row * DM + c) = pk4_fp8(v[j].x, v[j].y, v[j].z, v[j].w);
            else *(u32x2*)(H + (size_t)row * DM + c) = (u32x2){pk2(v[j].x, v[j].y), pk2(v[j].z, v[j].w)};
        }
        if (ROUTER) {
            float mylg = 0.f;
#pragma unroll 1
            for (int e = 0; e < 16; ++e) { float p = 0.f;
#pragma unroll
                for (int j = 0; j < 4; ++j) { const f32x4 w = *(const LAS f32x4*)(RT + e * 1024 + 256 * j + 4 * lane); p += v[j].x * w.x + v[j].y * w.y + v[j].z * w.z + v[j].w * w.w; }
                p = wave_sum(p); mylg = (lane == e) ? p : mylg; }
            const float mx = max16(mylg);
            const float ex = expf(mylg - mx);
            const float mine = ex / sum16(ex);
            if (lane < 16) {
                if (row < NLAT) AFFT[(size_t)((row >> 12) * 16 + lane) * TL + (row & 4095)] = mine;
                else { const int rc = row - NLAT; AFFC[(size_t)((rc >> 8) * 16 + lane) * LCX + (rc & 255)] = mine; }
                SLOT[(size_t)row * 16 + lane] = -1;
            }
        }
    }
}


struct EpiBf16 { static constexpr bool WIDE = true; bf16* O; int ldo;
    DI void operator()(int row, int col, f32x4 v0, f32x4 v1) const { bf16* p = O + (size_t)row * ldo + col;
        *(u32x2*)p = (u32x2){pk2(v0[0], v0[1]), pk2(v0[2], v0[3])}; *(u32x2*)(p + 128) = (u32x2){pk2(v1[0], v1[1]), pk2(v1[2], v1[3])}; }
    DI void wide(int row, int col, f32x4 a0, f32x4 a1, f32x4 b0, f32x4 b1) const { bf16* p = O + (size_t)row * ldo + col;
        *(u32x4*)p = (u32x4){pk2(a0[0], a0[1]), pk2(a0[2], a0[3]), pk2(a1[0], a1[1]), pk2(a1[2], a1[3])}; *(u32x4*)(p + 128) = (u32x4){pk2(b0[0], b0[1]), pk2(b0[2], b0[3]), pk2(b1[0], b1[1]), pk2(b1[2], b1[3])}; } };
struct EpiF32 { static constexpr bool WIDE = false; float* O; int ldo;
    DI void operator()(int row, int col, f32x4 v0, f32x4 v1) const { float* p = O + (size_t)row * ldo + col; *(f32x4*)p = v0; *(f32x4*)(p + 128) = v1; } };
struct EpiResid { static constexpr bool WIDE = false; const float* xin_lat; const float* xin_ctx; float* xout_lat; float* xout_ctx; const float* modg;
    DI void operator()(int row, int col, f32x4 v0, f32x4 v1) const {
        const float* xi; float* xo; int mi;
        if (row < NLAT) { xi = xin_lat + (size_t)row * DM; xo = xout_lat + (size_t)row * DM; mi = row >> 12; }
        else { xi = xin_ctx + (size_t)(row - NLAT) * DM; xo = xout_ctx + (size_t)(row - NLAT) * DM; mi = 8; }
        const float* g = modg + mi * 6144 + col;
        const f32x4 g0 = *(const f32x4*)g, g1 = *(const f32x4*)(g + 128), x0 = *(const f32x4*)(xi + col), x1 = *(const f32x4*)(xi + col + 128);
        *(f32x4*)(xo + col) = x0 + g0 * v0; *(f32x4*)(xo + col + 128) = x1 + g1 * v1; } };
struct EpiGlu { static constexpr bool WIDE = false; bf16* O;
    DI void operator()(int row, int col, f32x4 v0, f32x4 v1) const { const int f = ((col & 2047) >> 8) * 128 + (col & 255);
        *(u32x2*)(O + (size_t)row * DM + f) = (u32x2){pk2(siluf_(v0[0]) * v1[0], siluf_(v0[1]) * v1[1]), pk2(siluf_(v0[2]) * v1[2], siluf_(v0[3]) * v1[3])}; } };
struct EpiGlu8 { static constexpr bool WIDE = true; unsigned char* O;
    DI void operator()(int row, int col, f32x4 v0, f32x4 v1) const { const int f = ((col & 2047) >> 8) * 128 + (col & 255);
        *(unsigned*)(O + (size_t)row * DM + f) = pk4_fp8(8.f * siluf_(v0[0]) * v1[0], 8.f * siluf_(v0[1]) * v1[1], 8.f * siluf_(v0[2]) * v1[2], 8.f * siluf_(v0[3]) * v1[3]); }
    DI void wide(int row, int col, f32x4 a0, f32x4 a1, f32x4 b0, f32x4 b1) const { const int f = ((col & 2047) >> 8) * 128 + (col & 255);
        *(u32x2*)(O + (size_t)row * DM + f) = (u32x2){pk4_fp8(8.f * siluf_(a0[0]) * b0[0], 8.f * siluf_(a0[1]) * b0[1], 8.f * siluf_(a0[2]) * b0[2], 8.f * siluf_(a0[3]) * b0[3]),
                                                    pk4_fp8(8.f * siluf_(a1[0]) * b1[0], 8.f * siluf_(a1[1]) * b1[1], 8.f * siluf_(a1[2]) * b1[2], 8.f * siluf_(a1[3]) * b1[3])}; } };
struct EpiGate { static constexpr bool WIDE = true; bf16* O; const float* gate;
    DI void operator()(int row, int col, f32x4 v0, f32x4 v1) const { const float g = gate[row]; bf16* p = O + (size_t)row * DM + (col & 1023);
        *(u32x2*)p = (u32x2){pk2(v0[0] * g, v0[1] * g), pk2(v0[2] * g, v0[3] * g)}; *(u32x2*)(p + 128) = (u32x2){pk2(v1[0] * g, v1[1] * g), pk2(v1[2] * g, v1[3] * g)}; }
    DI void wide(int row, int col, f32x4 a0, f32x4 a1, f32x4 b0, f32x4 b1) const { const float g = gate[row]; bf16* p = O + (size_t)row * DM + (col & 1023);
        *(u32x4*)p = (u32x4){pk2(a0[0] * g, a0[1] * g), pk2(a0[2] * g, a0[3] * g), pk2(a1[0] * g, a1[1] * g), pk2(a1[2] * g, a1[3] * g)};
        *(u32x4*)(p + 128) = (u32x4){pk2(b0[0] * g, b0[1] * g), pk2(b0[2] * g, b0[3] * g), pk2(b1[0] * g, b1[1] * g), pk2(b1[2] * g, b1[3] * g)}; } };
typedef _Float16 f16x2_t __attribute__((ext_vector_type(2)));
DI unsigned pk2h(float a, float b) { f16x2_t h; h.x = (_Float16)a; h.y = (_Float16)b; return __builtin_bit_cast(unsigned, h); }
DI float h2f(unsigned short x) { return (float)__builtin_bit_cast(_Float16, x); }
struct EpiLoraW { static constexpr bool WIDE = false; unsigned short* W; const float* w0;
    DI void one(int row, int col, f32x4 v) const { const int d = col >> 9, c = col & 511; f32x4 o;
#pragma unroll
        for (int e = 0; e < 4; ++e) { const float lw = w0[col + e] + v[e]; const float z = -lw; const float sp = fmaxf(z, 0.f) + __logf(1.f + __expf(-fabsf(z))); o[e] = -__expf(-sp - 0.5f); }
        *(u32x2*)(W + ((size_t)d * MT + row) * 512 + c) = (u32x2){pk2h(o[0], o[1]), pk2h(o[2], o[3])}; }
    DI void operator()(int row, int col, f32x4 v0, f32x4 v1) const { one(row, col, v0); one(row, col + 128, v1); } };
struct EpiLoraA { static constexpr bool WIDE = false; bf16* Aout; const float* a0;
    DI void one(int row, int col, f32x4 v) const { const int d = col >> 9, c = col & 511; const f32x4 b = *(const f32x4*)(a0 + col);
        *(u32x2*)(Aout + ((size_t)d * MT + row) * 512 + c) = (u32x2){pk2(sigmoidf_(b[0] + v[0]), sigmoidf_(b[1] + v[1])), pk2(sigmoidf_(b[2] + v[2]), sigmoidf_(b[3] + v[3]))}; }
    DI void operator()(int row, int col, f32x4 v0, f32x4 v1) const { one(row, col, v0); one(row, col + 128, v1); } };

namespace pg8 {
constexpr int BM = 256, BK = 64, HALF = 128, HTB = HALF * BK * 2, STAGE_BYTES = 8 * HTB;
DI int lds_byte(int r, int c) { const int st = (r >> 4) * 2 + (c >> 5), rr = r & 15, cc = c & 31, ob = rr * 64 + cc * 2; return st * 1024 + (ob ^ (((ob >> 9) & 1) << 5)); }
DI void stage_rc(int b, int& R, int& C) { const int st = b / 1024, sb = b % 1024, swz = sb ^ (((sb >> 9) & 1) << 5); R = (st >> 1) * 16 + swz / 64; C = (st & 1) * 32 + (swz % 64) / 2; }
DI int perm32(int rho) { const int n = rho >> 4, i = rho & 15; return 8 * (i >> 2) + 4 * n + (i & 3); }
struct Unit { int pm, pn; };
struct Gemm { const bf16* A; const bf16* Bt; int lda, K; const int* rows; int scale_w = 0x7f7f7f7f, scale_a = 0x7f7f7f7f; };
struct OrderMN { int nM, nN, G, c;
    DI bool next(int i, Unit& u) const { const int L = i * G + c; if (L >= nM * nN) return false; u.pm = L / nN; u.pn = L % nN; return true; } };
struct OrderMoE { int nMt, nN, mstride  , G, c;
    DI bool next(int i, Unit& u) const { const int L = i * G + c, per = nMt * nN; if (L >= NEXP * per) return false; const int e = L / per, q = L % per; u.pm = e * mstride + q / nN; u.pn = e * nN + q % nN; return true; } };
template <class E4> struct EpiAdapt { E4 e;
    DI void operator()(const f32x4 (&acc)[2][2][4][2], const Unit& u, int wr, int wc, int fr, int fq) const {
#pragma unroll
        for (int ai = 0; ai < 2; ++ai)
#pragma unroll
            for (int m = 0; m < 4; ++m) { const int row = u.pm * BM + ai * HALF + wr * 64 + m * 16 + fr;
                if constexpr (E4::WIDE) e.wide(row, u.pn * BM + wc * 32 + 8 * fq, acc[ai][0][m][0], acc[ai][0][m][1], acc[ai][1][m][0], acc[ai][1][m][1]);
                else {
#pragma unroll
                    for (int n = 0; n < 2; ++n) e(row, u.pn * BM + wc * 32 + 8 * fq + 4 * n, acc[ai][0][m][n], acc[ai][1][m][n]); } } } };

template <class Epi, class Sched, bool F8 = false>
DI void gemm_phase(LAS unsigned char* lds, const Gemm g, const Sched& S, const Epi& E, const int tid) {
    const int wid = __builtin_amdgcn_readfirstlane(tid >> 6), lane = tid & 63, wr = wid >> 2, wc = wid & 3, fr = lane & 15, fq = lane >> 4;
    const int K = g.K, nt = K / BK;
    unsigned voffB[2];
#pragma unroll
    for (int i = 0; i < 2; ++i) { int R, C; stage_rc(tid * 16 + i * 8192, R, C); const int Rb = (R & ~31) + perm32(R & 31); voffB[i] = (unsigned)(Rb * K + C) * 2u; }
    const size_t kstep = (size_t)(BK * 2), hstep = (size_t)HALF * K * 2, tstep = 2 * hstep;
    const unsigned ldsw = (unsigned)wid * 1024u;
    const int aoff = lds_byte(wr * 64 + fr, fq * 8), boff = lds_byte(wc * 32 + fr, fq * 8);
    const char* const gA = (const char*)g.A;
#define PG8_SA(b, h) (((b) * 2 + (h)) * HTB)
#define PG8_SB(b, h) ((4 + (b) * 2 + (h)) * HTB)
#define PG8_STAGE(bufoff, gbase, voff) do { _Pragma("unroll") for (int _i = 0; _i < 2; ++_i) \
        __builtin_amdgcn_global_load_lds((const unsigned*)((const char*)(gbase) + (voff)[_i]), (LAS unsigned*)(lds + (bufoff) + ldsw + _i * 8192), 16, 0, 0); } while (0)
#define PG8_LDA(dst, b, h) do { _Pragma("unroll") for (int m = 0; m < 4; ++m) _Pragma("unroll") for (int k = 0; k < 2; ++k) dst[m][k] = *(const LAS bf16x8*)(lds + PG8_SA(b, h) + aoff + m * 2048 + k * 1024); } while (0)
#define PG8_LDB(dst, b, h) do { _Pragma("unroll") for (int n = 0; n < 2; ++n) _Pragma("unroll") for (int k = 0; k < 2; ++k) dst[n][k] = *(const LAS bf16x8*)(lds + PG8_SB(b, h) + boff + n * 2048 + k * 1024); } while (0)
#define PG8_MMA(ai, bj, At, Bt) do { __builtin_amdgcn_s_setprio(1); _Pragma("unroll") for (int m = 0; m < 4; ++m) _Pragma("unroll") for (int n = 0; n < 2; ++n) { \
        if constexpr (F8) { const v8i_t w8 = __builtin_shufflevector(__builtin_bit_cast(i32x4_t, Bt[n][0]), __builtin_bit_cast(i32x4_t, Bt[n][1]), 0, 1, 2, 3, 4, 5, 6, 7), x8 = __builtin_shufflevector(__builtin_bit_cast(i32x4_t, At[m][0]), __builtin_bit_cast(i32x4_t, At[m][1]), 0, 1, 2, 3, 4, 5, 6, 7); \
            acc[ai][bj][m][n] = __builtin_amdgcn_mfma_scale_f32_16x16x128_f8f6f4(w8, x8, acc[ai][bj][m][n], 0, 0, 0, g.scale_w, 0, g.scale_a); } \
        else { _Pragma("unroll") for (int k = 0; k < 2; ++k) acc[ai][bj][m][n] = __builtin_amdgcn_mfma_f32_16x16x32_bf16(Bt[n][k], At[m][k], acc[ai][bj][m][n], 0, 0, 0); } } __builtin_amdgcn_s_setprio(0); } while (0)
#define PG8_WAIT_V(n) asm volatile("s_waitcnt vmcnt(" #n ")" ::: "memory")
#define PG8_WAIT_L(n) asm volatile("s_waitcnt lgkmcnt(" #n ")" ::: "memory")
#define PG8_BAR __builtin_amdgcn_s_barrier()
#define PG8_SCHED __builtin_amdgcn_sched_barrier(0)
#define PG8_ROWIDX(ri, u) do { _Pragma("unroll") for (int _h = 0; _h < 2; ++_h) _Pragma("unroll") for (int _i = 0; _i < 2; ++_i) { int _R, _C; stage_rc(tid * 16 + _i * 8192, _R, _C); (void)_C; \
        const int _lr = (u).pm * BM + _h * HALF + _R; ri[_h][_i] = g.rows ? g.rows[_lr] : _lr; } } while (0)
#define PG8_AOFF_FROM(vo, ri) do { _Pragma("unroll") for (int _h = 0; _h < 2; ++_h) _Pragma("unroll") for (int _i = 0; _i < 2; ++_i) { int _R, _C; stage_rc(tid * 16 + _i * 8192, _R, _C); (void)_R; \
        vo[_h][_i] = (unsigned)(((size_t)ri[_h][_i] * g.lda + _C) * 2u); } } while (0)
    Unit cur, nxt; int ui = 0;
    if (!S.next(0, cur)) return;
    f32x4 acc[2][2][4][2];
#pragma unroll
    for (int a = 0; a < 2; ++a)
#pragma unroll
        for (int b = 0; b < 2; ++b)
#pragma unroll
            for (int m = 0; m < 4; ++m)
#pragma unroll
                for (int n = 0; n < 2; ++n) acc[a][b][m][n] = (f32x4){0.f, 0.f, 0.f, 0.f};
    bf16x8 At[4][2], B0[2][2], B1[2][2];
    unsigned cvo[2][2]; int nri[2][2];
    PG8_ROWIDX(nri, cur); PG8_AOFF_FROM(cvo, nri);
    const char* cB = (const char*)g.Bt + (size_t)cur.pn * tstep;
    PG8_STAGE(PG8_SB(0, 0), cB, voffB); PG8_STAGE(PG8_SB(0, 1), cB + hstep, voffB); PG8_STAGE(PG8_SA(0, 0), gA, cvo[0]); PG8_STAGE(PG8_SA(0, 1), gA, cvo[1]);
    if (wr == 1) PG8_BAR;
    PG8_WAIT_V(2); PG8_BAR;
    PG8_STAGE(PG8_SB(1, 0), cB + kstep, voffB); PG8_STAGE(PG8_SA(1, 0), gA + kstep, cvo[0]); PG8_STAGE(PG8_SB(1, 1), cB + hstep + kstep, voffB);
    PG8_WAIT_V(6); PG8_BAR;
    for (;;) {
        const bool has_next = S.next(ui + 1, nxt);
        const char* nB = has_next ? (const char*)g.Bt + (size_t)nxt.pn * tstep : cB;
#pragma nounroll
        for (int t = 0; t < nt; t += 2) {
            const bool last = (t == nt - 2);
            const char* a1 = gA + (size_t)(t + 1) * kstep;
            const char* a2 = last ? gA : gA + (size_t)(t + 2) * kstep; const char* b2 = last ? nB : cB + (size_t)(t + 2) * kstep;
            const char* a3 = a2 + kstep; const char* b3 = b2 + kstep;
            if (t == nt - 4 && has_next) PG8_ROWIDX(nri, nxt);
            PG8_LDB(B0, 0, 0); PG8_LDB(B1, 0, 1); PG8_SCHED; PG8_LDA(At, 0, 0); PG8_STAGE(PG8_SA(1, 1), a1, cvo[1]);
            if (last && has_next) { if (nt < 4) PG8_ROWIDX(nri, nxt); PG8_AOFF_FROM(cvo, nri); }
            PG8_WAIT_V(8); PG8_WAIT_L(0); PG8_BAR; PG8_MMA(0, 0, At, B0); PG8_MMA(0, 1, At, B1); PG8_BAR; PG8_SCHED;
            PG8_LDA(At, 0, 1); PG8_STAGE(PG8_SB(0, 0), b2, voffB); PG8_STAGE(PG8_SB(0, 1), b2 + hstep, voffB); PG8_STAGE(PG8_SA(0, 0), a2, cvo[0]);
            PG8_WAIT_V(8); PG8_WAIT_L(0); PG8_BAR; PG8_MMA(1, 0, At, B0); PG8_MMA(1, 1, At, B1); PG8_BAR; PG8_SCHED;
            PG8_LDB(B0, 1, 0); PG8_LDB(B1, 1, 1); PG8_SCHED; PG8_LDA(At, 1, 0); PG8_STAGE(PG8_SA(0, 1), a2, cvo[1]);
            PG8_WAIT_V(8); PG8_WAIT_L(0); PG8_BAR; PG8_MMA(0, 0, At, B0); PG8_MMA(0, 1, At, B1); PG8_BAR; PG8_SCHED;
            PG8_LDA(At, 1, 1); PG8_STAGE(PG8_SB(1, 0), b3, voffB); PG8_STAGE(PG8_SB(1, 1), b3 + hstep, voffB); PG8_STAGE(PG8_SA(1, 0), a3, cvo[0]);
            PG8_WAIT_V(8); PG8_WAIT_L(0); PG8_BAR; PG8_MMA(1, 0, At, B0); PG8_MMA(1, 1, At, B1); PG8_BAR; PG8_SCHED;
        }
        if (wr == 0) PG8_BAR;
        E(acc, cur, wr, wc, fr, fq);
        if (!has_next) break;
#pragma unroll
        for (int a = 0; a < 2; ++a)
#pragma unroll
            for (int b = 0; b < 2; ++b)
#pragma unroll
                for (int m = 0; m < 4; ++m)
#pragma unroll
                    for (int n = 0; n < 2; ++n) acc[a][b][m][n] = (f32x4){0.f, 0.f, 0.f, 0.f};
        cur = nxt; cB = nB; ++ui;
        if (wr == 1) PG8_BAR;
    }
    PG8_WAIT_V(0);
    PG8_BAR;
#undef PG8_SA
#undef PG8_SB
#undef PG8_STAGE
#undef PG8_LDA
#undef PG8_LDB
#undef PG8_MMA
#undef PG8_WAIT_V
#undef PG8_WAIT_L
#undef PG8_BAR
#undef PG8_SCHED
#undef PG8_ROWIDX
#undef PG8_AOFF_FROM
}
}
template <class E4> DI void fast_gemm(const Ctx& C, const bf16* A, int lda, const bf16* Bt, int K, int nM, int nN, const E4& e, bool rev = false) {
    pg8::Gemm g{A, Bt, lda, K, nullptr}; pg8::OrderMN S{nM, nN, C.nb, rev ? C.nb - 1 - C.vcu : C.vcu}; pg8::EpiAdapt<E4> E{e};
    pg8::gemm_phase(C.lds, g, S, E, C.tid);
}

DI float max16_acc(float m, const f32x16& x) {
    asm volatile("s_nop 15\n\tv_max3_f32 %0, %0, %1, %2\n\tv_max3_f32 %0, %0, %3, %4\n\tv_max3_f32 %0, %0, %5, %6\n\tv_max3_f32 %0, %0, %7, %8\n\tv_max3_f32 %0, %0, %9, %10\n\tv_max3_f32 %0, %0, %11, %12\n\tv_max3_f32 %0, %0, %13, %14\n\tv_max3_f32 %0, %0, %15, %16"
                 : "+v"(m) : "v"(x[0]), "v"(x[1]), "v"(x[2]), "v"(x[3]), "v"(x[4]), "v"(x[5]), "v"(x[6]), "v"(x[7]), "v"(x[8]), "v"(x[9]), "v"(x[10]), "v"(x[11]), "v"(x[12]), "v"(x[13]), "v"(x[14]), "v"(x[15]));
    return m; }
DI int swap23(int x) { return (x & ~12) | ((x & 4) << 1) | ((x & 8) >> 1); }
DI void flash_store(const f32x16 (&o)[2], float l, bf16* orow  , int h) {
    const float inv = 1.f / l;
#pragma unroll
    for (int dt = 0; dt < 2; ++dt)
#pragma unroll
        for (int g = 0; g < 4; ++g)
            *(u32x2*)(orow + 32 * dt + 8 * g + 4 * h) = (u32x2){pk2(o[dt][4 * g] * inv, o[dt][4 * g + 1] * inv), pk2(o[dt][4 * g + 2] * inv, o[dt][4 * g + 3] * inv)};
}


template <int DQK> struct AttnGeo { static constexpr int KSTR = DQK * 2 + 16, KBYTES = 64 * KSTR, VSTR = 144, VBYTES = 64 * VSTR, BUF = KBYTES + VBYTES, KPIECES = 64 * DQK / 8; };
template <int DQK, bool NAT>
DI void attn_tile_loop(const Ctx& C, f32x16 (&o)[2], float& l, const bf16x8 (&qf)[DQK / 16], const bf16* __restrict__ Kb, const bf16* __restrict__ Vt, int pos1, int n1, int pos2, int n2,
                       const LAS float* tab, int grow, int rs, int qc, int cs) {
    typedef AttnGeo<DQK> G;
    const int tid = C.tid, r = C.lane & 31, h = C.lane >> 5, kr = swap23(r), ntiles = n1 + n2;
    constexpr bool K2 = G::KPIECES > 512;
    const int kq0 = tid, kq1 = tid + 512;
    const int kl0 = (kq0 / (DQK / 8)) * G::KSTR + (kq0 % (DQK / 8)) * 16, kl1 = (kq1 / (DQK / 8)) * G::KSTR + (kq1 % (DQK / 8)) * 16;
    const int vl = G::KBYTES + (tid >> 3) * G::VSTR + (tid & 7) * 16;
    const bf16* vg = Vt + (size_t)(tid >> 3) * KPOS + 8 * (tid & 7);
    u32x4 rk0, rk1, rv;
    rk1 = (u32x4){0u, 0u, 0u, 0u};
#define ATT_POS(t) ((t) < n1 ? pos1 + 64 * (t) : pos2 + 64 * ((t) - n1))
    { const int pos0 = ATT_POS(0); rk0 = *(const u32x4*)(Kb + (size_t)pos0 * DQK + 8 * kq0); if (K2 && tid < 256) rk1 = *(const u32x4*)(Kb + (size_t)pos0 * DQK + 8 * kq1); rv = *(const u32x4*)(vg + pos0); }
    __syncthreads();
    *(LAS u32x4*)(C.lds + kl0) = rk0; if (K2 && tid < 256) *(LAS u32x4*)(C.lds + kl1) = rk1; *(LAS u32x4*)(C.lds + vl) = rv;
    __syncthreads();
    if (C.wave >= 4) __builtin_amdgcn_s_setprio(1);
    float mref = 0.f; bool first = true;
    f32x16 nmref;
#pragma unroll
    for (int i = 0; i < 16; ++i) nmref[i] = 0.f;
    constexpr float THR = 8.f;
    for (int t = 0; t < ntiles; ++t) {
        const LAS unsigned char* B = C.lds + (t & 1) * G::BUF;
        if (t + 1 < ntiles) { const int pos0 = ATT_POS(t + 1);
            rk0 = *(const u32x4*)(Kb + (size_t)pos0 * DQK + 8 * kq0); if (K2 && tid < 256) rk1 = *(const u32x4*)(Kb + (size_t)pos0 * DQK + 8 * kq1); rv = *(const u32x4*)(vg + pos0); }
        const int gr = (pos1 >> 6) + t;
        const bool active = !NAT || t >= n1 || (gr >= rs && gr < rs + 8);
        if (active) {
            f32x16 sc[2];
            constexpr int NK = DQK / 16, NS = 2 * NK, RD = 4;
            const LAS unsigned char* kp = B + kr * G::KSTR + 16 * h;
            bf16x8 fr[RD];
#pragma unroll
            for (int s = 0; s < RD; ++s) fr[s] = *(const LAS bf16x8*)(kp + (s / NK) * 32 * G::KSTR + 32 * (s % NK));
#pragma unroll
            for (int s = 0; s < NS; ++s) { sc[s / NK] = MFMA32(fr[s % RD], qf[s % NK], (s % NK == 0) ? nmref : sc[s / NK]);
                if (s + RD < NS) fr[s % RD] = *(const LAS bf16x8*)(kp + ((s + RD) / NK) * 32 * G::KSTR + 32 * ((s + RD) % NK)); }
            const LAS unsigned char* vp = B + G::KBYTES + r * G::VSTR + 16 * h;
#pragma unroll
            for (int v = 0; v < RD; ++v) fr[v] = *(const LAS bf16x8*)(vp + (v & 1) * 32 * G::VSTR + (v >> 1) * 32);
            __builtin_amdgcn_sched_group_barrier(0x100, RD, 0);
#pragma unroll
            for (int s = 0; s < NS - RD; ++s) { __builtin_amdgcn_sched_group_barrier(0x008, 1, 0); __builtin_amdgcn_sched_group_barrier(0x100, 1, 0); }
            __builtin_amdgcn_sched_group_barrier(0x008, RD, 0);
            __builtin_amdgcn_sched_group_barrier(0x100, RD, 0);
            if (NAT && t < n1) {
                const LAS float* trl = tab + (gr - grow + 7) * 128 + (8 * h - qc + 63);
#pragma unroll
                for (int j = 0; j < 2; ++j) { float bv[16];
#pragma unroll
                    for (int i = 0; i < 16; ++i) bv[i] = trl[32 * j + ((i & 3) | (((i >> 2) & 1) << 2) | ((i >> 3) << 4))];
                    asm volatile("" : "+v"(bv[0]), "+v"(bv[1]), "+v"(bv[2]), "+v"(bv[3]), "+v"(bv[4]), "+v"(bv[5]), "+v"(bv[6]), "+v"(bv[7]), "+v"(bv[8]), "+v"(bv[9]), "+v"(bv[10]), "+v"(bv[11]), "+v"(bv[12]), "+v"(bv[13]), "+v"(bv[14]), "+v"(bv[15]));
#pragma unroll
                    for (int i = 0; i < 16; ++i) {
                        const int cc = 32 * j + ((i & 3) | (((i >> 2) & 1) << 2) | ((i >> 3) << 4)) + 8 * h; const bool ok = (cc >= cs) && (cc < cs + 16);
                        sc[j][i] = ok ? sc[j][i] + bv[i] : -1e30f;
                    } }
            }
            float mx = max16_acc(max16_acc(-3.0e38f, sc[0]), sc[1]);
            if (first || __builtin_amdgcn_ballot_w64(mx > THR) != 0ull) {
                mx = fmaxf(mx, xor32(mx, C.lane));
                const float delta = first ? mx : fmaxf(mx, 0.f);
#pragma unroll
                for (int i = 0; i < 16; ++i) { sc[0][i] -= delta; sc[1][i] -= delta; }
                if (!first) { const float alpha = __builtin_amdgcn_exp2f(-delta); l *= alpha;
#pragma unroll
                    for (int i = 0; i < 16; ++i) { o[0][i] *= alpha; o[1][i] *= alpha; } }
                mref += delta; first = false;
#pragma unroll
                for (int i = 0; i < 16; ++i) nmref[i] = -mref;
            }
            float rs1 = 0.f;
#pragma unroll
            for (int j = 0; j < 2; ++j)
#pragma unroll
                for (int i = 0; i < 16; ++i) { sc[j][i] = __builtin_amdgcn_exp2f(sc[j][i]); rs1 += sc[j][i]; }
            l += rs1;
#pragma unroll
            for (int j = 0; j < 2; ++j)
#pragma unroll
                for (int s2 = 0; s2 < 2; ++s2) {
                    u32x4 pw; pw.x = pk2(sc[j][8 * s2], sc[j][8 * s2 + 1]); pw.y = pk2(sc[j][8 * s2 + 2], sc[j][8 * s2 + 3]); pw.z = pk2(sc[j][8 * s2 + 4], sc[j][8 * s2 + 5]); pw.w = pk2(sc[j][8 * s2 + 6], sc[j][8 * s2 + 7]);
                    const bf16x8 pb = __builtin_bit_cast(bf16x8, pw);
#pragma unroll
                    for (int dt = 0; dt < 2; ++dt) { const int v = 4 * j + 2 * s2 + dt;
                        o[dt] = MFMA32(fr[v % RD], pb, o[dt]);
                        if (v + RD < 8) fr[v % RD] = *(const LAS bf16x8*)(vp + ((v + RD) & 1) * 32 * G::VSTR + ((v + RD) >> 1) * 32); }
                }
#pragma unroll
            for (int v = 0; v < 8 - RD; ++v) { __builtin_amdgcn_sched_group_barrier(0x008, 1, 1); __builtin_amdgcn_sched_group_barrier(0x100, 1, 1); }
            __builtin_amdgcn_sched_group_barrier(0x008, RD, 1);
        }
        if (t + 1 < ntiles) { LAS unsigned char* Bn = C.lds + ((t + 1) & 1) * G::BUF;
            *(LAS u32x4*)(Bn + kl0) = rk0; if (K2 && tid < 256) *(LAS u32x4*)(Bn + kl1) = rk1; *(LAS u32x4*)(Bn + vl) = rv; }
        __syncthreads();
    }
    __builtin_amdgcn_s_setprio(0);
    l += xor32(l, C.lane);
#undef ATT_POS
}
DI void conv_unit(const Ctx& C, int u, const bf16* U, const float (&wk)[31], float bias, const float* lng, const float* lnb, bf16* OCAT);
DI const float* in_ptr(const unsigned char* ws, int k);
constexpr int CONV_PER_TAIL = 3;
DI int conv_in_fin(int nb) { const int extra = (MT / 64) % nb; const int n = CONV_PER_TAIL * (nb - extra); return n < MT / 32 ? n : MT / 32; }
DI void ph_attn_mla2(const Ctx& C, const bf16* QB, const bf16* KB, const bf16* VT, bf16* OCAT, bool last, unsigned char* ws, int lq) {
    const int r = C.lane & 31, h = C.lane >> 5;
    const int nunits = 1024 + (last ? 0 : 64);
    int k = 0;
    for (;; ++k) {
        const int u = C.vcu + k * C.nb, cu = conv_in_fin(C.nb) + (C.nb - 1 - C.vcu) + k * C.nb;
        const bool a_on = u < nunits, c_on = cu < MT / 32;
        if (!a_on && !c_on) break;
        if (a_on) {
            const int bh = u < 1024 ? (u >> 4) : u - 1024, qblk = u < 1024 ? (u & 15) : 16, b = bh >> 3, hh = bh & 7;
            const int qpos = qblk * 256 + 32 * C.wave + r;
            const bf16* qp = QB + ((size_t)bh * KPOS + qpos) * 96 + 8 * h;
            bf16x8 qf[6];
#pragma unroll
            for (int kk = 0; kk < 6; ++kk) qf[kk] = *(const bf16x8*)(qp + 16 * kk);
            f32x16 o[2];
#pragma unroll
            for (int i = 0; i < 16; ++i) { o[0][i] = 0.f; o[1][i] = 0.f; }
            float l = 0.f;
            attn_tile_loop<96, false>(C, o, l, qf, KB + (size_t)bh * KPOS * 96, VT + (size_t)bh * 64 * KPOS, qblk < 16 ? 0 : TL, qblk < 16 ? KPOS / 64 : LCX / 64, 0, 0, nullptr, 0, 0, 0, 0);
            const int row = qblk < 16 ? b * TL + qpos : NLAT + b * LCX + (qpos - TL);
            flash_store(o, l, OCAT + (size_t)row * DM + hh * 64, h);
        }
        if (c_on) { float wk[31]; const float* dww = in_ptr(ws, I_DWW) + (size_t)lq * 31 * 512;
#pragma unroll
            for (int kt = 0; kt < 31; ++kt) wk[kt] = dww[kt * 512 + C.tid];
            conv_unit(C, cu, (const bf16*)(ws + WS_ARENA + A_U), wk, in_ptr(ws, I_DWB)[lq * 512 + C.tid], in_ptr(ws, I_LNG) + lq * 512, in_ptr(ws, I_LNB) + lq * 512, OCAT); }
    }
}
DI void ph_natten2(const Ctx& C, const bf16* QN, const bf16* KN, const bf16* VTN, bf16* OCAT, const float* rpb  , bool last, unsigned* work_ctr, unsigned char* ws, int lq) {
    const int r = C.lane & 31, h = C.lane >> 5;
    LAS float* tab = (LAS float*)(C.lds + 2 * AttnGeo<64>::BUF);
    LAS int* uslot = (LAS int*)(tab + 1920);
    const int nunits = 1024 + (last ? 0 : 64);
    for (;;) {
        __syncthreads();
        if (C.tid == 0) *uslot = (int)__hip_atomic_fetch_add(work_ctr, 1u, __ATOMIC_RELAXED, __HIP_MEMORY_SCOPE_AGENT);
        __syncthreads();
        const int u = *uslot;
        if (u >= nunits) break;
        const bool isctx = u >= 1024;
        const int bh = isctx ? u - 1024 : (u >> 4), b = bh >> 3, hh = bh & 7;
        for (int i = C.tid; i < 15 * 128; i += 512) { const int dc = (i & 127) - 48; tab[i] = (dc >= 0 && dc < 31) ? rpb[hh * 465 + (i >> 7) * 31 + dc] * LOG2E : 0.f; }
        int qpos, row, grow = 0, qc = 0, rs = 0, cs = 0, rlo = 0, nband = 0;
        if (!isctx) { const int rg = u & 15; grow = 4 * rg + (C.wave >> 1); qc = 32 * (C.wave & 1) + r; qpos = grow * 64 + qc; row = b * TL + qpos;
            rs = grow - 4; rs = rs < 0 ? 0 : (rs > 56 ? 56 : rs); cs = qc - 8; cs = cs < 0 ? 0 : (cs > 48 ? 48 : cs);
            rlo = 4 * rg - 4; rlo = rlo < 0 ? 0 : (rlo > 56 ? 56 : rlo); int rhi = 4 * rg + 3 - 4; rhi = rhi < 0 ? 0 : (rhi > 56 ? 56 : rhi); nband = rhi + 8 - rlo; }
        else { qpos = TL + 32 * C.wave + r; row = NLAT + b * LCX + 32 * C.wave + r; }
        const bf16* qp = QN + ((size_t)bh * KPOS + qpos) * 64 + 8 * h;
        bf16x8 qf[4];
#pragma unroll
        for (int kk = 0; kk < 4; ++kk) qf[kk] = *(const bf16x8*)(qp + 16 * kk);
        f32x16 o[2];
#pragma unroll
        for (int i = 0; i < 16; ++i) { o[0][i] = 0.f; o[1][i] = 0.f; }
        float l = 0.f;
        attn_tile_loop<64, true>(C, o, l, qf, KN + (size_t)bh * KPOS * 64, VTN + (size_t)bh * 64 * KPOS, rlo * 64, nband, TL, LCX / 64, tab, grow, rs, qc, cs);
        flash_store(o, l, OCAT + (size_t)row * DM + 512 + hh * 64, h);
    }
}


DI void ph_mla_fin(const Ctx& C, const bf16* U, const bf16* QPRE, const bf16* KVPRE, const float* qg, const float* kg, const f32x2* CS, bf16* QB, bf16* KB, bf16* VT) {
    LAS bf16* VL = (LAS bf16*)C.lds;
    const int lane = C.lane, j = lane >> 3, sub = lane & 7;
    const float C2 = 0.10206207261596575f * LOG2E;
    float qgn[8], qgr[4], kgn[8], kgr[4];
#pragma unroll
    for (int e = 0; e < 8; ++e) { qgn[e] = qg[8 * sub + e] * C2; kgn[e] = kg[8 * sub + e]; }
#pragma unroll
    for (int m = 0; m < 4; ++m) { qgr[m] = qg[64 + sub + 8 * m] * C2; kgr[m] = kg[64 + sub + 8 * m]; }
    for (int u = C.vcu; u < MT / 64; u += C.nb) {
        const int row0 = 64 * u, b = row0 < NLAT ? (row0 >> 12) : ((row0 - NLAT) >> 8), pos0 = row0 < NLAT ? (row0 & 4095) : TL + ((row0 - NLAT) & 255);
        const bool lat = row0 < NLAT;
        const int pl = 8 * C.wave + j, row = row0 + pl, pos = pos0 + pl;
        const bf16* ur = U + (size_t)row * EV_INP;
        float sq = 0.f, skv = 0.f;
#pragma unroll
        for (int m = 0; m < 6; ++m) { float x[8]; unpack8(*(const u32x4*)(ur + 8 * (sub + 8 * m)), x);
#pragma unroll
            for (int e = 0; e < 8; ++e) sq += x[e] * x[e]; }
#pragma unroll
        for (int m = 0; m < 4; ++m) { float x[8]; unpack8(*(const u32x4*)(ur + 384 + 8 * (sub + 8 * m)), x);
#pragma unroll
            for (int e = 0; e < 8; ++e) skv += x[e] * x[e]; }
        sq = sum8(sq); skv = sum8(skv);
        const float rsq = 1.0f / sqrtf(sq * (1.f / 384.f) + EPS), rskv = 1.0f / sqrtf(skv * (1.f / 256.f) + EPS);
        float krv[4];
#pragma unroll
        for (int m = 0; m < 4; ++m) krv[m] = bf2f(ur[640 + sub + 8 * m]);
        float cr = 1.f, sr = 0.f, cc = 1.f, sc = 0.f;
        if (lat) { const f32x2 a0 = CS[pos * 16 + sub], a1 = CS[pos * 16 + 8 + sub]; cr = a0.x; sr = a0.y; cc = a1.x; sc = a1.y; }
        const bf16* qrow = QPRE + (size_t)row * 768; const bf16* kvrow = KVPRE + (size_t)row * 1024;
#pragma unroll 2
        for (int hh = 0; hh < 8; ++hh) {
            { float qn[8], qr[4]; unpack8(*(const u32x4*)(qrow + hh * 96 + 8 * sub), qn); float ss = 0.f;
#pragma unroll
              for (int e = 0; e < 8; ++e) qn[e] *= rsq;
#pragma unroll
              for (int m = 0; m < 4; ++m) { qr[m] = bf2f(qrow[hh * 96 + 64 + sub + 8 * m]) * rsq; ss += qr[m] * qr[m]; }
#pragma unroll
              for (int e = 0; e < 8; ++e) ss += qn[e] * qn[e];
              const float rn = 1.0f / sqrtf(sum8(ss) * (1.f / 96.f) + EPS);
#pragma unroll
              for (int e = 0; e < 8; ++e) qn[e] *= rn * qgn[e];
#pragma unroll
              for (int m = 0; m < 4; ++m) qr[m] *= rn * qgr[m];
              { const float x0 = qr[0], x1 = qr[1], y0 = qr[2], y1 = qr[3]; qr[0] = x0 * cr - x1 * sr; qr[1] = x1 * cr + x0 * sr; qr[2] = y0 * cc - y1 * sc; qr[3] = y1 * cc + y0 * sc; }
              bf16* qo = QB + ((size_t)(b * 8 + hh) * KPOS + pos) * 96;
              *(u32x4*)(qo + 8 * sub) = pack8(qn);
#pragma unroll
              for (int m = 0; m < 4; ++m) qo[64 + sub + 8 * m] = f2bf(qr[m]); }
            { float kn[8], kr[4]; unpack8(*(const u32x4*)(kvrow + hh * 128 + 8 * sub), kn); float ss = 0.f;
#pragma unroll
              for (int e = 0; e < 8; ++e) kn[e] *= rskv;
#pragma unroll
              for (int m = 0; m < 4; ++m) { kr[m] = krv[m]; ss += kr[m] * kr[m]; }
#pragma unroll
              for (int e = 0; e < 8; ++e) ss += kn[e] * kn[e];
              const float rn = 1.0f / sqrtf(sum8(ss) * (1.f / 96.f) + EPS);
#pragma unroll
              for (int e = 0; e < 8; ++e) kn[e] *= rn * kgn[e];
#pragma unroll
              for (int m = 0; m < 4; ++m) kr[m] *= rn * kgr[m];
              { const float x0 = kr[0], x1 = kr[1], y0 = kr[2], y1 = kr[3]; kr[0] = x0 * cr - x1 * sr; kr[1] = x1 * cr + x0 * sr; kr[2] = y0 * cc - y1 * sc; kr[3] = y1 * cc + y0 * sc; }
              bf16* ko = KB + ((size_t)(b * 8 + hh) * KPOS + pos) * 96;
              *(u32x4*)(ko + 8 * sub) = pack8(kn);
#pragma unroll
              for (int m = 0; m < 4; ++m) ko[64 + sub + 8 * m] = f2bf(kr[m]); }
            { float vv[8]; unpack8(*(const u32x4*)(kvrow + hh * 128 + 64 + 8 * sub), vv);
#pragma unroll
              for (int e = 0; e < 8; ++e) VL[(hh * 64 + 8 * sub + e) * 64 + pl] = f2bf(vv[e] * rskv); }
        }
        __syncthreads();
        { const int hd = C.tid;
            bf16* dst = VT + ((size_t)(b * 8 + (hd >> 6)) * 64 + (hd & 63)) * KPOS + pos0;
#pragma unroll
            for (int q = 0; q < 8; ++q) *(u32x4*)(dst + 8 * q) = *(const LAS u32x4*)(VL + hd * 64 + 8 * q); }
        __syncthreads();
    }
}

DI void conv_unit(const Ctx& C, int u, const bf16* U, const float (&wk)[31], float bias, const float* lng, const float* lnb, bf16* OCAT) {
    LAS float* G = (LAS float*)C.lds;
    const int c = C.tid;
    const int row0 = 32 * u; int base, t0, tseq;
    if (row0 < NLAT) { base = row0 & ~4095; t0 = row0 & 4095; tseq = TL; } else { const int rc = row0 - NLAT; base = NLAT + (rc & ~255); t0 = rc & 255; tseq = LCX; }
    __syncthreads();
    for (int rr = C.wave; rr < 62; rr += 8) { const int tt = t0 - 15 + rr; float g[8];
#pragma unroll
        for (int e = 0; e < 8; ++e) g[e] = 0.f;
        if (tt >= 0 && tt < tseq) { const bf16* ur = U + (size_t)(base + tt) * EV_INP; float av[8], gv[8]; unpack8(*(const u32x4*)(ur + 672 + 8 * C.lane), av); unpack8(*(const u32x4*)(ur + 1184 + 8 * C.lane), gv);
#pragma unroll
            for (int e = 0; e < 8; ++e) g[e] = av[e] * sigmoidf_(gv[e]); }
        *(LAS f32x4*)(G + rr * 512 + 8 * C.lane) = (f32x4){g[0], g[1], g[2], g[3]}; *(LAS f32x4*)(G + rr * 512 + 8 * C.lane + 4) = (f32x4){g[4], g[5], g[6], g[7]}; }
    __syncthreads();
    float acc[32];
#pragma unroll
    for (int t = 0; t < 32; ++t) acc[t] = bias;
#pragma unroll
    for (int rr = 0; rr < 62; ++rr) { const float gv = G[rr * 512 + c];
#pragma unroll
        for (int t = 0; t < 32; ++t) { const int k = rr - t; if (k >= 0 && k < 31) acc[t] += gv * wk[k]; } }
    __syncthreads();
#pragma unroll
    for (int t = 0; t < 32; ++t) G[t * 512 + c] = acc[t];
    __syncthreads();
#pragma unroll
    for (int q = 0; q < 4; ++q) {
        const int t = 4 * C.wave + q, row = row0 + t;
        const f32x4 a0 = *(const LAS f32x4*)(G + t * 512 + 8 * C.lane), a1 = *(const LAS f32x4*)(G + t * 512 + 8 * C.lane + 4);
        float x[8] = {a0.x, a0.y, a0.z, a0.w, a1.x, a1.y, a1.z, a1.w}; float s = 0.f;
#pragma unroll
        for (int e = 0; e < 8; ++e) s += x[e];
        const float mu = wave_sum(s) * (1.f / 512.f); float s2 = 0.f;
#pragma unroll
        for (int e = 0; e < 8; ++e) { x[e] -= mu; s2 += x[e] * x[e]; }
        const float rstd = 1.0f / sqrtf(wave_sum(s2) * (1.f / 512.f) + EPS);
        float y[8];
#pragma unroll
        for (int e = 0; e < 8; ++e) { const float z = x[e] * rstd * lng[8 * C.lane + e] + lnb[8 * C.lane + e]; y[e] = siluf_(z); }
        *(u32x4*)(OCAT + (size_t)row * DM + 512 + 8 * C.lane) = pack8(y);
    }
    __syncthreads();
}
DI void wprep_span(const Ctx& C, int first, int stride, const float* w1, const float* w3, const float* w2, bf16* W13, bf16* W2) {
    LAS float* scr = (LAS float*)(C.lds + C.wave * 16640);
    constexpr int PER = 16 * 16, NIT = NEXP * 3 * PER;
    for (int it = first; it < NIT; it += stride) {
        const int e = it / (3 * PER), r = it % (3 * PER), which = r / PER, q = r % PER, kb = q / 16, n0 = (q % 16) * 64;
#if MOE_F8
        if (which == 0)      transpose_item64_f8(w1 + (size_t)e * DM * DM, DM, DM, (unsigned char*)W13 + (size_t)e * 2048 * DM, (n0 >> 7) * 256 + (n0 & 127), scr, kb * 64, n0, C.lane);
        else if (which == 1) transpose_item64_f8(w3 + (size_t)e * DM * DM, DM, DM, (unsigned char*)W13 + (size_t)e * 2048 * DM, (n0 >> 7) * 256 + (n0 & 127) + 128, scr, kb * 64, n0, C.lane);
        else                 transpose_item64_f8(w2 + (size_t)e * DM * DM, DM, DM, (unsigned char*)W2 + (size_t)e * DM * DM, n0, scr, kb * 64, n0, C.lane); }
#else
        if (which == 0)      transpose_item64(w1 + (size_t)e * DM * DM, DM, DM, W13 + (size_t)e * 2048 * DM, (n0 >> 7) * 256 + (n0 & 127), scr, kb * 64, n0, C.lane);
        else if (which == 1) transpose_item64(w3 + (size_t)e * DM * DM, DM, DM, W13 + (size_t)e * 2048 * DM, (n0 >> 7) * 256 + (n0 & 127) + 128, scr, kb * 64, n0, C.lane);
        else                 transpose_item64(w2 + (size_t)e * DM * DM, DM, DM, W2 + (size_t)e * DM * DM, n0, scr, kb * 64, n0, C.lane); }
#endif
}
constexpr int WPREP_PER_WAVE = (NEXP * 3 * 256 + 2047) / 2048;

DI void shifted8(const bf16* up, const bf16* uc, const bf16* un, bool hp, bool hn, const float (&s0)[8], const float (&s1)[8], const float (&s2)[8], int c0, float (&o)[8]) {
    const u32x4 z = {0u, 0u, 0u, 0u};
    const u32x4 vp = hp ? *(const u32x4*)(up + c0) : z, vc = *(const u32x4*)(uc + c0), vn = hn ? *(const u32x4*)(un + c0) : z;
    float p[8], c[8], n[8]; unpack8(vp, p); unpack8(vc, c); unpack8(vn, n);
#pragma unroll
    for (int e = 0; e < 8; ++e) o[e] = p[e] * s0[e] + c[e] * s1[e] + n[e] * s2[e];
}
DI void load_sw(const float* sw, int c0, float (&s0)[8], float (&s1)[8], float (&s2)[8]) {
#pragma unroll
    for (int e = 0; e < 8; ++e) { s0[e] = sw[c0 + e]; s1[e] = sw[RW_IN + c0 + e]; s2[e] = sw[2 * RW_IN + c0 + e]; }
}
DI void ph_prep(const Ctx& C, const bf16* U, const float* sw  , const float* kkw  , const float* naqg, const float* nakg,
                bf16* R, bf16* V, bf16* K, bf16* KK, bf16* L, bf16* QN, bf16* KN, bf16* VTN) {
    LAS bf16* VL = (LAS bf16*)C.lds;
    const int lane = C.lane, hh = lane >> 3, sub = lane & 7;
    const float C2 = 0.125f * LOG2E;
    for (int u = C.vcu; u < MT / 32; u += C.nb) {
        const int row0 = 32 * u; const bool lat = row0 < NLAT;
        const int b = lat ? (row0 >> 12) : ((row0 - NLAT) >> 8), pos0 = lat ? (row0 & 4095) : TL + ((row0 - NLAT) & 255), tseq = lat ? TL : LCX, tb = lat ? (row0 & 4095) : ((row0 - NLAT) & 255);
#define PREP_ROWVARS(i) const int pl = 4 * C.wave + (i), row = row0 + pl, t = tb + pl; const bool hp = t > 0, hn = t < tseq - 1; \
            const bf16* uc = U + (size_t)row * OD_INP; const bf16* up = uc - OD_INP; const bf16* un = uc + OD_INP
        { float s0[8], s1[8], s2[8]; load_sw(sw, 8 * lane, s0, s1, s2);
          for (int i = 0; i < 4; ++i) { PREP_ROWVARS(i); float o[8]; shifted8(up, uc, un, hp, hn, s0, s1, s2, 8 * lane, o); *(u32x4*)(R + (size_t)row * 512 + 8 * lane) = pack8(o); } }
        { float s0[8], s1[8], s2[8]; load_sw(sw, 1024 + 8 * lane, s0, s1, s2);
          for (int i = 0; i < 4; ++i) { PREP_ROWVARS(i); float o[8]; shifted8(up, uc, un, hp, hn, s0, s1, s2, 1024 + 8 * lane, o); *(u32x4*)(V + (size_t)row * 512 + 8 * lane) = pack8(o); } }
        { float s0[8], s1[8], s2[8]; load_sw(sw, 512 + 8 * lane, s0, s1, s2); float kw[8];
#pragma unroll
          for (int e = 0; e < 8; ++e) kw[e] = kkw[8 * lane + e];
          for (int i = 0; i < 4; ++i) { PREP_ROWVARS(i); float o[8]; shifted8(up, uc, un, hp, hn, s0, s1, s2, 512 + 8 * lane, o); *(u32x4*)(K + (size_t)row * 512 + 8 * lane) = pack8(o);
              float kk[8]; float ss = 0.f;
#pragma unroll
              for (int e = 0; e < 8; ++e) { kk[e] = o[e] * kw[e]; ss += kk[e] * kk[e]; }
              ss = sum8(ss); const float rn = 1.0f / sqrtf(ss + 1e-12f);
#pragma unroll
              for (int e = 0; e < 8; ++e) kk[e] *= rn;
              *(u32x4*)(KK + (size_t)row * 512 + 8 * lane) = pack8(kk); } }
        if (lane < 48) { float s0[8], s1[8], s2[8]; load_sw(sw, 1536 + 8 * lane, s0, s1, s2);
          for (int i = 0; i < 4; ++i) { PREP_ROWVARS(i); float o[8]; shifted8(up, uc, un, hp, hn, s0, s1, s2, 1536 + 8 * lane, o);
              if (lane < 16) {
#pragma unroll
                  for (int e = 0; e < 8; ++e) { const float ex = __expf(2.f * o[e]); o[e] = 1.f - 2.f * __builtin_amdgcn_rcpf(ex + 1.f); }
              } else if (lane >= 32) {
#pragma unroll
                  for (int e = 0; e < 8; ++e) o[e] = sigmoidf_(o[e]);
              }
              *(u32x4*)(L + (size_t)row * 384 + 8 * lane) = pack8(o); } }
        { float gq[8], gk[8];
#pragma unroll
          for (int e = 0; e < 8; ++e) { gq[e] = naqg[8 * sub + e] * C2; gk[e] = nakg[8 * sub + e]; }
          for (int i = 0; i < 4; ++i) { const int pl = 4 * C.wave + i, row = row0 + pl, pos = pos0 + pl; const bf16* uc = U + (size_t)row * OD_INP;
            { float x[8]; unpack8(*(const u32x4*)(uc + RW_IN + 8 * lane), x); float ss = 0.f;
#pragma unroll
                for (int e = 0; e < 8; ++e) ss += x[e] * x[e];
                ss = sum8(ss); const float rn = 1.0f / sqrtf(ss * (1.f / 64.f) + EPS);
#pragma unroll
                for (int e = 0; e < 8; ++e) x[e] = x[e] * rn * gq[e];
                *(u32x4*)(QN + ((size_t)(b * 8 + hh) * KPOS + pos) * 64 + 8 * sub) = pack8(x); }
            { float x[8]; unpack8(*(const u32x4*)(uc + RW_IN + 512 + 8 * lane), x); float ss = 0.f;
#pragma unroll
                for (int e = 0; e < 8; ++e) ss += x[e] * x[e];
                ss = sum8(ss); const float rn = 1.0f / sqrtf(ss * (1.f / 64.f) + EPS);
#pragma unroll
                for (int e = 0; e < 8; ++e) x[e] = x[e] * rn * gk[e];
                *(u32x4*)(KN + ((size_t)(b * 8 + hh) * KPOS + pos) * 64 + 8 * sub) = pack8(x); }
            { const u32x4 vv = *(const u32x4*)(uc + RW_IN + 1024 + 8 * lane); const unsigned w4[4] = {vv.x, vv.y, vv.z, vv.w};
#pragma unroll
                for (int e = 0; e < 8; ++e) { const int dv = 8 * sub + e; VL[(hh * 64 + dv) * 32 + pl] = (bf16)((e & 1) ? (w4[e >> 1] >> 16) : (w4[e >> 1] & 0xffffu)); } } } }
#undef PREP_ROWVARS
        __syncthreads();
        { const int hd = C.tid; bf16* dst = VTN + ((size_t)(b * 8 + (hd >> 6)) * 64 + (hd & 63)) * KPOS + pos0;
#pragma unroll
            for (int q = 0; q < 4; ++q) *(u32x4*)(dst + 8 * q) = *(const LAS u32x4*)(VL + hd * 32 + 8 * q); }
        __syncthreads();
    }
}

DI int scan_row(int s, int d, int b) { if (s < LCX) return NLAT + b * LCX + (d ? (LCX - 1 - s) : s); const int t = s - LCX; return b * TL + (d ? (TL - 1 - t) : t); }


constexpr int CCH = 16, NCHK = KPOS / CCH, NPROB = NB * 8 * 2 * NCHK, IMG_ELEMS = 3 * 32 * 16;
template <int N> struct ICk { static constexpr int value = N; };
DI int crow_(int reg, int h) { return (reg & 3) + 8 * (reg >> 2) + 4 * h; }
DI bf16x8 pack_lo8(const f32x16& x) {
    u32x4 p; p.x = pk2(x[0], x[1]); p.y = pk2(x[2], x[3]); p.z = pk2(x[4], x[5]); p.w = pk2(x[6], x[7]); return __builtin_bit_cast(bf16x8, p); }
DI bf16x8 pack_hi8(const f32x16& x) { u32x4 p; p.x = pk2(x[8], x[9]); p.y = pk2(x[10], x[11]); p.z = pk2(x[12], x[13]); p.w = pk2(x[14], x[15]); return __builtin_bit_cast(bf16x8, p); }
DI int perm16(int k) { return (k & ~15) | swap23(k & 15); }

DI void ph_wkv_pre(const Ctx& C, const bf16* R, const bf16* K, const bf16* KK, const unsigned short* LW, const bf16* AR_, const float* ka, bf16* IMG) {
    LAS unsigned char* wl = C.lds + C.wave * 13312;
    LAS bf16* ARl = (LAS bf16*)wl; LAS bf16* BKl = (LAS bf16*)(wl + 4608); LAS float* Ll = (LAS float*)(wl + 9216); LAS bf16* OUT = (LAS bf16*)(wl + 10240);
    const int lane = C.lane, r = lane & 31, h = lane >> 5;
    const int gw = C.vcu * 8 + C.wave, ngw = C.nb * 8;
    for (int p = gw; p < NPROB; p += ngw) {
        const int j = p % NCHK, rest = p / NCHK, d = rest & 1, hh = (rest >> 1) & 7, b = rest >> 4;
        const unsigned short* Wd = LW + (size_t)d * MT * 512; const bf16* Ad = AR_ + (size_t)d * MT * 512;
        const float kav = ka[hh * 64 + lane];
        const int row0 = scan_row(j * CCH, d, b), sg = d ? -1 : 1;
        float lw[16]; bf16 rr[16], kx[16], kkx[16], ax[16];
#pragma unroll
        for (int t = 0; t < 16; ++t) { const size_t off = (size_t)(row0 + sg * t) * 512 + hh * 64 + lane; lw[t] = h2f(Wd[off]); rr[t] = R[off]; kx[t] = K[off]; kkx[t] = KK[off]; ax[t] = Ad[off]; }
        float cum = 0.f, e0 = 1.f;
#pragma unroll
        for (int t = 0; t < 16; ++t) {
            cum += lw[t]; const float e1 = __expf(cum), ei = __builtin_amdgcn_rcpf(e1);
            const float kkv = bf2f(kkx[t]), av = bf2f(ax[t]), keff = bf2f(kx[t]) * (1.f + (av - 1.f) * kav);
            ARl[t * 72 + lane] = f2bf(-kkv * e0); ARl[(16 + t) * 72 + lane] = f2bf(bf2f(rr[t]) * e1);
            BKl[t * 72 + lane] = f2bf(kkv * av * ei); BKl[(16 + t) * 72 + lane] = f2bf(keff * ei);
            e0 = e1;
        }
        asm volatile("s_waitcnt lgkmcnt(0)" ::: "memory");
        f32x16 g;
#pragma unroll
        for (int i = 0; i < 16; ++i) g[i] = 0.f;
#pragma unroll
        for (int q = 0; q < 4; ++q) g = MFMA32(*(const LAS bf16x8*)(ARl + r * 72 + 16 * q + 8 * h), *(const LAS bf16x8*)(BKl + r * 72 + 16 * q + 8 * h), g);
        const int sI = r & 15; const bool isk = r >= 16;
#pragma unroll
        for (int i = 0; i < 16; ++i) {
            const int row = crow_(i, h), t = row & 15; const bool keep = (i < 8) ? (sI < t) : (sI <= t); const float val = keep ? g[i] : 0.f;
            if (i < 8) { if (!isk) { Ll[t * 16 + sI] = val; OUT[512 + row * 16 + perm16(sI)] = 0; } else OUT[row * 16 + sI] = f2bf(val); }
            else       { if (!isk) OUT[512 + row * 16 + perm16(sI)] = f2bf(val); else OUT[row * 16 + sI] = f2bf(val); }
        }
        asm volatile("s_waitcnt lgkmcnt(0)" ::: "memory");
        { const int c = lane & 15; float Pr[16];
            Pr[0] = (c == 0) ? 1.f : 0.f;
#pragma unroll
            for (int t = 1; t < 16; ++t) { const float lrow = Ll[t * 16 + c]; float acc = (c == t) ? 1.f : 0.f;
#pragma unroll
                for (int u = 0; u < t; ++u) acc += rdlane(lrow, u) * Pr[u];
                Pr[t] = acc; }
            if (lane < 16) {
#pragma unroll
                for (int t = 0; t < 16; ++t) { OUT[1024 + t * 16 + perm16(c)] = f2bf(Pr[t]); OUT[1024 + (16 + t) * 16 + c] = 0; } } }
        asm volatile("s_waitcnt lgkmcnt(0)" ::: "memory");
        { bf16* dst = IMG + (size_t)p * IMG_ELEMS;
#pragma unroll
            for (int q = 0; q < 3; ++q) *(u32x4*)(dst + (q * 64 + lane) * 8) = *(const LAS u32x4*)(OUT + (q * 64 + lane) * 8); }
        asm volatile("s_waitcnt lgkmcnt(0)" ::: "memory");
    }
}

DI void ph_wkv_chunk(const Ctx& C, const bf16* R, const bf16* V, const bf16* K, const bf16* KK, const unsigned short* LW, const bf16* AR_, const float* ka, const bf16* IMG, bf16* YS) {
    constexpr int S_AR = 0, S_BKT = 4608, S_VT = 9728, S_VT2 = 11264, S_GC = 12800, S_MM = 13056, S_MRB = 14592, S_PP = 16128, SLOT = 17664, CUMO = 2 * SLOT, YSTO = CUMO + 8192, DEPTH = 4;
    const int lane = C.lane, wv = C.wave, r = lane & 31, h = lane >> 5;
    const bool isE = wv == 2 || wv == 3 || wv == 6 || wv == 7, isS = wv < 2;
    const int te = (wv == 2 ? 0 : (wv == 3 ? 1 : (wv == 6 ? 2 : 3))) * 64 + lane, et = te >> 4, ekq = te & 15;
    const int vhf = te >> 7, vt = (te >> 3) & 15, viq = te & 7;
    const int hf = wv & 1;
    for (int cid0 = C.bid; cid0 < 128; cid0 += C.nb) {
        const int chain = cid0, b = chain >> 4, hh = (chain >> 1) & 7, d = chain & 1;
        const unsigned short* Wd = LW + (size_t)d * MT * 512; const bf16* Ad = AR_ + (size_t)d * MT * 512; bf16* Yd = YS + (size_t)d * MT * 512;
        const bf16* img = IMG + (size_t)(((b * 8 + hh) * 2 + d) * NCHK) * IMG_ELEMS;
        f32x16 ST[2];
#pragma unroll
        for (int i = 0; i < 16; ++i) { ST[0][i] = 0.f; ST[1][i] = 0.f; }
        const f32x4 kav = *(const f32x4*)(ka + hh * 64 + 4 * ekq);
        unsigned ring[DEPTH][16];
        __syncthreads();
        auto issue = [&](int ch, unsigned (&rg)[16]) __attribute__((always_inline)) {
            if (ch < 0 || ch >= NCHK) return;
            const int row0 = scan_row(ch * CCH, d, b), sg = d ? -1 : 1;
            if (isE) {
                const size_t off = (size_t)(row0 + sg * et) * 512 + hh * 64 + 4 * ekq;
                const u32x2 x0 = *(const u32x2*)(R + off), x1 = *(const u32x2*)(K + off), x2 = *(const u32x2*)(KK + off), x3 = *(const u32x2*)(Ad + off);
                const u32x2 x4 = *(const u32x2*)(V + (size_t)(row0 + sg * vt) * 512 + hh * 64 + 32 * vhf + 4 * viq);
                rg[0] = x0.x; rg[1] = x0.y; rg[2] = x1.x; rg[3] = x1.y; rg[4] = x2.x; rg[5] = x2.y; rg[6] = x3.x; rg[7] = x3.y; rg[8] = x4.x; rg[9] = x4.y;
                asm volatile("; wkv issue role E" ::);
            } else if (wv == 4) {
#define W5_(t) rg[(t)] = (unsigned)Wd[(size_t)(row0 + sg * (t)) * 512 + hh * 64 + lane]
                W5_(0); W5_(1); W5_(2); W5_(3); W5_(4); W5_(5); W5_(6); W5_(7); W5_(8); W5_(9); W5_(10); W5_(11); W5_(12); W5_(13); W5_(14); W5_(15);
#undef W5_
                asm volatile("; wkv issue role C" ::);
            } else if (wv == 5) {
#define W6_(q) do { const u32x4 x = *(const u32x4*)(img + (size_t)ch * IMG_ELEMS + ((q) * 64 + lane) * 8); rg[4 * (q)] = x.x; rg[4 * (q) + 1] = x.y; rg[4 * (q) + 2] = x.z; rg[4 * (q) + 3] = x.w; } while (0)
                W6_(0); W6_(1); W6_(2);
#undef W6_
                asm volatile("; wkv issue role V" ::);
            }
        };
        issue(0, ring[0]); issue(1, ring[1]); issue(2, ring[2]); issue(3, ring[3]);
#define WKV_BAR() asm volatile("s_waitcnt lgkmcnt(0)\n\ts_barrier" ::: "memory")
#define WKV_LOOP(...) for (int n0 = -2; n0 < NCHK; n0 += DEPTH) { auto iter = [&](auto kc) __attribute__((always_inline)) { constexpr int kk = decltype(kc)::value; \
            constexpr int riE = (kk + 3) % DEPTH, riW = kk % DEPTH; (void)riE; (void)riW; const int n = n0 + kk; (void)n; __VA_ARGS__; WKV_BAR(); }; iter(ICk<0>{}); iter(ICk<1>{}); iter(ICk<2>{}); iter(ICk<3>{}); }
        if (isS) {
            WKV_LOOP({
                if (n >= 0 && n < NCHK) {
                    const LAS unsigned char* B = C.lds + (n & 1) * SLOT;
                    f32x16 T1;
                    _Pragma("unroll") for (int i = 0; i < 16; ++i) T1[i] = 0.f;
                    _Pragma("unroll") for (int tau = 0; tau < 2; ++tau) {
                        T1 = MFMA32(*(const LAS bf16x8*)(B + S_AR + r * 144 + (32 * tau + 8 * h) * 2), pack_lo8(ST[tau]), T1);
                        T1 = MFMA32(*(const LAS bf16x8*)(B + S_AR + r * 144 + (32 * tau + 16 + 8 * h) * 2), pack_hi8(ST[tau]), T1);
                    }
                    const bf16x8 vtf = *(const LAS bf16x8*)(B + (hf ? S_VT2 : S_VT) + r * 48 + 16 * h);
                    T1 = MFMA32(*(const LAS bf16x8*)(B + S_MM + r * 48 + 16 * h), vtf, T1);
                    f32x16 ET;
                    _Pragma("unroll") for (int i = 0; i < 16; ++i) ET[i] = 0.f;
                    ET = MFMA32(*(const LAS bf16x8*)(B + S_PP + r * 48 + 16 * h), pack_lo8(T1), ET);
                    const bf16x8 ef = pack_lo8(ET);
                    T1 = MFMA32(*(const LAS bf16x8*)(B + S_MRB + r * 48 + 16 * h), ef, T1);
                    _Pragma("unroll") for (int tau = 0; tau < 2; ++tau) {
                        ST[tau] = MFMA32(*(const LAS bf16x8*)(B + S_BKT + (32 * tau + r) * 80 + 16 * h), ef, ST[tau]);
                        ST[tau] = MFMA32(*(const LAS bf16x8*)(B + S_BKT + (32 * tau + r) * 80 + 32 + 16 * h), vtf, ST[tau]);
                        _Pragma("unroll") for (int g4 = 0; g4 < 4; ++g4) { const f32x4 gc = *(const LAS f32x4*)(B + S_GC + (32 * tau + 8 * g4 + 4 * h) * 4);
                            ST[tau][4 * g4] *= gc.x; ST[tau][4 * g4 + 1] *= gc.y; ST[tau][4 * g4 + 2] *= gc.z; ST[tau][4 * g4 + 3] *= gc.w; }
                    }
                    LAS float* ys = (LAS float*)(C.lds + YSTO) + ((n & 1) * 2 + hf) * 512;
                    _Pragma("unroll") for (int q = 0; q < 8; ++q) ys[(8 * (q >> 2) + 4 * h + (q & 3)) * 32 + r] = T1[8 + q];
                }
            });
        } else if (isE) {
            WKV_LOOP({
                const int ch = n + 1;
                if (ch >= 0) {
                    if (ch < NCHK) {
                        LAS unsigned char* B = C.lds + (ch & 1) * SLOT; const LAS float* ec = (const LAS float*)(C.lds + CUMO) + (ch & 1) * 1024;
                        const f32x4 e1 = *(const LAS f32x4*)(ec + et * 64 + 4 * ekq);
                        f32x4 e0 = {1.f, 1.f, 1.f, 1.f}; if (et > 0) e0 = *(const LAS f32x4*)(ec + (et - 1) * 64 + 4 * ekq);
                        const float rv[4] = {bflo(ring[riE][0]), bfhi(ring[riE][0]), bflo(ring[riE][1]), bfhi(ring[riE][1])}; const float kv[4] = {bflo(ring[riE][2]), bfhi(ring[riE][2]), bflo(ring[riE][3]), bfhi(ring[riE][3])};
                        const float kkv[4] = {bflo(ring[riE][4]), bfhi(ring[riE][4]), bflo(ring[riE][5]), bfhi(ring[riE][5])}; const float av[4] = {bflo(ring[riE][6]), bfhi(ring[riE][6]), bflo(ring[riE][7]), bfhi(ring[riE][7])};
                        float ah[4]; float rh[4]; float bc[4]; float kc4[4];
                        _Pragma("unroll") for (int e = 0; e < 4; ++e) { const float ei = __builtin_amdgcn_rcpf(e1[e]);
                            ah[e] = -kkv[e] * e0[e]; rh[e] = rv[e] * e1[e]; bc[e] = kkv[e] * av[e] * ei; kc4[e] = kv[e] * (1.f + (av[e] - 1.f) * kav[e]) * ei; }
                        const int pk = perm16(4 * ekq);
                        *(LAS u32x2*)((LAS bf16*)(B + S_AR) + et * 72 + pk) = (u32x2){pk2(ah[0], ah[1]), pk2(ah[2], ah[3])};
                        *(LAS u32x2*)((LAS bf16*)(B + S_AR) + (16 + et) * 72 + pk) = (u32x2){pk2(rh[0], rh[1]), pk2(rh[2], rh[3])};
                        const int pt = perm16(et);
                        _Pragma("unroll") for (int e = 0; e < 4; ++e) { ((LAS bf16*)(B + S_BKT))[(4 * ekq + e) * 40 + pt] = f2bf(bc[e]); ((LAS bf16*)(B + S_BKT))[(4 * ekq + e) * 40 + 16 + et] = f2bf(kc4[e]); }
                        if (et == 15) *(LAS f32x4*)((LAS float*)(B + S_GC) + 4 * ekq) = e1;
                        LAS bf16* vtp = (LAS bf16*)(B + (vhf ? S_VT2 : S_VT)) + (4 * viq) * 24 + vt;
                        vtp[0] = (bf16)(ring[riE][8] & 0xffffu); vtp[24] = (bf16)(ring[riE][8] >> 16); vtp[48] = (bf16)(ring[riE][9] & 0xffffu); vtp[72] = (bf16)(ring[riE][9] >> 16);
                    }
                    issue(ch + DEPTH, ring[riE]);
                }
            });
        } else if (wv == 4) {
            WKV_LOOP({
                const int ch = n + 2;
                if (ch < NCHK) { LAS float* ec = (LAS float*)(C.lds + CUMO) + (ch & 1) * 1024; float c = 0.f;
#define C5_(t) do { c += h2f((unsigned short)ring[riW][(t)]); ec[(t) * 64 + lane] = __expf(c); } while (0)
                    C5_(0); C5_(1); C5_(2); C5_(3); C5_(4); C5_(5); C5_(6); C5_(7); C5_(8); C5_(9); C5_(10); C5_(11); C5_(12); C5_(13); C5_(14); C5_(15);
                }
                issue(ch + DEPTH, ring[riW]);
            });
        } else {
            WKV_LOOP({
                { const int chy = n - 1;
                  if (chy >= 0 && chy < NCHK) { const int yh = lane >> 5, yt = (lane & 31) >> 1, yi = 16 * (lane & 1);
                    const LAS float* ys = (const LAS float*)(C.lds + YSTO) + ((chy & 1) * 2 + yh) * 512 + yt * 32 + yi;
                    bf16* dst = Yd + (size_t)(scan_row(chy * CCH, d, b) + (d ? -1 : 1) * yt) * 512 + hh * 64 + 32 * yh + yi;
                    _Pragma("unroll") for (int q = 0; q < 2; ++q) { const f32x4 a0 = *(const LAS f32x4*)(ys + 8 * q); const f32x4 a1 = *(const LAS f32x4*)(ys + 8 * q + 4);
                        *(u32x4*)(dst + 8 * q) = (u32x4){pk2(a0.x, a0.y), pk2(a0.z, a0.w), pk2(a1.x, a1.y), pk2(a1.z, a1.w)}; } } }
                const int ch = n + 1;
                if (ch >= 0) {
                    if (ch < NCHK) { LAS unsigned char* B = C.lds + (ch & 1) * SLOT;
                        const int irow = lane >> 1; const int ihv = lane & 1;
                        *(LAS u32x4*)(B + S_MM + irow * 48 + ihv * 16) = (u32x4){ring[riE][0], ring[riE][1], ring[riE][2], ring[riE][3]};
                        *(LAS u32x4*)(B + S_MRB + irow * 48 + ihv * 16) = (u32x4){ring[riE][4], ring[riE][5], ring[riE][6], ring[riE][7]};
                        *(LAS u32x4*)(B + S_PP + irow * 48 + ihv * 16) = (u32x4){ring[riE][8], ring[riE][9], ring[riE][10], ring[riE][11]};
                    }
                    issue(ch + DEPTH, ring[riE]);
                }
            });
        }
#undef C5_
#undef WKV_LOOP
#undef WKV_BAR
    }
}

DI void ph_post(const Ctx& C, const bf16* YS, const bf16* R, const bf16* V, const bf16* K, const bf16* A2, const float* ka, const bf16* G, const float* rk, const float* gng, const float* gnb, bf16* OCAT, bool last) {
    const int gw = C.bid * 8 + C.wave, ngw = C.nb * 8, lane = C.lane, nrows = last ? NLAT : MT;
    for (int row = gw; row < nrows; row += ngw) {
        const size_t o = (size_t)row * 512 + 8 * lane;
        float y[8], y1[8]; unpack8(*(const u32x4*)(YS + o), y); unpack8(*(const u32x4*)(YS + (size_t)MT * 512 + o), y1);
#pragma unroll
        for (int e = 0; e < 8; ++e) y[e] += y1[e];
        float r[8], v[8], kx[8], a0[8], a1[8], g[8];
        unpack8(*(const u32x4*)(R + o), r); unpack8(*(const u32x4*)(V + o), v); unpack8(*(const u32x4*)(K + o), kx); unpack8(*(const u32x4*)(A2 + o), a0); unpack8(*(const u32x4*)(A2 + (size_t)MT * 512 + o), a1); unpack8(*(const u32x4*)(G + o), g);
        float bsum = 0.f;
#pragma unroll
        for (int e = 0; e < 8; ++e) { const float kae = ka[8 * lane + e]; bsum += r[e] * (kx[e] * (1.f + (a0[e] - 1.f) * kae) + kx[e] * (1.f + (a1[e] - 1.f) * kae)) * rk[8 * lane + e]; }
        bsum = sum8(bsum);
        float s = 0.f;
#pragma unroll
        for (int e = 0; e < 8; ++e) { y[e] += bsum * v[e]; s += y[e]; }
        const float mu = sum8(s) * (1.f / 64.f); float s2 = 0.f;
#pragma unroll
        for (int e = 0; e < 8; ++e) { y[e] -= mu; s2 += y[e] * y[e]; }
        const float rstd = 1.0f / sqrtf(sum8(s2) * (1.f / 64.f) + GN_EPS);
        float out[8];
#pragma unroll
        for (int e = 0; e < 8; ++e) out[e] = (y[e] * rstd * gng[8 * lane + e] + gnb[8 * lane + e]) * g[e];
        *(u32x4*)(OCAT + (size_t)row * DM + 8 * lane) = pack8(out);
    }
}

DI void ph_topk2(const Ctx& C, const float* AFFT, const float* AFFC, int* ROWS, float* GATE, int* SLOT, bool last) {
    LAS unsigned* wcnt = (LAS unsigned*)C.lds;
    LAS unsigned* cnt = wcnt + 16;
    const int tid = C.tid, nprob = last ? 128 : 256;
    for (int p = C.bid; p < nprob; p += C.nb) {
        const bool isctx = p >= 128; const int be = p & 127, b = be >> 4, e = be & 15;
        const int n = isctx ? LCX : TL, cap = isctx ? CAPC : CAPL;
        const float* src = isctx ? AFFC + (size_t)be * LCX : AFFT + (size_t)be * TL;
        unsigned v[8]; const int per = isctx ? 1 : 8, t0 = tid * per;
#pragma unroll
        for (int q = 0; q < 8; ++q) v[q] = 0u;
        if (!isctx) { const u32x4 a0 = *(const u32x4*)(src + t0), a1 = *(const u32x4*)(src + t0 + 4); v[0] = a0.x; v[1] = a0.y; v[2] = a0.z; v[3] = a0.w; v[4] = a1.x; v[5] = a1.y; v[6] = a1.z; v[7] = a1.w; }
        else if (tid < LCX) v[0] = __builtin_bit_cast(unsigned, src[tid]);
        __syncthreads();
        unsigned T = 0u;
        for (int bit = 30; bit >= 0; --bit) {
            const unsigned cand = T | (1u << bit); unsigned c = 0u;
#pragma unroll
            for (int q = 0; q < 8; ++q) c += (unsigned)__builtin_popcountll(__builtin_amdgcn_ballot_w64(v[q] >= cand));
            LAS unsigned* wc = wcnt + (bit & 1) * 8;
            if (C.lane == 0) wc[C.wave] = c;
            __syncthreads();
            const unsigned tot = wc[0] + wc[1] + wc[2] + wc[3] + wc[4] + wc[5] + wc[6] + wc[7];
            if (tot >= (unsigned)cap) T = cand;
        }
        unsigned myc = 0u;
#pragma unroll
        for (int q = 0; q < 8; ++q) myc += (v[q] > T ? 0x10000u : 0u) + ((v[q] == T && (isctx ? (q == 0 && tid < LCX) : true)) ? 1u : 0u);
        __syncthreads();
        cnt[tid] = myc;
        __syncthreads();
        for (int off = 1; off < 512; off <<= 1) { const unsigned add = tid >= off ? cnt[tid - off] : 0u; __syncthreads(); cnt[tid] += add; __syncthreads(); }
        const unsigned total = cnt[511], keq = (unsigned)cap - (total >> 16);
        unsigned before = cnt[tid] - myc;
        for (int q = 0; q < per; ++q) { const int t = t0 + q; if (t >= n) break; const unsigned x = v[q]; const unsigned gtb = before >> 16, eqb = before & 0xFFFFu;
            const bool sel = x > T || (x == T && eqb < keq);
            if (sel) { const int jx = (int)(gtb + (eqb < keq ? eqb : keq));
                const int slot = isctx ? NB * CAPL + b * CAPC + jx : b * CAPL + jx, row = isctx ? NLAT + b * LCX + t : b * TL + t;
                ROWS[e * ESLOTS + slot] = row; GATE[e * ESLOTS + slot] = __builtin_bit_cast(float, x); SLOT[(size_t)row * 16 + e] = slot; }
            before += (x > T ? 0x10000u : 0u) + (x == T ? 1u : 0u); }
        __syncthreads();
    }
}


DI void ph_combine(const Ctx& C, float* xlat, float* xctx, const float* modg2  , const int* SLOT, const bf16* Y2, bool last,
                   const float* ngain  , const float* nmod  , bf16* H) {
    const int gw = C.bid * 8 + C.wave, ngw = C.nb * 8, lane = C.lane, nrows = last ? NLAT : MT;
    for (int row = gw; row < nrows; row += ngw) {
        float* xr = row < NLAT ? xlat + (size_t)row * DM : xctx + (size_t)(row - NLAT) * DM;
        const int mi = row < NLAT ? (row >> 12) : 8;
        const int sv = SLOT[(size_t)row * 16 + (lane & 15)];
        f32x4 acc[4];
#pragma unroll
        for (int j = 0; j < 4; ++j) acc[j] = (f32x4){0.f, 0.f, 0.f, 0.f};
#pragma unroll
        for (int e = 0; e < 16; ++e) {
            const int s = __builtin_amdgcn_readlane(sv, e);
            if (s >= 0) { const bf16* yp = Y2 + ((size_t)e * ESLOTS + s) * DM + 4 * lane;
#pragma unroll
                for (int j = 0; j < 4; ++j) { const u32x2 w = *(const u32x2*)(yp + 256 * j); acc[j] += (f32x4){bflo(w.x), bfhi(w.x), bflo(w.y), bfhi(w.y)}; } }
        }
#pragma unroll
        for (int j = 0; j < 4; ++j) { const int c = 256 * j + 4 * lane; const f32x4 g = *(const f32x4*)(modg2 + mi * 6144 + c); f32x4 x = *(const f32x4*)(xr + c); x += g * acc[j]; *(f32x4*)(xr + c) = x; acc[j] = x; }
        if (ngain) {
            float ss = 0.f;
#pragma unroll
            for (int j = 0; j < 4; ++j) ss += acc[j].x * acc[j].x + acc[j].y * acc[j].y + acc[j].z * acc[j].z + acc[j].w * acc[j].w;
            const float rs = 1.0f / sqrtf(wave_sum(ss) * (1.f / 1024.f) + EPS);
            const float* mp = nmod + mi * 6144;
#pragma unroll
            for (int j = 0; j < 4; ++j) { const int c = 256 * j + 4 * lane;
                const f32x4 g = *(const f32x4*)(ngain + c), sc = *(const f32x4*)(mp + 1024 + c), sh = *(const f32x4*)(mp + c);
                const f32x4 hv = (acc[j] * rs) * g * (sc + 1.0f) + sh;
                *(u32x2*)(H + (size_t)row * DM + c) = (u32x2){pk2(hv.x, hv.y), pk2(hv.z, hv.w)}; }
        }
    }
}

template <int N> struct IC { static constexpr int value = N; };
DI const float* in_ptr(const unsigned char* ws, int k) { const unsigned long long v = ((const unsigned long long*)(ws + 128 * 1024))[k];
    const unsigned lo = __builtin_amdgcn_readfirstlane((unsigned)v), hi = __builtin_amdgcn_readfirstlane((unsigned)(v >> 32));
    return (const float*)(__attribute__((address_space(1))) const float*)(((unsigned long long)hi << 32) | lo); }
template <class T> DI T* launder_ptr(T* p) { unsigned long long v = (unsigned long long)p; unsigned lo = (unsigned)v, hi = (unsigned)(v >> 32); asm volatile("" : "+v"(lo), "+v"(hi));
    lo = __builtin_amdgcn_readfirstlane(lo); hi = __builtin_amdgcn_readfirstlane(hi); return (T*)(__attribute__((address_space(1))) T*)(((unsigned long long)hi << 32) | lo); }
constexpr int N_PHASES = 1 + 23 + 22;
constexpr size_t WS_PTRS = 128 * 1024;
#define P_XC    ((float*)(ws + WS_XC))
#define P_MOD   ((const float*)(ws + WS_MOD))
#define P_HB    ((bf16*)(ws + WS_HB))
#define P_OCAT  ((bf16*)(ws + WS_OCAT))
#define P_AR    (ws + WS_ARENA)
#define P_ROWS  ((int*)(ws + WS_ROWS))
#define P_GATE  ((float*)(ws + WS_GATE))
#define P_SLOT  ((int*)(ws + WS_SLOT))
#define P_AFFT  ((float*)(ws + WS_AFFT))
#define P_AFFC  ((float*)(ws + WS_AFFC))
#define P_W13   ((bf16*)(ws + WS_W13))
#define P_W2    ((bf16*)(ws + WS_W2))
#define P_U     ((bf16*)(P_AR + A_U))
#define P_QPRE  ((float*)(P_AR + A_QPRE))
#define P_KVPRE ((float*)(P_AR + A_KVPRE))
#define P_QB    ((bf16*)(P_AR + A_QB))
#define P_KB    ((bf16*)(P_AR + A_KB))
#define P_VT    ((bf16*)(P_AR + A_VT))
#define P_W     ((unsigned short*)(P_AR + A_W))
#define P_KEFF  ((bf16*)(P_AR + A_KEFF))
#define P_R     ((bf16*)(P_AR + A_R))
#define P_V     ((bf16*)(P_AR + A_V))
#define P_KK    ((bf16*)(P_AR + A_KK))
#define P_G     ((bf16*)(P_AR + A_G))
#define P_K     ((bf16*)(P_AR + A_K))
#define P_L     ((bf16*)(P_AR + A_L))
#define P_QN    ((bf16*)(P_AR + A_QN))
#define P_KN    ((bf16*)(P_AR + A_KN))
#define P_VTN   ((bf16*)(P_AR + A_VTN))
#define P_YS    ((bf16*)(P_AR + A_YS))
#define P_IMG   ((bf16*)(P_AR + A_IMG))
#define P_HID   ((bf16*)(P_AR + A_HID))
#define P_Y2    ((bf16*)(P_AR + A_Y2))
#define MODL(i) (P_MOD + (size_t)(i) * 9 * 6144)
#if MOE_F8
#define MOE1_PHASE(NMT) do { pg8::Gemm g{P_HB, P_W13, DM / 2, DM / 2, P_ROWS, SCALE_W, SCALE_ONE}; pg8::OrderMoE S{(NMT), 8, 17, C.nb, C.vcu}; pg8::EpiAdapt<EpiGlu8> E{EpiGlu8{(unsigned char*)P_HID}}; \
        pg8::gemm_phase<pg8::EpiAdapt<EpiGlu8>, pg8::OrderMoE, true>(C.lds, g, S, E, C.tid); } while (0)
#define MOE2_PHASE(NMT) do { pg8::Gemm g{P_HID, P_W2, DM / 2, DM / 2, nullptr, SCALE_W, SCALE_HID}; pg8::OrderMoE S{(NMT), 4, 17, C.nb, C.vcu}; pg8::EpiAdapt<EpiGate> E{EpiGate{P_Y2, P_GATE}}; \
        pg8::gemm_phase<pg8::EpiAdapt<EpiGate>, pg8::OrderMoE, true>(C.lds, g, S, E, C.tid); } while (0)
#else
#define MOE1_PHASE(NMT) do { pg8::Gemm g{P_HB, P_W13, DM, DM, P_ROWS}; pg8::OrderMoE S{(NMT), 8, 17, C.nb, C.vcu}; pg8::EpiAdapt<EpiGlu> E{EpiGlu{P_HID}}; pg8::gemm_phase(C.lds, g, S, E, C.tid); } while (0)
#define MOE2_PHASE(NMT) do { pg8::Gemm g{P_HID, P_W2, DM, DM, nullptr}; pg8::OrderMoE S{(NMT), 4, 17, C.nb, C.vcu}; pg8::EpiAdapt<EpiGate> E{EpiGate{P_Y2, P_GATE}}; pg8::gemm_phase(C.lds, g, S, E, C.tid); } while (0)
#endif
#define WPREP_TAIL(NUNITS, LAYER) do { __syncthreads(); const int extra_ = (NUNITS) % C.nb, j_ = C.vcu - extra_; const size_t wo_ = (size_t)(LAYER) * NEXP * DM * DM; \
        if (j_ >= 0) wprep_span(C, j_ * 8 + C.wave, (C.nb - extra_) * 8, in_ptr(ws, I_MW1) + wo_, in_ptr(ws, I_MW3) + wo_, in_ptr(ws, I_MW2) + wo_, (bf16*)(ws + WS_W13), (bf16*)(ws + WS_W2)); } while (0)
#define RELAUNDER() do { int l_ = C.lane; asm volatile("" : "+v"(l_)); C.lane = l_; C.tid = (C.wave << 6) | l_; } while (0)
__global__ void __launch_bounds__(512, 2) fwd_kernel(Args a) {
    extern __shared__ __attribute__((aligned(16))) unsigned char smem[];
    Ctx C0; C0.lds = (LAS unsigned char*)smem; C0.tid = threadIdx.x; C0.lane = C0.tid & 63; C0.wave = __builtin_amdgcn_readfirstlane(C0.tid >> 6); C0.bid = blockIdx.x; C0.nb = gridDim.x;
    C0.vcu = (C0.nb % 8 == 0) ? (C0.bid % 8) * (C0.nb / 8) + C0.bid / 8 : C0.bid;
    volatile LAS unsigned* bst = (volatile LAS unsigned*)(C0.lds + LDS_BYTES - 16);
#if MEGA
    if (C0.tid == 0) { bst[0] = 0u; bst[1] = 0u; }
    __syncthreads();
    const unsigned bar_x = xcd_barrier_post((unsigned*)(a.ws + WS_CTL) + 4096, bst, C0.tid == 0).x;
#define SEAM() do { if (ph < hi) { XcdBarrier b2_; b2_.bar = (unsigned*)(ws + WS_CTL) + 4096; b2_.x = bar_x; b2_.st = bst; xcd_barrier(b2_, C.tid == 0); } } while (0)
#else
#define SEAM() do { } while (0)
#endif
#if MEGA
    constexpr int lo = 0, hi = N_PHASES;
#else
    const int lo = a.ph_lo, hi = a.ph_hi;
#endif
    int ph = 0;
#ifndef ONLY
#define ONLY -1
#endif
#ifndef REPMASK
#define REPMASK 0
#endif
#ifndef SITE_LO
#define SITE_LO 0
#define SITE_HI 99
#endif
#define PHASE(SITE, ...) do { if ((ONLY < 0 || ONLY == (SITE)) && (SITE) >= SITE_LO && (SITE) <= SITE_HI && ph >= lo && ph < hi) { Ctx C; C.lds = C0.lds; \
        { int w_ = C0.wave; asm volatile("" : "+s"(w_)); unsigned m_ = ~0u; asm volatile("" : "+s"(m_)); int l_ = (int)__builtin_amdgcn_mbcnt_hi(m_, __builtin_amdgcn_mbcnt_lo(m_, 0u)); C.wave = w_; C.lane = l_; C.tid = (w_ << 6) | l_; } \
        { int b_ = C0.bid, n_ = C0.nb, v_ = C0.vcu; asm volatile("" : "+s"(b_), "+s"(n_), "+s"(v_)); C.bid = b_; C.nb = n_; C.vcu = v_; } \
        unsigned z_ = 0u; asm volatile("" : "+s"(z_)); unsigned char* ws = a.ws + z_; float* XL = a.out + z_; const int lq = __builtin_amdgcn_readfirstlane(lp); typedef const __attribute__((address_space(1))) float* gfp_t; const gfp_t* INT_ = (const gfp_t*)(ws + WS_PTRS); (void)INT_; (void)XL; (void)lq; \
        for (int rep_ = 0; rep_ < ((((REPMASK) >> (SITE)) & 1) ? 2 : 1); ++rep_) { __VA_ARGS__; if ((((REPMASK) >> (SITE)) & 1)) __syncthreads(); } ++ph; SEAM(); } else ++ph; } while (0)

    { const int lp = 0;
      PHASE(0, { if (C.bid == 0) { _Pragma("unroll") for (int k = 0; k < 40; ++k) if (C.tid == k) ((const float**)(ws + WS_PTRS))[k] = a.in[k]; }
                 ph_prologue(C, a); }); }

    auto layer_pair = [&](auto lpc) __attribute__((always_inline)) {
        constexpr int lp = decltype(lpc)::value;
        if constexpr (lp == 0) PHASE(1, { const int i = 2 * lq; const float* xl = (i == 0) ? in_ptr(ws, I_X) : XL; const float* xc = (i == 0) ? in_ptr(ws, I_CTX) : P_XC;
                   ph_norm<false>(C, xl, xc, in_ptr(ws, I_N1G) + i * DM, MODL(i), 0, 1024, P_HB, nullptr, nullptr, nullptr, nullptr); });
        PHASE(2, { EpiBf16 E{P_U, EV_INP}; fast_gemm(C, P_HB, DM, (const bf16*)(ws + WS_WEVIN) + (size_t)lq * EV_INP * DM, DM, MT / 256, EV_INP / 256, E); });
        PHASE(3, { EpiBf16 Eq{(bf16*)P_QPRE, 768}; fast_gemm(C, P_U, EV_INP, (const bf16*)(ws + WS_WUQ) + (size_t)lq * 768 * 384, 384, MT / 256, 3, Eq); RELAUNDER();
                   EpiBf16 Ek{(bf16*)P_KVPRE, 1024}; fast_gemm(C, P_U + 384, EV_INP, (const bf16*)(ws + WS_WUKV) + (size_t)lq * 1024 * 256, 256, MT / 256, 4, Ek, true); });
        PHASE(4, { ph_mla_fin(C, P_U, (const bf16*)P_QPRE, (const bf16*)P_KVPRE, in_ptr(ws, I_QG) + lq * 96, in_ptr(ws, I_KG) + lq * 96, (const f32x2*)(ws + WS_ROPE), P_QB, P_KB, P_VT);
                   const int extra_ = (MT / 64) % C.nb, j_ = C.vcu - extra_;
                   if (j_ >= 0) { for (int q_ = 0; q_ < CONV_PER_TAIL; ++q_) { const int cu_ = j_ + q_ * (C.nb - extra_); if (cu_ >= conv_in_fin(C.nb)) break;
                       float wk[31]; const float* dww = in_ptr(ws, I_DWW) + (size_t)lq * 31 * 512;
                       _Pragma("unroll") for (int kt = 0; kt < 31; ++kt) wk[kt] = dww[kt * 512 + C.tid];
                       conv_unit(C, cu_, P_U, wk, in_ptr(ws, I_DWB)[lq * 512 + C.tid], in_ptr(ws, I_LNG) + lq * 512, in_ptr(ws, I_LNB) + lq * 512, P_OCAT); } } });
        PHASE(5, ph_attn_mla2(C, P_QB, P_KB, P_VT, P_OCAT, false, ws, lq));
        PHASE(6, { const int i = 2 * lq; const float* xl = (i == 0) ? in_ptr(ws, I_X) : XL; const float* xc = (i == 0) ? in_ptr(ws, I_CTX) : P_XC;
                   { EpiResid E{xl, xc, XL, P_XC, MODL(i) + 2048}; fast_gemm(C, P_OCAT, DM, (const bf16*)(ws + WS_WEVOUT) + (size_t)lq * DM * DM, DM, MT / 256, 4, E); }
                   WPREP_TAIL(MT / 256 * 4, i); });
        PHASE(7, { const int i = 2 * lq; ph_norm<true>(C, XL, P_XC, in_ptr(ws, I_N2G) + i * DM, MODL(i), 3072, 4096, P_HB, in_ptr(ws, I_ROUTER) + (size_t)i * DM * 16, P_AFFT, P_AFFC, P_SLOT); });
        PHASE(8, ph_topk2(C, P_AFFT, P_AFFC, P_ROWS, P_GATE, P_SLOT, false));
        PHASE(9, { MOE1_PHASE(17); });
        PHASE(10, { MOE2_PHASE(17); });
        PHASE(11, { const int i = 2 * lq; ph_combine(C, XL, P_XC, MODL(i) + 5120, P_SLOT, P_Y2, false, in_ptr(ws, I_N1G) + (i + 1) * DM, MODL(i + 1), P_HB); });
        PHASE(13, { EpiBf16 E{P_U, OD_INP}; fast_gemm(C, P_HB, DM, (const bf16*)(ws + WS_WODIN) + (size_t)lq * OD_INP * DM, DM, MT / 256, OD_INP / 256, E); });
        PHASE(14, ph_prep(C, P_U, in_ptr(ws, I_SHIFTW) + (size_t)lq * 3 * RW_IN, in_ptr(ws, I_KKW) + lq * 512, in_ptr(ws, I_NAQG) + lq * 64, in_ptr(ws, I_NAKG) + lq * 64, P_R, P_V, P_K, P_KK, P_L, P_QN, P_KN, P_VTN));
        PHASE(15, { const bf16* WL = (const bf16*)(ws + WS_WLORA) + (size_t)lq * 655360;
                    { EpiLoraW E{P_W, in_ptr(ws, I_W0) + lq * 1024}; fast_gemm(C, P_L, 384, WL, 256, MT / 256, 4, E); } RELAUNDER();
                    { EpiLoraA E{P_KEFF, in_ptr(ws, I_A0) + lq * 1024}; fast_gemm(C, P_L, 384, WL + (size_t)1024 * 256, 256, MT / 256, 4, E, true); } RELAUNDER();
                    { EpiBf16 E{P_G, 512}; fast_gemm(C, P_L + 128, 384, WL + (size_t)2048 * 256, 256, MT / 256, 2, E); } });
        PHASE(16, ph_wkv_pre(C, P_R, P_K, P_KK, P_W, P_KEFF, in_ptr(ws, I_KA) + lq * 512, P_IMG));
        PHASE(17, { ph_wkv_chunk(C, P_R, P_V, P_K, P_KK, P_W, P_KEFF, in_ptr(ws, I_KA) + lq * 512, P_IMG, P_YS); __syncthreads();
                    ph_natten2(C, P_QN, P_KN, P_VTN, P_OCAT, in_ptr(ws, I_RPB) + (size_t)lq * 8 * 465, lq == 1, (unsigned*)(ws + WS_CTL) + 8192 + 64 * lq, ws, lq); });
        PHASE(18, ph_post(C, P_YS, P_R, P_V, P_K, P_KEFF, in_ptr(ws, I_KA) + lq * 512, P_G, in_ptr(ws, I_RK) + lq * 512, in_ptr(ws, I_GNG) + lq * 512, in_ptr(ws, I_GNB) + lq * 512, P_OCAT, lq == 1));
        PHASE(19, { const int i = 2 * lq + 1; EpiResid E{XL, P_XC, XL, P_XC, MODL(i) + 2048};
                    fast_gemm(C, P_OCAT, DM, (const bf16*)(ws + WS_WODOUT) + (size_t)lq * DM * DM, DM, (lq == 1) ? NLAT / 256 : MT / 256, 4, E);
                    WPREP_TAIL(((lq == 1) ? NLAT / 256 : MT / 256) * 4, i); });
        PHASE(20, { const int i = 2 * lq + 1; ph_norm<true>(C, XL, P_XC, in_ptr(ws, I_N2G) + i * DM, MODL(i), 3072, 4096, P_HB, in_ptr(ws, I_ROUTER) + (size_t)i * DM * 16, P_AFFT, P_AFFC, P_SLOT); });
        PHASE(21, ph_topk2(C, P_AFFT, P_AFFC, P_ROWS, P_GATE, P_SLOT, lq == 1));
        PHASE(22, { MOE1_PHASE((lq == 1) ? 16 : 17); });
        PHASE(23, { MOE2_PHASE((lq == 1) ? 16 : 17); });
        PHASE(24, { const int i = 2 * lq + 1;
                    if (lp == 0) ph_combine(C, XL, P_XC, MODL(i) + 5120, P_SLOT, P_Y2, false, in_ptr(ws, I_N1G) + (i + 1) * DM, MODL(i + 1), P_HB);
                    else ph_combine(C, XL, P_XC, MODL(i) + 5120, P_SLOT, P_Y2, true, nullptr, nullptr, nullptr); });
    };
    layer_pair(IC<0>{}); layer_pair(IC<1>{});
}

extern "C" void kernel_launch(void* const* d_in, const int* in_sizes, int n_in, void* d_out, int out_size, void* d_ws, size_t ws_size, hipStream_t stream) {
    static int grid = 0;
    if (grid == 0) {
        if (n_in != 40 || out_size != NLAT * DM || ws_size < WS_END) { fprintf(stderr, "kernel_launch: unexpected shapes (n_in %d out %d ws %zu need %zu)\n", n_in, out_size, ws_size, (size_t)WS_END); grid = -1; return; }
        int dev = 0, cus = 0, per_cu = 0;
        if (hipGetDevice(&dev) != hipSuccess || hipDeviceGetAttribute(&cus, hipDeviceAttributeMultiprocessorCount, dev) != hipSuccess) { grid = -1; return; }
        if (hipFuncSetAttribute((const void*)fwd_kernel, hipFuncAttributeMaxDynamicSharedMemorySize, LDS_BYTES) != hipSuccess) { fprintf(stderr, "kernel_launch: hipFuncSetAttribute failed\n"); grid = -1; return; }
        if (hipOccupancyMaxActiveBlocksPerMultiprocessor(&per_cu, (const void*)fwd_kernel, 512, LDS_BYTES) != hipSuccess || per_cu < 1) { fprintf(stderr, "kernel_launch: occupancy query says %d\n", per_cu); per_cu = 1; }
        (void)hipGetLastError();
        grid = cus;
    }
    if (grid < 0) return;
    (void)hipMemsetAsync((char*)d_ws + WS_CTL, 0, CTL_BYTES, stream);
    Args a{};
    for (int i = 0; i < 40; ++i) a.in[i] = (const float*)d_in[i];
    a.out = (float*)d_out; a.ws = (unsigned char*)d_ws;
#if MEGA
    a.ph_lo = 0; a.ph_hi = N_PHASES;
    hipLaunchKernelGGL(fwd_kernel, dim3(grid), dim3(512), LDS_BYTES, stream, a);
#else
    for (int p = 0; p < N_PHASES; ++p) { a.ph_lo = p; a.ph_hi = p + 1; hipLaunchKernelGGL(fwd_kernel, dim3(grid), dim3(512), LDS_BYTES, stream, a); }
#endif
}
```

```cpp
#include <hip/hip_runtime.h>
#include <cstdio>
#include <cstdint>

#ifndef MEGA
#define MEGA 1
#endif

#define LAS __attribute__((address_space(3)))
#define DI __device__ __forceinline__

typedef unsigned short bf16;
typedef short bf16x8 __attribute__((ext_vector_type(8)));
typedef float f32x4 __attribute__((ext_vector_type(4)));
typedef float f32x2 __attribute__((ext_vector_type(2)));
typedef float f32x16 __attribute__((ext_vector_type(16)));
typedef unsigned u32x4 __attribute__((ext_vector_type(4)));
typedef unsigned u32x2 __attribute__((ext_vector_type(2)));
typedef __bf16 bf16x2_t __attribute__((ext_vector_type(2)));

constexpr int DM = 1024, NB = 8, TL = 4096, LCX = 256;
constexpr int NLAT = NB * TL, NCTX = NB * LCX, MT = NLAT + NCTX;
constexpr int KPOS = TL + LCX;
constexpr float EPS = 1e-6f, GN_EPS = 64e-5f;
constexpr int EV_IN = 1696, EV_INP = 1792, OD_IN = 3456, OD_INP = 3584, RW_IN = 1920;
constexpr int NEXP = 16, CAPL = 512, CAPC = 32, ESLOTS = NB * CAPL + NB * CAPC;
constexpr float LOG2E = 1.4426950408889634f;

constexpr size_t MiB = 1ull << 20;
constexpr size_t WS_CTL = 0, CTL_BYTES = 1 * MiB;
constexpr size_t WS_MOD = 1 * MiB, WS_ROPE = 2 * MiB, WS_XC = 4 * MiB;
constexpr size_t WS_ROWS = 12 * MiB, WS_GATE = 12 * MiB + 512 * 1024, WS_SLOT = 13 * MiB, WS_AFFT = 16 * MiB, WS_AFFC = 18 * MiB;
constexpr size_t WS_WEVIN = 20 * MiB, WS_WEVOUT = 27 * MiB, WS_WUQ = 31 * MiB, WS_WUKV = 33 * MiB, WS_WODIN = 34 * MiB, WS_WODOUT = 48 * MiB, WS_WLORA = 52 * MiB;
constexpr size_t WS_W13 = 56 * MiB, WS_W2 = 120 * MiB, WS_HB = 152 * MiB, WS_OCAT = 220 * MiB, WS_ARENA = 288 * MiB;
constexpr size_t A_U = 0, A_QPRE = 119 * MiB, A_KVPRE = 221 * MiB, A_QB = 357 * MiB, A_KB = 408 * MiB, A_VT = 459 * MiB;
constexpr size_t A_W = 0, A_KEFF = 136 * MiB  , A_G = 204 * MiB, A_R = 238 * MiB, A_V = 272 * MiB, A_KK = 306 * MiB, A_K = 340 * MiB, A_L = 374 * MiB,
                 A_QN = 400 * MiB, A_KN = 434 * MiB, A_VTN = 468 * MiB, A_YS = 612 * MiB  ;
constexpr size_t A_HID = 0, A_Y2 = 136 * MiB;
constexpr size_t A_IMG = 510 * MiB;
constexpr size_t WS_END = WS_ARENA + 680 * MiB;
constexpr int LDS_BYTES = 147456;

DI unsigned pk2(float lo, float hi) { f32x2 v = {lo, hi}; bf16x2_t b = __builtin_convertvector(v, bf16x2_t); return __builtin_bit_cast(unsigned, b); }
DI float bflo(unsigned u) { return __builtin_bit_cast(float, u << 16); }
DI float bfhi(unsigned u) { return __builtin_bit_cast(float, u & 0xffff0000u); }
DI float bf2f(bf16 x) { return __builtin_bit_cast(float, ((unsigned)x) << 16); }
DI bf16 f2bf(float f) { return (bf16)(pk2(f, 0.f) & 0xffffu); }
DI void unpack8(u32x4 v, float (&f)[8]) { f[0] = bflo(v.x); f[1] = bfhi(v.x); f[2] = bflo(v.y); f[3] = bfhi(v.y); f[4] = bflo(v.z); f[5] = bfhi(v.z); f[6] = bflo(v.w); f[7] = bfhi(v.w); }
DI u32x4 pack8(const float (&f)[8]) { u32x4 r; r.x = pk2(f[0], f[1]); r.y = pk2(f[2], f[3]); r.z = pk2(f[4], f[5]); r.w = pk2(f[6], f[7]); return r; }
#define DPP_ADD(x, ctrl) ((x) + __builtin_bit_cast(float, __builtin_amdgcn_update_dpp(0, __builtin_bit_cast(int, (x)), (ctrl), 0xf, 0xf, false)))
#define DPP_MAX(x, ctrl) fmaxf((x), __builtin_bit_cast(float, __builtin_amdgcn_update_dpp(0, __builtin_bit_cast(int, (x)), (ctrl), 0xf, 0xf, false)))
DI float sum8(float x) { x = DPP_ADD(x, 0xB1); x = DPP_ADD(x, 0x4E); x = DPP_ADD(x, 0x141); return x; }
DI float sum16(float x) { x = DPP_ADD(x, 0xB1); x = DPP_ADD(x, 0x4E); x = DPP_ADD(x, 0x141); x = DPP_ADD(x, 0x140); return x; }
DI float max16(float x) { x = DPP_MAX(x, 0xB1); x = DPP_MAX(x, 0x4E); x = DPP_MAX(x, 0x141); x = DPP_MAX(x, 0x140); return x; }
DI float rdlane(float x, int l) { return __builtin_bit_cast(float, __builtin_amdgcn_readlane(__builtin_bit_cast(int, x), l)); }
DI float wave_sum(float v) { const float x = sum16(v); return (rdlane(x, 0) + rdlane(x, 16)) + (rdlane(x, 32) + rdlane(x, 48)); }
DI float xor32(float v, int lane) { return __builtin_bit_cast(float, __builtin_amdgcn_ds_bpermute((lane ^ 32) << 2, __builtin_bit_cast(int, v))); }
typedef int v8i_t __attribute__((ext_vector_type(8)));
typedef int i32x4_t __attribute__((ext_vector_type(4)));
DI unsigned pk4_fp8(float a, float b, float c, float d) {
    a = __builtin_amdgcn_fmed3f(a, -448.f, 448.f); b = __builtin_amdgcn_fmed3f(b, -448.f, 448.f); c = __builtin_amdgcn_fmed3f(c, -448.f, 448.f); d = __builtin_amdgcn_fmed3f(d, -448.f, 448.f);
    int p = __builtin_amdgcn_cvt_pk_fp8_f32(a, b, 0, false); p = __builtin_amdgcn_cvt_pk_fp8_f32(c, d, p, true); return (unsigned)p; }
#ifndef MOE_F8
#define MOE_F8 1
#endif
constexpr int SCALE_ONE = 0x7f7f7f7f, SCALE_W = 0x79797979  , SCALE_HID = 0x7c7c7c7c  ;
DI float sigmoidf_(float x) { return __builtin_amdgcn_rcpf(1.f + __expf(-x)); }
DI float siluf_(float x) { return x * __builtin_amdgcn_rcpf(1.f + __expf(-x)); }
#define MFMA32(a, b, c) __builtin_amdgcn_mfma_f32_32x32x16_bf16((a), (b), (c), 0, 0, 0)

#define XB_TMO      128
#define XB_XCNT(j)  (256  + 64 * (j))
#define XB_XSUB(j)  (1280 + 64 * (j))
#define XB_XGEN(j)  (2304 + 64 * (j))
#define XB_TOP      3328
#define XB_TOPGEN   3392
#define XCD_BAR_WORDS 3456
#define XB_SPIN_CAP (1u << 22)
__device__ __forceinline__ unsigned xb_ld(unsigned* p)              { return __hip_atomic_load(p, __ATOMIC_RELAXED, __HIP_MEMORY_SCOPE_AGENT); }
__device__ __forceinline__ unsigned xb_add(unsigned* p, unsigned v) { return __hip_atomic_fetch_add(p, v, __ATOMIC_RELAXED, __HIP_MEMORY_SCOPE_AGENT); }
__device__ __forceinline__ unsigned xb_xcc_id() { return (unsigned)__builtin_amdgcn_s_getreg((3 << 11) | 20) & 0xFu; }
#define XB_SPIN(cond, bar) do { unsigned _sp = 0; while (cond) { __builtin_amdgcn_s_sleep(1); \
    if ((++_sp & 255u) == 0u) { if (xb_ld(&(bar)[XB_TMO])) break; if (_sp > XB_SPIN_CAP) { atomicAdd(&(bar)[XB_TMO], 1u); break; } } } } while (0)
struct XcdBarrier { unsigned* bar; unsigned x; volatile LAS unsigned* st; };
__device__ __forceinline__ XcdBarrier xcd_barrier_post(unsigned* bar, volatile LAS unsigned* st, bool leader) {
    XcdBarrier b; b.bar = bar; b.x = xb_xcc_id(); b.st = st;
    if (leader) (void)xb_add(&bar[XB_XCNT(b.x)], 1u);
    return b;
}
__device__ __forceinline__ void xcd_barrier_complete(unsigned* bar, unsigned x, unsigned& nloc, unsigned& nx) {
    const unsigned G = gridDim.x * gridDim.y * gridDim.z;
    unsigned sum, cnt, mine, sp = 0u;
    for (;;) {
        sum = 0u; cnt = 0u; mine = 0u;
#pragma unroll
        for (unsigned j = 0; j < 16; ++j) { const unsigned c = xb_ld(&bar[XB_XCNT(j)]); sum += c; cnt += (c > 0u) ? 1u : 0u; mine = (j == x) ? c : mine; }
        if (sum == G) break;
        __builtin_amdgcn_s_sleep(1);
        if ((++sp & 255u) == 0u) { if (xb_ld(&bar[XB_TMO])) break; if (sp > XB_SPIN_CAP) { atomicAdd(&bar[XB_TMO], 1u); break; } }
    }
    nloc = mine > 0u ? mine : 1u; nx = cnt > 0u ? cnt : 1u;
}
__device__ __forceinline__ void xcd_barrier(const XcdBarrier& b, bool leader) {
    asm volatile("s_waitcnt vmcnt(0)" ::: "memory");
    __syncthreads();
    if (leader) {
        unsigned* bar = b.bar;
        __builtin_amdgcn_s_waitcnt(0);
        unsigned nloc = b.st[0], nx = b.st[1];
        if (nloc == 0u) { xcd_barrier_complete(bar, b.x, nloc, nx); b.st[0] = nloc; b.st[1] = nx; }
        const unsigned old = xb_add(&bar[XB_XSUB(b.x)], 1u);
        const unsigned gen = old / nloc;
        if (old + 1u == (gen + 1u) * nloc) {
            __builtin_amdgcn_fence(__ATOMIC_RELEASE, "agent");
            asm volatile("s_waitcnt vmcnt(0)" ::: "memory");
            const unsigned og = xb_add(&bar[XB_TOP], 1u);
            const unsigned tg = og / nx;
            if (og + 1u == (tg + 1u) * nx) xb_add(&bar[XB_TOPGEN], 1u);
            else XB_SPIN(xb_ld(&bar[XB_TOPGEN]) == tg, bar);
            __builtin_amdgcn_fence(__ATOMIC_ACQUIRE, "agent");
            xb_add(&bar[XB_XGEN(b.x)], 1u);
            asm volatile("s_waitcnt vmcnt(0)" ::: "memory");
        } else {
            XB_SPIN(xb_ld(&bar[XB_XGEN(b.x)]) == gen, bar);
            __builtin_amdgcn_fence(__ATOMIC_ACQUIRE, "agent");
            asm volatile("s_waitcnt vmcnt(0)" ::: "memory");
        }
    }
    __syncthreads();
}

struct Ctx { LAS unsigned char* lds; int tid, lane, wave, bid, nb, vcu; };
struct Args { const float* in[40]; float* out; unsigned char* ws; int ph_lo, ph_hi; };
enum { I_X = 0, I_C, I_CTX, I_CCTX, I_ADAW, I_ADAB, I_N1G, I_N2G, I_EVWIN, I_EVWOUT, I_QNORM, I_WUQ, I_KVNORM, I_WUKV, I_QG, I_KG, I_DWW, I_DWB, I_LNG, I_LNB,
       I_ODWIN, I_ODWOUT, I_SHIFTW, I_W0, I_W2L, I_A0, I_A2, I_G2, I_KKW, I_KA, I_RK, I_GNG, I_GNB, I_NAQG, I_NAKG, I_RPB, I_ROUTER, I_MW1, I_MW3, I_MW2 };

DI void transpose_item(const float* __restrict__ W, int K, int N, bf16* __restrict__ WT, int dst_row0, const float* __restrict__ gain, LAS float* scr, int k0, int n0, int lane) {
#pragma unroll 8
    for (int i = 0; i < 32; ++i) { const int kk = 2 * i + (lane >> 5); float v = W[(size_t)(k0 + kk) * N + n0 + (lane & 31)]; if (gain) v *= gain[k0 + kk]; scr[kk * 33 + (lane & 31)] = v; }
    asm volatile("s_waitcnt lgkmcnt(0)" ::: "memory");
    const int c = lane & 7;
#pragma unroll
    for (int j = 0; j < 4; ++j) { const int n = (lane >> 3) + 8 * j; const LAS float* s = scr + (8 * c) * 33 + n;
        u32x4 o; o.x = pk2(s[0 * 33], s[1 * 33]); o.y = pk2(s[2 * 33], s[3 * 33]); o.z = pk2(s[4 * 33], s[5 * 33]); o.w = pk2(s[6 * 33], s[7 * 33]);
        *(u32x4*)(WT + (size_t)(dst_row0 + n) * K + k0 + 8 * c) = o; }
    asm volatile("s_waitcnt lgkmcnt(0)" ::: "memory");
}
DI void transpose_item64(const float* __restrict__ W, int K, int N, bf16* __restrict__ WT, int dst_row0, LAS float* scr, int k0, int n0, int lane) {
    f32x4 v[16];
#pragma unroll
    for (int i = 0; i < 16; ++i) v[i] = *(const f32x4*)(W + (size_t)(k0 + 4 * i + (lane >> 4)) * N + n0 + 4 * (lane & 15));
#pragma unroll
    for (int i = 0; i < 16; ++i) { LAS float* d = scr + (4 * i + (lane >> 4)) * 65 + 4 * (lane & 15); d[0] = v[i].x; d[1] = v[i].y; d[2] = v[i].z; d[3] = v[i].w; }
    asm volatile("s_waitcnt lgkmcnt(0)" ::: "memory");
    const int c = lane & 7;
#pragma unroll
    for (int j = 0; j < 8; ++j) { const int n = (lane >> 3) + 8 * j; const LAS float* s = scr + (8 * c) * 65 + n;
        u32x4 o; o.x = pk2(s[0 * 65], s[1 * 65]); o.y = pk2(s[2 * 65], s[3 * 65]); o.z = pk2(s[4 * 65], s[5 * 65]); o.w = pk2(s[6 * 65], s[7 * 65]);
        *(u32x4*)(WT + (size_t)(dst_row0 + n) * K + k0 + 8 * c) = o; }
    asm volatile("s_waitcnt lgkmcnt(0)" ::: "memory");
}
DI void transpose_item64_f8(const float* __restrict__ W, int K, int N, unsigned char* __restrict__ WT8, int dst_row0, LAS float* scr, int k0, int n0, int lane) {
    f32x4 v[16];
#pragma unroll
    for (int i = 0; i < 16; ++i) v[i] = *(const f32x4*)(W + (size_t)(k0 + 4 * i + (lane >> 4)) * N + n0 + 4 * (lane & 15));
#pragma unroll
    for (int i = 0; i < 16; ++i) { LAS float* d = scr + (4 * i + (lane >> 4)) * 65 + 4 * (lane & 15); d[0] = v[i].x; d[1] = v[i].y; d[2] = v[i].z; d[3] = v[i].w; }
    asm volatile("s_waitcnt lgkmcnt(0)" ::: "memory");
    const int c = lane & 7;
#pragma unroll
    for (int j = 0; j < 8; ++j) { const int n = (lane >> 3) + 8 * j; const LAS float* s = scr + (8 * c) * 65 + n;
        u32x2 o; o.x = pk4_fp8(64.f * s[0 * 65], 64.f * s[1 * 65], 64.f * s[2 * 65], 64.f * s[3 * 65]); o.y = pk4_fp8(64.f * s[4 * 65], 64.f * s[5 * 65], 64.f * s[6 * 65], 64.f * s[7 * 65]);
        *(u32x2*)(WT8 + (size_t)(dst_row0 + n) * K + k0 + 8 * c) = o; }
    asm volatile("s_waitcnt lgkmcnt(0)" ::: "memory");
}
DI void transpose_matrix(const Ctx& C, const float* W, int K, int N, bf16* WT, const float* gain, int mode  ) {
    LAS float* scr = (LAS float*)(C.lds + C.wave * 8704);
    const int nkb = K / 64, nnb = N / 32, nit = nkb * nnb, gw = C.vcu * 8 + C.wave, ngw = C.nb * 8;
    for (int it = gw; it < nit; it += ngw) {
        const int kb = it / nnb, nbk = it % nnb, n0 = nbk * 32;
        int d0 = n0; if (mode) d0 = (n0 >> 7) * 256 + (n0 & 127) + (mode == 2 ? 128 : 0);
        transpose_item(W, K, N, WT, d0, gain, scr, kb * 64, n0, C.lane);
    }
}

DI void ph_prologue(const Ctx& C, const Args& a) {
    unsigned char* ws = a.ws;
    {
        LAS float* sv = (LAS float*)C.lds;
        LAS float* red = sv + 9 * 1024;
        for (int i = C.tid; i < 9 * 1024; i += 512) { const int m = i >> 10, k = i & 1023; const float c = (m < 8) ? a.in[I_C][m * 1024 + k] : a.in[I_CCTX][k]; sv[i] = siluf_(c); }
        __syncthreads();
        float* MOD = (float*)(ws + WS_MOD);
        for (int it = C.bid; it < 4 * 96; it += C.nb) {
            const int layer = it / 96, col = (it % 96) * 64 + C.lane;
            const float* wp = a.in[I_ADAW] + (size_t)layer * 1024 * 6144 + col;
            float acc[9];
#pragma unroll
            for (int m = 0; m < 9; ++m) acc[m] = 0.f;
            const int kb = C.wave * 128;
#pragma unroll 16
            for (int k = 0; k < 128; ++k) { const float w = wp[(size_t)(kb + k) * 6144];
#pragma unroll
                for (int m = 0; m < 9; ++m) acc[m] += sv[m * 1024 + kb + k] * w; }
#pragma unroll
            for (int m = 0; m < 9; ++m) red[(C.wave * 9 + m) * 64 + C.lane] = acc[m];
            __syncthreads();
            for (int i = C.tid; i < 576; i += 512) { const int m = i >> 6, l = i & 63; float s = 0.f;
#pragma unroll
                for (int w = 0; w < 8; ++w) s += red[(w * 9 + m) * 64 + l];
                const int cc = (it % 96) * 64 + l;
                MOD[(size_t)(layer * 9 + m) * 6144 + cc] = s + a.in[I_ADAB][layer * 6144 + cc]; }
            __syncthreads();
        }
    }
    {
        f32x2* CS = (f32x2*)(ws + WS_ROPE);
        for (int i = C.bid * 512 + C.tid; i < 4096 * 16; i += C.nb * 512) {
            const int pos = i >> 4, j = i & 15, f = j & 7;
            const float inv = powf(10000.f, -(float)(2 * f) / 16.f);
            const float ang = (float)((j < 8) ? (pos >> 6) : (pos & 63)) * inv;
            const double tw = 6.283185307179586476925;
            const double x = (double)ang, n = __builtin_rint(x / tw), rr = x - n * tw;
            CS[i] = (f32x2){__cosf((float)rr), __sinf((float)rr)};
        }
    }
    for (int j = 0; j < 2; ++j) {
        transpose_matrix(C, a.in[I_EVWIN] + (size_t)j * DM * EV_IN, DM, EV_IN, (bf16*)(ws + WS_WEVIN) + (size_t)j * EV_INP * DM, nullptr, 0);
        transpose_matrix(C, a.in[I_EVWOUT] + (size_t)j * DM * DM, DM, DM, (bf16*)(ws + WS_WEVOUT) + (size_t)j * DM * DM, nullptr, 0);
        transpose_matrix(C, a.in[I_WUQ] + (size_t)j * 384 * 768, 384, 768, (bf16*)(ws + WS_WUQ) + (size_t)j * 768 * 384, a.in[I_QNORM] + j * 384, 0);
        transpose_matrix(C, a.in[I_WUKV] + (size_t)j * 256 * 1024, 256, 1024, (bf16*)(ws + WS_WUKV) + (size_t)j * 1024 * 256, a.in[I_KVNORM] + j * 256, 0);
        transpose_matrix(C, a.in[I_ODWIN] + (size_t)j * DM * OD_IN, DM, OD_IN, (bf16*)(ws + WS_WODIN) + (size_t)j * OD_INP * DM, nullptr, 0);
        transpose_matrix(C, a.in[I_ODWOUT] + (size_t)j * DM * DM, DM, DM, (bf16*)(ws + WS_WODOUT) + (size_t)j * DM * DM, nullptr, 0);
    }
    {
        const int gt = C.bid * 512 + C.tid, ngt = C.nb * 512;
        for (int j = 0; j < 2; ++j) {
            u32x4* p0 = (u32x4*)((bf16*)(ws + WS_WEVIN) + (size_t)j * EV_INP * DM + (size_t)EV_IN * DM);
            for (int i = gt; i < (EV_INP - EV_IN) * DM / 8; i += ngt) p0[i] = (u32x4){0u, 0u, 0u, 0u};
            u32x4* p1 = (u32x4*)((bf16*)(ws + WS_WODIN) + (size_t)j * OD_INP * DM + (size_t)OD_IN * DM);
            for (int i = gt; i < (OD_INP - OD_IN) * DM / 8; i += ngt) p1[i] = (u32x4){0u, 0u, 0u, 0u};
            bf16* WL = (bf16*)(ws + WS_WLORA) + (size_t)j * 655360;
            const float* w2 = a.in[I_W2L] + (size_t)j * 2 * 64 * 512; const float* a2 = a.in[I_A2] + (size_t)j * 2 * 64 * 512; const float* g2 = a.in[I_G2] + (size_t)j * 128 * 512;
            for (int i = gt; i < 655360; i += ngt) {
                const int n = i >> 8, k = i & 255; float v = 0.f;
                if (n < 1024) { const int d = n >> 9, c = n & 511; if (k >= d * 64 && k < d * 64 + 64) v = w2[(size_t)k * 512 + c]; }
                else if (n < 2048) { const int d = (n - 1024) >> 9, c = n & 511; if (k >= 128 + d * 64 && k < 192 + d * 64) v = a2[(size_t)(k - 128) * 512 + c]; }
                else { const int c = n - 2048; if (k >= 128) v = g2[(size_t)(k - 128) * 512 + c]; }
                WL[i] = f2bf(v);
            }
        }
    }
}

template <bool ROUTER> DI void norm_row(const Ctx& C, int row, const float* xlat, const float* xctx, const float* gain, const float* mod, int shift_off, int scale_off, bf16* H, float* AFFT, float* AFFC, int* SLOT);
template <bool ROUTER, int NR> DI void norm_rowsN(const Ctx& C, int row, const float* xlat, const float* gain, const float* mod, int shift_off, int scale_off, bf16* H, float* AFFT, int* SLOT);
template <bool ROUTER>
DI void ph_norm(const Ctx& C, const float* xlat, const float* xctx, const float* gain, const float* mod  , int shift_off, int scale_off, bf16* H,
                const float* router  , float* AFFT, float* AFFC, int* SLOT) {
    LAS float* RT = (LAS float*)C.lds;
    if (ROUTER) { for (int i = C.tid; i < 16384; i += 512) { const int c = i >> 4, e = i & 15; RT[e * 1024 + c] = router[i]; } __syncthreads(); }
    const int gw = C.bid * 8 + C.wave, ngw = C.nb * 8;
    for (int p = gw; p < NLAT / 4; p += ngw) norm_rowsN<ROUTER, 4>(C, 4 * p, xlat, gain, mod, shift_off, scale_off, H, AFFT, SLOT);
    for (int row = NLAT + gw; row < MT; row += ngw) norm_row<ROUTER>(C, row, xlat, xctx, gain, mod, shift_off, scale_off, H, AFFT, AFFC, SLOT);
}
template <bool ROUTER, int NR>
DI void norm_rowsN(const Ctx& C, int row, const float* xlat, const float* gain, const float* mod, int shift_off, int scale_off, bf16* H, float* AFFT, int* SLOT) {
    const LAS float* RT = (const LAS float*)C.lds; const int lane = C.lane;
    const float* xr = xlat + (size_t)row * DM;
    const float* mp = mod + (row >> 12) * 6144;
    f32x4 v[NR][4]; float rs[NR];
#pragma unroll
    for (int q = 0; q < NR; ++q) { float ss = 0.f;
#pragma unroll
        for (int j = 0; j < 4; ++j) { v[q][j] = *(const f32x4*)(xr + q * DM + 256 * j + 4 * lane); ss += v[q][j].x * v[q][j].x + v[q][j].y * v[q][j].y + v[q][j].z * v[q][j].z + v[q][j].w * v[q][j].w; }
        rs[q] = 1.0f / sqrtf(wave_sum(ss) * (1.f / 1024.f) + EPS); }
#pragma unroll
    for (int j = 0; j < 4; ++j) {
        const int c = 256 * j + 4 * lane;
        const f32x4 g = *(const f32x4*)(gain + c), sc = *(const f32x4*)(mp + scale_off + c), sh = *(const f32x4*)(mp + shift_off + c);
#pragma unroll
        for (int q = 0; q < NR; ++q) {
            v[q][j] = (v[q][j] * rs[q]) * g * (sc + 1.0f) + sh;
            if (ROUTER && MOE_F8) *(unsigned*)((unsigned char*)H + (size_t)(row + q) * DM + c) = pk4_fp8(v[q][j].x, v[q][j].y, v[q][j].z, v[q][j].w);
            else *(u32x2*)(H + (size_t)(row + q) * DM + c) = (u32x2){pk2(v[q][j].x, v[q][j].y), pk2(v[q][j].z, v[q][j].w)};
        }
    }
    if (ROUTER) {
        float lg[NR];
#pragma unroll
        for (int q = 0; q < NR; ++q) lg[q] = 0.f;
#pragma unroll 1
        for (int e = 0; e < 16; ++e) { float p[NR];
#pragma unroll
            for (int q = 0; q < NR; ++q) p[q] = 0.f;
#pragma unroll
            for (int j = 0; j < 4; ++j) { const f32x4 w = *(const LAS f32x4*)(RT + e * 1024 + 256 * j + 4 * lane);
#pragma unroll
                for (int q = 0; q < NR; ++q) p[q] += v[q][j].x * w.x + v[q][j].y * w.y + v[q][j].z * w.z + v[q][j].w * w.w; }
#pragma unroll
            for (int q = 0; q < NR; ++q) { const float t = wave_sum(p[q]); lg[q] = (lane == e) ? t : lg[q]; } }
#pragma unroll
        for (int q = 0; q < NR; ++q) { const float ex = expf(lg[q] - max16(lg[q])); const float af = ex / sum16(ex);
            if (lane < 16) { AFFT[(size_t)((row >> 12) * 16 + lane) * TL + ((row + q) & 4095)] = af; SLOT[(size_t)(row + q) * 16 + lane] = -1; } }
    }
}
template <bool ROUTER>
DI void norm_row(const Ctx& C, int row, const float* xlat, const float* xctx, const float* gain, const float* mod, int shift_off, int scale_off, bf16* H, float* AFFT, float* AFFC, int* SLOT) {
    const LAS float* RT = (const LAS float*)C.lds; const int lane = C.lane;
    {
        const float* xr = row < NLAT ? xlat + (size_t)row * DM : xctx + (size_t)(row - NLAT) * DM;
        const int mi = row < NLAT ? (row >> 12) : 8;
        const float* mp = mod + mi * 6144;
        f32x4 v[4]; float ss = 0.f;
#pragma unroll
        for (int j = 0; j < 4; ++j) { v[j] = *(const f32x4*)(xr + 256 * j + 4 * lane); ss += v[j].x * v[j].x + v[j].y * v[j].y + v[j].z * v[j].z + v[j].w * v[j].w; }
        ss = wave_sum(ss);
        const float rs = 1.0f / sqrtf(ss * (1.f / 1024.f) + EPS);
#pragma unroll
        for (int j = 0; j < 4; ++j) {
            const int c = 256 * j + 4 * lane;
            const f32x4 g = *(const f32x4*)(gain + c), sc = *(const f32x4*)(mp + scale_off + c), sh = *(const f32x4*)(mp + shift_off + c);
            v[j] = (v[j] * rs) * g * (sc + 1.0f) + sh;
            if (ROUTER && MOE_F8) *(unsigned*)((unsigned char*)H + (size_t)row * DM + c) = pk4_fp8(v[j].x, v[j].y, v[j].z, v[j].w);
            else *(u32x2*)(H + (size_t)row * DM + c) = (u32x2){pk2(v[j].x, v[j].y), pk2(v[j].z, v[j].w)};
        }
        if (ROUTER) {
            float mylg = 0.f;
#pragma unroll 1
            for (int e = 0; e < 16; ++e) { float p = 0.f;
#pragma unroll
                for (int j = 0; j < 4; ++j) { const f32x4 w = *(const LAS f32x4*)(RT + e * 1024 + 256 * j + 4 * lane); p += v[j].x * w.x + v[j].y * w.y + v[j].z * w.z + v[j].w * w.w; }
                p = wave_sum(p); mylg = (lane == e) ? p : mylg; }
            const float mx = max16(mylg);
            const float ex = expf(mylg - mx);
            const float mine = ex / sum16(ex);
            if (lane < 16) {
                if (row < NLAT) AFFT[(size_t)((row >> 12) * 16 + lane) * TL + (row & 4095)] = mine;
                else { const int rc = row - NLAT; AFFC[(size_t)((rc >> 8) * 16 + lane) * LCX + (rc & 255)] = mine; }
                SLOT[(size_t)row * 16 + lane] = -1;
            }
        }
    }
}


struct EpiBf16 { static constexpr bool WIDE = true; bf16* O; int ldo;
    DI void operator()(int row, int col, f32x4 v0, f32x4 v1) const { bf16* p = O + (size_t)row * ldo + col;
        *(u32x2*)p = (u32x2){pk2(v0[0], v0[1]), pk2(v0[2], v0[3])}; *(u32x2*)(p + 128) = (u32x2){pk2(v1[0], v1[1]), pk2(v1[2], v1[3])}; }
    DI void wide(int row, int col, f32x4 a0, f32x4 a1, f32x4 b0, f32x4 b1) const { bf16* p = O + (size_t)row * ldo + col;
        *(u32x4*)p = (u32x4){pk2(a0[0], a0[1]), pk2(a0[2], a0[3]), pk2(a1[0], a1[1]), pk2(a1[2], a1[3])}; *(u32x4*)(p + 128) = (u32x4){pk2(b0[0], b0[1]), pk2(b0[2], b0[3]), pk2(b1[0], b1[1]), pk2(b1[2], b1[3])}; } };
struct EpiF32 { static constexpr bool WIDE = false; float* O; int ldo;
    DI void operator()(int row, int col, f32x4 v0, f32x4 v1) const { float* p = O + (size_t)row * ldo + col; *(f32x4*)p = v0; *(f32x4*)(p + 128) = v1; } };
struct EpiResid { static constexpr bool WIDE = false; const float* xin_lat; const float* xin_ctx; float* xout_lat; float* xout_ctx; const float* modg;
    DI void operator()(int row, int col, f32x4 v0, f32x4 v1) const {
        const float* xi; float* xo; int mi;
        if (row < NLAT) { xi = xin_lat + (size_t)row * DM; xo = xout_lat + (size_t)row * DM; mi = row >> 12; }
        else { xi = xin_ctx + (size_t)(row - NLAT) * DM; xo = xout_ctx + (size_t)(row - NLAT) * DM; mi = 8; }
        const float* g = modg + mi * 6144 + col;
        const f32x4 g0 = *(const f32x4*)g, g1 = *(const f32x4*)(g + 128), x0 = *(const f32x4*)(xi + col), x1 = *(const f32x4*)(xi + col + 128);
        *(f32x4*)(xo + col) = x0 + g0 * v0; *(f32x4*)(xo + col + 128) = x1 + g1 * v1; } };
struct EpiGlu { static constexpr bool WIDE = false; bf16* O;
    DI void operator()(int row, int col, f32x4 v0, f32x4 v1) const { const int f = ((col & 2047) >> 8) * 128 + (col & 255);
        *(u32x2*)(O + (size_t)row * DM + f) = (u32x2){pk2(siluf_(v0[0]) * v1[0], siluf_(v0[1]) * v1[1]), pk2(siluf_(v0[2]) * v1[2], siluf_(v0[3]) * v1[3])}; } };
struct EpiGlu8 { static constexpr bool WIDE = true; unsigned char* O;
    DI void operator()(int row, int col, f32x4 v0, f32x4 v1) const { const int f = ((col & 2047) >> 8) * 128 + (col & 255);
        *(unsigned*)(O + (size_t)row * DM + f) = pk4_fp8(8.f * siluf_(v0[0]) * v1[0], 8.f * siluf_(v0[1]) * v1[1], 8.f * siluf_(v0[2]) * v1[2], 8.f * siluf_(v0[3]) * v1[3]); }
    DI void wide(int row, int col, f32x4 a0, f32x4 a1, f32x4 b0, f32x4 b1) const { const int f = ((col & 2047) >> 8) * 128 + (col & 255);
        *(u32x2*)(O + (size_t)row * DM + f) = (u32x2){pk4_fp8(8.f * siluf_(a0[0]) * b0[0], 8.f * siluf_(a0[1]) * b0[1], 8.f * siluf_(a0[2]) * b0[2], 8.f * siluf_(a0[3]) * b0[3]),
                                                    pk4_fp8(8.f * siluf_(a1[0]) * b1[0], 8.f * siluf_(a1[1]) * b1[1], 8.f * siluf_(a1[2]) * b1[2], 8.f * siluf_(a1[3]) * b1[3])}; } };
struct EpiGate { static constexpr bool WIDE = true; bf16* O; const float* gate;
    DI void operator()(int row, int col, f32x4 v0, f32x4 v1) const { const float g = gate[row]; bf16* p = O + (size_t)row * DM + (col & 1023);
        *(u32x2*)p = (u32x2){pk2(v0[0] * g, v0[1] * g), pk2(v0[2] * g, v0[3] * g)}; *(u32x2*)(p + 128) = (u32x2){pk2(v1[0] * g, v1[1] * g), pk2(v1[2] * g, v1[3] * g)}; }
    DI void wide(int row, int col, f32x4 a0, f32x4 a1, f32x4 b0, f32x4 b1) const { const float g = gate[row]; bf16* p = O + (size_t)row * DM + (col & 1023);
        *(u32x4*)p = (u32x4){pk2(a0[0] * g, a0[1] * g), pk2(a0[2] * g, a0[3] * g), pk2(a1[0] * g, a1[1] * g), pk2(a1[2] * g, a1[3] * g)};
        *(u32x4*)(p + 128) = (u32x4){pk2(b0[0] * g, b0[1] * g), pk2(b0[2] * g, b0[3] * g), pk2(b1[0] * g, b1[1] * g), pk2(b1[2] * g, b1[3] * g)}; } };
typedef _Float16 f16x2_t __attribute__((ext_vector_type(2)));
DI unsigned pk2h(float a, float b) { f16x2_t h; h.x = (_Float16)a; h.y = (_Float16)b; return __builtin_bit_cast(unsigned, h); }
DI float h2f(unsigned short x) { return (float)__builtin_bit_cast(_Float16, x); }
struct EpiLoraW { static constexpr bool WIDE = false; unsigned short* W; const float* w0;
    DI void one(int row, int col, f32x4 v) const { const int d = col >> 9, c = col & 511; f32x4 o;
#pragma unroll
        for (int e = 0; e < 4; ++e) { const float lw = w0[col + e] + v[e]; const float z = -lw; const float sp = fmaxf(z, 0.f) + __logf(1.f + __expf(-fabsf(z))); o[e] = -__expf(-sp - 0.5f); }
        *(u32x2*)(W + ((size_t)d * MT + row) * 512 + c) = (u32x2){pk2h(o[0], o[1]), pk2h(o[2], o[3])}; }
    DI void operator()(int row, int col, f32x4 v0, f32x4 v1) const { one(row, col, v0); one(row, col + 128, v1); } };
struct EpiLoraA { static constexpr bool WIDE = false; bf16* Aout; const float* a0;
    DI void one(int row, int col, f32x4 v) const { const int d = col >> 9, c = col & 511; const f32x4 b = *(const f32x4*)(a0 + col);
        *(u32x2*)(Aout + ((size_t)d * MT + row) * 512 + c) = (u32x2){pk2(sigmoidf_(b[0] + v[0]), sigmoidf_(b[1] + v[1])), pk2(sigmoidf_(b[2] + v[2]), sigmoidf_(b[3] + v[3]))}; }
    DI void operator()(int row, int col, f32x4 v0, f32x4 v1) const { one(row, col, v0); one(row, col + 128, v1); } };

namespace pg8 {
constexpr int BM = 256, BK = 64, HALF = 128, HTB = HALF * BK * 2, STAGE_BYTES = 8 * HTB;
DI int lds_byte(int r, int c) { const int st = (r >> 4) * 2 + (c >> 5), rr = r & 15, cc = c & 31, ob = rr * 64 + cc * 2; return st * 1024 + (ob ^ (((ob >> 9) & 1) << 5)); }
DI void stage_rc(int b, int& R, int& C) { const int st = b / 1024, sb = b % 1024, swz = sb ^ (((sb >> 9) & 1) << 5); R = (st >> 1) * 16 + swz / 64; C = (st & 1) * 32 + (swz % 64) / 2; }
DI int perm32(int rho) { const int n = rho >> 4, i = rho & 15; return 8 * (i >> 2) + 4 * n + (i & 3); }
struct Unit { int pm, pn; };
struct Gemm { const bf16* A; const bf16* Bt; int lda, K; const int* rows; int scale_w = 0x7f7f7f7f, scale_a = 0x7f7f7f7f; };
struct OrderMN { int nM, nN, G, c;
    DI bool next(int i, Unit& u) const { const int L = i * G + c; if (L >= nM * nN) return false; u.pm = L / nN; u.pn = L % nN; return true; } };
struct OrderMoE { int nMt, nN, mstride  , G, c;
    DI bool next(int i, Unit& u) const { const int L = i * G + c, per = nMt * nN; if (L >= NEXP * per) return false; const int e = L / per, q = L % per; u.pm = e * mstride + q / nN; u.pn = e * nN + q % nN; return true; } };
template <class E4> struct EpiAdapt { E4 e;
    DI void operator()(const f32x4 (&acc)[2][2][4][2], const Unit& u, int wr, int wc, int fr, int fq) const {
#pragma unroll
        for (int ai = 0; ai < 2; ++ai)
#pragma unroll
            for (int m = 0; m < 4; ++m) { const int row = u.pm * BM + ai * HALF + wr * 64 + m * 16 + fr;
                if constexpr (E4::WIDE) e.wide(row, u.pn * BM + wc * 32 + 8 * fq, acc[ai][0][m][0], acc[ai][0][m][1], acc[ai][1][m][0], acc[ai][1][m][1]);
                else {
#pragma unroll
                    for (int n = 0; n < 2; ++n) e(row, u.pn * BM + wc * 32 + 8 * fq + 4 * n, acc[ai][0][m][n], acc[ai][1][m][n]); } } } };

template <class Epi, class Sched, bool F8 = false>
DI void gemm_phase(LAS unsigned char* lds, const Gemm g, const Sched& S, const Epi& E, const int tid) {
    const int wid = __builtin_amdgcn_readfirstlane(tid >> 6), lane = tid & 63, wr = wid >> 2, wc = wid & 3, fr = lane & 15, fq = lane >> 4;
    const int K = g.K, nt = K / BK;
    unsigned voffB[2];
#pragma unroll
    for (int i = 0; i < 2; ++i) { int R, C; stage_rc(tid * 16 + i * 8192, R, C); const int Rb = (R & ~31) + perm32(R & 31); voffB[i] = (unsigned)(Rb * K + C) * 2u; }
    const size_t kstep = (size_t)(BK * 2), hstep = (size_t)HALF * K * 2, tstep = 2 * hstep;
    const unsigned ldsw = (unsigned)wid * 1024u;
    const int aoff = lds_byte(wr * 64 + fr, fq * 8), boff = lds_byte(wc * 32 + fr, fq * 8);
    const char* const gA = (const char*)g.A;
#define PG8_SA(b, h) (((b) * 2 + (h)) * HTB)
#define PG8_SB(b, h) ((4 + (b) * 2 + (h)) * HTB)
#define PG8_STAGE(bufoff, gbase, voff) do { _Pragma("unroll") for (int _i = 0; _i < 2; ++_i) \
        __builtin_amdgcn_global_load_lds((const unsigned*)((const char*)(gbase) + (voff)[_i]), (LAS unsigned*)(lds + (bufoff) + ldsw + _i * 8192), 16, 0, 0); } while (0)
#define PG8_LDA(dst, b, h) do { _Pragma("unroll") for (int m = 0; m < 4; ++m) _Pragma("unroll") for (int k = 0; k < 2; ++k) dst[m][k] = *(const LAS bf16x8*)(lds + PG8_SA(b, h) + aoff + m * 2048 + k * 1024); } while (0)
#define PG8_LDB(dst, b, h) do { _Pragma("unroll") for (int n = 0; n < 2; ++n) _Pragma("unroll") for (int k = 0; k < 2; ++k) dst[n][k] = *(const LAS bf16x8*)(lds + PG8_SB(b, h) + boff + n * 2048 + k * 1024); } while (0)
#define PG8_MMA(ai, bj, At, Bt) do { __builtin_amdgcn_s_setprio(1); _Pragma("unroll") for (int m = 0; m < 4; ++m) _Pragma("unroll") for (int n = 0; n < 2; ++n) { \
        if constexpr (F8) { const v8i_t w8 = __builtin_shufflevector(__builtin_bit_cast(i32x4_t, Bt[n][0]), __builtin_bit_cast(i32x4_t, Bt[n][1]), 0, 1, 2, 3, 4, 5, 6, 7), x8 = __builtin_shufflevector(__builtin_bit_cast(i32x4_t, At[m][0]), __builtin_bit_cast(i32x4_t, At[m][1]), 0, 1, 2, 3, 4, 5, 6, 7); \
            acc[ai][bj][m][n] = __builtin_amdgcn_mfma_scale_f32_16x16x128_f8f6f4(w8, x8, acc[ai][bj][m][n], 0, 0, 0, g.scale_w, 0, g.scale_a); } \
        else { _Pragma("unroll") for (int k = 0; k < 2; ++k) acc[ai][bj][m][n] = __builtin_amdgcn_mfma_f32_16x16x32_bf16(Bt[n][k], At[m][k], acc[ai][bj][m][n], 0, 0, 0); } } __builtin_amdgcn_s_setprio(0); } while (0)
#define PG8_WAIT_V(n) asm volatile("s_waitcnt vmcnt(" #n ")" ::: "memory")
#define PG8_WAIT_L(n) asm volatile("s_waitcnt lgkmcnt(" #n ")" ::: "memory")
#define PG8_BAR __builtin_amdgcn_s_barrier()
#define PG8_SCHED __builtin_amdgcn_sched_barrier(0)
#define PG8_ROWIDX(ri, u) do { _Pragma("unroll") for (int _h = 0; _h < 2; ++_h) _Pragma("unroll") for (int _i = 0; _i < 2; ++_i) { int _R, _C; stage_rc(tid * 16 + _i * 8192, _R, _C); (void)_C; \
        const int _lr = (u).pm * BM + _h * HALF + _R; ri[_h][_i] = g.rows ? g.rows[_lr] : _lr; } } while (0)
#define PG8_AOFF_FROM(vo, ri) do { _Pragma("unroll") for (int _h = 0; _h < 2; ++_h) _Pragma("unroll") for (int _i = 0; _i < 2; ++_i) { int _R, _C; stage_rc(tid * 16 + _i * 8192, _R, _C); (void)_R; \
        vo[_h][_i] = (unsigned)(((size_t)ri[_h][_i] * g.lda + _C) * 2u); } } while (0)
    Unit cur, nxt; int ui = 0;
    if (!S.next(0, cur)) return;
    f32x4 acc[2][2][4][2];
#pragma unroll
    for (int a = 0; a < 2; ++a)
#pragma unroll
        for (int b = 0; b < 2; ++b)
#pragma unroll
            for (int m = 0; m < 4; ++m)
#pragma unroll
                for (int n = 0; n < 2; ++n) acc[a][b][m][n] = (f32x4){0.f, 0.f, 0.f, 0.f};
    bf16x8 At[4][2], B0[2][2], B1[2][2];
    unsigned cvo[2][2]; int nri[2][2];
    PG8_ROWIDX(nri, cur); PG8_AOFF_FROM(cvo, nri);
    const char* cB = (const char*)g.Bt + (size_t)cur.pn * tstep;
    PG8_STAGE(PG8_SB(0, 0), cB, voffB); PG8_STAGE(PG8_SB(0, 1), cB + hstep, voffB); PG8_STAGE(PG8_SA(0, 0), gA, cvo[0]); PG8_STAGE(PG8_SA(0, 1), gA, cvo[1]);
    if (wr == 1) PG8_BAR;
    PG8_WAIT_V(2); PG8_BAR;
    PG8_STAGE(PG8_SB(1, 0), cB + kstep, voffB); PG8_STAGE(PG8_SA(1, 0), gA + kstep, cvo[0]); PG8_STAGE(PG8_SB(1, 1), cB + hstep + kstep, voffB);
    PG8_WAIT_V(6); PG8_BAR;
    for (;;) {
        const bool has_next = S.next(ui + 1, nxt);
        const char* nB = has_next ? (const char*)g.Bt + (size_t)nxt.pn * tstep : cB;
#pragma nounroll
        for (int t = 0; t < nt; t += 2) {
            const bool last = (t == nt - 2);
            const char* a1 = gA + (size_t)(t + 1) * kstep;
            const char* a2 = last ? gA : gA + (size_t)(t + 2) * kstep; const char* b2 = last ? nB : cB + (size_t)(t + 2) * kstep;
            const char* a3 = a2 + kstep; const char* b3 = b2 + kstep;
            if (t == nt - 4 && has_next) PG8_ROWIDX(nri, nxt);
            PG8_LDB(B0, 0, 0); PG8_LDB(B1, 0, 1); PG8_SCHED; PG8_LDA(At, 0, 0); PG8_STAGE(PG8_SA(1, 1), a1, cvo[1]);
            if (last && has_next) { if (nt < 4) PG8_ROWIDX(nri, nxt); PG8_AOFF_FROM(cvo, nri); }
            PG8_WAIT_V(8); PG8_WAIT_L(0); PG8_BAR; PG8_MMA(0, 0, At, B0); PG8_MMA(0, 1, At, B1); PG8_BAR; PG8_SCHED;
            PG8_LDA(At, 0, 1); PG8_STAGE(PG8_SB(0, 0), b2, voffB); PG8_STAGE(PG8_SB(0, 1), b2 + hstep, voffB); PG8_STAGE(PG8_SA(0, 0), a2, cvo[0]);
            PG8_WAIT_V(8); PG8_WAIT_L(0); PG8_BAR; PG8_MMA(1, 0, At, B0); PG8_MMA(1, 1, At, B1); PG8_BAR; PG8_SCHED;
            PG8_LDB(B0, 1, 0); PG8_LDB(B1, 1, 1); PG8_SCHED; PG8_LDA(At, 1, 0); PG8_STAGE(PG8_SA(0, 1), a2, cvo[1]);
            PG8_WAIT_V(8); PG8_WAIT_L(0); PG8_BAR; PG8_MMA(0, 0, At, B0); PG8_MMA(0, 1, At, B1); PG8_BAR; PG8_SCHED;
            PG8_LDA(At, 1, 1); PG8_STAGE(PG8_SB(1, 0), b3, voffB); PG8_STAGE(PG8_SB(1, 1), b3 + hstep, voffB); PG8_STAGE(PG8_SA(1, 0), a3, cvo[0]);
            PG8_WAIT_V(8); PG8_WAIT_L(0); PG8_BAR; PG8_MMA(1, 0, At, B0); PG8_MMA(1, 1, At, B1); PG8_BAR; PG8_SCHED;
        }
        if (wr == 0) PG8_BAR;
        E(acc, cur, wr, wc, fr, fq);
        if (!has_next) break;
#pragma unroll
        for (int a = 0; a < 2; ++a)
#pragma unroll
            for (int b = 0; b < 2; ++b)
#pragma unroll
                for (int m = 0; m < 4; ++m)
#pragma unroll
                    for (int n = 0; n < 2; ++n) acc[a][b][m][n] = (f32x4){0.f, 0.f, 0.f, 0.f};
        cur = nxt; cB = nB; ++ui;
        if (wr == 1) PG8_BAR;
    }
    PG8_WAIT_V(0);
    PG8_BAR;
#undef PG8_SA
#undef PG8_SB
#undef PG8_STAGE
#undef PG8_LDA
#undef PG8_LDB
#undef PG8_MMA
#undef PG8_WAIT_V
#undef PG8_WAIT_L
#undef PG8_BAR
#undef PG8_SCHED
#undef PG8_ROWIDX
#undef PG8_AOFF_FROM
}
}
template <class E4> DI void fast_gemm(const Ctx& C, const bf16* A, int lda, const bf16* Bt, int K, int nM, int nN, const E4& e, bool rev = false) {
    pg8::Gemm g{A, Bt, lda, K, nullptr}; pg8::OrderMN S{nM, nN, C.nb, rev ? C.nb - 1 - C.vcu : C.vcu}; pg8::EpiAdapt<E4> E{e};
    pg8::gemm_phase(C.lds, g, S, E, C.tid);
}

DI float max16_acc(float m, const f32x16& x) {
    asm volatile("s_nop 15\n\tv_max3_f32 %0, %0, %1, %2\n\tv_max3_f32 %0, %0, %3, %4\n\tv_max3_f32 %0, %0, %5, %6\n\tv_max3_f32 %0, %0, %7, %8\n\tv_max3_f32 %0, %0, %9, %10\n\tv_max3_f32 %0, %0, %11, %12\n\tv_max3_f32 %0, %0, %13, %14\n\tv_max3_f32 %0, %0, %15, %16"
                 : "+v"(m) : "v"(x[0]), "v"(x[1]), "v"(x[2]), "v"(x[3]), "v"(x[4]), "v"(x[5]), "v"(x[6]), "v"(x[7]), "v"(x[8]), "v"(x[9]), "v"(x[10]), "v"(x[11]), "v"(x[12]), "v"(x[13]), "v"(x[14]), "v"(x[15]));
    return m; }
DI int swap23(int x) { return (x & ~12) | ((x & 4) << 1) | ((x & 8) >> 1); }
DI void flash_store(const f32x16 (&o)[2], float l, bf16* orow  , int h) {
    const float inv = 1.f / l;
#pragma unroll
    for (int dt = 0; dt < 2; ++dt)
#pragma unroll
        for (int g = 0; g < 4; ++g)
            *(u32x2*)(orow + 32 * dt + 8 * g + 4 * h) = (u32x2){pk2(o[dt][4 * g] * inv, o[dt][4 * g + 1] * inv), pk2(o[dt][4 * g + 2] * inv, o[dt][4 * g + 3] * inv)};
}


template <int DQK> struct AttnGeo { static constexpr int KSTR = DQK * 2 + 16, KBYTES = 64 * KSTR, VSTR = 144, VBYTES = 64 * VSTR, BUF = KBYTES + VBYTES, KPIECES = 64 * DQK / 8; };
template <int DQK, bool NAT>
DI void attn_tile_loop(const Ctx& C, f32x16 (&o)[2], float& l, const bf16x8 (&qf)[DQK / 16], const bf16* __restrict__ Kb, const bf16* __restrict__ Vt, int pos1, int n1, int pos2, int n2,
                       const LAS float* tab, int grow, int rs, int qc, int cs) {
    typedef AttnGeo<DQK> G;
    const int tid = C.tid, r = C.lane & 31, h = C.lane >> 5, kr = swap23(r), ntiles = n1 + n2;
    constexpr bool K2 = G::KPIECES > 512;
    const int kq0 = tid, kq1 = tid + 512;
    const int kl0 = (kq0 / (DQK / 8)) * G::KSTR + (kq0 % (DQK / 8)) * 16, kl1 = (kq1 / (DQK / 8)) * G::KSTR + (kq1 % (DQK / 8)) * 16;
    const int vl = G::KBYTES + (tid >> 3) * G::VSTR + (tid & 7) * 16;
    const bf16* vg = Vt + (size_t)(tid >> 3) * KPOS + 8 * (tid & 7);
    u32x4 rk0, rk1, rv;
    rk1 = (u32x4){0u, 0u, 0u, 0u};
#define ATT_POS(t) ((t) < n1 ? pos1 + 64 * (t) : pos2 + 64 * ((t) - n1))
    { const int pos0 = ATT_POS(0); rk0 = *(const u32x4*)(Kb + (size_t)pos0 * DQK + 8 * kq0); if (K2 && tid < 256) rk1 = *(const u32x4*)(Kb + (size_t)pos0 * DQK + 8 * kq1); rv = *(const u32x4*)(vg + pos0); }
    __syncthreads();
    *(LAS u32x4*)(C.lds + kl0) = rk0; if (K2 && tid < 256) *(LAS u32x4*)(C.lds + kl1) = rk1; *(LAS u32x4*)(C.lds + vl) = rv;
    __syncthreads();
    if (C.wave >= 4) __builtin_amdgcn_s_setprio(1);
    float mref = 0.f; bool first = true;
    f32x16 nmref;
#pragma unroll
    for (int i = 0; i < 16; ++i) nmref[i] = 0.f;
    constexpr float THR = 8.f;
    for (int t = 0; t < ntiles; ++t) {
        const LAS unsigned char* B = C.lds + (t & 1) * G::BUF;
        if (t + 1 < ntiles) { const int pos0 = ATT_POS(t + 1);
            rk0 = *(const u32x4*)(Kb + (size_t)pos0 * DQK + 8 * kq0); if (K2 && tid < 256) rk1 = *(const u32x4*)(Kb + (size_t)pos0 * DQK + 8 * kq1); rv = *(const u32x4*)(vg + pos0); }
        const int gr = (pos1 >> 6) + t;
        const bool active = !NAT || t >= n1 || (gr >= rs && gr < rs + 8);
        if (active) {
            f32x16 sc[2];
            constexpr int NK = DQK / 16, NS = 2 * NK, RD = 4;
            const LAS unsigned char* kp = B + kr * G::KSTR + 16 * h;
            bf16x8 fr[RD];
#pragma unroll
            for (int s = 0; s < RD; ++s) fr[s] = *(const LAS bf16x8*)(kp + (s / NK) * 32 * G::KSTR + 32 * (s % NK));
#pragma unroll
            for (int s = 0; s < NS; ++s) { sc[s / NK] = MFMA32(fr[s % RD], qf[s % NK], (s % NK == 0) ? nmref : sc[s / NK]);
                if (s + RD < NS) fr[s % RD] = *(const LAS bf16x8*)(kp + ((s + RD) / NK) * 32 * G::KSTR + 32 * ((s + RD) % NK)); }
            const LAS unsigned char* vp = B + G::KBYTES + r * G::VSTR + 16 * h;
#pragma unroll
            for (int v = 0; v < RD; ++v) fr[v] = *(const LAS bf16x8*)(vp + (v & 1) * 32 * G::VSTR + (v >> 1) * 32);
            __builtin_amdgcn_sched_group_barrier(0x100, RD, 0);
#pragma unroll
            for (int s = 0; s < NS - RD; ++s) { __builtin_amdgcn_sched_group_barrier(0x008, 1, 0); __builtin_amdgcn_sched_group_barrier(0x100, 1, 0); }
            __builtin_amdgcn_sched_group_barrier(0x008, RD, 0);
            __builtin_amdgcn_sched_group_barrier(0x100, RD, 0);
            if (NAT && t < n1) {
                const LAS float* trl = tab + (gr - grow + 7) * 128 + (8 * h - qc + 63);
#pragma unroll
                for (int j = 0; j < 2; ++j) { float bv[16];
#pragma unroll
                    for (int i = 0; i < 16; ++i) bv[i] = trl[32 * j + ((i & 3) | (((i >> 2) & 1) << 2) | ((i >> 3) << 4))];
                    asm volatile("" : "+v"(bv[0]), "+v"(bv[1]), "+v"(bv[2]), "+v"(bv[3]), "+v"(bv[4]), "+v"(bv[5]), "+v"(bv[6]), "+v"(bv[7]), "+v"(bv[8]), "+v"(bv[9]), "+v"(bv[10]), "+v"(bv[11]), "+v"(bv[12]), "+v"(bv[13]), "+v"(bv[14]), "+v"(bv[15]));
#pragma unroll
                    for (int i = 0; i < 16; ++i) {
                        const int cc = 32 * j + ((i & 3) | (((i >> 2) & 1) << 2) | ((i >> 3) << 4)) + 8 * h; const bool ok = (cc >= cs) && (cc < cs + 16);
                        sc[j][i] = ok ? sc[j][i] + bv[i] : -1e30f;
                    } }
            }
            float mx = max16_acc(max16_acc(-3.0e38f, sc[0]), sc[1]);
            if (first || __builtin_amdgcn_ballot_w64(mx > THR) != 0ull) {
                mx = fmaxf(mx, xor32(mx, C.lane));
                const float delta = first ? mx : fmaxf(mx, 0.f);
#pragma unroll
                for (int i = 0; i < 16; ++i) { sc[0][i] -= delta; sc[1][i] -= delta; }
                if (!first) { const float alpha = __builtin_amdgcn_exp2f(-delta); l *= alpha;
#pragma unroll
                    for (int i = 0; i < 16; ++i) { o[0][i] *= alpha; o[1][i] *= alpha; } }
                mref += delta; first = false;
#pragma unroll
                for (int i = 0; i < 16; ++i) nmref[i] = -mref;
            }
            float rs1 = 0.f;
#pragma unroll
            for (int j = 0; j < 2; ++j)
#pragma unroll
                for (int i = 0; i < 16; ++i) { sc[j][i] = __builtin_amdgcn_exp2f(sc[j][i]); rs1 += sc[j][i]; }
            l += rs1;
#pragma unroll
            for (int j = 0; j < 2; ++j)
#pragma unroll
                for (int s2 = 0; s2 < 2; ++s2) {
                    u32x4 pw; pw.x = pk2(sc[j][8 * s2], sc[j][8 * s2 + 1]); pw.y = pk2(sc[j][8 * s2 + 2], sc[j][8 * s2 + 3]); pw.z = pk2(sc[j][8 * s2 + 4], sc[j][8 * s2 + 5]); pw.w = pk2(sc[j][8 * s2 + 6], sc[j][8 * s2 + 7]);
                    const bf16x8 pb = __builtin_bit_cast(bf16x8, pw);
#pragma unroll
                    for (int dt = 0; dt < 2; ++dt) { const int v = 4 * j + 2 * s2 + dt;
                        o[dt] = MFMA32(fr[v % RD], pb, o[dt]);
                        if (v + RD < 8) fr[v % RD] = *(const LAS bf16x8*)(vp + ((v + RD) & 1) * 32 * G::VSTR + ((v + RD) >> 1) * 32); }
                }
#pragma unroll
            for (int v = 0; v < 8 - RD; ++v) { __builtin_amdgcn_sched_group_barrier(0x008, 1, 1); __builtin_amdgcn_sched_group_barrier(0x100, 1, 1); }
            __builtin_amdgcn_sched_group_barrier(0x008, RD, 1);
        }
        if (t + 1 < ntiles) { LAS unsigned char* Bn = C.lds + ((t + 1) & 1) * G::BUF;
            *(LAS u32x4*)(Bn + kl0) = rk0; if (K2 && tid < 256) *(LAS u32x4*)(Bn + kl1) = rk1; *(LAS u32x4*)(Bn + vl) = rv; }
        __syncthreads();
    }
    __builtin_amdgcn_s_setprio(0);
    l += xor32(l, C.lane);
#undef ATT_POS
}
DI void conv_unit(const Ctx& C, int u, const bf16* U, const float (&wk)[31], float bias, const float* lng, const float* lnb, bf16* OCAT);
DI const float* in_ptr(const unsigned char* ws, int k);
constexpr int CONV_PER_TAIL = 3;
DI int conv_in_fin(int nb) { const int extra = (MT / 64) % nb; const int n = CONV_PER_TAIL * (nb - extra); return n < MT / 32 ? n : MT / 32; }
DI void ph_attn_mla2(const Ctx& C, const bf16* QB, const bf16* KB, const bf16* VT, bf16* OCAT, bool last, unsigned char* ws, int lq) {
    const int r = C.lane & 31, h = C.lane >> 5;
    const int nunits = 1024 + (last ? 0 : 64);
    int k = 0;
    for (;; ++k) {
        const int u = C.vcu + k * C.nb, cu = conv_in_fin(C.nb) + (C.nb - 1 - C.vcu) + k * C.nb;
        const bool a_on = u < nunits, c_on = cu < MT / 32;
        if (!a_on && !c_on) break;
        if (a_on) {
            const int bh = u < 1024 ? (u >> 4) : u - 1024, qblk = u < 1024 ? (u & 15) : 16, b = bh >> 3, hh = bh & 7;
            const int qpos = qblk * 256 + 32 * C.wave + r;
            const bf16* qp = QB + ((size_t)bh * KPOS + qpos) * 96 + 8 * h;
            bf16x8 qf[6];
#pragma unroll
            for (int kk = 0; kk < 6; ++kk) qf[kk] = *(const bf16x8*)(qp + 16 * kk);
            f32x16 o[2];
#pragma unroll
            for (int i = 0; i < 16; ++i) { o[0][i] = 0.f; o[1][i] = 0.f; }
            float l = 0.f;
            attn_tile_loop<96, false>(C, o, l, qf, KB + (size_t)bh * KPOS * 96, VT + (size_t)bh * 64 * KPOS, qblk < 16 ? 0 : TL, qblk < 16 ? KPOS / 64 : LCX / 64, 0, 0, nullptr, 0, 0, 0, 0);
            const int row = qblk < 16 ? b * TL + qpos : NLAT + b * LCX + (qpos - TL);
            flash_store(o, l, OCAT + (size_t)row * DM + hh * 64, h);
        }
        if (c_on) { float wk[31]; const float* dww = in_ptr(ws, I_DWW) + (size_t)lq * 31 * 512;
#pragma unroll
            for (int kt = 0; kt < 31; ++kt) wk[kt] = dww[kt * 512 + C.tid];
            conv_unit(C, cu, (const bf16*)(ws + WS_ARENA + A_U), wk, in_ptr(ws, I_DWB)[lq * 512 + C.tid], in_ptr(ws, I_LNG) + lq * 512, in_ptr(ws, I_LNB) + lq * 512, OCAT); }
    }
}
DI void ph_natten2(const Ctx& C, const bf16* QN, const bf16* KN, const bf16* VTN, bf16* OCAT, const float* rpb  , bool last, unsigned* work_ctr, unsigned char* ws, int lq) {
    const int r = C.lane & 31, h = C.lane >> 5;
    LAS float* tab = (LAS float*)(C.lds + 2 * AttnGeo<64>::BUF);
    LAS int* uslot = (LAS int*)(tab + 1920);
    const int nunits = 1024 + (last ? 0 : 64);
    for (;;) {
        __syncthreads();
        if (C.tid == 0) *uslot = (int)__hip_atomic_fetch_add(work_ctr, 1u, __ATOMIC_RELAXED, __HIP_MEMORY_SCOPE_AGENT);
        __syncthreads();
        const int u = *uslot;
        if (u >= nunits) break;
        const bool isctx = u >= 1024;
        const int bh = isctx ? u - 1024 : (u >> 4), b = bh >> 3, hh = bh & 7;
        for (int i = C.tid; i < 15 * 128; i += 512) { const int dc = (i & 127) - 48; tab[i] = (dc >= 0 && dc < 31) ? rpb[hh * 465 + (i >> 7) * 31 + dc] * LOG2E : 0.f; }
        int qpos, row, grow = 0, qc = 0, rs = 0, cs = 0, rlo = 0, nband = 0;
        if (!isctx) { const int rg = u & 15; grow = 4 * rg + (C.wave >> 1); qc = 32 * (C.wave & 1) + r; qpos = grow * 64 + qc; row = b * TL + qpos;
            rs = grow - 4; rs = rs < 0 ? 0 : (rs > 56 ? 56 : rs); cs = qc - 8; cs = cs < 0 ? 0 : (cs > 48 ? 48 : cs);
            rlo = 4 * rg - 4; rlo = rlo < 0 ? 0 : (rlo > 56 ? 56 : rlo); int rhi = 4 * rg + 3 - 4; rhi = rhi < 0 ? 0 : (rhi > 56 ? 56 : rhi); nband = rhi + 8 - rlo; }
        else { qpos = TL + 32 * C.wave + r; row = NLAT + b * LCX + 32 * C.wave + r; }
        const bf16* qp = QN + ((size_t)bh * KPOS + qpos) * 64 + 8 * h;
        bf16x8 qf[4];
#pragma unroll
        for (int kk = 0; kk < 4; ++kk) qf[kk] = *(const bf16x8*)(qp + 16 * kk);
        f32x16 o[2];
#pragma unroll
        for (int i = 0; i < 16; ++i) { o[0][i] = 0.f; o[1][i] = 0.f; }
        float l = 0.f;
        attn_tile_loop<64, true>(C, o, l, qf, KN + (size_t)bh * KPOS * 64, VTN + (size_t)bh * 64 * KPOS, rlo * 64, nband, TL, LCX / 64, tab, grow, rs, qc, cs);
        flash_store(o, l, OCAT + (size_t)row * DM + 512 + hh * 64, h);
    }
}


DI void ph_mla_fin(const Ctx& C, const bf16* U, const bf16* QPRE, const bf16* KVPRE, const float* qg, const float* kg, const f32x2* CS, bf16* QB, bf16* KB, bf16* VT) {
    LAS bf16* VL = (LAS bf16*)C.lds;
    const int lane = C.lane, j = lane >> 3, sub = lane & 7;
    const float C2 = 0.10206207261596575f * LOG2E;
    float qgn[8], qgr[4], kgn[8], kgr[4];
#pragma unroll
    for (int e = 0; e < 8; ++e) { qgn[e] = qg[8 * sub + e] * C2; kgn[e] = kg[8 * sub + e]; }
#pragma unroll
    for (int m = 0; m < 4; ++m) { qgr[m] = qg[64 + sub + 8 * m] * C2; kgr[m] = kg[64 + sub + 8 * m]; }
    for (int u = C.vcu; u < MT / 64; u += C.nb) {
        const int row0 = 64 * u, b = row0 < NLAT ? (row0 >> 12) : ((row0 - NLAT) >> 8), pos0 = row0 < NLAT ? (row0 & 4095) : TL + ((row0 - NLAT) & 255);
        const bool lat = row0 < NLAT;
        const int pl = 8 * C.wave + j, row = row0 + pl, pos = pos0 + pl;
        const bf16* ur = U + (size_t)row * EV_INP;
        float sq = 0.f, skv = 0.f;
#pragma unroll
        for (int m = 0; m < 6; ++m) { float x[8]; unpack8(*(const u32x4*)(ur + 8 * (sub + 8 * m)), x);
#pragma unroll
            for (int e = 0; e < 8; ++e) sq += x[e] * x[e]; }
#pragma unroll
        for (int m = 0; m < 4; ++m) { float x[8]; unpack8(*(const u32x4*)(ur + 384 + 8 * (sub + 8 * m)), x);
#pragma unroll
            for (int e = 0; e < 8; ++e) skv += x[e] * x[e]; }
        sq = sum8(sq); skv = sum8(skv);
        const float rsq = 1.0f / sqrtf(sq * (1.f / 384.f) + EPS), rskv = 1.0f / sqrtf(skv * (1.f / 256.f) + EPS);
        float krv[4];
#pragma unroll
        for (int m = 0; m < 4; ++m) krv[m] = bf2f(ur[640 + sub + 8 * m]);
        float cr = 1.f, sr = 0.f, cc = 1.f, sc = 0.f;
        if (lat) { const f32x2 a0 = CS[pos * 16 + sub], a1 = CS[pos * 16 + 8 + sub]; cr = a0.x; sr = a0.y; cc = a1.x; sc = a1.y; }
        const bf16* qrow = QPRE + (size_t)row * 768; const bf16* kvrow = KVPRE + (size_t)row * 1024;
#pragma unroll 2
        for (int hh = 0; hh < 8; ++hh) {
            { float qn[8], qr[4]; unpack8(*(const u32x4*)(qrow + hh * 96 + 8 * sub), qn); float ss = 0.f;
#pragma unroll
              for (int e = 0; e < 8; ++e) qn[e] *= rsq;
#pragma unroll
              for (int m = 0; m < 4; ++m) { qr[m] = bf2f(qrow[hh * 96 + 64 + sub + 8 * m]) * rsq; ss += qr[m] * qr[m]; }
#pragma unroll
              for (int e = 0; e < 8; ++e) ss += qn[e] * qn[e];
              const float rn = 1.0f / sqrtf(sum8(ss) * (1.f / 96.f) + EPS);
#pragma unroll
              for (int e = 0; e < 8; ++e) qn[e] *= rn * qgn[e];
#pragma unroll
              for (int m = 0; m < 4; ++m) qr[m] *= rn * qgr[m];
              { const float x0 = qr[0], x1 = qr[1], y0 = qr[2], y1 = qr[3]; qr[0] = x0 * cr - x1 * sr; qr[1] = x1 * cr + x0 * sr; qr[2] = y0 * cc - y1 * sc; qr[3] = y1 * cc + y0 * sc; }
              bf16* qo = QB + ((size_t)(b * 8 + hh) * KPOS + pos) * 96;
              *(u32x4*)(qo + 8 * sub) = pack8(qn);
#pragma unroll
              for (int m = 0; m < 4; ++m) qo[64 + sub + 8 * m] = f2bf(qr[m]); }
            { float kn[8], kr[4]; unpack8(*(const u32x4*)(kvrow + hh * 128 + 8 * sub), kn); float ss = 0.f;
#pragma unroll
              for (int e = 0; e < 8; ++e) kn[e] *= rskv;
#pragma unroll
              for (int m = 0; m < 4; ++m) { kr[m] = krv[m]; ss += kr[m] * kr[m]; }
#pragma unroll
              for (int e = 0; e < 8; ++e) ss += kn[e] * kn[e];
              const float rn = 1.0f / sqrtf(sum8(ss) * (1.f / 96.f) + EPS);
#pragma unroll
              for (int e = 0; e < 8; ++e) kn[e] *= rn * kgn[e];
#pragma unroll
              for (int m = 0; m < 4; ++m) kr[m] *= rn * kgr[m];
              { const float x0 = kr[0], x1 = kr[1], y0 = kr[2], y1 = kr[3]; kr[0] = x0 * cr - x1 * sr; kr[1] = x1 * cr + x0 * sr; kr[2] = y0 * cc - y1 * sc; kr[3] = y1 * cc + y0 * sc; }
              bf16* ko = KB + ((size_t)(b * 8 + hh) * KPOS + pos) * 96;
              *(u32x4*)(ko + 8 * sub) = pack8(kn);
#pragma unroll
              for (int m = 0; m < 4; ++m) ko[64 + sub + 8 * m] = f2bf(kr[m]); }
            { float vv[8]; unpack8(*(const u32x4*)(kvrow + hh * 128 + 64 + 8 * sub), vv);
#pragma unroll
              for (int e = 0; e < 8; ++e) VL[(hh * 64 + 8 * sub + e) * 64 + pl] = f2bf(vv[e] * rskv); }
        }
        __syncthreads();
        { const int hd = C.tid;
            bf16* dst = VT + ((size_t)(b * 8 + (hd >> 6)) * 64 + (hd & 63)) * KPOS + pos0;
#pragma unroll
            for (int q = 0; q < 8; ++q) *(u32x4*)(dst + 8 * q) = *(const LAS u32x4*)(VL + hd * 64 + 8 * q); }
        __syncthreads();
    }
}

DI void conv_unit(const Ctx& C, int u, const bf16* U, const float (&wk)[31], float bias, const float* lng, const float* lnb, bf16* OCAT) {
    LAS float* G = (LAS float*)C.lds;
    const int c = C.tid;
    const int row0 = 32 * u; int base, t0, tseq;
    if (row0 < NLAT) { base = row0 & ~4095; t0 = row0 & 4095; tseq = TL; } else { const int rc = row0 - NLAT; base = NLAT + (rc & ~255); t0 = rc & 255; tseq = LCX; }
    __syncthreads();
    for (int rr = C.wave; rr < 62; rr += 8) { const int tt = t0 - 15 + rr; float g[8];
#pragma unroll
        for (int e = 0; e < 8; ++e) g[e] = 0.f;
        if (tt >= 0 && tt < tseq) { const bf16* ur = U + (size_t)(base + tt) * EV_INP; float av[8], gv[8]; unpack8(*(const u32x4*)(ur + 672 + 8 * C.lane), av); unpack8(*(const u32x4*)(ur + 1184 + 8 * C.lane), gv);
#pragma unroll
            for (int e = 0; e < 8; ++e) g[e] = av[e] * sigmoidf_(gv[e]); }
        *(LAS f32x4*)(G + rr * 512 + 8 * C.lane) = (f32x4){g[0], g[1], g[2], g[3]}; *(LAS f32x4*)(G + rr * 512 + 8 * C.lane + 4) = (f32x4){g[4], g[5], g[6], g[7]}; }
    __syncthreads();
    float acc[32];
#pragma unroll
    for (int t = 0; t < 32; ++t) acc[t] = bias;
#pragma unroll
    for (int rr = 0; rr < 62; ++rr) { const float gv = G[rr * 512 + c];
#pragma unroll
        for (int t = 0; t < 32; ++t) { const int k = rr - t; if (k >= 0 && k < 31) acc[t] += gv * wk[k]; } }
    __syncthreads();
#pragma unroll
    for (int t = 0; t < 32; ++t) G[t * 512 + c] = acc[t];
    __syncthreads();
#pragma unroll
    for (int q = 0; q < 4; ++q) {
        const int t = 4 * C.wave + q, row = row0 + t;
        const f32x4 a0 = *(const LAS f32x4*)(G + t * 512 + 8 * C.lane), a1 = *(const LAS f32x4*)(G + t * 512 + 8 * C.lane + 4);
        float x[8] = {a0.x, a0.y, a0.z, a0.w, a1.x, a1.y, a1.z, a1.w}; float s = 0.f;
#pragma unroll
        for (int e = 0; e < 8; ++e) s += x[e];
        const float mu = wave_sum(s) * (1.f / 512.f); float s2 = 0.f;
#pragma unroll
        for (int e = 0; e < 8; ++e) { x[e] -= mu; s2 += x[e] * x[e]; }
        const float rstd = 1.0f / sqrtf(wave_sum(s2) * (1.f / 512.f) + EPS);
        float y[8];
#pragma unroll
        for (int e = 0; e < 8; ++e) { const float z = x[e] * rstd * lng[8 * C.lane + e] + lnb[8 * C.lane + e]; y[e] = siluf_(z); }
        *(u32x4*)(OCAT + (size_t)row * DM + 512 + 8 * C.lane) = pack8(y);
    }
    __syncthreads();
}
DI void wprep_span(const Ctx& C, int first, int stride, const float* w1, const float* w3, const float* w2, bf16* W13, bf16* W2) {
    LAS float* scr = (LAS float*)(C.lds + C.wave * 16640);
    constexpr int PER = 16 * 16, NIT = NEXP * 3 * PER;
    for (int it = first; it < NIT; it += stride) {
        const int e = it / (3 * PER), r = it % (3 * PER), which = r / PER, q = r % PER, kb = q / 16, n0 = (q % 16) * 64;
#if MOE_F8
        if (which == 0)      transpose_item64_f8(w1 + (size_t)e * DM * DM, DM, DM, (unsigned char*)W13 + (size_t)e * 2048 * DM, (n0 >> 7) * 256 + (n0 & 127), scr, kb * 64, n0, C.lane);
        else if (which == 1) transpose_item64_f8(w3 + (size_t)e * DM * DM, DM, DM, (unsigned char*)W13 + (size_t)e * 2048 * DM, (n0 >> 7) * 256 + (n0 & 127) + 128, scr, kb * 64, n0, C.lane);
        else                 transpose_item64_f8(w2 + (size_t)e * DM * DM, DM, DM, (unsigned char*)W2 + (size_t)e * DM * DM, n0, scr, kb * 64, n0, C.lane); }
#else
        if (which == 0)      transpose_item64(w1 + (size_t)e * DM * DM, DM, DM, W13 + (size_t)e * 2048 * DM, (n0 >> 7) * 256 + (n0 & 127), scr, kb * 64, n0, C.lane);
        else if (which == 1) transpose_item64(w3 + (size_t)e * DM * DM, DM, DM, W13 + (size_t)e * 2048 * DM, (n0 >> 7) * 256 + (n0 & 127) + 128, scr, kb * 64, n0, C.lane);
        else                 transpose_item64(w2 + (size_t)e * DM * DM, DM, DM, W2 + (size_t)e * DM * DM, n0, scr, kb * 64, n0, C.lane); }
#endif
}
constexpr int WPREP_PER_WAVE = (NEXP * 3 * 256 + 2047) / 2048;

DI void shifted8(const bf16* up, const bf16* uc, const bf16* un, bool hp, bool hn, const float (&s0)[8], const float (&s1)[8], const float (&s2)[8], int c0, float (&o)[8]) {
    const u32x4 z = {0u, 0u, 0u, 0u};
    const u32x4 vp = hp ? *(const u32x4*)(up + c0) : z, vc = *(const u32x4*)(uc + c0), vn = hn ? *(const u32x4*)(un + c0) : z;
    float p[8], c[8], n[8]; unpack8(vp, p); unpack8(vc, c); unpack8(vn, n);
#pragma unroll
    for (int e = 0; e < 8; ++e) o[e] = p[e] * s0[e] + c[e] * s1[e] + n[e] * s2[e];
}
DI void load_sw(const float* sw, int c0, float (&s0)[8], float (&s1)[8], float (&s2)[8]) {
#pragma unroll
    for (int e = 0; e < 8; ++e) { s0[e] = sw[c0 + e]; s1[e] = sw[RW_IN + c0 + e]; s2[e] = sw[2 * RW_IN + c0 + e]; }
}
DI void ph_prep(const Ctx& C, const bf16* U, const float* sw  , const float* kkw  , const float* naqg, const float* nakg,
                bf16* R, bf16* V, bf16* K, bf16* KK, bf16* L, bf16* QN, bf16* KN, bf16* VTN) {
    LAS bf16* VL = (LAS bf16*)C.lds;
    const int lane = C.lane, hh = lane >> 3, sub = lane & 7;
    const float C2 = 0.125f * LOG2E;
    for (int u = C.vcu; u < MT / 32; u += C.nb) {
        const int row0 = 32 * u; const bool lat = row0 < NLAT;
        const int b = lat ? (row0 >> 12) : ((row0 - NLAT) >> 8), pos0 = lat ? (row0 & 4095) : TL + ((row0 - NLAT) & 255), tseq = lat ? TL : LCX, tb = lat ? (row0 & 4095) : ((row0 - NLAT) & 255);
#define PREP_ROWVARS(i) const int pl = 4 * C.wave + (i), row = row0 + pl, t = tb + pl; const bool hp = t > 0, hn = t < tseq - 1; \
            const bf16* uc = U + (size_t)row * OD_INP; const bf16* up = uc - OD_INP; const bf16* un = uc + OD_INP
        { float s0[8], s1[8], s2[8]; load_sw(sw, 8 * lane, s0, s1, s2);
          for (int i = 0; i < 4; ++i) { PREP_ROWVARS(i); float o[8]; shifted8(up, uc, un, hp, hn, s0, s1, s2, 8 * lane, o); *(u32x4*)(R + (size_t)row * 512 + 8 * lane) = pack8(o); } }
        { float s0[8], s1[8], s2[8]; load_sw(sw, 1024 + 8 * lane, s0, s1, s2);
          for (int i = 0; i < 4; ++i) { PREP_ROWVARS(i); float o[8]; shifted8(up, uc, un, hp, hn, s0, s1, s2, 1024 + 8 * lane, o); *(u32x4*)(V + (size_t)row * 512 + 8 * lane) = pack8(o); } }
        { float s0[8], s1[8], s2[8]; load_sw(sw, 512 + 8 * lane, s0, s1, s2); float kw[8];
#pragma unroll
          for (int e = 0; e < 8; ++e) kw[e] = kkw[8 * lane + e];
          for (int i = 0; i < 4; ++i) { PREP_ROWVARS(i); float o[8]; shifted8(up, uc, un, hp, hn, s0, s1, s2, 512 + 8 * lane, o); *(u32x4*)(K + (size_t)row * 512 + 8 * lane) = pack8(o);
              float kk[8]; float ss = 0.f;
#pragma unroll
              for (int e = 0; e < 8; ++e) { kk[e] = o[e] * kw[e]; ss += kk[e] * kk[e]; }
              ss = sum8(ss); const float rn = 1.0f / sqrtf(ss + 1e-12f);
#pragma unroll
              for (int e = 0; e < 8; ++e) kk[e] *= rn;
              *(u32x4*)(KK + (size_t)row * 512 + 8 * lane) = pack8(kk); } }
        if (lane < 48) { float s0[8], s1[8], s2[8]; load_sw(sw, 1536 + 8 * lane, s0, s1, s2);
          for (int i = 0; i < 4; ++i) { PREP_ROWVARS(i); float o[8]; shifted8(up, uc, un, hp, hn, s0, s1, s2, 1536 + 8 * lane, o);
              if (lane < 16) {
#pragma unroll
                  for (int e = 0; e < 8; ++e) { const float ex = __expf(2.f * o[e]); o[e] = 1.f - 2.f * __builtin_amdgcn_rcpf(ex + 1.f); }
              } else if (lane >= 32) {
#pragma unroll
                  for (int e = 0; e < 8; ++e) o[e] = sigmoidf_(o[e]);
              }
              *(u32x4*)(L + (size_t)row * 384 + 8 * lane) = pack8(o); } }
        { float gq[8], gk[8];
#pragma unroll
          for (int e = 0; e < 8; ++e) { gq[e] = naqg[8 * sub + e] * C2; gk[e] = nakg[8 * sub + e]; }
          for (int i = 0; i < 4; ++i) { const int pl = 4 * C.wave + i, row = row0 + pl, pos = pos0 + pl; const bf16* uc = U + (size_t)row * OD_INP;
            { float x[8]; unpack8(*(const u32x4*)(uc + RW_IN + 8 * lane), x); float ss = 0.f;
#pragma unroll
                for (int e = 0; e < 8; ++e) ss += x[e] * x[e];
                ss = sum8(ss); const float rn = 1.0f / sqrtf(ss * (1.f / 64.f) + EPS);
#pragma unroll
                for (int e = 0; e < 8; ++e) x[e] = x[e] * rn * gq[e];
                *(u32x4*)(QN + ((size_t)(b * 8 + hh) * KPOS + pos) * 64 + 8 * sub) = pack8(x); }
            { float x[8]; unpack8(*(const u32x4*)(uc + RW_IN + 512 + 8 * lane), x); float ss = 0.f;
#pragma unroll
                for (int e = 0; e < 8; ++e) ss += x[e] * x[e];
                ss = sum8(ss); const float rn = 1.0f / sqrtf(ss * (1.f / 64.f) + EPS);
#pragma unroll
                for (int e = 0; e < 8; ++e) x[e] = x[e] * rn * gk[e];
                *(u32x4*)(KN + ((size_t)(b * 8 + hh) * KPOS + pos) * 64 + 8 * sub) = pack8(x); }
            { const u32x4 vv = *(const u32x4*)(uc + RW_IN + 1024 + 8 * lane); const unsigned w4[4] = {vv.x, vv.y, vv.z, vv.w};
#pragma unroll
                for (int e = 0; e < 8; ++e) { const int dv = 8 * sub + e; VL[(hh * 64 + dv) * 32 + pl] = (bf16)((e & 1) ? (w4[e >> 1] >> 16) : (w4[e >> 1] & 0xffffu)); } } } }
#undef PREP_ROWVARS
        __syncthreads();
        { const int hd = C.tid; bf16* dst = VTN + ((size_t)(b * 8 + (hd >> 6)) * 64 + (hd & 63)) * KPOS + pos0;
#pragma unroll
            for (int q = 0; q < 4; ++q) *(u32x4*)(dst + 8 * q) = *(const LAS u32x4*)(VL + hd * 32 + 8 * q); }
        __syncthreads();
    }
}

DI int scan_row(int s, int d, int b) { if (s < LCX) return NLAT + b * LCX + (d ? (LCX - 1 - s) : s); const int t = s - LCX; return b * TL + (d ? (TL - 1 - t) : t); }


constexpr int CCH = 16, NCHK = KPOS / CCH, NPROB = NB * 8 * 2 * NCHK, IMG_ELEMS = 3 * 32 * 16;
template <int N> struct ICk { static constexpr int value = N; };
DI int crow_(int reg, int h) { return (reg & 3) + 8 * (reg >> 2) + 4 * h; }
DI bf16x8 pack_lo8(const f32x16& x) {
    u32x4 p; p.x = pk2(x[0], x[1]); p.y = pk2(x[2], x[3]); p.z = pk2(x[4], x[5]); p.w = pk2(x[6], x[7]); return __builtin_bit_cast(bf16x8, p); }
DI bf16x8 pack_hi8(const f32x16& x) { u32x4 p; p.x = pk2(x[8], x[9]); p.y = pk2(x[10], x[11]); p.z = pk2(x[12], x[13]); p.w = pk2(x[14], x[15]); return __builtin_bit_cast(bf16x8, p); }
DI int perm16(int k) { return (k & ~15) | swap23(k & 15); }

DI void ph_wkv_pre(const Ctx& C, const bf16* R, const bf16* K, const bf16* KK, const unsigned short* LW, const bf16* AR_, const float* ka, bf16* IMG) {
    LAS unsigned char* wl = C.lds + C.wave * 13312;
    LAS bf16* ARl = (LAS bf16*)wl; LAS bf16* BKl = (LAS bf16*)(wl + 4608); LAS float* Ll = (LAS float*)(wl + 9216); LAS bf16* OUT = (LAS bf16*)(wl + 10240);
    const int lane = C.lane, r = lane & 31, h = lane >> 5;
    const int gw = C.vcu * 8 + C.wave, ngw = C.nb * 8;
    for (int p = gw; p < NPROB; p += ngw) {
        const int j = p % NCHK, rest = p / NCHK, d = rest & 1, hh = (rest >> 1) & 7, b = rest >> 4;
        const unsigned short* Wd = LW + (size_t)d * MT * 512; const bf16* Ad = AR_ + (size_t)d * MT * 512;
        const float kav = ka[hh * 64 + lane];
        const int row0 = scan_row(j * CCH, d, b), sg = d ? -1 : 1;
        float lw[16]; bf16 rr[16], kx[16], kkx[16], ax[16];
#pragma unroll
        for (int t = 0; t < 16; ++t) { const size_t off = (size_t)(row0 + sg * t) * 512 + hh * 64 + lane; lw[t] = h2f(Wd[off]); rr[t] = R[off]; kx[t] = K[off]; kkx[t] = KK[off]; ax[t] = Ad[off]; }
        float cum = 0.f, e0 = 1.f;
#pragma unroll
        for (int t = 0; t < 16; ++t) {
            cum += lw[t]; const float e1 = __expf(cum), ei = __builtin_amdgcn_rcpf(e1);
            const float kkv = bf2f(kkx[t]), av = bf2f(ax[t]), keff = bf2f(kx[t]) * (1.f + (av - 1.f) * kav);
            ARl[t * 72 + lane] = f2bf(-kkv * e0); ARl[(16 + t) * 72 + lane] = f2bf(bf2f(rr[t]) * e1);
            BKl[t * 72 + lane] = f2bf(kkv * av * ei); BKl[(16 + t) * 72 + lane] = f2bf(keff * ei);
            e0 = e1;
        }
        asm volatile("s_waitcnt lgkmcnt(0)" ::: "memory");
        f32x16 g;
#pragma unroll
        for (int i = 0; i < 16; ++i) g[i] = 0.f;
#pragma unroll
        for (int q = 0; q < 4; ++q) g = MFMA32(*(const LAS bf16x8*)(ARl + r * 72 + 16 * q + 8 * h), *(const LAS bf16x8*)(BKl + r * 72 + 16 * q + 8 * h), g);
        const int sI = r & 15; const bool isk = r >= 16;
#pragma unroll
        for (int i = 0; i < 16; ++i) {
            const int row = crow_(i, h), t = row & 15; const bool keep = (i < 8) ? (sI < t) : (sI <= t); const float val = keep ? g[i] : 0.f;
            if (i < 8) { if (!isk) { Ll[t * 16 + sI] = val; OUT[512 + row * 16 + perm16(sI)] = 0; } else OUT[row * 16 + sI] = f2bf(val); }
            else       { if (!isk) OUT[512 + row * 16 + perm16(sI)] = f2bf(val); else OUT[row * 16 + sI] = f2bf(val); }
        }
        asm volatile("s_waitcnt lgkmcnt(0)" ::: "memory");
        { const int c = lane & 15; float Pr[16];
            Pr[0] = (c == 0) ? 1.f : 0.f;
#pragma unroll
            for (int t = 1; t < 16; ++t) { const float lrow = Ll[t * 16 + c]; float acc = (c == t) ? 1.f : 0.f;
#pragma unroll
                for (int u = 0; u < t; ++u) acc += rdlane(lrow, u) * Pr[u];
                Pr[t] = acc; }
            if (lane < 16) {
#pragma unroll
                for (int t = 0; t < 16; ++t) { OUT[1024 + t * 16 + perm16(c)] = f2bf(Pr[t]); OUT[1024 + (16 + t) * 16 + c] = 0; } } }
        asm volatile("s_waitcnt lgkmcnt(0)" ::: "memory");
        { bf16* dst = IMG + (size_t)p * IMG_ELEMS;
#pragma unroll
            for (int q = 0; q < 3; ++q) *(u32x4*)(dst + (q * 64 + lane) * 8) = *(const LAS u32x4*)(OUT + (q * 64 + lane) * 8); }
        asm volatile("s_waitcnt lgkmcnt(0)" ::: "memory");
    }
}

DI void ph_wkv_chunk(const Ctx& C, const bf16* R, const bf16* V, const bf16* K, const bf16* KK, const unsigned short* LW, const bf16* AR_, const float* ka, const bf16* IMG, bf16* YS) {
    constexpr int S_AR = 0, S_BKT = 4608, S_VT = 9728, S_VT2 = 11264, S_GC = 12800, S_MM = 13056, S_MRB = 14592, S_PP = 16128, SLOT = 17664, CUMO = 2 * SLOT, YSTO = CUMO + 8192, DEPTH = 4;
    const int lane = C.lane, wv = C.wave, r = lane & 31, h = lane >> 5;
    const bool isE = wv == 2 || wv == 3 || wv == 6 || wv == 7, isS = wv < 2;
    const int te = (wv == 2 ? 0 : (wv == 3 ? 1 : (wv == 6 ? 2 : 3))) * 64 + lane, et = te >> 4, ekq = te & 15;
    const int vhf = te >> 7, vt = (te >> 3) & 15, viq = te & 7;
    const int hf = wv & 1;
    for (int cid0 = C.bid; cid0 < 128; cid0 += C.nb) {
        const int chain = cid0, b = chain >> 4, hh = (chain >> 1) & 7, d = chain & 1;
        const unsigned short* Wd = LW + (size_t)d * MT * 512; const bf16* Ad = AR_ + (size_t)d * MT * 512; bf16* Yd = YS + (size_t)d * MT * 512;
        const bf16* img = IMG + (size_t)(((b * 8 + hh) * 2 + d) * NCHK) * IMG_ELEMS;
        f32x16 ST[2];
#pragma unroll
        for (int i = 0; i < 16; ++i) { ST[0][i] = 0.f; ST[1][i] = 0.f; }
        const f32x4 kav = *(const f32x4*)(ka + hh * 64 + 4 * ekq);
        unsigned ring[DEPTH][16];
        __syncthreads();
        auto issue = [&](int ch, unsigned (&rg)[16]) __attribute__((always_inline)) {
            if (ch < 0 || ch >= NCHK) return;
            const int row0 = scan_row(ch * CCH, d, b), sg = d ? -1 : 1;
            if (isE) {
                const size_t off = (size_t)(row0 + sg * et) * 512 + hh * 64 + 4 * ekq;
                const u32x2 x0 = *(const u32x2*)(R + off), x1 = *(const u32x2*)(K + off), x2 = *(const u32x2*)(KK + off), x3 = *(const u32x2*)(Ad + off);
                const u32x2 x4 = *(const u32x2*)(V + (size_t)(row0 + sg * vt) * 512 + hh * 64 + 32 * vhf + 4 * viq);
                rg[0] = x0.x; rg[1] = x0.y; rg[2] = x1.x; rg[3] = x1.y; rg[4] = x2.x; rg[5] = x2.y; rg[6] = x3.x; rg[7] = x3.y; rg[8] = x4.x; rg[9] = x4.y;
                asm volatile("; wkv issue role E" ::);
            } else if (wv == 4) {
#define W5_(t) rg[(t)] = (unsigned)Wd[(size_t)(row0 + sg * (t)) * 512 + hh * 64 + lane]
                W5_(0); W5_(1); W5_(2); W5_(3); W5_(4); W5_(5); W5_(6); W5_(7); W5_(8); W5_(9); W5_(10); W5_(11); W5_(12); W5_(13); W5_(14); W5_(15);
#undef W5_
                asm volatile("; wkv issue role C" ::);
            } else if (wv == 5) {
#define W6_(q) do { const u32x4 x = *(const u32x4*)(img + (size_t)ch * IMG_ELEMS + ((q) * 64 + lane) * 8); rg[4 * (q)] = x.x; rg[4 * (q) + 1] = x.y; rg[4 * (q) + 2] = x.z; rg[4 * (q) + 3] = x.w; } while (0)
                W6_(0); W6_(1); W6_(2);
#undef W6_
                asm volatile("; wkv issue role V" ::);
            }
        };
        issue(0, ring[0]); issue(1, ring[1]); issue(2, ring[2]); issue(3, ring[3]);
#define WKV_BAR() asm volatile("s_waitcnt lgkmcnt(0)\n\ts_barrier" ::: "memory")
#define WKV_LOOP(...) for (int n0 = -2; n0 < NCHK; n0 += DEPTH) { auto iter = [&](auto kc) __attribute__((always_inline)) { constexpr int kk = decltype(kc)::value; \
            constexpr int riE = (kk + 3) % DEPTH, riW = kk % DEPTH; (void)riE; (void)riW; const int n = n0 + kk; (void)n; __VA_ARGS__; WKV_BAR(); }; iter(ICk<0>{}); iter(ICk<1>{}); iter(ICk<2>{}); iter(ICk<3>{}); }
        if (isS) {
            WKV_LOOP({
                if (n >= 0 && n < NCHK) {
                    const LAS unsigned char* B = C.lds + (n & 1) * SLOT;
                    f32x16 T1;
                    _Pragma("unroll") for (int i = 0; i < 16; ++i) T1[i] = 0.f;
                    _Pragma("unroll") for (int tau = 0; tau < 2; ++tau) {
                        T1 = MFMA32(*(const LAS bf16x8*)(B + S_AR + r * 144 + (32 * tau + 8 * h) * 2), pack_lo8(ST[tau]), T1);
                        T1 = MFMA32(*(const LAS bf16x8*)(B + S_AR + r * 144 + (32 * tau + 16 + 8 * h) * 2), pack_hi8(ST[tau]), T1);
                    }
                    const bf16x8 vtf = *(const LAS bf16x8*)(B + (hf ? S_VT2 : S_VT) + r * 48 + 16 * h);
                    T1 = MFMA32(*(const LAS bf16x8*)(B + S_MM + r * 48 + 16 * h), vtf, T1);
                    f32x16 ET;
                    _Pragma("unroll") for (int i = 0; i < 16; ++i) ET[i] = 0.f;
                    ET = MFMA32(*(const LAS bf16x8*)(B + S_PP + r * 48 + 16 * h), pack_lo8(T1), ET);
                    const bf16x8 ef = pack_lo8(ET);
                    T1 = MFMA32(*(const LAS bf16x8*)(B + S_MRB + r * 48 + 16 * h), ef, T1);
                    _Pragma("unroll") for (int tau = 0; tau < 2; ++tau) {
                        ST[tau] = MFMA32(*(const LAS bf16x8*)(B + S_BKT + (32 * tau + r) * 80 + 16 * h), ef, ST[tau]);
                        ST[tau] = MFMA32(*(const LAS bf16x8*)(B + S_BKT + (32 * tau + r) * 80 + 32 + 16 * h), vtf, ST[tau]);
                        _Pragma("unroll") for (int g4 = 0; g4 < 4; ++g4) { const f32x4 gc = *(const LAS f32x4*)(B + S_GC + (32 * tau + 8 * g4 + 4 * h) * 4);
                            ST[tau][4 * g4] *= gc.x; ST[tau][4 * g4 + 1] *= gc.y; ST[tau][4 * g4 + 2] *= gc.z; ST[tau][4 * g4 + 3] *= gc.w; }
                    }
                    LAS float* ys = (LAS float*)(C.lds + YSTO) + ((n & 1) * 2 + hf) * 512;
                    _Pragma("unroll") for (int q = 0; q < 8; ++q) ys[(8 * (q >> 2) + 4 * h + (q & 3)) * 32 + r] = T1[8 + q];
                }
            });
        } else if (isE) {
            WKV_LOOP({
                const int ch = n + 1;
                if (ch >= 0) {
                    if (ch < NCHK) {
                        LAS unsigned char* B = C.lds + (ch & 1) * SLOT; const LAS float* ec = (const LAS float*)(C.lds + CUMO) + (ch & 1) * 1024;
                        const f32x4 e1 = *(const LAS f32x4*)(ec + et * 64 + 4 * ekq);
                        f32x4 e0 = {1.f, 1.f, 1.f, 1.f}; if (et > 0) e0 = *(const LAS f32x4*)(ec + (et - 1) * 64 + 4 * ekq);
                        const float rv[4] = {bflo(ring[riE][0]), bfhi(ring[riE][0]), bflo(ring[riE][1]), bfhi(ring[riE][1])}; const float kv[4] = {bflo(ring[riE][2]), bfhi(ring[riE][2]), bflo(ring[riE][3]), bfhi(ring[riE][3])};
                        const float kkv[4] = {bflo(ring[riE][4]), bfhi(ring[riE][4]), bflo(ring[riE][5]), bfhi(ring[riE][5])}; const float av[4] = {bflo(ring[riE][6]), bfhi(ring[riE][6]), bflo(ring[riE][7]), bfhi(ring[riE][7])};
                        float ah[4]; float rh[4]; float bc[4]; float kc4[4];
                        _Pragma("unroll") for (int e = 0; e < 4; ++e) { const float ei = __builtin_amdgcn_rcpf(e1[e]);
                            ah[e] = -kkv[e] * e0[e]; rh[e] = rv[e] * e1[e]; bc[e] = kkv[e] * av[e] * ei; kc4[e] = kv[e] * (1.f + (av[e] - 1.f) * kav[e]) * ei; }
                        const int pk = perm16(4 * ekq);
                        *(LAS u32x2*)((LAS bf16*)(B + S_AR) + et * 72 + pk) = (u32x2){pk2(ah[0], ah[1]), pk2(ah[2], ah[3])};
                        *(LAS u32x2*)((LAS bf16*)(B + S_AR) + (16 + et) * 72 + pk) = (u32x2){pk2(rh[0], rh[1]), pk2(rh[2], rh[3])};
                        const int pt = perm16(et);
                        _Pragma("unroll") for (int e = 0; e < 4; ++e) { ((LAS bf16*)(B + S_BKT))[(4 * ekq + e) * 40 + pt] = f2bf(bc[e]); ((LAS bf16*)(B + S_BKT))[(4 * ekq + e) * 40 + 16 + et] = f2bf(kc4[e]); }
                        if (et == 15) *(LAS f32x4*)((LAS float*)(B + S_GC) + 4 * ekq) = e1;
                        LAS bf16* vtp = (LAS bf16*)(B + (vhf ? S_VT2 : S_VT)) + (4 * viq) * 24 + vt;
                        vtp[0] = (bf16)(ring[riE][8] & 0xffffu); vtp[24] = (bf16)(ring[riE][8] >> 16); vtp[48] = (bf16)(ring[riE][9] & 0xffffu); vtp[72] = (bf16)(ring[riE][9] >> 16);
                    }
                    issue(ch + DEPTH, ring[riE]);
                }
            });
        } else if (wv == 4) {
            WKV_LOOP({
                const int ch = n + 2;
                if (ch < NCHK) { LAS float* ec = (LAS float*)(C.lds + CUMO) + (ch & 1) * 1024; float c = 0.f;
#define C5_(t) do { c += h2f((unsigned short)ring[riW][(t)]); ec[(t) * 64 + lane] = __expf(c); } while (0)
                    C5_(0); C5_(1); C5_(2); C5_(3); C5_(4); C5_(5); C5_(6); C5_(7); C5_(8); C5_(9); C5_(10); C5_(11); C5_(12); C5_(13); C5_(14); C5_(15);
                }
                issue(ch + DEPTH, ring[riW]);
            });
        } else {
            WKV_LOOP({
                { const int chy = n - 1;
                  if (chy >= 0 && chy < NCHK) { const int yh = lane >> 5, yt = (lane & 31) >> 1, yi = 16 * (lane & 1);
                    const LAS float* ys = (const LAS float*)(C.lds + YSTO) + ((chy & 1) * 2 + yh) * 512 + yt * 32 + yi;
                    bf16* dst = Yd + (size_t)(scan_row(chy * CCH, d, b) + (d ? -1 : 1) * yt) * 512 + hh * 64 + 32 * yh + yi;
                    _Pragma("unroll") for (int q = 0; q < 2; ++q) { const f32x4 a0 = *(const LAS f32x4*)(ys + 8 * q); const f32x4 a1 = *(const LAS f32x4*)(ys + 8 * q + 4);
                        *(u32x4*)(dst + 8 * q) = (u32x4){pk2(a0.x, a0.y), pk2(a0.z, a0.w), pk2(a1.x, a1.y), pk2(a1.z, a1.w)}; } } }
                const int ch = n + 1;
                if (ch >= 0) {
                    if (ch < NCHK) { LAS unsigned char* B = C.lds + (ch & 1) * SLOT;
                        const int irow = lane >> 1; const int ihv = lane & 1;
                        *(LAS u32x4*)(B + S_MM + irow * 48 + ihv * 16) = (u32x4){ring[riE][0], ring[riE][1], ring[riE][2], ring[riE][3]};
                        *(LAS u32x4*)(B + S_MRB + irow * 48 + ihv * 16) = (u32x4){ring[riE][4], ring[riE][5], ring[riE][6], ring[riE][7]};
                        *(LAS u32x4*)(B + S_PP + irow * 48 + ihv * 16) = (u32x4){ring[riE][8], ring[riE][9], ring[riE][10], ring[riE][11]};
                    }
                    issue(ch + DEPTH, ring[riE]);
                }
            });
        }
#undef C5_
#undef WKV_LOOP
#undef WKV_BAR
    }
}

DI void ph_post(const Ctx& C, const bf16* YS, const bf16* R, const bf16* V, const bf16* K, const bf16* A2, const float* ka, const bf16* G, const float* rk, const float* gng, const float* gnb, bf16* OCAT, bool last) {
    const int gw = C.bid * 8 + C.wave, ngw = C.nb * 8, lane = C.lane, nrows = last ? NLAT : MT;
    for (int row = gw; row < nrows; row += ngw) {
        const size_t o = (size_t)row * 512 + 8 * lane;
        float y[8], y1[8]; unpack8(*(const u32x4*)(YS + o), y); unpack8(*(const u32x4*)(YS + (size_t)MT * 512 + o), y1);
#pragma unroll
        for (int e = 0; e < 8; ++e) y[e] += y1[e];
        float r[8], v[8], kx[8], a0[8], a1[8], g[8];
        unpack8(*(const u32x4*)(R + o), r); unpack8(*(const u32x4*)(V + o), v); unpack8(*(const u32x4*)(K + o), kx); unpack8(*(const u32x4*)(A2 + o), a0); unpack8(*(const u32x4*)(A2 + (size_t)MT * 512 + o), a1); unpack8(*(const u32x4*)(G + o), g);
        float bsum = 0.f;
#pragma unroll
        for (int e = 0; e < 8; ++e) { const float kae = ka[8 * lane + e]; bsum += r[e] * (kx[e] * (1.f + (a0[e] - 1.f) * kae) + kx[e] * (1.f + (a1[e] - 1.f) * kae)) * rk[8 * lane + e]; }
        bsum = sum8(bsum);
        float s = 0.f;
#pragma unroll
        for (int e = 0; e < 8; ++e) { y[e] += bsum * v[e]; s += y[e]; }
        const float mu = sum8(s) * (1.f / 64.f); float s2 = 0.f;
#pragma unroll
        for (int e = 0; e < 8; ++e) { y[e] -= mu; s2 += y[e] * y[e]; }
        const float rstd = 1.0f / sqrtf(sum8(s2) * (1.f / 64.f) + GN_EPS);
        float out[8];
#pragma unroll
        for (int e = 0; e < 8; ++e) out[e] = (y[e] * rstd * gng[8 * lane + e] + gnb[8 * lane + e]) * g[e];
        *(u32x4*)(OCAT + (size_t)row * DM + 8 * lane) = pack8(out);
    }
}

DI void ph_topk2(const Ctx& C, const float* AFFT, const float* AFFC, int* ROWS, float* GATE, int* SLOT, bool last) {
    LAS unsigned* wcnt = (LAS unsigned*)C.lds;
    LAS unsigned* cnt = wcnt + 16;
    const int tid = C.tid, nprob = last ? 128 : 256;
    for (int p = C.bid; p < nprob; p += C.nb) {
        const bool isctx = p >= 128; const int be = p & 127, b = be >> 4, e = be & 15;
        const int n = isctx ? LCX : TL, cap = isctx ? CAPC : CAPL;
        const float* src = isctx ? AFFC + (size_t)be * LCX : AFFT + (size_t)be * TL;
        unsigned v[8]; const int per = isctx ? 1 : 8, t0 = tid * per;
#pragma unroll
        for (int q = 0; q < 8; ++q) v[q] = 0u;
        if (!isctx) { const u32x4 a0 = *(const u32x4*)(src + t0), a1 = *(const u32x4*)(src + t0 + 4); v[0] = a0.x; v[1] = a0.y; v[2] = a0.z; v[3] = a0.w; v[4] = a1.x; v[5] = a1.y; v[6] = a1.z; v[7] = a1.w; }
        else if (tid < LCX) v[0] = __builtin_bit_cast(unsigned, src[tid]);
        __syncthreads();
        unsigned T = 0u;
        for (int bit = 30; bit >= 0; --bit) {
            const unsigned cand = T | (1u << bit); unsigned c = 0u;
#pragma unroll
            for (int q = 0; q < 8; ++q) c += (unsigned)__builtin_popcountll(__builtin_amdgcn_ballot_w64(v[q] >= cand));
            LAS unsigned* wc = wcnt + (bit & 1) * 8;
            if (C.lane == 0) wc[C.wave] = c;
            __syncthreads();
            const unsigned tot = wc[0] + wc[1] + wc[2] + wc[3] + wc[4] + wc[5] + wc[6] + wc[7];
            if (tot >= (unsigned)cap) T = cand;
        }
        unsigned myc = 0u;
#pragma unroll
        for (int q = 0; q < 8; ++q) myc += (v[q] > T ? 0x10000u : 0u) + ((v[q] == T && (isctx ? (q == 0 && tid < LCX) : true)) ? 1u : 0u);
        __syncthreads();
        cnt[tid] = myc;
        __syncthreads();
        for (int off = 1; off < 512; off <<= 1) { const unsigned add = tid >= off ? cnt[tid - off] : 0u; __syncthreads(); cnt[tid] += add; __syncthreads(); }
        const unsigned total = cnt[511], keq = (unsigned)cap - (total >> 16);
        unsigned before = cnt[tid] - myc;
        for (int q = 0; q < per; ++q) { const int t = t0 + q; if (t >= n) break; const unsigned x = v[q]; const unsigned gtb = before >> 16, eqb = before & 0xFFFFu;
            const bool sel = x > T || (x == T && eqb < keq);
            if (sel) { const int jx = (int)(gtb + (eqb < keq ? eqb : keq));
                const int slot = isctx ? NB * CAPL + b * CAPC + jx : b * CAPL + jx, row = isctx ? NLAT + b * LCX + t : b * TL + t;
                ROWS[e * ESLOTS + slot] = row; GATE[e * ESLOTS + slot] = __builtin_bit_cast(float, x); SLOT[(size_t)row * 16 + e] = slot; }
            before += (x > T ? 0x10000u : 0u) + (x == T ? 1u : 0u); }
        __syncthreads();
    }
}


DI void ph_combine(const Ctx& C, float* xlat, float* xctx, const float* modg2  , const int* SLOT, const bf16* Y2, bool last,
                   const float* ngain  , const float* nmod  , bf16* H) {
    const int gw = C.bid * 8 + C.wave, ngw = C.nb * 8, lane = C.lane, nrows = last ? NLAT : MT;
    int sv_next = (gw < nrows) ? SLOT[(size_t)gw * 16 + (lane & 15)] : -1;
    for (int row = gw; row < nrows; row += ngw) {
        float* xr = row < NLAT ? xlat + (size_t)row * DM : xctx + (size_t)(row - NLAT) * DM;
        const int mi = row < NLAT ? (row >> 12) : 8;
        const int sv = sv_next;
        if (row + ngw < nrows) sv_next = SLOT[(size_t)(row + ngw) * 16 + (lane & 15)];
        f32x4 xv[4], gv[4];
#pragma unroll
        for (int j = 0; j < 4; ++j) { const int c = 256 * j + 4 * lane; gv[j] = *(const f32x4*)(modg2 + mi * 6144 + c); xv[j] = *(const f32x4*)(xr + c); }
        f32x4 acc[4];
#pragma unroll
        for (int j = 0; j < 4; ++j) acc[j] = (f32x4){0.f, 0.f, 0.f, 0.f};
        unsigned mask = (unsigned)__builtin_amdgcn_ballot_w64(sv >= 0) & 0xffffu;
        while (mask) {
            const bf16* yp[4]; float m[4];
            { const int e0 = __builtin_ctz(mask); mask &= mask - 1u; const int s0 = __builtin_amdgcn_readlane(sv, e0); yp[0] = Y2 + ((size_t)e0 * ESLOTS + s0) * DM + 4 * lane; m[0] = 1.f; }
#pragma unroll
            for (int k = 1; k < 4; ++k) {
                if (mask) { const int ek = __builtin_ctz(mask); mask &= mask - 1u; const int sk = __builtin_amdgcn_readlane(sv, ek); yp[k] = Y2 + ((size_t)ek * ESLOTS + sk) * DM + 4 * lane; m[k] = 1.f; }
                else { yp[k] = yp[0]; m[k] = 0.f; } }
            u32x2 w[4][4];
#pragma unroll
            for (int k = 0; k < 4; ++k)
#pragma unroll
                for (int j = 0; j < 4; ++j) w[k][j] = *(const u32x2*)(yp[k] + 256 * j);
#pragma unroll
            for (int k = 0; k < 4; ++k)
#pragma unroll
                for (int j = 0; j < 4; ++j) acc[j] += m[k] * (f32x4){bflo(w[k][j].x), bfhi(w[k][j].x), bflo(w[k][j].y), bfhi(w[k][j].y)};
        }
#pragma unroll
        for (int j = 0; j < 4; ++j) { const int c = 256 * j + 4 * lane; f32x4 x = xv[j]; x += gv[j] * acc[j]; *(f32x4*)(xr + c) = x; acc[j] = x; }
        if (ngain) {
            float ss = 0.f;
#pragma unroll
            for (int j = 0; j < 4; ++j) ss += acc[j].x * acc[j].x + acc[j].y * acc[j].y + acc[j].z * acc[j].z + acc[j].w * acc[j].w;
            const float rs = 1.0f / sqrtf(wave_sum(ss) * (1.f / 1024.f) + EPS);
            const float* mp = nmod + mi * 6144;
#pragma unroll
            for (int j = 0; j < 4; ++j) { const int c = 256 * j + 4 * lane;
                const f32x4 g = *(const f32x4*)(ngain + c), sc = *(const f32x4*)(mp + 1024 + c), sh = *(const f32x4*)(mp + c);
                const f32x4 hv = (acc[j] * rs) * g * (sc + 1.0f) + sh;
                *(u32x2*)(H + (size_t)row * DM + c) = (u32x2){pk2(hv.x, hv.y), pk2(hv.z, hv.w)}; }
        }
    }
}

template <int N> struct IC { static constexpr int value = N; };
DI const float* in_ptr(const unsigned char* ws, int k) { const unsigned long long v = ((const unsigned long long*)(ws + 128 * 1024))[k];
    const unsigned lo = __builtin_amdgcn_readfirstlane((unsigned)v), hi = __builtin_amdgcn_readfirstlane((unsigned)(v >> 32));
    return (const float*)(__attribute__((address_space(1))) const float*)(((unsigned long long)hi << 32) | lo); }
template <class T> DI T* launder_ptr(T* p) { unsigned long long v = (unsigned long long)p; unsigned lo = (unsigned)v, hi = (unsigned)(v >> 32); asm volatile("" : "+v"(lo), "+v"(hi));
    lo = __builtin_amdgcn_readfirstlane(lo); hi = __builtin_amdgcn_readfirstlane(hi); return (T*)(__attribute__((address_space(1))) T*)(((unsigned long long)hi << 32) | lo); }
constexpr int N_PHASES = 1 + 23 + 22;
constexpr size_t WS_PTRS = 128 * 1024;
#define P_XC    ((float*)(ws + WS_XC))
#define P_MOD   ((const float*)(ws + WS_MOD))
#define P_HB    ((bf16*)(ws + WS_HB))
#define P_OCAT  ((bf16*)(ws + WS_OCAT))
#define P_AR    (ws + WS_ARENA)
#define P_ROWS  ((int*)(ws + WS_ROWS))
#define P_GATE  ((float*)(ws + WS_GATE))
#define P_SLOT  ((int*)(ws + WS_SLOT))
#define P_AFFT  ((float*)(ws + WS_AFFT))
#define P_AFFC  ((float*)(ws + WS_AFFC))
#define P_W13   ((bf16*)(ws + WS_W13))
#define P_W2    ((bf16*)(ws + WS_W2))
#define P_U     ((bf16*)(P_AR + A_U))
#define P_QPRE  ((float*)(P_AR + A_QPRE))
#define P_KVPRE ((float*)(P_AR + A_KVPRE))
#define P_QB    ((bf16*)(P_AR + A_QB))
#define P_KB    ((bf16*)(P_AR + A_KB))
#define P_VT    ((bf16*)(P_AR + A_VT))
#define P_W     ((unsigned short*)(P_AR + A_W))
#define P_KEFF  ((bf16*)(P_AR + A_KEFF))
#define P_R     ((bf16*)(P_AR + A_R))
#define P_V     ((bf16*)(P_AR + A_V))
#define P_KK    ((bf16*)(P_AR + A_KK))
#define P_G     ((bf16*)(P_AR + A_G))
#define P_K     ((bf16*)(P_AR + A_K))
#define P_L     ((bf16*)(P_AR + A_L))
#define P_QN    ((bf16*)(P_AR + A_QN))
#define P_KN    ((bf16*)(P_AR + A_KN))
#define P_VTN   ((bf16*)(P_AR + A_VTN))
#define P_YS    ((bf16*)(P_AR + A_YS))
#define P_IMG   ((bf16*)(P_AR + A_IMG))
#define P_HID   ((bf16*)(P_AR + A_HID))
#define P_Y2    ((bf16*)(P_AR + A_Y2))
#define MODL(i) (P_MOD + (size_t)(i) * 9 * 6144)
#if MOE_F8
#define MOE1_PHASE(NMT) do { pg8::Gemm g{P_HB, P_W13, DM / 2, DM / 2, P_ROWS, SCALE_W, SCALE_ONE}; pg8::OrderMoE S{(NMT), 8, 17, C.nb, C.vcu}; pg8::EpiAdapt<EpiGlu8> E{EpiGlu8{(unsigned char*)P_HID}}; \
        pg8::gemm_phase<pg8::EpiAdapt<EpiGlu8>, pg8::OrderMoE, true>(C.lds, g, S, E, C.tid); } while (0)
#define MOE2_PHASE(NMT) do { pg8::Gemm g{P_HID, P_W2, DM / 2, DM / 2, nullptr, SCALE_W, SCALE_HID}; pg8::OrderMoE S{(NMT), 4, 17, C.nb, C.vcu}; pg8::EpiAdapt<EpiGate> E{EpiGate{P_Y2, P_GATE}}; \
        pg8::gemm_phase<pg8::EpiAdapt<EpiGate>, pg8::OrderMoE, true>(C.lds, g, S, E, C.tid); } while (0)
#else
#define MOE1_PHASE(NMT) do { pg8::Gemm g{P_HB, P_W13, DM, DM, P_ROWS}; pg8::OrderMoE S{(NMT), 8, 17, C.nb, C.vcu}; pg8::EpiAdapt<EpiGlu> E{EpiGlu{P_HID}}; pg8::gemm_phase(C.lds, g, S, E, C.tid); } while (0)
#define MOE2_PHASE(NMT) do { pg8::Gemm g{P_HID, P_W2, DM, DM, nullptr}; pg8::OrderMoE S{(NMT), 4, 17, C.nb, C.vcu}; pg8::EpiAdapt<EpiGate> E{EpiGate{P_Y2, P_GATE}}; pg8::gemm_phase(C.lds, g, S, E, C.tid); } while (0)
#endif
#define WPREP_TAIL(NUNITS, LAYER) do { __syncthreads(); const int extra_ = (NUNITS) % C.nb, j_ = C.vcu - extra_; const size_t wo_ = (size_t)(LAYER) * NEXP * DM * DM; \
        if (j_ >= 0) wprep_span(C, j_ * 8 + C.wave, (C.nb - extra_) * 8, in_ptr(ws, I_MW1) + wo_, in_ptr(ws, I_MW3) + wo_, in_ptr(ws, I_MW2) + wo_, (bf16*)(ws + WS_W13), (bf16*)(ws + WS_W2)); } while (0)
#define RELAUNDER() do { int l_ = C.lane; asm volatile("" : "+v"(l_)); C.lane = l_; C.tid = (C.wave << 6) | l_; } while (0)
__global__ void __launch_bounds__(512, 2) fwd_kernel(Args a) {
    extern __shared__ __attribute__((aligned(16))) unsigned char smem[];
    Ctx C0; C0.lds = (LAS unsigned char*)smem; C0.tid = threadIdx.x; C0.lane = C0.tid & 63; C0.wave = __builtin_amdgcn_readfirstlane(C0.tid >> 6); C0.bid = blockIdx.x; C0.nb = gridDim.x;
    C0.vcu = (C0.nb % 8 == 0) ? (C0.bid % 8) * (C0.nb / 8) + C0.bid / 8 : C0.bid;
    volatile LAS unsigned* bst = (volatile LAS unsigned*)(C0.lds + LDS_BYTES - 16);
#if MEGA
    if (C0.tid == 0) { bst[0] = 0u; bst[1] = 0u; }
    __syncthreads();
    const unsigned bar_x = xcd_barrier_post((unsigned*)(a.ws + WS_CTL) + 4096, bst, C0.tid == 0).x;
#define SEAM() do { if (ph < hi) { XcdBarrier b2_; b2_.bar = (unsigned*)(ws + WS_CTL) + 4096; b2_.x = bar_x; b2_.st = bst; xcd_barrier(b2_, C.tid == 0); } } while (0)
#else
#define SEAM() do { } while (0)
#endif
#if MEGA
    constexpr int lo = 0, hi = N_PHASES;
#else
    const int lo = a.ph_lo, hi = a.ph_hi;
#endif
    int ph = 0;
#ifndef ONLY
#define ONLY -1
#endif
#ifndef REPMASK
#define REPMASK 0
#endif
#ifndef SITE_LO
#define SITE_LO 0
#define SITE_HI 99
#endif
#define PHASE(SITE, ...) do { if ((ONLY < 0 || ONLY == (SITE)) && (SITE) >= SITE_LO && (SITE) <= SITE_HI && ph >= lo && ph < hi) { Ctx C; C.lds = C0.lds; \
        { int w_ = C0.wave; asm volatile("" : "+s"(w_)); unsigned m_ = ~0u; asm volatile("" : "+s"(m_)); int l_ = (int)__builtin_amdgcn_mbcnt_hi(m_, __builtin_amdgcn_mbcnt_lo(m_, 0u)); C.wave = w_; C.lane = l_; C.tid = (w_ << 6) | l_; } \
        { int b_ = C0.bid, n_ = C0.nb, v_ = C0.vcu; asm volatile("" : "+s"(b_), "+s"(n_), "+s"(v_)); C.bid = b_; C.nb = n_; C.vcu = v_; } \
        unsigned z_ = 0u; asm volatile("" : "+s"(z_)); unsigned char* ws = a.ws + z_; float* XL = a.out + z_; const int lq = __builtin_amdgcn_readfirstlane(lp); typedef const __attribute__((address_space(1))) float* gfp_t; const gfp_t* INT_ = (const gfp_t*)(ws + WS_PTRS); (void)INT_; (void)XL; (void)lq; \
        for (int rep_ = 0; rep_ < ((((REPMASK) >> (SITE)) & 1) ? 2 : 1); ++rep_) { __VA_ARGS__; if ((((REPMASK) >> (SITE)) & 1)) __syncthreads(); } ++ph; SEAM(); } else ++ph; } while (0)

    { const int lp = 0;
      PHASE(0, { if (C.bid == 0) { _Pragma("unroll") for (int k = 0; k < 40; ++k) if (C.tid == k) ((const float**)(ws + WS_PTRS))[k] = a.in[k]; }
                 ph_prologue(C, a); }); }

    auto layer_pair = [&](auto lpc) __attribute__((always_inline)) {
        constexpr int lp = decltype(lpc)::value;
        if constexpr (lp == 0) PHASE(1, { const int i = 2 * lq; const float* xl = (i == 0) ? in_ptr(ws, I_X) : XL; const float* xc = (i == 0) ? in_ptr(ws, I_CTX) : P_XC;
                   ph_norm<false>(C, xl, xc, in_ptr(ws, I_N1G) + i * DM, MODL(i), 0, 1024, P_HB, nullptr, nullptr, nullptr, nullptr); });
        PHASE(2, { EpiBf16 E{P_U, EV_INP}; fast_gemm(C, P_HB, DM, (const bf16*)(ws + WS_WEVIN) + (size_t)lq * EV_INP * DM, DM, MT / 256, EV_INP / 256, E); });
        PHASE(3, { EpiBf16 Eq{(bf16*)P_QPRE, 768}; fast_gemm(C, P_U, EV_INP, (const bf16*)(ws + WS_WUQ) + (size_t)lq * 768 * 384, 384, MT / 256, 3, Eq); RELAUNDER();
                   EpiBf16 Ek{(bf16*)P_KVPRE, 1024}; fast_gemm(C, P_U + 384, EV_INP, (const bf16*)(ws + WS_WUKV) + (size_t)lq * 1024 * 256, 256, MT / 256, 4, Ek, true); });
        PHASE(4, { ph_mla_fin(C, P_U, (const bf16*)P_QPRE, (const bf16*)P_KVPRE, in_ptr(ws, I_QG) + lq * 96, in_ptr(ws, I_KG) + lq * 96, (const f32x2*)(ws + WS_ROPE), P_QB, P_KB, P_VT);
                   const int extra_ = (MT / 64) % C.nb, j_ = C.vcu - extra_;
                   if (j_ >= 0) { for (int q_ = 0; q_ < CONV_PER_TAIL; ++q_) { const int cu_ = j_ + q_ * (C.nb - extra_); if (cu_ >= conv_in_fin(C.nb)) break;
                       float wk[31]; const float* dww = in_ptr(ws, I_DWW) + (size_t)lq * 31 * 512;
                       _Pragma("unroll") for (int kt = 0; kt < 31; ++kt) wk[kt] = dww[kt * 512 + C.tid];
                       conv_unit(C, cu_, P_U, wk, in_ptr(ws, I_DWB)[lq * 512 + C.tid], in_ptr(ws, I_LNG) + lq * 512, in_ptr(ws, I_LNB) + lq * 512, P_OCAT); } } });
        PHASE(5, ph_attn_mla2(C, P_QB, P_KB, P_VT, P_OCAT, false, ws, lq));
        PHASE(6, { const int i = 2 * lq; const float* xl = (i == 0) ? in_ptr(ws, I_X) : XL; const float* xc = (i == 0) ? in_ptr(ws, I_CTX) : P_XC;
                   { EpiResid E{xl, xc, XL, P_XC, MODL(i) + 2048}; fast_gemm(C, P_OCAT, DM, (const bf16*)(ws + WS_WEVOUT) + (size_t)lq * DM * DM, DM, MT / 256, 4, E); }
                   WPREP_TAIL(MT / 256 * 4, i); });
        PHASE(7, { const int i = 2 * lq; ph_norm<true>(C, XL, P_XC, in_ptr(ws, I_N2G) + i * DM, MODL(i), 3072, 4096, P_HB, in_ptr(ws, I_ROUTER) + (size_t)i * DM * 16, P_AFFT, P_AFFC, P_SLOT); });
        PHASE(8, ph_topk2(C, P_AFFT, P_AFFC, P_ROWS, P_GATE, P_SLOT, false));
        PHASE(9, { MOE1_PHASE(17); });
        PHASE(10, { MOE2_PHASE(17); });
        PHASE(11, { const int i = 2 * lq; ph_combine(C, XL, P_XC, MODL(i) + 5120, P_SLOT, P_Y2, false, in_ptr(ws, I_N1G) + (i + 1) * DM, MODL(i + 1), P_HB); });
        PHASE(13, { EpiBf16 E{P_U, OD_INP}; fast_gemm(C, P_HB, DM, (const bf16*)(ws + WS_WODIN) + (size_t)lq * OD_INP * DM, DM, MT / 256, OD_INP / 256, E); });
        PHASE(14, ph_prep(C, P_U, in_ptr(ws, I_SHIFTW) + (size_t)lq * 3 * RW_IN, in_ptr(ws, I_KKW) + lq * 512, in_ptr(ws, I_NAQG) + lq * 64, in_ptr(ws, I_NAKG) + lq * 64, P_R, P_V, P_K, P_KK, P_L, P_QN, P_KN, P_VTN));
        PHASE(15, { const bf16* WL = (const bf16*)(ws + WS_WLORA) + (size_t)lq * 655360;
                    { EpiLoraW E{P_W, in_ptr(ws, I_W0) + lq * 1024}; fast_gemm(C, P_L, 384, WL, 256, MT / 256, 4, E); } RELAUNDER();
                    { EpiLoraA E{P_KEFF, in_ptr(ws, I_A0) + lq * 1024}; fast_gemm(C, P_L, 384, WL + (size_t)1024 * 256, 256, MT / 256, 4, E, true); } RELAUNDER();
                    { EpiBf16 E{P_G, 512}; fast_gemm(C, P_L + 128, 384, WL + (size_t)2048 * 256, 256, MT / 256, 2, E); } });
        PHASE(16, ph_wkv_pre(C, P_R, P_K, P_KK, P_W, P_KEFF, in_ptr(ws, I_KA) + lq * 512, P_IMG));
        PHASE(17, { ph_wkv_chunk(C, P_R, P_V, P_K, P_KK, P_W, P_KEFF, in_ptr(ws, I_KA) + lq * 512, P_IMG, P_YS); __syncthreads();
                    ph_natten2(C, P_QN, P_KN, P_VTN, P_OCAT, in_ptr(ws, I_RPB) + (size_t)lq * 8 * 465, lq == 1, (unsigned*)(ws + WS_CTL) + 8192 + 64 * lq, ws, lq); });
        PHASE(18, ph_post(C, P_YS, P_R, P_V, P_K, P_KEFF, in_ptr(ws, I_KA) + lq * 512, P_G, in_ptr(ws, I_RK) + lq * 512, in_ptr(ws, I_GNG) + lq * 512, in_ptr(ws, I_GNB) + lq * 512, P_OCAT, lq == 1));
        PHASE(19, { const int i = 2 * lq + 1; EpiResid E{XL, P_XC, XL, P_XC, MODL(i) + 2048};
                    fast_gemm(C, P_OCAT, DM, (const bf16*)(ws + WS_WODOUT) + (size_t)lq * DM * DM, DM, (lq == 1) ? NLAT / 256 : MT / 256, 4, E);
                    WPREP_TAIL(((lq == 1) ? NLAT / 256 : MT / 256) * 4, i); });
        PHASE(20, { const int i = 2 * lq + 1; ph_norm<true>(C, XL, P_XC, in_ptr(ws, I_N2G) + i * DM, MODL(i), 3072, 4096, P_HB, in_ptr(ws, I_ROUTER) + (size_t)i * DM * 16, P_AFFT, P_AFFC, P_SLOT); });
        PHASE(21, ph_topk2(C, P_AFFT, P_AFFC, P_ROWS, P_GATE, P_SLOT, lq == 1));
        PHASE(22, { MOE1_PHASE((lq == 1) ? 16 : 17); });
        PHASE(23, { MOE2_PHASE((lq == 1) ? 16 : 17); });
        PHASE(24, { const int i = 2 * lq + 1;
                    if (lp == 0) ph_combine(C, XL, P_XC, MODL(i) + 5120, P_SLOT, P_Y2, false, in_ptr(ws, I_N1G) + (i + 1) * DM, MODL(i + 1), P_HB);
                    else ph_combine(C, XL, P_XC, MODL(i) + 5120, P_SLOT, P_Y2, true, nullptr, nullptr, nullptr); });
    };
    layer_pair(IC<0>{}); layer_pair(IC<1>{});
}

extern "C" void kernel_launch(void* const* d_in, const int* in_sizes, int n_in, void* d_out, int out_size, void* d_ws, size_t ws_size, hipStream_t stream) {
    static int grid = 0;
    if (grid == 0) {
        if (n_in != 40 || out_size != NLAT * DM || ws_size < WS_END) { fprintf(stderr, "kernel_launch: unexpected shapes (n_in %d out %d ws %zu need %zu)\n", n_in, out_size, ws_size, (size_t)WS_END); grid = -1; return; }
        int dev = 0, cus = 0, per_cu = 0;
        if (hipGetDevice(&dev) != hipSuccess || hipDeviceGetAttribute(&cus, hipDeviceAttributeMultiprocessorCount, dev) != hipSuccess) { grid = -1; return; }
        if (hipFuncSetAttribute((const void*)fwd_kernel, hipFuncAttributeMaxDynamicSharedMemorySize, LDS_BYTES) != hipSuccess) { fprintf(stderr, "kernel_launch: hipFuncSetAttribute failed\n"); grid = -1; return; }
        if (hipOccupancyMaxActiveBlocksPerMultiprocessor(&per_cu, (const void*)fwd_kernel, 512, LDS_BYTES) != hipSuccess || per_cu < 1) { fprintf(stderr, "kernel_launch: occupancy query says %d\n", per_cu); per_cu = 1; }
        (void)hipGetLastError();
        grid = cus;
    }
    if (grid < 0) return;
    (void)hipMemsetAsync((char*)d_ws + WS_CTL, 0, CTL_BYTES, stream);
    Args a{};
    for (int i = 0; i < 40; ++i) a.in[i] = (const float*)d_in[i];
    a.out = (float*)d_out; a.ws = (unsigned char*)d_ws;
#if MEGA
    a.ph_lo = 0; a.ph_hi = N_PHASES;
    hipLaunchKernelGGL(fwd_kernel, dim3(grid), dim3(512), LDS_BYTES, stream, a);
#else
    for (int p = 0; p < N_PHASES; ++p) { a.ph_lo = p; a.ph_hi = p + 1; hipLaunchKernelGGL(fwd_kernel, dim3(grid), dim3(512), LDS_BYTES, stream, a); }
#endif
}
```

```cpp
#include <hip/hip_runtime.h>
#include <cstdio>
#include <cstdint>

#ifndef MEGA
#define MEGA 1
#endif

#define LAS __attribute__((address_space(3)))
#define DI __device__ __forceinline__

typedef unsigned short bf16;
typedef short bf16x8 __attribute__((ext_vector_type(8)));
typedef float f32x4 __attribute__((ext_vector_type(4)));
typedef float f32x2 __attribute__((ext_vector_type(2)));
typedef float f32x16 __attribute__((ext_vector_type(16)));
typedef unsigned u32x4 __attribute__((ext_vector_type(4)));
typedef unsigned u32x2 __attribute__((ext_vector_type(2)));
typedef __bf16 bf16x2_t __attribute__((ext_vector_type(2)));

constexpr int DM = 1024, NB = 8, TL = 4096, LCX = 256;
constexpr int NLAT = NB * TL, NCTX = NB * LCX, MT = NLAT + NCTX;
constexpr int KPOS = TL + LCX;
constexpr float EPS = 1e-6f, GN_EPS = 64e-5f;
constexpr int EV_IN = 1696, EV_INP = 1792, OD_IN = 3456, OD_INP = 3584, RW_IN = 1920;
constexpr int NEXP = 16, CAPL = 512, CAPC = 32, ESLOTS = NB * CAPL + NB * CAPC;
constexpr float LOG2E = 1.4426950408889634f;

constexpr size_t MiB = 1ull << 20;
constexpr size_t WS_CTL = 0, CTL_BYTES = 1 * MiB;
constexpr size_t WS_MOD = 1 * MiB, WS_ROPE = 2 * MiB, WS_XC = 4 * MiB;
constexpr size_t WS_ROWS = 12 * MiB, WS_GATE = 12 * MiB + 512 * 1024, WS_SLOT = 13 * MiB, WS_AFFT = 16 * MiB, WS_AFFC = 18 * MiB;
constexpr size_t WS_WEVIN = 20 * MiB, WS_WEVOUT = 27 * MiB, WS_WUQ = 31 * MiB, WS_WUKV = 33 * MiB, WS_WODIN = 34 * MiB, WS_WODOUT = 48 * MiB, WS_WLORA = 52 * MiB;
constexpr size_t WS_W13 = 56 * MiB, WS_W2 = 120 * MiB, WS_HB = 152 * MiB, WS_OCAT = 220 * MiB, WS_ARENA = 288 * MiB;
constexpr size_t A_U = 0, A_QPRE = 119 * MiB, A_KVPRE = 221 * MiB, A_QB = 357 * MiB, A_KB = 408 * MiB, A_VT = 459 * MiB;
constexpr size_t A_W = 0, A_KEFF = 136 * MiB  , A_G = 204 * MiB, A_R = 238 * MiB, A_V = 272 * MiB, A_KK = 306 * MiB, A_K = 340 * MiB, A_L = 374 * MiB,
                 A_QN = 400 * MiB, A_KN = 434 * MiB, A_VTN = 468 * MiB, A_YS = 612 * MiB  ;
constexpr size_t A_HID = 0, A_Y2 = 136 * MiB;
constexpr size_t A_IMG = 510 * MiB;
constexpr size_t WS_END = WS_ARENA + 680 * MiB;
constexpr int LDS_BYTES = 147456;

DI unsigned pk2(float lo, float hi) { f32x2 v = {lo, hi}; bf16x2_t b = __builtin_convertvector(v, bf16x2_t); return __builtin_bit_cast(unsigned, b); }
DI float bflo(unsigned u) { return __builtin_bit_cast(float, u << 16); }
DI float bfhi(unsigned u) { return __builtin_bit_cast(float, u & 0xffff0000u); }
DI float bf2f(bf16 x) { return __builtin_bit_cast(float, ((unsigned)x) << 16); }
DI bf16 f2bf(float f) { return (bf16)(pk2(f, 0.f) & 0xffffu); }
DI void unpack8(u32x4 v, float (&f)[8]) { f[0] = bflo(v.x); f[1] = bfhi(v.x); f[2] = bflo(v.y); f[3] = bfhi(v.y); f[4] = bflo(v.z); f[5] = bfhi(v.z); f[6] = bflo(v.w); f[7] = bfhi(v.w); }
DI u32x4 pack8(const float (&f)[8]) { u32x4 r; r.x = pk2(f[0], f[1]); r.y = pk2(f[2], f[3]); r.z = pk2(f[4], f[5]); r.w = pk2(f[6], f[7]); return r; }
#define DPP_ADD(x, ctrl) ((x) + __builtin_bit_cast(float, __builtin_amdgcn_update_dpp(0, __builtin_bit_cast(int, (x)), (ctrl), 0xf, 0xf, false)))
#define DPP_MAX(x, ctrl) fmaxf((x), __builtin_bit_cast(float, __builtin_amdgcn_update_dpp(0, __builtin_bit_cast(int, (x)), (ctrl), 0xf, 0xf, false)))
DI float sum8(float x) { x = DPP_ADD(x, 0xB1); x = DPP_ADD(x, 0x4E); x = DPP_ADD(x, 0x141); return x; }
DI float sum16(float x) { x = DPP_ADD(x, 0xB1); x = DPP_ADD(x, 0x4E); x = DPP_ADD(x, 0x141); x = DPP_ADD(x, 0x140); return x; }
DI float max16(float x) { x = DPP_MAX(x, 0xB1); x = DPP_MAX(x, 0x4E); x = DPP_MAX(x, 0x141); x = DPP_MAX(x, 0x140); return x; }
DI float rdlane(float x, int l) { return __builtin_bit_cast(float, __builtin_amdgcn_readlane(__builtin_bit_cast(int, x), l)); }
DI float wave_sum(float v) { const float x = sum16(v); return (rdlane(x, 0) + rdlane(x, 16)) + (rdlane(x, 32) + rdlane(x, 48)); }
DI float xor32(float v, int lane) { return __builtin_bit_cast(float, __builtin_amdgcn_ds_bpermute((lane ^ 32) << 2, __builtin_bit_cast(int, v))); }
typedef int v8i_t __attribute__((ext_vector_type(8)));
typedef int i32x4_t __attribute__((ext_vector_type(4)));
DI unsigned pk4_fp8(float a, float b, float c, float d) {
    a = __builtin_amdgcn_fmed3f(a, -448.f, 448.f); b = __builtin_amdgcn_fmed3f(b, -448.f, 448.f); c = __builtin_amdgcn_fmed3f(c, -448.f, 448.f); d = __builtin_amdgcn_fmed3f(d, -448.f, 448.f);
    int p = __builtin_amdgcn_cvt_pk_fp8_f32(a, b, 0, false); p = __builtin_amdgcn_cvt_pk_fp8_f32(c, d, p, true); return (unsigned)p; }
#ifndef MOE_F8
#define MOE_F8 1
#endif
constexpr int SCALE_ONE = 0x7f7f7f7f, SCALE_W = 0x79797979  , SCALE_HID = 0x7c7c7c7c  ;
DI float sigmoidf_(float x) { return __builtin_amdgcn_rcpf(1.f + __expf(-x)); }
DI float siluf_(float x) { return x * __builtin_amdgcn_rcpf(1.f + __expf(-x)); }
#define MFMA32(a, b, c) __builtin_amdgcn_mfma_f32_32x32x16_bf16((a), (b), (c), 0, 0, 0)

#define XB_TMO      128
#define XB_XCNT(j)  (256  + 64 * (j))
#define XB_XSUB(j)  (1280 + 64 * (j))
#define XB_XGEN(j)  (2304 + 64 * (j))
#define XB_TOP      3328
#define XB_TOPGEN   3392
#define XCD_BAR_WORDS 3456
#define XB_SPIN_CAP (1u << 22)
__device__ __forceinline__ unsigned xb_ld(unsigned* p)              { return __hip_atomic_load(p, __ATOMIC_RELAXED, __HIP_MEMORY_SCOPE_AGENT); }
__device__ __forceinline__ unsigned xb_add(unsigned* p, unsigned v) { return __hip_atomic_fetch_add(p, v, __ATOMIC_RELAXED, __HIP_MEMORY_SCOPE_AGENT); }
__device__ __forceinline__ unsigned xb_xcc_id() { return (unsigned)__builtin_amdgcn_s_getreg((3 << 11) | 20) & 0xFu; }
#define XB_SPIN(cond, bar) do { unsigned _sp = 0; while (cond) { __builtin_amdgcn_s_sleep(1); \
    if ((++_sp & 255u) == 0u) { if (xb_ld(&(bar)[XB_TMO])) break; if (_sp > XB_SPIN_CAP) { atomicAdd(&(bar)[XB_TMO], 1u); break; } } } } while (0)
struct XcdBarrier { unsigned* bar; unsigned x; volatile LAS unsigned* st; };
__device__ __forceinline__ XcdBarrier xcd_barrier_post(unsigned* bar, volatile LAS unsigned* st, bool leader) {
    XcdBarrier b; b.bar = bar; b.x = xb_xcc_id(); b.st = st;
    if (leader) (void)xb_add(&bar[XB_XCNT(b.x)], 1u);
    return b;
}
__device__ __forceinline__ void xcd_barrier_complete(unsigned* bar, unsigned x, unsigned& nloc, unsigned& nx) {
    const unsigned G = gridDim.x * gridDim.y * gridDim.z;
    unsigned sum, cnt, mine, sp = 0u;
    for (;;) {
        sum = 0u; cnt = 0u; mine = 0u;
#pragma unroll
        for (unsigned j = 0; j < 16; ++j) { const unsigned c = xb_ld(&bar[XB_XCNT(j)]); sum += c; cnt += (c > 0u) ? 1u : 0u; mine = (j == x) ? c : mine; }
        if (sum == G) break;
        __builtin_amdgcn_s_sleep(1);
        if ((++sp & 255u) == 0u) { if (xb_ld(&bar[XB_TMO])) break; if (sp > XB_SPIN_CAP) { atomicAdd(&bar[XB_TMO], 1u); break; } }
    }
    nloc = mine > 0u ? mine : 1u; nx = cnt > 0u ? cnt : 1u;
}
__device__ __forceinline__ void xcd_barrier(const XcdBarrier& b, bool leader) {
    asm volatile("s_waitcnt vmcnt(0)" ::: "memory");
    __syncthreads();
    if (leader) {
        unsigned* bar = b.bar;
        __builtin_amdgcn_s_waitcnt(0);
        unsigned nloc = b.st[0], nx = b.st[1];
        if (nloc == 0u) { xcd_barrier_complete(bar, b.x, nloc, nx); b.st[0] = nloc; b.st[1] = nx; }
        const unsigned old = xb_add(&bar[XB_XSUB(b.x)], 1u);
        const unsigned gen = old / nloc;
        if (old + 1u == (gen + 1u) * nloc) {
            __builtin_amdgcn_fence(__ATOMIC_RELEASE, "agent");
            asm volatile("s_waitcnt vmcnt(0)" ::: "memory");
            const unsigned og = xb_add(&bar[XB_TOP], 1u);
            const unsigned tg = og / nx;
            if (og + 1u == (tg + 1u) * nx) xb_add(&bar[XB_TOPGEN], 1u);
            else XB_SPIN(xb_ld(&bar[XB_TOPGEN]) == tg, bar);
            __builtin_amdgcn_fence(__ATOMIC_ACQUIRE, "agent");
            xb_add(&bar[XB_XGEN(b.x)], 1u);
            asm volatile("s_waitcnt vmcnt(0)" ::: "memory");
        } else {
            XB_SPIN(xb_ld(&bar[XB_XGEN(b.x)]) == gen, bar);
            __builtin_amdgcn_fence(__ATOMIC_ACQUIRE, "agent");
            asm volatile("s_waitcnt vmcnt(0)" ::: "memory");
        }
    }
    __syncthreads();
}

struct Ctx { LAS unsigned char* lds; int tid, lane, wave, bid, nb, vcu; };
struct Args { const float* in[40]; float* out; unsigned char* ws; int ph_lo, ph_hi; };
enum { I_X = 0, I_C, I_CTX, I_CCTX, I_ADAW, I_ADAB, I_N1G, I_N2G, I_EVWIN, I_EVWOUT, I_QNORM, I_WUQ, I_KVNORM, I_WUKV, I_QG, I_KG, I_DWW, I_DWB, I_LNG, I_LNB,
       I_ODWIN, I_ODWOUT, I_SHIFTW, I_W0, I_W2L, I_A0, I_A2, I_G2, I_KKW, I_KA, I_RK, I_GNG, I_GNB, I_NAQG, I_NAKG, I_RPB, I_ROUTER, I_MW1, I_MW3, I_MW2 };

DI void transpose_item(const float* __restrict__ W, int K, int N, bf16* __restrict__ WT, int dst_row0, const float* __restrict__ gain, LAS float* scr, int k0, int n0, int lane) {
#pragma unroll 8
    for (int i = 0; i < 32; ++i) { const int kk = 2 * i + (lane >> 5); float v = W[(size_t)(k0 + kk) * N + n0 + (lane & 31)]; if (gain) v *= gain[k0 + kk]; scr[kk * 33 + (lane & 31)] = v; }
    asm volatile("s_waitcnt lgkmcnt(0)" ::: "memory");
    const int c = lane & 7;
#pragma unroll
    for (int j = 0; j < 4; ++j) { const int n = (lane >> 3) + 8 * j; const LAS float* s = scr + (8 * c) * 33 + n;
        u32x4 o; o.x = pk2(s[0 * 33], s[1 * 33]); o.y = pk2(s[2 * 33], s[3 * 33]); o.z = pk2(s[4 * 33], s[5 * 33]); o.w = pk2(s[6 * 33], s[7 * 33]);
        *(u32x4*)(WT + (size_t)(dst_row0 + n) * K + k0 + 8 * c) = o; }
    asm volatile("s_waitcnt lgkmcnt(0)" ::: "memory");
}
DI void transpose_item64(const float* __restrict__ W, int K, int N, bf16* __restrict__ WT, int dst_row0, LAS float* scr, int k0, int n0, int lane) {
    f32x4 v[16];
#pragma unroll
    for (int i = 0; i < 16; ++i) v[i] = *(const f32x4*)(W + (size_t)(k0 + 4 * i + (lane >> 4)) * N + n0 + 4 * (lane & 15));
#pragma unroll
    for (int i = 0; i < 16; ++i) { LAS float* d = scr + (4 * i + (lane >> 4)) * 65 + 4 * (lane & 15); d[0] = v[i].x; d[1] = v[i].y; d[2] = v[i].z; d[3] = v[i].w; }
    asm volatile("s_waitcnt lgkmcnt(0)" ::: "memory");
    const int c = lane & 7;
#pragma unroll
    for (int j = 0; j < 8; ++j) { const int n = (lane >> 3) + 8 * j; const LAS float* s = scr + (8 * c) * 65 + n;
        u32x4 o; o.x = pk2(s[0 * 65], s[1 * 65]); o.y = pk2(s[2 * 65], s[3 * 65]); o.z = pk2(s[4 * 65], s[5 * 65]); o.w = pk2(s[6 * 65], s[7 * 65]);
        *(u32x4*)(WT + (size_t)(dst_row0 + n) * K + k0 + 8 * c) = o; }
    asm volatile("s_waitcnt lgkmcnt(0)" ::: "memory");
}
DI void transpose_item64_f8(const float* __restrict__ W, int K, int N, unsigned char* __restrict__ WT8, int dst_row0, LAS float* scr, int k0, int n0, int lane) {
    f32x4 v[16];
#pragma unroll
    for (int i = 0; i < 16; ++i) v[i] = *(const f32x4*)(W + (size_t)(k0 + 4 * i + (lane >> 4)) * N + n0 + 4 * (lane & 15));
#pragma unroll
    for (int i = 0; i < 16; ++i) { LAS float* d = scr + (4 * i + (lane >> 4)) * 65 + 4 * (lane & 15); d[0] = v[i].x; d[1] = v[i].y; d[2] = v[i].z; d[3] = v[i].w; }
    asm volatile("s_waitcnt lgkmcnt(0)" ::: "memory");
    const int c = lane & 7;
#pragma unroll
    for (int j = 0; j < 8; ++j) { const int n = (lane >> 3) + 8 * j; const LAS float* s = scr + (8 * c) * 65 + n;
        u32x2 o; o.x = pk4_fp8(64.f * s[0 * 65], 64.f * s[1 * 65], 64.f * s[2 * 65], 64.f * s[3 * 65]); o.y = pk4_fp8(64.f * s[4 * 65], 64.f * s[5 * 65], 64.f * s[6 * 65], 64.f * s[7 * 65]);
        *(u32x2*)(WT8 + (size_t)(dst_row0 + n) * K + k0 + 8 * c) = o; }
    asm volatile("s_waitcnt lgkmcnt(0)" ::: "memory");
}
DI void transpose_matrix(const Ctx& C, const float* W, int K, int N, bf16* WT, const float* gain, int mode  ) {
    LAS float* scr = (LAS float*)(C.lds + C.wave * 8704);
    const int nkb = K / 64, nnb = N / 32, nit = nkb * nnb, gw = C.vcu * 8 + C.wave, ngw = C.nb * 8;
    for (int it = gw; it < nit; it += ngw) {
        const int kb = it / nnb, nbk = it % nnb, n0 = nbk * 32;
        int d0 = n0; if (mode) d0 = (n0 >> 7) * 256 + (n0 & 127) + (mode == 2 ? 128 : 0);
        transpose_item(W, K, N, WT, d0, gain, scr, kb * 64, n0, C.lane);
    }
}

DI void ph_prologue(const Ctx& C, const Args& a) {
    unsigned char* ws = a.ws;
    {
        LAS float* sv = (LAS float*)C.lds;
        LAS float* red = sv + 9 * 1024;
        for (int i = C.tid; i < 9 * 1024; i += 512) { const int m = i >> 10, k = i & 1023; const float c = (m < 8) ? a.in[I_C][m * 1024 + k] : a.in[I_CCTX][k]; sv[i] = siluf_(c); }
        __syncthreads();
        float* MOD = (float*)(ws + WS_MOD);
        for (int it = C.bid; it < 4 * 96; it += C.nb) {
            const int layer = it / 96, col = (it % 96) * 64 + C.lane;
            const float* wp = a.in[I_ADAW] + (size_t)layer * 1024 * 6144 + col;
            float acc[9];
#pragma unroll
            for (int m = 0; m < 9; ++m) acc[m] = 0.f;
            const int kb = C.wave * 128;
#pragma unroll 16
            for (int k = 0; k < 128; ++k) { const float w = wp[(size_t)(kb + k) * 6144];
#pragma unroll
                for (int m = 0; m < 9; ++m) acc[m] += sv[m * 1024 + kb + k] * w; }
#pragma unroll
            for (int m = 0; m < 9; ++m) red[(C.wave * 9 + m) * 64 + C.lane] = acc[m];
            __syncthreads();
            for (int i = C.tid; i < 576; i += 512) { const int m = i >> 6, l = i & 63; float s = 0.f;
#pragma unroll
                for (int w = 0; w < 8; ++w) s += red[(w * 9 + m) * 64 + l];
                const int cc = (it % 96) * 64 + l;
                MOD[(size_t)(layer * 9 + m) * 6144 + cc] = s + a.in[I_ADAB][layer * 6144 + cc]; }
            __syncthreads();
        }
    }
    {
        f32x2* CS = (f32x2*)(ws + WS_ROPE);
        for (int i = C.bid * 512 + C.tid; i < 4096 * 16; i += C.nb * 512) {
            const int pos = i >> 4, j = i & 15, f = j & 7;
            const float inv = powf(10000.f, -(float)(2 * f) / 16.f);
            const float ang = (float)((j < 8) ? (pos >> 6) : (pos & 63)) * inv;
            const double tw = 6.283185307179586476925;
            const double x = (double)ang, n = __builtin_rint(x / tw), rr = x - n * tw;
            CS[i] = (f32x2){__cosf((float)rr), __sinf((float)rr)};
        }
    }
    for (int j = 0; j < 2; ++j) {
        transpose_matrix(C, a.in[I_EVWIN] + (size_t)j * DM * EV_IN, DM, EV_IN, (bf16*)(ws + WS_WEVIN) + (size_t)j * EV_INP * DM, nullptr, 0);
        transpose_matrix(C, a.in[I_EVWOUT] + (size_t)j * DM * DM, DM, DM, (bf16*)(ws + WS_WEVOUT) + (size_t)j * DM * DM, nullptr, 0);
        transpose_matrix(C, a.in[I_WUQ] + (size_t)j * 384 * 768, 384, 768, (bf16*)(ws + WS_WUQ) + (size_t)j * 768 * 384, a.in[I_QNORM] + j * 384, 0);
        transpose_matrix(C, a.in[I_WUKV] + (size_t)j * 256 * 1024, 256, 1024, (bf16*)(ws + WS_WUKV) + (size_t)j * 1024 * 256, a.in[I_KVNORM] + j * 256, 0);
        transpose_matrix(C, a.in[I_ODWIN] + (size_t)j * DM * OD_IN, DM, OD_IN, (bf16*)(ws + WS_WODIN) + (size_t)j * OD_INP * DM, nullptr, 0);
        transpose_matrix(C, a.in[I_ODWOUT] + (size_t)j * DM * DM, DM, DM, (bf16*)(ws + WS_WODOUT) + (size_t)j * DM * DM, nullptr, 0);
    }
    {
        const int gt = C.bid * 512 + C.tid, ngt = C.nb * 512;
        for (int j = 0; j < 2; ++j) {
            u32x4* p0 = (u32x4*)((bf16*)(ws + WS_WEVIN) + (size_t)j * EV_INP * DM + (size_t)EV_IN * DM);
            for (int i = gt; i < (EV_INP - EV_IN) * DM / 8; i += ngt) p0[i] = (u32x4){0u, 0u, 0u, 0u};
            u32x4* p1 = (u32x4*)((bf16*)(ws + WS_WODIN) + (size_t)j * OD_INP * DM + (size_t)OD_IN * DM);
            for (int i = gt; i < (OD_INP - OD_IN) * DM / 8; i += ngt) p1[i] = (u32x4){0u, 0u, 0u, 0u};
            bf16* WL = (bf16*)(ws + WS_WLORA) + (size_t)j * 655360;
            const float* w2 = a.in[I_W2L] + (size_t)j * 2 * 64 * 512; const float* a2 = a.in[I_A2] + (size_t)j * 2 * 64 * 512; const float* g2 = a.in[I_G2] + (size_t)j * 128 * 512;
            for (int i = gt; i < 655360; i += ngt) {
                const int n = i >> 8, k = i & 255; float v = 0.f;
                if (n < 1024) { const int d = n >> 9, c = n & 511; if (k >= d * 64 && k < d * 64 + 64) v = w2[(size_t)k * 512 + c]; }
                else if (n < 2048) { const int d = (n - 1024) >> 9, c = n & 511; if (k >= 128 + d * 64 && k < 192 + d * 64) v = a2[(size_t)(k - 128) * 512 + c]; }
                else { const int c = n - 2048; if (k >= 128) v = g2[(size_t)(k - 128) * 512 + c]; }
                WL[i] = f2bf(v);
            }
        }
    }
}

template <bool ROUTER> DI void norm_row(const Ctx& C, int row, const float* xlat, const float* xctx, const float* gain, const float* mod, int shift_off, int scale_off, bf16* H, float* AFFT, float* AFFC, int* SLOT);
template <bool ROUTER, int NR> DI void norm_rowsN(const Ctx& C, int row, const float* xlat, const float* gain, const float* mod, int shift_off, int scale_off, bf16* H, float* AFFT, int* SLOT);
template <bool ROUTER>
DI void ph_norm(const Ctx& C, const float* xlat, const float* xctx, const float* gain, const float* mod  , int shift_off, int scale_off, bf16* H,
                const float* router  , float* AFFT, float* AFFC, int* SLOT) {
    LAS float* RT = (LAS float*)C.lds;
    if (ROUTER) { for (int i = C.tid; i < 16384; i += 512) { const int c = i >> 4, e = i & 15; RT[e * 1024 + c] = router[i]; } __syncthreads(); }
    const int gw = C.bid * 8 + C.wave, ngw = C.nb * 8;
    for (int p = gw; p < NLAT / 4; p += ngw) norm_rowsN<ROUTER, 4>(C, 4 * p, xlat, gain, mod, shift_off, scale_off, H, AFFT, SLOT);
    for (int row = NLAT + gw; row < MT; row += ngw) norm_row<ROUTER>(C, row, xlat, xctx, gain, mod, shift_off, scale_off, H, AFFT, AFFC, SLOT);
}
template <bool ROUTER, int NR>
DI void norm_rowsN(const Ctx& C, int row, const float* xlat, const float* gain, const float* mod, int shift_off, int scale_off, bf16* H, float* AFFT, int* SLOT) {
    const LAS float* RT = (const LAS float*)C.lds; const int lane = C.lane;
    const float* xr = xlat + (size_t)row * DM;
    const float* mp = mod + (row >> 12) * 6144;
    f32x4 v[NR][4]; float rs[NR];
#pragma unroll
    for (int q = 0; q < NR; ++q) { float ss = 0.f;
#pragma unroll
        for (int j = 0; j < 4; ++j) { v[q][j] = *(const f32x4*)(xr + q * DM + 256 * j + 4 * lane); ss += v[q][j].x * v[q][j].x + v[q][j].y * v[q][j].y + v[q][j].z * v[q][j].z + v[q][j].w * v[q][j].w; }
        rs[q] = 1.0f / sqrtf(wave_sum(ss) * (1.f / 1024.f) + EPS); }
#pragma unroll
    for (int j = 0; j < 4; ++j) {
        const int c = 256 * j + 4 * lane;
        const f32x4 g = *(const f32x4*)(gain + c), sc = *(const f32x4*)(mp + scale_off + c), sh = *(const f32x4*)(mp + shift_off + c);
#pragma unroll
        for (int q = 0; q < NR; ++q) {
            v[q][j] = (v[q][j] * rs[q]) * g * (sc + 1.0f) + sh;
            if (ROUTER && MOE_F8) *(unsigned*)((unsigned char*)H + (size_t)(row + q) * DM + c) = pk4_fp8(v[q][j].x, v[q][j].y, v[q][j].z, v[q][j].w);
            else *(u32x2*)(H + (size_t)(row + q) * DM + c) = (u32x2){pk2(v[q][j].x, v[q][j].y), pk2(v[q][j].z, v[q][j].w)};
        }
    }
    if (ROUTER) {
        float lg[NR];
#pragma unroll
        for (int q = 0; q < NR; ++q) lg[q] = 0.f;
#pragma unroll 1
        for (int e = 0; e < 16; ++e) { float p[NR];
#pragma unroll
            for (int q = 0; q < NR; ++q) p[q] = 0.f;
#pragma unroll
            for (int j = 0; j < 4; ++j) { const f32x4 w = *(const LAS f32x4*)(RT + e * 1024 + 256 * j + 4 * lane);
#pragma unroll
                for (int q = 0; q < NR; ++q) p[q] += v[q][j].x * w.x + v[q][j].y * w.y + v[q][j].z * w.z + v[q][j].w * w.w; }
#pragma unroll
            for (int q = 0; q < NR; ++q) { const float t = wave_sum(p[q]); lg[q] = (lane == e) ? t : lg[q]; } }
#pragma unroll
        for (int q = 0; q < NR; ++q) { const float ex = expf(lg[q] - max16(lg[q])); const float af = ex / sum16(ex);
            if (lane < 16) { AFFT[(size_t)((row >> 12) * 16 + lane) * TL + ((row + q) & 4095)] = af; SLOT[(size_t)(row + q) * 16 + lane] = -1; } }
    }
}
template <bool ROUTER>
DI void norm_row(const Ctx& C, int row, const float* xlat, const float* xctx, const float* gain, const float* mod, int shift_off, int scale_off, bf16* H, float* AFFT, float* AFFC, int* SLOT) {
    const LAS float* RT = (const LAS float*)C.lds; const int lane = C.lane;
    {
        const float* xr = row < NLAT ? xlat + (size_t)row * DM : xctx + (size_t)(row - NLAT) * DM;
        const int mi = row < NLAT ? (row >> 12) : 8;
        const float* mp = mod + mi * 6144;
        f32x4 v[4]; float ss = 0.f;
#pragma unroll
        for (int j = 0; j < 4; ++j) { v[j] = *(const f32x4*)(xr + 256 * j + 4 * lane); ss += v[j].x * v[j].x + v[j].y * v[j].y + v[j].z * v[j].z + v[j].w * v[j].w; }
        ss = wave_sum(ss);
        const float rs = 1.0f / sqrtf(ss * (1.f / 1024.f) + EPS);
#pragma unroll
        for (int j = 0; j < 4; ++j) {
            const int c = 256 * j + 4 * lane;
            const f32x4 g = *(const f32x4*)(gain + c), sc = *(const f32x4*)(mp + scale_off + c), sh = *(const f32x4*)(mp + shift_off + c);
            v[j] = (v[j] * rs) * g * (sc + 1.0f) + sh;
            if (ROUTER && MOE_F8) *(unsigned*)((unsigned char*)H + (size_t)row * DM + c) = pk4_fp8(v[j].x, v[j].y, v[j].z, v[j].w);
            else *(u32x2*)(H + (size_t)row * DM + c) = (u32x2){pk2(v[j].x, v[j].y), pk2(v[j].z, v[j].w)};
        }
        if (ROUTER) {
            float mylg = 0.f;
#pragma unroll 1
            for (int e = 0; e < 16; ++e) { float p = 0.f;
#pragma unroll
                for (int j = 0; j < 4; ++j) { const f32x4 w = *(const LAS f32x4*)(RT + e * 1024 + 256 * j + 4 * lane); p += v[j].x * w.x + v[j].y * w.y + v[j].z * w.z + v[j].w * w.w; }
                p = wave_sum(p); mylg = (lane == e) ? p : mylg; }
            const float mx = max16(mylg);
            const float ex = expf(mylg - mx);
            const float mine = ex / sum16(ex);
            if (lane < 16) {
                if (row < NLAT) AFFT[(size_t)((row >> 12) * 16 + lane) * TL + (row & 4095)] = mine;
                else { const int rc = row - NLAT; AFFC[(size_t)((rc >> 8) * 16 + lane) * LCX + (rc & 255)] = mine; }
                SLOT[(size_t)row * 16 + lane] = -1;
            }
        }
    }
}


struct EpiBf16 { static constexpr bool WIDE = true; bf16* O; int ldo;
    DI void operator()(int row, int col, f32x4 v0, f32x4 v1) const { bf16* p = O + (size_t)row * ldo + col;
        *(u32x2*)p = (u32x2){pk2(v0[0], v0[1]), pk2(v0[2], v0[3])}; *(u32x2*)(p + 128) = (u32x2){pk2(v1[0], v1[1]), pk2(v1[2], v1[3])}; }
    DI void wide(int row, int col, f32x4 a0, f32x4 a1, f32x4 b0, f32x4 b1) const { bf16* p = O + (size_t)row * ldo + col;
        *(u32x4*)p = (u32x4){pk2(a0[0], a0[1]), pk2(a0[2], a0[3]), pk2(a1[0], a1[1]), pk2(a1[2], a1[3])}; *(u32x4*)(p + 128) = (u32x4){pk2(b0[0], b0[1]), pk2(b0[2], b0[3]), pk2(b1[0], b1[1]), pk2(b1[2], b1[3])}; } };
struct EpiF32 { static constexpr bool WIDE = false; float* O; int ldo;
    DI void operator()(int row, int col, f32x4 v0, f32x4 v1) const { float* p = O + (size_t)row * ldo + col; *(f32x4*)p = v0; *(f32x4*)(p + 128) = v1; } };
struct EpiResid { static constexpr bool WIDE = false; const float* xin_lat; const float* xin_ctx; float* xout_lat; float* xout_ctx; const float* modg;
    DI void operator()(int row, int col, f32x4 v0, f32x4 v1) const {
        const float* xi; float* xo; int mi;
        if (row < NLAT) { xi = xin_lat + (size_t)row * DM; xo = xout_lat + (size_t)row * DM; mi = row >> 12; }
        else { xi = xin_ctx + (size_t)(row - NLAT) * DM; xo = xout_ctx + (size_t)(row - NLAT) * DM; mi = 8; }
        const float* g = modg + mi * 6144 + col;
        const f32x4 g0 = *(const f32x4*)g, g1 = *(const f32x4*)(g + 128), x0 = *(const f32x4*)(xi + col), x1 = *(const f32x4*)(xi + col + 128);
        *(f32x4*)(xo + col) = x0 + g0 * v0; *(f32x4*)(xo + col + 128) = x1 + g1 * v1; } };
struct EpiGlu { static constexpr bool WIDE = false; bf16* O;
    DI void operator()(int row, int col, f32x4 v0, f32x4 v1) const { const int f = ((col & 2047) >> 8) * 128 + (col & 255);
        *(u32x2*)(O + (size_t)row * DM + f) = (u32x2){pk2(siluf_(v0[0]) * v1[0], siluf_(v0[1]) * v1[1]), pk2(siluf_(v0[2]) * v1[2], siluf_(v0[3]) * v1[3])}; } };
struct EpiGlu8 { static constexpr bool WIDE = true; unsigned char* O;
    DI void operator()(int row, int col, f32x4 v0, f32x4 v1) const { const int f = ((col & 2047) >> 8) * 128 + (col & 255);
        *(unsigned*)(O + (size_t)row * DM + f) = pk4_fp8(8.f * siluf_(v0[0]) * v1[0], 8.f * siluf_(v0[1]) * v1[1], 8.f * siluf_(v0[2]) * v1[2], 8.f * siluf_(v0[3]) * v1[3]); }
    DI void wide(int row, int col, f32x4 a0, f32x4 a1, f32x4 b0, f32x4 b1) const { const int f = ((col & 2047) >> 8) * 128 + (col & 255);
        *(u32x2*)(O + (size_t)row * DM + f) = (u32x2){pk4_fp8(8.f * siluf_(a0[0]) * b0[0], 8.f * siluf_(a0[1]) * b0[1], 8.f * siluf_(a0[2]) * b0[2], 8.f * siluf_(a0[3]) * b0[3]),
                                                    pk4_fp8(8.f * siluf_(a1[0]) * b1[0], 8.f * siluf_(a1[1]) * b1[1], 8.f * siluf_(a1[2]) * b1[2], 8.f * siluf_(a1[3]) * b1[3])}; } };
struct EpiGate { static constexpr bool WIDE = true; bf16* O; const float* gate;
    DI void operator()(int row, int col, f32x4 v0, f32x4 v1) const { const float g = gate[row]; bf16* p = O + (size_t)row * DM + (col & 1023);
        *(u32x2*)p = (u32x2){pk2(v0[0] * g, v0[1] * g), pk2(v0[2] * g, v0[3] * g)}; *(u32x2*)(p + 128) = (u32x2){pk2(v1[0] * g, v1[1] * g), pk2(v1[2] * g, v1[3] * g)}; }
    DI void wide(int row, int col, f32x4 a0, f32x4 a1, f32x4 b0, f32x4 b1) const { const float g = gate[row]; bf16* p = O + (size_t)row * DM + (col & 1023);
        *(u32x4*)p = (u32x4){pk2(a0[0] * g, a0[1] * g), pk2(a0[2] * g, a0[3] * g), pk2(a1[0] * g, a1[1] * g), pk2(a1[2] * g, a1[3] * g)};
        *(u32x4*)(p + 128) = (u32x4){pk2(b0[0] * g, b0[1] * g), pk2(b0[2] * g, b0[3] * g), pk2(b1[0] * g, b1[1] * g), pk2(b1[2] * g, b1[3] * g)}; } };
typedef _Float16 f16x2_t __attribute__((ext_vector_type(2)));
DI unsigned pk2h(float a, float b) { f16x2_t h; h.x = (_Float16)a; h.y = (_Float16)b; return __builtin_bit_cast(unsigned, h); }
DI float h2f(unsigned short x) { return (float)__builtin_bit_cast(_Float16, x); }
struct EpiLoraW { static constexpr bool WIDE = false; unsigned short* W; const float* w0;
    DI void one(int row, int col, f32x4 v) const { const int d = col >> 9, c = col & 511; f32x4 o;
#pragma unroll
        for (int e = 0; e < 4; ++e) { const float lw = w0[col + e] + v[e]; const float z = -lw; const float sp = fmaxf(z, 0.f) + __logf(1.f + __expf(-fabsf(z))); o[e] = -__expf(-sp - 0.5f); }
        *(u32x2*)(W + ((size_t)d * MT + row) * 512 + c) = (u32x2){pk2h(o[0], o[1]), pk2h(o[2], o[3])}; }
    DI void operator()(int row, int col, f32x4 v0, f32x4 v1) const { one(row, col, v0); one(row, col + 128, v1); } };
struct EpiLoraA { static constexpr bool WIDE = false; bf16* Aout; const float* a0;
    DI void one(int row, int col, f32x4 v) const { const int d = col >> 9, c = col & 511; const f32x4 b = *(const f32x4*)(a0 + col);
        *(u32x2*)(Aout + ((size_t)d * MT + row) * 512 + c) = (u32x2){pk2(sigmoidf_(b[0] + v[0]), sigmoidf_(b[1] + v[1])), pk2(sigmoidf_(b[2] + v[2]), sigmoidf_(b[3] + v[3]))}; }
    DI void operator()(int row, int col, f32x4 v0, f32x4 v1) const { one(row, col, v0); one(row, col + 128, v1); } };

namespace pg8 {
constexpr int BM = 256, BK = 64, HALF = 128, HTB = HALF * BK * 2, STAGE_BYTES = 8 * HTB;
DI int lds_byte(int r, int c) { const int st = (r >> 4) * 2 + (c >> 5), rr = r & 15, cc = c & 31, ob = rr * 64 + cc * 2; return st * 1024 + (ob ^ (((ob >> 9) & 1) << 5)); }
DI void stage_rc(int b, int& R, int& C) { const int st = b / 1024, sb = b % 1024, swz = sb ^ (((sb >> 9) & 1) << 5); R = (st >> 1) * 16 + swz / 64; C = (st & 1) * 32 + (swz % 64) / 2; }
DI int perm32(int rho) { const int n = rho >> 4, i = rho & 15; return 8 * (i >> 2) + 4 * n + (i & 3); }
struct Unit { int pm, pn; };
struct Gemm { const bf16* A; const bf16* Bt; int lda, K; const int* rows; int scale_w = 0x7f7f7f7f, scale_a = 0x7f7f7f7f; };
struct OrderMN { int nM, nN, G, c;
    DI bool next(int i, Unit& u) const { const int L = i * G + c; if (L >= nM * nN) return false; u.pm = L / nN; u.pn = L % nN; return true; } };
struct OrderMoE { int nMt, nN, mstride  , G, c;
    DI bool next(int i, Unit& u) const { const int L = i * G + c, per = nMt * nN; if (L >= NEXP * per) return false; const int e = L / per, q = L % per; u.pm = e * mstride + q / nN; u.pn = e * nN + q % nN; return true; } };
template <class E4> struct EpiAdapt { E4 e;
    DI void operator()(const f32x4 (&acc)[2][2][4][2], const Unit& u, int wr, int wc, int fr, int fq) const {
#pragma unroll
        for (int ai = 0; ai < 2; ++ai)
#pragma unroll
            for (int m = 0; m < 4; ++m) { const int row = u.pm * BM + ai * HALF + wr * 64 + m * 16 + fr;
                if constexpr (E4::WIDE) e.wide(row, u.pn * BM + wc * 32 + 8 * fq, acc[ai][0][m][0], acc[ai][0][m][1], acc[ai][1][m][0], acc[ai][1][m][1]);
                else {
#pragma unroll
                    for (int n = 0; n < 2; ++n) e(row, u.pn * BM + wc * 32 + 8 * fq + 4 * n, acc[ai][0][m][n], acc[ai][1][m][n]); } } } };

template <class Epi, class Sched, bool F8 = false>
DI void gemm_phase(LAS unsigned char* lds, const Gemm g, const Sched& S, const Epi& E, const int tid) {
    const int wid = __builtin_amdgcn_readfirstlane(tid >> 6), lane = tid & 63, wr = wid >> 2, wc = wid & 3, fr = lane & 15, fq = lane >> 4;
    const int K = g.K, nt = K / BK;
    unsigned voffB[2];
#pragma unroll
    for (int i = 0; i < 2; ++i) { int R, C; stage_rc(tid * 16 + i * 8192, R, C); const int Rb = (R & ~31) + perm32(R & 31); voffB[i] = (unsigned)(Rb * K + C) * 2u; }
    const size_t kstep = (size_t)(BK * 2), hstep = (size_t)HALF * K * 2, tstep = 2 * hstep;
    const unsigned ldsw = (unsigned)wid * 1024u;
    const int aoff = lds_byte(wr * 64 + fr, fq * 8), boff = lds_byte(wc * 32 + fr, fq * 8);
    const char* const gA = (const char*)g.A;
#define PG8_SA(b, h) (((b) * 2 + (h)) * HTB)
#define PG8_SB(b, h) ((4 + (b) * 2 + (h)) * HTB)
#define PG8_STAGE(bufoff, gbase, voff) do { _Pragma("unroll") for (int _i = 0; _i < 2; ++_i) \
        __builtin_amdgcn_global_load_lds((const unsigned*)((const char*)(gbase) + (voff)[_i]), (LAS unsigned*)(lds + (bufoff) + ldsw + _i * 8192), 16, 0, 0); } while (0)
#define PG8_LDA(dst, b, h) do { _Pragma("unroll") for (int m = 0; m < 4; ++m) _Pragma("unroll") for (int k = 0; k < 2; ++k) dst[m][k] = *(const LAS bf16x8*)(lds + PG8_SA(b, h) + aoff + m * 2048 + k * 1024); } while (0)
#define PG8_LDB(dst, b, h) do { _Pragma("unroll") for (int n = 0; n < 2; ++n) _Pragma("unroll") for (int k = 0; k < 2; ++k) dst[n][k] = *(const LAS bf16x8*)(lds + PG8_SB(b, h) + boff + n * 2048 + k * 1024); } while (0)
#define PG8_MMA(ai, bj, At, Bt) do { __builtin_amdgcn_s_setprio(1); _Pragma("unroll") for (int m = 0; m < 4; ++m) _Pragma("unroll") for (int n = 0; n < 2; ++n) { \
        if constexpr (F8) { const v8i_t w8 = __builtin_shufflevector(__builtin_bit_cast(i32x4_t, Bt[n][0]), __builtin_bit_cast(i32x4_t, Bt[n][1]), 0, 1, 2, 3, 4, 5, 6, 7), x8 = __builtin_shufflevector(__builtin_bit_cast(i32x4_t, At[m][0]), __builtin_bit_cast(i32x4_t, At[m][1]), 0, 1, 2, 3, 4, 5, 6, 7); \
            acc[ai][bj][m][n] = __builtin_amdgcn_mfma_scale_f32_16x16x128_f8f6f4(w8, x8, acc[ai][bj][m][n], 0, 0, 0, g.scale_w, 0, g.scale_a); } \
        else { _Pragma("unroll") for (int k = 0; k < 2; ++k) acc[ai][bj][m][n] = __builtin_amdgcn_mfma_f32_16x16x32_bf16(Bt[n][k], At[m][k], acc[ai][bj][m][n], 0, 0, 0); } } __builtin_amdgcn_s_setprio(0); } while (0)
#define PG8_WAIT_V(n) asm volatile("s_waitcnt vmcnt(" #n ")" ::: "memory")
#define PG8_WAIT_L(n) asm volatile("s_waitcnt lgkmcnt(" #n ")" ::: "memory")
#define PG8_BAR __builtin_amdgcn_s_barrier()
#define PG8_SCHED __builtin_amdgcn_sched_barrier(0)
#define PG8_ROWIDX(ri, u) do { _Pragma("unroll") for (int _h = 0; _h < 2; ++_h) _Pragma("unroll") for (int _i = 0; _i < 2; ++_i) { int _R, _C; stage_rc(tid * 16 + _i * 8192, _R, _C); (void)_C; \
        const int _lr = (u).pm * BM + _h * HALF + _R; ri[_h][_i] = g.rows ? g.rows[_lr] : _lr; } } while (0)
#define PG8_AOFF_FROM(vo, ri) do { _Pragma("unroll") for (int _h = 0; _h < 2; ++_h) _Pragma("unroll") for (int _i = 0; _i < 2; ++_i) { int _R, _C; stage_rc(tid * 16 + _i * 8192, _R, _C); (void)_R; \
        vo[_h][_i] = (unsigned)(((size_t)ri[_h][_i] * g.lda + _C) * 2u); } } while (0)
    Unit cur, nxt; int ui = 0;
    if (!S.next(0, cur)) return;
    f32x4 acc[2][2][4][2];
#pragma unroll
    for (int a = 0; a < 2; ++a)
#pragma unroll
        for (int b = 0; b < 2; ++b)
#pragma unroll
            for (int m = 0; m < 4; ++m)
#pragma unroll
                for (int n = 0; n < 2; ++n) acc[a][b][m][n] = (f32x4){0.f, 0.f, 0.f, 0.f};
    bf16x8 At[4][2], B0[2][2], B1[2][2];
    unsigned cvo[2][2]; int nri[2][2];
    PG8_ROWIDX(nri, cur); PG8_AOFF_FROM(cvo, nri);
    const char* cB = (const char*)g.Bt + (size_t)cur.pn * tstep;
    PG8_STAGE(PG8_SB(0, 0), cB, voffB); PG8_STAGE(PG8_SB(0, 1), cB + hstep, voffB); PG8_STAGE(PG8_SA(0, 0), gA, cvo[0]); PG8_STAGE(PG8_SA(0, 1), gA, cvo[1]);
    if (wr == 1) PG8_BAR;
    PG8_WAIT_V(2); PG8_BAR;
    PG8_STAGE(PG8_SB(1, 0), cB + kstep, voffB); PG8_STAGE(PG8_SA(1, 0), gA + kstep, cvo[0]); PG8_STAGE(PG8_SB(1, 1), cB + hstep + kstep, voffB);
    PG8_WAIT_V(6); PG8_BAR;
    for (;;) {
        const bool has_next = S.next(ui + 1, nxt);
        const char* nB = has_next ? (const char*)g.Bt + (size_t)nxt.pn * tstep : cB;
#pragma nounroll
        for (int t = 0; t < nt; t += 2) {
            const bool last = (t == nt - 2);
            const char* a1 = gA + (size_t)(t + 1) * kstep;
            const char* a2 = last ? gA : gA + (size_t)(t + 2) * kstep; const char* b2 = last ? nB : cB + (size_t)(t + 2) * kstep;
            const char* a3 = a2 + kstep; const char* b3 = b2 + kstep;
            if (t == nt - 4 && has_next) PG8_ROWIDX(nri, nxt);
            PG8_LDB(B0, 0, 0); PG8_LDB(B1, 0, 1); PG8_SCHED; PG8_LDA(At, 0, 0); PG8_STAGE(PG8_SA(1, 1), a1, cvo[1]);
            if (last && has_next) { if (nt < 4) PG8_ROWIDX(nri, nxt); PG8_AOFF_FROM(cvo, nri); }
            PG8_WAIT_V(8); PG8_WAIT_L(0); PG8_BAR; PG8_MMA(0, 0, At, B0); PG8_MMA(0, 1, At, B1); PG8_BAR; PG8_SCHED;
            PG8_LDA(At, 0, 1); PG8_STAGE(PG8_SB(0, 0), b2, voffB); PG8_STAGE(PG8_SB(0, 1), b2 + hstep, voffB); PG8_STAGE(PG8_SA(0, 0), a2, cvo[0]);
            PG8_WAIT_V(8); PG8_WAIT_L(0); PG8_BAR; PG8_MMA(1, 0, At, B0); PG8_MMA(1, 1, At, B1); PG8_BAR; PG8_SCHED;
            PG8_LDB(B0, 1, 0); PG8_LDB(B1, 1, 1); PG8_SCHED; PG8_LDA(At, 1, 0); PG8_STAGE(PG8_SA(0, 1), a2, cvo[1]);
            PG8_WAIT_V(8); PG8_WAIT_L(0); PG8_BAR; PG8_MMA(0, 0, At, B0); PG8_MMA(0, 1, At, B1); PG8_BAR; PG8_SCHED;
            PG8_LDA(At, 1, 1); PG8_STAGE(PG8_SB(1, 0), b3, voffB); PG8_STAGE(PG8_SB(1, 1), b3 + hstep, voffB); PG8_STAGE(PG8_SA(1, 0), a3, cvo[0]);
            PG8_WAIT_V(8); PG8_WAIT_L(0); PG8_BAR; PG8_MMA(1, 0, At, B0); PG8_MMA(1, 1, At, B1); PG8_BAR; PG8_SCHED;
        }
        if (wr == 0) PG8_BAR;
        E(acc, cur, wr, wc, fr, fq);
        if (!has_next) break;
#pragma unroll
        for (int a = 0; a < 2; ++a)
#pragma unroll
            for (int b = 0; b < 2; ++b)
#pragma unroll
                for (int m = 0; m < 4; ++m)
#pragma unroll
                    for (int n = 0; n < 2; ++n) acc[a][b][m][n] = (f32x4){0.f, 0.f, 0.f, 0.f};
        cur = nxt; cB = nB; ++ui;
        if (wr == 1) PG8_BAR;
    }
    PG8_WAIT_V(0);
    PG8_BAR;
#undef PG8_SA
#undef PG8_SB
#undef PG8_STAGE
#undef PG8_LDA
#undef PG8_LDB
#undef PG8_MMA
#undef PG8_WAIT_V
#undef PG8_WAIT_L
#undef PG8_BAR
#undef PG8_SCHED
#undef PG8_ROWIDX
#undef PG8_AOFF_FROM
}
}
template <class E4> DI void fast_gemm(const Ctx& C, const bf16* A, int lda, const bf16* Bt, int K, int nM, int nN, const E4& e, bool rev = false) {
    pg8::Gemm g{A, Bt, lda, K, nullptr}; pg8::OrderMN S{nM, nN, C.nb, rev ? C.nb - 1 - C.vcu : C.vcu}; pg8::EpiAdapt<E4> E{e};
    pg8::gemm_phase(C.lds, g, S, E, C.tid);
}

DI float max16_acc(float m, const f32x16& x) {
    asm volatile("s_nop 15\n\tv_max3_f32 %0, %0, %1, %2\n\tv_max3_f32 %0, %0, %3, %4\n\tv_max3_f32 %0, %0, %5, %6\n\tv_max3_f32 %0, %0, %7, %8\n\tv_max3_f32 %0, %0, %9, %10\n\tv_max3_f32 %0, %0, %11, %12\n\tv_max3_f32 %0, %0, %13, %14\n\tv_max3_f32 %0, %0, %15, %16"
                 : "+v"(m) : "v"(x[0]), "v"(x[1]), "v"(x[2]), "v"(x[3]), "v"(x[4]), "v"(x[5]), "v"(x[6]), "v"(x[7]), "v"(x[8]), "v"(x[9]), "v"(x[10]), "v"(x[11]), "v"(x[12]), "v"(x[13]), "v"(x[14]), "v"(x[15]));
    return m; }
DI int swap23(int x) { return (x & ~12) | ((x & 4) << 1) | ((x & 8) >> 1); }
DI void flash_store(const f32x16 (&o)[2], float l, bf16* orow  , int h) {
    const float inv = 1.f / l;
#pragma unroll
    for (int dt = 0; dt < 2; ++dt)
#pragma unroll
        for (int g = 0; g < 4; ++g)
            *(u32x2*)(orow + 32 * dt + 8 * g + 4 * h) = (u32x2){pk2(o[dt][4 * g] * inv, o[dt][4 * g + 1] * inv), pk2(o[dt][4 * g + 2] * inv, o[dt][4 * g + 3] * inv)};
}


template <int DQK> struct AttnGeo { static constexpr int KSTR = DQK * 2 + 16, KBYTES = 64 * KSTR, VSTR = 144, VBYTES = 64 * VSTR, BUF = KBYTES + VBYTES, KPIECES = 64 * DQK / 8; };
template <int DQK, bool NAT>
DI void attn_tile_loop(const Ctx& C, f32x16 (&o)[2], float& l, const bf16x8 (&qf)[DQK / 16], const bf16* __restrict__ Kb, const bf16* __restrict__ Vt, int pos1, int n1, int pos2, int n2,
                       const LAS float* tab, int grow, int rs, int qc, int cs) {
    typedef AttnGeo<DQK> G;
    const int tid = C.tid, r = C.lane & 31, h = C.lane >> 5, kr = swap23(r), ntiles = n1 + n2;
    constexpr bool K2 = G::KPIECES > 512;
    const int kq0 = tid, kq1 = tid + 512;
    const int kl0 = (kq0 / (DQK / 8)) * G::KSTR + (kq0 % (DQK / 8)) * 16, kl1 = (kq1 / (DQK / 8)) * G::KSTR + (kq1 % (DQK / 8)) * 16;
    const int vl = G::KBYTES + (tid >> 3) * G::VSTR + (tid & 7) * 16;
    const bf16* vg = Vt + (size_t)(tid >> 3) * KPOS + 8 * (tid & 7);
    u32x4 rk0, rk1, rv;
    rk1 = (u32x4){0u, 0u, 0u, 0u};
#define ATT_POS(t) ((t) < n1 ? pos1 + 64 * (t) : pos2 + 64 * ((t) - n1))
    { const int pos0 = ATT_POS(0); rk0 = *(const u32x4*)(Kb + (size_t)pos0 * DQK + 8 * kq0); if (K2 && tid < 256) rk1 = *(const u32x4*)(Kb + (size_t)pos0 * DQK + 8 * kq1); rv = *(const u32x4*)(vg + pos0); }
    __syncthreads();
    *(LAS u32x4*)(C.lds + kl0) = rk0; if (K2 && tid < 256) *(LAS u32x4*)(C.lds + kl1) = rk1; *(LAS u32x4*)(C.lds + vl) = rv;
    __syncthreads();
    if (C.wave >= 4) __builtin_amdgcn_s_setprio(1);
    float mref = 0.f; bool first = true;
    f32x16 nmref;
#pragma unroll
    for (int i = 0; i < 16; ++i) nmref[i] = 0.f;
    constexpr float THR = 8.f;
    for (int t = 0; t < ntiles; ++t) {
        const LAS unsigned char* B = C.lds + (t & 1) * G::BUF;
        if (t + 1 < ntiles) { const int pos0 = ATT_POS(t + 1);
            rk0 = *(const u32x4*)(Kb + (size_t)pos0 * DQK + 8 * kq0); if (K2 && tid < 256) rk1 = *(const u32x4*)(Kb + (size_t)pos0 * DQK + 8 * kq1); rv = *(const u32x4*)(vg + pos0); }
        const int gr = (pos1 >> 6) + t;
        const bool active = !NAT || t >= n1 || (gr >= rs && gr < rs + 8);
        if (active) {
            f32x16 sc[2];
            constexpr int NK = DQK / 16, NS = 2 * NK, RD = 4;
            const LAS unsigned char* kp = B + kr * G::KSTR + 16 * h;
            bf16x8 fr[RD];
#pragma unroll
            for (int s = 0; s < RD; ++s) fr[s] = *(const LAS bf16x8*)(kp + (s / NK) * 32 * G::KSTR + 32 * (s % NK));
#pragma unroll
            for (int s = 0; s < NS; ++s) { sc[s / NK] = MFMA32(fr[s % RD], qf[s % NK], (s % NK == 0) ? nmref : sc[s / NK]);
                if (s + RD < NS) fr[s % RD] = *(const LAS bf16x8*)(kp + ((s + RD) / NK) * 32 * G::KSTR + 32 * ((s + RD) % NK)); }
            const LAS unsigned char* vp = B + G::KBYTES + r * G::VSTR + 16 * h;
#pragma unroll
            for (int v = 0; v < RD; ++v) fr[v] = *(const LAS bf16x8*)(vp + (v & 1) * 32 * G::VSTR + (v >> 1) * 32);
            __builtin_amdgcn_sched_group_barrier(0x100, RD, 0);
#pragma unroll
            for (int s = 0; s < NS - RD; ++s) { __builtin_amdgcn_sched_group_barrier(0x008, 1, 0); __builtin_amdgcn_sched_group_barrier(0x100, 1, 0); }
            __builtin_amdgcn_sched_group_barrier(0x008, RD, 0);
            __builtin_amdgcn_sched_group_barrier(0x100, RD, 0);
            if (NAT && t < n1) {
                const LAS float* trl = tab + (gr - grow + 7) * 128 + (8 * h - qc + 63);
#pragma unroll
                for (int j = 0; j < 2; ++j) { float bv[16];
#pragma unroll
                    for (int i = 0; i < 16; ++i) bv[i] = trl[32 * j + ((i & 3) | (((i >> 2) & 1) << 2) | ((i >> 3) << 4))];
                    asm volatile("" : "+v"(bv[0]), "+v"(bv[1]), "+v"(bv[2]), "+v"(bv[3]), "+v"(bv[4]), "+v"(bv[5]), "+v"(bv[6]), "+v"(bv[7]), "+v"(bv[8]), "+v"(bv[9]), "+v"(bv[10]), "+v"(bv[11]), "+v"(bv[12]), "+v"(bv[13]), "+v"(bv[14]), "+v"(bv[15]));
#pragma unroll
                    for (int i = 0; i < 16; ++i) {
                        const int cc = 32 * j + ((i & 3) | (((i >> 2) & 1) << 2) | ((i >> 3) << 4)) + 8 * h; const bool ok = (cc >= cs) && (cc < cs + 16);
                        sc[j][i] = ok ? sc[j][i] + bv[i] : -1e30f;
                    } }
            }
            float mx = max16_acc(max16_acc(-3.0e38f, sc[0]), sc[1]);
            if (first || __builtin_amdgcn_ballot_w64(mx > THR) != 0ull) {
                mx = fmaxf(mx, xor32(mx, C.lane));
                const float delta = first ? mx : fmaxf(mx, 0.f);
#pragma unroll
                for (int i = 0; i < 16; ++i) { sc[0][i] -= delta; sc[1][i] -= delta; }
                if (!first) { const float alpha = __builtin_amdgcn_exp2f(-delta); l *= alpha;
#pragma unroll
                    for (int i = 0; i < 16; ++i) { o[0][i] *= alpha; o[1][i] *= alpha; } }
                mref += delta; first = false;
#pragma unroll
                for (int i = 0; i < 16; ++i) nmref[i] = -mref;
            }
            float rs1 = 0.f;
#pragma unroll
            for (int j = 0; j < 2; ++j)
#pragma unroll
                for (int i = 0; i < 16; ++i) { sc[j][i] = __builtin_amdgcn_exp2f(sc[j][i]); rs1 += sc[j][i]; }
            l += rs1;
#pragma unroll
            for (int j = 0; j < 2; ++j)
#pragma unroll
                for (int s2 = 0; s2 < 2; ++s2) {
                    u32x4 pw; pw.x = pk2(sc[j][8 * s2], sc[j][8 * s2 + 1]); pw.y = pk2(sc[j][8 * s2 + 2], sc[j][8 * s2 + 3]); pw.z = pk2(sc[j][8 * s2 + 4], sc[j][8 * s2 + 5]); pw.w = pk2(sc[j][8 * s2 + 6], sc[j][8 * s2 + 7]);
                    const bf16x8 pb = __builtin_bit_cast(bf16x8, pw);
#pragma unroll
                    for (int dt = 0; dt < 2; ++dt) { const int v = 4 * j + 2 * s2 + dt;
                        o[dt] = MFMA32(fr[v % RD], pb, o[dt]);
                        if (v + RD < 8) fr[v % RD] = *(const LAS bf16x8*)(vp + ((v + RD) & 1) * 32 * G::VSTR + ((v + RD) >> 1) * 32); }
                }
#pragma unroll
            for (int v = 0; v < 8 - RD; ++v) { __builtin_amdgcn_sched_group_barrier(0x008, 1, 1); __builtin_amdgcn_sched_group_barrier(0x100, 1, 1); }
            __builtin_amdgcn_sched_group_barrier(0x008, RD, 1);
        }
        if (t + 1 < ntiles) { LAS unsigned char* Bn = C.lds + ((t + 1) & 1) * G::BUF;
            *(LAS u32x4*)(Bn + kl0) = rk0; if (K2 && tid < 256) *(LAS u32x4*)(Bn + kl1) = rk1; *(LAS u32x4*)(Bn + vl) = rv; }
        __syncthreads();
    }
    __builtin_amdgcn_s_setprio(0);
    l += xor32(l, C.lane);
#undef ATT_POS
}
DI void conv_unit(const Ctx& C, int u, const bf16* U, const float (&wk)[31], float bias, const float* lng, const float* lnb, bf16* OCAT);
DI const float* in_ptr(const unsigned char* ws, int k);
constexpr int CONV_PER_TAIL = 3;
DI int conv_in_fin(int nb) { const int extra = (MT / 64) % nb; const int n = CONV_PER_TAIL * (nb - extra); return n < MT / 32 ? n : MT / 32; }
DI void ph_attn_mla2(const Ctx& C, const bf16* QB, const bf16* KB, const bf16* VT, bf16* OCAT, bool last, unsigned char* ws, int lq) {
    const int r = C.lane & 31, h = C.lane >> 5;
    const int nunits = 1024 + (last ? 0 : 64);
    int k = 0;
    for (;; ++k) {
        const int u = C.vcu + k * C.nb, cu = conv_in_fin(C.nb) + (C.nb - 1 - C.vcu) + k * C.nb;
        const bool a_on = u < nunits, c_on = cu < MT / 32;
        if (!a_on && !c_on) break;
        if (a_on) {
            const int bh = u < 1024 ? (u >> 4) : u - 1024, qblk = u < 1024 ? (u & 15) : 16, b = bh >> 3, hh = bh & 7;
            const int qpos = qblk * 256 + 32 * C.wave + r;
            const bf16* qp = QB + ((size_t)bh * KPOS + qpos) * 96 + 8 * h;
            bf16x8 qf[6];
#pragma unroll
            for (int kk = 0; kk < 6; ++kk) qf[kk] = *(const bf16x8*)(qp + 16 * kk);
            f32x16 o[2];
#pragma unroll
            for (int i = 0; i < 16; ++i) { o[0][i] = 0.f; o[1][i] = 0.f; }
            float l = 0.f;
            attn_tile_loop<96, false>(C, o, l, qf, KB + (size_t)bh * KPOS * 96, VT + (size_t)bh * 64 * KPOS, qblk < 16 ? 0 : TL, qblk < 16 ? KPOS / 64 : LCX / 64, 0, 0, nullptr, 0, 0, 0, 0);
            const int row = qblk < 16 ? b * TL + qpos : NLAT + b * LCX + (qpos - TL);
            flash_store(o, l, OCAT + (size_t)row * DM + hh * 64, h);
        }
        if (c_on) { float wk[31]; const float* dww = in_ptr(ws, I_DWW) + (size_t)lq * 31 * 512;
#pragma unroll
            for (int kt = 0; kt < 31; ++kt) wk[kt] = dww[kt * 512 + C.tid];
            conv_unit(C, cu, (const bf16*)(ws + WS_ARENA + A_U), wk, in_ptr(ws, I_DWB)[lq * 512 + C.tid], in_ptr(ws, I_LNG) + lq * 512, in_ptr(ws, I_LNB) + lq * 512, OCAT); }
    }
}
DI void ph_natten2(const Ctx& C, const bf16* QN, const bf16* KN, const bf16* VTN, bf16* OCAT, const float* rpb  , bool last, unsigned* work_ctr, unsigned char* ws, int lq) {
    const int r = C.lane & 31, h = C.lane >> 5;
    LAS float* tab = (LAS float*)(C.lds + 2 * AttnGeo<64>::BUF);
    LAS int* uslot = (LAS int*)(tab + 1920);
    const int nunits = 1024 + (last ? 0 : 64);
    for (;;) {
        __syncthreads();
        if (C.tid == 0) *uslot = (int)__hip_atomic_fetch_add(work_ctr, 1u, __ATOMIC_RELAXED, __HIP_MEMORY_SCOPE_AGENT);
        __syncthreads();
        const int u = *uslot;
        if (u >= nunits) break;
        const bool isctx = u >= 1024;
        const int bh = isctx ? u - 1024 : (u >> 4), b = bh >> 3, hh = bh & 7;
        for (int i = C.tid; i < 15 * 128; i += 512) { const int dc = (i & 127) - 48; tab[i] = (dc >= 0 && dc < 31) ? rpb[hh * 465 + (i >> 7) * 31 + dc] * LOG2E : 0.f; }
        int qpos, row, grow = 0, qc = 0, rs = 0, cs = 0, rlo = 0, nband = 0;
        if (!isctx) { const int rg = u & 15; grow = 4 * rg + (C.wave >> 1); qc = 32 * (C.wave & 1) + r; qpos = grow * 64 + qc; row = b * TL + qpos;
            rs = grow - 4; rs = rs < 0 ? 0 : (rs > 56 ? 56 : rs); cs = qc - 8; cs = cs < 0 ? 0 : (cs > 48 ? 48 : cs);
            rlo = 4 * rg - 4; rlo = rlo < 0 ? 0 : (rlo > 56 ? 56 : rlo); int rhi = 4 * rg + 3 - 4; rhi = rhi < 0 ? 0 : (rhi > 56 ? 56 : rhi); nband = rhi + 8 - rlo; }
        else { qpos = TL + 32 * C.wave + r; row = NLAT + b * LCX + 32 * C.wave + r; }
        const bf16* qp = QN + ((size_t)bh * KPOS + qpos) * 64 + 8 * h;
        bf16x8 qf[4];
#pragma unroll
        for (int kk = 0; kk < 4; ++kk) qf[kk] = *(const bf16x8*)(qp + 16 * kk);
        f32x16 o[2];
#pragma unroll
        for (int i = 0; i < 16; ++i) { o[0][i] = 0.f; o[1][i] = 0.f; }
        float l = 0.f;
        attn_tile_loop<64, true>(C, o, l, qf, KN + (size_t)bh * KPOS * 64, VTN + (size_t)bh * 64 * KPOS, rlo * 64, nband, TL, LCX / 64, tab, grow, rs, qc, cs);
        flash_store(o, l, OCAT + (size_t)row * DM + 512 + hh * 64, h);
    }
}


DI void ph_mla_fin(const Ctx& C, const bf16* U, const bf16* QPRE, const bf16* KVPRE, const float* qg, const float* kg, const f32x2* CS, bf16* QB, bf16* KB, bf16* VT) {
    LAS bf16* VL = (LAS bf16*)C.lds;
    const int lane = C.lane, j = lane >> 3, sub = lane & 7;
    const float C2 = 0.10206207261596575f * LOG2E;
    float qgn[8], qgr[4], kgn[8], kgr[4];
#pragma unroll
    for (int e = 0; e < 8; ++e) { qgn[e] = qg[8 * sub + e] * C2; kgn[e] = kg[8 * sub + e]; }
#pragma unroll
    for (int m = 0; m < 4; ++m) { qgr[m] = qg[64 + sub + 8 * m] * C2; kgr[m] = kg[64 + sub + 8 * m]; }
    for (int u = C.vcu; u < MT / 64; u += C.nb) {
        const int row0 = 64 * u, b = row0 < NLAT ? (row0 >> 12) : ((row0 - NLAT) >> 8), pos0 = row0 < NLAT ? (row0 & 4095) : TL + ((row0 - NLAT) & 255);
        const bool lat = row0 < NLAT;
        const int pl = 8 * C.wave + j, row = row0 + pl, pos = pos0 + pl;
        const bf16* ur = U + (size_t)row * EV_INP;
        float sq = 0.f, skv = 0.f;
#pragma unroll
        for (int m = 0; m < 6; ++m) { float x[8]; unpack8(*(const u32x4*)(ur + 8 * (sub + 8 * m)), x);
#pragma unroll
            for (int e = 0; e < 8; ++e) sq += x[e] * x[e]; }
#pragma unroll
        for (int m = 0; m < 4; ++m) { float x[8]; unpack8(*(const u32x4*)(ur + 384 + 8 * (sub + 8 * m)), x);
#pragma unroll
            for (int e = 0; e < 8; ++e) skv += x[e] * x[e]; }
        sq = sum8(sq); skv = sum8(skv);
        const float rsq = 1.0f / sqrtf(sq * (1.f / 384.f) + EPS), rskv = 1.0f / sqrtf(skv * (1.f / 256.f) + EPS);
        float krv[4];
#pragma unroll
        for (int m = 0; m < 4; ++m) krv[m] = bf2f(ur[640 + sub + 8 * m]);
        float cr = 1.f, sr = 0.f, cc = 1.f, sc = 0.f;
        if (lat) { const f32x2 a0 = CS[pos * 16 + sub], a1 = CS[pos * 16 + 8 + sub]; cr = a0.x; sr = a0.y; cc = a1.x; sc = a1.y; }
        const bf16* qrow = QPRE + (size_t)row * 768; const bf16* kvrow = KVPRE + (size_t)row * 1024;
#pragma unroll 2
        for (int hh = 0; hh < 8; ++hh) {
            { float qn[8], qr[4]; unpack8(*(const u32x4*)(qrow + hh * 96 + 8 * sub), qn); float ss = 0.f;
#pragma unroll
              for (int e = 0; e < 8; ++e) qn[e] *= rsq;
#pragma unroll
              for (int m = 0; m < 4; ++m) { qr[m] = bf2f(qrow[hh * 96 + 64 + sub + 8 * m]) * rsq; ss += qr[m] * qr[m]; }
#pragma unroll
              for (int e = 0; e < 8; ++e) ss += qn[e] * qn[e];
              const float rn = 1.0f / sqrtf(sum8(ss) * (1.f / 96.f) + EPS);
#pragma unroll
              for (int e = 0; e < 8; ++e) qn[e] *= rn * qgn[e];
#pragma unroll
              for (int m = 0; m < 4; ++m) qr[m] *= rn * qgr[m];
              { const float x0 = qr[0], x1 = qr[1], y0 = qr[2], y1 = qr[3]; qr[0] = x0 * cr - x1 * sr; qr[1] = x1 * cr + x0 * sr; qr[2] = y0 * cc - y1 * sc; qr[3] = y1 * cc + y0 * sc; }
              bf16* qo = QB + ((size_t)(b * 8 + hh) * KPOS + pos) * 96;
              *(u32x4*)(qo + 8 * sub) = pack8(qn);
#pragma unroll
              for (int m = 0; m < 4; ++m) qo[64 + sub + 8 * m] = f2bf(qr[m]); }
            { float kn[8], kr[4]; unpack8(*(const u32x4*)(kvrow + hh * 128 + 8 * sub), kn); float ss = 0.f;
#pragma unroll
              for (int e = 0; e < 8; ++e) kn[e] *= rskv;
#pragma unroll
              for (int m = 0; m < 4; ++m) { kr[m] = krv[m]; ss += kr[m] * kr[m]; }
#pragma unroll
              for (int e = 0; e < 8; ++e) ss += kn[e] * kn[e];
              const float rn = 1.0f / sqrtf(sum8(ss) * (1.f / 96.f) + EPS);
#pragma unroll
              for (int e = 0; e < 8; ++e) kn[e] *= rn * kgn[e];
#pragma unroll
              for (int m = 0; m < 4; ++m) kr[m] *= rn * kgr[m];
              { const float x0 = kr[0], x1 = kr[1], y0 = kr[2], y1 = kr[3]; kr[0] = x0 * cr - x1 * sr; kr[1] = x1 * cr + x0 * sr; kr[2] = y0 * cc - y1 * sc; kr[3] = y1 * cc + y0 * sc; }
              bf16* ko = KB + ((size_t)(b * 8 + hh) * KPOS + pos) * 96;
              *(u32x4*)(ko + 8 * sub) = pack8(kn);
#pragma unroll
              for (int m = 0; m < 4; ++m) ko[64 + sub + 8 * m] = f2bf(kr[m]); }
            { float vv[8]; unpack8(*(const u32x4*)(kvrow + hh * 128 + 64 + 8 * sub), vv);
#pragma unroll
              for (int e = 0; e < 8; ++e) VL[(hh * 64 + 8 * sub + e) * 64 + pl] = f2bf(vv[e] * rskv); }
        }
        __syncthreads();
        { const int hd = C.tid;
            bf16* dst = VT + ((size_t)(b * 8 + (hd >> 6)) * 64 + (hd & 63)) * KPOS + pos0;
#pragma unroll
            for (int q = 0; q < 8; ++q) *(u32x4*)(dst + 8 * q) = *(const LAS u32x4*)(VL + hd * 64 + 8 * q); }
        __syncthreads();
    }
}

DI void conv_unit(const Ctx& C, int u, const bf16* U, const float (&wk)[31], float bias, const float* lng, const float* lnb, bf16* OCAT) {
    LAS float* G = (LAS float*)C.lds;
    const int c = C.tid;
    const int row0 = 32 * u; int base, t0, tseq;
    if (row0 < NLAT) { base = row0 & ~4095; t0 = row0 & 4095; tseq = TL; } else { const int rc = row0 - NLAT; base = NLAT + (rc & ~255); t0 = rc & 255; tseq = LCX; }
    __syncthreads();
    for (int rr = C.wave; rr < 62; rr += 8) { const int tt = t0 - 15 + rr; float g[8];
#pragma unroll
        for (int e = 0; e < 8; ++e) g[e] = 0.f;
        if (tt >= 0 && tt < tseq) { const bf16* ur = U + (size_t)(base + tt) * EV_INP; float av[8], gv[8]; unpack8(*(const u32x4*)(ur + 672 + 8 * C.lane), av); unpack8(*(const u32x4*)(ur + 1184 + 8 * C.lane), gv);
#pragma unroll
            for (int e = 0; e < 8; ++e) g[e] = av[e] * sigmoidf_(gv[e]); }
        *(LAS f32x4*)(G + rr * 512 + 8 * C.lane) = (f32x4){g[0], g[1], g[2], g[3]}; *(LAS f32x4*)(G + rr * 512 + 8 * C.lane + 4) = (f32x4){g[4], g[5], g[6], g[7]}; }
    __syncthreads();
    float acc[32];
#pragma unroll
    for (int t = 0; t < 32; ++t) acc[t] = bias;
#pragma unroll
    for (int rr = 0; rr < 62; ++rr) { const float gv = G[rr * 512 + c];
#pragma unroll
        for (int t = 0; t < 32; ++t) { const int k = rr - t; if (k >= 0 && k < 31) acc[t] += gv * wk[k]; } }
    __syncthreads();
#pragma unroll
    for (int t = 0; t < 32; ++t) G[t * 512 + c] = acc[t];
    __syncthreads();
#pragma unroll
    for (int q = 0; q < 4; ++q) {
        const int t = 4 * C.wave + q, row = row0 + t;
        const f32x4 a0 = *(const LAS f32x4*)(G + t * 512 + 8 * C.lane), a1 = *(const LAS f32x4*)(G + t * 512 + 8 * C.lane + 4);
        float x[8] = {a0.x, a0.y, a0.z, a0.w, a1.x, a1.y, a1.z, a1.w}; float s = 0.f;
#pragma unroll
        for (int e = 0; e < 8; ++e) s += x[e];
        const float mu = wave_sum(s) * (1.f / 512.f); float s2 = 0.f;
#pragma unroll
        for (int e = 0; e < 8; ++e) { x[e] -= mu; s2 += x[e] * x[e]; }
        const float rstd = 1.0f / sqrtf(wave_sum(s2) * (1.f / 512.f) + EPS);
        float y[8];
#pragma unroll
        for (int e = 0; e < 8; ++e) { const float z = x[e] * rstd * lng[8 * C.lane + e] + lnb[8 * C.lane + e]; y[e] = siluf_(z); }
        *(u32x4*)(OCAT + (size_t)row * DM + 512 + 8 * C.lane) = pack8(y);
    }
    __syncthreads();
}
DI void wprep_span(const Ctx& C, int first, int stride, const float* w1, const float* w3, const float* w2, bf16* W13, bf16* W2) {
    LAS float* scr = (LAS float*)(C.lds + C.wave * 16640);
    constexpr int PER = 16 * 16, NIT = NEXP * 3 * PER;
    for (int it = first; it < NIT; it += stride) {
        const int e = it / (3 * PER), r = it % (3 * PER), which = r / PER, q = r % PER, kb = q / 16, n0 = (q % 16) * 64;
#if MOE_F8
        if (which == 0)      transpose_item64_f8(w1 + (size_t)e * DM * DM, DM, DM, (unsigned char*)W13 + (size_t)e * 2048 * DM, (n0 >> 7) * 256 + (n0 & 127), scr, kb * 64, n0, C.lane);
        else if (which == 1) transpose_item64_f8(w3 + (size_t)e * DM * DM, DM, DM, (unsigned char*)W13 + (size_t)e * 2048 * DM, (n0 >> 7) * 256 + (n0 & 127) + 128, scr, kb * 64, n0, C.lane);
        else                 transpose_item64_f8(w2 + (size_t)e * DM * DM, DM, DM, (unsigned char*)W2 + (size_t)e * DM * DM, n0, scr, kb * 64, n0, C.lane); }
#else
        if (which == 0)      transpose_item64(w1 + (size_t)e * DM * DM, DM, DM, W13 + (size_t)e * 2048 * DM, (n0 >> 7) * 256 + (n0 & 127), scr, kb * 64, n0, C.lane);
        else if (which == 1) transpose_item64(w3 + (size_t)e * DM * DM, DM, DM, W13 + (size_t)e * 2048 * DM, (n0 >> 7) * 256 + (n0 & 127) + 128, scr, kb * 64, n0, C.lane);
        else                 transpose_item64(w2 + (size_t)e * DM * DM, DM, DM, W2 + (size_t)e * DM * DM, n0, scr, kb * 64, n0, C.lane); }
#endif
}
constexpr int WPREP_PER_WAVE = (NEXP * 3 * 256 + 2047) / 2048;

DI void shifted8(const bf16* __restrict__ up, const bf16* __restrict__ uc, const bf16* __restrict__ un, bool hp, bool hn, const float (&s0)[8], const float (&s1)[8], const float (&s2)[8], int c0, float (&o)[8]) {
    const u32x4 z = {0u, 0u, 0u, 0u};
    const u32x4 vp = hp ? *(const u32x4*)(up + c0) : z, vc = *(const u32x4*)(uc + c0), vn = hn ? *(const u32x4*)(un + c0) : z;
    float p[8], c[8], n[8]; unpack8(vp, p); unpack8(vc, c); unpack8(vn, n);
#pragma unroll
    for (int e = 0; e < 8; ++e) o[e] = p[e] * s0[e] + c[e] * s1[e] + n[e] * s2[e];
}
DI void load_sw(const float* sw, int c0, float (&s0)[8], float (&s1)[8], float (&s2)[8]) {
#pragma unroll
    for (int e = 0; e < 8; ++e) { s0[e] = sw[c0 + e]; s1[e] = sw[RW_IN + c0 + e]; s2[e] = sw[2 * RW_IN + c0 + e]; }
}
DI void ph_prep(const Ctx& C, const bf16* __restrict__ U, const float* __restrict__ sw  , const float* __restrict__ kkw  , const float* __restrict__ naqg, const float* __restrict__ nakg,
                bf16* __restrict__ R, bf16* __restrict__ V, bf16* __restrict__ K, bf16* __restrict__ KK, bf16* __restrict__ L, bf16* __restrict__ QN, bf16* __restrict__ KN, bf16* __restrict__ VTN) {
    LAS bf16* VL = (LAS bf16*)C.lds;
    const int lane = C.lane, hh = lane >> 3, sub = lane & 7;
    const float C2 = 0.125f * LOG2E;
    for (int u = C.vcu; u < MT / 32; u += C.nb) {
        const int row0 = 32 * u; const bool lat = row0 < NLAT;
        const int b = lat ? (row0 >> 12) : ((row0 - NLAT) >> 8), pos0 = lat ? (row0 & 4095) : TL + ((row0 - NLAT) & 255), tseq = lat ? TL : LCX, tb = lat ? (row0 & 4095) : ((row0 - NLAT) & 255);
#define PREP_ROWVARS(i) const int pl = 4 * C.wave + (i), row = row0 + pl, t = tb + pl; const bool hp = t > 0, hn = t < tseq - 1; \
            const bf16* uc = U + (size_t)row * OD_INP; const bf16* up = uc - OD_INP; const bf16* un = uc + OD_INP
        { float s0[8], s1[8], s2[8]; load_sw(sw, 8 * lane, s0, s1, s2);
          _Pragma("unroll") for (int i = 0; i < 4; ++i) { PREP_ROWVARS(i); float o[8]; shifted8(up, uc, un, hp, hn, s0, s1, s2, 8 * lane, o); *(u32x4*)(R + (size_t)row * 512 + 8 * lane) = pack8(o); } }
        { float s0[8], s1[8], s2[8]; load_sw(sw, 1024 + 8 * lane, s0, s1, s2);
          _Pragma("unroll") for (int i = 0; i < 4; ++i) { PREP_ROWVARS(i); float o[8]; shifted8(up, uc, un, hp, hn, s0, s1, s2, 1024 + 8 * lane, o); *(u32x4*)(V + (size_t)row * 512 + 8 * lane) = pack8(o); } }
        { float s0[8], s1[8], s2[8]; load_sw(sw, 512 + 8 * lane, s0, s1, s2); float kw[8];
#pragma unroll
          for (int e = 0; e < 8; ++e) kw[e] = kkw[8 * lane + e];
          _Pragma("unroll") for (int i = 0; i < 4; ++i) { PREP_ROWVARS(i); float o[8]; shifted8(up, uc, un, hp, hn, s0, s1, s2, 512 + 8 * lane, o); *(u32x4*)(K + (size_t)row * 512 + 8 * lane) = pack8(o);
              float kk[8]; float ss = 0.f;
#pragma unroll
              for (int e = 0; e < 8; ++e) { kk[e] = o[e] * kw[e]; ss += kk[e] * kk[e]; }
              ss = sum8(ss); const float rn = 1.0f / sqrtf(ss + 1e-12f);
#pragma unroll
              for (int e = 0; e < 8; ++e) kk[e] *= rn;
              *(u32x4*)(KK + (size_t)row * 512 + 8 * lane) = pack8(kk); } }
        if (lane < 48) { float s0[8], s1[8], s2[8]; load_sw(sw, 1536 + 8 * lane, s0, s1, s2);
          _Pragma("unroll") for (int i = 0; i < 4; ++i) { PREP_ROWVARS(i); float o[8]; shifted8(up, uc, un, hp, hn, s0, s1, s2, 1536 + 8 * lane, o);
              if (lane < 16) {
#pragma unroll
                  for (int e = 0; e < 8; ++e) { const float ex = __expf(2.f * o[e]); o[e] = 1.f - 2.f * __builtin_amdgcn_rcpf(ex + 1.f); }
              } else if (lane >= 32) {
#pragma unroll
                  for (int e = 0; e < 8; ++e) o[e] = sigmoidf_(o[e]);
              }
              *(u32x4*)(L + (size_t)row * 384 + 8 * lane) = pack8(o); } }
        { float gq[8], gk[8];
#pragma unroll
          for (int e = 0; e < 8; ++e) { gq[e] = naqg[8 * sub + e] * C2; gk[e] = nakg[8 * sub + e]; }
          _Pragma("unroll") for (int i = 0; i < 4; ++i) { const int pl = 4 * C.wave + i, row = row0 + pl, pos = pos0 + pl; const bf16* uc = U + (size_t)row * OD_INP;
            { float x[8]; unpack8(*(const u32x4*)(uc + RW_IN + 8 * lane), x); float ss = 0.f;
#pragma unroll
                for (int e = 0; e < 8; ++e) ss += x[e] * x[e];
                ss = sum8(ss); const float rn = 1.0f / sqrtf(ss * (1.f / 64.f) + EPS);
#pragma unroll
                for (int e = 0; e < 8; ++e) x[e] = x[e] * rn * gq[e];
                *(u32x4*)(QN + ((size_t)(b * 8 + hh) * KPOS + pos) * 64 + 8 * sub) = pack8(x); }
            { float x[8]; unpack8(*(const u32x4*)(uc + RW_IN + 512 + 8 * lane), x); float ss = 0.f;
#pragma unroll
                for (int e = 0; e < 8; ++e) ss += x[e] * x[e];
                ss = sum8(ss); const float rn = 1.0f / sqrtf(ss * (1.f / 64.f) + EPS);
#pragma unroll
                for (int e = 0; e < 8; ++e) x[e] = x[e] * rn * gk[e];
                *(u32x4*)(KN + ((size_t)(b * 8 + hh) * KPOS + pos) * 64 + 8 * sub) = pack8(x); }
            { const u32x4 vv = *(const u32x4*)(uc + RW_IN + 1024 + 8 * lane); const unsigned w4[4] = {vv.x, vv.y, vv.z, vv.w};
#pragma unroll
                for (int e = 0; e < 8; ++e) { const int dv = 8 * sub + e; VL[(hh * 64 + dv) * 32 + pl] = (bf16)((e & 1) ? (w4[e >> 1] >> 16) : (w4[e >> 1] & 0xffffu)); } } } }
#undef PREP_ROWVARS
        __syncthreads();
        { const int hd = C.tid; bf16* dst = VTN + ((size_t)(b * 8 + (hd >> 6)) * 64 + (hd & 63)) * KPOS + pos0;
#pragma unroll
            for (int q = 0; q < 4; ++q) *(u32x4*)(dst + 8 * q) = *(const LAS u32x4*)(VL + hd * 32 + 8 * q); }
        __syncthreads();
    }
}

DI int scan_row(int s, int d, int b) { if (s < LCX) return NLAT + b * LCX + (d ? (LCX - 1 - s) : s); const int t = s - LCX; return b * TL + (d ? (TL - 1 - t) : t); }


constexpr int CCH = 16, NCHK = KPOS / CCH, NPROB = NB * 8 * 2 * NCHK, IMG_ELEMS = 3 * 32 * 16;
template <int N> struct ICk { static constexpr int value = N; };
DI int crow_(int reg, int h) { return (reg & 3) + 8 * (reg >> 2) + 4 * h; }
DI bf16x8 pack_lo8(const f32x16& x) {
    u32x4 p; p.x = pk2(x[0], x[1]); p.y = pk2(x[2], x[3]); p.z = pk2(x[4], x[5]); p.w = pk2(x[6], x[7]); return __builtin_bit_cast(bf16x8, p); }
DI bf16x8 pack_hi8(const f32x16& x) { u32x4 p; p.x = pk2(x[8], x[9]); p.y = pk2(x[10], x[11]); p.z = pk2(x[12], x[13]); p.w = pk2(x[14], x[15]); return __builtin_bit_cast(bf16x8, p); }
DI int perm16(int k) { return (k & ~15) | swap23(k & 15); }

DI void ph_wkv_pre(const Ctx& C, const bf16* R, const bf16* K, const bf16* KK, const unsigned short* LW, const bf16* AR_, const float* ka, bf16* IMG) {
    LAS unsigned char* wl = C.lds + C.wave * 13312;
    LAS bf16* ARl = (LAS bf16*)wl; LAS bf16* BKl = (LAS bf16*)(wl + 4608); LAS float* Ll = (LAS float*)(wl + 9216); LAS bf16* OUT = (LAS bf16*)(wl + 10240);
    const int lane = C.lane, r = lane & 31, h = lane >> 5;
    const int gw = C.vcu * 8 + C.wave, ngw = C.nb * 8;
    for (int p = gw; p < NPROB; p += ngw) {
        const int j = p % NCHK, rest = p / NCHK, d = rest & 1, hh = (rest >> 1) & 7, b = rest >> 4;
        const unsigned short* Wd = LW + (size_t)d * MT * 512; const bf16* Ad = AR_ + (size_t)d * MT * 512;
        const float kav = ka[hh * 64 + lane];
        const int row0 = scan_row(j * CCH, d, b), sg = d ? -1 : 1;
        float lw[16]; bf16 rr[16], kx[16], kkx[16], ax[16];
#pragma unroll
        for (int t = 0; t < 16; ++t) { const size_t off = (size_t)(row0 + sg * t) * 512 + hh * 64 + lane; lw[t] = h2f(Wd[off]); rr[t] = R[off]; kx[t] = K[off]; kkx[t] = KK[off]; ax[t] = Ad[off]; }
        float cum = 0.f, e0 = 1.f;
#pragma unroll
        for (int t = 0; t < 16; ++t) {
            cum += lw[t]; const float e1 = __expf(cum), ei = __builtin_amdgcn_rcpf(e1);
            const float kkv = bf2f(kkx[t]), av = bf2f(ax[t]), keff = bf2f(kx[t]) * (1.f + (av - 1.f) * kav);
            ARl[t * 72 + lane] = f2bf(-kkv * e0); ARl[(16 + t) * 72 + lane] = f2bf(bf2f(rr[t]) * e1);
            BKl[t * 72 + lane] = f2bf(kkv * av * ei); BKl[(16 + t) * 72 + lane] = f2bf(keff * ei);
            e0 = e1;
        }
        asm volatile("s_waitcnt lgkmcnt(0)" ::: "memory");
        f32x16 g;
#pragma unroll
        for (int i = 0; i < 16; ++i) g[i] = 0.f;
#pragma unroll
        for (int q = 0; q < 4; ++q) g = MFMA32(*(const LAS bf16x8*)(ARl + r * 72 + 16 * q + 8 * h), *(const LAS bf16x8*)(BKl + r * 72 + 16 * q + 8 * h), g);
        const int sI = r & 15; const bool isk = r >= 16;
#pragma unroll
        for (int i = 0; i < 16; ++i) {
            const int row = crow_(i, h), t = row & 15; const bool keep = (i < 8) ? (sI < t) : (sI <= t); const float val = keep ? g[i] : 0.f;
            if (i < 8) { if (!isk) { Ll[t * 16 + sI] = val; OUT[512 + row * 16 + perm16(sI)] = 0; } else OUT[row * 16 + sI] = f2bf(val); }
            else       { if (!isk) OUT[512 + row * 16 + perm16(sI)] = f2bf(val); else OUT[row * 16 + sI] = f2bf(val); }
        }
        asm volatile("s_waitcnt lgkmcnt(0)" ::: "memory");
        { const int c = lane & 15; float Pr[16];
            Pr[0] = (c == 0) ? 1.f : 0.f;
#pragma unroll
            for (int t = 1; t < 16; ++t) { const float lrow = Ll[t * 16 + c]; float acc = (c == t) ? 1.f : 0.f;
#pragma unroll
                for (int u = 0; u < t; ++u) acc += rdlane(lrow, u) * Pr[u];
                Pr[t] = acc; }
            if (lane < 16) {
#pragma unroll
                for (int t = 0; t < 16; ++t) { OUT[1024 + t * 16 + perm16(c)] = f2bf(Pr[t]); OUT[1024 + (16 + t) * 16 + c] = 0; } } }
        asm volatile("s_waitcnt lgkmcnt(0)" ::: "memory");
        { bf16* dst = IMG + (size_t)p * IMG_ELEMS;
#pragma unroll
            for (int q = 0; q < 3; ++q) *(u32x4*)(dst + (q * 64 + lane) * 8) = *(const LAS u32x4*)(OUT + (q * 64 + lane) * 8); }
        asm volatile("s_waitcnt lgkmcnt(0)" ::: "memory");
    }
}

DI void ph_wkv_chunk(const Ctx& C, const bf16* R, const bf16* V, const bf16* K, const bf16* KK, const unsigned short* LW, const bf16* AR_, const float* ka, const bf16* IMG, bf16* YS) {
    constexpr int S_AR = 0, S_BKT = 4608, S_VT = 9728, S_VT2 = 11264, S_GC = 12800, S_MM = 13056, S_MRB = 14592, S_PP = 16128, SLOT = 17664, CUMO = 2 * SLOT, YSTO = CUMO + 8192, DEPTH = 4;
    const int lane = C.lane, wv = C.wave, r = lane & 31, h = lane >> 5;
    const bool isE = wv == 2 || wv == 3 || wv == 6 || wv == 7, isS = wv < 2;
    const int te = (wv == 2 ? 0 : (wv == 3 ? 1 : (wv == 6 ? 2 : 3))) * 64 + lane, et = te >> 4, ekq = te & 15;
    const int vhf = te >> 7, vt = (te >> 3) & 15, viq = te & 7;
    const int hf = wv & 1;
    for (int cid0 = C.bid; cid0 < 128; cid0 += C.nb) {
        const int chain = cid0, b = chain >> 4, hh = (chain >> 1) & 7, d = chain & 1;
        const unsigned short* Wd = LW + (size_t)d * MT * 512; const bf16* Ad = AR_ + (size_t)d * MT * 512; bf16* Yd = YS + (size_t)d * MT * 512;
        const bf16* img = IMG + (size_t)(((b * 8 + hh) * 2 + d) * NCHK) * IMG_ELEMS;
        f32x16 ST[2];
#pragma unroll
        for (int i = 0; i < 16; ++i) { ST[0][i] = 0.f; ST[1][i] = 0.f; }
        const f32x4 kav = *(const f32x4*)(ka + hh * 64 + 4 * ekq);
        unsigned ring[DEPTH][16];
        __syncthreads();
        auto issue = [&](int ch, unsigned (&rg)[16]) __attribute__((always_inline)) {
            if (ch < 0 || ch >= NCHK) return;
            const int row0 = scan_row(ch * CCH, d, b), sg = d ? -1 : 1;
            if (isE) {
                const size_t off = (size_t)(row0 + sg * et) * 512 + hh * 64 + 4 * ekq;
                const u32x2 x0 = *(const u32x2*)(R + off), x1 = *(const u32x2*)(K + off), x2 = *(const u32x2*)(KK + off), x3 = *(const u32x2*)(Ad + off);
                const u32x2 x4 = *(const u32x2*)(V + (size_t)(row0 + sg * vt) * 512 + hh * 64 + 32 * vhf + 4 * viq);
                rg[0] = x0.x; rg[1] = x0.y; rg[2] = x1.x; rg[3] = x1.y; rg[4] = x2.x; rg[5] = x2.y; rg[6] = x3.x; rg[7] = x3.y; rg[8] = x4.x; rg[9] = x4.y;
                asm volatile("; wkv issue role E" ::);
            } else if (wv == 4) {
#define W5_(t) rg[(t)] = (unsigned)Wd[(size_t)(row0 + sg * (t)) * 512 + hh * 64 + lane]
                W5_(0); W5_(1); W5_(2); W5_(3); W5_(4); W5_(5); W5_(6); W5_(7); W5_(8); W5_(9); W5_(10); W5_(11); W5_(12); W5_(13); W5_(14); W5_(15);
#undef W5_
                asm volatile("; wkv issue role C" ::);
            } else if (wv == 5) {
#define W6_(q) do { const u32x4 x = *(const u32x4*)(img + (size_t)ch * IMG_ELEMS + ((q) * 64 + lane) * 8); rg[4 * (q)] = x.x; rg[4 * (q) + 1] = x.y; rg[4 * (q) + 2] = x.z; rg[4 * (q) + 3] = x.w; } while (0)
                W6_(0); W6_(1); W6_(2);
#undef W6_
                asm volatile("; wkv issue role V" ::);
            }
        };
        issue(0, ring[0]); issue(1, ring[1]); issue(2, ring[2]); issue(3, ring[3]);
#define WKV_BAR() asm volatile("s_waitcnt lgkmcnt(0)\n\ts_barrier" ::: "memory")
#define WKV_LOOP(...) for (int n0 = -2; n0 < NCHK; n0 += DEPTH) { auto iter = [&](auto kc) __attribute__((always_inline)) { constexpr int kk = decltype(kc)::value; \
            constexpr int riE = (kk + 3) % DEPTH, riW = kk % DEPTH; (void)riE; (void)riW; const int n = n0 + kk; (void)n; __VA_ARGS__; WKV_BAR(); }; iter(ICk<0>{}); iter(ICk<1>{}); iter(ICk<2>{}); iter(ICk<3>{}); }
        if (isS) {
            WKV_LOOP({
                if (n >= 0 && n < NCHK) {
                    const LAS unsigned char* B = C.lds + (n & 1) * SLOT;
                    f32x16 T1;
                    _Pragma("unroll") for (int i = 0; i < 16; ++i) T1[i] = 0.f;
                    _Pragma("unroll") for (int tau = 0; tau < 2; ++tau) {
                        T1 = MFMA32(*(const LAS bf16x8*)(B + S_AR + r * 144 + (32 * tau + 8 * h) * 2), pack_lo8(ST[tau]), T1);
                        T1 = MFMA32(*(const LAS bf16x8*)(B + S_AR + r * 144 + (32 * tau + 16 + 8 * h) * 2), pack_hi8(ST[tau]), T1);
                    }
                    const bf16x8 vtf = *(const LAS bf16x8*)(B + (hf ? S_VT2 : S_VT) + r * 48 + 16 * h);
                    T1 = MFMA32(*(const LAS bf16x8*)(B + S_MM + r * 48 + 16 * h), vtf, T1);
                    f32x16 ET;
                    _Pragma("unroll") for (int i = 0; i < 16; ++i) ET[i] = 0.f;
                    ET = MFMA32(*(const LAS bf16x8*)(B + S_PP + r * 48 + 16 * h), pack_lo8(T1), ET);
                    const bf16x8 ef = pack_lo8(ET);
                    T1 = MFMA32(*(const LAS bf16x8*)(B + S_MRB + r * 48 + 16 * h), ef, T1);
                    _Pragma("unroll") for (int tau = 0; tau < 2; ++tau) {
                        ST[tau] = MFMA32(*(const LAS bf16x8*)(B + S_BKT + (32 * tau + r) * 80 + 16 * h), ef, ST[tau]);
                        ST[tau] = MFMA32(*(const LAS bf16x8*)(B + S_BKT + (32 * tau + r) * 80 + 32 + 16 * h), vtf, ST[tau]);
                        _Pragma("unroll") for (int g4 = 0; g4 < 4; ++g4) { const f32x4 gc = *(const LAS f32x4*)(B + S_GC + (32 * tau + 8 * g4 + 4 * h) * 4);
                            ST[tau][4 * g4] *= gc.x; ST[tau][4 * g4 + 1] *= gc.y; ST[tau][4 * g4 + 2] *= gc.z; ST[tau][4 * g4 + 3] *= gc.w; }
                    }
                    LAS float* ys = (LAS float*)(C.lds + YSTO) + ((n & 1) * 2 + hf) * 512;
                    _Pragma("unroll") for (int q = 0; q < 8; ++q) ys[(8 * (q >> 2) + 4 * h + (q & 3)) * 32 + r] = T1[8 + q];
                }
            });
        } else if (isE) {
            WKV_LOOP({
                const int ch = n + 1;
                if (ch >= 0) {
                    if (ch < NCHK) {
                        LAS unsigned char* B = C.lds + (ch & 1) * SLOT; const LAS float* ec = (const LAS float*)(C.lds + CUMO) + (ch & 1) * 1024;
                        const f32x4 e1 = *(const LAS f32x4*)(ec + et * 64 + 4 * ekq);
                        f32x4 e0 = {1.f, 1.f, 1.f, 1.f}; if (et > 0) e0 = *(const LAS f32x4*)(ec + (et - 1) * 64 + 4 * ekq);
                        const float rv[4] = {bflo(ring[riE][0]), bfhi(ring[riE][0]), bflo(ring[riE][1]), bfhi(ring[riE][1])}; const float kv[4] = {bflo(ring[riE][2]), bfhi(ring[riE][2]), bflo(ring[riE][3]), bfhi(ring[riE][3])};
                        const float kkv[4] = {bflo(ring[riE][4]), bfhi(ring[riE][4]), bflo(ring[riE][5]), bfhi(ring[riE][5])}; const float av[4] = {bflo(ring[riE][6]), bfhi(ring[riE][6]), bflo(ring[riE][7]), bfhi(ring[riE][7])};
                        float ah[4]; float rh[4]; float bc[4]; float kc4[4];
                        _Pragma("unroll") for (int e = 0; e < 4; ++e) { const float ei = __builtin_amdgcn_rcpf(e1[e]);
                            ah[e] = -kkv[e] * e0[e]; rh[e] = rv[e] * e1[e]; bc[e] = kkv[e] * av[e] * ei; kc4[e] = kv[e] * (1.f + (av[e] - 1.f) * kav[e]) * ei; }
                        const int pk = perm16(4 * ekq);
                        *(LAS u32x2*)((LAS bf16*)(B + S_AR) + et * 72 + pk) = (u32x2){pk2(ah[0], ah[1]), pk2(ah[2], ah[3])};
                        *(LAS u32x2*)((LAS bf16*)(B + S_AR) + (16 + et) * 72 + pk) = (u32x2){pk2(rh[0], rh[1]), pk2(rh[2], rh[3])};
                        const int pt = perm16(et);
                        _Pragma("unroll") for (int e = 0; e < 4; ++e) { ((LAS bf16*)(B + S_BKT))[(4 * ekq + e) * 40 + pt] = f2bf(bc[e]); ((LAS bf16*)(B + S_BKT))[(4 * ekq + e) * 40 + 16 + et] = f2bf(kc4[e]); }
                        if (et == 15) *(LAS f32x4*)((LAS float*)(B + S_GC) + 4 * ekq) = e1;
                        LAS bf16* vtp = (LAS bf16*)(B + (vhf ? S_VT2 : S_VT)) + (4 * viq) * 24 + vt;
                        vtp[0] = (bf16)(ring[riE][8] & 0xffffu); vtp[24] = (bf16)(ring[riE][8] >> 16); vtp[48] = (bf16)(ring[riE][9] & 0xffffu); vtp[72] = (bf16)(ring[riE][9] >> 16);
                    }
                    issue(ch + DEPTH, ring[riE]);
                }
            });
        } else if (wv == 4) {
            WKV_LOOP({
                const int ch = n + 2;
                if (ch < NCHK) { LAS float* ec = (LAS float*)(C.lds + CUMO) + (ch & 1) * 1024; float c = 0.f;
#define C5_(t) do { c += h2f((unsigned short)ring[riW][(t)]); ec[(t) * 64 + lane] = __expf(c); } while (0)
                    C5_(0); C5_(1); C5_(2); C5_(3); C5_(4); C5_(5); C5_(6); C5_(7); C5_(8); C5_(9); C5_(10); C5_(11); C5_(12); C5_(13); C5_(14); C5_(15);
                }
                issue(ch + DEPTH, ring[riW]);
            });
        } else {
            WKV_LOOP({
                { const int chy = n - 1;
                  if (chy >= 0 && chy < NCHK) { const int yh = lane >> 5, yt = (lane & 31) >> 1, yi = 16 * (lane & 1);
                    const LAS float* ys = (const LAS float*)(C.lds + YSTO) + ((chy & 1) * 2 + yh) * 512 + yt * 32 + yi;
                    bf16* dst = Yd + (size_t)(scan_row(chy * CCH, d, b) + (d ? -1 : 1) * yt) * 512 + hh * 64 + 32 * yh + yi;
                    _Pragma("unroll") for (int q = 0; q < 2; ++q) { const f32x4 a0 = *(const LAS f32x4*)(ys + 8 * q); const f32x4 a1 = *(const LAS f32x4*)(ys + 8 * q + 4);
                        *(u32x4*)(dst + 8 * q) = (u32x4){pk2(a0.x, a0.y), pk2(a0.z, a0.w), pk2(a1.x, a1.y), pk2(a1.z, a1.w)}; } } }
                const int ch = n + 1;
                if (ch >= 0) {
                    if (ch < NCHK) { LAS unsigned char* B = C.lds + (ch & 1) * SLOT;
                        const int irow = lane >> 1; const int ihv = lane & 1;
                        *(LAS u32x4*)(B + S_MM + irow * 48 + ihv * 16) = (u32x4){ring[riE][0], ring[riE][1], ring[riE][2], ring[riE][3]};
                        *(LAS u32x4*)(B + S_MRB + irow * 48 + ihv * 16) = (u32x4){ring[riE][4], ring[riE][5], ring[riE][6], ring[riE][7]};
                        *(LAS u32x4*)(B + S_PP + irow * 48 + ihv * 16) = (u32x4){ring[riE][8], ring[riE][9], ring[riE][10], ring[riE][11]};
                    }
                    issue(ch + DEPTH, ring[riE]);
                }
            });
        }
#undef C5_
#undef WKV_LOOP
#undef WKV_BAR
    }
}

DI void ph_post(const Ctx& C, const bf16* YS, const bf16* R, const bf16* V, const bf16* K, const bf16* A2, const float* ka, const bf16* G, const float* rk, const float* gng, const float* gnb, bf16* OCAT, bool last) {
    const int gw = C.bid * 8 + C.wave, ngw = C.nb * 8, lane = C.lane, nrows = last ? NLAT : MT;
    for (int row = gw; row < nrows; row += ngw) {
        const size_t o = (size_t)row * 512 + 8 * lane;
        float y[8], y1[8]; unpack8(*(const u32x4*)(YS + o), y); unpack8(*(const u32x4*)(YS + (size_t)MT * 512 + o), y1);
#pragma unroll
        for (int e = 0; e < 8; ++e) y[e] += y1[e];
        float r[8], v[8], kx[8], a0[8], a1[8], g[8];
        unpack8(*(const u32x4*)(R + o), r); unpack8(*(const u32x4*)(V + o), v); unpack8(*(const u32x4*)(K + o), kx); unpack8(*(const u32x4*)(A2 + o), a0); unpack8(*(const u32x4*)(A2 + (size_t)MT * 512 + o), a1); unpack8(*(const u32x4*)(G + o), g);
        float bsum = 0.f;
#pragma unroll
        for (int e = 0; e < 8; ++e) { const float kae = ka[8 * lane + e]; bsum += r[e] * (kx[e] * (1.f + (a0[e] - 1.f) * kae) + kx[e] * (1.f + (a1[e] - 1.f) * kae)) * rk[8 * lane + e]; }
        bsum = sum8(bsum);
        float s = 0.f;
#pragma unroll
        for (int e = 0; e < 8; ++e) { y[e] += bsum * v[e]; s += y[e]; }
        const float mu = sum8(s) * (1.f / 64.f); float s2 = 0.f;
#pragma unroll
        for (int e = 0; e < 8; ++e) { y[e] -= mu; s2 += y[e] * y[e]; }
        const float rstd = 1.0f / sqrtf(sum8(s2) * (1.f / 64.f) + GN_EPS);
        float out[8];
#pragma unroll
        for (int e = 0; e < 8; ++e) out[e] = (y[e] * rstd * gng[8 * lane + e] + gnb[8 * lane + e]) * g[e];
        *(u32x4*)(OCAT + (size_t)row * DM + 8 * lane) = pack8(out);
    }
}

DI void ph_topk2(const Ctx& C, const float* AFFT, const float* AFFC, int* ROWS, float* GATE, int* SLOT, bool last) {
    LAS unsigned* wcnt = (LAS unsigned*)C.lds;
    LAS unsigned* cnt = wcnt + 16;
    const int tid = C.tid, nprob = last ? 128 : 256;
    for (int p = C.bid; p < nprob; p += C.nb) {
        const bool isctx = p >= 128; const int be = p & 127, b = be >> 4, e = be & 15;
        const int n = isctx ? LCX : TL, cap = isctx ? CAPC : CAPL;
        const float* src = isctx ? AFFC + (size_t)be * LCX : AFFT + (size_t)be * TL;
        unsigned v[8]; const int per = isctx ? 1 : 8, t0 = tid * per;
#pragma unroll
        for (int q = 0; q < 8; ++q) v[q] = 0u;
        if (!isctx) { const u32x4 a0 = *(const u32x4*)(src + t0), a1 = *(const u32x4*)(src + t0 + 4); v[0] = a0.x; v[1] = a0.y; v[2] = a0.z; v[3] = a0.w; v[4] = a1.x; v[5] = a1.y; v[6] = a1.z; v[7] = a1.w; }
        else if (tid < LCX) v[0] = __builtin_bit_cast(unsigned, src[tid]);
        __syncthreads();
        unsigned T = 0u;
        for (int bit = 30; bit >= 0; --bit) {
            const unsigned cand = T | (1u << bit); unsigned c = 0u;
#pragma unroll
            for (int q = 0; q < 8; ++q) c += (unsigned)__builtin_popcountll(__builtin_amdgcn_ballot_w64(v[q] >= cand));
            LAS unsigned* wc = wcnt + (bit & 1) * 8;
            if (C.lane == 0) wc[C.wave] = c;
            __syncthreads();
            const unsigned tot = wc[0] + wc[1] + wc[2] + wc[3] + wc[4] + wc[5] + wc[6] + wc[7];
            if (tot >= (unsigned)cap) T = cand;
        }
        unsigned myc = 0u;
#pragma unroll
        for (int q = 0; q < 8; ++q) myc += (v[q] > T ? 0x10000u : 0u) + ((v[q] == T && (isctx ? (q == 0 && tid < LCX) : true)) ? 1u : 0u);
        __syncthreads();
        cnt[tid] = myc;
        __syncthreads();
        for (int off = 1; off < 512; off <<= 1) { const unsigned add = tid >= off ? cnt[tid - off] : 0u; __syncthreads(); cnt[tid] += add; __syncthreads(); }
        const unsigned total = cnt[511], keq = (unsigned)cap - (total >> 16);
        unsigned before = cnt[tid] - myc;
        for (int q = 0; q < per; ++q) { const int t = t0 + q; if (t >= n) break; const unsigned x = v[q]; const unsigned gtb = before >> 16, eqb = before & 0xFFFFu;
            const bool sel = x > T || (x == T && eqb < keq);
            if (sel) { const int jx = (int)(gtb + (eqb < keq ? eqb : keq));
                const int slot = isctx ? NB * CAPL + b * CAPC + jx : b * CAPL + jx, row = isctx ? NLAT + b * LCX + t : b * TL + t;
                ROWS[e * ESLOTS + slot] = row; GATE[e * ESLOTS + slot] = __builtin_bit_cast(float, x); SLOT[(size_t)row * 16 + e] = slot; }
            before += (x > T ? 0x10000u : 0u) + (x == T ? 1u : 0u); }
        __syncthreads();
    }
}


DI void ph_combine(const Ctx& C, float* xlat, float* xctx, const float* modg2  , const int* SLOT, const bf16* Y2, bool last,
                   const float* ngain  , const float* nmod  , bf16* H) {
    const int gw = C.bid * 8 + C.wave, ngw = C.nb * 8, lane = C.lane, nrows = last ? NLAT : MT;
    int sv_next = (gw < nrows) ? SLOT[(size_t)gw * 16 + (lane & 15)] : -1;
    for (int row = gw; row < nrows; row += ngw) {
        float* xr = row < NLAT ? xlat + (size_t)row * DM : xctx + (size_t)(row - NLAT) * DM;
        const int mi = row < NLAT ? (row >> 12) : 8;
        const int sv = sv_next;
        if (row + ngw < nrows) sv_next = SLOT[(size_t)(row + ngw) * 16 + (lane & 15)];
        f32x4 xv[4], gv[4];
#pragma unroll
        for (int j = 0; j < 4; ++j) { const int c = 256 * j + 4 * lane; gv[j] = *(const f32x4*)(modg2 + mi * 6144 + c); xv[j] = *(const f32x4*)(xr + c); }
        f32x4 acc[4];
#pragma unroll
        for (int j = 0; j < 4; ++j) acc[j] = (f32x4){0.f, 0.f, 0.f, 0.f};
        unsigned mask = (unsigned)__builtin_amdgcn_ballot_w64(sv >= 0) & 0xffffu;
        while (mask) {
            const bf16* yp[4]; float m[4];
            { const int e0 = __builtin_ctz(mask); mask &= mask - 1u; const int s0 = __builtin_amdgcn_readlane(sv, e0); yp[0] = Y2 + ((size_t)e0 * ESLOTS + s0) * DM + 4 * lane; m[0] = 1.f; }
#pragma unroll
            for (int k = 1; k < 4; ++k) {
                if (mask) { const int ek = __builtin_ctz(mask); mask &= mask - 1u; const int sk = __builtin_amdgcn_readlane(sv, ek); yp[k] = Y2 + ((size_t)ek * ESLOTS + sk) * DM + 4 * lane; m[k] = 1.f; }
                else { yp[k] = yp[0]; m[k] = 0.f; } }
            u32x2 w[4][4];
#pragma unroll
            for (int k = 0; k < 4; ++k)
#pragma unroll
                for (int j = 0; j < 4; ++j) w[k][j] = *(const u32x2*)(yp[k] + 256 * j);
#pragma unroll
            for (int k = 0; k < 4; ++k)
#pragma unroll
                for (int j = 0; j < 4; ++j) acc[j] += m[k] * (f32x4){bflo(w[k][j].x), bfhi(w[k][j].x), bflo(w[k][j].y), bfhi(w[k][j].y)};
        }
#pragma unroll
        for (int j = 0; j < 4; ++j) { const int c = 256 * j + 4 * lane; f32x4 x = xv[j]; x += gv[j] * acc[j]; *(f32x4*)(xr + c) = x; acc[j] = x; }
        if (ngain) {
            float ss = 0.f;
#pragma unroll
            for (int j = 0; j < 4; ++j) ss += acc[j].x * acc[j].x + acc[j].y * acc[j].y + acc[j].z * acc[j].z + acc[j].w * acc[j].w;
            const float rs = 1.0f / sqrtf(wave_sum(ss) * (1.f / 1024.f) + EPS);
            const float* mp = nmod + mi * 6144;
#pragma unroll
            for (int j = 0; j < 4; ++j) { const int c = 256 * j + 4 * lane;
                const f32x4 g = *(const f32x4*)(ngain + c), sc = *(const f32x4*)(mp + 1024 + c), sh = *(const f32x4*)(mp + c);
                const f32x4 hv = (acc[j] * rs) * g * (sc + 1.0f) + sh;
                *(u32x2*)(H + (size_t)row * DM + c) = (u32x2){pk2(hv.x, hv.y), pk2(hv.z, hv.w)}; }
        }
    }
}

template <int N> struct IC { static constexpr int value = N; };
DI const float* in_ptr(const unsigned char* ws, int k) { const unsigned long long v = ((const unsigned long long*)(ws + 128 * 1024))[k];
    const unsigned lo = __builtin_amdgcn_readfirstlane((unsigned)v), hi = __builtin_amdgcn_readfirstlane((unsigned)(v >> 32));
    return (const float*)(__attribute__((address_space(1))) const float*)(((unsigned long long)hi << 32) | lo); }
template <class T> DI T* launder_ptr(T* p) { unsigned long long v = (unsigned long long)p; unsigned lo = (unsigned)v, hi = (unsigned)(v >> 32); asm volatile("" : "+v"(lo), "+v"(hi));
    lo = __builtin_amdgcn_readfirstlane(lo); hi = __builtin_amdgcn_readfirstlane(hi); return (T*)(__attribute__((address_space(1))) T*)(((unsigned long long)hi << 32) | lo); }
constexpr int N_PHASES = 1 + 23 + 22;
constexpr size_t WS_PTRS = 128 * 1024;
#define P_XC    ((float*)(ws + WS_XC))
#define P_MOD   ((const float*)(ws + WS_MOD))
#define P_HB    ((bf16*)(ws + WS_HB))
#define P_OCAT  ((bf16*)(ws + WS_OCAT))
#define P_AR    (ws + WS_ARENA)
#define P_ROWS  ((int*)(ws + WS_ROWS))
#define P_GATE  ((float*)(ws + WS_GATE))
#define P_SLOT  ((int*)(ws + WS_SLOT))
#define P_AFFT  ((float*)(ws + WS_AFFT))
#define P_AFFC  ((float*)(ws + WS_AFFC))
#define P_W13   ((bf16*)(ws + WS_W13))
#define P_W2    ((bf16*)(ws + WS_W2))
#define P_U     ((bf16*)(P_AR + A_U))
#define P_QPRE  ((float*)(P_AR + A_QPRE))
#define P_KVPRE ((float*)(P_AR + A_KVPRE))
#define P_QB    ((bf16*)(P_AR + A_QB))
#define P_KB    ((bf16*)(P_AR + A_KB))
#define P_VT    ((bf16*)(P_AR + A_VT))
#define P_W     ((unsigned short*)(P_AR + A_W))
#define P_KEFF  ((bf16*)(P_AR + A_KEFF))
#define P_R     ((bf16*)(P_AR + A_R))
#define P_V     ((bf16*)(P_AR + A_V))
#define P_KK    ((bf16*)(P_AR + A_KK))
#define P_G     ((bf16*)(P_AR + A_G))
#define P_K     ((bf16*)(P_AR + A_K))
#define P_L     ((bf16*)(P_AR + A_L))
#define P_QN    ((bf16*)(P_AR + A_QN))
#define P_KN    ((bf16*)(P_AR + A_KN))
#define P_VTN   ((bf16*)(P_AR + A_VTN))
#define P_YS    ((bf16*)(P_AR + A_YS))
#define P_IMG   ((bf16*)(P_AR + A_IMG))
#define P_HID   ((bf16*)(P_AR + A_HID))
#define P_Y2    ((bf16*)(P_AR + A_Y2))
#define MODL(i) (P_MOD + (size_t)(i) * 9 * 6144)
#if MOE_F8
#define MOE1_PHASE(NMT) do { pg8::Gemm g{P_HB, P_W13, DM / 2, DM / 2, P_ROWS, SCALE_W, SCALE_ONE}; pg8::OrderMoE S{(NMT), 8, 17, C.nb, C.vcu}; pg8::EpiAdapt<EpiGlu8> E{EpiGlu8{(unsigned char*)P_HID}}; \
        pg8::gemm_phase<pg8::EpiAdapt<EpiGlu8>, pg8::OrderMoE, true>(C.lds, g, S, E, C.tid); } while (0)
#define MOE2_PHASE(NMT) do { pg8::Gemm g{P_HID, P_W2, DM / 2, DM / 2, nullptr, SCALE_W, SCALE_HID}; pg8::OrderMoE S{(NMT), 4, 17, C.nb, C.vcu}; pg8::EpiAdapt<EpiGate> E{EpiGate{P_Y2, P_GATE}}; \
        pg8::gemm_phase<pg8::EpiAdapt<EpiGate>, pg8::OrderMoE, true>(C.lds, g, S, E, C.tid); } while (0)
#else
#define MOE1_PHASE(NMT) do { pg8::Gemm g{P_HB, P_W13, DM, DM, P_ROWS}; pg8::OrderMoE S{(NMT), 8, 17, C.nb, C.vcu}; pg8::EpiAdapt<EpiGlu> E{EpiGlu{P_HID}}; pg8::gemm_phase(C.lds, g, S, E, C.tid); } while (0)
#define MOE2_PHASE(NMT) do { pg8::Gemm g{P_HID, P_W2, DM, DM, nullptr}; pg8::OrderMoE S{(NMT), 4, 17, C.nb, C.vcu}; pg8::EpiAdapt<EpiGate> E{EpiGate{P_Y2, P_GATE}}; pg8::gemm_phase(C.lds, g, S, E, C.tid); } while (0)
#endif
#define WPREP_TAIL(NUNITS, LAYER) do { __syncthreads(); const int extra_ = (NUNITS) % C.nb, j_ = C.vcu - extra_; const size_t wo_ = (size_t)(LAYER) * NEXP * DM * DM; \
        if (j_ >= 0) wprep_span(C, j_ * 8 + C.wave, (C.nb - extra_) * 8, in_ptr(ws, I_MW1) + wo_, in_ptr(ws, I_MW3) + wo_, in_ptr(ws, I_MW2) + wo_, (bf16*)(ws + WS_W13), (bf16*)(ws + WS_W2)); } while (0)
#define RELAUNDER() do { int l_ = C.lane; asm volatile("" : "+v"(l_)); C.lane = l_; C.tid = (C.wave << 6) | l_; } while (0)
__global__ void __launch_bounds__(512, 2) fwd_kernel(Args a) {
    extern __shared__ __attribute__((aligned(16))) unsigned char smem[];
    Ctx C0; C0.lds = (LAS unsigned char*)smem; C0.tid = threadIdx.x; C0.lane = C0.tid & 63; C0.wave = __builtin_amdgcn_readfirstlane(C0.tid >> 6); C0.bid = blockIdx.x; C0.nb = gridDim.x;
    C0.vcu = (C0.nb % 8 == 0) ? (C0.bid % 8) * (C0.nb / 8) + C0.bid / 8 : C0.bid;
    volatile LAS unsigned* bst = (volatile LAS unsigned*)(C0.lds + LDS_BYTES - 16);
#if MEGA
    if (C0.tid == 0) { bst[0] = 0u; bst[1] = 0u; }
    __syncthreads();
    const unsigned bar_x = xcd_barrier_post((unsigned*)(a.ws + WS_CTL) + 4096, bst, C0.tid == 0).x;
#define SEAM() do { if (ph < hi) { XcdBarrier b2_; b2_.bar = (unsigned*)(ws + WS_CTL) + 4096; b2_.x = bar_x; b2_.st = bst; xcd_barrier(b2_, C.tid == 0); } } while (0)
#else
#define SEAM() do { } while (0)
#endif
#if MEGA
    constexpr int lo = 0, hi = N_PHASES;
#else
    const int lo = a.ph_lo, hi = a.ph_hi;
#endif
    int ph = 0;
#ifndef ONLY
#define ONLY -1
#endif
#ifndef REPMASK
#define REPMASK 0
#endif
#ifndef SITE_LO
#define SITE_LO 0
#define SITE_HI 99
#endif
#define PHASE(SITE, ...) do { if ((ONLY < 0 || ONLY == (SITE)) && (SITE) >= SITE_LO && (SITE) <= SITE_HI && ph >= lo && ph < hi) { Ctx C; C.lds = C0.lds; \
        { int w_ = C0.wave; asm volatile("" : "+s"(w_)); unsigned m_ = ~0u; asm volatile("" : "+s"(m_)); int l_ = (int)__builtin_amdgcn_mbcnt_hi(m_, __builtin_amdgcn_mbcnt_lo(m_, 0u)); C.wave = w_; C.lane = l_; C.tid = (w_ << 6) | l_; } \
        { int b_ = C0.bid, n_ = C0.nb, v_ = C0.vcu; asm volatile("" : "+s"(b_), "+s"(n_), "+s"(v_)); C.bid = b_; C.nb = n_; C.vcu = v_; } \
        unsigned z_ = 0u; asm volatile("" : "+s"(z_)); unsigned char* ws = a.ws + z_; float* XL = a.out + z_; const int lq = __builtin_amdgcn_readfirstlane(lp); typedef const __attribute__((address_space(1))) float* gfp_t; const gfp_t* INT_ = (const gfp_t*)(ws + WS_PTRS); (void)INT_; (void)XL; (void)lq; \
        for (int rep_ = 0; rep_ < ((((REPMASK) >> (SITE)) & 1) ? 2 : 1); ++rep_) { __VA_ARGS__; if ((((REPMASK) >> (SITE)) & 1)) __syncthreads(); } ++ph; SEAM(); } else ++ph; } while (0)

    { const int lp = 0;
      PHASE(0, { if (C.bid == 0) { _Pragma("unroll") for (int k = 0; k < 40; ++k) if (C.tid == k) ((const float**)(ws + WS_PTRS))[k] = a.in[k]; }
                 ph_prologue(C, a); }); }

    auto layer_pair = [&](auto lpc) __attribute__((always_inline)) {
        constexpr int lp = decltype(lpc)::value;
        if constexpr (lp == 0) PHASE(1, { const int i = 2 * lq; const float* xl = (i == 0) ? in_ptr(ws, I_X) : XL; const float* xc = (i == 0) ? in_ptr(ws, I_CTX) : P_XC;
                   ph_norm<false>(C, xl, xc, in_ptr(ws, I_N1G) + i * DM, MODL(i), 0, 1024, P_HB, nullptr, nullptr, nullptr, nullptr); });
        PHASE(2, { EpiBf16 E{P_U, EV_INP}; fast_gemm(C, P_HB, DM, (const bf16*)(ws + WS_WEVIN) + (size_t)lq * EV_INP * DM, DM, MT / 256, EV_INP / 256, E); });
        PHASE(3, { EpiBf16 Eq{(bf16*)P_QPRE, 768}; fast_gemm(C, P_U, EV_INP, (const bf16*)(ws + WS_WUQ) + (size_t)lq * 768 * 384, 384, MT / 256, 3, Eq); RELAUNDER();
                   EpiBf16 Ek{(bf16*)P_KVPRE, 1024}; fast_gemm(C, P_U + 384, EV_INP, (const bf16*)(ws + WS_WUKV) + (size_t)lq * 1024 * 256, 256, MT / 256, 4, Ek, true); });
        PHASE(4, { ph_mla_fin(C, P_U, (const bf16*)P_QPRE, (const bf16*)P_KVPRE, in_ptr(ws, I_QG) + lq * 96, in_ptr(ws, I_KG) + lq * 96, (const f32x2*)(ws + WS_ROPE), P_QB, P_KB, P_VT);
                   const int extra_ = (MT / 64) % C.nb, j_ = C.vcu - extra_;
                   if (j_ >= 0) { for (int q_ = 0; q_ < CONV_PER_TAIL; ++q_) { const int cu_ = j_ + q_ * (C.nb - extra_); if (cu_ >= conv_in_fin(C.nb)) break;
                       float wk[31]; const float* dww = in_ptr(ws, I_DWW) + (size_t)lq * 31 * 512;
                       _Pragma("unroll") for (int kt = 0; kt < 31; ++kt) wk[kt] = dww[kt * 512 + C.tid];
                       conv_unit(C, cu_, P_U, wk, in_ptr(ws, I_DWB)[lq * 512 + C.tid], in_ptr(ws, I_LNG) + lq * 512, in_ptr(ws, I_LNB) + lq * 512, P_OCAT); } } });
        PHASE(5, ph_attn_mla2(C, P_QB, P_KB, P_VT, P_OCAT, false, ws, lq));
        PHASE(6, { const int i = 2 * lq; const float* xl = (i == 0) ? in_ptr(ws, I_X) : XL; const float* xc = (i == 0) ? in_ptr(ws, I_CTX) : P_XC;
                   { EpiResid E{xl, xc, XL, P_XC, MODL(i) + 2048}; fast_gemm(C, P_OCAT, DM, (const bf16*)(ws + WS_WEVOUT) + (size_t)lq * DM * DM, DM, MT / 256, 4, E); }
                   WPREP_TAIL(MT / 256 * 4, i); });
        PHASE(7, { const int i = 2 * lq; ph_norm<true>(C, XL, P_XC, in_ptr(ws, I_N2G) + i * DM, MODL(i), 3072, 4096, P_HB, in_ptr(ws, I_ROUTER) + (size_t)i * DM * 16, P_AFFT, P_AFFC, P_SLOT); });
        PHASE(8, ph_topk2(C, P_AFFT, P_AFFC, P_ROWS, P_GATE, P_SLOT, false));
        PHASE(9, { MOE1_PHASE(17); });
        PHASE(10, { MOE2_PHASE(17); });
        PHASE(11, { const int i = 2 * lq; ph_combine(C, XL, P_XC, MODL(i) + 5120, P_SLOT, P_Y2, false, in_ptr(ws, I_N1G) + (i + 1) * DM, MODL(i + 1), P_HB); });
        PHASE(13, { EpiBf16 E{P_U, OD_INP}; fast_gemm(C, P_HB, DM, (const bf16*)(ws + WS_WODIN) + (size_t)lq * OD_INP * DM, DM, MT / 256, OD_INP / 256, E); });
        PHASE(14, ph_prep(C, P_U, in_ptr(ws, I_SHIFTW) + (size_t)lq * 3 * RW_IN, in_ptr(ws, I_KKW) + lq * 512, in_ptr(ws, I_NAQG) + lq * 64, in_ptr(ws, I_NAKG) + lq * 64, P_R, P_V, P_K, P_KK, P_L, P_QN, P_KN, P_VTN));
        PHASE(15, { const bf16* WL = (const bf16*)(ws + WS_WLORA) + (size_t)lq * 655360;
                    { EpiLoraW E{P_W, in_ptr(ws, I_W0) + lq * 1024}; fast_gemm(C, P_L, 384, WL, 256, MT / 256, 4, E); } RELAUNDER();
                    { EpiLoraA E{P_KEFF, in_ptr(ws, I_A0) + lq * 1024}; fast_gemm(C, P_L, 384, WL + (size_t)1024 * 256, 256, MT / 256, 4, E, true); } RELAUNDER();
                    { EpiBf16 E{P_G, 512}; fast_gemm(C, P_L + 128, 384, WL + (size_t)2048 * 256, 256, MT / 256, 2, E); } });
        PHASE(16, ph_wkv_pre(C, P_R, P_K, P_KK, P_W, P_KEFF, in_ptr(ws, I_KA) + lq * 512, P_IMG));
        PHASE(17, { ph_wkv_chunk(C, P_R, P_V, P_K, P_KK, P_W, P_KEFF, in_ptr(ws, I_KA) + lq * 512, P_IMG, P_YS); __syncthreads();
                    ph_natten2(C, P_QN, P_KN, P_VTN, P_OCAT, in_ptr(ws, I_RPB) + (size_t)lq * 8 * 465, lq == 1, (unsigned*)(ws + WS_CTL) + 8192 + 64 * lq, ws, lq); });
        PHASE(18, ph_post(C, P_YS, P_R, P_V, P_K, P_KEFF, in_ptr(ws, I_KA) + lq * 512, P_G, in_ptr(ws, I_RK) + lq * 512, in_ptr(ws, I_GNG) + lq * 512, in_ptr(ws, I_GNB) + lq * 512, P_OCAT, lq == 1));
        PHASE(19, { const int i = 2 * lq + 1; EpiResid E{XL, P_XC, XL, P_XC, MODL(i) + 2048};
                    fast_gemm(C, P_OCAT, DM, (const bf16*)(ws + WS_WODOUT) + (size_t)lq * DM * DM, DM, (lq == 1) ? NLAT / 256 : MT / 256, 4, E);
                    WPREP_TAIL(((lq == 1) ? NLAT / 256 : MT / 256) * 4, i); });
        PHASE(20, { const int i = 2 * lq + 1; ph_norm<true>(C, XL, P_XC, in_ptr(ws, I_N2G) + i * DM, MODL(i), 3072, 4096, P_HB, in_ptr(ws, I_ROUTER) + (size_t)i * DM * 16, P_AFFT, P_AFFC, P_SLOT); });
        PHASE(21, ph_topk2(C, P_AFFT, P_AFFC, P_ROWS, P_GATE, P_SLOT, lq == 1));
        PHASE(22, { MOE1_PHASE((lq == 1) ? 16 : 17); });
        PHASE(23, { MOE2_PHASE((lq == 1) ? 16 : 17); });
        PHASE(24, { const int i = 2 * lq + 1;
                    if (lp == 0) ph_combine(C, XL, P_XC, MODL(i) + 5120, P_SLOT, P_Y2, false, in_ptr(ws, I_N1G) + (i + 1) * DM, MODL(i + 1), P_HB);
                    else ph_combine(C, XL, P_XC, MODL(i) + 5120, P_SLOT, P_Y2, true, nullptr, nullptr, nullptr); });
    };
    layer_pair(IC<0>{}); layer_pair(IC<1>{});
}

extern "C" void kernel_launch(void* const* d_in, const int* in_sizes, int n_in, void* d_out, int out_size, void* d_ws, size_t ws_size, hipStream_t stream) {
    static int grid = 0;
    if (grid == 0) {
        if (n_in != 40 || out_size != NLAT * DM || ws_size < WS_END) { fprintf(stderr, "kernel_launch: unexpected shapes (n_in %d out %d ws %zu need %zu)\n", n_in, out_size, ws_size, (size_t)WS_END); grid = -1; return; }
        int dev = 0, cus = 0, per_cu = 0;
        if (hipGetDevice(&dev) != hipSuccess || hipDeviceGetAttribute(&cus, hipDeviceAttributeMultiprocessorCount, dev) != hipSuccess) { grid = -1; return; }
        if (hipFuncSetAttribute((const void*)fwd_kernel, hipFuncAttributeMaxDynamicSharedMemorySize, LDS_BYTES) != hipSuccess) { fprintf(stderr, "kernel_launch: hipFuncSetAttribute failed\n"); grid = -1; return; }
        if (hipOccupancyMaxActiveBlocksPerMultiprocessor(&per_cu, (const void*)fwd_kernel, 512, LDS_BYTES) != hipSuccess || per_cu < 1) { fprintf(stderr, "kernel_launch: occupancy query says %d\n", per_cu); per_cu = 1; }
        (void)hipGetLastError();
        grid = cus;
    }
    if (grid < 0) return;
    (void)hipMemsetAsync((char*)d_ws + WS_CTL, 0, CTL_BYTES, stream);
    Args a{};
    for (int i = 0; i < 40; ++i) a.in[i] = (const float*)d_in[i];
    a.out = (float*)d_out; a.ws = (unsigned char*)d_ws;
#if MEGA
    a.ph_lo = 0; a.ph_hi = N_PHASES;
    hipLaunchKernelGGL(fwd_kernel, dim3(grid), dim3(512), LDS_BYTES, stream, a);
#else
    for (int p = 0; p < N_PHASES; ++p) { a.ph_lo = p; a.ph_hi = p + 1; hipLaunchKernelGGL(fwd_kernel, dim3(grid), dim3(512), LDS_BYTES, stream, a); }
#endif
}
```

```cpp
#include <hip/hip_runtime.h>
#include <cstdio>
#include <cstdint>

#ifndef MEGA
#define MEGA 1
#endif

#define LAS __attribute__((address_space(3)))
#define DI __device__ __forceinline__

typedef unsigned short bf16;
typedef short bf16x8 __attribute__((ext_vector_type(8)));
typedef float f32x4 __attribute__((ext_vector_type(4)));
typedef float f32x2 __attribute__((ext_vector_type(2)));
typedef float f32x16 __attribute__((ext_vector_type(16)));
typedef unsigned u32x4 __attribute__((ext_vector_type(4)));
typedef unsigned u32x2 __attribute__((ext_vector_type(2)));
typedef __bf16 bf16x2_t __attribute__((ext_vector_type(2)));

constexpr int DM = 1024, NB = 8, TL = 4096, LCX = 256;
constexpr int NLAT = NB * TL, NCTX = NB * LCX, MT = NLAT + NCTX;
constexpr int KPOS = TL + LCX;
constexpr float EPS = 1e-6f, GN_EPS = 64e-5f;
constexpr int EV_IN = 1696, EV_INP = 1792, OD_IN = 3456, OD_INP = 3584, RW_IN = 1920;
constexpr int NEXP = 16, CAPL = 512, CAPC = 32, ESLOTS = NB * CAPL + NB * CAPC;
constexpr float LOG2E = 1.4426950408889634f;

constexpr size_t MiB = 1ull << 20;
constexpr size_t WS_CTL = 0, CTL_BYTES = 1 * MiB;
constexpr size_t WS_MOD = 1 * MiB, WS_ROPE = 2 * MiB, WS_XC = 4 * MiB;
constexpr size_t WS_ROWS = 12 * MiB, WS_GATE = 12 * MiB + 512 * 1024, WS_SLOT = 13 * MiB, WS_AFFT = 16 * MiB, WS_AFFC = 18 * MiB;
constexpr size_t WS_WEVIN = 20 * MiB, WS_WEVOUT = 27 * MiB, WS_WUQ = 31 * MiB, WS_WUKV = 33 * MiB, WS_WODIN = 34 * MiB, WS_WODOUT = 48 * MiB, WS_WLORA = 52 * MiB;
constexpr size_t WS_W13 = 56 * MiB, WS_W2 = 120 * MiB, WS_HB = 152 * MiB, WS_OCAT = 220 * MiB, WS_ARENA = 288 * MiB;
constexpr size_t A_U = 0, A_QPRE = 119 * MiB, A_KVPRE = 221 * MiB, A_QB = 357 * MiB, A_KB = 408 * MiB, A_VT = 459 * MiB;
constexpr size_t A_W = 0, A_KEFF = 136 * MiB  , A_G = 204 * MiB, A_R = 238 * MiB, A_V = 272 * MiB, A_KK = 306 * MiB, A_K = 340 * MiB, A_L = 374 * MiB,
                 A_QN = 400 * MiB, A_KN = 434 * MiB, A_VTN = 468 * MiB, A_YS = 612 * MiB  ;
constexpr size_t A_HID = 0, A_Y2 = 136 * MiB;
constexpr size_t A_IMG = 510 * MiB;
constexpr size_t WS_END = WS_ARENA + 680 * MiB;
constexpr int LDS_BYTES = 147456;

DI unsigned pk2(float lo, float hi) { f32x2 v = {lo, hi}; bf16x2_t b = __builtin_convertvector(v, bf16x2_t); return __builtin_bit_cast(unsigned, b); }
DI float bflo(unsigned u) { return __builtin_bit_cast(float, u << 16); }
DI float bfhi(unsigned u) { return __builtin_bit_cast(float, u & 0xffff0000u); }
DI float bf2f(bf16 x) { return __builtin_bit_cast(float, ((unsigned)x) << 16); }
DI bf16 f2bf(float f) { return (bf16)(pk2(f, 0.f) & 0xffffu); }
DI void unpack8(u32x4 v, float (&f)[8]) { f[0] = bflo(v.x); f[1] = bfhi(v.x); f[2] = bflo(v.y); f[3] = bfhi(v.y); f[4] = bflo(v.z); f[5] = bfhi(v.z); f[6] = bflo(v.w); f[7] = bfhi(v.w); }
DI u32x4 pack8(const float (&f)[8]) { u32x4 r; r.x = pk2(f[0], f[1]); r.y = pk2(f[2], f[3]); r.z = pk2(f[4], f[5]); r.w = pk2(f[6], f[7]); return r; }
#define DPP_ADD(x, ctrl) ((x) + __builtin_bit_cast(float, __builtin_amdgcn_update_dpp(0, __builtin_bit_cast(int, (x)), (ctrl), 0xf, 0xf, false)))
#define DPP_MAX(x, ctrl) fmaxf((x), __builtin_bit_cast(float, __builtin_amdgcn_update_dpp(0, __builtin_bit_cast(int, (x)), (ctrl), 0xf, 0xf, false)))
DI float sum8(float x) { x = DPP_ADD(x, 0xB1); x = DPP_ADD(x, 0x4E); x = DPP_ADD(x, 0x141); return x; }
DI float sum16(float x) { x = DPP_ADD(x, 0xB1); x = DPP_ADD(x, 0x4E); x = DPP_ADD(x, 0x141); x = DPP_ADD(x, 0x140); return x; }
DI float max16(float x) { x = DPP_MAX(x, 0xB1); x = DPP_MAX(x, 0x4E); x = DPP_MAX(x, 0x141); x = DPP_MAX(x, 0x140); return x; }
DI float rdlane(float x, int l) { return __builtin_bit_cast(float, __builtin_amdgcn_readlane(__builtin_bit_cast(int, x), l)); }
DI float wave_sum(float v) { const float x = sum16(v); return (rdlane(x, 0) + rdlane(x, 16)) + (rdlane(x, 32) + rdlane(x, 48)); }
DI float xor32(float v, int lane) { return __builtin_bit_cast(float, __builtin_amdgcn_ds_bpermute((lane ^ 32) << 2, __builtin_bit_cast(int, v))); }
typedef int v8i_t __attribute__((ext_vector_type(8)));
typedef int i32x4_t __attribute__((ext_vector_type(4)));
DI unsigned pk4_fp8(float a, float b, float c, float d) {
    a = __builtin_amdgcn_fmed3f(a, -448.f, 448.f); b = __builtin_amdgcn_fmed3f(b, -448.f, 448.f); c = __builtin_amdgcn_fmed3f(c, -448.f, 448.f); d = __builtin_amdgcn_fmed3f(d, -448.f, 448.f);
    int p = __builtin_amdgcn_cvt_pk_fp8_f32(a, b, 0, false); p = __builtin_amdgcn_cvt_pk_fp8_f32(c, d, p, true); return (unsigned)p; }
#ifndef MOE_F8
#define MOE_F8 1
#endif
constexpr int SCALE_ONE = 0x7f7f7f7f, SCALE_W = 0x79797979  , SCALE_HID = 0x7c7c7c7c  ;
DI float sigmoidf_(float x) { return __builtin_amdgcn_rcpf(1.f + __expf(-x)); }
DI float siluf_(float x) { return x * __builtin_amdgcn_rcpf(1.f + __expf(-x)); }
#define MFMA32(a, b, c) __builtin_amdgcn_mfma_f32_32x32x16_bf16((a), (b), (c), 0, 0, 0)

#define XB_TMO      128
#define XB_XCNT(j)  (256  + 64 * (j))
#define XB_XSUB(j)  (1280 + 64 * (j))
#define XB_XGEN(j)  (2304 + 64 * (j))
#define XB_TOP      3328
#define XB_TOPGEN   3392
#define XCD_BAR_WORDS 3456
#define XB_SPIN_CAP (1u << 22)
__device__ __forceinline__ unsigned xb_ld(unsigned* p)              { return __hip_atomic_load(p, __ATOMIC_RELAXED, __HIP_MEMORY_SCOPE_AGENT); }
__device__ __forceinline__ unsigned xb_add(unsigned* p, unsigned v) { return __hip_atomic_fetch_add(p, v, __ATOMIC_RELAXED, __HIP_MEMORY_SCOPE_AGENT); }
__device__ __forceinline__ unsigned xb_xcc_id() { return (unsigned)__builtin_amdgcn_s_getreg((3 << 11) | 20) & 0xFu; }
#define XB_SPIN(cond, bar) do { unsigned _sp = 0; while (cond) { __builtin_amdgcn_s_sleep(1); \
    if ((++_sp & 255u) == 0u) { if (xb_ld(&(bar)[XB_TMO])) break; if (_sp > XB_SPIN_CAP) { atomicAdd(&(bar)[XB_TMO], 1u); break; } } } } while (0)
struct XcdBarrier { unsigned* bar; unsigned x; volatile LAS unsigned* st; };
__device__ __forceinline__ XcdBarrier xcd_barrier_post(unsigned* bar, volatile LAS unsigned* st, bool leader) {
    XcdBarrier b; b.bar = bar; b.x = xb_xcc_id(); b.st = st;
    if (leader) (void)xb_add(&bar[XB_XCNT(b.x)], 1u);
    return b;
}
__device__ __forceinline__ void xcd_barrier_complete(unsigned* bar, unsigned x, unsigned& nloc, unsigned& nx) {
    const unsigned G = gridDim.x * gridDim.y * gridDim.z;
    unsigned sum, cnt, mine, sp = 0u;
    for (;;) {
        sum = 0u; cnt = 0u; mine = 0u;
#pragma unroll
        for (unsigned j = 0; j < 16; ++j) { const unsigned c = xb_ld(&bar[XB_XCNT(j)]); sum += c; cnt += (c > 0u) ? 1u : 0u; mine = (j == x) ? c : mine; }
        if (sum == G) break;
        __builtin_amdgcn_s_sleep(1);
        if ((++sp & 255u) == 0u) { if (xb_ld(&bar[XB_TMO])) break; if (sp > XB_SPIN_CAP) { atomicAdd(&bar[XB_TMO], 1u); break; } }
    }
    nloc = mine > 0u ? mine : 1u; nx = cnt > 0u ? cnt : 1u;
}
__device__ __forceinline__ void xcd_barrier(const XcdBarrier& b, bool leader) {
    asm volatile("s_waitcnt vmcnt(0)" ::: "memory");
    __syncthreads();
    if (leader) {
        unsigned* bar = b.bar;
        __builtin_amdgcn_s_waitcnt(0);
        unsigned nloc = b.st[0], nx = b.st[1];
        if (nloc == 0u) { xcd_barrier_complete(bar, b.x, nloc, nx); b.st[0] = nloc; b.st[1] = nx; }
        const unsigned old = xb_add(&bar[XB_XSUB(b.x)], 1u);
        const unsigned gen = old / nloc;
        if (old + 1u == (gen + 1u) * nloc) {
            __builtin_amdgcn_fence(__ATOMIC_RELEASE, "agent");
            asm volatile("s_waitcnt vmcnt(0)" ::: "memory");
            const unsigned og = xb_add(&bar[XB_TOP], 1u);
            const unsigned tg = og / nx;
            if (og + 1u == (tg + 1u) * nx) xb_add(&bar[XB_TOPGEN], 1u);
            else XB_SPIN(xb_ld(&bar[XB_TOPGEN]) == tg, bar);
            __builtin_amdgcn_fence(__ATOMIC_ACQUIRE, "agent");
            xb_add(&bar[XB_XGEN(b.x)], 1u);
            asm volatile("s_waitcnt vmcnt(0)" ::: "memory");
        } else {
            XB_SPIN(xb_ld(&bar[XB_XGEN(b.x)]) == gen, bar);
            __builtin_amdgcn_fence(__ATOMIC_ACQUIRE, "agent");
            asm volatile("s_waitcnt vmcnt(0)" ::: "memory");
        }
    }
    __syncthreads();
}

struct Ctx { LAS unsigned char* lds; int tid, lane, wave, bid, nb, vcu; };
struct Args { const float* in[40]; float* out; unsigned char* ws; int ph_lo, ph_hi; };
enum { I_X = 0, I_C, I_CTX, I_CCTX, I_ADAW, I_ADAB, I_N1G, I_N2G, I_EVWIN, I_EVWOUT, I_QNORM, I_WUQ, I_KVNORM, I_WUKV, I_QG, I_KG, I_DWW, I_DWB, I_LNG, I_LNB,
       I_ODWIN, I_ODWOUT, I_SHIFTW, I_W0, I_W2L, I_A0, I_A2, I_G2, I_KKW, I_KA, I_RK, I_GNG, I_GNB, I_NAQG, I_NAKG, I_RPB, I_ROUTER, I_MW1, I_MW3, I_MW2 };

DI void transpose_item(const float* __restrict__ W, int K, int N, bf16* __restrict__ WT, int dst_row0, const float* __restrict__ gain, LAS float* scr, int k0, int n0, int lane) {
#pragma unroll 8
    for (int i = 0; i < 32; ++i) { const int kk = 2 * i + (lane >> 5); float v = W[(size_t)(k0 + kk) * N + n0 + (lane & 31)]; if (gain) v *= gain[k0 + kk]; scr[kk * 33 + (lane & 31)] = v; }
    asm volatile("s_waitcnt lgkmcnt(0)" ::: "memory");
    const int c = lane & 7;
#pragma unroll
    for (int j = 0; j < 4; ++j) { const int n = (lane >> 3) + 8 * j; const LAS float* s = scr + (8 * c) * 33 + n;
        u32x4 o; o.x = pk2(s[0 * 33], s[1 * 33]); o.y = pk2(s[2 * 33], s[3 * 33]); o.z = pk2(s[4 * 33], s[5 * 33]); o.w = pk2(s[6 * 33], s[7 * 33]);
        *(u32x4*)(WT + (size_t)(dst_row0 + n) * K + k0 + 8 * c) = o; }
    asm volatile("s_waitcnt lgkmcnt(0)" ::: "memory");
}
DI void transpose_item64(const float* __restrict__ W, int K, int N, bf16* __restrict__ WT, int dst_row0, LAS float* scr, int k0, int n0, int lane) {
    f32x4 v[16];
#pragma unroll
    for (int i = 0; i < 16; ++i) v[i] = *(const f32x4*)(W + (size_t)(k0 + 4 * i + (lane >> 4)) * N + n0 + 4 * (lane & 15));
#pragma unroll
    for (int i = 0; i < 16; ++i) { LAS float* d = scr + (4 * i + (lane >> 4)) * 65 + 4 * (lane & 15); d[0] = v[i].x; d[1] = v[i].y; d[2] = v[i].z; d[3] = v[i].w; }
    asm volatile("s_waitcnt lgkmcnt(0)" ::: "memory");
    const int c = lane & 7;
#pragma unroll
    for (int j = 0; j < 8; ++j) { const int n = (lane >> 3) + 8 * j; const LAS float* s = scr + (8 * c) * 65 + n;
        u32x4 o; o.x = pk2(s[0 * 65], s[1 * 65]); o.y = pk2(s[2 * 65], s[3 * 65]); o.z = pk2(s[4 * 65], s[5 * 65]); o.w = pk2(s[6 * 65], s[7 * 65]);
        *(u32x4*)(WT + (size_t)(dst_row0 + n) * K + k0 + 8 * c) = o; }
    asm volatile("s_waitcnt lgkmcnt(0)" ::: "memory");
}
DI void transpose_item64_f8(const float* __restrict__ W, int K, int N, unsigned char* __restrict__ WT8, int dst_row0, LAS float* scr, int k0, int n0, int lane) {
    f32x4 v[16];
#pragma unroll
    for (int i = 0; i < 16; ++i) v[i] = *(const f32x4*)(W + (size_t)(k0 + 4 * i + (lane >> 4)) * N + n0 + 4 * (lane & 15));
#pragma unroll
    for (int i = 0; i < 16; ++i) { LAS float* d = scr + (4 * i + (lane >> 4)) * 65 + 4 * (lane & 15); d[0] = v[i].x; d[1] = v[i].y; d[2] = v[i].z; d[3] = v[i].w; }
    asm volatile("s_waitcnt lgkmcnt(0)" ::: "memory");
    const int c = lane & 7;
#pragma unroll
    for (int j = 0; j < 8; ++j) { const int n = (lane >> 3) + 8 * j; const LAS float* s = scr + (8 * c) * 65 + n;
        u32x2 o; o.x = pk4_fp8(64.f * s[0 * 65], 64.f * s[1 * 65], 64.f * s[2 * 65], 64.f * s[3 * 65]); o.y = pk4_fp8(64.f * s[4 * 65], 64.f * s[5 * 65], 64.f * s[6 * 65], 64.f * s[7 * 65]);
        *(u32x2*)(WT8 + (size_t)(dst_row0 + n) * K + k0 + 8 * c) = o; }
    asm volatile("s_waitcnt lgkmcnt(0)" ::: "memory");
}
DI void transpose_matrix(const Ctx& C, const float* W, int K, int N, bf16* WT, const float* gain, int mode  ) {
    LAS float* scr = (LAS float*)(C.lds + C.wave * 8704);
    const int nkb = K / 64, nnb = N / 32, nit = nkb * nnb, gw = C.vcu * 8 + C.wave, ngw = C.nb * 8;
    for (int it = gw; it < nit; it += ngw) {
        const int kb = it / nnb, nbk = it % nnb, n0 = nbk * 32;
        int d0 = n0; if (mode) d0 = (n0 >> 7) * 256 + (n0 & 127) + (mode == 2 ? 128 : 0);
        transpose_item(W, K, N, WT, d0, gain, scr, kb * 64, n0, C.lane);
    }
}

DI void ph_prologue(const Ctx& C, const Args& a) {
    unsigned char* ws = a.ws;
    {
        LAS float* sv = (LAS float*)C.lds;
        LAS float* red = sv + 9 * 1024;
        for (int i = C.tid; i < 9 * 1024; i += 512) { const int m = i >> 10, k = i & 1023; const float c = (m < 8) ? a.in[I_C][m * 1024 + k] : a.in[I_CCTX][k]; sv[i] = siluf_(c); }
        __syncthreads();
        float* MOD = (float*)(ws + WS_MOD);
        for (int it = C.bid; it < 4 * 96; it += C.nb) {
            const int layer = it / 96, col = (it % 96) * 64 + C.lane;
            const float* wp = a.in[I_ADAW] + (size_t)layer * 1024 * 6144 + col;
            float acc[9];
#pragma unroll
            for (int m = 0; m < 9; ++m) acc[m] = 0.f;
            const int kb = C.wave * 128;
#pragma unroll 16
            for (int k = 0; k < 128; ++k) { const float w = wp[(size_t)(kb + k) * 6144];
#pragma unroll
                for (int m = 0; m < 9; ++m) acc[m] += sv[m * 1024 + kb + k] * w; }
#pragma unroll
            for (int m = 0; m < 9; ++m) red[(C.wave * 9 + m) * 64 + C.lane] = acc[m];
            __syncthreads();
            for (int i = C.tid; i < 576; i += 512) { const int m = i >> 6, l = i & 63; float s = 0.f;
#pragma unroll
                for (int w = 0; w < 8; ++w) s += red[(w * 9 + m) * 64 + l];
                const int cc = (it % 96) * 64 + l;
                MOD[(size_t)(layer * 9 + m) * 6144 + cc] = s + a.in[I_ADAB][layer * 6144 + cc]; }
            __syncthreads();
        }
    }
    {
        f32x2* CS = (f32x2*)(ws + WS_ROPE);
        for (int i = C.bid * 512 + C.tid; i < 4096 * 16; i += C.nb * 512) {
            const int pos = i >> 4, j = i & 15, f = j & 7;
            const float inv = powf(10000.f, -(float)(2 * f) / 16.f);
            const float ang = (float)((j < 8) ? (pos >> 6) : (pos & 63)) * inv;
            const double tw = 6.283185307179586476925;
            const double x = (double)ang, n = __builtin_rint(x / tw), rr = x - n * tw;
            CS[i] = (f32x2){__cosf((float)rr), __sinf((float)rr)};
        }
    }
    for (int j = 0; j < 2; ++j) {
        transpose_matrix(C, a.in[I_EVWIN] + (size_t)j * DM * EV_IN, DM, EV_IN, (bf16*)(ws + WS_WEVIN) + (size_t)j * EV_INP * DM, nullptr, 0);
        transpose_matrix(C, a.in[I_EVWOUT] + (size_t)j * DM * DM, DM, DM, (bf16*)(ws + WS_WEVOUT) + (size_t)j * DM * DM, nullptr, 0);
        transpose_matrix(C, a.in[I_WUQ] + (size_t)j * 384 * 768, 384, 768, (bf16*)(ws + WS_WUQ) + (size_t)j * 768 * 384, a.in[I_QNORM] + j * 384, 0);
        transpose_matrix(C, a.in[I_WUKV] + (size_t)j * 256 * 1024, 256, 1024, (bf16*)(ws + WS_WUKV) + (size_t)j * 1024 * 256, a.in[I_KVNORM] + j * 256, 0);
        transpose_matrix(C, a.in[I_ODWIN] + (size_t)j * DM * OD_IN, DM, OD_IN, (bf16*)(ws + WS_WODIN) + (size_t)j * OD_INP * DM, nullptr, 0);
        transpose_matrix(C, a.in[I_ODWOUT] + (size_t)j * DM * DM, DM, DM, (bf16*)(ws + WS_WODOUT) + (size_t)j * DM * DM, nullptr, 0);
    }
    {
        const int gt = C.bid * 512 + C.tid, ngt = C.nb * 512;
        for (int j = 0; j < 2; ++j) {
            u32x4* p0 = (u32x4*)((bf16*)(ws + WS_WEVIN) + (size_t)j * EV_INP * DM + (size_t)EV_IN * DM);
            for (int i = gt; i < (EV_INP - EV_IN) * DM / 8; i += ngt) p0[i] = (u32x4){0u, 0u, 0u, 0u};
            u32x4* p1 = (u32x4*)((bf16*)(ws + WS_WODIN) + (size_t)j * OD_INP * DM + (size_t)OD_IN * DM);
            for (int i = gt; i < (OD_INP - OD_IN) * DM / 8; i += ngt) p1[i] = (u32x4){0u, 0u, 0u, 0u};
            bf16* WL = (bf16*)(ws + WS_WLORA) + (size_t)j * 655360;
            const float* w2 = a.in[I_W2L] + (size_t)j * 2 * 64 * 512; const float* a2 = a.in[I_A2] + (size_t)j * 2 * 64 * 512; const float* g2 = a.in[I_G2] + (size_t)j * 128 * 512;
            for (int i = gt; i < 655360; i += ngt) {
                const int n = i >> 8, k = i & 255; float v = 0.f;
                if (n < 1024) { const int d = n >> 9, c = n & 511; if (k >= d * 64 && k < d * 64 + 64) v = w2[(size_t)k * 512 + c]; }
                else if (n < 2048) { const int d = (n - 1024) >> 9, c = n & 511; if (k >= 128 + d * 64 && k < 192 + d * 64) v = a2[(size_t)(k - 128) * 512 + c]; }
                else { const int c = n - 2048; if (k >= 128) v = g2[(size_t)(k - 128) * 512 + c]; }
                WL[i] = f2bf(v);
            }
        }
    }
}

template <bool ROUTER> DI void norm_row(const Ctx& C, int row, const float* xlat, const float* xctx, const float* gain, const float* mod, int shift_off, int scale_off, bf16* H, float* AFFT, float* AFFC, int* SLOT);
template <bool ROUTER, int NR> DI void norm_rowsN(const Ctx& C, int row, const float* xlat, const float* gain, const float* mod, int shift_off, int scale_off, bf16* H, float* AFFT, int* SLOT);
template <bool ROUTER>
DI void ph_norm(const Ctx& C, const float* xlat, const float* xctx, const float* gain, const float* mod  , int shift_off, int scale_off, bf16* H,
                const float* router  , float* AFFT, float* AFFC, int* SLOT) {
    LAS float* RT = (LAS float*)C.lds;
    if (ROUTER) { for (int i = C.tid; i < 16384; i += 512) { const int c = i >> 4, e = i & 15; RT[e * 1024 + c] = router[i]; } __syncthreads(); }
    const int gw = C.bid * 8 + C.wave, ngw = C.nb * 8;
    for (int p = gw; p < NLAT / 4; p += ngw) norm_rowsN<ROUTER, 4>(C, 4 * p, xlat, gain, mod, shift_off, scale_off, H, AFFT, SLOT);
    for (int row = NLAT + gw; row < MT; row += ngw) norm_row<ROUTER>(C, row, xlat, xctx, gain, mod, shift_off, scale_off, H, AFFT, AFFC, SLOT);
}
template <bool ROUTER, int NR>
DI void norm_rowsN(const Ctx& C, int row, const float* __restrict__ xlat, const float* __restrict__ gain, const float* __restrict__ mod, int shift_off, int scale_off, bf16* __restrict__ H, float* __restrict__ AFFT, int* __restrict__ SLOT) {
    const LAS float* RT = (const LAS float*)C.lds; const int lane = C.lane;
    const float* xr = xlat + (size_t)row * DM;
    const float* mp = mod + (row >> 12) * 6144;
    f32x4 v[NR][4]; float rs[NR];
#pragma unroll
    for (int q = 0; q < NR; ++q) { float ss = 0.f;
#pragma unroll
        for (int j = 0; j < 4; ++j) { v[q][j] = *(const f32x4*)(xr + q * DM + 256 * j + 4 * lane); ss += v[q][j].x * v[q][j].x + v[q][j].y * v[q][j].y + v[q][j].z * v[q][j].z + v[q][j].w * v[q][j].w; }
        rs[q] = 1.0f / sqrtf(wave_sum(ss) * (1.f / 1024.f) + EPS); }
#pragma unroll
    for (int j = 0; j < 4; ++j) {
        const int c = 256 * j + 4 * lane;
        const f32x4 g = *(const f32x4*)(gain + c), sc = *(const f32x4*)(mp + scale_off + c), sh = *(const f32x4*)(mp + shift_off + c);
#pragma unroll
        for (int q = 0; q < NR; ++q) {
            v[q][j] = (v[q][j] * rs[q]) * g * (sc + 1.0f) + sh;
            if (ROUTER && MOE_F8) *(unsigned*)((unsigned char*)H + (size_t)(row + q) * DM + c) = pk4_fp8(v[q][j].x, v[q][j].y, v[q][j].z, v[q][j].w);
            else *(u32x2*)(H + (size_t)(row + q) * DM + c) = (u32x2){pk2(v[q][j].x, v[q][j].y), pk2(v[q][j].z, v[q][j].w)};
        }
    }
    if (ROUTER) {
        float lg[NR];
#pragma unroll
        for (int q = 0; q < NR; ++q) lg[q] = 0.f;
#pragma unroll 1
        for (int e = 0; e < 16; ++e) { float p[NR];
#pragma unroll
            for (int q = 0; q < NR; ++q) p[q] = 0.f;
#pragma unroll
            for (int j = 0; j < 4; ++j) { const f32x4 w = *(const LAS f32x4*)(RT + e * 1024 + 256 * j + 4 * lane);
#pragma unroll
                for (int q = 0; q < NR; ++q) p[q] += v[q][j].x * w.x + v[q][j].y * w.y + v[q][j].z * w.z + v[q][j].w * w.w; }
#pragma unroll
            for (int q = 0; q < NR; ++q) { const float t = wave_sum(p[q]); lg[q] = (lane == e) ? t : lg[q]; } }
#pragma unroll
        for (int q = 0; q < NR; ++q) { const float ex = expf(lg[q] - max16(lg[q])); const float af = ex / sum16(ex);
            if (lane < 16) { AFFT[(size_t)((row >> 12) * 16 + lane) * TL + ((row + q) & 4095)] = af; SLOT[(size_t)(row + q) * 16 + lane] = -1; } }
    }
}
template <bool ROUTER>
DI void norm_row(const Ctx& C, int row, const float* __restrict__ xlat, const float* __restrict__ xctx, const float* __restrict__ gain, const float* __restrict__ mod, int shift_off, int scale_off, bf16* __restrict__ H, float* __restrict__ AFFT, float* __restrict__ AFFC, int* __restrict__ SLOT) {
    const LAS float* RT = (const LAS float*)C.lds; const int lane = C.lane;
    {
        const float* xr = row < NLAT ? xlat + (size_t)row * DM : xctx + (size_t)(row - NLAT) * DM;
        const int mi = row < NLAT ? (row >> 12) : 8;
        const float* mp = mod + mi * 6144;
        f32x4 v[4]; float ss = 0.f;
#pragma unroll
        for (int j = 0; j < 4; ++j) { v[j] = *(const f32x4*)(xr + 256 * j + 4 * lane); ss += v[j].x * v[j].x + v[j].y * v[j].y + v[j].z * v[j].z + v[j].w * v[j].w; }
        ss = wave_sum(ss);
        const float rs = 1.0f / sqrtf(ss * (1.f / 1024.f) + EPS);
#pragma unroll
        for (int j = 0; j < 4; ++j) {
            const int c = 256 * j + 4 * lane;
            const f32x4 g = *(const f32x4*)(gain + c), sc = *(const f32x4*)(mp + scale_off + c), sh = *(const f32x4*)(mp + shift_off + c);
            v[j] = (v[j] * rs) * g * (sc + 1.0f) + sh;
            if (ROUTER && MOE_F8) *(unsigned*)((unsigned char*)H + (size_t)row * DM + c) = pk4_fp8(v[j].x, v[j].y, v[j].z, v[j].w);
            else *(u32x2*)(H + (size_t)row * DM + c) = (u32x2){pk2(v[j].x, v[j].y), pk2(v[j].z, v[j].w)};
        }
        if (ROUTER) {
            float mylg = 0.f;
#pragma unroll 1
            for (int e = 0; e < 16; ++e) { float p = 0.f;
#pragma unroll
                for (int j = 0; j < 4; ++j) { const f32x4 w = *(const LAS f32x4*)(RT + e * 1024 + 256 * j + 4 * lane); p += v[j].x * w.x + v[j].y * w.y + v[j].z * w.z + v[j].w * w.w; }
                p = wave_sum(p); mylg = (lane == e) ? p : mylg; }
            const float mx = max16(mylg);
            const float ex = expf(mylg - mx);
            const float mine = ex / sum16(ex);
            if (lane < 16) {
                if (row < NLAT) AFFT[(size_t)((row >> 12) * 16 + lane) * TL + (row & 4095)] = mine;
                else { const int rc = row - NLAT; AFFC[(size_t)((rc >> 8) * 16 + lane) * LCX + (rc & 255)] = mine; }
                SLOT[(size_t)row * 16 + lane] = -1;
            }
        }
    }
}


struct EpiBf16 { static constexpr bool WIDE = true; bf16* O; int ldo;
    DI void operator()(int row, int col, f32x4 v0, f32x4 v1) const { bf16* p = O + (size_t)row * ldo + col;
        *(u32x2*)p = (u32x2){pk2(v0[0], v0[1]), pk2(v0[2], v0[3])}; *(u32x2*)(p + 128) = (u32x2){pk2(v1[0], v1[1]), pk2(v1[2], v1[3])}; }
    DI void wide(int row, int col, f32x4 a0, f32x4 a1, f32x4 b0, f32x4 b1) const { bf16* p = O + (size_t)row * ldo + col;
        *(u32x4*)p = (u32x4){pk2(a0[0], a0[1]), pk2(a0[2], a0[3]), pk2(a1[0], a1[1]), pk2(a1[2], a1[3])}; *(u32x4*)(p + 128) = (u32x4){pk2(b0[0], b0[1]), pk2(b0[2], b0[3]), pk2(b1[0], b1[1]), pk2(b1[2], b1[3])}; } };
struct EpiF32 { static constexpr bool WIDE = false; float* O; int ldo;
    DI void operator()(int row, int col, f32x4 v0, f32x4 v1) const { float* p = O + (size_t)row * ldo + col; *(f32x4*)p = v0; *(f32x4*)(p + 128) = v1; } };
struct EpiResid { static constexpr bool WIDE = false; const float* xin_lat; const float* xin_ctx; float* xout_lat; float* xout_ctx; const float* modg;
    DI void operator()(int row, int col, f32x4 v0, f32x4 v1) const {
        const float* xi; float* xo; int mi;
        if (row < NLAT) { xi = xin_lat + (size_t)row * DM; xo = xout_lat + (size_t)row * DM; mi = row >> 12; }
        else { xi = xin_ctx + (size_t)(row - NLAT) * DM; xo = xout_ctx + (size_t)(row - NLAT) * DM; mi = 8; }
        const float* g = modg + mi * 6144 + col;
        const f32x4 g0 = *(const f32x4*)g, g1 = *(const f32x4*)(g + 128), x0 = *(const f32x4*)(xi + col), x1 = *(const f32x4*)(xi + col + 128);
        *(f32x4*)(xo + col) = x0 + g0 * v0; *(f32x4*)(xo + col + 128) = x1 + g1 * v1; } };
struct EpiGlu { static constexpr bool WIDE = false; bf16* O;
    DI void operator()(int row, int col, f32x4 v0, f32x4 v1) const { const int f = ((col & 2047) >> 8) * 128 + (col & 255);
        *(u32x2*)(O + (size_t)row * DM + f) = (u32x2){pk2(siluf_(v0[0]) * v1[0], siluf_(v0[1]) * v1[1]), pk2(siluf_(v0[2]) * v1[2], siluf_(v0[3]) * v1[3])}; } };
struct EpiGlu8 { static constexpr bool WIDE = true; unsigned char* O;
    DI void operator()(int row, int col, f32x4 v0, f32x4 v1) const { const int f = ((col & 2047) >> 8) * 128 + (col & 255);
        *(unsigned*)(O + (size_t)row * DM + f) = pk4_fp8(8.f * siluf_(v0[0]) * v1[0], 8.f * siluf_(v0[1]) * v1[1], 8.f * siluf_(v0[2]) * v1[2], 8.f * siluf_(v0[3]) * v1[3]); }
    DI void wide(int row, int col, f32x4 a0, f32x4 a1, f32x4 b0, f32x4 b1) const { const int f = ((col & 2047) >> 8) * 128 + (col & 255);
        *(u32x2*)(O + (size_t)row * DM + f) = (u32x2){pk4_fp8(8.f * siluf_(a0[0]) * b0[0], 8.f * siluf_(a0[1]) * b0[1], 8.f * siluf_(a0[2]) * b0[2], 8.f * siluf_(a0[3]) * b0[3]),
                                                    pk4_fp8(8.f * siluf_(a1[0]) * b1[0], 8.f * siluf_(a1[1]) * b1[1], 8.f * siluf_(a1[2]) * b1[2], 8.f * siluf_(a1[3]) * b1[3])}; } };
struct EpiGate { static constexpr bool WIDE = true; bf16* O; const float* gate;
    DI void operator()(int row, int col, f32x4 v0, f32x4 v1) const { const float g = gate[row]; bf16* p = O + (size_t)row * DM + (col & 1023);
        *(u32x2*)p = (u32x2){pk2(v0[0] * g, v0[1] * g), pk2(v0[2] * g, v0[3] * g)}; *(u32x2*)(p + 128) = (u32x2){pk2(v1[0] * g, v1[1] * g), pk2(v1[2] * g, v1[3] * g)}; }
    DI void wide(int row, int col, f32x4 a0, f32x4 a1, f32x4 b0, f32x4 b1) const { const float g = gate[row]; bf16* p = O + (size_t)row * DM + (col & 1023);
        *(u32x4*)p = (u32x4){pk2(a0[0] * g, a0[1] * g), pk2(a0[2] * g, a0[3] * g), pk2(a1[0] * g, a1[1] * g), pk2(a1[2] * g, a1[3] * g)};
        *(u32x4*)(p + 128) = (u32x4){pk2(b0[0] * g, b0[1] * g), pk2(b0[2] * g, b0[3] * g), pk2(b1[0] * g, b1[1] * g), pk2(b1[2] * g, b1[3] * g)}; } };
typedef _Float16 f16x2_t __attribute__((ext_vector_type(2)));
DI unsigned pk2h(float a, float b) { f16x2_t h; h.x = (_Float16)a; h.y = (_Float16)b; return __builtin_bit_cast(unsigned, h); }
DI float h2f(unsigned short x) { return (float)__builtin_bit_cast(_Float16, x); }
struct EpiLoraW { static constexpr bool WIDE = false; unsigned short* W; const float* w0;
    DI void one(int row, int col, f32x4 v) const { const int d = col >> 9, c = col & 511; f32x4 o;
#pragma unroll
        for (int e = 0; e < 4; ++e) { const float lw = w0[col + e] + v[e]; const float z = -lw; const float sp = fmaxf(z, 0.f) + __logf(1.f + __expf(-fabsf(z))); o[e] = -__expf(-sp - 0.5f); }
        *(u32x2*)(W + ((size_t)d * MT + row) * 512 + c) = (u32x2){pk2h(o[0], o[1]), pk2h(o[2], o[3])}; }
    DI void operator()(int row, int col, f32x4 v0, f32x4 v1) const { one(row, col, v0); one(row, col + 128, v1); } };
struct EpiLoraA { static constexpr bool WIDE = false; bf16* Aout; const float* a0;
    DI void one(int row, int col, f32x4 v) const { const int d = col >> 9, c = col & 511; const f32x4 b = *(const f32x4*)(a0 + col);
        *(u32x2*)(Aout + ((size_t)d * MT + row) * 512 + c) = (u32x2){pk2(sigmoidf_(b[0] + v[0]), sigmoidf_(b[1] + v[1])), pk2(sigmoidf_(b[2] + v[2]), sigmoidf_(b[3] + v[3]))}; }
    DI void operator()(int row, int col, f32x4 v0, f32x4 v1) const { one(row, col, v0); one(row, col + 128, v1); } };

namespace pg8 {
constexpr int BM = 256, BK = 64, HALF = 128, HTB = HALF * BK * 2, STAGE_BYTES = 8 * HTB;
DI int lds_byte(int r, int c) { const int st = (r >> 4) * 2 + (c >> 5), rr = r & 15, cc = c & 31, ob = rr * 64 + cc * 2; return st * 1024 + (ob ^ (((ob >> 9) & 1) << 5)); }
DI void stage_rc(int b, int& R, int& C) { const int st = b / 1024, sb = b % 1024, swz = sb ^ (((sb >> 9) & 1) << 5); R = (st >> 1) * 16 + swz / 64; C = (st & 1) * 32 + (swz % 64) / 2; }
DI int perm32(int rho) { const int n = rho >> 4, i = rho & 15; return 8 * (i >> 2) + 4 * n + (i & 3); }
struct Unit { int pm, pn; };
struct Gemm { const bf16* A; const bf16* Bt; int lda, K; const int* rows; int scale_w = 0x7f7f7f7f, scale_a = 0x7f7f7f7f; };
struct OrderMN { int nM, nN, G, c;
    DI bool next(int i, Unit& u) const { const int L = i * G + c; if (L >= nM * nN) return false; u.pm = L / nN; u.pn = L % nN; return true; } };
struct OrderMoE { int nMt, nN, mstride  , G, c;
    DI bool next(int i, Unit& u) const { const int L = i * G + c, per = nMt * nN; if (L >= NEXP * per) return false; const int e = L / per, q = L % per; u.pm = e * mstride + q / nN; u.pn = e * nN + q % nN; return true; } };
template <class E4> struct EpiAdapt { E4 e;
    DI void operator()(const f32x4 (&acc)[2][2][4][2], const Unit& u, int wr, int wc, int fr, int fq) const {
#pragma unroll
        for (int ai = 0; ai < 2; ++ai)
#pragma unroll
            for (int m = 0; m < 4; ++m) { const int row = u.pm * BM + ai * HALF + wr * 64 + m * 16 + fr;
                if constexpr (E4::WIDE) e.wide(row, u.pn * BM + wc * 32 + 8 * fq, acc[ai][0][m][0], acc[ai][0][m][1], acc[ai][1][m][0], acc[ai][1][m][1]);
                else {
#pragma unroll
                    for (int n = 0; n < 2; ++n) e(row, u.pn * BM + wc * 32 + 8 * fq + 4 * n, acc[ai][0][m][n], acc[ai][1][m][n]); } } } };

template <class Epi, class Sched, bool F8 = false>
DI void gemm_phase(LAS unsigned char* lds, const Gemm g, const Sched& S, const Epi& E, const int tid) {
    const int wid = __builtin_amdgcn_readfirstlane(tid >> 6), lane = tid & 63, wr = wid >> 2, wc = wid & 3, fr = lane & 15, fq = lane >> 4;
    const int K = g.K, nt = K / BK;
    unsigned voffB[2];
#pragma unroll
    for (int i = 0; i < 2; ++i) { int R, C; stage_rc(tid * 16 + i * 8192, R, C); const int Rb = (R & ~31) + perm32(R & 31); voffB[i] = (unsigned)(Rb * K + C) * 2u; }
    const size_t kstep = (size_t)(BK * 2), hstep = (size_t)HALF * K * 2, tstep = 2 * hstep;
    const unsigned ldsw = (unsigned)wid * 1024u;
    const int aoff = lds_byte(wr * 64 + fr, fq * 8), boff = lds_byte(wc * 32 + fr, fq * 8);
    const char* const gA = (const char*)g.A;
#define PG8_SA(b, h) (((b) * 2 + (h)) * HTB)
#define PG8_SB(b, h) ((4 + (b) * 2 + (h)) * HTB)
#define PG8_STAGE(bufoff, gbase, voff) do { _Pragma("unroll") for (int _i = 0; _i < 2; ++_i) \
        __builtin_amdgcn_global_load_lds((const unsigned*)((const char*)(gbase) + (voff)[_i]), (LAS unsigned*)(lds + (bufoff) + ldsw + _i * 8192), 16, 0, 0); } while (0)
#define PG8_LDA(dst, b, h) do { _Pragma("unroll") for (int m = 0; m < 4; ++m) _Pragma("unroll") for (int k = 0; k < 2; ++k) dst[m][k] = *(const LAS bf16x8*)(lds + PG8_SA(b, h) + aoff + m * 2048 + k * 1024); } while (0)
#define PG8_LDB(dst, b, h) do { _Pragma("unroll") for (int n = 0; n < 2; ++n) _Pragma("unroll") for (int k = 0; k < 2; ++k) dst[n][k] = *(const LAS bf16x8*)(lds + PG8_SB(b, h) + boff + n * 2048 + k * 1024); } while (0)
#define PG8_MMA(ai, bj, At, Bt) do { __builtin_amdgcn_s_setprio(1); _Pragma("unroll") for (int m = 0; m < 4; ++m) _Pragma("unroll") for (int n = 0; n < 2; ++n) { \
        if constexpr (F8) { const v8i_t w8 = __builtin_shufflevector(__builtin_bit_cast(i32x4_t, Bt[n][0]), __builtin_bit_cast(i32x4_t, Bt[n][1]), 0, 1, 2, 3, 4, 5, 6, 7), x8 = __builtin_shufflevector(__builtin_bit_cast(i32x4_t, At[m][0]), __builtin_bit_cast(i32x4_t, At[m][1]), 0, 1, 2, 3, 4, 5, 6, 7); \
            acc[ai][bj][m][n] = __builtin_amdgcn_mfma_scale_f32_16x16x128_f8f6f4(w8, x8, acc[ai][bj][m][n], 0, 0, 0, g.scale_w, 0, g.scale_a); } \
        else { _Pragma("unroll") for (int k = 0; k < 2; ++k) acc[ai][bj][m][n] = __builtin_amdgcn_mfma_f32_16x16x32_bf16(Bt[n][k], At[m][k], acc[ai][bj][m][n], 0, 0, 0); } } __builtin_amdgcn_s_setprio(0); } while (0)
#define PG8_WAIT_V(n) asm volatile("s_waitcnt vmcnt(" #n ")" ::: "memory")
#define PG8_WAIT_L(n) asm volatile("s_waitcnt lgkmcnt(" #n ")" ::: "memory")
#define PG8_BAR __builtin_amdgcn_s_barrier()
#define PG8_SCHED __builtin_amdgcn_sched_barrier(0)
#define PG8_ROWIDX(ri, u) do { _Pragma("unroll") for (int _h = 0; _h < 2; ++_h) _Pragma("unroll") for (int _i = 0; _i < 2; ++_i) { int _R, _C; stage_rc(tid * 16 + _i * 8192, _R, _C); (void)_C; \
        const int _lr = (u).pm * BM + _h * HALF + _R; ri[_h][_i] = g.rows ? g.rows[_lr] : _lr; } } while (0)
#define PG8_AOFF_FROM(vo, ri) do { _Pragma("unroll") for (int _h = 0; _h < 2; ++_h) _Pragma("unroll") for (int _i = 0; _i < 2; ++_i) { int _R, _C; stage_rc(tid * 16 + _i * 8192, _R, _C); (void)_R; \
        vo[_h][_i] = (unsigned)(((size_t)ri[_h][_i] * g.lda + _C) * 2u); } } while (0)
    Unit cur, nxt; int ui = 0;
    if (!S.next(0, cur)) return;
    f32x4 acc[2][2][4][2];
#pragma unroll
    for (int a = 0; a < 2; ++a)
#pragma unroll
        for (int b = 0; b < 2; ++b)
#pragma unroll
            for (int m = 0; m < 4; ++m)
#pragma unroll
                for (int n = 0; n < 2; ++n) acc[a][b][m][n] = (f32x4){0.f, 0.f, 0.f, 0.f};
    bf16x8 At[4][2], B0[2][2], B1[2][2];
    unsigned cvo[2][2]; int nri[2][2];
    PG8_ROWIDX(nri, cur); PG8_AOFF_FROM(cvo, nri);
    const char* cB = (const char*)g.Bt + (size_t)cur.pn * tstep;
    PG8_STAGE(PG8_SB(0, 0), cB, voffB); PG8_STAGE(PG8_SB(0, 1), cB + hstep, voffB); PG8_STAGE(PG8_SA(0, 0), gA, cvo[0]); PG8_STAGE(PG8_SA(0, 1), gA, cvo[1]);
    if (wr == 1) PG8_BAR;
    PG8_WAIT_V(2); PG8_BAR;
    PG8_STAGE(PG8_SB(1, 0), cB + kstep, voffB); PG8_STAGE(PG8_SA(1, 0), gA + kstep, cvo[0]); PG8_STAGE(PG8_SB(1, 1), cB + hstep + kstep, voffB);
    PG8_WAIT_V(6); PG8_BAR;
    for (;;) {
        const bool has_next = S.next(ui + 1, nxt);
        const char* nB = has_next ? (const char*)g.Bt + (size_t)nxt.pn * tstep : cB;
#pragma nounroll
        for (int t = 0; t < nt; t += 2) {
            const bool last = (t == nt - 2);
            const char* a1 = gA + (size_t)(t + 1) * kstep;
            const char* a2 = last ? gA : gA + (size_t)(t + 2) * kstep; const char* b2 = last ? nB : cB + (size_t)(t + 2) * kstep;
            const char* a3 = a2 + kstep; const char* b3 = b2 + kstep;
            if (t == nt - 4 && has_next) PG8_ROWIDX(nri, nxt);
            PG8_LDB(B0, 0, 0); PG8_LDB(B1, 0, 1); PG8_SCHED; PG8_LDA(At, 0, 0); PG8_STAGE(PG8_SA(1, 1), a1, cvo[1]);
            if (last && has_next) { if (nt < 4) PG8_ROWIDX(nri, nxt); PG8_AOFF_FROM(cvo, nri); }
            PG8_WAIT_V(8); PG8_WAIT_L(0); PG8_BAR; PG8_MMA(0, 0, At, B0); PG8_MMA(0, 1, At, B1); PG8_BAR; PG8_SCHED;
            PG8_LDA(At, 0, 1); PG8_STAGE(PG8_SB(0, 0), b2, voffB); PG8_STAGE(PG8_SB(0, 1), b2 + hstep, voffB); PG8_STAGE(PG8_SA(0, 0), a2, cvo[0]);
            PG8_WAIT_V(8); PG8_WAIT_L(0); PG8_BAR; PG8_MMA(1, 0, At, B0); PG8_MMA(1, 1, At, B1); PG8_BAR; PG8_SCHED;
            PG8_LDB(B0, 1, 0); PG8_LDB(B1, 1, 1); PG8_SCHED; PG8_LDA(At, 1, 0); PG8_STAGE(PG8_SA(0, 1), a2, cvo[1]);
            PG8_WAIT_V(8); PG8_WAIT_L(0); PG8_BAR; PG8_MMA(0, 0, At, B0); PG8_MMA(0, 1, At, B1); PG8_BAR; PG8_SCHED;
            PG8_LDA(At, 1, 1); PG8_STAGE(PG8_SB(1, 0), b3, voffB); PG8_STAGE(PG8_SB(1, 1), b3 + hstep, voffB); PG8_STAGE(PG8_SA(1, 0), a3, cvo[0]);
            PG8_WAIT_V(8); PG8_WAIT_L(0); PG8_BAR; PG8_MMA(1, 0, At, B0); PG8_MMA(1, 1, At, B1); PG8_BAR; PG8_SCHED;
        }
        if (wr == 0) PG8_BAR;
        E(acc, cur, wr, wc, fr, fq);
        if (!has_next) break;
#pragma unroll
        for (int a = 0; a < 2; ++a)
#pragma unroll
            for (int b = 0; b < 2; ++b)
#pragma unroll
                for (int m = 0; m < 4; ++m)
#pragma unroll
                    for (int n = 0; n < 2; ++n) acc[a][b][m][n] = (f32x4){0.f, 0.f, 0.f, 0.f};
        cur = nxt; cB = nB; ++ui;
        if (wr == 1) PG8_BAR;
    }
    PG8_WAIT_V(0);
    PG8_BAR;
#undef PG8_SA
#undef PG8_SB
#undef PG8_STAGE
#undef PG8_LDA
#undef PG8_LDB
#undef PG8_MMA
#undef PG8_WAIT_V
#undef PG8_WAIT_L
#undef PG8_BAR
#undef PG8_SCHED
#undef PG8_ROWIDX
#undef PG8_AOFF_FROM
}
}
template <class E4> DI void fast_gemm(const Ctx& C, const bf16* A, int lda, const bf16* Bt, int K, int nM, int nN, const E4& e, bool rev = false) {
    pg8::Gemm g{A, Bt, lda, K, nullptr}; pg8::OrderMN S{nM, nN, C.nb, rev ? C.nb - 1 - C.vcu : C.vcu}; pg8::EpiAdapt<E4> E{e};
    pg8::gemm_phase(C.lds, g, S, E, C.tid);
}

DI float max16_acc(float m, const f32x16& x) {
    asm volatile("s_nop 15\n\tv_max3_f32 %0, %0, %1, %2\n\tv_max3_f32 %0, %0, %3, %4\n\tv_max3_f32 %0, %0, %5, %6\n\tv_max3_f32 %0, %0, %7, %8\n\tv_max3_f32 %0, %0, %9, %10\n\tv_max3_f32 %0, %0, %11, %12\n\tv_max3_f32 %0, %0, %13, %14\n\tv_max3_f32 %0, %0, %15, %16"
                 : "+v"(m) : "v"(x[0]), "v"(x[1]), "v"(x[2]), "v"(x[3]), "v"(x[4]), "v"(x[5]), "v"(x[6]), "v"(x[7]), "v"(x[8]), "v"(x[9]), "v"(x[10]), "v"(x[11]), "v"(x[12]), "v"(x[13]), "v"(x[14]), "v"(x[15]));
    return m; }
DI int swap23(int x) { return (x & ~12) | ((x & 4) << 1) | ((x & 8) >> 1); }
DI void flash_store(const f32x16 (&o)[2], float l, bf16* orow  , int h) {
    const float inv = 1.f / l;
#pragma unroll
    for (int dt = 0; dt < 2; ++dt)
#pragma unroll
        for (int g = 0; g < 4; ++g)
            *(u32x2*)(orow + 32 * dt + 8 * g + 4 * h) = (u32x2){pk2(o[dt][4 * g] * inv, o[dt][4 * g + 1] * inv), pk2(o[dt][4 * g + 2] * inv, o[dt][4 * g + 3] * inv)};
}


template <int DQK> struct AttnGeo { static constexpr int KSTR = DQK * 2 + 16, KBYTES = 64 * KSTR, VSTR = 144, VBYTES = 64 * VSTR, BUF = KBYTES + VBYTES, KPIECES = 64 * DQK / 8; };
template <int DQK, bool NAT>
DI void attn_tile_loop(const Ctx& C, f32x16 (&o)[2], float& l, const bf16x8 (&qf)[DQK / 16], const bf16* __restrict__ Kb, const bf16* __restrict__ Vt, int pos1, int n1, int pos2, int n2,
                       const LAS float* tab, int grow, int rs, int qc, int cs) {
    typedef AttnGeo<DQK> G;
    const int tid = C.tid, r = C.lane & 31, h = C.lane >> 5, kr = swap23(r), ntiles = n1 + n2;
    constexpr bool K2 = G::KPIECES > 512;
    const int kq0 = tid, kq1 = tid + 512;
    const int kl0 = (kq0 / (DQK / 8)) * G::KSTR + (kq0 % (DQK / 8)) * 16, kl1 = (kq1 / (DQK / 8)) * G::KSTR + (kq1 % (DQK / 8)) * 16;
    const int vl = G::KBYTES + (tid >> 3) * G::VSTR + (tid & 7) * 16;
    const bf16* vg = Vt + (size_t)(tid >> 3) * KPOS + 8 * (tid & 7);
    u32x4 rk0, rk1, rv;
    rk1 = (u32x4){0u, 0u, 0u, 0u};
#define ATT_POS(t) ((t) < n1 ? pos1 + 64 * (t) : pos2 + 64 * ((t) - n1))
    { const int pos0 = ATT_POS(0); rk0 = *(const u32x4*)(Kb + (size_t)pos0 * DQK + 8 * kq0); if (K2 && tid < 256) rk1 = *(const u32x4*)(Kb + (size_t)pos0 * DQK + 8 * kq1); rv = *(const u32x4*)(vg + pos0); }
    __syncthreads();
    *(LAS u32x4*)(C.lds + kl0) = rk0; if (K2 && tid < 256) *(LAS u32x4*)(C.lds + kl1) = rk1; *(LAS u32x4*)(C.lds + vl) = rv;
    __syncthreads();
    if (C.wave >= 4) __builtin_amdgcn_s_setprio(1);
    float mref = 0.f; bool first = true;
    f32x16 nmref;
#pragma unroll
    for (int i = 0; i < 16; ++i) nmref[i] = 0.f;
    constexpr float THR = 8.f;
    for (int t = 0; t < ntiles; ++t) {
        const LAS unsigned char* B = C.lds + (t & 1) * G::BUF;
        if (t + 1 < ntiles) { const int pos0 = ATT_POS(t + 1);
            rk0 = *(const u32x4*)(Kb + (size_t)pos0 * DQK + 8 * kq0); if (K2 && tid < 256) rk1 = *(const u32x4*)(Kb + (size_t)pos0 * DQK + 8 * kq1); rv = *(const u32x4*)(vg + pos0); }
        const int gr = (pos1 >> 6) + t;
        const bool active = !NAT || t >= n1 || (gr >= rs && gr < rs + 8);
        if (active) {
            f32x16 sc[2];
            constexpr int NK = DQK / 16, NS = 2 * NK, RD = 4;
            const LAS unsigned char* kp = B + kr * G::KSTR + 16 * h;
            bf16x8 fr[RD];
#pragma unroll
            for (int s = 0; s < RD; ++s) fr[s] = *(const LAS bf16x8*)(kp + (s / NK) * 32 * G::KSTR + 32 * (s % NK));
#pragma unroll
            for (int s = 0; s < NS; ++s) { sc[s / NK] = MFMA32(fr[s % RD], qf[s % NK], (s % NK == 0) ? nmref : sc[s / NK]);
                if (s + RD < NS) fr[s % RD] = *(const LAS bf16x8*)(kp + ((s + RD) / NK) * 32 * G::KSTR + 32 * ((s + RD) % NK)); }
            const LAS unsigned char* vp = B + G::KBYTES + r * G::VSTR + 16 * h;
#pragma unroll
            for (int v = 0; v < RD; ++v) fr[v] = *(const LAS bf16x8*)(vp + (v & 1) * 32 * G::VSTR + (v >> 1) * 32);
            __builtin_amdgcn_sched_group_barrier(0x100, RD, 0);
#pragma unroll
            for (int s = 0; s < NS - RD; ++s) { __builtin_amdgcn_sched_group_barrier(0x008, 1, 0); __builtin_amdgcn_sched_group_barrier(0x100, 1, 0); }
            __builtin_amdgcn_sched_group_barrier(0x008, RD, 0);
            __builtin_amdgcn_sched_group_barrier(0x100, RD, 0);
            if (NAT && t < n1) {
                const LAS float* trl = tab + (gr - grow + 7) * 128 + (8 * h - qc + 63);
#pragma unroll
                for (int j = 0; j < 2; ++j) { float bv[16];
#pragma unroll
                    for (int i = 0; i < 16; ++i) bv[i] = trl[32 * j + ((i & 3) | (((i >> 2) & 1) << 2) | ((i >> 3) << 4))];
                    asm volatile("" : "+v"(bv[0]), "+v"(bv[1]), "+v"(bv[2]), "+v"(bv[3]), "+v"(bv[4]), "+v"(bv[5]), "+v"(bv[6]), "+v"(bv[7]), "+v"(bv[8]), "+v"(bv[9]), "+v"(bv[10]), "+v"(bv[11]), "+v"(bv[12]), "+v"(bv[13]), "+v"(bv[14]), "+v"(bv[15]));
#pragma unroll
                    for (int i = 0; i < 16; ++i) {
                        const int cc = 32 * j + ((i & 3) | (((i >> 2) & 1) << 2) | ((i >> 3) << 4)) + 8 * h; const bool ok = (cc >= cs) && (cc < cs + 16);
                        sc[j][i] = ok ? sc[j][i] + bv[i] : -1e30f;
                    } }
            }
            float mx = max16_acc(max16_acc(-3.0e38f, sc[0]), sc[1]);
            if (first || __builtin_amdgcn_ballot_w64(mx > THR) != 0ull) {
                mx = fmaxf(mx, xor32(mx, C.lane));
                const float delta = first ? mx : fmaxf(mx, 0.f);
#pragma unroll
                for (int i = 0; i < 16; ++i) { sc[0][i] -= delta; sc[1][i] -= delta; }
                if (!first) { const float alpha = __builtin_amdgcn_exp2f(-delta); l *= alpha;
#pragma unroll
                    for (int i = 0; i < 16; ++i) { o[0][i] *= alpha; o[1][i] *= alpha; } }
                mref += delta; first = false;
#pragma unroll
                for (int i = 0; i < 16; ++i) nmref[i] = -mref;
            }
            float rs1 = 0.f;
#pragma unroll
            for (int j = 0; j < 2; ++j)
#pragma unroll
                for (int i = 0; i < 16; ++i) { sc[j][i] = __builtin_amdgcn_exp2f(sc[j][i]); rs1 += sc[j][i]; }
            l += rs1;
#pragma unroll
            for (int j = 0; j < 2; ++j)
#pragma unroll
                for (int s2 = 0; s2 < 2; ++s2) {
                    u32x4 pw; pw.x = pk2(sc[j][8 * s2], sc[j][8 * s2 + 1]); pw.y = pk2(sc[j][8 * s2 + 2], sc[j][8 * s2 + 3]); pw.z = pk2(sc[j][8 * s2 + 4], sc[j][8 * s2 + 5]); pw.w = pk2(sc[j][8 * s2 + 6], sc[j][8 * s2 + 7]);
                    const bf16x8 pb = __builtin_bit_cast(bf16x8, pw);
#pragma unroll
                    for (int dt = 0; dt < 2; ++dt) { const int v = 4 * j + 2 * s2 + dt;
                        o[dt] = MFMA32(fr[v % RD], pb, o[dt]);
                        if (v + RD < 8) fr[v % RD] = *(const LAS bf16x8*)(vp + ((v + RD) & 1) * 32 * G::VSTR + ((v + RD) >> 1) * 32); }
                }
#pragma unroll
            for (int v = 0; v < 8 - RD; ++v) { __builtin_amdgcn_sched_group_barrier(0x008, 1, 1); __builtin_amdgcn_sched_group_barrier(0x100, 1, 1); }
            __builtin_amdgcn_sched_group_barrier(0x008, RD, 1);
        }
        if (t + 1 < ntiles) { LAS unsigned char* Bn = C.lds + ((t + 1) & 1) * G::BUF;
            *(LAS u32x4*)(Bn + kl0) = rk0; if (K2 && tid < 256) *(LAS u32x4*)(Bn + kl1) = rk1; *(LAS u32x4*)(Bn + vl) = rv; }
        __syncthreads();
    }
    __builtin_amdgcn_s_setprio(0);
    l += xor32(l, C.lane);
#undef ATT_POS
}
DI void conv_unit(const Ctx& C, int u, const bf16* U, const float (&wk)[31], float bias, const float* lng, const float* lnb, bf16* OCAT);
DI const float* in_ptr(const unsigned char* ws, int k);
constexpr int CONV_PER_TAIL = 3;
DI int conv_in_fin(int nb) { const int extra = (MT / 64) % nb; const int n = CONV_PER_TAIL * (nb - extra); return n < MT / 32 ? n : MT / 32; }
DI void ph_attn_mla2(const Ctx& C, const bf16* QB, const bf16* KB, const bf16* VT, bf16* OCAT, bool last, unsigned char* ws, int lq) {
    const int r = C.lane & 31, h = C.lane >> 5;
    const int nunits = 1024 + (last ? 0 : 64);
    int k = 0;
    for (;; ++k) {
        const int u = C.vcu + k * C.nb, cu = conv_in_fin(C.nb) + (C.nb - 1 - C.vcu) + k * C.nb;
        const bool a_on = u < nunits, c_on = cu < MT / 32;
        if (!a_on && !c_on) break;
        if (a_on) {
            const int bh = u < 1024 ? (u >> 4) : u - 1024, qblk = u < 1024 ? (u & 15) : 16, b = bh >> 3, hh = bh & 7;
            const int qpos = qblk * 256 + 32 * C.wave + r;
            const bf16* qp = QB + ((size_t)bh * KPOS + qpos) * 96 + 8 * h;
            bf16x8 qf[6];
#pragma unroll
            for (int kk = 0; kk < 6; ++kk) qf[kk] = *(const bf16x8*)(qp + 16 * kk);
            f32x16 o[2];
#pragma unroll
            for (int i = 0; i < 16; ++i) { o[0][i] = 0.f; o[1][i] = 0.f; }
            float l = 0.f;
            attn_tile_loop<96, false>(C, o, l, qf, KB + (size_t)bh * KPOS * 96, VT + (size_t)bh * 64 * KPOS, qblk < 16 ? 0 : TL, qblk < 16 ? KPOS / 64 : LCX / 64, 0, 0, nullptr, 0, 0, 0, 0);
            const int row = qblk < 16 ? b * TL + qpos : NLAT + b * LCX + (qpos - TL);
            flash_store(o, l, OCAT + (size_t)row * DM + hh * 64, h);
        }
        if (c_on) { float wk[31]; const float* dww = in_ptr(ws, I_DWW) + (size_t)lq * 31 * 512;
#pragma unroll
            for (int kt = 0; kt < 31; ++kt) wk[kt] = dww[kt * 512 + C.tid];
            conv_unit(C, cu, (const bf16*)(ws + WS_ARENA + A_U), wk, in_ptr(ws, I_DWB)[lq * 512 + C.tid], in_ptr(ws, I_LNG) + lq * 512, in_ptr(ws, I_LNB) + lq * 512, OCAT); }
    }
}
DI void ph_natten2(const Ctx& C, const bf16* QN, const bf16* KN, const bf16* VTN, bf16* OCAT, const float* rpb  , bool last, unsigned* work_ctr, unsigned char* ws, int lq) {
    const int r = C.lane & 31, h = C.lane >> 5;
    LAS float* tab = (LAS float*)(C.lds + 2 * AttnGeo<64>::BUF);
    LAS int* uslot = (LAS int*)(tab + 1920);
    const int nunits = 1024 + (last ? 0 : 64);
    for (;;) {
        __syncthreads();
        if (C.tid == 0) *uslot = (int)__hip_atomic_fetch_add(work_ctr, 1u, __ATOMIC_RELAXED, __HIP_MEMORY_SCOPE_AGENT);
        __syncthreads();
        const int u = *uslot;
        if (u >= nunits) break;
        const bool isctx = u >= 1024;
        const int bh = isctx ? u - 1024 : (u >> 4), b = bh >> 3, hh = bh & 7;
        for (int i = C.tid; i < 15 * 128; i += 512) { const int dc = (i & 127) - 48; tab[i] = (dc >= 0 && dc < 31) ? rpb[hh * 465 + (i >> 7) * 31 + dc] * LOG2E : 0.f; }
        int qpos, row, grow = 0, qc = 0, rs = 0, cs = 0, rlo = 0, nband = 0;
        if (!isctx) { const int rg = u & 15; grow = 4 * rg + (C.wave >> 1); qc = 32 * (C.wave & 1) + r; qpos = grow * 64 + qc; row = b * TL + qpos;
            rs = grow - 4; rs = rs < 0 ? 0 : (rs > 56 ? 56 : rs); cs = qc - 8; cs = cs < 0 ? 0 : (cs > 48 ? 48 : cs);
            rlo = 4 * rg - 4; rlo = rlo < 0 ? 0 : (rlo > 56 ? 56 : rlo); int rhi = 4 * rg + 3 - 4; rhi = rhi < 0 ? 0 : (rhi > 56 ? 56 : rhi); nband = rhi + 8 - rlo; }
        else { qpos = TL + 32 * C.wave + r; row = NLAT + b * LCX + 32 * C.wave + r; }
        const bf16* qp = QN + ((size_t)bh * KPOS + qpos) * 64 + 8 * h;
        bf16x8 qf[4];
#pragma unroll
        for (int kk = 0; kk < 4; ++kk) qf[kk] = *(const bf16x8*)(qp + 16 * kk);
        f32x16 o[2];
#pragma unroll
        for (int i = 0; i < 16; ++i) { o[0][i] = 0.f; o[1][i] = 0.f; }
        float l = 0.f;
        attn_tile_loop<64, true>(C, o, l, qf, KN + (size_t)bh * KPOS * 64, VTN + (size_t)bh * 64 * KPOS, rlo * 64, nband, TL, LCX / 64, tab, grow, rs, qc, cs);
        flash_store(o, l, OCAT + (size_t)row * DM + 512 + hh * 64, h);
    }
}


DI void ph_mla_fin(const Ctx& C, const bf16* __restrict__ U, const bf16* __restrict__ QPRE, const bf16* __restrict__ KVPRE, const float* __restrict__ qg, const float* __restrict__ kg, const f32x2* __restrict__ CS, bf16* __restrict__ QB, bf16* __restrict__ KB, bf16* __restrict__ VT) {
    LAS bf16* VL = (LAS bf16*)C.lds;
    const int lane = C.lane, j = lane >> 3, sub = lane & 7;
    const float C2 = 0.10206207261596575f * LOG2E;
    float qgn[8], qgr[4], kgn[8], kgr[4];
#pragma unroll
    for (int e = 0; e < 8; ++e) { qgn[e] = qg[8 * sub + e] * C2; kgn[e] = kg[8 * sub + e]; }
#pragma unroll
    for (int m = 0; m < 4; ++m) { qgr[m] = qg[64 + sub + 8 * m] * C2; kgr[m] = kg[64 + sub + 8 * m]; }
    for (int u = C.vcu; u < MT / 64; u += C.nb) {
        const int row0 = 64 * u, b = row0 < NLAT ? (row0 >> 12) : ((row0 - NLAT) >> 8), pos0 = row0 < NLAT ? (row0 & 4095) : TL + ((row0 - NLAT) & 255);
        const bool lat = row0 < NLAT;
        const int pl = 8 * C.wave + j, row = row0 + pl, pos = pos0 + pl;
        const bf16* ur = U + (size_t)row * EV_INP;
        float sq = 0.f, skv = 0.f;
#pragma unroll
        for (int m = 0; m < 6; ++m) { float x[8]; unpack8(*(const u32x4*)(ur + 8 * (sub + 8 * m)), x);
#pragma unroll
            for (int e = 0; e < 8; ++e) sq += x[e] * x[e]; }
#pragma unroll
        for (int m = 0; m < 4; ++m) { float x[8]; unpack8(*(const u32x4*)(ur + 384 + 8 * (sub + 8 * m)), x);
#pragma unroll
            for (int e = 0; e < 8; ++e) skv += x[e] * x[e]; }
        sq = sum8(sq); skv = sum8(skv);
        const float rsq = 1.0f / sqrtf(sq * (1.f / 384.f) + EPS), rskv = 1.0f / sqrtf(skv * (1.f / 256.f) + EPS);
        float krv[4];
#pragma unroll
        for (int m = 0; m < 4; ++m) krv[m] = bf2f(ur[640 + sub + 8 * m]);
        float cr = 1.f, sr = 0.f, cc = 1.f, sc = 0.f;
        if (lat) { const f32x2 a0 = CS[pos * 16 + sub], a1 = CS[pos * 16 + 8 + sub]; cr = a0.x; sr = a0.y; cc = a1.x; sc = a1.y; }
        const bf16* qrow = QPRE + (size_t)row * 768; const bf16* kvrow = KVPRE + (size_t)row * 1024;
#pragma unroll 2
        for (int hh = 0; hh < 8; ++hh) {
            { float qn[8], qr[4]; unpack8(*(const u32x4*)(qrow + hh * 96 + 8 * sub), qn); float ss = 0.f;
#pragma unroll
              for (int e = 0; e < 8; ++e) qn[e] *= rsq;
#pragma unroll
              for (int m = 0; m < 4; ++m) { qr[m] = bf2f(qrow[hh * 96 + 64 + sub + 8 * m]) * rsq; ss += qr[m] * qr[m]; }
#pragma unroll
              for (int e = 0; e < 8; ++e) ss += qn[e] * qn[e];
              const float rn = 1.0f / sqrtf(sum8(ss) * (1.f / 96.f) + EPS);
#pragma unroll
              for (int e = 0; e < 8; ++e) qn[e] *= rn * qgn[e];
#pragma unroll
              for (int m = 0; m < 4; ++m) qr[m] *= rn * qgr[m];
              { const float x0 = qr[0], x1 = qr[1], y0 = qr[2], y1 = qr[3]; qr[0] = x0 * cr - x1 * sr; qr[1] = x1 * cr + x0 * sr; qr[2] = y0 * cc - y1 * sc; qr[3] = y1 * cc + y0 * sc; }
              bf16* qo = QB + ((size_t)(b * 8 + hh) * KPOS + pos) * 96;
              *(u32x4*)(qo + 8 * sub) = pack8(qn);
#pragma unroll
              for (int m = 0; m < 4; ++m) qo[64 + sub + 8 * m] = f2bf(qr[m]); }
            { float kn[8], kr[4]; unpack8(*(const u32x4*)(kvrow + hh * 128 + 8 * sub), kn); float ss = 0.f;
#pragma unroll
              for (int e = 0; e < 8; ++e) kn[e] *= rskv;
#pragma unroll
              for (int m = 0; m < 4; ++m) { kr[m] = krv[m]; ss += kr[m] * kr[m]; }
#pragma unroll
              for (int e = 0; e < 8; ++e) ss += kn[e] * kn[e];
              const float rn = 1.0f / sqrtf(sum8(ss) * (1.f / 96.f) + EPS);
#pragma unroll
              for (int e = 0; e < 8; ++e) kn[e] *= rn * kgn[e];
#pragma unroll
              for (int m = 0; m < 4; ++m) kr[m] *= rn * kgr[m];
              { const float x0 = kr[0], x1 = kr[1], y0 = kr[2], y1 = kr[3]; kr[0] = x0 * cr - x1 * sr; kr[1] = x1 * cr + x0 * sr; kr[2] = y0 * cc - y1 * sc; kr[3] = y1 * cc + y0 * sc; }
              bf16* ko = KB + ((size_t)(b * 8 + hh) * KPOS + pos) * 96;
              *(u32x4*)(ko + 8 * sub) = pack8(kn);
#pragma unroll
              for (int m = 0; m < 4; ++m) ko[64 + sub + 8 * m] = f2bf(kr[m]); }
            { float vv[8]; unpack8(*(const u32x4*)(kvrow + hh * 128 + 64 + 8 * sub), vv);
#pragma unroll
              for (int e = 0; e < 8; ++e) VL[(hh * 64 + 8 * sub + e) * 64 + pl] = f2bf(vv[e] * rskv); }
        }
        __syncthreads();
        { const int hd = C.tid;
            bf16* dst = VT + ((size_t)(b * 8 + (hd >> 6)) * 64 + (hd & 63)) * KPOS + pos0;
#pragma unroll
            for (int q = 0; q < 8; ++q) *(u32x4*)(dst + 8 * q) = *(const LAS u32x4*)(VL + hd * 64 + 8 * q); }
        __syncthreads();
    }
}

DI void conv_unit(const Ctx& C, int u, const bf16* __restrict__ U, const float (&wk)[31], float bias, const float* __restrict__ lng, const float* __restrict__ lnb, bf16* __restrict__ OCAT) {
    LAS float* G = (LAS float*)C.lds;
    const int c = C.tid;
    const int row0 = 32 * u; int base, t0, tseq;
    if (row0 < NLAT) { base = row0 & ~4095; t0 = row0 & 4095; tseq = TL; } else { const int rc = row0 - NLAT; base = NLAT + (rc & ~255); t0 = rc & 255; tseq = LCX; }
    __syncthreads();
    for (int rr = C.wave; rr < 62; rr += 8) { const int tt = t0 - 15 + rr; float g[8];
#pragma unroll
        for (int e = 0; e < 8; ++e) g[e] = 0.f;
        if (tt >= 0 && tt < tseq) { const bf16* ur = U + (size_t)(base + tt) * EV_INP; float av[8], gv[8]; unpack8(*(const u32x4*)(ur + 672 + 8 * C.lane), av); unpack8(*(const u32x4*)(ur + 1184 + 8 * C.lane), gv);
#pragma unroll
            for (int e = 0; e < 8; ++e) g[e] = av[e] * sigmoidf_(gv[e]); }
        *(LAS f32x4*)(G + rr * 512 + 8 * C.lane) = (f32x4){g[0], g[1], g[2], g[3]}; *(LAS f32x4*)(G + rr * 512 + 8 * C.lane + 4) = (f32x4){g[4], g[5], g[6], g[7]}; }
    __syncthreads();
    float acc[32];
#pragma unroll
    for (int t = 0; t < 32; ++t) acc[t] = bias;
#pragma unroll
    for (int rr = 0; rr < 62; ++rr) { const float gv = G[rr * 512 + c];
#pragma unroll
        for (int t = 0; t < 32; ++t) { const int k = rr - t; if (k >= 0 && k < 31) acc[t] += gv * wk[k]; } }
    __syncthreads();
#pragma unroll
    for (int t = 0; t < 32; ++t) G[t * 512 + c] = acc[t];
    __syncthreads();
#pragma unroll
    for (int q = 0; q < 4; ++q) {
        const int t = 4 * C.wave + q, row = row0 + t;
        const f32x4 a0 = *(const LAS f32x4*)(G + t * 512 + 8 * C.lane), a1 = *(const LAS f32x4*)(G + t * 512 + 8 * C.lane + 4);
        float x[8] = {a0.x, a0.y, a0.z, a0.w, a1.x, a1.y, a1.z, a1.w}; float s = 0.f;
#pragma unroll
        for (int e = 0; e < 8; ++e) s += x[e];
        const float mu = wave_sum(s) * (1.f / 512.f); float s2 = 0.f;
#pragma unroll
        for (int e = 0; e < 8; ++e) { x[e] -= mu; s2 += x[e] * x[e]; }
        const float rstd = 1.0f / sqrtf(wave_sum(s2) * (1.f / 512.f) + EPS);
        float y[8];
#pragma unroll
        for (int e = 0; e < 8; ++e) { const float z = x[e] * rstd * lng[8 * C.lane + e] + lnb[8 * C.lane + e]; y[e] = siluf_(z); }
        *(u32x4*)(OCAT + (size_t)row * DM + 512 + 8 * C.lane) = pack8(y);
    }
    __syncthreads();
}
DI void wprep_span(const Ctx& C, int first, int stride, const float* w1, const float* w3, const float* w2, bf16* W13, bf16* W2) {
    LAS float* scr = (LAS float*)(C.lds + C.wave * 16640);
    constexpr int PER = 16 * 16, NIT = NEXP * 3 * PER;
    for (int it = first; it < NIT; it += stride) {
        const int e = it / (3 * PER), r = it % (3 * PER), which = r / PER, q = r % PER, kb = q / 16, n0 = (q % 16) * 64;
#if MOE_F8
        if (which == 0)      transpose_item64_f8(w1 + (size_t)e * DM * DM, DM, DM, (unsigned char*)W13 + (size_t)e * 2048 * DM, (n0 >> 7) * 256 + (n0 & 127), scr, kb * 64, n0, C.lane);
        else if (which == 1) transpose_item64_f8(w3 + (size_t)e * DM * DM, DM, DM, (unsigned char*)W13 + (size_t)e * 2048 * DM, (n0 >> 7) * 256 + (n0 & 127) + 128, scr, kb * 64, n0, C.lane);
        else                 transpose_item64_f8(w2 + (size_t)e * DM * DM, DM, DM, (unsigned char*)W2 + (size_t)e * DM * DM, n0, scr, kb * 64, n0, C.lane); }
#else
        if (which == 0)      transpose_item64(w1 + (size_t)e * DM * DM, DM, DM, W13 + (size_t)e * 2048 * DM, (n0 >> 7) * 256 + (n0 & 127), scr, kb * 64, n0, C.lane);
        else if (which == 1) transpose_item64(w3 + (size_t)e * DM * DM, DM, DM, W13 + (size_t)e * 2048 * DM, (n0 >> 7) * 256 + (n0 & 127) + 128, scr, kb * 64, n0, C.lane);
        else                 transpose_item64(w2 + (size_t)e * DM * DM, DM, DM, W2 + (size_t)e * DM * DM, n0, scr, kb * 64, n0, C.lane); }
#endif
}
constexpr int WPREP_PER_WAVE = (NEXP * 3 * 256 + 2047) / 2048;

DI void shifted8(const bf16* __restrict__ up, const bf16* __restrict__ uc, const bf16* __restrict__ un, bool hp, bool hn, const float (&s0)[8], const float (&s1)[8], const float (&s2)[8], int c0, float (&o)[8]) {
    const u32x4 z = {0u, 0u, 0u, 0u};
    const u32x4 vp = hp ? *(const u32x4*)(up + c0) : z, vc = *(const u32x4*)(uc + c0), vn = hn ? *(const u32x4*)(un + c0) : z;
    float p[8], c[8], n[8]; unpack8(vp, p); unpack8(vc, c); unpack8(vn, n);
#pragma unroll
    for (int e = 0; e < 8; ++e) o[e] = p[e] * s0[e] + c[e] * s1[e] + n[e] * s2[e];
}
DI void load_sw(const float* sw, int c0, float (&s0)[8], float (&s1)[8], float (&s2)[8]) {
#pragma unroll
    for (int e = 0; e < 8; ++e) { s0[e] = sw[c0 + e]; s1[e] = sw[RW_IN + c0 + e]; s2[e] = sw[2 * RW_IN + c0 + e]; }
}
DI void ph_prep(const Ctx& C, const bf16* __restrict__ U, const float* __restrict__ sw  , const float* __restrict__ kkw  , const float* __restrict__ naqg, const float* __restrict__ nakg,
                bf16* __restrict__ R, bf16* __restrict__ V, bf16* __restrict__ K, bf16* __restrict__ KK, bf16* __restrict__ L, bf16* __restrict__ QN, bf16* __restrict__ KN, bf16* __restrict__ VTN) {
    LAS bf16* VL = (LAS bf16*)C.lds;
    const int lane = C.lane, hh = lane >> 3, sub = lane & 7;
    const float C2 = 0.125f * LOG2E;
    for (int u = C.vcu; u < MT / 32; u += C.nb) {
        const int row0 = 32 * u; const bool lat = row0 < NLAT;
        const int b = lat ? (row0 >> 12) : ((row0 - NLAT) >> 8), pos0 = lat ? (row0 & 4095) : TL + ((row0 - NLAT) & 255), tseq = lat ? TL : LCX, tb = lat ? (row0 & 4095) : ((row0 - NLAT) & 255);
#define PREP_ROWVARS(i) const int pl = 4 * C.wave + (i), row = row0 + pl, t = tb + pl; const bool hp = t > 0, hn = t < tseq - 1; \
            const bf16* uc = U + (size_t)row * OD_INP; const bf16* up = uc - OD_INP; const bf16* un = uc + OD_INP
        { float s0[8], s1[8], s2[8]; load_sw(sw, 8 * lane, s0, s1, s2);
          _Pragma("unroll") for (int i = 0; i < 4; ++i) { PREP_ROWVARS(i); float o[8]; shifted8(up, uc, un, hp, hn, s0, s1, s2, 8 * lane, o); *(u32x4*)(R + (size_t)row * 512 + 8 * lane) = pack8(o); } }
        { float s0[8], s1[8], s2[8]; load_sw(sw, 1024 + 8 * lane, s0, s1, s2);
          _Pragma("unroll") for (int i = 0; i < 4; ++i) { PREP_ROWVARS(i); float o[8]; shifted8(up, uc, un, hp, hn, s0, s1, s2, 1024 + 8 * lane, o); *(u32x4*)(V + (size_t)row * 512 + 8 * lane) = pack8(o); } }
        { float s0[8], s1[8], s2[8]; load_sw(sw, 512 + 8 * lane, s0, s1, s2); float kw[8];
#pragma unroll
          for (int e = 0; e < 8; ++e) kw[e] = kkw[8 * lane + e];
          _Pragma("unroll") for (int i = 0; i < 4; ++i) { PREP_ROWVARS(i); float o[8]; shifted8(up, uc, un, hp, hn, s0, s1, s2, 512 + 8 * lane, o); *(u32x4*)(K + (size_t)row * 512 + 8 * lane) = pack8(o);
              float kk[8]; float ss = 0.f;
#pragma unroll
              for (int e = 0; e < 8; ++e) { kk[e] = o[e] * kw[e]; ss += kk[e] * kk[e]; }
              ss = sum8(ss); const float rn = 1.0f / sqrtf(ss + 1e-12f);
#pragma unroll
              for (int e = 0; e < 8; ++e) kk[e] *= rn;
              *(u32x4*)(KK + (size_t)row * 512 + 8 * lane) = pack8(kk); } }
        if (lane < 48) { float s0[8], s1[8], s2[8]; load_sw(sw, 1536 + 8 * lane, s0, s1, s2);
          _Pragma("unroll") for (int i = 0; i < 4; ++i) { PREP_ROWVARS(i); float o[8]; shifted8(up, uc, un, hp, hn, s0, s1, s2, 1536 + 8 * lane, o);
              if (lane < 16) {
#pragma unroll
                  for (int e = 0; e < 8; ++e) { const float ex = __expf(2.f * o[e]); o[e] = 1.f - 2.f * __builtin_amdgcn_rcpf(ex + 1.f); }
              } else if (lane >= 32) {
#pragma unroll
                  for (int e = 0; e < 8; ++e) o[e] = sigmoidf_(o[e]);
              }
              *(u32x4*)(L + (size_t)row * 384 + 8 * lane) = pack8(o); } }
        { float gq[8], gk[8];
#pragma unroll
          for (int e = 0; e < 8; ++e) { gq[e] = naqg[8 * sub + e] * C2; gk[e] = nakg[8 * sub + e]; }
          _Pragma("unroll") for (int i = 0; i < 4; ++i) { const int pl = 4 * C.wave + i, row = row0 + pl, pos = pos0 + pl; const bf16* uc = U + (size_t)row * OD_INP;
            { float x[8]; unpack8(*(const u32x4*)(uc + RW_IN + 8 * lane), x); float ss = 0.f;
#pragma unroll
                for (int e = 0; e < 8; ++e) ss += x[e] * x[e];
                ss = sum8(ss); const float rn = 1.0f / sqrtf(ss * (1.f / 64.f) + EPS);
#pragma unroll
                for (int e = 0; e < 8; ++e) x[e] = x[e] * rn * gq[e];
                *(u32x4*)(QN + ((size_t)(b * 8 + hh) * KPOS + pos) * 64 + 8 * sub) = pack8(x); }
            { float x[8]; unpack8(*(const u32x4*)(uc + RW_IN + 512 + 8 * lane), x); float ss = 0.f;
#pragma unroll
                for (int e = 0; e < 8; ++e) ss += x[e] * x[e];
                ss = sum8(ss); const float rn = 1.0f / sqrtf(ss * (1.f / 64.f) + EPS);
#pragma unroll
                for (int e = 0; e < 8; ++e) x[e] = x[e] * rn * gk[e];
                *(u32x4*)(KN + ((size_t)(b * 8 + hh) * KPOS + pos) * 64 + 8 * sub) = pack8(x); }
            { const u32x4 vv = *(const u32x4*)(uc + RW_IN + 1024 + 8 * lane); const unsigned w4[4] = {vv.x, vv.y, vv.z, vv.w};
#pragma unroll
                for (int e = 0; e < 8; ++e) { const int dv = 8 * sub + e; VL[(hh * 64 + dv) * 32 + pl] = (bf16)((e & 1) ? (w4[e >> 1] >> 16) : (w4[e >> 1] & 0xffffu)); } } } }
#undef PREP_ROWVARS
        __syncthreads();
        { const int hd = C.tid; bf16* dst = VTN + ((size_t)(b * 8 + (hd >> 6)) * 64 + (hd & 63)) * KPOS + pos0;
#pragma unroll
            for (int q = 0; q < 4; ++q) *(u32x4*)(dst + 8 * q) = *(const LAS u32x4*)(VL + hd * 32 + 8 * q); }
        __syncthreads();
    }
}

DI int scan_row(int s, int d, int b) { if (s < LCX) return NLAT + b * LCX + (d ? (LCX - 1 - s) : s); const int t = s - LCX; return b * TL + (d ? (TL - 1 - t) : t); }


constexpr int CCH = 16, NCHK = KPOS / CCH, NPROB = NB * 8 * 2 * NCHK, IMG_ELEMS = 3 * 32 * 16;
template <int N> struct ICk { static constexpr int value = N; };
DI int crow_(int reg, int h) { return (reg & 3) + 8 * (reg >> 2) + 4 * h; }
DI bf16x8 pack_lo8(const f32x16& x) {
    u32x4 p; p.x = pk2(x[0], x[1]); p.y = pk2(x[2], x[3]); p.z = pk2(x[4], x[5]); p.w = pk2(x[6], x[7]); return __builtin_bit_cast(bf16x8, p); }
DI bf16x8 pack_hi8(const f32x16& x) { u32x4 p; p.x = pk2(x[8], x[9]); p.y = pk2(x[10], x[11]); p.z = pk2(x[12], x[13]); p.w = pk2(x[14], x[15]); return __builtin_bit_cast(bf16x8, p); }
DI int perm16(int k) { return (k & ~15) | swap23(k & 15); }

DI void ph_wkv_pre(const Ctx& C, const bf16* __restrict__ R, const bf16* __restrict__ K, const bf16* __restrict__ KK, const unsigned short* __restrict__ LW, const bf16* __restrict__ AR_, const float* __restrict__ ka, bf16* __restrict__ IMG) {
    LAS unsigned char* wl = C.lds + C.wave * 13312;
    LAS bf16* ARl = (LAS bf16*)wl; LAS bf16* BKl = (LAS bf16*)(wl + 4608); LAS float* Ll = (LAS float*)(wl + 9216); LAS bf16* OUT = (LAS bf16*)(wl + 10240);
    const int lane = C.lane, r = lane & 31, h = lane >> 5;
    const int gw = C.vcu * 8 + C.wave, ngw = C.nb * 8;
    for (int p = gw; p < NPROB; p += ngw) {
        const int j = p % NCHK, rest = p / NCHK, d = rest & 1, hh = (rest >> 1) & 7, b = rest >> 4;
        const unsigned short* Wd = LW + (size_t)d * MT * 512; const bf16* Ad = AR_ + (size_t)d * MT * 512;
        const float kav = ka[hh * 64 + lane];
        const int row0 = scan_row(j * CCH, d, b), sg = d ? -1 : 1;
        float lw[16]; bf16 rr[16], kx[16], kkx[16], ax[16];
#pragma unroll
        for (int t = 0; t < 16; ++t) { const size_t off = (size_t)(row0 + sg * t) * 512 + hh * 64 + lane; lw[t] = h2f(Wd[off]); rr[t] = R[off]; kx[t] = K[off]; kkx[t] = KK[off]; ax[t] = Ad[off]; }
        float cum = 0.f, e0 = 1.f;
#pragma unroll
        for (int t = 0; t < 16; ++t) {
            cum += lw[t]; const float e1 = __expf(cum), ei = __builtin_amdgcn_rcpf(e1);
            const float kkv = bf2f(kkx[t]), av = bf2f(ax[t]), keff = bf2f(kx[t]) * (1.f + (av - 1.f) * kav);
            ARl[t * 72 + lane] = f2bf(-kkv * e0); ARl[(16 + t) * 72 + lane] = f2bf(bf2f(rr[t]) * e1);
            BKl[t * 72 + lane] = f2bf(kkv * av * ei); BKl[(16 + t) * 72 + lane] = f2bf(keff * ei);
            e0 = e1;
        }
        asm volatile("s_waitcnt lgkmcnt(0)" ::: "memory");
        f32x16 g;
#pragma unroll
        for (int i = 0; i < 16; ++i) g[i] = 0.f;
#pragma unroll
        for (int q = 0; q < 4; ++q) g = MFMA32(*(const LAS bf16x8*)(ARl + r * 72 + 16 * q + 8 * h), *(const LAS bf16x8*)(BKl + r * 72 + 16 * q + 8 * h), g);
        const int sI = r & 15; const bool isk = r >= 16;
#pragma unroll
        for (int i = 0; i < 16; ++i) {
            const int row = crow_(i, h), t = row & 15; const bool keep = (i < 8) ? (sI < t) : (sI <= t); const float val = keep ? g[i] : 0.f;
            if (i < 8) { if (!isk) { Ll[t * 16 + sI] = val; OUT[512 + row * 16 + perm16(sI)] = 0; } else OUT[row * 16 + sI] = f2bf(val); }
            else       { if (!isk) OUT[512 + row * 16 + perm16(sI)] = f2bf(val); else OUT[row * 16 + sI] = f2bf(val); }
        }
        asm volatile("s_waitcnt lgkmcnt(0)" ::: "memory");
        { const int c = lane & 15; float Pr[16];
            Pr[0] = (c == 0) ? 1.f : 0.f;
#pragma unroll
            for (int t = 1; t < 16; ++t) { const float lrow = Ll[t * 16 + c]; float acc = (c == t) ? 1.f : 0.f;
#pragma unroll
                for (int u = 0; u < t; ++u) acc += rdlane(lrow, u) * Pr[u];
                Pr[t] = acc; }
            if (lane < 16) {
#pragma unroll
                for (int t = 0; t < 16; ++t) { OUT[1024 + t * 16 + perm16(c)] = f2bf(Pr[t]); OUT[1024 + (16 + t) * 16 + c] = 0; } } }
        asm volatile("s_waitcnt lgkmcnt(0)" ::: "memory");
        { bf16* dst = IMG + (size_t)p * IMG_ELEMS;
#pragma unroll
            for (int q = 0; q < 3; ++q) *(u32x4*)(dst + (q * 64 + lane) * 8) = *(const LAS u32x4*)(OUT + (q * 64 + lane) * 8); }
        asm volatile("s_waitcnt lgkmcnt(0)" ::: "memory");
    }
}

DI void ph_wkv_chunk(const Ctx& C, const bf16* R, const bf16* V, const bf16* K, const bf16* KK, const unsigned short* LW, const bf16* AR_, const float* ka, const bf16* IMG, bf16* YS) {
    constexpr int S_AR = 0, S_BKT = 4608, S_VT = 9728, S_VT2 = 11264, S_GC = 12800, S_MM = 13056, S_MRB = 14592, S_PP = 16128, SLOT = 17664, CUMO = 2 * SLOT, YSTO = CUMO + 8192, DEPTH = 4;
    const int lane = C.lane, wv = C.wave, r = lane & 31, h = lane >> 5;
    const bool isE = wv == 2 || wv == 3 || wv == 6 || wv == 7, isS = wv < 2;
    const int te = (wv == 2 ? 0 : (wv == 3 ? 1 : (wv == 6 ? 2 : 3))) * 64 + lane, et = te >> 4, ekq = te & 15;
    const int vhf = te >> 7, vt = (te >> 3) & 15, viq = te & 7;
    const int hf = wv & 1;
    for (int cid0 = C.bid; cid0 < 128; cid0 += C.nb) {
        const int chain = cid0, b = chain >> 4, hh = (chain >> 1) & 7, d = chain & 1;
        const unsigned short* Wd = LW + (size_t)d * MT * 512; const bf16* Ad = AR_ + (size_t)d * MT * 512; bf16* Yd = YS + (size_t)d * MT * 512;
        const bf16* img = IMG + (size_t)(((b * 8 + hh) * 2 + d) * NCHK) * IMG_ELEMS;
        f32x16 ST[2];
#pragma unroll
        for (int i = 0; i < 16; ++i) { ST[0][i] = 0.f; ST[1][i] = 0.f; }
        const f32x4 kav = *(const f32x4*)(ka + hh * 64 + 4 * ekq);
        unsigned ring[DEPTH][16];
        __syncthreads();
        auto issue = [&](int ch, unsigned (&rg)[16]) __attribute__((always_inline)) {
            if (ch < 0 || ch >= NCHK) return;
            const int row0 = scan_row(ch * CCH, d, b), sg = d ? -1 : 1;
            if (isE) {
                const size_t off = (size_t)(row0 + sg * et) * 512 + hh * 64 + 4 * ekq;
                const u32x2 x0 = *(const u32x2*)(R + off), x1 = *(const u32x2*)(K + off), x2 = *(const u32x2*)(KK + off), x3 = *(const u32x2*)(Ad + off);
                const u32x2 x4 = *(const u32x2*)(V + (size_t)(row0 + sg * vt) * 512 + hh * 64 + 32 * vhf + 4 * viq);
                rg[0] = x0.x; rg[1] = x0.y; rg[2] = x1.x; rg[3] = x1.y; rg[4] = x2.x; rg[5] = x2.y; rg[6] = x3.x; rg[7] = x3.y; rg[8] = x4.x; rg[9] = x4.y;
                asm volatile("; wkv issue role E" ::);
            } else if (wv == 4) {
#define W5_(t) rg[(t)] = (unsigned)Wd[(size_t)(row0 + sg * (t)) * 512 + hh * 64 + lane]
                W5_(0); W5_(1); W5_(2); W5_(3); W5_(4); W5_(5); W5_(6); W5_(7); W5_(8); W5_(9); W5_(10); W5_(11); W5_(12); W5_(13); W5_(14); W5_(15);
#undef W5_
                asm volatile("; wkv issue role C" ::);
            } else if (wv == 5) {
#define W6_(q) do { const u32x4 x = *(const u32x4*)(img + (size_t)ch * IMG_ELEMS + ((q) * 64 + lane) * 8); rg[4 * (q)] = x.x; rg[4 * (q) + 1] = x.y; rg[4 * (q) + 2] = x.z; rg[4 * (q) + 3] = x.w; } while (0)
                W6_(0); W6_(1); W6_(2);
#undef W6_
                asm volatile("; wkv issue role V" ::);
            }
        };
        issue(0, ring[0]); issue(1, ring[1]); issue(2, ring[2]); issue(3, ring[3]);
#define WKV_BAR() asm volatile("s_waitcnt lgkmcnt(0)\n\ts_barrier" ::: "memory")
#define WKV_LOOP(...) for (int n0 = -2; n0 < NCHK; n0 += DEPTH) { auto iter = [&](auto kc) __attribute__((always_inline)) { constexpr int kk = decltype(kc)::value; \
            constexpr int riE = (kk + 3) % DEPTH, riW = kk % DEPTH; (void)riE; (void)riW; const int n = n0 + kk; (void)n; __VA_ARGS__; WKV_BAR(); }; iter(ICk<0>{}); iter(ICk<1>{}); iter(ICk<2>{}); iter(ICk<3>{}); }
        if (isS) {
            WKV_LOOP({
                if (n >= 0 && n < NCHK) {
                    const LAS unsigned char* B = C.lds + (n & 1) * SLOT;
                    f32x16 T1;
                    _Pragma("unroll") for (int i = 0; i < 16; ++i) T1[i] = 0.f;
                    _Pragma("unroll") for (int tau = 0; tau < 2; ++tau) {
                        T1 = MFMA32(*(const LAS bf16x8*)(B + S_AR + r * 144 + (32 * tau + 8 * h) * 2), pack_lo8(ST[tau]), T1);
                        T1 = MFMA32(*(const LAS bf16x8*)(B + S_AR + r * 144 + (32 * tau + 16 + 8 * h) * 2), pack_hi8(ST[tau]), T1);
                    }
                    const bf16x8 vtf = *(const LAS bf16x8*)(B + (hf ? S_VT2 : S_VT) + r * 48 + 16 * h);
                    T1 = MFMA32(*(const LAS bf16x8*)(B + S_MM + r * 48 + 16 * h), vtf, T1);
                    f32x16 ET;
                    _Pragma("unroll") for (int i = 0; i < 16; ++i) ET[i] = 0.f;
                    ET = MFMA32(*(const LAS bf16x8*)(B + S_PP + r * 48 + 16 * h), pack_lo8(T1), ET);
                    const bf16x8 ef = pack_lo8(ET);
                    T1 = MFMA32(*(const LAS bf16x8*)(B + S_MRB + r * 48 + 16 * h), ef, T1);
                    _Pragma("unroll") for (int tau = 0; tau < 2; ++tau) {
                        ST[tau] = MFMA32(*(const LAS bf16x8*)(B + S_BKT + (32 * tau + r) * 80 + 16 * h), ef, ST[tau]);
                        ST[tau] = MFMA32(*(const LAS bf16x8*)(B + S_BKT + (32 * tau + r) * 80 + 32 + 16 * h), vtf, ST[tau]);
                        _Pragma("unroll") for (int g4 = 0; g4 < 4; ++g4) { const f32x4 gc = *(const LAS f32x4*)(B + S_GC + (32 * tau + 8 * g4 + 4 * h) * 4);
                            ST[tau][4 * g4] *= gc.x; ST[tau][4 * g4 + 1] *= gc.y; ST[tau][4 * g4 + 2] *= gc.z; ST[tau][4 * g4 + 3] *= gc.w; }
                    }
                    LAS float* ys = (LAS float*)(C.lds + YSTO) + ((n & 1) * 2 + hf) * 512;
                    _Pragma("unroll") for (int q = 0; q < 8; ++q) ys[(8 * (q >> 2) + 4 * h + (q & 3)) * 32 + r] = T1[8 + q];
                }
            });
        } else if (isE) {
            WKV_LOOP({
                const int ch = n + 1;
                if (ch >= 0) {
                    if (ch < NCHK) {
                        LAS unsigned char* B = C.lds + (ch & 1) * SLOT; const LAS float* ec = (const LAS float*)(C.lds + CUMO) + (ch & 1) * 1024;
                        const f32x4 e1 = *(const LAS f32x4*)(ec + et * 64 + 4 * ekq);
                        f32x4 e0 = {1.f, 1.f, 1.f, 1.f}; if (et > 0) e0 = *(const LAS f32x4*)(ec + (et - 1) * 64 + 4 * ekq);
                        const float rv[4] = {bflo(ring[riE][0]), bfhi(ring[riE][0]), bflo(ring[riE][1]), bfhi(ring[riE][1])}; const float kv[4] = {bflo(ring[riE][2]), bfhi(ring[riE][2]), bflo(ring[riE][3]), bfhi(ring[riE][3])};
                        const float kkv[4] = {bflo(ring[riE][4]), bfhi(ring[riE][4]), bflo(ring[riE][5]), bfhi(ring[riE][5])}; const float av[4] = {bflo(ring[riE][6]), bfhi(ring[riE][6]), bflo(ring[riE][7]), bfhi(ring[riE][7])};
                        float ah[4]; float rh[4]; float bc[4]; float kc4[4];
                        _Pragma("unroll") for (int e = 0; e < 4; ++e) { const float ei = __builtin_amdgcn_rcpf(e1[e]);
                            ah[e] = -kkv[e] * e0[e]; rh[e] = rv[e] * e1[e]; bc[e] = kkv[e] * av[e] * ei; kc4[e] = kv[e] * (1.f + (av[e] - 1.f) * kav[e]) * ei; }
                        const int pk = perm16(4 * ekq);
                        *(LAS u32x2*)((LAS bf16*)(B + S_AR) + et * 72 + pk) = (u32x2){pk2(ah[0], ah[1]), pk2(ah[2], ah[3])};
                        *(LAS u32x2*)((LAS bf16*)(B + S_AR) + (16 + et) * 72 + pk) = (u32x2){pk2(rh[0], rh[1]), pk2(rh[2], rh[3])};
                        const int pt = perm16(et);
                        _Pragma("unroll") for (int e = 0; e < 4; ++e) { ((LAS bf16*)(B + S_BKT))[(4 * ekq + e) * 40 + pt] = f2bf(bc[e]); ((LAS bf16*)(B + S_BKT))[(4 * ekq + e) * 40 + 16 + et] = f2bf(kc4[e]); }
                        if (et == 15) *(LAS f32x4*)((LAS float*)(B + S_GC) + 4 * ekq) = e1;
                        LAS bf16* vtp = (LAS bf16*)(B + (vhf ? S_VT2 : S_VT)) + (4 * viq) * 24 + vt;
                        vtp[0] = (bf16)(ring[riE][8] & 0xffffu); vtp[24] = (bf16)(ring[riE][8] >> 16); vtp[48] = (bf16)(ring[riE][9] & 0xffffu); vtp[72] = (bf16)(ring[riE][9] >> 16);
                    }
                    issue(ch + DEPTH, ring[riE]);
                }
            });
        } else if (wv == 4) {
            WKV_LOOP({
                const int ch = n + 2;
                if (ch < NCHK) { LAS float* ec = (LAS float*)(C.lds + CUMO) + (ch & 1) * 1024; float c = 0.f;
#define C5_(t) do { c += h2f((unsigned short)ring[riW][(t)]); ec[(t) * 64 + lane] = __expf(c); } while (0)
                    C5_(0); C5_(1); C5_(2); C5_(3); C5_(4); C5_(5); C5_(6); C5_(7); C5_(8); C5_(9); C5_(10); C5_(11); C5_(12); C5_(13); C5_(14); C5_(15);
                }
                issue(ch + DEPTH, ring[riW]);
            });
        } else {
            WKV_LOOP({
                { const int chy = n - 1;
                  if (chy >= 0 && chy < NCHK) { const int yh = lane >> 5, yt = (lane & 31) >> 1, yi = 16 * (lane & 1);
                    const LAS float* ys = (const LAS float*)(C.lds + YSTO) + ((chy & 1) * 2 + yh) * 512 + yt * 32 + yi;
                    bf16* dst = Yd + (size_t)(scan_row(chy * CCH, d, b) + (d ? -1 : 1) * yt) * 512 + hh * 64 + 32 * yh + yi;
                    _Pragma("unroll") for (int q = 0; q < 2; ++q) { const f32x4 a0 = *(const LAS f32x4*)(ys + 8 * q); const f32x4 a1 = *(const LAS f32x4*)(ys + 8 * q + 4);
                        *(u32x4*)(dst + 8 * q) = (u32x4){pk2(a0.x, a0.y), pk2(a0.z, a0.w), pk2(a1.x, a1.y), pk2(a1.z, a1.w)}; } } }
                const int ch = n + 1;
                if (ch >= 0) {
                    if (ch < NCHK) { LAS unsigned char* B = C.lds + (ch & 1) * SLOT;
                        const int irow = lane >> 1; const int ihv = lane & 1;
                        *(LAS u32x4*)(B + S_MM + irow * 48 + ihv * 16) = (u32x4){ring[riE][0], ring[riE][1], ring[riE][2], ring[riE][3]};
                        *(LAS u32x4*)(B + S_MRB + irow * 48 + ihv * 16) = (u32x4){ring[riE][4], ring[riE][5], ring[riE][6], ring[riE][7]};
                        *(LAS u32x4*)(B + S_PP + irow * 48 + ihv * 16) = (u32x4){ring[riE][8], ring[riE][9], ring[riE][10], ring[riE][11]};
                    }
                    issue(ch + DEPTH, ring[riE]);
                }
            });
        }
#undef C5_
#undef WKV_LOOP
#undef WKV_BAR
    }
}

DI void ph_post(const Ctx& C, const bf16* __restrict__ YS, const bf16* __restrict__ R, const bf16* __restrict__ V, const bf16* __restrict__ K, const bf16* __restrict__ A2, const float* __restrict__ ka, const bf16* __restrict__ G, const float* __restrict__ rk, const float* __restrict__ gng, const float* __restrict__ gnb, bf16* __restrict__ OCAT, bool last) {
    const int gw = C.bid * 8 + C.wave, ngw = C.nb * 8, lane = C.lane, nrows = last ? NLAT : MT;
#pragma unroll 2
    for (int row = gw; row < nrows; row += ngw) {
        const size_t o = (size_t)row * 512 + 8 * lane;
        float y[8], y1[8]; unpack8(*(const u32x4*)(YS + o), y); unpack8(*(const u32x4*)(YS + (size_t)MT * 512 + o), y1);
#pragma unroll
        for (int e = 0; e < 8; ++e) y[e] += y1[e];
        float r[8], v[8], kx[8], a0[8], a1[8], g[8];
        unpack8(*(const u32x4*)(R + o), r); unpack8(*(const u32x4*)(V + o), v); unpack8(*(const u32x4*)(K + o), kx); unpack8(*(const u32x4*)(A2 + o), a0); unpack8(*(const u32x4*)(A2 + (size_t)MT * 512 + o), a1); unpack8(*(const u32x4*)(G + o), g);
        float bsum = 0.f;
#pragma unroll
        for (int e = 0; e < 8; ++e) { const float kae = ka[8 * lane + e]; bsum += r[e] * (kx[e] * (1.f + (a0[e] - 1.f) * kae) + kx[e] * (1.f + (a1[e] - 1.f) * kae)) * rk[8 * lane + e]; }
        bsum = sum8(bsum);
        float s = 0.f;
#pragma unroll
        for (int e = 0; e < 8; ++e) { y[e] += bsum * v[e]; s += y[e]; }
        const float mu = sum8(s) * (1.f / 64.f); float s2 = 0.f;
#pragma unroll
        for (int e = 0; e < 8; ++e) { y[e] -= mu; s2 += y[e] * y[e]; }
        const float rstd = 1.0f / sqrtf(sum8(s2) * (1.f / 64.f) + GN_EPS);
        float out[8];
#pragma unroll
        for (int e = 0; e < 8; ++e) out[e] = (y[e] * rstd * gng[8 * lane + e] + gnb[8 * lane + e]) * g[e];
        *(u32x4*)(OCAT + (size_t)row * DM + 8 * lane) = pack8(out);
    }
}

DI void ph_topk2(const Ctx& C, const float* AFFT, const float* AFFC, int* ROWS, float* GATE, int* SLOT, bool last) {
    LAS unsigned* wcnt = (LAS unsigned*)C.lds;
    LAS unsigned* cnt = wcnt + 16;
    const int tid = C.tid, nprob = last ? 128 : 256;
    for (int p = C.bid; p < nprob; p += C.nb) {
        const bool isctx = p >= 128; const int be = p & 127, b = be >> 4, e = be & 15;
        const int n = isctx ? LCX : TL, cap = isctx ? CAPC : CAPL;
        const float* src = isctx ? AFFC + (size_t)be * LCX : AFFT + (size_t)be * TL;
        unsigned v[8]; const int per = isctx ? 1 : 8, t0 = tid * per;
#pragma unroll
        for (int q = 0; q < 8; ++q) v[q] = 0u;
        if (!isctx) { const u32x4 a0 = *(const u32x4*)(src + t0), a1 = *(const u32x4*)(src + t0 + 4); v[0] = a0.x; v[1] = a0.y; v[2] = a0.z; v[3] = a0.w; v[4] = a1.x; v[5] = a1.y; v[6] = a1.z; v[7] = a1.w; }
        else if (tid < LCX) v[0] = __builtin_bit_cast(unsigned, src[tid]);
        __syncthreads();
        unsigned T = 0u;
        for (int bit = 30; bit >= 0; --bit) {
            const unsigned cand = T | (1u << bit); unsigned c = 0u;
#pragma unroll
            for (int q = 0; q < 8; ++q) c += (unsigned)__builtin_popcountll(__builtin_amdgcn_ballot_w64(v[q] >= cand));
            LAS unsigned* wc = wcnt + (bit & 1) * 8;
            if (C.lane == 0) wc[C.wave] = c;
            __syncthreads();
            const unsigned tot = wc[0] + wc[1] + wc[2] + wc[3] + wc[4] + wc[5] + wc[6] + wc[7];
            if (tot >= (unsigned)cap) T = cand;
        }
        unsigned myc = 0u;
#pragma unroll
        for (int q = 0; q < 8; ++q) myc += (v[q] > T ? 0x10000u : 0u) + ((v[q] == T && (isctx ? (q == 0 && tid < LCX) : true)) ? 1u : 0u);
        __syncthreads();
        cnt[tid] = myc;
        __syncthreads();
        for (int off = 1; off < 512; off <<= 1) { const unsigned add = tid >= off ? cnt[tid - off] : 0u; __syncthreads(); cnt[tid] += add; __syncthreads(); }
        const unsigned total = cnt[511], keq = (unsigned)cap - (total >> 16);
        unsigned before = cnt[tid] - myc;
        for (int q = 0; q < per; ++q) { const int t = t0 + q; if (t >= n) break; const unsigned x = v[q]; const unsigned gtb = before >> 16, eqb = before & 0xFFFFu;
            const bool sel = x > T || (x == T && eqb < keq);
            if (sel) { const int jx = (int)(gtb + (eqb < keq ? eqb : keq));
                const int slot = isctx ? NB * CAPL + b * CAPC + jx : b * CAPL + jx, row = isctx ? NLAT + b * LCX + t : b * TL + t;
                ROWS[e * ESLOTS + slot] = row; GATE[e * ESLOTS + slot] = __builtin_bit_cast(float, x); SLOT[(size_t)row * 16 + e] = slot; }
            before += (x > T ? 0x10000u : 0u) + (x == T ? 1u : 0u); }
        __syncthreads();
    }
}


DI void ph_combine(const Ctx& C, float* __restrict__ xlat, float* __restrict__ xctx, const float* __restrict__ modg2  , const int* __restrict__ SLOT, const bf16* __restrict__ Y2, bool last,
                   const float* __restrict__ ngain  , const float* __restrict__ nmod  , bf16* __restrict__ H) {
    const int gw = C.bid * 8 + C.wave, ngw = C.nb * 8, lane = C.lane, nrows = last ? NLAT : MT;
    int sv_next = (gw < nrows) ? SLOT[(size_t)gw * 16 + (lane & 15)] : -1;
    for (int row = gw; row < nrows; row += ngw) {
        float* xr = row < NLAT ? xlat + (size_t)row * DM : xctx + (size_t)(row - NLAT) * DM;
        const int mi = row < NLAT ? (row >> 12) : 8;
        const int sv = sv_next;
        if (row + ngw < nrows) sv_next = SLOT[(size_t)(row + ngw) * 16 + (lane & 15)];
        f32x4 xv[4], gv[4];
#pragma unroll
        for (int j = 0; j < 4; ++j) { const int c = 256 * j + 4 * lane; gv[j] = *(const f32x4*)(modg2 + mi * 6144 + c); xv[j] = *(const f32x4*)(xr + c); }
        f32x4 acc[4];
#pragma unroll
        for (int j = 0; j < 4; ++j) acc[j] = (f32x4){0.f, 0.f, 0.f, 0.f};
        unsigned mask = (unsigned)__builtin_amdgcn_ballot_w64(sv >= 0) & 0xffffu;
        while (mask) {
            const bf16* yp[4]; float m[4];
            { const int e0 = __builtin_ctz(mask); mask &= mask - 1u; const int s0 = __builtin_amdgcn_readlane(sv, e0); yp[0] = Y2 + ((size_t)e0 * ESLOTS + s0) * DM + 4 * lane; m[0] = 1.f; }
#pragma unroll
            for (int k = 1; k < 4; ++k) {
                if (mask) { const int ek = __builtin_ctz(mask); mask &= mask - 1u; const int sk = __builtin_amdgcn_readlane(sv, ek); yp[k] = Y2 + ((size_t)ek * ESLOTS + sk) * DM + 4 * lane; m[k] = 1.f; }
                else { yp[k] = yp[0]; m[k] = 0.f; } }
            u32x2 w[4][4];
#pragma unroll
            for (int k = 0; k < 4; ++k)
#pragma unroll
                for (int j = 0; j < 4; ++j) w[k][j] = *(const u32x2*)(yp[k] + 256 * j);
#pragma unroll
            for (int k = 0; k < 4; ++k)
#pragma unroll
                for (int j = 0; j < 4; ++j) acc[j] += m[k] * (f32x4){bflo(w[k][j].x), bfhi(w[k][j].x), bflo(w[k][j].y), bfhi(w[k][j].y)};
        }
#pragma unroll
        for (int j = 0; j < 4; ++j) { const int c = 256 * j + 4 * lane; f32x4 x = xv[j]; x += gv[j] * acc[j]; *(f32x4*)(xr + c) = x; acc[j] = x; }
        if (ngain) {
            float ss = 0.f;
#pragma unroll
            for (int j = 0; j < 4; ++j) ss += acc[j].x * acc[j].x + acc[j].y * acc[j].y + acc[j].z * acc[j].z + acc[j].w * acc[j].w;
            const float rs = 1.0f / sqrtf(wave_sum(ss) * (1.f / 1024.f) + EPS);
            const float* mp = nmod + mi * 6144;
#pragma unroll
            for (int j = 0; j < 4; ++j) { const int c = 256 * j + 4 * lane;
                const f32x4 g = *(const f32x4*)(ngain + c), sc = *(const f32x4*)(mp + 1024 + c), sh = *(const f32x4*)(mp + c);
                const f32x4 hv = (acc[j] * rs) * g * (sc + 1.0f) + sh;
                *(u32x2*)(H + (size_t)row * DM + c) = (u32x2){pk2(hv.x, hv.y), pk2(hv.z, hv.w)}; }
        }
    }
}

template <int N> struct IC { static constexpr int value = N; };
DI const float* in_ptr(const unsigned char* ws, int k) { const unsigned long long v = ((const unsigned long long*)(ws + 128 * 1024))[k];
    const unsigned lo = __builtin_amdgcn_readfirstlane((unsigned)v), hi = __builtin_amdgcn_readfirstlane((unsigned)(v >> 32));
    return (const float*)(__attribute__((address_space(1))) const float*)(((unsigned long long)hi << 32) | lo); }
template <class T> DI T* launder_ptr(T* p) { unsigned long long v = (unsigned long long)p; unsigned lo = (unsigned)v, hi = (unsigned)(v >> 32); asm volatile("" : "+v"(lo), "+v"(hi));
    lo = __builtin_amdgcn_readfirstlane(lo); hi = __builtin_amdgcn_readfirstlane(hi); return (T*)(__attribute__((address_space(1))) T*)(((unsigned long long)hi << 32) | lo); }
constexpr int N_PHASES = 1 + 23 + 22;
constexpr size_t WS_PTRS = 128 * 1024;
#define P_XC    ((float*)(ws + WS_XC))
#define P_MOD   ((const float*)(ws + WS_MOD))
#define P_HB    ((bf16*)(ws + WS_HB))
#define P_OCAT  ((bf16*)(ws + WS_OCAT))
#define P_AR    (ws + WS_ARENA)
#define P_ROWS  ((int*)(ws + WS_ROWS))
#define P_GATE  ((float*)(ws + WS_GATE))
#define P_SLOT  ((int*)(ws + WS_SLOT))
#define P_AFFT  ((float*)(ws + WS_AFFT))
#define P_AFFC  ((float*)(ws + WS_AFFC))
#define P_W13   ((bf16*)(ws + WS_W13))
#define P_W2    ((bf16*)(ws + WS_W2))
#define P_U     ((bf16*)(P_AR + A_U))
#define P_QPRE  ((float*)(P_AR + A_QPRE))
#define P_KVPRE ((float*)(P_AR + A_KVPRE))
#define P_QB    ((bf16*)(P_AR + A_QB))
#define P_KB    ((bf16*)(P_AR + A_KB))
#define P_VT    ((bf16*)(P_AR + A_VT))
#define P_W     ((unsigned short*)(P_AR + A_W))
#define P_KEFF  ((bf16*)(P_AR + A_KEFF))
#define P_R     ((bf16*)(P_AR + A_R))
#define P_V     ((bf16*)(P_AR + A_V))
#define P_KK    ((bf16*)(P_AR + A_KK))
#define P_G     ((bf16*)(P_AR + A_G))
#define P_K     ((bf16*)(P_AR + A_K))
#define P_L     ((bf16*)(P_AR + A_L))
#define P_QN    ((bf16*)(P_AR + A_QN))
#define P_KN    ((bf16*)(P_AR + A_KN))
#define P_VTN   ((bf16*)(P_AR + A_VTN))
#define P_YS    ((bf16*)(P_AR + A_YS))
#define P_IMG   ((bf16*)(P_AR + A_IMG))
#define P_HID   ((bf16*)(P_AR + A_HID))
#define P_Y2    ((bf16*)(P_AR + A_Y2))
#define MODL(i) (P_MOD + (size_t)(i) * 9 * 6144)
#if MOE_F8
#define MOE1_PHASE(NMT) do { pg8::Gemm g{P_HB, P_W13, DM / 2, DM / 2, P_ROWS, SCALE_W, SCALE_ONE}; pg8::OrderMoE S{(NMT), 8, 17, C.nb, C.vcu}; pg8::EpiAdapt<EpiGlu8> E{EpiGlu8{(unsigned char*)P_HID}}; \
        pg8::gemm_phase<pg8::EpiAdapt<EpiGlu8>, pg8::OrderMoE, true>(C.lds, g, S, E, C.tid); } while (0)
#define MOE2_PHASE(NMT) do { pg8::Gemm g{P_HID, P_W2, DM / 2, DM / 2, nullptr, SCALE_W, SCALE_HID}; pg8::OrderMoE S{(NMT), 4, 17, C.nb, C.vcu}; pg8::EpiAdapt<EpiGate> E{EpiGate{P_Y2, P_GATE}}; \
        pg8::gemm_phase<pg8::EpiAdapt<EpiGate>, pg8::OrderMoE, true>(C.lds, g, S, E, C.tid); } while (0)
#else
#define MOE1_PHASE(NMT) do { pg8::Gemm g{P_HB, P_W13, DM, DM, P_ROWS}; pg8::OrderMoE S{(NMT), 8, 17, C.nb, C.vcu}; pg8::EpiAdapt<EpiGlu> E{EpiGlu{P_HID}}; pg8::gemm_phase(C.lds, g, S, E, C.tid); } while (0)
#define MOE2_PHASE(NMT) do { pg8::Gemm g{P_HID, P_W2, DM, DM, nullptr}; pg8::OrderMoE S{(NMT), 4, 17, C.nb, C.vcu}; pg8::EpiAdapt<EpiGate> E{EpiGate{P_Y2, P_GATE}}; pg8::gemm_phase(C.lds, g, S, E, C.tid); } while (0)
#endif
#define WPREP_TAIL(NUNITS, LAYER) do { __syncthreads(); const int extra_ = (NUNITS) % C.nb, j_ = C.vcu - extra_; const size_t wo_ = (size_t)(LAYER) * NEXP * DM * DM; \
        if (j_ >= 0) wprep_span(C, j_ * 8 + C.wave, (C.nb - extra_) * 8, in_ptr(ws, I_MW1) + wo_, in_ptr(ws, I_MW3) + wo_, in_ptr(ws, I_MW2) + wo_, (bf16*)(ws + WS_W13), (bf16*)(ws + WS_W2)); } while (0)
#define RELAUNDER() do { int l_ = C.lane; asm volatile("" : "+v"(l_)); C.lane = l_; C.tid = (C.wave << 6) | l_; } while (0)
__global__ void __launch_bounds__(512, 2) fwd_kernel(Args a) {
    extern __shared__ __attribute__((aligned(16))) unsigned char smem[];
    Ctx C0; C0.lds = (LAS unsigned char*)smem; C0.tid = threadIdx.x; C0.lane = C0.tid & 63; C0.wave = __builtin_amdgcn_readfirstlane(C0.tid >> 6); C0.bid = blockIdx.x; C0.nb = gridDim.x;
    C0.vcu = (C0.nb % 8 == 0) ? (C0.bid % 8) * (C0.nb / 8) + C0.bid / 8 : C0.bid;
    volatile LAS unsigned* bst = (volatile LAS unsigned*)(C0.lds + LDS_BYTES - 16);
#if MEGA
    if (C0.tid == 0) { bst[0] = 0u; bst[1] = 0u; }
    __syncthreads();
    const unsigned bar_x = xcd_barrier_post((unsigned*)(a.ws + WS_CTL) + 4096, bst, C0.tid == 0).x;
#define SEAM() do { if (ph < hi) { XcdBarrier b2_; b2_.bar = (unsigned*)(ws + WS_CTL) + 4096; b2_.x = bar_x; b2_.st = bst; xcd_barrier(b2_, C.tid == 0); } } while (0)
#else
#define SEAM() do { } while (0)
#endif
#if MEGA
    constexpr int lo = 0, hi = N_PHASES;
#else
    const int lo = a.ph_lo, hi = a.ph_hi;
#endif
    int ph = 0;
#ifndef ONLY
#define ONLY -1
#endif
#ifndef REPMASK
#define REPMASK 0
#endif
#ifndef SITE_LO
#define SITE_LO 0
#define SITE_HI 99
#endif
#define PHASE(SITE, ...) do { if ((ONLY < 0 || ONLY == (SITE)) && (SITE) >= SITE_LO && (SITE) <= SITE_HI && ph >= lo && ph < hi) { Ctx C; C.lds = C0.lds; \
        { int w_ = C0.wave; asm volatile("" : "+s"(w_)); unsigned m_ = ~0u; asm volatile("" : "+s"(m_)); int l_ = (int)__builtin_amdgcn_mbcnt_hi(m_, __builtin_amdgcn_mbcnt_lo(m_, 0u)); C.wave = w_; C.lane = l_; C.tid = (w_ << 6) | l_; } \
        { int b_ = C0.bid, n_ = C0.nb, v_ = C0.vcu; asm volatile("" : "+s"(b_), "+s"(n_), "+s"(v_)); C.bid = b_; C.nb = n_; C.vcu = v_; } \
        unsigned z_ = 0u; asm volatile("" : "+s"(z_)); unsigned char* ws = a.ws + z_; float* XL = a.out + z_; const int lq = __builtin_amdgcn_readfirstlane(lp); typedef const __attribute__((address_space(1))) float* gfp_t; const gfp_t* INT_ = (const gfp_t*)(ws + WS_PTRS); (void)INT_; (void)XL; (void)lq; \
        for (int rep_ = 0; rep_ < ((((REPMASK) >> (SITE)) & 1) ? 2 : 1); ++rep_) { __VA_ARGS__; if ((((REPMASK) >> (SITE)) & 1)) __syncthreads(); } ++ph; SEAM(); } else ++ph; } while (0)

    { const int lp = 0;
      PHASE(0, { if (C.bid == 0) { _Pragma("unroll") for (int k = 0; k < 40; ++k) if (C.tid == k) ((const float**)(ws + WS_PTRS))[k] = a.in[k]; }
                 ph_prologue(C, a); }); }

    auto layer_pair = [&](auto lpc) __attribute__((always_inline)) {
        constexpr int lp = decltype(lpc)::value;
        if constexpr (lp == 0) PHASE(1, { const int i = 2 * lq; const float* xl = (i == 0) ? in_ptr(ws, I_X) : XL; const float* xc = (i == 0) ? in_ptr(ws, I_CTX) : P_XC;
                   ph_norm<false>(C, xl, xc, in_ptr(ws, I_N1G) + i * DM, MODL(i), 0, 1024, P_HB, nullptr, nullptr, nullptr, nullptr); });
        PHASE(2, { EpiBf16 E{P_U, EV_INP}; fast_gemm(C, P_HB, DM, (const bf16*)(ws + WS_WEVIN) + (size_t)lq * EV_INP * DM, DM, MT / 256, EV_INP / 256, E); });
        PHASE(3, { EpiBf16 Eq{(bf16*)P_QPRE, 768}; fast_gemm(C, P_U, EV_INP, (const bf16*)(ws + WS_WUQ) + (size_t)lq * 768 * 384, 384, MT / 256, 3, Eq); RELAUNDER();
                   EpiBf16 Ek{(bf16*)P_KVPRE, 1024}; fast_gemm(C, P_U + 384, EV_INP, (const bf16*)(ws + WS_WUKV) + (size_t)lq * 1024 * 256, 256, MT / 256, 4, Ek, true); });
        PHASE(4, { ph_mla_fin(C, P_U, (const bf16*)P_QPRE, (const bf16*)P_KVPRE, in_ptr(ws, I_QG) + lq * 96, in_ptr(ws, I_KG) + lq * 96, (const f32x2*)(ws + WS_ROPE), P_QB, P_KB, P_VT);
                   const int extra_ = (MT / 64) % C.nb, j_ = C.vcu - extra_;
                   if (j_ >= 0) { for (int q_ = 0; q_ < CONV_PER_TAIL; ++q_) { const int cu_ = j_ + q_ * (C.nb - extra_); if (cu_ >= conv_in_fin(C.nb)) break;
                       float wk[31]; const float* dww = in_ptr(ws, I_DWW) + (size_t)lq * 31 * 512;
                       _Pragma("unroll") for (int kt = 0; kt < 31; ++kt) wk[kt] = dww[kt * 512 + C.tid];
                       conv_unit(C, cu_, P_U, wk, in_ptr(ws, I_DWB)[lq * 512 + C.tid], in_ptr(ws, I_LNG) + lq * 512, in_ptr(ws, I_LNB) + lq * 512, P_OCAT); } } });
        PHASE(5, ph_attn_mla2(C, P_QB, P_KB, P_VT, P_OCAT, false, ws, lq));
        PHASE(6, { const int i = 2 * lq; const float* xl = (i == 0) ? in_ptr(ws, I_X) : XL; const float* xc = (i == 0) ? in_ptr(ws, I_CTX) : P_XC;
                   { EpiResid E{xl, xc, XL, P_XC, MODL(i) + 2048}; fast_gemm(C, P_OCAT, DM, (const bf16*)(ws + WS_WEVOUT) + (size_t)lq * DM * DM, DM, MT / 256, 4, E); }
                   WPREP_TAIL(MT / 256 * 4, i); });
        PHASE(7, { const int i = 2 * lq; ph_norm<true>(C, XL, P_XC, in_ptr(ws, I_N2G) + i * DM, MODL(i), 3072, 4096, P_HB, in_ptr(ws, I_ROUTER) + (size_t)i * DM * 16, P_AFFT, P_AFFC, P_SLOT); });
        PHASE(8, ph_topk2(C, P_AFFT, P_AFFC, P_ROWS, P_GATE, P_SLOT, false));
        PHASE(9, { MOE1_PHASE(17); });
        PHASE(10, { MOE2_PHASE(17); });
        PHASE(11, { const int i = 2 * lq; ph_combine(C, XL, P_XC, MODL(i) + 5120, P_SLOT, P_Y2, false, in_ptr(ws, I_N1G) + (i + 1) * DM, MODL(i + 1), P_HB); });
        PHASE(13, { EpiBf16 E{P_U, OD_INP}; fast_gemm(C, P_HB, DM, (const bf16*)(ws + WS_WODIN) + (size_t)lq * OD_INP * DM, DM, MT / 256, OD_INP / 256, E); });
        PHASE(14, ph_prep(C, P_U, in_ptr(ws, I_SHIFTW) + (size_t)lq * 3 * RW_IN, in_ptr(ws, I_KKW) + lq * 512, in_ptr(ws, I_NAQG) + lq * 64, in_ptr(ws, I_NAKG) + lq * 64, P_R, P_V, P_K, P_KK, P_L, P_QN, P_KN, P_VTN));
        PHASE(15, { const bf16* WL = (const bf16*)(ws + WS_WLORA) + (size_t)lq * 655360;
                    { EpiLoraW E{P_W, in_ptr(ws, I_W0) + lq * 1024}; fast_gemm(C, P_L, 384, WL, 256, MT / 256, 4, E); } RELAUNDER();
                    { EpiLoraA E{P_KEFF, in_ptr(ws, I_A0) + lq * 1024}; fast_gemm(C, P_L, 384, WL + (size_t)1024 * 256, 256, MT / 256, 4, E, true); } RELAUNDER();
                    { EpiBf16 E{P_G, 512}; fast_gemm(C, P_L + 128, 384, WL + (size_t)2048 * 256, 256, MT / 256, 2, E); } });
        PHASE(16, ph_wkv_pre(C, P_R, P_K, P_KK, P_W, P_KEFF, in_ptr(ws, I_KA) + lq * 512, P_IMG));
        PHASE(17, { ph_wkv_chunk(C, P_R, P_V, P_K, P_KK, P_W, P_KEFF, in_ptr(ws, I_KA) + lq * 512, P_IMG, P_YS); __syncthreads();
                    ph_natten2(C, P_QN, P_KN, P_VTN, P_OCAT, in_ptr(ws, I_RPB) + (size_t)lq * 8 * 465, lq == 1, (unsigned*)(ws + WS_CTL) + 8192 + 64 * lq, ws, lq); });
        PHASE(18, ph_post(C, P_YS, P_R, P_V, P_K, P_KEFF, in_ptr(ws, I_KA) + lq * 512, P_G, in_ptr(ws, I_RK) + lq * 512, in_ptr(ws, I_GNG) + lq * 512, in_ptr(ws, I_GNB) + lq * 512, P_OCAT, lq == 1));
        PHASE(19, { const int i = 2 * lq + 1; EpiResid E{XL, P_XC, XL, P_XC, MODL(i) + 2048};
                    fast_gemm(C, P_OCAT, DM, (const bf16*)(ws + WS_WODOUT) + (size_t)lq * DM * DM, DM, (lq == 1) ? NLAT / 256 : MT / 256, 4, E);
                    WPREP_TAIL(((lq == 1) ? NLAT / 256 : MT / 256) * 4, i); });
        PHASE(20, { const int i = 2 * lq + 1; ph_norm<true>(C, XL, P_XC, in_ptr(ws, I_N2G) + i * DM, MODL(i), 3072, 4096, P_HB, in_ptr(ws, I_ROUTER) + (size_t)i * DM * 16, P_AFFT, P_AFFC, P_SLOT); });
        PHASE(21, ph_topk2(C, P_AFFT, P_AFFC, P_ROWS, P_GATE, P_SLOT, lq == 1));
        PHASE(22, { MOE1_PHASE((lq == 1) ? 16 : 17); });
        PHASE(23, { MOE2_PHASE((lq == 1) ? 16 : 17); });
        PHASE(24, { const int i = 2 * lq + 1;
                    if (lp == 0) ph_combine(C, XL, P_XC, MODL(i) + 5120, P_SLOT, P_Y2, false, in_ptr(ws, I_N1G) + (i + 1) * DM, MODL(i + 1), P_HB);
                    else ph_combine(C, XL, P_XC, MODL(i) + 5120, P_SLOT, P_Y2, true, nullptr, nullptr, nullptr); });
    };
    layer_pair(IC<0>{}); layer_pair(IC<1>{});
}

extern "C" void kernel_launch(void* const* d_in, const int* in_sizes, int n_in, void* d_out, int out_size, void* d_ws, size_t ws_size, hipStream_t stream) {
    static int grid = 0;
    if (grid == 0) {
        if (n_in != 40 || out_size != NLAT * DM || ws_size < WS_END) { fprintf(stderr, "kernel_launch: unexpected shapes (n_in %d out %d ws %zu need %zu)\n", n_in, out_size, ws_size, (size_t)WS_END); grid = -1; return; }
        int dev = 0, cus = 0, per_cu = 0;
        if (hipGetDevice(&dev) != hipSuccess || hipDeviceGetAttribute(&cus, hipDeviceAttributeMultiprocessorCount, dev) != hipSuccess) { grid = -1; return; }
        if (hipFuncSetAttribute((const void*)fwd_kernel, hipFuncAttributeMaxDynamicSharedMemorySize, LDS_BYTES) != hipSuccess) { fprintf(stderr, "kernel_launch: hipFuncSetAttribute failed\n"); grid = -1; return; }
        if (hipOccupancyMaxActiveBlocksPerMultiprocessor(&per_cu, (const void*)fwd_kernel, 512, LDS_BYTES) != hipSuccess || per_cu < 1) { fprintf(stderr, "kernel_launch: occupancy query says %d\n", per_cu); per_cu = 1; }
        (void)hipGetLastError();
        grid = cus;
    }
    if (grid < 0) return;
    (void)hipMemsetAsync((char*)d_ws + WS_CTL, 0, CTL_BYTES, stream);
    Args a{};
    for (int i = 0; i < 40; ++i) a.in[i] = (const float*)d_in[i];
    a.out = (float*)d_out; a.ws = (unsigned char*)d_ws;
#if MEGA
    a.ph_lo = 0; a.ph_hi = N_PHASES;
    hipLaunchKernelGGL(fwd_kernel, dim3(grid), dim3(512), LDS_BYTES, stream, a);
#else
    for (int p = 0; p < N_PHASES; ++p) { a.ph_lo = p; a.ph_hi = p + 1; hipLaunchKernelGGL(fwd_kernel, dim3(grid), dim3(512), LDS_BYTES, stream, a); }
#endif
}
```

```cpp
#include <hip/hip_runtime.h>
#include <cstdio>
#include <cstdint>

#ifndef MEGA
#define MEGA 1
#endif

#define LAS __attribute__((address_space(3)))
#define DI __device__ __forceinline__

typedef unsigned short bf16;
typedef short bf16x8 __attribute__((ext_vector_type(8)));
typedef float f32x4 __attribute__((ext_vector_type(4)));
typedef float f32x2 __attribute__((ext_vector_type(2)));
typedef float f32x16 __attribute__((ext_vector_type(16)));
typedef unsigned u32x4 __attribute__((ext_vector_type(4)));
typedef unsigned u32x2 __attribute__((ext_vector_type(2)));
typedef __bf16 bf16x2_t __attribute__((ext_vector_type(2)));

constexpr int DM = 1024, NB = 8, TL = 4096, LCX = 256;
constexpr int NLAT = NB * TL, NCTX = NB * LCX, MT = NLAT + NCTX;
constexpr int KPOS = TL + LCX;
constexpr float EPS = 1e-6f, GN_EPS = 64e-5f;
constexpr int EV_IN = 1696, EV_INP = 1792, OD_IN = 3456, OD_INP = 3584, RW_IN = 1920;
constexpr int NEXP = 16, CAPL = 512, CAPC = 32, ESLOTS = NB * CAPL + NB * CAPC;
constexpr float LOG2E = 1.4426950408889634f;

constexpr size_t MiB = 1ull << 20;
constexpr size_t WS_CTL = 0, CTL_BYTES = 1 * MiB;
constexpr size_t WS_MOD = 1 * MiB, WS_ROPE = 2 * MiB, WS_XC = 4 * MiB;
constexpr size_t WS_ROWS = 12 * MiB, WS_GATE = 12 * MiB + 512 * 1024, WS_SLOT = 13 * MiB, WS_AFFT = 16 * MiB, WS_AFFC = 18 * MiB;
constexpr size_t WS_WEVIN = 20 * MiB, WS_WEVOUT = 27 * MiB, WS_WUQ = 31 * MiB, WS_WUKV = 33 * MiB, WS_WODIN = 34 * MiB, WS_WODOUT = 48 * MiB, WS_WLORA = 52 * MiB;
constexpr size_t WS_W13 = 56 * MiB, WS_W2 = 120 * MiB, WS_HB = 152 * MiB, WS_OCAT = 220 * MiB, WS_ARENA = 288 * MiB;
constexpr size_t A_U = 0, A_QPRE = 119 * MiB, A_KVPRE = 221 * MiB, A_QB = 357 * MiB, A_KB = 408 * MiB, A_VT = 459 * MiB;
constexpr size_t A_W = 0, A_KEFF = 136 * MiB  , A_G = 204 * MiB, A_R = 238 * MiB, A_V = 272 * MiB, A_KK = 306 * MiB, A_K = 340 * MiB, A_L = 374 * MiB,
                 A_QN = 400 * MiB, A_KN = 434 * MiB, A_VTN = 468 * MiB, A_YS = 612 * MiB  ;
constexpr size_t A_HID = 0, A_Y2 = 136 * MiB;
constexpr size_t A_IMG = 510 * MiB;
constexpr size_t WS_END = WS_ARENA + 680 * MiB;
constexpr int LDS_BYTES = 147456;

DI unsigned pk2(float lo, float hi) { f32x2 v = {lo, hi}; bf16x2_t b = __builtin_convertvector(v, bf16x2_t); return __builtin_bit_cast(unsigned, b); }
DI float bflo(unsigned u) { return __builtin_bit_cast(float, u << 16); }
DI float bfhi(unsigned u) { return __builtin_bit_cast(float, u & 0xffff0000u); }
DI float bf2f(bf16 x) { return __builtin_bit_cast(float, ((unsigned)x) << 16); }
DI bf16 f2bf(float f) { return (bf16)(pk2(f, 0.f) & 0xffffu); }
DI void unpack8(u32x4 v, float (&f)[8]) { f[0] = bflo(v.x); f[1] = bfhi(v.x); f[2] = bflo(v.y); f[3] = bfhi(v.y); f[4] = bflo(v.z); f[5] = bfhi(v.z); f[6] = bflo(v.w); f[7] = bfhi(v.w); }
DI u32x4 pack8(const float (&f)[8]) { u32x4 r; r.x = pk2(f[0], f[1]); r.y = pk2(f[2], f[3]); r.z = pk2(f[4], f[5]); r.w = pk2(f[6], f[7]); return r; }
#define DPP_ADD(x, ctrl) ((x) + __builtin_bit_cast(float, __builtin_amdgcn_update_dpp(0, __builtin_bit_cast(int, (x)), (ctrl), 0xf, 0xf, false)))
#define DPP_MAX(x, ctrl) fmaxf((x), __builtin_bit_cast(float, __builtin_amdgcn_update_dpp(0, __builtin_bit_cast(int, (x)), (ctrl), 0xf, 0xf, false)))
DI float sum8(float x) { x = DPP_ADD(x, 0xB1); x = DPP_ADD(x, 0x4E); x = DPP_ADD(x, 0x141); return x; }
DI float sum16(float x) { x = DPP_ADD(x, 0xB1); x = DPP_ADD(x, 0x4E); x = DPP_ADD(x, 0x141); x = DPP_ADD(x, 0x140); return x; }
DI float max16(float x) { x = DPP_MAX(x, 0xB1); x = DPP_MAX(x, 0x4E); x = DPP_MAX(x, 0x141); x = DPP_MAX(x, 0x140); return x; }
DI float rdlane(float x, int l) { return __builtin_bit_cast(float, __builtin_amdgcn_readlane(__builtin_bit_cast(int, x), l)); }
DI float wave_sum(float v) { const float x = sum16(v); return (rdlane(x, 0) + rdlane(x, 16)) + (rdlane(x, 32) + rdlane(x, 48)); }
DI float xor32(float v, int lane) { return __builtin_bit_cast(float, __builtin_amdgcn_ds_bpermute((lane ^ 32) << 2, __builtin_bit_cast(int, v))); }
typedef int v8i_t __attribute__((ext_vector_type(8)));
typedef int i32x4_t __attribute__((ext_vector_type(4)));
DI unsigned pk4_fp8(float a, float b, float c, float d) {
    a = __builtin_amdgcn_fmed3f(a, -448.f, 448.f); b = __builtin_amdgcn_fmed3f(b, -448.f, 448.f); c = __builtin_amdgcn_fmed3f(c, -448.f, 448.f); d = __builtin_amdgcn_fmed3f(d, -448.f, 448.f);
    int p = __builtin_amdgcn_cvt_pk_fp8_f32(a, b, 0, false); p = __builtin_amdgcn_cvt_pk_fp8_f32(c, d, p, true); return (unsigned)p; }
#ifndef MOE_F8
#define MOE_F8 1
#endif
constexpr int SCALE_ONE = 0x7f7f7f7f, SCALE_W = 0x79797979  , SCALE_HID = 0x7c7c7c7c  ;
DI float sigmoidf_(float x) { return __builtin_amdgcn_rcpf(1.f + __expf(-x)); }
DI float siluf_(float x) { return x * __builtin_amdgcn_rcpf(1.f + __expf(-x)); }
#define MFMA32(a, b, c) __builtin_amdgcn_mfma_f32_32x32x16_bf16((a), (b), (c), 0, 0, 0)

#define XB_TMO      128
#define XB_XCNT(j)  (256  + 64 * (j))
#define XB_XSUB(j)  (1280 + 64 * (j))
#define XB_XGEN(j)  (2304 + 64 * (j))
#define XB_TOP      3328
#define XB_TOPGEN   3392
#define XCD_BAR_WORDS 3456
#define XB_SPIN_CAP (1u << 22)
__device__ __forceinline__ unsigned xb_ld(unsigned* p)              { return __hip_atomic_load(p, __ATOMIC_RELAXED, __HIP_MEMORY_SCOPE_AGENT); }
__device__ __forceinline__ unsigned xb_add(unsigned* p, unsigned v) { return __hip_atomic_fetch_add(p, v, __ATOMIC_RELAXED, __HIP_MEMORY_SCOPE_AGENT); }
__device__ __forceinline__ unsigned xb_xcc_id() { return (unsigned)__builtin_amdgcn_s_getreg((3 << 11) | 20) & 0xFu; }
#define XB_SPIN(cond, bar) do { unsigned _sp = 0; while (cond) { __builtin_amdgcn_s_sleep(1); \
    if ((++_sp & 255u) == 0u) { if (xb_ld(&(bar)[XB_TMO])) break; if (_sp > XB_SPIN_CAP) { atomicAdd(&(bar)[XB_TMO], 1u); break; } } } } while (0)
struct XcdBarrier { unsigned* bar; unsigned x; volatile LAS unsigned* st; };
__device__ __forceinline__ XcdBarrier xcd_barrier_post(unsigned* bar, volatile LAS unsigned* st, bool leader) {
    XcdBarrier b; b.bar = bar; b.x = xb_xcc_id(); b.st = st;
    if (leader) (void)xb_add(&bar[XB_XCNT(b.x)], 1u);
    return b;
}
__device__ __forceinline__ void xcd_barrier_complete(unsigned* bar, unsigned x, unsigned& nloc, unsigned& nx) {
    const unsigned G = gridDim.x * gridDim.y * gridDim.z;
    unsigned sum, cnt, mine, sp = 0u;
    for (;;) {
        sum = 0u; cnt = 0u; mine = 0u;
#pragma unroll
        for (unsigned j = 0; j < 16; ++j) { const unsigned c = xb_ld(&bar[XB_XCNT(j)]); sum += c; cnt += (c > 0u) ? 1u : 0u; mine = (j == x) ? c : mine; }
        if (sum == G) break;
        __builtin_amdgcn_s_sleep(1);
        if ((++sp & 255u) == 0u) { if (xb_ld(&bar[XB_TMO])) break; if (sp > XB_SPIN_CAP) { atomicAdd(&bar[XB_TMO], 1u); break; } }
    }
    nloc = mine > 0u ? mine : 1u; nx = cnt > 0u ? cnt : 1u;
}
__device__ __forceinline__ void xcd_barrier(const XcdBarrier& b, bool leader) {
    asm volatile("s_waitcnt vmcnt(0)" ::: "memory");
    __syncthreads();
    if (leader) {
        unsigned* bar = b.bar;
        __builtin_amdgcn_s_waitcnt(0);
        unsigned nloc = b.st[0], nx = b.st[1];
        if (nloc == 0u) { xcd_barrier_complete(bar, b.x, nloc, nx); b.st[0] = nloc; b.st[1] = nx; }
        const unsigned old = xb_add(&bar[XB_XSUB(b.x)], 1u);
        const unsigned gen = old / nloc;
        if (old + 1u == (gen + 1u) * nloc) {
            __builtin_amdgcn_fence(__ATOMIC_RELEASE, "agent");
            asm volatile("s_waitcnt vmcnt(0)" ::: "memory");
            const unsigned og = xb_add(&bar[XB_TOP], 1u);
            const unsigned tg = og / nx;
            if (og + 1u == (tg + 1u) * nx) xb_add(&bar[XB_TOPGEN], 1u);
            else XB_SPIN(xb_ld(&bar[XB_TOPGEN]) == tg, bar);
            __builtin_amdgcn_fence(__ATOMIC_ACQUIRE, "agent");
            xb_add(&bar[XB_XGEN(b.x)], 1u);
            asm volatile("s_waitcnt vmcnt(0)" ::: "memory");
        } else {
            XB_SPIN(xb_ld(&bar[XB_XGEN(b.x)]) == gen, bar);
            __builtin_amdgcn_fence(__ATOMIC_ACQUIRE, "agent");
            asm volatile("s_waitcnt vmcnt(0)" ::: "memory");
        }
    }
    __syncthreads();
}

struct Ctx { LAS unsigned char* lds; int tid, lane, wave, bid, nb, vcu; };
struct Args { const float* in[40]; float* out; unsigned char* ws; int ph_lo, ph_hi; };
enum { I_X = 0, I_C, I_CTX, I_CCTX, I_ADAW, I_ADAB, I_N1G, I_N2G, I_EVWIN, I_EVWOUT, I_QNORM, I_WUQ, I_KVNORM, I_WUKV, I_QG, I_KG, I_DWW, I_DWB, I_LNG, I_LNB,
       I_ODWIN, I_ODWOUT, I_SHIFTW, I_W0, I_W2L, I_A0, I_A2, I_G2, I_KKW, I_KA, I_RK, I_GNG, I_GNB, I_NAQG, I_NAKG, I_RPB, I_ROUTER, I_MW1, I_MW3, I_MW2 };

DI void transpose_item(const float* __restrict__ W, int K, int N, bf16* __restrict__ WT, int dst_row0, const float* __restrict__ gain, LAS float* scr, int k0, int n0, int lane) {
#pragma unroll 8
    for (int i = 0; i < 32; ++i) { const int kk = 2 * i + (lane >> 5); float v = W[(size_t)(k0 + kk) * N + n0 + (lane & 31)]; if (gain) v *= gain[k0 + kk]; scr[kk * 33 + (lane & 31)] = v; }
    asm volatile("s_waitcnt lgkmcnt(0)" ::: "memory");
    const int c = lane & 7;
#pragma unroll
    for (int j = 0; j < 4; ++j) { const int n = (lane >> 3) + 8 * j; const LAS float* s = scr + (8 * c) * 33 + n;
        u32x4 o; o.x = pk2(s[0 * 33], s[1 * 33]); o.y = pk2(s[2 * 33], s[3 * 33]); o.z = pk2(s[4 * 33], s[5 * 33]); o.w = pk2(s[6 * 33], s[7 * 33]);
        *(u32x4*)(WT + (size_t)(dst_row0 + n) * K + k0 + 8 * c) = o; }
    asm volatile("s_waitcnt lgkmcnt(0)" ::: "memory");
}
DI void transpose_item64(const float* __restrict__ W, int K, int N, bf16* __restrict__ WT, int dst_row0, LAS float* scr, int k0, int n0, int lane) {
    f32x4 v[16];
#pragma unroll
    for (int i = 0; i < 16; ++i) v[i] = *(const f32x4*)(W + (size_t)(k0 + 4 * i + (lane >> 4)) * N + n0 + 4 * (lane & 15));
#pragma unroll
    for (int i = 0; i < 16; ++i) { LAS float* d = scr + (4 * i + (lane >> 4)) * 65 + 4 * (lane & 15); d[0] = v[i].x; d[1] = v[i].y; d[2] = v[i].z; d[3] = v[i].w; }
    asm volatile("s_waitcnt lgkmcnt(0)" ::: "memory");
    const int c = lane & 7;
#pragma unroll
    for (int j = 0; j < 8; ++j) { const int n = (lane >> 3) + 8 * j; const LAS float* s = scr + (8 * c) * 65 + n;
        u32x4 o; o.x = pk2(s[0 * 65], s[1 * 65]); o.y = pk2(s[2 * 65], s[3 * 65]); o.z = pk2(s[4 * 65], s[5 * 65]); o.w = pk2(s[6 * 65], s[7 * 65]);
        *(u32x4*)(WT + (size_t)(dst_row0 + n) * K + k0 + 8 * c) = o; }
    asm volatile("s_waitcnt lgkmcnt(0)" ::: "memory");
}
DI void transpose_item64_f8(const float* __restrict__ W, int K, int N, unsigned char* __restrict__ WT8, int dst_row0, LAS float* scr, int k0, int n0, int lane) {
    f32x4 v[16];
#pragma unroll
    for (int i = 0; i < 16; ++i) v[i] = *(const f32x4*)(W + (size_t)(k0 + 4 * i + (lane >> 4)) * N + n0 + 4 * (lane & 15));
#pragma unroll
    for (int i = 0; i < 16; ++i) { LAS float* d = scr + (4 * i + (lane >> 4)) * 65 + 4 * (lane & 15); d[0] = v[i].x; d[1] = v[i].y; d[2] = v[i].z; d[3] = v[i].w; }
    asm volatile("s_waitcnt lgkmcnt(0)" ::: "memory");
    const int c = lane & 7;
#pragma unroll
    for (int j = 0; j < 8; ++j) { const int n = (lane >> 3) + 8 * j; const LAS float* s = scr + (8 * c) * 65 + n;
        u32x2 o; o.x = pk4_fp8(64.f * s[0 * 65], 64.f * s[1 * 65], 64.f * s[2 * 65], 64.f * s[3 * 65]); o.y = pk4_fp8(64.f * s[4 * 65], 64.f * s[5 * 65], 64.f * s[6 * 65], 64.f * s[7 * 65]);
        *(u32x2*)(WT8 + (size_t)(dst_row0 + n) * K + k0 + 8 * c) = o; }
    asm volatile("s_waitcnt lgkmcnt(0)" ::: "memory");
}
DI void transpose_matrix(const Ctx& C, const float* W, int K, int N, bf16* WT, const float* gain, int mode  ) {
    LAS float* scr = (LAS float*)(C.lds + C.wave * 8704);
    const int nkb = K / 64, nnb = N / 32, nit = nkb * nnb, gw = C.vcu * 8 + C.wave, ngw = C.nb * 8;
    for (int it = gw; it < nit; it += ngw) {
        const int kb = it / nnb, nbk = it % nnb, n0 = nbk * 32;
        int d0 = n0; if (mode) d0 = (n0 >> 7) * 256 + (n0 & 127) + (mode == 2 ? 128 : 0);
        transpose_item(W, K, N, WT, d0, gain, scr, kb * 64, n0, C.lane);
    }
}

DI void ph_prologue(const Ctx& C, const Args& a) {
    unsigned char* ws = a.ws;
    {
        LAS float* sv = (LAS float*)C.lds;
        LAS float* red = sv + 9 * 1024;
        for (int i = C.tid; i < 9 * 1024; i += 512) { const int m = i >> 10, k = i & 1023; const float c = (m < 8) ? a.in[I_C][m * 1024 + k] : a.in[I_CCTX][k]; sv[i] = siluf_(c); }
        __syncthreads();
        float* MOD = (float*)(ws + WS_MOD);
        for (int it = C.bid; it < 4 * 96; it += C.nb) {
            const int layer = it / 96, col = (it % 96) * 64 + C.lane;
            const float* wp = a.in[I_ADAW] + (size_t)layer * 1024 * 6144 + col;
            float acc[9];
#pragma unroll
            for (int m = 0; m < 9; ++m) acc[m] = 0.f;
            const int kb = C.wave * 128;
#pragma unroll 16
            for (int k = 0; k < 128; ++k) { const float w = wp[(size_t)(kb + k) * 6144];
#pragma unroll
                for (int m = 0; m < 9; ++m) acc[m] += sv[m * 1024 + kb + k] * w; }
#pragma unroll
            for (int m = 0; m < 9; ++m) red[(C.wave * 9 + m) * 64 + C.lane] = acc[m];
            __syncthreads();
            for (int i = C.tid; i < 576; i += 512) { const int m = i >> 6, l = i & 63; float s = 0.f;
#pragma unroll
                for (int w = 0; w < 8; ++w) s += red[(w * 9 + m) * 64 + l];
                const int cc = (it % 96) * 64 + l;
                MOD[(size_t)(layer * 9 + m) * 6144 + cc] = s + a.in[I_ADAB][layer * 6144 + cc]; }
            __syncthreads();
        }
    }
    {
        f32x2* CS = (f32x2*)(ws + WS_ROPE);
        for (int i = C.bid * 512 + C.tid; i < 4096 * 16; i += C.nb * 512) {
            const int pos = i >> 4, j = i & 15, f = j & 7;
            const float inv = powf(10000.f, -(float)(2 * f) / 16.f);
            const float ang = (float)((j < 8) ? (pos >> 6) : (pos & 63)) * inv;
            const double tw = 6.283185307179586476925;
            const double x = (double)ang, n = __builtin_rint(x / tw), rr = x - n * tw;
            CS[i] = (f32x2){__cosf((float)rr), __sinf((float)rr)};
        }
    }
    for (int j = 0; j < 2; ++j) {
        transpose_matrix(C, a.in[I_EVWIN] + (size_t)j * DM * EV_IN, DM, EV_IN, (bf16*)(ws + WS_WEVIN) + (size_t)j * EV_INP * DM, nullptr, 0);
        transpose_matrix(C, a.in[I_EVWOUT] + (size_t)j * DM * DM, DM, DM, (bf16*)(ws + WS_WEVOUT) + (size_t)j * DM * DM, nullptr, 0);
        transpose_matrix(C, a.in[I_WUQ] + (size_t)j * 384 * 768, 384, 768, (bf16*)(ws + WS_WUQ) + (size_t)j * 768 * 384, a.in[I_QNORM] + j * 384, 0);
        transpose_matrix(C, a.in[I_WUKV] + (size_t)j * 256 * 1024, 256, 1024, (bf16*)(ws + WS_WUKV) + (size_t)j * 1024 * 256, a.in[I_KVNORM] + j * 256, 0);
        transpose_matrix(C, a.in[I_ODWIN] + (size_t)j * DM * OD_IN, DM, OD_IN, (bf16*)(ws + WS_WODIN) + (size_t)j * OD_INP * DM, nullptr, 0);
        transpose_matrix(C, a.in[I_ODWOUT] + (size_t)j * DM * DM, DM, DM, (bf16*)(ws + WS_WODOUT) + (size_t)j * DM * DM, nullptr, 0);
    }
    {
        const int gt = C.bid * 512 + C.tid, ngt = C.nb * 512;
        for (int j = 0; j < 2; ++j) {
            u32x4* p0 = (u32x4*)((bf16*)(ws + WS_WEVIN) + (size_t)j * EV_INP * DM + (size_t)EV_IN * DM);
            for (int i = gt; i < (EV_INP - EV_IN) * DM / 8; i += ngt) p0[i] = (u32x4){0u, 0u, 0u, 0u};
            u32x4* p1 = (u32x4*)((bf16*)(ws + WS_WODIN) + (size_t)j * OD_INP * DM + (size_t)OD_IN * DM);
            for (int i = gt; i < (OD_INP - OD_IN) * DM / 8; i += ngt) p1[i] = (u32x4){0u, 0u, 0u, 0u};
            bf16* WL = (bf16*)(ws + WS_WLORA) + (size_t)j * 655360;
            const float* w2 = a.in[I_W2L] + (size_t)j * 2 * 64 * 512; const float* a2 = a.in[I_A2] + (size_t)j * 2 * 64 * 512; const float* g2 = a.in[I_G2] + (size_t)j * 128 * 512;
            for (int i = gt; i < 655360; i += ngt) {
                const int n = i >> 8, k = i & 255; float v = 0.f;
                if (n < 1024) { const int d = n >> 9, c = n & 511; if (k >= d * 64 && k < d * 64 + 64) v = w2[(size_t)k * 512 + c]; }
                else if (n < 2048) { const int d = (n - 1024) >> 9, c = n & 511; if (k >= 128 + d * 64 && k < 192 + d * 64) v = a2[(size_t)(k - 128) * 512 + c]; }
                else { const int c = n - 2048; if (k >= 128) v = g2[(size_t)(k - 128) * 512 + c]; }
                WL[i] = f2bf(v);
            }
        }
    }
}

template <bool ROUTER> DI void norm_row(const Ctx& C, int row, const float* xlat, const float* xctx, const float* gain, const float* mod, int shift_off, int scale_off, bf16* H, float* AFFT, float* AFFC, int* SLOT);
template <bool ROUTER, int NR> DI void norm_rowsN(const Ctx& C, int row, const float* xlat, const float* gain, const float* mod, int shift_off, int scale_off, bf16* H, float* AFFT, int* SLOT);
template <bool ROUTER>
DI void ph_norm(const Ctx& C, const float* xlat, const float* xctx, const float* gain, const float* mod  , int shift_off, int scale_off, bf16* H,
                const float* router  , float* AFFT, float* AFFC, int* SLOT) {
    LAS float* RT = (LAS float*)C.lds;
    if (ROUTER) { for (int i = C.tid; i < 16384; i += 512) { const int c = i >> 4, e = i & 15; RT[e * 1024 + c] = router[i]; } __syncthreads(); }
    const int gw = C.bid * 8 + C.wave, ngw = C.nb * 8;
    for (int p = gw; p < NLAT / 4; p += ngw) norm_rowsN<ROUTER, 4>(C, 4 * p, xlat, gain, mod, shift_off, scale_off, H, AFFT, SLOT);
    for (int row = NLAT + gw; row < MT; row += ngw) norm_row<ROUTER>(C, row, xlat, xctx, gain, mod, shift_off, scale_off, H, AFFT, AFFC, SLOT);
}
template <bool ROUTER, int NR>
DI void norm_rowsN(const Ctx& C, int row, const float* __restrict__ xlat, const float* __restrict__ gain, const float* __restrict__ mod, int shift_off, int scale_off, bf16* __restrict__ H, float* __restrict__ AFFT, int* __restrict__ SLOT) {
    const LAS float* RT = (const LAS float*)C.lds; const int lane = C.lane;
    const float* xr = xlat + (size_t)row * DM;
    const float* mp = mod + (row >> 12) * 6144;
    f32x4 v[NR][4]; float rs[NR];
#pragma unroll
    for (int q = 0; q < NR; ++q) { float ss = 0.f;
#pragma unroll
        for (int j = 0; j < 4; ++j) { v[q][j] = *(const f32x4*)(xr + q * DM + 256 * j + 4 * lane); ss += v[q][j].x * v[q][j].x + v[q][j].y * v[q][j].y + v[q][j].z * v[q][j].z + v[q][j].w * v[q][j].w; }
        rs[q] = 1.0f / sqrtf(wave_sum(ss) * (1.f / 1024.f) + EPS); }
#pragma unroll
    for (int j = 0; j < 4; ++j) {
        const int c = 256 * j + 4 * lane;
        const f32x4 g = *(const f32x4*)(gain + c), sc = *(const f32x4*)(mp + scale_off + c), sh = *(const f32x4*)(mp + shift_off + c);
#pragma unroll
        for (int q = 0; q < NR; ++q) {
            v[q][j] = (v[q][j] * rs[q]) * g * (sc + 1.0f) + sh;
            if (ROUTER && MOE_F8) *(unsigned*)((unsigned char*)H + (size_t)(row + q) * DM + c) = pk4_fp8(v[q][j].x, v[q][j].y, v[q][j].z, v[q][j].w);
            else *(u32x2*)(H + (size_t)(row + q) * DM + c) = (u32x2){pk2(v[q][j].x, v[q][j].y), pk2(v[q][j].z, v[q][j].w)};
        }
    }
    if (ROUTER) {
        float lg[NR];
#pragma unroll
        for (int q = 0; q < NR; ++q) lg[q] = 0.f;
#pragma unroll 1
        for (int e = 0; e < 16; ++e) { float p[NR];
#pragma unroll
            for (int q = 0; q < NR; ++q) p[q] = 0.f;
#pragma unroll
            for (int j = 0; j < 4; ++j) { const f32x4 w = *(const LAS f32x4*)(RT + e * 1024 + 256 * j + 4 * lane);
#pragma unroll
                for (int q = 0; q < NR; ++q) p[q] += v[q][j].x * w.x + v[q][j].y * w.y + v[q][j].z * w.z + v[q][j].w * w.w; }
#pragma unroll
            for (int q = 0; q < NR; ++q) { const float t = wave_sum(p[q]); lg[q] = (lane == e) ? t : lg[q]; } }
#pragma unroll
        for (int q = 0; q < NR; ++q) { const float ex = expf(lg[q] - max16(lg[q])); const float af = ex / sum16(ex);
            if (lane < 16) { AFFT[(size_t)((row >> 12) * 16 + lane) * TL + ((row + q) & 4095)] = af; SLOT[(size_t)(row + q) * 16 + lane] = -1; } }
    }
}
template <bool ROUTER>
DI void norm_row(const Ctx& C, int row, const float* __restrict__ xlat, const float* __restrict__ xctx, const float* __restrict__ gain, const float* __restrict__ mod, int shift_off, int scale_off, bf16* __restrict__ H, float* __restrict__ AFFT, float* __restrict__ AFFC, int* __restrict__ SLOT) {
    const LAS float* RT = (const LAS float*)C.lds; const int lane = C.lane;
    {
        const float* xr = row < NLAT ? xlat + (size_t)row * DM : xctx + (size_t)(row - NLAT) * DM;
        const int mi = row < NLAT ? (row >> 12) : 8;
        const float* mp = mod + mi * 6144;
        f32x4 v[4]; float ss = 0.f;
#pragma unroll
        for (int j = 0; j < 4; ++j) { v[j] = *(const f32x4*)(xr + 256 * j + 4 * lane); ss += v[j].x * v[j].x + v[j].y * v[j].y + v[j].z * v[j].z + v[j].w * v[j].w; }
        ss = wave_sum(ss);
        const float rs = 1.0f / sqrtf(ss * (1.f / 1024.f) + EPS);
#pragma unroll
        for (int j = 0; j < 4; ++j) {
            const int c = 256 * j + 4 * lane;
            const f32x4 g = *(const f32x4*)(gain + c), sc = *(const f32x4*)(mp + scale_off + c), sh = *(const f32x4*)(mp + shift_off + c);
            v[j] = (v[j] * rs) * g * (sc + 1.0f) + sh;
            if (ROUTER && MOE_F8) *(unsigned*)((unsigned char*)H + (size_t)row * DM + c) = pk4_fp8(v[j].x, v[j].y, v[j].z, v[j].w);
            else *(u32x2*)(H + (size_t)row * DM + c) = (u32x2){pk2(v[j].x, v[j].y), pk2(v[j].z, v[j].w)};
        }
        if (ROUTER) {
            float mylg = 0.f;
#pragma unroll 1
            for (int e = 0; e < 16; ++e) { float p = 0.f;
#pragma unroll
                for (int j = 0; j < 4; ++j) { const f32x4 w = *(const LAS f32x4*)(RT + e * 1024 + 256 * j + 4 * lane); p += v[j].x * w.x + v[j].y * w.y + v[j].z * w.z + v[j].w * w.w; }
                p = wave_sum(p); mylg = (lane == e) ? p : mylg; }
            const float mx = max16(mylg);
            const float ex = expf(mylg - mx);
            const float mine = ex / sum16(ex);
            if (lane < 16) {
                if (row < NLAT) AFFT[(size_t)((row >> 12) * 16 + lane) * TL + (row & 4095)] = mine;
                else { const int rc = row - NLAT; AFFC[(size_t)((rc >> 8) * 16 + lane) * LCX + (rc & 255)] = mine; }
                SLOT[(size_t)row * 16 + lane] = -1;
            }
        }
    }
}


struct EpiBf16 { static constexpr bool WIDE = true, CUSTOM = false; bf16* O; int ldo;
    DI void operator()(int row, int col, f32x4 v0, f32x4 v1) const { bf16* p = O + (size_t)row * ldo + col;
        *(u32x2*)p = (u32x2){pk2(v0[0], v0[1]), pk2(v0[2], v0[3])}; *(u32x2*)(p + 128) = (u32x2){pk2(v1[0], v1[1]), pk2(v1[2], v1[3])}; }
    DI void wide(int row, int col, f32x4 a0, f32x4 a1, f32x4 b0, f32x4 b1) const { bf16* p = O + (size_t)row * ldo + col;
        *(u32x4*)p = (u32x4){pk2(a0[0], a0[1]), pk2(a0[2], a0[3]), pk2(a1[0], a1[1]), pk2(a1[2], a1[3])}; *(u32x4*)(p + 128) = (u32x4){pk2(b0[0], b0[1]), pk2(b0[2], b0[3]), pk2(b1[0], b1[1]), pk2(b1[2], b1[3])}; } };
struct EpiF32 { static constexpr bool WIDE = false, CUSTOM = false; float* O; int ldo;
    DI void operator()(int row, int col, f32x4 v0, f32x4 v1) const { float* p = O + (size_t)row * ldo + col; *(f32x4*)p = v0; *(f32x4*)(p + 128) = v1; } };
struct EpiResid { static constexpr bool WIDE = false, CUSTOM = true; const float* xin_lat; const float* xin_ctx; float* xout_lat; float* xout_ctx; const float* modg;
    DI void run(const f32x4 (&acc)[2][2][4][2], int pm, int pn, int wr, int wc, int fr, int fq) const {
        const int r0 = pm * 256 + wr * 64 + fr, c0 = pn * 256 + wc * 32 + 8 * fq; const bool lat = pm * 256 < NLAT;
        const float* xi = lat ? xin_lat + (size_t)r0 * DM : xin_ctx + (size_t)(r0 - NLAT) * DM; float* xo = lat ? xout_lat + (size_t)r0 * DM : xout_ctx + (size_t)(r0 - NLAT) * DM;
        const float* g = modg + (lat ? (pm * 256) >> 12 : 8) * 6144 + c0;
        f32x4 gv[2][2];
#pragma unroll
        for (int n = 0; n < 2; ++n) { gv[n][0] = *(const f32x4*)(g + 4 * n); gv[n][1] = *(const f32x4*)(g + 4 * n + 128); }
#pragma unroll
        for (int ai = 0; ai < 2; ++ai)
#pragma unroll
            for (int mh = 0; mh < 2; ++mh) { f32x4 xv[2][2][2];
#pragma unroll
                for (int m2 = 0; m2 < 2; ++m2)
#pragma unroll
                    for (int n = 0; n < 2; ++n) { const size_t o = (size_t)(ai * 128 + (2 * mh + m2) * 16) * DM + c0 + 4 * n; xv[m2][n][0] = *(const f32x4*)(xi + o); xv[m2][n][1] = *(const f32x4*)(xi + o + 128); }
#pragma unroll
                for (int m2 = 0; m2 < 2; ++m2)
#pragma unroll
                    for (int n = 0; n < 2; ++n) { const size_t o = (size_t)(ai * 128 + (2 * mh + m2) * 16) * DM + c0 + 4 * n;
                        *(f32x4*)(xo + o) = xv[m2][n][0] + gv[n][0] * acc[ai][0][2 * mh + m2][n]; *(f32x4*)(xo + o + 128) = xv[m2][n][1] + gv[n][1] * acc[ai][1][2 * mh + m2][n]; } } }
    DI void operator()(int row, int col, f32x4 v0, f32x4 v1) const {
        const float* xi; float* xo; int mi;
        if (row < NLAT) { xi = xin_lat + (size_t)row * DM; xo = xout_lat + (size_t)row * DM; mi = row >> 12; }
        else { xi = xin_ctx + (size_t)(row - NLAT) * DM; xo = xout_ctx + (size_t)(row - NLAT) * DM; mi = 8; }
        const float* g = modg + mi * 6144 + col;
        const f32x4 g0 = *(const f32x4*)g, g1 = *(const f32x4*)(g + 128), x0 = *(const f32x4*)(xi + col), x1 = *(const f32x4*)(xi + col + 128);
        *(f32x4*)(xo + col) = x0 + g0 * v0; *(f32x4*)(xo + col + 128) = x1 + g1 * v1; } };
struct EpiGlu { static constexpr bool WIDE = false, CUSTOM = false; bf16* O;
    DI void operator()(int row, int col, f32x4 v0, f32x4 v1) const { const int f = ((col & 2047) >> 8) * 128 + (col & 255);
        *(u32x2*)(O + (size_t)row * DM + f) = (u32x2){pk2(siluf_(v0[0]) * v1[0], siluf_(v0[1]) * v1[1]), pk2(siluf_(v0[2]) * v1[2], siluf_(v0[3]) * v1[3])}; } };
struct EpiGlu8 { static constexpr bool WIDE = true, CUSTOM = false; unsigned char* O;
    DI void operator()(int row, int col, f32x4 v0, f32x4 v1) const { const int f = ((col & 2047) >> 8) * 128 + (col & 255);
        *(unsigned*)(O + (size_t)row * DM + f) = pk4_fp8(8.f * siluf_(v0[0]) * v1[0], 8.f * siluf_(v0[1]) * v1[1], 8.f * siluf_(v0[2]) * v1[2], 8.f * siluf_(v0[3]) * v1[3]); }
    DI void wide(int row, int col, f32x4 a0, f32x4 a1, f32x4 b0, f32x4 b1) const { const int f = ((col & 2047) >> 8) * 128 + (col & 255);
        *(u32x2*)(O + (size_t)row * DM + f) = (u32x2){pk4_fp8(8.f * siluf_(a0[0]) * b0[0], 8.f * siluf_(a0[1]) * b0[1], 8.f * siluf_(a0[2]) * b0[2], 8.f * siluf_(a0[3]) * b0[3]),
                                                    pk4_fp8(8.f * siluf_(a1[0]) * b1[0], 8.f * siluf_(a1[1]) * b1[1], 8.f * siluf_(a1[2]) * b1[2], 8.f * siluf_(a1[3]) * b1[3])}; } };
struct EpiGate { static constexpr bool WIDE = true, CUSTOM = true; bf16* O; const float* gate;
    DI void run(const f32x4 (&acc)[2][2][4][2], int pm, int pn, int wr, int wc, int fr, int fq) const {
        const int r0 = pm * 256 + wr * 64 + fr, col = (pn * 256 + wc * 32 + 8 * fq) & 1023; float gt[2][4];
#pragma unroll
        for (int ai = 0; ai < 2; ++ai)
#pragma unroll
            for (int m = 0; m < 4; ++m) gt[ai][m] = gate[r0 + ai * 128 + m * 16];
#pragma unroll
        for (int ai = 0; ai < 2; ++ai)
#pragma unroll
            for (int m = 0; m < 4; ++m) { const float g = gt[ai][m]; bf16* p = O + (size_t)(r0 + ai * 128 + m * 16) * DM + col;
                const f32x4 a0 = acc[ai][0][m][0], a1 = acc[ai][0][m][1], b0 = acc[ai][1][m][0], b1 = acc[ai][1][m][1];
                *(u32x4*)p = (u32x4){pk2(a0[0] * g, a0[1] * g), pk2(a0[2] * g, a0[3] * g), pk2(a1[0] * g, a1[1] * g), pk2(a1[2] * g, a1[3] * g)};
                *(u32x4*)(p + 128) = (u32x4){pk2(b0[0] * g, b0[1] * g), pk2(b0[2] * g, b0[3] * g), pk2(b1[0] * g, b1[1] * g), pk2(b1[2] * g, b1[3] * g)}; } }
    DI void operator()(int row, int col, f32x4 v0, f32x4 v1) const { const float g = gate[row]; bf16* p = O + (size_t)row * DM + (col & 1023);
        *(u32x2*)p = (u32x2){pk2(v0[0] * g, v0[1] * g), pk2(v0[2] * g, v0[3] * g)}; *(u32x2*)(p + 128) = (u32x2){pk2(v1[0] * g, v1[1] * g), pk2(v1[2] * g, v1[3] * g)}; }
    DI void wide(int row, int col, f32x4 a0, f32x4 a1, f32x4 b0, f32x4 b1) const { const float g = gate[row]; bf16* p = O + (size_t)row * DM + (col & 1023);
        *(u32x4*)p = (u32x4){pk2(a0[0] * g, a0[1] * g), pk2(a0[2] * g, a0[3] * g), pk2(a1[0] * g, a1[1] * g), pk2(a1[2] * g, a1[3] * g)};
        *(u32x4*)(p + 128) = (u32x4){pk2(b0[0] * g, b0[1] * g), pk2(b0[2] * g, b0[3] * g), pk2(b1[0] * g, b1[1] * g), pk2(b1[2] * g, b1[3] * g)}; } };
typedef _Float16 f16x2_t __attribute__((ext_vector_type(2)));
DI unsigned pk2h(float a, float b) { f16x2_t h; h.x = (_Float16)a; h.y = (_Float16)b; return __builtin_bit_cast(unsigned, h); }
DI float h2f(unsigned short x) { return (float)__builtin_bit_cast(_Float16, x); }
struct EpiLoraW { static constexpr bool WIDE = false, CUSTOM = false; unsigned short* W; const float* w0;
    DI void one(int row, int col, f32x4 v) const { const int d = col >> 9, c = col & 511; f32x4 o;
#pragma unroll
        for (int e = 0; e < 4; ++e) { const float lw = w0[col + e] + v[e]; const float z = -lw; const float sp = fmaxf(z, 0.f) + __logf(1.f + __expf(-fabsf(z))); o[e] = -__expf(-sp - 0.5f); }
        *(u32x2*)(W + ((size_t)d * MT + row) * 512 + c) = (u32x2){pk2h(o[0], o[1]), pk2h(o[2], o[3])}; }
    DI void operator()(int row, int col, f32x4 v0, f32x4 v1) const { one(row, col, v0); one(row, col + 128, v1); } };
struct EpiLoraA { static constexpr bool WIDE = false, CUSTOM = false; bf16* Aout; const float* a0;
    DI void one(int row, int col, f32x4 v) const { const int d = col >> 9, c = col & 511; const f32x4 b = *(const f32x4*)(a0 + col);
        *(u32x2*)(Aout + ((size_t)d * MT + row) * 512 + c) = (u32x2){pk2(sigmoidf_(b[0] + v[0]), sigmoidf_(b[1] + v[1])), pk2(sigmoidf_(b[2] + v[2]), sigmoidf_(b[3] + v[3]))}; }
    DI void operator()(int row, int col, f32x4 v0, f32x4 v1) const { one(row, col, v0); one(row, col + 128, v1); } };

namespace pg8 {
constexpr int BM = 256, BK = 64, HALF = 128, HTB = HALF * BK * 2, STAGE_BYTES = 8 * HTB;
DI int lds_byte(int r, int c) { const int st = (r >> 4) * 2 + (c >> 5), rr = r & 15, cc = c & 31, ob = rr * 64 + cc * 2; return st * 1024 + (ob ^ (((ob >> 9) & 1) << 5)); }
DI void stage_rc(int b, int& R, int& C) { const int st = b / 1024, sb = b % 1024, swz = sb ^ (((sb >> 9) & 1) << 5); R = (st >> 1) * 16 + swz / 64; C = (st & 1) * 32 + (swz % 64) / 2; }
DI int perm32(int rho) { const int n = rho >> 4, i = rho & 15; return 8 * (i >> 2) + 4 * n + (i & 3); }
struct Unit { int pm, pn; };
struct Gemm { const bf16* A; const bf16* Bt; int lda, K; const int* rows; int scale_w = 0x7f7f7f7f, scale_a = 0x7f7f7f7f; };
struct OrderMN { int nM, nN, G, c;
    DI bool next(int i, Unit& u) const { const int L = i * G + c; if (L >= nM * nN) return false; u.pm = L / nN; u.pn = L % nN; return true; } };
struct OrderMoE { int nMt, nN, mstride  , G, c;
    DI bool next(int i, Unit& u) const { const int L = i * G + c, per = nMt * nN; if (L >= NEXP * per) return false; const int e = L / per, q = L % per; u.pm = e * mstride + q / nN; u.pn = e * nN + q % nN; return true; } };
template <class E4> struct EpiAdapt { E4 e;
    DI void operator()(const f32x4 (&acc)[2][2][4][2], const Unit& u, int wr, int wc, int fr, int fq) const {
        if constexpr (E4::CUSTOM) { e.run(acc, u.pm, u.pn, wr, wc, fr, fq); return; }
#pragma unroll
        for (int ai = 0; ai < 2; ++ai)
#pragma unroll
            for (int m = 0; m < 4; ++m) { const int row = u.pm * BM + ai * HALF + wr * 64 + m * 16 + fr;
                if constexpr (E4::WIDE) e.wide(row, u.pn * BM + wc * 32 + 8 * fq, acc[ai][0][m][0], acc[ai][0][m][1], acc[ai][1][m][0], acc[ai][1][m][1]);
                else {
#pragma unroll
                    for (int n = 0; n < 2; ++n) e(row, u.pn * BM + wc * 32 + 8 * fq + 4 * n, acc[ai][0][m][n], acc[ai][1][m][n]); } } } };

template <class Epi, class Sched, bool F8 = false>
DI void gemm_phase(LAS unsigned char* lds, const Gemm g, const Sched& S, const Epi& E, const int tid) {
    const int wid = __builtin_amdgcn_readfirstlane(tid >> 6), lane = tid & 63, wr = wid >> 2, wc = wid & 3, fr = lane & 15, fq = lane >> 4;
    const int K = g.K, nt = K / BK;
    unsigned voffB[2];
#pragma unroll
    for (int i = 0; i < 2; ++i) { int R, C; stage_rc(tid * 16 + i * 8192, R, C); const int Rb = (R & ~31) + perm32(R & 31); voffB[i] = (unsigned)(Rb * K + C) * 2u; }
    const size_t kstep = (size_t)(BK * 2), hstep = (size_t)HALF * K * 2, tstep = 2 * hstep;
    const unsigned ldsw = (unsigned)wid * 1024u;
    const int aoff = lds_byte(wr * 64 + fr, fq * 8), boff = lds_byte(wc * 32 + fr, fq * 8);
    const char* const gA = (const char*)g.A;
#define PG8_SA(b, h) (((b) * 2 + (h)) * HTB)
#define PG8_SB(b, h) ((4 + (b) * 2 + (h)) * HTB)
#define PG8_STAGE(bufoff, gbase, voff) do { _Pragma("unroll") for (int _i = 0; _i < 2; ++_i) \
        __builtin_amdgcn_global_load_lds((const unsigned*)((const char*)(gbase) + (voff)[_i]), (LAS unsigned*)(lds + (bufoff) + ldsw + _i * 8192), 16, 0, 0); } while (0)
#define PG8_LDA(dst, b, h) do { _Pragma("unroll") for (int m = 0; m < 4; ++m) _Pragma("unroll") for (int k = 0; k < 2; ++k) dst[m][k] = *(const LAS bf16x8*)(lds + PG8_SA(b, h) + aoff + m * 2048 + k * 1024); } while (0)
#define PG8_LDB(dst, b, h) do { _Pragma("unroll") for (int n = 0; n < 2; ++n) _Pragma("unroll") for (int k = 0; k < 2; ++k) dst[n][k] = *(const LAS bf16x8*)(lds + PG8_SB(b, h) + boff + n * 2048 + k * 1024); } while (0)
#define PG8_MMA(ai, bj, At, Bt) do { __builtin_amdgcn_s_setprio(1); _Pragma("unroll") for (int m = 0; m < 4; ++m) _Pragma("unroll") for (int n = 0; n < 2; ++n) { \
        if constexpr (F8) { const v8i_t w8 = __builtin_shufflevector(__builtin_bit_cast(i32x4_t, Bt[n][0]), __builtin_bit_cast(i32x4_t, Bt[n][1]), 0, 1, 2, 3, 4, 5, 6, 7), x8 = __builtin_shufflevector(__builtin_bit_cast(i32x4_t, At[m][0]), __builtin_bit_cast(i32x4_t, At[m][1]), 0, 1, 2, 3, 4, 5, 6, 7); \
            acc[ai][bj][m][n] = __builtin_amdgcn_mfma_scale_f32_16x16x128_f8f6f4(w8, x8, acc[ai][bj][m][n], 0, 0, 0, g.scale_w, 0, g.scale_a); } \
        else { _Pragma("unroll") for (int k = 0; k < 2; ++k) acc[ai][bj][m][n] = __builtin_amdgcn_mfma_f32_16x16x32_bf16(Bt[n][k], At[m][k], acc[ai][bj][m][n], 0, 0, 0); } } __builtin_amdgcn_s_setprio(0); } while (0)
#define PG8_WAIT_V(n) asm volatile("s_waitcnt vmcnt(" #n ")" ::: "memory")
#define PG8_WAIT_L(n) asm volatile("s_waitcnt lgkmcnt(" #n ")" ::: "memory")
#define PG8_BAR __builtin_amdgcn_s_barrier()
#define PG8_SCHED __builtin_amdgcn_sched_barrier(0)
#define PG8_ROWIDX(ri, u) do { _Pragma("unroll") for (int _h = 0; _h < 2; ++_h) _Pragma("unroll") for (int _i = 0; _i < 2; ++_i) { int _R, _C; stage_rc(tid * 16 + _i * 8192, _R, _C); (void)_C; \
        const int _lr = (u).pm * BM + _h * HALF + _R; ri[_h][_i] = g.rows ? g.rows[_lr] : _lr; } } while (0)
#define PG8_AOFF_FROM(vo, ri) do { _Pragma("unroll") for (int _h = 0; _h < 2; ++_h) _Pragma("unroll") for (int _i = 0; _i < 2; ++_i) { int _R, _C; stage_rc(tid * 16 + _i * 8192, _R, _C); (void)_R; \
        vo[_h][_i] = (unsigned)(((size_t)ri[_h][_i] * g.lda + _C) * 2u); } } while (0)
    Unit cur, nxt; int ui = 0;
    if (!S.next(0, cur)) return;
    f32x4 acc[2][2][4][2];
#pragma unroll
    for (int a = 0; a < 2; ++a)
#pragma unroll
        for (int b = 0; b < 2; ++b)
#pragma unroll
            for (int m = 0; m < 4; ++m)
#pragma unroll
                for (int n = 0; n < 2; ++n) acc[a][b][m][n] = (f32x4){0.f, 0.f, 0.f, 0.f};
    bf16x8 At[4][2], B0[2][2], B1[2][2];
    unsigned cvo[2][2]; int nri[2][2];
    PG8_ROWIDX(nri, cur); PG8_AOFF_FROM(cvo, nri);
    const char* cB = (const char*)g.Bt + (size_t)cur.pn * tstep;
    PG8_STAGE(PG8_SB(0, 0), cB, voffB); PG8_STAGE(PG8_SB(0, 1), cB + hstep, voffB); PG8_STAGE(PG8_SA(0, 0), gA, cvo[0]); PG8_STAGE(PG8_SA(0, 1), gA, cvo[1]);
    if (wr == 1) PG8_BAR;
    PG8_WAIT_V(2); PG8_BAR;
    PG8_STAGE(PG8_SB(1, 0), cB + kstep, voffB); PG8_STAGE(PG8_SA(1, 0), gA + kstep, cvo[0]); PG8_STAGE(PG8_SB(1, 1), cB + hstep + kstep, voffB);
    PG8_WAIT_V(6); PG8_BAR;
    for (;;) {
        const bool has_next = S.next(ui + 1, nxt);
        const char* nB = has_next ? (const char*)g.Bt + (size_t)nxt.pn * tstep : cB;
#pragma nounroll
        for (int t = 0; t < nt; t += 2) {
            const bool last = (t == nt - 2);
            const char* a1 = gA + (size_t)(t + 1) * kstep;
            const char* a2 = last ? gA : gA + (size_t)(t + 2) * kstep; const char* b2 = last ? nB : cB + (size_t)(t + 2) * kstep;
            const char* a3 = a2 + kstep; const char* b3 = b2 + kstep;
            if (t == nt - 4 && has_next) PG8_ROWIDX(nri, nxt);
            PG8_LDB(B0, 0, 0); PG8_LDB(B1, 0, 1); PG8_SCHED; PG8_LDA(At, 0, 0); PG8_STAGE(PG8_SA(1, 1), a1, cvo[1]);
            if (last && has_next) { if (nt < 4) PG8_ROWIDX(nri, nxt); PG8_AOFF_FROM(cvo, nri); }
            PG8_WAIT_V(8); PG8_WAIT_L(0); PG8_BAR; PG8_MMA(0, 0, At, B0); PG8_MMA(0, 1, At, B1); PG8_BAR; PG8_SCHED;
            PG8_LDA(At, 0, 1); PG8_STAGE(PG8_SB(0, 0), b2, voffB); PG8_STAGE(PG8_SB(0, 1), b2 + hstep, voffB); PG8_STAGE(PG8_SA(0, 0), a2, cvo[0]);
            PG8_WAIT_V(8); PG8_WAIT_L(0); PG8_BAR; PG8_MMA(1, 0, At, B0); PG8_MMA(1, 1, At, B1); PG8_BAR; PG8_SCHED;
            PG8_LDB(B0, 1, 0); PG8_LDB(B1, 1, 1); PG8_SCHED; PG8_LDA(At, 1, 0); PG8_STAGE(PG8_SA(0, 1), a2, cvo[1]);
            PG8_WAIT_V(8); PG8_WAIT_L(0); PG8_BAR; PG8_MMA(0, 0, At, B0); PG8_MMA(0, 1, At, B1); PG8_BAR; PG8_SCHED;
            PG8_LDA(At, 1, 1); PG8_STAGE(PG8_SB(1, 0), b3, voffB); PG8_STAGE(PG8_SB(1, 1), b3 + hstep, voffB); PG8_STAGE(PG8_SA(1, 0), a3, cvo[0]);
            PG8_WAIT_V(8); PG8_WAIT_L(0); PG8_BAR; PG8_MMA(1, 0, At, B0); PG8_MMA(1, 1, At, B1); PG8_BAR; PG8_SCHED;
        }
        if (wr == 0) PG8_BAR;
        E(acc, cur, wr, wc, fr, fq);
        if (!has_next) break;
#pragma unroll
        for (int a = 0; a < 2; ++a)
#pragma unroll
            for (int b = 0; b < 2; ++b)
#pragma unroll
                for (int m = 0; m < 4; ++m)
#pragma unroll
                    for (int n = 0; n < 2; ++n) acc[a][b][m][n] = (f32x4){0.f, 0.f, 0.f, 0.f};
        cur = nxt; cB = nB; ++ui;
        if (wr == 1) PG8_BAR;
    }
    PG8_WAIT_V(0);
    PG8_BAR;
#undef PG8_SA
#undef PG8_SB
#undef PG8_STAGE
#undef PG8_LDA
#undef PG8_LDB
#undef PG8_MMA
#undef PG8_WAIT_V
#undef PG8_WAIT_L
#undef PG8_BAR
#undef PG8_SCHED
#undef PG8_ROWIDX
#undef PG8_AOFF_FROM
}
}
template <class E4> DI void fast_gemm(const Ctx& C, const bf16* A, int lda, const bf16* Bt, int K, int nM, int nN, const E4& e, bool rev = false) {
    pg8::Gemm g{A, Bt, lda, K, nullptr}; pg8::OrderMN S{nM, nN, C.nb, rev ? C.nb - 1 - C.vcu : C.vcu}; pg8::EpiAdapt<E4> E{e};
    pg8::gemm_phase(C.lds, g, S, E, C.tid);
}

DI float max16_acc(float m, const f32x16& x) {
    asm volatile("s_nop 15\n\tv_max3_f32 %0, %0, %1, %2\n\tv_max3_f32 %0, %0, %3, %4\n\tv_max3_f32 %0, %0, %5, %6\n\tv_max3_f32 %0, %0, %7, %8\n\tv_max3_f32 %0, %0, %9, %10\n\tv_max3_f32 %0, %0, %11, %12\n\tv_max3_f32 %0, %0, %13, %14\n\tv_max3_f32 %0, %0, %15, %16"
                 : "+v"(m) : "v"(x[0]), "v"(x[1]), "v"(x[2]), "v"(x[3]), "v"(x[4]), "v"(x[5]), "v"(x[6]), "v"(x[7]), "v"(x[8]), "v"(x[9]), "v"(x[10]), "v"(x[11]), "v"(x[12]), "v"(x[13]), "v"(x[14]), "v"(x[15]));
    return m; }
DI int swap23(int x) { return (x & ~12) | ((x & 4) << 1) | ((x & 8) >> 1); }
DI void flash_store(const f32x16 (&o)[2], float l, bf16* orow  , int h) {
    const float inv = 1.f / l;
#pragma unroll
    for (int dt = 0; dt < 2; ++dt)
#pragma unroll
        for (int g = 0; g < 4; ++g)
            *(u32x2*)(orow + 32 * dt + 8 * g + 4 * h) = (u32x2){pk2(o[dt][4 * g] * inv, o[dt][4 * g + 1] * inv), pk2(o[dt][4 * g + 2] * inv, o[dt][4 * g + 3] * inv)};
}


template <int DQK> struct AttnGeo { static constexpr int KSTR = DQK * 2 + 16, KBYTES = 64 * KSTR, VSTR = 144, VBYTES = 64 * VSTR, BUF = KBYTES + VBYTES, KPIECES = 64 * DQK / 8; };
template <int DQK, bool NAT>
DI void attn_tile_loop(const Ctx& C, f32x16 (&o)[2], float& l, const bf16x8 (&qf)[DQK / 16], const bf16* __restrict__ Kb, const bf16* __restrict__ Vt, int pos1, int n1, int pos2, int n2,
                       const LAS float* tab, int grow, int rs, int qc, int cs) {
    typedef AttnGeo<DQK> G;
    const int tid = C.tid, r = C.lane & 31, h = C.lane >> 5, kr = swap23(r), ntiles = n1 + n2;
    constexpr bool K2 = G::KPIECES > 512;
    const int kq0 = tid, kq1 = tid + 512;
    const int kl0 = (kq0 / (DQK / 8)) * G::KSTR + (kq0 % (DQK / 8)) * 16, kl1 = (kq1 / (DQK / 8)) * G::KSTR + (kq1 % (DQK / 8)) * 16;
    const int vl = G::KBYTES + (tid >> 3) * G::VSTR + (tid & 7) * 16;
    const bf16* vg = Vt + (size_t)(tid >> 3) * KPOS + 8 * (tid & 7);
    u32x4 rk0, rk1, rv;
    rk1 = (u32x4){0u, 0u, 0u, 0u};
#define ATT_POS(t) ((t) < n1 ? pos1 + 64 * (t) : pos2 + 64 * ((t) - n1))
    { const int pos0 = ATT_POS(0); rk0 = *(const u32x4*)(Kb + (size_t)pos0 * DQK + 8 * kq0); if (K2 && tid < 256) rk1 = *(const u32x4*)(Kb + (size_t)pos0 * DQK + 8 * kq1); rv = *(const u32x4*)(vg + pos0); }
    __syncthreads();
    *(LAS u32x4*)(C.lds + kl0) = rk0; if (K2 && tid < 256) *(LAS u32x4*)(C.lds + kl1) = rk1; *(LAS u32x4*)(C.lds + vl) = rv;
    __syncthreads();
    if (C.wave >= 4) __builtin_amdgcn_s_setprio(1);
    float mref = 0.f; bool first = true;
    f32x16 nmref;
#pragma unroll
    for (int i = 0; i < 16; ++i) nmref[i] = 0.f;
    constexpr float THR = 8.f;
    for (int t = 0; t < ntiles; ++t) {
        const LAS unsigned char* B = C.lds + (t & 1) * G::BUF;
        if (t + 1 < ntiles) { const int pos0 = ATT_POS(t + 1);
            rk0 = *(const u32x4*)(Kb + (size_t)pos0 * DQK + 8 * kq0); if (K2 && tid < 256) rk1 = *(const u32x4*)(Kb + (size_t)pos0 * DQK + 8 * kq1); rv = *(const u32x4*)(vg + pos0); }
        const int gr = (pos1 >> 6) + t;
        const bool active = !NAT || t >= n1 || (gr >= rs && gr < rs + 8);
        if (active) {
            f32x16 sc[2];
            constexpr int NK = DQK / 16, NS = 2 * NK, RD = 4;
            const LAS unsigned char* kp = B + kr * G::KSTR + 16 * h;
            bf16x8 fr[RD];
#pragma unroll
            for (int s = 0; s < RD; ++s) fr[s] = *(const LAS bf16x8*)(kp + (s / NK) * 32 * G::KSTR + 32 * (s % NK));
#pragma unroll
            for (int s = 0; s < NS; ++s) { sc[s / NK] = MFMA32(fr[s % RD], qf[s % NK], (s % NK == 0) ? nmref : sc[s / NK]);
                if (s + RD < NS) fr[s % RD] = *(const LAS bf16x8*)(kp + ((s + RD) / NK) * 32 * G::KSTR + 32 * ((s + RD) % NK)); }
            const LAS unsigned char* vp = B + G::KBYTES + r * G::VSTR + 16 * h;
#pragma unroll
            for (int v = 0; v < RD; ++v) fr[v] = *(const LAS bf16x8*)(vp + (v & 1) * 32 * G::VSTR + (v >> 1) * 32);
            __builtin_amdgcn_sched_group_barrier(0x100, RD, 0);
#pragma unroll
            for (int s = 0; s < NS - RD; ++s) { __builtin_amdgcn_sched_group_barrier(0x008, 1, 0); __builtin_amdgcn_sched_group_barrier(0x100, 1, 0); }
            __builtin_amdgcn_sched_group_barrier(0x008, RD, 0);
            __builtin_amdgcn_sched_group_barrier(0x100, RD, 0);
            if (NAT && t < n1) {
                const LAS float* trl = tab + (gr - grow + 7) * 128 + (8 * h - qc + 63);
#pragma unroll
                for (int j = 0; j < 2; ++j) { float bv[16];
#pragma unroll
                    for (int i = 0; i < 16; ++i) bv[i] = trl[32 * j + ((i & 3) | (((i >> 2) & 1) << 2) | ((i >> 3) << 4))];
                    asm volatile("" : "+v"(bv[0]), "+v"(bv[1]), "+v"(bv[2]), "+v"(bv[3]), "+v"(bv[4]), "+v"(bv[5]), "+v"(bv[6]), "+v"(bv[7]), "+v"(bv[8]), "+v"(bv[9]), "+v"(bv[10]), "+v"(bv[11]), "+v"(bv[12]), "+v"(bv[13]), "+v"(bv[14]), "+v"(bv[15]));
#pragma unroll
                    for (int i = 0; i < 16; ++i) {
                        const int cc = 32 * j + ((i & 3) | (((i >> 2) & 1) << 2) | ((i >> 3) << 4)) + 8 * h; const bool ok = (cc >= cs) && (cc < cs + 16);
                        sc[j][i] = ok ? sc[j][i] + bv[i] : -1e30f;
                    } }
            }
            float mx = max16_acc(max16_acc(-3.0e38f, sc[0]), sc[1]);
            if (first || __builtin_amdgcn_ballot_w64(mx > THR) != 0ull) {
                mx = fmaxf(mx, xor32(mx, C.lane));
                const float delta = first ? mx : fmaxf(mx, 0.f);
#pragma unroll
                for (int i = 0; i < 16; ++i) { sc[0][i] -= delta; sc[1][i] -= delta; }
                if (!first) { const float alpha = __builtin_amdgcn_exp2f(-delta); l *= alpha;
#pragma unroll
                    for (int i = 0; i < 16; ++i) { o[0][i] *= alpha; o[1][i] *= alpha; } }
                mref += delta; first = false;
#pragma unroll
                for (int i = 0; i < 16; ++i) nmref[i] = -mref;
            }
            float rs1 = 0.f;
#pragma unroll
            for (int j = 0; j < 2; ++j)
#pragma unroll
                for (int i = 0; i < 16; ++i) { sc[j][i] = __builtin_amdgcn_exp2f(sc[j][i]); rs1 += sc[j][i]; }
            l += rs1;
#pragma unroll
            for (int j = 0; j < 2; ++j)
#pragma unroll
                for (int s2 = 0; s2 < 2; ++s2) {
                    u32x4 pw; pw.x = pk2(sc[j][8 * s2], sc[j][8 * s2 + 1]); pw.y = pk2(sc[j][8 * s2 + 2], sc[j][8 * s2 + 3]); pw.z = pk2(sc[j][8 * s2 + 4], sc[j][8 * s2 + 5]); pw.w = pk2(sc[j][8 * s2 + 6], sc[j][8 * s2 + 7]);
                    const bf16x8 pb = __builtin_bit_cast(bf16x8, pw);
#pragma unroll
                    for (int dt = 0; dt < 2; ++dt) { const int v = 4 * j + 2 * s2 + dt;
                        o[dt] = MFMA32(fr[v % RD], pb, o[dt]);
                        if (v + RD < 8) fr[v % RD] = *(const LAS bf16x8*)(vp + ((v + RD) & 1) * 32 * G::VSTR + ((v + RD) >> 1) * 32); }
                }
#pragma unroll
            for (int v = 0; v < 8 - RD; ++v) { __builtin_amdgcn_sched_group_barrier(0x008, 1, 1); __builtin_amdgcn_sched_group_barrier(0x100, 1, 1); }
            __builtin_amdgcn_sched_group_barrier(0x008, RD, 1);
        }
        if (t + 1 < ntiles) { LAS unsigned char* Bn = C.lds + ((t + 1) & 1) * G::BUF;
            *(LAS u32x4*)(Bn + kl0) = rk0; if (K2 && tid < 256) *(LAS u32x4*)(Bn + kl1) = rk1; *(LAS u32x4*)(Bn + vl) = rv; }
        __syncthreads();
    }
    __builtin_amdgcn_s_setprio(0);
    l += xor32(l, C.lane);
#undef ATT_POS
}
DI void conv_unit(const Ctx& C, int u, const bf16* U, const float (&wk)[31], float bias, const float* lng, const float* lnb, bf16* OCAT);
DI const float* in_ptr(const unsigned char* ws, int k);
constexpr int CONV_PER_TAIL = 3;
DI int conv_in_fin(int nb) { const int extra = (MT / 64) % nb; const int n = CONV_PER_TAIL * (nb - extra); return n < MT / 32 ? n : MT / 32; }
DI void ph_attn_mla2(const Ctx& C, const bf16* QB, const bf16* KB, const bf16* VT, bf16* OCAT, bool last, unsigned char* ws, int lq) {
    const int r = C.lane & 31, h = C.lane >> 5;
    const int nunits = 1024 + (last ? 0 : 64);
    int k = 0;
    for (;; ++k) {
        const int u = C.vcu + k * C.nb, cu = conv_in_fin(C.nb) + (C.nb - 1 - C.vcu) + k * C.nb;
        const bool a_on = u < nunits, c_on = cu < MT / 32;
        if (!a_on && !c_on) break;
        if (a_on) {
            const int bh = u < 1024 ? (u >> 4) : u - 1024, qblk = u < 1024 ? (u & 15) : 16, b = bh >> 3, hh = bh & 7;
            const int qpos = qblk * 256 + 32 * C.wave + r;
            const bf16* qp = QB + ((size_t)bh * KPOS + qpos) * 96 + 8 * h;
            bf16x8 qf[6];
#pragma unroll
            for (int kk = 0; kk < 6; ++kk) qf[kk] = *(const bf16x8*)(qp + 16 * kk);
            f32x16 o[2];
#pragma unroll
            for (int i = 0; i < 16; ++i) { o[0][i] = 0.f; o[1][i] = 0.f; }
            float l = 0.f;
            attn_tile_loop<96, false>(C, o, l, qf, KB + (size_t)bh * KPOS * 96, VT + (size_t)bh * 64 * KPOS, qblk < 16 ? 0 : TL, qblk < 16 ? KPOS / 64 : LCX / 64, 0, 0, nullptr, 0, 0, 0, 0);
            const int row = qblk < 16 ? b * TL + qpos : NLAT + b * LCX + (qpos - TL);
            flash_store(o, l, OCAT + (size_t)row * DM + hh * 64, h);
        }
        if (c_on) { float wk[31]; const float* dww = in_ptr(ws, I_DWW) + (size_t)lq * 31 * 512;
#pragma unroll
            for (int kt = 0; kt < 31; ++kt) wk[kt] = dww[kt * 512 + C.tid];
            conv_unit(C, cu, (const bf16*)(ws + WS_ARENA + A_U), wk, in_ptr(ws, I_DWB)[lq * 512 + C.tid], in_ptr(ws, I_LNG) + lq * 512, in_ptr(ws, I_LNB) + lq * 512, OCAT); }
    }
}
DI void ph_natten2(const Ctx& C, const bf16* QN, const bf16* KN, const bf16* VTN, bf16* OCAT, const float* rpb  , bool last, unsigned* work_ctr, unsigned char* ws, int lq) {
    const int r = C.lane & 31, h = C.lane >> 5;
    LAS float* tab = (LAS float*)(C.lds + 2 * AttnGeo<64>::BUF);
    LAS int* uslot = (LAS int*)(tab + 1920);
    const int nunits = 1024 + (last ? 0 : 64);
    for (;;) {
        __syncthreads();
        if (C.tid == 0) *uslot = (int)__hip_atomic_fetch_add(work_ctr, 1u, __ATOMIC_RELAXED, __HIP_MEMORY_SCOPE_AGENT);
        __syncthreads();
        const int u = *uslot;
        if (u >= nunits) break;
        const bool isctx = u >= 1024;
        const int bh = isctx ? u - 1024 : (u >> 4), b = bh >> 3, hh = bh & 7;
        for (int i = C.tid; i < 15 * 128; i += 512) { const int dc = (i & 127) - 48; tab[i] = (dc >= 0 && dc < 31) ? rpb[hh * 465 + (i >> 7) * 31 + dc] * LOG2E : 0.f; }
        int qpos, row, grow = 0, qc = 0, rs = 0, cs = 0, rlo = 0, nband = 0;
        if (!isctx) { const int rg = u & 15; grow = 4 * rg + (C.wave >> 1); qc = 32 * (C.wave & 1) + r; qpos = grow * 64 + qc; row = b * TL + qpos;
            rs = grow - 4; rs = rs < 0 ? 0 : (rs > 56 ? 56 : rs); cs = qc - 8; cs = cs < 0 ? 0 : (cs > 48 ? 48 : cs);
            rlo = 4 * rg - 4; rlo = rlo < 0 ? 0 : (rlo > 56 ? 56 : rlo); int rhi = 4 * rg + 3 - 4; rhi = rhi < 0 ? 0 : (rhi > 56 ? 56 : rhi); nband = rhi + 8 - rlo; }
        else { qpos = TL + 32 * C.wave + r; row = NLAT + b * LCX + 32 * C.wave + r; }
        const bf16* qp = QN + ((size_t)bh * KPOS + qpos) * 64 + 8 * h;
        bf16x8 qf[4];
#pragma unroll
        for (int kk = 0; kk < 4; ++kk) qf[kk] = *(const bf16x8*)(qp + 16 * kk);
        f32x16 o[2];
#pragma unroll
        for (int i = 0; i < 16; ++i) { o[0][i] = 0.f; o[1][i] = 0.f; }
        float l = 0.f;
        attn_tile_loop<64, true>(C, o, l, qf, KN + (size_t)bh * KPOS * 64, VTN + (size_t)bh * 64 * KPOS, rlo * 64, nband, TL, LCX / 64, tab, grow, rs, qc, cs);
        flash_store(o, l, OCAT + (size_t)row * DM + 512 + hh * 64, h);
    }
}


DI void ph_mla_fin(const Ctx& C, const bf16* __restrict__ U, const bf16* __restrict__ QPRE, const bf16* __restrict__ KVPRE, const float* __restrict__ qg, const float* __restrict__ kg, const f32x2* __restrict__ CS, bf16* __restrict__ QB, bf16* __restrict__ KB, bf16* __restrict__ VT) {
    LAS bf16* VL = (LAS bf16*)C.lds;
    const int lane = C.lane, j = lane >> 3, sub = lane & 7;
    const float C2 = 0.10206207261596575f * LOG2E;
    float qgn[8], qgr[4], kgn[8], kgr[4];
#pragma unroll
    for (int e = 0; e < 8; ++e) { qgn[e] = qg[8 * sub + e] * C2; kgn[e] = kg[8 * sub + e]; }
#pragma unroll
    for (int m = 0; m < 4; ++m) { qgr[m] = qg[64 + sub + 8 * m] * C2; kgr[m] = kg[64 + sub + 8 * m]; }
    for (int u = C.vcu; u < MT / 64; u += C.nb) {
        const int row0 = 64 * u, b = row0 < NLAT ? (row0 >> 12) : ((row0 - NLAT) >> 8), pos0 = row0 < NLAT ? (row0 & 4095) : TL + ((row0 - NLAT) & 255);
        const bool lat = row0 < NLAT;
        const int pl = 8 * C.wave + j, row = row0 + pl, pos = pos0 + pl;
        const bf16* ur = U + (size_t)row * EV_INP;
        float sq = 0.f, skv = 0.f;
#pragma unroll
        for (int m = 0; m < 6; ++m) { float x[8]; unpack8(*(const u32x4*)(ur + 8 * (sub + 8 * m)), x);
#pragma unroll
            for (int e = 0; e < 8; ++e) sq += x[e] * x[e]; }
#pragma unroll
        for (int m = 0; m < 4; ++m) { float x[8]; unpack8(*(const u32x4*)(ur + 384 + 8 * (sub + 8 * m)), x);
#pragma unroll
            for (int e = 0; e < 8; ++e) skv += x[e] * x[e]; }
        sq = sum8(sq); skv = sum8(skv);
        const float rsq = 1.0f / sqrtf(sq * (1.f / 384.f) + EPS), rskv = 1.0f / sqrtf(skv * (1.f / 256.f) + EPS);
        float krv[4];
#pragma unroll
        for (int m = 0; m < 4; ++m) krv[m] = bf2f(ur[640 + sub + 8 * m]);
        float cr = 1.f, sr = 0.f, cc = 1.f, sc = 0.f;
        if (lat) { const f32x2 a0 = CS[pos * 16 + sub], a1 = CS[pos * 16 + 8 + sub]; cr = a0.x; sr = a0.y; cc = a1.x; sc = a1.y; }
        const bf16* qrow = QPRE + (size_t)row * 768; const bf16* kvrow = KVPRE + (size_t)row * 1024;
#pragma unroll 2
        for (int hh = 0; hh < 8; ++hh) {
            { float qn[8], qr[4]; unpack8(*(const u32x4*)(qrow + hh * 96 + 8 * sub), qn); float ss = 0.f;
#pragma unroll
              for (int e = 0; e < 8; ++e) qn[e] *= rsq;
#pragma unroll
              for (int m = 0; m < 4; ++m) { qr[m] = bf2f(qrow[hh * 96 + 64 + sub + 8 * m]) * rsq; ss += qr[m] * qr[m]; }
#pragma unroll
              for (int e = 0; e < 8; ++e) ss += qn[e] * qn[e];
              const float rn = 1.0f / sqrtf(sum8(ss) * (1.f / 96.f) + EPS);
#pragma unroll
              for (int e = 0; e < 8; ++e) qn[e] *= rn * qgn[e];
#pragma unroll
              for (int m = 0; m < 4; ++m) qr[m] *= rn * qgr[m];
              { const float x0 = qr[0], x1 = qr[1], y0 = qr[2], y1 = qr[3]; qr[0] = x0 * cr - x1 * sr; qr[1] = x1 * cr + x0 * sr; qr[2] = y0 * cc - y1 * sc; qr[3] = y1 * cc + y0 * sc; }
              bf16* qo = QB + ((size_t)(b * 8 + hh) * KPOS + pos) * 96;
              *(u32x4*)(qo + 8 * sub) = pack8(qn);
#pragma unroll
              for (int m = 0; m < 4; ++m) qo[64 + sub + 8 * m] = f2bf(qr[m]); }
            { float kn[8], kr[4]; unpack8(*(const u32x4*)(kvrow + hh * 128 + 8 * sub), kn); float ss = 0.f;
#pragma unroll
              for (int e = 0; e < 8; ++e) kn[e] *= rskv;
#pragma unroll
              for (int m = 0; m < 4; ++m) { kr[m] = krv[m]; ss += kr[m] * kr[m]; }
#pragma unroll
              for (int e = 0; e < 8; ++e) ss += kn[e] * kn[e];
              const float rn = 1.0f / sqrtf(sum8(ss) * (1.f / 96.f) + EPS);
#pragma unroll
              for (int e = 0; e < 8; ++e) kn[e] *= rn * kgn[e];
#pragma unroll
              for (int m = 0; m < 4; ++m) kr[m] *= rn * kgr[m];
              { const float x0 = kr[0], x1 = kr[1], y0 = kr[2], y1 = kr[3]; kr[0] = x0 * cr - x1 * sr; kr[1] = x1 * cr + x0 * sr; kr[2] = y0 * cc - y1 * sc; kr[3] = y1 * cc + y0 * sc; }
              bf16* ko = KB + ((size_t)(b * 8 + hh) * KPOS + pos) * 96;
              *(u32x4*)(ko + 8 * sub) = pack8(kn);
#pragma unroll
              for (int m = 0; m < 4; ++m) ko[64 + sub + 8 * m] = f2bf(kr[m]); }
            { float vv[8]; unpack8(*(const u32x4*)(kvrow + hh * 128 + 64 + 8 * sub), vv);
#pragma unroll
              for (int e = 0; e < 8; ++e) VL[(hh * 64 + 8 * sub + e) * 64 + pl] = f2bf(vv[e] * rskv); }
        }
        __syncthreads();
        { const int hd = C.tid;
            bf16* dst = VT + ((size_t)(b * 8 + (hd >> 6)) * 64 + (hd & 63)) * KPOS + pos0;
#pragma unroll
            for (int q = 0; q < 8; ++q) *(u32x4*)(dst + 8 * q) = *(const LAS u32x4*)(VL + hd * 64 + 8 * q); }
        __syncthreads();
    }
}

DI void conv_unit(const Ctx& C, int u, const bf16* __restrict__ U, const float (&wk)[31], float bias, const float* __restrict__ lng, const float* __restrict__ lnb, bf16* __restrict__ OCAT) {
    LAS float* G = (LAS float*)C.lds;
    const int c = C.tid;
    const int row0 = 32 * u; int base, t0, tseq;
    if (row0 < NLAT) { base = row0 & ~4095; t0 = row0 & 4095; tseq = TL; } else { const int rc = row0 - NLAT; base = NLAT + (rc & ~255); t0 = rc & 255; tseq = LCX; }
    __syncthreads();
    for (int rr = C.wave; rr < 62; rr += 8) { const int tt = t0 - 15 + rr; float g[8];
#pragma unroll
        for (int e = 0; e < 8; ++e) g[e] = 0.f;
        if (tt >= 0 && tt < tseq) { const bf16* ur = U + (size_t)(base + tt) * EV_INP; float av[8], gv[8]; unpack8(*(const u32x4*)(ur + 672 + 8 * C.lane), av); unpack8(*(const u32x4*)(ur + 1184 + 8 * C.lane), gv);
#pragma unroll
            for (int e = 0; e < 8; ++e) g[e] = av[e] * sigmoidf_(gv[e]); }
        *(LAS f32x4*)(G + rr * 512 + 8 * C.lane) = (f32x4){g[0], g[1], g[2], g[3]}; *(LAS f32x4*)(G + rr * 512 + 8 * C.lane + 4) = (f32x4){g[4], g[5], g[6], g[7]}; }
    __syncthreads();
    float acc[32];
#pragma unroll
    for (int t = 0; t < 32; ++t) acc[t] = bias;
#pragma unroll
    for (int rr = 0; rr < 62; ++rr) { const float gv = G[rr * 512 + c];
#pragma unroll
        for (int t = 0; t < 32; ++t) { const int k = rr - t; if (k >= 0 && k < 31) acc[t] += gv * wk[k]; } }
    __syncthreads();
#pragma unroll
    for (int t = 0; t < 32; ++t) G[t * 512 + c] = acc[t];
    __syncthreads();
#pragma unroll
    for (int q = 0; q < 4; ++q) {
        const int t = 4 * C.wave + q, row = row0 + t;
        const f32x4 a0 = *(const LAS f32x4*)(G + t * 512 + 8 * C.lane), a1 = *(const LAS f32x4*)(G + t * 512 + 8 * C.lane + 4);
        float x[8] = {a0.x, a0.y, a0.z, a0.w, a1.x, a1.y, a1.z, a1.w}; float s = 0.f;
#pragma unroll
        for (int e = 0; e < 8; ++e) s += x[e];
        const float mu = wave_sum(s) * (1.f / 512.f); float s2 = 0.f;
#pragma unroll
        for (int e = 0; e < 8; ++e) { x[e] -= mu; s2 += x[e] * x[e]; }
        const float rstd = 1.0f / sqrtf(wave_sum(s2) * (1.f / 512.f) + EPS);
        float y[8];
#pragma unroll
        for (int e = 0; e < 8; ++e) { const float z = x[e] * rstd * lng[8 * C.lane + e] + lnb[8 * C.lane + e]; y[e] = siluf_(z); }
        *(u32x4*)(OCAT + (size_t)row * DM + 512 + 8 * C.lane) = pack8(y);
    }
    __syncthreads();
}
DI void wprep_span(const Ctx& C, int first, int stride, const float* w1, const float* w3, const float* w2, bf16* W13, bf16* W2) {
    LAS float* scr = (LAS float*)(C.lds + C.wave * 16640);
    constexpr int PER = 16 * 16, NIT = NEXP * 3 * PER;
    for (int it = first; it < NIT; it += stride) {
        const int e = it / (3 * PER), r = it % (3 * PER), which = r / PER, q = r % PER, kb = q / 16, n0 = (q % 16) * 64;
#if MOE_F8
        if (which == 0)      transpose_item64_f8(w1 + (size_t)e * DM * DM, DM, DM, (unsigned char*)W13 + (size_t)e * 2048 * DM, (n0 >> 7) * 256 + (n0 & 127), scr, kb * 64, n0, C.lane);
        else if (which == 1) transpose_item64_f8(w3 + (size_t)e * DM * DM, DM, DM, (unsigned char*)W13 + (size_t)e * 2048 * DM, (n0 >> 7) * 256 + (n0 & 127) + 128, scr, kb * 64, n0, C.lane);
        else                 transpose_item64_f8(w2 + (size_t)e * DM * DM, DM, DM, (unsigned char*)W2 + (size_t)e * DM * DM, n0, scr, kb * 64, n0, C.lane); }
#else
        if (which == 0)      transpose_item64(w1 + (size_t)e * DM * DM, DM, DM, W13 + (size_t)e * 2048 * DM, (n0 >> 7) * 256 + (n0 & 127), scr, kb * 64, n0, C.lane);
        else if (which == 1) transpose_item64(w3 + (size_t)e * DM * DM, DM, DM, W13 + (size_t)e * 2048 * DM, (n0 >> 7) * 256 + (n0 & 127) + 128, scr, kb * 64, n0, C.lane);
        else                 transpose_item64(w2 + (size_t)e * DM * DM, DM, DM, W2 + (size_t)e * DM * DM, n0, scr, kb * 64, n0, C.lane); }
#endif
}
constexpr int WPREP_PER_WAVE = (NEXP * 3 * 256 + 2047) / 2048;

DI void shifted8(const bf16* __restrict__ up, const bf16* __restrict__ uc, const bf16* __restrict__ un, bool hp, bool hn, const float (&s0)[8], const float (&s1)[8], const float (&s2)[8], int c0, float (&o)[8]) {
    const u32x4 z = {0u, 0u, 0u, 0u};
    const u32x4 vp = hp ? *(const u32x4*)(up + c0) : z, vc = *(const u32x4*)(uc + c0), vn = hn ? *(const u32x4*)(un + c0) : z;
    float p[8], c[8], n[8]; unpack8(vp, p); unpack8(vc, c); unpack8(vn, n);
#pragma unroll
    for (int e = 0; e < 8; ++e) o[e] = p[e] * s0[e] + c[e] * s1[e] + n[e] * s2[e];
}
DI void load_sw(const float* sw, int c0, float (&s0)[8], float (&s1)[8], float (&s2)[8]) {
#pragma unroll
    for (int e = 0; e < 8; ++e) { s0[e] = sw[c0 + e]; s1[e] = sw[RW_IN + c0 + e]; s2[e] = sw[2 * RW_IN + c0 + e]; }
}
DI void ph_prep(const Ctx& C, const bf16* __restrict__ U, const float* __restrict__ sw  , const float* __restrict__ kkw  , const float* __restrict__ naqg, const float* __restrict__ nakg,
                bf16* __restrict__ R, bf16* __restrict__ V, bf16* __restrict__ K, bf16* __restrict__ KK, bf16* __restrict__ L, bf16* __restrict__ QN, bf16* __restrict__ KN, bf16* __restrict__ VTN) {
    LAS bf16* VL = (LAS bf16*)C.lds;
    const int lane = C.lane, hh = lane >> 3, sub = lane & 7;
    const float C2 = 0.125f * LOG2E;
    for (int u = C.vcu; u < MT / 32; u += C.nb) {
        const int row0 = 32 * u; const bool lat = row0 < NLAT;
        const int b = lat ? (row0 >> 12) : ((row0 - NLAT) >> 8), pos0 = lat ? (row0 & 4095) : TL + ((row0 - NLAT) & 255), tseq = lat ? TL : LCX, tb = lat ? (row0 & 4095) : ((row0 - NLAT) & 255);
#define PREP_ROWVARS(i) const int pl = 4 * C.wave + (i), row = row0 + pl, t = tb + pl; const bool hp = t > 0, hn = t < tseq - 1; \
            const bf16* uc = U + (size_t)row * OD_INP; const bf16* up = uc - OD_INP; const bf16* un = uc + OD_INP
        { float s0[8], s1[8], s2[8]; load_sw(sw, 8 * lane, s0, s1, s2);
          _Pragma("unroll") for (int i = 0; i < 4; ++i) { PREP_ROWVARS(i); float o[8]; shifted8(up, uc, un, hp, hn, s0, s1, s2, 8 * lane, o); *(u32x4*)(R + (size_t)row * 512 + 8 * lane) = pack8(o); } }
        { float s0[8], s1[8], s2[8]; load_sw(sw, 1024 + 8 * lane, s0, s1, s2);
          _Pragma("unroll") for (int i = 0; i < 4; ++i) { PREP_ROWVARS(i); float o[8]; shifted8(up, uc, un, hp, hn, s0, s1, s2, 1024 + 8 * lane, o); *(u32x4*)(V + (size_t)row * 512 + 8 * lane) = pack8(o); } }
        { float s0[8], s1[8], s2[8]; load_sw(sw, 512 + 8 * lane, s0, s1, s2); float kw[8];
#pragma unroll
          for (int e = 0; e < 8; ++e) kw[e] = kkw[8 * lane + e];
          _Pragma("unroll") for (int i = 0; i < 4; ++i) { PREP_ROWVARS(i); float o[8]; shifted8(up, uc, un, hp, hn, s0, s1, s2, 512 + 8 * lane, o); *(u32x4*)(K + (size_t)row * 512 + 8 * lane) = pack8(o);
              float kk[8]; float ss = 0.f;
#pragma unroll
              for (int e = 0; e < 8; ++e) { kk[e] = o[e] * kw[e]; ss += kk[e] * kk[e]; }
              ss = sum8(ss); const float rn = 1.0f / sqrtf(ss + 1e-12f);
#pragma unroll
              for (int e = 0; e < 8; ++e) kk[e] *= rn;
              *(u32x4*)(KK + (size_t)row * 512 + 8 * lane) = pack8(kk); } }
        if (lane < 48) { float s0[8], s1[8], s2[8]; load_sw(sw, 1536 + 8 * lane, s0, s1, s2);
          _Pragma("unroll") for (int i = 0; i < 4; ++i) { PREP_ROWVARS(i); float o[8]; shifted8(up, uc, un, hp, hn, s0, s1, s2, 1536 + 8 * lane, o);
              if (lane < 16) {
#pragma unroll
                  for (int e = 0; e < 8; ++e) { const float ex = __expf(2.f * o[e]); o[e] = 1.f - 2.f * __builtin_amdgcn_rcpf(ex + 1.f); }
              } else if (lane >= 32) {
#pragma unroll
                  for (int e = 0; e < 8; ++e) o[e] = sigmoidf_(o[e]);
              }
              *(u32x4*)(L + (size_t)row * 384 + 8 * lane) = pack8(o); } }
        { float gq[8], gk[8];
#pragma unroll
          for (int e = 0; e < 8; ++e) { gq[e] = naqg[8 * sub + e] * C2; gk[e] = nakg[8 * sub + e]; }
          _Pragma("unroll") for (int i = 0; i < 4; ++i) { const int pl = 4 * C.wave + i, row = row0 + pl, pos = pos0 + pl; const bf16* uc = U + (size_t)row * OD_INP;
            { float x[8]; unpack8(*(const u32x4*)(uc + RW_IN + 8 * lane), x); float ss = 0.f;
#pragma unroll
                for (int e = 0; e < 8; ++e) ss += x[e] * x[e];
                ss = sum8(ss); const float rn = 1.0f / sqrtf(ss * (1.f / 64.f) + EPS);
#pragma unroll
                for (int e = 0; e < 8; ++e) x[e] = x[e] * rn * gq[e];
                *(u32x4*)(QN + ((size_t)(b * 8 + hh) * KPOS + pos) * 64 + 8 * sub) = pack8(x); }
            { float x[8]; unpack8(*(const u32x4*)(uc + RW_IN + 512 + 8 * lane), x); float ss = 0.f;
#pragma unroll
                for (int e = 0; e < 8; ++e) ss += x[e] * x[e];
                ss = sum8(ss); const float rn = 1.0f / sqrtf(ss * (1.f / 64.f) + EPS);
#pragma unroll
                for (int e = 0; e < 8; ++e) x[e] = x[e] * rn * gk[e];
                *(u32x4*)(KN + ((size_t)(b * 8 + hh) * KPOS + pos) * 64 + 8 * sub) = pack8(x); }
            { const u32x4 vv = *(const u32x4*)(uc + RW_IN + 1024 + 8 * lane); const unsigned w4[4] = {vv.x, vv.y, vv.z, vv.w};
#pragma unroll
                for (int e = 0; e < 8; ++e) { const int dv = 8 * sub + e; VL[(hh * 64 + dv) * 32 + pl] = (bf16)((e & 1) ? (w4[e >> 1] >> 16) : (w4[e >> 1] & 0xffffu)); } } } }
#undef PREP_ROWVARS
        __syncthreads();
        { const int hd = C.tid; bf16* dst = VTN + ((size_t)(b * 8 + (hd >> 6)) * 64 + (hd & 63)) * KPOS + pos0;
#pragma unroll
            for (int q = 0; q < 4; ++q) *(u32x4*)(dst + 8 * q) = *(const LAS u32x4*)(VL + hd * 32 + 8 * q); }
        __syncthreads();
    }
}

DI int scan_row(int s, int d, int b) { if (s < LCX) return NLAT + b * LCX + (d ? (LCX - 1 - s) : s); const int t = s - LCX; return b * TL + (d ? (TL - 1 - t) : t); }


constexpr int CCH = 16, NCHK = KPOS / CCH, NPROB = NB * 8 * 2 * NCHK, IMG_ELEMS = 3 * 32 * 16;
template <int N> struct ICk { static constexpr int value = N; };
DI int crow_(int reg, int h) { return (reg & 3) + 8 * (reg >> 2) + 4 * h; }
DI bf16x8 pack_lo8(const f32x16& x) {
    u32x4 p; p.x = pk2(x[0], x[1]); p.y = pk2(x[2], x[3]); p.z = pk2(x[4], x[5]); p.w = pk2(x[6], x[7]); return __builtin_bit_cast(bf16x8, p); }
DI bf16x8 pack_hi8(const f32x16& x) { u32x4 p; p.x = pk2(x[8], x[9]); p.y = pk2(x[10], x[11]); p.z = pk2(x[12], x[13]); p.w = pk2(x[14], x[15]); return __builtin_bit_cast(bf16x8, p); }
DI int perm16(int k) { return (k & ~15) | swap23(k & 15); }

DI void ph_wkv_pre(const Ctx& C, const bf16* __restrict__ R, const bf16* __restrict__ K, const bf16* __restrict__ KK, const unsigned short* __restrict__ LW, const bf16* __restrict__ AR_, const float* __restrict__ ka, bf16* __restrict__ IMG) {
    LAS unsigned char* wl = C.lds + C.wave * 13312;
    LAS bf16* ARl = (LAS bf16*)wl; LAS bf16* BKl = (LAS bf16*)(wl + 4608); LAS float* Ll = (LAS float*)(wl + 9216); LAS bf16* OUT = (LAS bf16*)(wl + 10240);
    const int lane = C.lane, r = lane & 31, h = lane >> 5;
    const int gw = C.vcu * 8 + C.wave, ngw = C.nb * 8;
    for (int p = gw; p < NPROB; p += ngw) {
        const int j = p % NCHK, rest = p / NCHK, d = rest & 1, hh = (rest >> 1) & 7, b = rest >> 4;
        const unsigned short* Wd = LW + (size_t)d * MT * 512; const bf16* Ad = AR_ + (size_t)d * MT * 512;
        const float kav = ka[hh * 64 + lane];
        const int row0 = scan_row(j * CCH, d, b), sg = d ? -1 : 1;
        float lw[16]; bf16 rr[16], kx[16], kkx[16], ax[16];
#pragma unroll
        for (int t = 0; t < 16; ++t) { const size_t off = (size_t)(row0 + sg * t) * 512 + hh * 64 + lane; lw[t] = h2f(Wd[off]); rr[t] = R[off]; kx[t] = K[off]; kkx[t] = KK[off]; ax[t] = Ad[off]; }
        float cum = 0.f, e0 = 1.f;
#pragma unroll
        for (int t = 0; t < 16; ++t) {
            cum += lw[t]; const float e1 = __expf(cum), ei = __builtin_amdgcn_rcpf(e1);
            const float kkv = bf2f(kkx[t]), av = bf2f(ax[t]), keff = bf2f(kx[t]) * (1.f + (av - 1.f) * kav);
            ARl[t * 72 + lane] = f2bf(-kkv * e0); ARl[(16 + t) * 72 + lane] = f2bf(bf2f(rr[t]) * e1);
            BKl[t * 72 + lane] = f2bf(kkv * av * ei); BKl[(16 + t) * 72 + lane] = f2bf(keff * ei);
            e0 = e1;
        }
        asm volatile("s_waitcnt lgkmcnt(0)" ::: "memory");
        f32x16 g;
#pragma unroll
        for (int i = 0; i < 16; ++i) g[i] = 0.f;
#pragma unroll
        for (int q = 0; q < 4; ++q) g = MFMA32(*(const LAS bf16x8*)(ARl + r * 72 + 16 * q + 8 * h), *(const LAS bf16x8*)(BKl + r * 72 + 16 * q + 8 * h), g);
        const int sI = r & 15; const bool isk = r >= 16;
#pragma unroll
        for (int i = 0; i < 16; ++i) {
            const int row = crow_(i, h), t = row & 15; const bool keep = (i < 8) ? (sI < t) : (sI <= t); const float val = keep ? g[i] : 0.f;
            if (i < 8) { if (!isk) { Ll[t * 16 + sI] = val; OUT[512 + row * 16 + perm16(sI)] = 0; } else OUT[row * 16 + sI] = f2bf(val); }
            else       { if (!isk) OUT[512 + row * 16 + perm16(sI)] = f2bf(val); else OUT[row * 16 + sI] = f2bf(val); }
        }
        asm volatile("s_waitcnt lgkmcnt(0)" ::: "memory");
        { const int c = lane & 15; float Pr[16];
            Pr[0] = (c == 0) ? 1.f : 0.f;
#pragma unroll
            for (int t = 1; t < 16; ++t) { const float lrow = Ll[t * 16 + c]; float acc = (c == t) ? 1.f : 0.f;
#pragma unroll
                for (int u = 0; u < t; ++u) acc += rdlane(lrow, u) * Pr[u];
                Pr[t] = acc; }
            if (lane < 16) {
#pragma unroll
                for (int t = 0; t < 16; ++t) { OUT[1024 + t * 16 + perm16(c)] = f2bf(Pr[t]); OUT[1024 + (16 + t) * 16 + c] = 0; } } }
        asm volatile("s_waitcnt lgkmcnt(0)" ::: "memory");
        { bf16* dst = IMG + (size_t)p * IMG_ELEMS;
#pragma unroll
            for (int q = 0; q < 3; ++q) *(u32x4*)(dst + (q * 64 + lane) * 8) = *(const LAS u32x4*)(OUT + (q * 64 + lane) * 8); }
        asm volatile("s_waitcnt lgkmcnt(0)" ::: "memory");
    }
}

DI void ph_wkv_chunk(const Ctx& C, const bf16* R, const bf16* V, const bf16* K, const bf16* KK, const unsigned short* LW, const bf16* AR_, const float* ka, const bf16* IMG, bf16* YS) {
    constexpr int S_AR = 0, S_BKT = 4608, S_VT = 9728, S_VT2 = 11264, S_GC = 12800, S_MM = 13056, S_MRB = 14592, S_PP = 16128, SLOT = 17664, CUMO = 2 * SLOT, YSTO = CUMO + 8192, DEPTH = 4;
    const int lane = C.lane, wv = C.wave, r = lane & 31, h = lane >> 5;
    const bool isE = wv == 2 || wv == 3 || wv == 6 || wv == 7, isS = wv < 2;
    const int te = (wv == 2 ? 0 : (wv == 3 ? 1 : (wv == 6 ? 2 : 3))) * 64 + lane, et = te >> 4, ekq = te & 15;
    const int vhf = te >> 7, vt = (te >> 3) & 15, viq = te & 7;
    const int hf = wv & 1;
    for (int cid0 = C.bid; cid0 < 128; cid0 += C.nb) {
        const int chain = cid0, b = chain >> 4, hh = (chain >> 1) & 7, d = chain & 1;
        const unsigned short* Wd = LW + (size_t)d * MT * 512; const bf16* Ad = AR_ + (size_t)d * MT * 512; bf16* Yd = YS + (size_t)d * MT * 512;
        const bf16* img = IMG + (size_t)(((b * 8 + hh) * 2 + d) * NCHK) * IMG_ELEMS;
        f32x16 ST[2];
#pragma unroll
        for (int i = 0; i < 16; ++i) { ST[0][i] = 0.f; ST[1][i] = 0.f; }
        const f32x4 kav = *(const f32x4*)(ka + hh * 64 + 4 * ekq);
        unsigned ring[DEPTH][16];
        __syncthreads();
        auto issue = [&](int ch, unsigned (&rg)[16]) __attribute__((always_inline)) {
            if (ch < 0 || ch >= NCHK) return;
            const int row0 = scan_row(ch * CCH, d, b), sg = d ? -1 : 1;
            if (isE) {
                const size_t off = (size_t)(row0 + sg * et) * 512 + hh * 64 + 4 * ekq;
                const u32x2 x0 = *(const u32x2*)(R + off), x1 = *(const u32x2*)(K + off), x2 = *(const u32x2*)(KK + off), x3 = *(const u32x2*)(Ad + off);
                const u32x2 x4 = *(const u32x2*)(V + (size_t)(row0 + sg * vt) * 512 + hh * 64 + 32 * vhf + 4 * viq);
                rg[0] = x0.x; rg[1] = x0.y; rg[2] = x1.x; rg[3] = x1.y; rg[4] = x2.x; rg[5] = x2.y; rg[6] = x3.x; rg[7] = x3.y; rg[8] = x4.x; rg[9] = x4.y;
                asm volatile("; wkv issue role E" ::);
            } else if (wv == 4) {
#define W5_(t) rg[(t)] = (unsigned)Wd[(size_t)(row0 + sg * (t)) * 512 + hh * 64 + lane]
                W5_(0); W5_(1); W5_(2); W5_(3); W5_(4); W5_(5); W5_(6); W5_(7); W5_(8); W5_(9); W5_(10); W5_(11); W5_(12); W5_(13); W5_(14); W5_(15);
#undef W5_
                asm volatile("; wkv issue role C" ::);
            } else if (wv == 5) {
#define W6_(q) do { const u32x4 x = *(const u32x4*)(img + (size_t)ch * IMG_ELEMS + ((q) * 64 + lane) * 8); rg[4 * (q)] = x.x; rg[4 * (q) + 1] = x.y; rg[4 * (q) + 2] = x.z; rg[4 * (q) + 3] = x.w; } while (0)
                W6_(0); W6_(1); W6_(2);
#undef W6_
                asm volatile("; wkv issue role V" ::);
            }
        };
        issue(0, ring[0]); issue(1, ring[1]); issue(2, ring[2]); issue(3, ring[3]);
#define WKV_BAR() asm volatile("s_waitcnt lgkmcnt(0)\n\ts_barrier" ::: "memory")
#define WKV_LOOP(...) for (int n0 = -2; n0 < NCHK; n0 += DEPTH) { auto iter = [&](auto kc) __attribute__((always_inline)) { constexpr int kk = decltype(kc)::value; \
            constexpr int riE = (kk + 3) % DEPTH, riW = kk % DEPTH; (void)riE; (void)riW; const int n = n0 + kk; (void)n; __VA_ARGS__; WKV_BAR(); }; iter(ICk<0>{}); iter(ICk<1>{}); iter(ICk<2>{}); iter(ICk<3>{}); }
        if (isS) {
            WKV_LOOP({
                if (n >= 0 && n < NCHK) {
                    const LAS unsigned char* B = C.lds + (n & 1) * SLOT;
                    f32x16 T1;
                    _Pragma("unroll") for (int i = 0; i < 16; ++i) T1[i] = 0.f;
                    _Pragma("unroll") for (int tau = 0; tau < 2; ++tau) {
                        T1 = MFMA32(*(const LAS bf16x8*)(B + S_AR + r * 144 + (32 * tau + 8 * h) * 2), pack_lo8(ST[tau]), T1);
                        T1 = MFMA32(*(const LAS bf16x8*)(B + S_AR + r * 144 + (32 * tau + 16 + 8 * h) * 2), pack_hi8(ST[tau]), T1);
                    }
                    const bf16x8 vtf = *(const LAS bf16x8*)(B + (hf ? S_VT2 : S_VT) + r * 48 + 16 * h);
                    T1 = MFMA32(*(const LAS bf16x8*)(B + S_MM + r * 48 + 16 * h), vtf, T1);
                    f32x16 ET;
                    _Pragma("unroll") for (int i = 0; i < 16; ++i) ET[i] = 0.f;
                    ET = MFMA32(*(const LAS bf16x8*)(B + S_PP + r * 48 + 16 * h), pack_lo8(T1), ET);
                    const bf16x8 ef = pack_lo8(ET);
                    T1 = MFMA32(*(const LAS bf16x8*)(B + S_MRB + r * 48 + 16 * h), ef, T1);
                    _Pragma("unroll") for (int tau = 0; tau < 2; ++tau) {
                        ST[tau] = MFMA32(*(const LAS bf16x8*)(B + S_BKT + (32 * tau + r) * 80 + 16 * h), ef, ST[tau]);
                        ST[tau] = MFMA32(*(const LAS bf16x8*)(B + S_BKT + (32 * tau + r) * 80 + 32 + 16 * h), vtf, ST[tau]);
                        _Pragma("unroll") for (int g4 = 0; g4 < 4; ++g4) { const f32x4 gc = *(const LAS f32x4*)(B + S_GC + (32 * tau + 8 * g4 + 4 * h) * 4);
                            ST[tau][4 * g4] *= gc.x; ST[tau][4 * g4 + 1] *= gc.y; ST[tau][4 * g4 + 2] *= gc.z; ST[tau][4 * g4 + 3] *= gc.w; }
                    }
                    LAS float* ys = (LAS float*)(C.lds + YSTO) + ((n & 1) * 2 + hf) * 512;
                    _Pragma("unroll") for (int q = 0; q < 8; ++q) ys[(8 * (q >> 2) + 4 * h + (q & 3)) * 32 + r] = T1[8 + q];
                }
            });
        } else if (isE) {
            WKV_LOOP({
                const int ch = n + 1;
                if (ch >= 0) {
                    if (ch < NCHK) {
                        LAS unsigned char* B = C.lds + (ch & 1) * SLOT; const LAS float* ec = (const LAS float*)(C.lds + CUMO) + (ch & 1) * 1024;
                        const f32x4 e1 = *(const LAS f32x4*)(ec + et * 64 + 4 * ekq);
                        f32x4 e0 = {1.f, 1.f, 1.f, 1.f}; if (et > 0) e0 = *(const LAS f32x4*)(ec + (et - 1) * 64 + 4 * ekq);
                        const float rv[4] = {bflo(ring[riE][0]), bfhi(ring[riE][0]), bflo(ring[riE][1]), bfhi(ring[riE][1])}; const float kv[4] = {bflo(ring[riE][2]), bfhi(ring[riE][2]), bflo(ring[riE][3]), bfhi(ring[riE][3])};
                        const float kkv[4] = {bflo(ring[riE][4]), bfhi(ring[riE][4]), bflo(ring[riE][5]), bfhi(ring[riE][5])}; const float av[4] = {bflo(ring[riE][6]), bfhi(ring[riE][6]), bflo(ring[riE][7]), bfhi(ring[riE][7])};
                        float ah[4]; float rh[4]; float bc[4]; float kc4[4];
                        _Pragma("unroll") for (int e = 0; e < 4; ++e) { const float ei = __builtin_amdgcn_rcpf(e1[e]);
                            ah[e] = -kkv[e] * e0[e]; rh[e] = rv[e] * e1[e]; bc[e] = kkv[e] * av[e] * ei; kc4[e] = kv[e] * (1.f + (av[e] - 1.f) * kav[e]) * ei; }
                        const int pk = perm16(4 * ekq);
                        *(LAS u32x2*)((LAS bf16*)(B + S_AR) + et * 72 + pk) = (u32x2){pk2(ah[0], ah[1]), pk2(ah[2], ah[3])};
                        *(LAS u32x2*)((LAS bf16*)(B + S_AR) + (16 + et) * 72 + pk) = (u32x2){pk2(rh[0], rh[1]), pk2(rh[2], rh[3])};
                        const int pt = perm16(et);
                        _Pragma("unroll") for (int e = 0; e < 4; ++e) { ((LAS bf16*)(B + S_BKT))[(4 * ekq + e) * 40 + pt] = f2bf(bc[e]); ((LAS bf16*)(B + S_BKT))[(4 * ekq + e) * 40 + 16 + et] = f2bf(kc4[e]); }
                        if (et == 15) *(LAS f32x4*)((LAS float*)(B + S_GC) + 4 * ekq) = e1;
                        LAS bf16* vtp = (LAS bf16*)(B + (vhf ? S_VT2 : S_VT)) + (4 * viq) * 24 + vt;
                        vtp[0] = (bf16)(ring[riE][8] & 0xffffu); vtp[24] = (bf16)(ring[riE][8] >> 16); vtp[48] = (bf16)(ring[riE][9] & 0xffffu); vtp[72] = (bf16)(ring[riE][9] >> 16);
                    }
                    issue(ch + DEPTH, ring[riE]);
                }
            });
        } else if (wv == 4) {
            WKV_LOOP({
                const int ch = n + 2;
                if (ch < NCHK) { LAS float* ec = (LAS float*)(C.lds + CUMO) + (ch & 1) * 1024; float c = 0.f;
#define C5_(t) do { c += h2f((unsigned short)ring[riW][(t)]); ec[(t) * 64 + lane] = __expf(c); } while (0)
                    C5_(0); C5_(1); C5_(2); C5_(3); C5_(4); C5_(5); C5_(6); C5_(7); C5_(8); C5_(9); C5_(10); C5_(11); C5_(12); C5_(13); C5_(14); C5_(15);
                }
                issue(ch + DEPTH, ring[riW]);
            });
        } else {
            WKV_LOOP({
                { const int chy = n - 1;
                  if (chy >= 0 && chy < NCHK) { const int yh = lane >> 5, yt = (lane & 31) >> 1, yi = 16 * (lane & 1);
                    const LAS float* ys = (const LAS float*)(C.lds + YSTO) + ((chy & 1) * 2 + yh) * 512 + yt * 32 + yi;
                    bf16* dst = Yd + (size_t)(scan_row(chy * CCH, d, b) + (d ? -1 : 1) * yt) * 512 + hh * 64 + 32 * yh + yi;
                    _Pragma("unroll") for (int q = 0; q < 2; ++q) { const f32x4 a0 = *(const LAS f32x4*)(ys + 8 * q); const f32x4 a1 = *(const LAS f32x4*)(ys + 8 * q + 4);
                        *(u32x4*)(dst + 8 * q) = (u32x4){pk2(a0.x, a0.y), pk2(a0.z, a0.w), pk2(a1.x, a1.y), pk2(a1.z, a1.w)}; } } }
                const int ch = n + 1;
                if (ch >= 0) {
                    if (ch < NCHK) { LAS unsigned char* B = C.lds + (ch & 1) * SLOT;
                        const int irow = lane >> 1; const int ihv = lane & 1;
                        *(LAS u32x4*)(B + S_MM + irow * 48 + ihv * 16) = (u32x4){ring[riE][0], ring[riE][1], ring[riE][2], ring[riE][3]};
                        *(LAS u32x4*)(B + S_MRB + irow * 48 + ihv * 16) = (u32x4){ring[riE][4], ring[riE][5], ring[riE][6], ring[riE][7]};
                        *(LAS u32x4*)(B + S_PP + irow * 48 + ihv * 16) = (u32x4){ring[riE][8], ring[riE][9], ring[riE][10], ring[riE][11]};
                    }
                    issue(ch + DEPTH, ring[riE]);
                }
            });
        }
#undef C5_
#undef WKV_LOOP
#undef WKV_BAR
    }
}

DI void ph_post(const Ctx& C, const bf16* __restrict__ YS, const bf16* __restrict__ R, const bf16* __restrict__ V, const bf16* __restrict__ K, const bf16* __restrict__ A2, const float* __restrict__ ka, const bf16* __restrict__ G, const float* __restrict__ rk, const float* __restrict__ gng, const float* __restrict__ gnb, bf16* __restrict__ OCAT, bool last) {
    const int gw = C.bid * 8 + C.wave, ngw = C.nb * 8, lane = C.lane, nrows = last ? NLAT : MT;
#pragma unroll 2
    for (int row = gw; row < nrows; row += ngw) {
        const size_t o = (size_t)row * 512 + 8 * lane;
        float y[8], y1[8]; unpack8(*(const u32x4*)(YS + o), y); unpack8(*(const u32x4*)(YS + (size_t)MT * 512 + o), y1);
#pragma unroll
        for (int e = 0; e < 8; ++e) y[e] += y1[e];
        float r[8], v[8], kx[8], a0[8], a1[8], g[8];
        unpack8(*(const u32x4*)(R + o), r); unpack8(*(const u32x4*)(V + o), v); unpack8(*(const u32x4*)(K + o), kx); unpack8(*(const u32x4*)(A2 + o), a0); unpack8(*(const u32x4*)(A2 + (size_t)MT * 512 + o), a1); unpack8(*(const u32x4*)(G + o), g);
        float bsum = 0.f;
#pragma unroll
        for (int e = 0; e < 8; ++e) { const float kae = ka[8 * lane + e]; bsum += r[e] * (kx[e] * (1.f + (a0[e] - 1.f) * kae) + kx[e] * (1.f + (a1[e] - 1.f) * kae)) * rk[8 * lane + e]; }
        bsum = sum8(bsum);
        float s = 0.f;
#pragma unroll
        for (int e = 0; e < 8; ++e) { y[e] += bsum * v[e]; s += y[e]; }
        const float mu = sum8(s) * (1.f / 64.f); float s2 = 0.f;
#pragma unroll
        for (int e = 0; e < 8; ++e) { y[e] -= mu; s2 += y[e] * y[e]; }
        const float rstd = 1.0f / sqrtf(sum8(s2) * (1.f / 64.f) + GN_EPS);
        float out[8];
#pragma unroll
        for (int e = 0; e < 8; ++e) out[e] = (y[e] * rstd * gng[8 * lane + e] + gnb[8 * lane + e]) * g[e];
        *(u32x4*)(OCAT + (size_t)row * DM + 8 * lane) = pack8(out);
    }
}

DI void ph_topk2(const Ctx& C, const float* AFFT, const float* AFFC, int* ROWS, float* GATE, int* SLOT, bool last) {
    LAS unsigned* wcnt = (LAS unsigned*)C.lds;
    LAS unsigned* cnt = wcnt + 16;
    const int tid = C.tid, nprob = last ? 128 : 256;
    for (int p = C.bid; p < nprob; p += C.nb) {
        const bool isctx = p >= 128; const int be = p & 127, b = be >> 4, e = be & 15;
        const int n = isctx ? LCX : TL, cap = isctx ? CAPC : CAPL;
        const float* src = isctx ? AFFC + (size_t)be * LCX : AFFT + (size_t)be * TL;
        unsigned v[8]; const int per = isctx ? 1 : 8, t0 = tid * per;
#pragma unroll
        for (int q = 0; q < 8; ++q) v[q] = 0u;
        if (!isctx) { const u32x4 a0 = *(const u32x4*)(src + t0), a1 = *(const u32x4*)(src + t0 + 4); v[0] = a0.x; v[1] = a0.y; v[2] = a0.z; v[3] = a0.w; v[4] = a1.x; v[5] = a1.y; v[6] = a1.z; v[7] = a1.w; }
        else if (tid < LCX) v[0] = __builtin_bit_cast(unsigned, src[tid]);
        __syncthreads();
        unsigned T = 0u;
        for (int bit = 30; bit >= 0; --bit) {
            const unsigned cand = T | (1u << bit); unsigned c = 0u;
#pragma unroll
            for (int q = 0; q < 8; ++q) c += (unsigned)__builtin_popcountll(__builtin_amdgcn_ballot_w64(v[q] >= cand));
            LAS unsigned* wc = wcnt + (bit & 1) * 8;
            if (C.lane == 0) wc[C.wave] = c;
            __syncthreads();
            const unsigned tot = wc[0] + wc[1] + wc[2] + wc[3] + wc[4] + wc[5] + wc[6] + wc[7];
            if (tot >= (unsigned)cap) T = cand;
        }
        unsigned myc = 0u;
#pragma unroll
        for (int q = 0; q < 8; ++q) myc += (v[q] > T ? 0x10000u : 0u) + ((v[q] == T && (isctx ? (q == 0 && tid < LCX) : true)) ? 1u : 0u);
        __syncthreads();
        cnt[tid] = myc;
        __syncthreads();
        for (int off = 1; off < 512; off <<= 1) { const unsigned add = tid >= off ? cnt[tid - off] : 0u; __syncthreads(); cnt[tid] += add; __syncthreads(); }
        const unsigned total = cnt[511], keq = (unsigned)cap - (total >> 16);
        unsigned before = cnt[tid] - myc;
        for (int q = 0; q < per; ++q) { const int t = t0 + q; if (t >= n) break; const unsigned x = v[q]; const unsigned gtb = before >> 16, eqb = before & 0xFFFFu;
            const bool sel = x > T || (x == T && eqb < keq);
            if (sel) { const int jx = (int)(gtb + (eqb < keq ? eqb : keq));
                const int slot = isctx ? NB * CAPL + b * CAPC + jx : b * CAPL + jx, row = isctx ? NLAT + b * LCX + t : b * TL + t;
                ROWS[e * ESLOTS + slot] = row; GATE[e * ESLOTS + slot] = __builtin_bit_cast(float, x); SLOT[(size_t)row * 16 + e] = slot; }
            before += (x > T ? 0x10000u : 0u) + (x == T ? 1u : 0u); }
        __syncthreads();
    }
}


DI void ph_combine(const Ctx& C, float* __restrict__ xlat, float* __restrict__ xctx, const float* __restrict__ modg2  , const int* __restrict__ SLOT, const bf16* __restrict__ Y2, bool last,
                   const float* __restrict__ ngain  , const float* __restrict__ nmod  , bf16* __restrict__ H) {
    const int gw = C.bid * 8 + C.wave, ngw = C.nb * 8, lane = C.lane, nrows = last ? NLAT : MT;
    int sv_next = (gw < nrows) ? SLOT[(size_t)gw * 16 + (lane & 15)] : -1;
    for (int row = gw; row < nrows; row += ngw) {
        float* xr = row < NLAT ? xlat + (size_t)row * DM : xctx + (size_t)(row - NLAT) * DM;
        const int mi = row < NLAT ? (row >> 12) : 8;
        const int sv = sv_next;
        if (row + ngw < nrows) sv_next = SLOT[(size_t)(row + ngw) * 16 + (lane & 15)];
        f32x4 xv[4], gv[4];
#pragma unroll
        for (int j = 0; j < 4; ++j) { const int c = 256 * j + 4 * lane; gv[j] = *(const f32x4*)(modg2 + mi * 6144 + c); xv[j] = *(const f32x4*)(xr + c); }
        f32x4 acc[4];
#pragma unroll
        for (int j = 0; j < 4; ++j) acc[j] = (f32x4){0.f, 0.f, 0.f, 0.f};
        unsigned mask = (unsigned)__builtin_amdgcn_ballot_w64(sv >= 0) & 0xffffu;
        while (mask) {
            const bf16* yp[4]; float m[4];
            { const int e0 = __builtin_ctz(mask); mask &= mask - 1u; const int s0 = __builtin_amdgcn_readlane(sv, e0); yp[0] = Y2 + ((size_t)e0 * ESLOTS + s0) * DM + 4 * lane; m[0] = 1.f; }
#pragma unroll
            for (int k = 1; k < 4; ++k) {
                if (mask) { const int ek = __builtin_ctz(mask); mask &= mask - 1u; const int sk = __builtin_amdgcn_readlane(sv, ek); yp[k] = Y2 + ((size_t)ek * ESLOTS + sk) * DM + 4 * lane; m[k] = 1.f; }
                else { yp[k] = yp[0]; m[k] = 0.f; } }
            u32x2 w[4][4];
#pragma unroll
            for (int k = 0; k < 4; ++k)
#pragma unroll
                for (int j = 0; j < 4; ++j) w[k][j] = *(const u32x2*)(yp[k] + 256 * j);
#pragma unroll
            for (int k = 0; k < 4; ++k)
#pragma unroll
                for (int j = 0; j < 4; ++j) acc[j] += m[k] * (f32x4){bflo(w[k][j].x), bfhi(w[k][j].x), bflo(w[k][j].y), bfhi(w[k][j].y)};
        }
#pragma unroll
        for (int j = 0; j < 4; ++j) { const int c = 256 * j + 4 * lane; f32x4 x = xv[j]; x += gv[j] * acc[j]; *(f32x4*)(xr + c) = x; acc[j] = x; }
        if (ngain) {
            float ss = 0.f;
#pragma unroll
            for (int j = 0; j < 4; ++j) ss += acc[j].x * acc[j].x + acc[j].y * acc[j].y + acc[j].z * acc[j].z + acc[j].w * acc[j].w;
            const float rs = 1.0f / sqrtf(wave_sum(ss) * (1.f / 1024.f) + EPS);
            const float* mp = nmod + mi * 6144;
#pragma unroll
            for (int j = 0; j < 4; ++j) { const int c = 256 * j + 4 * lane;
                const f32x4 g = *(const f32x4*)(ngain + c), sc = *(const f32x4*)(mp + 1024 + c), sh = *(const f32x4*)(mp + c);
                const f32x4 hv = (acc[j] * rs) * g * (sc + 1.0f) + sh;
                *(u32x2*)(H + (size_t)row * DM + c) = (u32x2){pk2(hv.x, hv.y), pk2(hv.z, hv.w)}; }
        }
    }
}

template <int N> struct IC { static constexpr int value = N; };
DI const float* in_ptr(const unsigned char* ws, int k) { const unsigned long long v = ((const unsigned long long*)(ws + 128 * 1024))[k];
    const unsigned lo = __builtin_amdgcn_readfirstlane((unsigned)v), hi = __builtin_amdgcn_readfirstlane((unsigned)(v >> 32));
    return (const float*)(__attribute__((address_space(1))) const float*)(((unsigned long long)hi << 32) | lo); }
template <class T> DI T* launder_ptr(T* p) { unsigned long long v = (unsigned long long)p; unsigned lo = (unsigned)v, hi = (unsigned)(v >> 32); asm volatile("" : "+v"(lo), "+v"(hi));
    lo = __builtin_amdgcn_readfirstlane(lo); hi = __builtin_amdgcn_readfirstlane(hi); return (T*)(__attribute__((address_space(1))) T*)(((unsigned long long)hi << 32) | lo); }
constexpr int N_PHASES = 1 + 23 + 22;
constexpr size_t WS_PTRS = 128 * 1024;
#define P_XC    ((float*)(ws + WS_XC))
#define P_MOD   ((const float*)(ws + WS_MOD))
#define P_HB    ((bf16*)(ws + WS_HB))
#define P_OCAT  ((bf16*)(ws + WS_OCAT))
#define P_AR    (ws + WS_ARENA)
#define P_ROWS  ((int*)(ws + WS_ROWS))
#define P_GATE  ((float*)(ws + WS_GATE))
#define P_SLOT  ((int*)(ws + WS_SLOT))
#define P_AFFT  ((float*)(ws + WS_AFFT))
#define P_AFFC  ((float*)(ws + WS_AFFC))
#define P_W13   ((bf16*)(ws + WS_W13))
#define P_W2    ((bf16*)(ws + WS_W2))
#define P_U     ((bf16*)(P_AR + A_U))
#define P_QPRE  ((float*)(P_AR + A_QPRE))
#define P_KVPRE ((float*)(P_AR + A_KVPRE))
#define P_QB    ((bf16*)(P_AR + A_QB))
#define P_KB    ((bf16*)(P_AR + A_KB))
#define P_VT    ((bf16*)(P_AR + A_VT))
#define P_W     ((unsigned short*)(P_AR + A_W))
#define P_KEFF  ((bf16*)(P_AR + A_KEFF))
#define P_R     ((bf16*)(P_AR + A_R))
#define P_V     ((bf16*)(P_AR + A_V))
#define P_KK    ((bf16*)(P_AR + A_KK))
#define P_G     ((bf16*)(P_AR + A_G))
#define P_K     ((bf16*)(P_AR + A_K))
#define P_L     ((bf16*)(P_AR + A_L))
#define P_QN    ((bf16*)(P_AR + A_QN))
#define P_KN    ((bf16*)(P_AR + A_KN))
#define P_VTN   ((bf16*)(P_AR + A_VTN))
#define P_YS    ((bf16*)(P_AR + A_YS))
#define P_IMG   ((bf16*)(P_AR + A_IMG))
#define P_HID   ((bf16*)(P_AR + A_HID))
#define P_Y2    ((bf16*)(P_AR + A_Y2))
#define MODL(i) (P_MOD + (size_t)(i) * 9 * 6144)
#if MOE_F8
#define MOE1_PHASE(NMT) do { pg8::Gemm g{P_HB, P_W13, DM / 2, DM / 2, P_ROWS, SCALE_W, SCALE_ONE}; pg8::OrderMoE S{(NMT), 8, 17, C.nb, C.vcu}; pg8::EpiAdapt<EpiGlu8> E{EpiGlu8{(unsigned char*)P_HID}}; \
        pg8::gemm_phase<pg8::EpiAdapt<EpiGlu8>, pg8::OrderMoE, true>(C.lds, g, S, E, C.tid); } while (0)
#define MOE2_PHASE(NMT) do { pg8::Gemm g{P_HID, P_W2, DM / 2, DM / 2, nullptr, SCALE_W, SCALE_HID}; pg8::OrderMoE S{(NMT), 4, 17, C.nb, C.vcu}; pg8::EpiAdapt<EpiGate> E{EpiGate{P_Y2, P_GATE}}; \
        pg8::gemm_phase<pg8::EpiAdapt<EpiGate>, pg8::OrderMoE, true>(C.lds, g, S, E, C.tid); } while (0)
#else
#define MOE1_PHASE(NMT) do { pg8::Gemm g{P_HB, P_W13, DM, DM, P_ROWS}; pg8::OrderMoE S{(NMT), 8, 17, C.nb, C.vcu}; pg8::EpiAdapt<EpiGlu> E{EpiGlu{P_HID}}; pg8::gemm_phase(C.lds, g, S, E, C.tid); } while (0)
#define MOE2_PHASE(NMT) do { pg8::Gemm g{P_HID, P_W2, DM, DM, nullptr}; pg8::OrderMoE S{(NMT), 4, 17, C.nb, C.vcu}; pg8::EpiAdapt<EpiGate> E{EpiGate{P_Y2, P_GATE}}; pg8::gemm_phase(C.lds, g, S, E, C.tid); } while (0)
#endif
#define WPREP_TAIL(NUNITS, LAYER) do { __syncthreads(); const int extra_ = (NUNITS) % C.nb, j_ = C.vcu - extra_; const size_t wo_ = (size_t)(LAYER) * NEXP * DM * DM; \
        if (j_ >= 0) wprep_span(C, j_ * 8 + C.wave, (C.nb - extra_) * 8, in_ptr(ws, I_MW1) + wo_, in_ptr(ws, I_MW3) + wo_, in_ptr(ws, I_MW2) + wo_, (bf16*)(ws + WS_W13), (bf16*)(ws + WS_W2)); } while (0)
#define RELAUNDER() do { int l_ = C.lane; asm volatile("" : "+v"(l_)); C.lane = l_; C.tid = (C.wave << 6) | l_; } while (0)
__global__ void __launch_bounds__(512, 2) fwd_kernel(Args a) {
    extern __shared__ __attribute__((aligned(16))) unsigned char smem[];
    Ctx C0; C0.lds = (LAS unsigned char*)smem; C0.tid = threadIdx.x; C0.lane = C0.tid & 63; C0.wave = __builtin_amdgcn_readfirstlane(C0.tid >> 6); C0.bid = blockIdx.x; C0.nb = gridDim.x;
    C0.vcu = (C0.nb % 8 == 0) ? (C0.bid % 8) * (C0.nb / 8) + C0.bid / 8 : C0.bid;
    volatile LAS unsigned* bst = (volatile LAS unsigned*)(C0.lds + LDS_BYTES - 16);
#if MEGA
    if (C0.tid == 0) { bst[0] = 0u; bst[1] = 0u; }
    __syncthreads();
    const unsigned bar_x = xcd_barrier_post((unsigned*)(a.ws + WS_CTL) + 4096, bst, C0.tid == 0).x;
#define SEAM() do { if (ph < hi) { XcdBarrier b2_; b2_.bar = (unsigned*)(ws + WS_CTL) + 4096; b2_.x = bar_x; b2_.st = bst; xcd_barrier(b2_, C.tid == 0); } } while (0)
#else
#define SEAM() do { } while (0)
#endif
#if MEGA
    constexpr int lo = 0, hi = N_PHASES;
#else
    const int lo = a.ph_lo, hi = a.ph_hi;
#endif
    int ph = 0;
#ifndef ONLY
#define ONLY -1
#endif
#ifndef REPMASK
#define REPMASK 0
#endif
#ifndef SITE_LO
#define SITE_LO 0
#define SITE_HI 99
#endif
#define PHASE(SITE, ...) do { if ((ONLY < 0 || ONLY == (SITE)) && (SITE) >= SITE_LO && (SITE) <= SITE_HI && ph >= lo && ph < hi) { Ctx C; C.lds = C0.lds; \
        { int w_ = C0.wave; asm volatile("" : "+s"(w_)); unsigned m_ = ~0u; asm volatile("" : "+s"(m_)); int l_ = (int)__builtin_amdgcn_mbcnt_hi(m_, __builtin_amdgcn_mbcnt_lo(m_, 0u)); C.wave = w_; C.lane = l_; C.tid = (w_ << 6) | l_; } \
        { int b_ = C0.bid, n_ = C0.nb, v_ = C0.vcu; asm volatile("" : "+s"(b_), "+s"(n_), "+s"(v_)); C.bid = b_; C.nb = n_; C.vcu = v_; } \
        unsigned z_ = 0u; asm volatile("" : "+s"(z_)); unsigned char* ws = a.ws + z_; float* XL = a.out + z_; const int lq = __builtin_amdgcn_readfirstlane(lp); typedef const __attribute__((address_space(1))) float* gfp_t; const gfp_t* INT_ = (const gfp_t*)(ws + WS_PTRS); (void)INT_; (void)XL; (void)lq; \
        for (int rep_ = 0; rep_ < ((((REPMASK) >> (SITE)) & 1) ? 2 : 1); ++rep_) { __VA_ARGS__; if ((((REPMASK) >> (SITE)) & 1)) __syncthreads(); } ++ph; SEAM(); } else ++ph; } while (0)

    { const int lp = 0;
      PHASE(0, { if (C.bid == 0) { _Pragma("unroll") for (int k = 0; k < 40; ++k) if (C.tid == k) ((const float**)(ws + WS_PTRS))[k] = a.in[k]; }
                 ph_prologue(C, a); }); }

    auto layer_pair = [&](auto lpc) __attribute__((always_inline)) {
        constexpr int lp = decltype(lpc)::value;
        if constexpr (lp == 0) PHASE(1, { const int i = 2 * lq; const float* xl = (i == 0) ? in_ptr(ws, I_X) : XL; const float* xc = (i == 0) ? in_ptr(ws, I_CTX) : P_XC;
                   ph_norm<false>(C, xl, xc, in_ptr(ws, I_N1G) + i * DM, MODL(i), 0, 1024, P_HB, nullptr, nullptr, nullptr, nullptr); });
        PHASE(2, { EpiBf16 E{P_U, EV_INP}; fast_gemm(C, P_HB, DM, (const bf16*)(ws + WS_WEVIN) + (size_t)lq * EV_INP * DM, DM, MT / 256, EV_INP / 256, E); });
        PHASE(3, { EpiBf16 Eq{(bf16*)P_QPRE, 768}; fast_gemm(C, P_U, EV_INP, (const bf16*)(ws + WS_WUQ) + (size_t)lq * 768 * 384, 384, MT / 256, 3, Eq); RELAUNDER();
                   EpiBf16 Ek{(bf16*)P_KVPRE, 1024}; fast_gemm(C, P_U + 384, EV_INP, (const bf16*)(ws + WS_WUKV) + (size_t)lq * 1024 * 256, 256, MT / 256, 4, Ek, true); });
        PHASE(4, { ph_mla_fin(C, P_U, (const bf16*)P_QPRE, (const bf16*)P_KVPRE, in_ptr(ws, I_QG) + lq * 96, in_ptr(ws, I_KG) + lq * 96, (const f32x2*)(ws + WS_ROPE), P_QB, P_KB, P_VT);
                   const int extra_ = (MT / 64) % C.nb, j_ = C.vcu - extra_;
                   if (j_ >= 0) { for (int q_ = 0; q_ < CONV_PER_TAIL; ++q_) { const int cu_ = j_ + q_ * (C.nb - extra_); if (cu_ >= conv_in_fin(C.nb)) break;
                       float wk[31]; const float* dww = in_ptr(ws, I_DWW) + (size_t)lq * 31 * 512;
                       _Pragma("unroll") for (int kt = 0; kt < 31; ++kt) wk[kt] = dww[kt * 512 + C.tid];
                       conv_unit(C, cu_, P_U, wk, in_ptr(ws, I_DWB)[lq * 512 + C.tid], in_ptr(ws, I_LNG) + lq * 512, in_ptr(ws, I_LNB) + lq * 512, P_OCAT); } } });
        PHASE(5, ph_attn_mla2(C, P_QB, P_KB, P_VT, P_OCAT, false, ws, lq));
        PHASE(6, { const int i = 2 * lq; const float* xl = (i == 0) ? in_ptr(ws, I_X) : XL; const float* xc = (i == 0) ? in_ptr(ws, I_CTX) : P_XC;
                   { EpiResid E{xl, xc, XL, P_XC, MODL(i) + 2048}; fast_gemm(C, P_OCAT, DM, (const bf16*)(ws + WS_WEVOUT) + (size_t)lq * DM * DM, DM, MT / 256, 4, E); }
                   WPREP_TAIL(MT / 256 * 4, i); });
        PHASE(7, { const int i = 2 * lq; ph_norm<true>(C, XL, P_XC, in_ptr(ws, I_N2G) + i * DM, MODL(i), 3072, 4096, P_HB, in_ptr(ws, I_ROUTER) + (size_t)i * DM * 16, P_AFFT, P_AFFC, P_SLOT); });
        PHASE(8, ph_topk2(C, P_AFFT, P_AFFC, P_ROWS, P_GATE, P_SLOT, false));
        PHASE(9, { MOE1_PHASE(17); });
        PHASE(10, { MOE2_PHASE(17); });
        PHASE(11, { const int i = 2 * lq; ph_combine(C, XL, P_XC, MODL(i) + 5120, P_SLOT, P_Y2, false, in_ptr(ws, I_N1G) + (i + 1) * DM, MODL(i + 1), P_HB); });
        PHASE(13, { EpiBf16 E{P_U, OD_INP}; fast_gemm(C, P_HB, DM, (const bf16*)(ws + WS_WODIN) + (size_t)lq * OD_INP * DM, DM, MT / 256, OD_INP / 256, E); });
        PHASE(14, ph_prep(C, P_U, in_ptr(ws, I_SHIFTW) + (size_t)lq * 3 * RW_IN, in_ptr(ws, I_KKW) + lq * 512, in_ptr(ws, I_NAQG) + lq * 64, in_ptr(ws, I_NAKG) + lq * 64, P_R, P_V, P_K, P_KK, P_L, P_QN, P_KN, P_VTN));
        PHASE(15, { const bf16* WL = (const bf16*)(ws + WS_WLORA) + (size_t)lq * 655360;
                    { EpiLoraW E{P_W, in_ptr(ws, I_W0) + lq * 1024}; fast_gemm(C, P_L, 384, WL, 256, MT / 256, 4, E); } RELAUNDER();
                    { EpiLoraA E{P_KEFF, in_ptr(ws, I_A0) + lq * 1024}; fast_gemm(C, P_L, 384, WL + (size_t)1024 * 256, 256, MT / 256, 4, E, true); } RELAUNDER();
                    { EpiBf16 E{P_G, 512}; fast_gemm(C, P_L + 128, 384, WL + (size_t)2048 * 256, 256, MT / 256, 2, E); } });
        PHASE(16, ph_wkv_pre(C, P_R, P_K, P_KK, P_W, P_KEFF, in_ptr(ws, I_KA) + lq * 512, P_IMG));
        PHASE(17, { ph_wkv_chunk(C, P_R, P_V, P_K, P_KK, P_W, P_KEFF, in_ptr(ws, I_KA) + lq * 512, P_IMG, P_YS); __syncthreads();
                    ph_natten2(C, P_QN, P_KN, P_VTN, P_OCAT, in_ptr(ws, I_RPB) + (size_t)lq * 8 * 465, lq == 1, (unsigned*)(ws + WS_CTL) + 8192 + 64 * lq, ws, lq); });
        PHASE(18, ph_post(C, P_YS, P_R, P_V, P_K, P_KEFF, in_ptr(ws, I_KA) + lq * 512, P_G, in_ptr(ws, I_RK) + lq * 512, in_ptr(ws, I_GNG) + lq * 512, in_ptr(ws, I_GNB) + lq * 512, P_OCAT, lq == 1));
        PHASE(19, { const int i = 2 * lq + 1; EpiResid E{XL, P_XC, XL, P_XC, MODL(i) + 2048};
                    fast_gemm(C, P_OCAT, DM, (const bf16*)(ws + WS_WODOUT) + (size_t)lq * DM * DM, DM, (lq == 1) ? NLAT / 256 : MT / 256, 4, E);
                    WPREP_TAIL(((lq == 1) ? NLAT / 256 : MT / 256) * 4, i); });
        PHASE(20, { const int i = 2 * lq + 1; ph_norm<true>(C, XL, P_XC, in_ptr(ws, I_N2G) + i * DM, MODL(i), 3072, 4096, P_HB, in_ptr(ws, I_ROUTER) + (size_t)i * DM * 16, P_AFFT, P_AFFC, P_SLOT); });
        PHASE(21, ph_topk2(C, P_AFFT, P_AFFC, P_ROWS, P_GATE, P_SLOT, lq == 1));
        PHASE(22, { MOE1_PHASE((lq == 1) ? 16 : 17); });
        PHASE(23, { MOE2_PHASE((lq == 1) ? 16 : 17); });
        PHASE(24, { const int i = 2 * lq + 1;
                    if (lp == 0) ph_combine(C, XL, P_XC, MODL(i) + 5120, P_SLOT, P_Y2, false, in_ptr(ws, I_N1G) + (i + 1) * DM, MODL(i + 1), P_HB);
                    else ph_combine(C, XL, P_XC, MODL(i) + 5120, P_SLOT, P_Y2, true, nullptr, nullptr, nullptr); });
    };
    layer_pair(IC<0>{}); layer_pair(IC<1>{});
}

extern "C" void kernel_launch(void* const* d_in, const int* in_sizes, int n_in, void* d_out, int out_size, void* d_ws, size_t ws_size, hipStream_t stream) {
    static int grid = 0;
    if (grid == 0) {
        if (n_in != 40 || out_size != NLAT * DM || ws_size < WS_END) { fprintf(stderr, "kernel_launch: unexpected shapes (n_in %d out %d ws %zu need %zu)\n", n_in, out_size, ws_size, (size_t)WS_END); grid = -1; return; }
        int dev = 0, cus = 0, per_cu = 0;
        if (hipGetDevice(&dev) != hipSuccess || hipDeviceGetAttribute(&cus, hipDeviceAttributeMultiprocessorCount, dev) != hipSuccess) { grid = -1; return; }
        if (hipFuncSetAttribute((const void*)fwd_kernel, hipFuncAttributeMaxDynamicSharedMemorySize, LDS_BYTES) != hipSuccess) { fprintf(stderr, "kernel_launch: hipFuncSetAttribute failed\n"); grid = -1; return; }
        if (hipOccupancyMaxActiveBlocksPerMultiprocessor(&per_cu, (const void*)fwd_kernel, 512, LDS_BYTES) != hipSuccess || per_cu < 1) { fprintf(stderr, "kernel_launch: occupancy query says %d\n", per_cu); per_cu = 1; }
        (void)hipGetLastError();
        grid = cus;
    }
    if (grid < 0) return;
    (void)hipMemsetAsync((char*)d_ws + WS_CTL, 0, CTL_BYTES, stream);
    Args a{};
    for (int i = 0; i < 40; ++i) a.in[i] = (const float*)d_in[i];
    a.out = (float*)d_out; a.ws = (unsigned char*)d_ws;
#if MEGA
    a.ph_lo = 0; a.ph_hi = N_PHASES;
    hipLaunchKernelGGL(fwd_kernel, dim3(grid), dim3(512), LDS_BYTES, stream, a);
#else
    for (int p = 0; p < N_PHASES; ++p) { a.ph_lo = p; a.ph_hi = p + 1; hipLaunchKernelGGL(fwd_kernel, dim3(grid), dim3(512), LDS_BYTES, stream, a); }
#endif
}
```

```cpp
#include <hip/hip_runtime.h>
#include <cstdio>
#include <cstdint>

#ifndef MEGA
#define MEGA 1
#endif

#define LAS __attribute__((address_space(3)))
#define DI __device__ __forceinline__

typedef unsigned short bf16;
typedef short bf16x8 __attribute__((ext_vector_type(8)));
typedef float f32x4 __attribute__((ext_vector_type(4)));
typedef float f32x2 __attribute__((ext_vector_type(2)));
typedef float f32x16 __attribute__((ext_vector_type(16)));
typedef unsigned u32x4 __attribute__((ext_vector_type(4)));
typedef unsigned u32x2 __attribute__((ext_vector_type(2)));
typedef __bf16 bf16x2_t __attribute__((ext_vector_type(2)));

constexpr int DM = 1024, NB = 8, TL = 4096, LCX = 256;
constexpr int NLAT = NB * TL, NCTX = NB * LCX, MT = NLAT + NCTX;
constexpr int KPOS = TL + LCX;
constexpr float EPS = 1e-6f, GN_EPS = 64e-5f;
constexpr int EV_IN = 1696, EV_INP = 1792, OD_IN = 3456, OD_INP = 3584, RW_IN = 1920;
constexpr int NEXP = 16, CAPL = 512, CAPC = 32, ESLOTS = NB * CAPL + NB * CAPC;
constexpr float LOG2E = 1.4426950408889634f;

constexpr size_t MiB = 1ull << 20;
constexpr size_t WS_CTL = 0, CTL_BYTES = 1 * MiB;
constexpr size_t WS_MOD = 1 * MiB, WS_ROPE = 2 * MiB, WS_XC = 4 * MiB;
constexpr size_t WS_ROWS = 12 * MiB, WS_GATE = 12 * MiB + 512 * 1024, WS_SLOT = 13 * MiB, WS_AFFT = 16 * MiB, WS_AFFC = 18 * MiB;
constexpr size_t WS_WEVIN = 20 * MiB, WS_WEVOUT = 27 * MiB, WS_WUQ = 31 * MiB, WS_WUKV = 33 * MiB, WS_WODIN = 34 * MiB, WS_WODOUT = 48 * MiB, WS_WLORA = 52 * MiB;
constexpr size_t WS_W13 = 56 * MiB, WS_W2 = 120 * MiB, WS_HB = 152 * MiB, WS_OCAT = 220 * MiB, WS_ARENA = 288 * MiB;
constexpr size_t A_U = 0, A_QPRE = 119 * MiB, A_KVPRE = 221 * MiB, A_QB = 357 * MiB, A_KB = 408 * MiB, A_VT = 459 * MiB;
constexpr size_t A_W = 0, A_KEFF = 136 * MiB  , A_G = 204 * MiB, A_R = 238 * MiB, A_V = 272 * MiB, A_KK = 306 * MiB, A_K = 340 * MiB, A_L = 374 * MiB,
                 A_QN = 400 * MiB, A_KN = 434 * MiB, A_VTN = 468 * MiB, A_YS = 612 * MiB  ;
constexpr size_t A_HID = 0, A_Y2 = 136 * MiB;
constexpr size_t A_IMG = 510 * MiB;
constexpr size_t WS_END = WS_ARENA + 680 * MiB;
constexpr int LDS_BYTES = 147456;

DI unsigned pk2(float lo, float hi) { f32x2 v = {lo, hi}; bf16x2_t b = __builtin_convertvector(v, bf16x2_t); return __builtin_bit_cast(unsigned, b); }
DI float bflo(unsigned u) { return __builtin_bit_cast(float, u << 16); }
DI float bfhi(unsigned u) { return __builtin_bit_cast(float, u & 0xffff0000u); }
DI float bf2f(bf16 x) { return __builtin_bit_cast(float, ((unsigned)x) << 16); }
DI bf16 f2bf(float f) { return (bf16)(pk2(f, 0.f) & 0xffffu); }
DI void unpack8(u32x4 v, float (&f)[8]) { f[0] = bflo(v.x); f[1] = bfhi(v.x); f[2] = bflo(v.y); f[3] = bfhi(v.y); f[4] = bflo(v.z); f[5] = bfhi(v.z); f[6] = bflo(v.w); f[7] = bfhi(v.w); }
DI u32x4 pack8(const float (&f)[8]) { u32x4 r; r.x = pk2(f[0], f[1]); r.y = pk2(f[2], f[3]); r.z = pk2(f[4], f[5]); r.w = pk2(f[6], f[7]); return r; }
#define DPP_ADD(x, ctrl) ((x) + __builtin_bit_cast(float, __builtin_amdgcn_update_dpp(0, __builtin_bit_cast(int, (x)), (ctrl), 0xf, 0xf, false)))
#define DPP_MAX(x, ctrl) fmaxf((x), __builtin_bit_cast(float, __builtin_amdgcn_update_dpp(0, __builtin_bit_cast(int, (x)), (ctrl), 0xf, 0xf, false)))
DI float sum8(float x) { x = DPP_ADD(x, 0xB1); x = DPP_ADD(x, 0x4E); x = DPP_ADD(x, 0x141); return x; }
DI float sum16(float x) { x = DPP_ADD(x, 0xB1); x = DPP_ADD(x, 0x4E); x = DPP_ADD(x, 0x141); x = DPP_ADD(x, 0x140); return x; }
DI float max16(float x) { x = DPP_MAX(x, 0xB1); x = DPP_MAX(x, 0x4E); x = DPP_MAX(x, 0x141); x = DPP_MAX(x, 0x140); return x; }
DI float rdlane(float x, int l) { return __builtin_bit_cast(float, __builtin_amdgcn_readlane(__builtin_bit_cast(int, x), l)); }
DI float wave_sum(float v) { const float x = sum16(v); return (rdlane(x, 0) + rdlane(x, 16)) + (rdlane(x, 32) + rdlane(x, 48)); }
DI float xor32(float v, int lane) { return __builtin_bit_cast(float, __builtin_amdgcn_ds_bpermute((lane ^ 32) << 2, __builtin_bit_cast(int, v))); }
typedef int v8i_t __attribute__((ext_vector_type(8)));
typedef int i32x4_t __attribute__((ext_vector_type(4)));
DI unsigned pk4_fp8(float a, float b, float c, float d) {
    a = __builtin_amdgcn_fmed3f(a, -448.f, 448.f); b = __builtin_amdgcn_fmed3f(b, -448.f, 448.f); c = __builtin_amdgcn_fmed3f(c, -448.f, 448.f); d = __builtin_amdgcn_fmed3f(d, -448.f, 448.f);
    int p = __builtin_amdgcn_cvt_pk_fp8_f32(a, b, 0, false); p = __builtin_amdgcn_cvt_pk_fp8_f32(c, d, p, true); return (unsigned)p; }
#ifndef MOE_F8
#define MOE_F8 1
#endif
constexpr int SCALE_ONE = 0x7f7f7f7f, SCALE_W = 0x79797979  , SCALE_HID = 0x7c7c7c7c  ;
DI float sigmoidf_(float x) { return __builtin_amdgcn_rcpf(1.f + __expf(-x)); }
DI float siluf_(float x) { return x * __builtin_amdgcn_rcpf(1.f + __expf(-x)); }
#define MFMA32(a, b, c) __builtin_amdgcn_mfma_f32_32x32x16_bf16((a), (b), (c), 0, 0, 0)

#define XB_TMO      128
#define XB_XCNT(j)  (256  + 64 * (j))
#define XB_XSUB(j)  (1280 + 64 * (j))
#define XB_XGEN(j)  (2304 + 64 * (j))
#define XB_TOP      3328
#define XB_TOPGEN   3392
#define XCD_BAR_WORDS 3456
#define XB_SPIN_CAP (1u << 22)
__device__ __forceinline__ unsigned xb_ld(unsigned* p)              { return __hip_atomic_load(p, __ATOMIC_RELAXED, __HIP_MEMORY_SCOPE_AGENT); }
__device__ __forceinline__ unsigned xb_add(unsigned* p, unsigned v) { return __hip_atomic_fetch_add(p, v, __ATOMIC_RELAXED, __HIP_MEMORY_SCOPE_AGENT); }
__device__ __forceinline__ unsigned xb_xcc_id() { return (unsigned)__builtin_amdgcn_s_getreg((3 << 11) | 20) & 0xFu; }
#define XB_SPIN(cond, bar) do { unsigned _sp = 0; while (cond) { __builtin_amdgcn_s_sleep(1); \
    if ((++_sp & 255u) == 0u) { if (xb_ld(&(bar)[XB_TMO])) break; if (_sp > XB_SPIN_CAP) { atomicAdd(&(bar)[XB_TMO], 1u); break; } } } } while (0)
struct XcdBarrier { unsigned* bar; unsigned x; volatile LAS unsigned* st; };
__device__ __forceinline__ XcdBarrier xcd_barrier_post(unsigned* bar, volatile LAS unsigned* st, bool leader) {
    XcdBarrier b; b.bar = bar; b.x = xb_xcc_id(); b.st = st;
    if (leader) (void)xb_add(&bar[XB_XCNT(b.x)], 1u);
    return b;
}
__device__ __forceinline__ void xcd_barrier_complete(unsigned* bar, unsigned x, unsigned& nloc, unsigned& nx) {
    const unsigned G = gridDim.x * gridDim.y * gridDim.z;
    unsigned sum, cnt, mine, sp = 0u;
    for (;;) {
        sum = 0u; cnt = 0u; mine = 0u;
#pragma unroll
        for (unsigned j = 0; j < 16; ++j) { const unsigned c = xb_ld(&bar[XB_XCNT(j)]); sum += c; cnt += (c > 0u) ? 1u : 0u; mine = (j == x) ? c : mine; }
        if (sum == G) break;
        __builtin_amdgcn_s_sleep(1);
        if ((++sp & 255u) == 0u) { if (xb_ld(&bar[XB_TMO])) break; if (sp > XB_SPIN_CAP) { atomicAdd(&bar[XB_TMO], 1u); break; } }
    }
    nloc = mine > 0u ? mine : 1u; nx = cnt > 0u ? cnt : 1u;
}
__device__ __forceinline__ void xcd_barrier(const XcdBarrier& b, bool leader) {
    asm volatile("s_waitcnt vmcnt(0)" ::: "memory");
    __syncthreads();
    if (leader) {
        unsigned* bar = b.bar;
        __builtin_amdgcn_s_waitcnt(0);
        unsigned nloc = b.st[0], nx = b.st[1];
        if (nloc == 0u) { xcd_barrier_complete(bar, b.x, nloc, nx); b.st[0] = nloc; b.st[1] = nx; }
        const unsigned old = xb_add(&bar[XB_XSUB(b.x)], 1u);
        const unsigned gen = old / nloc;
        if (old + 1u == (gen + 1u) * nloc) {
            __builtin_amdgcn_fence(__ATOMIC_RELEASE, "agent");
            asm volatile("s_waitcnt vmcnt(0)" ::: "memory");
            const unsigned og = xb_add(&bar[XB_TOP], 1u);
            const unsigned tg = og / nx;
            if (og + 1u == (tg + 1u) * nx) xb_add(&bar[XB_TOPGEN], 1u);
            else XB_SPIN(xb_ld(&bar[XB_TOPGEN]) == tg, bar);
            __builtin_amdgcn_fence(__ATOMIC_ACQUIRE, "agent");
            xb_add(&bar[XB_XGEN(b.x)], 1u);
            asm volatile("s_waitcnt vmcnt(0)" ::: "memory");
        } else {
            XB_SPIN(xb_ld(&bar[XB_XGEN(b.x)]) == gen, bar);
            __builtin_amdgcn_fence(__ATOMIC_ACQUIRE, "agent");
            asm volatile("s_waitcnt vmcnt(0)" ::: "memory");
        }
    }
    __syncthreads();
}

struct Ctx { LAS unsigned char* lds; int tid, lane, wave, bid, nb, vcu; };
struct Args { const float* in[40]; float* out; unsigned char* ws; int ph_lo, ph_hi; };
enum { I_X = 0, I_C, I_CTX, I_CCTX, I_ADAW, I_ADAB, I_N1G, I_N2G, I_EVWIN, I_EVWOUT, I_QNORM, I_WUQ, I_KVNORM, I_WUKV, I_QG, I_KG, I_DWW, I_DWB, I_LNG, I_LNB,
       I_ODWIN, I_ODWOUT, I_SHIFTW, I_W0, I_W2L, I_A0, I_A2, I_G2, I_KKW, I_KA, I_RK, I_GNG, I_GNB, I_NAQG, I_NAKG, I_RPB, I_ROUTER, I_MW1, I_MW3, I_MW2 };

DI void transpose_item(const float* __restrict__ W, int K, int N, bf16* __restrict__ WT, int dst_row0, const float* __restrict__ gain, LAS float* scr, int k0, int n0, int lane) {
#pragma unroll 8
    for (int i = 0; i < 32; ++i) { const int kk = 2 * i + (lane >> 5); float v = W[(size_t)(k0 + kk) * N + n0 + (lane & 31)]; if (gain) v *= gain[k0 + kk]; scr[kk * 33 + (lane & 31)] = v; }
    asm volatile("s_waitcnt lgkmcnt(0)" ::: "memory");
    const int c = lane & 7;
#pragma unroll
    for (int j = 0; j < 4; ++j) { const int n = (lane >> 3) + 8 * j; const LAS float* s = scr + (8 * c) * 33 + n;
        u32x4 o; o.x = pk2(s[0 * 33], s[1 * 33]); o.y = pk2(s[2 * 33], s[3 * 33]); o.z = pk2(s[4 * 33], s[5 * 33]); o.w = pk2(s[6 * 33], s[7 * 33]);
        *(u32x4*)(WT + (size_t)(dst_row0 + n) * K + k0 + 8 * c) = o; }
    asm volatile("s_waitcnt lgkmcnt(0)" ::: "memory");
}
DI void transpose_item64(const float* __restrict__ W, int K, int N, bf16* __restrict__ WT, int dst_row0, LAS float* scr, int k0, int n0, int lane) {
    f32x4 v[16];
#pragma unroll
    for (int i = 0; i < 16; ++i) v[i] = *(const f32x4*)(W + (size_t)(k0 + 4 * i + (lane >> 4)) * N + n0 + 4 * (lane & 15));
#pragma unroll
    for (int i = 0; i < 16; ++i) { LAS float* d = scr + (4 * i + (lane >> 4)) * 65 + 4 * (lane & 15); d[0] = v[i].x; d[1] = v[i].y; d[2] = v[i].z; d[3] = v[i].w; }
    asm volatile("s_waitcnt lgkmcnt(0)" ::: "memory");
    const int c = lane & 7;
#pragma unroll
    for (int j = 0; j < 8; ++j) { const int n = (lane >> 3) + 8 * j; const LAS float* s = scr + (8 * c) * 65 + n;
        u32x4 o; o.x = pk2(s[0 * 65], s[1 * 65]); o.y = pk2(s[2 * 65], s[3 * 65]); o.z = pk2(s[4 * 65], s[5 * 65]); o.w = pk2(s[6 * 65], s[7 * 65]);
        *(u32x4*)(WT + (size_t)(dst_row0 + n) * K + k0 + 8 * c) = o; }
    asm volatile("s_waitcnt lgkmcnt(0)" ::: "memory");
}
DI void transpose_item64_f8(const float* __restrict__ W, int K, int N, unsigned char* __restrict__ WT8, int dst_row0, LAS float* scr, int k0, int n0, int lane) {
    f32x4 v[16];
#pragma unroll
    for (int i = 0; i < 16; ++i) v[i] = *(const f32x4*)(W + (size_t)(k0 + 4 * i + (lane >> 4)) * N + n0 + 4 * (lane & 15));
#pragma unroll
    for (int i = 0; i < 16; ++i) { LAS float* d = scr + (4 * i + (lane >> 4)) * 65 + 4 * (lane & 15); d[0] = v[i].x; d[1] = v[i].y; d[2] = v[i].z; d[3] = v[i].w; }
    asm volatile("s_waitcnt lgkmcnt(0)" ::: "memory");
    const int c = lane & 7;
#pragma unroll
    for (int j = 0; j < 8; ++j) { const int n = (lane >> 3) + 8 * j; const LAS float* s = scr + (8 * c) * 65 + n;
        u32x2 o; o.x = pk4_fp8(64.f * s[0 * 65], 64.f * s[1 * 65], 64.f * s[2 * 65], 64.f * s[3 * 65]); o.y = pk4_fp8(64.f * s[4 * 65], 64.f * s[5 * 65], 64.f * s[6 * 65], 64.f * s[7 * 65]);
        *(u32x2*)(WT8 + (size_t)(dst_row0 + n) * K + k0 + 8 * c) = o; }
    asm volatile("s_waitcnt lgkmcnt(0)" ::: "memory");
}
DI void transpose_matrix(const Ctx& C, const float* W, int K, int N, bf16* WT, const float* gain, int mode  ) {
    LAS float* scr = (LAS float*)(C.lds + C.wave * 8704);
    const int nkb = K / 64, nnb = N / 32, nit = nkb * nnb, gw = C.vcu * 8 + C.wave, ngw = C.nb * 8;
    for (int it = gw; it < nit; it += ngw) {
        const int kb = it / nnb, nbk = it % nnb, n0 = nbk * 32;
        int d0 = n0; if (mode) d0 = (n0 >> 7) * 256 + (n0 & 127) + (mode == 2 ? 128 : 0);
        transpose_item(W, K, N, WT, d0, gain, scr, kb * 64, n0, C.lane);
    }
}

DI void ph_prologue(const Ctx& C, const Args& a) {
    unsigned char* ws = a.ws;
    {
        LAS float* sv = (LAS float*)C.lds;
        LAS float* red = sv + 9 * 1024;
        for (int i = C.tid; i < 9 * 1024; i += 512) { const int m = i >> 10, k = i & 1023; const float c = (m < 8) ? a.in[I_C][m * 1024 + k] : a.in[I_CCTX][k]; sv[i] = siluf_(c); }
        __syncthreads();
        float* MOD = (float*)(ws + WS_MOD);
        for (int it = C.bid; it < 4 * 96; it += C.nb) {
            const int layer = it / 96, col = (it % 96) * 64 + C.lane;
            const float* wp = a.in[I_ADAW] + (size_t)layer * 1024 * 6144 + col;
            float acc[9];
#pragma unroll
            for (int m = 0; m < 9; ++m) acc[m] = 0.f;
            const int kb = C.wave * 128;
#pragma unroll 16
            for (int k = 0; k < 128; ++k) { const float w = wp[(size_t)(kb + k) * 6144];
#pragma unroll
                for (int m = 0; m < 9; ++m) acc[m] += sv[m * 1024 + kb + k] * w; }
#pragma unroll
            for (int m = 0; m < 9; ++m) red[(C.wave * 9 + m) * 64 + C.lane] = acc[m];
            __syncthreads();
            for (int i = C.tid; i < 576; i += 512) { const int m = i >> 6, l = i & 63; float s = 0.f;
#pragma unroll
                for (int w = 0; w < 8; ++w) s += red[(w * 9 + m) * 64 + l];
                const int cc = (it % 96) * 64 + l;
                MOD[(size_t)(layer * 9 + m) * 6144 + cc] = s + a.in[I_ADAB][layer * 6144 + cc]; }
            __syncthreads();
        }
    }
    {
        f32x2* CS = (f32x2*)(ws + WS_ROPE);
        for (int i = C.bid * 512 + C.tid; i < 4096 * 16; i += C.nb * 512) {
            const int pos = i >> 4, j = i & 15, f = j & 7;
            const float inv = powf(10000.f, -(float)(2 * f) / 16.f);
            const float ang = (float)((j < 8) ? (pos >> 6) : (pos & 63)) * inv;
            const double tw = 6.283185307179586476925;
            const double x = (double)ang, n = __builtin_rint(x / tw), rr = x - n * tw;
            CS[i] = (f32x2){__cosf((float)rr), __sinf((float)rr)};
        }
    }
    for (int j = 0; j < 2; ++j) {
        transpose_matrix(C, a.in[I_EVWIN] + (size_t)j * DM * EV_IN, DM, EV_IN, (bf16*)(ws + WS_WEVIN) + (size_t)j * EV_INP * DM, nullptr, 0);
        transpose_matrix(C, a.in[I_EVWOUT] + (size_t)j * DM * DM, DM, DM, (bf16*)(ws + WS_WEVOUT) + (size_t)j * DM * DM, nullptr, 0);
        transpose_matrix(C, a.in[I_WUQ] + (size_t)j * 384 * 768, 384, 768, (bf16*)(ws + WS_WUQ) + (size_t)j * 768 * 384, a.in[I_QNORM] + j * 384, 0);
        transpose_matrix(C, a.in[I_WUKV] + (size_t)j * 256 * 1024, 256, 1024, (bf16*)(ws + WS_WUKV) + (size_t)j * 1024 * 256, a.in[I_KVNORM] + j * 256, 0);
        transpose_matrix(C, a.in[I_ODWIN] + (size_t)j * DM * OD_IN, DM, OD_IN, (bf16*)(ws + WS_WODIN) + (size_t)j * OD_INP * DM, nullptr, 0);
        transpose_matrix(C, a.in[I_ODWOUT] + (size_t)j * DM * DM, DM, DM, (bf16*)(ws + WS_WODOUT) + (size_t)j * DM * DM, nullptr, 0);
    }
    {
        const int gt = C.bid * 512 + C.tid, ngt = C.nb * 512;
        for (int j = 0; j < 2; ++j) {
            u32x4* p0 = (u32x4*)((bf16*)(ws + WS_WEVIN) + (size_t)j * EV_INP * DM + (size_t)EV_IN * DM);
            for (int i = gt; i < (EV_INP - EV_IN) * DM / 8; i += ngt) p0[i] = (u32x4){0u, 0u, 0u, 0u};
            u32x4* p1 = (u32x4*)((bf16*)(ws + WS_WODIN) + (size_t)j * OD_INP * DM + (size_t)OD_IN * DM);
            for (int i = gt; i < (OD_INP - OD_IN) * DM / 8; i += ngt) p1[i] = (u32x4){0u, 0u, 0u, 0u};
            bf16* WL = (bf16*)(ws + WS_WLORA) + (size_t)j * 655360;
            const float* w2 = a.in[I_W2L] + (size_t)j * 2 * 64 * 512; const float* a2 = a.in[I_A2] + (size_t)j * 2 * 64 * 512; const float* g2 = a.in[I_G2] + (size_t)j * 128 * 512;
            for (int i = gt; i < 655360; i += ngt) {
                const int n = i >> 8, k = i & 255; float v = 0.f;
                if (n < 1024) { const int d = n >> 9, c = n & 511; if (k >= d * 64 && k < d * 64 + 64) v = w2[(size_t)k * 512 + c]; }
                else if (n < 2048) { const int d = (n - 1024) >> 9, c = n & 511; if (k >= 128 + d * 64 && k < 192 + d * 64) v = a2[(size_t)(k - 128) * 512 + c]; }
                else { const int c = n - 2048; if (k >= 128) v = g2[(size_t)(k - 128) * 512 + c]; }
                WL[i] = f2bf(v);
            }
        }
    }
}

template <bool ROUTER> DI void norm_row(const Ctx& C, int row, const float* xlat, const float* xctx, const float* gain, const float* mod, int shift_off, int scale_off, bf16* H, float* AFFT, float* AFFC, int* SLOT);
template <bool ROUTER, int NR> DI void norm_rowsN(const Ctx& C, int row, const float* xlat, const float* gain, const float* mod, int shift_off, int scale_off, bf16* H, float* AFFT, int* SLOT);
template <bool ROUTER>
DI void ph_norm(const Ctx& C, const float* xlat, const float* xctx, const float* gain, const float* mod  , int shift_off, int scale_off, bf16* H,
                const float* router  , float* AFFT, float* AFFC, int* SLOT) {
    LAS float* RT = (LAS float*)C.lds;
    if (ROUTER) { for (int i = C.tid; i < 16384; i += 512) { const int c = i >> 4, e = i & 15; RT[e * 1024 + c] = router[i]; } __syncthreads(); }
    const int gw = C.bid * 8 + C.wave, ngw = C.nb * 8;
    for (int p = gw; p < NLAT / 4; p += ngw) norm_rowsN<ROUTER, 4>(C, 4 * p, xlat, gain, mod, shift_off, scale_off, H, AFFT, SLOT);
    for (int row = NLAT + gw; row < MT; row += ngw) norm_row<ROUTER>(C, row, xlat, xctx, gain, mod, shift_off, scale_off, H, AFFT, AFFC, SLOT);
}
template <bool ROUTER, int NR>
DI void norm_rowsN(const Ctx& C, int row, const float* __restrict__ xlat, const float* __restrict__ gain, const float* __restrict__ mod, int shift_off, int scale_off, bf16* __restrict__ H, float* __restrict__ AFFT, int* __restrict__ SLOT) {
    const LAS float* RT = (const LAS float*)C.lds; const int lane = C.lane;
    const float* xr = xlat + (size_t)row * DM;
    const float* mp = mod + (row >> 12) * 6144;
    f32x4 v[NR][4]; float rs[NR];
#pragma unroll
    for (int q = 0; q < NR; ++q) { float ss = 0.f;
#pragma unroll
        for (int j = 0; j < 4; ++j) { v[q][j] = *(const f32x4*)(xr + q * DM + 256 * j + 4 * lane); ss += v[q][j].x * v[q][j].x + v[q][j].y * v[q][j].y + v[q][j].z * v[q][j].z + v[q][j].w * v[q][j].w; }
        rs[q] = 1.0f / sqrtf(wave_sum(ss) * (1.f / 1024.f) + EPS); }
#pragma unroll
    for (int j = 0; j < 4; ++j) {
        const int c = 256 * j + 4 * lane;
        const f32x4 g = *(const f32x4*)(gain + c), sc = *(const f32x4*)(mp + scale_off + c), sh = *(const f32x4*)(mp + shift_off + c);
#pragma unroll
        for (int q = 0; q < NR; ++q) {
            v[q][j] = (v[q][j] * rs[q]) * g * (sc + 1.0f) + sh;
            if (ROUTER && MOE_F8) *(unsigned*)((unsigned char*)H + (size_t)(row + q) * DM + c) = pk4_fp8(v[q][j].x, v[q][j].y, v[q][j].z, v[q][j].w);
            else *(u32x2*)(H + (size_t)(row + q) * DM + c) = (u32x2){pk2(v[q][j].x, v[q][j].y), pk2(v[q][j].z, v[q][j].w)};
        }
    }
    if constexpr (ROUTER && NR == 4) {
        float lgp = 0.f;
#pragma unroll 1
        for (int e = 0; e < 16; ++e) { float p[4] = {0.f, 0.f, 0.f, 0.f};
#pragma unroll
            for (int j = 0; j < 4; ++j) { const f32x4 w = *(const LAS f32x4*)(RT + e * 1024 + 256 * j + 4 * lane);
#pragma unroll
                for (int q = 0; q < 4; ++q) p[q] += v[q][j].x * w.x + v[q][j].y * w.y + v[q][j].z * w.z + v[q][j].w * w.w; }
            asm volatile("v_nop\n\tv_nop\n\tv_permlane32_swap_b32 %0, %1\n\ts_nop 1" : "+v"(p[0]), "+v"(p[1]));
            asm volatile("v_nop\n\tv_nop\n\tv_permlane32_swap_b32 %0, %1\n\ts_nop 1" : "+v"(p[2]), "+v"(p[3]));
            float t01 = p[0] + p[1], t23 = p[2] + p[3];
            asm volatile("v_nop\n\tv_nop\n\tv_permlane16_swap_b32 %0, %1\n\ts_nop 1" : "+v"(t01), "+v"(t23));
            const float u = sum16(t01 + t23);
            lgp = ((lane & 15) == e) ? u : lgp; }
        const float ex = expf(lgp - max16(lgp)); const float af = ex / sum16(ex);
        const int g = lane >> 4, q = (g == 1) ? 2 : ((g == 2) ? 1 : g), ee = lane & 15;
        AFFT[(size_t)((row >> 12) * 16 + ee) * TL + ((row + q) & 4095)] = af; SLOT[(size_t)(row + q) * 16 + ee] = -1;
    } else if (ROUTER) {
        float lg[NR];
#pragma unroll
        for (int q = 0; q < NR; ++q) lg[q] = 0.f;
#pragma unroll 1
        for (int e = 0; e < 16; ++e) { float p[NR];
#pragma unroll
            for (int q = 0; q < NR; ++q) p[q] = 0.f;
#pragma unroll
            for (int j = 0; j < 4; ++j) { const f32x4 w = *(const LAS f32x4*)(RT + e * 1024 + 256 * j + 4 * lane);
#pragma unroll
                for (int q = 0; q < NR; ++q) p[q] += v[q][j].x * w.x + v[q][j].y * w.y + v[q][j].z * w.z + v[q][j].w * w.w; }
#pragma unroll
            for (int q = 0; q < NR; ++q) { const float t = wave_sum(p[q]); lg[q] = (lane == e) ? t : lg[q]; } }
#pragma unroll
        for (int q = 0; q < NR; ++q) { const float ex = expf(lg[q] - max16(lg[q])); const float af = ex / sum16(ex);
            if (lane < 16) { AFFT[(size_t)((row >> 12) * 16 + lane) * TL + ((row + q) & 4095)] = af; SLOT[(size_t)(row + q) * 16 + lane] = -1; } }
    }
}
template <bool ROUTER>
DI void norm_row(const Ctx& C, int row, const float* __restrict__ xlat, const float* __restrict__ xctx, const float* __restrict__ gain, const float* __restrict__ mod, int shift_off, int scale_off, bf16* __restrict__ H, float* __restrict__ AFFT, float* __restrict__ AFFC, int* __restrict__ SLOT) {
    const LAS float* RT = (const LAS float*)C.lds; const int lane = C.lane;
    {
        const float* xr = row < NLAT ? xlat + (size_t)row * DM : xctx + (size_t)(row - NLAT) * DM;
        const int mi = row < NLAT ? (row >> 12) : 8;
        const float* mp = mod + mi * 6144;
        f32x4 v[4]; float ss = 0.f;
#pragma unroll
        for (int j = 0; j < 4; ++j) { v[j] = *(const f32x4*)(xr + 256 * j + 4 * lane); ss += v[j].x * v[j].x + v[j].y * v[j].y + v[j].z * v[j].z + v[j].w * v[j].w; }
        ss = wave_sum(ss);
        const float rs = 1.0f / sqrtf(ss * (1.f / 1024.f) + EPS);
#pragma unroll
        for (int j = 0; j < 4; ++j) {
            const int c = 256 * j + 4 * lane;
            const f32x4 g = *(const f32x4*)(gain + c), sc = *(const f32x4*)(mp + scale_off + c), sh = *(const f32x4*)(mp + shift_off + c);
            v[j] = (v[j] * rs) * g * (sc + 1.0f) + sh;
            if (ROUTER && MOE_F8) *(unsigned*)((unsigned char*)H + (size_t)row * DM + c) = pk4_fp8(v[j].x, v[j].y, v[j].z, v[j].w);
            else *(u32x2*)(H + (size_t)row * DM + c) = (u32x2){pk2(v[j].x, v[j].y), pk2(v[j].z, v[j].w)};
        }
        if (ROUTER) {
            float mylg = 0.f;
#pragma unroll 1
            for (int e = 0; e < 16; ++e) { float p = 0.f;
#pragma unroll
                for (int j = 0; j < 4; ++j) { const f32x4 w = *(const LAS f32x4*)(RT + e * 1024 + 256 * j + 4 * lane); p += v[j].x * w.x + v[j].y * w.y + v[j].z * w.z + v[j].w * w.w; }
                p = wave_sum(p); mylg = (lane == e) ? p : mylg; }
            const float mx = max16(mylg);
            const float ex = expf(mylg - mx);
            const float mine = ex / sum16(ex);
            if (lane < 16) {
                if (row < NLAT) AFFT[(size_t)((row >> 12) * 16 + lane) * TL + (row & 4095)] = mine;
                else { const int rc = row - NLAT; AFFC[(size_t)((rc >> 8) * 16 + lane) * LCX + (rc & 255)] = mine; }
                SLOT[(size_t)row * 16 + lane] = -1;
            }
        }
    }
}


struct EpiBf16 { static constexpr bool WIDE = true, CUSTOM = false; bf16* O; int ldo;
    DI void operator()(int row, int col, f32x4 v0, f32x4 v1) const { bf16* p = O + (size_t)row * ldo + col;
        *(u32x2*)p = (u32x2){pk2(v0[0], v0[1]), pk2(v0[2], v0[3])}; *(u32x2*)(p + 128) = (u32x2){pk2(v1[0], v1[1]), pk2(v1[2], v1[3])}; }
    DI void wide(int row, int col, f32x4 a0, f32x4 a1, f32x4 b0, f32x4 b1) const { bf16* p = O + (size_t)row * ldo + col;
        *(u32x4*)p = (u32x4){pk2(a0[0], a0[1]), pk2(a0[2], a0[3]), pk2(a1[0], a1[1]), pk2(a1[2], a1[3])}; *(u32x4*)(p + 128) = (u32x4){pk2(b0[0], b0[1]), pk2(b0[2], b0[3]), pk2(b1[0], b1[1]), pk2(b1[2], b1[3])}; } };
struct EpiF32 { static constexpr bool WIDE = false, CUSTOM = false; float* O; int ldo;
    DI void operator()(int row, int col, f32x4 v0, f32x4 v1) const { float* p = O + (size_t)row * ldo + col; *(f32x4*)p = v0; *(f32x4*)(p + 128) = v1; } };
struct EpiResid { static constexpr bool WIDE = false, CUSTOM = true; const float* xin_lat; const float* xin_ctx; float* xout_lat; float* xout_ctx; const float* modg;
    DI void run(const f32x4 (&acc)[2][2][4][2], int pm, int pn, int wr, int wc, int fr, int fq) const {
        const int r0 = pm * 256 + wr * 64 + fr, c0 = pn * 256 + wc * 32 + 8 * fq; const bool lat = pm * 256 < NLAT;
        const float* xi = lat ? xin_lat + (size_t)r0 * DM : xin_ctx + (size_t)(r0 - NLAT) * DM; float* xo = lat ? xout_lat + (size_t)r0 * DM : xout_ctx + (size_t)(r0 - NLAT) * DM;
        const float* g = modg + (lat ? (pm * 256) >> 12 : 8) * 6144 + c0;
        f32x4 gv[2][2];
#pragma unroll
        for (int n = 0; n < 2; ++n) { gv[n][0] = *(const f32x4*)(g + 4 * n); gv[n][1] = *(const f32x4*)(g + 4 * n + 128); }
#pragma unroll
        for (int ai = 0; ai < 2; ++ai)
#pragma unroll
            for (int mh = 0; mh < 2; ++mh) { f32x4 xv[2][2][2];
#pragma unroll
                for (int m2 = 0; m2 < 2; ++m2)
#pragma unroll
                    for (int n = 0; n < 2; ++n) { const size_t o = (size_t)(ai * 128 + (2 * mh + m2) * 16) * DM + c0 + 4 * n; xv[m2][n][0] = *(const f32x4*)(xi + o); xv[m2][n][1] = *(const f32x4*)(xi + o + 128); }
#pragma unroll
                for (int m2 = 0; m2 < 2; ++m2)
#pragma unroll
                    for (int n = 0; n < 2; ++n) { const size_t o = (size_t)(ai * 128 + (2 * mh + m2) * 16) * DM + c0 + 4 * n;
                        *(f32x4*)(xo + o) = xv[m2][n][0] + gv[n][0] * acc[ai][0][2 * mh + m2][n]; *(f32x4*)(xo + o + 128) = xv[m2][n][1] + gv[n][1] * acc[ai][1][2 * mh + m2][n]; } } }
    DI void operator()(int row, int col, f32x4 v0, f32x4 v1) const {
        const float* xi; float* xo; int mi;
        if (row < NLAT) { xi = xin_lat + (size_t)row * DM; xo = xout_lat + (size_t)row * DM; mi = row >> 12; }
        else { xi = xin_ctx + (size_t)(row - NLAT) * DM; xo = xout_ctx + (size_t)(row - NLAT) * DM; mi = 8; }
        const float* g = modg + mi * 6144 + col;
        const f32x4 g0 = *(const f32x4*)g, g1 = *(const f32x4*)(g + 128), x0 = *(const f32x4*)(xi + col), x1 = *(const f32x4*)(xi + col + 128);
        *(f32x4*)(xo + col) = x0 + g0 * v0; *(f32x4*)(xo + col + 128) = x1 + g1 * v1; } };
struct EpiGlu { static constexpr bool WIDE = false, CUSTOM = false; bf16* O;
    DI void operator()(int row, int col, f32x4 v0, f32x4 v1) const { const int f = ((col & 2047) >> 8) * 128 + (col & 255);
        *(u32x2*)(O + (size_t)row * DM + f) = (u32x2){pk2(siluf_(v0[0]) * v1[0], siluf_(v0[1]) * v1[1]), pk2(siluf_(v0[2]) * v1[2], siluf_(v0[3]) * v1[3])}; } };
struct EpiGlu8 { static constexpr bool WIDE = true, CUSTOM = false; unsigned char* O;
    DI void operator()(int row, int col, f32x4 v0, f32x4 v1) const { const int f = ((col & 2047) >> 8) * 128 + (col & 255);
        *(unsigned*)(O + (size_t)row * DM + f) = pk4_fp8(8.f * siluf_(v0[0]) * v1[0], 8.f * siluf_(v0[1]) * v1[1], 8.f * siluf_(v0[2]) * v1[2], 8.f * siluf_(v0[3]) * v1[3]); }
    DI void wide(int row, int col, f32x4 a0, f32x4 a1, f32x4 b0, f32x4 b1) const { const int f = ((col & 2047) >> 8) * 128 + (col & 255);
        *(u32x2*)(O + (size_t)row * DM + f) = (u32x2){pk4_fp8(8.f * siluf_(a0[0]) * b0[0], 8.f * siluf_(a0[1]) * b0[1], 8.f * siluf_(a0[2]) * b0[2], 8.f * siluf_(a0[3]) * b0[3]),
                                                    pk4_fp8(8.f * siluf_(a1[0]) * b1[0], 8.f * siluf_(a1[1]) * b1[1], 8.f * siluf_(a1[2]) * b1[2], 8.f * siluf_(a1[3]) * b1[3])}; } };
struct EpiGate { static constexpr bool WIDE = true, CUSTOM = true; bf16* O; const float* gate;
    DI void run(const f32x4 (&acc)[2][2][4][2], int pm, int pn, int wr, int wc, int fr, int fq) const {
        const int r0 = pm * 256 + wr * 64 + fr, col = (pn * 256 + wc * 32 + 8 * fq) & 1023; float gt[2][4];
#pragma unroll
        for (int ai = 0; ai < 2; ++ai)
#pragma unroll
            for (int m = 0; m < 4; ++m) gt[ai][m] = gate[r0 + ai * 128 + m * 16];
#pragma unroll
        for (int ai = 0; ai < 2; ++ai)
#pragma unroll
            for (int m = 0; m < 4; ++m) { const float g = gt[ai][m]; bf16* p = O + (size_t)(r0 + ai * 128 + m * 16) * DM + col;
                const f32x4 a0 = acc[ai][0][m][0], a1 = acc[ai][0][m][1], b0 = acc[ai][1][m][0], b1 = acc[ai][1][m][1];
                *(u32x4*)p = (u32x4){pk2(a0[0] * g, a0[1] * g), pk2(a0[2] * g, a0[3] * g), pk2(a1[0] * g, a1[1] * g), pk2(a1[2] * g, a1[3] * g)};
                *(u32x4*)(p + 128) = (u32x4){pk2(b0[0] * g, b0[1] * g), pk2(b0[2] * g, b0[3] * g), pk2(b1[0] * g, b1[1] * g), pk2(b1[2] * g, b1[3] * g)}; } }
    DI void operator()(int row, int col, f32x4 v0, f32x4 v1) const { const float g = gate[row]; bf16* p = O + (size_t)row * DM + (col & 1023);
        *(u32x2*)p = (u32x2){pk2(v0[0] * g, v0[1] * g), pk2(v0[2] * g, v0[3] * g)}; *(u32x2*)(p + 128) = (u32x2){pk2(v1[0] * g, v1[1] * g), pk2(v1[2] * g, v1[3] * g)}; }
    DI void wide(int row, int col, f32x4 a0, f32x4 a1, f32x4 b0, f32x4 b1) const { const float g = gate[row]; bf16* p = O + (size_t)row * DM + (col & 1023);
        *(u32x4*)p = (u32x4){pk2(a0[0] * g, a0[1] * g), pk2(a0[2] * g, a0[3] * g), pk2(a1[0] * g, a1[1] * g), pk2(a1[2] * g, a1[3] * g)};
        *(u32x4*)(p + 128) = (u32x4){pk2(b0[0] * g, b0[1] * g), pk2(b0[2] * g, b0[3] * g), pk2(b1[0] * g, b1[1] * g), pk2(b1[2] * g, b1[3] * g)}; } };
typedef _Float16 f16x2_t __attribute__((ext_vector_type(2)));
DI unsigned pk2h(float a, float b) { f16x2_t h; h.x = (_Float16)a; h.y = (_Float16)b; return __builtin_bit_cast(unsigned, h); }
DI float h2f(unsigned short x) { return (float)__builtin_bit_cast(_Float16, x); }
struct EpiLoraW { static constexpr bool WIDE = false, CUSTOM = true; unsigned short* W; const float* w0;
    DI void one(int row, int col, f32x4 v) const { const int d = col >> 9, c = col & 511; f32x4 o;
#pragma unroll
        for (int e = 0; e < 4; ++e) { const float lw = w0[col + e] + v[e]; const float z = -lw; const float sp = fmaxf(z, 0.f) + __logf(1.f + __expf(-fabsf(z))); o[e] = -__expf(-sp - 0.5f); }
        *(u32x2*)(W + ((size_t)d * MT + row) * 512 + c) = (u32x2){pk2h(o[0], o[1]), pk2h(o[2], o[3])}; }
    DI void operator()(int row, int col, f32x4 v0, f32x4 v1) const { one(row, col, v0); one(row, col + 128, v1); }
    DI void run(const f32x4 (&acc)[2][2][4][2], int pm, int pn, int wr, int wc, int fr, int fq) const {
        const int r0 = pm * 256 + wr * 64 + fr, c0 = pn * 256 + wc * 32 + 8 * fq; f32x4 wv[2][2];
#pragma unroll
        for (int n = 0; n < 2; ++n) { wv[n][0] = *(const f32x4*)(w0 + c0 + 4 * n); wv[n][1] = *(const f32x4*)(w0 + c0 + 4 * n + 128); }
#pragma unroll
        for (int ai = 0; ai < 2; ++ai)
#pragma unroll
            for (int m = 0; m < 4; ++m)
#pragma unroll
                for (int n = 0; n < 2; ++n)
#pragma unroll
                    for (int bj = 0; bj < 2; ++bj) { const int row = r0 + ai * 128 + m * 16, col = c0 + 4 * n + 128 * bj, d = col >> 9, c = col & 511; f32x4 o;
#pragma unroll
                        for (int e = 0; e < 4; ++e) { const float lw = wv[n][bj][e] + acc[ai][bj][m][n][e]; const float z = -lw; const float sp = fmaxf(z, 0.f) + __logf(1.f + __expf(-fabsf(z))); o[e] = -__expf(-sp - 0.5f); }
                        *(u32x2*)(W + ((size_t)d * MT + row) * 512 + c) = (u32x2){pk2h(o[0], o[1]), pk2h(o[2], o[3])}; } } };
struct EpiLoraA { static constexpr bool WIDE = false, CUSTOM = true; bf16* Aout; const float* a0;
    DI void one(int row, int col, f32x4 v) const { const int d = col >> 9, c = col & 511; const f32x4 b = *(const f32x4*)(a0 + col);
        *(u32x2*)(Aout + ((size_t)d * MT + row) * 512 + c) = (u32x2){pk2(sigmoidf_(b[0] + v[0]), sigmoidf_(b[1] + v[1])), pk2(sigmoidf_(b[2] + v[2]), sigmoidf_(b[3] + v[3]))}; }
    DI void operator()(int row, int col, f32x4 v0, f32x4 v1) const { one(row, col, v0); one(row, col + 128, v1); }
    DI void run(const f32x4 (&acc)[2][2][4][2], int pm, int pn, int wr, int wc, int fr, int fq) const {
        const int r0 = pm * 256 + wr * 64 + fr, c0 = pn * 256 + wc * 32 + 8 * fq; f32x4 av[2][2];
#pragma unroll
        for (int n = 0; n < 2; ++n) { av[n][0] = *(const f32x4*)(a0 + c0 + 4 * n); av[n][1] = *(const f32x4*)(a0 + c0 + 4 * n + 128); }
#pragma unroll
        for (int ai = 0; ai < 2; ++ai)
#pragma unroll
            for (int m = 0; m < 4; ++m)
#pragma unroll
                for (int n = 0; n < 2; ++n)
#pragma unroll
                    for (int bj = 0; bj < 2; ++bj) { const int row = r0 + ai * 128 + m * 16, col = c0 + 4 * n + 128 * bj, d = col >> 9, c = col & 511; const f32x4 b = av[n][bj], v = acc[ai][bj][m][n];
                        *(u32x2*)(Aout + ((size_t)d * MT + row) * 512 + c) = (u32x2){pk2(sigmoidf_(b[0] + v[0]), sigmoidf_(b[1] + v[1])), pk2(sigmoidf_(b[2] + v[2]), sigmoidf_(b[3] + v[3]))}; } } };

namespace pg8 {
constexpr int BM = 256, BK = 64, HALF = 128, HTB = HALF * BK * 2, STAGE_BYTES = 8 * HTB;
DI int lds_byte(int r, int c) { const int st = (r >> 4) * 2 + (c >> 5), rr = r & 15, cc = c & 31, ob = rr * 64 + cc * 2; return st * 1024 + (ob ^ (((ob >> 9) & 1) << 5)); }
DI void stage_rc(int b, int& R, int& C) { const int st = b / 1024, sb = b % 1024, swz = sb ^ (((sb >> 9) & 1) << 5); R = (st >> 1) * 16 + swz / 64; C = (st & 1) * 32 + (swz % 64) / 2; }
DI int perm32(int rho) { const int n = rho >> 4, i = rho & 15; return 8 * (i >> 2) + 4 * n + (i & 3); }
struct Unit { int pm, pn; };
struct Gemm { const bf16* A; const bf16* Bt; int lda, K; const int* rows; int scale_w = 0x7f7f7f7f, scale_a = 0x7f7f7f7f; };
struct OrderMN { int nM, nN, G, c;
    DI bool next(int i, Unit& u) const { const int L = i * G + c; if (L >= nM * nN) return false; u.pm = L / nN; u.pn = L % nN; return true; } };
struct OrderMoE { int nMt, nN, mstride  , G, c;
    DI bool next(int i, Unit& u) const { const int L = i * G + c, per = nMt * nN; if (L >= NEXP * per) return false; const int e = L / per, q = L % per; u.pm = e * mstride + q / nN; u.pn = e * nN + q % nN; return true; } };
template <class E4> struct EpiAdapt { E4 e;
    DI void operator()(const f32x4 (&acc)[2][2][4][2], const Unit& u, int wr, int wc, int fr, int fq) const {
        if constexpr (E4::CUSTOM) { e.run(acc, u.pm, u.pn, wr, wc, fr, fq); return; }
#pragma unroll
        for (int ai = 0; ai < 2; ++ai)
#pragma unroll
            for (int m = 0; m < 4; ++m) { const int row = u.pm * BM + ai * HALF + wr * 64 + m * 16 + fr;
                if constexpr (E4::WIDE) e.wide(row, u.pn * BM + wc * 32 + 8 * fq, acc[ai][0][m][0], acc[ai][0][m][1], acc[ai][1][m][0], acc[ai][1][m][1]);
                else {
#pragma unroll
                    for (int n = 0; n < 2; ++n) e(row, u.pn * BM + wc * 32 + 8 * fq + 4 * n, acc[ai][0][m][n], acc[ai][1][m][n]); } } } };

template <class Epi, class Sched, bool F8 = false>
DI void gemm_phase(LAS unsigned char* lds, const Gemm g, const Sched& S, const Epi& E, const int tid) {
    const int wid = __builtin_amdgcn_readfirstlane(tid >> 6), lane = tid & 63, wr = wid >> 2, wc = wid & 3, fr = lane & 15, fq = lane >> 4;
    const int K = g.K, nt = K / BK;
    unsigned voffB[2];
#pragma unroll
    for (int i = 0; i < 2; ++i) { int R, C; stage_rc(tid * 16 + i * 8192, R, C); const int Rb = (R & ~31) + perm32(R & 31); voffB[i] = (unsigned)(Rb * K + C) * 2u; }
    const size_t kstep = (size_t)(BK * 2), hstep = (size_t)HALF * K * 2, tstep = 2 * hstep;
    const unsigned ldsw = (unsigned)wid * 1024u;
    const int aoff = lds_byte(wr * 64 + fr, fq * 8), boff = lds_byte(wc * 32 + fr, fq * 8);
    const char* const gA = (const char*)g.A;
#define PG8_SA(b, h) (((b) * 2 + (h)) * HTB)
#define PG8_SB(b, h) ((4 + (b) * 2 + (h)) * HTB)
#define PG8_STAGE(bufoff, gbase, voff) do { _Pragma("unroll") for (int _i = 0; _i < 2; ++_i) \
        __builtin_amdgcn_global_load_lds((const unsigned*)((const char*)(gbase) + (voff)[_i]), (LAS unsigned*)(lds + (bufoff) + ldsw + _i * 8192), 16, 0, 0); } while (0)
#define PG8_LDA(dst, b, h) do { _Pragma("unroll") for (int m = 0; m < 4; ++m) _Pragma("unroll") for (int k = 0; k < 2; ++k) dst[m][k] = *(const LAS bf16x8*)(lds + PG8_SA(b, h) + aoff + m * 2048 + k * 1024); } while (0)
#define PG8_LDB(dst, b, h) do { _Pragma("unroll") for (int n = 0; n < 2; ++n) _Pragma("unroll") for (int k = 0; k < 2; ++k) dst[n][k] = *(const LAS bf16x8*)(lds + PG8_SB(b, h) + boff + n * 2048 + k * 1024); } while (0)
#define PG8_MMA(ai, bj, At, Bt) do { __builtin_amdgcn_s_setprio(1); _Pragma("unroll") for (int m = 0; m < 4; ++m) _Pragma("unroll") for (int n = 0; n < 2; ++n) { \
        if constexpr (F8) { const v8i_t w8 = __builtin_shufflevector(__builtin_bit_cast(i32x4_t, Bt[n][0]), __builtin_bit_cast(i32x4_t, Bt[n][1]), 0, 1, 2, 3, 4, 5, 6, 7), x8 = __builtin_shufflevector(__builtin_bit_cast(i32x4_t, At[m][0]), __builtin_bit_cast(i32x4_t, At[m][1]), 0, 1, 2, 3, 4, 5, 6, 7); \
            acc[ai][bj][m][n] = __builtin_amdgcn_mfma_scale_f32_16x16x128_f8f6f4(w8, x8, acc[ai][bj][m][n], 0, 0, 0, g.scale_w, 0, g.scale_a); } \
        else { _Pragma("unroll") for (int k = 0; k < 2; ++k) acc[ai][bj][m][n] = __builtin_amdgcn_mfma_f32_16x16x32_bf16(Bt[n][k], At[m][k], acc[ai][bj][m][n], 0, 0, 0); } } __builtin_amdgcn_s_setprio(0); } while (0)
#define PG8_WAIT_V(n) asm volatile("s_waitcnt vmcnt(" #n ")" ::: "memory")
#define PG8_WAIT_L(n) asm volatile("s_waitcnt lgkmcnt(" #n ")" ::: "memory")
#define PG8_BAR __builtin_amdgcn_s_barrier()
#define PG8_SCHED __builtin_amdgcn_sched_barrier(0)
#define PG8_ROWIDX(ri, u) do { _Pragma("unroll") for (int _h = 0; _h < 2; ++_h) _Pragma("unroll") for (int _i = 0; _i < 2; ++_i) { int _R, _C; stage_rc(tid * 16 + _i * 8192, _R, _C); (void)_C; \
        const int _lr = (u).pm * BM + _h * HALF + _R; ri[_h][_i] = g.rows ? g.rows[_lr] : _lr; } } while (0)
#define PG8_AOFF_FROM(vo, ri) do { _Pragma("unroll") for (int _h = 0; _h < 2; ++_h) _Pragma("unroll") for (int _i = 0; _i < 2; ++_i) { int _R, _C; stage_rc(tid * 16 + _i * 8192, _R, _C); (void)_R; \
        vo[_h][_i] = (unsigned)(((size_t)ri[_h][_i] * g.lda + _C) * 2u); } } while (0)
    Unit cur, nxt; int ui = 0;
    if (!S.next(0, cur)) return;
    f32x4 acc[2][2][4][2];
#pragma unroll
    for (int a = 0; a < 2; ++a)
#pragma unroll
        for (int b = 0; b < 2; ++b)
#pragma unroll
            for (int m = 0; m < 4; ++m)
#pragma unroll
                for (int n = 0; n < 2; ++n) acc[a][b][m][n] = (f32x4){0.f, 0.f, 0.f, 0.f};
    bf16x8 At[4][2], B0[2][2], B1[2][2];
    unsigned cvo[2][2]; int nri[2][2];
    PG8_ROWIDX(nri, cur); PG8_AOFF_FROM(cvo, nri);
    const char* cB = (const char*)g.Bt + (size_t)cur.pn * tstep;
    PG8_STAGE(PG8_SB(0, 0), cB, voffB); PG8_STAGE(PG8_SB(0, 1), cB + hstep, voffB); PG8_STAGE(PG8_SA(0, 0), gA, cvo[0]); PG8_STAGE(PG8_SA(0, 1), gA, cvo[1]);
    if (wr == 1) PG8_BAR;
    PG8_WAIT_V(2); PG8_BAR;
    PG8_STAGE(PG8_SB(1, 0), cB + kstep, voffB); PG8_STAGE(PG8_SA(1, 0), gA + kstep, cvo[0]); PG8_STAGE(PG8_SB(1, 1), cB + hstep + kstep, voffB);
    PG8_WAIT_V(6); PG8_BAR;
    for (;;) {
        const bool has_next = S.next(ui + 1, nxt);
        const char* nB = has_next ? (const char*)g.Bt + (size_t)nxt.pn * tstep : cB;
#pragma nounroll
        for (int t = 0; t < nt; t += 2) {
            const bool last = (t == nt - 2);
            const char* a1 = gA + (size_t)(t + 1) * kstep;
            const char* a2 = last ? gA : gA + (size_t)(t + 2) * kstep; const char* b2 = last ? nB : cB + (size_t)(t + 2) * kstep;
            const char* a3 = a2 + kstep; const char* b3 = b2 + kstep;
            if (t == nt - 4 && has_next) PG8_ROWIDX(nri, nxt);
            PG8_LDB(B0, 0, 0); PG8_LDB(B1, 0, 1); PG8_SCHED; PG8_LDA(At, 0, 0); PG8_STAGE(PG8_SA(1, 1), a1, cvo[1]);
            if (last && has_next) { if (nt < 4) PG8_ROWIDX(nri, nxt); PG8_AOFF_FROM(cvo, nri); }
            PG8_WAIT_V(8); PG8_WAIT_L(0); PG8_BAR; PG8_MMA(0, 0, At, B0); PG8_MMA(0, 1, At, B1); PG8_BAR; PG8_SCHED;
            PG8_LDA(At, 0, 1); PG8_STAGE(PG8_SB(0, 0), b2, voffB); PG8_STAGE(PG8_SB(0, 1), b2 + hstep, voffB); PG8_STAGE(PG8_SA(0, 0), a2, cvo[0]);
            PG8_WAIT_V(8); PG8_WAIT_L(0); PG8_BAR; PG8_MMA(1, 0, At, B0); PG8_MMA(1, 1, At, B1); PG8_BAR; PG8_SCHED;
            PG8_LDB(B0, 1, 0); PG8_LDB(B1, 1, 1); PG8_SCHED; PG8_LDA(At, 1, 0); PG8_STAGE(PG8_SA(0, 1), a2, cvo[1]);
            PG8_WAIT_V(8); PG8_WAIT_L(0); PG8_BAR; PG8_MMA(0, 0, At, B0); PG8_MMA(0, 1, At, B1); PG8_BAR; PG8_SCHED;
            PG8_LDA(At, 1, 1); PG8_STAGE(PG8_SB(1, 0), b3, voffB); PG8_STAGE(PG8_SB(1, 1), b3 + hstep, voffB); PG8_STAGE(PG8_SA(1, 0), a3, cvo[0]);
            PG8_WAIT_V(8); PG8_WAIT_L(0); PG8_BAR; PG8_MMA(1, 0, At, B0); PG8_MMA(1, 1, At, B1); PG8_BAR; PG8_SCHED;
        }
        if (wr == 0) PG8_BAR;
        E(acc, cur, wr, wc, fr, fq);
        if (!has_next) break;
#pragma unroll
        for (int a = 0; a < 2; ++a)
#pragma unroll
            for (int b = 0; b < 2; ++b)
#pragma unroll
                for (int m = 0; m < 4; ++m)
#pragma unroll
                    for (int n = 0; n < 2; ++n) acc[a][b][m][n] = (f32x4){0.f, 0.f, 0.f, 0.f};
        cur = nxt; cB = nB; ++ui;
        if (wr == 1) PG8_BAR;
    }
    PG8_WAIT_V(0);
    PG8_BAR;
#undef PG8_SA
#undef PG8_SB
#undef PG8_STAGE
#undef PG8_LDA
#undef PG8_LDB
#undef PG8_MMA
#undef PG8_WAIT_V
#undef PG8_WAIT_L
#undef PG8_BAR
#undef PG8_SCHED
#undef PG8_ROWIDX
#undef PG8_AOFF_FROM
}
}
template <class E4> DI void fast_gemm(const Ctx& C, const bf16* A, int lda, const bf16* Bt, int K, int nM, int nN, const E4& e, bool rev = false) {
    pg8::Gemm g{A, Bt, lda, K, nullptr}; pg8::OrderMN S{nM, nN, C.nb, rev ? C.nb - 1 - C.vcu : C.vcu}; pg8::EpiAdapt<E4> E{e};
    pg8::gemm_phase(C.lds, g, S, E, C.tid);
}

DI float max16_acc(float m, const f32x16& x) {
    asm volatile("s_nop 15\n\tv_max3_f32 %0, %0, %1, %2\n\tv_max3_f32 %0, %0, %3, %4\n\tv_max3_f32 %0, %0, %5, %6\n\tv_max3_f32 %0, %0, %7, %8\n\tv_max3_f32 %0, %0, %9, %10\n\tv_max3_f32 %0, %0, %11, %12\n\tv_max3_f32 %0, %0, %13, %14\n\tv_max3_f32 %0, %0, %15, %16"
                 : "+v"(m) : "v"(x[0]), "v"(x[1]), "v"(x[2]), "v"(x[3]), "v"(x[4]), "v"(x[5]), "v"(x[6]), "v"(x[7]), "v"(x[8]), "v"(x[9]), "v"(x[10]), "v"(x[11]), "v"(x[12]), "v"(x[13]), "v"(x[14]), "v"(x[15]));
    return m; }
DI int swap23(int x) { return (x & ~12) | ((x & 4) << 1) | ((x & 8) >> 1); }
DI void flash_store(const f32x16 (&o)[2], float l, bf16* orow  , int h) {
    const float inv = 1.f / l;
#pragma unroll
    for (int dt = 0; dt < 2; ++dt)
#pragma unroll
        for (int g = 0; g < 4; ++g)
            *(u32x2*)(orow + 32 * dt + 8 * g + 4 * h) = (u32x2){pk2(o[dt][4 * g] * inv, o[dt][4 * g + 1] * inv), pk2(o[dt][4 * g + 2] * inv, o[dt][4 * g + 3] * inv)};
}


template <int DQK> struct AttnGeo { static constexpr int KSTR = DQK * 2 + 16, KBYTES = 64 * KSTR, VSTR = 144, VBYTES = 64 * VSTR, BUF = KBYTES + VBYTES, KPIECES = 64 * DQK / 8; };
template <int DQK, bool NAT>
DI void attn_tile_loop(const Ctx& C, f32x16 (&o)[2], float& l, const bf16x8 (&qf)[DQK / 16], const bf16* __restrict__ Kb, const bf16* __restrict__ Vt, int pos1, int n1, int pos2, int n2,
                       const LAS float* tab, int grow, int rs, int qc, int cs) {
    typedef AttnGeo<DQK> G;
    const int tid = C.tid, r = C.lane & 31, h = C.lane >> 5, kr = swap23(r), ntiles = n1 + n2;
    constexpr bool K2 = G::KPIECES > 512;
    const int kq0 = tid, kq1 = tid + 512;
    const int kl0 = (kq0 / (DQK / 8)) * G::KSTR + (kq0 % (DQK / 8)) * 16, kl1 = (kq1 / (DQK / 8)) * G::KSTR + (kq1 % (DQK / 8)) * 16;
    const int vl = G::KBYTES + (tid >> 3) * G::VSTR + (tid & 7) * 16;
    const bf16* vg = Vt + (size_t)(tid >> 3) * KPOS + 8 * (tid & 7);
    u32x4 rk0, rk1, rv;
    rk1 = (u32x4){0u, 0u, 0u, 0u};
#define ATT_POS(t) ((t) < n1 ? pos1 + 64 * (t) : pos2 + 64 * ((t) - n1))
    { const int pos0 = ATT_POS(0); rk0 = *(const u32x4*)(Kb + (size_t)pos0 * DQK + 8 * kq0); if (K2 && tid < 256) rk1 = *(const u32x4*)(Kb + (size_t)pos0 * DQK + 8 * kq1); rv = *(const u32x4*)(vg + pos0); }
    __syncthreads();
    *(LAS u32x4*)(C.lds + kl0) = rk0; if (K2 && tid < 256) *(LAS u32x4*)(C.lds + kl1) = rk1; *(LAS u32x4*)(C.lds + vl) = rv;
    __syncthreads();
    if (C.wave >= 4) __builtin_amdgcn_s_setprio(1);
    float mref = 0.f; bool first = true;
    f32x16 nmref;
#pragma unroll
    for (int i = 0; i < 16; ++i) nmref[i] = 0.f;
    constexpr float THR = 8.f;
    for (int t = 0; t < ntiles; ++t) {
        const LAS unsigned char* B = C.lds + (t & 1) * G::BUF;
        if (t + 1 < ntiles) { const int pos0 = ATT_POS(t + 1);
            rk0 = *(const u32x4*)(Kb + (size_t)pos0 * DQK + 8 * kq0); if (K2 && tid < 256) rk1 = *(const u32x4*)(Kb + (size_t)pos0 * DQK + 8 * kq1); rv = *(const u32x4*)(vg + pos0); }
        const int gr = (pos1 >> 6) + t;
        const bool active = !NAT || t >= n1 || (gr >= rs && gr < rs + 8);
        if (active) {
            f32x16 sc[2];
            constexpr int NK = DQK / 16, NS = 2 * NK, RD = 4;
            const LAS unsigned char* kp = B + kr * G::KSTR + 16 * h;
            bf16x8 fr[RD];
#pragma unroll
            for (int s = 0; s < RD; ++s) fr[s] = *(const LAS bf16x8*)(kp + (s / NK) * 32 * G::KSTR + 32 * (s % NK));
#pragma unroll
            for (int s = 0; s < NS; ++s) { sc[s / NK] = MFMA32(fr[s % RD], qf[s % NK], (s % NK == 0) ? nmref : sc[s / NK]);
                if (s + RD < NS) fr[s % RD] = *(const LAS bf16x8*)(kp + ((s + RD) / NK) * 32 * G::KSTR + 32 * ((s + RD) % NK)); }
            const LAS unsigned char* vp = B + G::KBYTES + r * G::VSTR + 16 * h;
#pragma unroll
            for (int v = 0; v < RD; ++v) fr[v] = *(const LAS bf16x8*)(vp + (v & 1) * 32 * G::VSTR + (v >> 1) * 32);
            __builtin_amdgcn_sched_group_barrier(0x100, RD, 0);
#pragma unroll
            for (int s = 0; s < NS - RD; ++s) { __builtin_amdgcn_sched_group_barrier(0x008, 1, 0); __builtin_amdgcn_sched_group_barrier(0x100, 1, 0); }
            __builtin_amdgcn_sched_group_barrier(0x008, RD, 0);
            __builtin_amdgcn_sched_group_barrier(0x100, RD, 0);
            if (NAT && t < n1) {
                const LAS float* trl = tab + (gr - grow + 7) * 128 + (8 * h - qc + 63);
#pragma unroll
                for (int j = 0; j < 2; ++j) { float bv[16];
#pragma unroll
                    for (int i = 0; i < 16; ++i) bv[i] = trl[32 * j + ((i & 3) | (((i >> 2) & 1) << 2) | ((i >> 3) << 4))];
                    asm volatile("" : "+v"(bv[0]), "+v"(bv[1]), "+v"(bv[2]), "+v"(bv[3]), "+v"(bv[4]), "+v"(bv[5]), "+v"(bv[6]), "+v"(bv[7]), "+v"(bv[8]), "+v"(bv[9]), "+v"(bv[10]), "+v"(bv[11]), "+v"(bv[12]), "+v"(bv[13]), "+v"(bv[14]), "+v"(bv[15]));
#pragma unroll
                    for (int i = 0; i < 16; ++i) {
                        const int cc = 32 * j + ((i & 3) | (((i >> 2) & 1) << 2) | ((i >> 3) << 4)) + 8 * h; const bool ok = (cc >= cs) && (cc < cs + 16);
                        sc[j][i] = ok ? sc[j][i] + bv[i] : -1e30f;
                    } }
            }
            float mx = max16_acc(max16_acc(-3.0e38f, sc[0]), sc[1]);
            if (first || __builtin_amdgcn_ballot_w64(mx > THR) != 0ull) {
                mx = fmaxf(mx, xor32(mx, C.lane));
                const float delta = first ? mx : fmaxf(mx, 0.f);
#pragma unroll
                for (int i = 0; i < 16; ++i) { sc[0][i] -= delta; sc[1][i] -= delta; }
                if (!first) { const float alpha = __builtin_amdgcn_exp2f(-delta); l *= alpha;
#pragma unroll
                    for (int i = 0; i < 16; ++i) { o[0][i] *= alpha; o[1][i] *= alpha; } }
                mref += delta; first = false;
#pragma unroll
                for (int i = 0; i < 16; ++i) nmref[i] = -mref;
            }
            float rs1 = 0.f;
#pragma unroll
            for (int j = 0; j < 2; ++j)
#pragma unroll
                for (int i = 0; i < 16; ++i) { sc[j][i] = __builtin_amdgcn_exp2f(sc[j][i]); rs1 += sc[j][i]; }
            l += rs1;
#pragma unroll
            for (int j = 0; j < 2; ++j)
#pragma unroll
                for (int s2 = 0; s2 < 2; ++s2) {
                    u32x4 pw; pw.x = pk2(sc[j][8 * s2], sc[j][8 * s2 + 1]); pw.y = pk2(sc[j][8 * s2 + 2], sc[j][8 * s2 + 3]); pw.z = pk2(sc[j][8 * s2 + 4], sc[j][8 * s2 + 5]); pw.w = pk2(sc[j][8 * s2 + 6], sc[j][8 * s2 + 7]);
                    const bf16x8 pb = __builtin_bit_cast(bf16x8, pw);
#pragma unroll
                    for (int dt = 0; dt < 2; ++dt) { const int v = 4 * j + 2 * s2 + dt;
                        o[dt] = MFMA32(fr[v % RD], pb, o[dt]);
                        if (v + RD < 8) fr[v % RD] = *(const LAS bf16x8*)(vp + ((v + RD) & 1) * 32 * G::VSTR + ((v + RD) >> 1) * 32); }
                }
#pragma unroll
            for (int v = 0; v < 8 - RD; ++v) { __builtin_amdgcn_sched_group_barrier(0x008, 1, 1); __builtin_amdgcn_sched_group_barrier(0x100, 1, 1); }
            __builtin_amdgcn_sched_group_barrier(0x008, RD, 1);
        }
        if (t + 1 < ntiles) { LAS unsigned char* Bn = C.lds + ((t + 1) & 1) * G::BUF;
            *(LAS u32x4*)(Bn + kl0) = rk0; if (K2 && tid < 256) *(LAS u32x4*)(Bn + kl1) = rk1; *(LAS u32x4*)(Bn + vl) = rv; }
        __syncthreads();
    }
    __builtin_amdgcn_s_setprio(0);
    l += xor32(l, C.lane);
#undef ATT_POS
}
DI void conv_unit(const Ctx& C, int u, const bf16* U, const float (&wk)[31], float bias, const float* lng, const float* lnb, bf16* OCAT);
DI const float* in_ptr(const unsigned char* ws, int k);
constexpr int CONV_PER_TAIL = 3;
DI int conv_in_fin(int nb) { const int extra = (MT / 64) % nb; const int n = CONV_PER_TAIL * (nb - extra); return n < MT / 32 ? n : MT / 32; }
DI void ph_attn_mla2(const Ctx& C, const bf16* QB, const bf16* KB, const bf16* VT, bf16* OCAT, bool last, unsigned char* ws, int lq) {
    const int r = C.lane & 31, h = C.lane >> 5;
    const int nunits = 1024 + (last ? 0 : 64);
    int k = 0;
    for (;; ++k) {
        const int u = C.vcu + k * C.nb, cu = conv_in_fin(C.nb) + (C.nb - 1 - C.vcu) + k * C.nb;
        const bool a_on = u < nunits, c_on = cu < MT / 32;
        if (!a_on && !c_on) break;
        if (a_on) {
            const int bh = u < 1024 ? (u >> 4) : u - 1024, qblk = u < 1024 ? (u & 15) : 16, b = bh >> 3, hh = bh & 7;
            const int qpos = qblk * 256 + 32 * C.wave + r;
            const bf16* qp = QB + ((size_t)bh * KPOS + qpos) * 96 + 8 * h;
            bf16x8 qf[6];
#pragma unroll
            for (int kk = 0; kk < 6; ++kk) qf[kk] = *(const bf16x8*)(qp + 16 * kk);
            f32x16 o[2];
#pragma unroll
            for (int i = 0; i < 16; ++i) { o[0][i] = 0.f; o[1][i] = 0.f; }
            float l = 0.f;
            attn_tile_loop<96, false>(C, o, l, qf, KB + (size_t)bh * KPOS * 96, VT + (size_t)bh * 64 * KPOS, qblk < 16 ? 0 : TL, qblk < 16 ? KPOS / 64 : LCX / 64, 0, 0, nullptr, 0, 0, 0, 0);
            const int row = qblk < 16 ? b * TL + qpos : NLAT + b * LCX + (qpos - TL);
            flash_store(o, l, OCAT + (size_t)row * DM + hh * 64, h);
        }
        if (c_on) { float wk[31]; const float* dww = in_ptr(ws, I_DWW) + (size_t)lq * 31 * 512;
#pragma unroll
            for (int kt = 0; kt < 31; ++kt) wk[kt] = dww[kt * 512 + C.tid];
            conv_unit(C, cu, (const bf16*)(ws + WS_ARENA + A_U), wk, in_ptr(ws, I_DWB)[lq * 512 + C.tid], in_ptr(ws, I_LNG) + lq * 512, in_ptr(ws, I_LNB) + lq * 512, OCAT); }
    }
}
DI void ph_natten2(const Ctx& C, const bf16* QN, const bf16* KN, const bf16* VTN, bf16* OCAT, const float* rpb  , bool last, unsigned* work_ctr, unsigned char* ws, int lq) {
    const int r = C.lane & 31, h = C.lane >> 5;
    LAS float* tab = (LAS float*)(C.lds + 2 * AttnGeo<64>::BUF);
    LAS int* uslot = (LAS int*)(tab + 1920);
    const int nunits = 1024 + (last ? 0 : 64);
    for (;;) {
        __syncthreads();
        if (C.tid == 0) *uslot = (int)__hip_atomic_fetch_add(work_ctr, 1u, __ATOMIC_RELAXED, __HIP_MEMORY_SCOPE_AGENT);
        __syncthreads();
        const int u = *uslot;
        if (u >= nunits) break;
        const bool isctx = u >= 1024;
        const int bh = isctx ? u - 1024 : (u >> 4), b = bh >> 3, hh = bh & 7;
        for (int i = C.tid; i < 15 * 128; i += 512) { const int dc = (i & 127) - 48; tab[i] = (dc >= 0 && dc < 31) ? rpb[hh * 465 + (i >> 7) * 31 + dc] * LOG2E : 0.f; }
        int qpos, row, grow = 0, qc = 0, rs = 0, cs = 0, rlo = 0, nband = 0;
        if (!isctx) { const int rg = u & 15; grow = 4 * rg + (C.wave >> 1); qc = 32 * (C.wave & 1) + r; qpos = grow * 64 + qc; row = b * TL + qpos;
            rs = grow - 4; rs = rs < 0 ? 0 : (rs > 56 ? 56 : rs); cs = qc - 8; cs = cs < 0 ? 0 : (cs > 48 ? 48 : cs);
            rlo = 4 * rg - 4; rlo = rlo < 0 ? 0 : (rlo > 56 ? 56 : rlo); int rhi = 4 * rg + 3 - 4; rhi = rhi < 0 ? 0 : (rhi > 56 ? 56 : rhi); nband = rhi + 8 - rlo; }
        else { qpos = TL + 32 * C.wave + r; row = NLAT + b * LCX + 32 * C.wave + r; }
        const bf16* qp = QN + ((size_t)bh * KPOS + qpos) * 64 + 8 * h;
        bf16x8 qf[4];
#pragma unroll
        for (int kk = 0; kk < 4; ++kk) qf[kk] = *(const bf16x8*)(qp + 16 * kk);
        f32x16 o[2];
#pragma unroll
        for (int i = 0; i < 16; ++i) { o[0][i] = 0.f; o[1][i] = 0.f; }
        float l = 0.f;
        attn_tile_loop<64, true>(C, o, l, qf, KN + (size_t)bh * KPOS * 64, VTN + (size_t)bh * 64 * KPOS, rlo * 64, nband, TL, LCX / 64, tab, grow, rs, qc, cs);
        flash_store(o, l, OCAT + (size_t)row * DM + 512 + hh * 64, h);
    }
}


DI void ph_mla_fin(const Ctx& C, const bf16* __restrict__ U, const bf16* __restrict__ QPRE, const bf16* __restrict__ KVPRE, const float* __restrict__ qg, const float* __restrict__ kg, const f32x2* __restrict__ CS, bf16* __restrict__ QB, bf16* __restrict__ KB, bf16* __restrict__ VT) {
    LAS bf16* VL = (LAS bf16*)C.lds;
    const int lane = C.lane, j = lane >> 3, sub = lane & 7;
    const float C2 = 0.10206207261596575f * LOG2E;
    float qgn[8], qgr[4], kgn[8], kgr[4];
#pragma unroll
    for (int e = 0; e < 8; ++e) { qgn[e] = qg[8 * sub + e] * C2; kgn[e] = kg[8 * sub + e]; }
#pragma unroll
    for (int m = 0; m < 4; ++m) { qgr[m] = qg[64 + sub + 8 * m] * C2; kgr[m] = kg[64 + sub + 8 * m]; }
    for (int u = C.vcu; u < MT / 64; u += C.nb) {
        const int row0 = 64 * u, b = row0 < NLAT ? (row0 >> 12) : ((row0 - NLAT) >> 8), pos0 = row0 < NLAT ? (row0 & 4095) : TL + ((row0 - NLAT) & 255);
        const bool lat = row0 < NLAT;
        const int pl = 8 * C.wave + j, row = row0 + pl, pos = pos0 + pl;
        const bf16* ur = U + (size_t)row * EV_INP;
        float sq = 0.f, skv = 0.f;
#pragma unroll
        for (int m = 0; m < 6; ++m) { float x[8]; unpack8(*(const u32x4*)(ur + 8 * (sub + 8 * m)), x);
#pragma unroll
            for (int e = 0; e < 8; ++e) sq += x[e] * x[e]; }
#pragma unroll
        for (int m = 0; m < 4; ++m) { float x[8]; unpack8(*(const u32x4*)(ur + 384 + 8 * (sub + 8 * m)), x);
#pragma unroll
            for (int e = 0; e < 8; ++e) skv += x[e] * x[e]; }
        sq = sum8(sq); skv = sum8(skv);
        const float rsq = 1.0f / sqrtf(sq * (1.f / 384.f) + EPS), rskv = 1.0f / sqrtf(skv * (1.f / 256.f) + EPS);
        float krv[4];
#pragma unroll
        for (int m = 0; m < 4; ++m) krv[m] = bf2f(ur[640 + sub + 8 * m]);
        float cr = 1.f, sr = 0.f, cc = 1.f, sc = 0.f;
        if (lat) { const f32x2 a0 = CS[pos * 16 + sub], a1 = CS[pos * 16 + 8 + sub]; cr = a0.x; sr = a0.y; cc = a1.x; sc = a1.y; }
        const bf16* qrow = QPRE + (size_t)row * 768; const bf16* kvrow = KVPRE + (size_t)row * 1024;
#pragma unroll 2
        for (int hh = 0; hh < 8; ++hh) {
            { float qn[8], qr[4]; unpack8(*(const u32x4*)(qrow + hh * 96 + 8 * sub), qn); float ss = 0.f;
#pragma unroll
              for (int e = 0; e < 8; ++e) qn[e] *= rsq;
#pragma unroll
              for (int m = 0; m < 4; ++m) { qr[m] = bf2f(qrow[hh * 96 + 64 + sub + 8 * m]) * rsq; ss += qr[m] * qr[m]; }
#pragma unroll
              for (int e = 0; e < 8; ++e) ss += qn[e] * qn[e];
              const float rn = 1.0f / sqrtf(sum8(ss) * (1.f / 96.f) + EPS);
#pragma unroll
              for (int e = 0; e < 8; ++e) qn[e] *= rn * qgn[e];
#pragma unroll
              for (int m = 0; m < 4; ++m) qr[m] *= rn * qgr[m];
              { const float x0 = qr[0], x1 = qr[1], y0 = qr[2], y1 = qr[3]; qr[0] = x0 * cr - x1 * sr; qr[1] = x1 * cr + x0 * sr; qr[2] = y0 * cc - y1 * sc; qr[3] = y1 * cc + y0 * sc; }
              bf16* qo = QB + ((size_t)(b * 8 + hh) * KPOS + pos) * 96;
              *(u32x4*)(qo + 8 * sub) = pack8(qn);
#pragma unroll
              for (int m = 0; m < 4; ++m) qo[64 + sub + 8 * m] = f2bf(qr[m]); }
            { float kn[8], kr[4]; unpack8(*(const u32x4*)(kvrow + hh * 128 + 8 * sub), kn); float ss = 0.f;
#pragma unroll
              for (int e = 0; e < 8; ++e) kn[e] *= rskv;
#pragma unroll
              for (int m = 0; m < 4; ++m) { kr[m] = krv[m]; ss += kr[m] * kr[m]; }
#pragma unroll
              for (int e = 0; e < 8; ++e) ss += kn[e] * kn[e];
              const float rn = 1.0f / sqrtf(sum8(ss) * (1.f / 96.f) + EPS);
#pragma unroll
              for (int e = 0; e < 8; ++e) kn[e] *= rn * kgn[e];
#pragma unroll
              for (int m = 0; m < 4; ++m) kr[m] *= rn * kgr[m];
              { const float x0 = kr[0], x1 = kr[1], y0 = kr[2], y1 = kr[3]; kr[0] = x0 * cr - x1 * sr; kr[1] = x1 * cr + x0 * sr; kr[2] = y0 * cc - y1 * sc; kr[3] = y1 * cc + y0 * sc; }
              bf16* ko = KB + ((size_t)(b * 8 + hh) * KPOS + pos) * 96;
              *(u32x4*)(ko + 8 * sub) = pack8(kn);
#pragma unroll
              for (int m = 0; m < 4; ++m) ko[64 + sub + 8 * m] = f2bf(kr[m]); }
            { float vv[8]; unpack8(*(const u32x4*)(kvrow + hh * 128 + 64 + 8 * sub), vv);
#pragma unroll
              for (int e = 0; e < 8; ++e) VL[(hh * 64 + 8 * sub + e) * 64 + pl] = f2bf(vv[e] * rskv); }
        }
        __syncthreads();
        { const int hd = C.tid;
            bf16* dst = VT + ((size_t)(b * 8 + (hd >> 6)) * 64 + (hd & 63)) * KPOS + pos0;
#pragma unroll
            for (int q = 0; q < 8; ++q) *(u32x4*)(dst + 8 * q) = *(const LAS u32x4*)(VL + hd * 64 + 8 * q); }
        __syncthreads();
    }
}

DI void conv_unit(const Ctx& C, int u, const bf16* __restrict__ U, const float (&wk)[31], float bias, const float* __restrict__ lng, const float* __restrict__ lnb, bf16* __restrict__ OCAT) {
    LAS float* G = (LAS float*)C.lds;
    const int c = C.tid;
    const int row0 = 32 * u; int base, t0, tseq;
    if (row0 < NLAT) { base = row0 & ~4095; t0 = row0 & 4095; tseq = TL; } else { const int rc = row0 - NLAT; base = NLAT + (rc & ~255); t0 = rc & 255; tseq = LCX; }
    __syncthreads();
    for (int rr = C.wave; rr < 62; rr += 8) { const int tt = t0 - 15 + rr; float g[8];
#pragma unroll
        for (int e = 0; e < 8; ++e) g[e] = 0.f;
        if (tt >= 0 && tt < tseq) { const bf16* ur = U + (size_t)(base + tt) * EV_INP; float av[8], gv[8]; unpack8(*(const u32x4*)(ur + 672 + 8 * C.lane), av); unpack8(*(const u32x4*)(ur + 1184 + 8 * C.lane), gv);
#pragma unroll
            for (int e = 0; e < 8; ++e) g[e] = av[e] * sigmoidf_(gv[e]); }
        *(LAS f32x4*)(G + rr * 512 + 8 * C.lane) = (f32x4){g[0], g[1], g[2], g[3]}; *(LAS f32x4*)(G + rr * 512 + 8 * C.lane + 4) = (f32x4){g[4], g[5], g[6], g[7]}; }
    __syncthreads();
    float acc[32];
#pragma unroll
    for (int t = 0; t < 32; ++t) acc[t] = bias;
#pragma unroll
    for (int rr = 0; rr < 62; ++rr) { const float gv = G[rr * 512 + c];
#pragma unroll
        for (int t = 0; t < 32; ++t) { const int k = rr - t; if (k >= 0 && k < 31) acc[t] += gv * wk[k]; } }
    __syncthreads();
#pragma unroll
    for (int t = 0; t < 32; ++t) G[t * 512 + c] = acc[t];
    __syncthreads();
#pragma unroll
    for (int q = 0; q < 4; ++q) {
        const int t = 4 * C.wave + q, row = row0 + t;
        const f32x4 a0 = *(const LAS f32x4*)(G + t * 512 + 8 * C.lane), a1 = *(const LAS f32x4*)(G + t * 512 + 8 * C.lane + 4);
        float x[8] = {a0.x, a0.y, a0.z, a0.w, a1.x, a1.y, a1.z, a1.w}; float s = 0.f;
#pragma unroll
        for (int e = 0; e < 8; ++e) s += x[e];
        const float mu = wave_sum(s) * (1.f / 512.f); float s2 = 0.f;
#pragma unroll
        for (int e = 0; e < 8; ++e) { x[e] -= mu; s2 += x[e] * x[e]; }
        const float rstd = 1.0f / sqrtf(wave_sum(s2) * (1.f / 512.f) + EPS);
        float y[8];
#pragma unroll
        for (int e = 0; e < 8; ++e) { const float z = x[e] * rstd * lng[8 * C.lane + e] + lnb[8 * C.lane + e]; y[e] = siluf_(z); }
        *(u32x4*)(OCAT + (size_t)row * DM + 512 + 8 * C.lane) = pack8(y);
    }
    __syncthreads();
}
DI void wprep_span(const Ctx& C, int first, int stride, const float* w1, const float* w3, const float* w2, bf16* W13, bf16* W2) {
    LAS float* scr = (LAS float*)(C.lds + C.wave * 16640);
    constexpr int PER = 16 * 16, NIT = NEXP * 3 * PER;
    for (int it = first; it < NIT; it += stride) {
        const int e = it / (3 * PER), r = it % (3 * PER), which = r / PER, q = r % PER, kb = q / 16, n0 = (q % 16) * 64;
#if MOE_F8
        if (which == 0)      transpose_item64_f8(w1 + (size_t)e * DM * DM, DM, DM, (unsigned char*)W13 + (size_t)e * 2048 * DM, (n0 >> 7) * 256 + (n0 & 127), scr, kb * 64, n0, C.lane);
        else if (which == 1) transpose_item64_f8(w3 + (size_t)e * DM * DM, DM, DM, (unsigned char*)W13 + (size_t)e * 2048 * DM, (n0 >> 7) * 256 + (n0 & 127) + 128, scr, kb * 64, n0, C.lane);
        else                 transpose_item64_f8(w2 + (size_t)e * DM * DM, DM, DM, (unsigned char*)W2 + (size_t)e * DM * DM, n0, scr, kb * 64, n0, C.lane); }
#else
        if (which == 0)      transpose_item64(w1 + (size_t)e * DM * DM, DM, DM, W13 + (size_t)e * 2048 * DM, (n0 >> 7) * 256 + (n0 & 127), scr, kb * 64, n0, C.lane);
        else if (which == 1) transpose_item64(w3 + (size_t)e * DM * DM, DM, DM, W13 + (size_t)e * 2048 * DM, (n0 >> 7) * 256 + (n0 & 127) + 128, scr, kb * 64, n0, C.lane);
        else                 transpose_item64(w2 + (size_t)e * DM * DM, DM, DM, W2 + (size_t)e * DM * DM, n0, scr, kb * 64, n0, C.lane); }
#endif
}
constexpr int WPREP_PER_WAVE = (NEXP * 3 * 256 + 2047) / 2048;

DI void shifted8(const bf16* __restrict__ up, const bf16* __restrict__ uc, const bf16* __restrict__ un, bool hp, bool hn, const float (&s0)[8], const float (&s1)[8], const float (&s2)[8], int c0, float (&o)[8]) {
    const u32x4 z = {0u, 0u, 0u, 0u};
    const u32x4 vp = hp ? *(const u32x4*)(up + c0) : z, vc = *(const u32x4*)(uc + c0), vn = hn ? *(const u32x4*)(un + c0) : z;
    float p[8], c[8], n[8]; unpack8(vp, p); unpack8(vc, c); unpack8(vn, n);
#pragma unroll
    for (int e = 0; e < 8; ++e) o[e] = p[e] * s0[e] + c[e] * s1[e] + n[e] * s2[e];
}
DI void load_sw(const float* sw, int c0, float (&s0)[8], float (&s1)[8], float (&s2)[8]) {
#pragma unroll
    for (int e = 0; e < 8; ++e) { s0[e] = sw[c0 + e]; s1[e] = sw[RW_IN + c0 + e]; s2[e] = sw[2 * RW_IN + c0 + e]; }
}
DI void ph_prep(const Ctx& C, const bf16* __restrict__ U, const float* __restrict__ sw  , const float* __restrict__ kkw  , const float* __restrict__ naqg, const float* __restrict__ nakg,
                bf16* __restrict__ R, bf16* __restrict__ V, bf16* __restrict__ K, bf16* __restrict__ KK, bf16* __restrict__ L, bf16* __restrict__ QN, bf16* __restrict__ KN, bf16* __restrict__ VTN) {
    LAS bf16* VL = (LAS bf16*)C.lds;
    const int lane = C.lane, hh = lane >> 3, sub = lane & 7;
    const float C2 = 0.125f * LOG2E;
    for (int u = C.vcu; u < MT / 32; u += C.nb) {
        const int row0 = 32 * u; const bool lat = row0 < NLAT;
        const int b = lat ? (row0 >> 12) : ((row0 - NLAT) >> 8), pos0 = lat ? (row0 & 4095) : TL + ((row0 - NLAT) & 255), tseq = lat ? TL : LCX, tb = lat ? (row0 & 4095) : ((row0 - NLAT) & 255);
#define PREP_ROWVARS(i) const int pl = 4 * C.wave + (i), row = row0 + pl, t = tb + pl; const bool hp = t > 0, hn = t < tseq - 1; \
            const bf16* uc = U + (size_t)row * OD_INP; const bf16* up = uc - OD_INP; const bf16* un = uc + OD_INP
        { float s0[8], s1[8], s2[8]; load_sw(sw, 8 * lane, s0, s1, s2);
          _Pragma("unroll") for (int i = 0; i < 4; ++i) { PREP_ROWVARS(i); float o[8]; shifted8(up, uc, un, hp, hn, s0, s1, s2, 8 * lane, o); *(u32x4*)(R + (size_t)row * 512 + 8 * lane) = pack8(o); } }
        { float s0[8], s1[8], s2[8]; load_sw(sw, 1024 + 8 * lane, s0, s1, s2);
          _Pragma("unroll") for (int i = 0; i < 4; ++i) { PREP_ROWVARS(i); float o[8]; shifted8(up, uc, un, hp, hn, s0, s1, s2, 1024 + 8 * lane, o); *(u32x4*)(V + (size_t)row * 512 + 8 * lane) = pack8(o); } }
        { float s0[8], s1[8], s2[8]; load_sw(sw, 512 + 8 * lane, s0, s1, s2); float kw[8];
#pragma unroll
          for (int e = 0; e < 8; ++e) kw[e] = kkw[8 * lane + e];
          _Pragma("unroll") for (int i = 0; i < 4; ++i) { PREP_ROWVARS(i); float o[8]; shifted8(up, uc, un, hp, hn, s0, s1, s2, 512 + 8 * lane, o); *(u32x4*)(K + (size_t)row * 512 + 8 * lane) = pack8(o);
              float kk[8]; float ss = 0.f;
#pragma unroll
              for (int e = 0; e < 8; ++e) { kk[e] = o[e] * kw[e]; ss += kk[e] * kk[e]; }
              ss = sum8(ss); const float rn = 1.0f / sqrtf(ss + 1e-12f);
#pragma unroll
              for (int e = 0; e < 8; ++e) kk[e] *= rn;
              *(u32x4*)(KK + (size_t)row * 512 + 8 * lane) = pack8(kk); } }
        if (lane < 48) { float s0[8], s1[8], s2[8]; load_sw(sw, 1536 + 8 * lane, s0, s1, s2);
          _Pragma("unroll") for (int i = 0; i < 4; ++i) { PREP_ROWVARS(i); float o[8]; shifted8(up, uc, un, hp, hn, s0, s1, s2, 1536 + 8 * lane, o);
              if (lane < 16) {
#pragma unroll
                  for (int e = 0; e < 8; ++e) { const float ex = __expf(2.f * o[e]); o[e] = 1.f - 2.f * __builtin_amdgcn_rcpf(ex + 1.f); }
              } else if (lane >= 32) {
#pragma unroll
                  for (int e = 0; e < 8; ++e) o[e] = sigmoidf_(o[e]);
              }
              *(u32x4*)(L + (size_t)row * 384 + 8 * lane) = pack8(o); } }
        { float gq[8], gk[8];
#pragma unroll
          for (int e = 0; e < 8; ++e) { gq[e] = naqg[8 * sub + e] * C2; gk[e] = nakg[8 * sub + e]; }
          _Pragma("unroll") for (int i = 0; i < 4; ++i) { const int pl = 4 * C.wave + i, row = row0 + pl, pos = pos0 + pl; const bf16* uc = U + (size_t)row * OD_INP;
            { float x[8]; unpack8(*(const u32x4*)(uc + RW_IN + 8 * lane), x); float ss = 0.f;
#pragma unroll
                for (int e = 0; e < 8; ++e) ss += x[e] * x[e];
                ss = sum8(ss); const float rn = 1.0f / sqrtf(ss * (1.f / 64.f) + EPS);
#pragma unroll
                for (int e = 0; e < 8; ++e) x[e] = x[e] * rn * gq[e];
                *(u32x4*)(QN + ((size_t)(b * 8 + hh) * KPOS + pos) * 64 + 8 * sub) = pack8(x); }
            { float x[8]; unpack8(*(const u32x4*)(uc + RW_IN + 512 + 8 * lane), x); float ss = 0.f;
#pragma unroll
                for (int e = 0; e < 8; ++e) ss += x[e] * x[e];
                ss = sum8(ss); const float rn = 1.0f / sqrtf(ss * (1.f / 64.f) + EPS);
#pragma unroll
                for (int e = 0; e < 8; ++e) x[e] = x[e] * rn * gk[e];
                *(u32x4*)(KN + ((size_t)(b * 8 + hh) * KPOS + pos) * 64 + 8 * sub) = pack8(x); }
            { const u32x4 vv = *(const u32x4*)(uc + RW_IN + 1024 + 8 * lane); const unsigned w4[4] = {vv.x, vv.y, vv.z, vv.w};
#pragma unroll
                for (int e = 0; e < 8; ++e) { const int dv = 8 * sub + e; VL[(hh * 64 + dv) * 32 + pl] = (bf16)((e & 1) ? (w4[e >> 1] >> 16) : (w4[e >> 1] & 0xffffu)); } } } }
#undef PREP_ROWVARS
        __syncthreads();
        { const int hd = C.tid; bf16* dst = VTN + ((size_t)(b * 8 + (hd >> 6)) * 64 + (hd & 63)) * KPOS + pos0;
#pragma unroll
            for (int q = 0; q < 4; ++q) *(u32x4*)(dst + 8 * q) = *(const LAS u32x4*)(VL + hd * 32 + 8 * q); }
        __syncthreads();
    }
}

DI int scan_row(int s, int d, int b) { if (s < LCX) return NLAT + b * LCX + (d ? (LCX - 1 - s) : s); const int t = s - LCX; return b * TL + (d ? (TL - 1 - t) : t); }


constexpr int CCH = 16, NCHK = KPOS / CCH, NPROB = NB * 8 * 2 * NCHK, IMG_ELEMS = 3 * 32 * 16;
template <int N> struct ICk { static constexpr int value = N; };
DI int crow_(int reg, int h) { return (reg & 3) + 8 * (reg >> 2) + 4 * h; }
DI bf16x8 pack_lo8(const f32x16& x) {
    u32x4 p; p.x = pk2(x[0], x[1]); p.y = pk2(x[2], x[3]); p.z = pk2(x[4], x[5]); p.w = pk2(x[6], x[7]); return __builtin_bit_cast(bf16x8, p); }
DI bf16x8 pack_hi8(const f32x16& x) { u32x4 p; p.x = pk2(x[8], x[9]); p.y = pk2(x[10], x[11]); p.z = pk2(x[12], x[13]); p.w = pk2(x[14], x[15]); return __builtin_bit_cast(bf16x8, p); }
DI int perm16(int k) { return (k & ~15) | swap23(k & 15); }

DI void ph_wkv_pre(const Ctx& C, const bf16* __restrict__ R, const bf16* __restrict__ K, const bf16* __restrict__ KK, const unsigned short* __restrict__ LW, const bf16* __restrict__ AR_, const float* __restrict__ ka, bf16* __restrict__ IMG) {
    LAS unsigned char* wl = C.lds + C.wave * 13312;
    LAS bf16* ARl = (LAS bf16*)wl; LAS bf16* BKl = (LAS bf16*)(wl + 4608); LAS float* Ll = (LAS float*)(wl + 9216); LAS bf16* OUT = (LAS bf16*)(wl + 10240);
    const int lane = C.lane, r = lane & 31, h = lane >> 5;
    const int gw = C.vcu * 8 + C.wave, ngw = C.nb * 8;
    for (int p = gw; p < NPROB; p += ngw) {
        const int j = p % NCHK, rest = p / NCHK, d = rest & 1, hh = (rest >> 1) & 7, b = rest >> 4;
        const unsigned short* Wd = LW + (size_t)d * MT * 512; const bf16* Ad = AR_ + (size_t)d * MT * 512;
        const float kav = ka[hh * 64 + lane];
        const int row0 = scan_row(j * CCH, d, b), sg = d ? -1 : 1;
        float lw[16]; bf16 rr[16], kx[16], kkx[16], ax[16];
#pragma unroll
        for (int t = 0; t < 16; ++t) { const size_t off = (size_t)(row0 + sg * t) * 512 + hh * 64 + lane; lw[t] = h2f(Wd[off]); rr[t] = R[off]; kx[t] = K[off]; kkx[t] = KK[off]; ax[t] = Ad[off]; }
        float cum = 0.f, e0 = 1.f;
#pragma unroll
        for (int t = 0; t < 16; ++t) {
            cum += lw[t]; const float e1 = __expf(cum), ei = __builtin_amdgcn_rcpf(e1);
            const float kkv = bf2f(kkx[t]), av = bf2f(ax[t]), keff = bf2f(kx[t]) * (1.f + (av - 1.f) * kav);
            ARl[t * 72 + lane] = f2bf(-kkv * e0); ARl[(16 + t) * 72 + lane] = f2bf(bf2f(rr[t]) * e1);
            BKl[t * 72 + lane] = f2bf(kkv * av * ei); BKl[(16 + t) * 72 + lane] = f2bf(keff * ei);
            e0 = e1;
        }
        asm volatile("s_waitcnt lgkmcnt(0)" ::: "memory");
        f32x16 g;
#pragma unroll
        for (int i = 0; i < 16; ++i) g[i] = 0.f;
#pragma unroll
        for (int q = 0; q < 4; ++q) g = MFMA32(*(const LAS bf16x8*)(ARl + r * 72 + 16 * q + 8 * h), *(const LAS bf16x8*)(BKl + r * 72 + 16 * q + 8 * h), g);
        const int sI = r & 15; const bool isk = r >= 16;
#pragma unroll
        for (int i = 0; i < 16; ++i) {
            const int row = crow_(i, h), t = row & 15; const bool keep = (i < 8) ? (sI < t) : (sI <= t); const float val = keep ? g[i] : 0.f;
            if (i < 8) { if (!isk) { Ll[t * 16 + sI] = val; OUT[512 + row * 16 + perm16(sI)] = 0; } else OUT[row * 16 + sI] = f2bf(val); }
            else       { if (!isk) OUT[512 + row * 16 + perm16(sI)] = f2bf(val); else OUT[row * 16 + sI] = f2bf(val); }
        }
        asm volatile("s_waitcnt lgkmcnt(0)" ::: "memory");
        { const int c = lane & 15; float Pr[16];
            Pr[0] = (c == 0) ? 1.f : 0.f;
#pragma unroll
            for (int t = 1; t < 16; ++t) { const float lrow = Ll[t * 16 + c]; float acc = (c == t) ? 1.f : 0.f;
#pragma unroll
                for (int u = 0; u < t; ++u) acc += rdlane(lrow, u) * Pr[u];
                Pr[t] = acc; }
            if (lane < 16) {
#pragma unroll
                for (int t = 0; t < 16; ++t) { OUT[1024 + t * 16 + perm16(c)] = f2bf(Pr[t]); OUT[1024 + (16 + t) * 16 + c] = 0; } } }
        asm volatile("s_waitcnt lgkmcnt(0)" ::: "memory");
        { bf16* dst = IMG + (size_t)p * IMG_ELEMS;
#pragma unroll
            for (int q = 0; q < 3; ++q) *(u32x4*)(dst + (q * 64 + lane) * 8) = *(const LAS u32x4*)(OUT + (q * 64 + lane) * 8); }
        asm volatile("s_waitcnt lgkmcnt(0)" ::: "memory");
    }
}

DI void ph_wkv_chunk(const Ctx& C, const bf16* R, const bf16* V, const bf16* K, const bf16* KK, const unsigned short* LW, const bf16* AR_, const float* ka, const bf16* IMG, bf16* YS) {
    constexpr int S_AR = 0, S_BKT = 4608, S_VT = 9728, S_VT2 = 11264, S_GC = 12800, S_MM = 13056, S_MRB = 14592, S_PP = 16128, SLOT = 17664, CUMO = 2 * SLOT, YSTO = CUMO + 8192, DEPTH = 4;
    const int lane = C.lane, wv = C.wave, r = lane & 31, h = lane >> 5;
    const bool isE = wv == 2 || wv == 3 || wv == 6 || wv == 7, isS = wv < 2;
    const int te = (wv == 2 ? 0 : (wv == 3 ? 1 : (wv == 6 ? 2 : 3))) * 64 + lane, et = te >> 4, ekq = te & 15;
    const int vhf = te >> 7, vt = (te >> 3) & 15, viq = te & 7;
    const int hf = wv & 1;
    for (int cid0 = C.bid; cid0 < 128; cid0 += C.nb) {
        const int chain = cid0, b = chain >> 4, hh = (chain >> 1) & 7, d = chain & 1;
        const unsigned short* Wd = LW + (size_t)d * MT * 512; const bf16* Ad = AR_ + (size_t)d * MT * 512; bf16* Yd = YS + (size_t)d * MT * 512;
        const bf16* img = IMG + (size_t)(((b * 8 + hh) * 2 + d) * NCHK) * IMG_ELEMS;
        f32x16 ST[2];
#pragma unroll
        for (int i = 0; i < 16; ++i) { ST[0][i] = 0.f; ST[1][i] = 0.f; }
        const f32x4 kav = *(const f32x4*)(ka + hh * 64 + 4 * ekq);
        unsigned ring[DEPTH][16];
        __syncthreads();
        auto issue = [&](int ch, unsigned (&rg)[16]) __attribute__((always_inline)) {
            if (ch < 0 || ch >= NCHK) return;
            const int row0 = scan_row(ch * CCH, d, b), sg = d ? -1 : 1;
            if (isE) {
                const size_t off = (size_t)(row0 + sg * et) * 512 + hh * 64 + 4 * ekq;
                const u32x2 x0 = *(const u32x2*)(R + off), x1 = *(const u32x2*)(K + off), x2 = *(const u32x2*)(KK + off), x3 = *(const u32x2*)(Ad + off);
                const u32x2 x4 = *(const u32x2*)(V + (size_t)(row0 + sg * vt) * 512 + hh * 64 + 32 * vhf + 4 * viq);
                rg[0] = x0.x; rg[1] = x0.y; rg[2] = x1.x; rg[3] = x1.y; rg[4] = x2.x; rg[5] = x2.y; rg[6] = x3.x; rg[7] = x3.y; rg[8] = x4.x; rg[9] = x4.y;
                asm volatile("; wkv issue role E" ::);
            } else if (wv == 4) {
#define W5_(t) rg[(t)] = (unsigned)Wd[(size_t)(row0 + sg * (t)) * 512 + hh * 64 + lane]
                W5_(0); W5_(1); W5_(2); W5_(3); W5_(4); W5_(5); W5_(6); W5_(7); W5_(8); W5_(9); W5_(10); W5_(11); W5_(12); W5_(13); W5_(14); W5_(15);
#undef W5_
                asm volatile("; wkv issue role C" ::);
            } else if (wv == 5) {
#define W6_(q) do { const u32x4 x = *(const u32x4*)(img + (size_t)ch * IMG_ELEMS + ((q) * 64 + lane) * 8); rg[4 * (q)] = x.x; rg[4 * (q) + 1] = x.y; rg[4 * (q) + 2] = x.z; rg[4 * (q) + 3] = x.w; } while (0)
                W6_(0); W6_(1); W6_(2);
#undef W6_
                asm volatile("; wkv issue role V" ::);
            }
        };
        issue(0, ring[0]); issue(1, ring[1]); issue(2, ring[2]); issue(3, ring[3]);
#define WKV_BAR() asm volatile("s_waitcnt lgkmcnt(0)\n\ts_barrier" ::: "memory")
#define WKV_LOOP(...) for (int n0 = -2; n0 < NCHK; n0 += DEPTH) { auto iter = [&](auto kc) __attribute__((always_inline)) { constexpr int kk = decltype(kc)::value; \
            constexpr int riE = (kk + 3) % DEPTH, riW = kk % DEPTH; (void)riE; (void)riW; const int n = n0 + kk; (void)n; __VA_ARGS__; WKV_BAR(); }; iter(ICk<0>{}); iter(ICk<1>{}); iter(ICk<2>{}); iter(ICk<3>{}); }
        if (isS) {
            WKV_LOOP({
                if (n >= 0 && n < NCHK) {
                    const LAS unsigned char* B = C.lds + (n & 1) * SLOT;
                    f32x16 T1;
                    _Pragma("unroll") for (int i = 0; i < 16; ++i) T1[i] = 0.f;
                    _Pragma("unroll") for (int tau = 0; tau < 2; ++tau) {
                        T1 = MFMA32(*(const LAS bf16x8*)(B + S_AR + r * 144 + (32 * tau + 8 * h) * 2), pack_lo8(ST[tau]), T1);
                        T1 = MFMA32(*(const LAS bf16x8*)(B + S_AR + r * 144 + (32 * tau + 16 + 8 * h) * 2), pack_hi8(ST[tau]), T1);
                    }
                    const bf16x8 vtf = *(const LAS bf16x8*)(B + (hf ? S_VT2 : S_VT) + r * 48 + 16 * h);
                    T1 = MFMA32(*(const LAS bf16x8*)(B + S_MM + r * 48 + 16 * h), vtf, T1);
                    f32x16 ET;
                    _Pragma("unroll") for (int i = 0; i < 16; ++i) ET[i] = 0.f;
                    ET = MFMA32(*(const LAS bf16x8*)(B + S_PP + r * 48 + 16 * h), pack_lo8(T1), ET);
                    const bf16x8 ef = pack_lo8(ET);
                    T1 = MFMA32(*(const LAS bf16x8*)(B + S_MRB + r * 48 + 16 * h), ef, T1);
                    _Pragma("unroll") for (int tau = 0; tau < 2; ++tau) {
                        ST[tau] = MFMA32(*(const LAS bf16x8*)(B + S_BKT + (32 * tau + r) * 80 + 16 * h), ef, ST[tau]);
                        ST[tau] = MFMA32(*(const LAS bf16x8*)(B + S_BKT + (32 * tau + r) * 80 + 32 + 16 * h), vtf, ST[tau]);
                        _Pragma("unroll") for (int g4 = 0; g4 < 4; ++g4) { const f32x4 gc = *(const LAS f32x4*)(B + S_GC + (32 * tau + 8 * g4 + 4 * h) * 4);
                            ST[tau][4 * g4] *= gc.x; ST[tau][4 * g4 + 1] *= gc.y; ST[tau][4 * g4 + 2] *= gc.z; ST[tau][4 * g4 + 3] *= gc.w; }
                    }
                    LAS float* ys = (LAS float*)(C.lds + YSTO) + ((n & 1) * 2 + hf) * 512;
                    _Pragma("unroll") for (int q = 0; q < 8; ++q) ys[(8 * (q >> 2) + 4 * h + (q & 3)) * 32 + r] = T1[8 + q];
                }
            });
        } else if (isE) {
            WKV_LOOP({
                const int ch = n + 1;
                if (ch >= 0) {
                    if (ch < NCHK) {
                        LAS unsigned char* B = C.lds + (ch & 1) * SLOT; const LAS float* ec = (const LAS float*)(C.lds + CUMO) + (ch & 1) * 1024;
                        const f32x4 e1 = *(const LAS f32x4*)(ec + et * 64 + 4 * ekq);
                        f32x4 e0 = {1.f, 1.f, 1.f, 1.f}; if (et > 0) e0 = *(const LAS f32x4*)(ec + (et - 1) * 64 + 4 * ekq);
                        const float rv[4] = {bflo(ring[riE][0]), bfhi(ring[riE][0]), bflo(ring[riE][1]), bfhi(ring[riE][1])}; const float kv[4] = {bflo(ring[riE][2]), bfhi(ring[riE][2]), bflo(ring[riE][3]), bfhi(ring[riE][3])};
                        const float kkv[4] = {bflo(ring[riE][4]), bfhi(ring[riE][4]), bflo(ring[riE][5]), bfhi(ring[riE][5])}; const float av[4] = {bflo(ring[riE][6]), bfhi(ring[riE][6]), bflo(ring[riE][7]), bfhi(ring[riE][7])};
                        float ah[4]; float rh[4]; float bc[4]; float kc4[4];
                        _Pragma("unroll") for (int e = 0; e < 4; ++e) { const float ei = __builtin_amdgcn_rcpf(e1[e]);
                            ah[e] = -kkv[e] * e0[e]; rh[e] = rv[e] * e1[e]; bc[e] = kkv[e] * av[e] * ei; kc4[e] = kv[e] * (1.f + (av[e] - 1.f) * kav[e]) * ei; }
                        const int pk = perm16(4 * ekq);
                        *(LAS u32x2*)((LAS bf16*)(B + S_AR) + et * 72 + pk) = (u32x2){pk2(ah[0], ah[1]), pk2(ah[2], ah[3])};
                        *(LAS u32x2*)((LAS bf16*)(B + S_AR) + (16 + et) * 72 + pk) = (u32x2){pk2(rh[0], rh[1]), pk2(rh[2], rh[3])};
                        const int pt = perm16(et);
                        _Pragma("unroll") for (int e = 0; e < 4; ++e) { ((LAS bf16*)(B + S_BKT))[(4 * ekq + e) * 40 + pt] = f2bf(bc[e]); ((LAS bf16*)(B + S_BKT))[(4 * ekq + e) * 40 + 16 + et] = f2bf(kc4[e]); }
                        if (et == 15) *(LAS f32x4*)((LAS float*)(B + S_GC) + 4 * ekq) = e1;
                        LAS bf16* vtp = (LAS bf16*)(B + (vhf ? S_VT2 : S_VT)) + (4 * viq) * 24 + vt;
                        vtp[0] = (bf16)(ring[riE][8] & 0xffffu); vtp[24] = (bf16)(ring[riE][8] >> 16); vtp[48] = (bf16)(ring[riE][9] & 0xffffu); vtp[72] = (bf16)(ring[riE][9] >> 16);
                    }
                    issue(ch + DEPTH, ring[riE]);
                }
            });
        } else if (wv == 4) {
            WKV_LOOP({
                const int ch = n + 2;
                if (ch < NCHK) { LAS float* ec = (LAS float*)(C.lds + CUMO) + (ch & 1) * 1024; float c = 0.f;
#define C5_(t) do { c += h2f((unsigned short)ring[riW][(t)]); ec[(t) * 64 + lane] = __expf(c); } while (0)
                    C5_(0); C5_(1); C5_(2); C5_(3); C5_(4); C5_(5); C5_(6); C5_(7); C5_(8); C5_(9); C5_(10); C5_(11); C5_(12); C5_(13); C5_(14); C5_(15);
                }
                issue(ch + DEPTH, ring[riW]);
            });
        } else {
            WKV_LOOP({
                { const int chy = n - 1;
                  if (chy >= 0 && chy < NCHK) { const int yh = lane >> 5, yt = (lane & 31) >> 1, yi = 16 * (lane & 1);
                    const LAS float* ys = (const LAS float*)(C.lds + YSTO) + ((chy & 1) * 2 + yh) * 512 + yt * 32 + yi;
                    bf16* dst = Yd + (size_t)(scan_row(chy * CCH, d, b) + (d ? -1 : 1) * yt) * 512 + hh * 64 + 32 * yh + yi;
                    _Pragma("unroll") for (int q = 0; q < 2; ++q) { const f32x4 a0 = *(const LAS f32x4*)(ys + 8 * q); const f32x4 a1 = *(const LAS f32x4*)(ys + 8 * q + 4);
                        *(u32x4*)(dst + 8 * q) = (u32x4){pk2(a0.x, a0.y), pk2(a0.z, a0.w), pk2(a1.x, a1.y), pk2(a1.z, a1.w)}; } } }
                const int ch = n + 1;
                if (ch >= 0) {
                    if (ch < NCHK) { LAS unsigned char* B = C.lds + (ch & 1) * SLOT;
                        const int irow = lane >> 1; const int ihv = lane & 1;
                        *(LAS u32x4*)(B + S_MM + irow * 48 + ihv * 16) = (u32x4){ring[riE][0], ring[riE][1], ring[riE][2], ring[riE][3]};
                        *(LAS u32x4*)(B + S_MRB + irow * 48 + ihv * 16) = (u32x4){ring[riE][4], ring[riE][5], ring[riE][6], ring[riE][7]};
                        *(LAS u32x4*)(B + S_PP + irow * 48 + ihv * 16) = (u32x4){ring[riE][8], ring[riE][9], ring[riE][10], ring[riE][11]};
                    }
                    issue(ch + DEPTH, ring[riE]);
                }
            });
        }
#undef C5_
#undef WKV_LOOP
#undef WKV_BAR
    }
}

DI void ph_post(const Ctx& C, const bf16* __restrict__ YS, const bf16* __restrict__ R, const bf16* __restrict__ V, const bf16* __restrict__ K, const bf16* __restrict__ A2, const float* __restrict__ ka, const bf16* __restrict__ G, const float* __restrict__ rk, const float* __restrict__ gng, const float* __restrict__ gnb, bf16* __restrict__ OCAT, bool last) {
    const int gw = C.bid * 8 + C.wave, ngw = C.nb * 8, lane = C.lane, nrows = last ? NLAT : MT;
#pragma unroll 2
    for (int row = gw; row < nrows; row += ngw) {
        const size_t o = (size_t)row * 512 + 8 * lane;
        float y[8], y1[8]; unpack8(*(const u32x4*)(YS + o), y); unpack8(*(const u32x4*)(YS + (size_t)MT * 512 + o), y1);
#pragma unroll
        for (int e = 0; e < 8; ++e) y[e] += y1[e];
        float r[8], v[8], kx[8], a0[8], a1[8], g[8];
        unpack8(*(const u32x4*)(R + o), r); unpack8(*(const u32x4*)(V + o), v); unpack8(*(const u32x4*)(K + o), kx); unpack8(*(const u32x4*)(A2 + o), a0); unpack8(*(const u32x4*)(A2 + (size_t)MT * 512 + o), a1); unpack8(*(const u32x4*)(G + o), g);
        float bsum = 0.f;
#pragma unroll
        for (int e = 0; e < 8; ++e) { const float kae = ka[8 * lane + e]; bsum += r[e] * (kx[e] * (1.f + (a0[e] - 1.f) * kae) + kx[e] * (1.f + (a1[e] - 1.f) * kae)) * rk[8 * lane + e]; }
        bsum = sum8(bsum);
        float s = 0.f;
#pragma unroll
        for (int e = 0; e < 8; ++e) { y[e] += bsum * v[e]; s += y[e]; }
        const float mu = sum8(s) * (1.f / 64.f); float s2 = 0.f;
#pragma unroll
        for (int e = 0; e < 8; ++e) { y[e] -= mu; s2 += y[e] * y[e]; }
        const float rstd = 1.0f / sqrtf(sum8(s2) * (1.f / 64.f) + GN_EPS);
        float out[8];
#pragma unroll
        for (int e = 0; e < 8; ++e) out[e] = (y[e] * rstd * gng[8 * lane + e] + gnb[8 * lane + e]) * g[e];
        *(u32x4*)(OCAT + (size_t)row * DM + 8 * lane) = pack8(out);
    }
}

DI void ph_topk2(const Ctx& C, const float* AFFT, const float* AFFC, int* ROWS, float* GATE, int* SLOT, bool last) {
    LAS unsigned* wcnt = (LAS unsigned*)C.lds;
    LAS unsigned* cnt = wcnt + 16;
    const int tid = C.tid, nprob = last ? 128 : 256;
    for (int p = C.bid; p < nprob; p += C.nb) {
        const bool isctx = p >= 128; const int be = p & 127, b = be >> 4, e = be & 15;
        const int n = isctx ? LCX : TL, cap = isctx ? CAPC : CAPL;
        const float* src = isctx ? AFFC + (size_t)be * LCX : AFFT + (size_t)be * TL;
        unsigned v[8]; const int per = isctx ? 1 : 8, t0 = tid * per;
#pragma unroll
        for (int q = 0; q < 8; ++q) v[q] = 0u;
        if (!isctx) { const u32x4 a0 = *(const u32x4*)(src + t0), a1 = *(const u32x4*)(src + t0 + 4); v[0] = a0.x; v[1] = a0.y; v[2] = a0.z; v[3] = a0.w; v[4] = a1.x; v[5] = a1.y; v[6] = a1.z; v[7] = a1.w; }
        else if (tid < LCX) v[0] = __builtin_bit_cast(unsigned, src[tid]);
        __syncthreads();
        unsigned T = 0u;
        for (int bit = 30; bit >= 0; --bit) {
            const unsigned cand = T | (1u << bit); unsigned c = 0u;
#pragma unroll
            for (int q = 0; q < 8; ++q) c += (unsigned)__builtin_popcountll(__builtin_amdgcn_ballot_w64(v[q] >= cand));
            LAS unsigned* wc = wcnt + (bit & 1) * 8;
            if (C.lane == 0) wc[C.wave] = c;
            __syncthreads();
            const unsigned tot = wc[0] + wc[1] + wc[2] + wc[3] + wc[4] + wc[5] + wc[6] + wc[7];
            if (tot >= (unsigned)cap) T = cand;
        }
        unsigned myc = 0u;
#pragma unroll
        for (int q = 0; q < 8; ++q) myc += (v[q] > T ? 0x10000u : 0u) + ((v[q] == T && (isctx ? (q == 0 && tid < LCX) : true)) ? 1u : 0u);
        __syncthreads();
        cnt[tid] = myc;
        __syncthreads();
        for (int off = 1; off < 512; off <<= 1) { const unsigned add = tid >= off ? cnt[tid - off] : 0u; __syncthreads(); cnt[tid] += add; __syncthreads(); }
        const unsigned total = cnt[511], keq = (unsigned)cap - (total >> 16);
        unsigned before = cnt[tid] - myc;
        for (int q = 0; q < per; ++q) { const int t = t0 + q; if (t >= n) break; const unsigned x = v[q]; const unsigned gtb = before >> 16, eqb = before & 0xFFFFu;
            const bool sel = x > T || (x == T && eqb < keq);
            if (sel) { const int jx = (int)(gtb + (eqb < keq ? eqb : keq));
                const int slot = isctx ? NB * CAPL + b * CAPC + jx : b * CAPL + jx, row = isctx ? NLAT + b * LCX + t : b * TL + t;
                ROWS[e * ESLOTS + slot] = row; GATE[e * ESLOTS + slot] = __builtin_bit_cast(float, x); SLOT[(size_t)row * 16 + e] = slot; }
            before += (x > T ? 0x10000u : 0u) + (x == T ? 1u : 0u); }
        __syncthreads();
    }
}


DI void ph_combine(const Ctx& C, float* __restrict__ xlat, float* __restrict__ xctx, const float* __restrict__ modg2  , const int* __restrict__ SLOT, const bf16* __restrict__ Y2, bool last,
                   const float* __restrict__ ngain  , const float* __restrict__ nmod  , bf16* __restrict__ H) {
    const int gw = C.bid * 8 + C.wave, ngw = C.nb * 8, lane = C.lane, nrows = last ? NLAT : MT;
    int sv_next = (gw < nrows) ? SLOT[(size_t)gw * 16 + (lane & 15)] : -1;
    for (int row = gw; row < nrows; row += ngw) {
        float* xr = row < NLAT ? xlat + (size_t)row * DM : xctx + (size_t)(row - NLAT) * DM;
        const int mi = row < NLAT ? (row >> 12) : 8;
        const int sv = sv_next;
        if (row + ngw < nrows) sv_next = SLOT[(size_t)(row + ngw) * 16 + (lane & 15)];
        f32x4 xv[4], gv[4];
#pragma unroll
        for (int j = 0; j < 4; ++j) { const int c = 256 * j + 4 * lane; gv[j] = *(const f32x4*)(modg2 + mi * 6144 + c); xv[j] = *(const f32x4*)(xr + c); }
        f32x4 acc[4];
#pragma unroll
        for (int j = 0; j < 4; ++j) acc[j] = (f32x4){0.f, 0.f, 0.f, 0.f};
        unsigned mask = (unsigned)__builtin_amdgcn_ballot_w64(sv >= 0) & 0xffffu;
        while (mask) {
            const bf16* yp[4]; float m[4];
            { const int e0 = __builtin_ctz(mask); mask &= mask - 1u; const int s0 = __builtin_amdgcn_readlane(sv, e0); yp[0] = Y2 + ((size_t)e0 * ESLOTS + s0) * DM + 4 * lane; m[0] = 1.f; }
#pragma unroll
            for (int k = 1; k < 4; ++k) {
                if (mask) { const int ek = __builtin_ctz(mask); mask &= mask - 1u; const int sk = __builtin_amdgcn_readlane(sv, ek); yp[k] = Y2 + ((size_t)ek * ESLOTS + sk) * DM + 4 * lane; m[k] = 1.f; }
                else { yp[k] = yp[0]; m[k] = 0.f; } }
            u32x2 w[4][4];
#pragma unroll
            for (int k = 0; k < 4; ++k)
#pragma unroll
                for (int j = 0; j < 4; ++j) w[k][j] = *(const u32x2*)(yp[k] + 256 * j);
#pragma unroll
            for (int k = 0; k < 4; ++k)
#pragma unroll
                for (int j = 0; j < 4; ++j) acc[j] += m[k] * (f32x4){bflo(w[k][j].x), bfhi(w[k][j].x), bflo(w[k][j].y), bfhi(w[k][j].y)};
        }
#pragma unroll
        for (int j = 0; j < 4; ++j) { const int c = 256 * j + 4 * lane; f32x4 x = xv[j]; x += gv[j] * acc[j]; *(f32x4*)(xr + c) = x; acc[j] = x; }
        if (ngain) {
            float ss = 0.f;
#pragma unroll
            for (int j = 0; j < 4; ++j) ss += acc[j].x * acc[j].x + acc[j].y * acc[j].y + acc[j].z * acc[j].z + acc[j].w * acc[j].w;
            const float rs = 1.0f / sqrtf(wave_sum(ss) * (1.f / 1024.f) + EPS);
            const float* mp = nmod + mi * 6144;
#pragma unroll
            for (int j = 0; j < 4; ++j) { const int c = 256 * j + 4 * lane;
                const f32x4 g = *(const f32x4*)(ngain + c), sc = *(const f32x4*)(mp + 1024 + c), sh = *(const f32x4*)(mp + c);
                const f32x4 hv = (acc[j] * rs) * g * (sc + 1.0f) + sh;
                *(u32x2*)(H + (size_t)row * DM + c) = (u32x2){pk2(hv.x, hv.y), pk2(hv.z, hv.w)}; }
        }
    }
}

template <int N> struct IC { static constexpr int value = N; };
DI const float* in_ptr(const unsigned char* ws, int k) { const unsigned long long v = ((const unsigned long long*)(ws + 128 * 1024))[k];
    const unsigned lo = __builtin_amdgcn_readfirstlane((unsigned)v), hi = __builtin_amdgcn_readfirstlane((unsigned)(v >> 32));
    return (const float*)(__attribute__((address_space(1))) const float*)(((unsigned long long)hi << 32) | lo); }
template <class T> DI T* launder_ptr(T* p) { unsigned long long v = (unsigned long long)p; unsigned lo = (unsigned)v, hi = (unsigned)(v >> 32); asm volatile("" : "+v"(lo), "+v"(hi));
    lo = __builtin_amdgcn_readfirstlane(lo); hi = __builtin_amdgcn_readfirstlane(hi); return (T*)(__attribute__((address_space(1))) T*)(((unsigned long long)hi << 32) | lo); }
constexpr int N_PHASES = 1 + 23 + 22;
constexpr size_t WS_PTRS = 128 * 1024;
#define P_XC    ((float*)(ws + WS_XC))
#define P_MOD   ((const float*)(ws + WS_MOD))
#define P_HB    ((bf16*)(ws + WS_HB))
#define P_OCAT  ((bf16*)(ws + WS_OCAT))
#define P_AR    (ws + WS_ARENA)
#define P_ROWS  ((int*)(ws + WS_ROWS))
#define P_GATE  ((float*)(ws + WS_GATE))
#define P_SLOT  ((int*)(ws + WS_SLOT))
#define P_AFFT  ((float*)(ws + WS_AFFT))
#define P_AFFC  ((float*)(ws + WS_AFFC))
#define P_W13   ((bf16*)(ws + WS_W13))
#define P_W2    ((bf16*)(ws + WS_W2))
#define P_U     ((bf16*)(P_AR + A_U))
#define P_QPRE  ((float*)(P_AR + A_QPRE))
#define P_KVPRE ((float*)(P_AR + A_KVPRE))
#define P_QB    ((bf16*)(P_AR + A_QB))
#define P_KB    ((bf16*)(P_AR + A_KB))
#define P_VT    ((bf16*)(P_AR + A_VT))
#define P_W     ((unsigned short*)(P_AR + A_W))
#define P_KEFF  ((bf16*)(P_AR + A_KEFF))
#define P_R     ((bf16*)(P_AR + A_R))
#define P_V     ((bf16*)(P_AR + A_V))
#define P_KK    ((bf16*)(P_AR + A_KK))
#define P_G     ((bf16*)(P_AR + A_G))
#define P_K     ((bf16*)(P_AR + A_K))
#define P_L     ((bf16*)(P_AR + A_L))
#define P_QN    ((bf16*)(P_AR + A_QN))
#define P_KN    ((bf16*)(P_AR + A_KN))
#define P_VTN   ((bf16*)(P_AR + A_VTN))
#define P_YS    ((bf16*)(P_AR + A_YS))
#define P_IMG   ((bf16*)(P_AR + A_IMG))
#define P_HID   ((bf16*)(P_AR + A_HID))
#define P_Y2    ((bf16*)(P_AR + A_Y2))
#define MODL(i) (P_MOD + (size_t)(i) * 9 * 6144)
#if MOE_F8
#define MOE1_PHASE(NMT) do { pg8::Gemm g{P_HB, P_W13, DM / 2, DM / 2, P_ROWS, SCALE_W, SCALE_ONE}; pg8::OrderMoE S{(NMT), 8, 17, C.nb, C.vcu}; pg8::EpiAdapt<EpiGlu8> E{EpiGlu8{(unsigned char*)P_HID}}; \
        pg8::gemm_phase<pg8::EpiAdapt<EpiGlu8>, pg8::OrderMoE, true>(C.lds, g, S, E, C.tid); } while (0)
#define MOE2_PHASE(NMT) do { pg8::Gemm g{P_HID, P_W2, DM / 2, DM / 2, nullptr, SCALE_W, SCALE_HID}; pg8::OrderMoE S{(NMT), 4, 17, C.nb, C.vcu}; pg8::EpiAdapt<EpiGate> E{EpiGate{P_Y2, P_GATE}}; \
        pg8::gemm_phase<pg8::EpiAdapt<EpiGate>, pg8::OrderMoE, true>(C.lds, g, S, E, C.tid); } while (0)
#else
#define MOE1_PHASE(NMT) do { pg8::Gemm g{P_HB, P_W13, DM, DM, P_ROWS}; pg8::OrderMoE S{(NMT), 8, 17, C.nb, C.vcu}; pg8::EpiAdapt<EpiGlu> E{EpiGlu{P_HID}}; pg8::gemm_phase(C.lds, g, S, E, C.tid); } while (0)
#define MOE2_PHASE(NMT) do { pg8::Gemm g{P_HID, P_W2, DM, DM, nullptr}; pg8::OrderMoE S{(NMT), 4, 17, C.nb, C.vcu}; pg8::EpiAdapt<EpiGate> E{EpiGate{P_Y2, P_GATE}}; pg8::gemm_phase(C.lds, g, S, E, C.tid); } while (0)
#endif
#define WPREP_TAIL(NUNITS, LAYER) do { __syncthreads(); const int extra_ = (NUNITS) % C.nb, j_ = C.vcu - extra_; const size_t wo_ = (size_t)(LAYER) * NEXP * DM * DM; \
        if (j_ >= 0) wprep_span(C, j_ * 8 + C.wave, (C.nb - extra_) * 8, in_ptr(ws, I_MW1) + wo_, in_ptr(ws, I_MW3) + wo_, in_ptr(ws, I_MW2) + wo_, (bf16*)(ws + WS_W13), (bf16*)(ws + WS_W2)); } while (0)
#define RELAUNDER() do { int l_ = C.lane; asm volatile("" : "+v"(l_)); C.lane = l_; C.tid = (C.wave << 6) | l_; } while (0)
__global__ void __launch_bounds__(512, 2) fwd_kernel(Args a) {
    extern __shared__ __attribute__((aligned(16))) unsigned char smem[];
    Ctx C0; C0.lds = (LAS unsigned char*)smem; C0.tid = threadIdx.x; C0.lane = C0.tid & 63; C0.wave = __builtin_amdgcn_readfirstlane(C0.tid >> 6); C0.bid = blockIdx.x; C0.nb = gridDim.x;
    C0.vcu = (C0.nb % 8 == 0) ? (C0.bid % 8) * (C0.nb / 8) + C0.bid / 8 : C0.bid;
    volatile LAS unsigned* bst = (volatile LAS unsigned*)(C0.lds + LDS_BYTES - 16);
#if MEGA
    if (C0.tid == 0) { bst[0] = 0u; bst[1] = 0u; }
    __syncthreads();
    const unsigned bar_x = xcd_barrier_post((unsigned*)(a.ws + WS_CTL) + 4096, bst, C0.tid == 0).x;
#define SEAM() do { if (ph < hi) { XcdBarrier b2_; b2_.bar = (unsigned*)(ws + WS_CTL) + 4096; b2_.x = bar_x; b2_.st = bst; xcd_barrier(b2_, C.tid == 0); } } while (0)
#else
#define SEAM() do { } while (0)
#endif
#if MEGA
    constexpr int lo = 0, hi = N_PHASES;
#else
    const int lo = a.ph_lo, hi = a.ph_hi;
#endif
    int ph = 0;
#ifndef ONLY
#define ONLY -1
#endif
#ifndef REPMASK
#define REPMASK 0
#endif
#ifndef SITE_LO
#define SITE_LO 0
#define SITE_HI 99
#endif
#define PHASE(SITE, ...) do { if ((ONLY < 0 || ONLY == (SITE)) && (SITE) >= SITE_LO && (SITE) <= SITE_HI && ph >= lo && ph < hi) { Ctx C; C.lds = C0.lds; \
        { int w_ = C0.wave; asm volatile("" : "+s"(w_)); unsigned m_ = ~0u; asm volatile("" : "+s"(m_)); int l_ = (int)__builtin_amdgcn_mbcnt_hi(m_, __builtin_amdgcn_mbcnt_lo(m_, 0u)); C.wave = w_; C.lane = l_; C.tid = (w_ << 6) | l_; } \
        { int b_ = C0.bid, n_ = C0.nb, v_ = C0.vcu; asm volatile("" : "+s"(b_), "+s"(n_), "+s"(v_)); C.bid = b_; C.nb = n_; C.vcu = v_; } \
        unsigned z_ = 0u; asm volatile("" : "+s"(z_)); unsigned char* ws = a.ws + z_; float* XL = a.out + z_; const int lq = __builtin_amdgcn_readfirstlane(lp); typedef const __attribute__((address_space(1))) float* gfp_t; const gfp_t* INT_ = (const gfp_t*)(ws + WS_PTRS); (void)INT_; (void)XL; (void)lq; \
        for (int rep_ = 0; rep_ < ((((REPMASK) >> (SITE)) & 1) ? 2 : 1); ++rep_) { __VA_ARGS__; if ((((REPMASK) >> (SITE)) & 1)) __syncthreads(); } ++ph; SEAM(); } else ++ph; } while (0)

    { const int lp = 0;
      PHASE(0, { if (C.bid == 0) { _Pragma("unroll") for (int k = 0; k < 40; ++k) if (C.tid == k) ((const float**)(ws + WS_PTRS))[k] = a.in[k]; }
                 ph_prologue(C, a); }); }

    auto layer_pair = [&](auto lpc) __attribute__((always_inline)) {
        constexpr int lp = decltype(lpc)::value;
        if constexpr (lp == 0) PHASE(1, { const int i = 2 * lq; const float* xl = (i == 0) ? in_ptr(ws, I_X) : XL; const float* xc = (i == 0) ? in_ptr(ws, I_CTX) : P_XC;
                   ph_norm<false>(C, xl, xc, in_ptr(ws, I_N1G) + i * DM, MODL(i), 0, 1024, P_HB, nullptr, nullptr, nullptr, nullptr); });
        PHASE(2, { EpiBf16 E{P_U, EV_INP}; fast_gemm(C, P_HB, DM, (const bf16*)(ws + WS_WEVIN) + (size_t)lq * EV_INP * DM, DM, MT / 256, EV_INP / 256, E); });
        PHASE(3, { EpiBf16 Eq{(bf16*)P_QPRE, 768}; fast_gemm(C, P_U, EV_INP, (const bf16*)(ws + WS_WUQ) + (size_t)lq * 768 * 384, 384, MT / 256, 3, Eq); RELAUNDER();
                   EpiBf16 Ek{(bf16*)P_KVPRE, 1024}; fast_gemm(C, P_U + 384, EV_INP, (const bf16*)(ws + WS_WUKV) + (size_t)lq * 1024 * 256, 256, MT / 256, 4, Ek, true); });
        PHASE(4, { ph_mla_fin(C, P_U, (const bf16*)P_QPRE, (const bf16*)P_KVPRE, in_ptr(ws, I_QG) + lq * 96, in_ptr(ws, I_KG) + lq * 96, (const f32x2*)(ws + WS_ROPE), P_QB, P_KB, P_VT);
                   const int extra_ = (MT / 64) % C.nb, j_ = C.vcu - extra_;
                   if (j_ >= 0) { for (int q_ = 0; q_ < CONV_PER_TAIL; ++q_) { const int cu_ = j_ + q_ * (C.nb - extra_); if (cu_ >= conv_in_fin(C.nb)) break;
                       float wk[31]; const float* dww = in_ptr(ws, I_DWW) + (size_t)lq * 31 * 512;
                       _Pragma("unroll") for (int kt = 0; kt < 31; ++kt) wk[kt] = dww[kt * 512 + C.tid];
                       conv_unit(C, cu_, P_U, wk, in_ptr(ws, I_DWB)[lq * 512 + C.tid], in_ptr(ws, I_LNG) + lq * 512, in_ptr(ws, I_LNB) + lq * 512, P_OCAT); } } });
        PHASE(5, ph_attn_mla2(C, P_QB, P_KB, P_VT, P_OCAT, false, ws, lq));
        PHASE(6, { const int i = 2 * lq; const float* xl = (i == 0) ? in_ptr(ws, I_X) : XL; const float* xc = (i == 0) ? in_ptr(ws, I_CTX) : P_XC;
                   { EpiResid E{xl, xc, XL, P_XC, MODL(i) + 2048}; fast_gemm(C, P_OCAT, DM, (const bf16*)(ws + WS_WEVOUT) + (size_t)lq * DM * DM, DM, MT / 256, 4, E); }
                   WPREP_TAIL(MT / 256 * 4, i); });
        PHASE(7, { const int i = 2 * lq; ph_norm<true>(C, XL, P_XC, in_ptr(ws, I_N2G) + i * DM, MODL(i), 3072, 4096, P_HB, in_ptr(ws, I_ROUTER) + (size_t)i * DM * 16, P_AFFT, P_AFFC, P_SLOT); });
        PHASE(8, ph_topk2(C, P_AFFT, P_AFFC, P_ROWS, P_GATE, P_SLOT, false));
        PHASE(9, { MOE1_PHASE(17); });
        PHASE(10, { MOE2_PHASE(17); });
        PHASE(11, { const int i = 2 * lq; ph_combine(C, XL, P_XC, MODL(i) + 5120, P_SLOT, P_Y2, false, in_ptr(ws, I_N1G) + (i + 1) * DM, MODL(i + 1), P_HB); });
        PHASE(13, { EpiBf16 E{P_U, OD_INP}; fast_gemm(C, P_HB, DM, (const bf16*)(ws + WS_WODIN) + (size_t)lq * OD_INP * DM, DM, MT / 256, OD_INP / 256, E); });
        PHASE(14, ph_prep(C, P_U, in_ptr(ws, I_SHIFTW) + (size_t)lq * 3 * RW_IN, in_ptr(ws, I_KKW) + lq * 512, in_ptr(ws, I_NAQG) + lq * 64, in_ptr(ws, I_NAKG) + lq * 64, P_R, P_V, P_K, P_KK, P_L, P_QN, P_KN, P_VTN));
        PHASE(15, { const bf16* WL = (const bf16*)(ws + WS_WLORA) + (size_t)lq * 655360;
                    { EpiLoraW E{P_W, in_ptr(ws, I_W0) + lq * 1024}; fast_gemm(C, P_L, 384, WL, 256, MT / 256, 4, E); } RELAUNDER();
                    { EpiLoraA E{P_KEFF, in_ptr(ws, I_A0) + lq * 1024}; fast_gemm(C, P_L, 384, WL + (size_t)1024 * 256, 256, MT / 256, 4, E, true); } RELAUNDER();
                    { EpiBf16 E{P_G, 512}; fast_gemm(C, P_L + 128, 384, WL + (size_t)2048 * 256, 256, MT / 256, 2, E); } });
        PHASE(16, ph_wkv_pre(C, P_R, P_K, P_KK, P_W, P_KEFF, in_ptr(ws, I_KA) + lq * 512, P_IMG));
        PHASE(17, { ph_wkv_chunk(C, P_R, P_V, P_K, P_KK, P_W, P_KEFF, in_ptr(ws, I_KA) + lq * 512, P_IMG, P_YS); __syncthreads();
                    ph_natten2(C, P_QN, P_KN, P_VTN, P_OCAT, in_ptr(ws, I_RPB) + (size_t)lq * 8 * 465, lq == 1, (unsigned*)(ws + WS_CTL) + 8192 + 64 * lq, ws, lq); });
        PHASE(18, ph_post(C, P_YS, P_R, P_V, P_K, P_KEFF, in_ptr(ws, I_KA) + lq * 512, P_G, in_ptr(ws, I_RK) + lq * 512, in_ptr(ws, I_GNG) + lq * 512, in_ptr(ws, I_GNB) + lq * 512, P_OCAT, lq == 1));
        PHASE(19, { const int i = 2 * lq + 1; EpiResid E{XL, P_XC, XL, P_XC, MODL(i) + 2048};
                    fast_gemm(C, P_OCAT, DM, (const bf16*)(ws + WS_WODOUT) + (size_t)lq * DM * DM, DM, (lq == 1) ? NLAT / 256 : MT / 256, 4, E);
                    WPREP_TAIL(((lq == 1) ? NLAT / 256 : MT / 256) * 4, i); });
        PHASE(20, { const int i = 2 * lq + 1; ph_norm<true>(C, XL, P_XC, in_ptr(ws, I_N2G) + i * DM, MODL(i), 3072, 4096, P_HB, in_ptr(ws, I_ROUTER) + (size_t)i * DM * 16, P_AFFT, P_AFFC, P_SLOT); });
        PHASE(21, ph_topk2(C, P_AFFT, P_AFFC, P_ROWS, P_GATE, P_SLOT, lq == 1));
        PHASE(22, { MOE1_PHASE((lq == 1) ? 16 : 17); });
        PHASE(23, { MOE2_PHASE((lq == 1) ? 16 : 17); });
        PHASE(24, { const int i = 2 * lq + 1;
                    if (lp == 0) ph_combine(C, XL, P_XC, MODL(i) + 5120, P_SLOT, P_Y2, false, in_ptr(ws, I_N1G) + (i + 1) * DM, MODL(i + 1), P_HB);
                    else ph_combine(C, XL, P_XC, MODL(i) + 5120, P_SLOT, P_Y2, true, nullptr, nullptr, nullptr); });
    };
    layer_pair(IC<0>{}); layer_pair(IC<1>{});
}

extern "C" void kernel_launch(void* const* d_in, const int* in_sizes, int n_in, void* d_out, int out_size, void* d_ws, size_t ws_size, hipStream_t stream) {
    static int grid = 0;
    if (grid == 0) {
        if (n_in != 40 || out_size != NLAT * DM || ws_size < WS_END) { fprintf(stderr, "kernel_launch: unexpected shapes (n_in %d out %d ws %zu need %zu)\n", n_in, out_size, ws_size, (size_t)WS_END); grid = -1; return; }
        int dev = 0, cus = 0, per_cu = 0;
        if (hipGetDevice(&dev) != hipSuccess || hipDeviceGetAttribute(&cus, hipDeviceAttributeMultiprocessorCount, dev) != hipSuccess) { grid = -1; return; }
        if (hipFuncSetAttribute((const void*)fwd_kernel, hipFuncAttributeMaxDynamicSharedMemorySize, LDS_BYTES) != hipSuccess) { fprintf(stderr, "kernel_launch: hipFuncSetAttribute failed\n"); grid = -1; return; }
        if (hipOccupancyMaxActiveBlocksPerMultiprocessor(&per_cu, (const void*)fwd_kernel, 512, LDS_BYTES) != hipSuccess || per_cu < 1) { fprintf(stderr, "kernel_launch: occupancy query says %d\n", per_cu); per_cu = 1; }
        (void)hipGetLastError();
        grid = cus;
    }
    if (grid < 0) return;
    (void)hipMemsetAsync((char*)d_ws + WS_CTL, 0, CTL_BYTES, stream);
    Args a{};
    for (int i = 0; i < 40; ++i) a.in[i] = (const float*)d_in[i];
    a.out = (float*)d_out; a.ws = (unsigned char*)d_ws;
#if MEGA
    a.ph_lo = 0; a.ph_hi = N_PHASES;
    hipLaunchKernelGGL(fwd_kernel, dim3(grid), dim3(512), LDS_BYTES, stream, a);
#else
    for (int p = 0; p < N_PHASES; ++p) { a.ph_lo = p; a.ph_hi = p + 1; hipLaunchKernelGGL(fwd_kernel, dim3(grid), dim3(512), LDS_BYTES, stream, a); }
#endif
}
```

```cpp
#include <hip/hip_runtime.h>
#include <cstdio>
#include <cstdint>

#ifndef MEGA
#define MEGA 1
#endif

#define LAS __attribute__((address_space(3)))
#define DI __device__ __forceinline__

typedef unsigned short bf16;
typedef short bf16x8 __attribute__((ext_vector_type(8)));
typedef float f32x4 __attribute__((ext_vector_type(4)));
typedef float f32x2 __attribute__((ext_vector_type(2)));
typedef float f32x16 __attribute__((ext_vector_type(16)));
typedef unsigned u32x4 __attribute__((ext_vector_type(4)));
typedef unsigned u32x2 __attribute__((ext_vector_type(2)));
typedef __bf16 bf16x2_t __attribute__((ext_vector_type(2)));

constexpr int DM = 1024, NB = 8, TL = 4096, LCX = 256;
constexpr int NLAT = NB * TL, NCTX = NB * LCX, MT = NLAT + NCTX;
constexpr int KPOS = TL + LCX;
constexpr float EPS = 1e-6f, GN_EPS = 64e-5f;
constexpr int EV_IN = 1696, EV_INP = 1792, OD_IN = 3456, OD_INP = 3584, RW_IN = 1920;
constexpr int NEXP = 16, CAPL = 512, CAPC = 32, ESLOTS = NB * CAPL + NB * CAPC;
constexpr float LOG2E = 1.4426950408889634f;

constexpr size_t MiB = 1ull << 20;
constexpr size_t WS_CTL = 0, CTL_BYTES = 1 * MiB;
constexpr size_t WS_MOD = 1 * MiB, WS_ROPE = 2 * MiB, WS_XC = 4 * MiB;
constexpr size_t WS_ROWS = 12 * MiB, WS_GATE = 12 * MiB + 512 * 1024, WS_SLOT = 13 * MiB, WS_AFFT = 16 * MiB, WS_AFFC = 18 * MiB;
constexpr size_t WS_WEVIN = 20 * MiB, WS_WEVOUT = 27 * MiB, WS_WUQ = 31 * MiB, WS_WUKV = 33 * MiB, WS_WODIN = 34 * MiB, WS_WODOUT = 48 * MiB, WS_WLORA = 52 * MiB;
constexpr size_t WS_W13 = 56 * MiB, WS_W2 = 120 * MiB, WS_HB = 152 * MiB, WS_OCAT = 220 * MiB, WS_ARENA = 288 * MiB;
constexpr size_t A_U = 0, A_QPRE = 119 * MiB, A_KVPRE = 221 * MiB, A_QB = 357 * MiB, A_KB = 408 * MiB, A_VT = 459 * MiB;
constexpr size_t A_W = 0, A_KEFF = 136 * MiB  , A_G = 204 * MiB, A_R = 238 * MiB, A_V = 272 * MiB, A_KK = 306 * MiB, A_K = 340 * MiB, A_L = 374 * MiB,
                 A_QN = 400 * MiB, A_KN = 434 * MiB, A_VTN = 468 * MiB, A_YS = 612 * MiB  ;
constexpr size_t A_HID = 0, A_Y2 = 136 * MiB;
constexpr size_t A_IMG = 510 * MiB;
constexpr size_t WS_END = WS_ARENA + 680 * MiB;
constexpr int LDS_BYTES = 147456;

DI unsigned pk2(float lo, float hi) { f32x2 v = {lo, hi}; bf16x2_t b = __builtin_convertvector(v, bf16x2_t); return __builtin_bit_cast(unsigned, b); }
DI float bflo(unsigned u) { return __builtin_bit_cast(float, u << 16); }
DI float bfhi(unsigned u) { return __builtin_bit_cast(float, u & 0xffff0000u); }
DI float bf2f(bf16 x) { return __builtin_bit_cast(float, ((unsigned)x) << 16); }
DI bf16 f2bf(float f) { return (bf16)(pk2(f, 0.f) & 0xffffu); }
DI void unpack8(u32x4 v, float (&f)[8]) { f[0] = bflo(v.x); f[1] = bfhi(v.x); f[2] = bflo(v.y); f[3] = bfhi(v.y); f[4] = bflo(v.z); f[5] = bfhi(v.z); f[6] = bflo(v.w); f[7] = bfhi(v.w); }
DI u32x4 pack8(const float (&f)[8]) { u32x4 r; r.x = pk2(f[0], f[1]); r.y = pk2(f[2], f[3]); r.z = pk2(f[4], f[5]); r.w = pk2(f[6], f[7]); return r; }
#define DPP_ADD(x, ctrl) ((x) + __builtin_bit_cast(float, __builtin_amdgcn_update_dpp(0, __builtin_bit_cast(int, (x)), (ctrl), 0xf, 0xf, false)))
#define DPP_MAX(x, ctrl) fmaxf((x), __builtin_bit_cast(float, __builtin_amdgcn_update_dpp(0, __builtin_bit_cast(int, (x)), (ctrl), 0xf, 0xf, false)))
DI float sum8(float x) { x = DPP_ADD(x, 0xB1); x = DPP_ADD(x, 0x4E); x = DPP_ADD(x, 0x141); return x; }
DI float sum16(float x) { x = DPP_ADD(x, 0xB1); x = DPP_ADD(x, 0x4E); x = DPP_ADD(x, 0x141); x = DPP_ADD(x, 0x140); return x; }
DI float max16(float x) { x = DPP_MAX(x, 0xB1); x = DPP_MAX(x, 0x4E); x = DPP_MAX(x, 0x141); x = DPP_MAX(x, 0x140); return x; }
DI float rdlane(float x, int l) { return __builtin_bit_cast(float, __builtin_amdgcn_readlane(__builtin_bit_cast(int, x), l)); }
DI float wave_sum(float v) { const float x = sum16(v); return (rdlane(x, 0) + rdlane(x, 16)) + (rdlane(x, 32) + rdlane(x, 48)); }
DI float xor32(float v, int lane) { return __builtin_bit_cast(float, __builtin_amdgcn_ds_bpermute((lane ^ 32) << 2, __builtin_bit_cast(int, v))); }
typedef int v8i_t __attribute__((ext_vector_type(8)));
typedef int i32x4_t __attribute__((ext_vector_type(4)));
DI unsigned pk4_fp8(float a, float b, float c, float d) {
    a = __builtin_amdgcn_fmed3f(a, -448.f, 448.f); b = __builtin_amdgcn_fmed3f(b, -448.f, 448.f); c = __builtin_amdgcn_fmed3f(c, -448.f, 448.f); d = __builtin_amdgcn_fmed3f(d, -448.f, 448.f);
    int p = __builtin_amdgcn_cvt_pk_fp8_f32(a, b, 0, false); p = __builtin_amdgcn_cvt_pk_fp8_f32(c, d, p, true); return (unsigned)p; }
#ifndef MOE_F8
#define MOE_F8 1
#endif
constexpr int SCALE_ONE = 0x7f7f7f7f, SCALE_W = 0x79797979  , SCALE_HID = 0x7c7c7c7c  ;
DI float sigmoidf_(float x) { return __builtin_amdgcn_rcpf(1.f + __expf(-x)); }
DI float siluf_(float x) { return x * __builtin_amdgcn_rcpf(1.f + __expf(-x)); }
#define MFMA32(a, b, c) __builtin_amdgcn_mfma_f32_32x32x16_bf16((a), (b), (c), 0, 0, 0)

#define XB_TMO      128
#define XB_XCNT(j)  (256  + 64 * (j))
#define XB_XSUB(j)  (1280 + 64 * (j))
#define XB_XGEN(j)  (2304 + 64 * (j))
#define XB_TOP      3328
#define XB_TOPGEN   3392
#define XCD_BAR_WORDS 3456
#define XB_SPIN_CAP (1u << 22)
__device__ __forceinline__ unsigned xb_ld(unsigned* p)              { return __hip_atomic_load(p, __ATOMIC_RELAXED, __HIP_MEMORY_SCOPE_AGENT); }
__device__ __forceinline__ unsigned xb_add(unsigned* p, unsigned v) { return __hip_atomic_fetch_add(p, v, __ATOMIC_RELAXED, __HIP_MEMORY_SCOPE_AGENT); }
__device__ __forceinline__ unsigned xb_xcc_id() { return (unsigned)__builtin_amdgcn_s_getreg((3 << 11) | 20) & 0xFu; }
#define XB_SPIN(cond, bar) do { unsigned _sp = 0; while (cond) { __builtin_amdgcn_s_sleep(1); \
    if ((++_sp & 255u) == 0u) { if (xb_ld(&(bar)[XB_TMO])) break; if (_sp > XB_SPIN_CAP) { atomicAdd(&(bar)[XB_TMO], 1u); break; } } } } while (0)
struct XcdBarrier { unsigned* bar; unsigned x; volatile LAS unsigned* st; };
__device__ __forceinline__ XcdBarrier xcd_barrier_post(unsigned* bar, volatile LAS unsigned* st, bool leader) {
    XcdBarrier b; b.bar = bar; b.x = xb_xcc_id(); b.st = st;
    if (leader) (void)xb_add(&bar[XB_XCNT(b.x)], 1u);
    return b;
}
__device__ __forceinline__ void xcd_barrier_complete(unsigned* bar, unsigned x, unsigned& nloc, unsigned& nx) {
    const unsigned G = gridDim.x * gridDim.y * gridDim.z;
    unsigned sum, cnt, mine, sp = 0u;
    for (;;) {
        sum = 0u; cnt = 0u; mine = 0u;
#pragma unroll
        for (unsigned j = 0; j < 16; ++j) { const unsigned c = xb_ld(&bar[XB_XCNT(j)]); sum += c; cnt += (c > 0u) ? 1u : 0u; mine = (j == x) ? c : mine; }
        if (sum == G) break;
        __builtin_amdgcn_s_sleep(1);
        if ((++sp & 255u) == 0u) { if (xb_ld(&bar[XB_TMO])) break; if (sp > XB_SPIN_CAP) { atomicAdd(&bar[XB_TMO], 1u); break; } }
    }
    nloc = mine > 0u ? mine : 1u; nx = cnt > 0u ? cnt : 1u;
}
__device__ __forceinline__ void xcd_barrier(const XcdBarrier& b, bool leader) {
    asm volatile("s_waitcnt vmcnt(0)" ::: "memory");
    __syncthreads();
    if (leader) {
        unsigned* bar = b.bar;
        __builtin_amdgcn_s_waitcnt(0);
        unsigned nloc = b.st[0], nx = b.st[1];
        if (nloc == 0u) { xcd_barrier_complete(bar, b.x, nloc, nx); b.st[0] = nloc; b.st[1] = nx; }
        const unsigned old = xb_add(&bar[XB_XSUB(b.x)], 1u);
        const unsigned gen = old / nloc;
        if (old + 1u == (gen + 1u) * nloc) {
            __builtin_amdgcn_fence(__ATOMIC_RELEASE, "agent");
            asm volatile("s_waitcnt vmcnt(0)" ::: "memory");
            const unsigned og = xb_add(&bar[XB_TOP], 1u);
            const unsigned tg = og / nx;
            if (og + 1u == (tg + 1u) * nx) xb_add(&bar[XB_TOPGEN], 1u);
            else XB_SPIN(xb_ld(&bar[XB_TOPGEN]) == tg, bar);
            __builtin_amdgcn_fence(__ATOMIC_ACQUIRE, "agent");
            xb_add(&bar[XB_XGEN(b.x)], 1u);
            asm volatile("s_waitcnt vmcnt(0)" ::: "memory");
        } else {
            XB_SPIN(xb_ld(&bar[XB_XGEN(b.x)]) == gen, bar);
            __builtin_amdgcn_fence(__ATOMIC_ACQUIRE, "agent");
            asm volatile("s_waitcnt vmcnt(0)" ::: "memory");
        }
    }
    __syncthreads();
}

struct Ctx { LAS unsigned char* lds; int tid, lane, wave, bid, nb, vcu; };
struct Args { const float* in[40]; float* out; unsigned char* ws; int ph_lo, ph_hi; };
enum { I_X = 0, I_C, I_CTX, I_CCTX, I_ADAW, I_ADAB, I_N1G, I_N2G, I_EVWIN, I_EVWOUT, I_QNORM, I_WUQ, I_KVNORM, I_WUKV, I_QG, I_KG, I_DWW, I_DWB, I_LNG, I_LNB,
       I_ODWIN, I_ODWOUT, I_SHIFTW, I_W0, I_W2L, I_A0, I_A2, I_G2, I_KKW, I_KA, I_RK, I_GNG, I_GNB, I_NAQG, I_NAKG, I_RPB, I_ROUTER, I_MW1, I_MW3, I_MW2 };

DI void transpose_item(const float* __restrict__ W, int K, int N, bf16* __restrict__ WT, int dst_row0, const float* __restrict__ gain, LAS float* scr, int k0, int n0, int lane) {
#pragma unroll 8
    for (int i = 0; i < 32; ++i) { const int kk = 2 * i + (lane >> 5); float v = W[(size_t)(k0 + kk) * N + n0 + (lane & 31)]; if (gain) v *= gain[k0 + kk]; scr[kk * 33 + (lane & 31)] = v; }
    asm volatile("s_waitcnt lgkmcnt(0)" ::: "memory");
    const int c = lane & 7;
#pragma unroll
    for (int j = 0; j < 4; ++j) { const int n = (lane >> 3) + 8 * j; const LAS float* s = scr + (8 * c) * 33 + n;
        u32x4 o; o.x = pk2(s[0 * 33], s[1 * 33]); o.y = pk2(s[2 * 33], s[3 * 33]); o.z = pk2(s[4 * 33], s[5 * 33]); o.w = pk2(s[6 * 33], s[7 * 33]);
        *(u32x4*)(WT + (size_t)(dst_row0 + n) * K + k0 + 8 * c) = o; }
    asm volatile("s_waitcnt lgkmcnt(0)" ::: "memory");
}
DI void transpose_item64(const float* __restrict__ W, int K, int N, bf16* __restrict__ WT, int dst_row0, LAS float* scr, int k0, int n0, int lane) {
    f32x4 v[16];
#pragma unroll
    for (int i = 0; i < 16; ++i) v[i] = *(const f32x4*)(W + (size_t)(k0 + 4 * i + (lane >> 4)) * N + n0 + 4 * (lane & 15));
#pragma unroll
    for (int i = 0; i < 16; ++i) { LAS float* d = scr + (4 * i + (lane >> 4)) * 65 + 4 * (lane & 15); d[0] = v[i].x; d[1] = v[i].y; d[2] = v[i].z; d[3] = v[i].w; }
    asm volatile("s_waitcnt lgkmcnt(0)" ::: "memory");
    const int c = lane & 7;
#pragma unroll
    for (int j = 0; j < 8; ++j) { const int n = (lane >> 3) + 8 * j; const LAS float* s = scr + (8 * c) * 65 + n;
        u32x4 o; o.x = pk2(s[0 * 65], s[1 * 65]); o.y = pk2(s[2 * 65], s[3 * 65]); o.z = pk2(s[4 * 65], s[5 * 65]); o.w = pk2(s[6 * 65], s[7 * 65]);
        *(u32x4*)(WT + (size_t)(dst_row0 + n) * K + k0 + 8 * c) = o; }
    asm volatile("s_waitcnt lgkmcnt(0)" ::: "memory");
}
DI void transpose_item64_f8(const float* __restrict__ W, int K, int N, unsigned char* __restrict__ WT8, int dst_row0, LAS float* scr, int k0, int n0, int lane) {
    f32x4 v[16];
#pragma unroll
    for (int i = 0; i < 16; ++i) v[i] = *(const f32x4*)(W + (size_t)(k0 + 4 * i + (lane >> 4)) * N + n0 + 4 * (lane & 15));
#pragma unroll
    for (int i = 0; i < 16; ++i) { LAS float* d = scr + (4 * i + (lane >> 4)) * 65 + 4 * (lane & 15); d[0] = v[i].x; d[1] = v[i].y; d[2] = v[i].z; d[3] = v[i].w; }
    asm volatile("s_waitcnt lgkmcnt(0)" ::: "memory");
    const int c = lane & 7;
#pragma unroll
    for (int j = 0; j < 8; ++j) { const int n = (lane >> 3) + 8 * j; const LAS float* s = scr + (8 * c) * 65 + n;
        u32x2 o; o.x = pk4_fp8(64.f * s[0 * 65], 64.f * s[1 * 65], 64.f * s[2 * 65], 64.f * s[3 * 65]); o.y = pk4_fp8(64.f * s[4 * 65], 64.f * s[5 * 65], 64.f * s[6 * 65], 64.f * s[7 * 65]);
        *(u32x2*)(WT8 + (size_t)(dst_row0 + n) * K + k0 + 8 * c) = o; }
    asm volatile("s_waitcnt lgkmcnt(0)" ::: "memory");
}
DI void transpose_matrix(const Ctx& C, const float* W, int K, int N, bf16* WT, const float* gain, int mode  ) {
    LAS float* scr = (LAS float*)(C.lds + C.wave * 8704);
    const int nkb = K / 64, nnb = N / 32, nit = nkb * nnb, gw = C.vcu * 8 + C.wave, ngw = C.nb * 8;
    for (int it = gw; it < nit; it += ngw) {
        const int kb = it / nnb, nbk = it % nnb, n0 = nbk * 32;
        int d0 = n0; if (mode) d0 = (n0 >> 7) * 256 + (n0 & 127) + (mode == 2 ? 128 : 0);
        transpose_item(W, K, N, WT, d0, gain, scr, kb * 64, n0, C.lane);
    }
}

DI void ph_prologue(const Ctx& C, const Args& a) {
    unsigned char* ws = a.ws;
    {
        LAS float* sv = (LAS float*)C.lds;
        LAS float* red = sv + 9 * 1024;
        for (int i = C.tid; i < 9 * 1024; i += 512) { const int m = i >> 10, k = i & 1023; const float c = (m < 8) ? a.in[I_C][m * 1024 + k] : a.in[I_CCTX][k]; sv[i] = siluf_(c); }
        __syncthreads();
        float* MOD = (float*)(ws + WS_MOD);
        for (int it = C.bid; it < 4 * 96; it += C.nb) {
            const int layer = it / 96, col = (it % 96) * 64 + C.lane;
            const float* wp = a.in[I_ADAW] + (size_t)layer * 1024 * 6144 + col;
            float acc[9];
#pragma unroll
            for (int m = 0; m < 9; ++m) acc[m] = 0.f;
            const int kb = C.wave * 128;
#pragma unroll 16
            for (int k = 0; k < 128; ++k) { const float w = wp[(size_t)(kb + k) * 6144];
#pragma unroll
                for (int m = 0; m < 9; ++m) acc[m] += sv[m * 1024 + kb + k] * w; }
#pragma unroll
            for (int m = 0; m < 9; ++m) red[(C.wave * 9 + m) * 64 + C.lane] = acc[m];
            __syncthreads();
            for (int i = C.tid; i < 576; i += 512) { const int m = i >> 6, l = i & 63; float s = 0.f;
#pragma unroll
                for (int w = 0; w < 8; ++w) s += red[(w * 9 + m) * 64 + l];
                const int cc = (it % 96) * 64 + l;
                MOD[(size_t)(layer * 9 + m) * 6144 + cc] = s + a.in[I_ADAB][layer * 6144 + cc]; }
            __syncthreads();
        }
    }
    {
        f32x2* CS = (f32x2*)(ws + WS_ROPE);
        for (int i = C.bid * 512 + C.tid; i < 4096 * 16; i += C.nb * 512) {
            const int pos = i >> 4, j = i & 15, f = j & 7;
            const float inv = powf(10000.f, -(float)(2 * f) / 16.f);
            const float ang = (float)((j < 8) ? (pos >> 6) : (pos & 63)) * inv;
            const double tw = 6.283185307179586476925;
            const double x = (double)ang, n = __builtin_rint(x / tw), rr = x - n * tw;
            CS[i] = (f32x2){__cosf((float)rr), __sinf((float)rr)};
        }
    }
    for (int j = 0; j < 2; ++j) {
        transpose_matrix(C, a.in[I_EVWIN] + (size_t)j * DM * EV_IN, DM, EV_IN, (bf16*)(ws + WS_WEVIN) + (size_t)j * EV_INP * DM, nullptr, 0);
        transpose_matrix(C, a.in[I_EVWOUT] + (size_t)j * DM * DM, DM, DM, (bf16*)(ws + WS_WEVOUT) + (size_t)j * DM * DM, nullptr, 0);
        transpose_matrix(C, a.in[I_WUQ] + (size_t)j * 384 * 768, 384, 768, (bf16*)(ws + WS_WUQ) + (size_t)j * 768 * 384, a.in[I_QNORM] + j * 384, 0);
        transpose_matrix(C, a.in[I_WUKV] + (size_t)j * 256 * 1024, 256, 1024, (bf16*)(ws + WS_WUKV) + (size_t)j * 1024 * 256, a.in[I_KVNORM] + j * 256, 0);
        transpose_matrix(C, a.in[I_ODWIN] + (size_t)j * DM * OD_IN, DM, OD_IN, (bf16*)(ws + WS_WODIN) + (size_t)j * OD_INP * DM, nullptr, 0);
        transpose_matrix(C, a.in[I_ODWOUT] + (size_t)j * DM * DM, DM, DM, (bf16*)(ws + WS_WODOUT) + (size_t)j * DM * DM, nullptr, 0);
    }
    {
        const int gt = C.bid * 512 + C.tid, ngt = C.nb * 512;
        for (int j = 0; j < 2; ++j) {
            u32x4* p0 = (u32x4*)((bf16*)(ws + WS_WEVIN) + (size_t)j * EV_INP * DM + (size_t)EV_IN * DM);
            for (int i = gt; i < (EV_INP - EV_IN) * DM / 8; i += ngt) p0[i] = (u32x4){0u, 0u, 0u, 0u};
            u32x4* p1 = (u32x4*)((bf16*)(ws + WS_WODIN) + (size_t)j * OD_INP * DM + (size_t)OD_IN * DM);
            for (int i = gt; i < (OD_INP - OD_IN) * DM / 8; i += ngt) p1[i] = (u32x4){0u, 0u, 0u, 0u};
            bf16* WL = (bf16*)(ws + WS_WLORA) + (size_t)j * 655360;
            const float* w2 = a.in[I_W2L] + (size_t)j * 2 * 64 * 512; const float* a2 = a.in[I_A2] + (size_t)j * 2 * 64 * 512; const float* g2 = a.in[I_G2] + (size_t)j * 128 * 512;
            for (int i = gt; i < 655360; i += ngt) {
                const int n = i >> 8, k = i & 255; float v = 0.f;
                if (n < 1024) { const int d = n >> 9, c = n & 511; if (k >= d * 64 && k < d * 64 + 64) v = w2[(size_t)k * 512 + c]; }
                else if (n < 2048) { const int d = (n - 1024) >> 9, c = n & 511; if (k >= 128 + d * 64 && k < 192 + d * 64) v = a2[(size_t)(k - 128) * 512 + c]; }
                else { const int c = n - 2048; if (k >= 128) v = g2[(size_t)(k - 128) * 512 + c]; }
                WL[i] = f2bf(v);
            }
        }
    }
}

template <bool ROUTER> DI void norm_row(const Ctx& C, int row, const float* xlat, const float* xctx, const float* gain, const float* mod, int shift_off, int scale_off, bf16* H, float* AFFT, float* AFFC, int* SLOT);
template <bool ROUTER, int NR> DI void norm_rowsN(const Ctx& C, int row, const float* xlat, const float* gain, const float* mod, int shift_off, int scale_off, bf16* H, float* AFFT, int* SLOT);
template <bool ROUTER>
DI void ph_norm(const Ctx& C, const float* xlat, const float* xctx, const float* gain, const float* mod  , int shift_off, int scale_off, bf16* H,
                const float* router  , float* AFFT, float* AFFC, int* SLOT) {
    LAS float* RT = (LAS float*)C.lds;
    if (ROUTER) { for (int i = C.tid; i < 16384; i += 512) { const int c = i >> 4, e = i & 15; RT[e * 1024 + c] = router[i]; } __syncthreads(); }
    const int gw = C.bid * 8 + C.wave, ngw = C.nb * 8;
    for (int p = gw; p < NLAT / 4; p += ngw) norm_rowsN<ROUTER, 4>(C, 4 * p, xlat, gain, mod, shift_off, scale_off, H, AFFT, SLOT);
    for (int row = NLAT + gw; row < MT; row += ngw) norm_row<ROUTER>(C, row, xlat, xctx, gain, mod, shift_off, scale_off, H, AFFT, AFFC, SLOT);
}
template <bool ROUTER, int NR>
DI void norm_rowsN(const Ctx& C, int row, const float* __restrict__ xlat, const float* __restrict__ gain, const float* __restrict__ mod, int shift_off, int scale_off, bf16* __restrict__ H, float* __restrict__ AFFT, int* __restrict__ SLOT) {
    const LAS float* RT = (const LAS float*)C.lds; const int lane = C.lane;
    const float* xr = xlat + (size_t)row * DM;
    const float* mp = mod + (row >> 12) * 6144;
    f32x4 v[NR][4]; float rs[NR];
#pragma unroll
    for (int q = 0; q < NR; ++q) { float ss = 0.f;
#pragma unroll
        for (int j = 0; j < 4; ++j) { v[q][j] = *(const f32x4*)(xr + q * DM + 256 * j + 4 * lane); ss += v[q][j].x * v[q][j].x + v[q][j].y * v[q][j].y + v[q][j].z * v[q][j].z + v[q][j].w * v[q][j].w; }
        rs[q] = 1.0f / sqrtf(wave_sum(ss) * (1.f / 1024.f) + EPS); }
#pragma unroll
    for (int j = 0; j < 4; ++j) {
        const int c = 256 * j + 4 * lane;
        const f32x4 g = *(const f32x4*)(gain + c), sc = *(const f32x4*)(mp + scale_off + c), sh = *(const f32x4*)(mp + shift_off + c);
#pragma unroll
        for (int q = 0; q < NR; ++q) {
            v[q][j] = (v[q][j] * rs[q]) * g * (sc + 1.0f) + sh;
            if (ROUTER && MOE_F8) *(unsigned*)((unsigned char*)H + (size_t)(row + q) * DM + c) = pk4_fp8(v[q][j].x, v[q][j].y, v[q][j].z, v[q][j].w);
            else *(u32x2*)(H + (size_t)(row + q) * DM + c) = (u32x2){pk2(v[q][j].x, v[q][j].y), pk2(v[q][j].z, v[q][j].w)};
        }
    }
    if constexpr (ROUTER && NR == 4) {
        float lgp = 0.f;
#pragma unroll 1
        for (int e = 0; e < 16; ++e) { float p[4] = {0.f, 0.f, 0.f, 0.f};
#pragma unroll
            for (int j = 0; j < 4; ++j) { const f32x4 w = *(const LAS f32x4*)(RT + e * 1024 + 256 * j + 4 * lane);
#pragma unroll
                for (int q = 0; q < 4; ++q) p[q] += v[q][j].x * w.x + v[q][j].y * w.y + v[q][j].z * w.z + v[q][j].w * w.w; }
            asm volatile("v_nop\n\tv_nop\n\tv_permlane32_swap_b32 %0, %1\n\ts_nop 1" : "+v"(p[0]), "+v"(p[1]));
            asm volatile("v_nop\n\tv_nop\n\tv_permlane32_swap_b32 %0, %1\n\ts_nop 1" : "+v"(p[2]), "+v"(p[3]));
            float t01 = p[0] + p[1], t23 = p[2] + p[3];
            asm volatile("v_nop\n\tv_nop\n\tv_permlane16_swap_b32 %0, %1\n\ts_nop 1" : "+v"(t01), "+v"(t23));
            const float u = sum16(t01 + t23);
            lgp = ((lane & 15) == e) ? u : lgp; }
        const float ex = expf(lgp - max16(lgp)); const float af = ex / sum16(ex);
        const int g = lane >> 4, q = (g == 1) ? 2 : ((g == 2) ? 1 : g), ee = lane & 15;
        AFFT[(size_t)((row >> 12) * 16 + ee) * TL + ((row + q) & 4095)] = af; SLOT[(size_t)(row + q) * 16 + ee] = -1;
    } else if (ROUTER) {
        float lg[NR];
#pragma unroll
        for (int q = 0; q < NR; ++q) lg[q] = 0.f;
#pragma unroll 1
        for (int e = 0; e < 16; ++e) { float p[NR];
#pragma unroll
            for (int q = 0; q < NR; ++q) p[q] = 0.f;
#pragma unroll
            for (int j = 0; j < 4; ++j) { const f32x4 w = *(const LAS f32x4*)(RT + e * 1024 + 256 * j + 4 * lane);
#pragma unroll
                for (int q = 0; q < NR; ++q) p[q] += v[q][j].x * w.x + v[q][j].y * w.y + v[q][j].z * w.z + v[q][j].w * w.w; }
#pragma unroll
            for (int q = 0; q < NR; ++q) { const float t = wave_sum(p[q]); lg[q] = (lane == e) ? t : lg[q]; } }
#pragma unroll
        for (int q = 0; q < NR; ++q) { const float ex = expf(lg[q] - max16(lg[q])); const float af = ex / sum16(ex);
            if (lane < 16) { AFFT[(size_t)((row >> 12) * 16 + lane) * TL + ((row + q) & 4095)] = af; SLOT[(size_t)(row + q) * 16 + lane] = -1; } }
    }
}
template <bool ROUTER>
DI void norm_row(const Ctx& C, int row, const float* __restrict__ xlat, const float* __restrict__ xctx, const float* __restrict__ gain, const float* __restrict__ mod, int shift_off, int scale_off, bf16* __restrict__ H, float* __restrict__ AFFT, float* __restrict__ AFFC, int* __restrict__ SLOT) {
    const LAS float* RT = (const LAS float*)C.lds; const int lane = C.lane;
    {
        const float* xr = row < NLAT ? xlat + (size_t)row * DM : xctx + (size_t)(row - NLAT) * DM;
        const int mi = row < NLAT ? (row >> 12) : 8;
        const float* mp = mod + mi * 6144;
        f32x4 v[4]; float ss = 0.f;
#pragma unroll
        for (int j = 0; j < 4; ++j) { v[j] = *(const f32x4*)(xr + 256 * j + 4 * lane); ss += v[j].x * v[j].x + v[j].y * v[j].y + v[j].z * v[j].z + v[j].w * v[j].w; }
        ss = wave_sum(ss);
        const float rs = 1.0f / sqrtf(ss * (1.f / 1024.f) + EPS);
#pragma unroll
        for (int j = 0; j < 4; ++j) {
            const int c = 256 * j + 4 * lane;
            const f32x4 g = *(const f32x4*)(gain + c), sc = *(const f32x4*)(mp + scale_off + c), sh = *(const f32x4*)(mp + shift_off + c);
            v[j] = (v[j] * rs) * g * (sc + 1.0f) + sh;
            if (ROUTER && MOE_F8) *(unsigned*)((unsigned char*)H + (size_t)row * DM + c) = pk4_fp8(v[j].x, v[j].y, v[j].z, v[j].w);
            else *(u32x2*)(H + (size_t)row * DM + c) = (u32x2){pk2(v[j].x, v[j].y), pk2(v[j].z, v[j].w)};
        }
        if (ROUTER) {
            float mylg = 0.f;
#pragma unroll 1
            for (int e = 0; e < 16; ++e) { float p = 0.f;
#pragma unroll
                for (int j = 0; j < 4; ++j) { const f32x4 w = *(const LAS f32x4*)(RT + e * 1024 + 256 * j + 4 * lane); p += v[j].x * w.x + v[j].y * w.y + v[j].z * w.z + v[j].w * w.w; }
                p = wave_sum(p); mylg = (lane == e) ? p : mylg; }
            const float mx = max16(mylg);
            const float ex = expf(mylg - mx);
            const float mine = ex / sum16(ex);
            if (lane < 16) {
                if (row < NLAT) AFFT[(size_t)((row >> 12) * 16 + lane) * TL + (row & 4095)] = mine;
                else { const int rc = row - NLAT; AFFC[(size_t)((rc >> 8) * 16 + lane) * LCX + (rc & 255)] = mine; }
                SLOT[(size_t)row * 16 + lane] = -1;
            }
        }
    }
}


struct EpiBf16 { static constexpr bool WIDE = true, CUSTOM = false; bf16* O; int ldo;
    DI void operator()(int row, int col, f32x4 v0, f32x4 v1) const { bf16* p = O + (size_t)row * ldo + col;
        *(u32x2*)p = (u32x2){pk2(v0[0], v0[1]), pk2(v0[2], v0[3])}; *(u32x2*)(p + 128) = (u32x2){pk2(v1[0], v1[1]), pk2(v1[2], v1[3])}; }
    DI void wide(int row, int col, f32x4 a0, f32x4 a1, f32x4 b0, f32x4 b1) const { bf16* p = O + (size_t)row * ldo + col;
        *(u32x4*)p = (u32x4){pk2(a0[0], a0[1]), pk2(a0[2], a0[3]), pk2(a1[0], a1[1]), pk2(a1[2], a1[3])}; *(u32x4*)(p + 128) = (u32x4){pk2(b0[0], b0[1]), pk2(b0[2], b0[3]), pk2(b1[0], b1[1]), pk2(b1[2], b1[3])}; } };
struct EpiF32 { static constexpr bool WIDE = false, CUSTOM = false; float* O; int ldo;
    DI void operator()(int row, int col, f32x4 v0, f32x4 v1) const { float* p = O + (size_t)row * ldo + col; *(f32x4*)p = v0; *(f32x4*)(p + 128) = v1; } };
struct EpiResid { static constexpr bool WIDE = false, CUSTOM = true; const float* xin_lat; const float* xin_ctx; float* xout_lat; float* xout_ctx; const float* modg;
    DI void run(const f32x4 (&acc)[2][2][4][2], int pm, int pn, int wr, int wc, int fr, int fq) const {
        const int r0 = pm * 256 + wr * 64 + fr, c0 = pn * 256 + wc * 32 + 8 * fq; const bool lat = pm * 256 < NLAT;
        const float* xi = lat ? xin_lat + (size_t)r0 * DM : xin_ctx + (size_t)(r0 - NLAT) * DM; float* xo = lat ? xout_lat + (size_t)r0 * DM : xout_ctx + (size_t)(r0 - NLAT) * DM;
        const float* g = modg + (lat ? (pm * 256) >> 12 : 8) * 6144 + c0;
        f32x4 gv[2][2];
#pragma unroll
        for (int n = 0; n < 2; ++n) { gv[n][0] = *(const f32x4*)(g + 4 * n); gv[n][1] = *(const f32x4*)(g + 4 * n + 128); }
#pragma unroll
        for (int ai = 0; ai < 2; ++ai)
#pragma unroll
            for (int mh = 0; mh < 2; ++mh) { f32x4 xv[2][2][2];
#pragma unroll
                for (int m2 = 0; m2 < 2; ++m2)
#pragma unroll
                    for (int n = 0; n < 2; ++n) { const size_t o = (size_t)(ai * 128 + (2 * mh + m2) * 16) * DM + c0 + 4 * n; xv[m2][n][0] = *(const f32x4*)(xi + o); xv[m2][n][1] = *(const f32x4*)(xi + o + 128); }
#pragma unroll
                for (int m2 = 0; m2 < 2; ++m2)
#pragma unroll
                    for (int n = 0; n < 2; ++n) { const size_t o = (size_t)(ai * 128 + (2 * mh + m2) * 16) * DM + c0 + 4 * n;
                        *(f32x4*)(xo + o) = xv[m2][n][0] + gv[n][0] * acc[ai][0][2 * mh + m2][n]; *(f32x4*)(xo + o + 128) = xv[m2][n][1] + gv[n][1] * acc[ai][1][2 * mh + m2][n]; } } }
    DI void operator()(int row, int col, f32x4 v0, f32x4 v1) const {
        const float* xi; float* xo; int mi;
        if (row < NLAT) { xi = xin_lat + (size_t)row * DM; xo = xout_lat + (size_t)row * DM; mi = row >> 12; }
        else { xi = xin_ctx + (size_t)(row - NLAT) * DM; xo = xout_ctx + (size_t)(row - NLAT) * DM; mi = 8; }
        const float* g = modg + mi * 6144 + col;
        const f32x4 g0 = *(const f32x4*)g, g1 = *(const f32x4*)(g + 128), x0 = *(const f32x4*)(xi + col), x1 = *(const f32x4*)(xi + col + 128);
        *(f32x4*)(xo + col) = x0 + g0 * v0; *(f32x4*)(xo + col + 128) = x1 + g1 * v1; } };
struct EpiGlu { static constexpr bool WIDE = false, CUSTOM = false; bf16* O;
    DI void operator()(int row, int col, f32x4 v0, f32x4 v1) const { const int f = ((col & 2047) >> 8) * 128 + (col & 255);
        *(u32x2*)(O + (size_t)row * DM + f) = (u32x2){pk2(siluf_(v0[0]) * v1[0], siluf_(v0[1]) * v1[1]), pk2(siluf_(v0[2]) * v1[2], siluf_(v0[3]) * v1[3])}; } };
struct EpiGlu8 { static constexpr bool WIDE = true, CUSTOM = false; unsigned char* O;
    DI void operator()(int row, int col, f32x4 v0, f32x4 v1) const { const int f = ((col & 2047) >> 8) * 128 + (col & 255);
        *(unsigned*)(O + (size_t)row * DM + f) = pk4_fp8(8.f * siluf_(v0[0]) * v1[0], 8.f * siluf_(v0[1]) * v1[1], 8.f * siluf_(v0[2]) * v1[2], 8.f * siluf_(v0[3]) * v1[3]); }
    DI void wide(int row, int col, f32x4 a0, f32x4 a1, f32x4 b0, f32x4 b1) const { const int f = ((col & 2047) >> 8) * 128 + (col & 255);
        *(u32x2*)(O + (size_t)row * DM + f) = (u32x2){pk4_fp8(8.f * siluf_(a0[0]) * b0[0], 8.f * siluf_(a0[1]) * b0[1], 8.f * siluf_(a0[2]) * b0[2], 8.f * siluf_(a0[3]) * b0[3]),
                                                    pk4_fp8(8.f * siluf_(a1[0]) * b1[0], 8.f * siluf_(a1[1]) * b1[1], 8.f * siluf_(a1[2]) * b1[2], 8.f * siluf_(a1[3]) * b1[3])}; } };
struct EpiGate { static constexpr bool WIDE = true, CUSTOM = true; bf16* O; const float* gate;
    DI void run(const f32x4 (&acc)[2][2][4][2], int pm, int pn, int wr, int wc, int fr, int fq) const {
        const int r0 = pm * 256 + wr * 64 + fr, col = (pn * 256 + wc * 32 + 8 * fq) & 1023; float gt[2][4];
#pragma unroll
        for (int ai = 0; ai < 2; ++ai)
#pragma unroll
            for (int m = 0; m < 4; ++m) gt[ai][m] = gate[r0 + ai * 128 + m * 16];
#pragma unroll
        for (int ai = 0; ai < 2; ++ai)
#pragma unroll
            for (int m = 0; m < 4; ++m) { const float g = gt[ai][m]; bf16* p = O + (size_t)(r0 + ai * 128 + m * 16) * DM + col;
                const f32x4 a0 = acc[ai][0][m][0], a1 = acc[ai][0][m][1], b0 = acc[ai][1][m][0], b1 = acc[ai][1][m][1];
                *(u32x4*)p = (u32x4){pk2(a0[0] * g, a0[1] * g), pk2(a0[2] * g, a0[3] * g), pk2(a1[0] * g, a1[1] * g), pk2(a1[2] * g, a1[3] * g)};
                *(u32x4*)(p + 128) = (u32x4){pk2(b0[0] * g, b0[1] * g), pk2(b0[2] * g, b0[3] * g), pk2(b1[0] * g, b1[1] * g), pk2(b1[2] * g, b1[3] * g)}; } }
    DI void operator()(int row, int col, f32x4 v0, f32x4 v1) const { const float g = gate[row]; bf16* p = O + (size_t)row * DM + (col & 1023);
        *(u32x2*)p = (u32x2){pk2(v0[0] * g, v0[1] * g), pk2(v0[2] * g, v0[3] * g)}; *(u32x2*)(p + 128) = (u32x2){pk2(v1[0] * g, v1[1] * g), pk2(v1[2] * g, v1[3] * g)}; }
    DI void wide(int row, int col, f32x4 a0, f32x4 a1, f32x4 b0, f32x4 b1) const { const float g = gate[row]; bf16* p = O + (size_t)row * DM + (col & 1023);
        *(u32x4*)p = (u32x4){pk2(a0[0] * g, a0[1] * g), pk2(a0[2] * g, a0[3] * g), pk2(a1[0] * g, a1[1] * g), pk2(a1[2] * g, a1[3] * g)};
        *(u32x4*)(p + 128) = (u32x4){pk2(b0[0] * g, b0[1] * g), pk2(b0[2] * g, b0[3] * g), pk2(b1[0] * g, b1[1] * g), pk2(b1[2] * g, b1[3] * g)}; } };
typedef _Float16 f16x2_t __attribute__((ext_vector_type(2)));
DI unsigned pk2h(float a, float b) { f16x2_t h; h.x = (_Float16)a; h.y = (_Float16)b; return __builtin_bit_cast(unsigned, h); }
DI float h2f(unsigned short x) { return (float)__builtin_bit_cast(_Float16, x); }
struct EpiLoraW { static constexpr bool WIDE = false, CUSTOM = true; unsigned short* W; const float* w0;
    DI void one(int row, int col, f32x4 v) const { const int d = col >> 9, c = col & 511; f32x4 o;
#pragma unroll
        for (int e = 0; e < 4; ++e) { const float lw = w0[col + e] + v[e]; const float z = -lw; const float sp = fmaxf(z, 0.f) + __logf(1.f + __expf(-fabsf(z))); o[e] = -__expf(-sp - 0.5f); }
        *(u32x2*)(W + ((size_t)d * MT + row) * 512 + c) = (u32x2){pk2h(o[0], o[1]), pk2h(o[2], o[3])}; }
    DI void operator()(int row, int col, f32x4 v0, f32x4 v1) const { one(row, col, v0); one(row, col + 128, v1); }
    DI void run(const f32x4 (&acc)[2][2][4][2], int pm, int pn, int wr, int wc, int fr, int fq) const {
        const int r0 = pm * 256 + wr * 64 + fr, c0 = pn * 256 + wc * 32 + 8 * fq; f32x4 wv[2][2];
#pragma unroll
        for (int n = 0; n < 2; ++n) { wv[n][0] = *(const f32x4*)(w0 + c0 + 4 * n); wv[n][1] = *(const f32x4*)(w0 + c0 + 4 * n + 128); }
#pragma unroll
        for (int ai = 0; ai < 2; ++ai)
#pragma unroll
            for (int m = 0; m < 4; ++m)
#pragma unroll
                for (int n = 0; n < 2; ++n)
#pragma unroll
                    for (int bj = 0; bj < 2; ++bj) { const int row = r0 + ai * 128 + m * 16, col = c0 + 4 * n + 128 * bj, d = col >> 9, c = col & 511; f32x4 o;
#pragma unroll
                        for (int e = 0; e < 4; ++e) { const float lw = wv[n][bj][e] + acc[ai][bj][m][n][e]; const float z = -lw; const float sp = fmaxf(z, 0.f) + __logf(1.f + __expf(-fabsf(z))); o[e] = -__expf(-sp - 0.5f); }
                        *(u32x2*)(W + ((size_t)d * MT + row) * 512 + c) = (u32x2){pk2h(o[0], o[1]), pk2h(o[2], o[3])}; } } };
struct EpiLoraA { static constexpr bool WIDE = false, CUSTOM = true; bf16* Aout; const float* a0;
    DI void one(int row, int col, f32x4 v) const { const int d = col >> 9, c = col & 511; const f32x4 b = *(const f32x4*)(a0 + col);
        *(u32x2*)(Aout + ((size_t)d * MT + row) * 512 + c) = (u32x2){pk2(sigmoidf_(b[0] + v[0]), sigmoidf_(b[1] + v[1])), pk2(sigmoidf_(b[2] + v[2]), sigmoidf_(b[3] + v[3]))}; }
    DI void operator()(int row, int col, f32x4 v0, f32x4 v1) const { one(row, col, v0); one(row, col + 128, v1); }
    DI void run(const f32x4 (&acc)[2][2][4][2], int pm, int pn, int wr, int wc, int fr, int fq) const {
        const int r0 = pm * 256 + wr * 64 + fr, c0 = pn * 256 + wc * 32 + 8 * fq; f32x4 av[2][2];
#pragma unroll
        for (int n = 0; n < 2; ++n) { av[n][0] = *(const f32x4*)(a0 + c0 + 4 * n); av[n][1] = *(const f32x4*)(a0 + c0 + 4 * n + 128); }
#pragma unroll
        for (int ai = 0; ai < 2; ++ai)
#pragma unroll
            for (int m = 0; m < 4; ++m)
#pragma unroll
                for (int n = 0; n < 2; ++n)
#pragma unroll
                    for (int bj = 0; bj < 2; ++bj) { const int row = r0 + ai * 128 + m * 16, col = c0 + 4 * n + 128 * bj, d = col >> 9, c = col & 511; const f32x4 b = av[n][bj], v = acc[ai][bj][m][n];
                        *(u32x2*)(Aout + ((size_t)d * MT + row) * 512 + c) = (u32x2){pk2(sigmoidf_(b[0] + v[0]), sigmoidf_(b[1] + v[1])), pk2(sigmoidf_(b[2] + v[2]), sigmoidf_(b[3] + v[3]))}; } } };

namespace pg8 {
constexpr int BM = 256, BK = 64, HALF = 128, HTB = HALF * BK * 2, STAGE_BYTES = 8 * HTB;
DI int lds_byte(int r, int c) { const int st = (r >> 4) * 2 + (c >> 5), rr = r & 15, cc = c & 31, ob = rr * 64 + cc * 2; return st * 1024 + (ob ^ (((ob >> 9) & 1) << 5)); }
DI void stage_rc(int b, int& R, int& C) { const int st = b / 1024, sb = b % 1024, swz = sb ^ (((sb >> 9) & 1) << 5); R = (st >> 1) * 16 + swz / 64; C = (st & 1) * 32 + (swz % 64) / 2; }
DI int perm32(int rho) { const int n = rho >> 4, i = rho & 15; return 8 * (i >> 2) + 4 * n + (i & 3); }
struct Unit { int pm, pn; };
struct Gemm { const bf16* A; const bf16* Bt; int lda, K; const int* rows; int scale_w = 0x7f7f7f7f, scale_a = 0x7f7f7f7f; };
struct OrderMN { int nM, nN, G, c;
    DI bool next(int i, Unit& u) const { const int L = i * G + c; if (L >= nM * nN) return false; u.pm = L / nN; u.pn = L % nN; return true; } };
struct OrderMoE { int nMt, nN, mstride  , G, c;
    DI bool next(int i, Unit& u) const { const int L = i * G + c, per = nMt * nN; if (L >= NEXP * per) return false; const int e = L / per, q = L % per; u.pm = e * mstride + q / nN; u.pn = e * nN + q % nN; return true; } };
template <class E4> struct EpiAdapt { E4 e;
    DI void operator()(const f32x4 (&acc)[2][2][4][2], const Unit& u, int wr, int wc, int fr, int fq) const {
        if constexpr (E4::CUSTOM) { e.run(acc, u.pm, u.pn, wr, wc, fr, fq); return; }
#pragma unroll
        for (int ai = 0; ai < 2; ++ai)
#pragma unroll
            for (int m = 0; m < 4; ++m) { const int row = u.pm * BM + ai * HALF + wr * 64 + m * 16 + fr;
                if constexpr (E4::WIDE) e.wide(row, u.pn * BM + wc * 32 + 8 * fq, acc[ai][0][m][0], acc[ai][0][m][1], acc[ai][1][m][0], acc[ai][1][m][1]);
                else {
#pragma unroll
                    for (int n = 0; n < 2; ++n) e(row, u.pn * BM + wc * 32 + 8 * fq + 4 * n, acc[ai][0][m][n], acc[ai][1][m][n]); } } } };

template <class Epi, class Sched, bool F8 = false>
DI void gemm_phase(LAS unsigned char* lds, const Gemm g, const Sched& S, const Epi& E, const int tid) {
    const int wid = __builtin_amdgcn_readfirstlane(tid >> 6), lane = tid & 63, wr = wid >> 2, wc = wid & 3, fr = lane & 15, fq = lane >> 4;
    const int K = g.K, nt = K / BK;
    unsigned voffB[2];
#pragma unroll
    for (int i = 0; i < 2; ++i) { int R, C; stage_rc(tid * 16 + i * 8192, R, C); const int Rb = (R & ~31) + perm32(R & 31); voffB[i] = (unsigned)(Rb * K + C) * 2u; }
    const size_t kstep = (size_t)(BK * 2), hstep = (size_t)HALF * K * 2, tstep = 2 * hstep;
    const unsigned ldsw = (unsigned)wid * 1024u;
    const int aoff = lds_byte(wr * 64 + fr, fq * 8), boff = lds_byte(wc * 32 + fr, fq * 8);
    const char* const gA = (const char*)g.A;
#define PG8_SA(b, h) (((b) * 2 + (h)) * HTB)
#define PG8_SB(b, h) ((4 + (b) * 2 + (h)) * HTB)
#define PG8_STAGE(bufoff, gbase, voff) do { _Pragma("unroll") for (int _i = 0; _i < 2; ++_i) \
        __builtin_amdgcn_global_load_lds((const unsigned*)((const char*)(gbase) + (voff)[_i]), (LAS unsigned*)(lds + (bufoff) + ldsw + _i * 8192), 16, 0, 0); } while (0)
#define PG8_LDA(dst, b, h) do { _Pragma("unroll") for (int m = 0; m < 4; ++m) _Pragma("unroll") for (int k = 0; k < 2; ++k) dst[m][k] = *(const LAS bf16x8*)(lds + PG8_SA(b, h) + aoff + m * 2048 + k * 1024); } while (0)
#define PG8_LDB(dst, b, h) do { _Pragma("unroll") for (int n = 0; n < 2; ++n) _Pragma("unroll") for (int k = 0; k < 2; ++k) dst[n][k] = *(const LAS bf16x8*)(lds + PG8_SB(b, h) + boff + n * 2048 + k * 1024); } while (0)
#define PG8_MMA(ai, bj, At, Bt) do { __builtin_amdgcn_s_setprio(1); _Pragma("unroll") for (int m = 0; m < 4; ++m) _Pragma("unroll") for (int n = 0; n < 2; ++n) { \
        if constexpr (F8) { const v8i_t w8 = __builtin_shufflevector(__builtin_bit_cast(i32x4_t, Bt[n][0]), __builtin_bit_cast(i32x4_t, Bt[n][1]), 0, 1, 2, 3, 4, 5, 6, 7), x8 = __builtin_shufflevector(__builtin_bit_cast(i32x4_t, At[m][0]), __builtin_bit_cast(i32x4_t, At[m][1]), 0, 1, 2, 3, 4, 5, 6, 7); \
            acc[ai][bj][m][n] = __builtin_amdgcn_mfma_scale_f32_16x16x128_f8f6f4(w8, x8, acc[ai][bj][m][n], 0, 0, 0, g.scale_w, 0, g.scale_a); } \
        else { _Pragma("unroll") for (int k = 0; k < 2; ++k) acc[ai][bj][m][n] = __builtin_amdgcn_mfma_f32_16x16x32_bf16(Bt[n][k], At[m][k], acc[ai][bj][m][n], 0, 0, 0); } } __builtin_amdgcn_s_setprio(0); } while (0)
#define PG8_WAIT_V(n) asm volatile("s_waitcnt vmcnt(" #n ")" ::: "memory")
#define PG8_WAIT_L(n) asm volatile("s_waitcnt lgkmcnt(" #n ")" ::: "memory")
#define PG8_BAR __builtin_amdgcn_s_barrier()
#define PG8_SCHED __builtin_amdgcn_sched_barrier(0)
#define PG8_ROWIDX(ri, u) do { _Pragma("unroll") for (int _h = 0; _h < 2; ++_h) _Pragma("unroll") for (int _i = 0; _i < 2; ++_i) { int _R, _C; stage_rc(tid * 16 + _i * 8192, _R, _C); (void)_C; \
        const int _lr = (u).pm * BM + _h * HALF + _R; ri[_h][_i] = g.rows ? g.rows[_lr] : _lr; } } while (0)
#define PG8_AOFF_FROM(vo, ri) do { _Pragma("unroll") for (int _h = 0; _h < 2; ++_h) _Pragma("unroll") for (int _i = 0; _i < 2; ++_i) { int _R, _C; stage_rc(tid * 16 + _i * 8192, _R, _C); (void)_R; \
        vo[_h][_i] = (unsigned)(((size_t)ri[_h][_i] * g.lda + _C) * 2u); } } while (0)
    Unit cur, nxt; int ui = 0;
    if (!S.next(0, cur)) return;
    f32x4 acc[2][2][4][2];
#pragma unroll
    for (int a = 0; a < 2; ++a)
#pragma unroll
        for (int b = 0; b < 2; ++b)
#pragma unroll
            for (int m = 0; m < 4; ++m)
#pragma unroll
                for (int n = 0; n < 2; ++n) acc[a][b][m][n] = (f32x4){0.f, 0.f, 0.f, 0.f};
    bf16x8 At[4][2], B0[2][2], B1[2][2];
    unsigned cvo[2][2]; int nri[2][2];
    PG8_ROWIDX(nri, cur); PG8_AOFF_FROM(cvo, nri);
    const char* cB = (const char*)g.Bt + (size_t)cur.pn * tstep;
    PG8_STAGE(PG8_SB(0, 0), cB, voffB); PG8_STAGE(PG8_SB(0, 1), cB + hstep, voffB); PG8_STAGE(PG8_SA(0, 0), gA, cvo[0]); PG8_STAGE(PG8_SA(0, 1), gA, cvo[1]);
    if (wr == 1) PG8_BAR;
    PG8_WAIT_V(2); PG8_BAR;
    PG8_STAGE(PG8_SB(1, 0), cB + kstep, voffB); PG8_STAGE(PG8_SA(1, 0), gA + kstep, cvo[0]); PG8_STAGE(PG8_SB(1, 1), cB + hstep + kstep, voffB);
    PG8_WAIT_V(6); PG8_BAR;
    for (;;) {
        const bool has_next = S.next(ui + 1, nxt);
        const char* nB = has_next ? (const char*)g.Bt + (size_t)nxt.pn * tstep : cB;
#pragma nounroll
        for (int t = 0; t < nt; t += 2) {
            const bool last = (t == nt - 2);
            const char* a1 = gA + (size_t)(t + 1) * kstep;
            const char* a2 = last ? gA : gA + (size_t)(t + 2) * kstep; const char* b2 = last ? nB : cB + (size_t)(t + 2) * kstep;
            const char* a3 = a2 + kstep; const char* b3 = b2 + kstep;
            if (t == nt - 4 && has_next) PG8_ROWIDX(nri, nxt);
            PG8_LDB(B0, 0, 0); PG8_LDB(B1, 0, 1); PG8_SCHED; PG8_LDA(At, 0, 0); PG8_STAGE(PG8_SA(1, 1), a1, cvo[1]);
            if (last && has_next) { if (nt < 4) PG8_ROWIDX(nri, nxt); PG8_AOFF_FROM(cvo, nri); }
            PG8_WAIT_V(8); PG8_WAIT_L(0); PG8_BAR; PG8_MMA(0, 0, At, B0); PG8_MMA(0, 1, At, B1); PG8_BAR; PG8_SCHED;
            PG8_LDA(At, 0, 1); PG8_STAGE(PG8_SB(0, 0), b2, voffB); PG8_STAGE(PG8_SB(0, 1), b2 + hstep, voffB); PG8_STAGE(PG8_SA(0, 0), a2, cvo[0]);
            PG8_WAIT_V(8); PG8_WAIT_L(0); PG8_BAR; PG8_MMA(1, 0, At, B0); PG8_MMA(1, 1, At, B1); PG8_BAR; PG8_SCHED;
            PG8_LDB(B0, 1, 0); PG8_LDB(B1, 1, 1); PG8_SCHED; PG8_LDA(At, 1, 0); PG8_STAGE(PG8_SA(0, 1), a2, cvo[1]);
            PG8_WAIT_V(8); PG8_WAIT_L(0); PG8_BAR; PG8_MMA(0, 0, At, B0); PG8_MMA(0, 1, At, B1); PG8_BAR; PG8_SCHED;
            PG8_LDA(At, 1, 1); PG8_STAGE(PG8_SB(1, 0), b3, voffB); PG8_STAGE(PG8_SB(1, 1), b3 + hstep, voffB); PG8_STAGE(PG8_SA(1, 0), a3, cvo[0]);
            PG8_WAIT_V(8); PG8_WAIT_L(0); PG8_BAR; PG8_MMA(1, 0, At, B0); PG8_MMA(1, 1, At, B1); PG8_BAR; PG8_SCHED;
        }
        if (wr == 0) PG8_BAR;
        E(acc, cur, wr, wc, fr, fq);
        if (!has_next) break;
#pragma unroll
        for (int a = 0; a < 2; ++a)
#pragma unroll
            for (int b = 0; b < 2; ++b)
#pragma unroll
                for (int m = 0; m < 4; ++m)
#pragma unroll
                    for (int n = 0; n < 2; ++n) acc[a][b][m][n] = (f32x4){0.f, 0.f, 0.f, 0.f};
        cur = nxt; cB = nB; ++ui;
        if (wr == 1) PG8_BAR;
    }
    PG8_WAIT_V(0);
    PG8_BAR;
#undef PG8_SA
#undef PG8_SB
#undef PG8_STAGE
#undef PG8_LDA
#undef PG8_LDB
#undef PG8_MMA
#undef PG8_WAIT_V
#undef PG8_WAIT_L
#undef PG8_BAR
#undef PG8_SCHED
#undef PG8_ROWIDX
#undef PG8_AOFF_FROM
}
}
template <class E4> DI void fast_gemm(const Ctx& C, const bf16* A, int lda, const bf16* Bt, int K, int nM, int nN, const E4& e, bool rev = false, int off = 0) {
    const int cr = ((C.vcu - off) % C.nb + C.nb) % C.nb;
    pg8::Gemm g{A, Bt, lda, K, nullptr}; pg8::OrderMN S{nM, nN, C.nb, rev ? C.nb - 1 - C.vcu : cr}; pg8::EpiAdapt<E4> E{e};
    pg8::gemm_phase(C.lds, g, S, E, C.tid);
}

DI float max16_acc(float m, const f32x16& x) {
    asm volatile("s_nop 15\n\tv_max3_f32 %0, %0, %1, %2\n\tv_max3_f32 %0, %0, %3, %4\n\tv_max3_f32 %0, %0, %5, %6\n\tv_max3_f32 %0, %0, %7, %8\n\tv_max3_f32 %0, %0, %9, %10\n\tv_max3_f32 %0, %0, %11, %12\n\tv_max3_f32 %0, %0, %13, %14\n\tv_max3_f32 %0, %0, %15, %16"
                 : "+v"(m) : "v"(x[0]), "v"(x[1]), "v"(x[2]), "v"(x[3]), "v"(x[4]), "v"(x[5]), "v"(x[6]), "v"(x[7]), "v"(x[8]), "v"(x[9]), "v"(x[10]), "v"(x[11]), "v"(x[12]), "v"(x[13]), "v"(x[14]), "v"(x[15]));
    return m; }
DI int swap23(int x) { return (x & ~12) | ((x & 4) << 1) | ((x & 8) >> 1); }
DI void flash_store(const f32x16 (&o)[2], float l, bf16* orow  , int h) {
    const float inv = 1.f / l;
#pragma unroll
    for (int dt = 0; dt < 2; ++dt)
#pragma unroll
        for (int g = 0; g < 4; ++g)
            *(u32x2*)(orow + 32 * dt + 8 * g + 4 * h) = (u32x2){pk2(o[dt][4 * g] * inv, o[dt][4 * g + 1] * inv), pk2(o[dt][4 * g + 2] * inv, o[dt][4 * g + 3] * inv)};
}


template <int DQK> struct AttnGeo { static constexpr int KSTR = DQK * 2 + 16, KBYTES = 64 * KSTR, VSTR = 144, VBYTES = 64 * VSTR, BUF = KBYTES + VBYTES, KPIECES = 64 * DQK / 8; };
template <int DQK, bool NAT>
DI void attn_tile_loop(const Ctx& C, f32x16 (&o)[2], float& l, const bf16x8 (&qf)[DQK / 16], const bf16* __restrict__ Kb, const bf16* __restrict__ Vt, int pos1, int n1, int pos2, int n2,
                       const LAS float* tab, int grow, int rs, int qc, int cs) {
    typedef AttnGeo<DQK> G;
    const int tid = C.tid, r = C.lane & 31, h = C.lane >> 5, kr = swap23(r), ntiles = n1 + n2;
    constexpr bool K2 = G::KPIECES > 512;
    const int kq0 = tid, kq1 = tid + 512;
    const int kl0 = (kq0 / (DQK / 8)) * G::KSTR + (kq0 % (DQK / 8)) * 16, kl1 = (kq1 / (DQK / 8)) * G::KSTR + (kq1 % (DQK / 8)) * 16;
    const int vl = G::KBYTES + (tid >> 3) * G::VSTR + (tid & 7) * 16;
    const bf16* vg = Vt + (size_t)(tid >> 3) * KPOS + 8 * (tid & 7);
    u32x4 rk0, rk1, rv;
    rk1 = (u32x4){0u, 0u, 0u, 0u};
#define ATT_POS(t) ((t) < n1 ? pos1 + 64 * (t) : pos2 + 64 * ((t) - n1))
    { const int pos0 = ATT_POS(0); rk0 = *(const u32x4*)(Kb + (size_t)pos0 * DQK + 8 * kq0); if (K2 && tid < 256) rk1 = *(const u32x4*)(Kb + (size_t)pos0 * DQK + 8 * kq1); rv = *(const u32x4*)(vg + pos0); }
    __syncthreads();
    *(LAS u32x4*)(C.lds + kl0) = rk0; if (K2 && tid < 256) *(LAS u32x4*)(C.lds + kl1) = rk1; *(LAS u32x4*)(C.lds + vl) = rv;
    __syncthreads();
    if (C.wave >= 4) __builtin_amdgcn_s_setprio(1);
    float mref = 0.f; bool first = true;
    f32x16 nmref;
#pragma unroll
    for (int i = 0; i < 16; ++i) nmref[i] = 0.f;
    constexpr float THR = 8.f;
    for (int t = 0; t < ntiles; ++t) {
        const LAS unsigned char* B = C.lds + (t & 1) * G::BUF;
        if (t + 1 < ntiles) { const int pos0 = ATT_POS(t + 1);
            rk0 = *(const u32x4*)(Kb + (size_t)pos0 * DQK + 8 * kq0); if (K2 && tid < 256) rk1 = *(const u32x4*)(Kb + (size_t)pos0 * DQK + 8 * kq1); rv = *(const u32x4*)(vg + pos0); }
        const int gr = (pos1 >> 6) + t;
        const bool active = !NAT || t >= n1 || (gr >= rs && gr < rs + 8);
        if (active) {
            f32x16 sc[2];
            constexpr int NK = DQK / 16, NS = 2 * NK, RD = 4;
            const LAS unsigned char* kp = B + kr * G::KSTR + 16 * h;
            bf16x8 fr[RD];
#pragma unroll
            for (int s = 0; s < RD; ++s) fr[s] = *(const LAS bf16x8*)(kp + (s / NK) * 32 * G::KSTR + 32 * (s % NK));
#pragma unroll
            for (int s = 0; s < NS; ++s) { sc[s / NK] = MFMA32(fr[s % RD], qf[s % NK], (s % NK == 0) ? nmref : sc[s / NK]);
                if (s + RD < NS) fr[s % RD] = *(const LAS bf16x8*)(kp + ((s + RD) / NK) * 32 * G::KSTR + 32 * ((s + RD) % NK)); }
            const LAS unsigned char* vp = B + G::KBYTES + r * G::VSTR + 16 * h;
#pragma unroll
            for (int v = 0; v < RD; ++v) fr[v] = *(const LAS bf16x8*)(vp + (v & 1) * 32 * G::VSTR + (v >> 1) * 32);
            __builtin_amdgcn_sched_group_barrier(0x100, RD, 0);
#pragma unroll
            for (int s = 0; s < NS - RD; ++s) { __builtin_amdgcn_sched_group_barrier(0x008, 1, 0); __builtin_amdgcn_sched_group_barrier(0x100, 1, 0); }
            __builtin_amdgcn_sched_group_barrier(0x008, RD, 0);
            __builtin_amdgcn_sched_group_barrier(0x100, RD, 0);
            if (NAT && t < n1) {
                const LAS float* trl = tab + (gr - grow + 7) * 128 + (8 * h - qc + 63);
#pragma unroll
                for (int j = 0; j < 2; ++j) { float bv[16];
#pragma unroll
                    for (int i = 0; i < 16; ++i) bv[i] = trl[32 * j + ((i & 3) | (((i >> 2) & 1) << 2) | ((i >> 3) << 4))];
                    asm volatile("" : "+v"(bv[0]), "+v"(bv[1]), "+v"(bv[2]), "+v"(bv[3]), "+v"(bv[4]), "+v"(bv[5]), "+v"(bv[6]), "+v"(bv[7]), "+v"(bv[8]), "+v"(bv[9]), "+v"(bv[10]), "+v"(bv[11]), "+v"(bv[12]), "+v"(bv[13]), "+v"(bv[14]), "+v"(bv[15]));
#pragma unroll
                    for (int i = 0; i < 16; ++i) {
                        const int cc = 32 * j + ((i & 3) | (((i >> 2) & 1) << 2) | ((i >> 3) << 4)) + 8 * h; const bool ok = (cc >= cs) && (cc < cs + 16);
                        sc[j][i] = ok ? sc[j][i] + bv[i] : -1e30f;
                    } }
            }
            float mx = max16_acc(max16_acc(-3.0e38f, sc[0]), sc[1]);
            if (first || __builtin_amdgcn_ballot_w64(mx > THR) != 0ull) {
                mx = fmaxf(mx, xor32(mx, C.lane));
                const float delta = first ? mx : fmaxf(mx, 0.f);
#pragma unroll
                for (int i = 0; i < 16; ++i) { sc[0][i] -= delta; sc[1][i] -= delta; }
                if (!first) { const float alpha = __builtin_amdgcn_exp2f(-delta); l *= alpha;
#pragma unroll
                    for (int i = 0; i < 16; ++i) { o[0][i] *= alpha; o[1][i] *= alpha; } }
                mref += delta; first = false;
#pragma unroll
                for (int i = 0; i < 16; ++i) nmref[i] = -mref;
            }
            float rs1 = 0.f;
#pragma unroll
            for (int j = 0; j < 2; ++j)
#pragma unroll
                for (int i = 0; i < 16; ++i) { sc[j][i] = __builtin_amdgcn_exp2f(sc[j][i]); rs1 += sc[j][i]; }
            l += rs1;
#pragma unroll
            for (int j = 0; j < 2; ++j)
#pragma unroll
                for (int s2 = 0; s2 < 2; ++s2) {
                    u32x4 pw; pw.x = pk2(sc[j][8 * s2], sc[j][8 * s2 + 1]); pw.y = pk2(sc[j][8 * s2 + 2], sc[j][8 * s2 + 3]); pw.z = pk2(sc[j][8 * s2 + 4], sc[j][8 * s2 + 5]); pw.w = pk2(sc[j][8 * s2 + 6], sc[j][8 * s2 + 7]);
                    const bf16x8 pb = __builtin_bit_cast(bf16x8, pw);
#pragma unroll
                    for (int dt = 0; dt < 2; ++dt) { const int v = 4 * j + 2 * s2 + dt;
                        o[dt] = MFMA32(fr[v % RD], pb, o[dt]);
                        if (v + RD < 8) fr[v % RD] = *(const LAS bf16x8*)(vp + ((v + RD) & 1) * 32 * G::VSTR + ((v + RD) >> 1) * 32); }
                }
#pragma unroll
            for (int v = 0; v < 8 - RD; ++v) { __builtin_amdgcn_sched_group_barrier(0x008, 1, 1); __builtin_amdgcn_sched_group_barrier(0x100, 1, 1); }
            __builtin_amdgcn_sched_group_barrier(0x008, RD, 1);
        }
        if (t + 1 < ntiles) { LAS unsigned char* Bn = C.lds + ((t + 1) & 1) * G::BUF;
            *(LAS u32x4*)(Bn + kl0) = rk0; if (K2 && tid < 256) *(LAS u32x4*)(Bn + kl1) = rk1; *(LAS u32x4*)(Bn + vl) = rv; }
        __syncthreads();
    }
    __builtin_amdgcn_s_setprio(0);
    l += xor32(l, C.lane);
#undef ATT_POS
}
DI void conv_unit(const Ctx& C, int u, const bf16* U, const float (&wk)[31], float bias, const float* lng, const float* lnb, bf16* OCAT);
DI const float* in_ptr(const unsigned char* ws, int k);
constexpr int CONV_PER_TAIL = 3;
DI int conv_in_fin(int nb) { const int extra = (MT / 64) % nb; const int n = CONV_PER_TAIL * (nb - extra); return n < MT / 32 ? n : MT / 32; }
DI void ph_attn_mla2(const Ctx& C, const bf16* QB, const bf16* KB, const bf16* VT, bf16* OCAT, bool last, unsigned char* ws, int lq) {
    const int r = C.lane & 31, h = C.lane >> 5;
    const int nunits = 1024 + (last ? 0 : 64);
    int k = 0;
    for (;; ++k) {
        const int u = C.vcu + k * C.nb, cu = conv_in_fin(C.nb) + (C.nb - 1 - C.vcu) + k * C.nb;
        const bool a_on = u < nunits, c_on = cu < MT / 32;
        if (!a_on && !c_on) break;
        if (a_on) {
            const int bh = u < 1024 ? (u >> 4) : u - 1024, qblk = u < 1024 ? (u & 15) : 16, b = bh >> 3, hh = bh & 7;
            const int qpos = qblk * 256 + 32 * C.wave + r;
            const bf16* qp = QB + ((size_t)bh * KPOS + qpos) * 96 + 8 * h;
            bf16x8 qf[6];
#pragma unroll
            for (int kk = 0; kk < 6; ++kk) qf[kk] = *(const bf16x8*)(qp + 16 * kk);
            f32x16 o[2];
#pragma unroll
            for (int i = 0; i < 16; ++i) { o[0][i] = 0.f; o[1][i] = 0.f; }
            float l = 0.f;
            attn_tile_loop<96, false>(C, o, l, qf, KB + (size_t)bh * KPOS * 96, VT + (size_t)bh * 64 * KPOS, qblk < 16 ? 0 : TL, qblk < 16 ? KPOS / 64 : LCX / 64, 0, 0, nullptr, 0, 0, 0, 0);
            const int row = qblk < 16 ? b * TL + qpos : NLAT + b * LCX + (qpos - TL);
            flash_store(o, l, OCAT + (size_t)row * DM + hh * 64, h);
        }
        if (c_on) { float wk[31]; const float* dww = in_ptr(ws, I_DWW) + (size_t)lq * 31 * 512;
#pragma unroll
            for (int kt = 0; kt < 31; ++kt) wk[kt] = dww[kt * 512 + C.tid];
            conv_unit(C, cu, (const bf16*)(ws + WS_ARENA + A_U), wk, in_ptr(ws, I_DWB)[lq * 512 + C.tid], in_ptr(ws, I_LNG) + lq * 512, in_ptr(ws, I_LNB) + lq * 512, OCAT); }
    }
}
DI void ph_natten2(const Ctx& C, const bf16* QN, const bf16* KN, const bf16* VTN, bf16* OCAT, const float* rpb  , bool last, unsigned* work_ctr, unsigned char* ws, int lq) {
    const int r = C.lane & 31, h = C.lane >> 5;
    LAS float* tab = (LAS float*)(C.lds + 2 * AttnGeo<64>::BUF);
    LAS int* uslot = (LAS int*)(tab + 1920);
    const int nunits = 1024 + (last ? 0 : 64);
    for (;;) {
        __syncthreads();
        if (C.tid == 0) *uslot = (int)__hip_atomic_fetch_add(work_ctr, 1u, __ATOMIC_RELAXED, __HIP_MEMORY_SCOPE_AGENT);
        __syncthreads();
        const int u = *uslot;
        if (u >= nunits) break;
        const bool isctx = u >= 1024;
        const int bh = isctx ? u - 1024 : (u >> 4), b = bh >> 3, hh = bh & 7;
        for (int i = C.tid; i < 15 * 128; i += 512) { const int dc = (i & 127) - 48; tab[i] = (dc >= 0 && dc < 31) ? rpb[hh * 465 + (i >> 7) * 31 + dc] * LOG2E : 0.f; }
        int qpos, row, grow = 0, qc = 0, rs = 0, cs = 0, rlo = 0, nband = 0;
        if (!isctx) { const int rg = u & 15; grow = 4 * rg + (C.wave >> 1); qc = 32 * (C.wave & 1) + r; qpos = grow * 64 + qc; row = b * TL + qpos;
            rs = grow - 4; rs = rs < 0 ? 0 : (rs > 56 ? 56 : rs); cs = qc - 8; cs = cs < 0 ? 0 : (cs > 48 ? 48 : cs);
            rlo = 4 * rg - 4; rlo = rlo < 0 ? 0 : (rlo > 56 ? 56 : rlo); int rhi = 4 * rg + 3 - 4; rhi = rhi < 0 ? 0 : (rhi > 56 ? 56 : rhi); nband = rhi + 8 - rlo; }
        else { qpos = TL + 32 * C.wave + r; row = NLAT + b * LCX + 32 * C.wave + r; }
        const bf16* qp = QN + ((size_t)bh * KPOS + qpos) * 64 + 8 * h;
        bf16x8 qf[4];
#pragma unroll
        for (int kk = 0; kk < 4; ++kk) qf[kk] = *(const bf16x8*)(qp + 16 * kk);
        f32x16 o[2];
#pragma unroll
        for (int i = 0; i < 16; ++i) { o[0][i] = 0.f; o[1][i] = 0.f; }
        float l = 0.f;
        attn_tile_loop<64, true>(C, o, l, qf, KN + (size_t)bh * KPOS * 64, VTN + (size_t)bh * 64 * KPOS, rlo * 64, nband, TL, LCX / 64, tab, grow, rs, qc, cs);
        flash_store(o, l, OCAT + (size_t)row * DM + 512 + hh * 64, h);
    }
}


DI void ph_mla_fin(const Ctx& C, const bf16* __restrict__ U, const bf16* __restrict__ QPRE, const bf16* __restrict__ KVPRE, const float* __restrict__ qg, const float* __restrict__ kg, const f32x2* __restrict__ CS, bf16* __restrict__ QB, bf16* __restrict__ KB, bf16* __restrict__ VT) {
    LAS bf16* VL = (LAS bf16*)C.lds;
    const int lane = C.lane, j = lane >> 3, sub = lane & 7;
    const float C2 = 0.10206207261596575f * LOG2E;
    float qgn[8], qgr[4], kgn[8], kgr[4];
#pragma unroll
    for (int e = 0; e < 8; ++e) { qgn[e] = qg[8 * sub + e] * C2; kgn[e] = kg[8 * sub + e]; }
#pragma unroll
    for (int m = 0; m < 4; ++m) { qgr[m] = qg[64 + sub + 8 * m] * C2; kgr[m] = kg[64 + sub + 8 * m]; }
    for (int u = C.vcu; u < MT / 64; u += C.nb) {
        const int row0 = 64 * u, b = row0 < NLAT ? (row0 >> 12) : ((row0 - NLAT) >> 8), pos0 = row0 < NLAT ? (row0 & 4095) : TL + ((row0 - NLAT) & 255);
        const bool lat = row0 < NLAT;
        const int pl = 8 * C.wave + j, row = row0 + pl, pos = pos0 + pl;
        const bf16* ur = U + (size_t)row * EV_INP;
        float sq = 0.f, skv = 0.f;
#pragma unroll
        for (int m = 0; m < 6; ++m) { float x[8]; unpack8(*(const u32x4*)(ur + 8 * (sub + 8 * m)), x);
#pragma unroll
            for (int e = 0; e < 8; ++e) sq += x[e] * x[e]; }
#pragma unroll
        for (int m = 0; m < 4; ++m) { float x[8]; unpack8(*(const u32x4*)(ur + 384 + 8 * (sub + 8 * m)), x);
#pragma unroll
            for (int e = 0; e < 8; ++e) skv += x[e] * x[e]; }
        sq = sum8(sq); skv = sum8(skv);
        const float rsq = 1.0f / sqrtf(sq * (1.f / 384.f) + EPS), rskv = 1.0f / sqrtf(skv * (1.f / 256.f) + EPS);
        float krv[4];
#pragma unroll
        for (int m = 0; m < 4; ++m) krv[m] = bf2f(ur[640 + sub + 8 * m]);
        float cr = 1.f, sr = 0.f, cc = 1.f, sc = 0.f;
        if (lat) { const f32x2 a0 = CS[pos * 16 + sub], a1 = CS[pos * 16 + 8 + sub]; cr = a0.x; sr = a0.y; cc = a1.x; sc = a1.y; }
        const bf16* qrow = QPRE + (size_t)row * 768; const bf16* kvrow = KVPRE + (size_t)row * 1024;
#pragma unroll 2
        for (int hh = 0; hh < 8; ++hh) {
            { float qn[8], qr[4]; unpack8(*(const u32x4*)(qrow + hh * 96 + 8 * sub), qn); float ss = 0.f;
#pragma unroll
              for (int e = 0; e < 8; ++e) qn[e] *= rsq;
#pragma unroll
              for (int m = 0; m < 4; ++m) { qr[m] = bf2f(qrow[hh * 96 + 64 + sub + 8 * m]) * rsq; ss += qr[m] * qr[m]; }
#pragma unroll
              for (int e = 0; e < 8; ++e) ss += qn[e] * qn[e];
              const float rn = 1.0f / sqrtf(sum8(ss) * (1.f / 96.f) + EPS);
#pragma unroll
              for (int e = 0; e < 8; ++e) qn[e] *= rn * qgn[e];
#pragma unroll
              for (int m = 0; m < 4; ++m) qr[m] *= rn * qgr[m];
              { const float x0 = qr[0], x1 = qr[1], y0 = qr[2], y1 = qr[3]; qr[0] = x0 * cr - x1 * sr; qr[1] = x1 * cr + x0 * sr; qr[2] = y0 * cc - y1 * sc; qr[3] = y1 * cc + y0 * sc; }
              bf16* qo = QB + ((size_t)(b * 8 + hh) * KPOS + pos) * 96;
              *(u32x4*)(qo + 8 * sub) = pack8(qn);
#pragma unroll
              for (int m = 0; m < 4; ++m) qo[64 + sub + 8 * m] = f2bf(qr[m]); }
            { float kn[8], kr[4]; unpack8(*(const u32x4*)(kvrow + hh * 128 + 8 * sub), kn); float ss = 0.f;
#pragma unroll
              for (int e = 0; e < 8; ++e) kn[e] *= rskv;
#pragma unroll
              for (int m = 0; m < 4; ++m) { kr[m] = krv[m]; ss += kr[m] * kr[m]; }
#pragma unroll
              for (int e = 0; e < 8; ++e) ss += kn[e] * kn[e];
              const float rn = 1.0f / sqrtf(sum8(ss) * (1.f / 96.f) + EPS);
#pragma unroll
              for (int e = 0; e < 8; ++e) kn[e] *= rn * kgn[e];
#pragma unroll
              for (int m = 0; m < 4; ++m) kr[m] *= rn * kgr[m];
              { const float x0 = kr[0], x1 = kr[1], y0 = kr[2], y1 = kr[3]; kr[0] = x0 * cr - x1 * sr; kr[1] = x1 * cr + x0 * sr; kr[2] = y0 * cc - y1 * sc; kr[3] = y1 * cc + y0 * sc; }
              bf16* ko = KB + ((size_t)(b * 8 + hh) * KPOS + pos) * 96;
              *(u32x4*)(ko + 8 * sub) = pack8(kn);
#pragma unroll
              for (int m = 0; m < 4; ++m) ko[64 + sub + 8 * m] = f2bf(kr[m]); }
            { float vv[8]; unpack8(*(const u32x4*)(kvrow + hh * 128 + 64 + 8 * sub), vv);
#pragma unroll
              for (int e = 0; e < 8; ++e) VL[(hh * 64 + 8 * sub + e) * 64 + pl] = f2bf(vv[e] * rskv); }
        }
        __syncthreads();
        { const int hd = C.tid;
            bf16* dst = VT + ((size_t)(b * 8 + (hd >> 6)) * 64 + (hd & 63)) * KPOS + pos0;
#pragma unroll
            for (int q = 0; q < 8; ++q) *(u32x4*)(dst + 8 * q) = *(const LAS u32x4*)(VL + hd * 64 + 8 * q); }
        __syncthreads();
    }
}

DI void conv_unit(const Ctx& C, int u, const bf16* __restrict__ U, const float (&wk)[31], float bias, const float* __restrict__ lng, const float* __restrict__ lnb, bf16* __restrict__ OCAT) {
    LAS float* G = (LAS float*)C.lds;
    const int c = C.tid;
    const int row0 = 32 * u; int base, t0, tseq;
    if (row0 < NLAT) { base = row0 & ~4095; t0 = row0 & 4095; tseq = TL; } else { const int rc = row0 - NLAT; base = NLAT + (rc & ~255); t0 = rc & 255; tseq = LCX; }
    __syncthreads();
    for (int rr = C.wave; rr < 62; rr += 8) { const int tt = t0 - 15 + rr; float g[8];
#pragma unroll
        for (int e = 0; e < 8; ++e) g[e] = 0.f;
        if (tt >= 0 && tt < tseq) { const bf16* ur = U + (size_t)(base + tt) * EV_INP; float av[8], gv[8]; unpack8(*(const u32x4*)(ur + 672 + 8 * C.lane), av); unpack8(*(const u32x4*)(ur + 1184 + 8 * C.lane), gv);
#pragma unroll
            for (int e = 0; e < 8; ++e) g[e] = av[e] * sigmoidf_(gv[e]); }
        *(LAS f32x4*)(G + rr * 512 + 8 * C.lane) = (f32x4){g[0], g[1], g[2], g[3]}; *(LAS f32x4*)(G + rr * 512 + 8 * C.lane + 4) = (f32x4){g[4], g[5], g[6], g[7]}; }
    __syncthreads();
    float acc[32];
#pragma unroll
    for (int t = 0; t < 32; ++t) acc[t] = bias;
#pragma unroll
    for (int rr = 0; rr < 62; ++rr) { const float gv = G[rr * 512 + c];
#pragma unroll
        for (int t = 0; t < 32; ++t) { const int k = rr - t; if (k >= 0 && k < 31) acc[t] += gv * wk[k]; } }
    __syncthreads();
#pragma unroll
    for (int t = 0; t < 32; ++t) G[t * 512 + c] = acc[t];
    __syncthreads();
#pragma unroll
    for (int q = 0; q < 4; ++q) {
        const int t = 4 * C.wave + q, row = row0 + t;
        const f32x4 a0 = *(const LAS f32x4*)(G + t * 512 + 8 * C.lane), a1 = *(const LAS f32x4*)(G + t * 512 + 8 * C.lane + 4);
        float x[8] = {a0.x, a0.y, a0.z, a0.w, a1.x, a1.y, a1.z, a1.w}; float s = 0.f;
#pragma unroll
        for (int e = 0; e < 8; ++e) s += x[e];
        const float mu = wave_sum(s) * (1.f / 512.f); float s2 = 0.f;
#pragma unroll
        for (int e = 0; e < 8; ++e) { x[e] -= mu; s2 += x[e] * x[e]; }
        const float rstd = 1.0f / sqrtf(wave_sum(s2) * (1.f / 512.f) + EPS);
        float y[8];
#pragma unroll
        for (int e = 0; e < 8; ++e) { const float z = x[e] * rstd * lng[8 * C.lane + e] + lnb[8 * C.lane + e]; y[e] = siluf_(z); }
        *(u32x4*)(OCAT + (size_t)row * DM + 512 + 8 * C.lane) = pack8(y);
    }
    __syncthreads();
}
DI void wprep_span(const Ctx& C, int first, int stride, const float* w1, const float* w3, const float* w2, bf16* W13, bf16* W2) {
    LAS float* scr = (LAS float*)(C.lds + C.wave * 16640);
    constexpr int PER = 16 * 16, NIT = NEXP * 3 * PER;
    for (int it = first; it < NIT; it += stride) {
        const int e = it / (3 * PER), r = it % (3 * PER), which = r / PER, q = r % PER, kb = q / 16, n0 = (q % 16) * 64;
#if MOE_F8
        if (which == 0)      transpose_item64_f8(w1 + (size_t)e * DM * DM, DM, DM, (unsigned char*)W13 + (size_t)e * 2048 * DM, (n0 >> 7) * 256 + (n0 & 127), scr, kb * 64, n0, C.lane);
        else if (which == 1) transpose_item64_f8(w3 + (size_t)e * DM * DM, DM, DM, (unsigned char*)W13 + (size_t)e * 2048 * DM, (n0 >> 7) * 256 + (n0 & 127) + 128, scr, kb * 64, n0, C.lane);
        else                 transpose_item64_f8(w2 + (size_t)e * DM * DM, DM, DM, (unsigned char*)W2 + (size_t)e * DM * DM, n0, scr, kb * 64, n0, C.lane); }
#else
        if (which == 0)      transpose_item64(w1 + (size_t)e * DM * DM, DM, DM, W13 + (size_t)e * 2048 * DM, (n0 >> 7) * 256 + (n0 & 127), scr, kb * 64, n0, C.lane);
        else if (which == 1) transpose_item64(w3 + (size_t)e * DM * DM, DM, DM, W13 + (size_t)e * 2048 * DM, (n0 >> 7) * 256 + (n0 & 127) + 128, scr, kb * 64, n0, C.lane);
        else                 transpose_item64(w2 + (size_t)e * DM * DM, DM, DM, W2 + (size_t)e * DM * DM, n0, scr, kb * 64, n0, C.lane); }
#endif
}
constexpr int WPREP_PER_WAVE = (NEXP * 3 * 256 + 2047) / 2048;

DI void shifted8(const bf16* __restrict__ up, const bf16* __restrict__ uc, const bf16* __restrict__ un, bool hp, bool hn, const float (&s0)[8], const float (&s1)[8], const float (&s2)[8], int c0, float (&o)[8]) {
    const u32x4 z = {0u, 0u, 0u, 0u};
    const u32x4 vp = hp ? *(const u32x4*)(up + c0) : z, vc = *(const u32x4*)(uc + c0), vn = hn ? *(const u32x4*)(un + c0) : z;
    float p[8], c[8], n[8]; unpack8(vp, p); unpack8(vc, c); unpack8(vn, n);
#pragma unroll
    for (int e = 0; e < 8; ++e) o[e] = p[e] * s0[e] + c[e] * s1[e] + n[e] * s2[e];
}
DI void load_sw(const float* sw, int c0, float (&s0)[8], float (&s1)[8], float (&s2)[8]) {
#pragma unroll
    for (int e = 0; e < 8; ++e) { s0[e] = sw[c0 + e]; s1[e] = sw[RW_IN + c0 + e]; s2[e] = sw[2 * RW_IN + c0 + e]; }
}
DI void ph_prep(const Ctx& C, const bf16* __restrict__ U, const float* __restrict__ sw  , const float* __restrict__ kkw  , const float* __restrict__ naqg, const float* __restrict__ nakg,
                bf16* __restrict__ R, bf16* __restrict__ V, bf16* __restrict__ K, bf16* __restrict__ KK, bf16* __restrict__ L, bf16* __restrict__ QN, bf16* __restrict__ KN, bf16* __restrict__ VTN) {
    LAS bf16* VL = (LAS bf16*)C.lds;
    const int lane = C.lane, hh = lane >> 3, sub = lane & 7;
    const float C2 = 0.125f * LOG2E;
    for (int u = C.vcu; u < MT / 32; u += C.nb) {
        const int row0 = 32 * u; const bool lat = row0 < NLAT;
        const int b = lat ? (row0 >> 12) : ((row0 - NLAT) >> 8), pos0 = lat ? (row0 & 4095) : TL + ((row0 - NLAT) & 255), tseq = lat ? TL : LCX, tb = lat ? (row0 & 4095) : ((row0 - NLAT) & 255);
#define PREP_ROWVARS(i) const int pl = 4 * C.wave + (i), row = row0 + pl, t = tb + pl; const bool hp = t > 0, hn = t < tseq - 1; \
            const bf16* uc = U + (size_t)row * OD_INP; const bf16* up = uc - OD_INP; const bf16* un = uc + OD_INP
        { float s0[8], s1[8], s2[8]; load_sw(sw, 8 * lane, s0, s1, s2);
          _Pragma("unroll") for (int i = 0; i < 4; ++i) { PREP_ROWVARS(i); float o[8]; shifted8(up, uc, un, hp, hn, s0, s1, s2, 8 * lane, o); *(u32x4*)(R + (size_t)row * 512 + 8 * lane) = pack8(o); } }
        { float s0[8], s1[8], s2[8]; load_sw(sw, 1024 + 8 * lane, s0, s1, s2);
          _Pragma("unroll") for (int i = 0; i < 4; ++i) { PREP_ROWVARS(i); float o[8]; shifted8(up, uc, un, hp, hn, s0, s1, s2, 1024 + 8 * lane, o); *(u32x4*)(V + (size_t)row * 512 + 8 * lane) = pack8(o); } }
        { float s0[8], s1[8], s2[8]; load_sw(sw, 512 + 8 * lane, s0, s1, s2); float kw[8];
#pragma unroll
          for (int e = 0; e < 8; ++e) kw[e] = kkw[8 * lane + e];
          _Pragma("unroll") for (int i = 0; i < 4; ++i) { PREP_ROWVARS(i); float o[8]; shifted8(up, uc, un, hp, hn, s0, s1, s2, 512 + 8 * lane, o); *(u32x4*)(K + (size_t)row * 512 + 8 * lane) = pack8(o);
              float kk[8]; float ss = 0.f;
#pragma unroll
              for (int e = 0; e < 8; ++e) { kk[e] = o[e] * kw[e]; ss += kk[e] * kk[e]; }
              ss = sum8(ss); const float rn = 1.0f / sqrtf(ss + 1e-12f);
#pragma unroll
              for (int e = 0; e < 8; ++e) kk[e] *= rn;
              *(u32x4*)(KK + (size_t)row * 512 + 8 * lane) = pack8(kk); } }
        if (lane < 48) { float s0[8], s1[8], s2[8]; load_sw(sw, 1536 + 8 * lane, s0, s1, s2);
          _Pragma("unroll") for (int i = 0; i < 4; ++i) { PREP_ROWVARS(i); float o[8]; shifted8(up, uc, un, hp, hn, s0, s1, s2, 1536 + 8 * lane, o);
              if (lane < 16) {
#pragma unroll
                  for (int e = 0; e < 8; ++e) { const float ex = __expf(2.f * o[e]); o[e] = 1.f - 2.f * __builtin_amdgcn_rcpf(ex + 1.f); }
              } else if (lane >= 32) {
#pragma unroll
                  for (int e = 0; e < 8; ++e) o[e] = sigmoidf_(o[e]);
              }
              *(u32x4*)(L + (size_t)row * 384 + 8 * lane) = pack8(o); } }
        { float gq[8], gk[8];
#pragma unroll
          for (int e = 0; e < 8; ++e) { gq[e] = naqg[8 * sub + e] * C2; gk[e] = nakg[8 * sub + e]; }
          _Pragma("unroll") for (int i = 0; i < 4; ++i) { const int pl = 4 * C.wave + i, row = row0 + pl, pos = pos0 + pl; const bf16* uc = U + (size_t)row * OD_INP;
            { float x[8]; unpack8(*(const u32x4*)(uc + RW_IN + 8 * lane), x); float ss = 0.f;
#pragma unroll
                for (int e = 0; e < 8; ++e) ss += x[e] * x[e];
                ss = sum8(ss); const float rn = 1.0f / sqrtf(ss * (1.f / 64.f) + EPS);
#pragma unroll
                for (int e = 0; e < 8; ++e) x[e] = x[e] * rn * gq[e];
                *(u32x4*)(QN + ((size_t)(b * 8 + hh) * KPOS + pos) * 64 + 8 * sub) = pack8(x); }
            { float x[8]; unpack8(*(const u32x4*)(uc + RW_IN + 512 + 8 * lane), x); float ss = 0.f;
#pragma unroll
                for (int e = 0; e < 8; ++e) ss += x[e] * x[e];
                ss = sum8(ss); const float rn = 1.0f / sqrtf(ss * (1.f / 64.f) + EPS);
#pragma unroll
                for (int e = 0; e < 8; ++e) x[e] = x[e] * rn * gk[e];
                *(u32x4*)(KN + ((size_t)(b * 8 + hh) * KPOS + pos) * 64 + 8 * sub) = pack8(x); }
            { const u32x4 vv = *(const u32x4*)(uc + RW_IN + 1024 + 8 * lane); const unsigned w4[4] = {vv.x, vv.y, vv.z, vv.w};
#pragma unroll
                for (int e = 0; e < 8; ++e) { const int dv = 8 * sub + e; VL[(hh * 64 + dv) * 32 + pl] = (bf16)((e & 1) ? (w4[e >> 1] >> 16) : (w4[e >> 1] & 0xffffu)); } } } }
#undef PREP_ROWVARS
        __syncthreads();
        { const int hd = C.tid; bf16* dst = VTN + ((size_t)(b * 8 + (hd >> 6)) * 64 + (hd & 63)) * KPOS + pos0;
#pragma unroll
            for (int q = 0; q < 4; ++q) *(u32x4*)(dst + 8 * q) = *(const LAS u32x4*)(VL + hd * 32 + 8 * q); }
        __syncthreads();
    }
}

DI int scan_row(int s, int d, int b) { if (s < LCX) return NLAT + b * LCX + (d ? (LCX - 1 - s) : s); const int t = s - LCX; return b * TL + (d ? (TL - 1 - t) : t); }


constexpr int CCH = 16, NCHK = KPOS / CCH, NPROB = NB * 8 * 2 * NCHK, IMG_ELEMS = 3 * 32 * 16;
template <int N> struct ICk { static constexpr int value = N; };
DI int crow_(int reg, int h) { return (reg & 3) + 8 * (reg >> 2) + 4 * h; }
DI bf16x8 pack_lo8(const f32x16& x) {
    u32x4 p; p.x = pk2(x[0], x[1]); p.y = pk2(x[2], x[3]); p.z = pk2(x[4], x[5]); p.w = pk2(x[6], x[7]); return __builtin_bit_cast(bf16x8, p); }
DI bf16x8 pack_hi8(const f32x16& x) { u32x4 p; p.x = pk2(x[8], x[9]); p.y = pk2(x[10], x[11]); p.z = pk2(x[12], x[13]); p.w = pk2(x[14], x[15]); return __builtin_bit_cast(bf16x8, p); }
DI int perm16(int k) { return (k & ~15) | swap23(k & 15); }

DI void ph_wkv_pre(const Ctx& C, const bf16* __restrict__ R, const bf16* __restrict__ K, const bf16* __restrict__ KK, const unsigned short* __restrict__ LW, const bf16* __restrict__ AR_, const float* __restrict__ ka, bf16* __restrict__ IMG) {
    LAS unsigned char* wl = C.lds + C.wave * 13312;
    LAS bf16* ARl = (LAS bf16*)wl; LAS bf16* BKl = (LAS bf16*)(wl + 4608); LAS float* Ll = (LAS float*)(wl + 9216); LAS bf16* OUT = (LAS bf16*)(wl + 10240);
    const int lane = C.lane, r = lane & 31, h = lane >> 5;
    const int gw = C.vcu * 8 + C.wave, ngw = C.nb * 8;
    for (int p = gw; p < NPROB; p += ngw) {
        const int j = p % NCHK, rest = p / NCHK, d = rest & 1, hh = (rest >> 1) & 7, b = rest >> 4;
        const unsigned short* Wd = LW + (size_t)d * MT * 512; const bf16* Ad = AR_ + (size_t)d * MT * 512;
        const float kav = ka[hh * 64 + lane];
        const int row0 = scan_row(j * CCH, d, b), sg = d ? -1 : 1;
        float lw[16]; bf16 rr[16], kx[16], kkx[16], ax[16];
#pragma unroll
        for (int t = 0; t < 16; ++t) { const size_t off = (size_t)(row0 + sg * t) * 512 + hh * 64 + lane; lw[t] = h2f(Wd[off]); rr[t] = R[off]; kx[t] = K[off]; kkx[t] = KK[off]; ax[t] = Ad[off]; }
        float cum = 0.f, e0 = 1.f;
#pragma unroll
        for (int t = 0; t < 16; ++t) {
            cum += lw[t]; const float e1 = __expf(cum), ei = __builtin_amdgcn_rcpf(e1);
            const float kkv = bf2f(kkx[t]), av = bf2f(ax[t]), keff = bf2f(kx[t]) * (1.f + (av - 1.f) * kav);
            ARl[t * 72 + lane] = f2bf(-kkv * e0); ARl[(16 + t) * 72 + lane] = f2bf(bf2f(rr[t]) * e1);
            BKl[t * 72 + lane] = f2bf(kkv * av * ei); BKl[(16 + t) * 72 + lane] = f2bf(keff * ei);
            e0 = e1;
        }
        asm volatile("s_waitcnt lgkmcnt(0)" ::: "memory");
        f32x16 g;
#pragma unroll
        for (int i = 0; i < 16; ++i) g[i] = 0.f;
#pragma unroll
        for (int q = 0; q < 4; ++q) g = MFMA32(*(const LAS bf16x8*)(ARl + r * 72 + 16 * q + 8 * h), *(const LAS bf16x8*)(BKl + r * 72 + 16 * q + 8 * h), g);
        const int sI = r & 15; const bool isk = r >= 16;
#pragma unroll
        for (int i = 0; i < 16; ++i) {
            const int row = crow_(i, h), t = row & 15; const bool keep = (i < 8) ? (sI < t) : (sI <= t); const float val = keep ? g[i] : 0.f;
            if (i < 8) { if (!isk) { Ll[t * 16 + sI] = val; OUT[512 + row * 16 + perm16(sI)] = 0; } else OUT[row * 16 + sI] = f2bf(val); }
            else       { if (!isk) OUT[512 + row * 16 + perm16(sI)] = f2bf(val); else OUT[row * 16 + sI] = f2bf(val); }
        }
        asm volatile("s_waitcnt lgkmcnt(0)" ::: "memory");
        { const int c = lane & 15; float Pr[16];
            Pr[0] = (c == 0) ? 1.f : 0.f;
#pragma unroll
            for (int t = 1; t < 16; ++t) { const float lrow = Ll[t * 16 + c]; float acc = (c == t) ? 1.f : 0.f;
#pragma unroll
                for (int u = 0; u < t; ++u) acc += rdlane(lrow, u) * Pr[u];
                Pr[t] = acc; }
            if (lane < 16) {
#pragma unroll
                for (int t = 0; t < 16; ++t) { OUT[1024 + t * 16 + perm16(c)] = f2bf(Pr[t]); OUT[1024 + (16 + t) * 16 + c] = 0; } } }
        asm volatile("s_waitcnt lgkmcnt(0)" ::: "memory");
        { bf16* dst = IMG + (size_t)p * IMG_ELEMS;
#pragma unroll
            for (int q = 0; q < 3; ++q) *(u32x4*)(dst + (q * 64 + lane) * 8) = *(const LAS u32x4*)(OUT + (q * 64 + lane) * 8); }
        asm volatile("s_waitcnt lgkmcnt(0)" ::: "memory");
    }
}

DI void ph_wkv_chunk(const Ctx& C, const bf16* R, const bf16* V, const bf16* K, const bf16* KK, const unsigned short* LW, const bf16* AR_, const float* ka, const bf16* IMG, bf16* YS) {
    constexpr int S_AR = 0, S_BKT = 4608, S_VT = 9728, S_VT2 = 11264, S_GC = 12800, S_MM = 13056, S_MRB = 14592, S_PP = 16128, SLOT = 17664, CUMO = 2 * SLOT, YSTO = CUMO + 8192, DEPTH = 4;
    const int lane = C.lane, wv = C.wave, r = lane & 31, h = lane >> 5;
    const bool isE = wv == 2 || wv == 3 || wv == 6 || wv == 7, isS = wv < 2;
    const int te = (wv == 2 ? 0 : (wv == 3 ? 1 : (wv == 6 ? 2 : 3))) * 64 + lane, et = te >> 4, ekq = te & 15;
    const int vhf = te >> 7, vt = (te >> 3) & 15, viq = te & 7;
    const int hf = wv & 1;
    for (int cid0 = C.bid; cid0 < 128; cid0 += C.nb) {
        const int chain = cid0, b = chain >> 4, hh = (chain >> 1) & 7, d = chain & 1;
        const unsigned short* Wd = LW + (size_t)d * MT * 512; const bf16* Ad = AR_ + (size_t)d * MT * 512; bf16* Yd = YS + (size_t)d * MT * 512;
        const bf16* img = IMG + (size_t)(((b * 8 + hh) * 2 + d) * NCHK) * IMG_ELEMS;
        f32x16 ST[2];
#pragma unroll
        for (int i = 0; i < 16; ++i) { ST[0][i] = 0.f; ST[1][i] = 0.f; }
        const f32x4 kav = *(const f32x4*)(ka + hh * 64 + 4 * ekq);
        unsigned ring[DEPTH][16];
        __syncthreads();
        auto issue = [&](int ch, unsigned (&rg)[16]) __attribute__((always_inline)) {
            if (ch < 0 || ch >= NCHK) return;
            const int row0 = scan_row(ch * CCH, d, b), sg = d ? -1 : 1;
            if (isE) {
                const size_t off = (size_t)(row0 + sg * et) * 512 + hh * 64 + 4 * ekq;
                const u32x2 x0 = *(const u32x2*)(R + off), x1 = *(const u32x2*)(K + off), x2 = *(const u32x2*)(KK + off), x3 = *(const u32x2*)(Ad + off);
                const u32x2 x4 = *(const u32x2*)(V + (size_t)(row0 + sg * vt) * 512 + hh * 64 + 32 * vhf + 4 * viq);
                rg[0] = x0.x; rg[1] = x0.y; rg[2] = x1.x; rg[3] = x1.y; rg[4] = x2.x; rg[5] = x2.y; rg[6] = x3.x; rg[7] = x3.y; rg[8] = x4.x; rg[9] = x4.y;
                asm volatile("; wkv issue role E" ::);
            } else if (wv == 4) {
#define W5_(t) rg[(t)] = (unsigned)Wd[(size_t)(row0 + sg * (t)) * 512 + hh * 64 + lane]
                W5_(0); W5_(1); W5_(2); W5_(3); W5_(4); W5_(5); W5_(6); W5_(7); W5_(8); W5_(9); W5_(10); W5_(11); W5_(12); W5_(13); W5_(14); W5_(15);
#undef W5_
                asm volatile("; wkv issue role C" ::);
            } else if (wv == 5) {
#define W6_(q) do { const u32x4 x = *(const u32x4*)(img + (size_t)ch * IMG_ELEMS + ((q) * 64 + lane) * 8); rg[4 * (q)] = x.x; rg[4 * (q) + 1] = x.y; rg[4 * (q) + 2] = x.z; rg[4 * (q) + 3] = x.w; } while (0)
                W6_(0); W6_(1); W6_(2);
#undef W6_
                asm volatile("; wkv issue role V" ::);
            }
        };
        issue(0, ring[0]); issue(1, ring[1]); issue(2, ring[2]); issue(3, ring[3]);
#define WKV_BAR() asm volatile("s_waitcnt lgkmcnt(0)\n\ts_barrier" ::: "memory")
#define WKV_LOOP(...) for (int n0 = -2; n0 < NCHK; n0 += DEPTH) { auto iter = [&](auto kc) __attribute__((always_inline)) { constexpr int kk = decltype(kc)::value; \
            constexpr int riE = (kk + 3) % DEPTH, riW = kk % DEPTH; (void)riE; (void)riW; const int n = n0 + kk; (void)n; __VA_ARGS__; WKV_BAR(); }; iter(ICk<0>{}); iter(ICk<1>{}); iter(ICk<2>{}); iter(ICk<3>{}); }
        if (isS) {
            WKV_LOOP({
                if (n >= 0 && n < NCHK) {
                    const LAS unsigned char* B = C.lds + (n & 1) * SLOT;
                    f32x16 T1;
                    _Pragma("unroll") for (int i = 0; i < 16; ++i) T1[i] = 0.f;
                    _Pragma("unroll") for (int tau = 0; tau < 2; ++tau) {
                        T1 = MFMA32(*(const LAS bf16x8*)(B + S_AR + r * 144 + (32 * tau + 8 * h) * 2), pack_lo8(ST[tau]), T1);
                        T1 = MFMA32(*(const LAS bf16x8*)(B + S_AR + r * 144 + (32 * tau + 16 + 8 * h) * 2), pack_hi8(ST[tau]), T1);
                    }
                    const bf16x8 vtf = *(const LAS bf16x8*)(B + (hf ? S_VT2 : S_VT) + r * 48 + 16 * h);
                    T1 = MFMA32(*(const LAS bf16x8*)(B + S_MM + r * 48 + 16 * h), vtf, T1);
                    f32x16 ET;
                    _Pragma("unroll") for (int i = 0; i < 16; ++i) ET[i] = 0.f;
                    ET = MFMA32(*(const LAS bf16x8*)(B + S_PP + r * 48 + 16 * h), pack_lo8(T1), ET);
                    const bf16x8 ef = pack_lo8(ET);
                    T1 = MFMA32(*(const LAS bf16x8*)(B + S_MRB + r * 48 + 16 * h), ef, T1);
                    _Pragma("unroll") for (int tau = 0; tau < 2; ++tau) {
                        ST[tau] = MFMA32(*(const LAS bf16x8*)(B + S_BKT + (32 * tau + r) * 80 + 16 * h), ef, ST[tau]);
                        ST[tau] = MFMA32(*(const LAS bf16x8*)(B + S_BKT + (32 * tau + r) * 80 + 32 + 16 * h), vtf, ST[tau]);
                        _Pragma("unroll") for (int g4 = 0; g4 < 4; ++g4) { const f32x4 gc = *(const LAS f32x4*)(B + S_GC + (32 * tau + 8 * g4 + 4 * h) * 4);
                            ST[tau][4 * g4] *= gc.x; ST[tau][4 * g4 + 1] *= gc.y; ST[tau][4 * g4 + 2] *= gc.z; ST[tau][4 * g4 + 3] *= gc.w; }
                    }
                    LAS float* ys = (LAS float*)(C.lds + YSTO) + ((n & 1) * 2 + hf) * 512;
                    _Pragma("unroll") for (int q = 0; q < 8; ++q) ys[(8 * (q >> 2) + 4 * h + (q & 3)) * 32 + r] = T1[8 + q];
                }
            });
        } else if (isE) {
            WKV_LOOP({
                const int ch = n + 1;
                if (ch >= 0) {
                    if (ch < NCHK) {
                        LAS unsigned char* B = C.lds + (ch & 1) * SLOT; const LAS float* ec = (const LAS float*)(C.lds + CUMO) + (ch & 1) * 1024;
                        const f32x4 e1 = *(const LAS f32x4*)(ec + et * 64 + 4 * ekq);
                        f32x4 e0 = {1.f, 1.f, 1.f, 1.f}; if (et > 0) e0 = *(const LAS f32x4*)(ec + (et - 1) * 64 + 4 * ekq);
                        const float rv[4] = {bflo(ring[riE][0]), bfhi(ring[riE][0]), bflo(ring[riE][1]), bfhi(ring[riE][1])}; const float kv[4] = {bflo(ring[riE][2]), bfhi(ring[riE][2]), bflo(ring[riE][3]), bfhi(ring[riE][3])};
                        const float kkv[4] = {bflo(ring[riE][4]), bfhi(ring[riE][4]), bflo(ring[riE][5]), bfhi(ring[riE][5])}; const float av[4] = {bflo(ring[riE][6]), bfhi(ring[riE][6]), bflo(ring[riE][7]), bfhi(ring[riE][7])};
                        float ah[4]; float rh[4]; float bc[4]; float kc4[4];
                        _Pragma("unroll") for (int e = 0; e < 4; ++e) { const float ei = __builtin_amdgcn_rcpf(e1[e]);
                            ah[e] = -kkv[e] * e0[e]; rh[e] = rv[e] * e1[e]; bc[e] = kkv[e] * av[e] * ei; kc4[e] = kv[e] * (1.f + (av[e] - 1.f) * kav[e]) * ei; }
                        const int pk = perm16(4 * ekq);
                        *(LAS u32x2*)((LAS bf16*)(B + S_AR) + et * 72 + pk) = (u32x2){pk2(ah[0], ah[1]), pk2(ah[2], ah[3])};
                        *(LAS u32x2*)((LAS bf16*)(B + S_AR) + (16 + et) * 72 + pk) = (u32x2){pk2(rh[0], rh[1]), pk2(rh[2], rh[3])};
                        const int pt = perm16(et);
                        _Pragma("unroll") for (int e = 0; e < 4; ++e) { ((LAS bf16*)(B + S_BKT))[(4 * ekq + e) * 40 + pt] = f2bf(bc[e]); ((LAS bf16*)(B + S_BKT))[(4 * ekq + e) * 40 + 16 + et] = f2bf(kc4[e]); }
                        if (et == 15) *(LAS f32x4*)((LAS float*)(B + S_GC) + 4 * ekq) = e1;
                        LAS bf16* vtp = (LAS bf16*)(B + (vhf ? S_VT2 : S_VT)) + (4 * viq) * 24 + vt;
                        vtp[0] = (bf16)(ring[riE][8] & 0xffffu); vtp[24] = (bf16)(ring[riE][8] >> 16); vtp[48] = (bf16)(ring[riE][9] & 0xffffu); vtp[72] = (bf16)(ring[riE][9] >> 16);
                    }
                    issue(ch + DEPTH, ring[riE]);
                }
            });
        } else if (wv == 4) {
            WKV_LOOP({
                const int ch = n + 2;
                if (ch < NCHK) { LAS float* ec = (LAS float*)(C.lds + CUMO) + (ch & 1) * 1024; float c = 0.f;
#define C5_(t) do { c += h2f((unsigned short)ring[riW][(t)]); ec[(t) * 64 + lane] = __expf(c); } while (0)
                    C5_(0); C5_(1); C5_(2); C5_(3); C5_(4); C5_(5); C5_(6); C5_(7); C5_(8); C5_(9); C5_(10); C5_(11); C5_(12); C5_(13); C5_(14); C5_(15);
                }
                issue(ch + DEPTH, ring[riW]);
            });
        } else {
            WKV_LOOP({
                { const int chy = n - 1;
                  if (chy >= 0 && chy < NCHK) { const int yh = lane >> 5, yt = (lane & 31) >> 1, yi = 16 * (lane & 1);
                    const LAS float* ys = (const LAS float*)(C.lds + YSTO) + ((chy & 1) * 2 + yh) * 512 + yt * 32 + yi;
                    bf16* dst = Yd + (size_t)(scan_row(chy * CCH, d, b) + (d ? -1 : 1) * yt) * 512 + hh * 64 + 32 * yh + yi;
                    _Pragma("unroll") for (int q = 0; q < 2; ++q) { const f32x4 a0 = *(const LAS f32x4*)(ys + 8 * q); const f32x4 a1 = *(const LAS f32x4*)(ys + 8 * q + 4);
                        *(u32x4*)(dst + 8 * q) = (u32x4){pk2(a0.x, a0.y), pk2(a0.z, a0.w), pk2(a1.x, a1.y), pk2(a1.z, a1.w)}; } } }
                const int ch = n + 1;
                if (ch >= 0) {
                    if (ch < NCHK) { LAS unsigned char* B = C.lds + (ch & 1) * SLOT;
                        const int irow = lane >> 1; const int ihv = lane & 1;
                        *(LAS u32x4*)(B + S_MM + irow * 48 + ihv * 16) = (u32x4){ring[riE][0], ring[riE][1], ring[riE][2], ring[riE][3]};
                        *(LAS u32x4*)(B + S_MRB + irow * 48 + ihv * 16) = (u32x4){ring[riE][4], ring[riE][5], ring[riE][6], ring[riE][7]};
                        *(LAS u32x4*)(B + S_PP + irow * 48 + ihv * 16) = (u32x4){ring[riE][8], ring[riE][9], ring[riE][10], ring[riE][11]};
                    }
                    issue(ch + DEPTH, ring[riE]);
                }
            });
        }
#undef C5_
#undef WKV_LOOP
#undef WKV_BAR
    }
}

DI void ph_post(const Ctx& C, const bf16* __restrict__ YS, const bf16* __restrict__ R, const bf16* __restrict__ V, const bf16* __restrict__ K, const bf16* __restrict__ A2, const float* __restrict__ ka, const bf16* __restrict__ G, const float* __restrict__ rk, const float* __restrict__ gng, const float* __restrict__ gnb, bf16* __restrict__ OCAT, bool last) {
    const int gw = C.bid * 8 + C.wave, ngw = C.nb * 8, lane = C.lane, nrows = last ? NLAT : MT;
#pragma unroll 2
    for (int row = gw; row < nrows; row += ngw) {
        const size_t o = (size_t)row * 512 + 8 * lane;
        float y[8], y1[8]; unpack8(*(const u32x4*)(YS + o), y); unpack8(*(const u32x4*)(YS + (size_t)MT * 512 + o), y1);
#pragma unroll
        for (int e = 0; e < 8; ++e) y[e] += y1[e];
        float r[8], v[8], kx[8], a0[8], a1[8], g[8];
        unpack8(*(const u32x4*)(R + o), r); unpack8(*(const u32x4*)(V + o), v); unpack8(*(const u32x4*)(K + o), kx); unpack8(*(const u32x4*)(A2 + o), a0); unpack8(*(const u32x4*)(A2 + (size_t)MT * 512 + o), a1); unpack8(*(const u32x4*)(G + o), g);
        float bsum = 0.f;
#pragma unroll
        for (int e = 0; e < 8; ++e) { const float kae = ka[8 * lane + e]; bsum += r[e] * (kx[e] * (1.f + (a0[e] - 1.f) * kae) + kx[e] * (1.f + (a1[e] - 1.f) * kae)) * rk[8 * lane + e]; }
        bsum = sum8(bsum);
        float s = 0.f;
#pragma unroll
        for (int e = 0; e < 8; ++e) { y[e] += bsum * v[e]; s += y[e]; }
        const float mu = sum8(s) * (1.f / 64.f); float s2 = 0.f;
#pragma unroll
        for (int e = 0; e < 8; ++e) { y[e] -= mu; s2 += y[e] * y[e]; }
        const float rstd = 1.0f / sqrtf(sum8(s2) * (1.f / 64.f) + GN_EPS);
        float out[8];
#pragma unroll
        for (int e = 0; e < 8; ++e) out[e] = (y[e] * rstd * gng[8 * lane + e] + gnb[8 * lane + e]) * g[e];
        *(u32x4*)(OCAT + (size_t)row * DM + 8 * lane) = pack8(out);
    }
}

DI void ph_topk2(const Ctx& C, const float* AFFT, const float* AFFC, int* ROWS, float* GATE, int* SLOT, bool last) {
    LAS unsigned* wcnt = (LAS unsigned*)C.lds;
    LAS unsigned* cnt = wcnt + 16;
    const int tid = C.tid, nprob = last ? 128 : 256;
    for (int p = C.bid; p < nprob; p += C.nb) {
        const bool isctx = p >= 128; const int be = p & 127, b = be >> 4, e = be & 15;
        const int n = isctx ? LCX : TL, cap = isctx ? CAPC : CAPL;
        const float* src = isctx ? AFFC + (size_t)be * LCX : AFFT + (size_t)be * TL;
        unsigned v[8]; const int per = isctx ? 1 : 8, t0 = tid * per;
#pragma unroll
        for (int q = 0; q < 8; ++q) v[q] = 0u;
        if (!isctx) { const u32x4 a0 = *(const u32x4*)(src + t0), a1 = *(const u32x4*)(src + t0 + 4); v[0] = a0.x; v[1] = a0.y; v[2] = a0.z; v[3] = a0.w; v[4] = a1.x; v[5] = a1.y; v[6] = a1.z; v[7] = a1.w; }
        else if (tid < LCX) v[0] = __builtin_bit_cast(unsigned, src[tid]);
        __syncthreads();
        unsigned T = 0u;
        for (int bit = 30; bit >= 0; --bit) {
            const unsigned cand = T | (1u << bit); unsigned c = 0u;
#pragma unroll
            for (int q = 0; q < 8; ++q) c += (unsigned)__builtin_popcountll(__builtin_amdgcn_ballot_w64(v[q] >= cand));
            LAS unsigned* wc = wcnt + (bit & 1) * 8;
            if (C.lane == 0) wc[C.wave] = c;
            __syncthreads();
            const unsigned tot = wc[0] + wc[1] + wc[2] + wc[3] + wc[4] + wc[5] + wc[6] + wc[7];
            if (tot >= (unsigned)cap) T = cand;
        }
        unsigned myc = 0u;
#pragma unroll
        for (int q = 0; q < 8; ++q) myc += (v[q] > T ? 0x10000u : 0u) + ((v[q] == T && (isctx ? (q == 0 && tid < LCX) : true)) ? 1u : 0u);
        __syncthreads();
        cnt[tid] = myc;
        __syncthreads();
        for (int off = 1; off < 512; off <<= 1) { const unsigned add = tid >= off ? cnt[tid - off] : 0u; __syncthreads(); cnt[tid] += add; __syncthreads(); }
        const unsigned total = cnt[511], keq = (unsigned)cap - (total >> 16);
        unsigned before = cnt[tid] - myc;
        for (int q = 0; q < per; ++q) { const int t = t0 + q; if (t >= n) break; const unsigned x = v[q]; const unsigned gtb = before >> 16, eqb = before & 0xFFFFu;
            const bool sel = x > T || (x == T && eqb < keq);
            if (sel) { const int jx = (int)(gtb + (eqb < keq ? eqb : keq));
                const int slot = isctx ? NB * CAPL + b * CAPC + jx : b * CAPL + jx, row = isctx ? NLAT + b * LCX + t : b * TL + t;
                ROWS[e * ESLOTS + slot] = row; GATE[e * ESLOTS + slot] = __builtin_bit_cast(float, x); SLOT[(size_t)row * 16 + e] = slot; }
            before += (x > T ? 0x10000u : 0u) + (x == T ? 1u : 0u); }
        __syncthreads();
    }
}


DI void ph_combine(const Ctx& C, float* __restrict__ xlat, float* __restrict__ xctx, const float* __restrict__ modg2  , const int* __restrict__ SLOT, const bf16* __restrict__ Y2, bool last,
                   const float* __restrict__ ngain  , const float* __restrict__ nmod  , bf16* __restrict__ H) {
    const int gw = C.bid * 8 + C.wave, ngw = C.nb * 8, lane = C.lane, nrows = last ? NLAT : MT;
    int sv_next = (gw < nrows) ? SLOT[(size_t)gw * 16 + (lane & 15)] : -1;
    for (int row = gw; row < nrows; row += ngw) {
        float* xr = row < NLAT ? xlat + (size_t)row * DM : xctx + (size_t)(row - NLAT) * DM;
        const int mi = row < NLAT ? (row >> 12) : 8;
        const int sv = sv_next;
        if (row + ngw < nrows) sv_next = SLOT[(size_t)(row + ngw) * 16 + (lane & 15)];
        f32x4 xv[4], gv[4];
#pragma unroll
        for (int j = 0; j < 4; ++j) { const int c = 256 * j + 4 * lane; gv[j] = *(const f32x4*)(modg2 + mi * 6144 + c); xv[j] = *(const f32x4*)(xr + c); }
        f32x4 acc[4];
#pragma unroll
        for (int j = 0; j < 4; ++j) acc[j] = (f32x4){0.f, 0.f, 0.f, 0.f};
        unsigned mask = (unsigned)__builtin_amdgcn_ballot_w64(sv >= 0) & 0xffffu;
        while (mask) {
            const bf16* yp[4]; float m[4];
            { const int e0 = __builtin_ctz(mask); mask &= mask - 1u; const int s0 = __builtin_amdgcn_readlane(sv, e0); yp[0] = Y2 + ((size_t)e0 * ESLOTS + s0) * DM + 4 * lane; m[0] = 1.f; }
#pragma unroll
            for (int k = 1; k < 4; ++k) {
                if (mask) { const int ek = __builtin_ctz(mask); mask &= mask - 1u; const int sk = __builtin_amdgcn_readlane(sv, ek); yp[k] = Y2 + ((size_t)ek * ESLOTS + sk) * DM + 4 * lane; m[k] = 1.f; }
                else { yp[k] = yp[0]; m[k] = 0.f; } }
            u32x2 w[4][4];
#pragma unroll
            for (int k = 0; k < 4; ++k)
#pragma unroll
                for (int j = 0; j < 4; ++j) w[k][j] = *(const u32x2*)(yp[k] + 256 * j);
#pragma unroll
            for (int k = 0; k < 4; ++k)
#pragma unroll
                for (int j = 0; j < 4; ++j) acc[j] += m[k] * (f32x4){bflo(w[k][j].x), bfhi(w[k][j].x), bflo(w[k][j].y), bfhi(w[k][j].y)};
        }
#pragma unroll
        for (int j = 0; j < 4; ++j) { const int c = 256 * j + 4 * lane; f32x4 x = xv[j]; x += gv[j] * acc[j]; *(f32x4*)(xr + c) = x; acc[j] = x; }
        if (ngain) {
            float ss = 0.f;
#pragma unroll
            for (int j = 0; j < 4; ++j) ss += acc[j].x * acc[j].x + acc[j].y * acc[j].y + acc[j].z * acc[j].z + acc[j].w * acc[j].w;
            const float rs = 1.0f / sqrtf(wave_sum(ss) * (1.f / 1024.f) + EPS);
            const float* mp = nmod + mi * 6144;
#pragma unroll
            for (int j = 0; j < 4; ++j) { const int c = 256 * j + 4 * lane;
                const f32x4 g = *(const f32x4*)(ngain + c), sc = *(const f32x4*)(mp + 1024 + c), sh = *(const f32x4*)(mp + c);
                const f32x4 hv = (acc[j] * rs) * g * (sc + 1.0f) + sh;
                *(u32x2*)(H + (size_t)row * DM + c) = (u32x2){pk2(hv.x, hv.y), pk2(hv.z, hv.w)}; }
        }
    }
}

template <int N> struct IC { static constexpr int value = N; };
DI const float* in_ptr(const unsigned char* ws, int k) { const unsigned long long v = ((const unsigned long long*)(ws + 128 * 1024))[k];
    const unsigned lo = __builtin_amdgcn_readfirstlane((unsigned)v), hi = __builtin_amdgcn_readfirstlane((unsigned)(v >> 32));
    return (const float*)(__attribute__((address_space(1))) const float*)(((unsigned long long)hi << 32) | lo); }
template <class T> DI T* launder_ptr(T* p) { unsigned long long v = (unsigned long long)p; unsigned lo = (unsigned)v, hi = (unsigned)(v >> 32); asm volatile("" : "+v"(lo), "+v"(hi));
    lo = __builtin_amdgcn_readfirstlane(lo); hi = __builtin_amdgcn_readfirstlane(hi); return (T*)(__attribute__((address_space(1))) T*)(((unsigned long long)hi << 32) | lo); }
constexpr int N_PHASES = 1 + 23 + 22;
constexpr size_t WS_PTRS = 128 * 1024;
#define P_XC    ((float*)(ws + WS_XC))
#define P_MOD   ((const float*)(ws + WS_MOD))
#define P_HB    ((bf16*)(ws + WS_HB))
#define P_OCAT  ((bf16*)(ws + WS_OCAT))
#define P_AR    (ws + WS_ARENA)
#define P_ROWS  ((int*)(ws + WS_ROWS))
#define P_GATE  ((float*)(ws + WS_GATE))
#define P_SLOT  ((int*)(ws + WS_SLOT))
#define P_AFFT  ((float*)(ws + WS_AFFT))
#define P_AFFC  ((float*)(ws + WS_AFFC))
#define P_W13   ((bf16*)(ws + WS_W13))
#define P_W2    ((bf16*)(ws + WS_W2))
#define P_U     ((bf16*)(P_AR + A_U))
#define P_QPRE  ((float*)(P_AR + A_QPRE))
#define P_KVPRE ((float*)(P_AR + A_KVPRE))
#define P_QB    ((bf16*)(P_AR + A_QB))
#define P_KB    ((bf16*)(P_AR + A_KB))
#define P_VT    ((bf16*)(P_AR + A_VT))
#define P_W     ((unsigned short*)(P_AR + A_W))
#define P_KEFF  ((bf16*)(P_AR + A_KEFF))
#define P_R     ((bf16*)(P_AR + A_R))
#define P_V     ((bf16*)(P_AR + A_V))
#define P_KK    ((bf16*)(P_AR + A_KK))
#define P_G     ((bf16*)(P_AR + A_G))
#define P_K     ((bf16*)(P_AR + A_K))
#define P_L     ((bf16*)(P_AR + A_L))
#define P_QN    ((bf16*)(P_AR + A_QN))
#define P_KN    ((bf16*)(P_AR + A_KN))
#define P_VTN   ((bf16*)(P_AR + A_VTN))
#define P_YS    ((bf16*)(P_AR + A_YS))
#define P_IMG   ((bf16*)(P_AR + A_IMG))
#define P_HID   ((bf16*)(P_AR + A_HID))
#define P_Y2    ((bf16*)(P_AR + A_Y2))
#define MODL(i) (P_MOD + (size_t)(i) * 9 * 6144)
#if MOE_F8
#define MOE1_PHASE(NMT) do { pg8::Gemm g{P_HB, P_W13, DM / 2, DM / 2, P_ROWS, SCALE_W, SCALE_ONE}; pg8::OrderMoE S{(NMT), 8, 17, C.nb, C.vcu}; pg8::EpiAdapt<EpiGlu8> E{EpiGlu8{(unsigned char*)P_HID}}; \
        pg8::gemm_phase<pg8::EpiAdapt<EpiGlu8>, pg8::OrderMoE, true>(C.lds, g, S, E, C.tid); } while (0)
#define MOE2_PHASE(NMT) do { pg8::Gemm g{P_HID, P_W2, DM / 2, DM / 2, nullptr, SCALE_W, SCALE_HID}; pg8::OrderMoE S{(NMT), 4, 17, C.nb, C.vcu}; pg8::EpiAdapt<EpiGate> E{EpiGate{P_Y2, P_GATE}}; \
        pg8::gemm_phase<pg8::EpiAdapt<EpiGate>, pg8::OrderMoE, true>(C.lds, g, S, E, C.tid); } while (0)
#else
#define MOE1_PHASE(NMT) do { pg8::Gemm g{P_HB, P_W13, DM, DM, P_ROWS}; pg8::OrderMoE S{(NMT), 8, 17, C.nb, C.vcu}; pg8::EpiAdapt<EpiGlu> E{EpiGlu{P_HID}}; pg8::gemm_phase(C.lds, g, S, E, C.tid); } while (0)
#define MOE2_PHASE(NMT) do { pg8::Gemm g{P_HID, P_W2, DM, DM, nullptr}; pg8::OrderMoE S{(NMT), 4, 17, C.nb, C.vcu}; pg8::EpiAdapt<EpiGate> E{EpiGate{P_Y2, P_GATE}}; pg8::gemm_phase(C.lds, g, S, E, C.tid); } while (0)
#endif
#define WPREP_TAIL(NUNITS, LAYER) do { __syncthreads(); const int extra_ = (NUNITS) % C.nb, j_ = C.vcu - extra_; const size_t wo_ = (size_t)(LAYER) * NEXP * DM * DM; \
        if (j_ >= 0) wprep_span(C, j_ * 8 + C.wave, (C.nb - extra_) * 8, in_ptr(ws, I_MW1) + wo_, in_ptr(ws, I_MW3) + wo_, in_ptr(ws, I_MW2) + wo_, (bf16*)(ws + WS_W13), (bf16*)(ws + WS_W2)); } while (0)
#define RELAUNDER() do { int l_ = C.lane; asm volatile("" : "+v"(l_)); C.lane = l_; C.tid = (C.wave << 6) | l_; } while (0)
__global__ void __launch_bounds__(512, 2) fwd_kernel(Args a) {
    extern __shared__ __attribute__((aligned(16))) unsigned char smem[];
    Ctx C0; C0.lds = (LAS unsigned char*)smem; C0.tid = threadIdx.x; C0.lane = C0.tid & 63; C0.wave = __builtin_amdgcn_readfirstlane(C0.tid >> 6); C0.bid = blockIdx.x; C0.nb = gridDim.x;
    C0.vcu = (C0.nb % 8 == 0) ? (C0.bid % 8) * (C0.nb / 8) + C0.bid / 8 : C0.bid;
    volatile LAS unsigned* bst = (volatile LAS unsigned*)(C0.lds + LDS_BYTES - 16);
#if MEGA
    if (C0.tid == 0) { bst[0] = 0u; bst[1] = 0u; }
    __syncthreads();
    const unsigned bar_x = xcd_barrier_post((unsigned*)(a.ws + WS_CTL) + 4096, bst, C0.tid == 0).x;
#define SEAM() do { if (ph < hi) { XcdBarrier b2_; b2_.bar = (unsigned*)(ws + WS_CTL) + 4096; b2_.x = bar_x; b2_.st = bst; xcd_barrier(b2_, C.tid == 0); } } while (0)
#else
#define SEAM() do { } while (0)
#endif
#if MEGA
    constexpr int lo = 0, hi = N_PHASES;
#else
    const int lo = a.ph_lo, hi = a.ph_hi;
#endif
    int ph = 0;
#ifndef ONLY
#define ONLY -1
#endif
#ifndef REPMASK
#define REPMASK 0
#endif
#ifndef SITE_LO
#define SITE_LO 0
#define SITE_HI 99
#endif
#define PHASE(SITE, ...) do { if ((ONLY < 0 || ONLY == (SITE)) && (SITE) >= SITE_LO && (SITE) <= SITE_HI && ph >= lo && ph < hi) { Ctx C; C.lds = C0.lds; \
        { int w_ = C0.wave; asm volatile("" : "+s"(w_)); unsigned m_ = ~0u; asm volatile("" : "+s"(m_)); int l_ = (int)__builtin_amdgcn_mbcnt_hi(m_, __builtin_amdgcn_mbcnt_lo(m_, 0u)); C.wave = w_; C.lane = l_; C.tid = (w_ << 6) | l_; } \
        { int b_ = C0.bid, n_ = C0.nb, v_ = C0.vcu; asm volatile("" : "+s"(b_), "+s"(n_), "+s"(v_)); C.bid = b_; C.nb = n_; C.vcu = v_; } \
        unsigned z_ = 0u; asm volatile("" : "+s"(z_)); unsigned char* ws = a.ws + z_; float* XL = a.out + z_; const int lq = __builtin_amdgcn_readfirstlane(lp); typedef const __attribute__((address_space(1))) float* gfp_t; const gfp_t* INT_ = (const gfp_t*)(ws + WS_PTRS); (void)INT_; (void)XL; (void)lq; \
        for (int rep_ = 0; rep_ < ((((REPMASK) >> (SITE)) & 1) ? 2 : 1); ++rep_) { __VA_ARGS__; if ((((REPMASK) >> (SITE)) & 1)) __syncthreads(); } ++ph; SEAM(); } else ++ph; } while (0)

    { const int lp = 0;
      PHASE(0, { if (C.bid == 0) { _Pragma("unroll") for (int k = 0; k < 40; ++k) if (C.tid == k) ((const float**)(ws + WS_PTRS))[k] = a.in[k]; }
                 ph_prologue(C, a); }); }

    auto layer_pair = [&](auto lpc) __attribute__((always_inline)) {
        constexpr int lp = decltype(lpc)::value;
        if constexpr (lp == 0) PHASE(1, { const int i = 2 * lq; const float* xl = (i == 0) ? in_ptr(ws, I_X) : XL; const float* xc = (i == 0) ? in_ptr(ws, I_CTX) : P_XC;
                   ph_norm<false>(C, xl, xc, in_ptr(ws, I_N1G) + i * DM, MODL(i), 0, 1024, P_HB, nullptr, nullptr, nullptr, nullptr); });
        PHASE(2, { EpiBf16 E{P_U, EV_INP}; fast_gemm(C, P_HB, DM, (const bf16*)(ws + WS_WEVIN) + (size_t)lq * EV_INP * DM, DM, MT / 256, EV_INP / 256, E); });
        PHASE(3, { EpiBf16 Eq{(bf16*)P_QPRE, 768}; fast_gemm(C, P_U, EV_INP, (const bf16*)(ws + WS_WUQ) + (size_t)lq * 768 * 384, 384, MT / 256, 3, Eq); RELAUNDER();
                   EpiBf16 Ek{(bf16*)P_KVPRE, 1024}; fast_gemm(C, P_U + 384, EV_INP, (const bf16*)(ws + WS_WUKV) + (size_t)lq * 1024 * 256, 256, MT / 256, 4, Ek, true); });
        PHASE(4, { ph_mla_fin(C, P_U, (const bf16*)P_QPRE, (const bf16*)P_KVPRE, in_ptr(ws, I_QG) + lq * 96, in_ptr(ws, I_KG) + lq * 96, (const f32x2*)(ws + WS_ROPE), P_QB, P_KB, P_VT);
                   const int extra_ = (MT / 64) % C.nb, j_ = C.vcu - extra_;
                   if (j_ >= 0) { for (int q_ = 0; q_ < CONV_PER_TAIL; ++q_) { const int cu_ = j_ + q_ * (C.nb - extra_); if (cu_ >= conv_in_fin(C.nb)) break;
                       float wk[31]; const float* dww = in_ptr(ws, I_DWW) + (size_t)lq * 31 * 512;
                       _Pragma("unroll") for (int kt = 0; kt < 31; ++kt) wk[kt] = dww[kt * 512 + C.tid];
                       conv_unit(C, cu_, P_U, wk, in_ptr(ws, I_DWB)[lq * 512 + C.tid], in_ptr(ws, I_LNG) + lq * 512, in_ptr(ws, I_LNB) + lq * 512, P_OCAT); } } });
        PHASE(5, ph_attn_mla2(C, P_QB, P_KB, P_VT, P_OCAT, false, ws, lq));
        PHASE(6, { const int i = 2 * lq; const float* xl = (i == 0) ? in_ptr(ws, I_X) : XL; const float* xc = (i == 0) ? in_ptr(ws, I_CTX) : P_XC;
                   { EpiResid E{xl, xc, XL, P_XC, MODL(i) + 2048}; fast_gemm(C, P_OCAT, DM, (const bf16*)(ws + WS_WEVOUT) + (size_t)lq * DM * DM, DM, MT / 256, 4, E); }
                   WPREP_TAIL(MT / 256 * 4, i); });
        PHASE(7, { const int i = 2 * lq; ph_norm<true>(C, XL, P_XC, in_ptr(ws, I_N2G) + i * DM, MODL(i), 3072, 4096, P_HB, in_ptr(ws, I_ROUTER) + (size_t)i * DM * 16, P_AFFT, P_AFFC, P_SLOT); });
        PHASE(8, ph_topk2(C, P_AFFT, P_AFFC, P_ROWS, P_GATE, P_SLOT, false));
        PHASE(9, { MOE1_PHASE(17); });
        PHASE(10, { MOE2_PHASE(17); });
        PHASE(11, { const int i = 2 * lq; ph_combine(C, XL, P_XC, MODL(i) + 5120, P_SLOT, P_Y2, false, in_ptr(ws, I_N1G) + (i + 1) * DM, MODL(i + 1), P_HB); });
        PHASE(13, { EpiBf16 E{P_U, OD_INP}; fast_gemm(C, P_HB, DM, (const bf16*)(ws + WS_WODIN) + (size_t)lq * OD_INP * DM, DM, MT / 256, OD_INP / 256, E); });
        PHASE(14, ph_prep(C, P_U, in_ptr(ws, I_SHIFTW) + (size_t)lq * 3 * RW_IN, in_ptr(ws, I_KKW) + lq * 512, in_ptr(ws, I_NAQG) + lq * 64, in_ptr(ws, I_NAKG) + lq * 64, P_R, P_V, P_K, P_KK, P_L, P_QN, P_KN, P_VTN));
        PHASE(15, { const bf16* WL = (const bf16*)(ws + WS_WLORA) + (size_t)lq * 655360;
                    { EpiLoraW E{P_W, in_ptr(ws, I_W0) + lq * 1024}; fast_gemm(C, P_L, 384, WL, 256, MT / 256, 4, E); } RELAUNDER();
                    { EpiLoraA E{P_KEFF, in_ptr(ws, I_A0) + lq * 1024}; fast_gemm(C, P_L, 384, WL + (size_t)1024 * 256, 256, MT / 256, 4, E, false, MT / 256 * 4); } RELAUNDER();
                    { EpiBf16 E{P_G, 512}; fast_gemm(C, P_L + 128, 384, WL + (size_t)2048 * 256, 256, MT / 256, 2, E, false, MT / 256 * 8); } });
        PHASE(16, ph_wkv_pre(C, P_R, P_K, P_KK, P_W, P_KEFF, in_ptr(ws, I_KA) + lq * 512, P_IMG));
        PHASE(17, { ph_wkv_chunk(C, P_R, P_V, P_K, P_KK, P_W, P_KEFF, in_ptr(ws, I_KA) + lq * 512, P_IMG, P_YS); __syncthreads();
                    ph_natten2(C, P_QN, P_KN, P_VTN, P_OCAT, in_ptr(ws, I_RPB) + (size_t)lq * 8 * 465, lq == 1, (unsigned*)(ws + WS_CTL) + 8192 + 64 * lq, ws, lq); });
        PHASE(18, ph_post(C, P_YS, P_R, P_V, P_K, P_KEFF, in_ptr(ws, I_KA) + lq * 512, P_G, in_ptr(ws, I_RK) + lq * 512, in_ptr(ws, I_GNG) + lq * 512, in_ptr(ws, I_GNB) + lq * 512, P_OCAT, lq == 1));
        PHASE(19, { const int i = 2 * lq + 1; EpiResid E{XL, P_XC, XL, P_XC, MODL(i) + 2048};
                    fast_gemm(C, P_OCAT, DM, (const bf16*)(ws + WS_WODOUT) + (size_t)lq * DM * DM, DM, (lq == 1) ? NLAT / 256 : MT / 256, 4, E);
                    WPREP_TAIL(((lq == 1) ? NLAT / 256 : MT / 256) * 4, i); });
        PHASE(20, { const int i = 2 * lq + 1; ph_norm<true>(C, XL, P_XC, in_ptr(ws, I_N2G) + i * DM, MODL(i), 3072, 4096, P_HB, in_ptr(ws, I_ROUTER) + (size_t)i * DM * 16, P_AFFT, P_AFFC, P_SLOT); });
        PHASE(21, ph_topk2(C, P_AFFT, P_AFFC, P_ROWS, P_GATE, P_SLOT, lq == 1));
        PHASE(22, { MOE1_PHASE((lq == 1) ? 16 : 17); });
        PHASE(23, { MOE2_PHASE((lq == 1) ? 16 : 17); });
        PHASE(24, { const int i = 2 * lq + 1;
                    if (lp == 0) ph_combine(C, XL, P_XC, MODL(i) + 5120, P_SLOT, P_Y2, false, in_ptr(ws, I_N1G) + (i + 1) * DM, MODL(i + 1), P_HB);
                    else ph_combine(C, XL, P_XC, MODL(i) + 5120, P_SLOT, P_Y2, true, nullptr, nullptr, nullptr); });
    };
    layer_pair(IC<0>{}); layer_pair(IC<1>{});
}

extern "C" void kernel_launch(void* const* d_in, const int* in_sizes, int n_in, void* d_out, int out_size, void* d_ws, size_t ws_size, hipStream_t stream) {
    static int grid = 0;
    if (grid == 0) {
        if (n_in != 40 || out_size != NLAT * DM || ws_size < WS_END) { fprintf(stderr, "kernel_launch: unexpected shapes (n_in %d out %d ws %zu need %zu)\n", n_in, out_size, ws_size, (size_t)WS_END); grid = -1; return; }
        int dev = 0, cus = 0, per_cu = 0;
        if (hipGetDevice(&dev) != hipSuccess || hipDeviceGetAttribute(&cus, hipDeviceAttributeMultiprocessorCount, dev) != hipSuccess) { grid = -1; return; }
        if (hipFuncSetAttribute((const void*)fwd_kernel, hipFuncAttributeMaxDynamicSharedMemorySize, LDS_BYTES) != hipSuccess) { fprintf(stderr, "kernel_launch: hipFuncSetAttribute failed\n"); grid = -1; return; }
        if (hipOccupancyMaxActiveBlocksPerMultiprocessor(&per_cu, (const void*)fwd_kernel, 512, LDS_BYTES) != hipSuccess || per_cu < 1) { fprintf(stderr, "kernel_launch: occupancy query says %d\n", per_cu); per_cu = 1; }
        (void)hipGetLastError();
        grid = cus;
    }
    if (grid < 0) return;
    (void)hipMemsetAsync((char*)d_ws + WS_CTL, 0, CTL_BYTES, stream);
    Args a{};
    for (int i = 0; i < 40; ++i) a.in[i] = (const float*)d_in[i];
    a.out = (float*)d_out; a.ws = (unsigned char*)d_ws;
#if MEGA
    a.ph_lo = 0; a.ph_hi = N_PHASES;
    hipLaunchKernelGGL(fwd_kernel, dim3(grid), dim3(512), LDS_BYTES, stream, a);
#else
    for (int p = 0; p < N_PHASES; ++p) { a.ph_lo = p; a.ph_hi = p + 1; hipLaunchKernelGGL(fwd_kernel, dim3(grid), dim3(512), LDS_BYTES, stream, a); }
#endif
}
```
